# Optimizing an MI355X kernel written in HIP

```python
import jax, jax.numpy as jnp
from jax import lax
import numpy as np

D_MODEL = 1024
BATCH = 16
SEQ = 2048
DEPTH = 1

N_MEM = 256
XATTN_HEADS = 4
XATTN_HEAD_DIM = D_MODEL // XATTN_HEADS
CONV_WIDTH = D_MODEL // 2
CONV_K = 3
ATTN_HEADS = 8
HEAD_DIM = 64
ATTN_WIDTH = ATTN_HEADS * HEAD_DIM
MOBA_BLOCK = 256
MOBA_TOPK = 3
MOBA_Q_CHUNK = 32
ROPE_THETA = 10000.0
N_BRANCH = 2
IN_PROJ_WIDTH = 3 * CONV_WIDTH + 3 * ATTN_WIDTH + N_BRANCH * D_MODEL
PEER_HEADS = 8
PEER_N_KEYS = 128
PEER_N_EXPERTS = PEER_N_KEYS * PEER_N_KEYS
PEER_QUERY_DIM = 256
PEER_HALF = PEER_QUERY_DIM // 2
PEER_TOPK = 16
PEER_TOKEN_CHUNK = 128

EPS = 1e-6
MASK_VALUE = -1e30

kernel_name = "hybrid_conv_moba_xattn_peer_block"


def rmsnorm(x, g):
    xf = x.astype(jnp.float32)
    y = xf * lax.rsqrt(jnp.mean(xf * xf, axis=-1, keepdims=True) + EPS)
    return (y * g.astype(jnp.float32)).astype(x.dtype)


def rope(x):
    s, hd = x.shape[2], x.shape[3]
    half = hd // 2
    inv = ROPE_THETA ** (-jnp.arange(half, dtype=jnp.float32) / half)
    ang = jnp.arange(s, dtype=jnp.float32)[:, None] * inv[None, :]
    cos, sin = jnp.cos(ang), jnp.sin(ang)
    xf = x.astype(jnp.float32)
    x1, x2 = xf[..., :half], xf[..., half:]
    out = jnp.concatenate([x1 * cos - x2 * sin, x2 * cos + x1 * sin], axis=-1)
    return out.astype(x.dtype)


def short_gated_conv(xin, b_gate, c_gate, w_conv):
    u = c_gate * xin
    ch = u.shape[-1]
    y = lax.conv_general_dilated(
        u, w_conv.reshape(CONV_K, 1, ch), window_strides=(1,),
        padding=[(CONV_K - 1, 0)], dimension_numbers=("NWC", "WIO", "NWC"),
        feature_group_count=ch)
    return b_gate * y


def moba_attention(q, k, v):
    b, h, s, hd = q.shape
    n_blk = -(-s // MOBA_BLOCK)
    pad = n_blk * MOBA_BLOCK - s
    kb = jnp.pad(k, ((0, 0), (0, 0), (0, pad), (0, 0))).reshape(b, h, n_blk, MOBA_BLOCK, hd)
    vb = jnp.pad(v, ((0, 0), (0, 0), (0, pad), (0, 0))).reshape(b, h, n_blk, MOBA_BLOCK, hd)
    kbar = jnp.mean(kb.astype(jnp.float32), axis=3)
    q_blk = jnp.arange(s) // MOBA_BLOCK
    gate = jnp.einsum("bhsd,bhnd->bhsn", q.astype(jnp.float32), kbar)
    past = jnp.arange(n_blk)[None, :] < q_blk[:, None]
    gate = jnp.where(past, gate, MASK_VALUE)
    if n_blk > 1:
        _, sel = lax.top_k(gate, min(MOBA_TOPK, n_blk - 1))
    else:
        sel = jnp.zeros((b, h, s, 1), dtype=jnp.int32)
    n_sel = sel.shape[-1]
    scale = hd ** -0.5
    n_chunk = s // MOBA_Q_CHUNK
    q_c = q.reshape(b, h, n_chunk, MOBA_Q_CHUNK, hd).transpose(2, 0, 1, 3, 4)
    sel_c = sel.reshape(b, h, n_chunk, MOBA_Q_CHUNK, n_sel).transpose(2, 0, 1, 3, 4)
    gather_blocks = jax.vmap(jax.vmap(lambda t, i: t[i]))

    def step(args):
        c, qc, selc = args
        start = c * MOBA_Q_CHUNK
        b_own = start // MOBA_BLOCK
        k_own = lax.dynamic_index_in_dim(kb, b_own, axis=2, keepdims=False)
        v_own = lax.dynamic_index_in_dim(vb, b_own, axis=2, keepdims=False)
        q_pos = start + jnp.arange(MOBA_Q_CHUNK)
        k_pos = b_own * MOBA_BLOCK + jnp.arange(MOBA_BLOCK)
        s_own = jnp.einsum("bhqd,bhkd->bhqk", qc, k_own).astype(jnp.float32) * scale
        s_own = jnp.where(k_pos[None, :] <= q_pos[:, None], s_own, MASK_VALUE)
        k_sel = gather_blocks(kb, selc)
        v_sel = gather_blocks(vb, selc)
        s_sel = jnp.einsum("bhqd,bhqnkd->bhqnk", qc, k_sel).astype(jnp.float32) * scale
        ok = selc < b_own
        s_sel = jnp.where(ok[..., None], s_sel, MASK_VALUE)
        scores = jnp.concatenate(
            [s_sel.reshape(b, h, MOBA_Q_CHUNK, n_sel * MOBA_BLOCK), s_own], axis=-1)
        p = jax.nn.softmax(scores, axis=-1).astype(v.dtype)
        p_sel = p[..., :n_sel * MOBA_BLOCK].reshape(b, h, MOBA_Q_CHUNK, n_sel, MOBA_BLOCK)
        p_own = p[..., n_sel * MOBA_BLOCK:]
        return (jnp.einsum("bhqnk,bhqnkd->bhqd", p_sel, v_sel)
                + jnp.einsum("bhqk,bhkd->bhqd", p_own, v_own))

    out = lax.map(step, (jnp.arange(n_chunk), q_c, sel_c))
    return out.transpose(1, 2, 0, 3, 4).reshape(b, h, s, hd)


def memory_cross_attention(a, mem_n, w_q, w_kv, w_o):
    b, s, d = a.shape
    q = (a @ w_q).reshape(b, s, XATTN_HEADS, XATTN_HEAD_DIM)
    k, v = jnp.split(mem_n @ w_kv, 2, axis=-1)
    k = k.reshape(b, -1, XATTN_HEADS, XATTN_HEAD_DIM)
    v = v.reshape(b, -1, XATTN_HEADS, XATTN_HEAD_DIM)
    scores = jnp.einsum("bshd,bmhd->bhsm", q, k).astype(jnp.float32) * (XATTN_HEAD_DIM ** -0.5)
    p = jax.nn.softmax(scores, axis=-1).astype(v.dtype)
    o = jnp.einsum("bhsm,bmhd->bshd", p, v).reshape(b, s, d)
    return o @ w_o


def peer_ffn(a, w_pq, sub_keys, u, v):
    b, s, d = a.shape
    q = (a @ w_pq).reshape(b, s, PEER_HEADS, 2, PEER_HALF)
    s_half = jnp.einsum("bshpd,hpnd->bshpn", q, sub_keys).astype(jnp.float32)
    v_half, i_half = lax.top_k(s_half, PEER_TOPK)
    cand = v_half[..., 0, :, None] + v_half[..., 1, None, :]
    cand_idx = i_half[..., 0, :, None] * PEER_N_KEYS + i_half[..., 1, None, :]
    cand = cand.reshape(b, s, PEER_HEADS, PEER_TOPK * PEER_TOPK)
    cand_idx = cand_idx.reshape(b, s, PEER_HEADS, PEER_TOPK * PEER_TOPK)
    top_s, pos = lax.top_k(cand, PEER_TOPK)
    expert = jnp.take_along_axis(cand_idx, pos, axis=-1)
    g = jax.nn.softmax(top_s, axis=-1).astype(a.dtype)
    n_tok = b * s
    n_chunk = n_tok // PEER_TOKEN_CHUNK
    n_sel = PEER_HEADS * PEER_TOPK
    x_c = a.reshape(n_chunk, PEER_TOKEN_CHUNK, d)
    e_c = expert.reshape(n_chunk, PEER_TOKEN_CHUNK, n_sel)
    g_c = g.reshape(n_chunk, PEER_TOKEN_CHUNK, n_sel)

    def step(args):
        xc, ec, gc = args
        act = jax.nn.gelu(jnp.einsum("cd,ced->ce", xc, u[ec]))
        return jnp.einsum("ce,ced->cd", gc * act, v[ec])

    return lax.map(step, (x_c, e_c, g_c)).reshape(b, s, d)


def setup_inputs(seed: int = 0) -> dict:
    key = jax.random.key(seed)
    ks = jax.random.split(key, 20)
    f32 = jnp.float32
    nrm = lambda k, shape, sc: jax.random.normal(k, shape, f32) * sc
    gain = lambda k, shape: 1.0 + 0.02 * jax.random.normal(k, shape, f32)
    L, D = DEPTH, D_MODEL
    return {
        "x": nrm(ks[0], (BATCH, SEQ, D), 1.0),
        "mem": nrm(ks[1], (BATCH, N_MEM, D), 1.0),
        "g_mix": gain(ks[2], (L, D)),
        "w_in": nrm(ks[3], (L, D, IN_PROJ_WIDTH), D ** -0.5),
        "w_conv": nrm(ks[4], (L, CONV_K, CONV_WIDTH), CONV_K ** -0.5),
        "w_conv_out": nrm(ks[5], (L, CONV_WIDTH, D), CONV_WIDTH ** -0.5),
        "w_attn_out": nrm(ks[6], (L, ATTN_WIDTH, D), ATTN_WIDTH ** -0.5),
        "w_merge": nrm(ks[7], (L, D, D), D ** -0.5),
        "g_xattn": gain(ks[8], (L, D)),
        "g_mem": gain(ks[9], (L, D)),
        "w_xq": nrm(ks[10], (L, D, D), D ** -0.5),
        "w_xkv": nrm(ks[11], (L, D, 2 * D), D ** -0.5),
        "w_xo": nrm(ks[12], (L, D, D), D ** -0.5),
        "g_ffn": gain(ks[13], (L, D)),
        "w_pq": nrm(ks[14], (L, D, PEER_HEADS * PEER_QUERY_DIM), D ** -0.5),
        "peer_sub_keys": nrm(ks[15], (L, PEER_HEADS, 2, PEER_N_KEYS, PEER_HALF), PEER_HALF ** -0.5),
        "peer_u": nrm(ks[16], (L, PEER_N_EXPERTS, D), D ** -0.5),
        "peer_v": nrm(ks[17], (L, PEER_N_EXPERTS, D), PEER_HEADS ** -0.5),
        "g_final": gain(ks[18], (D,)),
    }


def reference(x, mem, g_mix, w_in, w_conv, w_conv_out, w_attn_out, w_merge, g_xattn, g_mem,
              w_xq, w_xkv, w_xo, g_ffn, w_pq, peer_sub_keys, peer_u, peer_v, g_final):
    b, s, d = x.shape
    cw, aw = CONV_WIDTH, ATTN_WIDTH
    splits = [cw, 2 * cw, 3 * cw, 3 * cw + aw, 3 * cw + 2 * aw, 3 * cw + 3 * aw,
              3 * cw + 3 * aw + d]
    h = x
    for l in range(DEPTH):
        a = rmsnorm(h, g_mix[l])
        xin, b_gate, c_gate, q, k, v, gate_conv, gate_attn = jnp.split(a @ w_in[l], splits, axis=-1)
        y_conv = short_gated_conv(xin, b_gate, c_gate, w_conv[l]) @ w_conv_out[l]
        to_heads = lambda t: t.reshape(b, s, ATTN_HEADS, HEAD_DIM).transpose(0, 2, 1, 3)
        o = moba_attention(rope(to_heads(q)), rope(to_heads(k)), to_heads(v))
        y_attn = o.transpose(0, 2, 1, 3).reshape(b, s, aw) @ w_attn_out[l]
        merged = jax.nn.sigmoid(gate_conv) * y_conv + jax.nn.sigmoid(gate_attn) * y_attn
        h = h + merged @ w_merge[l]
        h = h + memory_cross_attention(rmsnorm(h, g_xattn[l]), rmsnorm(mem, g_mem[l]),
                                       w_xq[l], w_xkv[l], w_xo[l])
        h = h + peer_ffn(rmsnorm(h, g_ffn[l]), w_pq[l], peer_sub_keys[l], peer_u[l], peer_v[l])
    return rmsnorm(h, g_final)
```

```cpp
#include <hip/hip_runtime.h>
#include <cstdio>
#include <cstdint>

namespace orc {
constexpr int D = 1024, B = 16, S = 2048, NMEM = 256, XH = 4, XHD = 256, CW = 512, AH = 8, HD = 64, AW = 512;
constexpr int MBLK = 256, NBLK = S / MBLK, TOPK = 3, INW = 5120;
constexpr int PH = 8, PNK = 128, PQD = 256, PHALF = 128, PTOPK = 16, NEXP = PNK * PNK;
constexpr float EPS = 1e-6f;
constexpr int C_XIN = 0, C_B = 512, C_C = 1024, C_Q = 1536, C_K = 2048, C_V = 2560, C_GC = 3072, C_GA = 4096;

__device__ __forceinline__ float wave_sum(float v) {
#pragma unroll
    for (int o = 1; o < 64; o <<= 1) v += __shfl_xor(v, o);
    return v;
}
__device__ __forceinline__ float wave_max(float v) {
#pragma unroll
    for (int o = 1; o < 64; o <<= 1) v = fmaxf(v, __shfl_xor(v, o));
    return v;
}

__global__ void __launch_bounds__(256) k_rmsnorm(const float* __restrict__ x, const float* __restrict__ g, float* __restrict__ y, int rows) {
    const int row = blockIdx.x * 4 + (threadIdx.x >> 6), lane = threadIdx.x & 63;
    if (row >= rows) return;
    const float* xr = x + (size_t)row * D; float* yr = y + (size_t)row * D;
    float v[16]; float s = 0.f;
#pragma unroll
    for (int j = 0; j < 16; ++j) { v[j] = xr[lane + 64 * j]; s += v[j] * v[j]; }
    s = wave_sum(s);
    const float r = rsqrtf(s * (1.f / D) + EPS);
#pragma unroll
    for (int j = 0; j < 16; ++j) yr[lane + 64 * j] = v[j] * r * g[lane + 64 * j];
}

__global__ void __launch_bounds__(256) k_gemm(const float* __restrict__ A, int lda, const float* __restrict__ Bm, int ldb, float* C, int ldc,
                                              const float* R, int K) {
    __shared__ float As[16][64 + 4];
    __shared__ float Bs[16][64 + 4];
    const int tx = threadIdx.x & 15, ty = threadIdx.x >> 4;
    const int m0 = blockIdx.y * 64, n0 = blockIdx.x * 64;
    float acc[4][4];
#pragma unroll
    for (int i = 0; i < 4; ++i)
#pragma unroll
        for (int j = 0; j < 4; ++j) acc[i][j] = 0.f;
    for (int k0 = 0; k0 < K; k0 += 16) {
#pragma unroll
        for (int i = 0; i < 4; ++i) { const int idx = threadIdx.x + 256 * i; const int r = idx >> 4, c = idx & 15; As[c][r] = A[(size_t)(m0 + r) * lda + k0 + c]; }
#pragma unroll
        for (int i = 0; i < 4; ++i) { const int idx = threadIdx.x + 256 * i; const int r = idx >> 6, c = idx & 63; Bs[r][c] = Bm[(size_t)(k0 + r) * ldb + n0 + c]; }
        __syncthreads();
#pragma unroll
        for (int kk = 0; kk < 16; ++kk) {
            float a[4], b[4];
#pragma unroll
            for (int i = 0; i < 4; ++i) a[i] = As[kk][ty * 4 + i];
#pragma unroll
            for (int j = 0; j < 4; ++j) b[j] = Bs[kk][tx * 4 + j];
#pragma unroll
            for (int i = 0; i < 4; ++i)
#pragma unroll
                for (int j = 0; j < 4; ++j) acc[i][j] += a[i] * b[j];
        }
        __syncthreads();
    }
#pragma unroll
    for (int i = 0; i < 4; ++i)
#pragma unroll
        for (int j = 0; j < 4; ++j) { const size_t o = (size_t)(m0 + ty * 4 + i) * ldc + n0 + tx * 4 + j; C[o] = acc[i][j] + (R ? R[o] : 0.f); }
}

__global__ void __launch_bounds__(256) k_rope(float* __restrict__ P) {
    const int idx = blockIdx.x * 256 + threadIdx.x;
    const int i = idx & 31, h = (idx >> 5) & 7, qk = (idx >> 8) & 1, s = idx >> 9;
    if (s >= S) return;
    const float inv = powf(10000.0f, -(float)i / 32.0f);
    const float ang = (float)s * inv;
    const float c = cosf(ang), sn = sinf(ang);
    float* p = P + (size_t)s * INW + (qk ? C_K : C_Q) + h * HD;
    const float x1 = p[i], x2 = p[i + 32];
    p[i] = x1 * c - x2 * sn; p[i + 32] = x2 * c + x1 * sn;
}

__global__ void __launch_bounds__(256) k_conv(const float* __restrict__ P, const float* __restrict__ wconv, float* __restrict__ yc) {
    const int idx = blockIdx.x * 256 + threadIdx.x; const int c = idx & 511, s = idx >> 9;
    if (s >= S) return;
    float y = 0.f;
#pragma unroll
    for (int k = 0; k < 3; ++k) { const int ss = s - 2 + k; if (ss >= 0) { const float* pr = P + (size_t)ss * INW; y += wconv[k * CW + c] * (pr[C_C + c] * pr[C_XIN + c]); } }
    yc[(size_t)s * CW + c] = P[(size_t)s * INW + C_B + c] * y;
}

__global__ void __launch_bounds__(64) k_kbar(const float* __restrict__ P, float* __restrict__ kbar) {
    const int h = blockIdx.x >> 3, n = blockIdx.x & 7, d = threadIdx.x;
    float s = 0.f;
    for (int j = 0; j < MBLK; ++j) s += P[(size_t)(n * MBLK + j) * INW + C_K + h * HD + d];
    kbar[(h * NBLK + n) * HD + d] = s * (1.f / MBLK);
}

__global__ void __launch_bounds__(256) k_moba(const float* __restrict__ P, const float* __restrict__ kbar, float* __restrict__ o) {
    __shared__ float q[HD];
    __shared__ float sc[S];
    __shared__ float red[256];
    __shared__ int selmask;
    __shared__ float gate[NBLK];
    const int s = blockIdx.x >> 3, h = blockIdx.x & 7, tid = threadIdx.x;
    const int bown = s / MBLK;
    if (tid < HD) q[tid] = P[(size_t)s * INW + C_Q + h * HD + tid];
    __syncthreads();
    if (tid < NBLK) { float g = 0.f; for (int d = 0; d < HD; ++d) g += q[d] * kbar[(h * NBLK + tid) * HD + d]; gate[tid] = g; }
    __syncthreads();
    if (tid == 0) {
        int m = 0;
        for (int r = 0; r < TOPK; ++r) { int best = -1; float bv = 0.f; for (int n = 0; n < bown; ++n) if (!((m >> n) & 1) && (best < 0 || gate[n] > bv)) { best = n; bv = gate[n]; } if (best >= 0) m |= 1 << best; }
        selmask = m;
    }
    __syncthreads();
    const int m = selmask;
    float mx = -3.0e38f;
    for (int j = tid; j < S; j += 256) {
        const int kb = j / MBLK; const bool ok = (kb == bown) ? (j <= s) : ((m >> kb) & 1);
        float v = -3.0e38f;
        if (ok) { const float* kr = P + (size_t)j * INW + C_K + h * HD; float a = 0.f; for (int d = 0; d < HD; ++d) a += q[d] * kr[d]; v = a * 0.125f; }
        sc[j] = v; mx = fmaxf(mx, v);
    }
    red[tid] = mx; __syncthreads();
    for (int st = 128; st > 0; st >>= 1) { if (tid < st) red[tid] = fmaxf(red[tid], red[tid + st]); __syncthreads(); }
    mx = red[0]; __syncthreads();
    float sum = 0.f;
    for (int j = tid; j < S; j += 256) { const float v = sc[j]; const float p = (v > -1.0e38f) ? expf(v - mx) : 0.f; sc[j] = p; sum += p; }
    red[tid] = sum; __syncthreads();
    for (int st = 128; st > 0; st >>= 1) { if (tid < st) red[tid] += red[tid + st]; __syncthreads(); }
    sum = red[0]; __syncthreads();
    const int d = tid & 63, part = tid >> 6;
    float acc = 0.f;
    for (int j = part; j <= s; j += 4) { const float p = sc[j]; if (p != 0.f) acc += p * P[(size_t)j * INW + C_V + h * HD + d]; }
    red[tid] = acc; __syncthreads();
    if (tid < 64) o[(size_t)s * AW + h * HD + tid] = (red[tid] + red[tid + 64] + red[tid + 128] + red[tid + 192]) / sum;
}

__global__ void __launch_bounds__(256) k_merge(const float* __restrict__ P, const float* __restrict__ yconv, const float* __restrict__ yattn, float* __restrict__ merged) {
    const int idx = blockIdx.x * 256 + threadIdx.x; const int c = idx & 1023, s = idx >> 10;
    if (s >= S) return;
    const float gc = P[(size_t)s * INW + C_GC + c], ga = P[(size_t)s * INW + C_GA + c];
    merged[idx] = yconv[idx] / (1.f + expf(-gc)) + yattn[idx] / (1.f + expf(-ga));
}

__global__ void __launch_bounds__(256) k_xattn(const float* __restrict__ qx, const float* __restrict__ kv, float* __restrict__ ox) {
    __shared__ float q[XHD];
    __shared__ float p[NMEM];
    __shared__ float red[256];
    const int s = blockIdx.x >> 2, h = blockIdx.x & 3, tid = threadIdx.x;
    q[tid] = qx[(size_t)s * D + h * XHD + tid];
    __syncthreads();
    const float* kr = kv + (size_t)tid * (2 * D) + h * XHD;
    float a = 0.f;
    for (int d = 0; d < XHD; ++d) a += q[d] * kr[d];
    a *= 0.0625f;
    red[tid] = a; __syncthreads();
    for (int st = 128; st > 0; st >>= 1) { if (tid < st) red[tid] = fmaxf(red[tid], red[tid + st]); __syncthreads(); }
    const float mx = red[0]; __syncthreads();
    const float e = expf(a - mx); p[tid] = e; red[tid] = e; __syncthreads();
    for (int st = 128; st > 0; st >>= 1) { if (tid < st) red[tid] += red[tid + st]; __syncthreads(); }
    const float sum = red[0];
    float acc = 0.f;
    for (int m = 0; m < NMEM; ++m) acc += p[m] * kv[(size_t)m * (2 * D) + D + h * XHD + tid];
    ox[(size_t)s * D + h * XHD + tid] = acc / sum;
}

__global__ void __launch_bounds__(256) k_shalf(const float* __restrict__ pq, const float* __restrict__ sk, float* __restrict__ sh) {
    const int idx = blockIdx.x * 256 + threadIdx.x; const int n = idx & 127, hp = (idx >> 7) & 15, s = idx >> 11;
    if (s >= S) return;
    const float* qr = pq + (size_t)s * 2048 + hp * 128; const float* kr = sk + ((size_t)hp * 128 + n) * 128;
    float a = 0.f;
    for (int d = 0; d < 128; ++d) a += qr[d] * kr[d];
    sh[idx] = a;
}

__global__ void __launch_bounds__(64) k_route(const float* __restrict__ sh, int* __restrict__ eidx, float* __restrict__ gw) {
    const int s = blockIdx.x >> 3, h = blockIdx.x & 7, lane = threadIdx.x;
    __shared__ float tv[2][16];
    __shared__ int ti[2][16];
    for (int p = 0; p < 2; ++p) {
        const float* r = sh + (size_t)s * 2048 + (h * 2 + p) * 128;
        float v0 = r[lane], v1 = r[lane + 64];
        for (int it = 0; it < 16; ++it) {
            float bv; int bi;
            if (v0 >= v1) { bv = v0; bi = lane; } else { bv = v1; bi = lane + 64; }
#pragma unroll
            for (int o = 1; o < 64; o <<= 1) { const float ov = __shfl_xor(bv, o); const int oi = __shfl_xor(bi, o); if (ov > bv || (ov == bv && oi < bi)) { bv = ov; bi = oi; } }
            if (lane == 0) { tv[p][it] = bv; ti[p][it] = bi; }
            if (bi == lane) v0 = -3.0e38f; if (bi == lane + 64) v1 = -3.0e38f;
        }
    }
    __syncthreads();
    float cv[4];
#pragma unroll
    for (int j = 0; j < 4; ++j) { const int c = lane + 64 * j; cv[j] = tv[0][c >> 4] + tv[1][c & 15]; }
    __shared__ float sv[16];
    __shared__ int sc[16];
    for (int it = 0; it < 16; ++it) {
        float bv = cv[0]; int bi = lane;
#pragma unroll
        for (int j = 1; j < 4; ++j) if (cv[j] > bv) { bv = cv[j]; bi = lane + 64 * j; }
#pragma unroll
        for (int o = 1; o < 64; o <<= 1) { const float ov = __shfl_xor(bv, o); const int oi = __shfl_xor(bi, o); if (ov > bv || (ov == bv && oi < bi)) { bv = ov; bi = oi; } }
        if (lane == 0) { sv[it] = bv; sc[it] = bi; }
#pragma unroll
        for (int j = 0; j < 4; ++j) if (bi == lane + 64 * j) cv[j] = -3.0e38f;
    }
    __syncthreads();
    if (lane < 16) {
        const float mx = sv[0];
        float sum = 0.f;
        for (int j = 0; j < 16; ++j) sum += expf(sv[j] - mx);
        const int c = sc[lane];
        eidx[(size_t)s * 128 + h * 16 + lane] = ti[0][c >> 4] * PNK + ti[1][c & 15];
        gw[(size_t)s * 128 + h * 16 + lane] = expf(sv[lane] - mx) / sum;
    }
}

__device__ __forceinline__ float gelu_tanh(float x) { const float u = 0.7978845608028654f * (x + 0.044715f * x * x * x); return 0.5f * x * (1.f + tanhf(u)); }

__global__ void __launch_bounds__(256) k_peer_u(const float* __restrict__ a3, const float* __restrict__ U, const int* __restrict__ eidx, const float* __restrict__ gw, float* __restrict__ w) {
    const int pair = blockIdx.x * 4 + (threadIdx.x >> 6), lane = threadIdx.x & 63;
    const int s = pair >> 7;
    const float* xr = a3 + (size_t)s * D; const float* ur = U + (size_t)eidx[pair] * D;
    float a = 0.f;
#pragma unroll
    for (int j = 0; j < 16; ++j) a += xr[lane + 64 * j] * ur[lane + 64 * j];
    a = wave_sum(a);
    if (lane == 0) w[pair] = gw[pair] * gelu_tanh(a);
}

__global__ void __launch_bounds__(256) k_peer_v_final(const float* __restrict__ V, const int* __restrict__ eidx, const float* __restrict__ w, float* __restrict__ hio, const float* __restrict__ gfin) {
    __shared__ float red[4];
    const int s = blockIdx.x, tid = threadIdx.x;
    float acc[4] = {0.f, 0.f, 0.f, 0.f};
    for (int j = 0; j < 128; ++j) {
        const float ww = w[(size_t)s * 128 + j]; const float* vr = V + (size_t)eidx[(size_t)s * 128 + j] * D;
#pragma unroll
        for (int i = 0; i < 4; ++i) acc[i] += ww * vr[tid + 256 * i];
    }
    float ss = 0.f;
#pragma unroll
    for (int i = 0; i < 4; ++i) { acc[i] += hio[(size_t)s * D + tid + 256 * i]; ss += acc[i] * acc[i]; }
    ss = wave_sum(ss);
    if ((tid & 63) == 0) red[tid >> 6] = ss;
    __syncthreads();
    const float r = rsqrtf((red[0] + red[1] + red[2] + red[3]) * (1.f / D) + EPS);
#pragma unroll
    for (int i = 0; i < 4; ++i) hio[(size_t)s * D + tid + 256 * i] = acc[i] * r * gfin[tid + 256 * i];
}

struct Scratch { float *a, *P, *yc, *o, *yconv, *yattn, *merged, *kbar, *memn, *kv, *qx, *ox, *pq, *sh, *gw, *w; int* eidx; };

static void gemm(hipStream_t st, const float* A, int lda, const float* Bm, int ldb, float* C, int ldc, const float* R, int M, int N, int K) {
    hipLaunchKernelGGL(k_gemm, dim3(N / 64, M / 64), dim3(256), 0, st, A, lda, Bm, ldb, C, ldc, R, K);
}

static void forward_batch(hipStream_t st, void* const* d_in, float* out, const Scratch& z, int b) {
    const float* x = (const float*)d_in[0] + (size_t)b * S * D; const float* mem = (const float*)d_in[1] + (size_t)b * NMEM * D;
    const float *g_mix = (const float*)d_in[2], *w_in = (const float*)d_in[3], *w_conv = (const float*)d_in[4], *w_conv_out = (const float*)d_in[5], *w_attn_out = (const float*)d_in[6],
                *w_merge = (const float*)d_in[7], *g_xattn = (const float*)d_in[8], *g_mem = (const float*)d_in[9], *w_xq = (const float*)d_in[10], *w_xkv = (const float*)d_in[11],
                *w_xo = (const float*)d_in[12], *g_ffn = (const float*)d_in[13], *w_pq = (const float*)d_in[14], *sub_keys = (const float*)d_in[15], *peer_u = (const float*)d_in[16],
                *peer_v = (const float*)d_in[17], *g_final = (const float*)d_in[18];
    float* h = out + (size_t)b * S * D;
    hipLaunchKernelGGL(k_rmsnorm, dim3(S / 4), dim3(256), 0, st, x, g_mix, z.a, S);
    gemm(st, z.a, D, w_in, INW, z.P, INW, nullptr, S, INW, D);
    hipLaunchKernelGGL(k_rope, dim3(S * 2 * 8 * 32 / 256), dim3(256), 0, st, z.P);
    hipLaunchKernelGGL(k_conv, dim3(S * CW / 256), dim3(256), 0, st, z.P, w_conv, z.yc);
    hipLaunchKernelGGL(k_kbar, dim3(AH * NBLK), dim3(64), 0, st, z.P, z.kbar);
    hipLaunchKernelGGL(k_moba, dim3(S * AH), dim3(256), 0, st, z.P, z.kbar, z.o);
    gemm(st, z.yc, CW, w_conv_out, D, z.yconv, D, nullptr, S, D, CW);
    gemm(st, z.o, AW, w_attn_out, D, z.yattn, D, nullptr, S, D, AW);
    hipLaunchKernelGGL(k_merge, dim3(S * D / 256), dim3(256), 0, st, z.P, z.yconv, z.yattn, z.merged);
    gemm(st, z.merged, D, w_merge, D, h, D, x, S, D, D);
    hipLaunchKernelGGL(k_rmsnorm, dim3(S / 4), dim3(256), 0, st, h, g_xattn, z.a, S);
    hipLaunchKernelGGL(k_rmsnorm, dim3(NMEM / 4), dim3(256), 0, st, mem, g_mem, z.memn, NMEM);
    gemm(st, z.a, D, w_xq, D, z.qx, D, nullptr, S, D, D);
    gemm(st, z.memn, D, w_xkv, 2 * D, z.kv, 2 * D, nullptr, NMEM, 2 * D, D);
    hipLaunchKernelGGL(k_xattn, dim3(S * XH), dim3(256), 0, st, z.qx, z.kv, z.ox);
    gemm(st, z.ox, D, w_xo, D, h, D, h, S, D, D);
    hipLaunchKernelGGL(k_rmsnorm, dim3(S / 4), dim3(256), 0, st, h, g_ffn, z.a, S);
    gemm(st, z.a, D, w_pq, 2048, z.pq, 2048, nullptr, S, 2048, D);
    hipLaunchKernelGGL(k_shalf, dim3(S * 2048 / 256), dim3(256), 0, st, z.pq, sub_keys, z.sh);
    hipLaunchKernelGGL(k_route, dim3(S * PH), dim3(64), 0, st, z.sh, z.eidx, z.gw);
    hipLaunchKernelGGL(k_peer_u, dim3(S * 128 / 4), dim3(256), 0, st, z.a, peer_u, z.eidx, z.gw, z.w);
    hipLaunchKernelGGL(k_peer_v_final, dim3(S), dim3(256), 0, st, peer_v, z.eidx, z.w, h, g_final);
}

static Scratch carve(void* ws) {
    float* p = (float*)ws; Scratch z;
    auto take = [&](size_t n) { float* r = p; p += (n + 63) & ~(size_t)63; return r; };
    z.a = take((size_t)S * D); z.P = take((size_t)S * INW); z.yc = take((size_t)S * CW); z.o = take((size_t)S * AW); z.yconv = take((size_t)S * D); z.yattn = take((size_t)S * D);
    z.merged = take((size_t)S * D); z.kbar = take(AH * NBLK * HD); z.memn = take((size_t)NMEM * D); z.kv = take((size_t)NMEM * 2 * D); z.qx = take((size_t)S * D); z.ox = take((size_t)S * D);
    z.pq = take((size_t)S * 2048); z.sh = take((size_t)S * 2048); z.gw = take((size_t)S * 128); z.w = take((size_t)S * 128); z.eidx = (int*)take((size_t)S * 128);
    return z;
}
constexpr size_t SCRATCH_BYTES = 160u << 20;
}

extern "C" void kernel_launch(void* const* d_in, const int* in_sizes, int n_in, void* d_out, int out_size, void* d_ws, size_t ws_size, hipStream_t stream) {
    if (n_in != 19 || out_size != orc::B * orc::S * orc::D || ws_size < orc::SCRATCH_BYTES) { fprintf(stderr, "kernel_launch: unexpected shapes (n_in %d out %d ws %zu)\n", n_in, out_size, ws_size); return; }
    const orc::Scratch z = orc::carve(d_ws);
    for (int b = 0; b < orc::B; ++b) orc::forward_batch(stream, d_in, (float*)d_out, z, b);
}
```

```cpp
#include <hip/hip_runtime.h>
#include <hip/hip_bf16.h>
#include <cstdio>
#include <cstdint>
#include <cmath>

#ifndef DIAG
#define DIAG 0
#endif


template <int O> __device__ __forceinline__ float shx(float v) { static_assert(O > 0 && O < 32, "shx"); return __uint_as_float((unsigned)__builtin_amdgcn_ds_swizzle((int)__float_as_uint(v), (O << 10) | 0x1f)); }
__device__ __forceinline__ float sum32(float v) { auto r = __builtin_amdgcn_permlane32_swap(__float_as_uint(v), __float_as_uint(v), false, false); return __uint_as_float(r[0]) + __uint_as_float(r[1]); }
__device__ __forceinline__ float max32(float v) { auto r = __builtin_amdgcn_permlane32_swap(__float_as_uint(v), __float_as_uint(v), false, false); return fmaxf(__uint_as_float(r[0]), __uint_as_float(r[1])); }
__device__ __forceinline__ float wave_sum(float v) { v += shx<1>(v); v += shx<2>(v); v += shx<4>(v); v += shx<8>(v); v += shx<16>(v); return sum32(v); }

namespace pg8 {
#define PG8_LAS __attribute__((address_space(3)))
typedef unsigned short bf16_t;
typedef short bf16x8 __attribute__((ext_vector_type(8)));
typedef float f32x4 __attribute__((ext_vector_type(4)));
typedef float f32x2 __attribute__((ext_vector_type(2)));
typedef unsigned u32x4 __attribute__((ext_vector_type(4)));
typedef unsigned u32x2 __attribute__((ext_vector_type(2)));
constexpr int BM = 256, BK = 64, HALF = 128, HTB = HALF * BK * 2  , STAGE_BYTES = 8 * HTB, NXCD = 8, WGM = 8;

__host__ __device__ __forceinline__ int lds_byte(int r, int c) { const int st = (r >> 4) * 2 + (c >> 5), rr = r & 15, cc = c & 31, ob = rr * 64 + cc * 2; return st * 1024 + (ob ^ (((ob >> 9) & 1) << 5)); }
__host__ __device__ __forceinline__ void stage_rc(int b, int& R, int& C) { const int st = b / 1024, sb = b % 1024, swz = sb ^ (((sb >> 9) & 1) << 5); R = (st >> 1) * 16 + swz / 64; C = (st & 1) * 32 + (swz % 64) / 2; }
__host__ __device__ __forceinline__ int perm32(int rho) { const int n = rho >> 4, i = rho & 15; return 8 * (i >> 2) + 4 * n + (i & 3); }

struct Unit { int pm, pn; const char* a; const char* b; };
struct Gemm { int lda, ldb, K; };

struct StaticOrder {
    int nM, nN, nwg, G, c; const char* A; const char* Bt; size_t astep, bstep;
    __device__ void init(const void* A_, int lda, const void* Bt_, int ldb, int M, int N, int G_, int c_) { nM = M / BM; nN = N / BM; nwg = nM * nN; G = G_; c = c_; A = (const char*)A_; Bt = (const char*)Bt_; astep = (size_t)BM * lda * 2; bstep = (size_t)BM * ldb * 2; }
    __device__ bool next(int i, Unit& u) const {
        const long L = (long)i * G + c; if (L >= nwg) return false;
        int wgid = (int)L; { const int q = nwg / NXCD, r = nwg % NXCD, xcd = wgid % NXCD, off = wgid / NXCD; wgid = (xcd < r ? xcd * (q + 1) : r * (q + 1) + (xcd - r) * q) + off; }
        const int nig = WGM * nN, gid = wgid / nig, fm = gid * WGM, gsz = (nM - fm) < WGM ? (nM - fm) : WGM;
        u.pm = fm + ((wgid % nig) % gsz); u.pn = (wgid % nig) / gsz; u.a = A + (size_t)u.pm * astep; u.b = Bt + (size_t)u.pn * bstep; return true;
    }
};

__device__ __forceinline__ unsigned cvt_pk_bf16(float lo, float hi) { typedef __bf16 bf2 __attribute__((ext_vector_type(2))); f32x2 v = {lo, hi}; bf2 b = __builtin_convertvector(v, bf2); return __builtin_bit_cast(unsigned, b); }
__device__ __forceinline__ float bf_lo(unsigned u) { return __uint_as_float(u << 16); }
__device__ __forceinline__ float bf_hi(unsigned u) { return __uint_as_float(u & 0xffff0000u); }

template <class Epi, class Sched, bool ALIGN_EPI>
__device__ __forceinline__ void gemm_phase(PG8_LAS unsigned char* lds, const Gemm g, const Sched& S, const Epi& E) {
    int tid = threadIdx.x; asm volatile("" : "+v"(tid));
    const int wid = __builtin_amdgcn_readfirstlane(tid >> 6), lane = tid & 63, wr = wid >> 2, wc = wid & 3, fr = lane & 15, fq = lane >> 4;
    const int K = g.K, nt = K / BK;
    unsigned voffA[2], voffB[2];
#pragma unroll
    for (int i = 0; i < 2; ++i) { int R, C; stage_rc(tid * 16 + i * 8192, R, C); const int Rb = Epi::PERM ? ((R & ~31) + perm32(R & 31)) : R;
        voffA[i] = (unsigned)(R * g.lda + C) * 2u; voffB[i] = (unsigned)(Rb * g.ldb + C) * 2u; }
    const size_t kstep = (size_t)(BK * 2);
    const size_t hstepA = (size_t)HALF * g.lda * 2, hstepB = (size_t)HALF * g.ldb * 2;
    const unsigned ldsw = (unsigned)wid * 1024u;
    const int aoff = lds_byte(wr * 64 + fr, fq * 8), boff = lds_byte(wc * 32 + fr, fq * 8);
#define PG8_SA(b, h) (((b) * 2 + (h)) * HTB)
#define PG8_SB(b, h) ((4 + (b) * 2 + (h)) * HTB)
#define PG8_STAGE(bufoff, gbase, voff) do { _Pragma("unroll") for (int _i = 0; _i < 2; ++_i) \
        __builtin_amdgcn_global_load_lds((const unsigned*)((const char*)(gbase) + (voff)[_i]), (PG8_LAS unsigned*)(lds + (bufoff) + ldsw + _i * 8192), 16, 0, 0); } while (0)
#define PG8_LDA(dst, b, h) do { _Pragma("unroll") for (int m = 0; m < 4; ++m) _Pragma("unroll") for (int k = 0; k < 2; ++k) dst[m][k] = *(const PG8_LAS bf16x8*)(lds + PG8_SA(b, h) + aoff + m * 2048 + k * 1024); } while (0)
#define PG8_LDB(dst, b, h) do { _Pragma("unroll") for (int n = 0; n < 2; ++n) _Pragma("unroll") for (int k = 0; k < 2; ++k) dst[n][k] = *(const PG8_LAS bf16x8*)(lds + PG8_SB(b, h) + boff + n * 2048 + k * 1024); } while (0)
#define PG8_MMA(ai, bj, At, Bt) do { __builtin_amdgcn_s_setprio(1); _Pragma("unroll") for (int m = 0; m < 4; ++m) _Pragma("unroll") for (int n = 0; n < 2; ++n) _Pragma("unroll") for (int k = 0; k < 2; ++k) \
        acc[ai][bj][m][n] = __builtin_amdgcn_mfma_f32_16x16x32_bf16(Bt[n][k], At[m][k], acc[ai][bj][m][n], 0, 0, 0); __builtin_amdgcn_s_setprio(0); } while (0)
#define PG8_WAIT_V(n) asm volatile("s_waitcnt vmcnt(" #n ")" ::: "memory")
#define PG8_WAIT_L(n) asm volatile("s_waitcnt lgkmcnt(" #n ")" ::: "memory")
#define PG8_BAR __builtin_amdgcn_s_barrier()
#define PG8_SCHED __builtin_amdgcn_sched_barrier(0)
    Unit cur, nxt; int ui = 0;
    if (!S.next(0, cur)) return;
    f32x4 acc[2][2][4][2];
#pragma unroll
    for (int a = 0; a < 2; ++a)
#pragma unroll
        for (int b = 0; b < 2; ++b)
#pragma unroll
            for (int m = 0; m < 4; ++m)
#pragma unroll
                for (int n = 0; n < 2; ++n) acc[a][b][m][n] = (f32x4){0.f, 0.f, 0.f, 0.f};
    bf16x8 At[4][2], B0[2][2], B1[2][2];
    const char* cA = cur.a; const char* cB = cur.b;
    PG8_STAGE(PG8_SB(0, 0), cB, voffB); PG8_STAGE(PG8_SB(0, 1), cB + hstepB, voffB); PG8_STAGE(PG8_SA(0, 0), cA, voffA); PG8_STAGE(PG8_SA(0, 1), cA + hstepA, voffA);
    if (wr == 1) PG8_BAR;
    PG8_WAIT_V(2); PG8_BAR;
    PG8_STAGE(PG8_SB(1, 0), cB + kstep, voffB); PG8_STAGE(PG8_SA(1, 0), cA + kstep, voffA); PG8_STAGE(PG8_SB(1, 1), cB + hstepB + kstep, voffB);
    PG8_WAIT_V(6); PG8_BAR;
    for (;;) {
        const bool has_next = S.next(ui + 1, nxt);
        const char* nA = has_next ? nxt.a : cA; const char* nB = has_next ? nxt.b : cB;
        for (int t = 0; t < nt; t += 2) {
            const bool last = (t == nt - 2);
            const char* a1 = cA + (size_t)(t + 1) * kstep;
            const char* a2 = last ? nA : cA + (size_t)(t + 2) * kstep; const char* b2 = last ? nB : cB + (size_t)(t + 2) * kstep;
            const char* a3 = a2 + kstep; const char* b3 = b2 + kstep;
            PG8_LDB(B0, 0, 0); PG8_LDB(B1, 0, 1); PG8_SCHED; PG8_LDA(At, 0, 0); PG8_STAGE(PG8_SA(1, 1), a1 + hstepA, voffA);
            PG8_WAIT_V(8); PG8_WAIT_L(0); PG8_BAR; PG8_MMA(0, 0, At, B0); PG8_MMA(0, 1, At, B1); PG8_BAR; PG8_SCHED;
            PG8_LDA(At, 0, 1); PG8_STAGE(PG8_SB(0, 0), b2, voffB); PG8_STAGE(PG8_SB(0, 1), b2 + hstepB, voffB); PG8_STAGE(PG8_SA(0, 0), a2, voffA);
            PG8_WAIT_V(8); PG8_WAIT_L(0); PG8_BAR; PG8_MMA(1, 0, At, B0); PG8_MMA(1, 1, At, B1); PG8_BAR; PG8_SCHED;
            PG8_LDB(B0, 1, 0); PG8_LDB(B1, 1, 1); PG8_SCHED; PG8_LDA(At, 1, 0); PG8_STAGE(PG8_SA(0, 1), a2 + hstepA, voffA);
            PG8_WAIT_V(8); PG8_WAIT_L(0); PG8_BAR; PG8_MMA(0, 0, At, B0); PG8_MMA(0, 1, At, B1); PG8_BAR; PG8_SCHED;
            PG8_LDA(At, 1, 1); PG8_STAGE(PG8_SB(1, 0), b3, voffB); PG8_STAGE(PG8_SB(1, 1), b3 + hstepB, voffB); PG8_STAGE(PG8_SA(1, 0), a3, voffA);
            PG8_WAIT_V(8); PG8_WAIT_L(0); PG8_BAR; PG8_MMA(1, 0, At, B0); PG8_MMA(1, 1, At, B1); PG8_BAR; PG8_SCHED;
        }
        if constexpr (ALIGN_EPI) { if (wr == 0) PG8_BAR; }
        if constexpr (!Epi::AFTER_DRAIN) { E(acc, cur, wr, wc, fr, fq); }
        if (!has_next) break;
#pragma unroll
        for (int a = 0; a < 2; ++a)
#pragma unroll
            for (int b = 0; b < 2; ++b)
#pragma unroll
                for (int m = 0; m < 4; ++m)
#pragma unroll
                    for (int n = 0; n < 2; ++n) acc[a][b][m][n] = (f32x4){0.f, 0.f, 0.f, 0.f};
        cur = nxt; cA = nA; cB = nB; ++ui;
        if constexpr (ALIGN_EPI) { if (wr == 1) PG8_BAR; }
    }
    PG8_WAIT_V(0);
    if constexpr (!ALIGN_EPI) { if (wr == 0) PG8_BAR; }
    PG8_BAR;
    if constexpr (Epi::AFTER_DRAIN) { E.fused(acc, cur, wr, wc, fr, fq, lds, wid, lane); }
#undef PG8_SA
#undef PG8_SB
#undef PG8_STAGE
#undef PG8_LDA
#undef PG8_LDB
#undef PG8_MMA
#undef PG8_WAIT_V
#undef PG8_WAIT_L
#undef PG8_BAR
#undef PG8_SCHED
}

typedef f32x4 AccT[2][2][4][2];

struct EpiBf16 {
    static constexpr bool PERM = true, AFTER_DRAIN = false;
    bf16_t* O; int ldc;
    __device__ __forceinline__ void operator()(const AccT& acc, const Unit& u, int wr, int wc, int fr, int fq) const {
        { int t_ = threadIdx.x; asm volatile("" : "+v"(t_)); fr = t_ & 15; fq = (t_ >> 4) & 3; }
        const int row0 = u.pm * BM + wr * 64 + fr, col0 = u.pn * BM + wc * 32 + 8 * fq;
#pragma unroll
        for (int ai = 0; ai < 2; ++ai)
#pragma unroll
            for (int m = 0; m < 4; ++m) { bf16_t* rowp = O + (size_t)(row0 + ai * HALF + m * 16) * ldc + col0;
#pragma unroll
                for (int bj = 0; bj < 2; ++bj) { const f32x4 v0 = acc[ai][bj][m][0], v1 = acc[ai][bj][m][1];
                    u32x4 w; w.x = cvt_pk_bf16(v0[0], v0[1]); w.y = cvt_pk_bf16(v0[2], v0[3]); w.z = cvt_pk_bf16(v1[0], v1[1]); w.w = cvt_pk_bf16(v1[2], v1[3]);
                    *(u32x4*)(rowp + bj * HALF) = w; } }
    }
};
struct EpiF16 {
    static constexpr bool PERM = true, AFTER_DRAIN = false;
    _Float16* O; int ldc;
    __device__ __forceinline__ void operator()(const AccT& acc, const Unit& u, int wr, int wc, int fr, int fq) const {
        { int t_ = threadIdx.x; asm volatile("" : "+v"(t_)); fr = t_ & 15; fq = (t_ >> 4) & 3; }
        typedef _Float16 h8 __attribute__((ext_vector_type(8)));
        const int row0 = u.pm * BM + wr * 64 + fr, col0 = u.pn * BM + wc * 32 + 8 * fq;
#pragma unroll
        for (int ai = 0; ai < 2; ++ai)
#pragma unroll
            for (int m = 0; m < 4; ++m) { _Float16* rowp = O + (size_t)(row0 + ai * HALF + m * 16) * ldc + col0;
#pragma unroll
                for (int bj = 0; bj < 2; ++bj) { const f32x4 v0 = acc[ai][bj][m][0], v1 = acc[ai][bj][m][1];
                    h8 w = {(_Float16)v0[0], (_Float16)v0[1], (_Float16)v0[2], (_Float16)v0[3], (_Float16)v1[0], (_Float16)v1[1], (_Float16)v1[2], (_Float16)v1[3]};
                    *(h8*)(rowp + bj * HALF) = w; } }
    }
};
struct EpiGateMul {
    static constexpr bool PERM = true, AFTER_DRAIN = false;
    bf16_t* G; int ldc;
    __device__ __forceinline__ void operator()(const AccT& acc, const Unit& u, int wr, int wc, int fr, int fq) const {
        { int t_ = threadIdx.x; asm volatile("" : "+v"(t_)); fr = t_ & 15; fq = (t_ >> 4) & 3; }
        const int row0 = u.pm * BM + wr * 64 + fr, col0 = u.pn * BM + wc * 32 + 8 * fq;
#pragma unroll
        for (int ai = 0; ai < 2; ++ai)
#pragma unroll
            for (int m = 0; m < 4; ++m) { bf16_t* rowp = G + (size_t)(row0 + ai * HALF + m * 16) * ldc + col0;
#pragma unroll
                for (int bj = 0; bj < 2; ++bj) { const f32x4 v0 = acc[ai][bj][m][0], v1 = acc[ai][bj][m][1]; const u32x4 gq = *(const u32x4*)(rowp + bj * HALF);
                    u32x4 w; w.x = cvt_pk_bf16(v0[0] * bf_lo(gq.x), v0[1] * bf_hi(gq.x)); w.y = cvt_pk_bf16(v0[2] * bf_lo(gq.y), v0[3] * bf_hi(gq.y));
                    w.z = cvt_pk_bf16(v1[0] * bf_lo(gq.z), v1[1] * bf_hi(gq.z)); w.w = cvt_pk_bf16(v1[2] * bf_lo(gq.w), v1[3] * bf_hi(gq.w));
                    *(u32x4*)(rowp + bj * HALF) = w; } }
    }
};
struct EpiGateFma {
    static constexpr bool PERM = true, AFTER_DRAIN = false;
    const bf16_t* Tm; bf16_t* G2; int ldc;
    __device__ __forceinline__ void operator()(const AccT& acc, const Unit& u, int wr, int wc, int fr, int fq) const {
        { int t_ = threadIdx.x; asm volatile("" : "+v"(t_)); fr = t_ & 15; fq = (t_ >> 4) & 3; }
        const int row0 = u.pm * BM + wr * 64 + fr, col0 = u.pn * BM + wc * 32 + 8 * fq;
#pragma unroll
        for (int ai = 0; ai < 2; ++ai)
#pragma unroll
            for (int m = 0; m < 4; ++m) { const size_t off = (size_t)(row0 + ai * HALF + m * 16) * ldc + col0;
#pragma unroll
                for (int bj = 0; bj < 2; ++bj) { const f32x4 v0 = acc[ai][bj][m][0], v1 = acc[ai][bj][m][1]; const u32x4 gq = *(const u32x4*)(G2 + off + bj * HALF); const u32x4 tq = *(const u32x4*)(Tm + off + bj * HALF);
                    u32x4 w; w.x = cvt_pk_bf16(bf_lo(tq.x) + v0[0] * bf_lo(gq.x), bf_hi(tq.x) + v0[1] * bf_hi(gq.x)); w.y = cvt_pk_bf16(bf_lo(tq.y) + v0[2] * bf_lo(gq.y), bf_hi(tq.y) + v0[3] * bf_hi(gq.y));
                    w.z = cvt_pk_bf16(bf_lo(tq.z) + v1[0] * bf_lo(gq.z), bf_hi(tq.z) + v1[1] * bf_hi(gq.z)); w.w = cvt_pk_bf16(bf_lo(tq.w) + v1[2] * bf_lo(gq.w), bf_hi(tq.w) + v1[3] * bf_hi(gq.w));
                    *(u32x4*)(G2 + off + bj * HALF) = w; } }
    }
};
struct EpiResF32 {
    static constexpr bool PERM = false, AFTER_DRAIN = false;
    const float* res; float* out; int ldc;
    __device__ __forceinline__ void operator()(const AccT& acc, const Unit& u, int wr, int wc, int fr, int fq) const {
        { int t_ = threadIdx.x; asm volatile("" : "+v"(t_)); fr = t_ & 15; fq = (t_ >> 4) & 3; }
        const int row0 = u.pm * BM + wr * 64 + fr, col0 = u.pn * BM + wc * 32 + 4 * fq;
#pragma unroll
        for (int ai = 0; ai < 2; ++ai)
#pragma unroll
            for (int m = 0; m < 4; ++m) { const size_t off = (size_t)(row0 + ai * HALF + m * 16) * ldc + col0;
#pragma unroll
                for (int bj = 0; bj < 2; ++bj)
#pragma unroll
                    for (int n = 0; n < 2; ++n) { const f32x4 r = *(const f32x4*)(res + off + bj * HALF + n * 16); *(f32x4*)(out + off + bj * HALF + n * 16) = r + acc[ai][bj][m][n]; } }
    }
};
struct EpiIn {
    static constexpr bool PERM = true, AFTER_DRAIN = false;
    bf16_t *U, *Bb, *Q, *Kb, *V, *SGC, *SGA; const float* ropec; const float* ropes; float* kbar; float qscale;
    __device__ __forceinline__ void operator()(const AccT& acc, const Unit& u, int wr, int wc, int fr, int fq) const {
        { int t_ = threadIdx.x; asm volatile("" : "+v"(t_)); fr = t_ & 15; fq = (t_ >> 4) & 3; }
        const int pn = u.pn; const int row0 = u.pm * BM + wr * 64 + fr;
        if (pn < 4) {
            const int c0 = 128 * pn + 16 * wc + 4 * fq;
#pragma unroll
            for (int ai = 0; ai < 2; ++ai)
#pragma unroll
                for (int m = 0; m < 4; ++m) { int ro = row0 + ai * HALF + m * 16; asm volatile("" : "+v"(ro)); bf16_t* rowp = U + (size_t)ro * 512 + c0;
#pragma unroll
                    for (int bj = 0; bj < 2; ++bj) { const f32x4 x = acc[ai][bj][m][0] * acc[ai][bj][m][1]; u32x2 w; w.x = cvt_pk_bf16(x[0], x[1]); w.y = cvt_pk_bf16(x[2], x[3]); *(u32x2*)(rowp + bj * 64) = w; } }
        } else if (pn < 6 || (pn >= 10 && pn < 12)) {
            bf16_t* O = pn < 6 ? Bb : V; const int col0 = (pn < 6 ? pn - 4 : pn - 10) * BM + wc * 32 + 8 * fq;
#pragma unroll
            for (int ai = 0; ai < 2; ++ai)
#pragma unroll
                for (int m = 0; m < 4; ++m) { int ro = row0 + ai * HALF + m * 16; asm volatile("" : "+v"(ro)); bf16_t* rowp = O + (size_t)ro * 512 + col0;
#pragma unroll
                    for (int bj = 0; bj < 2; ++bj) { const f32x4 v0 = acc[ai][bj][m][0], v1 = acc[ai][bj][m][1];
                        u32x4 w; w.x = cvt_pk_bf16(v0[0], v0[1]); w.y = cvt_pk_bf16(v0[2], v0[3]); w.z = cvt_pk_bf16(v1[0], v1[1]); w.w = cvt_pk_bf16(v1[2], v1[3]);
                        *(u32x4*)(rowp + bj * HALF) = w; } }
        } else if (pn < 10) {
            const bool isk = pn >= 8; bf16_t* O = isk ? Kb : Q; const int colt = (isk ? pn - 8 : pn - 6) * BM + wc * 32 + 8 * fq;
            const int g4 = 4 * (4 * (wc & 1) + fq);
            const float sc = isk ? 1.f : qscale;
            f32x4 cs0[2] = {(f32x4){0.f, 0.f, 0.f, 0.f}, (f32x4){0.f, 0.f, 0.f, 0.f}}, cs1[2] = {(f32x4){0.f, 0.f, 0.f, 0.f}, (f32x4){0.f, 0.f, 0.f, 0.f}};
#pragma unroll
            for (int ai = 0; ai < 2; ++ai)
#pragma unroll
                for (int m = 0; m < 4; ++m) { int row = row0 + ai * HALF + m * 16; asm volatile("" : "+v"(row)); const int pos = row & 2047;
                    const f32x4 c = *(const f32x4*)(ropec + pos * 32 + g4) * sc, s = *(const f32x4*)(ropes + pos * 32 + g4) * sc;
                    bf16_t* rowp = O + (size_t)row * 512 + colt;
#pragma unroll
                    for (int bj = 0; bj < 2; ++bj) { const f32x4 x1 = acc[ai][bj][m][0], x2 = acc[ai][bj][m][1]; const f32x4 o1 = x1 * c - x2 * s, o2 = x2 * c + x1 * s;
                        cs0[bj] += o1; cs1[bj] += o2;
                        u32x4 w; w.x = cvt_pk_bf16(o1[0], o1[1]); w.y = cvt_pk_bf16(o1[2], o1[3]); w.z = cvt_pk_bf16(o2[0], o2[1]); w.w = cvt_pk_bf16(o2[2], o2[3]);
                        *(u32x4*)(rowp + bj * HALF) = w; }
                    asm volatile("" : "+v"(cs0[0]), "+v"(cs0[1]), "+v"(cs1[0]), "+v"(cs1[1]) :: "memory"); }
            if (isk) {
#pragma unroll
                for (int bj = 0; bj < 2; ++bj)
#pragma unroll
                    for (int j = 0; j < 4; ++j) { float a = cs0[bj][j], b = cs1[bj][j];
                        a += shx<1>(a); b += shx<1>(b); a += shx<2>(a); b += shx<2>(b); a += shx<4>(a); b += shx<4>(b); a += shx<8>(a); b += shx<8>(b);
                        if (fr == 0) { const int pc = (pn - 8) * BM + bj * HALF + wc * 32 + 8 * fq;
                            float* kb = kbar + (size_t)u.pm * 512 + pc; atomicAdd(kb + j, a); atomicAdd(kb + 4 + j, b); } }
            }
        } else {
            bf16_t* O = pn < 16 ? SGC : SGA; const int col0 = (pn < 16 ? pn - 12 : pn - 16) * BM + wc * 32 + 8 * fq;
#pragma unroll
            for (int ai = 0; ai < 2; ++ai)
#pragma unroll
                for (int m = 0; m < 4; ++m) { int ro = row0 + ai * HALF + m * 16; asm volatile("" : "+v"(ro)); bf16_t* rowp = O + (size_t)ro * 1024 + col0;
#pragma unroll
                    for (int bj = 0; bj < 2; ++bj) { f32x4 v0 = acc[ai][bj][m][0], v1 = acc[ai][bj][m][1];
#pragma unroll
                        for (int j = 0; j < 4; ++j) { v0[j] = __builtin_amdgcn_rcpf(1.f + __expf(-v0[j])); v1[j] = __builtin_amdgcn_rcpf(1.f + __expf(-v1[j])); }
                        u32x4 w; w.x = cvt_pk_bf16(v0[0], v0[1]); w.y = cvt_pk_bf16(v0[2], v0[3]); w.z = cvt_pk_bf16(v1[0], v1[1]); w.w = cvt_pk_bf16(v1[2], v1[3]);
                        *(u32x4*)(rowp + bj * HALF) = w; }
                    asm volatile("" ::: "memory"); }
        }
    }
};
struct EpiSoftmax {
    static constexpr bool PERM = true, AFTER_DRAIN = true;
    bf16_t* O; int ldc; float scale_log2;
    __device__ __forceinline__ void fused(AccT& acc, const Unit& u, int wr, int wc, int fr, int fq, PG8_LAS unsigned char* lds, int wid, int lane) const {
        { int t_ = threadIdx.x; asm volatile("" : "+v"(t_)); fr = t_ & 15; fq = (t_ >> 4) & 3; }
        PG8_LAS f32x2* X = (PG8_LAS f32x2*)lds;
        float mx[2][4];
#pragma unroll
        for (int ai = 0; ai < 2; ++ai)
#pragma unroll
            for (int m = 0; m < 4; ++m) { float a = -3.0e38f;
#pragma unroll
                for (int bj = 0; bj < 2; ++bj)
#pragma unroll
                    for (int n = 0; n < 2; ++n) { acc[ai][bj][m][n] = acc[ai][bj][m][n] * scale_log2; const f32x4 x = acc[ai][bj][m][n]; a = fmaxf(fmaxf(a, fmaxf(x[0], x[1])), fmaxf(x[2], x[3])); }
                a = fmaxf(a, shx<16>(a)); a = max32(a); mx[ai][m] = a;
                float s = 0.f;
#pragma unroll
                for (int bj = 0; bj < 2; ++bj)
#pragma unroll
                    for (int n = 0; n < 2; ++n) { f32x4 x = acc[ai][bj][m][n];
#pragma unroll
                        for (int j = 0; j < 4; ++j) { x[j] = __builtin_amdgcn_exp2f(x[j] - a); s += x[j]; }
                        acc[ai][bj][m][n] = x; }
                s += shx<16>(s); s = sum32(s);
                if (fq == 0) X[(ai * HALF + wr * 64 + m * 16 + fr) * 4 + wc] = (f32x2){a, s};
            }
        asm volatile("s_waitcnt lgkmcnt(0)" ::: "memory"); __builtin_amdgcn_s_barrier(); asm volatile("" ::: "memory");
        const int row0 = u.pm * BM + wr * 64 + fr, col0 = u.pn * BM + wc * 32 + 8 * fq;
#pragma unroll
        for (int ai = 0; ai < 2; ++ai)
#pragma unroll
            for (int m = 0; m < 4; ++m) { const int r = ai * HALF + wr * 64 + m * 16 + fr;
                const f32x2 e0 = X[r * 4 + 0], e1 = X[r * 4 + 1], e2 = X[r * 4 + 2], e3 = X[r * 4 + 3];
                const float M = fmaxf(fmaxf(e0.x, e1.x), fmaxf(e2.x, e3.x));
                const float L = e0.y * __builtin_amdgcn_exp2f(e0.x - M) + e1.y * __builtin_amdgcn_exp2f(e1.x - M) + e2.y * __builtin_amdgcn_exp2f(e2.x - M) + e3.y * __builtin_amdgcn_exp2f(e3.x - M);
                const float f = __builtin_amdgcn_exp2f(mx[ai][m] - M) * __builtin_amdgcn_rcpf(L);
                bf16_t* rowp = O + (size_t)(row0 + ai * HALF + m * 16) * ldc + col0;
#pragma unroll
                for (int bj = 0; bj < 2; ++bj) { const f32x4 v0 = acc[ai][bj][m][0] * f, v1 = acc[ai][bj][m][1] * f;
                    u32x4 w; w.x = cvt_pk_bf16(v0[0], v0[1]); w.y = cvt_pk_bf16(v0[2], v0[3]); w.z = cvt_pk_bf16(v1[0], v1[1]); w.w = cvt_pk_bf16(v1[2], v1[3]);
                    *(u32x4*)(rowp + bj * HALF) = w; } }
        asm volatile("s_waitcnt lgkmcnt(0)" ::: "memory"); __builtin_amdgcn_s_barrier(); asm volatile("" ::: "memory");
    }
};
}
namespace attn_body {
using bf16=__hip_bfloat16;
using bf16x8=__attribute__((ext_vector_type(8)))short;
using s16x4=__attribute__((ext_vector_type(4)))short;
using f32x16=__attribute__((ext_vector_type(16)))float;
using u32x4=__attribute__((ext_vector_type(4)))unsigned;
constexpr int BATCH=16,NHEAD=8,SEQ=2048,D=64,DM=NHEAD*D;
constexpr int NW=8,QBLK=32,QB=QBLK*NW,KVBLK=64,NQB=SEQ/QB;
constexpr int ATTN_PITCH=DM, ATTN_UNIT_ROWS=QB;
__device__ __forceinline__ int crow(int r,int hi){return (r&3)+8*(r>>2)+4*hi;}
#define SBAR() __builtin_amdgcn_sched_barrier(0)
__device__ __forceinline__ void cmask(f32x16&p0,f32x16&p1,int jb,int qrel,int hi){
  const float NEG=-INFINITY; int kb=64*jb+4*hi;
  #pragma unroll
  for(int r=0;r<16;++r){int kv=kb+(r&3)+8*(r>>2); if(kv>qrel)p0[r]=NEG; if(kv+32>qrel)p1[r]=NEG;}
}

constexpr int NSLOT=3, SLOTB=8192;
constexpr int LDS_K=0, LDS_V=NSLOT*SLOTB, LDS_WS=2*NSLOT*SLOTB, LDS_OST=LDS_WS+NW*64*4, LDS_SEL=LDS_OST+NW*4096, LDS_BYTES=LDS_SEL+NW*64*4;
constexpr float C2=0.125f*1.4426950408889634f;
__device__ __forceinline__ void glds16(const void*gsrc,unsigned lds_dst){unsigned keep;
  asm volatile("s_mov_b32 %0, m0\n\ts_mov_b32 m0, %2\n\ts_nop 0\n\tglobal_load_lds_dwordx4 %1, off\n\ts_mov_b32 m0, %0":"=&s"(keep):"v"(gsrc),"s"(lds_dst):"memory");}
__device__ __forceinline__ float max3f(float a,float b,float c){float r;asm("v_max3_f32 %0, %1, %2, %3":"=v"(r):"v"(a),"v"(b),"v"(c));return r;}
__device__ __forceinline__ float max2f(float a,float b){float r;asm("v_max_f32_e32 %0, %1, %2":"=v"(r):"v"(a),"v"(b));return r;}
__device__ __forceinline__ float fadd_s(float a,float b){float r;asm("v_add_f32_e32 %0, %1, %2":"=v"(r):"v"(a),"v"(b));return r;}
__device__ __forceinline__ float fsub_s(float a,float b){float r;asm("v_sub_f32_e32 %0, %1, %2":"=v"(r):"v"(a),"v"(b));return r;}
typedef float f32x2_t __attribute__((ext_vector_type(2))); typedef __bf16 bf16x2_t __attribute__((ext_vector_type(2)));
__device__ __forceinline__ unsigned cvtpk_s(float lo,float hi){f32x2_t v={lo,hi};bf16x2_t b=__builtin_convertvector(v,bf16x2_t);return __builtin_bit_cast(unsigned,b);}
#define WAIT_BAR(N) asm volatile("s_waitcnt vmcnt(" #N ") lgkmcnt(0)\n\ts_barrier":::"memory")

__device__ __forceinline__ void qkt(f32x16&p0,f32x16&p1,const char*Kslot,const bf16x8*qr,const f32x16&negm,int r32,int hi){
  const char*kb=Kslot+hi*1024+r32*16;
  #pragma unroll
  for(int d0=0;d0<4;++d0){
    const bf16x8 b0=*reinterpret_cast<const bf16x8*>(kb+d0*2048);
    const bf16x8 b1=*reinterpret_cast<const bf16x8*>(kb+d0*2048+512);
    if(d0==0){p0=__builtin_amdgcn_mfma_f32_32x32x16_bf16(b0,qr[0],negm,0,0,0);p1=__builtin_amdgcn_mfma_f32_32x32x16_bf16(b1,qr[0],negm,0,0,0);}
    else{p0=__builtin_amdgcn_mfma_f32_32x32x16_bf16(b0,qr[d0],p0,0,0,0);p1=__builtin_amdgcn_mfma_f32_32x32x16_bf16(b1,qr[d0],p1,0,0,0);}}
}
typedef __attribute__((address_space(3))) const char* lds_cptr;
typedef short v4i16_t __attribute__((ext_vector_type(4)));
__device__ __forceinline__ void kload8(bf16x8*kf,lds_cptr kp){
  kf[0]=*(const __attribute__((address_space(3))) bf16x8*)(kp);      kf[1]=*(const __attribute__((address_space(3))) bf16x8*)(kp+512);
  kf[2]=*(const __attribute__((address_space(3))) bf16x8*)(kp+2048); kf[3]=*(const __attribute__((address_space(3))) bf16x8*)(kp+2560);
  kf[4]=*(const __attribute__((address_space(3))) bf16x8*)(kp+4096); kf[5]=*(const __attribute__((address_space(3))) bf16x8*)(kp+4608);
  kf[6]=*(const __attribute__((address_space(3))) bf16x8*)(kp+6144); kf[7]=*(const __attribute__((address_space(3))) bf16x8*)(kp+6656);
}
__device__ __forceinline__ void kload2(bf16x8*kf,lds_cptr kp,int j){ kf[2*j]=*(const __attribute__((address_space(3))) bf16x8*)(kp+j*2048); kf[2*j+1]=*(const __attribute__((address_space(3))) bf16x8*)(kp+j*2048+512); }
__device__ __forceinline__ s16x4 vtr(lds_cptr p){ return __builtin_bit_cast(s16x4,__builtin_amdgcn_ds_read_tr16_b64_v4i16((__attribute__((address_space(3))) v4i16_t*)p)); }
__device__ __forceinline__ float rowmax(const f32x16&p0,const f32x16&p1){
  float a=max3f(p0[0],p0[1],p1[0]),b=max3f(p0[2],p0[3],p1[1]);a=max3f(a,p1[2],p1[3]);
  #pragma unroll
  for(int r=4;r<16;r+=4){a=max3f(a,p0[r],p0[r+1]);b=max3f(b,p0[r+2],p0[r+3]);a=max3f(a,p1[r],p1[r+1]);b=max3f(b,p1[r+2],p1[r+3]);}
  const float m=max2f(a,b);
  auto rr=__builtin_amdgcn_permlane32_swap(__float_as_uint(m),__float_as_uint(m),false,false);
  return max2f(__uint_as_float(rr[0]),__uint_as_float(rr[1]));
}
__device__ __forceinline__ void pv(f32x16*o,int vb,bf16x8 pa0,bf16x8 pa1,bf16x8 pa2,bf16x8 pa3){
  #pragma unroll
  for(int d0=0;d0<2;++d0){s16x4 lo[4],hi[4];
    #pragma unroll
    for(int ks=0;ks<4;++ks){
      asm volatile("ds_read_b64_tr_b16 %0,%1 offset:%c2":"=&v"(lo[ks]):"v"(vb),"i"(d0*4096+ks*1024):"memory");
      asm volatile("ds_read_b64_tr_b16 %0,%1 offset:%c2":"=&v"(hi[ks]):"v"(vb),"i"(d0*4096+ks*1024+512):"memory");}
    asm volatile("s_waitcnt lgkmcnt(0)":::"memory");SBAR();
    #define PK(k) (bf16x8){lo[k][0],lo[k][1],lo[k][2],lo[k][3],hi[k][0],hi[k][1],hi[k][2],hi[k][3]}
    o[d0]=__builtin_amdgcn_mfma_f32_32x32x16_bf16(pa0,PK(0),o[d0],0,0,0);
    o[d0]=__builtin_amdgcn_mfma_f32_32x32x16_bf16(pa1,PK(1),o[d0],0,0,0);
    o[d0]=__builtin_amdgcn_mfma_f32_32x32x16_bf16(pa2,PK(2),o[d0],0,0,0);
    o[d0]=__builtin_amdgcn_mfma_f32_32x32x16_bf16(pa3,PK(3),o[d0],0,0,0);
    #undef PK
  }
}

#ifndef ATTN_STORE16
#define ATTN_STORE16(p,v) (*(u32x4*)(p)=(v))
#endif
template<int THRL> __device__ __forceinline__ void attn_unit(int b,int h,int qb,const bf16*Q,const bf16*__restrict__ K,const bf16*__restrict__ V,bf16*O,const float*__restrict__ kbar,char*shm){
  int tid=threadIdx.x; asm volatile("":"+v"(tid)); const int lane=tid&63,r32=lane&31,hi=lane>>5; const int wid=__builtin_amdgcn_readfirstlane(tid>>6);
  const long rowbase=(long)b*SEQ; const int q0=qb*QB;
  const bf16*Qw=Q+(rowbase+q0+wid*QBLK)*DM+h*D;
  const bf16*Kh=K+rowbase*DM+h*D,*Vh=V+rowbase*DM+h*D;
  const unsigned lds0=(unsigned)(uintptr_t)shm;
  float*wsf=(float*)(shm+LDS_WS)+wid*64;
  const bf16*ksrc=Kh+(long)lane*DM+wid*8;
  const bf16*vsrc=Vh+(long)(16*(wid&3)+(lane>>2))*DM+(wid>>2)*32+(lane&3)*8;
  const unsigned kdst=lds0+LDS_K+wid*1024, vdst=lds0+LDS_V+wid*1024;
  #define DMA_K(t,slot) glds16(ksrc+(long)(t)*KVBLK*DM,(unsigned)__builtin_amdgcn_readfirstlane(kdst+(slot)))
  #define DMA_V(t,slot) glds16(vsrc+(long)(t)*KVBLK*DM,(unsigned)__builtin_amdgcn_readfirstlane(vdst+(slot)))
  const int vb0=(int)(lds0+LDS_V)+((lane>>4)&1)*32+(lane&3)*8+(4*hi+((lane&15)>>2))*64;
  const char*Kbase=shm+LDS_K; bf16x8 kf[8];
  const lds_cptr shm3=(lds_cptr)shm; const lds_cptr kp0=shm3+LDS_K+hi*1024+r32*16; const lds_cptr vp0=shm3+LDS_V+((lane>>4)&1)*32+(lane&3)*8+(4*hi+((lane&15)>>2))*64;
  const int NT=(q0+QB)/KVBLK;
  DMA_K(0,0);DMA_V(0,0);DMA_K(1,SLOTB);
  bf16x8 qr[4];
  #pragma unroll
  for(int d0=0;d0<4;++d0)qr[d0]=*reinterpret_cast<const bf16x8*>(&Qw[(long)r32*DM+d0*16+hi*8]);
  int selm=0;
  if(qb>0){
    float g[7]; int hi8=8*hi; asm volatile("":"+v"(hi8)); const float*kb=kbar+(size_t)(b*8)*512+h*64+hi8;
    #pragma unroll
    for(int n=0;n<7;++n){ float a=0.f;
      if(n<qb){
        #pragma unroll
        for(int d0=0;d0<4;++d0){ const float4 k0=*(const float4*)(kb+n*512+16*d0),k1=*(const float4*)(kb+n*512+16*d0+4); const bf16x8 qq=qr[d0];
          #define QF(e) __uint_as_float(((unsigned)(unsigned short)qq[e])<<16)
          a+=QF(0)*k0.x+QF(1)*k0.y+QF(2)*k0.z+QF(3)*k0.w+QF(4)*k1.x+QF(5)*k1.y+QF(6)*k1.z+QF(7)*k1.w;
          #undef QF
        } }
      a=::sum32(a); g[n]=(n<qb)?a:-INFINITY; asm volatile("":"+v"(g[n])::"memory"); }
    #pragma unroll
    for(int r=0;r<3;++r){ int best=-1; float bv=-INFINITY;
      #pragma unroll
      for(int n=0;n<7;++n) if(!((selm>>n)&1)&&g[n]>bv){bv=g[n];best=n;}
      if(best>=0)selm|=1<<best; }
  }
  selm|=1<<qb;
  typedef __attribute__((address_space(3))) int* lds_iptr;
  ((lds_iptr)(shm3+LDS_SEL))[tid]=selm;
  #define CURNEG(blk) ({ int t_=threadIdx.x; asm volatile("":"+v"(t_)); const int sm_=((lds_iptr)(shm3+LDS_SEL))[t_]; ((sm_>>(blk))&1)?0.f:-INFINITY; })
  #define NEGUPD(t) do{ if((((t)+1)&3)==0){ const float cn_=CURNEG(((t)+1)>>2); _Pragma("unroll") for(int r=0;r<16;++r)negm[r]=cn_-mhat; asm volatile("":"+v"(negm)); } }while(0)
  float mhat=0.f,l_reg=0.f;f32x16 o[2];o[0]=f32x16{};o[1]=f32x16{};f32x16 negm; { const float cn_=CURNEG(0); _Pragma("unroll") for(int r=0;r<16;++r)negm[r]=cn_; } asm volatile("":"+v"(negm));
  const int qrel=wid*QBLK+r32;
  #define CMASK(P0,P1,t) do{int jb_=(t)-(NT-4); if(jb_>=0)cmask(P0,P1,jb_,qrel,hi);}while(0)
  bool resc=false;
  #define START(P0,P1) do{ const float rm=rowmax(P0,P1); resc=false; \
    { const float dl=__builtin_fmaxf(rm,-24.f); mhat=fadd_s(mhat,dl); \
      _Pragma("unroll") for(int r=0;r<16;++r){P0[r]=fsub_s(P0[r],dl);P1[r]=fsub_s(P1[r],dl);} \
      { const float cn_=CURNEG(0); _Pragma("unroll") for(int r=0;r<16;++r)negm[r]=cn_-mhat; } asm volatile("":"+v"(negm)); } \
    _Pragma("unroll") for(int r=0;r<16;++r)P0[r]=__builtin_amdgcn_exp2f(P0[r]); }while(0)
  #define RESC() do{ if(resc){ asm volatile("s_waitcnt lgkmcnt(0)":::"memory"); \
      _Pragma("unroll") for(int d_=0;d_<2;++d_) _Pragma("unroll") for(int r=0;r<16;++r)o[d_][r]*=wsf[crow(r,hi)]; } }while(0)
  f32x16 pA0,pA1,pB0,pB1;
  int sl_prev=0,sl_cur=0,sl_next=SLOTB;
  #define ROT() do{sl_prev=sl_cur;sl_cur=sl_next;sl_next=(sl_next==(NSLOT-1)*SLOTB)?0:sl_next+SLOTB;}while(0)
  DMA_K(2,2*SLOTB);
  WAIT_BAR(3);
  qkt(pA0,pA1,Kbase,qr,negm,r32,hi);asm volatile("s_nop 15\n\ts_nop 7":"+v"(pA0),"+v"(pA1));CMASK(pA0,pA1,0);
  START(pA0,pA1);
  _Pragma("unroll") for(int r=0;r<16;++r)pA1[r]=__builtin_amdgcn_exp2f(pA1[r]);
  WAIT_BAR(0);
  DMA_K(3,0);DMA_V(1,SLOTB);
  ROT();
  kload8(kf,kp0+sl_cur);
  WAIT_BAR(2);
  s16x4 vlo[8],vhi[8]; u32x4 pw0,pw1,pw2,pw3;
  #define PKW(P,B) cvtpk_s(P[B],P[B+1])
  #define PAF(k) __builtin_bit_cast(bf16x8,pw##k)
  #define VFR(i) (bf16x8){vlo[i][0],vlo[i][1],vlo[i][2],vlo[i][3],vhi[i][0],vhi[i][1],vhi[i][2],vhi[i][3]}
  #define PIN(x) asm volatile("":"+v"(x))
  #define MX3(a,b,c) __builtin_fmaxf(__builtin_fmaxf((a),(b)),(c))
  #define GAPA(MF,A0,A1,A2,A3,W0,W1,PW) do{ MF; sacc+=A0; sacc+=A1; sacc+=A2; sacc+=A3; PIN(sacc); W0; W1; PIN(PW); SBAR(); }while(0)
  #define EX(v) __builtin_amdgcn_exp2f(v)
  #define GAPB(MF,X,B) do{ MF; X[B]=EX(X[B]); X[B+1]=EX(X[B+1]); X[B+2]=EX(X[B+2]); X[B+3]=EX(X[B+3]); PIN(X); SBAR(); }while(0)
  #define VRD(i) do{ vlo[i]=vtr(vp_+(((i)>>2)*4096+((i)&3)*1024)); vhi[i]=vtr(vp_+(((i)>>2)*4096+((i)&3)*1024+512)); }while(0)
  #define KRD(G,j) do{ if(G){ kload2(kf,kp0+sl_next,j); SBAR(); } }while(0)
  #define STEP(C0,C1,P0,P1,t,GK,GV,GL) do{ SBAR(); \
    const lds_cptr vp_=vp0+sl_prev; \
    VRD(0); SBAR(); float sacc=(P0[0]+P0[1]); \
    GAPA(C0=__builtin_amdgcn_mfma_f32_32x32x16_bf16(kf[0],qr[0],negm,0,0,0), P0[2],P0[3],P0[4],P0[5],     pw0[0]=PKW(P0,0), pw0[1]=PKW(P0,2), pw0); \
    VRD(4); SBAR(); GAPA(C1=__builtin_amdgcn_mfma_f32_32x32x16_bf16(kf[1],qr[0],negm,0,0,0), P0[6],P0[7],P0[8],P0[9],     pw0[2]=PKW(P0,4), pw0[3]=PKW(P0,6), pw0); \
    VRD(1); SBAR(); GAPA(C0=__builtin_amdgcn_mfma_f32_32x32x16_bf16(kf[2],qr[1],C0,0,0,0),   P0[10],P0[11],P0[12],P0[13], pw1[0]=PKW(P0,8), pw1[1]=PKW(P0,10), pw1); \
    VRD(5); SBAR(); GAPA(C1=__builtin_amdgcn_mfma_f32_32x32x16_bf16(kf[3],qr[1],C1,0,0,0),   P0[14],P0[15],P1[0],P1[1],   pw1[2]=PKW(P0,12),pw1[3]=PKW(P0,14), pw1); \
    VRD(2); SBAR(); GAPA(C0=__builtin_amdgcn_mfma_f32_32x32x16_bf16(kf[4],qr[2],C0,0,0,0),   P1[2],P1[3],P1[4],P1[5],     pw2[0]=PKW(P1,0), pw2[1]=PKW(P1,2), pw2); \
    VRD(6); SBAR(); GAPA(C1=__builtin_amdgcn_mfma_f32_32x32x16_bf16(kf[5],qr[2],C1,0,0,0),   P1[6],P1[7],P1[8],P1[9],     pw2[2]=PKW(P1,4), pw2[3]=PKW(P1,6), pw2); \
    VRD(3); SBAR(); GAPA(C0=__builtin_amdgcn_mfma_f32_32x32x16_bf16(kf[6],qr[3],C0,0,0,0),   P1[10],P1[11],P1[12],P1[13], pw3[0]=PKW(P1,8), pw3[1]=PKW(P1,10), pw3); \
    VRD(7); SBAR(); GAPA(C1=__builtin_amdgcn_mfma_f32_32x32x16_bf16(kf[7],qr[3],C1,0,0,0),   P1[14],P1[15],0.f,0.f,       pw3[2]=PKW(P1,12),pw3[3]=PKW(P1,14), pw3); \
    l_reg+=sacc; \
    if(GK){DMA_K((t)+3,sl_cur);} if(GV){DMA_V((t)+1,sl_next);} \
    CMASK(C0,C1,t); \
    { float a=MX3(C0[0],C0[1],C1[0]),b=MX3(C0[2],C0[3],C1[1]); a=MX3(a,C1[2],C1[3]); \
      _Pragma("unroll") for(int r=4;r<16;r+=4){a=MX3(a,C0[r],C0[r+1]);b=MX3(b,C0[r+2],C0[r+3]);a=MX3(a,C1[r],C1[r+1]);b=MX3(b,C1[r+2],C1[r+3]);} \
      float rm=__builtin_fmaxf(a,b); { auto rr=__builtin_amdgcn_permlane32_swap(__float_as_uint(rm),__float_as_uint(rm),false,false); rm=__builtin_fmaxf(__uint_as_float(rr[0]),__uint_as_float(rr[1])); } \
      resc=false; \
      if(__builtin_expect(__any(rm>(float)THRL),0)){ const float dl=__builtin_fmaxf(rm,0.f); mhat+=dl; \
        _Pragma("unroll") for(int r=0;r<16;++r){C0[r]-=dl;C1[r]-=dl;} \
        { const float cn_=CURNEG(((t)+1)>>2); _Pragma("unroll") for(int r=0;r<16;++r)negm[r]=cn_-mhat; } asm volatile("":"+v"(negm)); \
        const float f=__builtin_amdgcn_exp2f(-dl); l_reg*=f; if(hi==0)wsf[r32]=f; resc=true; } } \
    SBAR(); \
    GAPB(o[0]=__builtin_amdgcn_mfma_f32_32x32x16_bf16(PAF(0),VFR(0),o[0],0,0,0), C0,0); \
    GAPB(o[1]=__builtin_amdgcn_mfma_f32_32x32x16_bf16(PAF(0),VFR(4),o[1],0,0,0), C0,4); \
    KRD(GL,0); GAPB(o[0]=__builtin_amdgcn_mfma_f32_32x32x16_bf16(PAF(1),VFR(1),o[0],0,0,0), C0,8); \
    KRD(GL,1); GAPB(o[1]=__builtin_amdgcn_mfma_f32_32x32x16_bf16(PAF(1),VFR(5),o[1],0,0,0), C0,12); \
    KRD(GL,2); GAPB(o[0]=__builtin_amdgcn_mfma_f32_32x32x16_bf16(PAF(2),VFR(2),o[0],0,0,0), C1,0); \
    KRD(GL,3); GAPB(o[1]=__builtin_amdgcn_mfma_f32_32x32x16_bf16(PAF(2),VFR(6),o[1],0,0,0), C1,4); \
    GAPB(o[0]=__builtin_amdgcn_mfma_f32_32x32x16_bf16(PAF(3),VFR(3),o[0],0,0,0), C1,8); \
    GAPB(o[1]=__builtin_amdgcn_mfma_f32_32x32x16_bf16(PAF(3),VFR(7),o[1],0,0,0), C1,12); \
    }while(0)
  int t=1;
  #undef CMASK
  #define CMASK(P0,P1,t) do{}while(0)
  for(;t+5<NT;t+=2){
    STEP(pB0,pB1,pA0,pA1,t,true,true,true);     WAIT_BAR(2); RESC(); ROT(); NEGUPD(t);
    STEP(pA0,pA1,pB0,pB1,t+1,true,true,true);   WAIT_BAR(2); RESC(); ROT(); NEGUPD(t+1);
  }
  #undef CMASK
  #define CMASK(P0,P1,t) do{int jb_=(t)-(NT-4); if(jb_>=0)cmask(P0,P1,jb_,qrel,hi);}while(0)
  #define ENDW(tt) do{ if((tt)+3<NT){WAIT_BAR(2);} else if((tt)+2<NT){WAIT_BAR(1);} else {WAIT_BAR(0);} }while(0)
  for(;t+1<NT;t+=2){
    STEP(pB0,pB1,pA0,pA1,t,(t+3<NT),(t+1<NT),(t+1<NT));       ENDW(t);   RESC(); ROT(); NEGUPD(t);
    STEP(pA0,pA1,pB0,pB1,t+1,(t+4<NT),(t+2<NT),(t+2<NT));     ENDW(t+1); RESC(); ROT(); NEGUPD(t+1);
  }
  STEP(pB0,pB1,pA0,pA1,NT-1,false,false,false); RESC();
  { float sacc=pB0[0]+pB0[1]; _Pragma("unroll") for(int r=2;r<16;++r)sacc+=pB0[r]; _Pragma("unroll") for(int r=0;r<16;++r)sacc+=pB1[r]; l_reg+=sacc;
    pw0=(u32x4){PKW(pB0,0),PKW(pB0,2),PKW(pB0,4),PKW(pB0,6)};pw1=(u32x4){PKW(pB0,8),PKW(pB0,10),PKW(pB0,12),PKW(pB0,14)};pw2=(u32x4){PKW(pB1,0),PKW(pB1,2),PKW(pB1,4),PKW(pB1,6)};pw3=(u32x4){PKW(pB1,8),PKW(pB1,10),PKW(pB1,12),PKW(pB1,14)};
    SBAR(); pv(o,vb0+sl_cur,PAF(0),PAF(1),PAF(2),PAF(3)); }
  #undef PKW
  #undef PAF
  #undef VFR
  #undef PIN
  #undef MX3
  #undef GAPA
  #undef GAPB
  #undef EX
  #undef VRD
  #undef KRD
  #undef STEP
  #undef ENDW
  {auto rr=__builtin_amdgcn_permlane32_swap(__float_as_uint(l_reg),__float_as_uint(l_reg),false,false);l_reg=__uint_as_float(rr[0])+__uint_as_float(rr[1]);}
  if(hi==0)wsf[32+r32]=l_reg;asm volatile("s_waitcnt lgkmcnt(0)":::"memory");
  float rli[16];
  #pragma unroll
  for(int r=0;r<16;++r)rli[r]=__builtin_amdgcn_rcpf(wsf[32+crow(r,hi)]);
  bf16*Ow=O+(rowbase+q0+wid*QBLK)*DM+h*D;
  { bf16*stg=(bf16*)(shm+LDS_OST)+wid*2048;
    #pragma unroll
    for(int r=0;r<16;++r){const int orow=crow(r,hi);
      #pragma unroll
      for(int d0=0;d0<2;++d0)stg[orow*64+d0*32+r32]=__float2bfloat16(o[d0][r]*rli[r]);}
    asm volatile("s_waitcnt lgkmcnt(0)":::"memory");
    #pragma unroll
    for(int i=0;i<4;++i){const int row=i*8+(lane>>3),ch=lane&7; const u32x4 v=*(const u32x4*)(stg+row*64+ch*8); ATTN_STORE16(Ow+(long)row*DM+ch*8,v);} }
  asm volatile("s_waitcnt lgkmcnt(0)\n\ts_barrier":::"memory");
  #undef DMA_K
  #undef DMA_V
  #undef CMASK
  #undef START
  #undef CURNEG
  #undef NEGUPD
  #undef RESC
  #undef ROT
}
constexpr int ATTN_LDS_BYTES=LDS_BYTES;
struct AttnTensors { const bf16* Q; const bf16* K; const bf16* V; bf16* O; const float* kbar; };
struct AttnUnit { int bh; int qb; };
struct StaticOrder {
  int vcu,G;
  __device__ __forceinline__ explicit StaticOrder(int grid,int block):vcu((grid%8==0)?(block%8)*(grid/8)+block/8:block),G(grid){}
  __device__ __forceinline__ bool next(int i,AttnUnit&u)const{
    if(G==256){ if(i>=4)return false; const int s=vcu&1; u.bh=vcu>>1; u.qb=s?((i==0)?6:(i==1)?1:(i==2)?5:2):((i==0)?7:(i==1)?0:(i==2)?4:3); return true; }
    const int L=i*G+vcu; if(L>=1024)return false; u.bh=L>>3; u.qb=L&7; return true; }
  __device__ __forceinline__ void a_ready(const AttnUnit&)const{}
  __device__ __forceinline__ void done(const AttnUnit&)const{}
};
template<class Sched,int THRL=8> __device__ __forceinline__ void attn_phase(char*lds,const AttnTensors&T,const Sched&S){
  AttnUnit u;
  for(int i=0;S.next(i,u);++i){ S.a_ready(u); attn_unit<THRL>(u.bh/NHEAD,u.bh%NHEAD,u.qb,T.Q,T.K,T.V,T.O,T.kbar,lds); S.done(u); }
}
#undef SBAR
#undef WAIT_BAR
}
constexpr int NWAVES = 8;
constexpr int T = 32768, D = 1024, SEQ = 2048, MEMROWS = 4096, INW = 5120;
constexpr float RMS_EPS = 1e-6f;
constexpr size_t MiB = 1u << 20;
constexpr size_t WS_CTL = 0, CTL_ZERO_BYTES = 2 * MiB, WS_KBAR = 1 * MiB;
constexpr size_t WS_WIN = 2 * MiB, WS_WC = 12 * MiB, WS_WA = 13 * MiB, WS_WM = 14 * MiB, WS_WXQ = 16 * MiB, WS_WXKV = 18 * MiB, WS_WXO = 22 * MiB, WS_MT = 24 * MiB, WS_ROPE = 28 * MiB;
constexpr size_t WS_MEMN = 32 * MiB, WS_KX = 40 * MiB, WS_VXT = 48 * MiB;
constexpr size_t WS_A = 64 * MiB;
constexpr size_t WS_YC = 128 * MiB, WS_QO = 160 * MiB, WS_U = 192 * MiB, WS_K = 224 * MiB, WS_V = 256 * MiB;
constexpr size_t WS_SGC = 320 * MiB, WS_SGA = 384 * MiB;
constexpr size_t WS_EIDX = 448 * MiB, WS_GW = 464 * MiB, WS_END = 480 * MiB;
constexpr size_t WS_QX = 128 * MiB, WS_PM = 192 * MiB, WS_OX = 128 * MiB;
constexpr size_t WS_SC = 128 * MiB;
constexpr int CW_TMO = 0, CW_BAR = 4096;
constexpr int RING_OFF = 0, RING_BYTES = 131072;
constexpr int LDSCTL_OFF = RING_BYTES, MISC_OFF = LDSCTL_OFF + 320;
constexpr int LDS_BYTES = 147456;

#define GAS __attribute__((address_space(1)))
#define LAS __attribute__((address_space(3)))
typedef unsigned short bf16;
typedef unsigned v4u __attribute__((ext_vector_type(4)));
typedef unsigned v2u __attribute__((ext_vector_type(2)));
typedef float f32x4 __attribute__((ext_vector_type(4)));
typedef GAS unsigned gu32;
#define RLX_AGENT __ATOMIC_RELAXED, __HIP_MEMORY_SCOPE_AGENT
#define LDS_WAIT() asm volatile("s_waitcnt lgkmcnt(0)" ::: "memory")
#define VM_WAIT() asm volatile("s_waitcnt vmcnt(0)" ::: "memory")
__device__ __forceinline__ unsigned pk2(float lo, float hi) { return pg8::cvt_pk_bf16(lo, hi); }
__device__ __forceinline__ float bflo(unsigned u) { return __uint_as_float(u << 16); }
__device__ __forceinline__ float bfhi(unsigned u) { return __uint_as_float(u & 0xffff0000u); }

#define XB_TMO      128
#define XB_XCNT(j)  (256  + 64 * (j))
#define XB_XSUB(j)  (1280 + 64 * (j))
#define XB_XGEN(j)  (2304 + 64 * (j))
#define XB_TOP      3328
#define XB_TOPGEN   3392
#define XCD_BAR_WORDS 3456
#define XB_SPIN_CAP (1u << 18)
__device__ __forceinline__ unsigned xb_ld(unsigned* p)              { return __hip_atomic_load(p, __ATOMIC_RELAXED, __HIP_MEMORY_SCOPE_AGENT); }
__device__ __forceinline__ unsigned xb_add(unsigned* p, unsigned v) { return __hip_atomic_fetch_add(p, v, __ATOMIC_RELAXED, __HIP_MEMORY_SCOPE_AGENT); }
__device__ __forceinline__ unsigned xb_xcc_id() { return (unsigned)__builtin_amdgcn_s_getreg((3 << 11) | 20) & 0xFu; }
#define XB_SPIN(cond, bar) do { unsigned _sp = 0; while (cond) { __builtin_amdgcn_s_sleep(1); \
    if ((++_sp & 255u) == 0u) { if (xb_ld(&(bar)[XB_TMO])) break; if (_sp > XB_SPIN_CAP) { atomicAdd(&(bar)[XB_TMO], 1u); break; } } } } while (0)
struct XcdBarrier { unsigned* bar; unsigned x; volatile LAS unsigned* st; };
__device__ __forceinline__ XcdBarrier xcd_barrier_post(unsigned* bar, volatile LAS unsigned* st) {
    XcdBarrier b; b.bar = bar; b.x = xb_xcc_id(); b.st = st;
    if (threadIdx.x == 0) (void)xb_add(&bar[XB_XCNT(b.x)], 1u);
    return b;
}
__device__ __forceinline__ void xcd_barrier_complete(unsigned* bar, unsigned x, unsigned& nloc, unsigned& nx) {
    const unsigned G = gridDim.x * gridDim.y * gridDim.z;
    unsigned sum, cnt, mine, sp = 0u;
    for (;;) {
        sum = 0u; cnt = 0u; mine = 0u;
#pragma unroll
        for (unsigned j = 0; j < 16; ++j) { const unsigned c = xb_ld(&bar[XB_XCNT(j)]); sum += c; cnt += (c > 0u) ? 1u : 0u; mine = (j == x) ? c : mine; }
        if (sum == G) break;
        __builtin_amdgcn_s_sleep(1);
        if ((++sp & 255u) == 0u) { if (xb_ld(&bar[XB_TMO])) break; if (sp > XB_SPIN_CAP) { atomicAdd(&bar[XB_TMO], 1u); break; } }
    }
    nloc = mine > 0u ? mine : 1u; nx = cnt > 0u ? cnt : 1u;
}
__device__ __forceinline__ void xcd_barrier(const XcdBarrier& b) {
    asm volatile("s_waitcnt vmcnt(0)" ::: "memory");
    __syncthreads();
    if (threadIdx.x == 0) {
        unsigned* bar = b.bar;
        __builtin_amdgcn_s_waitcnt(0);
        unsigned nloc = b.st[0], nx = b.st[1];
        if (nloc == 0u) { xcd_barrier_complete(bar, b.x, nloc, nx); b.st[0] = nloc; b.st[1] = nx; }
        const unsigned old = xb_add(&bar[XB_XSUB(b.x)], 1u);
        const unsigned gen = old / nloc;
        if (old + 1u == (gen + 1u) * nloc) {
            __builtin_amdgcn_fence(__ATOMIC_RELEASE, "agent");
            asm volatile("s_waitcnt vmcnt(0)" ::: "memory");
            const unsigned og = xb_add(&bar[XB_TOP], 1u);
            const unsigned tg = og / nx;
            if (og + 1u == (tg + 1u) * nx) xb_add(&bar[XB_TOPGEN], 1u);
            else XB_SPIN(xb_ld(&bar[XB_TOPGEN]) == tg, bar);
            __builtin_amdgcn_fence(__ATOMIC_ACQUIRE, "agent");
            xb_add(&bar[XB_XGEN(b.x)], 1u);
            asm volatile("s_waitcnt vmcnt(0)" ::: "memory");
        } else {
            XB_SPIN(xb_ld(&bar[XB_XGEN(b.x)]) == gen, bar);
            __builtin_amdgcn_fence(__ATOMIC_ACQUIRE, "agent");
            asm volatile("s_waitcnt vmcnt(0)" ::: "memory");
        }
    }
    __syncthreads();
}

struct MapId { static __device__ __forceinline__ int src(int j) { return j; } };
struct MapWin {
    static __device__ __forceinline__ int src(int j) {
        if (j < 1024) { const int g8 = j >> 3, i = j & 7; return ((i < 4) ? 0 : 1024) + 4 * g8 + (i & 3); }
        if (j < 1536) return 512 + (j - 1024);
        if (j < 2560) { const int jj = j - 1536, qk = jj >> 9, p = jj & 511, head = p >> 6, pl = p & 63, g = pl >> 3, i = pl & 7; return 1536 + qk * 512 + head * 64 + 4 * g + (i & 3) + 32 * (i >> 2); }
        return j;
    }
};
template <class MAP>
__device__ __forceinline__ void p0_transpose_item(const float* W, int K, int N, int NOUT, bf16* WT, LAS float* scr, int item, int lane) {
    const int nblk = NOUT / 32, kb = item / nblk, nb = item % nblk, k0 = 64 * kb, n0 = 32 * nb;
    const int sc = MAP::src(n0 + (lane & 31));
#pragma unroll 8
    for (int i = 0; i < 32; ++i) { const int kk = 2 * i + (lane >> 5); scr[kk * 33 + (lane & 31)] = W[(size_t)(k0 + kk) * N + sc]; }
    LDS_WAIT(); asm volatile("" ::: "memory");
    const int c = lane & 7;
#pragma unroll
    for (int j = 0; j < 4; ++j) { const int n = (lane >> 3) + 8 * j; const LAS float* s = scr + (8 * c) * 33 + n;
        v4u o; o.x = pk2(s[0 * 33], s[1 * 33]); o.y = pk2(s[2 * 33], s[3 * 33]); o.z = pk2(s[4 * 33], s[5 * 33]); o.w = pk2(s[6 * 33], s[7 * 33]);
        *(GAS v4u*)(WT + (size_t)(n0 + n) * K + k0 + 8 * c) = o; }
    LDS_WAIT(); asm volatile("" ::: "memory");
}
__device__ __forceinline__ void rms_row_to_bf16(const float* xrow, const float* g, bf16* orow, int lane) {
    const GAS f32x4* xr = (const GAS f32x4*)xrow + lane; const GAS f32x4* gr = (const GAS f32x4*)g + lane;
    f32x4 v[4]; float s = 0.f;
#pragma unroll
    for (int j = 0; j < 4; ++j) { v[j] = xr[64 * j]; s += (v[j].x * v[j].x + v[j].y * v[j].y) + (v[j].z * v[j].z + v[j].w * v[j].w); }
    const float r = rsqrtf(wave_sum(s) * (1.f / 1024.f) + RMS_EPS);
    GAS v2u* o8 = (GAS v2u*)orow + lane;
#pragma unroll
    for (int j = 0; j < 4; ++j) { const f32x4 gg = gr[64 * j]; v2u w; w.x = pk2(v[j].x * r * gg.x, v[j].y * r * gg.y); w.y = pk2(v[j].z * r * gg.z, v[j].w * r * gg.w); o8[64 * j] = w; }
}
__device__ __forceinline__ float fmax_asm(float a, float b) { float r; asm("v_max_f32 %0, %1, %2" : "=v"(r) : "v"(a), "v"(b)); return r; }
__device__ __forceinline__ float fmin_asm(float a, float b) { float r; asm("v_min_f32 %0, %1, %2" : "=v"(r) : "v"(a), "v"(b)); return r; }

#ifndef PH_MASK
#define PH_MASK 0xFFFFFFFFu
#endif
#define PH(k) ((PH_MASK >> (k)) & 1u)
struct Args { const float* in[19]; float* out; unsigned char* ws; };

struct XOrder {
    const char* A; const char* Bt; int G, c, i0; bool pv;
    __device__ bool next(int i, pg8::Unit& u) const {
        if (i > 0 && i0 >= 0) return false;
        const int L = (i0 >= 0 ? i0 : i) * G + c; if (L >= 512) return false;
        const int b = L >> 5, head = (L >> 3) & 3, rt = L & 7;
        u.pm = b * 8 + rt; u.pn = head;
        u.a = A + ((size_t)(b * 2048 + rt * 256) * 1024 + head * 256) * 2;
        u.b = pv ? Bt + ((size_t)(head * 256) * 4096 + b * 256) * 2 : Bt + ((size_t)(b * 256) * 1024 + head * 256) * 2;
        return true;
    }
};

__global__ void __launch_bounds__(NWAVES * 64, 2) mk_fwd(Args args) {
    extern __shared__ __attribute__((aligned(16))) unsigned char lds[];
    LAS unsigned char* L = (LAS unsigned char*)lds;
    volatile LAS unsigned* MISC = (volatile LAS unsigned*)(L + MISC_OFF);
    const int wave = __builtin_amdgcn_readfirstlane((int)threadIdx.x >> 6);
#define PH_LANES int tid = threadIdx.x; asm volatile("" : "+v"(tid)); const int lane = tid & 63; const int gt = vcu * (NWAVES * 64) + tid; (void)lane; (void)gt
    const int G = gridDim.x; const int bx = blockIdx.x; const int vcu = (G % 8 == 0) ? (bx % 8) * (G / 8) + bx / 8 : bx;
    unsigned char* ws = args.ws;
    gu32* ctl = (gu32*)(ws + WS_CTL);
    for (int u = threadIdx.x; u < (LDS_BYTES - LDSCTL_OFF) / 4; u += NWAVES * 64) ((LAS unsigned*)(L + LDSCTL_OFF))[u] = 0u;
    __syncthreads();
    XcdBarrier bar = xcd_barrier_post((unsigned*)(ctl + CW_BAR), MISC + 8);

    const float *x = args.in[0], *mem = args.in[1], *g_mix = args.in[2], *w_in = args.in[3], *w_conv = args.in[4], *w_conv_out = args.in[5], *w_attn_out = args.in[6], *w_merge = args.in[7],
                *g_xattn = args.in[8], *g_mem = args.in[9], *w_xq = args.in[10], *w_xkv = args.in[11], *w_xo = args.in[12], *g_ffn = args.in[13], *w_pq = args.in[14], *sub_keys = args.in[15],
                *peer_u = args.in[16], *peer_v = args.in[17], *g_final = args.in[18];
    float* out = args.out;
    bf16 *WinT = (bf16*)(ws + WS_WIN), *WcT = (bf16*)(ws + WS_WC), *WaT = (bf16*)(ws + WS_WA), *WmT = (bf16*)(ws + WS_WM), *WxqT = (bf16*)(ws + WS_WXQ), *WxkvT = (bf16*)(ws + WS_WXKV),
         *WxoT = (bf16*)(ws + WS_WXO), *MT = (bf16*)(ws + WS_MT);
    float* ropec = (float*)(ws + WS_ROPE); float* ropes = ropec + 2048 * 32;
    float* kbar = (float*)(ws + WS_KBAR);
    bf16 *MEMN = (bf16*)(ws + WS_MEMN), *KX = (bf16*)(ws + WS_KX), *VXT = (bf16*)(ws + WS_VXT), *A = (bf16*)(ws + WS_A);
    bf16 *YC = (bf16*)(ws + WS_YC), *QO = (bf16*)(ws + WS_QO), *U = (bf16*)(ws + WS_U), *KB = (bf16*)(ws + WS_K), *VB = (bf16*)(ws + WS_V), *SGC = (bf16*)(ws + WS_SGC), *SGA = (bf16*)(ws + WS_SGA);
    bf16 *QX = (bf16*)(ws + WS_QX), *PM = (bf16*)(ws + WS_PM), *OX = (bf16*)(ws + WS_OX);
    _Float16* SC = (_Float16*)(ws + WS_SC);
    int* EIDX = (int*)(ws + WS_EIDX); float* GW = (float*)(ws + WS_GW);
    const int gw = vcu * NWAVES + wave, NGW = G * NWAVES;
    const int NGT = G * NWAVES * 64;

    asm volatile("; ===== PHASE 0 =====");
    if (PH(0)) {
        PH_LANES;
        LAS float* scr = (LAS float*)(L + RING_OFF + wave * 16384);
        constexpr int I_IN = (1024 / 64) * (5120 / 32), I_C = (512 / 64) * (1024 / 32), I_M = (1024 / 64) * (1024 / 32), I_KV = (1024 / 64) * (2048 / 32);
        constexpr int NITEMS = I_IN + 2 * I_C + 3 * I_M + I_KV;
        for (int it = gw; it < NITEMS; it += NGW) {
            int r = it;
            if (r < I_IN) { p0_transpose_item<MapWin>(w_in, 1024, 5120, 5120, WinT, scr, r, lane); continue; } r -= I_IN;
            if (r < I_C) { p0_transpose_item<MapId>(w_conv_out, 512, 1024, 1024, WcT, scr, r, lane); continue; } r -= I_C;
            if (r < I_C) { p0_transpose_item<MapId>(w_attn_out, 512, 1024, 1024, WaT, scr, r, lane); continue; } r -= I_C;
            if (r < I_M) { p0_transpose_item<MapId>(w_merge, 1024, 1024, 1024, WmT, scr, r, lane); continue; } r -= I_M;
            if (r < I_M) { p0_transpose_item<MapId>(w_xq, 1024, 1024, 1024, WxqT, scr, r, lane); continue; } r -= I_M;
            if (r < I_M) { p0_transpose_item<MapId>(w_xo, 1024, 1024, 1024, WxoT, scr, r, lane); continue; } r -= I_M;
            p0_transpose_item<MapId>(w_xkv, 1024, 2048, 2048, WxkvT, scr, r, lane);
        }
        for (int m = gw; m < T; m += NGW) rms_row_to_bf16(x + (size_t)m * D, g_mix, A + (size_t)m * D, lane);
        for (int m = gw; m < MEMROWS; m += NGW) rms_row_to_bf16(mem + (size_t)m * D, g_mem, MEMN + (size_t)m * D, lane);
        for (int i = gt; i < 2048 * 32; i += NGT) { const int pos = i >> 5, f = i & 31; const float inv = powf(10000.0f, -(float)f / 32.0f); const float ang = (float)pos * inv; ropec[i] = cosf(ang); ropes[i] = sinf(ang); }
        __syncthreads();
        {
            LAS float* skl = (LAS float*)(L + RING_OFF);
            LAS float* wtl = skl + 128 * 129;
            for (int it = bx; it < 256; it += G) {
                const int hp = it >> 4, cb = it & 15;
                for (int i = tid; i < 128 * 128; i += NWAVES * 64) { const int n = i >> 7, d = i & 127; skl[n * 129 + d] = sub_keys[((size_t)hp * 128 + n) * 128 + d]; }
                for (int i = tid; i < 64 * 128; i += NWAVES * 64) { const int c = i >> 7, d = i & 127; wtl[c * 129 + d] = w_pq[(size_t)(cb * 64 + c) * 2048 + hp * 128 + d]; }
                __syncthreads();
                const int cg = tid & 15, ng = tid >> 4;
                float acc[4][4];
#pragma unroll
                for (int i = 0; i < 4; ++i)
#pragma unroll
                    for (int j = 0; j < 4; ++j) acc[i][j] = 0.f;
                for (int d = 0; d < 128; ++d) {
                    float wv[4], sv[4];
#pragma unroll
                    for (int i = 0; i < 4; ++i) { wv[i] = wtl[(4 * cg + i) * 129 + d]; sv[i] = skl[(4 * ng + i) * 129 + d]; }
#pragma unroll
                    for (int i = 0; i < 4; ++i)
#pragma unroll
                        for (int j = 0; j < 4; ++j) acc[i][j] += sv[i] * wv[j];
                }
#pragma unroll
                for (int i = 0; i < 4; ++i) { v2u w; w.x = pk2(acc[i][0], acc[i][1]); w.y = pk2(acc[i][2], acc[i][3]); *(GAS v2u*)(MT + (size_t)(hp * 128 + 4 * ng + i) * 1024 + cb * 64 + 4 * cg) = w; }
                __syncthreads();
            }
        }
    }
    xcd_barrier(bar);

    asm volatile("; ===== PHASE 1 =====");
    if (PH(1)) {
        PH_LANES;
        pg8::Gemm g{1024, 1024, 1024}; pg8::StaticOrder S; S.init(A, 1024, WinT, 1024, T, INW, G, bx);
        pg8::EpiIn E{U, YC, QO, KB, VB, SGC, SGA, ropec, ropes, kbar, 0.125f * 1.4426950408889634f};
        pg8::gemm_phase<pg8::EpiIn, pg8::StaticOrder, true>(L + RING_OFF, g, S, E);
    }
    if (PH(1)) {
        PH_LANES;
        pg8::Gemm g{1024, 1024, 1024}; pg8::StaticOrder S; S.init(MEMN, 1024, WxkvT, 1024, MEMROWS, 1024, G, bx);
        pg8::EpiBf16 E{KX, 1024};
        pg8::gemm_phase<pg8::EpiBf16, pg8::StaticOrder, true>(L + RING_OFF, g, S, E);
    }
    if (PH(1)) {
        PH_LANES;
        pg8::Gemm g{1024, 1024, 1024}; pg8::StaticOrder S; S.init(WxkvT + (size_t)1024 * 1024, 1024, MEMN, 1024, 1024, MEMROWS, G, (bx + 128) % G);
        pg8::EpiBf16 E{VXT, 4096};
        pg8::gemm_phase<pg8::EpiBf16, pg8::StaticOrder, true>(L + RING_OFF, g, S, E);
    }
    xcd_barrier(bar);

    asm volatile("; ===== PHASE 2 =====");
    if (PH(2)) {
        PH_LANES;
        for (int i = gt; i < T * 64; i += NGT) {
            const int row = i >> 6, cg = i & 63, s = row & 2047;
            const v4u u0 = *(const GAS v4u*)(U + (size_t)row * 512 + cg * 8);
            v4u u1 = (v4u){0u, 0u, 0u, 0u}, u2 = (v4u){0u, 0u, 0u, 0u};
            if (s >= 1) u1 = *(const GAS v4u*)(U + (size_t)(row - 1) * 512 + cg * 8);
            if (s >= 2) u2 = *(const GAS v4u*)(U + (size_t)(row - 2) * 512 + cg * 8);
            const v4u bq = *(const GAS v4u*)(YC + (size_t)row * 512 + cg * 8);
            const f32x4 w0a = *(const GAS f32x4*)(w_conv + cg * 8), w0b = *(const GAS f32x4*)(w_conv + cg * 8 + 4);
            const f32x4 w1a = *(const GAS f32x4*)(w_conv + 512 + cg * 8), w1b = *(const GAS f32x4*)(w_conv + 512 + cg * 8 + 4);
            const f32x4 w2a = *(const GAS f32x4*)(w_conv + 1024 + cg * 8), w2b = *(const GAS f32x4*)(w_conv + 1024 + cg * 8 + 4);
            v4u o;
#define CONV2(q, wa, ia, ib) pk2(bflo(bq.q) * (w0##wa[ia] * bflo(u2.q) + w1##wa[ia] * bflo(u1.q) + w2##wa[ia] * bflo(u0.q)), bfhi(bq.q) * (w0##wa[ib] * bfhi(u2.q) + w1##wa[ib] * bfhi(u1.q) + w2##wa[ib] * bfhi(u0.q)))
            o.x = CONV2(x, a, 0, 1); o.y = CONV2(y, a, 2, 3); o.z = CONV2(z, b, 0, 1); o.w = CONV2(w, b, 2, 3);
#undef CONV2
            *(GAS v4u*)(YC + (size_t)row * 512 + cg * 8) = o;
        }
        __syncthreads();
        const attn_body::AttnTensors AT{(const attn_body::bf16*)QO, (const attn_body::bf16*)KB, (const attn_body::bf16*)VB, (attn_body::bf16*)QO, kbar};
        const attn_body::StaticOrder S(G, bx);
        attn_body::attn_phase<attn_body::StaticOrder>((char*)lds + RING_OFF, AT, S);
    }
    xcd_barrier(bar);

    asm volatile("; ===== PHASE 3 =====");
    if (PH(3)) {
        PH_LANES;
        pg8::Gemm g{512, 512, 512}; pg8::StaticOrder S; S.init(YC, 512, WcT, 512, T, 1024, G, bx);
        pg8::EpiGateMul E{SGC, 1024};
        pg8::gemm_phase<pg8::EpiGateMul, pg8::StaticOrder, true>(L + RING_OFF, g, S, E);
    }
    if (PH(3)) {
        PH_LANES;
        pg8::Gemm g{512, 512, 512}; pg8::StaticOrder S; S.init(QO, 512, WaT, 512, T, 1024, G, bx);
        pg8::EpiGateFma E{SGC, SGA, 1024};
        pg8::gemm_phase<pg8::EpiGateFma, pg8::StaticOrder, true>(L + RING_OFF, g, S, E);
    }
    xcd_barrier(bar);

    asm volatile("; ===== PHASE 4 =====");
    if (PH(4)) {
        PH_LANES;
        pg8::Gemm g{1024, 1024, 1024}; pg8::StaticOrder S; S.init(SGA, 1024, WmT, 1024, T, 1024, G, bx);
        pg8::EpiResF32 E{x, out, 1024};
        pg8::gemm_phase<pg8::EpiResF32, pg8::StaticOrder, true>(L + RING_OFF, g, S, E);
    }
    xcd_barrier(bar);

    asm volatile("; ===== PHASE 5 =====");
    if (PH(5)) {
        PH_LANES;
        for (int m = gw; m < T; m += NGW) rms_row_to_bf16(out + (size_t)m * D, g_xattn, A + (size_t)m * D, lane);
    }
    xcd_barrier(bar);

    asm volatile("; ===== PHASE 6 =====");
    if (PH(6)) {
        PH_LANES;
        pg8::Gemm g{1024, 1024, 1024}; pg8::StaticOrder S; S.init(A, 1024, WxqT, 1024, T, 1024, G, bx);
        pg8::EpiBf16 E{QX, 1024};
        pg8::gemm_phase<pg8::EpiBf16, pg8::StaticOrder, true>(L + RING_OFF, g, S, E);
    }
    xcd_barrier(bar);

    asm volatile("; ===== PHASE 7 =====");
    if (PH(7)) {
        PH_LANES;
        pg8::Gemm g{1024, 1024, 256};
        pg8::EpiSoftmax E{PM, 1024, 0.0625f * 1.4426950408889634f};
        { XOrder S{(const char*)QX, (const char*)KX, G, vcu, 0, false}; pg8::gemm_phase<pg8::EpiSoftmax, XOrder, false>(L + RING_OFF, g, S, E); }
        { XOrder S{(const char*)QX, (const char*)KX, G, vcu, 1, false}; pg8::gemm_phase<pg8::EpiSoftmax, XOrder, false>(L + RING_OFF, g, S, E); }
    }
    xcd_barrier(bar);

    asm volatile("; ===== PHASE 8 =====");
    if (PH(8)) {
        PH_LANES;
        pg8::Gemm g{1024, 4096, 256};
        pg8::EpiBf16 E{OX, 1024};
        { XOrder S{(const char*)PM, (const char*)VXT, G, vcu, 0, true}; pg8::gemm_phase<pg8::EpiBf16, XOrder, false>(L + RING_OFF, g, S, E); }
        { XOrder S{(const char*)PM, (const char*)VXT, G, vcu, 1, true}; pg8::gemm_phase<pg8::EpiBf16, XOrder, false>(L + RING_OFF, g, S, E); }
    }
    xcd_barrier(bar);

    asm volatile("; ===== PHASE 9 =====");
    if (PH(9)) {
        PH_LANES;
        pg8::Gemm g{1024, 1024, 1024}; pg8::StaticOrder S; S.init(OX, 1024, WxoT, 1024, T, 1024, G, bx);
        pg8::EpiResF32 E{out, out, 1024};
        pg8::gemm_phase<pg8::EpiResF32, pg8::StaticOrder, true>(L + RING_OFF, g, S, E);
    }
    xcd_barrier(bar);

    asm volatile("; ===== PHASE 10 =====");
    if (PH(10)) {
        PH_LANES;
        for (int m = gw; m < T; m += NGW) rms_row_to_bf16(out + (size_t)m * D, g_ffn, A + (size_t)m * D, lane);
    }
    xcd_barrier(bar);

    asm volatile("; ===== PHASE 11 =====");
    if (PH(11)) {
        PH_LANES;
        pg8::Gemm g{1024, 1024, 1024}; pg8::StaticOrder S; S.init(A, 1024, MT, 1024, T, 2048, G, bx);
        pg8::EpiF16 E{SC, 2048};
        pg8::gemm_phase<pg8::EpiF16, pg8::StaticOrder, true>(L + RING_OFF, g, S, E);
    }
    xcd_barrier(bar);

    asm volatile("; ===== PHASE 12 =====");
    if (PH(12)) {
        PH_LANES;
        typedef _Float16 h8 __attribute__((ext_vector_type(8)));
        LAS unsigned char* idl = L + RING_OFF + tid * 32;
        for (int task = gt; task < T * 8; task += NGT) {
            const int t = task >> 3, h = task & 7;
            const _Float16* row = SC + (size_t)t * 2048 + h * 256;
            float LA[16], LB[16];
#pragma unroll
            for (int p = 0; p < 2; ++p) {
                float Lk[16];
#pragma unroll
                for (int k = 0; k < 16; ++k) Lk[k] = -INFINITY;
                for (int c = 0; c < 16; ++c) {
                    const h8 v = *(const h8*)(row + p * 128 + c * 8);
#pragma unroll
                    for (int e = 0; e < 8; ++e) {
                        float key = __uint_as_float(__float_as_uint((float)v[e]) | (unsigned)(c * 8 + e));
#pragma unroll
                        for (int k = 0; k < 16; ++k) { const float hi_ = fmax_asm(Lk[k], key); key = fmin_asm(Lk[k], key); Lk[k] = hi_; }
                    }
                }
#pragma unroll
                for (int k = 0; k < 16; ++k) { if (p == 0) LA[k] = Lk[k]; else LB[k] = Lk[k]; }
            }
#pragma unroll
            for (int k = 0; k < 16; k += 4) {
                ((LAS unsigned*)idl)[k >> 2] = (__float_as_uint(LA[k]) & 127u) | ((__float_as_uint(LA[k + 1]) & 127u) << 8) | ((__float_as_uint(LA[k + 2]) & 127u) << 16) | ((__float_as_uint(LA[k + 3]) & 127u) << 24);
                ((LAS unsigned*)idl)[4 + (k >> 2)] = (__float_as_uint(LB[k]) & 127u) | ((__float_as_uint(LB[k + 1]) & 127u) << 8) | ((__float_as_uint(LB[k + 2]) & 127u) << 16) | ((__float_as_uint(LB[k + 3]) & 127u) << 24);
            }
            float Ck[16];
#pragma unroll
            for (int k = 0; k < 16; ++k) Ck[k] = -INFINITY;
#pragma unroll
            for (int a = 0; a < 16; ++a)
#pragma unroll
                for (int b = 0; b < 16; ++b)
                    if ((a + 1) * (b + 1) <= 16) {
                        float key = __uint_as_float((__float_as_uint(LA[a] + LB[b]) & ~255u) | (unsigned)(a * 16 + b));
#pragma unroll
                        for (int k = 0; k < 16; ++k) { const float hi_ = fmax_asm(Ck[k], key); key = fmin_asm(Ck[k], key); Ck[k] = hi_; }
                    }
            LDS_WAIT();
            float ex[16]; float sum = 0.f;
#pragma unroll
            for (int k = 0; k < 16; ++k) { ex[k] = __expf(Ck[k] - Ck[0]); sum += ex[k]; }
            const float rs = 1.f / sum;
            int* eo = EIDX + (size_t)t * 128 + h * 16; float* go = GW + (size_t)t * 128 + h * 16;
#pragma unroll
            for (int k = 0; k < 16; k += 4) {
                int ev[4];
#pragma unroll
                for (int j = 0; j < 4; ++j) { const unsigned id = __float_as_uint(Ck[k + j]) & 255u; ev[j] = (int)idl[id >> 4] * 128 + (int)idl[16 + (id & 15u)]; }
                *(GAS v4u*)(eo + k) = (v4u){(unsigned)ev[0], (unsigned)ev[1], (unsigned)ev[2], (unsigned)ev[3]};
                *(GAS f32x4*)(go + k) = (f32x4){ex[k] * rs, ex[k + 1] * rs, ex[k + 2] * rs, ex[k + 3] * rs};
            }
            LDS_WAIT();
        }
    }
    xcd_barrier(bar);

    asm volatile("; ===== PHASE 13 =====");
    if (PH(13)) {
        PH_LANES;
        for (int t = gw; t < T; t += NGW) {
            const GAS v2u* ar = (const GAS v2u*)(A + (size_t)t * D) + lane;
            float a[16];
#pragma unroll
            for (int j = 0; j < 4; ++j) { const v2u q = ar[64 * j]; a[4 * j] = bflo(q.x); a[4 * j + 1] = bfhi(q.x); a[4 * j + 2] = bflo(q.y); a[4 * j + 3] = bfhi(q.y); }
            const int e0 = EIDX[(size_t)t * 128 + lane], e1 = EIDX[(size_t)t * 128 + 64 + lane];
            const float g0 = GW[(size_t)t * 128 + lane], g1 = GW[(size_t)t * 128 + 64 + lane];
            float w0 = 0.f, w1 = 0.f;
#pragma unroll
            for (int half = 0; half < 2; ++half) {
                const int ev = half ? e1 : e0;
#pragma unroll 2
                for (int s = 0; s < 64; ++s) {
                    const int e = __builtin_amdgcn_readlane(ev, s);
                    const GAS f32x4* ur = (const GAS f32x4*)(peer_u + (size_t)e * D) + lane;
                    float d = 0.f;
#pragma unroll
                    for (int j = 0; j < 4; ++j) { const f32x4 uu = ur[64 * j]; d += (a[4 * j] * uu.x + a[4 * j + 1] * uu.y) + (a[4 * j + 2] * uu.z + a[4 * j + 3] * uu.w); }
                    d = wave_sum(d);
                    const float u3 = 0.7978845608028654f * (d + 0.044715f * d * d * d);
                    const float act = d * __builtin_amdgcn_rcpf(1.f + __expf(-2.f * u3));
                    if (half == 0) { if (lane == s) w0 = g0 * act; } else { if (lane == s) w1 = g1 * act; }
                }
            }
            f32x4 o[4] = {(f32x4){0.f, 0.f, 0.f, 0.f}, (f32x4){0.f, 0.f, 0.f, 0.f}, (f32x4){0.f, 0.f, 0.f, 0.f}, (f32x4){0.f, 0.f, 0.f, 0.f}};
#pragma unroll
            for (int half = 0; half < 2; ++half) {
                const int ev = half ? e1 : e0; const float wv = half ? w1 : w0;
#pragma unroll 4
                for (int s = 0; s < 64; ++s) {
                    const int e = __builtin_amdgcn_readlane(ev, s); const float w = __uint_as_float(__builtin_amdgcn_readlane(__float_as_uint(wv), s));
                    const GAS f32x4* vr = (const GAS f32x4*)(peer_v + (size_t)e * D) + lane;
#pragma unroll
                    for (int j = 0; j < 4; ++j) o[j] += vr[64 * j] * w;
                }
            }
            GAS f32x4* hr = (GAS f32x4*)(out + (size_t)t * D) + lane; const GAS f32x4* gr = (const GAS f32x4*)g_final + lane;
            float ss = 0.f;
#pragma unroll
            for (int j = 0; j < 4; ++j) { o[j] += hr[64 * j]; ss += (o[j].x * o[j].x + o[j].y * o[j].y) + (o[j].z * o[j].z + o[j].w * o[j].w); }
            const float r = rsqrtf(wave_sum(ss) * (1.f / 1024.f) + RMS_EPS);
#pragma unroll
            for (int j = 0; j < 4; ++j) hr[64 * j] = o[j] * r * gr[64 * j];
        }
    }
}

extern "C" void kernel_launch(void* const* d_in, const int* in_sizes, int n_in, void* d_out, int out_size, void* d_ws, size_t ws_size, hipStream_t stream) {
    static int grid = 0;
    if (grid == 0) {
        if (n_in != 19 || out_size != T * D || ws_size < WS_END) { fprintf(stderr, "kernel_launch: unexpected problem (n_in %d, out %d, ws %zu < %zu); nothing launched\n", n_in, out_size, ws_size, (size_t)WS_END); grid = -1; return; }
        int dev = 0, cus = 0, per_cu = 0;
        if (hipGetDevice(&dev) != hipSuccess || hipDeviceGetAttribute(&cus, hipDeviceAttributeMultiprocessorCount, dev) != hipSuccess) { grid = -1; return; }
        if (hipFuncSetAttribute((const void*)mk_fwd, hipFuncAttributeMaxDynamicSharedMemorySize, LDS_BYTES) != hipSuccess) { fprintf(stderr, "kernel_launch: hipFuncSetAttribute failed\n"); grid = -1; return; }
        if (hipOccupancyMaxActiveBlocksPerMultiprocessor(&per_cu, (const void*)mk_fwd, NWAVES * 64, LDS_BYTES) != hipSuccess || per_cu < 1) { fprintf(stderr, "kernel_launch: occupancy query says %d blocks per CU\n", per_cu); }
        (void)hipGetLastError();
        grid = cus;
    }
    if (grid < 0) return;
    if (hipMemsetAsync((char*)d_ws + WS_CTL, 0, CTL_ZERO_BYTES, stream) != hipSuccess) return;
    Args a{};
    for (int i = 0; i < 19; ++i) a.in[i] = (const float*)d_in[i];
    a.out = (float*)d_out; a.ws = (unsigned char*)d_ws;
    hipLaunchKernelGGL(mk_fwd, dim3(grid), dim3(NWAVES * 64), LDS_BYTES, stream, a);
}
```

```cpp
#include <hip/hip_runtime.h>
#include <hip/hip_bf16.h>
#include <cstdio>
#include <cstdint>
#include <cmath>

#ifndef DIAG
#define DIAG 0
#endif


template <int O> __device__ __forceinline__ float shx(float v) { static_assert(O > 0 && O < 32, "shx"); return __uint_as_float((unsigned)__builtin_amdgcn_ds_swizzle((int)__float_as_uint(v), (O << 10) | 0x1f)); }
__device__ __forceinline__ float sum32(float v) { auto r = __builtin_amdgcn_permlane32_swap(__float_as_uint(v), __float_as_uint(v), false, false); return __uint_as_float(r[0]) + __uint_as_float(r[1]); }
__device__ __forceinline__ float max32(float v) { auto r = __builtin_amdgcn_permlane32_swap(__float_as_uint(v), __float_as_uint(v), false, false); return fmaxf(__uint_as_float(r[0]), __uint_as_float(r[1])); }
__device__ __forceinline__ float wave_max(float v) { v = fmaxf(v, shx<1>(v)); v = fmaxf(v, shx<2>(v)); v = fmaxf(v, shx<4>(v)); v = fmaxf(v, shx<8>(v)); v = fmaxf(v, shx<16>(v)); return max32(v); }
__device__ __forceinline__ float wave_sum(float v) { v += shx<1>(v); v += shx<2>(v); v += shx<4>(v); v += shx<8>(v); v += shx<16>(v); return sum32(v); }

namespace pg8 {
#define PG8_LAS __attribute__((address_space(3)))
typedef unsigned short bf16_t;
typedef short bf16x8 __attribute__((ext_vector_type(8)));
typedef float f32x4 __attribute__((ext_vector_type(4)));
typedef float f32x2 __attribute__((ext_vector_type(2)));
typedef unsigned u32x4 __attribute__((ext_vector_type(4)));
typedef unsigned u32x2 __attribute__((ext_vector_type(2)));
constexpr int BM = 256, BK = 64, HALF = 128, HTB = HALF * BK * 2  , STAGE_BYTES = 8 * HTB, NXCD = 8, WGM = 8;

__host__ __device__ __forceinline__ int lds_byte(int r, int c) { const int st = (r >> 4) * 2 + (c >> 5), rr = r & 15, cc = c & 31, ob = rr * 64 + cc * 2; return st * 1024 + (ob ^ (((ob >> 9) & 1) << 5)); }
__host__ __device__ __forceinline__ void stage_rc(int b, int& R, int& C) { const int st = b / 1024, sb = b % 1024, swz = sb ^ (((sb >> 9) & 1) << 5); R = (st >> 1) * 16 + swz / 64; C = (st & 1) * 32 + (swz % 64) / 2; }
__host__ __device__ __forceinline__ int perm32(int rho) { const int n = rho >> 4, i = rho & 15; return 8 * (i >> 2) + 4 * n + (i & 3); }

struct Unit { int pm, pn; const char* a; const char* b; };
struct Gemm { int lda, ldb, K; };

struct StaticOrder {
    int nM, nN, nwg, G, c; const char* A; const char* Bt; size_t astep, bstep;
    __device__ void init(const void* A_, int lda, const void* Bt_, int ldb, int M, int N, int G_, int c_) { nM = M / BM; nN = N / BM; nwg = nM * nN; G = G_; c = c_; A = (const char*)A_; Bt = (const char*)Bt_; astep = (size_t)BM * lda * 2; bstep = (size_t)BM * ldb * 2; }
    __device__ bool next(int i, Unit& u) const {
        const long L = (long)i * G + c; if (L >= nwg) return false;
        int wgid = (int)L; { const int q = nwg / NXCD, r = nwg % NXCD, xcd = wgid % NXCD, off = wgid / NXCD; wgid = (xcd < r ? xcd * (q + 1) : r * (q + 1) + (xcd - r) * q) + off; }
        const int nig = WGM * nN, gid = wgid / nig, fm = gid * WGM, gsz = (nM - fm) < WGM ? (nM - fm) : WGM;
        u.pm = fm + ((wgid % nig) % gsz); u.pn = (wgid % nig) / gsz; u.a = A + (size_t)u.pm * astep; u.b = Bt + (size_t)u.pn * bstep; return true;
    }
};

__device__ __forceinline__ unsigned cvt_pk_bf16(float lo, float hi) { typedef __bf16 bf2 __attribute__((ext_vector_type(2))); f32x2 v = {lo, hi}; bf2 b = __builtin_convertvector(v, bf2); return __builtin_bit_cast(unsigned, b); }
__device__ __forceinline__ float bf_lo(unsigned u) { return __uint_as_float(u << 16); }
__device__ __forceinline__ float bf_hi(unsigned u) { return __uint_as_float(u & 0xffff0000u); }

template <class Epi, class Sched, bool ALIGN_EPI>
__device__ __forceinline__ void gemm_phase(PG8_LAS unsigned char* lds, const Gemm g, const Sched& S, const Epi& E) {
    int tid = threadIdx.x; asm volatile("" : "+v"(tid));
    const int wid = __builtin_amdgcn_readfirstlane(tid >> 6), lane = tid & 63, wr = wid >> 2, wc = wid & 3, fr = lane & 15, fq = lane >> 4;
    const int K = g.K, nt = K / BK;
    unsigned voffA[2], voffB[2];
#pragma unroll
    for (int i = 0; i < 2; ++i) { int R, C; stage_rc(tid * 16 + i * 8192, R, C); const int Rb = Epi::PERM ? ((R & ~31) + perm32(R & 31)) : R;
        voffA[i] = (unsigned)(R * g.lda + C) * 2u; voffB[i] = (unsigned)(Rb * g.ldb + C) * 2u; }
    const size_t kstep = (size_t)(BK * 2);
    const size_t hstepA = (size_t)HALF * g.lda * 2, hstepB = (size_t)HALF * g.ldb * 2;
    const unsigned ldsw = (unsigned)wid * 1024u;
    const int aoff = lds_byte(wr * 64 + fr, fq * 8), boff = lds_byte(wc * 32 + fr, fq * 8);
#define PG8_SA(b, h) (((b) * 2 + (h)) * HTB)
#define PG8_SB(b, h) ((4 + (b) * 2 + (h)) * HTB)
#define PG8_STAGE(bufoff, gbase, voff) do { _Pragma("unroll") for (int _i = 0; _i < 2; ++_i) \
        __builtin_amdgcn_global_load_lds((const unsigned*)((const char*)(gbase) + (voff)[_i]), (PG8_LAS unsigned*)(lds + (bufoff) + ldsw + _i * 8192), 16, 0, 0); } while (0)
#define PG8_LDA(dst, b, h) do { _Pragma("unroll") for (int m = 0; m < 4; ++m) _Pragma("unroll") for (int k = 0; k < 2; ++k) dst[m][k] = *(const PG8_LAS bf16x8*)(lds + PG8_SA(b, h) + aoff + m * 2048 + k * 1024); } while (0)
#define PG8_LDB(dst, b, h) do { _Pragma("unroll") for (int n = 0; n < 2; ++n) _Pragma("unroll") for (int k = 0; k < 2; ++k) dst[n][k] = *(const PG8_LAS bf16x8*)(lds + PG8_SB(b, h) + boff + n * 2048 + k * 1024); } while (0)
#define PG8_MMA(ai, bj, At, Bt) do { __builtin_amdgcn_s_setprio(1); _Pragma("unroll") for (int m = 0; m < 4; ++m) _Pragma("unroll") for (int n = 0; n < 2; ++n) _Pragma("unroll") for (int k = 0; k < 2; ++k) \
        acc[ai][bj][m][n] = __builtin_amdgcn_mfma_f32_16x16x32_bf16(Bt[n][k], At[m][k], acc[ai][bj][m][n], 0, 0, 0); __builtin_amdgcn_s_setprio(0); } while (0)
#define PG8_WAIT_V(n) asm volatile("s_waitcnt vmcnt(" #n ")" ::: "memory")
#define PG8_WAIT_L(n) asm volatile("s_waitcnt lgkmcnt(" #n ")" ::: "memory")
#define PG8_BAR __builtin_amdgcn_s_barrier()
#define PG8_SCHED __builtin_amdgcn_sched_barrier(0)
    Unit cur, nxt; int ui = 0;
    if (!S.next(0, cur)) return;
    f32x4 acc[2][2][4][2];
#pragma unroll
    for (int a = 0; a < 2; ++a)
#pragma unroll
        for (int b = 0; b < 2; ++b)
#pragma unroll
            for (int m = 0; m < 4; ++m)
#pragma unroll
                for (int n = 0; n < 2; ++n) acc[a][b][m][n] = (f32x4){0.f, 0.f, 0.f, 0.f};
    bf16x8 At[4][2], B0[2][2], B1[2][2];
    const char* cA = cur.a; const char* cB = cur.b;
    PG8_STAGE(PG8_SB(0, 0), cB, voffB); PG8_STAGE(PG8_SB(0, 1), cB + hstepB, voffB); PG8_STAGE(PG8_SA(0, 0), cA, voffA); PG8_STAGE(PG8_SA(0, 1), cA + hstepA, voffA);
    if (wr == 1) PG8_BAR;
    PG8_WAIT_V(2); PG8_BAR;
    PG8_STAGE(PG8_SB(1, 0), cB + kstep, voffB); PG8_STAGE(PG8_SA(1, 0), cA + kstep, voffA); PG8_STAGE(PG8_SB(1, 1), cB + hstepB + kstep, voffB);
    PG8_WAIT_V(6); PG8_BAR;
    for (;;) {
        const bool has_next = S.next(ui + 1, nxt);
        const char* nA = has_next ? nxt.a : cA; const char* nB = has_next ? nxt.b : cB;
        for (int t = 0; t < nt; t += 2) {
            const bool last = (t == nt - 2);
            const char* a1 = cA + (size_t)(t + 1) * kstep;
            const char* a2 = last ? nA : cA + (size_t)(t + 2) * kstep; const char* b2 = last ? nB : cB + (size_t)(t + 2) * kstep;
            const char* a3 = a2 + kstep; const char* b3 = b2 + kstep;
            PG8_LDB(B0, 0, 0); PG8_LDB(B1, 0, 1); PG8_SCHED; PG8_LDA(At, 0, 0); PG8_STAGE(PG8_SA(1, 1), a1 + hstepA, voffA);
            PG8_WAIT_V(8); PG8_WAIT_L(0); PG8_BAR; PG8_MMA(0, 0, At, B0); PG8_MMA(0, 1, At, B1); PG8_BAR; PG8_SCHED;
            PG8_LDA(At, 0, 1); PG8_STAGE(PG8_SB(0, 0), b2, voffB); PG8_STAGE(PG8_SB(0, 1), b2 + hstepB, voffB); PG8_STAGE(PG8_SA(0, 0), a2, voffA);
            PG8_WAIT_V(8); PG8_WAIT_L(0); PG8_BAR; PG8_MMA(1, 0, At, B0); PG8_MMA(1, 1, At, B1); PG8_BAR; PG8_SCHED;
            PG8_LDB(B0, 1, 0); PG8_LDB(B1, 1, 1); PG8_SCHED; PG8_LDA(At, 1, 0); PG8_STAGE(PG8_SA(0, 1), a2 + hstepA, voffA);
            PG8_WAIT_V(8); PG8_WAIT_L(0); PG8_BAR; PG8_MMA(0, 0, At, B0); PG8_MMA(0, 1, At, B1); PG8_BAR; PG8_SCHED;
            PG8_LDA(At, 1, 1); PG8_STAGE(PG8_SB(1, 0), b3, voffB); PG8_STAGE(PG8_SB(1, 1), b3 + hstepB, voffB); PG8_STAGE(PG8_SA(1, 0), a3, voffA);
            PG8_WAIT_V(8); PG8_WAIT_L(0); PG8_BAR; PG8_MMA(1, 0, At, B0); PG8_MMA(1, 1, At, B1); PG8_BAR; PG8_SCHED;
        }
        if constexpr (ALIGN_EPI) { if (wr == 0) PG8_BAR; }
        if constexpr (!Epi::AFTER_DRAIN) { E(acc, cur, wr, wc, fr, fq); }
        if (!has_next) break;
#pragma unroll
        for (int a = 0; a < 2; ++a)
#pragma unroll
            for (int b = 0; b < 2; ++b)
#pragma unroll
                for (int m = 0; m < 4; ++m)
#pragma unroll
                    for (int n = 0; n < 2; ++n) acc[a][b][m][n] = (f32x4){0.f, 0.f, 0.f, 0.f};
        cur = nxt; cA = nA; cB = nB; ++ui;
        if constexpr (ALIGN_EPI) { if (wr == 1) PG8_BAR; }
    }
    PG8_WAIT_V(0);
    if constexpr (!ALIGN_EPI) { if (wr == 0) PG8_BAR; }
    PG8_BAR;
    if constexpr (Epi::AFTER_DRAIN) { E.fused(acc, cur, wr, wc, fr, fq, lds, wid, lane); }
#undef PG8_SA
#undef PG8_SB
#undef PG8_STAGE
#undef PG8_LDA
#undef PG8_LDB
#undef PG8_MMA
#undef PG8_WAIT_V
#undef PG8_WAIT_L
#undef PG8_BAR
#undef PG8_SCHED
}

typedef f32x4 AccT[2][2][4][2];

struct EpiBf16 {
    static constexpr bool PERM = true, AFTER_DRAIN = false;
    bf16_t* O; int ldc;
    __device__ __forceinline__ void operator()(const AccT& acc, const Unit& u, int wr, int wc, int fr, int fq) const {
        { int t_ = threadIdx.x; asm volatile("" : "+v"(t_)); fr = t_ & 15; fq = (t_ >> 4) & 3; }
        const int row0 = u.pm * BM + wr * 64 + fr, col0 = u.pn * BM + wc * 32 + 8 * fq;
#pragma unroll
        for (int ai = 0; ai < 2; ++ai)
#pragma unroll
            for (int m = 0; m < 4; ++m) { bf16_t* rowp = O + (size_t)(row0 + ai * HALF + m * 16) * ldc + col0;
#pragma unroll
                for (int bj = 0; bj < 2; ++bj) { const f32x4 v0 = acc[ai][bj][m][0], v1 = acc[ai][bj][m][1];
                    u32x4 w; w.x = cvt_pk_bf16(v0[0], v0[1]); w.y = cvt_pk_bf16(v0[2], v0[3]); w.z = cvt_pk_bf16(v1[0], v1[1]); w.w = cvt_pk_bf16(v1[2], v1[3]);
                    *(u32x4*)(rowp + bj * HALF) = w; } }
    }
};
struct EpiF16 {
    static constexpr bool PERM = true, AFTER_DRAIN = false;
    _Float16* O; int ldc;
    __device__ __forceinline__ void operator()(const AccT& acc, const Unit& u, int wr, int wc, int fr, int fq) const {
        { int t_ = threadIdx.x; asm volatile("" : "+v"(t_)); fr = t_ & 15; fq = (t_ >> 4) & 3; }
        typedef _Float16 h8 __attribute__((ext_vector_type(8)));
        const int row0 = u.pm * BM + wr * 64 + fr, col0 = u.pn * BM + wc * 32 + 8 * fq;
#pragma unroll
        for (int ai = 0; ai < 2; ++ai)
#pragma unroll
            for (int m = 0; m < 4; ++m) { _Float16* rowp = O + (size_t)(row0 + ai * HALF + m * 16) * ldc + col0;
#pragma unroll
                for (int bj = 0; bj < 2; ++bj) { const f32x4 v0 = acc[ai][bj][m][0], v1 = acc[ai][bj][m][1];
                    h8 w = {(_Float16)v0[0], (_Float16)v0[1], (_Float16)v0[2], (_Float16)v0[3], (_Float16)v1[0], (_Float16)v1[1], (_Float16)v1[2], (_Float16)v1[3]};
                    *(h8*)(rowp + bj * HALF) = w; } }
    }
};
struct EpiGateMul {
    static constexpr bool PERM = true, AFTER_DRAIN = false;
    bf16_t* G; int ldc;
    __device__ __forceinline__ void operator()(const AccT& acc, const Unit& u, int wr, int wc, int fr, int fq) const {
        { int t_ = threadIdx.x; asm volatile("" : "+v"(t_)); fr = t_ & 15; fq = (t_ >> 4) & 3; }
        const int row0 = u.pm * BM + wr * 64 + fr, col0 = u.pn * BM + wc * 32 + 8 * fq;
#pragma unroll
        for (int ai = 0; ai < 2; ++ai)
#pragma unroll
            for (int m = 0; m < 4; ++m) { bf16_t* rowp = G + (size_t)(row0 + ai * HALF + m * 16) * ldc + col0;
#pragma unroll
                for (int bj = 0; bj < 2; ++bj) { const f32x4 v0 = acc[ai][bj][m][0], v1 = acc[ai][bj][m][1]; const u32x4 gq = *(const u32x4*)(rowp + bj * HALF);
                    u32x4 w; w.x = cvt_pk_bf16(v0[0] * bf_lo(gq.x), v0[1] * bf_hi(gq.x)); w.y = cvt_pk_bf16(v0[2] * bf_lo(gq.y), v0[3] * bf_hi(gq.y));
                    w.z = cvt_pk_bf16(v1[0] * bf_lo(gq.z), v1[1] * bf_hi(gq.z)); w.w = cvt_pk_bf16(v1[2] * bf_lo(gq.w), v1[3] * bf_hi(gq.w));
                    *(u32x4*)(rowp + bj * HALF) = w; } }
    }
};
struct EpiGateFma {
    static constexpr bool PERM = true, AFTER_DRAIN = false;
    const bf16_t* Tm; bf16_t* G2; int ldc;
    __device__ __forceinline__ void operator()(const AccT& acc, const Unit& u, int wr, int wc, int fr, int fq) const {
        { int t_ = threadIdx.x; asm volatile("" : "+v"(t_)); fr = t_ & 15; fq = (t_ >> 4) & 3; }
        const int row0 = u.pm * BM + wr * 64 + fr, col0 = u.pn * BM + wc * 32 + 8 * fq;
#pragma unroll
        for (int ai = 0; ai < 2; ++ai)
#pragma unroll
            for (int m = 0; m < 4; ++m) { const size_t off = (size_t)(row0 + ai * HALF + m * 16) * ldc + col0;
#pragma unroll
                for (int bj = 0; bj < 2; ++bj) { const f32x4 v0 = acc[ai][bj][m][0], v1 = acc[ai][bj][m][1]; const u32x4 gq = *(const u32x4*)(G2 + off + bj * HALF); const u32x4 tq = *(const u32x4*)(Tm + off + bj * HALF);
                    u32x4 w; w.x = cvt_pk_bf16(bf_lo(tq.x) + v0[0] * bf_lo(gq.x), bf_hi(tq.x) + v0[1] * bf_hi(gq.x)); w.y = cvt_pk_bf16(bf_lo(tq.y) + v0[2] * bf_lo(gq.y), bf_hi(tq.y) + v0[3] * bf_hi(gq.y));
                    w.z = cvt_pk_bf16(bf_lo(tq.z) + v1[0] * bf_lo(gq.z), bf_hi(tq.z) + v1[1] * bf_hi(gq.z)); w.w = cvt_pk_bf16(bf_lo(tq.w) + v1[2] * bf_lo(gq.w), bf_hi(tq.w) + v1[3] * bf_hi(gq.w));
                    *(u32x4*)(G2 + off + bj * HALF) = w; } }
    }
};
struct EpiResF32 {
    static constexpr bool PERM = false, AFTER_DRAIN = false;
    const float* res; float* out; int ldc;
    __device__ __forceinline__ void operator()(const AccT& acc, const Unit& u, int wr, int wc, int fr, int fq) const {
        { int t_ = threadIdx.x; asm volatile("" : "+v"(t_)); fr = t_ & 15; fq = (t_ >> 4) & 3; }
        const int row0 = u.pm * BM + wr * 64 + fr, col0 = u.pn * BM + wc * 32 + 4 * fq;
#pragma unroll
        for (int ai = 0; ai < 2; ++ai)
#pragma unroll
            for (int m = 0; m < 4; ++m) { const size_t off = (size_t)(row0 + ai * HALF + m * 16) * ldc + col0;
#pragma unroll
                for (int bj = 0; bj < 2; ++bj)
#pragma unroll
                    for (int n = 0; n < 2; ++n) { const f32x4 r = *(const f32x4*)(res + off + bj * HALF + n * 16); *(f32x4*)(out + off + bj * HALF + n * 16) = r + acc[ai][bj][m][n]; } }
    }
};
struct EpiIn {
    static constexpr bool PERM = true, AFTER_DRAIN = false;
    bf16_t *U, *Bb, *Q, *Kb, *V, *SGC, *SGA; const float* ropec; const float* ropes; float* kbar; float qscale;
    __device__ __forceinline__ void operator()(const AccT& acc, const Unit& u, int wr, int wc, int fr, int fq) const {
        { int t_ = threadIdx.x; asm volatile("" : "+v"(t_)); fr = t_ & 15; fq = (t_ >> 4) & 3; }
        const int pn = u.pn; const int row0 = u.pm * BM + wr * 64 + fr;
        if (pn < 4) {
            const int c0 = 128 * pn + 16 * wc + 4 * fq;
#pragma unroll
            for (int ai = 0; ai < 2; ++ai)
#pragma unroll
                for (int m = 0; m < 4; ++m) { int ro = row0 + ai * HALF + m * 16; asm volatile("" : "+v"(ro)); bf16_t* rowp = U + (size_t)ro * 512 + c0;
#pragma unroll
                    for (int bj = 0; bj < 2; ++bj) { const f32x4 x = acc[ai][bj][m][0] * acc[ai][bj][m][1]; u32x2 w; w.x = cvt_pk_bf16(x[0], x[1]); w.y = cvt_pk_bf16(x[2], x[3]); *(u32x2*)(rowp + bj * 64) = w; } }
        } else if (pn < 6 || (pn >= 10 && pn < 12)) {
            bf16_t* O = pn < 6 ? Bb : V; const int col0 = (pn < 6 ? pn - 4 : pn - 10) * BM + wc * 32 + 8 * fq;
#pragma unroll
            for (int ai = 0; ai < 2; ++ai)
#pragma unroll
                for (int m = 0; m < 4; ++m) { int ro = row0 + ai * HALF + m * 16; asm volatile("" : "+v"(ro)); bf16_t* rowp = O + (size_t)ro * 512 + col0;
#pragma unroll
                    for (int bj = 0; bj < 2; ++bj) { const f32x4 v0 = acc[ai][bj][m][0], v1 = acc[ai][bj][m][1];
                        u32x4 w; w.x = cvt_pk_bf16(v0[0], v0[1]); w.y = cvt_pk_bf16(v0[2], v0[3]); w.z = cvt_pk_bf16(v1[0], v1[1]); w.w = cvt_pk_bf16(v1[2], v1[3]);
                        *(u32x4*)(rowp + bj * HALF) = w; } }
        } else if (pn < 10) {
            const bool isk = pn >= 8; bf16_t* O = isk ? Kb : Q; const int colt = (isk ? pn - 8 : pn - 6) * BM + wc * 32 + 8 * fq;
            const int g4 = 4 * (4 * (wc & 1) + fq);
            const float sc = isk ? 1.f : qscale;
            f32x4 cs0[2] = {(f32x4){0.f, 0.f, 0.f, 0.f}, (f32x4){0.f, 0.f, 0.f, 0.f}}, cs1[2] = {(f32x4){0.f, 0.f, 0.f, 0.f}, (f32x4){0.f, 0.f, 0.f, 0.f}};
#pragma unroll
            for (int ai = 0; ai < 2; ++ai)
#pragma unroll
                for (int m = 0; m < 4; ++m) { int row = row0 + ai * HALF + m * 16; asm volatile("" : "+v"(row)); const int pos = row & 2047;
                    const f32x4 c = *(const f32x4*)(ropec + pos * 32 + g4) * sc, s = *(const f32x4*)(ropes + pos * 32 + g4) * sc;
                    bf16_t* rowp = O + (size_t)row * 512 + colt;
#pragma unroll
                    for (int bj = 0; bj < 2; ++bj) { const f32x4 x1 = acc[ai][bj][m][0], x2 = acc[ai][bj][m][1]; const f32x4 o1 = x1 * c - x2 * s, o2 = x2 * c + x1 * s;
                        cs0[bj] += o1; cs1[bj] += o2;
                        u32x4 w; w.x = cvt_pk_bf16(o1[0], o1[1]); w.y = cvt_pk_bf16(o1[2], o1[3]); w.z = cvt_pk_bf16(o2[0], o2[1]); w.w = cvt_pk_bf16(o2[2], o2[3]);
                        *(u32x4*)(rowp + bj * HALF) = w; }
                    asm volatile("" : "+v"(cs0[0]), "+v"(cs0[1]), "+v"(cs1[0]), "+v"(cs1[1]) :: "memory"); }
            if (isk) {
#pragma unroll
                for (int bj = 0; bj < 2; ++bj)
#pragma unroll
                    for (int j = 0; j < 4; ++j) { float a = cs0[bj][j], b = cs1[bj][j];
                        a += shx<1>(a); b += shx<1>(b); a += shx<2>(a); b += shx<2>(b); a += shx<4>(a); b += shx<4>(b); a += shx<8>(a); b += shx<8>(b);
                        if (fr == 0) { const int pc = (pn - 8) * BM + bj * HALF + wc * 32 + 8 * fq;
                            float* kb = kbar + (size_t)u.pm * 512 + pc; atomicAdd(kb + j, a); atomicAdd(kb + 4 + j, b); } }
            }
        } else {
            bf16_t* O = pn < 16 ? SGC : SGA; const int col0 = (pn < 16 ? pn - 12 : pn - 16) * BM + wc * 32 + 8 * fq;
#pragma unroll
            for (int ai = 0; ai < 2; ++ai)
#pragma unroll
                for (int m = 0; m < 4; ++m) { int ro = row0 + ai * HALF + m * 16; asm volatile("" : "+v"(ro)); bf16_t* rowp = O + (size_t)ro * 1024 + col0;
#pragma unroll
                    for (int bj = 0; bj < 2; ++bj) { f32x4 v0 = acc[ai][bj][m][0], v1 = acc[ai][bj][m][1];
#pragma unroll
                        for (int j = 0; j < 4; ++j) { v0[j] = __builtin_amdgcn_rcpf(1.f + __expf(-v0[j])); v1[j] = __builtin_amdgcn_rcpf(1.f + __expf(-v1[j])); }
                        u32x4 w; w.x = cvt_pk_bf16(v0[0], v0[1]); w.y = cvt_pk_bf16(v0[2], v0[3]); w.z = cvt_pk_bf16(v1[0], v1[1]); w.w = cvt_pk_bf16(v1[2], v1[3]);
                        *(u32x4*)(rowp + bj * HALF) = w; }
                    asm volatile("" ::: "memory"); }
        }
    }
};
struct EpiSoftmax {
    static constexpr bool PERM = true, AFTER_DRAIN = true;
    bf16_t* O; int ldc; float scale_log2;
    __device__ __forceinline__ void fused(AccT& acc, const Unit& u, int wr, int wc, int fr, int fq, PG8_LAS unsigned char* lds, int wid, int lane) const {
        { int t_ = threadIdx.x; asm volatile("" : "+v"(t_)); fr = t_ & 15; fq = (t_ >> 4) & 3; }
        PG8_LAS f32x2* X = (PG8_LAS f32x2*)lds;
        float mx[2][4];
#pragma unroll
        for (int ai = 0; ai < 2; ++ai)
#pragma unroll
            for (int m = 0; m < 4; ++m) { float a = -3.0e38f;
#pragma unroll
                for (int bj = 0; bj < 2; ++bj)
#pragma unroll
                    for (int n = 0; n < 2; ++n) { acc[ai][bj][m][n] = acc[ai][bj][m][n] * scale_log2; const f32x4 x = acc[ai][bj][m][n]; a = fmaxf(fmaxf(a, fmaxf(x[0], x[1])), fmaxf(x[2], x[3])); }
                a = fmaxf(a, shx<16>(a)); a = max32(a); mx[ai][m] = a;
                float s = 0.f;
#pragma unroll
                for (int bj = 0; bj < 2; ++bj)
#pragma unroll
                    for (int n = 0; n < 2; ++n) { f32x4 x = acc[ai][bj][m][n];
#pragma unroll
                        for (int j = 0; j < 4; ++j) { x[j] = __builtin_amdgcn_exp2f(x[j] - a); s += x[j]; }
                        acc[ai][bj][m][n] = x; }
                s += shx<16>(s); s = sum32(s);
                if (fq == 0) X[(ai * HALF + wr * 64 + m * 16 + fr) * 4 + wc] = (f32x2){a, s};
            }
        asm volatile("s_waitcnt lgkmcnt(0)" ::: "memory"); __builtin_amdgcn_s_barrier(); asm volatile("" ::: "memory");
        const int row0 = u.pm * BM + wr * 64 + fr, col0 = u.pn * BM + wc * 32 + 8 * fq;
#pragma unroll
        for (int ai = 0; ai < 2; ++ai)
#pragma unroll
            for (int m = 0; m < 4; ++m) { const int r = ai * HALF + wr * 64 + m * 16 + fr;
                const f32x2 e0 = X[r * 4 + 0], e1 = X[r * 4 + 1], e2 = X[r * 4 + 2], e3 = X[r * 4 + 3];
                const float M = fmaxf(fmaxf(e0.x, e1.x), fmaxf(e2.x, e3.x));
                const float L = e0.y * __builtin_amdgcn_exp2f(e0.x - M) + e1.y * __builtin_amdgcn_exp2f(e1.x - M) + e2.y * __builtin_amdgcn_exp2f(e2.x - M) + e3.y * __builtin_amdgcn_exp2f(e3.x - M);
                const float f = __builtin_amdgcn_exp2f(mx[ai][m] - M) * __builtin_amdgcn_rcpf(L);
                bf16_t* rowp = O + (size_t)(row0 + ai * HALF + m * 16) * ldc + col0;
#pragma unroll
                for (int bj = 0; bj < 2; ++bj) { const f32x4 v0 = acc[ai][bj][m][0] * f, v1 = acc[ai][bj][m][1] * f;
                    u32x4 w; w.x = cvt_pk_bf16(v0[0], v0[1]); w.y = cvt_pk_bf16(v0[2], v0[3]); w.z = cvt_pk_bf16(v1[0], v1[1]); w.w = cvt_pk_bf16(v1[2], v1[3]);
                    *(u32x4*)(rowp + bj * HALF) = w; } }
        asm volatile("s_waitcnt lgkmcnt(0)" ::: "memory"); __builtin_amdgcn_s_barrier(); asm volatile("" ::: "memory");
    }
};
}
namespace attn_body {
using bf16=__hip_bfloat16;
using bf16x8=__attribute__((ext_vector_type(8)))short;
using s16x4=__attribute__((ext_vector_type(4)))short;
using f32x16=__attribute__((ext_vector_type(16)))float;
using u32x4=__attribute__((ext_vector_type(4)))unsigned;
constexpr int BATCH=16,NHEAD=8,SEQ=2048,D=64,DM=NHEAD*D;
constexpr int NW=8,QBLK=32,QB=QBLK*NW,KVBLK=64,NQB=SEQ/QB;
constexpr int ATTN_PITCH=DM, ATTN_UNIT_ROWS=QB;
__device__ __forceinline__ int crow(int r,int hi){return (r&3)+8*(r>>2)+4*hi;}
#define SBAR() __builtin_amdgcn_sched_barrier(0)
__device__ __forceinline__ void cmask(f32x16&p0,f32x16&p1,int jb,int qrel,int hi){
  const float NEG=-INFINITY; int kb=64*jb+4*hi;
  #pragma unroll
  for(int r=0;r<16;++r){int kv=kb+(r&3)+8*(r>>2); if(kv>qrel)p0[r]=NEG; if(kv+32>qrel)p1[r]=NEG;}
}

constexpr int NSLOT=3, SLOTB=8192;
constexpr int LDS_K=0, LDS_V=NSLOT*SLOTB, LDS_WS=2*NSLOT*SLOTB, LDS_OST=LDS_WS+NW*64*4, LDS_SEL=LDS_OST+NW*4096, LDS_BYTES=LDS_SEL+NW*64*4;
constexpr float C2=0.125f*1.4426950408889634f;
__device__ __forceinline__ void glds16(const void*gsrc,unsigned lds_dst){unsigned keep;
  asm volatile("s_mov_b32 %0, m0\n\ts_mov_b32 m0, %2\n\ts_nop 0\n\tglobal_load_lds_dwordx4 %1, off\n\ts_mov_b32 m0, %0":"=&s"(keep):"v"(gsrc),"s"(lds_dst):"memory");}
__device__ __forceinline__ float max3f(float a,float b,float c){float r;asm("v_max3_f32 %0, %1, %2, %3":"=v"(r):"v"(a),"v"(b),"v"(c));return r;}
__device__ __forceinline__ float max2f(float a,float b){float r;asm("v_max_f32_e32 %0, %1, %2":"=v"(r):"v"(a),"v"(b));return r;}
__device__ __forceinline__ float fadd_s(float a,float b){float r;asm("v_add_f32_e32 %0, %1, %2":"=v"(r):"v"(a),"v"(b));return r;}
__device__ __forceinline__ float fsub_s(float a,float b){float r;asm("v_sub_f32_e32 %0, %1, %2":"=v"(r):"v"(a),"v"(b));return r;}
typedef float f32x2_t __attribute__((ext_vector_type(2))); typedef __bf16 bf16x2_t __attribute__((ext_vector_type(2)));
__device__ __forceinline__ unsigned cvtpk_s(float lo,float hi){f32x2_t v={lo,hi};bf16x2_t b=__builtin_convertvector(v,bf16x2_t);return __builtin_bit_cast(unsigned,b);}
#define WAIT_BAR(N) asm volatile("s_waitcnt vmcnt(" #N ") lgkmcnt(0)\n\ts_barrier":::"memory")

__device__ __forceinline__ void qkt(f32x16&p0,f32x16&p1,const char*Kslot,const bf16x8*qr,const f32x16&negm,int r32,int hi){
  const char*kb=Kslot+hi*1024+r32*16;
  #pragma unroll
  for(int d0=0;d0<4;++d0){
    const bf16x8 b0=*reinterpret_cast<const bf16x8*>(kb+d0*2048);
    const bf16x8 b1=*reinterpret_cast<const bf16x8*>(kb+d0*2048+512);
    if(d0==0){p0=__builtin_amdgcn_mfma_f32_32x32x16_bf16(b0,qr[0],negm,0,0,0);p1=__builtin_amdgcn_mfma_f32_32x32x16_bf16(b1,qr[0],negm,0,0,0);}
    else{p0=__builtin_amdgcn_mfma_f32_32x32x16_bf16(b0,qr[d0],p0,0,0,0);p1=__builtin_amdgcn_mfma_f32_32x32x16_bf16(b1,qr[d0],p1,0,0,0);}}
}
typedef __attribute__((address_space(3))) const char* lds_cptr;
typedef short v4i16_t __attribute__((ext_vector_type(4)));
__device__ __forceinline__ void kload8(bf16x8*kf,lds_cptr kp){
  kf[0]=*(const __attribute__((address_space(3))) bf16x8*)(kp);      kf[1]=*(const __attribute__((address_space(3))) bf16x8*)(kp+512);
  kf[2]=*(const __attribute__((address_space(3))) bf16x8*)(kp+2048); kf[3]=*(const __attribute__((address_space(3))) bf16x8*)(kp+2560);
  kf[4]=*(const __attribute__((address_space(3))) bf16x8*)(kp+4096); kf[5]=*(const __attribute__((address_space(3))) bf16x8*)(kp+4608);
  kf[6]=*(const __attribute__((address_space(3))) bf16x8*)(kp+6144); kf[7]=*(const __attribute__((address_space(3))) bf16x8*)(kp+6656);
}
__device__ __forceinline__ void kload2(bf16x8*kf,lds_cptr kp,int j){ kf[2*j]=*(const __attribute__((address_space(3))) bf16x8*)(kp+j*2048); kf[2*j+1]=*(const __attribute__((address_space(3))) bf16x8*)(kp+j*2048+512); }
__device__ __forceinline__ s16x4 vtr(lds_cptr p){ return __builtin_bit_cast(s16x4,__builtin_amdgcn_ds_read_tr16_b64_v4i16((__attribute__((address_space(3))) v4i16_t*)p)); }
__device__ __forceinline__ float rowmax(const f32x16&p0,const f32x16&p1){
  float a=max3f(p0[0],p0[1],p1[0]),b=max3f(p0[2],p0[3],p1[1]);a=max3f(a,p1[2],p1[3]);
  #pragma unroll
  for(int r=4;r<16;r+=4){a=max3f(a,p0[r],p0[r+1]);b=max3f(b,p0[r+2],p0[r+3]);a=max3f(a,p1[r],p1[r+1]);b=max3f(b,p1[r+2],p1[r+3]);}
  const float m=max2f(a,b);
  auto rr=__builtin_amdgcn_permlane32_swap(__float_as_uint(m),__float_as_uint(m),false,false);
  return max2f(__uint_as_float(rr[0]),__uint_as_float(rr[1]));
}
__device__ __forceinline__ void pv(f32x16*o,int vb,bf16x8 pa0,bf16x8 pa1,bf16x8 pa2,bf16x8 pa3){
  #pragma unroll
  for(int d0=0;d0<2;++d0){s16x4 lo[4],hi[4];
    #pragma unroll
    for(int ks=0;ks<4;++ks){
      asm volatile("ds_read_b64_tr_b16 %0,%1 offset:%c2":"=&v"(lo[ks]):"v"(vb),"i"(d0*4096+ks*1024):"memory");
      asm volatile("ds_read_b64_tr_b16 %0,%1 offset:%c2":"=&v"(hi[ks]):"v"(vb),"i"(d0*4096+ks*1024+512):"memory");}
    asm volatile("s_waitcnt lgkmcnt(0)":::"memory");SBAR();
    #define PK(k) (bf16x8){lo[k][0],lo[k][1],lo[k][2],lo[k][3],hi[k][0],hi[k][1],hi[k][2],hi[k][3]}
    o[d0]=__builtin_amdgcn_mfma_f32_32x32x16_bf16(pa0,PK(0),o[d0],0,0,0);
    o[d0]=__builtin_amdgcn_mfma_f32_32x32x16_bf16(pa1,PK(1),o[d0],0,0,0);
    o[d0]=__builtin_amdgcn_mfma_f32_32x32x16_bf16(pa2,PK(2),o[d0],0,0,0);
    o[d0]=__builtin_amdgcn_mfma_f32_32x32x16_bf16(pa3,PK(3),o[d0],0,0,0);
    #undef PK
  }
}

#ifndef ATTN_STORE16
#define ATTN_STORE16(p,v) (*(u32x4*)(p)=(v))
#endif
template<int THRL> __device__ __forceinline__ void attn_unit(int b,int h,int qb,const bf16*Q,const bf16*__restrict__ K,const bf16*__restrict__ V,bf16*O,const float*__restrict__ kbar,char*shm){
  int tid=threadIdx.x; asm volatile("":"+v"(tid)); const int lane=tid&63,r32=lane&31,hi=lane>>5; const int wid=__builtin_amdgcn_readfirstlane(tid>>6);
  const long rowbase=(long)b*SEQ; const int q0=qb*QB;
  const bf16*Qw=Q+(rowbase+q0+wid*QBLK)*DM+h*D;
  const bf16*Kh=K+rowbase*DM+h*D,*Vh=V+rowbase*DM+h*D;
  const unsigned lds0=(unsigned)(uintptr_t)shm;
  float*wsf=(float*)(shm+LDS_WS)+wid*64;
  const bf16*ksrc=Kh+(long)lane*DM+wid*8;
  const bf16*vsrc=Vh+(long)(16*(wid&3)+(lane>>2))*DM+(wid>>2)*32+(lane&3)*8;
  const unsigned kdst=lds0+LDS_K+wid*1024, vdst=lds0+LDS_V+wid*1024;
  #define DMA_K(t,slot) glds16(ksrc+(long)(t)*KVBLK*DM,(unsigned)__builtin_amdgcn_readfirstlane(kdst+(slot)))
  #define DMA_V(t,slot) glds16(vsrc+(long)(t)*KVBLK*DM,(unsigned)__builtin_amdgcn_readfirstlane(vdst+(slot)))
  const int vb0=(int)(lds0+LDS_V)+((lane>>4)&1)*32+(lane&3)*8+(4*hi+((lane&15)>>2))*64;
  const char*Kbase=shm+LDS_K; bf16x8 kf[8];
  const lds_cptr shm3=(lds_cptr)shm; const lds_cptr kp0=shm3+LDS_K+hi*1024+r32*16; const lds_cptr vp0=shm3+LDS_V+((lane>>4)&1)*32+(lane&3)*8+(4*hi+((lane&15)>>2))*64;
  const int NT=(q0+QB)/KVBLK;
  DMA_K(0,0);DMA_V(0,0);DMA_K(1,SLOTB);
  bf16x8 qr[4];
  #pragma unroll
  for(int d0=0;d0<4;++d0)qr[d0]=*reinterpret_cast<const bf16x8*>(&Qw[(long)r32*DM+d0*16+hi*8]);
  int selm=0;
  if(qb>0){
    float g[7]; int hi8=8*hi; asm volatile("":"+v"(hi8)); const float*kb=kbar+(size_t)(b*8)*512+h*64+hi8;
    #pragma unroll
    for(int n=0;n<7;++n){ float a=0.f;
      if(n<qb){
        #pragma unroll
        for(int d0=0;d0<4;++d0){ const float4 k0=*(const float4*)(kb+n*512+16*d0),k1=*(const float4*)(kb+n*512+16*d0+4); const bf16x8 qq=qr[d0];
          #define QF(e) __uint_as_float(((unsigned)(unsigned short)qq[e])<<16)
          a+=QF(0)*k0.x+QF(1)*k0.y+QF(2)*k0.z+QF(3)*k0.w+QF(4)*k1.x+QF(5)*k1.y+QF(6)*k1.z+QF(7)*k1.w;
          #undef QF
        } }
      a=::sum32(a); g[n]=(n<qb)?a:-INFINITY; asm volatile("":"+v"(g[n])::"memory"); }
    #pragma unroll
    for(int r=0;r<3;++r){ int best=-1; float bv=-INFINITY;
      #pragma unroll
      for(int n=0;n<7;++n) if(!((selm>>n)&1)&&g[n]>bv){bv=g[n];best=n;}
      if(best>=0)selm|=1<<best; }
  }
  selm|=1<<qb;
  typedef __attribute__((address_space(3))) int* lds_iptr;
  ((lds_iptr)(shm3+LDS_SEL))[tid]=selm;
  #define CURNEG(blk) ({ int t_=threadIdx.x; asm volatile("":"+v"(t_)); const int sm_=((lds_iptr)(shm3+LDS_SEL))[t_]; ((sm_>>(blk))&1)?0.f:-INFINITY; })
  #define NEGUPD(t) do{ if((((t)+1)&3)==0){ const float cn_=CURNEG(((t)+1)>>2); _Pragma("unroll") for(int r=0;r<16;++r)negm[r]=cn_-mhat; asm volatile("":"+v"(negm)); } }while(0)
  float mhat=0.f,l_reg=0.f;f32x16 o[2];o[0]=f32x16{};o[1]=f32x16{};f32x16 negm; { const float cn_=CURNEG(0); _Pragma("unroll") for(int r=0;r<16;++r)negm[r]=cn_; } asm volatile("":"+v"(negm));
  const int qrel=wid*QBLK+r32;
  #define CMASK(P0,P1,t) do{int jb_=(t)-(NT-4); if(jb_>=0)cmask(P0,P1,jb_,qrel,hi);}while(0)
  bool resc=false;
  #define START(P0,P1) do{ const float rm=rowmax(P0,P1); resc=false; \
    { const float dl=__builtin_fmaxf(rm,-24.f); mhat=fadd_s(mhat,dl); \
      _Pragma("unroll") for(int r=0;r<16;++r){P0[r]=fsub_s(P0[r],dl);P1[r]=fsub_s(P1[r],dl);} \
      { const float cn_=CURNEG(0); _Pragma("unroll") for(int r=0;r<16;++r)negm[r]=cn_-mhat; } asm volatile("":"+v"(negm)); } \
    _Pragma("unroll") for(int r=0;r<16;++r)P0[r]=__builtin_amdgcn_exp2f(P0[r]); }while(0)
  #define RESC() do{ if(resc){ asm volatile("s_waitcnt lgkmcnt(0)":::"memory"); \
      _Pragma("unroll") for(int d_=0;d_<2;++d_) _Pragma("unroll") for(int r=0;r<16;++r)o[d_][r]*=wsf[crow(r,hi)]; } }while(0)
  f32x16 pA0,pA1,pB0,pB1;
  int sl_prev=0,sl_cur=0,sl_next=SLOTB;
  #define ROT() do{sl_prev=sl_cur;sl_cur=sl_next;sl_next=(sl_next==(NSLOT-1)*SLOTB)?0:sl_next+SLOTB;}while(0)
  DMA_K(2,2*SLOTB);
  WAIT_BAR(3);
  qkt(pA0,pA1,Kbase,qr,negm,r32,hi);asm volatile("s_nop 15\n\ts_nop 7":"+v"(pA0),"+v"(pA1));CMASK(pA0,pA1,0);
  START(pA0,pA1);
  _Pragma("unroll") for(int r=0;r<16;++r)pA1[r]=__builtin_amdgcn_exp2f(pA1[r]);
  WAIT_BAR(0);
  DMA_K(3,0);DMA_V(1,SLOTB);
  ROT();
  kload8(kf,kp0+sl_cur);
  WAIT_BAR(2);
  s16x4 vlo[8],vhi[8]; u32x4 pw0,pw1,pw2,pw3;
  #define PKW(P,B) cvtpk_s(P[B],P[B+1])
  #define PAF(k) __builtin_bit_cast(bf16x8,pw##k)
  #define VFR(i) (bf16x8){vlo[i][0],vlo[i][1],vlo[i][2],vlo[i][3],vhi[i][0],vhi[i][1],vhi[i][2],vhi[i][3]}
  #define PIN(x) asm volatile("":"+v"(x))
  #define MX3(a,b,c) __builtin_fmaxf(__builtin_fmaxf((a),(b)),(c))
  #define GAPA(MF,A0,A1,A2,A3,W0,W1,PW) do{ MF; sacc+=A0; sacc+=A1; sacc+=A2; sacc+=A3; PIN(sacc); W0; W1; PIN(PW); SBAR(); }while(0)
  #define EX(v) __builtin_amdgcn_exp2f(v)
  #define GAPB(MF,X,B) do{ MF; X[B]=EX(X[B]); X[B+1]=EX(X[B+1]); X[B+2]=EX(X[B+2]); X[B+3]=EX(X[B+3]); PIN(X); SBAR(); }while(0)
  #define VRD(i) do{ vlo[i]=vtr(vp_+(((i)>>2)*4096+((i)&3)*1024)); vhi[i]=vtr(vp_+(((i)>>2)*4096+((i)&3)*1024+512)); }while(0)
  #define KRD(G,j) do{ if(G){ kload2(kf,kp0+sl_next,j); SBAR(); } }while(0)
  #define STEP(C0,C1,P0,P1,t,GK,GV,GL) do{ SBAR(); \
    const lds_cptr vp_=vp0+sl_prev; \
    VRD(0); SBAR(); float sacc=(P0[0]+P0[1]); \
    GAPA(C0=__builtin_amdgcn_mfma_f32_32x32x16_bf16(kf[0],qr[0],negm,0,0,0), P0[2],P0[3],P0[4],P0[5],     pw0[0]=PKW(P0,0), pw0[1]=PKW(P0,2), pw0); \
    VRD(4); SBAR(); GAPA(C1=__builtin_amdgcn_mfma_f32_32x32x16_bf16(kf[1],qr[0],negm,0,0,0), P0[6],P0[7],P0[8],P0[9],     pw0[2]=PKW(P0,4), pw0[3]=PKW(P0,6), pw0); \
    VRD(1); SBAR(); GAPA(C0=__builtin_amdgcn_mfma_f32_32x32x16_bf16(kf[2],qr[1],C0,0,0,0),   P0[10],P0[11],P0[12],P0[13], pw1[0]=PKW(P0,8), pw1[1]=PKW(P0,10), pw1); \
    VRD(5); SBAR(); GAPA(C1=__builtin_amdgcn_mfma_f32_32x32x16_bf16(kf[3],qr[1],C1,0,0,0),   P0[14],P0[15],P1[0],P1[1],   pw1[2]=PKW(P0,12),pw1[3]=PKW(P0,14), pw1); \
    VRD(2); SBAR(); GAPA(C0=__builtin_amdgcn_mfma_f32_32x32x16_bf16(kf[4],qr[2],C0,0,0,0),   P1[2],P1[3],P1[4],P1[5],     pw2[0]=PKW(P1,0), pw2[1]=PKW(P1,2), pw2); \
    VRD(6); SBAR(); GAPA(C1=__builtin_amdgcn_mfma_f32_32x32x16_bf16(kf[5],qr[2],C1,0,0,0),   P1[6],P1[7],P1[8],P1[9],     pw2[2]=PKW(P1,4), pw2[3]=PKW(P1,6), pw2); \
    VRD(3); SBAR(); GAPA(C0=__builtin_amdgcn_mfma_f32_32x32x16_bf16(kf[6],qr[3],C0,0,0,0),   P1[10],P1[11],P1[12],P1[13], pw3[0]=PKW(P1,8), pw3[1]=PKW(P1,10), pw3); \
    VRD(7); SBAR(); GAPA(C1=__builtin_amdgcn_mfma_f32_32x32x16_bf16(kf[7],qr[3],C1,0,0,0),   P1[14],P1[15],0.f,0.f,       pw3[2]=PKW(P1,12),pw3[3]=PKW(P1,14), pw3); \
    l_reg+=sacc; \
    if(GK){DMA_K((t)+3,sl_cur);} if(GV){DMA_V((t)+1,sl_next);} \
    CMASK(C0,C1,t); \
    { float a=MX3(C0[0],C0[1],C1[0]),b=MX3(C0[2],C0[3],C1[1]); a=MX3(a,C1[2],C1[3]); \
      _Pragma("unroll") for(int r=4;r<16;r+=4){a=MX3(a,C0[r],C0[r+1]);b=MX3(b,C0[r+2],C0[r+3]);a=MX3(a,C1[r],C1[r+1]);b=MX3(b,C1[r+2],C1[r+3]);} \
      float rm=__builtin_fmaxf(a,b); { auto rr=__builtin_amdgcn_permlane32_swap(__float_as_uint(rm),__float_as_uint(rm),false,false); rm=__builtin_fmaxf(__uint_as_float(rr[0]),__uint_as_float(rr[1])); } \
      resc=false; \
      if(__builtin_expect(__any(rm>(float)THRL),0)){ const float dl=__builtin_fmaxf(rm,0.f); mhat+=dl; \
        _Pragma("unroll") for(int r=0;r<16;++r){C0[r]-=dl;C1[r]-=dl;} \
        { const float cn_=CURNEG(((t)+1)>>2); _Pragma("unroll") for(int r=0;r<16;++r)negm[r]=cn_-mhat; } asm volatile("":"+v"(negm)); \
        const float f=__builtin_amdgcn_exp2f(-dl); l_reg*=f; if(hi==0)wsf[r32]=f; resc=true; } } \
    SBAR(); \
    GAPB(o[0]=__builtin_amdgcn_mfma_f32_32x32x16_bf16(PAF(0),VFR(0),o[0],0,0,0), C0,0); \
    GAPB(o[1]=__builtin_amdgcn_mfma_f32_32x32x16_bf16(PAF(0),VFR(4),o[1],0,0,0), C0,4); \
    KRD(GL,0); GAPB(o[0]=__builtin_amdgcn_mfma_f32_32x32x16_bf16(PAF(1),VFR(1),o[0],0,0,0), C0,8); \
    KRD(GL,1); GAPB(o[1]=__builtin_amdgcn_mfma_f32_32x32x16_bf16(PAF(1),VFR(5),o[1],0,0,0), C0,12); \
    KRD(GL,2); GAPB(o[0]=__builtin_amdgcn_mfma_f32_32x32x16_bf16(PAF(2),VFR(2),o[0],0,0,0), C1,0); \
    KRD(GL,3); GAPB(o[1]=__builtin_amdgcn_mfma_f32_32x32x16_bf16(PAF(2),VFR(6),o[1],0,0,0), C1,4); \
    GAPB(o[0]=__builtin_amdgcn_mfma_f32_32x32x16_bf16(PAF(3),VFR(3),o[0],0,0,0), C1,8); \
    GAPB(o[1]=__builtin_amdgcn_mfma_f32_32x32x16_bf16(PAF(3),VFR(7),o[1],0,0,0), C1,12); \
    }while(0)
  int t=1;
  #undef CMASK
  #define CMASK(P0,P1,t) do{}while(0)
  for(;t+5<NT;t+=2){
    STEP(pB0,pB1,pA0,pA1,t,true,true,true);     WAIT_BAR(2); RESC(); ROT(); NEGUPD(t);
    STEP(pA0,pA1,pB0,pB1,t+1,true,true,true);   WAIT_BAR(2); RESC(); ROT(); NEGUPD(t+1);
  }
  #undef CMASK
  #define CMASK(P0,P1,t) do{int jb_=(t)-(NT-4); if(jb_>=0)cmask(P0,P1,jb_,qrel,hi);}while(0)
  #define ENDW(tt) do{ if((tt)+3<NT){WAIT_BAR(2);} else if((tt)+2<NT){WAIT_BAR(1);} else {WAIT_BAR(0);} }while(0)
  for(;t+1<NT;t+=2){
    STEP(pB0,pB1,pA0,pA1,t,(t+3<NT),(t+1<NT),(t+1<NT));       ENDW(t);   RESC(); ROT(); NEGUPD(t);
    STEP(pA0,pA1,pB0,pB1,t+1,(t+4<NT),(t+2<NT),(t+2<NT));     ENDW(t+1); RESC(); ROT(); NEGUPD(t+1);
  }
  STEP(pB0,pB1,pA0,pA1,NT-1,false,false,false); RESC();
  { float sacc=pB0[0]+pB0[1]; _Pragma("unroll") for(int r=2;r<16;++r)sacc+=pB0[r]; _Pragma("unroll") for(int r=0;r<16;++r)sacc+=pB1[r]; l_reg+=sacc;
    pw0=(u32x4){PKW(pB0,0),PKW(pB0,2),PKW(pB0,4),PKW(pB0,6)};pw1=(u32x4){PKW(pB0,8),PKW(pB0,10),PKW(pB0,12),PKW(pB0,14)};pw2=(u32x4){PKW(pB1,0),PKW(pB1,2),PKW(pB1,4),PKW(pB1,6)};pw3=(u32x4){PKW(pB1,8),PKW(pB1,10),PKW(pB1,12),PKW(pB1,14)};
    SBAR(); pv(o,vb0+sl_cur,PAF(0),PAF(1),PAF(2),PAF(3)); }
  #undef PKW
  #undef PAF
  #undef VFR
  #undef PIN
  #undef MX3
  #undef GAPA
  #undef GAPB
  #undef EX
  #undef VRD
  #undef KRD
  #undef STEP
  #undef ENDW
  {auto rr=__builtin_amdgcn_permlane32_swap(__float_as_uint(l_reg),__float_as_uint(l_reg),false,false);l_reg=__uint_as_float(rr[0])+__uint_as_float(rr[1]);}
  if(hi==0)wsf[32+r32]=l_reg;asm volatile("s_waitcnt lgkmcnt(0)":::"memory");
  float rli[16];
  #pragma unroll
  for(int r=0;r<16;++r)rli[r]=__builtin_amdgcn_rcpf(wsf[32+crow(r,hi)]);
  bf16*Ow=O+(rowbase+q0+wid*QBLK)*DM+h*D;
  { bf16*stg=(bf16*)(shm+LDS_OST)+wid*2048;
    #pragma unroll
    for(int r=0;r<16;++r){const int orow=crow(r,hi);
      #pragma unroll
      for(int d0=0;d0<2;++d0)stg[orow*64+d0*32+r32]=__float2bfloat16(o[d0][r]*rli[r]);}
    asm volatile("s_waitcnt lgkmcnt(0)":::"memory");
    #pragma unroll
    for(int i=0;i<4;++i){const int row=i*8+(lane>>3),ch=lane&7; const u32x4 v=*(const u32x4*)(stg+row*64+ch*8); ATTN_STORE16(Ow+(long)row*DM+ch*8,v);} }
  asm volatile("s_waitcnt lgkmcnt(0)\n\ts_barrier":::"memory");
  #undef DMA_K
  #undef DMA_V
  #undef CMASK
  #undef START
  #undef CURNEG
  #undef NEGUPD
  #undef RESC
  #undef ROT
}
constexpr int ATTN_LDS_BYTES=LDS_BYTES;
struct AttnTensors { const bf16* Q; const bf16* K; const bf16* V; bf16* O; const float* kbar; };
struct AttnUnit { int bh; int qb; };
struct StaticOrder {
  int vcu,G;
  __device__ __forceinline__ explicit StaticOrder(int grid,int block):vcu((grid%8==0)?(block%8)*(grid/8)+block/8:block),G(grid){}
  __device__ __forceinline__ bool next(int i,AttnUnit&u)const{
    if(G==256){ if(i>=4)return false; const int s=vcu&1; u.bh=vcu>>1; u.qb=s?((i==0)?6:(i==1)?1:(i==2)?5:2):((i==0)?7:(i==1)?0:(i==2)?4:3); return true; }
    const int L=i*G+vcu; if(L>=1024)return false; u.bh=L>>3; u.qb=L&7; return true; }
  __device__ __forceinline__ void a_ready(const AttnUnit&)const{}
  __device__ __forceinline__ void done(const AttnUnit&)const{}
};
template<class Sched,int THRL=8> __device__ __forceinline__ void attn_phase(char*lds,const AttnTensors&T,const Sched&S){
  AttnUnit u;
  for(int i=0;S.next(i,u);++i){ S.a_ready(u); attn_unit<THRL>(u.bh/NHEAD,u.bh%NHEAD,u.qb,T.Q,T.K,T.V,T.O,T.kbar,lds); S.done(u); }
}
#undef SBAR
#undef WAIT_BAR
}
constexpr int NWAVES = 8;
constexpr int T = 32768, D = 1024, SEQ = 2048, MEMROWS = 4096, INW = 5120;
constexpr float RMS_EPS = 1e-6f;
constexpr size_t MiB = 1u << 20;
constexpr size_t WS_CTL = 0, CTL_ZERO_BYTES = 2 * MiB, WS_KBAR = 1 * MiB;
constexpr size_t WS_WIN = 2 * MiB, WS_WC = 12 * MiB, WS_WA = 13 * MiB, WS_WM = 14 * MiB, WS_WXQ = 16 * MiB, WS_WXKV = 18 * MiB, WS_WXO = 22 * MiB, WS_MT = 24 * MiB, WS_ROPE = 28 * MiB;
constexpr size_t WS_MEMN = 32 * MiB, WS_KX = 40 * MiB, WS_VXT = 48 * MiB;
constexpr size_t WS_A = 64 * MiB;
constexpr size_t WS_YC = 128 * MiB, WS_QO = 160 * MiB, WS_U = 192 * MiB, WS_K = 224 * MiB, WS_V = 256 * MiB;
constexpr size_t WS_SGC = 320 * MiB, WS_SGA = 384 * MiB;
constexpr size_t WS_EIDX = 448 * MiB, WS_GW = 464 * MiB, WS_PW = 480 * MiB, WS_END = 496 * MiB;
constexpr size_t WS_U8 = 288 * MiB, WS_V8T = 304 * MiB, WS_SU = 29 * MiB, WS_SV = 29 * MiB + 512 * 1024;
constexpr size_t WS_QX = 128 * MiB, WS_PM = 192 * MiB, WS_OX = 128 * MiB;
constexpr size_t WS_SC = 128 * MiB;
constexpr int CW_TMO = 0, CW_BAR = 4096;
constexpr int RING_OFF = 0, RING_BYTES = 131072;
constexpr int LDSCTL_OFF = RING_BYTES, MISC_OFF = LDSCTL_OFF + 320;
constexpr int LDS_BYTES = 147456;

#define GAS __attribute__((address_space(1)))
#define LAS __attribute__((address_space(3)))
typedef unsigned short bf16;
typedef unsigned v4u __attribute__((ext_vector_type(4)));
typedef unsigned v2u __attribute__((ext_vector_type(2)));
typedef float f32x4 __attribute__((ext_vector_type(4)));
typedef float f32x2v __attribute__((ext_vector_type(2)));
typedef GAS unsigned gu32;
#define RLX_AGENT __ATOMIC_RELAXED, __HIP_MEMORY_SCOPE_AGENT
#define LDS_WAIT() asm volatile("s_waitcnt lgkmcnt(0)" ::: "memory")
#define VM_WAIT() asm volatile("s_waitcnt vmcnt(0)" ::: "memory")
__device__ __forceinline__ unsigned pk2(float lo, float hi) { return pg8::cvt_pk_bf16(lo, hi); }
__device__ __forceinline__ float bflo(unsigned u) { return __uint_as_float(u << 16); }
__device__ __forceinline__ float bfhi(unsigned u) { return __uint_as_float(u & 0xffff0000u); }

#define XB_TMO      128
#define XB_XCNT(j)  (256  + 64 * (j))
#define XB_XSUB(j)  (1280 + 64 * (j))
#define XB_XGEN(j)  (2304 + 64 * (j))
#define XB_TOP      3328
#define XB_TOPGEN   3392
#define XCD_BAR_WORDS 3456
#define XB_SPIN_CAP (1u << 18)
__device__ __forceinline__ unsigned xb_ld(unsigned* p)              { return __hip_atomic_load(p, __ATOMIC_RELAXED, __HIP_MEMORY_SCOPE_AGENT); }
__device__ __forceinline__ unsigned xb_add(unsigned* p, unsigned v) { return __hip_atomic_fetch_add(p, v, __ATOMIC_RELAXED, __HIP_MEMORY_SCOPE_AGENT); }
__device__ __forceinline__ unsigned xb_xcc_id() { return (unsigned)__builtin_amdgcn_s_getreg((3 << 11) | 20) & 0xFu; }
#define XB_SPIN(cond, bar) do { unsigned _sp = 0; while (cond) { __builtin_amdgcn_s_sleep(1); \
    if ((++_sp & 255u) == 0u) { if (xb_ld(&(bar)[XB_TMO])) break; if (_sp > XB_SPIN_CAP) { atomicAdd(&(bar)[XB_TMO], 1u); break; } } } } while (0)
struct XcdBarrier { unsigned* bar; unsigned x; volatile LAS unsigned* st; };
__device__ __forceinline__ XcdBarrier xcd_barrier_post(unsigned* bar, volatile LAS unsigned* st) {
    XcdBarrier b; b.bar = bar; b.x = xb_xcc_id(); b.st = st;
    if (threadIdx.x == 0) (void)xb_add(&bar[XB_XCNT(b.x)], 1u);
    return b;
}
__device__ __forceinline__ void xcd_barrier_complete(unsigned* bar, unsigned x, unsigned& nloc, unsigned& nx) {
    const unsigned G = gridDim.x * gridDim.y * gridDim.z;
    unsigned sum, cnt, mine, sp = 0u;
    for (;;) {
        sum = 0u; cnt = 0u; mine = 0u;
#pragma unroll
        for (unsigned j = 0; j < 16; ++j) { const unsigned c = xb_ld(&bar[XB_XCNT(j)]); sum += c; cnt += (c > 0u) ? 1u : 0u; mine = (j == x) ? c : mine; }
        if (sum == G) break;
        __builtin_amdgcn_s_sleep(1);
        if ((++sp & 255u) == 0u) { if (xb_ld(&bar[XB_TMO])) break; if (sp > XB_SPIN_CAP) { atomicAdd(&bar[XB_TMO], 1u); break; } }
    }
    nloc = mine > 0u ? mine : 1u; nx = cnt > 0u ? cnt : 1u;
}
__device__ __forceinline__ void xcd_barrier(const XcdBarrier& b) {
    asm volatile("s_waitcnt vmcnt(0)" ::: "memory");
    __syncthreads();
    if (threadIdx.x == 0) {
        unsigned* bar = b.bar;
        __builtin_amdgcn_s_waitcnt(0);
        unsigned nloc = b.st[0], nx = b.st[1];
        if (nloc == 0u) { xcd_barrier_complete(bar, b.x, nloc, nx); b.st[0] = nloc; b.st[1] = nx; }
        const unsigned old = xb_add(&bar[XB_XSUB(b.x)], 1u);
        const unsigned gen = old / nloc;
        if (old + 1u == (gen + 1u) * nloc) {
            __builtin_amdgcn_fence(__ATOMIC_RELEASE, "agent");
            asm volatile("s_waitcnt vmcnt(0)" ::: "memory");
            const unsigned og = xb_add(&bar[XB_TOP], 1u);
            const unsigned tg = og / nx;
            if (og + 1u == (tg + 1u) * nx) xb_add(&bar[XB_TOPGEN], 1u);
            else XB_SPIN(xb_ld(&bar[XB_TOPGEN]) == tg, bar);
            __builtin_amdgcn_fence(__ATOMIC_ACQUIRE, "agent");
            xb_add(&bar[XB_XGEN(b.x)], 1u);
            asm volatile("s_waitcnt vmcnt(0)" ::: "memory");
        } else {
            XB_SPIN(xb_ld(&bar[XB_XGEN(b.x)]) == gen, bar);
            __builtin_amdgcn_fence(__ATOMIC_ACQUIRE, "agent");
            asm volatile("s_waitcnt vmcnt(0)" ::: "memory");
        }
    }
    __syncthreads();
}

struct MapId { static __device__ __forceinline__ int src(int j) { return j; } };
struct MapWin {
    static __device__ __forceinline__ int src(int j) {
        if (j < 1024) { const int g8 = j >> 3, i = j & 7; return ((i < 4) ? 0 : 1024) + 4 * g8 + (i & 3); }
        if (j < 1536) return 512 + (j - 1024);
        if (j < 2560) { const int jj = j - 1536, qk = jj >> 9, p = jj & 511, head = p >> 6, pl = p & 63, g = pl >> 3, i = pl & 7; return 1536 + qk * 512 + head * 64 + 4 * g + (i & 3) + 32 * (i >> 2); }
        return j;
    }
};
template <class MAP>
__device__ __forceinline__ void p0_transpose_item(const float* W, int K, int N, int NOUT, bf16* WT, LAS float* scr, int item, int lane) {
    const int nblk = NOUT / 32, kb = item / nblk, nb = item % nblk, k0 = 64 * kb, n0 = 32 * nb;
    const int sc = MAP::src(n0 + (lane & 31));
#pragma unroll 8
    for (int i = 0; i < 32; ++i) { const int kk = 2 * i + (lane >> 5); scr[kk * 33 + (lane & 31)] = W[(size_t)(k0 + kk) * N + sc]; }
    LDS_WAIT(); asm volatile("" ::: "memory");
    const int c = lane & 7;
#pragma unroll
    for (int j = 0; j < 4; ++j) { const int n = (lane >> 3) + 8 * j; const LAS float* s = scr + (8 * c) * 33 + n;
        v4u o; o.x = pk2(s[0 * 33], s[1 * 33]); o.y = pk2(s[2 * 33], s[3 * 33]); o.z = pk2(s[4 * 33], s[5 * 33]); o.w = pk2(s[6 * 33], s[7 * 33]);
        *(GAS v4u*)(WT + (size_t)(n0 + n) * K + k0 + 8 * c) = o; }
    LDS_WAIT(); asm volatile("" ::: "memory");
}
__device__ __forceinline__ void rms_row_to_bf16(const float* xrow, const float* g, bf16* orow, int lane) {
    const GAS f32x4* xr = (const GAS f32x4*)xrow + lane; const GAS f32x4* gr = (const GAS f32x4*)g + lane;
    f32x4 v[4]; float s = 0.f;
#pragma unroll
    for (int j = 0; j < 4; ++j) { v[j] = xr[64 * j]; s += (v[j].x * v[j].x + v[j].y * v[j].y) + (v[j].z * v[j].z + v[j].w * v[j].w); }
    const float r = rsqrtf(wave_sum(s) * (1.f / 1024.f) + RMS_EPS);
    GAS v2u* o8 = (GAS v2u*)orow + lane;
#pragma unroll
    for (int j = 0; j < 4; ++j) { const f32x4 gg = gr[64 * j]; v2u w; w.x = pk2(v[j].x * r * gg.x, v[j].y * r * gg.y); w.y = pk2(v[j].z * r * gg.z, v[j].w * r * gg.w); o8[64 * j] = w; }
}
__device__ __forceinline__ float fmax_asm(float a, float b) { float r; asm("v_max_f32 %0, %1, %2" : "=v"(r) : "v"(a), "v"(b)); return r; }
__device__ __forceinline__ float fmin_asm(float a, float b) { float r; asm("v_min_f32 %0, %1, %2" : "=v"(r) : "v"(a), "v"(b)); return r; }

#ifndef PH_MASK
#define PH_MASK 0xFFFFFFFFu
#endif
#define PH(k) ((PH_MASK >> (k)) & 1u)
struct Args { const float* in[19]; float* out; unsigned char* ws; };

struct XOrder {
    const char* A; const char* Bt; int G, c, i0; bool pv;
    __device__ bool next(int i, pg8::Unit& u) const {
        if (i > 0 && i0 >= 0) return false;
        const int L = (i0 >= 0 ? i0 : i) * G + c; if (L >= 512) return false;
        const int b = L >> 5, head = (L >> 3) & 3, rt = L & 7;
        u.pm = b * 8 + rt; u.pn = head;
        u.a = A + ((size_t)(b * 2048 + rt * 256) * 1024 + head * 256) * 2;
        u.b = pv ? Bt + ((size_t)(head * 256) * 4096 + b * 256) * 2 : Bt + ((size_t)(b * 256) * 1024 + head * 256) * 2;
        return true;
    }
};

__global__ void __launch_bounds__(NWAVES * 64, 2) mk_fwd(Args args) {
    extern __shared__ __attribute__((aligned(16))) unsigned char lds[];
    LAS unsigned char* L = (LAS unsigned char*)lds;
    volatile LAS unsigned* MISC = (volatile LAS unsigned*)(L + MISC_OFF);
    const int wave = __builtin_amdgcn_readfirstlane((int)threadIdx.x >> 6);
#define PH_LANES int tid = threadIdx.x; asm volatile("" : "+v"(tid)); const int lane = tid & 63; const int gt = vcu * (NWAVES * 64) + tid; (void)lane; (void)gt
    const int G = gridDim.x; const int bx = blockIdx.x; const int vcu = (G % 8 == 0) ? (bx % 8) * (G / 8) + bx / 8 : bx;
    unsigned char* ws = args.ws;
    gu32* ctl = (gu32*)(ws + WS_CTL);
    for (int u = threadIdx.x; u < (LDS_BYTES - LDSCTL_OFF) / 4; u += NWAVES * 64) ((LAS unsigned*)(L + LDSCTL_OFF))[u] = 0u;
    __syncthreads();
    XcdBarrier bar = xcd_barrier_post((unsigned*)(ctl + CW_BAR), MISC + 8);

    const float *x = args.in[0], *mem = args.in[1], *g_mix = args.in[2], *w_in = args.in[3], *w_conv = args.in[4], *w_conv_out = args.in[5], *w_attn_out = args.in[6], *w_merge = args.in[7],
                *g_xattn = args.in[8], *g_mem = args.in[9], *w_xq = args.in[10], *w_xkv = args.in[11], *w_xo = args.in[12], *g_ffn = args.in[13], *w_pq = args.in[14], *sub_keys = args.in[15],
                *peer_u = args.in[16], *peer_v = args.in[17], *g_final = args.in[18];
    float* out = args.out;
    bf16 *WinT = (bf16*)(ws + WS_WIN), *WcT = (bf16*)(ws + WS_WC), *WaT = (bf16*)(ws + WS_WA), *WmT = (bf16*)(ws + WS_WM), *WxqT = (bf16*)(ws + WS_WXQ), *WxkvT = (bf16*)(ws + WS_WXKV),
         *WxoT = (bf16*)(ws + WS_WXO), *MT = (bf16*)(ws + WS_MT);
    float* ropec = (float*)(ws + WS_ROPE); float* ropes = ropec + 2048 * 32;
    float* kbar = (float*)(ws + WS_KBAR);
    bf16 *MEMN = (bf16*)(ws + WS_MEMN), *KX = (bf16*)(ws + WS_KX), *VXT = (bf16*)(ws + WS_VXT), *A = (bf16*)(ws + WS_A);
    bf16 *YC = (bf16*)(ws + WS_YC), *QO = (bf16*)(ws + WS_QO), *U = (bf16*)(ws + WS_U), *KB = (bf16*)(ws + WS_K), *VB = (bf16*)(ws + WS_V), *SGC = (bf16*)(ws + WS_SGC), *SGA = (bf16*)(ws + WS_SGA);
    bf16 *QX = (bf16*)(ws + WS_QX), *PM = (bf16*)(ws + WS_PM), *OX = (bf16*)(ws + WS_OX);
    _Float16* SC = (_Float16*)(ws + WS_SC);
    int* EIDX = (int*)(ws + WS_EIDX); float* GW = (float*)(ws + WS_GW); unsigned* PW = (unsigned*)(ws + WS_PW);
    unsigned char* U8 = ws + WS_U8; unsigned char* V8T = ws + WS_V8T; float* SU = (float*)(ws + WS_SU); float* SV = (float*)(ws + WS_SV);
    const int gw = vcu * NWAVES + wave, NGW = G * NWAVES;
    const int NGT = G * NWAVES * 64;

    asm volatile("; ===== PHASE 0 =====");
    if (PH(0)) {
        PH_LANES;
        LAS float* scr = (LAS float*)(L + RING_OFF + wave * 16384);
        constexpr int I_IN = (1024 / 64) * (5120 / 32), I_C = (512 / 64) * (1024 / 32), I_M = (1024 / 64) * (1024 / 32), I_KV = (1024 / 64) * (2048 / 32);
        constexpr int NITEMS = I_IN + 2 * I_C + 3 * I_M + I_KV;
        for (int it = gw; it < NITEMS; it += NGW) {
            int r = it;
            if (r < I_IN) { p0_transpose_item<MapWin>(w_in, 1024, 5120, 5120, WinT, scr, r, lane); continue; } r -= I_IN;
            if (r < I_C) { p0_transpose_item<MapId>(w_conv_out, 512, 1024, 1024, WcT, scr, r, lane); continue; } r -= I_C;
            if (r < I_C) { p0_transpose_item<MapId>(w_attn_out, 512, 1024, 1024, WaT, scr, r, lane); continue; } r -= I_C;
            if (r < I_M) { p0_transpose_item<MapId>(w_merge, 1024, 1024, 1024, WmT, scr, r, lane); continue; } r -= I_M;
            if (r < I_M) { p0_transpose_item<MapId>(w_xq, 1024, 1024, 1024, WxqT, scr, r, lane); continue; } r -= I_M;
            if (r < I_M) { p0_transpose_item<MapId>(w_xo, 1024, 1024, 1024, WxoT, scr, r, lane); continue; } r -= I_M;
            p0_transpose_item<MapId>(w_xkv, 1024, 2048, 2048, WxkvT, scr, r, lane);
        }
        for (int m = gw; m < T; m += NGW) rms_row_to_bf16(x + (size_t)m * D, g_mix, A + (size_t)m * D, lane);
        for (int m = gw; m < MEMROWS; m += NGW) rms_row_to_bf16(mem + (size_t)m * D, g_mem, MEMN + (size_t)m * D, lane);
        for (int i = gt; i < 2048 * 32; i += NGT) { const int pos = i >> 5, f = i & 31; const float inv = powf(10000.0f, -(float)f / 32.0f); const float ang = (float)pos * inv; ropec[i] = cosf(ang); ropes[i] = sinf(ang); }
        for (int e = gw; e < 16384; e += NGW) {
            const GAS f32x4* r = (const GAS f32x4*)(peer_u + (size_t)e * D) + lane; f32x4 v[4]; float am = 0.f;
#pragma unroll
            for (int j = 0; j < 4; ++j) { v[j] = r[64 * j]; am = fmaxf(fmaxf(am, fmaxf(fabsf(v[j].x), fabsf(v[j].y))), fmaxf(fabsf(v[j].z), fabsf(v[j].w))); }
            am = wave_max(am);
            const float sc = am > 0.f ? 384.f / am : 1.f; if (lane == 0) SU[e] = am > 0.f ? am * (1.f / 384.f) : 1.f;
#pragma unroll
            for (int j = 0; j < 4; ++j) { int w = __builtin_amdgcn_cvt_pk_fp8_f32(v[j].x * sc, v[j].y * sc, 0, false); w = __builtin_amdgcn_cvt_pk_fp8_f32(v[j].z * sc, v[j].w * sc, w, true);
                *(GAS unsigned*)(U8 + (size_t)e * 1024 + 4 * lane + 256 * j) = (unsigned)w; }
        }
        __syncthreads();
        for (int it = bx; it < 256; it += G) {
            const int e0 = it * 64;
#pragma unroll 1
            for (int rr = 0; rr < 8; ++rr) {
                const int el = wave * 8 + rr, e = e0 + el;
                const GAS f32x4* r = (const GAS f32x4*)(peer_v + (size_t)e * D) + lane; f32x4 v[4]; float am = 0.f;
#pragma unroll
                for (int j = 0; j < 4; ++j) { v[j] = r[64 * j]; am = fmaxf(fmaxf(am, fmaxf(fabsf(v[j].x), fabsf(v[j].y))), fmaxf(fabsf(v[j].z), fabsf(v[j].w))); }
                am = wave_max(am);
                const float sc = am > 0.f ? 384.f / am : 1.f; if (lane == 0) SV[e] = am > 0.f ? am * (1.f / 384.f) : 1.f;
#pragma unroll
                for (int j = 0; j < 4; ++j) { int w = __builtin_amdgcn_cvt_pk_fp8_f32(v[j].x * sc, v[j].y * sc, 0, false); w = __builtin_amdgcn_cvt_pk_fp8_f32(v[j].z * sc, v[j].w * sc, w, true);
                    *(LAS unsigned*)(L + RING_OFF + el * 1024 + 4 * lane + 256 * j) = (unsigned)w; }
            }
            __syncthreads();
#pragma unroll
            for (int i = 0; i < 8; ++i) { const int idx = tid + 512 * i, sl = idx >> 5, k = idx & 31;
                const v2u a0 = *(const LAS v2u*)(L + RING_OFF + (2 * k) * 1024 + sl * 8), a1 = *(const LAS v2u*)(L + RING_OFF + (2 * k + 1) * 1024 + sl * 8);
                *(GAS v4u*)(V8T + ((size_t)sl * 16384 + e0 + 2 * k) * 8) = (v4u){a0.x, a0.y, a1.x, a1.y}; }
            __syncthreads();
        }
        {
            LAS float* skl = (LAS float*)(L + RING_OFF);
            LAS float* wtl = skl + 128 * 129;
            for (int it = bx; it < 256; it += G) {
                const int hp = it >> 4, cb = it & 15;
                for (int i = tid; i < 128 * 128; i += NWAVES * 64) { const int n = i >> 7, d = i & 127; skl[n * 129 + d] = sub_keys[((size_t)hp * 128 + n) * 128 + d]; }
                for (int i = tid; i < 64 * 128; i += NWAVES * 64) { const int c = i >> 7, d = i & 127; wtl[c * 129 + d] = w_pq[(size_t)(cb * 64 + c) * 2048 + hp * 128 + d]; }
                __syncthreads();
                const int cg = tid & 15, ng = tid >> 4;
                float acc[4][4];
#pragma unroll
                for (int i = 0; i < 4; ++i)
#pragma unroll
                    for (int j = 0; j < 4; ++j) acc[i][j] = 0.f;
                for (int d = 0; d < 128; ++d) {
                    float wv[4], sv[4];
#pragma unroll
                    for (int i = 0; i < 4; ++i) { wv[i] = wtl[(4 * cg + i) * 129 + d]; sv[i] = skl[(4 * ng + i) * 129 + d]; }
#pragma unroll
                    for (int i = 0; i < 4; ++i)
#pragma unroll
                        for (int j = 0; j < 4; ++j) acc[i][j] += sv[i] * wv[j];
                }
#pragma unroll
                for (int i = 0; i < 4; ++i) { v2u w; w.x = pk2(acc[i][0], acc[i][1]); w.y = pk2(acc[i][2], acc[i][3]); *(GAS v2u*)(MT + (size_t)(hp * 128 + 4 * ng + i) * 1024 + cb * 64 + 4 * cg) = w; }
                __syncthreads();
            }
        }
    }
    xcd_barrier(bar);

    asm volatile("; ===== PHASE 1 =====");
    if (PH(1)) {
        PH_LANES;
        pg8::Gemm g{1024, 1024, 1024}; pg8::StaticOrder S; S.init(A, 1024, WinT, 1024, T, INW, G, bx);
        pg8::EpiIn E{U, YC, QO, KB, VB, SGC, SGA, ropec, ropes, kbar, 0.125f * 1.4426950408889634f};
        pg8::gemm_phase<pg8::EpiIn, pg8::StaticOrder, true>(L + RING_OFF, g, S, E);
    }
    if (PH(1)) {
        PH_LANES;
        pg8::Gemm g{1024, 1024, 1024}; pg8::StaticOrder S; S.init(MEMN, 1024, WxkvT, 1024, MEMROWS, 1024, G, bx);
        pg8::EpiBf16 E{KX, 1024};
        pg8::gemm_phase<pg8::EpiBf16, pg8::StaticOrder, true>(L + RING_OFF, g, S, E);
    }
    if (PH(1)) {
        PH_LANES;
        pg8::Gemm g{1024, 1024, 1024}; pg8::StaticOrder S; S.init(WxkvT + (size_t)1024 * 1024, 1024, MEMN, 1024, 1024, MEMROWS, G, (bx + 128) % G);
        pg8::EpiBf16 E{VXT, 4096};
        pg8::gemm_phase<pg8::EpiBf16, pg8::StaticOrder, true>(L + RING_OFF, g, S, E);
    }
    xcd_barrier(bar);

    asm volatile("; ===== PHASE 2 =====");
    if (PH(2)) {
        PH_LANES;
        for (int i = gt; i < T * 64; i += NGT) {
            const int row = i >> 6, cg = i & 63, s = row & 2047;
            const v4u u0 = *(const GAS v4u*)(U + (size_t)row * 512 + cg * 8);
            v4u u1 = (v4u){0u, 0u, 0u, 0u}, u2 = (v4u){0u, 0u, 0u, 0u};
            if (s >= 1) u1 = *(const GAS v4u*)(U + (size_t)(row - 1) * 512 + cg * 8);
            if (s >= 2) u2 = *(const GAS v4u*)(U + (size_t)(row - 2) * 512 + cg * 8);
            const v4u bq = *(const GAS v4u*)(YC + (size_t)row * 512 + cg * 8);
            const f32x4 w0a = *(const GAS f32x4*)(w_conv + cg * 8), w0b = *(const GAS f32x4*)(w_conv + cg * 8 + 4);
            const f32x4 w1a = *(const GAS f32x4*)(w_conv + 512 + cg * 8), w1b = *(const GAS f32x4*)(w_conv + 512 + cg * 8 + 4);
            const f32x4 w2a = *(const GAS f32x4*)(w_conv + 1024 + cg * 8), w2b = *(const GAS f32x4*)(w_conv + 1024 + cg * 8 + 4);
            v4u o;
#define CONV2(q, wa, ia, ib) pk2(bflo(bq.q) * (w0##wa[ia] * bflo(u2.q) + w1##wa[ia] * bflo(u1.q) + w2##wa[ia] * bflo(u0.q)), bfhi(bq.q) * (w0##wa[ib] * bfhi(u2.q) + w1##wa[ib] * bfhi(u1.q) + w2##wa[ib] * bfhi(u0.q)))
            o.x = CONV2(x, a, 0, 1); o.y = CONV2(y, a, 2, 3); o.z = CONV2(z, b, 0, 1); o.w = CONV2(w, b, 2, 3);
#undef CONV2
            *(GAS v4u*)(YC + (size_t)row * 512 + cg * 8) = o;
        }
        __syncthreads();
        const attn_body::AttnTensors AT{(const attn_body::bf16*)QO, (const attn_body::bf16*)KB, (const attn_body::bf16*)VB, (attn_body::bf16*)QO, kbar};
        const attn_body::StaticOrder S(G, bx);
        attn_body::attn_phase<attn_body::StaticOrder>((char*)lds + RING_OFF, AT, S);
    }
    xcd_barrier(bar);

    asm volatile("; ===== PHASE 3 =====");
    if (PH(3)) {
        PH_LANES;
        pg8::Gemm g{512, 512, 512}; pg8::StaticOrder S; S.init(YC, 512, WcT, 512, T, 1024, G, bx);
        pg8::EpiGateMul E{SGC, 1024};
        pg8::gemm_phase<pg8::EpiGateMul, pg8::StaticOrder, true>(L + RING_OFF, g, S, E);
    }
    if (PH(3)) {
        PH_LANES;
        pg8::Gemm g{512, 512, 512}; pg8::StaticOrder S; S.init(QO, 512, WaT, 512, T, 1024, G, bx);
        pg8::EpiGateFma E{SGC, SGA, 1024};
        pg8::gemm_phase<pg8::EpiGateFma, pg8::StaticOrder, true>(L + RING_OFF, g, S, E);
    }
    xcd_barrier(bar);

    asm volatile("; ===== PHASE 4 =====");
    if (PH(4)) {
        PH_LANES;
        pg8::Gemm g{1024, 1024, 1024}; pg8::StaticOrder S; S.init(SGA, 1024, WmT, 1024, T, 1024, G, bx);
        pg8::EpiResF32 E{x, out, 1024};
        pg8::gemm_phase<pg8::EpiResF32, pg8::StaticOrder, true>(L + RING_OFF, g, S, E);
    }
    xcd_barrier(bar);

    asm volatile("; ===== PHASE 5 =====");
    if (PH(5)) {
        PH_LANES;
        for (int m = gw; m < T; m += NGW) rms_row_to_bf16(out + (size_t)m * D, g_xattn, A + (size_t)m * D, lane);
    }
    xcd_barrier(bar);

    asm volatile("; ===== PHASE 6 =====");
    if (PH(6)) {
        PH_LANES;
        pg8::Gemm g{1024, 1024, 1024}; pg8::StaticOrder S; S.init(A, 1024, WxqT, 1024, T, 1024, G, bx);
        pg8::EpiBf16 E{QX, 1024};
        pg8::gemm_phase<pg8::EpiBf16, pg8::StaticOrder, true>(L + RING_OFF, g, S, E);
    }
    xcd_barrier(bar);

    asm volatile("; ===== PHASE 7 =====");
    if (PH(7)) {
        PH_LANES;
        pg8::Gemm g{1024, 1024, 256};
        pg8::EpiSoftmax E{PM, 1024, 0.0625f * 1.4426950408889634f};
        { XOrder S{(const char*)QX, (const char*)KX, G, vcu, 0, false}; pg8::gemm_phase<pg8::EpiSoftmax, XOrder, false>(L + RING_OFF, g, S, E); }
        { XOrder S{(const char*)QX, (const char*)KX, G, vcu, 1, false}; pg8::gemm_phase<pg8::EpiSoftmax, XOrder, false>(L + RING_OFF, g, S, E); }
    }
    xcd_barrier(bar);

    asm volatile("; ===== PHASE 8 =====");
    if (PH(8)) {
        PH_LANES;
        pg8::Gemm g{1024, 4096, 256};
        pg8::EpiBf16 E{OX, 1024};
        { XOrder S{(const char*)PM, (const char*)VXT, G, vcu, 0, true}; pg8::gemm_phase<pg8::EpiBf16, XOrder, false>(L + RING_OFF, g, S, E); }
        { XOrder S{(const char*)PM, (const char*)VXT, G, vcu, 1, true}; pg8::gemm_phase<pg8::EpiBf16, XOrder, false>(L + RING_OFF, g, S, E); }
    }
    xcd_barrier(bar);

    asm volatile("; ===== PHASE 9 =====");
    if (PH(9)) {
        PH_LANES;
        pg8::Gemm g{1024, 1024, 1024}; pg8::StaticOrder S; S.init(OX, 1024, WxoT, 1024, T, 1024, G, bx);
        pg8::EpiResF32 E{out, out, 1024};
        pg8::gemm_phase<pg8::EpiResF32, pg8::StaticOrder, true>(L + RING_OFF, g, S, E);
    }
    xcd_barrier(bar);

    asm volatile("; ===== PHASE 10 =====");
    if (PH(10)) {
        PH_LANES;
        for (int m = gw; m < T; m += NGW) rms_row_to_bf16(out + (size_t)m * D, g_ffn, A + (size_t)m * D, lane);
    }
    xcd_barrier(bar);

    asm volatile("; ===== PHASE 11 =====");
    if (PH(11)) {
        PH_LANES;
        pg8::Gemm g{1024, 1024, 1024}; pg8::StaticOrder S; S.init(A, 1024, MT, 1024, T, 2048, G, bx);
        pg8::EpiF16 E{SC, 2048};
        pg8::gemm_phase<pg8::EpiF16, pg8::StaticOrder, true>(L + RING_OFF, g, S, E);
    }
    xcd_barrier(bar);

    asm volatile("; ===== PHASE 12 =====");
    if (PH(12)) {
        PH_LANES;
        typedef _Float16 h8 __attribute__((ext_vector_type(8)));
        LAS unsigned char* idl = L + RING_OFF + tid * 32;
        for (int task = gt; task < T * 8; task += NGT) {
            const int t = task >> 3, h = task & 7;
            const _Float16* row = SC + (size_t)t * 2048 + h * 256;
            float LA[16], LB[16];
#pragma unroll
            for (int p = 0; p < 2; ++p) {
                float Lk[16];
#pragma unroll
                for (int k = 0; k < 16; ++k) Lk[k] = -INFINITY;
                for (int c = 0; c < 16; ++c) {
                    const h8 v = *(const h8*)(row + p * 128 + c * 8);
#pragma unroll
                    for (int e = 0; e < 8; ++e) {
                        float key = __uint_as_float(__float_as_uint((float)v[e]) | (unsigned)(c * 8 + e));
#pragma unroll
                        for (int k = 0; k < 16; ++k) { const float hi_ = fmax_asm(Lk[k], key); key = fmin_asm(Lk[k], key); Lk[k] = hi_; }
                    }
                }
#pragma unroll
                for (int k = 0; k < 16; ++k) { if (p == 0) LA[k] = Lk[k]; else LB[k] = Lk[k]; }
            }
#pragma unroll
            for (int k = 0; k < 16; k += 4) {
                ((LAS unsigned*)idl)[k >> 2] = (__float_as_uint(LA[k]) & 127u) | ((__float_as_uint(LA[k + 1]) & 127u) << 8) | ((__float_as_uint(LA[k + 2]) & 127u) << 16) | ((__float_as_uint(LA[k + 3]) & 127u) << 24);
                ((LAS unsigned*)idl)[4 + (k >> 2)] = (__float_as_uint(LB[k]) & 127u) | ((__float_as_uint(LB[k + 1]) & 127u) << 8) | ((__float_as_uint(LB[k + 2]) & 127u) << 16) | ((__float_as_uint(LB[k + 3]) & 127u) << 24);
            }
            float Ck[16];
#pragma unroll
            for (int k = 0; k < 16; ++k) Ck[k] = -INFINITY;
#pragma unroll
            for (int a = 0; a < 16; ++a)
#pragma unroll
                for (int b = 0; b < 16; ++b)
                    if ((a + 1) * (b + 1) <= 16) {
                        float key = __uint_as_float((__float_as_uint(LA[a] + LB[b]) & ~255u) | (unsigned)(a * 16 + b));
#pragma unroll
                        for (int k = 0; k < 16; ++k) { const float hi_ = fmax_asm(Ck[k], key); key = fmin_asm(Ck[k], key); Ck[k] = hi_; }
                    }
            LDS_WAIT();
            float ex[16]; float sum = 0.f;
#pragma unroll
            for (int k = 0; k < 16; ++k) { ex[k] = __expf(Ck[k] - Ck[0]); sum += ex[k]; }
            const float rs = 1.f / sum;
            int* eo = EIDX + (size_t)t * 128 + h * 16; float* go = GW + (size_t)t * 128 + h * 16;
#pragma unroll
            for (int k = 0; k < 16; k += 4) {
                int ev[4];
#pragma unroll
                for (int j = 0; j < 4; ++j) { const unsigned id = __float_as_uint(Ck[k + j]) & 255u; ev[j] = (int)idl[id >> 4] * 128 + (int)idl[16 + (id & 15u)]; }
                *(GAS v4u*)(eo + k) = (v4u){(unsigned)ev[0], (unsigned)ev[1], (unsigned)ev[2], (unsigned)ev[3]};
                *(GAS f32x4*)(go + k) = (f32x4){ex[k] * rs, ex[k + 1] * rs, ex[k + 2] * rs, ex[k + 3] * rs};
            }
            LDS_WAIT();
        }
    }
    xcd_barrier(bar);

    asm volatile("; ===== PHASE 13 =====");
    if (PH(13)) {
        PH_LANES;
        for (int t = gw; t < T; t += NGW) {
            float a[16];
            { const GAS v4u* ar = (const GAS v4u*)(A + (size_t)t * D + 16 * lane); const v4u q0 = ar[0], q1 = ar[1];
              a[0] = bflo(q0.x); a[1] = bfhi(q0.x); a[2] = bflo(q0.y); a[3] = bfhi(q0.y); a[4] = bflo(q0.z); a[5] = bfhi(q0.z); a[6] = bflo(q0.w); a[7] = bfhi(q0.w);
              a[8] = bflo(q1.x); a[9] = bfhi(q1.x); a[10] = bflo(q1.y); a[11] = bfhi(q1.y); a[12] = bflo(q1.z); a[13] = bfhi(q1.z); a[14] = bflo(q1.w); a[15] = bfhi(q1.w); }
            const int e0 = EIDX[(size_t)t * 128 + lane], e1 = EIDX[(size_t)t * 128 + 64 + lane];
            const float g0 = GW[(size_t)t * 128 + lane], g1 = GW[(size_t)t * 128 + 64 + lane];
            const float s0 = SU[e0] * g0, s1 = SU[e1] * g1;
            const float v0s = SV[e0] * g0, v1s = SV[e1] * g1;
            const float u0s = SU[e0], u1s = SU[e1]; (void)s0; (void)s1;
#pragma unroll 1
            for (int hb = 0; hb < 8; ++hb) {
                const int ev = (hb < 4) ? e0 : e1; const int lb = (hb & 3) * 16;
                v4u q[16];
#pragma unroll
                for (int k = 0; k < 16; ++k) { const int e = __builtin_amdgcn_readlane(ev, lb + k); q[k] = *(const GAS v4u*)(U8 + (size_t)e * 1024 + 16 * lane); }
                float d[16];
#pragma unroll
                for (int k = 0; k < 16; ++k) {
                    const auto f0 = __builtin_amdgcn_cvt_pk_f32_fp8((int)q[k].x, false), f1 = __builtin_amdgcn_cvt_pk_f32_fp8((int)q[k].x, true), f2 = __builtin_amdgcn_cvt_pk_f32_fp8((int)q[k].y, false), f3 = __builtin_amdgcn_cvt_pk_f32_fp8((int)q[k].y, true),
                               f4 = __builtin_amdgcn_cvt_pk_f32_fp8((int)q[k].z, false), f5 = __builtin_amdgcn_cvt_pk_f32_fp8((int)q[k].z, true), f6 = __builtin_amdgcn_cvt_pk_f32_fp8((int)q[k].w, false), f7 = __builtin_amdgcn_cvt_pk_f32_fp8((int)q[k].w, true);
                    d[k] = ((a[0] * f0[0] + a[1] * f0[1]) + (a[2] * f1[0] + a[3] * f1[1])) + ((a[4] * f2[0] + a[5] * f2[1]) + (a[6] * f3[0] + a[7] * f3[1]))
                         + ((a[8] * f4[0] + a[9] * f4[1]) + (a[10] * f5[0] + a[11] * f5[1])) + ((a[12] * f6[0] + a[13] * f6[1]) + (a[14] * f7[0] + a[15] * f7[1]));
                }
                float r8[8], r4[4], r2[2];
#pragma unroll
                for (int i = 0; i < 8; ++i) { auto sw = __builtin_amdgcn_permlane32_swap(__float_as_uint(d[i]), __float_as_uint(d[i + 8]), false, false); r8[i] = __uint_as_float(sw[0]) + __uint_as_float(sw[1]); }
#pragma unroll
                for (int i = 0; i < 4; ++i) { auto sw = __builtin_amdgcn_permlane16_swap(__float_as_uint(r8[i]), __float_as_uint(r8[i + 4]), false, false); r4[i] = __uint_as_float(sw[0]) + __uint_as_float(sw[1]); }
                const bool b3 = (lane >> 3) & 1, b2 = (lane >> 2) & 1;
#pragma unroll
                for (int i = 0; i < 2; ++i) { const float keep = b3 ? r4[i + 2] : r4[i], send = b3 ? r4[i] : r4[i + 2]; r2[i] = keep + shx<8>(send); }
                float dot; { const float keep = b2 ? r2[1] : r2[0], send = b2 ? r2[0] : r2[1]; dot = keep + shx<4>(send); }
                dot += shx<2>(dot); dot += shx<1>(dot);
                const int src = (lb + (lane >> 2)) * 4;
                const int es = __builtin_amdgcn_ds_bpermute(src, ev);
                const float us = __uint_as_float((unsigned)__builtin_amdgcn_ds_bpermute(src, (int)__float_as_uint((hb < 4) ? u0s : u1s)));
                const float vs = __uint_as_float((unsigned)__builtin_amdgcn_ds_bpermute(src, (int)__float_as_uint((hb < 4) ? v0s : v1s)));
                const float act = dot * us;
                const float u3 = 0.7978845608028654f * (act + 0.044715f * act * act * act);
                const float ge = act * __builtin_amdgcn_rcpf(1.f + __expf(-2.f * u3));
                const float wv = ge * vs;
                if ((lane & 3) == 0) {
                    const unsigned pk = (pk2(0.f, wv) & 0xffff0000u) | (unsigned)es;
                    PW[((size_t)((t >> 6) * 8 + hb) * 4 + (lane >> 4)) * 256 + (t & 63) * 4 + ((lane >> 2) & 3)] = pk;
                }
            }
        }
    }
    xcd_barrier(bar);

    asm volatile("; ===== PHASE 14 =====");
    if (PH(14)) {
        PH_LANES;
        for (int item = vcu; item < 256; item += G) {
            const int sl = item & 127, half = item >> 7;
            __syncthreads();
#pragma unroll
            for (int i = 0; i < 16; ++i) *(LAS v4u*)(L + RING_OFF + (i * 512 + tid) * 16) = *(const GAS v4u*)(V8T + (size_t)sl * 131072 + (size_t)(i * 512 + tid) * 16);
            __syncthreads();
#pragma unroll 1
            for (int itk = 0; itk < 32; ++itk) {
                const int g64 = half * 256 + itk * 8 + wave;
                const int t = g64 * 64 + lane;
                f32x2v acc[4] = {(f32x2v){0.f, 0.f}, (f32x2v){0.f, 0.f}, (f32x2v){0.f, 0.f}, (f32x2v){0.f, 0.f}};
                const GAS v4u* pw = (const GAS v4u*)(PW + (size_t)g64 * 8192) + lane;
                v4u cur[4];
#pragma unroll
                for (int k = 0; k < 4; ++k) cur[k] = pw[k * 64];
#pragma unroll 1
                for (int c = 0; c < 8; ++c) {
                    v4u nxt[4];
                    const int cn = (c < 7) ? c + 1 : c;
#pragma unroll
                    for (int k = 0; k < 4; ++k) nxt[k] = pw[(cn * 4 + k) * 64];
                    v2u tb[16];
#pragma unroll
                    for (int k = 0; k < 4; ++k)
#pragma unroll
                        for (int i = 0; i < 4; ++i) { const unsigned p = cur[k][i]; tb[k * 4 + i] = *(const LAS v2u*)(L + RING_OFF + ((p & 0xffffu) << 3)); }
#pragma unroll
                    for (int k = 0; k < 4; ++k)
#pragma unroll
                        for (int i = 0; i < 4; ++i) { const unsigned p = cur[k][i]; const float w = __uint_as_float(p & 0xffff0000u); const v2u q = tb[k * 4 + i];
                            const f32x2v ww = (f32x2v){w, w};
                            acc[0] += ww * __builtin_amdgcn_cvt_pk_f32_fp8((int)q.x, false); acc[1] += ww * __builtin_amdgcn_cvt_pk_f32_fp8((int)q.x, true);
                            acc[2] += ww * __builtin_amdgcn_cvt_pk_f32_fp8((int)q.y, false); acc[3] += ww * __builtin_amdgcn_cvt_pk_f32_fp8((int)q.y, true); }
#pragma unroll
                    for (int k = 0; k < 4; ++k) cur[k] = nxt[k];
                }
                GAS f32x4* hr = (GAS f32x4*)(out + (size_t)t * D + sl * 8);
                const f32x4 h0 = hr[0], h1 = hr[1];
                hr[0] = h0 + (f32x4){acc[0].x, acc[0].y, acc[1].x, acc[1].y}; hr[1] = h1 + (f32x4){acc[2].x, acc[2].y, acc[3].x, acc[3].y};
            }
        }
    }
    xcd_barrier(bar);

    asm volatile("; ===== PHASE 15 =====");
    if (PH(15)) {
        PH_LANES;
        for (int t = gw; t < T; t += NGW) {
            GAS f32x4* hr = (GAS f32x4*)(out + (size_t)t * D) + lane; const GAS f32x4* gr = (const GAS f32x4*)g_final + lane;
            f32x4 o[4]; float ss = 0.f;
#pragma unroll
            for (int j = 0; j < 4; ++j) { o[j] = hr[64 * j]; ss += (o[j].x * o[j].x + o[j].y * o[j].y) + (o[j].z * o[j].z + o[j].w * o[j].w); }
            const float r = rsqrtf(wave_sum(ss) * (1.f / 1024.f) + RMS_EPS);
#pragma unroll
            for (int j = 0; j < 4; ++j) hr[64 * j] = o[j] * r * gr[64 * j];
        }
    }
}

extern "C" void kernel_launch(void* const* d_in, const int* in_sizes, int n_in, void* d_out, int out_size, void* d_ws, size_t ws_size, hipStream_t stream) {
    static int grid = 0;
    if (grid == 0) {
        if (n_in != 19 || out_size != T * D || ws_size < WS_END) { fprintf(stderr, "kernel_launch: unexpected problem (n_in %d, out %d, ws %zu < %zu); nothing launched\n", n_in, out_size, ws_size, (size_t)WS_END); grid = -1; return; }
        int dev = 0, cus = 0, per_cu = 0;
        if (hipGetDevice(&dev) != hipSuccess || hipDeviceGetAttribute(&cus, hipDeviceAttributeMultiprocessorCount, dev) != hipSuccess) { grid = -1; return; }
        if (hipFuncSetAttribute((const void*)mk_fwd, hipFuncAttributeMaxDynamicSharedMemorySize, LDS_BYTES) != hipSuccess) { fprintf(stderr, "kernel_launch: hipFuncSetAttribute failed\n"); grid = -1; return; }
        if (hipOccupancyMaxActiveBlocksPerMultiprocessor(&per_cu, (const void*)mk_fwd, NWAVES * 64, LDS_BYTES) != hipSuccess || per_cu < 1) { fprintf(stderr, "kernel_launch: occupancy query says %d blocks per CU\n", per_cu); }
        (void)hipGetLastError();
        grid = cus;
    }
    if (grid < 0) return;
    if (hipMemsetAsync((char*)d_ws + WS_CTL, 0, CTL_ZERO_BYTES, stream) != hipSuccess) return;
    Args a{};
    for (int i = 0; i < 19; ++i) a.in[i] = (const float*)d_in[i];
    a.out = (float*)d_out; a.ws = (unsigned char*)d_ws;
    hipLaunchKernelGGL(mk_fwd, dim3(grid), dim3(NWAVES * 64), LDS_BYTES, stream, a);
}
```

```cpp
#include <hip/hip_runtime.h>
#include <hip/hip_bf16.h>
#include <cstdio>
#include <cstdint>
#include <cmath>

#ifndef DIAG
#define DIAG 0
#endif


template <int O> __device__ __forceinline__ float shx(float v) { static_assert(O > 0 && O < 32, "shx"); return __uint_as_float((unsigned)__builtin_amdgcn_ds_swizzle((int)__float_as_uint(v), (O << 10) | 0x1f)); }
__device__ __forceinline__ float sum32(float v) { auto r = __builtin_amdgcn_permlane32_swap(__float_as_uint(v), __float_as_uint(v), false, false); return __uint_as_float(r[0]) + __uint_as_float(r[1]); }
__device__ __forceinline__ float max32(float v) { auto r = __builtin_amdgcn_permlane32_swap(__float_as_uint(v), __float_as_uint(v), false, false); return fmaxf(__uint_as_float(r[0]), __uint_as_float(r[1])); }
__device__ __forceinline__ float wave_max(float v) { v = fmaxf(v, shx<1>(v)); v = fmaxf(v, shx<2>(v)); v = fmaxf(v, shx<4>(v)); v = fmaxf(v, shx<8>(v)); v = fmaxf(v, shx<16>(v)); return max32(v); }
__device__ __forceinline__ float wave_sum(float v) { v += shx<1>(v); v += shx<2>(v); v += shx<4>(v); v += shx<8>(v); v += shx<16>(v); return sum32(v); }

namespace pg8 {
#define PG8_LAS __attribute__((address_space(3)))
typedef unsigned short bf16_t;
typedef short bf16x8 __attribute__((ext_vector_type(8)));
typedef float f32x4 __attribute__((ext_vector_type(4)));
typedef float f32x2 __attribute__((ext_vector_type(2)));
typedef unsigned u32x4 __attribute__((ext_vector_type(4)));
typedef unsigned u32x2 __attribute__((ext_vector_type(2)));
constexpr int BM = 256, BK = 64, HALF = 128, HTB = HALF * BK * 2  , STAGE_BYTES = 8 * HTB, NXCD = 8, WGM = 8;

__host__ __device__ __forceinline__ int lds_byte(int r, int c) { const int st = (r >> 4) * 2 + (c >> 5), rr = r & 15, cc = c & 31, ob = rr * 64 + cc * 2; return st * 1024 + (ob ^ (((ob >> 9) & 1) << 5)); }
__host__ __device__ __forceinline__ void stage_rc(int b, int& R, int& C) { const int st = b / 1024, sb = b % 1024, swz = sb ^ (((sb >> 9) & 1) << 5); R = (st >> 1) * 16 + swz / 64; C = (st & 1) * 32 + (swz % 64) / 2; }
__host__ __device__ __forceinline__ int perm32(int rho) { const int n = rho >> 4, i = rho & 15; return 8 * (i >> 2) + 4 * n + (i & 3); }

struct Unit { int pm, pn; const char* a; const char* b; };
struct Gemm { int lda, ldb, K; };

struct StaticOrder {
    int nM, nN, nwg, G, c; const char* A; const char* Bt; size_t astep, bstep;
    __device__ void init(const void* A_, int lda, const void* Bt_, int ldb, int M, int N, int G_, int c_) { nM = M / BM; nN = N / BM; nwg = nM * nN; G = G_; c = c_; A = (const char*)A_; Bt = (const char*)Bt_; astep = (size_t)BM * lda * 2; bstep = (size_t)BM * ldb * 2; }
    __device__ bool next(int i, Unit& u) const {
        const long L = (long)i * G + c; if (L >= nwg) return false;
        int wgid = (int)L; { const int q = nwg / NXCD, r = nwg % NXCD, xcd = wgid % NXCD, off = wgid / NXCD; wgid = (xcd < r ? xcd * (q + 1) : r * (q + 1) + (xcd - r) * q) + off; }
        const int nig = WGM * nN, gid = wgid / nig, fm = gid * WGM, gsz = (nM - fm) < WGM ? (nM - fm) : WGM;
        u.pm = fm + ((wgid % nig) % gsz); u.pn = (wgid % nig) / gsz; u.a = A + (size_t)u.pm * astep; u.b = Bt + (size_t)u.pn * bstep; return true;
    }
};

__device__ __forceinline__ unsigned cvt_pk_bf16(float lo, float hi) { typedef __bf16 bf2 __attribute__((ext_vector_type(2))); f32x2 v = {lo, hi}; bf2 b = __builtin_convertvector(v, bf2); return __builtin_bit_cast(unsigned, b); }
__device__ __forceinline__ float bf_lo(unsigned u) { return __uint_as_float(u << 16); }
__device__ __forceinline__ float bf_hi(unsigned u) { return __uint_as_float(u & 0xffff0000u); }

template <class Epi, class Sched, bool ALIGN_EPI>
__device__ __forceinline__ void gemm_phase(PG8_LAS unsigned char* lds, const Gemm g, const Sched& S, const Epi& E) {
    int tid = threadIdx.x; asm volatile("" : "+v"(tid));
    const int wid = __builtin_amdgcn_readfirstlane(tid >> 6), lane = tid & 63, wr = wid >> 2, wc = wid & 3, fr = lane & 15, fq = lane >> 4;
    const int K = g.K, nt = K / BK;
    unsigned voffA[2], voffB[2];
#pragma unroll
    for (int i = 0; i < 2; ++i) { int R, C; stage_rc(tid * 16 + i * 8192, R, C); const int Rb = Epi::PERM ? ((R & ~31) + perm32(R & 31)) : R;
        voffA[i] = (unsigned)(R * g.lda + C) * 2u; voffB[i] = (unsigned)(Rb * g.ldb + C) * 2u; }
    const size_t kstep = (size_t)(BK * 2);
    const size_t hstepA = (size_t)HALF * g.lda * 2, hstepB = (size_t)HALF * g.ldb * 2;
    const unsigned ldsw = (unsigned)wid * 1024u;
    const int aoff = lds_byte(wr * 64 + fr, fq * 8), boff = lds_byte(wc * 32 + fr, fq * 8);
#define PG8_SA(b, h) (((b) * 2 + (h)) * HTB)
#define PG8_SB(b, h) ((4 + (b) * 2 + (h)) * HTB)
#define PG8_STAGE(bufoff, gbase, voff) do { _Pragma("unroll") for (int _i = 0; _i < 2; ++_i) \
        __builtin_amdgcn_global_load_lds((const unsigned*)((const char*)(gbase) + (voff)[_i]), (PG8_LAS unsigned*)(lds + (bufoff) + ldsw + _i * 8192), 16, 0, 0); } while (0)
#define PG8_LDA(dst, b, h) do { _Pragma("unroll") for (int m = 0; m < 4; ++m) _Pragma("unroll") for (int k = 0; k < 2; ++k) dst[m][k] = *(const PG8_LAS bf16x8*)(lds + PG8_SA(b, h) + aoff + m * 2048 + k * 1024); } while (0)
#define PG8_LDB(dst, b, h) do { _Pragma("unroll") for (int n = 0; n < 2; ++n) _Pragma("unroll") for (int k = 0; k < 2; ++k) dst[n][k] = *(const PG8_LAS bf16x8*)(lds + PG8_SB(b, h) + boff + n * 2048 + k * 1024); } while (0)
#define PG8_MMA(ai, bj, At, Bt) do { __builtin_amdgcn_s_setprio(1); _Pragma("unroll") for (int m = 0; m < 4; ++m) _Pragma("unroll") for (int n = 0; n < 2; ++n) _Pragma("unroll") for (int k = 0; k < 2; ++k) \
        acc[ai][bj][m][n] = __builtin_amdgcn_mfma_f32_16x16x32_bf16(Bt[n][k], At[m][k], acc[ai][bj][m][n], 0, 0, 0); __builtin_amdgcn_s_setprio(0); } while (0)
#define PG8_WAIT_V(n) asm volatile("s_waitcnt vmcnt(" #n ")" ::: "memory")
#define PG8_WAIT_L(n) asm volatile("s_waitcnt lgkmcnt(" #n ")" ::: "memory")
#define PG8_BAR __builtin_amdgcn_s_barrier()
#define PG8_SCHED __builtin_amdgcn_sched_barrier(0)
    Unit cur, nxt; int ui = 0;
    if (!S.next(0, cur)) return;
    f32x4 acc[2][2][4][2];
#pragma unroll
    for (int a = 0; a < 2; ++a)
#pragma unroll
        for (int b = 0; b < 2; ++b)
#pragma unroll
            for (int m = 0; m < 4; ++m)
#pragma unroll
                for (int n = 0; n < 2; ++n) acc[a][b][m][n] = (f32x4){0.f, 0.f, 0.f, 0.f};
    bf16x8 At[4][2], B0[2][2], B1[2][2];
    const char* cA = cur.a; const char* cB = cur.b;
    PG8_STAGE(PG8_SB(0, 0), cB, voffB); PG8_STAGE(PG8_SB(0, 1), cB + hstepB, voffB); PG8_STAGE(PG8_SA(0, 0), cA, voffA); PG8_STAGE(PG8_SA(0, 1), cA + hstepA, voffA);
    if (wr == 1) PG8_BAR;
    PG8_WAIT_V(2); PG8_BAR;
    PG8_STAGE(PG8_SB(1, 0), cB + kstep, voffB); PG8_STAGE(PG8_SA(1, 0), cA + kstep, voffA); PG8_STAGE(PG8_SB(1, 1), cB + hstepB + kstep, voffB);
    PG8_WAIT_V(6); PG8_BAR;
    for (;;) {
        const bool has_next = S.next(ui + 1, nxt);
        const char* nA = has_next ? nxt.a : cA; const char* nB = has_next ? nxt.b : cB;
        for (int t = 0; t < nt; t += 2) {
            const bool last = (t == nt - 2);
            const char* a1 = cA + (size_t)(t + 1) * kstep;
            const char* a2 = last ? nA : cA + (size_t)(t + 2) * kstep; const char* b2 = last ? nB : cB + (size_t)(t + 2) * kstep;
            const char* a3 = a2 + kstep; const char* b3 = b2 + kstep;
            PG8_LDB(B0, 0, 0); PG8_LDB(B1, 0, 1); PG8_SCHED; PG8_LDA(At, 0, 0); PG8_STAGE(PG8_SA(1, 1), a1 + hstepA, voffA);
            PG8_WAIT_V(8); PG8_WAIT_L(0); PG8_BAR; PG8_MMA(0, 0, At, B0); PG8_MMA(0, 1, At, B1); PG8_BAR; PG8_SCHED;
            PG8_LDA(At, 0, 1); PG8_STAGE(PG8_SB(0, 0), b2, voffB); PG8_STAGE(PG8_SB(0, 1), b2 + hstepB, voffB); PG8_STAGE(PG8_SA(0, 0), a2, voffA);
            PG8_WAIT_V(8); PG8_WAIT_L(0); PG8_BAR; PG8_MMA(1, 0, At, B0); PG8_MMA(1, 1, At, B1); PG8_BAR; PG8_SCHED;
            PG8_LDB(B0, 1, 0); PG8_LDB(B1, 1, 1); PG8_SCHED; PG8_LDA(At, 1, 0); PG8_STAGE(PG8_SA(0, 1), a2 + hstepA, voffA);
            PG8_WAIT_V(8); PG8_WAIT_L(0); PG8_BAR; PG8_MMA(0, 0, At, B0); PG8_MMA(0, 1, At, B1); PG8_BAR; PG8_SCHED;
            PG8_LDA(At, 1, 1); PG8_STAGE(PG8_SB(1, 0), b3, voffB); PG8_STAGE(PG8_SB(1, 1), b3 + hstepB, voffB); PG8_STAGE(PG8_SA(1, 0), a3, voffA);
            PG8_WAIT_V(8); PG8_WAIT_L(0); PG8_BAR; PG8_MMA(1, 0, At, B0); PG8_MMA(1, 1, At, B1); PG8_BAR; PG8_SCHED;
        }
        if constexpr (ALIGN_EPI) { if (wr == 0) PG8_BAR; }
        if constexpr (!Epi::AFTER_DRAIN) { E(acc, cur, wr, wc, fr, fq); }
        if (!has_next) break;
#pragma unroll
        for (int a = 0; a < 2; ++a)
#pragma unroll
            for (int b = 0; b < 2; ++b)
#pragma unroll
                for (int m = 0; m < 4; ++m)
#pragma unroll
                    for (int n = 0; n < 2; ++n) acc[a][b][m][n] = (f32x4){0.f, 0.f, 0.f, 0.f};
        cur = nxt; cA = nA; cB = nB; ++ui;
        if constexpr (ALIGN_EPI) { if (wr == 1) PG8_BAR; }
    }
    PG8_WAIT_V(0);
    if constexpr (!ALIGN_EPI) { if (wr == 0) PG8_BAR; }
    PG8_BAR;
    if constexpr (Epi::AFTER_DRAIN) { E.fused(acc, cur, wr, wc, fr, fq, lds, wid, lane); }
#undef PG8_SA
#undef PG8_SB
#undef PG8_STAGE
#undef PG8_LDA
#undef PG8_LDB
#undef PG8_MMA
#undef PG8_WAIT_V
#undef PG8_WAIT_L
#undef PG8_BAR
#undef PG8_SCHED
}

typedef f32x4 AccT[2][2][4][2];

struct EpiBf16 {
    static constexpr bool PERM = true, AFTER_DRAIN = false;
    bf16_t* O; int ldc;
    __device__ __forceinline__ void operator()(const AccT& acc, const Unit& u, int wr, int wc, int fr, int fq) const {
        { int t_ = threadIdx.x; asm volatile("" : "+v"(t_)); fr = t_ & 15; fq = (t_ >> 4) & 3; }
        const int row0 = u.pm * BM + wr * 64 + fr, col0 = u.pn * BM + wc * 32 + 8 * fq;
#pragma unroll
        for (int ai = 0; ai < 2; ++ai)
#pragma unroll
            for (int m = 0; m < 4; ++m) { bf16_t* rowp = O + (size_t)(row0 + ai * HALF + m * 16) * ldc + col0;
#pragma unroll
                for (int bj = 0; bj < 2; ++bj) { const f32x4 v0 = acc[ai][bj][m][0], v1 = acc[ai][bj][m][1];
                    u32x4 w; w.x = cvt_pk_bf16(v0[0], v0[1]); w.y = cvt_pk_bf16(v0[2], v0[3]); w.z = cvt_pk_bf16(v1[0], v1[1]); w.w = cvt_pk_bf16(v1[2], v1[3]);
                    *(u32x4*)(rowp + bj * HALF) = w; } }
    }
};
struct EpiF16 {
    static constexpr bool PERM = true, AFTER_DRAIN = false;
    _Float16* O; int ldc;
    __device__ __forceinline__ void operator()(const AccT& acc, const Unit& u, int wr, int wc, int fr, int fq) const {
        { int t_ = threadIdx.x; asm volatile("" : "+v"(t_)); fr = t_ & 15; fq = (t_ >> 4) & 3; }
        typedef _Float16 h8 __attribute__((ext_vector_type(8)));
        const int row0 = u.pm * BM + wr * 64 + fr, col0 = u.pn * BM + wc * 32 + 8 * fq;
#pragma unroll
        for (int ai = 0; ai < 2; ++ai)
#pragma unroll
            for (int m = 0; m < 4; ++m) { _Float16* rowp = O + (size_t)(row0 + ai * HALF + m * 16) * ldc + col0;
#pragma unroll
                for (int bj = 0; bj < 2; ++bj) { const f32x4 v0 = acc[ai][bj][m][0], v1 = acc[ai][bj][m][1];
                    h8 w = {(_Float16)v0[0], (_Float16)v0[1], (_Float16)v0[2], (_Float16)v0[3], (_Float16)v1[0], (_Float16)v1[1], (_Float16)v1[2], (_Float16)v1[3]};
                    *(h8*)(rowp + bj * HALF) = w; } }
    }
};
struct EpiGateMul {
    static constexpr bool PERM = true, AFTER_DRAIN = false;
    const bf16_t* G; bf16_t* Dst; int ldc;
    __device__ __forceinline__ void operator()(const AccT& acc, const Unit& u, int wr, int wc, int fr, int fq) const {
        { int t_ = threadIdx.x; asm volatile("" : "+v"(t_)); fr = t_ & 15; fq = (t_ >> 4) & 3; }
        const int row0 = u.pm * BM + wr * 64 + fr, col0 = u.pn * BM + wc * 32 + 8 * fq;
#pragma unroll
        for (int ai = 0; ai < 2; ++ai)
#pragma unroll
            for (int m = 0; m < 4; ++m) { const size_t roff = (size_t)(row0 + ai * HALF + m * 16) * ldc + col0; const bf16_t* rowg = G + roff; bf16_t* rowp = Dst + roff;
#pragma unroll
                for (int bj = 0; bj < 2; ++bj) { const f32x4 v0 = acc[ai][bj][m][0], v1 = acc[ai][bj][m][1]; const u32x4 gq = *(const u32x4*)(rowg + bj * HALF);
                    u32x4 w; w.x = cvt_pk_bf16(v0[0] * bf_lo(gq.x), v0[1] * bf_hi(gq.x)); w.y = cvt_pk_bf16(v0[2] * bf_lo(gq.y), v0[3] * bf_hi(gq.y));
                    w.z = cvt_pk_bf16(v1[0] * bf_lo(gq.z), v1[1] * bf_hi(gq.z)); w.w = cvt_pk_bf16(v1[2] * bf_lo(gq.w), v1[3] * bf_hi(gq.w));
                    *(u32x4*)(rowp + bj * HALF) = w; } }
    }
};
struct EpiGateFma {
    static constexpr bool PERM = true, AFTER_DRAIN = false;
    const bf16_t* Tm; const bf16_t* G2; bf16_t* Dst; int ldc;
    __device__ __forceinline__ void operator()(const AccT& acc, const Unit& u, int wr, int wc, int fr, int fq) const {
        { int t_ = threadIdx.x; asm volatile("" : "+v"(t_)); fr = t_ & 15; fq = (t_ >> 4) & 3; }
        const int row0 = u.pm * BM + wr * 64 + fr, col0 = u.pn * BM + wc * 32 + 8 * fq;
#pragma unroll
        for (int ai = 0; ai < 2; ++ai)
#pragma unroll
            for (int m = 0; m < 4; ++m) { const size_t off = (size_t)(row0 + ai * HALF + m * 16) * ldc + col0;
#pragma unroll
                for (int bj = 0; bj < 2; ++bj) { const f32x4 v0 = acc[ai][bj][m][0], v1 = acc[ai][bj][m][1]; const u32x4 gq = *(const u32x4*)(G2 + off + bj * HALF); const u32x4 tq = *(const u32x4*)(Tm + off + bj * HALF);
                    u32x4 w; w.x = cvt_pk_bf16(bf_lo(tq.x) + v0[0] * bf_lo(gq.x), bf_hi(tq.x) + v0[1] * bf_hi(gq.x)); w.y = cvt_pk_bf16(bf_lo(tq.y) + v0[2] * bf_lo(gq.y), bf_hi(tq.y) + v0[3] * bf_hi(gq.y));
                    w.z = cvt_pk_bf16(bf_lo(tq.z) + v1[0] * bf_lo(gq.z), bf_hi(tq.z) + v1[1] * bf_hi(gq.z)); w.w = cvt_pk_bf16(bf_lo(tq.w) + v1[2] * bf_lo(gq.w), bf_hi(tq.w) + v1[3] * bf_hi(gq.w));
                    *(u32x4*)(Dst + off + bj * HALF) = w; } }
    }
};
struct EpiResF32 {
    static constexpr bool PERM = false, AFTER_DRAIN = false;
    const float* res; float* out; int ldc; float mul;
    __device__ __forceinline__ void operator()(const AccT& acc, const Unit& u, int wr, int wc, int fr, int fq) const {
        { int t_ = threadIdx.x; asm volatile("" : "+v"(t_)); fr = t_ & 15; fq = (t_ >> 4) & 3; }
        const int row0 = u.pm * BM + wr * 64 + fr, col0 = u.pn * BM + wc * 32 + 4 * fq;
#pragma unroll
        for (int ai = 0; ai < 2; ++ai)
#pragma unroll
            for (int m = 0; m < 4; ++m) { const size_t off = (size_t)(row0 + ai * HALF + m * 16) * ldc + col0;
#pragma unroll
                for (int bj = 0; bj < 2; ++bj)
#pragma unroll
                    for (int n = 0; n < 2; ++n) { const f32x4 r = *(const f32x4*)(res + off + bj * HALF + n * 16); *(f32x4*)(out + off + bj * HALF + n * 16) = r + acc[ai][bj][m][n] * mul; } }
    }
};

__device__ __forceinline__ float row_rs(const float* ssq, int row) {
    const f32x4* p = (const f32x4*)(ssq + (size_t)row * 16); const f32x4 a = p[0], b = p[1], c = p[2], d = p[3];
    const float s = ((a[0] + a[1]) + (a[2] + a[3])) + ((b[0] + b[1]) + (b[2] + b[3])) + ((c[0] + c[1]) + (c[2] + c[3])) + ((d[0] + d[1]) + (d[2] + d[3]));
    return rsqrtf(s * (1.f / 1024.f) + 1e-6f);
}
struct EpiBf16RS {
    static constexpr bool PERM = true, AFTER_DRAIN = false;
    bf16_t* O; int ldc; const float* ssq;
    __device__ __forceinline__ void operator()(const AccT& acc, const Unit& u, int wr, int wc, int fr, int fq) const {
        { int t_ = threadIdx.x; asm volatile("" : "+v"(t_)); fr = t_ & 15; fq = (t_ >> 4) & 3; }
        const int row0 = u.pm * BM + wr * 64 + fr, col0 = u.pn * BM + wc * 32 + 8 * fq;
#pragma unroll
        for (int ai = 0; ai < 2; ++ai)
#pragma unroll
            for (int m = 0; m < 4; ++m) { int ro = row0 + ai * HALF + m * 16; asm volatile("" : "+v"(ro)); const float rs = row_rs(ssq, ro); bf16_t* rowp = O + (size_t)ro * ldc + col0;
#pragma unroll
                for (int bj = 0; bj < 2; ++bj) { const f32x4 v0 = acc[ai][bj][m][0] * rs, v1 = acc[ai][bj][m][1] * rs;
                    u32x4 w; w.x = cvt_pk_bf16(v0[0], v0[1]); w.y = cvt_pk_bf16(v0[2], v0[3]); w.z = cvt_pk_bf16(v1[0], v1[1]); w.w = cvt_pk_bf16(v1[2], v1[3]);
                    *(u32x4*)(rowp + bj * HALF) = w; } }
    }
};
struct EpiF16RS {
    static constexpr bool PERM = true, AFTER_DRAIN = false;
    _Float16* O; int ldc; const float* ssq;
    __device__ __forceinline__ void operator()(const AccT& acc, const Unit& u, int wr, int wc, int fr, int fq) const {
        { int t_ = threadIdx.x; asm volatile("" : "+v"(t_)); fr = t_ & 15; fq = (t_ >> 4) & 3; }
        typedef _Float16 h8 __attribute__((ext_vector_type(8)));
        const int row0 = u.pm * BM + wr * 64 + fr, col0 = u.pn * BM + wc * 32 + 8 * fq;
#pragma unroll
        for (int ai = 0; ai < 2; ++ai)
#pragma unroll
            for (int m = 0; m < 4; ++m) { int ro = row0 + ai * HALF + m * 16; asm volatile("" : "+v"(ro)); const float rs = row_rs(ssq, ro); _Float16* rowp = O + (size_t)ro * ldc + col0;
#pragma unroll
                for (int bj = 0; bj < 2; ++bj) { const f32x4 v0 = acc[ai][bj][m][0] * rs, v1 = acc[ai][bj][m][1] * rs;
                    h8 w = {(_Float16)v0[0], (_Float16)v0[1], (_Float16)v0[2], (_Float16)v0[3], (_Float16)v1[0], (_Float16)v1[1], (_Float16)v1[2], (_Float16)v1[3]};
                    *(h8*)(rowp + bj * HALF) = w; } }
    }
};
template <bool RES_F32> struct EpiResNorm {
    static constexpr bool PERM = true, AFTER_DRAIN = false;
    const float* resf; bf16_t* H; float* ssq; int ldc; float mul;
    __device__ __forceinline__ void operator()(const AccT& acc, const Unit& u, int wr, int wc, int fr, int fq) const {
        { int t_ = threadIdx.x; asm volatile("" : "+v"(t_)); fr = t_ & 15; fq = (t_ >> 4) & 3; }
        const int row0 = u.pm * BM + wr * 64 + fr, col0 = u.pn * BM + wc * 32 + 8 * fq;
#pragma unroll
        for (int ai = 0; ai < 2; ++ai)
#pragma unroll
            for (int m = 0; m < 4; ++m) { int ro = row0 + ai * HALF + m * 16; asm volatile("" : "+v"(ro)); const size_t off = (size_t)ro * ldc + col0; float ss = 0.f;
#pragma unroll
                for (int bj = 0; bj < 2; ++bj) { f32x4 r0, r1;
                    if (RES_F32) { r0 = *(const f32x4*)(resf + off + bj * HALF); r1 = *(const f32x4*)(resf + off + bj * HALF + 4); }
                    else { const u32x4 q = *(const u32x4*)(H + off + bj * HALF); r0 = (f32x4){bf_lo(q.x), bf_hi(q.x), bf_lo(q.y), bf_hi(q.y)}; r1 = (f32x4){bf_lo(q.z), bf_hi(q.z), bf_lo(q.w), bf_hi(q.w)}; }
                    const f32x4 v0 = r0 + acc[ai][bj][m][0] * mul, v1 = r1 + acc[ai][bj][m][1] * mul;
                    ss += ((v0[0] * v0[0] + v0[1] * v0[1]) + (v0[2] * v0[2] + v0[3] * v0[3])) + ((v1[0] * v1[0] + v1[1] * v1[1]) + (v1[2] * v1[2] + v1[3] * v1[3]));
                    u32x4 w; w.x = cvt_pk_bf16(v0[0], v0[1]); w.y = cvt_pk_bf16(v0[2], v0[3]); w.z = cvt_pk_bf16(v1[0], v1[1]); w.w = cvt_pk_bf16(v1[2], v1[3]);
                    *(u32x4*)(H + off + bj * HALF) = w; }
                ss += shx<16>(ss); ss = sum32(ss);
                if (fq == 0) ssq[(size_t)ro * 16 + u.pn * 4 + wc] = ss; }
    }
};
struct EpiIn {
    static constexpr bool PERM = true, AFTER_DRAIN = false;
    bf16_t *U, *Bb, *Q, *Kb, *V, *SGC, *SGA; const float* ropec; const float* ropes; float* kbar; float qscale;
    __device__ __forceinline__ void operator()(const AccT& acc, const Unit& u, int wr, int wc, int fr, int fq) const {
        { int t_ = threadIdx.x; asm volatile("" : "+v"(t_)); fr = t_ & 15; fq = (t_ >> 4) & 3; }
        const int pn = u.pn; const int row0 = u.pm * BM + wr * 64 + fr;
        if (pn < 4) {
            const int c0 = 128 * pn + 16 * wc + 4 * fq;
#pragma unroll
            for (int ai = 0; ai < 2; ++ai)
#pragma unroll
                for (int m = 0; m < 4; ++m) { int ro = row0 + ai * HALF + m * 16; asm volatile("" : "+v"(ro)); bf16_t* rowp = U + (size_t)ro * 512 + c0;
#pragma unroll
                    for (int bj = 0; bj < 2; ++bj) { const f32x4 x = acc[ai][bj][m][0] * acc[ai][bj][m][1]; u32x2 w; w.x = cvt_pk_bf16(x[0], x[1]); w.y = cvt_pk_bf16(x[2], x[3]); *(u32x2*)(rowp + bj * 64) = w; } }
        } else if (pn < 6 || (pn >= 10 && pn < 12)) {
            bf16_t* O = pn < 6 ? Bb : V; const int col0 = (pn < 6 ? pn - 4 : pn - 10) * BM + wc * 32 + 8 * fq;
#pragma unroll
            for (int ai = 0; ai < 2; ++ai)
#pragma unroll
                for (int m = 0; m < 4; ++m) { int ro = row0 + ai * HALF + m * 16; asm volatile("" : "+v"(ro)); bf16_t* rowp = O + (size_t)ro * 512 + col0;
#pragma unroll
                    for (int bj = 0; bj < 2; ++bj) { const f32x4 v0 = acc[ai][bj][m][0], v1 = acc[ai][bj][m][1];
                        u32x4 w; w.x = cvt_pk_bf16(v0[0], v0[1]); w.y = cvt_pk_bf16(v0[2], v0[3]); w.z = cvt_pk_bf16(v1[0], v1[1]); w.w = cvt_pk_bf16(v1[2], v1[3]);
                        *(u32x4*)(rowp + bj * HALF) = w; } }
        } else if (pn < 10) {
            const bool isk = pn >= 8; bf16_t* O = isk ? Kb : Q; const int colt = (isk ? pn - 8 : pn - 6) * BM + wc * 32 + 8 * fq;
            const int g4 = 4 * (4 * (wc & 1) + fq);
            const float sc = isk ? 1.f : qscale;
            f32x4 cs0[2] = {(f32x4){0.f, 0.f, 0.f, 0.f}, (f32x4){0.f, 0.f, 0.f, 0.f}}, cs1[2] = {(f32x4){0.f, 0.f, 0.f, 0.f}, (f32x4){0.f, 0.f, 0.f, 0.f}};
#pragma unroll
            for (int ai = 0; ai < 2; ++ai)
#pragma unroll
                for (int m = 0; m < 4; ++m) { int row = row0 + ai * HALF + m * 16; asm volatile("" : "+v"(row)); const int pos = row & 2047;
                    const f32x4 c = *(const f32x4*)(ropec + pos * 32 + g4) * sc, s = *(const f32x4*)(ropes + pos * 32 + g4) * sc;
                    bf16_t* rowp = O + (size_t)row * 512 + colt;
#pragma unroll
                    for (int bj = 0; bj < 2; ++bj) { const f32x4 x1 = acc[ai][bj][m][0], x2 = acc[ai][bj][m][1]; const f32x4 o1 = x1 * c - x2 * s, o2 = x2 * c + x1 * s;
                        cs0[bj] += o1; cs1[bj] += o2;
                        u32x4 w; w.x = cvt_pk_bf16(o1[0], o1[1]); w.y = cvt_pk_bf16(o1[2], o1[3]); w.z = cvt_pk_bf16(o2[0], o2[1]); w.w = cvt_pk_bf16(o2[2], o2[3]);
                        *(u32x4*)(rowp + bj * HALF) = w; }
                    asm volatile("" : "+v"(cs0[0]), "+v"(cs0[1]), "+v"(cs1[0]), "+v"(cs1[1]) :: "memory"); }
            if (isk) {
#pragma unroll
                for (int bj = 0; bj < 2; ++bj)
#pragma unroll
                    for (int j = 0; j < 4; ++j) { float a = cs0[bj][j], b = cs1[bj][j];
                        a += shx<1>(a); b += shx<1>(b); a += shx<2>(a); b += shx<2>(b); a += shx<4>(a); b += shx<4>(b); a += shx<8>(a); b += shx<8>(b);
                        if (fr == 0) { const int pc = (pn - 8) * BM + bj * HALF + wc * 32 + 8 * fq;
                            float* kb = kbar + (size_t)u.pm * 512 + pc; atomicAdd(kb + j, a); atomicAdd(kb + 4 + j, b); } }
            }
        } else {
            bf16_t* O = pn < 16 ? SGC : SGA; const int col0 = (pn < 16 ? pn - 12 : pn - 16) * BM + wc * 32 + 8 * fq;
#pragma unroll
            for (int ai = 0; ai < 2; ++ai)
#pragma unroll
                for (int m = 0; m < 4; ++m) { int ro = row0 + ai * HALF + m * 16; asm volatile("" : "+v"(ro)); bf16_t* rowp = O + (size_t)ro * 1024 + col0;
#pragma unroll
                    for (int bj = 0; bj < 2; ++bj) { f32x4 v0 = acc[ai][bj][m][0], v1 = acc[ai][bj][m][1];
#pragma unroll
                        for (int j = 0; j < 4; ++j) { v0[j] = __builtin_amdgcn_rcpf(1.f + __expf(-v0[j])); v1[j] = __builtin_amdgcn_rcpf(1.f + __expf(-v1[j])); }
                        u32x4 w; w.x = cvt_pk_bf16(v0[0], v0[1]); w.y = cvt_pk_bf16(v0[2], v0[3]); w.z = cvt_pk_bf16(v1[0], v1[1]); w.w = cvt_pk_bf16(v1[2], v1[3]);
                        *(u32x4*)(rowp + bj * HALF) = w; }
                    asm volatile("" ::: "memory"); }
        }
    }
};
struct EpiSoftmax {
    static constexpr bool PERM = true, AFTER_DRAIN = true;
    bf16_t* O; int ldc; float scale_log2;
    __device__ __forceinline__ void fused(AccT& acc, const Unit& u, int wr, int wc, int fr, int fq, PG8_LAS unsigned char* lds, int wid, int lane) const {
        { int t_ = threadIdx.x; asm volatile("" : "+v"(t_)); fr = t_ & 15; fq = (t_ >> 4) & 3; }
        PG8_LAS f32x2* X = (PG8_LAS f32x2*)lds;
        float mx[2][4];
#pragma unroll
        for (int ai = 0; ai < 2; ++ai)
#pragma unroll
            for (int m = 0; m < 4; ++m) { float a = -3.0e38f;
#pragma unroll
                for (int bj = 0; bj < 2; ++bj)
#pragma unroll
                    for (int n = 0; n < 2; ++n) { acc[ai][bj][m][n] = acc[ai][bj][m][n] * scale_log2; const f32x4 x = acc[ai][bj][m][n]; a = fmaxf(fmaxf(a, fmaxf(x[0], x[1])), fmaxf(x[2], x[3])); }
                a = fmaxf(a, shx<16>(a)); a = max32(a); mx[ai][m] = a;
                float s = 0.f;
#pragma unroll
                for (int bj = 0; bj < 2; ++bj)
#pragma unroll
                    for (int n = 0; n < 2; ++n) { f32x4 x = acc[ai][bj][m][n];
#pragma unroll
                        for (int j = 0; j < 4; ++j) { x[j] = __builtin_amdgcn_exp2f(x[j] - a); s += x[j]; }
                        acc[ai][bj][m][n] = x; }
                s += shx<16>(s); s = sum32(s);
                if (fq == 0) X[(ai * HALF + wr * 64 + m * 16 + fr) * 4 + wc] = (f32x2){a, s};
            }
        asm volatile("s_waitcnt lgkmcnt(0)" ::: "memory"); __builtin_amdgcn_s_barrier(); asm volatile("" ::: "memory");
        const int row0 = u.pm * BM + wr * 64 + fr, col0 = u.pn * BM + wc * 32 + 8 * fq;
#pragma unroll
        for (int ai = 0; ai < 2; ++ai)
#pragma unroll
            for (int m = 0; m < 4; ++m) { const int r = ai * HALF + wr * 64 + m * 16 + fr;
                const f32x2 e0 = X[r * 4 + 0], e1 = X[r * 4 + 1], e2 = X[r * 4 + 2], e3 = X[r * 4 + 3];
                const float M = fmaxf(fmaxf(e0.x, e1.x), fmaxf(e2.x, e3.x));
                const float L = e0.y * __builtin_amdgcn_exp2f(e0.x - M) + e1.y * __builtin_amdgcn_exp2f(e1.x - M) + e2.y * __builtin_amdgcn_exp2f(e2.x - M) + e3.y * __builtin_amdgcn_exp2f(e3.x - M);
                const float f = __builtin_amdgcn_exp2f(mx[ai][m] - M) * __builtin_amdgcn_rcpf(L);
                bf16_t* rowp = O + (size_t)(row0 + ai * HALF + m * 16) * ldc + col0;
#pragma unroll
                for (int bj = 0; bj < 2; ++bj) { const f32x4 v0 = acc[ai][bj][m][0] * f, v1 = acc[ai][bj][m][1] * f;
                    u32x4 w; w.x = cvt_pk_bf16(v0[0], v0[1]); w.y = cvt_pk_bf16(v0[2], v0[3]); w.z = cvt_pk_bf16(v1[0], v1[1]); w.w = cvt_pk_bf16(v1[2], v1[3]);
                    *(u32x4*)(rowp + bj * HALF) = w; } }
        asm volatile("s_waitcnt lgkmcnt(0)" ::: "memory"); __builtin_amdgcn_s_barrier(); asm volatile("" ::: "memory");
    }
};
}
namespace attn_body {
using bf16=__hip_bfloat16;
using bf16x8=__attribute__((ext_vector_type(8)))short;
using s16x4=__attribute__((ext_vector_type(4)))short;
using f32x16=__attribute__((ext_vector_type(16)))float;
using u32x4=__attribute__((ext_vector_type(4)))unsigned;
constexpr int BATCH=16,NHEAD=8,SEQ=2048,D=64,DM=NHEAD*D;
constexpr int NW=8,QBLK=32,QB=QBLK*NW,KVBLK=64,NQB=SEQ/QB;
constexpr int ATTN_PITCH=DM, ATTN_UNIT_ROWS=QB;
__device__ __forceinline__ int crow(int r,int hi){return (r&3)+8*(r>>2)+4*hi;}
#define SBAR() __builtin_amdgcn_sched_barrier(0)
__device__ __forceinline__ void cmask(f32x16&p0,f32x16&p1,int jb,int qrel,int hi){
  const float NEG=-INFINITY; int kb=64*jb+4*hi;
  #pragma unroll
  for(int r=0;r<16;++r){int kv=kb+(r&3)+8*(r>>2); if(kv>qrel)p0[r]=NEG; if(kv+32>qrel)p1[r]=NEG;}
}

constexpr int NSLOT=3, SLOTB=8192;
constexpr int LDS_K=0, LDS_V=NSLOT*SLOTB, LDS_WS=2*NSLOT*SLOTB, LDS_OST=LDS_WS+NW*64*4, LDS_SEL=LDS_OST+NW*4096, LDS_BYTES=LDS_SEL+NW*64*4;
constexpr float C2=0.125f*1.4426950408889634f;
__device__ __forceinline__ void glds16(const void*gsrc,unsigned lds_dst){unsigned keep;
  asm volatile("s_mov_b32 %0, m0\n\ts_mov_b32 m0, %2\n\ts_nop 0\n\tglobal_load_lds_dwordx4 %1, off\n\ts_mov_b32 m0, %0":"=&s"(keep):"v"(gsrc),"s"(lds_dst):"memory");}
__device__ __forceinline__ float max3f(float a,float b,float c){float r;asm("v_max3_f32 %0, %1, %2, %3":"=v"(r):"v"(a),"v"(b),"v"(c));return r;}
__device__ __forceinline__ float max2f(float a,float b){float r;asm("v_max_f32_e32 %0, %1, %2":"=v"(r):"v"(a),"v"(b));return r;}
__device__ __forceinline__ float fadd_s(float a,float b){float r;asm("v_add_f32_e32 %0, %1, %2":"=v"(r):"v"(a),"v"(b));return r;}
__device__ __forceinline__ float fsub_s(float a,float b){float r;asm("v_sub_f32_e32 %0, %1, %2":"=v"(r):"v"(a),"v"(b));return r;}
typedef float f32x2_t __attribute__((ext_vector_type(2))); typedef __bf16 bf16x2_t __attribute__((ext_vector_type(2)));
__device__ __forceinline__ unsigned cvtpk_s(float lo,float hi){f32x2_t v={lo,hi};bf16x2_t b=__builtin_convertvector(v,bf16x2_t);return __builtin_bit_cast(unsigned,b);}
#define WAIT_BAR(N) asm volatile("s_waitcnt vmcnt(" #N ") lgkmcnt(0)\n\ts_barrier":::"memory")

__device__ __forceinline__ void qkt(f32x16&p0,f32x16&p1,const char*Kslot,const bf16x8*qr,const f32x16&negm,int r32,int hi){
  const char*kb=Kslot+hi*1024+r32*16;
  #pragma unroll
  for(int d0=0;d0<4;++d0){
    const bf16x8 b0=*reinterpret_cast<const bf16x8*>(kb+d0*2048);
    const bf16x8 b1=*reinterpret_cast<const bf16x8*>(kb+d0*2048+512);
    if(d0==0){p0=__builtin_amdgcn_mfma_f32_32x32x16_bf16(b0,qr[0],negm,0,0,0);p1=__builtin_amdgcn_mfma_f32_32x32x16_bf16(b1,qr[0],negm,0,0,0);}
    else{p0=__builtin_amdgcn_mfma_f32_32x32x16_bf16(b0,qr[d0],p0,0,0,0);p1=__builtin_amdgcn_mfma_f32_32x32x16_bf16(b1,qr[d0],p1,0,0,0);}}
}
typedef __attribute__((address_space(3))) const char* lds_cptr;
typedef short v4i16_t __attribute__((ext_vector_type(4)));
__device__ __forceinline__ void kload8(bf16x8*kf,lds_cptr kp){
  kf[0]=*(const __attribute__((address_space(3))) bf16x8*)(kp);      kf[1]=*(const __attribute__((address_space(3))) bf16x8*)(kp+512);
  kf[2]=*(const __attribute__((address_space(3))) bf16x8*)(kp+2048); kf[3]=*(const __attribute__((address_space(3))) bf16x8*)(kp+2560);
  kf[4]=*(const __attribute__((address_space(3))) bf16x8*)(kp+4096); kf[5]=*(const __attribute__((address_space(3))) bf16x8*)(kp+4608);
  kf[6]=*(const __attribute__((address_space(3))) bf16x8*)(kp+6144); kf[7]=*(const __attribute__((address_space(3))) bf16x8*)(kp+6656);
}
__device__ __forceinline__ void kload2(bf16x8*kf,lds_cptr kp,int j){ kf[2*j]=*(const __attribute__((address_space(3))) bf16x8*)(kp+j*2048); kf[2*j+1]=*(const __attribute__((address_space(3))) bf16x8*)(kp+j*2048+512); }
__device__ __forceinline__ s16x4 vtr(lds_cptr p){ return __builtin_bit_cast(s16x4,__builtin_amdgcn_ds_read_tr16_b64_v4i16((__attribute__((address_space(3))) v4i16_t*)p)); }
__device__ __forceinline__ float rowmax(const f32x16&p0,const f32x16&p1){
  float a=max3f(p0[0],p0[1],p1[0]),b=max3f(p0[2],p0[3],p1[1]);a=max3f(a,p1[2],p1[3]);
  #pragma unroll
  for(int r=4;r<16;r+=4){a=max3f(a,p0[r],p0[r+1]);b=max3f(b,p0[r+2],p0[r+3]);a=max3f(a,p1[r],p1[r+1]);b=max3f(b,p1[r+2],p1[r+3]);}
  const float m=max2f(a,b);
  auto rr=__builtin_amdgcn_permlane32_swap(__float_as_uint(m),__float_as_uint(m),false,false);
  return max2f(__uint_as_float(rr[0]),__uint_as_float(rr[1]));
}
__device__ __forceinline__ void pv(f32x16*o,int vb,bf16x8 pa0,bf16x8 pa1,bf16x8 pa2,bf16x8 pa3){
  #pragma unroll
  for(int d0=0;d0<2;++d0){s16x4 lo[4],hi[4];
    #pragma unroll
    for(int ks=0;ks<4;++ks){
      asm volatile("ds_read_b64_tr_b16 %0,%1 offset:%c2":"=&v"(lo[ks]):"v"(vb),"i"(d0*4096+ks*1024):"memory");
      asm volatile("ds_read_b64_tr_b16 %0,%1 offset:%c2":"=&v"(hi[ks]):"v"(vb),"i"(d0*4096+ks*1024+512):"memory");}
    asm volatile("s_waitcnt lgkmcnt(0)":::"memory");SBAR();
    #define PK(k) (bf16x8){lo[k][0],lo[k][1],lo[k][2],lo[k][3],hi[k][0],hi[k][1],hi[k][2],hi[k][3]}
    o[d0]=__builtin_amdgcn_mfma_f32_32x32x16_bf16(pa0,PK(0),o[d0],0,0,0);
    o[d0]=__builtin_amdgcn_mfma_f32_32x32x16_bf16(pa1,PK(1),o[d0],0,0,0);
    o[d0]=__builtin_amdgcn_mfma_f32_32x32x16_bf16(pa2,PK(2),o[d0],0,0,0);
    o[d0]=__builtin_amdgcn_mfma_f32_32x32x16_bf16(pa3,PK(3),o[d0],0,0,0);
    #undef PK
  }
}

#ifndef ATTN_STORE16
#define ATTN_STORE16(p,v) (*(u32x4*)(p)=(v))
#endif
template<int THRL> __device__ __forceinline__ void attn_unit(int b,int h,int qb,const bf16*Q,const bf16*__restrict__ K,const bf16*__restrict__ V,bf16*O,const float*__restrict__ kbar,char*shm){
  int tid=threadIdx.x; asm volatile("":"+v"(tid)); const int lane=tid&63,r32=lane&31,hi=lane>>5; const int wid=__builtin_amdgcn_readfirstlane(tid>>6);
  const long rowbase=(long)b*SEQ; const int q0=qb*QB;
  const bf16*Qw=Q+(rowbase+q0+wid*QBLK)*DM+h*D;
  const bf16*Kh=K+rowbase*DM+h*D,*Vh=V+rowbase*DM+h*D;
  const unsigned lds0=(unsigned)(uintptr_t)shm;
  float*wsf=(float*)(shm+LDS_WS)+wid*64;
  const bf16*ksrc=Kh+(long)lane*DM+wid*8;
  const bf16*vsrc=Vh+(long)(16*(wid&3)+(lane>>2))*DM+(wid>>2)*32+(lane&3)*8;
  const unsigned kdst=lds0+LDS_K+wid*1024, vdst=lds0+LDS_V+wid*1024;
  #define DMA_K(t,slot) glds16(ksrc+(long)(t)*KVBLK*DM,(unsigned)__builtin_amdgcn_readfirstlane(kdst+(slot)))
  #define DMA_V(t,slot) glds16(vsrc+(long)(t)*KVBLK*DM,(unsigned)__builtin_amdgcn_readfirstlane(vdst+(slot)))
  const int vb0=(int)(lds0+LDS_V)+((lane>>4)&1)*32+(lane&3)*8+(4*hi+((lane&15)>>2))*64;
  const char*Kbase=shm+LDS_K; bf16x8 kf[8];
  const lds_cptr shm3=(lds_cptr)shm; const lds_cptr kp0=shm3+LDS_K+hi*1024+r32*16; const lds_cptr vp0=shm3+LDS_V+((lane>>4)&1)*32+(lane&3)*8+(4*hi+((lane&15)>>2))*64;
  const int NT=(q0+QB)/KVBLK;
  DMA_K(0,0);DMA_V(0,0);DMA_K(1,SLOTB);
  bf16x8 qr[4];
  #pragma unroll
  for(int d0=0;d0<4;++d0)qr[d0]=*reinterpret_cast<const bf16x8*>(&Qw[(long)r32*DM+d0*16+hi*8]);
  int selm=0;
  if(qb>0){
    float g[7]; int hi8=8*hi; asm volatile("":"+v"(hi8)); const float*kb=kbar+(size_t)(b*8)*512+h*64+hi8;
    #pragma unroll
    for(int n=0;n<7;++n){ float a=0.f;
      if(n<qb){
        #pragma unroll
        for(int d0=0;d0<4;++d0){ const float4 k0=*(const float4*)(kb+n*512+16*d0),k1=*(const float4*)(kb+n*512+16*d0+4); const bf16x8 qq=qr[d0];
          #define QF(e) __uint_as_float(((unsigned)(unsigned short)qq[e])<<16)
          a+=QF(0)*k0.x+QF(1)*k0.y+QF(2)*k0.z+QF(3)*k0.w+QF(4)*k1.x+QF(5)*k1.y+QF(6)*k1.z+QF(7)*k1.w;
          #undef QF
        } }
      a=::sum32(a); g[n]=(n<qb)?a:-INFINITY; asm volatile("":"+v"(g[n])::"memory"); }
    #pragma unroll
    for(int r=0;r<3;++r){ int best=-1; float bv=-INFINITY;
      #pragma unroll
      for(int n=0;n<7;++n) if(!((selm>>n)&1)&&g[n]>bv){bv=g[n];best=n;}
      if(best>=0)selm|=1<<best; }
  }
  selm|=1<<qb;
  typedef __attribute__((address_space(3))) int* lds_iptr;
  ((lds_iptr)(shm3+LDS_SEL))[tid]=selm;
  #define CURNEG(blk) ({ int t_=threadIdx.x; asm volatile("":"+v"(t_)); const int sm_=((lds_iptr)(shm3+LDS_SEL))[t_]; ((sm_>>(blk))&1)?0.f:-INFINITY; })
  #define NEGUPD(t) do{ if((((t)+1)&3)==0){ const float cn_=CURNEG(((t)+1)>>2); _Pragma("unroll") for(int r=0;r<16;++r)negm[r]=cn_-mhat; asm volatile("":"+v"(negm)); } }while(0)
  float mhat=0.f,l_reg=0.f;f32x16 o[2];o[0]=f32x16{};o[1]=f32x16{};f32x16 negm; { const float cn_=CURNEG(0); _Pragma("unroll") for(int r=0;r<16;++r)negm[r]=cn_; } asm volatile("":"+v"(negm));
  const int qrel=wid*QBLK+r32;
  #define CMASK(P0,P1,t) do{int jb_=(t)-(NT-4); if(jb_>=0)cmask(P0,P1,jb_,qrel,hi);}while(0)
  bool resc=false;
  #define START(P0,P1) do{ const float rm=rowmax(P0,P1); resc=false; \
    { const float dl=__builtin_fmaxf(rm,-24.f); mhat=fadd_s(mhat,dl); \
      _Pragma("unroll") for(int r=0;r<16;++r){P0[r]=fsub_s(P0[r],dl);P1[r]=fsub_s(P1[r],dl);} \
      { const float cn_=CURNEG(0); _Pragma("unroll") for(int r=0;r<16;++r)negm[r]=cn_-mhat; } asm volatile("":"+v"(negm)); } \
    _Pragma("unroll") for(int r=0;r<16;++r)P0[r]=__builtin_amdgcn_exp2f(P0[r]); }while(0)
  #define RESC() do{ if(resc){ asm volatile("s_waitcnt lgkmcnt(0)":::"memory"); \
      _Pragma("unroll") for(int d_=0;d_<2;++d_) _Pragma("unroll") for(int r=0;r<16;++r)o[d_][r]*=wsf[crow(r,hi)]; } }while(0)
  f32x16 pA0,pA1,pB0,pB1;
  int sl_prev=0,sl_cur=0,sl_next=SLOTB;
  #define ROT() do{sl_prev=sl_cur;sl_cur=sl_next;sl_next=(sl_next==(NSLOT-1)*SLOTB)?0:sl_next+SLOTB;}while(0)
  DMA_K(2,2*SLOTB);
  WAIT_BAR(3);
  qkt(pA0,pA1,Kbase,qr,negm,r32,hi);asm volatile("s_nop 15\n\ts_nop 7":"+v"(pA0),"+v"(pA1));CMASK(pA0,pA1,0);
  START(pA0,pA1);
  _Pragma("unroll") for(int r=0;r<16;++r)pA1[r]=__builtin_amdgcn_exp2f(pA1[r]);
  WAIT_BAR(0);
  DMA_K(3,0);DMA_V(1,SLOTB);
  ROT();
  kload8(kf,kp0+sl_cur);
  WAIT_BAR(2);
  s16x4 vlo[8],vhi[8]; u32x4 pw0,pw1,pw2,pw3;
  #define PKW(P,B) cvtpk_s(P[B],P[B+1])
  #define PAF(k) __builtin_bit_cast(bf16x8,pw##k)
  #define VFR(i) (bf16x8){vlo[i][0],vlo[i][1],vlo[i][2],vlo[i][3],vhi[i][0],vhi[i][1],vhi[i][2],vhi[i][3]}
  #define PIN(x) asm volatile("":"+v"(x))
  #define MX3(a,b,c) __builtin_fmaxf(__builtin_fmaxf((a),(b)),(c))
  #define GAPA(MF,A0,A1,A2,A3,W0,W1,PW) do{ MF; sacc+=A0; sacc+=A1; sacc+=A2; sacc+=A3; PIN(sacc); W0; W1; PIN(PW); SBAR(); }while(0)
  #define EX(v) __builtin_amdgcn_exp2f(v)
  #define GAPB(MF,X,B) do{ MF; X[B]=EX(X[B]); X[B+1]=EX(X[B+1]); X[B+2]=EX(X[B+2]); X[B+3]=EX(X[B+3]); PIN(X); SBAR(); }while(0)
  #define VRD(i) do{ vlo[i]=vtr(vp_+(((i)>>2)*4096+((i)&3)*1024)); vhi[i]=vtr(vp_+(((i)>>2)*4096+((i)&3)*1024+512)); }while(0)
  #define KRD(G,j) do{ if(G){ kload2(kf,kp0+sl_next,j); SBAR(); } }while(0)
  #define STEP(C0,C1,P0,P1,t,GK,GV,GL) do{ SBAR(); \
    const lds_cptr vp_=vp0+sl_prev; \
    VRD(0); SBAR(); float sacc=(P0[0]+P0[1]); \
    GAPA(C0=__builtin_amdgcn_mfma_f32_32x32x16_bf16(kf[0],qr[0],negm,0,0,0), P0[2],P0[3],P0[4],P0[5],     pw0[0]=PKW(P0,0), pw0[1]=PKW(P0,2), pw0); \
    VRD(4); SBAR(); GAPA(C1=__builtin_amdgcn_mfma_f32_32x32x16_bf16(kf[1],qr[0],negm,0,0,0), P0[6],P0[7],P0[8],P0[9],     pw0[2]=PKW(P0,4), pw0[3]=PKW(P0,6), pw0); \
    VRD(1); SBAR(); GAPA(C0=__builtin_amdgcn_mfma_f32_32x32x16_bf16(kf[2],qr[1],C0,0,0,0),   P0[10],P0[11],P0[12],P0[13], pw1[0]=PKW(P0,8), pw1[1]=PKW(P0,10), pw1); \
    VRD(5); SBAR(); GAPA(C1=__builtin_amdgcn_mfma_f32_32x32x16_bf16(kf[3],qr[1],C1,0,0,0),   P0[14],P0[15],P1[0],P1[1],   pw1[2]=PKW(P0,12),pw1[3]=PKW(P0,14), pw1); \
    VRD(2); SBAR(); GAPA(C0=__builtin_amdgcn_mfma_f32_32x32x16_bf16(kf[4],qr[2],C0,0,0,0),   P1[2],P1[3],P1[4],P1[5],     pw2[0]=PKW(P1,0), pw2[1]=PKW(P1,2), pw2); \
    VRD(6); SBAR(); GAPA(C1=__builtin_amdgcn_mfma_f32_32x32x16_bf16(kf[5],qr[2],C1,0,0,0),   P1[6],P1[7],P1[8],P1[9],     pw2[2]=PKW(P1,4), pw2[3]=PKW(P1,6), pw2); \
    VRD(3); SBAR(); GAPA(C0=__builtin_amdgcn_mfma_f32_32x32x16_bf16(kf[6],qr[3],C0,0,0,0),   P1[10],P1[11],P1[12],P1[13], pw3[0]=PKW(P1,8), pw3[1]=PKW(P1,10), pw3); \
    VRD(7); SBAR(); GAPA(C1=__builtin_amdgcn_mfma_f32_32x32x16_bf16(kf[7],qr[3],C1,0,0,0),   P1[14],P1[15],0.f,0.f,       pw3[2]=PKW(P1,12),pw3[3]=PKW(P1,14), pw3); \
    l_reg+=sacc; \
    if(GK){DMA_K((t)+3,sl_cur);} if(GV){DMA_V((t)+1,sl_next);} \
    CMASK(C0,C1,t); \
    { float a=MX3(C0[0],C0[1],C1[0]),b=MX3(C0[2],C0[3],C1[1]); a=MX3(a,C1[2],C1[3]); \
      _Pragma("unroll") for(int r=4;r<16;r+=4){a=MX3(a,C0[r],C0[r+1]);b=MX3(b,C0[r+2],C0[r+3]);a=MX3(a,C1[r],C1[r+1]);b=MX3(b,C1[r+2],C1[r+3]);} \
      float rm=__builtin_fmaxf(a,b); { auto rr=__builtin_amdgcn_permlane32_swap(__float_as_uint(rm),__float_as_uint(rm),false,false); rm=__builtin_fmaxf(__uint_as_float(rr[0]),__uint_as_float(rr[1])); } \
      resc=false; \
      if(__builtin_expect(__any(rm>(float)THRL),0)){ const float dl=__builtin_fmaxf(rm,0.f); mhat+=dl; \
        _Pragma("unroll") for(int r=0;r<16;++r){C0[r]-=dl;C1[r]-=dl;} \
        { const float cn_=CURNEG(((t)+1)>>2); _Pragma("unroll") for(int r=0;r<16;++r)negm[r]=cn_-mhat; } asm volatile("":"+v"(negm)); \
        const float f=__builtin_amdgcn_exp2f(-dl); l_reg*=f; if(hi==0)wsf[r32]=f; resc=true; } } \
    SBAR(); \
    GAPB(o[0]=__builtin_amdgcn_mfma_f32_32x32x16_bf16(PAF(0),VFR(0),o[0],0,0,0), C0,0); \
    GAPB(o[1]=__builtin_amdgcn_mfma_f32_32x32x16_bf16(PAF(0),VFR(4),o[1],0,0,0), C0,4); \
    KRD(GL,0); GAPB(o[0]=__builtin_amdgcn_mfma_f32_32x32x16_bf16(PAF(1),VFR(1),o[0],0,0,0), C0,8); \
    KRD(GL,1); GAPB(o[1]=__builtin_amdgcn_mfma_f32_32x32x16_bf16(PAF(1),VFR(5),o[1],0,0,0), C0,12); \
    KRD(GL,2); GAPB(o[0]=__builtin_amdgcn_mfma_f32_32x32x16_bf16(PAF(2),VFR(2),o[0],0,0,0), C1,0); \
    KRD(GL,3); GAPB(o[1]=__builtin_amdgcn_mfma_f32_32x32x16_bf16(PAF(2),VFR(6),o[1],0,0,0), C1,4); \
    GAPB(o[0]=__builtin_amdgcn_mfma_f32_32x32x16_bf16(PAF(3),VFR(3),o[0],0,0,0), C1,8); \
    GAPB(o[1]=__builtin_amdgcn_mfma_f32_32x32x16_bf16(PAF(3),VFR(7),o[1],0,0,0), C1,12); \
    }while(0)
  int t=1;
  #undef CMASK
  #define CMASK(P0,P1,t) do{}while(0)
  for(;t+5<NT;t+=2){
    STEP(pB0,pB1,pA0,pA1,t,true,true,true);     WAIT_BAR(2); RESC(); ROT(); NEGUPD(t);
    STEP(pA0,pA1,pB0,pB1,t+1,true,true,true);   WAIT_BAR(2); RESC(); ROT(); NEGUPD(t+1);
  }
  #undef CMASK
  #define CMASK(P0,P1,t) do{int jb_=(t)-(NT-4); if(jb_>=0)cmask(P0,P1,jb_,qrel,hi);}while(0)
  #define ENDW(tt) do{ if((tt)+3<NT){WAIT_BAR(2);} else if((tt)+2<NT){WAIT_BAR(1);} else {WAIT_BAR(0);} }while(0)
  for(;t+1<NT;t+=2){
    STEP(pB0,pB1,pA0,pA1,t,(t+3<NT),(t+1<NT),(t+1<NT));       ENDW(t);   RESC(); ROT(); NEGUPD(t);
    STEP(pA0,pA1,pB0,pB1,t+1,(t+4<NT),(t+2<NT),(t+2<NT));     ENDW(t+1); RESC(); ROT(); NEGUPD(t+1);
  }
  STEP(pB0,pB1,pA0,pA1,NT-1,false,false,false); RESC();
  { float sacc=pB0[0]+pB0[1]; _Pragma("unroll") for(int r=2;r<16;++r)sacc+=pB0[r]; _Pragma("unroll") for(int r=0;r<16;++r)sacc+=pB1[r]; l_reg+=sacc;
    pw0=(u32x4){PKW(pB0,0),PKW(pB0,2),PKW(pB0,4),PKW(pB0,6)};pw1=(u32x4){PKW(pB0,8),PKW(pB0,10),PKW(pB0,12),PKW(pB0,14)};pw2=(u32x4){PKW(pB1,0),PKW(pB1,2),PKW(pB1,4),PKW(pB1,6)};pw3=(u32x4){PKW(pB1,8),PKW(pB1,10),PKW(pB1,12),PKW(pB1,14)};
    SBAR(); pv(o,vb0+sl_cur,PAF(0),PAF(1),PAF(2),PAF(3)); }
  #undef PKW
  #undef PAF
  #undef VFR
  #undef PIN
  #undef MX3
  #undef GAPA
  #undef GAPB
  #undef EX
  #undef VRD
  #undef KRD
  #undef STEP
  #undef ENDW
  {auto rr=__builtin_amdgcn_permlane32_swap(__float_as_uint(l_reg),__float_as_uint(l_reg),false,false);l_reg=__uint_as_float(rr[0])+__uint_as_float(rr[1]);}
  if(hi==0)wsf[32+r32]=l_reg;asm volatile("s_waitcnt lgkmcnt(0)":::"memory");
  float rli[16];
  #pragma unroll
  for(int r=0;r<16;++r)rli[r]=__builtin_amdgcn_rcpf(wsf[32+crow(r,hi)]);
  bf16*Ow=O+(rowbase+q0+wid*QBLK)*DM+h*D;
  { bf16*stg=(bf16*)(shm+LDS_OST)+wid*2048;
    #pragma unroll
    for(int r=0;r<16;++r){const int orow=crow(r,hi);
      #pragma unroll
      for(int d0=0;d0<2;++d0)stg[orow*64+d0*32+r32]=__float2bfloat16(o[d0][r]*rli[r]);}
    asm volatile("s_waitcnt lgkmcnt(0)":::"memory");
    #pragma unroll
    for(int i=0;i<4;++i){const int row=i*8+(lane>>3),ch=lane&7; const u32x4 v=*(const u32x4*)(stg+row*64+ch*8); ATTN_STORE16(Ow+(long)row*DM+ch*8,v);} }
  asm volatile("s_waitcnt lgkmcnt(0)\n\ts_barrier":::"memory");
  #undef DMA_K
  #undef DMA_V
  #undef CMASK
  #undef START
  #undef CURNEG
  #undef NEGUPD
  #undef RESC
  #undef ROT
}
constexpr int ATTN_LDS_BYTES=LDS_BYTES;
struct AttnTensors { const bf16* Q; const bf16* K; const bf16* V; bf16* O; const float* kbar; };
struct AttnUnit { int bh; int qb; };
struct StaticOrder {
  int vcu,G;
  __device__ __forceinline__ explicit StaticOrder(int grid,int block):vcu((grid%8==0)?(block%8)*(grid/8)+block/8:block),G(grid){}
  __device__ __forceinline__ bool next(int i,AttnUnit&u)const{
    if(G==256){ if(i>=4)return false; const int s=vcu&1; u.bh=vcu>>1; u.qb=s?((i==0)?6:(i==1)?1:(i==2)?5:2):((i==0)?7:(i==1)?0:(i==2)?4:3); return true; }
    const int L=i*G+vcu; if(L>=1024)return false; u.bh=L>>3; u.qb=L&7; return true; }
  __device__ __forceinline__ void a_ready(const AttnUnit&)const{}
  __device__ __forceinline__ void done(const AttnUnit&)const{}
};
template<class Sched,int THRL=8> __device__ __forceinline__ void attn_phase(char*lds,const AttnTensors&T,const Sched&S){
  AttnUnit u;
  for(int i=0;S.next(i,u);++i){ S.a_ready(u); attn_unit<THRL>(u.bh/NHEAD,u.bh%NHEAD,u.qb,T.Q,T.K,T.V,T.O,T.kbar,lds); S.done(u); }
}
#undef SBAR
#undef WAIT_BAR
}
constexpr int NWAVES = 8;
constexpr int T = 32768, D = 1024, SEQ = 2048, MEMROWS = 4096, INW = 5120;
constexpr float RMS_EPS = 1e-6f;
constexpr size_t MiB = 1u << 20;
constexpr size_t WS_CTL = 0, CTL_ZERO_BYTES = 2 * MiB, WS_KBAR = 1 * MiB;
constexpr size_t WS_WIN = 2 * MiB, WS_WC = 12 * MiB, WS_WA = 13 * MiB, WS_WM = 14 * MiB, WS_WXQ = 16 * MiB, WS_WXKV = 18 * MiB, WS_WXO = 22 * MiB, WS_MT = 24 * MiB, WS_ROPE = 28 * MiB;
constexpr size_t WS_MEMN = 32 * MiB, WS_KX = 40 * MiB, WS_VXT = 48 * MiB;
constexpr size_t WS_SSQ1 = 30 * MiB, WS_SSQ2 = 56 * MiB;
constexpr size_t WS_A = 64 * MiB;
constexpr size_t WS_YC = 128 * MiB, WS_QO = 160 * MiB, WS_U = 192 * MiB, WS_K = 224 * MiB, WS_V = 256 * MiB;
constexpr size_t WS_SGC = 320 * MiB, WS_SGA = 384 * MiB;
constexpr size_t WS_EIDX = 448 * MiB, WS_GW = 464 * MiB, WS_PW = 480 * MiB, WS_END = 496 * MiB;
constexpr size_t WS_U8 = 288 * MiB, WS_V8T = 304 * MiB, WS_SU = 29 * MiB, WS_SV = 29 * MiB + 512 * 1024;
constexpr size_t WS_QX = 128 * MiB, WS_PM = 192 * MiB, WS_OX = 128 * MiB;
constexpr size_t WS_PO = 128 * MiB;
constexpr size_t WS_SC = 128 * MiB;
constexpr int CW_TMO = 0, CW_BAR = 4096, CW_Q = 8192;
constexpr int RING_OFF = 0, RING_BYTES = 131072;
constexpr int LDSCTL_OFF = RING_BYTES, MISC_OFF = LDSCTL_OFF + 320;
constexpr int LDS_BYTES = 147456;

#define GAS __attribute__((address_space(1)))
#define LAS __attribute__((address_space(3)))
typedef unsigned short bf16;
typedef unsigned v4u __attribute__((ext_vector_type(4)));
typedef unsigned v2u __attribute__((ext_vector_type(2)));
typedef float f32x4 __attribute__((ext_vector_type(4)));
typedef float f32x2v __attribute__((ext_vector_type(2)));
typedef GAS unsigned gu32;
#define RLX_AGENT __ATOMIC_RELAXED, __HIP_MEMORY_SCOPE_AGENT
#define LDS_WAIT() asm volatile("s_waitcnt lgkmcnt(0)" ::: "memory")
#define VM_WAIT() asm volatile("s_waitcnt vmcnt(0)" ::: "memory")
__device__ __forceinline__ unsigned pk2(float lo, float hi) { return pg8::cvt_pk_bf16(lo, hi); }
__device__ __forceinline__ float bflo(unsigned u) { return __uint_as_float(u << 16); }
__device__ __forceinline__ float bfhi(unsigned u) { return __uint_as_float(u & 0xffff0000u); }

#define XB_TMO      128
#define XB_XCNT(j)  (256  + 64 * (j))
#define XB_XSUB(j)  (1280 + 64 * (j))
#define XB_XGEN(j)  (2304 + 64 * (j))
#define XB_TOP      3328
#define XB_TOPGEN   3392
#define XCD_BAR_WORDS 3456
#define XB_SPIN_CAP (1u << 18)
__device__ __forceinline__ unsigned xb_ld(unsigned* p)              { return __hip_atomic_load(p, __ATOMIC_RELAXED, __HIP_MEMORY_SCOPE_AGENT); }
__device__ __forceinline__ unsigned xb_add(unsigned* p, unsigned v) { return __hip_atomic_fetch_add(p, v, __ATOMIC_RELAXED, __HIP_MEMORY_SCOPE_AGENT); }
__device__ __forceinline__ unsigned xb_xcc_id() { return (unsigned)__builtin_amdgcn_s_getreg((3 << 11) | 20) & 0xFu; }
#define XB_SPIN(cond, bar) do { unsigned _sp = 0; while (cond) { __builtin_amdgcn_s_sleep(1); \
    if ((++_sp & 255u) == 0u) { if (xb_ld(&(bar)[XB_TMO])) break; if (_sp > XB_SPIN_CAP) { atomicAdd(&(bar)[XB_TMO], 1u); break; } } } } while (0)
struct XcdBarrier { unsigned* bar; unsigned x; volatile LAS unsigned* st; };
__device__ __forceinline__ XcdBarrier xcd_barrier_post(unsigned* bar, volatile LAS unsigned* st) {
    XcdBarrier b; b.bar = bar; b.x = xb_xcc_id(); b.st = st;
    if (threadIdx.x == 0) (void)xb_add(&bar[XB_XCNT(b.x)], 1u);
    return b;
}
__device__ __forceinline__ void xcd_barrier_complete(unsigned* bar, unsigned x, unsigned& nloc, unsigned& nx) {
    const unsigned G = gridDim.x * gridDim.y * gridDim.z;
    unsigned sum, cnt, mine, sp = 0u;
    for (;;) {
        sum = 0u; cnt = 0u; mine = 0u;
#pragma unroll
        for (unsigned j = 0; j < 16; ++j) { const unsigned c = xb_ld(&bar[XB_XCNT(j)]); sum += c; cnt += (c > 0u) ? 1u : 0u; mine = (j == x) ? c : mine; }
        if (sum == G) break;
        __builtin_amdgcn_s_sleep(1);
        if ((++sp & 255u) == 0u) { if (xb_ld(&bar[XB_TMO])) break; if (sp > XB_SPIN_CAP) { atomicAdd(&bar[XB_TMO], 1u); break; } }
    }
    nloc = mine > 0u ? mine : 1u; nx = cnt > 0u ? cnt : 1u;
}
__device__ __forceinline__ void xcd_barrier(const XcdBarrier& b) {
    asm volatile("s_waitcnt vmcnt(0)" ::: "memory");
    __syncthreads();
    if (threadIdx.x == 0) {
        unsigned* bar = b.bar;
        __builtin_amdgcn_s_waitcnt(0);
        unsigned nloc = b.st[0], nx = b.st[1];
        if (nloc == 0u) { xcd_barrier_complete(bar, b.x, nloc, nx); b.st[0] = nloc; b.st[1] = nx; }
        const unsigned old = xb_add(&bar[XB_XSUB(b.x)], 1u);
        const unsigned gen = old / nloc;
        if (old + 1u == (gen + 1u) * nloc) {
            __builtin_amdgcn_fence(__ATOMIC_RELEASE, "agent");
            asm volatile("s_waitcnt vmcnt(0)" ::: "memory");
            const unsigned og = xb_add(&bar[XB_TOP], 1u);
            const unsigned tg = og / nx;
            if (og + 1u == (tg + 1u) * nx) xb_add(&bar[XB_TOPGEN], 1u);
            else XB_SPIN(xb_ld(&bar[XB_TOPGEN]) == tg, bar);
            __builtin_amdgcn_fence(__ATOMIC_ACQUIRE, "agent");
            xb_add(&bar[XB_XGEN(b.x)], 1u);
            asm volatile("s_waitcnt vmcnt(0)" ::: "memory");
        } else {
            XB_SPIN(xb_ld(&bar[XB_XGEN(b.x)]) == gen, bar);
            __builtin_amdgcn_fence(__ATOMIC_ACQUIRE, "agent");
            asm volatile("s_waitcnt vmcnt(0)" ::: "memory");
        }
    }
    __syncthreads();
}

struct MapId { static __device__ __forceinline__ int src(int j) { return j; } };
struct MapWin {
    static __device__ __forceinline__ int src(int j) {
        if (j < 1024) { const int g8 = j >> 3, i = j & 7; return ((i < 4) ? 0 : 1024) + 4 * g8 + (i & 3); }
        if (j < 1536) return 512 + (j - 1024);
        if (j < 2560) { const int jj = j - 1536, qk = jj >> 9, p = jj & 511, head = p >> 6, pl = p & 63, g = pl >> 3, i = pl & 7; return 1536 + qk * 512 + head * 64 + 4 * g + (i & 3) + 32 * (i >> 2); }
        return j;
    }
};
template <class MAP>
__device__ __forceinline__ void p0_transpose_item(const float* W, int K, int N, int NOUT, bf16* WT, LAS float* scr, int item, int lane, const float* gain = nullptr) {
    const int nblk = NOUT / 32, kb = item / nblk, nb = item % nblk, k0 = 64 * kb, n0 = 32 * nb;
    const int sc = MAP::src(n0 + (lane & 31));
#pragma unroll 8
    for (int i = 0; i < 32; ++i) { const int kk = 2 * i + (lane >> 5); const float gk = gain ? gain[k0 + kk] : 1.f; scr[kk * 33 + (lane & 31)] = W[(size_t)(k0 + kk) * N + sc] * gk; }
    LDS_WAIT(); asm volatile("" ::: "memory");
    const int c = lane & 7;
#pragma unroll
    for (int j = 0; j < 4; ++j) { const int n = (lane >> 3) + 8 * j; const LAS float* s = scr + (8 * c) * 33 + n;
        v4u o; o.x = pk2(s[0 * 33], s[1 * 33]); o.y = pk2(s[2 * 33], s[3 * 33]); o.z = pk2(s[4 * 33], s[5 * 33]); o.w = pk2(s[6 * 33], s[7 * 33]);
        *(GAS v4u*)(WT + (size_t)(n0 + n) * K + k0 + 8 * c) = o; }
    LDS_WAIT(); asm volatile("" ::: "memory");
}
__device__ __forceinline__ void rms_row_to_bf16(const float* xrow, const float* g, bf16* orow, int lane) {
    const GAS f32x4* xr = (const GAS f32x4*)xrow + lane; const GAS f32x4* gr = (const GAS f32x4*)g + lane;
    f32x4 v[4]; float s = 0.f;
#pragma unroll
    for (int j = 0; j < 4; ++j) { v[j] = xr[64 * j]; s += (v[j].x * v[j].x + v[j].y * v[j].y) + (v[j].z * v[j].z + v[j].w * v[j].w); }
    const float r = rsqrtf(wave_sum(s) * (1.f / 1024.f) + RMS_EPS);
    GAS v2u* o8 = (GAS v2u*)orow + lane;
#pragma unroll
    for (int j = 0; j < 4; ++j) { const f32x4 gg = gr[64 * j]; v2u w; w.x = pk2(v[j].x * r * gg.x, v[j].y * r * gg.y); w.y = pk2(v[j].z * r * gg.z, v[j].w * r * gg.w); o8[64 * j] = w; }
}
__device__ __forceinline__ float fmax_asm(float a, float b) { float r; asm("v_max_f32 %0, %1, %2" : "=v"(r) : "v"(a), "v"(b)); return r; }
__device__ __forceinline__ float fmin_asm(float a, float b) { float r; asm("v_min_f32 %0, %1, %2" : "=v"(r) : "v"(a), "v"(b)); return r; }

#ifndef PH_MASK
#define PH_MASK 0xFFFFFFFFu
#endif
#define PH(k) ((PH_MASK >> (k)) & 1u)
#ifndef REP_MASK
#define REP_MASK 0u
#endif
#define NREP(k) (((REP_MASK >> (k)) & 1u) ? 2 : 1)
#ifndef DIAG_TS_A
#define DIAG_TS_A -1
#endif
#ifndef DIAG_TS_B
#define DIAG_TS_B -1
#endif
struct Args { const float* in[19]; float* out; unsigned char* ws; };

struct XOrder {
    const char* A; const char* Bt; int G, c, i0, mode;
    __device__ bool next(int i, pg8::Unit& u) const {
        if (i > 0) return false;
        const int L = i0 * G + c; if (L >= 512) return false;
        const int b = L >> 5, head = (L >> 3) & 3, rt = L & 7;
        u.pm = b * 8 + rt; u.pn = head;
        if (mode == 0) { u.a = A + (size_t)(b * 2048 + rt * 256) * 1024 * 2; u.b = Bt + (size_t)(head * 256) * 1024 * 2; }
        else { u.a = A + ((size_t)(b * 2048 + rt * 256) * 1024 + head * 256) * 2;
               u.b = (mode == 2) ? Bt + ((size_t)(head * 256) * 4096 + b * 256) * 2 : Bt + ((size_t)(b * 256) * 1024 + head * 256) * 2; }
        return true;
    }
};

__global__ void __launch_bounds__(NWAVES * 64, 2) mk_fwd(Args args) {
    extern __shared__ __attribute__((aligned(16))) unsigned char lds[];
    LAS unsigned char* L = (LAS unsigned char*)lds;
    volatile LAS unsigned* MISC = (volatile LAS unsigned*)(L + MISC_OFF);
    const int wave = __builtin_amdgcn_readfirstlane((int)threadIdx.x >> 6);
#define PH_LANES int tid = threadIdx.x; asm volatile("" : "+v"(tid)); const int lane = tid & 63; const int gt = vcu * (NWAVES * 64) + tid; (void)lane; (void)gt
    const int G = gridDim.x; const int bx = blockIdx.x; const int vcu = (G % 8 == 0) ? (bx % 8) * (G / 8) + bx / 8 : bx;
    unsigned char* ws = args.ws;
    gu32* ctl = (gu32*)(ws + WS_CTL);
    for (int u = threadIdx.x; u < (LDS_BYTES - LDSCTL_OFF) / 4; u += NWAVES * 64) ((LAS unsigned*)(L + LDSCTL_OFF))[u] = 0u;
    __syncthreads();
    XcdBarrier bar = xcd_barrier_post((unsigned*)(ctl + CW_BAR), MISC + 8);
    unsigned long long* tsw = (unsigned long long*)(ws + WS_CTL + 65536);
    int n_ts = 0;
#define TSTAMP() do { if (DIAG_TS_A >= 0) { if (bx == 0 && threadIdx.x == 0) tsw[n_ts] = __builtin_amdgcn_s_memrealtime(); ++n_ts; } } while (0)
    TSTAMP();

    const float *x = args.in[0], *mem = args.in[1], *g_mix = args.in[2], *w_in = args.in[3], *w_conv = args.in[4], *w_conv_out = args.in[5], *w_attn_out = args.in[6], *w_merge = args.in[7],
                *g_xattn = args.in[8], *g_mem = args.in[9], *w_xq = args.in[10], *w_xkv = args.in[11], *w_xo = args.in[12], *g_ffn = args.in[13], *w_pq = args.in[14], *sub_keys = args.in[15],
                *peer_u = args.in[16], *peer_v = args.in[17], *g_final = args.in[18];
    float* out = args.out;
    bf16 *WinT = (bf16*)(ws + WS_WIN), *WcT = (bf16*)(ws + WS_WC), *WaT = (bf16*)(ws + WS_WA), *WmT = (bf16*)(ws + WS_WM), *WxqT = (bf16*)(ws + WS_WXQ), *WxkvT = (bf16*)(ws + WS_WXKV),
         *WxoT = (bf16*)(ws + WS_WXO), *MT = (bf16*)(ws + WS_MT);
    float* ropec = (float*)(ws + WS_ROPE); float* ropes = ropec + 2048 * 32;
    float* kbar = (float*)(ws + WS_KBAR);
    bf16 *MEMN = (bf16*)(ws + WS_MEMN), *KX = (bf16*)(ws + WS_KX), *VXT = (bf16*)(ws + WS_VXT), *A = (bf16*)(ws + WS_A);
    bf16 *YC = (bf16*)(ws + WS_YC), *QO = (bf16*)(ws + WS_QO), *U = (bf16*)(ws + WS_U), *KB = (bf16*)(ws + WS_K), *VB = (bf16*)(ws + WS_V), *SGC = (bf16*)(ws + WS_SGC), *SGA = (bf16*)(ws + WS_SGA);
    bf16 *QX = (bf16*)(ws + WS_QX), *PM = (bf16*)(ws + WS_PM), *OX = (bf16*)(ws + WS_OX);
    _Float16* SC = (_Float16*)(ws + WS_SC);
    int* EIDX = (int*)(ws + WS_EIDX); float* GW = (float*)(ws + WS_GW); unsigned* PW = (unsigned*)(ws + WS_PW);
    float* PO = (float*)(ws + WS_PO); float* SSQ1 = (float*)(ws + WS_SSQ1); float* SSQ2 = (float*)(ws + WS_SSQ2); (void)PO;
    unsigned char* U8 = ws + WS_U8; unsigned char* V8T = ws + WS_V8T; float* SU = (float*)(ws + WS_SU); float* SV = (float*)(ws + WS_SV);
    const int gw = vcu * NWAVES + wave, NGW = G * NWAVES;
    const int NGT = G * NWAVES * 64;

    asm volatile("; ===== PHASE 0 =====");
    if (PH(0)) for (int rep = 0; rep < NREP(0); ++rep) {
        PH_LANES; const bool dummy = rep < NREP(0) - 1; (void)dummy;
        LAS float* scr = (LAS float*)(L + RING_OFF + wave * 16384);
        constexpr int I_IN = (1024 / 64) * (5120 / 32), I_C = (512 / 64) * (1024 / 32), I_M = (1024 / 64) * (1024 / 32), I_KV = (1024 / 64) * (2048 / 32);
        constexpr int NITEMS = I_IN + 2 * I_C + 3 * I_M + I_KV;
        for (int it = gw; it < NITEMS; it += NGW) {
            int r = it;
            if (r < I_IN) { p0_transpose_item<MapWin>(w_in, 1024, 5120, 5120, WinT, scr, r, lane); continue; } r -= I_IN;
            if (r < I_C) { p0_transpose_item<MapId>(w_conv_out, 512, 1024, 1024, WcT, scr, r, lane); continue; } r -= I_C;
            if (r < I_C) { p0_transpose_item<MapId>(w_attn_out, 512, 1024, 1024, WaT, scr, r, lane); continue; } r -= I_C;
            if (r < I_M) { p0_transpose_item<MapId>(w_merge, 1024, 1024, 1024, WmT, scr, r, lane); continue; } r -= I_M;
            if (r < I_M) { p0_transpose_item<MapId>(w_xq, 1024, 1024, 1024, WxqT, scr, r, lane, g_xattn); continue; } r -= I_M;
            if (r < I_M) { p0_transpose_item<MapId>(w_xo, 1024, 1024, 1024, WxoT, scr, r, lane); continue; } r -= I_M;
            p0_transpose_item<MapId>(w_xkv, 1024, 2048, 2048, WxkvT, scr, r, lane);
        }
        for (int m = gw; m < T; m += NGW) rms_row_to_bf16(x + (size_t)m * D, g_mix, A + (size_t)m * D, lane);
        for (int m = gw; m < MEMROWS; m += NGW) rms_row_to_bf16(mem + (size_t)m * D, g_mem, MEMN + (size_t)m * D, lane);
        for (int i = gt; i < 2048 * 32; i += NGT) { const int pos = i >> 5, f = i & 31; const float inv = powf(10000.0f, -(float)f / 32.0f); const float ang = (float)pos * inv; ropec[i] = cosf(ang); ropes[i] = sinf(ang); }
        for (int e = gw; e < 16384; e += NGW) {
            const GAS f32x4* r = (const GAS f32x4*)(peer_u + (size_t)e * D) + lane; f32x4 v[4]; float am = 0.f;
#pragma unroll
            for (int j = 0; j < 4; ++j) { v[j] = r[64 * j] * ((const GAS f32x4*)g_ffn + lane)[64 * j]; am = fmaxf(fmaxf(am, fmaxf(fabsf(v[j].x), fabsf(v[j].y))), fmaxf(fabsf(v[j].z), fabsf(v[j].w))); }
            am = wave_max(am);
            const float sc = am > 0.f ? 384.f / am : 1.f; if (lane == 0) SU[e] = am > 0.f ? am * (1.f / 384.f) : 1.f;
#pragma unroll
            for (int j = 0; j < 4; ++j) { int w = __builtin_amdgcn_cvt_pk_fp8_f32(v[j].x * sc, v[j].y * sc, 0, false); w = __builtin_amdgcn_cvt_pk_fp8_f32(v[j].z * sc, v[j].w * sc, w, true);
                *(GAS unsigned*)(U8 + (size_t)e * 1024 + 4 * lane + 256 * j) = (unsigned)w; }
        }
        __syncthreads();
        for (int it = bx; it < 256; it += G) {
            const int e0 = it * 64;
#pragma unroll 1
            for (int rr = 0; rr < 8; ++rr) {
                const int el = wave * 8 + rr, e = e0 + el;
                const GAS f32x4* r = (const GAS f32x4*)(peer_v + (size_t)e * D) + lane; f32x4 v[4]; float am = 0.f;
#pragma unroll
                for (int j = 0; j < 4; ++j) { v[j] = r[64 * j]; am = fmaxf(fmaxf(am, fmaxf(fabsf(v[j].x), fabsf(v[j].y))), fmaxf(fabsf(v[j].z), fabsf(v[j].w))); }
                am = wave_max(am);
                const float sc = am > 0.f ? 384.f / am : 1.f; if (lane == 0) SV[e] = am > 0.f ? am * (1.f / 384.f) : 1.f;
#pragma unroll
                for (int j = 0; j < 4; ++j) { int w = __builtin_amdgcn_cvt_pk_fp8_f32(v[j].x * sc, v[j].y * sc, 0, false); w = __builtin_amdgcn_cvt_pk_fp8_f32(v[j].z * sc, v[j].w * sc, w, true);
                    *(LAS unsigned*)(L + RING_OFF + el * 1024 + 4 * lane + 256 * j) = (unsigned)w; }
            }
            __syncthreads();
#pragma unroll
            for (int i = 0; i < 8; ++i) { const int idx = tid + 512 * i, sl = idx >> 5, k = idx & 31;
                const v2u a0 = *(const LAS v2u*)(L + RING_OFF + (2 * k) * 1024 + sl * 8), a1 = *(const LAS v2u*)(L + RING_OFF + (2 * k + 1) * 1024 + sl * 8);
                *(GAS v4u*)(V8T + ((size_t)sl * 16384 + e0 + 2 * k) * 8) = (v4u){a0.x, a0.y, a1.x, a1.y}; }
            __syncthreads();
        }
        {
            LAS float* skl = (LAS float*)(L + RING_OFF);
            LAS float* wtl = skl + 128 * 129;
            for (int it = bx; it < 256; it += G) {
                const int hp = it >> 4, cb = it & 15;
                for (int i = tid; i < 128 * 128; i += NWAVES * 64) { const int n = i >> 7, d = i & 127; skl[n * 129 + d] = sub_keys[((size_t)hp * 128 + n) * 128 + d]; }
                for (int i = tid; i < 64 * 128; i += NWAVES * 64) { const int c = i >> 7, d = i & 127; wtl[c * 129 + d] = w_pq[(size_t)(cb * 64 + c) * 2048 + hp * 128 + d] * g_ffn[cb * 64 + c]; }
                __syncthreads();
                const int cg = tid & 15, ng = tid >> 4;
                float acc[4][4];
#pragma unroll
                for (int i = 0; i < 4; ++i)
#pragma unroll
                    for (int j = 0; j < 4; ++j) acc[i][j] = 0.f;
                for (int d = 0; d < 128; ++d) {
                    float wv[4], sv[4];
#pragma unroll
                    for (int i = 0; i < 4; ++i) { wv[i] = wtl[(4 * cg + i) * 129 + d]; sv[i] = skl[(4 * ng + i) * 129 + d]; }
#pragma unroll
                    for (int i = 0; i < 4; ++i)
#pragma unroll
                        for (int j = 0; j < 4; ++j) acc[i][j] += sv[i] * wv[j];
                }
#pragma unroll
                for (int i = 0; i < 4; ++i) { v2u w; w.x = pk2(acc[i][0], acc[i][1]); w.y = pk2(acc[i][2], acc[i][3]); *(GAS v2u*)(MT + (size_t)(hp * 128 + 4 * ng + i) * 1024 + cb * 64 + 4 * cg) = w; }
                __syncthreads();
            }
        }
    }
    xcd_barrier(bar); TSTAMP();

    asm volatile("; ===== PHASE 1 =====");
    if (PH(1)) for (int rep = 0; rep < NREP(1); ++rep) {
        PH_LANES; const bool dummy = rep < NREP(1) - 1; (void)dummy;
        pg8::Gemm g{1024, 1024, 1024}; pg8::StaticOrder S; S.init(A, 1024, WinT, 1024, T, INW, G, bx);
        pg8::EpiIn E{U, YC, QO, KB, VB, SGC, SGA, ropec, ropes, kbar, 0.125f * 1.4426950408889634f};
        pg8::gemm_phase<pg8::EpiIn, pg8::StaticOrder, true>(L + RING_OFF, g, S, E);
    }
    if (PH(1)) for (int rep = 0; rep < NREP(1); ++rep) {
        PH_LANES; const bool dummy = rep < NREP(1) - 1; (void)dummy;
        pg8::Gemm g{1024, 1024, 1024}; pg8::StaticOrder S; S.init(MEMN, 1024, WxkvT, 1024, MEMROWS, 1024, G, bx);
        pg8::EpiBf16 E{KX, 1024};
        pg8::gemm_phase<pg8::EpiBf16, pg8::StaticOrder, true>(L + RING_OFF, g, S, E);
    }
    if (PH(1)) for (int rep = 0; rep < NREP(1); ++rep) {
        PH_LANES; const bool dummy = rep < NREP(1) - 1; (void)dummy;
        pg8::Gemm g{1024, 1024, 1024}; pg8::StaticOrder S; S.init(WxkvT + (size_t)1024 * 1024, 1024, MEMN, 1024, 1024, MEMROWS, G, (bx + 128) % G);
        pg8::EpiBf16 E{VXT, 4096};
        pg8::gemm_phase<pg8::EpiBf16, pg8::StaticOrder, true>(L + RING_OFF, g, S, E);
    }
    xcd_barrier(bar); TSTAMP();

    asm volatile("; ===== PHASE 2 =====");
    if (PH(2)) for (int rep = 0; rep < NREP(2); ++rep) {
        PH_LANES; const bool dummy = rep < NREP(2) - 1; (void)dummy;
        for (int i = gt; i < T * 64; i += NGT) {
            const int row = i >> 6, cg = i & 63, s = row & 2047;
            const v4u u0 = *(const GAS v4u*)(U + (size_t)row * 512 + cg * 8);
            v4u u1 = (v4u){0u, 0u, 0u, 0u}, u2 = (v4u){0u, 0u, 0u, 0u};
            if (s >= 1) u1 = *(const GAS v4u*)(U + (size_t)(row - 1) * 512 + cg * 8);
            if (s >= 2) u2 = *(const GAS v4u*)(U + (size_t)(row - 2) * 512 + cg * 8);
            const v4u bq = *(const GAS v4u*)(YC + (size_t)row * 512 + cg * 8);
            const f32x4 w0a = *(const GAS f32x4*)(w_conv + cg * 8), w0b = *(const GAS f32x4*)(w_conv + cg * 8 + 4);
            const f32x4 w1a = *(const GAS f32x4*)(w_conv + 512 + cg * 8), w1b = *(const GAS f32x4*)(w_conv + 512 + cg * 8 + 4);
            const f32x4 w2a = *(const GAS f32x4*)(w_conv + 1024 + cg * 8), w2b = *(const GAS f32x4*)(w_conv + 1024 + cg * 8 + 4);
            v4u o;
#define CONV2(q, wa, ia, ib) pk2(bflo(bq.q) * (w0##wa[ia] * bflo(u2.q) + w1##wa[ia] * bflo(u1.q) + w2##wa[ia] * bflo(u0.q)), bfhi(bq.q) * (w0##wa[ib] * bfhi(u2.q) + w1##wa[ib] * bfhi(u1.q) + w2##wa[ib] * bfhi(u0.q)))
            o.x = CONV2(x, a, 0, 1); o.y = CONV2(y, a, 2, 3); o.z = CONV2(z, b, 0, 1); o.w = CONV2(w, b, 2, 3);
#undef CONV2
            { const bool conv_dummy = (NREP(2) == 2) && !dummy; *(GAS v4u*)(YC + (size_t)row * 512 + cg * 8) = conv_dummy ? bq : o; }
        }
        __syncthreads();
        const attn_body::AttnTensors AT{(const attn_body::bf16*)QO, (const attn_body::bf16*)KB, (const attn_body::bf16*)VB, (attn_body::bf16*)(dummy ? A : QO), kbar};
        const attn_body::StaticOrder S(G, bx);
        attn_body::attn_phase<attn_body::StaticOrder>((char*)lds + RING_OFF, AT, S);
    }
    xcd_barrier(bar); TSTAMP();

    asm volatile("; ===== PHASE 3 =====");
    if (PH(3)) for (int rep = 0; rep < NREP(3); ++rep) {
        PH_LANES; const bool dummy = rep < NREP(3) - 1; (void)dummy;
        pg8::Gemm g{512, 512, 512}; pg8::StaticOrder S; S.init(YC, 512, WcT, 512, T, 1024, G, bx);
        pg8::EpiGateMul E{SGC, dummy ? A : SGC, 1024};
        pg8::gemm_phase<pg8::EpiGateMul, pg8::StaticOrder, true>(L + RING_OFF, g, S, E);
    }
    if (PH(3)) for (int rep = 0; rep < NREP(3); ++rep) {
        PH_LANES; const bool dummy = rep < NREP(3) - 1; (void)dummy;
        pg8::Gemm g{512, 512, 512}; pg8::StaticOrder S; S.init(QO, 512, WaT, 512, T, 1024, G, bx);
        pg8::EpiGateFma E{SGC, SGA, dummy ? A : SGA, 1024};
        pg8::gemm_phase<pg8::EpiGateFma, pg8::StaticOrder, true>(L + RING_OFF, g, S, E);
    }
    xcd_barrier(bar); TSTAMP();

    asm volatile("; ===== PHASE 4 =====");
    if (PH(4)) for (int rep = 0; rep < NREP(4); ++rep) {
        PH_LANES; const bool dummy = rep < NREP(4) - 1; (void)dummy;
        pg8::Gemm g{1024, 1024, 1024}; pg8::StaticOrder S; S.init(SGA, 1024, WmT, 1024, T, 1024, G, bx);
        pg8::EpiResNorm<true> E{x, A, SSQ1, 1024, 1.f};
        pg8::gemm_phase<pg8::EpiResNorm<true>, pg8::StaticOrder, true>(L + RING_OFF, g, S, E);
    }
    xcd_barrier(bar); TSTAMP();

    asm volatile("; ===== PHASE 6 =====");
    if (PH(6)) for (int rep = 0; rep < NREP(6); ++rep) {
        PH_LANES; const bool dummy = rep < NREP(6) - 1; (void)dummy;
        const pg8::Gemm gq{1024, 1024, 1024}, gs{1024, 1024, 256}, gv{1024, 4096, 256};
        const pg8::EpiBf16RS Eq{QX, 1024, SSQ1}; const pg8::EpiSoftmax Es{PM, 1024, 0.0625f * 1.4426950408889634f}; const pg8::EpiBf16 Ev{OX, 1024};
        { XOrder S{(const char*)A, (const char*)WxqT, G, vcu, 0, 0}; pg8::gemm_phase<pg8::EpiBf16RS, XOrder, false>(L + RING_OFF, gq, S, Eq); }
        VM_WAIT(); __syncthreads();
        { XOrder S{(const char*)QX, (const char*)KX, G, vcu, 0, 1}; pg8::gemm_phase<pg8::EpiSoftmax, XOrder, false>(L + RING_OFF, gs, S, Es); }
        VM_WAIT(); __syncthreads();
        { XOrder S{(const char*)PM, (const char*)VXT, G, vcu, 0, 2}; pg8::gemm_phase<pg8::EpiBf16, XOrder, false>(L + RING_OFF, gv, S, Ev); }
        VM_WAIT(); __syncthreads();
        { XOrder S{(const char*)A, (const char*)WxqT, G, vcu, 1, 0}; pg8::gemm_phase<pg8::EpiBf16RS, XOrder, false>(L + RING_OFF, gq, S, Eq); }
        VM_WAIT(); __syncthreads();
        { XOrder S{(const char*)QX, (const char*)KX, G, vcu, 1, 1}; pg8::gemm_phase<pg8::EpiSoftmax, XOrder, false>(L + RING_OFF, gs, S, Es); }
        VM_WAIT(); __syncthreads();
        { XOrder S{(const char*)PM, (const char*)VXT, G, vcu, 1, 2}; pg8::gemm_phase<pg8::EpiBf16, XOrder, false>(L + RING_OFF, gv, S, Ev); }
    }
    xcd_barrier(bar); TSTAMP();

    asm volatile("; ===== PHASE 9 =====");
    if (PH(9)) for (int rep = 0; rep < NREP(9); ++rep) {
        PH_LANES; const bool dummy = rep < NREP(9) - 1; (void)dummy;
        pg8::Gemm g{1024, 1024, 1024}; pg8::StaticOrder S; S.init(OX, 1024, WxoT, 1024, T, 1024, G, bx);
        pg8::EpiResNorm<false> E{nullptr, A, SSQ2, 1024, dummy ? 0.f : 1.f};
        pg8::gemm_phase<pg8::EpiResNorm<false>, pg8::StaticOrder, true>(L + RING_OFF, g, S, E);
    }
    xcd_barrier(bar); TSTAMP();

    asm volatile("; ===== PHASE 11 =====");
    if (PH(11)) for (int rep = 0; rep < NREP(11); ++rep) {
        PH_LANES; const bool dummy = rep < NREP(11) - 1; (void)dummy;
        pg8::Gemm g{1024, 1024, 1024}; pg8::StaticOrder S; S.init(A, 1024, MT, 1024, T, 2048, G, bx);
        pg8::EpiF16RS E{SC, 2048, SSQ2};
        pg8::gemm_phase<pg8::EpiF16RS, pg8::StaticOrder, true>(L + RING_OFF, g, S, E);
    }
    xcd_barrier(bar); TSTAMP();

    asm volatile("; ===== PHASE 12 =====");
    if (PH(12)) for (int rep = 0; rep < NREP(12); ++rep) {
        PH_LANES; const bool dummy = rep < NREP(12) - 1; (void)dummy;
        typedef _Float16 h8 __attribute__((ext_vector_type(8)));
        LAS unsigned char* idl = L + RING_OFF + tid * 32;
        for (int task = gt; task < T * 8; task += NGT) {
            const int t = task >> 3, h = task & 7;
            const _Float16* row = SC + (size_t)t * 2048 + h * 256;
            float LA[16], LB[16];
#pragma unroll
            for (int p = 0; p < 2; ++p) {
                float Lk[16];
#pragma unroll
                for (int k = 0; k < 16; ++k) Lk[k] = -INFINITY;
                for (int c = 0; c < 16; ++c) {
                    const h8 v = *(const h8*)(row + p * 128 + c * 8);
#pragma unroll
                    for (int e = 0; e < 8; ++e) {
                        float key = __uint_as_float(__float_as_uint((float)v[e]) | (unsigned)(c * 8 + e));
#pragma unroll
                        for (int k = 0; k < 16; ++k) { const float hi_ = fmax_asm(Lk[k], key); key = fmin_asm(Lk[k], key); Lk[k] = hi_; }
                    }
                }
#pragma unroll
                for (int k = 0; k < 16; ++k) { if (p == 0) LA[k] = Lk[k]; else LB[k] = Lk[k]; }
            }
#pragma unroll
            for (int k = 0; k < 16; k += 4) {
                ((LAS unsigned*)idl)[k >> 2] = (__float_as_uint(LA[k]) & 127u) | ((__float_as_uint(LA[k + 1]) & 127u) << 8) | ((__float_as_uint(LA[k + 2]) & 127u) << 16) | ((__float_as_uint(LA[k + 3]) & 127u) << 24);
                ((LAS unsigned*)idl)[4 + (k >> 2)] = (__float_as_uint(LB[k]) & 127u) | ((__float_as_uint(LB[k + 1]) & 127u) << 8) | ((__float_as_uint(LB[k + 2]) & 127u) << 16) | ((__float_as_uint(LB[k + 3]) & 127u) << 24);
            }
            float Ck[16];
#pragma unroll
            for (int k = 0; k < 16; ++k) Ck[k] = -INFINITY;
#pragma unroll
            for (int a = 0; a < 16; ++a)
#pragma unroll
                for (int b = 0; b < 16; ++b)
                    if ((a + 1) * (b + 1) <= 16) {
                        float key = __uint_as_float((__float_as_uint(LA[a] + LB[b]) & ~255u) | (unsigned)(a * 16 + b));
#pragma unroll
                        for (int k = 0; k < 16; ++k) { const float hi_ = fmax_asm(Ck[k], key); key = fmin_asm(Ck[k], key); Ck[k] = hi_; }
                    }
            LDS_WAIT();
            float ex[16]; float sum = 0.f;
#pragma unroll
            for (int k = 0; k < 16; ++k) { ex[k] = __expf(Ck[k] - Ck[0]); sum += ex[k]; }
            const float rs = 1.f / sum;
            int* eo = EIDX + (size_t)t * 128 + h * 16;
#pragma unroll
            for (int k = 0; k < 16; k += 4) {
                int ev[4];
#pragma unroll
                for (int j = 0; j < 4; ++j) { const unsigned id = __float_as_uint(Ck[k + j]) & 255u; ev[j] = (int)idl[id >> 4] * 128 + (int)idl[16 + (id & 15u)]; }
                *(GAS v4u*)(eo + k) = (v4u){(pk2(0.f, ex[k] * rs) & 0xffff0000u) | (unsigned)ev[0], (pk2(0.f, ex[k + 1] * rs) & 0xffff0000u) | (unsigned)ev[1],
                                             (pk2(0.f, ex[k + 2] * rs) & 0xffff0000u) | (unsigned)ev[2], (pk2(0.f, ex[k + 3] * rs) & 0xffff0000u) | (unsigned)ev[3]};
            }
            LDS_WAIT();
        }
    }
    xcd_barrier(bar); TSTAMP();

    asm volatile("; ===== PHASE 13 =====");
    if (PH(13)) for (int rep = 0; rep < NREP(13); ++rep) {
        PH_LANES; const bool dummy = rep < NREP(13) - 1; (void)dummy;
        for (int t = gw; t < T; t += NGW) {
            float a[16];
            { const GAS v4u* ar = (const GAS v4u*)(A + (size_t)t * D + 16 * lane); const v4u q0 = ar[0], q1 = ar[1];
              a[0] = bflo(q0.x); a[1] = bfhi(q0.x); a[2] = bflo(q0.y); a[3] = bfhi(q0.y); a[4] = bflo(q0.z); a[5] = bfhi(q0.z); a[6] = bflo(q0.w); a[7] = bfhi(q0.w);
              a[8] = bflo(q1.x); a[9] = bfhi(q1.x); a[10] = bflo(q1.y); a[11] = bfhi(q1.y); a[12] = bflo(q1.z); a[13] = bfhi(q1.z); a[14] = bflo(q1.w); a[15] = bfhi(q1.w); }
            const float rs2 = rsqrtf(wave_sum(lane < 16 ? SSQ2[(size_t)t * 16 + lane] : 0.f) * (1.f / 1024.f) + RMS_EPS);
            const unsigned p0 = (unsigned)EIDX[(size_t)t * 128 + lane], p1 = (unsigned)EIDX[(size_t)t * 128 + 64 + lane];
            const int e0 = (int)(p0 & 0xffffu), e1 = (int)(p1 & 0xffffu);
            const float v0s = SV[e0] * __uint_as_float(p0 & 0xffff0000u), v1s = SV[e1] * __uint_as_float(p1 & 0xffff0000u);
            const float u0s = SU[e0] * rs2, u1s = SU[e1] * rs2;
#pragma unroll 1
            for (int hb = 0; hb < 8; ++hb) {
                const int ev = (hb < 4) ? e0 : e1; const int lb = (hb & 3) * 16;
                v4u q[16];
#pragma unroll
                for (int k = 0; k < 16; ++k) { const int e = __builtin_amdgcn_readlane(ev, lb + k); q[k] = *(const GAS v4u*)(U8 + (size_t)e * 1024 + 16 * lane); }
                float d[16];
#pragma unroll
                for (int k = 0; k < 16; ++k) {
                    const auto f0 = __builtin_amdgcn_cvt_pk_f32_fp8((int)q[k].x, false), f1 = __builtin_amdgcn_cvt_pk_f32_fp8((int)q[k].x, true), f2 = __builtin_amdgcn_cvt_pk_f32_fp8((int)q[k].y, false), f3 = __builtin_amdgcn_cvt_pk_f32_fp8((int)q[k].y, true),
                               f4 = __builtin_amdgcn_cvt_pk_f32_fp8((int)q[k].z, false), f5 = __builtin_amdgcn_cvt_pk_f32_fp8((int)q[k].z, true), f6 = __builtin_amdgcn_cvt_pk_f32_fp8((int)q[k].w, false), f7 = __builtin_amdgcn_cvt_pk_f32_fp8((int)q[k].w, true);
                    d[k] = ((a[0] * f0[0] + a[1] * f0[1]) + (a[2] * f1[0] + a[3] * f1[1])) + ((a[4] * f2[0] + a[5] * f2[1]) + (a[6] * f3[0] + a[7] * f3[1]))
                         + ((a[8] * f4[0] + a[9] * f4[1]) + (a[10] * f5[0] + a[11] * f5[1])) + ((a[12] * f6[0] + a[13] * f6[1]) + (a[14] * f7[0] + a[15] * f7[1]));
                }
                float r8[8], r4[4], r2[2];
#pragma unroll
                for (int i = 0; i < 8; ++i) { auto sw = __builtin_amdgcn_permlane32_swap(__float_as_uint(d[i]), __float_as_uint(d[i + 8]), false, false); r8[i] = __uint_as_float(sw[0]) + __uint_as_float(sw[1]); }
#pragma unroll
                for (int i = 0; i < 4; ++i) { auto sw = __builtin_amdgcn_permlane16_swap(__float_as_uint(r8[i]), __float_as_uint(r8[i + 4]), false, false); r4[i] = __uint_as_float(sw[0]) + __uint_as_float(sw[1]); }
                const bool b3 = (lane >> 3) & 1, b2 = (lane >> 2) & 1;
#pragma unroll
                for (int i = 0; i < 2; ++i) { const float keep = b3 ? r4[i + 2] : r4[i], send = b3 ? r4[i] : r4[i + 2]; r2[i] = keep + shx<8>(send); }
                float dot; { const float keep = b2 ? r2[1] : r2[0], send = b2 ? r2[0] : r2[1]; dot = keep + shx<4>(send); }
                dot += shx<2>(dot); dot += shx<1>(dot);
                const int src = (lb + (lane >> 2)) * 4;
                const int es = __builtin_amdgcn_ds_bpermute(src, ev);
                const float us = __uint_as_float((unsigned)__builtin_amdgcn_ds_bpermute(src, (int)__float_as_uint((hb < 4) ? u0s : u1s)));
                const float vs = __uint_as_float((unsigned)__builtin_amdgcn_ds_bpermute(src, (int)__float_as_uint((hb < 4) ? v0s : v1s)));
                const float act = dot * us;
                const float u3 = 0.7978845608028654f * (act + 0.044715f * act * act * act);
                const float ge = act * __builtin_amdgcn_rcpf(1.f + __expf(-2.f * u3));
                const float wv = ge * vs;
                if ((lane & 3) == 0) {
                    const unsigned pk = (pk2(0.f, wv) & 0xffff0000u) | (unsigned)es;
                    PW[((size_t)((t >> 6) * 8 + hb) * 4 + (lane >> 4)) * 256 + (t & 63) * 4 + ((lane >> 2) & 3)] = pk;
                }
            }
        }
    }
    xcd_barrier(bar); TSTAMP();

    asm volatile("; ===== PHASE 14 =====");
    if (PH(14)) for (int rep = 0; rep < NREP(14); ++rep) {
        PH_LANES; const bool dummy = rep < NREP(14) - 1; (void)dummy;
        for (int item = vcu; item < 256; item += G) {
            const int sl = item & 127, half = item >> 7;
            __syncthreads();
#pragma unroll
            for (int i = 0; i < 16; ++i) *(LAS v4u*)(L + RING_OFF + (i * 512 + tid) * 16) = *(const GAS v4u*)(V8T + (size_t)sl * 131072 + (size_t)(i * 512 + tid) * 16);
            __syncthreads();
            const GAS v4u* pwb = (const GAS v4u*)(PW + (size_t)(half * 256 + wave) * 8192) + lane;
            v4u buf[4][4];
#pragma unroll
            for (int c = 0; c < 4; ++c)
#pragma unroll
                for (int k = 0; k < 4; ++k) buf[c][k] = pwb[c * 256 + k * 64];
#pragma unroll 1
            for (int itk = 0; itk < 32; ++itk) {
                const int g64 = half * 256 + itk * 8 + wave;
                const int t = g64 * 64 + lane;
                f32x2v acc[4] = {(f32x2v){0.f, 0.f}, (f32x2v){0.f, 0.f}, (f32x2v){0.f, 0.f}, (f32x2v){0.f, 0.f}};
#pragma unroll
                for (int c = 0; c < 8; ++c) {
                    v4u cur[4];
#pragma unroll
                    for (int k = 0; k < 4; ++k) cur[k] = buf[c & 3][k];
                    { const int sn = itk * 8 + c + 4; const int gn = (sn >> 3) > 31 ? 31 : (sn >> 3), cc = sn & 7; const GAS v4u* src = pwb + (size_t)gn * 8 * 2048 + cc * 256;
#pragma unroll
                      for (int k = 0; k < 4; ++k) buf[c & 3][k] = src[k * 64]; }
                    v2u tb[16];
#pragma unroll
                    for (int k = 0; k < 4; ++k)
#pragma unroll
                        for (int i = 0; i < 4; ++i) { const unsigned p = cur[k][i]; tb[k * 4 + i] = *(const LAS v2u*)(L + RING_OFF + ((p & 0xffffu) << 3)); }
#pragma unroll
                    for (int k = 0; k < 4; ++k)
#pragma unroll
                        for (int i = 0; i < 4; ++i) { const unsigned p = cur[k][i]; const float w = __uint_as_float(p & 0xffff0000u); const v2u q = tb[k * 4 + i];
                            const f32x2v ww = (f32x2v){w, w};
                            acc[0] += ww * __builtin_amdgcn_cvt_pk_f32_fp8((int)q.x, false); acc[1] += ww * __builtin_amdgcn_cvt_pk_f32_fp8((int)q.x, true);
                            acc[2] += ww * __builtin_amdgcn_cvt_pk_f32_fp8((int)q.y, false); acc[3] += ww * __builtin_amdgcn_cvt_pk_f32_fp8((int)q.y, true); }
                }
                GAS v4u* hr = (GAS v4u*)(A + (size_t)t * D + sl * 8);
                const v4u hq = *hr; const float mulv = dummy ? 0.f : 1.f;
                v4u ho; ho.x = pk2(bflo(hq.x) + acc[0].x * mulv, bfhi(hq.x) + acc[0].y * mulv); ho.y = pk2(bflo(hq.y) + acc[1].x * mulv, bfhi(hq.y) + acc[1].y * mulv);
                ho.z = pk2(bflo(hq.z) + acc[2].x * mulv, bfhi(hq.z) + acc[2].y * mulv); ho.w = pk2(bflo(hq.w) + acc[3].x * mulv, bfhi(hq.w) + acc[3].y * mulv);
                *hr = ho;
            }
        }
    }
    xcd_barrier(bar); TSTAMP();

#ifdef EXTRA_BARRIERS
    for (int eb = 0; eb < EXTRA_BARRIERS; ++eb) xcd_barrier(bar);
#endif
    asm volatile("; ===== PHASE 15 =====");
    if (PH(15)) for (int rep = 0; rep < NREP(15); ++rep) {
        PH_LANES; const bool dummy = rep < NREP(15) - 1; (void)dummy;
        for (int t = gw; t < T; t += NGW) {
            const GAS v4u* hr = (const GAS v4u*)(A + (size_t)t * D + 16 * lane); const v4u q0 = hr[0], q1 = hr[1];
            const GAS f32x4* gr = (const GAS f32x4*)(g_final + 16 * lane); GAS f32x4* orow = (GAS f32x4*)(out + (size_t)t * D + 16 * lane);
            f32x4 o[4] = {(f32x4){bflo(q0.x), bfhi(q0.x), bflo(q0.y), bfhi(q0.y)}, (f32x4){bflo(q0.z), bfhi(q0.z), bflo(q0.w), bfhi(q0.w)},
                          (f32x4){bflo(q1.x), bfhi(q1.x), bflo(q1.y), bfhi(q1.y)}, (f32x4){bflo(q1.z), bfhi(q1.z), bflo(q1.w), bfhi(q1.w)}};
            float ss = 0.f;
#pragma unroll
            for (int j = 0; j < 4; ++j) ss += (o[j].x * o[j].x + o[j].y * o[j].y) + (o[j].z * o[j].z + o[j].w * o[j].w);
            const float r = rsqrtf(wave_sum(ss) * (1.f / 1024.f) + RMS_EPS);
#pragma unroll
            for (int j = 0; j < 4; ++j) orow[j] = o[j] * r * gr[j];
        }
    }
}

extern "C" void kernel_launch(void* const* d_in, const int* in_sizes, int n_in, void* d_out, int out_size, void* d_ws, size_t ws_size, hipStream_t stream) {
    static int grid = 0;
    if (grid == 0) {
        if (n_in != 19 || out_size != T * D || ws_size < WS_END) { fprintf(stderr, "kernel_launch: unexpected problem (n_in %d, out %d, ws %zu < %zu); nothing launched\n", n_in, out_size, ws_size, (size_t)WS_END); grid = -1; return; }
        int dev = 0, cus = 0, per_cu = 0;
        if (hipGetDevice(&dev) != hipSuccess || hipDeviceGetAttribute(&cus, hipDeviceAttributeMultiprocessorCount, dev) != hipSuccess) { grid = -1; return; }
        if (hipFuncSetAttribute((const void*)mk_fwd, hipFuncAttributeMaxDynamicSharedMemorySize, LDS_BYTES) != hipSuccess) { fprintf(stderr, "kernel_launch: hipFuncSetAttribute failed\n"); grid = -1; return; }
        if (hipOccupancyMaxActiveBlocksPerMultiprocessor(&per_cu, (const void*)mk_fwd, NWAVES * 64, LDS_BYTES) != hipSuccess || per_cu < 1) { fprintf(stderr, "kernel_launch: occupancy query says %d blocks per CU\n", per_cu); }
        (void)hipGetLastError();
        grid = cus;
    }
    if (grid < 0) return;
    if (hipMemsetAsync((char*)d_ws + WS_CTL, 0, CTL_ZERO_BYTES, stream) != hipSuccess) return;
    Args a{};
    for (int i = 0; i < 19; ++i) a.in[i] = (const float*)d_in[i];
    a.out = (float*)d_out; a.ws = (unsigned char*)d_ws;
    hipLaunchKernelGGL(mk_fwd, dim3(grid), dim3(NWAVES * 64), LDS_BYTES, stream, a);
}
```

```cpp
#include <hip/hip_runtime.h>
#include <hip/hip_bf16.h>
#include <cstdio>
#include <cstdint>
#include <cmath>

#ifndef DIAG
#define DIAG 0
#endif


template <int O> __device__ __forceinline__ float shx(float v) { static_assert(O > 0 && O < 32, "shx"); return __uint_as_float((unsigned)__builtin_amdgcn_ds_swizzle((int)__float_as_uint(v), (O << 10) | 0x1f)); }
__device__ __forceinline__ float sum32(float v) { auto r = __builtin_amdgcn_permlane32_swap(__float_as_uint(v), __float_as_uint(v), false, false); return __uint_as_float(r[0]) + __uint_as_float(r[1]); }
__device__ __forceinline__ float max32(float v) { auto r = __builtin_amdgcn_permlane32_swap(__float_as_uint(v), __float_as_uint(v), false, false); return fmaxf(__uint_as_float(r[0]), __uint_as_float(r[1])); }
__device__ __forceinline__ float wave_max(float v) { v = fmaxf(v, shx<1>(v)); v = fmaxf(v, shx<2>(v)); v = fmaxf(v, shx<4>(v)); v = fmaxf(v, shx<8>(v)); v = fmaxf(v, shx<16>(v)); return max32(v); }
__device__ __forceinline__ float wave_sum(float v) { v += shx<1>(v); v += shx<2>(v); v += shx<4>(v); v += shx<8>(v); v += shx<16>(v); return sum32(v); }

namespace pg8 {
#define PG8_LAS __attribute__((address_space(3)))
typedef unsigned short bf16_t;
typedef short bf16x8 __attribute__((ext_vector_type(8)));
typedef float f32x4 __attribute__((ext_vector_type(4)));
typedef float f32x2 __attribute__((ext_vector_type(2)));
typedef unsigned u32x4 __attribute__((ext_vector_type(4)));
typedef unsigned u32x2 __attribute__((ext_vector_type(2)));
constexpr int BM = 256, BK = 64, HALF = 128, HTB = HALF * BK * 2  , STAGE_BYTES = 8 * HTB, NXCD = 8, WGM = 8;

__host__ __device__ __forceinline__ int lds_byte(int r, int c) { const int st = (r >> 4) * 2 + (c >> 5), rr = r & 15, cc = c & 31, ob = rr * 64 + cc * 2; return st * 1024 + (ob ^ (((ob >> 9) & 1) << 5)); }
__host__ __device__ __forceinline__ void stage_rc(int b, int& R, int& C) { const int st = b / 1024, sb = b % 1024, swz = sb ^ (((sb >> 9) & 1) << 5); R = (st >> 1) * 16 + swz / 64; C = (st & 1) * 32 + (swz % 64) / 2; }
__host__ __device__ __forceinline__ int perm32(int rho) { const int n = rho >> 4, i = rho & 15; return 8 * (i >> 2) + 4 * n + (i & 3); }

struct Unit { int pm, pn; const char* a; const char* b; };
struct Gemm { int lda, ldb, K; };

struct StaticOrder {
    int nM, nN, nwg, G, c; const char* A; const char* Bt; size_t astep, bstep;
    __device__ void init(const void* A_, int lda, const void* Bt_, int ldb, int M, int N, int G_, int c_) { nM = M / BM; nN = N / BM; nwg = nM * nN; G = G_; c = c_; A = (const char*)A_; Bt = (const char*)Bt_; astep = (size_t)BM * lda * 2; bstep = (size_t)BM * ldb * 2; }
    __device__ bool next(int i, Unit& u) const {
        const long L = (long)i * G + c; if (L >= nwg) return false;
        int wgid = (int)L; { const int q = nwg / NXCD, r = nwg % NXCD, xcd = wgid % NXCD, off = wgid / NXCD; wgid = (xcd < r ? xcd * (q + 1) : r * (q + 1) + (xcd - r) * q) + off; }
        const int nig = WGM * nN, gid = wgid / nig, fm = gid * WGM, gsz = (nM - fm) < WGM ? (nM - fm) : WGM;
        u.pm = fm + ((wgid % nig) % gsz); u.pn = (wgid % nig) / gsz; u.a = A + (size_t)u.pm * astep; u.b = Bt + (size_t)u.pn * bstep; return true;
    }
};

__device__ __forceinline__ unsigned cvt_pk_bf16(float lo, float hi) { typedef __bf16 bf2 __attribute__((ext_vector_type(2))); f32x2 v = {lo, hi}; bf2 b = __builtin_convertvector(v, bf2); return __builtin_bit_cast(unsigned, b); }
__device__ __forceinline__ float bf_lo(unsigned u) { return __uint_as_float(u << 16); }
__device__ __forceinline__ float bf_hi(unsigned u) { return __uint_as_float(u & 0xffff0000u); }

template <class Epi, class Sched, bool ALIGN_EPI>
__device__ __forceinline__ void gemm_phase(PG8_LAS unsigned char* lds, const Gemm g, const Sched& S, const Epi& E) {
    int tid = threadIdx.x; asm volatile("" : "+v"(tid));
    const int wid = __builtin_amdgcn_readfirstlane(tid >> 6), lane = tid & 63, wr = wid >> 2, wc = wid & 3, fr = lane & 15, fq = lane >> 4;
    const int K = g.K, nt = K / BK;
    unsigned voffA[2], voffB[2];
#pragma unroll
    for (int i = 0; i < 2; ++i) { int R, C; stage_rc(tid * 16 + i * 8192, R, C); const int Rb = Epi::PERM ? ((R & ~31) + perm32(R & 31)) : R;
        voffA[i] = (unsigned)(R * g.lda + C) * 2u; voffB[i] = (unsigned)(Rb * g.ldb + C) * 2u; }
    const size_t kstep = (size_t)(BK * 2);
    const size_t hstepA = (size_t)HALF * g.lda * 2, hstepB = (size_t)HALF * g.ldb * 2;
    const unsigned ldsw = (unsigned)wid * 1024u;
    const int aoff = lds_byte(wr * 64 + fr, fq * 8), boff = lds_byte(wc * 32 + fr, fq * 8);
#define PG8_SA(b, h) (((b) * 2 + (h)) * HTB)
#define PG8_SB(b, h) ((4 + (b) * 2 + (h)) * HTB)
#define PG8_STAGE(bufoff, gbase, voff) do { _Pragma("unroll") for (int _i = 0; _i < 2; ++_i) \
        __builtin_amdgcn_global_load_lds((const unsigned*)((const char*)(gbase) + (voff)[_i]), (PG8_LAS unsigned*)(lds + (bufoff) + ldsw + _i * 8192), 16, 0, 0); } while (0)
#define PG8_LDA(dst, b, h) do { _Pragma("unroll") for (int m = 0; m < 4; ++m) _Pragma("unroll") for (int k = 0; k < 2; ++k) dst[m][k] = *(const PG8_LAS bf16x8*)(lds + PG8_SA(b, h) + aoff + m * 2048 + k * 1024); } while (0)
#define PG8_LDB(dst, b, h) do { _Pragma("unroll") for (int n = 0; n < 2; ++n) _Pragma("unroll") for (int k = 0; k < 2; ++k) dst[n][k] = *(const PG8_LAS bf16x8*)(lds + PG8_SB(b, h) + boff + n * 2048 + k * 1024); } while (0)
#define PG8_MMA(ai, bj, At, Bt) do { __builtin_amdgcn_s_setprio(1); _Pragma("unroll") for (int m = 0; m < 4; ++m) _Pragma("unroll") for (int n = 0; n < 2; ++n) _Pragma("unroll") for (int k = 0; k < 2; ++k) \
        acc[ai][bj][m][n] = __builtin_amdgcn_mfma_f32_16x16x32_bf16(Bt[n][k], At[m][k], acc[ai][bj][m][n], 0, 0, 0); __builtin_amdgcn_s_setprio(0); } while (0)
#define PG8_WAIT_V(n) asm volatile("s_waitcnt vmcnt(" #n ")" ::: "memory")
#define PG8_WAIT_L(n) asm volatile("s_waitcnt lgkmcnt(" #n ")" ::: "memory")
#define PG8_BAR __builtin_amdgcn_s_barrier()
#define PG8_SCHED __builtin_amdgcn_sched_barrier(0)
    Unit cur, nxt; int ui = 0;
    if (!S.next(0, cur)) return;
    f32x4 acc[2][2][4][2];
#pragma unroll
    for (int a = 0; a < 2; ++a)
#pragma unroll
        for (int b = 0; b < 2; ++b)
#pragma unroll
            for (int m = 0; m < 4; ++m)
#pragma unroll
                for (int n = 0; n < 2; ++n) acc[a][b][m][n] = (f32x4){0.f, 0.f, 0.f, 0.f};
    bf16x8 At[4][2], B0[2][2], B1[2][2];
    const char* cA = cur.a; const char* cB = cur.b;
    PG8_STAGE(PG8_SB(0, 0), cB, voffB); PG8_STAGE(PG8_SB(0, 1), cB + hstepB, voffB); PG8_STAGE(PG8_SA(0, 0), cA, voffA); PG8_STAGE(PG8_SA(0, 1), cA + hstepA, voffA);
    if (wr == 1) PG8_BAR;
    PG8_WAIT_V(2); PG8_BAR;
    PG8_STAGE(PG8_SB(1, 0), cB + kstep, voffB); PG8_STAGE(PG8_SA(1, 0), cA + kstep, voffA); PG8_STAGE(PG8_SB(1, 1), cB + hstepB + kstep, voffB);
    PG8_WAIT_V(6); PG8_BAR;
    for (;;) {
        const bool has_next = S.next(ui + 1, nxt);
        const char* nA = has_next ? nxt.a : cA; const char* nB = has_next ? nxt.b : cB;
        for (int t = 0; t < nt; t += 2) {
            const bool last = (t == nt - 2);
            const char* a1 = cA + (size_t)(t + 1) * kstep;
            const char* a2 = last ? nA : cA + (size_t)(t + 2) * kstep; const char* b2 = last ? nB : cB + (size_t)(t + 2) * kstep;
            const char* a3 = a2 + kstep; const char* b3 = b2 + kstep;
            PG8_LDB(B0, 0, 0); PG8_LDB(B1, 0, 1); PG8_SCHED; PG8_LDA(At, 0, 0); PG8_STAGE(PG8_SA(1, 1), a1 + hstepA, voffA);
            PG8_WAIT_V(8); PG8_WAIT_L(0); PG8_BAR; PG8_MMA(0, 0, At, B0); PG8_MMA(0, 1, At, B1); PG8_BAR; PG8_SCHED;
            PG8_LDA(At, 0, 1); PG8_STAGE(PG8_SB(0, 0), b2, voffB); PG8_STAGE(PG8_SB(0, 1), b2 + hstepB, voffB); PG8_STAGE(PG8_SA(0, 0), a2, voffA);
            PG8_WAIT_V(8); PG8_WAIT_L(0); PG8_BAR; PG8_MMA(1, 0, At, B0); PG8_MMA(1, 1, At, B1); PG8_BAR; PG8_SCHED;
            PG8_LDB(B0, 1, 0); PG8_LDB(B1, 1, 1); PG8_SCHED; PG8_LDA(At, 1, 0); PG8_STAGE(PG8_SA(0, 1), a2 + hstepA, voffA);
            PG8_WAIT_V(8); PG8_WAIT_L(0); PG8_BAR; PG8_MMA(0, 0, At, B0); PG8_MMA(0, 1, At, B1); PG8_BAR; PG8_SCHED;
            PG8_LDA(At, 1, 1); PG8_STAGE(PG8_SB(1, 0), b3, voffB); PG8_STAGE(PG8_SB(1, 1), b3 + hstepB, voffB); PG8_STAGE(PG8_SA(1, 0), a3, voffA);
            PG8_WAIT_V(8); PG8_WAIT_L(0); PG8_BAR; PG8_MMA(1, 0, At, B0); PG8_MMA(1, 1, At, B1); PG8_BAR; PG8_SCHED;
        }
        if constexpr (ALIGN_EPI) { if (wr == 0) PG8_BAR; }
        if constexpr (!Epi::AFTER_DRAIN) { E(acc, cur, wr, wc, fr, fq); }
        if (!has_next) break;
#pragma unroll
        for (int a = 0; a < 2; ++a)
#pragma unroll
            for (int b = 0; b < 2; ++b)
#pragma unroll
                for (int m = 0; m < 4; ++m)
#pragma unroll
                    for (int n = 0; n < 2; ++n) acc[a][b][m][n] = (f32x4){0.f, 0.f, 0.f, 0.f};
        cur = nxt; cA = nA; cB = nB; ++ui;
        if constexpr (ALIGN_EPI) { if (wr == 1) PG8_BAR; }
    }
    PG8_WAIT_V(0);
    if constexpr (!ALIGN_EPI) { if (wr == 0) PG8_BAR; }
    PG8_BAR;
    if constexpr (Epi::AFTER_DRAIN) { E.fused(acc, cur, wr, wc, fr, fq, lds, wid, lane); }
#undef PG8_SA
#undef PG8_SB
#undef PG8_STAGE
#undef PG8_LDA
#undef PG8_LDB
#undef PG8_MMA
#undef PG8_WAIT_V
#undef PG8_WAIT_L
#undef PG8_BAR
#undef PG8_SCHED
}

typedef f32x4 AccT[2][2][4][2];

struct EpiBf16 {
    static constexpr bool PERM = true, AFTER_DRAIN = false;
    bf16_t* O; int ldc;
    __device__ __forceinline__ void operator()(const AccT& acc, const Unit& u, int wr, int wc, int fr, int fq) const {
        { int t_ = threadIdx.x; asm volatile("" : "+v"(t_)); fr = t_ & 15; fq = (t_ >> 4) & 3; }
        const int row0 = u.pm * BM + wr * 64 + fr, col0 = u.pn * BM + wc * 32 + 8 * fq;
#pragma unroll
        for (int ai = 0; ai < 2; ++ai)
#pragma unroll
            for (int m = 0; m < 4; ++m) { bf16_t* rowp = O + (size_t)(row0 + ai * HALF + m * 16) * ldc + col0;
#pragma unroll
                for (int bj = 0; bj < 2; ++bj) { const f32x4 v0 = acc[ai][bj][m][0], v1 = acc[ai][bj][m][1];
                    u32x4 w; w.x = cvt_pk_bf16(v0[0], v0[1]); w.y = cvt_pk_bf16(v0[2], v0[3]); w.z = cvt_pk_bf16(v1[0], v1[1]); w.w = cvt_pk_bf16(v1[2], v1[3]);
                    *(u32x4*)(rowp + bj * HALF) = w; } }
    }
};
struct EpiF16 {
    static constexpr bool PERM = true, AFTER_DRAIN = false;
    _Float16* O; int ldc;
    __device__ __forceinline__ void operator()(const AccT& acc, const Unit& u, int wr, int wc, int fr, int fq) const {
        { int t_ = threadIdx.x; asm volatile("" : "+v"(t_)); fr = t_ & 15; fq = (t_ >> 4) & 3; }
        typedef _Float16 h8 __attribute__((ext_vector_type(8)));
        const int row0 = u.pm * BM + wr * 64 + fr, col0 = u.pn * BM + wc * 32 + 8 * fq;
#pragma unroll
        for (int ai = 0; ai < 2; ++ai)
#pragma unroll
            for (int m = 0; m < 4; ++m) { _Float16* rowp = O + (size_t)(row0 + ai * HALF + m * 16) * ldc + col0;
#pragma unroll
                for (int bj = 0; bj < 2; ++bj) { const f32x4 v0 = acc[ai][bj][m][0], v1 = acc[ai][bj][m][1];
                    h8 w = {(_Float16)v0[0], (_Float16)v0[1], (_Float16)v0[2], (_Float16)v0[3], (_Float16)v1[0], (_Float16)v1[1], (_Float16)v1[2], (_Float16)v1[3]};
                    *(h8*)(rowp + bj * HALF) = w; } }
    }
};
struct EpiGateMul {
    static constexpr bool PERM = true, AFTER_DRAIN = false;
    const bf16_t* G; bf16_t* Dst; int ldc;
    __device__ __forceinline__ void operator()(const AccT& acc, const Unit& u, int wr, int wc, int fr, int fq) const {
        { int t_ = threadIdx.x; asm volatile("" : "+v"(t_)); fr = t_ & 15; fq = (t_ >> 4) & 3; }
        const int row0 = u.pm * BM + wr * 64 + fr, col0 = u.pn * BM + wc * 32 + 8 * fq;
#pragma unroll
        for (int ai = 0; ai < 2; ++ai)
#pragma unroll
            for (int m = 0; m < 4; ++m) { const size_t roff = (size_t)(row0 + ai * HALF + m * 16) * ldc + col0; const bf16_t* rowg = G + roff; bf16_t* rowp = Dst + roff;
#pragma unroll
                for (int bj = 0; bj < 2; ++bj) { const f32x4 v0 = acc[ai][bj][m][0], v1 = acc[ai][bj][m][1]; const u32x4 gq = *(const u32x4*)(rowg + bj * HALF);
                    u32x4 w; w.x = cvt_pk_bf16(v0[0] * bf_lo(gq.x), v0[1] * bf_hi(gq.x)); w.y = cvt_pk_bf16(v0[2] * bf_lo(gq.y), v0[3] * bf_hi(gq.y));
                    w.z = cvt_pk_bf16(v1[0] * bf_lo(gq.z), v1[1] * bf_hi(gq.z)); w.w = cvt_pk_bf16(v1[2] * bf_lo(gq.w), v1[3] * bf_hi(gq.w));
                    *(u32x4*)(rowp + bj * HALF) = w; } }
    }
};
struct EpiGateFma {
    static constexpr bool PERM = true, AFTER_DRAIN = false;
    const bf16_t* Tm; const bf16_t* G2; bf16_t* Dst; int ldc;
    __device__ __forceinline__ void operator()(const AccT& acc, const Unit& u, int wr, int wc, int fr, int fq) const {
        { int t_ = threadIdx.x; asm volatile("" : "+v"(t_)); fr = t_ & 15; fq = (t_ >> 4) & 3; }
        const int row0 = u.pm * BM + wr * 64 + fr, col0 = u.pn * BM + wc * 32 + 8 * fq;
#pragma unroll
        for (int ai = 0; ai < 2; ++ai)
#pragma unroll
            for (int m = 0; m < 4; ++m) { const size_t off = (size_t)(row0 + ai * HALF + m * 16) * ldc + col0;
#pragma unroll
                for (int bj = 0; bj < 2; ++bj) { const f32x4 v0 = acc[ai][bj][m][0], v1 = acc[ai][bj][m][1]; const u32x4 gq = *(const u32x4*)(G2 + off + bj * HALF); const u32x4 tq = *(const u32x4*)(Tm + off + bj * HALF);
                    u32x4 w; w.x = cvt_pk_bf16(bf_lo(tq.x) + v0[0] * bf_lo(gq.x), bf_hi(tq.x) + v0[1] * bf_hi(gq.x)); w.y = cvt_pk_bf16(bf_lo(tq.y) + v0[2] * bf_lo(gq.y), bf_hi(tq.y) + v0[3] * bf_hi(gq.y));
                    w.z = cvt_pk_bf16(bf_lo(tq.z) + v1[0] * bf_lo(gq.z), bf_hi(tq.z) + v1[1] * bf_hi(gq.z)); w.w = cvt_pk_bf16(bf_lo(tq.w) + v1[2] * bf_lo(gq.w), bf_hi(tq.w) + v1[3] * bf_hi(gq.w));
                    *(u32x4*)(Dst + off + bj * HALF) = w; } }
    }
};
struct EpiResF32 {
    static constexpr bool PERM = false, AFTER_DRAIN = false;
    const float* res; float* out; int ldc; float mul;
    __device__ __forceinline__ void operator()(const AccT& acc, const Unit& u, int wr, int wc, int fr, int fq) const {
        { int t_ = threadIdx.x; asm volatile("" : "+v"(t_)); fr = t_ & 15; fq = (t_ >> 4) & 3; }
        const int row0 = u.pm * BM + wr * 64 + fr, col0 = u.pn * BM + wc * 32 + 4 * fq;
#pragma unroll
        for (int ai = 0; ai < 2; ++ai)
#pragma unroll
            for (int m = 0; m < 4; ++m) { const size_t off = (size_t)(row0 + ai * HALF + m * 16) * ldc + col0;
#pragma unroll
                for (int bj = 0; bj < 2; ++bj)
#pragma unroll
                    for (int n = 0; n < 2; ++n) { const f32x4 r = *(const f32x4*)(res + off + bj * HALF + n * 16); *(f32x4*)(out + off + bj * HALF + n * 16) = r + acc[ai][bj][m][n] * mul; } }
    }
};

__device__ __forceinline__ float row_rs(const float* ssq, int row) {
    const f32x4* p = (const f32x4*)(ssq + (size_t)row * 16); const f32x4 a = p[0], b = p[1], c = p[2], d = p[3];
    const float s = ((a[0] + a[1]) + (a[2] + a[3])) + ((b[0] + b[1]) + (b[2] + b[3])) + ((c[0] + c[1]) + (c[2] + c[3])) + ((d[0] + d[1]) + (d[2] + d[3]));
    return rsqrtf(s * (1.f / 1024.f) + 1e-6f);
}
struct EpiBf16RS {
    static constexpr bool PERM = true, AFTER_DRAIN = false;
    bf16_t* O; int ldc; const float* ssq;
    __device__ __forceinline__ void operator()(const AccT& acc, const Unit& u, int wr, int wc, int fr, int fq) const {
        { int t_ = threadIdx.x; asm volatile("" : "+v"(t_)); fr = t_ & 15; fq = (t_ >> 4) & 3; }
        const int row0 = u.pm * BM + wr * 64 + fr, col0 = u.pn * BM + wc * 32 + 8 * fq;
#pragma unroll
        for (int ai = 0; ai < 2; ++ai)
#pragma unroll
            for (int m = 0; m < 4; ++m) { int ro = row0 + ai * HALF + m * 16; asm volatile("" : "+v"(ro)); const float rs = row_rs(ssq, ro); bf16_t* rowp = O + (size_t)ro * ldc + col0;
#pragma unroll
                for (int bj = 0; bj < 2; ++bj) { const f32x4 v0 = acc[ai][bj][m][0] * rs, v1 = acc[ai][bj][m][1] * rs;
                    u32x4 w; w.x = cvt_pk_bf16(v0[0], v0[1]); w.y = cvt_pk_bf16(v0[2], v0[3]); w.z = cvt_pk_bf16(v1[0], v1[1]); w.w = cvt_pk_bf16(v1[2], v1[3]);
                    *(u32x4*)(rowp + bj * HALF) = w; } }
    }
};
struct EpiF16RS {
    static constexpr bool PERM = true, AFTER_DRAIN = false;
    _Float16* O; int ldc; const float* ssq;
    __device__ __forceinline__ void operator()(const AccT& acc, const Unit& u, int wr, int wc, int fr, int fq) const {
        { int t_ = threadIdx.x; asm volatile("" : "+v"(t_)); fr = t_ & 15; fq = (t_ >> 4) & 3; }
        typedef _Float16 h8 __attribute__((ext_vector_type(8)));
        const int row0 = u.pm * BM + wr * 64 + fr, col0 = u.pn * BM + wc * 32 + 8 * fq;
#pragma unroll
        for (int ai = 0; ai < 2; ++ai)
#pragma unroll
            for (int m = 0; m < 4; ++m) { int ro = row0 + ai * HALF + m * 16; asm volatile("" : "+v"(ro)); const float rs = row_rs(ssq, ro); _Float16* rowp = O + (size_t)ro * ldc + col0;
#pragma unroll
                for (int bj = 0; bj < 2; ++bj) { const f32x4 v0 = acc[ai][bj][m][0] * rs, v1 = acc[ai][bj][m][1] * rs;
                    h8 w = {(_Float16)v0[0], (_Float16)v0[1], (_Float16)v0[2], (_Float16)v0[3], (_Float16)v1[0], (_Float16)v1[1], (_Float16)v1[2], (_Float16)v1[3]};
                    *(h8*)(rowp + bj * HALF) = w; } }
    }
};
template <bool RES_F32> struct EpiResNorm {
    static constexpr bool PERM = true, AFTER_DRAIN = false;
    const float* resf; bf16_t* H; float* ssq; int ldc; float mul;
    __device__ __forceinline__ void operator()(const AccT& acc, const Unit& u, int wr, int wc, int fr, int fq) const {
        { int t_ = threadIdx.x; asm volatile("" : "+v"(t_)); fr = t_ & 15; fq = (t_ >> 4) & 3; }
        const int row0 = u.pm * BM + wr * 64 + fr, col0 = u.pn * BM + wc * 32 + 8 * fq;
#pragma unroll
        for (int ai = 0; ai < 2; ++ai)
#pragma unroll
            for (int m = 0; m < 4; ++m) { int ro = row0 + ai * HALF + m * 16; asm volatile("" : "+v"(ro)); const size_t off = (size_t)ro * ldc + col0; float ss = 0.f;
#pragma unroll
                for (int bj = 0; bj < 2; ++bj) { f32x4 r0, r1;
                    if (RES_F32) { r0 = *(const f32x4*)(resf + off + bj * HALF); r1 = *(const f32x4*)(resf + off + bj * HALF + 4); }
                    else { const u32x4 q = *(const u32x4*)(H + off + bj * HALF); r0 = (f32x4){bf_lo(q.x), bf_hi(q.x), bf_lo(q.y), bf_hi(q.y)}; r1 = (f32x4){bf_lo(q.z), bf_hi(q.z), bf_lo(q.w), bf_hi(q.w)}; }
                    const f32x4 v0 = r0 + acc[ai][bj][m][0] * mul, v1 = r1 + acc[ai][bj][m][1] * mul;
                    ss += ((v0[0] * v0[0] + v0[1] * v0[1]) + (v0[2] * v0[2] + v0[3] * v0[3])) + ((v1[0] * v1[0] + v1[1] * v1[1]) + (v1[2] * v1[2] + v1[3] * v1[3]));
                    u32x4 w; w.x = cvt_pk_bf16(v0[0], v0[1]); w.y = cvt_pk_bf16(v0[2], v0[3]); w.z = cvt_pk_bf16(v1[0], v1[1]); w.w = cvt_pk_bf16(v1[2], v1[3]);
                    *(u32x4*)(H + off + bj * HALF) = w; }
                ss += shx<16>(ss); ss = sum32(ss);
                if (fq == 0) ssq[(size_t)ro * 16 + u.pn * 4 + wc] = ss; }
    }
};
struct EpiIn {
    static constexpr bool PERM = true, AFTER_DRAIN = false;
    bf16_t *U, *Bb, *Q, *Kb, *V, *SGC, *SGA; const float* ropec; const float* ropes; float* kbar; float qscale;
    __device__ __forceinline__ void operator()(const AccT& acc, const Unit& u, int wr, int wc, int fr, int fq) const {
        { int t_ = threadIdx.x; asm volatile("" : "+v"(t_)); fr = t_ & 15; fq = (t_ >> 4) & 3; }
        const int pn = u.pn; const int row0 = u.pm * BM + wr * 64 + fr;
        if (pn < 4) {
            const int c0 = 128 * pn + 16 * wc + 4 * fq;
#pragma unroll
            for (int ai = 0; ai < 2; ++ai)
#pragma unroll
                for (int m = 0; m < 4; ++m) { int ro = row0 + ai * HALF + m * 16; asm volatile("" : "+v"(ro)); bf16_t* rowp = U + (size_t)ro * 512 + c0;
#pragma unroll
                    for (int bj = 0; bj < 2; ++bj) { const f32x4 x = acc[ai][bj][m][0] * acc[ai][bj][m][1]; u32x2 w; w.x = cvt_pk_bf16(x[0], x[1]); w.y = cvt_pk_bf16(x[2], x[3]); *(u32x2*)(rowp + bj * 64) = w; } }
        } else if (pn < 6 || (pn >= 10 && pn < 12)) {
            bf16_t* O = pn < 6 ? Bb : V; const int col0 = (pn < 6 ? pn - 4 : pn - 10) * BM + wc * 32 + 8 * fq;
#pragma unroll
            for (int ai = 0; ai < 2; ++ai)
#pragma unroll
                for (int m = 0; m < 4; ++m) { int ro = row0 + ai * HALF + m * 16; asm volatile("" : "+v"(ro)); bf16_t* rowp = O + (size_t)ro * 512 + col0;
#pragma unroll
                    for (int bj = 0; bj < 2; ++bj) { const f32x4 v0 = acc[ai][bj][m][0], v1 = acc[ai][bj][m][1];
                        u32x4 w; w.x = cvt_pk_bf16(v0[0], v0[1]); w.y = cvt_pk_bf16(v0[2], v0[3]); w.z = cvt_pk_bf16(v1[0], v1[1]); w.w = cvt_pk_bf16(v1[2], v1[3]);
                        *(u32x4*)(rowp + bj * HALF) = w; } }
        } else if (pn < 10) {
            const bool isk = pn >= 8; bf16_t* O = isk ? Kb : Q; const int colt = (isk ? pn - 8 : pn - 6) * BM + wc * 32 + 8 * fq;
            const int g4 = 4 * (4 * (wc & 1) + fq);
            const float sc = isk ? 1.f : qscale;
            f32x4 cs0[2] = {(f32x4){0.f, 0.f, 0.f, 0.f}, (f32x4){0.f, 0.f, 0.f, 0.f}}, cs1[2] = {(f32x4){0.f, 0.f, 0.f, 0.f}, (f32x4){0.f, 0.f, 0.f, 0.f}};
#pragma unroll
            for (int ai = 0; ai < 2; ++ai)
#pragma unroll
                for (int m = 0; m < 4; ++m) { int row = row0 + ai * HALF + m * 16; asm volatile("" : "+v"(row)); const int pos = row & 2047;
                    const f32x4 c = *(const f32x4*)(ropec + pos * 32 + g4) * sc, s = *(const f32x4*)(ropes + pos * 32 + g4) * sc;
                    bf16_t* rowp = O + (size_t)row * 512 + colt;
#pragma unroll
                    for (int bj = 0; bj < 2; ++bj) { const f32x4 x1 = acc[ai][bj][m][0], x2 = acc[ai][bj][m][1]; const f32x4 o1 = x1 * c - x2 * s, o2 = x2 * c + x1 * s;
                        cs0[bj] += o1; cs1[bj] += o2;
                        u32x4 w; w.x = cvt_pk_bf16(o1[0], o1[1]); w.y = cvt_pk_bf16(o1[2], o1[3]); w.z = cvt_pk_bf16(o2[0], o2[1]); w.w = cvt_pk_bf16(o2[2], o2[3]);
                        *(u32x4*)(rowp + bj * HALF) = w; }
                    asm volatile("" : "+v"(cs0[0]), "+v"(cs0[1]), "+v"(cs1[0]), "+v"(cs1[1]) :: "memory"); }
            if (isk) {
#pragma unroll
                for (int bj = 0; bj < 2; ++bj)
#pragma unroll
                    for (int j = 0; j < 4; ++j) { float a = cs0[bj][j], b = cs1[bj][j];
                        a += shx<1>(a); b += shx<1>(b); a += shx<2>(a); b += shx<2>(b); a += shx<4>(a); b += shx<4>(b); a += shx<8>(a); b += shx<8>(b);
                        if (fr == 0) { const int pc = (pn - 8) * BM + bj * HALF + wc * 32 + 8 * fq;
                            float* kb = kbar + (size_t)u.pm * 512 + pc; atomicAdd(kb + j, a); atomicAdd(kb + 4 + j, b); } }
            }
        } else {
            bf16_t* O = pn < 16 ? SGC : SGA; const int col0 = (pn < 16 ? pn - 12 : pn - 16) * BM + wc * 32 + 8 * fq;
#pragma unroll
            for (int ai = 0; ai < 2; ++ai)
#pragma unroll
                for (int m = 0; m < 4; ++m) { int ro = row0 + ai * HALF + m * 16; asm volatile("" : "+v"(ro)); bf16_t* rowp = O + (size_t)ro * 1024 + col0;
#pragma unroll
                    for (int bj = 0; bj < 2; ++bj) { f32x4 v0 = acc[ai][bj][m][0], v1 = acc[ai][bj][m][1];
#pragma unroll
                        for (int j = 0; j < 4; ++j) { v0[j] = __builtin_amdgcn_rcpf(1.f + __expf(-v0[j])); v1[j] = __builtin_amdgcn_rcpf(1.f + __expf(-v1[j])); }
                        u32x4 w; w.x = cvt_pk_bf16(v0[0], v0[1]); w.y = cvt_pk_bf16(v0[2], v0[3]); w.z = cvt_pk_bf16(v1[0], v1[1]); w.w = cvt_pk_bf16(v1[2], v1[3]);
                        *(u32x4*)(rowp + bj * HALF) = w; }
                    asm volatile("" ::: "memory"); }
        }
    }
};
struct EpiSoftmax {
    static constexpr bool PERM = true, AFTER_DRAIN = true;
    bf16_t* O; int ldc; float scale_log2;
    __device__ __forceinline__ void fused(AccT& acc, const Unit& u, int wr, int wc, int fr, int fq, PG8_LAS unsigned char* lds, int wid, int lane) const {
        { int t_ = threadIdx.x; asm volatile("" : "+v"(t_)); fr = t_ & 15; fq = (t_ >> 4) & 3; }
        PG8_LAS f32x2* X = (PG8_LAS f32x2*)lds;
        float mx[2][4];
#pragma unroll
        for (int ai = 0; ai < 2; ++ai)
#pragma unroll
            for (int m = 0; m < 4; ++m) { float a = -3.0e38f;
#pragma unroll
                for (int bj = 0; bj < 2; ++bj)
#pragma unroll
                    for (int n = 0; n < 2; ++n) { acc[ai][bj][m][n] = acc[ai][bj][m][n] * scale_log2; const f32x4 x = acc[ai][bj][m][n]; a = fmaxf(fmaxf(a, fmaxf(x[0], x[1])), fmaxf(x[2], x[3])); }
                a = fmaxf(a, shx<16>(a)); a = max32(a); mx[ai][m] = a;
                float s = 0.f;
#pragma unroll
                for (int bj = 0; bj < 2; ++bj)
#pragma unroll
                    for (int n = 0; n < 2; ++n) { f32x4 x = acc[ai][bj][m][n];
#pragma unroll
                        for (int j = 0; j < 4; ++j) { x[j] = __builtin_amdgcn_exp2f(x[j] - a); s += x[j]; }
                        acc[ai][bj][m][n] = x; }
                s += shx<16>(s); s = sum32(s);
                if (fq == 0) X[(ai * HALF + wr * 64 + m * 16 + fr) * 4 + wc] = (f32x2){a, s};
            }
        asm volatile("s_waitcnt lgkmcnt(0)" ::: "memory"); __builtin_amdgcn_s_barrier(); asm volatile("" ::: "memory");
        const int row0 = u.pm * BM + wr * 64 + fr, col0 = u.pn * BM + wc * 32 + 8 * fq;
#pragma unroll
        for (int ai = 0; ai < 2; ++ai)
#pragma unroll
            for (int m = 0; m < 4; ++m) { const int r = ai * HALF + wr * 64 + m * 16 + fr;
                const f32x2 e0 = X[r * 4 + 0], e1 = X[r * 4 + 1], e2 = X[r * 4 + 2], e3 = X[r * 4 + 3];
                const float M = fmaxf(fmaxf(e0.x, e1.x), fmaxf(e2.x, e3.x));
                const float L = e0.y * __builtin_amdgcn_exp2f(e0.x - M) + e1.y * __builtin_amdgcn_exp2f(e1.x - M) + e2.y * __builtin_amdgcn_exp2f(e2.x - M) + e3.y * __builtin_amdgcn_exp2f(e3.x - M);
                const float f = __builtin_amdgcn_exp2f(mx[ai][m] - M) * __builtin_amdgcn_rcpf(L);
                bf16_t* rowp = O + (size_t)(row0 + ai * HALF + m * 16) * ldc + col0;
#pragma unroll
                for (int bj = 0; bj < 2; ++bj) { const f32x4 v0 = acc[ai][bj][m][0] * f, v1 = acc[ai][bj][m][1] * f;
                    u32x4 w; w.x = cvt_pk_bf16(v0[0], v0[1]); w.y = cvt_pk_bf16(v0[2], v0[3]); w.z = cvt_pk_bf16(v1[0], v1[1]); w.w = cvt_pk_bf16(v1[2], v1[3]);
                    *(u32x4*)(rowp + bj * HALF) = w; } }
        asm volatile("s_waitcnt lgkmcnt(0)" ::: "memory"); __builtin_amdgcn_s_barrier(); asm volatile("" ::: "memory");
    }
};
}
namespace attn_body {
using bf16=__hip_bfloat16;
using bf16x8=__attribute__((ext_vector_type(8)))short;
using s16x4=__attribute__((ext_vector_type(4)))short;
using f32x16=__attribute__((ext_vector_type(16)))float;
using u32x4=__attribute__((ext_vector_type(4)))unsigned;
constexpr int BATCH=16,NHEAD=8,SEQ=2048,D=64,DM=NHEAD*D;
constexpr int NW=8,QBLK=32,QB=QBLK*NW,KVBLK=64,NQB=SEQ/QB;
constexpr int ATTN_PITCH=DM, ATTN_UNIT_ROWS=QB;
__device__ __forceinline__ int crow(int r,int hi){return (r&3)+8*(r>>2)+4*hi;}
#define SBAR() __builtin_amdgcn_sched_barrier(0)
__device__ __forceinline__ void cmask(f32x16&p0,f32x16&p1,int jb,int qrel,int hi){
  const float NEG=-INFINITY; int kb=64*jb+4*hi;
  #pragma unroll
  for(int r=0;r<16;++r){int kv=kb+(r&3)+8*(r>>2); if(kv>qrel)p0[r]=NEG; if(kv+32>qrel)p1[r]=NEG;}
}

constexpr int NSLOT=3, SLOTB=8192;
constexpr int LDS_K=0, LDS_V=NSLOT*SLOTB, LDS_WS=2*NSLOT*SLOTB, LDS_OST=LDS_WS+NW*64*4, LDS_SEL=LDS_OST+NW*4096, LDS_BYTES=LDS_SEL+NW*64*4;
constexpr float C2=0.125f*1.4426950408889634f;
__device__ __forceinline__ void glds16(const void*gsrc,unsigned lds_dst){unsigned keep;
  asm volatile("s_mov_b32 %0, m0\n\ts_mov_b32 m0, %2\n\ts_nop 0\n\tglobal_load_lds_dwordx4 %1, off\n\ts_mov_b32 m0, %0":"=&s"(keep):"v"(gsrc),"s"(lds_dst):"memory");}
__device__ __forceinline__ float max3f(float a,float b,float c){float r;asm("v_max3_f32 %0, %1, %2, %3":"=v"(r):"v"(a),"v"(b),"v"(c));return r;}
__device__ __forceinline__ float max2f(float a,float b){float r;asm("v_max_f32_e32 %0, %1, %2":"=v"(r):"v"(a),"v"(b));return r;}
__device__ __forceinline__ float fadd_s(float a,float b){float r;asm("v_add_f32_e32 %0, %1, %2":"=v"(r):"v"(a),"v"(b));return r;}
__device__ __forceinline__ float fsub_s(float a,float b){float r;asm("v_sub_f32_e32 %0, %1, %2":"=v"(r):"v"(a),"v"(b));return r;}
typedef float f32x2_t __attribute__((ext_vector_type(2))); typedef __bf16 bf16x2_t __attribute__((ext_vector_type(2)));
__device__ __forceinline__ unsigned cvtpk_s(float lo,float hi){f32x2_t v={lo,hi};bf16x2_t b=__builtin_convertvector(v,bf16x2_t);return __builtin_bit_cast(unsigned,b);}
#define WAIT_BAR(N) asm volatile("s_waitcnt vmcnt(" #N ") lgkmcnt(0)\n\ts_barrier":::"memory")

__device__ __forceinline__ void qkt(f32x16&p0,f32x16&p1,const char*Kslot,const bf16x8*qr,const f32x16&negm,int r32,int hi){
  const char*kb=Kslot+hi*1024+r32*16;
  #pragma unroll
  for(int d0=0;d0<4;++d0){
    const bf16x8 b0=*reinterpret_cast<const bf16x8*>(kb+d0*2048);
    const bf16x8 b1=*reinterpret_cast<const bf16x8*>(kb+d0*2048+512);
    if(d0==0){p0=__builtin_amdgcn_mfma_f32_32x32x16_bf16(b0,qr[0],negm,0,0,0);p1=__builtin_amdgcn_mfma_f32_32x32x16_bf16(b1,qr[0],negm,0,0,0);}
    else{p0=__builtin_amdgcn_mfma_f32_32x32x16_bf16(b0,qr[d0],p0,0,0,0);p1=__builtin_amdgcn_mfma_f32_32x32x16_bf16(b1,qr[d0],p1,0,0,0);}}
}
typedef __attribute__((address_space(3))) const char* lds_cptr;
typedef short v4i16_t __attribute__((ext_vector_type(4)));
__device__ __forceinline__ void kload8(bf16x8*kf,lds_cptr kp){
  kf[0]=*(const __attribute__((address_space(3))) bf16x8*)(kp);      kf[1]=*(const __attribute__((address_space(3))) bf16x8*)(kp+512);
  kf[2]=*(const __attribute__((address_space(3))) bf16x8*)(kp+2048); kf[3]=*(const __attribute__((address_space(3))) bf16x8*)(kp+2560);
  kf[4]=*(const __attribute__((address_space(3))) bf16x8*)(kp+4096); kf[5]=*(const __attribute__((address_space(3))) bf16x8*)(kp+4608);
  kf[6]=*(const __attribute__((address_space(3))) bf16x8*)(kp+6144); kf[7]=*(const __attribute__((address_space(3))) bf16x8*)(kp+6656);
}
__device__ __forceinline__ void kload2(bf16x8*kf,lds_cptr kp,int j){ kf[2*j]=*(const __attribute__((address_space(3))) bf16x8*)(kp+j*2048); kf[2*j+1]=*(const __attribute__((address_space(3))) bf16x8*)(kp+j*2048+512); }
__device__ __forceinline__ s16x4 vtr(lds_cptr p){ return __builtin_bit_cast(s16x4,__builtin_amdgcn_ds_read_tr16_b64_v4i16((__attribute__((address_space(3))) v4i16_t*)p)); }
__device__ __forceinline__ float rowmax(const f32x16&p0,const f32x16&p1){
  float a=max3f(p0[0],p0[1],p1[0]),b=max3f(p0[2],p0[3],p1[1]);a=max3f(a,p1[2],p1[3]);
  #pragma unroll
  for(int r=4;r<16;r+=4){a=max3f(a,p0[r],p0[r+1]);b=max3f(b,p0[r+2],p0[r+3]);a=max3f(a,p1[r],p1[r+1]);b=max3f(b,p1[r+2],p1[r+3]);}
  const float m=max2f(a,b);
  auto rr=__builtin_amdgcn_permlane32_swap(__float_as_uint(m),__float_as_uint(m),false,false);
  return max2f(__uint_as_float(rr[0]),__uint_as_float(rr[1]));
}
__device__ __forceinline__ void pv(f32x16*o,int vb,bf16x8 pa0,bf16x8 pa1,bf16x8 pa2,bf16x8 pa3){
  #pragma unroll
  for(int d0=0;d0<2;++d0){s16x4 lo[4],hi[4];
    #pragma unroll
    for(int ks=0;ks<4;++ks){
      asm volatile("ds_read_b64_tr_b16 %0,%1 offset:%c2":"=&v"(lo[ks]):"v"(vb),"i"(d0*4096+ks*1024):"memory");
      asm volatile("ds_read_b64_tr_b16 %0,%1 offset:%c2":"=&v"(hi[ks]):"v"(vb),"i"(d0*4096+ks*1024+512):"memory");}
    asm volatile("s_waitcnt lgkmcnt(0)":::"memory");SBAR();
    #define PK(k) (bf16x8){lo[k][0],lo[k][1],lo[k][2],lo[k][3],hi[k][0],hi[k][1],hi[k][2],hi[k][3]}
    o[d0]=__builtin_amdgcn_mfma_f32_32x32x16_bf16(pa0,PK(0),o[d0],0,0,0);
    o[d0]=__builtin_amdgcn_mfma_f32_32x32x16_bf16(pa1,PK(1),o[d0],0,0,0);
    o[d0]=__builtin_amdgcn_mfma_f32_32x32x16_bf16(pa2,PK(2),o[d0],0,0,0);
    o[d0]=__builtin_amdgcn_mfma_f32_32x32x16_bf16(pa3,PK(3),o[d0],0,0,0);
    #undef PK
  }
}

#ifndef ATTN_STORE16
#define ATTN_STORE16(p,v) (*(u32x4*)(p)=(v))
#endif
template<int THRL> __device__ __forceinline__ void attn_unit(int b,int h,int qb,const bf16*Q,const bf16*__restrict__ K,const bf16*__restrict__ V,bf16*O,const float*__restrict__ kbar,char*shm){
  int tid=threadIdx.x; asm volatile("":"+v"(tid)); const int lane=tid&63,r32=lane&31,hi=lane>>5; const int wid=__builtin_amdgcn_readfirstlane(tid>>6);
  const long rowbase=(long)b*SEQ; const int q0=qb*QB;
  const bf16*Qw=Q+(rowbase+q0+wid*QBLK)*DM+h*D;
  const bf16*Kh=K+rowbase*DM+h*D,*Vh=V+rowbase*DM+h*D;
  const unsigned lds0=(unsigned)(uintptr_t)shm;
  float*wsf=(float*)(shm+LDS_WS)+wid*64;
  const bf16*ksrc=Kh+(long)lane*DM+wid*8;
  const bf16*vsrc=Vh+(long)(16*(wid&3)+(lane>>2))*DM+(wid>>2)*32+(lane&3)*8;
  const unsigned kdst=lds0+LDS_K+wid*1024, vdst=lds0+LDS_V+wid*1024;
  #define DMA_K(t,slot) glds16(ksrc+(long)(t)*KVBLK*DM,(unsigned)__builtin_amdgcn_readfirstlane(kdst+(slot)))
  #define DMA_V(t,slot) glds16(vsrc+(long)(t)*KVBLK*DM,(unsigned)__builtin_amdgcn_readfirstlane(vdst+(slot)))
  const int vb0=(int)(lds0+LDS_V)+((lane>>4)&1)*32+(lane&3)*8+(4*hi+((lane&15)>>2))*64;
  const char*Kbase=shm+LDS_K; bf16x8 kf[8];
  const lds_cptr shm3=(lds_cptr)shm; const lds_cptr kp0=shm3+LDS_K+hi*1024+r32*16; const lds_cptr vp0=shm3+LDS_V+((lane>>4)&1)*32+(lane&3)*8+(4*hi+((lane&15)>>2))*64;
  const int NT=(q0+QB)/KVBLK;
  DMA_K(0,0);DMA_V(0,0);DMA_K(1,SLOTB);
  bf16x8 qr[4];
  #pragma unroll
  for(int d0=0;d0<4;++d0)qr[d0]=*reinterpret_cast<const bf16x8*>(&Qw[(long)r32*DM+d0*16+hi*8]);
  int selm=0;
  if(qb>0){
    float g[7]; int hi8=8*hi; asm volatile("":"+v"(hi8)); const float*kb=kbar+(size_t)(b*8)*512+h*64+hi8;
    #pragma unroll
    for(int n=0;n<7;++n){ float a=0.f;
      if(n<qb){
        #pragma unroll
        for(int d0=0;d0<4;++d0){ const float4 k0=*(const float4*)(kb+n*512+16*d0),k1=*(const float4*)(kb+n*512+16*d0+4); const bf16x8 qq=qr[d0];
          #define QF(e) __uint_as_float(((unsigned)(unsigned short)qq[e])<<16)
          a+=QF(0)*k0.x+QF(1)*k0.y+QF(2)*k0.z+QF(3)*k0.w+QF(4)*k1.x+QF(5)*k1.y+QF(6)*k1.z+QF(7)*k1.w;
          #undef QF
        } }
      a=::sum32(a); g[n]=(n<qb)?a:-INFINITY; asm volatile("":"+v"(g[n])::"memory"); }
    #pragma unroll
    for(int r=0;r<3;++r){ int best=-1; float bv=-INFINITY;
      #pragma unroll
      for(int n=0;n<7;++n) if(!((selm>>n)&1)&&g[n]>bv){bv=g[n];best=n;}
      if(best>=0)selm|=1<<best; }
  }
  selm|=1<<qb;
  typedef __attribute__((address_space(3))) int* lds_iptr;
  ((lds_iptr)(shm3+LDS_SEL))[tid]=selm;
  #define CURNEG(blk) ({ int t_=threadIdx.x; asm volatile("":"+v"(t_)); const int sm_=((lds_iptr)(shm3+LDS_SEL))[t_]; ((sm_>>(blk))&1)?0.f:-INFINITY; })
  #define NEGUPD(t) do{ if((((t)+1)&3)==0){ const float cn_=CURNEG(((t)+1)>>2); _Pragma("unroll") for(int r=0;r<16;++r)negm[r]=cn_-mhat; asm volatile("":"+v"(negm)); } }while(0)
  float mhat=0.f,l_reg=0.f;f32x16 o[2];o[0]=f32x16{};o[1]=f32x16{};f32x16 negm; { const float cn_=CURNEG(0); _Pragma("unroll") for(int r=0;r<16;++r)negm[r]=cn_; } asm volatile("":"+v"(negm));
  const int qrel=wid*QBLK+r32;
  #define CMASK(P0,P1,t) do{int jb_=(t)-(NT-4); if(jb_>=0)cmask(P0,P1,jb_,qrel,hi);}while(0)
  bool resc=false;
  #define START(P0,P1) do{ const float rm=rowmax(P0,P1); resc=false; \
    { const float dl=__builtin_fmaxf(rm,-24.f); mhat=fadd_s(mhat,dl); \
      _Pragma("unroll") for(int r=0;r<16;++r){P0[r]=fsub_s(P0[r],dl);P1[r]=fsub_s(P1[r],dl);} \
      { const float cn_=CURNEG(0); _Pragma("unroll") for(int r=0;r<16;++r)negm[r]=cn_-mhat; } asm volatile("":"+v"(negm)); } \
    _Pragma("unroll") for(int r=0;r<16;++r)P0[r]=__builtin_amdgcn_exp2f(P0[r]); }while(0)
  #define RESC() do{ if(resc){ asm volatile("s_waitcnt lgkmcnt(0)":::"memory"); \
      _Pragma("unroll") for(int d_=0;d_<2;++d_) _Pragma("unroll") for(int r=0;r<16;++r)o[d_][r]*=wsf[crow(r,hi)]; } }while(0)
  f32x16 pA0,pA1,pB0,pB1;
  int sl_prev=0,sl_cur=0,sl_next=SLOTB;
  #define ROT() do{sl_prev=sl_cur;sl_cur=sl_next;sl_next=(sl_next==(NSLOT-1)*SLOTB)?0:sl_next+SLOTB;}while(0)
  DMA_K(2,2*SLOTB);
  WAIT_BAR(3);
  qkt(pA0,pA1,Kbase,qr,negm,r32,hi);asm volatile("s_nop 15\n\ts_nop 7":"+v"(pA0),"+v"(pA1));CMASK(pA0,pA1,0);
  START(pA0,pA1);
  _Pragma("unroll") for(int r=0;r<16;++r)pA1[r]=__builtin_amdgcn_exp2f(pA1[r]);
  WAIT_BAR(0);
  DMA_K(3,0);DMA_V(1,SLOTB);
  ROT();
  kload8(kf,kp0+sl_cur);
  WAIT_BAR(2);
  s16x4 vlo[8],vhi[8]; u32x4 pw0,pw1,pw2,pw3;
  #define PKW(P,B) cvtpk_s(P[B],P[B+1])
  #define PAF(k) __builtin_bit_cast(bf16x8,pw##k)
  #define VFR(i) (bf16x8){vlo[i][0],vlo[i][1],vlo[i][2],vlo[i][3],vhi[i][0],vhi[i][1],vhi[i][2],vhi[i][3]}
  #define PIN(x) asm volatile("":"+v"(x))
  #define MX3(a,b,c) __builtin_fmaxf(__builtin_fmaxf((a),(b)),(c))
  #define GAPA(MF,A0,A1,A2,A3,W0,W1,PW) do{ MF; sacc+=A0; sacc+=A1; sacc+=A2; sacc+=A3; PIN(sacc); W0; W1; PIN(PW); SBAR(); }while(0)
  #define EX(v) __builtin_amdgcn_exp2f(v)
  #define GAPB(MF,X,B) do{ MF; X[B]=EX(X[B]); X[B+1]=EX(X[B+1]); X[B+2]=EX(X[B+2]); X[B+3]=EX(X[B+3]); PIN(X); SBAR(); }while(0)
  #define VRD(i) do{ vlo[i]=vtr(vp_+(((i)>>2)*4096+((i)&3)*1024)); vhi[i]=vtr(vp_+(((i)>>2)*4096+((i)&3)*1024+512)); }while(0)
  #define KRD(G,j) do{ if(G){ kload2(kf,kp0+sl_next,j); SBAR(); } }while(0)
  #define STEP(C0,C1,P0,P1,t,GK,GV,GL) do{ SBAR(); \
    const lds_cptr vp_=vp0+sl_prev; \
    VRD(0); SBAR(); float sacc=(P0[0]+P0[1]); \
    GAPA(C0=__builtin_amdgcn_mfma_f32_32x32x16_bf16(kf[0],qr[0],negm,0,0,0), P0[2],P0[3],P0[4],P0[5],     pw0[0]=PKW(P0,0), pw0[1]=PKW(P0,2), pw0); \
    VRD(4); SBAR(); GAPA(C1=__builtin_amdgcn_mfma_f32_32x32x16_bf16(kf[1],qr[0],negm,0,0,0), P0[6],P0[7],P0[8],P0[9],     pw0[2]=PKW(P0,4), pw0[3]=PKW(P0,6), pw0); \
    VRD(1); SBAR(); GAPA(C0=__builtin_amdgcn_mfma_f32_32x32x16_bf16(kf[2],qr[1],C0,0,0,0),   P0[10],P0[11],P0[12],P0[13], pw1[0]=PKW(P0,8), pw1[1]=PKW(P0,10), pw1); \
    VRD(5); SBAR(); GAPA(C1=__builtin_amdgcn_mfma_f32_32x32x16_bf16(kf[3],qr[1],C1,0,0,0),   P0[14],P0[15],P1[0],P1[1],   pw1[2]=PKW(P0,12),pw1[3]=PKW(P0,14), pw1); \
    VRD(2); SBAR(); GAPA(C0=__builtin_amdgcn_mfma_f32_32x32x16_bf16(kf[4],qr[2],C0,0,0,0),   P1[2],P1[3],P1[4],P1[5],     pw2[0]=PKW(P1,0), pw2[1]=PKW(P1,2), pw2); \
    VRD(6); SBAR(); GAPA(C1=__builtin_amdgcn_mfma_f32_32x32x16_bf16(kf[5],qr[2],C1,0,0,0),   P1[6],P1[7],P1[8],P1[9],     pw2[2]=PKW(P1,4), pw2[3]=PKW(P1,6), pw2); \
    VRD(3); SBAR(); GAPA(C0=__builtin_amdgcn_mfma_f32_32x32x16_bf16(kf[6],qr[3],C0,0,0,0),   P1[10],P1[11],P1[12],P1[13], pw3[0]=PKW(P1,8), pw3[1]=PKW(P1,10), pw3); \
    VRD(7); SBAR(); GAPA(C1=__builtin_amdgcn_mfma_f32_32x32x16_bf16(kf[7],qr[3],C1,0,0,0),   P1[14],P1[15],0.f,0.f,       pw3[2]=PKW(P1,12),pw3[3]=PKW(P1,14), pw3); \
    l_reg+=sacc; \
    if(GK){DMA_K((t)+3,sl_cur);} if(GV){DMA_V((t)+1,sl_next);} \
    CMASK(C0,C1,t); \
    { float a=MX3(C0[0],C0[1],C1[0]),b=MX3(C0[2],C0[3],C1[1]); a=MX3(a,C1[2],C1[3]); \
      _Pragma("unroll") for(int r=4;r<16;r+=4){a=MX3(a,C0[r],C0[r+1]);b=MX3(b,C0[r+2],C0[r+3]);a=MX3(a,C1[r],C1[r+1]);b=MX3(b,C1[r+2],C1[r+3]);} \
      float rm=__builtin_fmaxf(a,b); { auto rr=__builtin_amdgcn_permlane32_swap(__float_as_uint(rm),__float_as_uint(rm),false,false); rm=__builtin_fmaxf(__uint_as_float(rr[0]),__uint_as_float(rr[1])); } \
      resc=false; \
      if(__builtin_expect(__any(rm>(float)THRL),0)){ const float dl=__builtin_fmaxf(rm,0.f); mhat+=dl; \
        _Pragma("unroll") for(int r=0;r<16;++r){C0[r]-=dl;C1[r]-=dl;} \
        { const float cn_=CURNEG(((t)+1)>>2); _Pragma("unroll") for(int r=0;r<16;++r)negm[r]=cn_-mhat; } asm volatile("":"+v"(negm)); \
        const float f=__builtin_amdgcn_exp2f(-dl); l_reg*=f; if(hi==0)wsf[r32]=f; resc=true; } } \
    SBAR(); \
    GAPB(o[0]=__builtin_amdgcn_mfma_f32_32x32x16_bf16(PAF(0),VFR(0),o[0],0,0,0), C0,0); \
    GAPB(o[1]=__builtin_amdgcn_mfma_f32_32x32x16_bf16(PAF(0),VFR(4),o[1],0,0,0), C0,4); \
    KRD(GL,0); GAPB(o[0]=__builtin_amdgcn_mfma_f32_32x32x16_bf16(PAF(1),VFR(1),o[0],0,0,0), C0,8); \
    KRD(GL,1); GAPB(o[1]=__builtin_amdgcn_mfma_f32_32x32x16_bf16(PAF(1),VFR(5),o[1],0,0,0), C0,12); \
    KRD(GL,2); GAPB(o[0]=__builtin_amdgcn_mfma_f32_32x32x16_bf16(PAF(2),VFR(2),o[0],0,0,0), C1,0); \
    KRD(GL,3); GAPB(o[1]=__builtin_amdgcn_mfma_f32_32x32x16_bf16(PAF(2),VFR(6),o[1],0,0,0), C1,4); \
    GAPB(o[0]=__builtin_amdgcn_mfma_f32_32x32x16_bf16(PAF(3),VFR(3),o[0],0,0,0), C1,8); \
    GAPB(o[1]=__builtin_amdgcn_mfma_f32_32x32x16_bf16(PAF(3),VFR(7),o[1],0,0,0), C1,12); \
    }while(0)
  int t=1;
  #undef CMASK
  #define CMASK(P0,P1,t) do{}while(0)
  for(;t+5<NT;t+=2){
    STEP(pB0,pB1,pA0,pA1,t,true,true,true);     WAIT_BAR(2); RESC(); ROT(); NEGUPD(t);
    STEP(pA0,pA1,pB0,pB1,t+1,true,true,true);   WAIT_BAR(2); RESC(); ROT(); NEGUPD(t+1);
  }
  #undef CMASK
  #define CMASK(P0,P1,t) do{int jb_=(t)-(NT-4); if(jb_>=0)cmask(P0,P1,jb_,qrel,hi);}while(0)
  #define ENDW(tt) do{ if((tt)+3<NT){WAIT_BAR(2);} else if((tt)+2<NT){WAIT_BAR(1);} else {WAIT_BAR(0);} }while(0)
  for(;t+1<NT;t+=2){
    STEP(pB0,pB1,pA0,pA1,t,(t+3<NT),(t+1<NT),(t+1<NT));       ENDW(t);   RESC(); ROT(); NEGUPD(t);
    STEP(pA0,pA1,pB0,pB1,t+1,(t+4<NT),(t+2<NT),(t+2<NT));     ENDW(t+1); RESC(); ROT(); NEGUPD(t+1);
  }
  STEP(pB0,pB1,pA0,pA1,NT-1,false,false,false); RESC();
  { float sacc=pB0[0]+pB0[1]; _Pragma("unroll") for(int r=2;r<16;++r)sacc+=pB0[r]; _Pragma("unroll") for(int r=0;r<16;++r)sacc+=pB1[r]; l_reg+=sacc;
    pw0=(u32x4){PKW(pB0,0),PKW(pB0,2),PKW(pB0,4),PKW(pB0,6)};pw1=(u32x4){PKW(pB0,8),PKW(pB0,10),PKW(pB0,12),PKW(pB0,14)};pw2=(u32x4){PKW(pB1,0),PKW(pB1,2),PKW(pB1,4),PKW(pB1,6)};pw3=(u32x4){PKW(pB1,8),PKW(pB1,10),PKW(pB1,12),PKW(pB1,14)};
    SBAR(); pv(o,vb0+sl_cur,PAF(0),PAF(1),PAF(2),PAF(3)); }
  #undef PKW
  #undef PAF
  #undef VFR
  #undef PIN
  #undef MX3
  #undef GAPA
  #undef GAPB
  #undef EX
  #undef VRD
  #undef KRD
  #undef STEP
  #undef ENDW
  {auto rr=__builtin_amdgcn_permlane32_swap(__float_as_uint(l_reg),__float_as_uint(l_reg),false,false);l_reg=__uint_as_float(rr[0])+__uint_as_float(rr[1]);}
  if(hi==0)wsf[32+r32]=l_reg;asm volatile("s_waitcnt lgkmcnt(0)":::"memory");
  float rli[16];
  #pragma unroll
  for(int r=0;r<16;++r)rli[r]=__builtin_amdgcn_rcpf(wsf[32+crow(r,hi)]);
  bf16*Ow=O+(rowbase+q0+wid*QBLK)*DM+h*D;
  { bf16*stg=(bf16*)(shm+LDS_OST)+wid*2048;
    #pragma unroll
    for(int r=0;r<16;++r){const int orow=crow(r,hi);
      #pragma unroll
      for(int d0=0;d0<2;++d0)stg[orow*64+d0*32+r32]=__float2bfloat16(o[d0][r]*rli[r]);}
    asm volatile("s_waitcnt lgkmcnt(0)":::"memory");
    #pragma unroll
    for(int i=0;i<4;++i){const int row=i*8+(lane>>3),ch=lane&7; const u32x4 v=*(const u32x4*)(stg+row*64+ch*8); ATTN_STORE16(Ow+(long)row*DM+ch*8,v);} }
  asm volatile("s_waitcnt lgkmcnt(0)\n\ts_barrier":::"memory");
  #undef DMA_K
  #undef DMA_V
  #undef CMASK
  #undef START
  #undef CURNEG
  #undef NEGUPD
  #undef RESC
  #undef ROT
}
constexpr int ATTN_LDS_BYTES=LDS_BYTES;
struct AttnTensors { const bf16* Q; const bf16* K; const bf16* V; bf16* O; const float* kbar; };
struct AttnUnit { int bh; int qb; };
struct StaticOrder {
  int vcu,G;
  __device__ __forceinline__ explicit StaticOrder(int grid,int block):vcu((grid%8==0)?(block%8)*(grid/8)+block/8:block),G(grid){}
  __device__ __forceinline__ bool next(int i,AttnUnit&u)const{
    if(G==256){ if(i>=4)return false; const int s=vcu&1; u.bh=vcu>>1; u.qb=s?((i==0)?6:(i==1)?1:(i==2)?5:2):((i==0)?7:(i==1)?0:(i==2)?4:3); return true; }
    const int L=i*G+vcu; if(L>=1024)return false; u.bh=L>>3; u.qb=L&7; return true; }
  __device__ __forceinline__ void a_ready(const AttnUnit&)const{}
  __device__ __forceinline__ void done(const AttnUnit&)const{}
};
template<class Sched,int THRL=8> __device__ __forceinline__ void attn_phase(char*lds,const AttnTensors&T,const Sched&S){
  AttnUnit u;
  for(int i=0;S.next(i,u);++i){ S.a_ready(u); attn_unit<THRL>(u.bh/NHEAD,u.bh%NHEAD,u.qb,T.Q,T.K,T.V,T.O,T.kbar,lds); S.done(u); }
}
#undef SBAR
#undef WAIT_BAR
}
constexpr int NWAVES = 8;
constexpr int T = 32768, D = 1024, SEQ = 2048, MEMROWS = 4096, INW = 5120;
constexpr float RMS_EPS = 1e-6f;
constexpr size_t MiB = 1u << 20;
constexpr size_t WS_CTL = 0, CTL_ZERO_BYTES = 2 * MiB, WS_KBAR = 1 * MiB;
constexpr size_t WS_WIN = 2 * MiB, WS_WC = 12 * MiB, WS_WA = 13 * MiB, WS_WM = 14 * MiB, WS_WXQ = 16 * MiB, WS_WXKV = 18 * MiB, WS_WXO = 22 * MiB, WS_MT = 24 * MiB, WS_ROPE = 28 * MiB;
constexpr size_t WS_MEMN = 32 * MiB, WS_KX = 40 * MiB, WS_VXT = 48 * MiB;
constexpr size_t WS_SSQ1 = 30 * MiB, WS_SSQ2 = 56 * MiB;
constexpr size_t WS_A = 64 * MiB;
constexpr size_t WS_YC = 128 * MiB, WS_QO = 160 * MiB, WS_U = 192 * MiB, WS_K = 224 * MiB, WS_V = 256 * MiB;
constexpr size_t WS_SGC = 320 * MiB, WS_SGA = 384 * MiB;
constexpr size_t WS_EIDX = 448 * MiB, WS_GW = 464 * MiB, WS_PW = 480 * MiB, WS_END = 496 * MiB;
constexpr size_t WS_U8 = 288 * MiB, WS_V8T = 304 * MiB, WS_SU = 29 * MiB, WS_SV = 29 * MiB + 512 * 1024;
constexpr size_t WS_QX = 128 * MiB, WS_PM = 192 * MiB, WS_OX = 128 * MiB;
constexpr size_t WS_PO = 128 * MiB;
constexpr size_t WS_SC = 128 * MiB;
constexpr int CW_TMO = 0, CW_BAR = 4096, CW_Q = 8192;
constexpr int RING_OFF = 0, RING_BYTES = 131072;
constexpr int LDSCTL_OFF = RING_BYTES, MISC_OFF = LDSCTL_OFF + 320;
constexpr int LDS_BYTES = 163840;
constexpr int UL_OFF = RING_BYTES + 512, UL_WAVE = (LDS_BYTES - UL_OFF) / 8, UL_CAP = ((UL_WAVE - 64) / 16) & ~15;

#define GAS __attribute__((address_space(1)))
#define LAS __attribute__((address_space(3)))
typedef unsigned short bf16;
typedef unsigned v4u __attribute__((ext_vector_type(4)));
typedef unsigned v2u __attribute__((ext_vector_type(2)));
typedef float f32x4 __attribute__((ext_vector_type(4)));
typedef float f32x2v __attribute__((ext_vector_type(2)));
typedef _Float16 h2v __attribute__((ext_vector_type(2)));
typedef GAS unsigned gu32;
#define RLX_AGENT __ATOMIC_RELAXED, __HIP_MEMORY_SCOPE_AGENT
#define LDS_WAIT() asm volatile("s_waitcnt lgkmcnt(0)" ::: "memory")
#define VM_WAIT() asm volatile("s_waitcnt vmcnt(0)" ::: "memory")
__device__ __forceinline__ unsigned pk2(float lo, float hi) { return pg8::cvt_pk_bf16(lo, hi); }
__device__ __forceinline__ float bflo(unsigned u) { return __uint_as_float(u << 16); }
__device__ __forceinline__ float bfhi(unsigned u) { return __uint_as_float(u & 0xffff0000u); }

#define XB_TMO      128
#define XB_XCNT(j)  (256  + 64 * (j))
#define XB_XSUB(j)  (1280 + 64 * (j))
#define XB_XGEN(j)  (2304 + 64 * (j))
#define XB_TOP      3328
#define XB_TOPGEN   3392
#define XCD_BAR_WORDS 3456
#define XB_SPIN_CAP (1u << 18)
__device__ __forceinline__ unsigned xb_ld(unsigned* p)              { return __hip_atomic_load(p, __ATOMIC_RELAXED, __HIP_MEMORY_SCOPE_AGENT); }
__device__ __forceinline__ unsigned xb_add(unsigned* p, unsigned v) { return __hip_atomic_fetch_add(p, v, __ATOMIC_RELAXED, __HIP_MEMORY_SCOPE_AGENT); }
__device__ __forceinline__ unsigned xb_xcc_id() { return (unsigned)__builtin_amdgcn_s_getreg((3 << 11) | 20) & 0xFu; }
#define XB_SPIN(cond, bar) do { unsigned _sp = 0; while (cond) { __builtin_amdgcn_s_sleep(1); \
    if ((++_sp & 255u) == 0u) { if (xb_ld(&(bar)[XB_TMO])) break; if (_sp > XB_SPIN_CAP) { atomicAdd(&(bar)[XB_TMO], 1u); break; } } } } while (0)
struct XcdBarrier { unsigned* bar; unsigned x; volatile LAS unsigned* st; };
__device__ __forceinline__ XcdBarrier xcd_barrier_post(unsigned* bar, volatile LAS unsigned* st) {
    XcdBarrier b; b.bar = bar; b.x = xb_xcc_id(); b.st = st;
    if (threadIdx.x == 0) (void)xb_add(&bar[XB_XCNT(b.x)], 1u);
    return b;
}
__device__ __forceinline__ void xcd_barrier_complete(unsigned* bar, unsigned x, unsigned& nloc, unsigned& nx) {
    const unsigned G = gridDim.x * gridDim.y * gridDim.z;
    unsigned sum, cnt, mine, sp = 0u;
    for (;;) {
        sum = 0u; cnt = 0u; mine = 0u;
#pragma unroll
        for (unsigned j = 0; j < 16; ++j) { const unsigned c = xb_ld(&bar[XB_XCNT(j)]); sum += c; cnt += (c > 0u) ? 1u : 0u; mine = (j == x) ? c : mine; }
        if (sum == G) break;
        __builtin_amdgcn_s_sleep(1);
        if ((++sp & 255u) == 0u) { if (xb_ld(&bar[XB_TMO])) break; if (sp > XB_SPIN_CAP) { atomicAdd(&bar[XB_TMO], 1u); break; } }
    }
    nloc = mine > 0u ? mine : 1u; nx = cnt > 0u ? cnt : 1u;
}
__device__ __forceinline__ void xcd_barrier(const XcdBarrier& b) {
    asm volatile("s_waitcnt vmcnt(0)" ::: "memory");
    __syncthreads();
    if (threadIdx.x == 0) {
        unsigned* bar = b.bar;
        __builtin_amdgcn_s_waitcnt(0);
        unsigned nloc = b.st[0], nx = b.st[1];
        if (nloc == 0u) { xcd_barrier_complete(bar, b.x, nloc, nx); b.st[0] = nloc; b.st[1] = nx; }
        const unsigned old = xb_add(&bar[XB_XSUB(b.x)], 1u);
        const unsigned gen = old / nloc;
        if (old + 1u == (gen + 1u) * nloc) {
            __builtin_amdgcn_fence(__ATOMIC_RELEASE, "agent");
            asm volatile("s_waitcnt vmcnt(0)" ::: "memory");
            const unsigned og = xb_add(&bar[XB_TOP], 1u);
            const unsigned tg = og / nx;
            if (og + 1u == (tg + 1u) * nx) xb_add(&bar[XB_TOPGEN], 1u);
            else XB_SPIN(xb_ld(&bar[XB_TOPGEN]) == tg, bar);
            __builtin_amdgcn_fence(__ATOMIC_ACQUIRE, "agent");
            xb_add(&bar[XB_XGEN(b.x)], 1u);
            asm volatile("s_waitcnt vmcnt(0)" ::: "memory");
        } else {
            XB_SPIN(xb_ld(&bar[XB_XGEN(b.x)]) == gen, bar);
            __builtin_amdgcn_fence(__ATOMIC_ACQUIRE, "agent");
            asm volatile("s_waitcnt vmcnt(0)" ::: "memory");
        }
    }
    __syncthreads();
}

struct MapId { static __device__ __forceinline__ int src(int j) { return j; } };
struct MapWin {
    static __device__ __forceinline__ int src(int j) {
        if (j < 1024) { const int g8 = j >> 3, i = j & 7; return ((i < 4) ? 0 : 1024) + 4 * g8 + (i & 3); }
        if (j < 1536) return 512 + (j - 1024);
        if (j < 2560) { const int jj = j - 1536, qk = jj >> 9, p = jj & 511, head = p >> 6, pl = p & 63, g = pl >> 3, i = pl & 7; return 1536 + qk * 512 + head * 64 + 4 * g + (i & 3) + 32 * (i >> 2); }
        return j;
    }
};
template <class MAP>
__device__ __forceinline__ void p0_transpose_item(const float* W, int K, int N, int NOUT, bf16* WT, LAS float* scr, int item, int lane, const float* gain = nullptr) {
    const int nblk = NOUT / 32, kb = item / nblk, nb = item % nblk, k0 = 64 * kb, n0 = 32 * nb;
    const int sc = MAP::src(n0 + (lane & 31));
#pragma unroll 8
    for (int i = 0; i < 32; ++i) { const int kk = 2 * i + (lane >> 5); const float gk = gain ? gain[k0 + kk] : 1.f; scr[kk * 33 + (lane & 31)] = W[(size_t)(k0 + kk) * N + sc] * gk; }
    LDS_WAIT(); asm volatile("" ::: "memory");
    const int c = lane & 7;
#pragma unroll
    for (int j = 0; j < 4; ++j) { const int n = (lane >> 3) + 8 * j; const LAS float* s = scr + (8 * c) * 33 + n;
        v4u o; o.x = pk2(s[0 * 33], s[1 * 33]); o.y = pk2(s[2 * 33], s[3 * 33]); o.z = pk2(s[4 * 33], s[5 * 33]); o.w = pk2(s[6 * 33], s[7 * 33]);
        *(GAS v4u*)(WT + (size_t)(n0 + n) * K + k0 + 8 * c) = o; }
    LDS_WAIT(); asm volatile("" ::: "memory");
}
__device__ __forceinline__ void rms_row_to_bf16(const float* xrow, const float* g, bf16* orow, int lane) {
    const GAS f32x4* xr = (const GAS f32x4*)xrow + lane; const GAS f32x4* gr = (const GAS f32x4*)g + lane;
    f32x4 v[4]; float s = 0.f;
#pragma unroll
    for (int j = 0; j < 4; ++j) { v[j] = xr[64 * j]; s += (v[j].x * v[j].x + v[j].y * v[j].y) + (v[j].z * v[j].z + v[j].w * v[j].w); }
    const float r = rsqrtf(wave_sum(s) * (1.f / 1024.f) + RMS_EPS);
    GAS v2u* o8 = (GAS v2u*)orow + lane;
#pragma unroll
    for (int j = 0; j < 4; ++j) { const f32x4 gg = gr[64 * j]; v2u w; w.x = pk2(v[j].x * r * gg.x, v[j].y * r * gg.y); w.y = pk2(v[j].z * r * gg.z, v[j].w * r * gg.w); o8[64 * j] = w; }
}
__device__ __forceinline__ float fmax_asm(float a, float b) { float r; asm("v_max_f32 %0, %1, %2" : "=v"(r) : "v"(a), "v"(b)); return r; }
__device__ __forceinline__ float fmin_asm(float a, float b) { float r; asm("v_min_f32 %0, %1, %2" : "=v"(r) : "v"(a), "v"(b)); return r; }

#ifndef PH_MASK
#define PH_MASK 0xFFFFFFFFu
#endif
#define PH(k) ((PH_MASK >> (k)) & 1u)
#ifndef REP_MASK
#define REP_MASK 0u
#endif
#define NREP(k) (((REP_MASK >> (k)) & 1u) ? 2 : 1)
#ifndef DIAG_TS_A
#define DIAG_TS_A -1
#endif
#ifndef DIAG_TS_B
#define DIAG_TS_B -1
#endif
struct Args { const float* in[19]; float* out; unsigned char* ws; };

struct XOrder {
    const char* A; const char* Bt; int G, c, i0, mode;
    __device__ bool next(int i, pg8::Unit& u) const {
        if (i > 0) return false;
        const int L = i0 * G + c; if (L >= 512) return false;
        const int b = L >> 5, head = (L >> 3) & 3, rt = L & 7;
        u.pm = b * 8 + rt; u.pn = head;
        if (mode == 0) { u.a = A + (size_t)(b * 2048 + rt * 256) * 1024 * 2; u.b = Bt + (size_t)(head * 256) * 1024 * 2; }
        else { u.a = A + ((size_t)(b * 2048 + rt * 256) * 1024 + head * 256) * 2;
               u.b = (mode == 2) ? Bt + ((size_t)(head * 256) * 4096 + b * 256) * 2 : Bt + ((size_t)(b * 256) * 1024 + head * 256) * 2; }
        return true;
    }
};

__global__ void __launch_bounds__(NWAVES * 64, 2) mk_fwd(Args args) {
    extern __shared__ __attribute__((aligned(16))) unsigned char lds[];
    LAS unsigned char* L = (LAS unsigned char*)lds;
    volatile LAS unsigned* MISC = (volatile LAS unsigned*)(L + MISC_OFF);
    const int wave = __builtin_amdgcn_readfirstlane((int)threadIdx.x >> 6);
#define PH_LANES int tid = threadIdx.x; asm volatile("" : "+v"(tid)); const int lane = tid & 63; const int gt = vcu * (NWAVES * 64) + tid; (void)lane; (void)gt
    const int G = gridDim.x; const int bx = blockIdx.x; const int vcu = (G % 8 == 0) ? (bx % 8) * (G / 8) + bx / 8 : bx;
    unsigned char* ws = args.ws;
    gu32* ctl = (gu32*)(ws + WS_CTL);
    for (int u = threadIdx.x; u < (LDS_BYTES - LDSCTL_OFF) / 4; u += NWAVES * 64) ((LAS unsigned*)(L + LDSCTL_OFF))[u] = 0u;
    __syncthreads();
    XcdBarrier bar = xcd_barrier_post((unsigned*)(ctl + CW_BAR), MISC + 8);
    unsigned long long* tsw = (unsigned long long*)(ws + WS_CTL + 65536);
    int n_ts = 0;
#define TSTAMP() do { if (DIAG_TS_A >= 0) { if (bx == 0 && threadIdx.x == 0) tsw[n_ts] = __builtin_amdgcn_s_memrealtime(); ++n_ts; } } while (0)
    TSTAMP();

    const float *x = args.in[0], *mem = args.in[1], *g_mix = args.in[2], *w_in = args.in[3], *w_conv = args.in[4], *w_conv_out = args.in[5], *w_attn_out = args.in[6], *w_merge = args.in[7],
                *g_xattn = args.in[8], *g_mem = args.in[9], *w_xq = args.in[10], *w_xkv = args.in[11], *w_xo = args.in[12], *g_ffn = args.in[13], *w_pq = args.in[14], *sub_keys = args.in[15],
                *peer_u = args.in[16], *peer_v = args.in[17], *g_final = args.in[18];
    float* out = args.out;
    bf16 *WinT = (bf16*)(ws + WS_WIN), *WcT = (bf16*)(ws + WS_WC), *WaT = (bf16*)(ws + WS_WA), *WmT = (bf16*)(ws + WS_WM), *WxqT = (bf16*)(ws + WS_WXQ), *WxkvT = (bf16*)(ws + WS_WXKV),
         *WxoT = (bf16*)(ws + WS_WXO), *MT = (bf16*)(ws + WS_MT);
    float* ropec = (float*)(ws + WS_ROPE); float* ropes = ropec + 2048 * 32;
    float* kbar = (float*)(ws + WS_KBAR);
    bf16 *MEMN = (bf16*)(ws + WS_MEMN), *KX = (bf16*)(ws + WS_KX), *VXT = (bf16*)(ws + WS_VXT), *A = (bf16*)(ws + WS_A);
    bf16 *YC = (bf16*)(ws + WS_YC), *QO = (bf16*)(ws + WS_QO), *U = (bf16*)(ws + WS_U), *KB = (bf16*)(ws + WS_K), *VB = (bf16*)(ws + WS_V), *SGC = (bf16*)(ws + WS_SGC), *SGA = (bf16*)(ws + WS_SGA);
    bf16 *QX = (bf16*)(ws + WS_QX), *PM = (bf16*)(ws + WS_PM), *OX = (bf16*)(ws + WS_OX);
    _Float16* SC = (_Float16*)(ws + WS_SC);
    int* EIDX = (int*)(ws + WS_EIDX); float* GW = (float*)(ws + WS_GW); unsigned* PW = (unsigned*)(ws + WS_PW);
    float* PO = (float*)(ws + WS_PO); float* SSQ1 = (float*)(ws + WS_SSQ1); float* SSQ2 = (float*)(ws + WS_SSQ2); (void)PO;
    unsigned char* U8 = ws + WS_U8; unsigned char* V8T = ws + WS_V8T; float* SU = (float*)(ws + WS_SU); float* SV = (float*)(ws + WS_SV);
    const int gw = vcu * NWAVES + wave, NGW = G * NWAVES;
    const int NGT = G * NWAVES * 64;

    asm volatile("; ===== PHASE 0 =====");
    if (PH(0)) for (int rep = 0; rep < NREP(0); ++rep) {
        PH_LANES; const bool dummy = rep < NREP(0) - 1; (void)dummy;
        LAS float* scr = (LAS float*)(L + RING_OFF + wave * 16384);
        constexpr int I_IN = (1024 / 64) * (5120 / 32), I_C = (512 / 64) * (1024 / 32), I_M = (1024 / 64) * (1024 / 32), I_KV = (1024 / 64) * (2048 / 32);
        constexpr int NITEMS = I_IN + 2 * I_C + 3 * I_M + I_KV;
        for (int it = gw; it < NITEMS; it += NGW) {
            int r = it;
            if (r < I_IN) { p0_transpose_item<MapWin>(w_in, 1024, 5120, 5120, WinT, scr, r, lane); continue; } r -= I_IN;
            if (r < I_C) { p0_transpose_item<MapId>(w_conv_out, 512, 1024, 1024, WcT, scr, r, lane); continue; } r -= I_C;
            if (r < I_C) { p0_transpose_item<MapId>(w_attn_out, 512, 1024, 1024, WaT, scr, r, lane); continue; } r -= I_C;
            if (r < I_M) { p0_transpose_item<MapId>(w_merge, 1024, 1024, 1024, WmT, scr, r, lane); continue; } r -= I_M;
            if (r < I_M) { p0_transpose_item<MapId>(w_xq, 1024, 1024, 1024, WxqT, scr, r, lane, g_xattn); continue; } r -= I_M;
            if (r < I_M) { p0_transpose_item<MapId>(w_xo, 1024, 1024, 1024, WxoT, scr, r, lane); continue; } r -= I_M;
            p0_transpose_item<MapId>(w_xkv, 1024, 2048, 2048, WxkvT, scr, r, lane);
        }
        for (int m = gw; m < T; m += NGW) rms_row_to_bf16(x + (size_t)m * D, g_mix, A + (size_t)m * D, lane);
        for (int m = gw; m < MEMROWS; m += NGW) rms_row_to_bf16(mem + (size_t)m * D, g_mem, MEMN + (size_t)m * D, lane);
        for (int i = gt; i < 2048 * 32; i += NGT) { const int pos = i >> 5, f = i & 31; const float inv = powf(10000.0f, -(float)f / 32.0f); const float ang = (float)pos * inv; ropec[i] = cosf(ang); ropes[i] = sinf(ang); }
        __syncthreads();
        {
            LAS float* skl = (LAS float*)(L + RING_OFF);
            LAS float* wtl = skl + 128 * 129;
            for (int it = bx; it < 256; it += G) {
                const int hp = it >> 4, cb = it & 15;
                for (int i = tid; i < 128 * 128; i += NWAVES * 64) { const int n = i >> 7, d = i & 127; skl[n * 129 + d] = sub_keys[((size_t)hp * 128 + n) * 128 + d]; }
                for (int i = tid; i < 64 * 128; i += NWAVES * 64) { const int c = i >> 7, d = i & 127; wtl[c * 129 + d] = w_pq[(size_t)(cb * 64 + c) * 2048 + hp * 128 + d] * g_ffn[cb * 64 + c]; }
                __syncthreads();
                const int cg = tid & 15, ng = tid >> 4;
                float acc[4][4];
#pragma unroll
                for (int i = 0; i < 4; ++i)
#pragma unroll
                    for (int j = 0; j < 4; ++j) acc[i][j] = 0.f;
                for (int d = 0; d < 128; ++d) {
                    float wv[4], sv[4];
#pragma unroll
                    for (int i = 0; i < 4; ++i) { wv[i] = wtl[(4 * cg + i) * 129 + d]; sv[i] = skl[(4 * ng + i) * 129 + d]; }
#pragma unroll
                    for (int i = 0; i < 4; ++i)
#pragma unroll
                        for (int j = 0; j < 4; ++j) acc[i][j] += sv[i] * wv[j];
                }
#pragma unroll
                for (int i = 0; i < 4; ++i) { v2u w; w.x = pk2(acc[i][0], acc[i][1]); w.y = pk2(acc[i][2], acc[i][3]); *(GAS v2u*)(MT + (size_t)(hp * 128 + 4 * ng + i) * 1024 + cb * 64 + 4 * cg) = w; }
                __syncthreads();
            }
        }
    }
    xcd_barrier(bar); TSTAMP();

    asm volatile("; ===== PHASE 1 =====");
    if (PH(1)) for (int rep = 0; rep < NREP(1); ++rep) {
        PH_LANES; const bool dummy = rep < NREP(1) - 1; (void)dummy;
        pg8::Gemm g{1024, 1024, 1024}; pg8::StaticOrder S; S.init(A, 1024, WinT, 1024, T, INW, G, bx);
        pg8::EpiIn E{U, YC, QO, KB, VB, SGC, SGA, ropec, ropes, kbar, 0.125f * 1.4426950408889634f};
        pg8::gemm_phase<pg8::EpiIn, pg8::StaticOrder, true>(L + RING_OFF, g, S, E);
    }
    if (PH(1)) for (int rep = 0; rep < NREP(1); ++rep) {
        PH_LANES; const bool dummy = rep < NREP(1) - 1; (void)dummy;
        pg8::Gemm g{1024, 1024, 1024}; pg8::StaticOrder S; S.init(MEMN, 1024, WxkvT, 1024, MEMROWS, 1024, G, bx);
        pg8::EpiBf16 E{KX, 1024};
        pg8::gemm_phase<pg8::EpiBf16, pg8::StaticOrder, true>(L + RING_OFF, g, S, E);
    }
    if (PH(1)) for (int rep = 0; rep < NREP(1); ++rep) {
        PH_LANES; const bool dummy = rep < NREP(1) - 1; (void)dummy;
        pg8::Gemm g{1024, 1024, 1024}; pg8::StaticOrder S; S.init(WxkvT + (size_t)1024 * 1024, 1024, MEMN, 1024, 1024, MEMROWS, G, (bx + 128) % G);
        pg8::EpiBf16 E{VXT, 4096};
        pg8::gemm_phase<pg8::EpiBf16, pg8::StaticOrder, true>(L + RING_OFF, g, S, E);
    }
    if (PH(1)) for (int rep = 0; rep < NREP(1); ++rep) {
        PH_LANES; const bool dummy = rep < NREP(1) - 1; (void)dummy;
        int cb, ncb;
        if (G == 256) { const bool idle = (bx >= 64 && bx < 128) || bx >= 192; cb = idle ? ((bx < 128) ? bx - 64 : bx - 128) : 256; ncb = 128; } else { cb = bx; ncb = G; }
        const int cw = cb * NWAVES + wave, ncw = ncb * NWAVES;
        for (int e = (cb < ncb ? cw : 16384); e < 16384; e += ncw) {
            const GAS f32x4* r = (const GAS f32x4*)(peer_u + (size_t)e * D) + lane; f32x4 v[4]; float am = 0.f;
#pragma unroll
            for (int j = 0; j < 4; ++j) { v[j] = r[64 * j] * ((const GAS f32x4*)g_ffn + lane)[64 * j]; am = fmaxf(fmaxf(am, fmaxf(fabsf(v[j].x), fabsf(v[j].y))), fmaxf(fabsf(v[j].z), fabsf(v[j].w))); }
            am = wave_max(am);
            const float sc = am > 0.f ? 127.f / am : 1.f; if (lane == 0) SU[e] = am > 0.f ? am * (1.f / 127.f) : 1.f;
#pragma unroll
            for (int j = 0; j < 4; ++j) { const unsigned w = ((unsigned)(int)rintf(v[j].x * sc) & 255u) | (((unsigned)(int)rintf(v[j].y * sc) & 255u) << 8) | (((unsigned)(int)rintf(v[j].z * sc) & 255u) << 16) | (((unsigned)(int)rintf(v[j].w * sc) & 255u) << 24);
                *(GAS unsigned*)(U8 + (size_t)e * 1024 + 4 * lane + 256 * j) = w; }
        }
        __syncthreads();
        for (int it = cb; it < 256; it += ncb) {
            const int e0 = it * 64;
#pragma unroll 1
            for (int rr = 0; rr < 8; ++rr) {
                const int el = wave * 8 + rr, e = e0 + el;
                const GAS f32x4* r = (const GAS f32x4*)(peer_v + (size_t)e * D) + lane; f32x4 v[4]; float am = 0.f;
#pragma unroll
                for (int j = 0; j < 4; ++j) { v[j] = r[64 * j]; am = fmaxf(fmaxf(am, fmaxf(fabsf(v[j].x), fabsf(v[j].y))), fmaxf(fabsf(v[j].z), fabsf(v[j].w))); }
                am = wave_max(am);
                const float sc = am > 0.f ? 384.f / am : 1.f; if (lane == 0) SV[e] = am > 0.f ? am * (1.f / 384.f) : 1.f;
#pragma unroll
                for (int j = 0; j < 4; ++j) { int w = __builtin_amdgcn_cvt_pk_fp8_f32(v[j].x * sc, v[j].y * sc, 0, false); w = __builtin_amdgcn_cvt_pk_fp8_f32(v[j].z * sc, v[j].w * sc, w, true);
                    *(LAS unsigned*)(L + RING_OFF + el * 1024 + 4 * lane + 256 * j) = (unsigned)w; }
            }
            __syncthreads();
#pragma unroll
            for (int i = 0; i < 8; ++i) { const int idx = tid + 512 * i, sl = idx >> 5, k = idx & 31;
                const v2u a0 = *(const LAS v2u*)(L + RING_OFF + (2 * k) * 1024 + sl * 8), a1 = *(const LAS v2u*)(L + RING_OFF + (2 * k + 1) * 1024 + sl * 8);
                *(GAS v4u*)(V8T + ((size_t)sl * 16384 + e0 + 2 * k) * 8) = (v4u){a0.x, a0.y, a1.x, a1.y}; }
            __syncthreads();
        }
    }
    xcd_barrier(bar); TSTAMP();

    asm volatile("; ===== PHASE 2 =====");
    if (PH(2)) for (int rep = 0; rep < NREP(2); ++rep) {
        PH_LANES; const bool dummy = rep < NREP(2) - 1; (void)dummy;
        for (int i = gt; i < T * 64; i += NGT) {
            const int row = i >> 6, cg = i & 63, s = row & 2047;
            const v4u u0 = *(const GAS v4u*)(U + (size_t)row * 512 + cg * 8);
            v4u u1 = (v4u){0u, 0u, 0u, 0u}, u2 = (v4u){0u, 0u, 0u, 0u};
            if (s >= 1) u1 = *(const GAS v4u*)(U + (size_t)(row - 1) * 512 + cg * 8);
            if (s >= 2) u2 = *(const GAS v4u*)(U + (size_t)(row - 2) * 512 + cg * 8);
            const v4u bq = *(const GAS v4u*)(YC + (size_t)row * 512 + cg * 8);
            const f32x4 w0a = *(const GAS f32x4*)(w_conv + cg * 8), w0b = *(const GAS f32x4*)(w_conv + cg * 8 + 4);
            const f32x4 w1a = *(const GAS f32x4*)(w_conv + 512 + cg * 8), w1b = *(const GAS f32x4*)(w_conv + 512 + cg * 8 + 4);
            const f32x4 w2a = *(const GAS f32x4*)(w_conv + 1024 + cg * 8), w2b = *(const GAS f32x4*)(w_conv + 1024 + cg * 8 + 4);
            v4u o;
#define CONV2(q, wa, ia, ib) pk2(bflo(bq.q) * (w0##wa[ia] * bflo(u2.q) + w1##wa[ia] * bflo(u1.q) + w2##wa[ia] * bflo(u0.q)), bfhi(bq.q) * (w0##wa[ib] * bfhi(u2.q) + w1##wa[ib] * bfhi(u1.q) + w2##wa[ib] * bfhi(u0.q)))
            o.x = CONV2(x, a, 0, 1); o.y = CONV2(y, a, 2, 3); o.z = CONV2(z, b, 0, 1); o.w = CONV2(w, b, 2, 3);
#undef CONV2
            { const bool conv_dummy = (NREP(2) == 2) && !dummy; *(GAS v4u*)(YC + (size_t)row * 512 + cg * 8) = conv_dummy ? bq : o; }
        }
        __syncthreads();
        const attn_body::AttnTensors AT{(const attn_body::bf16*)QO, (const attn_body::bf16*)KB, (const attn_body::bf16*)VB, (attn_body::bf16*)(dummy ? A : QO), kbar};
        const attn_body::StaticOrder S(G, bx);
        attn_body::attn_phase<attn_body::StaticOrder>((char*)lds + RING_OFF, AT, S);
    }
    xcd_barrier(bar); TSTAMP();

    asm volatile("; ===== PHASE 3 =====");
    if (PH(3)) for (int rep = 0; rep < NREP(3); ++rep) {
        PH_LANES; const bool dummy = rep < NREP(3) - 1; (void)dummy;
        pg8::Gemm g{512, 512, 512}; pg8::StaticOrder S; S.init(YC, 512, WcT, 512, T, 1024, G, bx);
        pg8::EpiGateMul E{SGC, dummy ? A : SGC, 1024};
        pg8::gemm_phase<pg8::EpiGateMul, pg8::StaticOrder, true>(L + RING_OFF, g, S, E);
    }
    if (PH(3)) for (int rep = 0; rep < NREP(3); ++rep) {
        PH_LANES; const bool dummy = rep < NREP(3) - 1; (void)dummy;
        pg8::Gemm g{512, 512, 512}; pg8::StaticOrder S; S.init(QO, 512, WaT, 512, T, 1024, G, bx);
        pg8::EpiGateFma E{SGC, SGA, dummy ? A : SGA, 1024};
        pg8::gemm_phase<pg8::EpiGateFma, pg8::StaticOrder, true>(L + RING_OFF, g, S, E);
    }
    xcd_barrier(bar); TSTAMP();

    asm volatile("; ===== PHASE 4 =====");
    if (PH(4)) for (int rep = 0; rep < NREP(4); ++rep) {
        PH_LANES; const bool dummy = rep < NREP(4) - 1; (void)dummy;
        pg8::Gemm g{1024, 1024, 1024}; pg8::StaticOrder S; S.init(SGA, 1024, WmT, 1024, T, 1024, G, bx);
        pg8::EpiResNorm<true> E{x, A, SSQ1, 1024, 1.f};
        pg8::gemm_phase<pg8::EpiResNorm<true>, pg8::StaticOrder, true>(L + RING_OFF, g, S, E);
    }
    xcd_barrier(bar); TSTAMP();

    asm volatile("; ===== PHASE 6 =====");
    if (PH(6)) for (int rep = 0; rep < NREP(6); ++rep) {
        PH_LANES; const bool dummy = rep < NREP(6) - 1; (void)dummy;
        const pg8::Gemm gq{1024, 1024, 1024}, gs{1024, 1024, 256}, gv{1024, 4096, 256};
        const pg8::EpiBf16RS Eq{QX, 1024, SSQ1}; const pg8::EpiSoftmax Es{PM, 1024, 0.0625f * 1.4426950408889634f}; const pg8::EpiBf16 Ev{OX, 1024};
        { XOrder S{(const char*)A, (const char*)WxqT, G, vcu, 0, 0}; pg8::gemm_phase<pg8::EpiBf16RS, XOrder, false>(L + RING_OFF, gq, S, Eq); }
        VM_WAIT(); __syncthreads();
        { XOrder S{(const char*)QX, (const char*)KX, G, vcu, 0, 1}; pg8::gemm_phase<pg8::EpiSoftmax, XOrder, false>(L + RING_OFF, gs, S, Es); }
        VM_WAIT(); __syncthreads();
        { XOrder S{(const char*)PM, (const char*)VXT, G, vcu, 0, 2}; pg8::gemm_phase<pg8::EpiBf16, XOrder, false>(L + RING_OFF, gv, S, Ev); }
        VM_WAIT(); __syncthreads();
        { XOrder S{(const char*)A, (const char*)WxqT, G, vcu, 1, 0}; pg8::gemm_phase<pg8::EpiBf16RS, XOrder, false>(L + RING_OFF, gq, S, Eq); }
        VM_WAIT(); __syncthreads();
        { XOrder S{(const char*)QX, (const char*)KX, G, vcu, 1, 1}; pg8::gemm_phase<pg8::EpiSoftmax, XOrder, false>(L + RING_OFF, gs, S, Es); }
        VM_WAIT(); __syncthreads();
        { XOrder S{(const char*)PM, (const char*)VXT, G, vcu, 1, 2}; pg8::gemm_phase<pg8::EpiBf16, XOrder, false>(L + RING_OFF, gv, S, Ev); }
    }
    xcd_barrier(bar); TSTAMP();

    asm volatile("; ===== PHASE 9 =====");
    if (PH(9)) for (int rep = 0; rep < NREP(9); ++rep) {
        PH_LANES; const bool dummy = rep < NREP(9) - 1; (void)dummy;
        pg8::Gemm g{1024, 1024, 1024}; pg8::StaticOrder S; S.init(OX, 1024, WxoT, 1024, T, 1024, G, bx);
        pg8::EpiResNorm<false> E{nullptr, A, SSQ2, 1024, dummy ? 0.f : 1.f};
        pg8::gemm_phase<pg8::EpiResNorm<false>, pg8::StaticOrder, true>(L + RING_OFF, g, S, E);
    }
    xcd_barrier(bar); TSTAMP();

    asm volatile("; ===== PHASE 11 =====");
    if (PH(11)) for (int rep = 0; rep < NREP(11); ++rep) {
        PH_LANES; const bool dummy = rep < NREP(11) - 1; (void)dummy;
        pg8::Gemm g{1024, 1024, 1024}; pg8::StaticOrder S; S.init(A, 1024, MT, 1024, T, 2048, G, bx);
        pg8::EpiF16RS E{SC, 2048, SSQ2};
        pg8::gemm_phase<pg8::EpiF16RS, pg8::StaticOrder, true>(L + RING_OFF, g, S, E);
    }
    xcd_barrier(bar); TSTAMP();

    asm volatile("; ===== PHASE 12 =====");
    if (PH(12)) for (int rep = 0; rep < NREP(12); ++rep) {
        PH_LANES; const bool dummy = rep < NREP(12) - 1; (void)dummy;
        typedef _Float16 h8 __attribute__((ext_vector_type(8)));
#define RCE(a, b) do { const float hi_ = fmax_asm(a, b); b = fmin_asm(a, b); a = hi_; } while (0)
#define RSORT16(K) do { RCE(K[0], K[1]); RCE(K[3], K[2]); RCE(K[4], K[5]); RCE(K[7], K[6]); RCE(K[8], K[9]); RCE(K[11], K[10]); RCE(K[12], K[13]); RCE(K[15], K[14]); RCE(K[0], K[2]); RCE(K[1], K[3]); RCE(K[6], K[4]); RCE(K[7], K[5]); RCE(K[8], K[10]); RCE(K[9], K[11]); RCE(K[14], K[12]); RCE(K[15], K[13]); RCE(K[0], K[1]); RCE(K[2], K[3]); RCE(K[5], K[4]); RCE(K[7], K[6]); RCE(K[8], K[9]); RCE(K[10], K[11]); RCE(K[13], K[12]); RCE(K[15], K[14]); RCE(K[0], K[4]); RCE(K[1], K[5]); RCE(K[2], K[6]); RCE(K[3], K[7]); RCE(K[12], K[8]); RCE(K[13], K[9]); RCE(K[14], K[10]); RCE(K[15], K[11]); RCE(K[0], K[2]); RCE(K[1], K[3]); RCE(K[4], K[6]); RCE(K[5], K[7]); RCE(K[10], K[8]); RCE(K[11], K[9]); RCE(K[14], K[12]); RCE(K[15], K[13]); RCE(K[0], K[1]); RCE(K[2], K[3]); RCE(K[4], K[5]); RCE(K[6], K[7]); RCE(K[9], K[8]); RCE(K[11], K[10]); RCE(K[13], K[12]); RCE(K[15], K[14]); RCE(K[0], K[8]); RCE(K[1], K[9]); RCE(K[2], K[10]); RCE(K[3], K[11]); RCE(K[4], K[12]); RCE(K[5], K[13]); RCE(K[6], K[14]); RCE(K[7], K[15]); RCE(K[0], K[4]); RCE(K[1], K[5]); RCE(K[2], K[6]); RCE(K[3], K[7]); RCE(K[8], K[12]); RCE(K[9], K[13]); RCE(K[10], K[14]); RCE(K[11], K[15]); RCE(K[0], K[2]); RCE(K[1], K[3]); RCE(K[4], K[6]); RCE(K[5], K[7]); RCE(K[8], K[10]); RCE(K[9], K[11]); RCE(K[12], K[14]); RCE(K[13], K[15]); RCE(K[0], K[1]); RCE(K[2], K[3]); RCE(K[4], K[5]); RCE(K[6], K[7]); RCE(K[8], K[9]); RCE(K[10], K[11]); RCE(K[12], K[13]); RCE(K[14], K[15]); } while (0)
#define RMERGE16(K) do { RCE(K[0], K[8]); RCE(K[1], K[9]); RCE(K[2], K[10]); RCE(K[3], K[11]); RCE(K[4], K[12]); RCE(K[5], K[13]); RCE(K[6], K[14]); RCE(K[7], K[15]); RCE(K[0], K[4]); RCE(K[1], K[5]); RCE(K[2], K[6]); RCE(K[3], K[7]); RCE(K[8], K[12]); RCE(K[9], K[13]); RCE(K[10], K[14]); RCE(K[11], K[15]); RCE(K[0], K[2]); RCE(K[1], K[3]); RCE(K[4], K[6]); RCE(K[5], K[7]); RCE(K[8], K[10]); RCE(K[9], K[11]); RCE(K[12], K[14]); RCE(K[13], K[15]); RCE(K[0], K[1]); RCE(K[2], K[3]); RCE(K[4], K[5]); RCE(K[6], K[7]); RCE(K[8], K[9]); RCE(K[10], K[11]); RCE(K[12], K[13]); RCE(K[14], K[15]); } while (0)
#define RKEYS(K, V0, V1, IDB) do { _Pragma("unroll") for (int e = 0; e < 8; ++e) { K[e] = __uint_as_float(__float_as_uint((float)V0[e]) | (unsigned)((IDB) + e)); K[8 + e] = __uint_as_float(__float_as_uint((float)V1[e]) | (unsigned)((IDB) + 8 + e)); } } while (0)
        LAS unsigned char* idl = L + RING_OFF + tid * 32;
        for (int task = gt; task < T * 8; task += NGT) {
            const int t = task >> 3, h = task & 7;
            const _Float16* row = SC + (size_t)t * 2048 + h * 256;
            float LA[16], LB[16];
#pragma unroll 1
            for (int p = 0; p < 2; ++p) {
                const _Float16* rp = row + p * 128;
                float Tk[16];
                { const h8 v0 = *(const h8*)rp, v1 = *(const h8*)(rp + 8); RKEYS(Tk, v0, v1, 0); RSORT16(Tk); }
#pragma unroll 1
                for (int c = 1; c < 8; ++c) {
                    const h8 v0 = *(const h8*)(rp + c * 16), v1 = *(const h8*)(rp + c * 16 + 8);
                    float K[16]; RKEYS(K, v0, v1, c * 16); RSORT16(K);
#pragma unroll
                    for (int i = 0; i < 16; ++i) Tk[i] = fmax_asm(Tk[i], K[15 - i]);
                    RMERGE16(Tk);
                }
#pragma unroll
                for (int k = 0; k < 16; ++k) { if (p == 0) LA[k] = Tk[k]; else LB[k] = Tk[k]; }
            }
#pragma unroll
            for (int k = 0; k < 16; k += 4) {
                ((LAS unsigned*)idl)[k >> 2] = (__float_as_uint(LA[k]) & 127u) | ((__float_as_uint(LA[k + 1]) & 127u) << 8) | ((__float_as_uint(LA[k + 2]) & 127u) << 16) | ((__float_as_uint(LA[k + 3]) & 127u) << 24);
                ((LAS unsigned*)idl)[4 + (k >> 2)] = (__float_as_uint(LB[k]) & 127u) | ((__float_as_uint(LB[k + 1]) & 127u) << 8) | ((__float_as_uint(LB[k + 2]) & 127u) << 16) | ((__float_as_uint(LB[k + 3]) & 127u) << 24);
            }
#define CKEY(a, b) __uint_as_float((__float_as_uint(LA[a] + LB[b]) & ~255u) | (unsigned)(255 - (16 * (a) + (b))))
            float Ck[16];
#pragma unroll
            for (int a = 0; a < 16; ++a) Ck[a] = CKEY(a, 0);
#define CRUN(b, n) do { _Pragma("unroll") for (int j = 0; j < (n); ++j) Ck[15 - j] = fmax_asm(Ck[15 - j], CKEY(j, b)); RMERGE16(Ck); } while (0)
            CRUN(1, 8); CRUN(2, 5); CRUN(3, 4); CRUN(4, 3); CRUN(5, 2); CRUN(6, 2); CRUN(7, 2);
#pragma unroll
            for (int j = 0; j < 8; ++j) Ck[15 - j] = fmax_asm(Ck[15 - j], CKEY(0, 8 + j));
            RMERGE16(Ck);
#undef CRUN
#undef CKEY
            LDS_WAIT();
            float ex[16]; float sum = 0.f;
#pragma unroll
            for (int k = 0; k < 16; ++k) { ex[k] = __expf(Ck[k] - Ck[0]); sum += ex[k]; }
            const float rs = 1.f / sum;
            int* eo = EIDX + (size_t)t * 128 + h * 16;
#pragma unroll
            for (int k = 0; k < 16; k += 4) {
                int ev[4];
#pragma unroll
                for (int j = 0; j < 4; ++j) { const unsigned id = 255u - (__float_as_uint(Ck[k + j]) & 255u); ev[j] = (int)idl[id >> 4] * 128 + (int)idl[16 + (id & 15u)]; }
                *(GAS v4u*)(eo + k) = (v4u){(pk2(0.f, ex[k] * rs) & 0xffff0000u) | (unsigned)ev[0], (pk2(0.f, ex[k + 1] * rs) & 0xffff0000u) | (unsigned)ev[1],
                                             (pk2(0.f, ex[k + 2] * rs) & 0xffff0000u) | (unsigned)ev[2], (pk2(0.f, ex[k + 3] * rs) & 0xffff0000u) | (unsigned)ev[3]};
            }
            LDS_WAIT();
        }
#undef RCE
#undef RSORT16
#undef RMERGE16
#undef RKEYS
    }
    xcd_barrier(bar); TSTAMP();

    asm volatile("; ===== PHASE 13 =====");
    if (PH(13)) for (int rep = 0; rep < NREP(13); ++rep) {
        PH_LANES; const bool dummy = rep < NREP(13) - 1; (void)dummy;
        volatile LAS unsigned* qslot = (volatile LAS unsigned*)(L + LDSCTL_OFF + 64);
        LAS unsigned char* tile = L + RING_OFF + wave * 8192;
        LAS float* rsl = (LAS float*)(L + UL_OFF + wave * UL_WAVE);
        LAS v4u* lst = (LAS v4u*)(L + UL_OFF + wave * UL_WAVE + 64);
        const int xs = (int)(xb_xcc_id() & 7u);
        __syncthreads();
        if (tid == 0) *qslot = __hip_atomic_fetch_add((unsigned*)(ctl + CW_Q + 64 * (rep * 8 + xs)), 1u, __ATOMIC_RELAXED, __HIP_MEMORY_SCOPE_AGENT);
        __syncthreads();
        const int rank = __builtin_amdgcn_readfirstlane((int)*qslot);
        int cnt[8];
#pragma unroll
        for (int j = 0; j < 8; ++j) cnt[j] = __builtin_amdgcn_readfirstlane((int)(xb_ld(bar.bar + XB_XCNT(j)) + xb_ld(bar.bar + XB_XCNT(j + 8))));
#pragma unroll 1
        for (int x = 0; x < 8; ++x) {
            int cn = 0;
#pragma unroll
            for (int j = 0; j < 8; ++j) cn = (j == x) ? cnt[j] : cn;
            int j0, jstep;
            if (x == xs) { j0 = rank * 8 + wave; jstep = cn * 8; } else if (cn == 0) { j0 = bx * 8 + wave; jstep = G * 8; } else continue;
#pragma unroll 1
            for (int job = j0; job < T / 8; job += jstep) {
                const int t0 = job * 8;
#pragma unroll 1
                for (int r0 = 0;; r0 += UL_CAP) {
                    v4u ar0[8], ar1[8]; unsigned pa[8], pb[8];
#pragma unroll
                    for (int tl = 0; tl < 8; ++tl) { const GAS v4u* ar = (const GAS v4u*)(A + (size_t)(t0 + tl) * D + 16 * lane); ar0[tl] = ar[0]; ar1[tl] = ar[1]; }
#pragma unroll
                    for (int tl = 0; tl < 8; ++tl) { pa[tl] = (unsigned)EIDX[(size_t)(t0 + tl) * 128 + lane]; pb[tl] = (unsigned)EIDX[(size_t)(t0 + tl) * 128 + 64 + lane]; }
                    float rs8[2];
                    { float s0 = SSQ2[(size_t)t0 * 16 + lane], s1 = SSQ2[(size_t)t0 * 16 + 64 + lane];
                      s0 += shx<1>(s0); s1 += shx<1>(s1); s0 += shx<2>(s0); s1 += shx<2>(s1); s0 += shx<4>(s0); s1 += shx<4>(s1); s0 += shx<8>(s0); s1 += shx<8>(s1);
                      rs8[0] = rsqrtf(s0 * (1.f / 1024.f) + RMS_EPS); rs8[1] = rsqrtf(s1 * (1.f / 1024.f) + RMS_EPS); }
#pragma unroll
                    for (int tl = 0; tl < 8; ++tl) {
                        float a[16];
                        a[0] = bflo(ar0[tl].x); a[1] = bfhi(ar0[tl].x); a[2] = bflo(ar0[tl].y); a[3] = bfhi(ar0[tl].y); a[4] = bflo(ar0[tl].z); a[5] = bfhi(ar0[tl].z); a[6] = bflo(ar0[tl].w); a[7] = bfhi(ar0[tl].w);
                        a[8] = bflo(ar1[tl].x); a[9] = bfhi(ar1[tl].x); a[10] = bflo(ar1[tl].y); a[11] = bfhi(ar1[tl].y); a[12] = bflo(ar1[tl].z); a[13] = bfhi(ar1[tl].z); a[14] = bflo(ar1[tl].w); a[15] = bfhi(ar1[tl].w);
                        float amx = 0.f;
#pragma unroll
                        for (int i = 0; i < 16; ++i) amx = fmaxf(amx, fabsf(a[i]));
                        amx = wave_max(amx);
                        const float asc = amx > 0.f ? 127.f / amx : 1.f;
                        v4u qv;
#define QP4(i) (((unsigned)(int)rintf(a[4 * (i)] * asc) & 255u) | (((unsigned)(int)rintf(a[4 * (i) + 1] * asc) & 255u) << 8) | (((unsigned)(int)rintf(a[4 * (i) + 2] * asc) & 255u) << 16) | (((unsigned)(int)rintf(a[4 * (i) + 3] * asc) & 255u) << 24))
                        qv.x = QP4(0); qv.y = QP4(1); qv.z = QP4(2); qv.w = QP4(3);
#undef QP4
                        *(LAS v4u*)(tile + tl * 1024 + lane * 16) = qv;
                        const float rsv = __uint_as_float((unsigned)__builtin_amdgcn_readlane((int)__float_as_uint(rs8[tl >> 2]), (tl & 3) * 16));
                        if (lane == 0) rsl[tl] = (amx > 0.f ? amx * (1.f / 127.f) : 1.f) * rsv;
                    }
                    int total = 0; unsigned long long m0s[8], m1s[8];
#pragma unroll
                    for (int tl = 0; tl < 8; ++tl) { m0s[tl] = __ballot((int)((pa[tl] & 0xffffu) >> 11) == x); m1s[tl] = __ballot((int)((pb[tl] & 0xffffu) >> 11) == x); total += __popcll(m0s[tl]) + __popcll(m1s[tl]); }
                    float sua[8], sva[8], sub[8], svb[8];
#pragma unroll
                    for (int tl = 0; tl < 8; ++tl) { sua[tl] = sva[tl] = sub[tl] = svb[tl] = 0.f;
                        if ((m0s[tl] >> lane) & 1ull) { sua[tl] = SU[pa[tl] & 0xffffu]; sva[tl] = SV[pa[tl] & 0xffffu]; }
                        if ((m1s[tl] >> lane) & 1ull) { sub[tl] = SU[pb[tl] & 0xffffu]; svb[tl] = SV[pb[tl] & 0xffffu]; } }
                    asm volatile("s_waitcnt vmcnt(0) lgkmcnt(0)" ::: "memory");
                    int base = -r0;
#pragma unroll
                    for (int tl = 0; tl < 8; ++tl) {
                        const int n0 = __popcll(m0s[tl]), n1 = __popcll(m1s[tl]); const float rs = rsl[tl];
                        const int k0 = base + (int)__builtin_amdgcn_mbcnt_hi((unsigned)(m0s[tl] >> 32), __builtin_amdgcn_mbcnt_lo((unsigned)m0s[tl], 0u));
                        const int k1 = base + n0 + (int)__builtin_amdgcn_mbcnt_hi((unsigned)(m1s[tl] >> 32), __builtin_amdgcn_mbcnt_lo((unsigned)m1s[tl], 0u));
                        if (((m0s[tl] >> lane) & 1ull) && k0 >= 0 && k0 < UL_CAP) lst[k0] = (v4u){pa[tl], (unsigned)((tl << 7) | lane), __float_as_uint(sua[tl] * rs), __float_as_uint(__uint_as_float(pa[tl] & 0xffff0000u) * sva[tl] * 256.f)};
                        if (((m1s[tl] >> lane) & 1ull) && k1 >= 0 && k1 < UL_CAP) lst[k1] = (v4u){pb[tl], (unsigned)((tl << 7) | 64 | lane), __float_as_uint(sub[tl] * rs), __float_as_uint(__uint_as_float(pb[tl] & 0xffff0000u) * svb[tl] * 256.f)};
                        base += n0 + n1;
                    }
                    const int count = (total - r0) < UL_CAP ? (total - r0) : UL_CAP;
                    asm volatile("s_waitcnt lgkmcnt(0)" ::: "memory");
#pragma unroll 1
                    for (int b16 = 0; b16 < count; b16 += 16) {
                        const int myi = b16 + (lane & 15); const v4u en = lst[myi < count ? myi : count - 1];
                        v4u q[16];
#pragma unroll
                        for (int k = 0; k < 16; ++k) { const int e_ = __builtin_amdgcn_readlane((int)en.x, k) & 0xffff; q[k] = *(const GAS v4u*)(U8 + (size_t)e_ * 1024 + 16 * lane); }
                        int d[16];
#pragma unroll
                        for (int k = 0; k < 16; ++k) { const int tl_ = __builtin_amdgcn_readlane((int)en.y, k) >> 7; const v4u qa = *(const LAS v4u*)(tile + tl_ * 1024 + lane * 16);
                            d[k] = __builtin_amdgcn_sdot4((int)q[k].w, (int)qa.w, __builtin_amdgcn_sdot4((int)q[k].z, (int)qa.z, __builtin_amdgcn_sdot4((int)q[k].y, (int)qa.y, __builtin_amdgcn_sdot4((int)q[k].x, (int)qa.x, 0, false), false), false), false); }
                        int r8[8], r4[4], r2[2];
#pragma unroll
                        for (int i = 0; i < 8; ++i) { auto sw = __builtin_amdgcn_permlane32_swap((unsigned)d[i], (unsigned)d[i + 8], false, false); r8[i] = (int)(sw[0] + sw[1]); }
#pragma unroll
                        for (int i = 0; i < 4; ++i) { auto sw = __builtin_amdgcn_permlane16_swap((unsigned)r8[i], (unsigned)r8[i + 4], false, false); r4[i] = (int)(sw[0] + sw[1]); }
                        const bool b3 = (lane >> 3) & 1, b2 = (lane >> 2) & 1;
#pragma unroll
                        for (int i = 0; i < 2; ++i) { const int keep = b3 ? r4[i + 2] : r4[i], send = b3 ? r4[i] : r4[i + 2]; r2[i] = keep + __builtin_amdgcn_ds_swizzle(send, (8 << 10) | 0x1f); }
                        int doti; { const int keep = b2 ? r2[1] : r2[0], send = b2 ? r2[0] : r2[1]; doti = keep + __builtin_amdgcn_ds_swizzle(send, (4 << 10) | 0x1f); }
                        doti += __builtin_amdgcn_ds_swizzle(doti, (2 << 10) | 0x1f); doti += __builtin_amdgcn_ds_swizzle(doti, (1 << 10) | 0x1f);
                        const int sl_ = (lane >> 2) * 4;
                        const unsigned ex = (unsigned)__builtin_amdgcn_ds_bpermute(sl_, (int)en.x), ey = (unsigned)__builtin_amdgcn_ds_bpermute(sl_, (int)en.y);
                        const float eus = __uint_as_float((unsigned)__builtin_amdgcn_ds_bpermute(sl_, (int)en.z)), evs = __uint_as_float((unsigned)__builtin_amdgcn_ds_bpermute(sl_, (int)en.w));
                        if ((lane & 3) == 0 && b16 + (lane >> 2) < count) {
                            const int e = (int)(ex & 0xffffu), slot = (int)(ey & 127u); const int t = t0 + (int)(ey >> 7);
                            const float act = (float)doti * eus; const float u3 = 0.7978845608028654f * (act + 0.044715f * act * act * act);
                            const float wv = act * __builtin_amdgcn_rcpf(1.f + __expf(-2.f * u3)) * evs;
                            PW[((size_t)((t >> 6) * 8 + (slot >> 4)) * 4 + ((slot >> 2) & 3)) * 256 + (t & 63) * 4 + (slot & 3)] = (pk2(0.f, wv) & 0xffff0000u) | (unsigned)e;
                        }
                    }
                    asm volatile("s_waitcnt lgkmcnt(0)" ::: "memory");
                    if (r0 + UL_CAP >= total) break;
                }
            }
        }
        __syncthreads();
    }
    xcd_barrier(bar); TSTAMP();

    asm volatile("; ===== PHASE 14 =====");
    if (PH(14)) for (int rep = 0; rep < NREP(14); ++rep) {
        PH_LANES; const bool dummy = rep < NREP(14) - 1; (void)dummy;
        for (int item = vcu; item < 256; item += G) {
            const int sl = item & 127, half = item >> 7;
            __syncthreads();
#pragma unroll
            for (int i = 0; i < 16; ++i) *(LAS v4u*)(L + RING_OFF + (i * 512 + tid) * 16) = *(const GAS v4u*)(V8T + (size_t)sl * 131072 + (size_t)(i * 512 + tid) * 16);
            __syncthreads();
            const GAS v4u* pwb = (const GAS v4u*)(PW + (size_t)(half * 256 + wave) * 8192) + lane;
            v4u buf[4][4];
#pragma unroll
            for (int c = 0; c < 4; ++c)
#pragma unroll
                for (int k = 0; k < 4; ++k) buf[c][k] = pwb[c * 256 + k * 64];
#pragma unroll 1
            for (int itk = 0; itk < 32; ++itk) {
                const int g64 = half * 256 + itk * 8 + wave;
                const int t = g64 * 64 + lane;
                h2v acc[4] = {(h2v){(_Float16)0, (_Float16)0}, (h2v){(_Float16)0, (_Float16)0}, (h2v){(_Float16)0, (_Float16)0}, (h2v){(_Float16)0, (_Float16)0}};
#pragma unroll
                for (int c = 0; c < 8; ++c) {
                    v4u cur[4];
#pragma unroll
                    for (int k = 0; k < 4; ++k) cur[k] = buf[c & 3][k];
                    { const int sn = itk * 8 + c + 4; const int gn = (sn >> 3) > 31 ? 31 : (sn >> 3), cc = sn & 7; const GAS v4u* src = pwb + (size_t)gn * 8 * 2048 + cc * 256;
#pragma unroll
                      for (int k = 0; k < 4; ++k) buf[c & 3][k] = src[k * 64]; }
                    v2u tb[16];
#pragma unroll
                    for (int k = 0; k < 4; ++k)
#pragma unroll
                        for (int i = 0; i < 4; ++i) { const unsigned p = cur[k][i]; tb[k * 4 + i] = *(const LAS v2u*)(L + RING_OFF + ((p & 0xffffu) << 3)); }
#pragma unroll
                    for (int k = 0; k < 4; ++k)
#pragma unroll
                        for (int i = 0; i < 4; ++i) { const unsigned p = cur[k][i]; const _Float16 wh = (_Float16)__uint_as_float(p & 0xffff0000u); const v2u q = tb[k * 4 + i];
                            const h2v ww = (h2v){wh, wh};
                            acc[0] += ww * __builtin_amdgcn_cvt_scalef32_pk_f16_fp8((int)q.x, 0.00390625f, false); acc[1] += ww * __builtin_amdgcn_cvt_scalef32_pk_f16_fp8((int)q.x, 0.00390625f, true);
                            acc[2] += ww * __builtin_amdgcn_cvt_scalef32_pk_f16_fp8((int)q.y, 0.00390625f, false); acc[3] += ww * __builtin_amdgcn_cvt_scalef32_pk_f16_fp8((int)q.y, 0.00390625f, true); }
                }
                GAS v4u* hr = (GAS v4u*)(A + (size_t)t * D + sl * 8);
                const v4u hq = *hr; const float mulv = dummy ? 0.f : 1.f;
                v4u ho; ho.x = pk2(bflo(hq.x) + (float)acc[0].x * mulv, bfhi(hq.x) + (float)acc[0].y * mulv); ho.y = pk2(bflo(hq.y) + (float)acc[1].x * mulv, bfhi(hq.y) + (float)acc[1].y * mulv);
                ho.z = pk2(bflo(hq.z) + (float)acc[2].x * mulv, bfhi(hq.z) + (float)acc[2].y * mulv); ho.w = pk2(bflo(hq.w) + (float)acc[3].x * mulv, bfhi(hq.w) + (float)acc[3].y * mulv);
                *hr = ho;
            }
        }
    }
    xcd_barrier(bar); TSTAMP();

#ifdef EXTRA_BARRIERS
    for (int eb = 0; eb < EXTRA_BARRIERS; ++eb) xcd_barrier(bar);
#endif
    asm volatile("; ===== PHASE 15 =====");
    if (PH(15)) for (int rep = 0; rep < NREP(15); ++rep) {
        PH_LANES; const bool dummy = rep < NREP(15) - 1; (void)dummy;
        for (int t = gw; t < T; t += NGW) {
            const GAS v4u* hr = (const GAS v4u*)(A + (size_t)t * D + 16 * lane); const v4u q0 = hr[0], q1 = hr[1];
            const GAS f32x4* gr = (const GAS f32x4*)(g_final + 16 * lane); GAS f32x4* orow = (GAS f32x4*)(out + (size_t)t * D + 16 * lane);
            f32x4 o[4] = {(f32x4){bflo(q0.x), bfhi(q0.x), bflo(q0.y), bfhi(q0.y)}, (f32x4){bflo(q0.z), bfhi(q0.z), bflo(q0.w), bfhi(q0.w)},
                          (f32x4){bflo(q1.x), bfhi(q1.x), bflo(q1.y), bfhi(q1.y)}, (f32x4){bflo(q1.z), bfhi(q1.z), bflo(q1.w), bfhi(q1.w)}};
            float ss = 0.f;
#pragma unroll
            for (int j = 0; j < 4; ++j) ss += (o[j].x * o[j].x + o[j].y * o[j].y) + (o[j].z * o[j].z + o[j].w * o[j].w);
            const float r = rsqrtf(wave_sum(ss) * (1.f / 1024.f) + RMS_EPS);
#pragma unroll
            for (int j = 0; j < 4; ++j) orow[j] = o[j] * r * gr[j];
        }
    }
}

extern "C" void kernel_launch(void* const* d_in, const int* in_sizes, int n_in, void* d_out, int out_size, void* d_ws, size_t ws_size, hipStream_t stream) {
    static int grid = 0;
    if (grid == 0) {
        if (n_in != 19 || out_size != T * D || ws_size < WS_END) { fprintf(stderr, "kernel_launch: unexpected problem (n_in %d, out %d, ws %zu < %zu); nothing launched\n", n_in, out_size, ws_size, (size_t)WS_END); grid = -1; return; }
        int dev = 0, cus = 0, per_cu = 0;
        if (hipGetDevice(&dev) != hipSuccess || hipDeviceGetAttribute(&cus, hipDeviceAttributeMultiprocessorCount, dev) != hipSuccess) { grid = -1; return; }
        if (hipFuncSetAttribute((const void*)mk_fwd, hipFuncAttributeMaxDynamicSharedMemorySize, LDS_BYTES) != hipSuccess) { fprintf(stderr, "kernel_launch: hipFuncSetAttribute failed\n"); grid = -1; return; }
        if (hipOccupancyMaxActiveBlocksPerMultiprocessor(&per_cu, (const void*)mk_fwd, NWAVES * 64, LDS_BYTES) != hipSuccess || per_cu < 1) { fprintf(stderr, "kernel_launch: occupancy query says %d blocks per CU\n", per_cu); }
        (void)hipGetLastError();
        grid = cus;
    }
    if (grid < 0) return;
    if (hipMemsetAsync((char*)d_ws + WS_CTL, 0, CTL_ZERO_BYTES, stream) != hipSuccess) return;
    Args a{};
    for (int i = 0; i < 19; ++i) a.in[i] = (const float*)d_in[i];
    a.out = (float*)d_out; a.ws = (unsigned char*)d_ws;
    hipLaunchKernelGGL(mk_fwd, dim3(grid), dim3(NWAVES * 64), LDS_BYTES, stream, a);
}
```

```cpp
#include <hip/hip_runtime.h>
#include <hip/hip_bf16.h>
#include <cstdio>
#include <cstdint>
#include <cmath>

#ifndef DIAG
#define DIAG 0
#endif


template <int O> __device__ __forceinline__ float shx(float v) { static_assert(O > 0 && O < 32, "shx"); return __uint_as_float((unsigned)__builtin_amdgcn_ds_swizzle((int)__float_as_uint(v), (O << 10) | 0x1f)); }
__device__ __forceinline__ float sum32(float v) { auto r = __builtin_amdgcn_permlane32_swap(__float_as_uint(v), __float_as_uint(v), false, false); return __uint_as_float(r[0]) + __uint_as_float(r[1]); }
__device__ __forceinline__ float max32(float v) { auto r = __builtin_amdgcn_permlane32_swap(__float_as_uint(v), __float_as_uint(v), false, false); return fmaxf(__uint_as_float(r[0]), __uint_as_float(r[1])); }
__device__ __forceinline__ float wave_max(float v) { v = fmaxf(v, shx<1>(v)); v = fmaxf(v, shx<2>(v)); v = fmaxf(v, shx<4>(v)); v = fmaxf(v, shx<8>(v)); v = fmaxf(v, shx<16>(v)); return max32(v); }
__device__ __forceinline__ float wave_sum(float v) { v += shx<1>(v); v += shx<2>(v); v += shx<4>(v); v += shx<8>(v); v += shx<16>(v); return sum32(v); }

namespace pg8 {
#define PG8_LAS __attribute__((address_space(3)))
typedef unsigned short bf16_t;
typedef short bf16x8 __attribute__((ext_vector_type(8)));
typedef float f32x4 __attribute__((ext_vector_type(4)));
typedef float f32x2 __attribute__((ext_vector_type(2)));
typedef unsigned u32x4 __attribute__((ext_vector_type(4)));
typedef unsigned u32x2 __attribute__((ext_vector_type(2)));
constexpr int BM = 256, BK = 64, HALF = 128, HTB = HALF * BK * 2  , STAGE_BYTES = 8 * HTB, NXCD = 8, WGM = 8;

__host__ __device__ __forceinline__ int lds_byte(int r, int c) { const int st = (r >> 4) * 2 + (c >> 5), rr = r & 15, cc = c & 31, ob = rr * 64 + cc * 2; return st * 1024 + (ob ^ (((ob >> 9) & 1) << 5)); }
__host__ __device__ __forceinline__ void stage_rc(int b, int& R, int& C) { const int st = b / 1024, sb = b % 1024, swz = sb ^ (((sb >> 9) & 1) << 5); R = (st >> 1) * 16 + swz / 64; C = (st & 1) * 32 + (swz % 64) / 2; }
__host__ __device__ __forceinline__ int perm32(int rho) { const int n = rho >> 4, i = rho & 15; return 8 * (i >> 2) + 4 * n + (i & 3); }

struct Unit { int pm, pn; const char* a; const char* b; };
struct Gemm { int lda, ldb, K; };

struct StaticOrder {
    int nM, nN, nwg, G, c; const char* A; const char* Bt; size_t astep, bstep;
    __device__ void init(const void* A_, int lda, const void* Bt_, int ldb, int M, int N, int G_, int c_) { nM = M / BM; nN = N / BM; nwg = nM * nN; G = G_; c = c_; A = (const char*)A_; Bt = (const char*)Bt_; astep = (size_t)BM * lda * 2; bstep = (size_t)BM * ldb * 2; }
    __device__ bool next(int i, Unit& u) const {
        const long L = (long)i * G + c; if (L >= nwg) return false;
        int wgid = (int)L; { const int q = nwg / NXCD, r = nwg % NXCD, xcd = wgid % NXCD, off = wgid / NXCD; wgid = (xcd < r ? xcd * (q + 1) : r * (q + 1) + (xcd - r) * q) + off; }
        const int nig = WGM * nN, gid = wgid / nig, fm = gid * WGM, gsz = (nM - fm) < WGM ? (nM - fm) : WGM;
        u.pm = fm + ((wgid % nig) % gsz); u.pn = (wgid % nig) / gsz; u.a = A + (size_t)u.pm * astep; u.b = Bt + (size_t)u.pn * bstep; return true;
    }
};

__device__ __forceinline__ unsigned cvt_pk_bf16(float lo, float hi) { typedef __bf16 bf2 __attribute__((ext_vector_type(2))); f32x2 v = {lo, hi}; bf2 b = __builtin_convertvector(v, bf2); return __builtin_bit_cast(unsigned, b); }
__device__ __forceinline__ float bf_lo(unsigned u) { return __uint_as_float(u << 16); }
__device__ __forceinline__ float bf_hi(unsigned u) { return __uint_as_float(u & 0xffff0000u); }

template <class Epi, class Sched, bool ALIGN_EPI>
__device__ __forceinline__ void gemm_phase(PG8_LAS unsigned char* lds, const Gemm g, const Sched& S, const Epi& E) {
    int tid = threadIdx.x; asm volatile("" : "+v"(tid));
    const int wid = __builtin_amdgcn_readfirstlane(tid >> 6), lane = tid & 63, wr = wid >> 2, wc = wid & 3, fr = lane & 15, fq = lane >> 4;
    const int K = g.K, nt = K / BK;
    unsigned voffA[2], voffB[2];
#pragma unroll
    for (int i = 0; i < 2; ++i) { int R, C; stage_rc(tid * 16 + i * 8192, R, C); const int Rb = Epi::PERM ? ((R & ~31) + perm32(R & 31)) : R;
        voffA[i] = (unsigned)(R * g.lda + C) * 2u; voffB[i] = (unsigned)(Rb * g.ldb + C) * 2u; }
    const size_t kstep = (size_t)(BK * 2);
    const size_t hstepA = (size_t)HALF * g.lda * 2, hstepB = (size_t)HALF * g.ldb * 2;
    const unsigned ldsw = (unsigned)wid * 1024u;
    const int aoff = lds_byte(wr * 64 + fr, fq * 8), boff = lds_byte(wc * 32 + fr, fq * 8);
#define PG8_SA(b, h) (((b) * 2 + (h)) * HTB)
#define PG8_SB(b, h) ((4 + (b) * 2 + (h)) * HTB)
#define PG8_STAGE(bufoff, gbase, voff) do { _Pragma("unroll") for (int _i = 0; _i < 2; ++_i) \
        __builtin_amdgcn_global_load_lds((const unsigned*)((const char*)(gbase) + (voff)[_i]), (PG8_LAS unsigned*)(lds + (bufoff) + ldsw + _i * 8192), 16, 0, 0); } while (0)
#define PG8_LDA(dst, b, h) do { _Pragma("unroll") for (int m = 0; m < 4; ++m) _Pragma("unroll") for (int k = 0; k < 2; ++k) dst[m][k] = *(const PG8_LAS bf16x8*)(lds + PG8_SA(b, h) + aoff + m * 2048 + k * 1024); } while (0)
#define PG8_LDB(dst, b, h) do { _Pragma("unroll") for (int n = 0; n < 2; ++n) _Pragma("unroll") for (int k = 0; k < 2; ++k) dst[n][k] = *(const PG8_LAS bf16x8*)(lds + PG8_SB(b, h) + boff + n * 2048 + k * 1024); } while (0)
#define PG8_MMA(ai, bj, At, Bt) do { __builtin_amdgcn_s_setprio(1); _Pragma("unroll") for (int m = 0; m < 4; ++m) _Pragma("unroll") for (int n = 0; n < 2; ++n) _Pragma("unroll") for (int k = 0; k < 2; ++k) \
        acc[ai][bj][m][n] = __builtin_amdgcn_mfma_f32_16x16x32_bf16(Bt[n][k], At[m][k], acc[ai][bj][m][n], 0, 0, 0); __builtin_amdgcn_s_setprio(0); } while (0)
#define PG8_WAIT_V(n) asm volatile("s_waitcnt vmcnt(" #n ")" ::: "memory")
#define PG8_WAIT_L(n) asm volatile("s_waitcnt lgkmcnt(" #n ")" ::: "memory")
#define PG8_BAR __builtin_amdgcn_s_barrier()
#define PG8_SCHED __builtin_amdgcn_sched_barrier(0)
    Unit cur, nxt; int ui = 0;
    if (!S.next(0, cur)) return;
    f32x4 acc[2][2][4][2];
#pragma unroll
    for (int a = 0; a < 2; ++a)
#pragma unroll
        for (int b = 0; b < 2; ++b)
#pragma unroll
            for (int m = 0; m < 4; ++m)
#pragma unroll
                for (int n = 0; n < 2; ++n) acc[a][b][m][n] = (f32x4){0.f, 0.f, 0.f, 0.f};
    bf16x8 At[4][2], B0[2][2], B1[2][2];
    const char* cA = cur.a; const char* cB = cur.b;
    PG8_STAGE(PG8_SB(0, 0), cB, voffB); PG8_STAGE(PG8_SB(0, 1), cB + hstepB, voffB); PG8_STAGE(PG8_SA(0, 0), cA, voffA); PG8_STAGE(PG8_SA(0, 1), cA + hstepA, voffA);
    if (wr == 1) PG8_BAR;
    PG8_WAIT_V(2); PG8_BAR;
    PG8_STAGE(PG8_SB(1, 0), cB + kstep, voffB); PG8_STAGE(PG8_SA(1, 0), cA + kstep, voffA); PG8_STAGE(PG8_SB(1, 1), cB + hstepB + kstep, voffB);
    PG8_WAIT_V(6); PG8_BAR;
    for (;;) {
        const bool has_next = S.next(ui + 1, nxt);
        const char* nA = has_next ? nxt.a : cA; const char* nB = has_next ? nxt.b : cB;
        for (int t = 0; t < nt; t += 2) {
            const bool last = (t == nt - 2);
            const char* a1 = cA + (size_t)(t + 1) * kstep;
            const char* a2 = last ? nA : cA + (size_t)(t + 2) * kstep; const char* b2 = last ? nB : cB + (size_t)(t + 2) * kstep;
            const char* a3 = a2 + kstep; const char* b3 = b2 + kstep;
            PG8_LDB(B0, 0, 0); PG8_LDB(B1, 0, 1); PG8_SCHED; PG8_LDA(At, 0, 0); PG8_STAGE(PG8_SA(1, 1), a1 + hstepA, voffA);
            PG8_WAIT_V(8); PG8_WAIT_L(0); PG8_BAR; PG8_MMA(0, 0, At, B0); PG8_MMA(0, 1, At, B1); PG8_BAR; PG8_SCHED;
            PG8_LDA(At, 0, 1); PG8_STAGE(PG8_SB(0, 0), b2, voffB); PG8_STAGE(PG8_SB(0, 1), b2 + hstepB, voffB); PG8_STAGE(PG8_SA(0, 0), a2, voffA);
            PG8_WAIT_V(8); PG8_WAIT_L(0); PG8_BAR; PG8_MMA(1, 0, At, B0); PG8_MMA(1, 1, At, B1); PG8_BAR; PG8_SCHED;
            PG8_LDB(B0, 1, 0); PG8_LDB(B1, 1, 1); PG8_SCHED; PG8_LDA(At, 1, 0); PG8_STAGE(PG8_SA(0, 1), a2 + hstepA, voffA);
            PG8_WAIT_V(8); PG8_WAIT_L(0); PG8_BAR; PG8_MMA(0, 0, At, B0); PG8_MMA(0, 1, At, B1); PG8_BAR; PG8_SCHED;
            PG8_LDA(At, 1, 1); PG8_STAGE(PG8_SB(1, 0), b3, voffB); PG8_STAGE(PG8_SB(1, 1), b3 + hstepB, voffB); PG8_STAGE(PG8_SA(1, 0), a3, voffA);
            PG8_WAIT_V(8); PG8_WAIT_L(0); PG8_BAR; PG8_MMA(1, 0, At, B0); PG8_MMA(1, 1, At, B1); PG8_BAR; PG8_SCHED;
        }
        if constexpr (ALIGN_EPI) { if (wr == 0) PG8_BAR; }
        if constexpr (!Epi::AFTER_DRAIN) { E(acc, cur, wr, wc, fr, fq); }
        if (!has_next) break;
#pragma unroll
        for (int a = 0; a < 2; ++a)
#pragma unroll
            for (int b = 0; b < 2; ++b)
#pragma unroll
                for (int m = 0; m < 4; ++m)
#pragma unroll
                    for (int n = 0; n < 2; ++n) acc[a][b][m][n] = (f32x4){0.f, 0.f, 0.f, 0.f};
        cur = nxt; cA = nA; cB = nB; ++ui;
        if constexpr (ALIGN_EPI) { if (wr == 1) PG8_BAR; }
    }
    PG8_WAIT_V(0);
    if constexpr (!ALIGN_EPI) { if (wr == 0) PG8_BAR; }
    PG8_BAR;
    if constexpr (Epi::AFTER_DRAIN) { E.fused(acc, cur, wr, wc, fr, fq, lds, wid, lane); }
#undef PG8_SA
#undef PG8_SB
#undef PG8_STAGE
#undef PG8_LDA
#undef PG8_LDB
#undef PG8_MMA
#undef PG8_WAIT_V
#undef PG8_WAIT_L
#undef PG8_BAR
#undef PG8_SCHED
}

typedef f32x4 AccT[2][2][4][2];

struct EpiBf16 {
    static constexpr bool PERM = true, AFTER_DRAIN = false;
    bf16_t* O; int ldc;
    __device__ __forceinline__ void operator()(const AccT& acc, const Unit& u, int wr, int wc, int fr, int fq) const {
        { int t_ = threadIdx.x; asm volatile("" : "+v"(t_)); fr = t_ & 15; fq = (t_ >> 4) & 3; }
        const int row0 = u.pm * BM + wr * 64 + fr, col0 = u.pn * BM + wc * 32 + 8 * fq;
#pragma unroll
        for (int ai = 0; ai < 2; ++ai)
#pragma unroll
            for (int m = 0; m < 4; ++m) { bf16_t* rowp = O + (size_t)(row0 + ai * HALF + m * 16) * ldc + col0;
#pragma unroll
                for (int bj = 0; bj < 2; ++bj) { const f32x4 v0 = acc[ai][bj][m][0], v1 = acc[ai][bj][m][1];
                    u32x4 w; w.x = cvt_pk_bf16(v0[0], v0[1]); w.y = cvt_pk_bf16(v0[2], v0[3]); w.z = cvt_pk_bf16(v1[0], v1[1]); w.w = cvt_pk_bf16(v1[2], v1[3]);
                    *(u32x4*)(rowp + bj * HALF) = w; } }
    }
};
struct EpiF16 {
    static constexpr bool PERM = true, AFTER_DRAIN = false;
    _Float16* O; int ldc;
    __device__ __forceinline__ void operator()(const AccT& acc, const Unit& u, int wr, int wc, int fr, int fq) const {
        { int t_ = threadIdx.x; asm volatile("" : "+v"(t_)); fr = t_ & 15; fq = (t_ >> 4) & 3; }
        typedef _Float16 h8 __attribute__((ext_vector_type(8)));
        const int row0 = u.pm * BM + wr * 64 + fr, col0 = u.pn * BM + wc * 32 + 8 * fq;
#pragma unroll
        for (int ai = 0; ai < 2; ++ai)
#pragma unroll
            for (int m = 0; m < 4; ++m) { _Float16* rowp = O + (size_t)(row0 + ai * HALF + m * 16) * ldc + col0;
#pragma unroll
                for (int bj = 0; bj < 2; ++bj) { const f32x4 v0 = acc[ai][bj][m][0], v1 = acc[ai][bj][m][1];
                    h8 w = {(_Float16)v0[0], (_Float16)v0[1], (_Float16)v0[2], (_Float16)v0[3], (_Float16)v1[0], (_Float16)v1[1], (_Float16)v1[2], (_Float16)v1[3]};
                    *(h8*)(rowp + bj * HALF) = w; } }
    }
};
struct EpiGateMul {
    static constexpr bool PERM = true, AFTER_DRAIN = false;
    const bf16_t* G; bf16_t* Dst; int ldc;
    __device__ __forceinline__ void operator()(const AccT& acc, const Unit& u, int wr, int wc, int fr, int fq) const {
        { int t_ = threadIdx.x; asm volatile("" : "+v"(t_)); fr = t_ & 15; fq = (t_ >> 4) & 3; }
        const int row0 = u.pm * BM + wr * 64 + fr, col0 = u.pn * BM + wc * 32 + 8 * fq;
#pragma unroll
        for (int ai = 0; ai < 2; ++ai)
#pragma unroll
            for (int m = 0; m < 4; ++m) { const size_t roff = (size_t)(row0 + ai * HALF + m * 16) * ldc + col0; const bf16_t* rowg = G + roff; bf16_t* rowp = Dst + roff;
#pragma unroll
                for (int bj = 0; bj < 2; ++bj) { const f32x4 v0 = acc[ai][bj][m][0], v1 = acc[ai][bj][m][1]; const u32x4 gq = *(const u32x4*)(rowg + bj * HALF);
                    u32x4 w; w.x = cvt_pk_bf16(v0[0] * bf_lo(gq.x), v0[1] * bf_hi(gq.x)); w.y = cvt_pk_bf16(v0[2] * bf_lo(gq.y), v0[3] * bf_hi(gq.y));
                    w.z = cvt_pk_bf16(v1[0] * bf_lo(gq.z), v1[1] * bf_hi(gq.z)); w.w = cvt_pk_bf16(v1[2] * bf_lo(gq.w), v1[3] * bf_hi(gq.w));
                    *(u32x4*)(rowp + bj * HALF) = w; } }
    }
};
struct EpiGateFma {
    static constexpr bool PERM = true, AFTER_DRAIN = false;
    const bf16_t* Tm; const bf16_t* G2; bf16_t* Dst; int ldc;
    __device__ __forceinline__ void operator()(const AccT& acc, const Unit& u, int wr, int wc, int fr, int fq) const {
        { int t_ = threadIdx.x; asm volatile("" : "+v"(t_)); fr = t_ & 15; fq = (t_ >> 4) & 3; }
        const int row0 = u.pm * BM + wr * 64 + fr, col0 = u.pn * BM + wc * 32 + 8 * fq;
#pragma unroll
        for (int ai = 0; ai < 2; ++ai)
#pragma unroll
            for (int m = 0; m < 4; ++m) { const size_t off = (size_t)(row0 + ai * HALF + m * 16) * ldc + col0;
#pragma unroll
                for (int bj = 0; bj < 2; ++bj) { const f32x4 v0 = acc[ai][bj][m][0], v1 = acc[ai][bj][m][1]; const u32x4 gq = *(const u32x4*)(G2 + off + bj * HALF); const u32x4 tq = *(const u32x4*)(Tm + off + bj * HALF);
                    u32x4 w; w.x = cvt_pk_bf16(bf_lo(tq.x) + v0[0] * bf_lo(gq.x), bf_hi(tq.x) + v0[1] * bf_hi(gq.x)); w.y = cvt_pk_bf16(bf_lo(tq.y) + v0[2] * bf_lo(gq.y), bf_hi(tq.y) + v0[3] * bf_hi(gq.y));
                    w.z = cvt_pk_bf16(bf_lo(tq.z) + v1[0] * bf_lo(gq.z), bf_hi(tq.z) + v1[1] * bf_hi(gq.z)); w.w = cvt_pk_bf16(bf_lo(tq.w) + v1[2] * bf_lo(gq.w), bf_hi(tq.w) + v1[3] * bf_hi(gq.w));
                    *(u32x4*)(Dst + off + bj * HALF) = w; } }
    }
};
struct EpiResF32 {
    static constexpr bool PERM = false, AFTER_DRAIN = false;
    const float* res; float* out; int ldc; float mul;
    __device__ __forceinline__ void operator()(const AccT& acc, const Unit& u, int wr, int wc, int fr, int fq) const {
        { int t_ = threadIdx.x; asm volatile("" : "+v"(t_)); fr = t_ & 15; fq = (t_ >> 4) & 3; }
        const int row0 = u.pm * BM + wr * 64 + fr, col0 = u.pn * BM + wc * 32 + 4 * fq;
#pragma unroll
        for (int ai = 0; ai < 2; ++ai)
#pragma unroll
            for (int m = 0; m < 4; ++m) { const size_t off = (size_t)(row0 + ai * HALF + m * 16) * ldc + col0;
#pragma unroll
                for (int bj = 0; bj < 2; ++bj)
#pragma unroll
                    for (int n = 0; n < 2; ++n) { const f32x4 r = *(const f32x4*)(res + off + bj * HALF + n * 16); *(f32x4*)(out + off + bj * HALF + n * 16) = r + acc[ai][bj][m][n] * mul; } }
    }
};

__device__ __forceinline__ float row_rs(const float* ssq, int row) {
    const f32x4* p = (const f32x4*)(ssq + (size_t)row * 16); const f32x4 a = p[0], b = p[1], c = p[2], d = p[3];
    const float s = ((a[0] + a[1]) + (a[2] + a[3])) + ((b[0] + b[1]) + (b[2] + b[3])) + ((c[0] + c[1]) + (c[2] + c[3])) + ((d[0] + d[1]) + (d[2] + d[3]));
    return rsqrtf(s * (1.f / 1024.f) + 1e-6f);
}
struct EpiBf16RS {
    static constexpr bool PERM = true, AFTER_DRAIN = false;
    bf16_t* O; int ldc; const float* ssq;
    __device__ __forceinline__ void operator()(const AccT& acc, const Unit& u, int wr, int wc, int fr, int fq) const {
        { int t_ = threadIdx.x; asm volatile("" : "+v"(t_)); fr = t_ & 15; fq = (t_ >> 4) & 3; }
        const int row0 = u.pm * BM + wr * 64 + fr, col0 = u.pn * BM + wc * 32 + 8 * fq;
#pragma unroll
        for (int ai = 0; ai < 2; ++ai)
#pragma unroll
            for (int m = 0; m < 4; ++m) { int ro = row0 + ai * HALF + m * 16; asm volatile("" : "+v"(ro)); const float rs = row_rs(ssq, ro); bf16_t* rowp = O + (size_t)ro * ldc + col0;
#pragma unroll
                for (int bj = 0; bj < 2; ++bj) { const f32x4 v0 = acc[ai][bj][m][0] * rs, v1 = acc[ai][bj][m][1] * rs;
                    u32x4 w; w.x = cvt_pk_bf16(v0[0], v0[1]); w.y = cvt_pk_bf16(v0[2], v0[3]); w.z = cvt_pk_bf16(v1[0], v1[1]); w.w = cvt_pk_bf16(v1[2], v1[3]);
                    *(u32x4*)(rowp + bj * HALF) = w; } }
    }
};
struct EpiF16RS {
    static constexpr bool PERM = true, AFTER_DRAIN = false;
    _Float16* O; int ldc; const float* ssq;
    __device__ __forceinline__ void operator()(const AccT& acc, const Unit& u, int wr, int wc, int fr, int fq) const {
        { int t_ = threadIdx.x; asm volatile("" : "+v"(t_)); fr = t_ & 15; fq = (t_ >> 4) & 3; }
        typedef _Float16 h8 __attribute__((ext_vector_type(8)));
        const int row0 = u.pm * BM + wr * 64 + fr, col0 = u.pn * BM + wc * 32 + 8 * fq;
#pragma unroll
        for (int ai = 0; ai < 2; ++ai)
#pragma unroll
            for (int m = 0; m < 4; ++m) { int ro = row0 + ai * HALF + m * 16; asm volatile("" : "+v"(ro)); const float rs = row_rs(ssq, ro); _Float16* rowp = O + (size_t)ro * ldc + col0;
#pragma unroll
                for (int bj = 0; bj < 2; ++bj) { const f32x4 v0 = acc[ai][bj][m][0] * rs, v1 = acc[ai][bj][m][1] * rs;
                    h8 w = {(_Float16)v0[0], (_Float16)v0[1], (_Float16)v0[2], (_Float16)v0[3], (_Float16)v1[0], (_Float16)v1[1], (_Float16)v1[2], (_Float16)v1[3]};
                    *(h8*)(rowp + bj * HALF) = w; } }
    }
};
template <bool RES_F32> struct EpiResNorm {
    static constexpr bool PERM = true, AFTER_DRAIN = false;
    const float* resf; bf16_t* H; float* ssq; int ldc; float mul;
    __device__ __forceinline__ void operator()(const AccT& acc, const Unit& u, int wr, int wc, int fr, int fq) const {
        { int t_ = threadIdx.x; asm volatile("" : "+v"(t_)); fr = t_ & 15; fq = (t_ >> 4) & 3; }
        const int row0 = u.pm * BM + wr * 64 + fr, col0 = u.pn * BM + wc * 32 + 8 * fq;
#pragma unroll
        for (int ai = 0; ai < 2; ++ai)
#pragma unroll
            for (int m = 0; m < 4; ++m) { int ro = row0 + ai * HALF + m * 16; asm volatile("" : "+v"(ro)); const size_t off = (size_t)ro * ldc + col0; float ss = 0.f;
#pragma unroll
                for (int bj = 0; bj < 2; ++bj) { f32x4 r0, r1;
                    if (RES_F32) { r0 = *(const f32x4*)(resf + off + bj * HALF); r1 = *(const f32x4*)(resf + off + bj * HALF + 4); }
                    else { const u32x4 q = *(const u32x4*)(H + off + bj * HALF); r0 = (f32x4){bf_lo(q.x), bf_hi(q.x), bf_lo(q.y), bf_hi(q.y)}; r1 = (f32x4){bf_lo(q.z), bf_hi(q.z), bf_lo(q.w), bf_hi(q.w)}; }
                    const f32x4 v0 = r0 + acc[ai][bj][m][0] * mul, v1 = r1 + acc[ai][bj][m][1] * mul;
                    ss += ((v0[0] * v0[0] + v0[1] * v0[1]) + (v0[2] * v0[2] + v0[3] * v0[3])) + ((v1[0] * v1[0] + v1[1] * v1[1]) + (v1[2] * v1[2] + v1[3] * v1[3]));
                    u32x4 w; w.x = cvt_pk_bf16(v0[0], v0[1]); w.y = cvt_pk_bf16(v0[2], v0[3]); w.z = cvt_pk_bf16(v1[0], v1[1]); w.w = cvt_pk_bf16(v1[2], v1[3]);
                    *(u32x4*)(H + off + bj * HALF) = w; }
                ss += shx<16>(ss); ss = sum32(ss);
                if (fq == 0) ssq[(size_t)ro * 16 + u.pn * 4 + wc] = ss; }
    }
};
struct EpiIn {
    static constexpr bool PERM = true, AFTER_DRAIN = false;
    bf16_t *U, *Bb, *Q, *Kb, *V, *SGC, *SGA; const float* ropec; const float* ropes; float* kbar; float qscale;
    __device__ __forceinline__ void operator()(const AccT& acc, const Unit& u, int wr, int wc, int fr, int fq) const {
        { int t_ = threadIdx.x; asm volatile("" : "+v"(t_)); fr = t_ & 15; fq = (t_ >> 4) & 3; }
        const int pn = u.pn; const int row0 = u.pm * BM + wr * 64 + fr;
        if (pn < 4) {
            const int c0 = 128 * pn + 16 * wc + 4 * fq;
#pragma unroll
            for (int ai = 0; ai < 2; ++ai)
#pragma unroll
                for (int m = 0; m < 4; ++m) { int ro = row0 + ai * HALF + m * 16; asm volatile("" : "+v"(ro)); bf16_t* rowp = U + (size_t)ro * 512 + c0;
#pragma unroll
                    for (int bj = 0; bj < 2; ++bj) { const f32x4 x = acc[ai][bj][m][0] * acc[ai][bj][m][1]; u32x2 w; w.x = cvt_pk_bf16(x[0], x[1]); w.y = cvt_pk_bf16(x[2], x[3]); *(u32x2*)(rowp + bj * 64) = w; } }
        } else if (pn < 6 || (pn >= 10 && pn < 12)) {
            bf16_t* O = pn < 6 ? Bb : V; const int col0 = (pn < 6 ? pn - 4 : pn - 10) * BM + wc * 32 + 8 * fq;
#pragma unroll
            for (int ai = 0; ai < 2; ++ai)
#pragma unroll
                for (int m = 0; m < 4; ++m) { int ro = row0 + ai * HALF + m * 16; asm volatile("" : "+v"(ro)); bf16_t* rowp = O + (size_t)ro * 512 + col0;
#pragma unroll
                    for (int bj = 0; bj < 2; ++bj) { const f32x4 v0 = acc[ai][bj][m][0], v1 = acc[ai][bj][m][1];
                        u32x4 w; w.x = cvt_pk_bf16(v0[0], v0[1]); w.y = cvt_pk_bf16(v0[2], v0[3]); w.z = cvt_pk_bf16(v1[0], v1[1]); w.w = cvt_pk_bf16(v1[2], v1[3]);
                        *(u32x4*)(rowp + bj * HALF) = w; } }
        } else if (pn < 10) {
            const bool isk = pn >= 8; bf16_t* O = isk ? Kb : Q; const int colt = (isk ? pn - 8 : pn - 6) * BM + wc * 32 + 8 * fq;
            const int g4 = 4 * (4 * (wc & 1) + fq);
            const float sc = isk ? 1.f : qscale;
            f32x4 cs0[2] = {(f32x4){0.f, 0.f, 0.f, 0.f}, (f32x4){0.f, 0.f, 0.f, 0.f}}, cs1[2] = {(f32x4){0.f, 0.f, 0.f, 0.f}, (f32x4){0.f, 0.f, 0.f, 0.f}};
#pragma unroll
            for (int ai = 0; ai < 2; ++ai)
#pragma unroll
                for (int m = 0; m < 4; ++m) { int row = row0 + ai * HALF + m * 16; asm volatile("" : "+v"(row)); const int pos = row & 2047;
                    const f32x4 c = *(const f32x4*)(ropec + pos * 32 + g4) * sc, s = *(const f32x4*)(ropes + pos * 32 + g4) * sc;
                    bf16_t* rowp = O + (size_t)row * 512 + colt;
#pragma unroll
                    for (int bj = 0; bj < 2; ++bj) { const f32x4 x1 = acc[ai][bj][m][0], x2 = acc[ai][bj][m][1]; const f32x4 o1 = x1 * c - x2 * s, o2 = x2 * c + x1 * s;
                        cs0[bj] += o1; cs1[bj] += o2;
                        u32x4 w; w.x = cvt_pk_bf16(o1[0], o1[1]); w.y = cvt_pk_bf16(o1[2], o1[3]); w.z = cvt_pk_bf16(o2[0], o2[1]); w.w = cvt_pk_bf16(o2[2], o2[3]);
                        *(u32x4*)(rowp + bj * HALF) = w; }
                    asm volatile("" : "+v"(cs0[0]), "+v"(cs0[1]), "+v"(cs1[0]), "+v"(cs1[1]) :: "memory"); }
            if (isk) {
#pragma unroll
                for (int bj = 0; bj < 2; ++bj)
#pragma unroll
                    for (int j = 0; j < 4; ++j) { float a = cs0[bj][j], b = cs1[bj][j];
                        a += shx<1>(a); b += shx<1>(b); a += shx<2>(a); b += shx<2>(b); a += shx<4>(a); b += shx<4>(b); a += shx<8>(a); b += shx<8>(b);
                        if (fr == 0) { const int pc = (pn - 8) * BM + bj * HALF + wc * 32 + 8 * fq;
                            float* kb = kbar + (size_t)u.pm * 512 + pc; atomicAdd(kb + j, a); atomicAdd(kb + 4 + j, b); } }
            }
        } else {
            bf16_t* O = pn < 16 ? SGC : SGA; const int col0 = (pn < 16 ? pn - 12 : pn - 16) * BM + wc * 32 + 8 * fq;
#pragma unroll
            for (int ai = 0; ai < 2; ++ai)
#pragma unroll
                for (int m = 0; m < 4; ++m) { int ro = row0 + ai * HALF + m * 16; asm volatile("" : "+v"(ro)); bf16_t* rowp = O + (size_t)ro * 1024 + col0;
#pragma unroll
                    for (int bj = 0; bj < 2; ++bj) { f32x4 v0 = acc[ai][bj][m][0], v1 = acc[ai][bj][m][1];
#pragma unroll
                        for (int j = 0; j < 4; ++j) { v0[j] = __builtin_amdgcn_rcpf(1.f + __expf(-v0[j])); v1[j] = __builtin_amdgcn_rcpf(1.f + __expf(-v1[j])); }
                        u32x4 w; w.x = cvt_pk_bf16(v0[0], v0[1]); w.y = cvt_pk_bf16(v0[2], v0[3]); w.z = cvt_pk_bf16(v1[0], v1[1]); w.w = cvt_pk_bf16(v1[2], v1[3]);
                        *(u32x4*)(rowp + bj * HALF) = w; }
                    asm volatile("" ::: "memory"); }
        }
    }
};
struct EpiSoftmax {
    static constexpr bool PERM = true, AFTER_DRAIN = true;
    bf16_t* O; int ldc; float scale_log2;
    __device__ __forceinline__ void fused(AccT& acc, const Unit& u, int wr, int wc, int fr, int fq, PG8_LAS unsigned char* lds, int wid, int lane) const {
        { int t_ = threadIdx.x; asm volatile("" : "+v"(t_)); fr = t_ & 15; fq = (t_ >> 4) & 3; }
        PG8_LAS f32x2* X = (PG8_LAS f32x2*)lds;
        float mx[2][4];
#pragma unroll
        for (int ai = 0; ai < 2; ++ai)
#pragma unroll
            for (int m = 0; m < 4; ++m) { float a = -3.0e38f;
#pragma unroll
                for (int bj = 0; bj < 2; ++bj)
#pragma unroll
                    for (int n = 0; n < 2; ++n) { acc[ai][bj][m][n] = acc[ai][bj][m][n] * scale_log2; const f32x4 x = acc[ai][bj][m][n]; a = fmaxf(fmaxf(a, fmaxf(x[0], x[1])), fmaxf(x[2], x[3])); }
                a = fmaxf(a, shx<16>(a)); a = max32(a); mx[ai][m] = a;
                float s = 0.f;
#pragma unroll
                for (int bj = 0; bj < 2; ++bj)
#pragma unroll
                    for (int n = 0; n < 2; ++n) { f32x4 x = acc[ai][bj][m][n];
#pragma unroll
                        for (int j = 0; j < 4; ++j) { x[j] = __builtin_amdgcn_exp2f(x[j] - a); s += x[j]; }
                        acc[ai][bj][m][n] = x; }
                s += shx<16>(s); s = sum32(s);
                if (fq == 0) X[(ai * HALF + wr * 64 + m * 16 + fr) * 4 + wc] = (f32x2){a, s};
            }
        asm volatile("s_waitcnt lgkmcnt(0)" ::: "memory"); __builtin_amdgcn_s_barrier(); asm volatile("" ::: "memory");
        const int row0 = u.pm * BM + wr * 64 + fr, col0 = u.pn * BM + wc * 32 + 8 * fq;
#pragma unroll
        for (int ai = 0; ai < 2; ++ai)
#pragma unroll
            for (int m = 0; m < 4; ++m) { const int r = ai * HALF + wr * 64 + m * 16 + fr;
                const f32x2 e0 = X[r * 4 + 0], e1 = X[r * 4 + 1], e2 = X[r * 4 + 2], e3 = X[r * 4 + 3];
                const float M = fmaxf(fmaxf(e0.x, e1.x), fmaxf(e2.x, e3.x));
                const float L = e0.y * __builtin_amdgcn_exp2f(e0.x - M) + e1.y * __builtin_amdgcn_exp2f(e1.x - M) + e2.y * __builtin_amdgcn_exp2f(e2.x - M) + e3.y * __builtin_amdgcn_exp2f(e3.x - M);
                const float f = __builtin_amdgcn_exp2f(mx[ai][m] - M) * __builtin_amdgcn_rcpf(L);
                bf16_t* rowp = O + (size_t)(row0 + ai * HALF + m * 16) * ldc + col0;
#pragma unroll
                for (int bj = 0; bj < 2; ++bj) { const f32x4 v0 = acc[ai][bj][m][0] * f, v1 = acc[ai][bj][m][1] * f;
                    u32x4 w; w.x = cvt_pk_bf16(v0[0], v0[1]); w.y = cvt_pk_bf16(v0[2], v0[3]); w.z = cvt_pk_bf16(v1[0], v1[1]); w.w = cvt_pk_bf16(v1[2], v1[3]);
                    *(u32x4*)(rowp + bj * HALF) = w; } }
        asm volatile("s_waitcnt lgkmcnt(0)" ::: "memory"); __builtin_amdgcn_s_barrier(); asm volatile("" ::: "memory");
    }
};
}
namespace attn_body {
using bf16=__hip_bfloat16;
using bf16x8=__attribute__((ext_vector_type(8)))short;
using s16x4=__attribute__((ext_vector_type(4)))short;
using f32x16=__attribute__((ext_vector_type(16)))float;
using u32x4=__attribute__((ext_vector_type(4)))unsigned;
constexpr int BATCH=16,NHEAD=8,SEQ=2048,D=64,DM=NHEAD*D;
constexpr int NW=8,QBLK=32,QB=QBLK*NW,KVBLK=64,NQB=SEQ/QB;
constexpr int ATTN_PITCH=DM, ATTN_UNIT_ROWS=QB;
__device__ __forceinline__ int crow(int r,int hi){return (r&3)+8*(r>>2)+4*hi;}
#define SBAR() __builtin_amdgcn_sched_barrier(0)
__device__ __forceinline__ void cmask(f32x16&p0,f32x16&p1,int jb,int qrel,int hi){
  const float NEG=-INFINITY; int kb=64*jb+4*hi;
  #pragma unroll
  for(int r=0;r<16;++r){int kv=kb+(r&3)+8*(r>>2); if(kv>qrel)p0[r]=NEG; if(kv+32>qrel)p1[r]=NEG;}
}

constexpr int NSLOT=3, SLOTB=8192;
constexpr int LDS_K=0, LDS_V=NSLOT*SLOTB, LDS_WS=2*NSLOT*SLOTB, LDS_OST=LDS_WS+NW*64*4, LDS_SEL=LDS_OST+NW*4096, LDS_BYTES=LDS_SEL+NW*64*4;
constexpr float C2=0.125f*1.4426950408889634f;
__device__ __forceinline__ void glds16(const void*gsrc,unsigned lds_dst){unsigned keep;
  asm volatile("s_mov_b32 %0, m0\n\ts_mov_b32 m0, %2\n\ts_nop 0\n\tglobal_load_lds_dwordx4 %1, off\n\ts_mov_b32 m0, %0":"=&s"(keep):"v"(gsrc),"s"(lds_dst):"memory");}
__device__ __forceinline__ float max3f(float a,float b,float c){float r;asm("v_max3_f32 %0, %1, %2, %3":"=v"(r):"v"(a),"v"(b),"v"(c));return r;}
__device__ __forceinline__ float max2f(float a,float b){float r;asm("v_max_f32_e32 %0, %1, %2":"=v"(r):"v"(a),"v"(b));return r;}
__device__ __forceinline__ float fadd_s(float a,float b){float r;asm("v_add_f32_e32 %0, %1, %2":"=v"(r):"v"(a),"v"(b));return r;}
__device__ __forceinline__ float fsub_s(float a,float b){float r;asm("v_sub_f32_e32 %0, %1, %2":"=v"(r):"v"(a),"v"(b));return r;}
typedef float f32x2_t __attribute__((ext_vector_type(2))); typedef __bf16 bf16x2_t __attribute__((ext_vector_type(2)));
__device__ __forceinline__ unsigned cvtpk_s(float lo,float hi){f32x2_t v={lo,hi};bf16x2_t b=__builtin_convertvector(v,bf16x2_t);return __builtin_bit_cast(unsigned,b);}
#define WAIT_BAR(N) asm volatile("s_waitcnt vmcnt(" #N ") lgkmcnt(0)\n\ts_barrier":::"memory")

__device__ __forceinline__ void qkt(f32x16&p0,f32x16&p1,const char*Kslot,const bf16x8*qr,const f32x16&negm,int r32,int hi){
  const char*kb=Kslot+hi*1024+r32*16;
  #pragma unroll
  for(int d0=0;d0<4;++d0){
    const bf16x8 b0=*reinterpret_cast<const bf16x8*>(kb+d0*2048);
    const bf16x8 b1=*reinterpret_cast<const bf16x8*>(kb+d0*2048+512);
    if(d0==0){p0=__builtin_amdgcn_mfma_f32_32x32x16_bf16(b0,qr[0],negm,0,0,0);p1=__builtin_amdgcn_mfma_f32_32x32x16_bf16(b1,qr[0],negm,0,0,0);}
    else{p0=__builtin_amdgcn_mfma_f32_32x32x16_bf16(b0,qr[d0],p0,0,0,0);p1=__builtin_amdgcn_mfma_f32_32x32x16_bf16(b1,qr[d0],p1,0,0,0);}}
}
typedef __attribute__((address_space(3))) const char* lds_cptr;
typedef short v4i16_t __attribute__((ext_vector_type(4)));
__device__ __forceinline__ void kload8(bf16x8*kf,lds_cptr kp){
  kf[0]=*(const __attribute__((address_space(3))) bf16x8*)(kp);      kf[1]=*(const __attribute__((address_space(3))) bf16x8*)(kp+512);
  kf[2]=*(const __attribute__((address_space(3))) bf16x8*)(kp+2048); kf[3]=*(const __attribute__((address_space(3))) bf16x8*)(kp+2560);
  kf[4]=*(const __attribute__((address_space(3))) bf16x8*)(kp+4096); kf[5]=*(const __attribute__((address_space(3))) bf16x8*)(kp+4608);
  kf[6]=*(const __attribute__((address_space(3))) bf16x8*)(kp+6144); kf[7]=*(const __attribute__((address_space(3))) bf16x8*)(kp+6656);
}
__device__ __forceinline__ void kload2(bf16x8*kf,lds_cptr kp,int j){ kf[2*j]=*(const __attribute__((address_space(3))) bf16x8*)(kp+j*2048); kf[2*j+1]=*(const __attribute__((address_space(3))) bf16x8*)(kp+j*2048+512); }
__device__ __forceinline__ s16x4 vtr(lds_cptr p){ return __builtin_bit_cast(s16x4,__builtin_amdgcn_ds_read_tr16_b64_v4i16((__attribute__((address_space(3))) v4i16_t*)p)); }
__device__ __forceinline__ float rowmax(const f32x16&p0,const f32x16&p1){
  float a=max3f(p0[0],p0[1],p1[0]),b=max3f(p0[2],p0[3],p1[1]);a=max3f(a,p1[2],p1[3]);
  #pragma unroll
  for(int r=4;r<16;r+=4){a=max3f(a,p0[r],p0[r+1]);b=max3f(b,p0[r+2],p0[r+3]);a=max3f(a,p1[r],p1[r+1]);b=max3f(b,p1[r+2],p1[r+3]);}
  const float m=max2f(a,b);
  auto rr=__builtin_amdgcn_permlane32_swap(__float_as_uint(m),__float_as_uint(m),false,false);
  return max2f(__uint_as_float(rr[0]),__uint_as_float(rr[1]));
}
__device__ __forceinline__ void pv(f32x16*o,int vb,bf16x8 pa0,bf16x8 pa1,bf16x8 pa2,bf16x8 pa3){
  #pragma unroll
  for(int d0=0;d0<2;++d0){s16x4 lo[4],hi[4];
    #pragma unroll
    for(int ks=0;ks<4;++ks){
      asm volatile("ds_read_b64_tr_b16 %0,%1 offset:%c2":"=&v"(lo[ks]):"v"(vb),"i"(d0*4096+ks*1024):"memory");
      asm volatile("ds_read_b64_tr_b16 %0,%1 offset:%c2":"=&v"(hi[ks]):"v"(vb),"i"(d0*4096+ks*1024+512):"memory");}
    asm volatile("s_waitcnt lgkmcnt(0)":::"memory");SBAR();
    #define PK(k) (bf16x8){lo[k][0],lo[k][1],lo[k][2],lo[k][3],hi[k][0],hi[k][1],hi[k][2],hi[k][3]}
    o[d0]=__builtin_amdgcn_mfma_f32_32x32x16_bf16(pa0,PK(0),o[d0],0,0,0);
    o[d0]=__builtin_amdgcn_mfma_f32_32x32x16_bf16(pa1,PK(1),o[d0],0,0,0);
    o[d0]=__builtin_amdgcn_mfma_f32_32x32x16_bf16(pa2,PK(2),o[d0],0,0,0);
    o[d0]=__builtin_amdgcn_mfma_f32_32x32x16_bf16(pa3,PK(3),o[d0],0,0,0);
    #undef PK
  }
}

#ifndef ATTN_STORE16
#define ATTN_STORE16(p,v) (*(u32x4*)(p)=(v))
#endif
template<int THRL> __device__ __forceinline__ void attn_unit(int b,int h,int qb,const bf16*Q,const bf16*__restrict__ K,const bf16*__restrict__ V,bf16*O,const float*__restrict__ kbar,char*shm){
  int tid=threadIdx.x; asm volatile("":"+v"(tid)); const int lane=tid&63,r32=lane&31,hi=lane>>5; const int wid=__builtin_amdgcn_readfirstlane(tid>>6);
  const long rowbase=(long)b*SEQ; const int q0=qb*QB;
  const bf16*Qw=Q+(rowbase+q0+wid*QBLK)*DM+h*D;
  const bf16*Kh=K+rowbase*DM+h*D,*Vh=V+rowbase*DM+h*D;
  const unsigned lds0=(unsigned)(uintptr_t)shm;
  float*wsf=(float*)(shm+LDS_WS)+wid*64;
  const bf16*ksrc=Kh+(long)lane*DM+wid*8;
  const bf16*vsrc=Vh+(long)(16*(wid&3)+(lane>>2))*DM+(wid>>2)*32+(lane&3)*8;
  const unsigned kdst=lds0+LDS_K+wid*1024, vdst=lds0+LDS_V+wid*1024;
  #define DMA_K(t,slot) glds16(ksrc+(long)(t)*KVBLK*DM,(unsigned)__builtin_amdgcn_readfirstlane(kdst+(slot)))
  #define DMA_V(t,slot) glds16(vsrc+(long)(t)*KVBLK*DM,(unsigned)__builtin_amdgcn_readfirstlane(vdst+(slot)))
  const int vb0=(int)(lds0+LDS_V)+((lane>>4)&1)*32+(lane&3)*8+(4*hi+((lane&15)>>2))*64;
  const char*Kbase=shm+LDS_K; bf16x8 kf[8];
  const lds_cptr shm3=(lds_cptr)shm; const lds_cptr kp0=shm3+LDS_K+hi*1024+r32*16; const lds_cptr vp0=shm3+LDS_V+((lane>>4)&1)*32+(lane&3)*8+(4*hi+((lane&15)>>2))*64;
  const int NT=(q0+QB)/KVBLK;
  DMA_K(0,0);DMA_V(0,0);DMA_K(1,SLOTB);
  bf16x8 qr[4];
  #pragma unroll
  for(int d0=0;d0<4;++d0)qr[d0]=*reinterpret_cast<const bf16x8*>(&Qw[(long)r32*DM+d0*16+hi*8]);
  int selm=0;
  if(qb>0){
    float g[7]; int hi8=8*hi; asm volatile("":"+v"(hi8)); const float*kb=kbar+(size_t)(b*8)*512+h*64+hi8;
    #pragma unroll
    for(int n=0;n<7;++n){ float a=0.f;
      if(n<qb){
        #pragma unroll
        for(int d0=0;d0<4;++d0){ const float4 k0=*(const float4*)(kb+n*512+16*d0),k1=*(const float4*)(kb+n*512+16*d0+4); const bf16x8 qq=qr[d0];
          #define QF(e) __uint_as_float(((unsigned)(unsigned short)qq[e])<<16)
          a+=QF(0)*k0.x+QF(1)*k0.y+QF(2)*k0.z+QF(3)*k0.w+QF(4)*k1.x+QF(5)*k1.y+QF(6)*k1.z+QF(7)*k1.w;
          #undef QF
        } }
      a=::sum32(a); g[n]=(n<qb)?a:-INFINITY; asm volatile("":"+v"(g[n])::"memory"); }
    #pragma unroll
    for(int r=0;r<3;++r){ int best=-1; float bv=-INFINITY;
      #pragma unroll
      for(int n=0;n<7;++n) if(!((selm>>n)&1)&&g[n]>bv){bv=g[n];best=n;}
      if(best>=0)selm|=1<<best; }
  }
  selm|=1<<qb;
  typedef __attribute__((address_space(3))) int* lds_iptr;
  ((lds_iptr)(shm3+LDS_SEL))[tid]=selm;
  #define CURNEG(blk) ({ int t_=threadIdx.x; asm volatile("":"+v"(t_)); const int sm_=((lds_iptr)(shm3+LDS_SEL))[t_]; ((sm_>>(blk))&1)?0.f:-INFINITY; })
  #define NEGUPD(t) do{ if((((t)+1)&3)==0){ const float cn_=CURNEG(((t)+1)>>2); _Pragma("unroll") for(int r=0;r<16;++r)negm[r]=cn_-mhat; asm volatile("":"+v"(negm)); } }while(0)
  float mhat=0.f,l_reg=0.f;f32x16 o[2];o[0]=f32x16{};o[1]=f32x16{};f32x16 negm; { const float cn_=CURNEG(0); _Pragma("unroll") for(int r=0;r<16;++r)negm[r]=cn_; } asm volatile("":"+v"(negm));
  const int qrel=wid*QBLK+r32;
  #define CMASK(P0,P1,t) do{int jb_=(t)-(NT-4); if(jb_>=0)cmask(P0,P1,jb_,qrel,hi);}while(0)
  bool resc=false;
  #define START(P0,P1) do{ const float rm=rowmax(P0,P1); resc=false; \
    { const float dl=__builtin_fmaxf(rm,-24.f); mhat=fadd_s(mhat,dl); \
      _Pragma("unroll") for(int r=0;r<16;++r){P0[r]=fsub_s(P0[r],dl);P1[r]=fsub_s(P1[r],dl);} \
      { const float cn_=CURNEG(0); _Pragma("unroll") for(int r=0;r<16;++r)negm[r]=cn_-mhat; } asm volatile("":"+v"(negm)); } \
    _Pragma("unroll") for(int r=0;r<16;++r)P0[r]=__builtin_amdgcn_exp2f(P0[r]); }while(0)
  #define RESC() do{ if(resc){ asm volatile("s_waitcnt lgkmcnt(0)":::"memory"); \
      _Pragma("unroll") for(int d_=0;d_<2;++d_) _Pragma("unroll") for(int r=0;r<16;++r)o[d_][r]*=wsf[crow(r,hi)]; } }while(0)
  f32x16 pA0,pA1,pB0,pB1;
  int sl_prev=0,sl_cur=0,sl_next=SLOTB;
  #define ROT() do{sl_prev=sl_cur;sl_cur=sl_next;sl_next=(sl_next==(NSLOT-1)*SLOTB)?0:sl_next+SLOTB;}while(0)
  DMA_K(2,2*SLOTB);
  WAIT_BAR(3);
  qkt(pA0,pA1,Kbase,qr,negm,r32,hi);asm volatile("s_nop 15\n\ts_nop 7":"+v"(pA0),"+v"(pA1));CMASK(pA0,pA1,0);
  START(pA0,pA1);
  _Pragma("unroll") for(int r=0;r<16;++r)pA1[r]=__builtin_amdgcn_exp2f(pA1[r]);
  WAIT_BAR(0);
  DMA_K(3,0);DMA_V(1,SLOTB);
  ROT();
  kload8(kf,kp0+sl_cur);
  WAIT_BAR(2);
  s16x4 vlo[8],vhi[8]; u32x4 pw0,pw1,pw2,pw3;
  #define PKW(P,B) cvtpk_s(P[B],P[B+1])
  #define PAF(k) __builtin_bit_cast(bf16x8,pw##k)
  #define VFR(i) (bf16x8){vlo[i][0],vlo[i][1],vlo[i][2],vlo[i][3],vhi[i][0],vhi[i][1],vhi[i][2],vhi[i][3]}
  #define PIN(x) asm volatile("":"+v"(x))
  #define MX3(a,b,c) __builtin_fmaxf(__builtin_fmaxf((a),(b)),(c))
  #define GAPA(MF,A0,A1,A2,A3,W0,W1,PW) do{ MF; sacc+=A0; sacc+=A1; sacc+=A2; sacc+=A3; PIN(sacc); W0; W1; PIN(PW); SBAR(); }while(0)
  #define EX(v) __builtin_amdgcn_exp2f(v)
  #define GAPB(MF,X,B) do{ MF; X[B]=EX(X[B]); X[B+1]=EX(X[B+1]); X[B+2]=EX(X[B+2]); X[B+3]=EX(X[B+3]); PIN(X); SBAR(); }while(0)
  #define VRD(i) do{ vlo[i]=vtr(vp_+(((i)>>2)*4096+((i)&3)*1024)); vhi[i]=vtr(vp_+(((i)>>2)*4096+((i)&3)*1024+512)); }while(0)
  #define KRD(G,j) do{ if(G){ kload2(kf,kp0+sl_next,j); SBAR(); } }while(0)
  #define STEP(C0,C1,P0,P1,t,GK,GV,GL) do{ SBAR(); \
    const lds_cptr vp_=vp0+sl_prev; \
    VRD(0); SBAR(); float sacc=(P0[0]+P0[1]); \
    GAPA(C0=__builtin_amdgcn_mfma_f32_32x32x16_bf16(kf[0],qr[0],negm,0,0,0), P0[2],P0[3],P0[4],P0[5],     pw0[0]=PKW(P0,0), pw0[1]=PKW(P0,2), pw0); \
    VRD(4); SBAR(); GAPA(C1=__builtin_amdgcn_mfma_f32_32x32x16_bf16(kf[1],qr[0],negm,0,0,0), P0[6],P0[7],P0[8],P0[9],     pw0[2]=PKW(P0,4), pw0[3]=PKW(P0,6), pw0); \
    VRD(1); SBAR(); GAPA(C0=__builtin_amdgcn_mfma_f32_32x32x16_bf16(kf[2],qr[1],C0,0,0,0),   P0[10],P0[11],P0[12],P0[13], pw1[0]=PKW(P0,8), pw1[1]=PKW(P0,10), pw1); \
    VRD(5); SBAR(); GAPA(C1=__builtin_amdgcn_mfma_f32_32x32x16_bf16(kf[3],qr[1],C1,0,0,0),   P0[14],P0[15],P1[0],P1[1],   pw1[2]=PKW(P0,12),pw1[3]=PKW(P0,14), pw1); \
    VRD(2); SBAR(); GAPA(C0=__builtin_amdgcn_mfma_f32_32x32x16_bf16(kf[4],qr[2],C0,0,0,0),   P1[2],P1[3],P1[4],P1[5],     pw2[0]=PKW(P1,0), pw2[1]=PKW(P1,2), pw2); \
    VRD(6); SBAR(); GAPA(C1=__builtin_amdgcn_mfma_f32_32x32x16_bf16(kf[5],qr[2],C1,0,0,0),   P1[6],P1[7],P1[8],P1[9],     pw2[2]=PKW(P1,4), pw2[3]=PKW(P1,6), pw2); \
    VRD(3); SBAR(); GAPA(C0=__builtin_amdgcn_mfma_f32_32x32x16_bf16(kf[6],qr[3],C0,0,0,0),   P1[10],P1[11],P1[12],P1[13], pw3[0]=PKW(P1,8), pw3[1]=PKW(P1,10), pw3); \
    VRD(7); SBAR(); GAPA(C1=__builtin_amdgcn_mfma_f32_32x32x16_bf16(kf[7],qr[3],C1,0,0,0),   P1[14],P1[15],0.f,0.f,       pw3[2]=PKW(P1,12),pw3[3]=PKW(P1,14), pw3); \
    l_reg+=sacc; \
    if(GK){DMA_K((t)+3,sl_cur);} if(GV){DMA_V((t)+1,sl_next);} \
    CMASK(C0,C1,t); \
    { float a=MX3(C0[0],C0[1],C1[0]),b=MX3(C0[2],C0[3],C1[1]); a=MX3(a,C1[2],C1[3]); \
      _Pragma("unroll") for(int r=4;r<16;r+=4){a=MX3(a,C0[r],C0[r+1]);b=MX3(b,C0[r+2],C0[r+3]);a=MX3(a,C1[r],C1[r+1]);b=MX3(b,C1[r+2],C1[r+3]);} \
      float rm=__builtin_fmaxf(a,b); { auto rr=__builtin_amdgcn_permlane32_swap(__float_as_uint(rm),__float_as_uint(rm),false,false); rm=__builtin_fmaxf(__uint_as_float(rr[0]),__uint_as_float(rr[1])); } \
      resc=false; \
      if(__builtin_expect(__any(rm>(float)THRL),0)){ const float dl=__builtin_fmaxf(rm,0.f); mhat+=dl; \
        _Pragma("unroll") for(int r=0;r<16;++r){C0[r]-=dl;C1[r]-=dl;} \
        { const float cn_=CURNEG(((t)+1)>>2); _Pragma("unroll") for(int r=0;r<16;++r)negm[r]=cn_-mhat; } asm volatile("":"+v"(negm)); \
        const float f=__builtin_amdgcn_exp2f(-dl); l_reg*=f; if(hi==0)wsf[r32]=f; resc=true; } } \
    SBAR(); \
    GAPB(o[0]=__builtin_amdgcn_mfma_f32_32x32x16_bf16(PAF(0),VFR(0),o[0],0,0,0), C0,0); \
    GAPB(o[1]=__builtin_amdgcn_mfma_f32_32x32x16_bf16(PAF(0),VFR(4),o[1],0,0,0), C0,4); \
    KRD(GL,0); GAPB(o[0]=__builtin_amdgcn_mfma_f32_32x32x16_bf16(PAF(1),VFR(1),o[0],0,0,0), C0,8); \
    KRD(GL,1); GAPB(o[1]=__builtin_amdgcn_mfma_f32_32x32x16_bf16(PAF(1),VFR(5),o[1],0,0,0), C0,12); \
    KRD(GL,2); GAPB(o[0]=__builtin_amdgcn_mfma_f32_32x32x16_bf16(PAF(2),VFR(2),o[0],0,0,0), C1,0); \
    KRD(GL,3); GAPB(o[1]=__builtin_amdgcn_mfma_f32_32x32x16_bf16(PAF(2),VFR(6),o[1],0,0,0), C1,4); \
    GAPB(o[0]=__builtin_amdgcn_mfma_f32_32x32x16_bf16(PAF(3),VFR(3),o[0],0,0,0), C1,8); \
    GAPB(o[1]=__builtin_amdgcn_mfma_f32_32x32x16_bf16(PAF(3),VFR(7),o[1],0,0,0), C1,12); \
    }while(0)
  int t=1;
  #undef CMASK
  #define CMASK(P0,P1,t) do{}while(0)
  for(;t+5<NT;t+=2){
    STEP(pB0,pB1,pA0,pA1,t,true,true,true);     WAIT_BAR(2); RESC(); ROT(); NEGUPD(t);
    STEP(pA0,pA1,pB0,pB1,t+1,true,true,true);   WAIT_BAR(2); RESC(); ROT(); NEGUPD(t+1);
  }
  #undef CMASK
  #define CMASK(P0,P1,t) do{int jb_=(t)-(NT-4); if(jb_>=0)cmask(P0,P1,jb_,qrel,hi);}while(0)
  #define ENDW(tt) do{ if((tt)+3<NT){WAIT_BAR(2);} else if((tt)+2<NT){WAIT_BAR(1);} else {WAIT_BAR(0);} }while(0)
  for(;t+1<NT;t+=2){
    STEP(pB0,pB1,pA0,pA1,t,(t+3<NT),(t+1<NT),(t+1<NT));       ENDW(t);   RESC(); ROT(); NEGUPD(t);
    STEP(pA0,pA1,pB0,pB1,t+1,(t+4<NT),(t+2<NT),(t+2<NT));     ENDW(t+1); RESC(); ROT(); NEGUPD(t+1);
  }
  STEP(pB0,pB1,pA0,pA1,NT-1,false,false,false); RESC();
  { float sacc=pB0[0]+pB0[1]; _Pragma("unroll") for(int r=2;r<16;++r)sacc+=pB0[r]; _Pragma("unroll") for(int r=0;r<16;++r)sacc+=pB1[r]; l_reg+=sacc;
    pw0=(u32x4){PKW(pB0,0),PKW(pB0,2),PKW(pB0,4),PKW(pB0,6)};pw1=(u32x4){PKW(pB0,8),PKW(pB0,10),PKW(pB0,12),PKW(pB0,14)};pw2=(u32x4){PKW(pB1,0),PKW(pB1,2),PKW(pB1,4),PKW(pB1,6)};pw3=(u32x4){PKW(pB1,8),PKW(pB1,10),PKW(pB1,12),PKW(pB1,14)};
    SBAR(); pv(o,vb0+sl_cur,PAF(0),PAF(1),PAF(2),PAF(3)); }
  #undef PKW
  #undef PAF
  #undef VFR
  #undef PIN
  #undef MX3
  #undef GAPA
  #undef GAPB
  #undef EX
  #undef VRD
  #undef KRD
  #undef STEP
  #undef ENDW
  {auto rr=__builtin_amdgcn_permlane32_swap(__float_as_uint(l_reg),__float_as_uint(l_reg),false,false);l_reg=__uint_as_float(rr[0])+__uint_as_float(rr[1]);}
  if(hi==0)wsf[32+r32]=l_reg;asm volatile("s_waitcnt lgkmcnt(0)":::"memory");
  float rli[16];
  #pragma unroll
  for(int r=0;r<16;++r)rli[r]=__builtin_amdgcn_rcpf(wsf[32+crow(r,hi)]);
  bf16*Ow=O+(rowbase+q0+wid*QBLK)*DM+h*D;
  { bf16*stg=(bf16*)(shm+LDS_OST)+wid*2048;
    #pragma unroll
    for(int r=0;r<16;++r){const int orow=crow(r,hi);
      #pragma unroll
      for(int d0=0;d0<2;++d0)stg[orow*64+d0*32+r32]=__float2bfloat16(o[d0][r]*rli[r]);}
    asm volatile("s_waitcnt lgkmcnt(0)":::"memory");
    #pragma unroll
    for(int i=0;i<4;++i){const int row=i*8+(lane>>3),ch=lane&7; const u32x4 v=*(const u32x4*)(stg+row*64+ch*8); ATTN_STORE16(Ow+(long)row*DM+ch*8,v);} }
  asm volatile("s_waitcnt lgkmcnt(0)\n\ts_barrier":::"memory");
  #undef DMA_K
  #undef DMA_V
  #undef CMASK
  #undef START
  #undef CURNEG
  #undef NEGUPD
  #undef RESC
  #undef ROT
}
constexpr int ATTN_LDS_BYTES=LDS_BYTES;
struct AttnTensors { const bf16* Q; const bf16* K; const bf16* V; bf16* O; const float* kbar; };
struct AttnUnit { int bh; int qb; };
struct StaticOrder {
  int vcu,G;
  __device__ __forceinline__ explicit StaticOrder(int grid,int block):vcu((grid%8==0)?(block%8)*(grid/8)+block/8:block),G(grid){}
  __device__ __forceinline__ bool next(int i,AttnUnit&u)const{
    if(G==256){ if(i>=4)return false; const int s=vcu&1; u.bh=vcu>>1; u.qb=s?((i==0)?6:(i==1)?1:(i==2)?5:2):((i==0)?7:(i==1)?0:(i==2)?4:3); return true; }
    const int L=i*G+vcu; if(L>=1024)return false; u.bh=L>>3; u.qb=L&7; return true; }
  __device__ __forceinline__ void a_ready(const AttnUnit&)const{}
  __device__ __forceinline__ void done(const AttnUnit&)const{}
};
template<class Sched,int THRL=8> __device__ __forceinline__ void attn_phase(char*lds,const AttnTensors&T,const Sched&S){
  AttnUnit u;
  for(int i=0;S.next(i,u);++i){ S.a_ready(u); attn_unit<THRL>(u.bh/NHEAD,u.bh%NHEAD,u.qb,T.Q,T.K,T.V,T.O,T.kbar,lds); S.done(u); }
}
#undef SBAR
#undef WAIT_BAR
}
constexpr int NWAVES = 8;
constexpr int T = 32768, D = 1024, SEQ = 2048, MEMROWS = 4096, INW = 5120;
constexpr float RMS_EPS = 1e-6f;
constexpr size_t MiB = 1u << 20;
constexpr size_t WS_CTL = 0, CTL_ZERO_BYTES = 2 * MiB, WS_KBAR = 1 * MiB;
constexpr size_t WS_WIN = 2 * MiB, WS_WC = 12 * MiB, WS_WA = 13 * MiB, WS_WM = 14 * MiB, WS_WXQ = 16 * MiB, WS_WXKV = 18 * MiB, WS_WXO = 22 * MiB, WS_MT = 24 * MiB, WS_ROPE = 28 * MiB;
constexpr size_t WS_MEMN = 32 * MiB, WS_KX = 40 * MiB, WS_VXT = 48 * MiB;
constexpr size_t WS_SSQ1 = 30 * MiB, WS_SSQ2 = 56 * MiB;
constexpr size_t WS_A = 64 * MiB;
constexpr size_t WS_YC = 128 * MiB, WS_QO = 160 * MiB, WS_U = 192 * MiB, WS_K = 224 * MiB, WS_V = 256 * MiB;
constexpr size_t WS_SGC = 320 * MiB, WS_SGA = 384 * MiB;
constexpr size_t WS_EIDX = 448 * MiB, WS_GW = 464 * MiB, WS_PW = 480 * MiB, WS_END = 496 * MiB;
constexpr size_t WS_U8 = 288 * MiB, WS_V8T = 304 * MiB, WS_SU = 29 * MiB, WS_SV = 29 * MiB + 512 * 1024;
constexpr size_t WS_QX = 128 * MiB, WS_PM = 192 * MiB, WS_OX = 128 * MiB;
constexpr size_t WS_PO = 128 * MiB;
constexpr size_t WS_SC = 128 * MiB;
constexpr int CW_TMO = 0, CW_BAR = 4096, CW_Q = 8192;
constexpr int RING_OFF = 0, RING_BYTES = 131072;
constexpr int LDSCTL_OFF = RING_BYTES, MISC_OFF = LDSCTL_OFF + 320;
constexpr int LDS_BYTES = 163840;
constexpr int UL_OFF = RING_BYTES + 512, UL_WAVE = (LDS_BYTES - UL_OFF) / 8, UL_CAP = ((UL_WAVE - 64) / 16) & ~15;

#define GAS __attribute__((address_space(1)))
#define LAS __attribute__((address_space(3)))
typedef unsigned short bf16;
typedef unsigned v4u __attribute__((ext_vector_type(4)));
typedef unsigned v2u __attribute__((ext_vector_type(2)));
typedef float f32x4 __attribute__((ext_vector_type(4)));
typedef float f32x2v __attribute__((ext_vector_type(2)));
typedef _Float16 h2v __attribute__((ext_vector_type(2)));
typedef GAS unsigned gu32;
#define RLX_AGENT __ATOMIC_RELAXED, __HIP_MEMORY_SCOPE_AGENT
#define LDS_WAIT() asm volatile("s_waitcnt lgkmcnt(0)" ::: "memory")
#define VM_WAIT() asm volatile("s_waitcnt vmcnt(0)" ::: "memory")
__device__ __forceinline__ unsigned pk2(float lo, float hi) { return pg8::cvt_pk_bf16(lo, hi); }
__device__ __forceinline__ float bflo(unsigned u) { return __uint_as_float(u << 16); }
__device__ __forceinline__ float bfhi(unsigned u) { return __uint_as_float(u & 0xffff0000u); }

#define XB_TMO      128
#define XB_XCNT(j)  (256  + 64 * (j))
#define XB_XSUB(j)  (1280 + 64 * (j))
#define XB_XGEN(j)  (2304 + 64 * (j))
#define XB_TOP      3328
#define XB_TOPGEN   3392
#define XCD_BAR_WORDS 3456
#define XB_SPIN_CAP (1u << 18)
__device__ __forceinline__ unsigned xb_ld(unsigned* p)              { return __hip_atomic_load(p, __ATOMIC_RELAXED, __HIP_MEMORY_SCOPE_AGENT); }
__device__ __forceinline__ unsigned xb_add(unsigned* p, unsigned v) { return __hip_atomic_fetch_add(p, v, __ATOMIC_RELAXED, __HIP_MEMORY_SCOPE_AGENT); }
__device__ __forceinline__ unsigned xb_xcc_id() { return (unsigned)__builtin_amdgcn_s_getreg((3 << 11) | 20) & 0xFu; }
#define XB_SPIN(cond, bar) do { unsigned _sp = 0; while (cond) { __builtin_amdgcn_s_sleep(1); \
    if ((++_sp & 255u) == 0u) { if (xb_ld(&(bar)[XB_TMO])) break; if (_sp > XB_SPIN_CAP) { atomicAdd(&(bar)[XB_TMO], 1u); break; } } } } while (0)
struct XcdBarrier { unsigned* bar; unsigned x; volatile LAS unsigned* st; };
__device__ __forceinline__ XcdBarrier xcd_barrier_post(unsigned* bar, volatile LAS unsigned* st) {
    XcdBarrier b; b.bar = bar; b.x = xb_xcc_id(); b.st = st;
    if (threadIdx.x == 0) (void)xb_add(&bar[XB_XCNT(b.x)], 1u);
    return b;
}
__device__ __forceinline__ void xcd_barrier_complete(unsigned* bar, unsigned x, unsigned& nloc, unsigned& nx) {
    const unsigned G = gridDim.x * gridDim.y * gridDim.z;
    unsigned sum, cnt, mine, sp = 0u;
    for (;;) {
        sum = 0u; cnt = 0u; mine = 0u;
#pragma unroll
        for (unsigned j = 0; j < 16; ++j) { const unsigned c = xb_ld(&bar[XB_XCNT(j)]); sum += c; cnt += (c > 0u) ? 1u : 0u; mine = (j == x) ? c : mine; }
        if (sum == G) break;
        __builtin_amdgcn_s_sleep(1);
        if ((++sp & 255u) == 0u) { if (xb_ld(&bar[XB_TMO])) break; if (sp > XB_SPIN_CAP) { atomicAdd(&bar[XB_TMO], 1u); break; } }
    }
    nloc = mine > 0u ? mine : 1u; nx = cnt > 0u ? cnt : 1u;
}
__device__ __forceinline__ void xcd_barrier(const XcdBarrier& b) {
    asm volatile("s_waitcnt vmcnt(0)" ::: "memory");
    __syncthreads();
    if (threadIdx.x == 0) {
        unsigned* bar = b.bar;
        __builtin_amdgcn_s_waitcnt(0);
        unsigned nloc = b.st[0], nx = b.st[1];
        if (nloc == 0u) { xcd_barrier_complete(bar, b.x, nloc, nx); b.st[0] = nloc; b.st[1] = nx; }
        const unsigned old = xb_add(&bar[XB_XSUB(b.x)], 1u);
        const unsigned gen = old / nloc;
        if (old + 1u == (gen + 1u) * nloc) {
            __builtin_amdgcn_fence(__ATOMIC_RELEASE, "agent");
            asm volatile("s_waitcnt vmcnt(0)" ::: "memory");
            const unsigned og = xb_add(&bar[XB_TOP], 1u);
            const unsigned tg = og / nx;
            if (og + 1u == (tg + 1u) * nx) xb_add(&bar[XB_TOPGEN], 1u);
            else XB_SPIN(xb_ld(&bar[XB_TOPGEN]) == tg, bar);
            __builtin_amdgcn_fence(__ATOMIC_ACQUIRE, "agent");
            xb_add(&bar[XB_XGEN(b.x)], 1u);
            asm volatile("s_waitcnt vmcnt(0)" ::: "memory");
        } else {
            XB_SPIN(xb_ld(&bar[XB_XGEN(b.x)]) == gen, bar);
            __builtin_amdgcn_fence(__ATOMIC_ACQUIRE, "agent");
            asm volatile("s_waitcnt vmcnt(0)" ::: "memory");
        }
    }
    __syncthreads();
}

struct MapId { static __device__ __forceinline__ int src(int j) { return j; } };
struct MapWin {
    static __device__ __forceinline__ int src(int j) {
        if (j < 1024) { const int g8 = j >> 3, i = j & 7; return ((i < 4) ? 0 : 1024) + 4 * g8 + (i & 3); }
        if (j < 1536) return 512 + (j - 1024);
        if (j < 2560) { const int jj = j - 1536, qk = jj >> 9, p = jj & 511, head = p >> 6, pl = p & 63, g = pl >> 3, i = pl & 7; return 1536 + qk * 512 + head * 64 + 4 * g + (i & 3) + 32 * (i >> 2); }
        return j;
    }
};
template <class MAP>
__device__ __forceinline__ void p0_transpose_item(const float* W, int K, int N, int NOUT, bf16* WT, LAS float* scr, int item, int lane, const float* gain = nullptr) {
    const int nblk = NOUT / 32, kb = item / nblk, nb = item % nblk, k0 = 64 * kb, n0 = 32 * nb;
    const int sc = MAP::src(n0 + (lane & 31));
    float wv[32];
#pragma unroll
    for (int i = 0; i < 32; ++i) wv[i] = W[(size_t)(k0 + 2 * i + (lane >> 5)) * N + sc];
#pragma unroll
    for (int i = 0; i < 32; ++i) { const int kk = 2 * i + (lane >> 5); const float gk = gain ? gain[k0 + kk] : 1.f; scr[kk * 33 + (lane & 31)] = wv[i] * gk; }
    LDS_WAIT(); asm volatile("" ::: "memory");
    const int c = lane & 7;
#pragma unroll
    for (int j = 0; j < 4; ++j) { const int n = (lane >> 3) + 8 * j; const LAS float* s = scr + (8 * c) * 33 + n;
        v4u o; o.x = pk2(s[0 * 33], s[1 * 33]); o.y = pk2(s[2 * 33], s[3 * 33]); o.z = pk2(s[4 * 33], s[5 * 33]); o.w = pk2(s[6 * 33], s[7 * 33]);
        *(GAS v4u*)(WT + (size_t)(n0 + n) * K + k0 + 8 * c) = o; }
    LDS_WAIT(); asm volatile("" ::: "memory");
}
__device__ __forceinline__ void rms_row_to_bf16(const float* xrow, const float* g, bf16* orow, int lane) {
    const GAS f32x4* xr = (const GAS f32x4*)xrow + lane; const GAS f32x4* gr = (const GAS f32x4*)g + lane;
    f32x4 v[4]; float s = 0.f;
#pragma unroll
    for (int j = 0; j < 4; ++j) { v[j] = xr[64 * j]; s += (v[j].x * v[j].x + v[j].y * v[j].y) + (v[j].z * v[j].z + v[j].w * v[j].w); }
    const float r = rsqrtf(wave_sum(s) * (1.f / 1024.f) + RMS_EPS);
    GAS v2u* o8 = (GAS v2u*)orow + lane;
#pragma unroll
    for (int j = 0; j < 4; ++j) { const f32x4 gg = gr[64 * j]; v2u w; w.x = pk2(v[j].x * r * gg.x, v[j].y * r * gg.y); w.y = pk2(v[j].z * r * gg.z, v[j].w * r * gg.w); o8[64 * j] = w; }
}
template <int NR>
__device__ __forceinline__ void rms_rows_to_bf16(const float* x, const float* g, bf16* o, int m0, int stride, int lane) {
    f32x4 v[NR][4];
#pragma unroll
    for (int i = 0; i < NR; ++i) { const GAS f32x4* xr = (const GAS f32x4*)(x + (size_t)(m0 + i * stride) * 1024) + lane;
#pragma unroll
        for (int j = 0; j < 4; ++j) v[i][j] = xr[64 * j]; }
    f32x4 gg[4];
#pragma unroll
    for (int j = 0; j < 4; ++j) gg[j] = ((const GAS f32x4*)g + lane)[64 * j];
#pragma unroll
    for (int i = 0; i < NR; ++i) { float s = 0.f;
#pragma unroll
        for (int j = 0; j < 4; ++j) s += (v[i][j].x * v[i][j].x + v[i][j].y * v[i][j].y) + (v[i][j].z * v[i][j].z + v[i][j].w * v[i][j].w);
        const float r = rsqrtf(wave_sum(s) * (1.f / 1024.f) + RMS_EPS);
        GAS v2u* o8 = (GAS v2u*)(o + (size_t)(m0 + i * stride) * 1024) + lane;
#pragma unroll
        for (int j = 0; j < 4; ++j) { v2u w; w.x = pk2(v[i][j].x * r * gg[j].x, v[i][j].y * r * gg[j].y); w.y = pk2(v[i][j].z * r * gg[j].z, v[i][j].w * r * gg[j].w); o8[64 * j] = w; } }
}
__device__ __forceinline__ float fmax_asm(float a, float b) { float r; asm("v_max_f32 %0, %1, %2" : "=v"(r) : "v"(a), "v"(b)); return r; }
__device__ __forceinline__ float fmin_asm(float a, float b) { float r; asm("v_min_f32 %0, %1, %2" : "=v"(r) : "v"(a), "v"(b)); return r; }

#ifndef PH_MASK
#define PH_MASK 0xFFFFFFFFu
#endif
#define PH(k) ((PH_MASK >> (k)) & 1u)
#ifndef REP_MASK
#define REP_MASK 0u
#endif
#define NREP(k) (((REP_MASK >> (k)) & 1u) ? 2 : 1)
#ifndef DIAG_TS_A
#define DIAG_TS_A -1
#endif
#ifndef DIAG_TS_B
#define DIAG_TS_B -1
#endif
struct Args { const float* in[19]; float* out; unsigned char* ws; };

struct XOrder {
    const char* A; const char* Bt; int G, c, i0, mode;
    __device__ bool next(int i, pg8::Unit& u) const {
        if (i > 0) return false;
        const int L = i0 * G + c; if (L >= 512) return false;
        const int b = L >> 5, head = (L >> 3) & 3, rt = L & 7;
        u.pm = b * 8 + rt; u.pn = head;
        if (mode == 0) { u.a = A + (size_t)(b * 2048 + rt * 256) * 1024 * 2; u.b = Bt + (size_t)(head * 256) * 1024 * 2; }
        else { u.a = A + ((size_t)(b * 2048 + rt * 256) * 1024 + head * 256) * 2;
               u.b = (mode == 2) ? Bt + ((size_t)(head * 256) * 4096 + b * 256) * 2 : Bt + ((size_t)(b * 256) * 1024 + head * 256) * 2; }
        return true;
    }
};

__global__ void __launch_bounds__(NWAVES * 64, 2) mk_fwd(Args args) {
    extern __shared__ __attribute__((aligned(16))) unsigned char lds[];
    LAS unsigned char* L = (LAS unsigned char*)lds;
    volatile LAS unsigned* MISC = (volatile LAS unsigned*)(L + MISC_OFF);
    const int wave = __builtin_amdgcn_readfirstlane((int)threadIdx.x >> 6);
#define PH_LANES int tid = threadIdx.x; asm volatile("" : "+v"(tid)); const int lane = tid & 63; const int gt = vcu * (NWAVES * 64) + tid; (void)lane; (void)gt
    const int G = gridDim.x; const int bx = blockIdx.x; const int vcu = (G % 8 == 0) ? (bx % 8) * (G / 8) + bx / 8 : bx;
    unsigned char* ws = args.ws;
    gu32* ctl = (gu32*)(ws + WS_CTL);
    for (int u = threadIdx.x; u < (LDS_BYTES - LDSCTL_OFF) / 4; u += NWAVES * 64) ((LAS unsigned*)(L + LDSCTL_OFF))[u] = 0u;
    __syncthreads();
    XcdBarrier bar = xcd_barrier_post((unsigned*)(ctl + CW_BAR), MISC + 8);
    unsigned long long* tsw = (unsigned long long*)(ws + WS_CTL + 65536);
    int n_ts = 0;
#define TSTAMP() do { if (DIAG_TS_A >= 0) { if (bx == 0 && threadIdx.x == 0) tsw[n_ts] = __builtin_amdgcn_s_memrealtime(); ++n_ts; } } while (0)
    TSTAMP();

    const float *x = args.in[0], *mem = args.in[1], *g_mix = args.in[2], *w_in = args.in[3], *w_conv = args.in[4], *w_conv_out = args.in[5], *w_attn_out = args.in[6], *w_merge = args.in[7],
                *g_xattn = args.in[8], *g_mem = args.in[9], *w_xq = args.in[10], *w_xkv = args.in[11], *w_xo = args.in[12], *g_ffn = args.in[13], *w_pq = args.in[14], *sub_keys = args.in[15],
                *peer_u = args.in[16], *peer_v = args.in[17], *g_final = args.in[18];
    float* out = args.out;
    bf16 *WinT = (bf16*)(ws + WS_WIN), *WcT = (bf16*)(ws + WS_WC), *WaT = (bf16*)(ws + WS_WA), *WmT = (bf16*)(ws + WS_WM), *WxqT = (bf16*)(ws + WS_WXQ), *WxkvT = (bf16*)(ws + WS_WXKV),
         *WxoT = (bf16*)(ws + WS_WXO), *MT = (bf16*)(ws + WS_MT);
    float* ropec = (float*)(ws + WS_ROPE); float* ropes = ropec + 2048 * 32;
    float* kbar = (float*)(ws + WS_KBAR);
    bf16 *MEMN = (bf16*)(ws + WS_MEMN), *KX = (bf16*)(ws + WS_KX), *VXT = (bf16*)(ws + WS_VXT), *A = (bf16*)(ws + WS_A);
    bf16 *YC = (bf16*)(ws + WS_YC), *QO = (bf16*)(ws + WS_QO), *U = (bf16*)(ws + WS_U), *KB = (bf16*)(ws + WS_K), *VB = (bf16*)(ws + WS_V), *SGC = (bf16*)(ws + WS_SGC), *SGA = (bf16*)(ws + WS_SGA);
    bf16 *QX = (bf16*)(ws + WS_QX), *PM = (bf16*)(ws + WS_PM), *OX = (bf16*)(ws + WS_OX);
    _Float16* SC = (_Float16*)(ws + WS_SC);
    int* EIDX = (int*)(ws + WS_EIDX); float* GW = (float*)(ws + WS_GW); unsigned* PW = (unsigned*)(ws + WS_PW);
    float* PO = (float*)(ws + WS_PO); float* SSQ1 = (float*)(ws + WS_SSQ1); float* SSQ2 = (float*)(ws + WS_SSQ2); (void)PO;
    unsigned char* U8 = ws + WS_U8; unsigned char* V8T = ws + WS_V8T; float* SU = (float*)(ws + WS_SU); float* SV = (float*)(ws + WS_SV);
    const int gw = vcu * NWAVES + wave, NGW = G * NWAVES;
    const int NGT = G * NWAVES * 64;

    asm volatile("; ===== PHASE 0 =====");
    if (PH(0)) for (int rep = 0; rep < NREP(0); ++rep) {
        PH_LANES; const bool dummy = rep < NREP(0) - 1; (void)dummy;
        LAS float* scr = (LAS float*)(L + RING_OFF + wave * 16384);
        constexpr int I_IN = (1024 / 64) * (5120 / 32), I_C = (512 / 64) * (1024 / 32), I_M = (1024 / 64) * (1024 / 32), I_KV = (1024 / 64) * (2048 / 32);
        constexpr int NITEMS = I_IN + 2 * I_C + 3 * I_M + I_KV;
        for (int it = gw; it < NITEMS; it += NGW) {
            int r = it;
            if (r < I_IN) { p0_transpose_item<MapWin>(w_in, 1024, 5120, 5120, WinT, scr, r, lane); continue; } r -= I_IN;
            if (r < I_C) { p0_transpose_item<MapId>(w_conv_out, 512, 1024, 1024, WcT, scr, r, lane); continue; } r -= I_C;
            if (r < I_C) { p0_transpose_item<MapId>(w_attn_out, 512, 1024, 1024, WaT, scr, r, lane); continue; } r -= I_C;
            if (r < I_M) { p0_transpose_item<MapId>(w_merge, 1024, 1024, 1024, WmT, scr, r, lane); continue; } r -= I_M;
            if (r < I_M) { p0_transpose_item<MapId>(w_xq, 1024, 1024, 1024, WxqT, scr, r, lane, g_xattn); continue; } r -= I_M;
            if (r < I_M) { p0_transpose_item<MapId>(w_xo, 1024, 1024, 1024, WxoT, scr, r, lane); continue; } r -= I_M;
            p0_transpose_item<MapId>(w_xkv, 1024, 2048, 2048, WxkvT, scr, r, lane);
        }
        { int m = gw; for (; m + 3 * NGW < T; m += 4 * NGW) rms_rows_to_bf16<4>(x, g_mix, A, m, NGW, lane); for (; m < T; m += NGW) rms_row_to_bf16(x + (size_t)m * D, g_mix, A + (size_t)m * D, lane); }
        { int m = gw; for (; m + NGW < MEMROWS; m += 2 * NGW) rms_rows_to_bf16<2>(mem, g_mem, MEMN, m, NGW, lane); for (; m < MEMROWS; m += NGW) rms_row_to_bf16(mem + (size_t)m * D, g_mem, MEMN + (size_t)m * D, lane); }
        for (int i = gt; i < 2048 * 32; i += NGT) { const int pos = i >> 5, f = i & 31; const float inv = powf(10000.0f, -(float)f / 32.0f); const float ang = (float)pos * inv; ropec[i] = cosf(ang); ropes[i] = sinf(ang); }
        __syncthreads();
        {
            LAS float* skl = (LAS float*)(L + RING_OFF);
            LAS float* wtl = skl + 128 * 129;
            for (int it = bx; it < 256; it += G) {
                const int hp = it >> 4, cb = it & 15;
                for (int i = tid; i < 128 * 128; i += NWAVES * 64) { const int n = i >> 7, d = i & 127; skl[n * 129 + d] = sub_keys[((size_t)hp * 128 + n) * 128 + d]; }
                for (int i = tid; i < 64 * 128; i += NWAVES * 64) { const int c = i >> 7, d = i & 127; wtl[c * 129 + d] = w_pq[(size_t)(cb * 64 + c) * 2048 + hp * 128 + d] * g_ffn[cb * 64 + c]; }
                __syncthreads();
                const int cg = tid & 15, ng = tid >> 4;
                float acc[4][4];
#pragma unroll
                for (int i = 0; i < 4; ++i)
#pragma unroll
                    for (int j = 0; j < 4; ++j) acc[i][j] = 0.f;
                for (int d = 0; d < 128; ++d) {
                    float wv[4], sv[4];
#pragma unroll
                    for (int i = 0; i < 4; ++i) { wv[i] = wtl[(4 * cg + i) * 129 + d]; sv[i] = skl[(4 * ng + i) * 129 + d]; }
#pragma unroll
                    for (int i = 0; i < 4; ++i)
#pragma unroll
                        for (int j = 0; j < 4; ++j) acc[i][j] += sv[i] * wv[j];
                }
#pragma unroll
                for (int i = 0; i < 4; ++i) { v2u w; w.x = pk2(acc[i][0], acc[i][1]); w.y = pk2(acc[i][2], acc[i][3]); *(GAS v2u*)(MT + (size_t)(hp * 128 + 4 * ng + i) * 1024 + cb * 64 + 4 * cg) = w; }
                __syncthreads();
            }
        }
    }
    xcd_barrier(bar); TSTAMP();

    asm volatile("; ===== PHASE 1 =====");
    if (PH(1)) for (int rep = 0; rep < NREP(1); ++rep) {
        PH_LANES; const bool dummy = rep < NREP(1) - 1; (void)dummy;
        pg8::Gemm g{1024, 1024, 1024}; pg8::StaticOrder S; S.init(A, 1024, WinT, 1024, T, INW, G, bx);
        pg8::EpiIn E{U, YC, QO, KB, VB, SGC, SGA, ropec, ropes, kbar, 0.125f * 1.4426950408889634f};
        pg8::gemm_phase<pg8::EpiIn, pg8::StaticOrder, true>(L + RING_OFF, g, S, E);
    }
    if (PH(1)) for (int rep = 0; rep < NREP(1); ++rep) {
        PH_LANES; const bool dummy = rep < NREP(1) - 1; (void)dummy;
        pg8::Gemm g{1024, 1024, 1024}; pg8::StaticOrder S; S.init(MEMN, 1024, WxkvT, 1024, MEMROWS, 1024, G, bx);
        pg8::EpiBf16 E{KX, 1024};
        pg8::gemm_phase<pg8::EpiBf16, pg8::StaticOrder, true>(L + RING_OFF, g, S, E);
    }
    if (PH(1)) for (int rep = 0; rep < NREP(1); ++rep) {
        PH_LANES; const bool dummy = rep < NREP(1) - 1; (void)dummy;
        pg8::Gemm g{1024, 1024, 1024}; pg8::StaticOrder S; S.init(WxkvT + (size_t)1024 * 1024, 1024, MEMN, 1024, 1024, MEMROWS, G, (bx + 128) % G);
        pg8::EpiBf16 E{VXT, 4096};
        pg8::gemm_phase<pg8::EpiBf16, pg8::StaticOrder, true>(L + RING_OFF, g, S, E);
    }
    if (PH(1)) for (int rep = 0; rep < NREP(1); ++rep) {
        PH_LANES; const bool dummy = rep < NREP(1) - 1; (void)dummy;
        int cb, ncb;
        if (G == 256) { const bool idle = (bx >= 64 && bx < 128) || bx >= 192; cb = idle ? ((bx < 128) ? bx - 64 : bx - 128) : 256; ncb = 128; } else { cb = bx; ncb = G; }
        const int cw = cb * NWAVES + wave, ncw = ncb * NWAVES;
        for (int e = (cb < ncb ? cw : 16384); e < 16384; e += ncw) {
            const GAS f32x4* r = (const GAS f32x4*)(peer_u + (size_t)e * D) + lane; f32x4 v[4]; float am = 0.f;
#pragma unroll
            for (int j = 0; j < 4; ++j) { v[j] = r[64 * j] * ((const GAS f32x4*)g_ffn + lane)[64 * j]; am = fmaxf(fmaxf(am, fmaxf(fabsf(v[j].x), fabsf(v[j].y))), fmaxf(fabsf(v[j].z), fabsf(v[j].w))); }
            am = wave_max(am);
            const float sc = am > 0.f ? 127.f / am : 1.f; if (lane == 0) SU[e] = am > 0.f ? am * (1.f / 127.f) : 1.f;
#pragma unroll
            for (int j = 0; j < 4; ++j) { const unsigned w = ((unsigned)(int)rintf(v[j].x * sc) & 255u) | (((unsigned)(int)rintf(v[j].y * sc) & 255u) << 8) | (((unsigned)(int)rintf(v[j].z * sc) & 255u) << 16) | (((unsigned)(int)rintf(v[j].w * sc) & 255u) << 24);
                *(GAS unsigned*)(U8 + (size_t)e * 1024 + 4 * lane + 256 * j) = w; }
        }
        __syncthreads();
        for (int it = cb; it < 256; it += ncb) {
            const int e0 = it * 64;
#pragma unroll 1
            for (int rr = 0; rr < 8; ++rr) {
                const int el = wave * 8 + rr, e = e0 + el;
                const GAS f32x4* r = (const GAS f32x4*)(peer_v + (size_t)e * D) + lane; f32x4 v[4]; float am = 0.f;
#pragma unroll
                for (int j = 0; j < 4; ++j) { v[j] = r[64 * j]; am = fmaxf(fmaxf(am, fmaxf(fabsf(v[j].x), fabsf(v[j].y))), fmaxf(fabsf(v[j].z), fabsf(v[j].w))); }
                am = wave_max(am);
                const float sc = am > 0.f ? 384.f / am : 1.f; if (lane == 0) SV[e] = am > 0.f ? am * (1.f / 384.f) : 1.f;
#pragma unroll
                for (int j = 0; j < 4; ++j) { int w = __builtin_amdgcn_cvt_pk_fp8_f32(v[j].x * sc, v[j].y * sc, 0, false); w = __builtin_amdgcn_cvt_pk_fp8_f32(v[j].z * sc, v[j].w * sc, w, true);
                    *(LAS unsigned*)(L + RING_OFF + el * 1024 + 4 * lane + 256 * j) = (unsigned)w; }
            }
            __syncthreads();
#pragma unroll
            for (int i = 0; i < 8; ++i) { const int idx = tid + 512 * i, sl = idx >> 5, k = idx & 31;
                const v2u a0 = *(const LAS v2u*)(L + RING_OFF + (2 * k) * 1024 + sl * 8), a1 = *(const LAS v2u*)(L + RING_OFF + (2 * k + 1) * 1024 + sl * 8);
                *(GAS v4u*)(V8T + ((size_t)sl * 16384 + e0 + 2 * k) * 8) = (v4u){a0.x, a0.y, a1.x, a1.y}; }
            __syncthreads();
        }
    }
    xcd_barrier(bar); TSTAMP();

    asm volatile("; ===== PHASE 2 =====");
    if (PH(2)) for (int rep = 0; rep < NREP(2); ++rep) {
        PH_LANES; const bool dummy = rep < NREP(2) - 1; (void)dummy;
        for (int i = gt; i < T * 64; i += NGT) {
            const int row = i >> 6, cg = i & 63, s = row & 2047;
            const v4u u0 = *(const GAS v4u*)(U + (size_t)row * 512 + cg * 8);
            v4u u1 = (v4u){0u, 0u, 0u, 0u}, u2 = (v4u){0u, 0u, 0u, 0u};
            if (s >= 1) u1 = *(const GAS v4u*)(U + (size_t)(row - 1) * 512 + cg * 8);
            if (s >= 2) u2 = *(const GAS v4u*)(U + (size_t)(row - 2) * 512 + cg * 8);
            const v4u bq = *(const GAS v4u*)(YC + (size_t)row * 512 + cg * 8);
            const f32x4 w0a = *(const GAS f32x4*)(w_conv + cg * 8), w0b = *(const GAS f32x4*)(w_conv + cg * 8 + 4);
            const f32x4 w1a = *(const GAS f32x4*)(w_conv + 512 + cg * 8), w1b = *(const GAS f32x4*)(w_conv + 512 + cg * 8 + 4);
            const f32x4 w2a = *(const GAS f32x4*)(w_conv + 1024 + cg * 8), w2b = *(const GAS f32x4*)(w_conv + 1024 + cg * 8 + 4);
            v4u o;
#define CONV2(q, wa, ia, ib) pk2(bflo(bq.q) * (w0##wa[ia] * bflo(u2.q) + w1##wa[ia] * bflo(u1.q) + w2##wa[ia] * bflo(u0.q)), bfhi(bq.q) * (w0##wa[ib] * bfhi(u2.q) + w1##wa[ib] * bfhi(u1.q) + w2##wa[ib] * bfhi(u0.q)))
            o.x = CONV2(x, a, 0, 1); o.y = CONV2(y, a, 2, 3); o.z = CONV2(z, b, 0, 1); o.w = CONV2(w, b, 2, 3);
#undef CONV2
            { const bool conv_dummy = (NREP(2) == 2) && !dummy; *(GAS v4u*)(YC + (size_t)row * 512 + cg * 8) = conv_dummy ? bq : o; }
        }
        __syncthreads();
        const attn_body::AttnTensors AT{(const attn_body::bf16*)QO, (const attn_body::bf16*)KB, (const attn_body::bf16*)VB, (attn_body::bf16*)(dummy ? A : QO), kbar};
        const attn_body::StaticOrder S(G, bx);
        attn_body::attn_phase<attn_body::StaticOrder>((char*)lds + RING_OFF, AT, S);
    }
    xcd_barrier(bar); TSTAMP();

    asm volatile("; ===== PHASE 3 =====");
    if (PH(3)) for (int rep = 0; rep < NREP(3); ++rep) {
        PH_LANES; const bool dummy = rep < NREP(3) - 1; (void)dummy;
        pg8::Gemm g{512, 512, 512}; pg8::StaticOrder S; S.init(YC, 512, WcT, 512, T, 1024, G, bx);
        pg8::EpiGateMul E{SGC, dummy ? A : SGC, 1024};
        pg8::gemm_phase<pg8::EpiGateMul, pg8::StaticOrder, true>(L + RING_OFF, g, S, E);
    }
    if (PH(3)) for (int rep = 0; rep < NREP(3); ++rep) {
        PH_LANES; const bool dummy = rep < NREP(3) - 1; (void)dummy;
        pg8::Gemm g{512, 512, 512}; pg8::StaticOrder S; S.init(QO, 512, WaT, 512, T, 1024, G, bx);
        pg8::EpiGateFma E{SGC, SGA, dummy ? A : SGA, 1024};
        pg8::gemm_phase<pg8::EpiGateFma, pg8::StaticOrder, true>(L + RING_OFF, g, S, E);
    }
    xcd_barrier(bar); TSTAMP();

    asm volatile("; ===== PHASE 4 =====");
    if (PH(4)) for (int rep = 0; rep < NREP(4); ++rep) {
        PH_LANES; const bool dummy = rep < NREP(4) - 1; (void)dummy;
        pg8::Gemm g{1024, 1024, 1024}; pg8::StaticOrder S; S.init(SGA, 1024, WmT, 1024, T, 1024, G, bx);
        pg8::EpiResNorm<true> E{x, A, SSQ1, 1024, 1.f};
        pg8::gemm_phase<pg8::EpiResNorm<true>, pg8::StaticOrder, true>(L + RING_OFF, g, S, E);
    }
    xcd_barrier(bar); TSTAMP();

    asm volatile("; ===== PHASE 6 =====");
    if (PH(6)) for (int rep = 0; rep < NREP(6); ++rep) {
        PH_LANES; const bool dummy = rep < NREP(6) - 1; (void)dummy;
        const pg8::Gemm gq{1024, 1024, 1024}, gs{1024, 1024, 256}, gv{1024, 4096, 256};
        const pg8::EpiBf16RS Eq{QX, 1024, SSQ1}; const pg8::EpiSoftmax Es{PM, 1024, 0.0625f * 1.4426950408889634f}; const pg8::EpiBf16 Ev{OX, 1024};
        { XOrder S{(const char*)A, (const char*)WxqT, G, vcu, 0, 0}; pg8::gemm_phase<pg8::EpiBf16RS, XOrder, false>(L + RING_OFF, gq, S, Eq); }
        VM_WAIT(); __syncthreads();
        { XOrder S{(const char*)QX, (const char*)KX, G, vcu, 0, 1}; pg8::gemm_phase<pg8::EpiSoftmax, XOrder, false>(L + RING_OFF, gs, S, Es); }
        VM_WAIT(); __syncthreads();
        { XOrder S{(const char*)PM, (const char*)VXT, G, vcu, 0, 2}; pg8::gemm_phase<pg8::EpiBf16, XOrder, false>(L + RING_OFF, gv, S, Ev); }
        VM_WAIT(); __syncthreads();
        { XOrder S{(const char*)A, (const char*)WxqT, G, vcu, 1, 0}; pg8::gemm_phase<pg8::EpiBf16RS, XOrder, false>(L + RING_OFF, gq, S, Eq); }
        VM_WAIT(); __syncthreads();
        { XOrder S{(const char*)QX, (const char*)KX, G, vcu, 1, 1}; pg8::gemm_phase<pg8::EpiSoftmax, XOrder, false>(L + RING_OFF, gs, S, Es); }
        VM_WAIT(); __syncthreads();
        { XOrder S{(const char*)PM, (const char*)VXT, G, vcu, 1, 2}; pg8::gemm_phase<pg8::EpiBf16, XOrder, false>(L + RING_OFF, gv, S, Ev); }
    }
    xcd_barrier(bar); TSTAMP();

    asm volatile("; ===== PHASE 9 =====");
    if (PH(9)) for (int rep = 0; rep < NREP(9); ++rep) {
        PH_LANES; const bool dummy = rep < NREP(9) - 1; (void)dummy;
        pg8::Gemm g{1024, 1024, 1024}; pg8::StaticOrder S; S.init(OX, 1024, WxoT, 1024, T, 1024, G, bx);
        pg8::EpiResNorm<false> E{nullptr, A, SSQ2, 1024, dummy ? 0.f : 1.f};
        pg8::gemm_phase<pg8::EpiResNorm<false>, pg8::StaticOrder, true>(L + RING_OFF, g, S, E);
    }
    xcd_barrier(bar); TSTAMP();

    asm volatile("; ===== PHASE 11 =====");
    if (PH(11)) for (int rep = 0; rep < NREP(11); ++rep) {
        PH_LANES; const bool dummy = rep < NREP(11) - 1; (void)dummy;
        pg8::Gemm g{1024, 1024, 1024}; pg8::StaticOrder S; S.init(A, 1024, MT, 1024, T, 2048, G, bx);
        pg8::EpiF16RS E{SC, 2048, SSQ2};
        pg8::gemm_phase<pg8::EpiF16RS, pg8::StaticOrder, true>(L + RING_OFF, g, S, E);
    }
    xcd_barrier(bar); TSTAMP();

    asm volatile("; ===== PHASE 12 =====");
    if (PH(12)) for (int rep = 0; rep < NREP(12); ++rep) {
        PH_LANES; const bool dummy = rep < NREP(12) - 1; (void)dummy;
        typedef _Float16 h8 __attribute__((ext_vector_type(8)));
#define RCE(a, b) do { const float hi_ = fmax_asm(a, b); b = fmin_asm(a, b); a = hi_; } while (0)
#define RSORT16(K) do { RCE(K[0], K[1]); RCE(K[3], K[2]); RCE(K[4], K[5]); RCE(K[7], K[6]); RCE(K[8], K[9]); RCE(K[11], K[10]); RCE(K[12], K[13]); RCE(K[15], K[14]); RCE(K[0], K[2]); RCE(K[1], K[3]); RCE(K[6], K[4]); RCE(K[7], K[5]); RCE(K[8], K[10]); RCE(K[9], K[11]); RCE(K[14], K[12]); RCE(K[15], K[13]); RCE(K[0], K[1]); RCE(K[2], K[3]); RCE(K[5], K[4]); RCE(K[7], K[6]); RCE(K[8], K[9]); RCE(K[10], K[11]); RCE(K[13], K[12]); RCE(K[15], K[14]); RCE(K[0], K[4]); RCE(K[1], K[5]); RCE(K[2], K[6]); RCE(K[3], K[7]); RCE(K[12], K[8]); RCE(K[13], K[9]); RCE(K[14], K[10]); RCE(K[15], K[11]); RCE(K[0], K[2]); RCE(K[1], K[3]); RCE(K[4], K[6]); RCE(K[5], K[7]); RCE(K[10], K[8]); RCE(K[11], K[9]); RCE(K[14], K[12]); RCE(K[15], K[13]); RCE(K[0], K[1]); RCE(K[2], K[3]); RCE(K[4], K[5]); RCE(K[6], K[7]); RCE(K[9], K[8]); RCE(K[11], K[10]); RCE(K[13], K[12]); RCE(K[15], K[14]); RCE(K[0], K[8]); RCE(K[1], K[9]); RCE(K[2], K[10]); RCE(K[3], K[11]); RCE(K[4], K[12]); RCE(K[5], K[13]); RCE(K[6], K[14]); RCE(K[7], K[15]); RCE(K[0], K[4]); RCE(K[1], K[5]); RCE(K[2], K[6]); RCE(K[3], K[7]); RCE(K[8], K[12]); RCE(K[9], K[13]); RCE(K[10], K[14]); RCE(K[11], K[15]); RCE(K[0], K[2]); RCE(K[1], K[3]); RCE(K[4], K[6]); RCE(K[5], K[7]); RCE(K[8], K[10]); RCE(K[9], K[11]); RCE(K[12], K[14]); RCE(K[13], K[15]); RCE(K[0], K[1]); RCE(K[2], K[3]); RCE(K[4], K[5]); RCE(K[6], K[7]); RCE(K[8], K[9]); RCE(K[10], K[11]); RCE(K[12], K[13]); RCE(K[14], K[15]); } while (0)
#define RMERGE16(K) do { RCE(K[0], K[8]); RCE(K[1], K[9]); RCE(K[2], K[10]); RCE(K[3], K[11]); RCE(K[4], K[12]); RCE(K[5], K[13]); RCE(K[6], K[14]); RCE(K[7], K[15]); RCE(K[0], K[4]); RCE(K[1], K[5]); RCE(K[2], K[6]); RCE(K[3], K[7]); RCE(K[8], K[12]); RCE(K[9], K[13]); RCE(K[10], K[14]); RCE(K[11], K[15]); RCE(K[0], K[2]); RCE(K[1], K[3]); RCE(K[4], K[6]); RCE(K[5], K[7]); RCE(K[8], K[10]); RCE(K[9], K[11]); RCE(K[12], K[14]); RCE(K[13], K[15]); RCE(K[0], K[1]); RCE(K[2], K[3]); RCE(K[4], K[5]); RCE(K[6], K[7]); RCE(K[8], K[9]); RCE(K[10], K[11]); RCE(K[12], K[13]); RCE(K[14], K[15]); } while (0)
#define RKEYS(K, V0, V1, IDB) do { _Pragma("unroll") for (int e = 0; e < 8; ++e) { K[e] = __uint_as_float(__float_as_uint((float)V0[e]) | (unsigned)((IDB) + e)); K[8 + e] = __uint_as_float(__float_as_uint((float)V1[e]) | (unsigned)((IDB) + 8 + e)); } } while (0)
        LAS unsigned char* idl = L + RING_OFF + tid * 32;
        for (int task = gt; task < T * 8; task += NGT) {
            const int t = task >> 3, h = task & 7;
            const _Float16* row = SC + (size_t)t * 2048 + h * 256;
            float LA[16], LB[16];
#pragma unroll 1
            for (int p = 0; p < 2; ++p) {
                const _Float16* rp = row + p * 128;
                float Tk[16];
                h8 n0 = *(const h8*)(rp + 16), n1 = *(const h8*)(rp + 24);
                { const h8 v0 = *(const h8*)rp, v1 = *(const h8*)(rp + 8); RKEYS(Tk, v0, v1, 0); RSORT16(Tk); }
#pragma unroll 1
                for (int c = 1; c < 8; ++c) {
                    const h8 v0 = n0, v1 = n1;
                    { const int cn = c < 7 ? c + 1 : c; n0 = *(const h8*)(rp + cn * 16); n1 = *(const h8*)(rp + cn * 16 + 8); }
                    float K[16]; RKEYS(K, v0, v1, c * 16); RSORT16(K);
#pragma unroll
                    for (int i = 0; i < 16; ++i) Tk[i] = fmax_asm(Tk[i], K[15 - i]);
                    RMERGE16(Tk);
                }
#pragma unroll
                for (int k = 0; k < 16; ++k) { if (p == 0) LA[k] = Tk[k]; else LB[k] = Tk[k]; }
            }
#pragma unroll
            for (int k = 0; k < 16; k += 4) {
                ((LAS unsigned*)idl)[k >> 2] = (__float_as_uint(LA[k]) & 127u) | ((__float_as_uint(LA[k + 1]) & 127u) << 8) | ((__float_as_uint(LA[k + 2]) & 127u) << 16) | ((__float_as_uint(LA[k + 3]) & 127u) << 24);
                ((LAS unsigned*)idl)[4 + (k >> 2)] = (__float_as_uint(LB[k]) & 127u) | ((__float_as_uint(LB[k + 1]) & 127u) << 8) | ((__float_as_uint(LB[k + 2]) & 127u) << 16) | ((__float_as_uint(LB[k + 3]) & 127u) << 24);
            }
#define CKEY(a, b) __uint_as_float((__float_as_uint(LA[a] + LB[b]) & ~255u) | (unsigned)(255 - (16 * (a) + (b))))
            float Ck[16];
#pragma unroll
            for (int a = 0; a < 16; ++a) Ck[a] = CKEY(a, 0);
#define CRUN(b, n) do { _Pragma("unroll") for (int j = 0; j < (n); ++j) Ck[15 - j] = fmax_asm(Ck[15 - j], CKEY(j, b)); RMERGE16(Ck); } while (0)
            CRUN(1, 8); CRUN(2, 5); CRUN(3, 4); CRUN(4, 3); CRUN(5, 2); CRUN(6, 2); CRUN(7, 2);
#pragma unroll
            for (int j = 0; j < 8; ++j) Ck[15 - j] = fmax_asm(Ck[15 - j], CKEY(0, 8 + j));
            RMERGE16(Ck);
#undef CRUN
#undef CKEY
            LDS_WAIT();
            float ex[16]; float sum = 0.f;
#pragma unroll
            for (int k = 0; k < 16; ++k) { ex[k] = __expf(Ck[k] - Ck[0]); sum += ex[k]; }
            const float rs = 1.f / sum;
            int* eo = EIDX + (size_t)t * 128 + h * 16;
#pragma unroll
            for (int k = 0; k < 16; k += 4) {
                int ev[4];
#pragma unroll
                for (int j = 0; j < 4; ++j) { const unsigned id = 255u - (__float_as_uint(Ck[k + j]) & 255u); ev[j] = (int)idl[id >> 4] * 128 + (int)idl[16 + (id & 15u)]; }
                *(GAS v4u*)(eo + k) = (v4u){(pk2(0.f, ex[k] * rs) & 0xffff0000u) | (unsigned)ev[0], (pk2(0.f, ex[k + 1] * rs) & 0xffff0000u) | (unsigned)ev[1],
                                             (pk2(0.f, ex[k + 2] * rs) & 0xffff0000u) | (unsigned)ev[2], (pk2(0.f, ex[k + 3] * rs) & 0xffff0000u) | (unsigned)ev[3]};
            }
            LDS_WAIT();
        }
#undef RCE
#undef RSORT16
#undef RMERGE16
#undef RKEYS
    }
    xcd_barrier(bar); TSTAMP();

    asm volatile("; ===== PHASE 13 =====");
    if (PH(13)) for (int rep = 0; rep < NREP(13); ++rep) {
        PH_LANES; const bool dummy = rep < NREP(13) - 1; (void)dummy;
        volatile LAS unsigned* qslot = (volatile LAS unsigned*)(L + LDSCTL_OFF + 64);
        LAS unsigned char* tile = L + RING_OFF + wave * 8192;
        LAS float* rsl = (LAS float*)(L + UL_OFF + wave * UL_WAVE);
        LAS v4u* lst = (LAS v4u*)(L + UL_OFF + wave * UL_WAVE + 64);
        const int xs = (int)(xb_xcc_id() & 7u);
        __syncthreads();
        if (tid == 0) *qslot = __hip_atomic_fetch_add((unsigned*)(ctl + CW_Q + 64 * (rep * 8 + xs)), 1u, __ATOMIC_RELAXED, __HIP_MEMORY_SCOPE_AGENT);
        __syncthreads();
        const int rank = __builtin_amdgcn_readfirstlane((int)*qslot);
        int cnt[8];
#pragma unroll
        for (int j = 0; j < 8; ++j) cnt[j] = __builtin_amdgcn_readfirstlane((int)(xb_ld(bar.bar + XB_XCNT(j)) + xb_ld(bar.bar + XB_XCNT(j + 8))));
#pragma unroll 1
        for (int x = 0; x < 8; ++x) {
            int cn = 0;
#pragma unroll
            for (int j = 0; j < 8; ++j) cn = (j == x) ? cnt[j] : cn;
            int j0, jstep;
            if (x == xs) { j0 = rank * 8 + wave; jstep = cn * 8; } else if (cn == 0) { j0 = bx * 8 + wave; jstep = G * 8; } else continue;
#pragma unroll 1
            for (int job = j0; job < T / 8; job += jstep) {
                const int t0 = job * 8;
#pragma unroll 1
                for (int r0 = 0;; r0 += UL_CAP) {
                    v4u ar0[8], ar1[8]; unsigned pa[8], pb[8];
#pragma unroll
                    for (int tl = 0; tl < 8; ++tl) { const GAS v4u* ar = (const GAS v4u*)(A + (size_t)(t0 + tl) * D + 16 * lane); ar0[tl] = ar[0]; ar1[tl] = ar[1]; }
#pragma unroll
                    for (int tl = 0; tl < 8; ++tl) { pa[tl] = (unsigned)EIDX[(size_t)(t0 + tl) * 128 + lane]; pb[tl] = (unsigned)EIDX[(size_t)(t0 + tl) * 128 + 64 + lane]; }
                    float rs8[2];
                    { float s0 = SSQ2[(size_t)t0 * 16 + lane], s1 = SSQ2[(size_t)t0 * 16 + 64 + lane];
                      s0 += shx<1>(s0); s1 += shx<1>(s1); s0 += shx<2>(s0); s1 += shx<2>(s1); s0 += shx<4>(s0); s1 += shx<4>(s1); s0 += shx<8>(s0); s1 += shx<8>(s1);
                      rs8[0] = rsqrtf(s0 * (1.f / 1024.f) + RMS_EPS); rs8[1] = rsqrtf(s1 * (1.f / 1024.f) + RMS_EPS); }
#pragma unroll
                    for (int tl = 0; tl < 8; ++tl) {
                        float a[16];
                        a[0] = bflo(ar0[tl].x); a[1] = bfhi(ar0[tl].x); a[2] = bflo(ar0[tl].y); a[3] = bfhi(ar0[tl].y); a[4] = bflo(ar0[tl].z); a[5] = bfhi(ar0[tl].z); a[6] = bflo(ar0[tl].w); a[7] = bfhi(ar0[tl].w);
                        a[8] = bflo(ar1[tl].x); a[9] = bfhi(ar1[tl].x); a[10] = bflo(ar1[tl].y); a[11] = bfhi(ar1[tl].y); a[12] = bflo(ar1[tl].z); a[13] = bfhi(ar1[tl].z); a[14] = bflo(ar1[tl].w); a[15] = bfhi(ar1[tl].w);
                        float amx = 0.f;
#pragma unroll
                        for (int i = 0; i < 16; ++i) amx = fmaxf(amx, fabsf(a[i]));
                        amx = wave_max(amx);
                        const float asc = amx > 0.f ? 127.f / amx : 1.f;
                        v4u qv;
#define QP4(i) (((unsigned)(int)rintf(a[4 * (i)] * asc) & 255u) | (((unsigned)(int)rintf(a[4 * (i) + 1] * asc) & 255u) << 8) | (((unsigned)(int)rintf(a[4 * (i) + 2] * asc) & 255u) << 16) | (((unsigned)(int)rintf(a[4 * (i) + 3] * asc) & 255u) << 24))
                        qv.x = QP4(0); qv.y = QP4(1); qv.z = QP4(2); qv.w = QP4(3);
#undef QP4
                        *(LAS v4u*)(tile + tl * 1024 + lane * 16) = qv;
                        const float rsv = __uint_as_float((unsigned)__builtin_amdgcn_readlane((int)__float_as_uint(rs8[tl >> 2]), (tl & 3) * 16));
                        if (lane == 0) rsl[tl] = (amx > 0.f ? amx * (1.f / 127.f) : 1.f) * rsv;
                    }
                    int total = 0; unsigned long long m0s[8], m1s[8];
#pragma unroll
                    for (int tl = 0; tl < 8; ++tl) { m0s[tl] = __ballot((int)((pa[tl] & 0xffffu) >> 11) == x); m1s[tl] = __ballot((int)((pb[tl] & 0xffffu) >> 11) == x); total += __popcll(m0s[tl]) + __popcll(m1s[tl]); }
                    float sua[8], sva[8], sub[8], svb[8];
#pragma unroll
                    for (int tl = 0; tl < 8; ++tl) { sua[tl] = sva[tl] = sub[tl] = svb[tl] = 0.f;
                        if ((m0s[tl] >> lane) & 1ull) { sua[tl] = SU[pa[tl] & 0xffffu]; sva[tl] = SV[pa[tl] & 0xffffu]; }
                        if ((m1s[tl] >> lane) & 1ull) { sub[tl] = SU[pb[tl] & 0xffffu]; svb[tl] = SV[pb[tl] & 0xffffu]; } }
                    asm volatile("s_waitcnt vmcnt(0) lgkmcnt(0)" ::: "memory");
                    int base = -r0;
#pragma unroll
                    for (int tl = 0; tl < 8; ++tl) {
                        const int n0 = __popcll(m0s[tl]), n1 = __popcll(m1s[tl]); const float rs = rsl[tl];
                        const int k0 = base + (int)__builtin_amdgcn_mbcnt_hi((unsigned)(m0s[tl] >> 32), __builtin_amdgcn_mbcnt_lo((unsigned)m0s[tl], 0u));
                        const int k1 = base + n0 + (int)__builtin_amdgcn_mbcnt_hi((unsigned)(m1s[tl] >> 32), __builtin_amdgcn_mbcnt_lo((unsigned)m1s[tl], 0u));
                        if (((m0s[tl] >> lane) & 1ull) && k0 >= 0 && k0 < UL_CAP) lst[k0] = (v4u){pa[tl], (unsigned)((tl << 7) | lane), __float_as_uint(sua[tl] * rs), __float_as_uint(__uint_as_float(pa[tl] & 0xffff0000u) * sva[tl] * 256.f)};
                        if (((m1s[tl] >> lane) & 1ull) && k1 >= 0 && k1 < UL_CAP) lst[k1] = (v4u){pb[tl], (unsigned)((tl << 7) | 64 | lane), __float_as_uint(sub[tl] * rs), __float_as_uint(__uint_as_float(pb[tl] & 0xffff0000u) * svb[tl] * 256.f)};
                        base += n0 + n1;
                    }
                    const int count = (total - r0) < UL_CAP ? (total - r0) : UL_CAP;
                    asm volatile("s_waitcnt lgkmcnt(0)" ::: "memory");
#pragma unroll 1
                    for (int b16 = 0; b16 < count; b16 += 16) {
                        const int myi = b16 + (lane & 15); const v4u en = lst[myi < count ? myi : count - 1];
                        v4u q[16];
#pragma unroll
                        for (int k = 0; k < 16; ++k) { const int e_ = __builtin_amdgcn_readlane((int)en.x, k) & 0xffff; q[k] = *(const GAS v4u*)(U8 + (size_t)e_ * 1024 + 16 * lane); }
                        int d[16];
#pragma unroll
                        for (int k = 0; k < 16; ++k) { const int tl_ = __builtin_amdgcn_readlane((int)en.y, k) >> 7; const v4u qa = *(const LAS v4u*)(tile + tl_ * 1024 + lane * 16);
                            d[k] = __builtin_amdgcn_sdot4((int)q[k].w, (int)qa.w, __builtin_amdgcn_sdot4((int)q[k].z, (int)qa.z, __builtin_amdgcn_sdot4((int)q[k].y, (int)qa.y, __builtin_amdgcn_sdot4((int)q[k].x, (int)qa.x, 0, false), false), false), false); }
                        int r8[8], r4[4], r2[2];
#pragma unroll
                        for (int i = 0; i < 8; ++i) { auto sw = __builtin_amdgcn_permlane32_swap((unsigned)d[i], (unsigned)d[i + 8], false, false); r8[i] = (int)(sw[0] + sw[1]); }
#pragma unroll
                        for (int i = 0; i < 4; ++i) { auto sw = __builtin_amdgcn_permlane16_swap((unsigned)r8[i], (unsigned)r8[i + 4], false, false); r4[i] = (int)(sw[0] + sw[1]); }
                        const bool b3 = (lane >> 3) & 1, b2 = (lane >> 2) & 1;
#pragma unroll
                        for (int i = 0; i < 2; ++i) { const int keep = b3 ? r4[i + 2] : r4[i], send = b3 ? r4[i] : r4[i + 2]; r2[i] = keep + __builtin_amdgcn_ds_swizzle(send, (8 << 10) | 0x1f); }
                        int doti; { const int keep = b2 ? r2[1] : r2[0], send = b2 ? r2[0] : r2[1]; doti = keep + __builtin_amdgcn_ds_swizzle(send, (4 << 10) | 0x1f); }
                        doti += __builtin_amdgcn_ds_swizzle(doti, (2 << 10) | 0x1f); doti += __builtin_amdgcn_ds_swizzle(doti, (1 << 10) | 0x1f);
                        const int sl_ = (lane >> 2) * 4;
                        const unsigned ex = (unsigned)__builtin_amdgcn_ds_bpermute(sl_, (int)en.x), ey = (unsigned)__builtin_amdgcn_ds_bpermute(sl_, (int)en.y);
                        const float eus = __uint_as_float((unsigned)__builtin_amdgcn_ds_bpermute(sl_, (int)en.z)), evs = __uint_as_float((unsigned)__builtin_amdgcn_ds_bpermute(sl_, (int)en.w));
                        if ((lane & 3) == 0 && b16 + (lane >> 2) < count) {
                            const int e = (int)(ex & 0xffffu), slot = (int)(ey & 127u); const int t = t0 + (int)(ey >> 7);
                            const float act = (float)doti * eus; const float u3 = 0.7978845608028654f * (act + 0.044715f * act * act * act);
                            const float wv = act * __builtin_amdgcn_rcpf(1.f + __expf(-2.f * u3)) * evs;
                            PW[((size_t)((t >> 6) * 8 + (slot >> 4)) * 4 + ((slot >> 2) & 3)) * 256 + (t & 63) * 4 + (slot & 3)] = (pk2(0.f, wv) & 0xffff0000u) | (unsigned)e;
                        }
                    }
                    asm volatile("s_waitcnt lgkmcnt(0)" ::: "memory");
                    if (r0 + UL_CAP >= total) break;
                }
            }
        }
        __syncthreads();
    }
    xcd_barrier(bar); TSTAMP();

    asm volatile("; ===== PHASE 14 =====");
    if (PH(14)) for (int rep = 0; rep < NREP(14); ++rep) {
        PH_LANES; const bool dummy = rep < NREP(14) - 1; (void)dummy;
        for (int item = vcu; item < 256; item += G) {
            const int sl = item & 127, half = item >> 7;
            __syncthreads();
#pragma unroll
            for (int i = 0; i < 16; ++i) *(LAS v4u*)(L + RING_OFF + (i * 512 + tid) * 16) = *(const GAS v4u*)(V8T + (size_t)sl * 131072 + (size_t)(i * 512 + tid) * 16);
            __syncthreads();
            const GAS v4u* pwb = (const GAS v4u*)(PW + (size_t)(half * 256 + wave) * 8192) + lane;
            v4u buf[4][4];
#pragma unroll
            for (int c = 0; c < 4; ++c)
#pragma unroll
                for (int k = 0; k < 4; ++k) buf[c][k] = pwb[c * 256 + k * 64];
#pragma unroll 1
            for (int itk = 0; itk < 32; ++itk) {
                const int g64 = half * 256 + itk * 8 + wave;
                const int t = g64 * 64 + lane;
                h2v acc[4] = {(h2v){(_Float16)0, (_Float16)0}, (h2v){(_Float16)0, (_Float16)0}, (h2v){(_Float16)0, (_Float16)0}, (h2v){(_Float16)0, (_Float16)0}};
#pragma unroll
                for (int c = 0; c < 8; ++c) {
                    v4u cur[4];
#pragma unroll
                    for (int k = 0; k < 4; ++k) cur[k] = buf[c & 3][k];
                    { const int sn = itk * 8 + c + 4; const int gn = (sn >> 3) > 31 ? 31 : (sn >> 3), cc = sn & 7; const GAS v4u* src = pwb + (size_t)gn * 8 * 2048 + cc * 256;
#pragma unroll
                      for (int k = 0; k < 4; ++k) buf[c & 3][k] = src[k * 64]; }
                    v2u tb[16];
#pragma unroll
                    for (int k = 0; k < 4; ++k)
#pragma unroll
                        for (int i = 0; i < 4; ++i) { const unsigned p = cur[k][i]; tb[k * 4 + i] = *(const LAS v2u*)(L + RING_OFF + ((p & 0xffffu) << 3)); }
#pragma unroll
                    for (int k = 0; k < 4; ++k)
#pragma unroll
                        for (int i = 0; i < 4; ++i) { const unsigned p = cur[k][i]; const _Float16 wh = (_Float16)__uint_as_float(p & 0xffff0000u); const v2u q = tb[k * 4 + i];
                            const h2v ww = (h2v){wh, wh};
                            acc[0] += ww * __builtin_amdgcn_cvt_scalef32_pk_f16_fp8((int)q.x, 0.00390625f, false); acc[1] += ww * __builtin_amdgcn_cvt_scalef32_pk_f16_fp8((int)q.x, 0.00390625f, true);
                            acc[2] += ww * __builtin_amdgcn_cvt_scalef32_pk_f16_fp8((int)q.y, 0.00390625f, false); acc[3] += ww * __builtin_amdgcn_cvt_scalef32_pk_f16_fp8((int)q.y, 0.00390625f, true); }
                }
                GAS v4u* hr = (GAS v4u*)(A + (size_t)t * D + sl * 8);
                const v4u hq = *hr; const float mulv = dummy ? 0.f : 1.f;
                v4u ho; ho.x = pk2(bflo(hq.x) + (float)acc[0].x * mulv, bfhi(hq.x) + (float)acc[0].y * mulv); ho.y = pk2(bflo(hq.y) + (float)acc[1].x * mulv, bfhi(hq.y) + (float)acc[1].y * mulv);
                ho.z = pk2(bflo(hq.z) + (float)acc[2].x * mulv, bfhi(hq.z) + (float)acc[2].y * mulv); ho.w = pk2(bflo(hq.w) + (float)acc[3].x * mulv, bfhi(hq.w) + (float)acc[3].y * mulv);
                *hr = ho;
            }
        }
    }
    xcd_barrier(bar); TSTAMP();

#ifdef EXTRA_BARRIERS
    for (int eb = 0; eb < EXTRA_BARRIERS; ++eb) xcd_barrier(bar);
#endif
    asm volatile("; ===== PHASE 15 =====");
    if (PH(15)) for (int rep = 0; rep < NREP(15); ++rep) {
        PH_LANES; const bool dummy = rep < NREP(15) - 1; (void)dummy;
        for (int t = gw; t < T; t += NGW) {
            const GAS v4u* hr = (const GAS v4u*)(A + (size_t)t * D + 16 * lane); const v4u q0 = hr[0], q1 = hr[1];
            const GAS f32x4* gr = (const GAS f32x4*)(g_final + 16 * lane); GAS f32x4* orow = (GAS f32x4*)(out + (size_t)t * D + 16 * lane);
            f32x4 o[4] = {(f32x4){bflo(q0.x), bfhi(q0.x), bflo(q0.y), bfhi(q0.y)}, (f32x4){bflo(q0.z), bfhi(q0.z), bflo(q0.w), bfhi(q0.w)},
                          (f32x4){bflo(q1.x), bfhi(q1.x), bflo(q1.y), bfhi(q1.y)}, (f32x4){bflo(q1.z), bfhi(q1.z), bflo(q1.w), bfhi(q1.w)}};
            float ss = 0.f;
#pragma unroll
            for (int j = 0; j < 4; ++j) ss += (o[j].x * o[j].x + o[j].y * o[j].y) + (o[j].z * o[j].z + o[j].w * o[j].w);
            const float r = rsqrtf(wave_sum(ss) * (1.f / 1024.f) + RMS_EPS);
#pragma unroll
            for (int j = 0; j < 4; ++j) orow[j] = o[j] * r * gr[j];
        }
    }
}

extern "C" void kernel_launch(void* const* d_in, const int* in_sizes, int n_in, void* d_out, int out_size, void* d_ws, size_t ws_size, hipStream_t stream) {
    static int grid = 0;
    if (grid == 0) {
        if (n_in != 19 || out_size != T * D || ws_size < WS_END) { fprintf(stderr, "kernel_launch: unexpected problem (n_in %d, out %d, ws %zu < %zu); nothing launched\n", n_in, out_size, ws_size, (size_t)WS_END); grid = -1; return; }
        int dev = 0, cus = 0, per_cu = 0;
        if (hipGetDevice(&dev) != hipSuccess || hipDeviceGetAttribute(&cus, hipDeviceAttributeMultiprocessorCount, dev) != hipSuccess) { grid = -1; return; }
        if (hipFuncSetAttribute((const void*)mk_fwd, hipFuncAttributeMaxDynamicSharedMemorySize, LDS_BYTES) != hipSuccess) { fprintf(stderr, "kernel_launch: hipFuncSetAttribute failed\n"); grid = -1; return; }
        if (hipOccupancyMaxActiveBlocksPerMultiprocessor(&per_cu, (const void*)mk_fwd, NWAVES * 64, LDS_BYTES) != hipSuccess || per_cu < 1) { fprintf(stderr, "kernel_launch: occupancy query says %d blocks per CU\n", per_cu); }
        (void)hipGetLastError();
        grid = cus;
    }
    if (grid < 0) return;
    if (hipMemsetAsync((char*)d_ws + WS_CTL, 0, CTL_ZERO_BYTES, stream) != hipSuccess) return;
    Args a{};
    for (int i = 0; i < 19; ++i) a.in[i] = (const float*)d_in[i];
    a.out = (float*)d_out; a.ws = (unsigned char*)d_ws;
    hipLaunchKernelGGL(mk_fwd, dim3(grid), dim3(NWAVES * 64), LDS_BYTES, stream, a);
}
```

```cpp
#include <hip/hip_runtime.h>
#include <hip/hip_bf16.h>
#include <cstdio>
#include <cstdint>
#include <cmath>

#ifndef DIAG
#define DIAG 0
#endif


template <int O> __device__ __forceinline__ float shx(float v) { static_assert(O > 0 && O < 32, "shx"); return __uint_as_float((unsigned)__builtin_amdgcn_ds_swizzle((int)__float_as_uint(v), (O << 10) | 0x1f)); }
__device__ __forceinline__ float sum32(float v) { auto r = __builtin_amdgcn_permlane32_swap(__float_as_uint(v), __float_as_uint(v), false, false); return __uint_as_float(r[0]) + __uint_as_float(r[1]); }
__device__ __forceinline__ float max32(float v) { auto r = __builtin_amdgcn_permlane32_swap(__float_as_uint(v), __float_as_uint(v), false, false); return fmaxf(__uint_as_float(r[0]), __uint_as_float(r[1])); }
__device__ __forceinline__ float wave_max(float v) { v = fmaxf(v, shx<1>(v)); v = fmaxf(v, shx<2>(v)); v = fmaxf(v, shx<4>(v)); v = fmaxf(v, shx<8>(v)); v = fmaxf(v, shx<16>(v)); return max32(v); }
__device__ __forceinline__ float wave_sum(float v) { v += shx<1>(v); v += shx<2>(v); v += shx<4>(v); v += shx<8>(v); v += shx<16>(v); return sum32(v); }

namespace pg8 {
#define PG8_LAS __attribute__((address_space(3)))
typedef unsigned short bf16_t;
typedef short bf16x8 __attribute__((ext_vector_type(8)));
typedef float f32x4 __attribute__((ext_vector_type(4)));
typedef float f32x2 __attribute__((ext_vector_type(2)));
typedef unsigned u32x4 __attribute__((ext_vector_type(4)));
typedef unsigned u32x2 __attribute__((ext_vector_type(2)));
constexpr int BM = 256, BK = 64, HALF = 128, HTB = HALF * BK * 2  , STAGE_BYTES = 8 * HTB, NXCD = 8, WGM = 8;

__host__ __device__ __forceinline__ int lds_byte(int r, int c) { const int st = (r >> 4) * 2 + (c >> 5), rr = r & 15, cc = c & 31, ob = rr * 64 + cc * 2; return st * 1024 + (ob ^ (((ob >> 9) & 1) << 5)); }
__host__ __device__ __forceinline__ void stage_rc(int b, int& R, int& C) { const int st = b / 1024, sb = b % 1024, swz = sb ^ (((sb >> 9) & 1) << 5); R = (st >> 1) * 16 + swz / 64; C = (st & 1) * 32 + (swz % 64) / 2; }
__host__ __device__ __forceinline__ int perm32(int rho) { const int n = rho >> 4, i = rho & 15; return 8 * (i >> 2) + 4 * n + (i & 3); }

struct Unit { int pm, pn; const char* a; const char* b; };
struct Gemm { int lda, ldb, K; };

struct StaticOrder {
    int nM, nN, nwg, G, c; const char* A; const char* Bt; size_t astep, bstep;
    __device__ void init(const void* A_, int lda, const void* Bt_, int ldb, int M, int N, int G_, int c_) { nM = M / BM; nN = N / BM; nwg = nM * nN; G = G_; c = c_; A = (const char*)A_; Bt = (const char*)Bt_; astep = (size_t)BM * lda * 2; bstep = (size_t)BM * ldb * 2; }
    __device__ bool next(int i, Unit& u) const {
        const long L = (long)i * G + c; if (L >= nwg) return false;
        int wgid = (int)L; { const int q = nwg / NXCD, r = nwg % NXCD, xcd = wgid % NXCD, off = wgid / NXCD; wgid = (xcd < r ? xcd * (q + 1) : r * (q + 1) + (xcd - r) * q) + off; }
        const int nig = WGM * nN, gid = wgid / nig, fm = gid * WGM, gsz = (nM - fm) < WGM ? (nM - fm) : WGM;
        u.pm = fm + ((wgid % nig) % gsz); u.pn = (wgid % nig) / gsz; u.a = A + (size_t)u.pm * astep; u.b = Bt + (size_t)u.pn * bstep; return true;
    }
};

__device__ __forceinline__ unsigned cvt_pk_bf16(float lo, float hi) { typedef __bf16 bf2 __attribute__((ext_vector_type(2))); f32x2 v = {lo, hi}; bf2 b = __builtin_convertvector(v, bf2); return __builtin_bit_cast(unsigned, b); }
__device__ __forceinline__ float bf_lo(unsigned u) { return __uint_as_float(u << 16); }
__device__ __forceinline__ float bf_hi(unsigned u) { return __uint_as_float(u & 0xffff0000u); }

template <class Epi, class Sched, bool ALIGN_EPI>
__device__ __forceinline__ void gemm_phase(PG8_LAS unsigned char* lds, const Gemm g, const Sched& S, const Epi& E) {
    int tid = threadIdx.x; asm volatile("" : "+v"(tid));
    const int wid = __builtin_amdgcn_readfirstlane(tid >> 6), lane = tid & 63, wr = wid >> 2, wc = wid & 3, fr = lane & 15, fq = lane >> 4;
    const int K = g.K, nt = K / BK;
    unsigned voffA[2], voffB[2];
#pragma unroll
    for (int i = 0; i < 2; ++i) { int R, C; stage_rc(tid * 16 + i * 8192, R, C); const int Rb = Epi::PERM ? ((R & ~31) + perm32(R & 31)) : R;
        voffA[i] = (unsigned)(R * g.lda + C) * 2u; voffB[i] = (unsigned)(Rb * g.ldb + C) * 2u; }
    const size_t kstep = (size_t)(BK * 2);
    const size_t hstepA = (size_t)HALF * g.lda * 2, hstepB = (size_t)HALF * g.ldb * 2;
    const unsigned ldsw = (unsigned)wid * 1024u;
    const int aoff = lds_byte(wr * 64 + fr, fq * 8), boff = lds_byte(wc * 32 + fr, fq * 8);
#define PG8_SA(b, h) (((b) * 2 + (h)) * HTB)
#define PG8_SB(b, h) ((4 + (b) * 2 + (h)) * HTB)
#define PG8_STAGE(bufoff, gbase, voff) do { _Pragma("unroll") for (int _i = 0; _i < 2; ++_i) \
        __builtin_amdgcn_global_load_lds((const unsigned*)((const char*)(gbase) + (voff)[_i]), (PG8_LAS unsigned*)(lds + (bufoff) + ldsw + _i * 8192), 16, 0, 0); } while (0)
#define PG8_LDA(dst, b, h) do { _Pragma("unroll") for (int m = 0; m < 4; ++m) _Pragma("unroll") for (int k = 0; k < 2; ++k) dst[m][k] = *(const PG8_LAS bf16x8*)(lds + PG8_SA(b, h) + aoff + m * 2048 + k * 1024); } while (0)
#define PG8_LDB(dst, b, h) do { _Pragma("unroll") for (int n = 0; n < 2; ++n) _Pragma("unroll") for (int k = 0; k < 2; ++k) dst[n][k] = *(const PG8_LAS bf16x8*)(lds + PG8_SB(b, h) + boff + n * 2048 + k * 1024); } while (0)
#define PG8_MMA(ai, bj, At, Bt) do { __builtin_amdgcn_s_setprio(1); _Pragma("unroll") for (int m = 0; m < 4; ++m) _Pragma("unroll") for (int n = 0; n < 2; ++n) _Pragma("unroll") for (int k = 0; k < 2; ++k) \
        acc[ai][bj][m][n] = __builtin_amdgcn_mfma_f32_16x16x32_bf16(Bt[n][k], At[m][k], acc[ai][bj][m][n], 0, 0, 0); __builtin_amdgcn_s_setprio(0); } while (0)
#define PG8_WAIT_V(n) asm volatile("s_waitcnt vmcnt(" #n ")" ::: "memory")
#define PG8_WAIT_L(n) asm volatile("s_waitcnt lgkmcnt(" #n ")" ::: "memory")
#define PG8_BAR __builtin_amdgcn_s_barrier()
#define PG8_SCHED __builtin_amdgcn_sched_barrier(0)
    Unit cur, nxt; int ui = 0;
    if (!S.next(0, cur)) return;
    f32x4 acc[2][2][4][2];
#pragma unroll
    for (int a = 0; a < 2; ++a)
#pragma unroll
        for (int b = 0; b < 2; ++b)
#pragma unroll
            for (int m = 0; m < 4; ++m)
#pragma unroll
                for (int n = 0; n < 2; ++n) acc[a][b][m][n] = (f32x4){0.f, 0.f, 0.f, 0.f};
    bf16x8 At[4][2], B0[2][2], B1[2][2];
    const char* cA = cur.a; const char* cB = cur.b;
    PG8_STAGE(PG8_SB(0, 0), cB, voffB); PG8_STAGE(PG8_SB(0, 1), cB + hstepB, voffB); PG8_STAGE(PG8_SA(0, 0), cA, voffA); PG8_STAGE(PG8_SA(0, 1), cA + hstepA, voffA);
    if (wr == 1) PG8_BAR;
    PG8_WAIT_V(2); PG8_BAR;
    PG8_STAGE(PG8_SB(1, 0), cB + kstep, voffB); PG8_STAGE(PG8_SA(1, 0), cA + kstep, voffA); PG8_STAGE(PG8_SB(1, 1), cB + hstepB + kstep, voffB);
    PG8_WAIT_V(6); PG8_BAR;
    for (;;) {
        const bool has_next = S.next(ui + 1, nxt);
        const char* nA = has_next ? nxt.a : cA; const char* nB = has_next ? nxt.b : cB;
        for (int t = 0; t < nt; t += 2) {
            const bool last = (t == nt - 2);
            const char* a1 = cA + (size_t)(t + 1) * kstep;
            const char* a2 = last ? nA : cA + (size_t)(t + 2) * kstep; const char* b2 = last ? nB : cB + (size_t)(t + 2) * kstep;
            const char* a3 = a2 + kstep; const char* b3 = b2 + kstep;
            PG8_LDB(B0, 0, 0); PG8_LDB(B1, 0, 1); PG8_SCHED; PG8_LDA(At, 0, 0); PG8_STAGE(PG8_SA(1, 1), a1 + hstepA, voffA);
            PG8_WAIT_V(8); PG8_WAIT_L(0); PG8_BAR; PG8_MMA(0, 0, At, B0); PG8_MMA(0, 1, At, B1); PG8_BAR; PG8_SCHED;
            PG8_LDA(At, 0, 1); PG8_STAGE(PG8_SB(0, 0), b2, voffB); PG8_STAGE(PG8_SB(0, 1), b2 + hstepB, voffB); PG8_STAGE(PG8_SA(0, 0), a2, voffA);
            PG8_WAIT_V(8); PG8_WAIT_L(0); PG8_BAR; PG8_MMA(1, 0, At, B0); PG8_MMA(1, 1, At, B1); PG8_BAR; PG8_SCHED;
            PG8_LDB(B0, 1, 0); PG8_LDB(B1, 1, 1); PG8_SCHED; PG8_LDA(At, 1, 0); PG8_STAGE(PG8_SA(0, 1), a2 + hstepA, voffA);
            PG8_WAIT_V(8); PG8_WAIT_L(0); PG8_BAR; PG8_MMA(0, 0, At, B0); PG8_MMA(0, 1, At, B1); PG8_BAR; PG8_SCHED;
            PG8_LDA(At, 1, 1); PG8_STAGE(PG8_SB(1, 0), b3, voffB); PG8_STAGE(PG8_SB(1, 1), b3 + hstepB, voffB); PG8_STAGE(PG8_SA(1, 0), a3, voffA);
            PG8_WAIT_V(8); PG8_WAIT_L(0); PG8_BAR; PG8_MMA(1, 0, At, B0); PG8_MMA(1, 1, At, B1); PG8_BAR; PG8_SCHED;
        }
        if constexpr (ALIGN_EPI) { if (wr == 0) PG8_BAR; }
        if constexpr (!Epi::AFTER_DRAIN) { E(acc, cur, wr, wc, fr, fq); }
        if (!has_next) break;
#pragma unroll
        for (int a = 0; a < 2; ++a)
#pragma unroll
            for (int b = 0; b < 2; ++b)
#pragma unroll
                for (int m = 0; m < 4; ++m)
#pragma unroll
                    for (int n = 0; n < 2; ++n) acc[a][b][m][n] = (f32x4){0.f, 0.f, 0.f, 0.f};
        cur = nxt; cA = nA; cB = nB; ++ui;
        if constexpr (ALIGN_EPI) { if (wr == 1) PG8_BAR; }
    }
    PG8_WAIT_V(0);
    if constexpr (!ALIGN_EPI) { if (wr == 0) PG8_BAR; }
    PG8_BAR;
    if constexpr (Epi::AFTER_DRAIN) { E.fused(acc, cur, wr, wc, fr, fq, lds, wid, lane); }
#undef PG8_SA
#undef PG8_SB
#undef PG8_STAGE
#undef PG8_LDA
#undef PG8_LDB
#undef PG8_MMA
#undef PG8_WAIT_V
#undef PG8_WAIT_L
#undef PG8_BAR
#undef PG8_SCHED
}

typedef f32x4 AccT[2][2][4][2];

struct EpiBf16 {
    static constexpr bool PERM = true, AFTER_DRAIN = false;
    bf16_t* O; int ldc;
    __device__ __forceinline__ void operator()(const AccT& acc, const Unit& u, int wr, int wc, int fr, int fq) const {
        { int t_ = threadIdx.x; asm volatile("" : "+v"(t_)); fr = t_ & 15; fq = (t_ >> 4) & 3; }
        const int row0 = u.pm * BM + wr * 64 + fr, col0 = u.pn * BM + wc * 32 + 8 * fq;
#pragma unroll
        for (int ai = 0; ai < 2; ++ai)
#pragma unroll
            for (int m = 0; m < 4; ++m) { bf16_t* rowp = O + (size_t)(row0 + ai * HALF + m * 16) * ldc + col0;
#pragma unroll
                for (int bj = 0; bj < 2; ++bj) { const f32x4 v0 = acc[ai][bj][m][0], v1 = acc[ai][bj][m][1];
                    u32x4 w; w.x = cvt_pk_bf16(v0[0], v0[1]); w.y = cvt_pk_bf16(v0[2], v0[3]); w.z = cvt_pk_bf16(v1[0], v1[1]); w.w = cvt_pk_bf16(v1[2], v1[3]);
                    *(u32x4*)(rowp + bj * HALF) = w; } }
    }
};
struct EpiF16 {
    static constexpr bool PERM = true, AFTER_DRAIN = false;
    _Float16* O; int ldc;
    __device__ __forceinline__ void operator()(const AccT& acc, const Unit& u, int wr, int wc, int fr, int fq) const {
        { int t_ = threadIdx.x; asm volatile("" : "+v"(t_)); fr = t_ & 15; fq = (t_ >> 4) & 3; }
        typedef _Float16 h8 __attribute__((ext_vector_type(8)));
        const int row0 = u.pm * BM + wr * 64 + fr, col0 = u.pn * BM + wc * 32 + 8 * fq;
#pragma unroll
        for (int ai = 0; ai < 2; ++ai)
#pragma unroll
            for (int m = 0; m < 4; ++m) { _Float16* rowp = O + (size_t)(row0 + ai * HALF + m * 16) * ldc + col0;
#pragma unroll
                for (int bj = 0; bj < 2; ++bj) { const f32x4 v0 = acc[ai][bj][m][0], v1 = acc[ai][bj][m][1];
                    h8 w = {(_Float16)v0[0], (_Float16)v0[1], (_Float16)v0[2], (_Float16)v0[3], (_Float16)v1[0], (_Float16)v1[1], (_Float16)v1[2], (_Float16)v1[3]};
                    *(h8*)(rowp + bj * HALF) = w; } }
    }
};
struct EpiGateMul {
    static constexpr bool PERM = true, AFTER_DRAIN = false;
    const bf16_t* G; bf16_t* Dst; int ldc;
    __device__ __forceinline__ void operator()(const AccT& acc, const Unit& u, int wr, int wc, int fr, int fq) const {
        { int t_ = threadIdx.x; asm volatile("" : "+v"(t_)); fr = t_ & 15; fq = (t_ >> 4) & 3; }
        const int row0 = u.pm * BM + wr * 64 + fr, col0 = u.pn * BM + wc * 32 + 8 * fq;
#pragma unroll
        for (int ai = 0; ai < 2; ++ai)
#pragma unroll
            for (int m = 0; m < 4; ++m) { const size_t roff = (size_t)(row0 + ai * HALF + m * 16) * ldc + col0; const bf16_t* rowg = G + roff; bf16_t* rowp = Dst + roff;
#pragma unroll
                for (int bj = 0; bj < 2; ++bj) { const f32x4 v0 = acc[ai][bj][m][0], v1 = acc[ai][bj][m][1]; const u32x4 gq = *(const u32x4*)(rowg + bj * HALF);
                    u32x4 w; w.x = cvt_pk_bf16(v0[0] * bf_lo(gq.x), v0[1] * bf_hi(gq.x)); w.y = cvt_pk_bf16(v0[2] * bf_lo(gq.y), v0[3] * bf_hi(gq.y));
                    w.z = cvt_pk_bf16(v1[0] * bf_lo(gq.z), v1[1] * bf_hi(gq.z)); w.w = cvt_pk_bf16(v1[2] * bf_lo(gq.w), v1[3] * bf_hi(gq.w));
                    *(u32x4*)(rowp + bj * HALF) = w; } }
    }
};
struct EpiGateFma {
    static constexpr bool PERM = true, AFTER_DRAIN = false;
    const bf16_t* Tm; const bf16_t* G2; bf16_t* Dst; int ldc;
    __device__ __forceinline__ void operator()(const AccT& acc, const Unit& u, int wr, int wc, int fr, int fq) const {
        { int t_ = threadIdx.x; asm volatile("" : "+v"(t_)); fr = t_ & 15; fq = (t_ >> 4) & 3; }
        const int row0 = u.pm * BM + wr * 64 + fr, col0 = u.pn * BM + wc * 32 + 8 * fq;
#pragma unroll
        for (int ai = 0; ai < 2; ++ai)
#pragma unroll
            for (int m = 0; m < 4; ++m) { const size_t off = (size_t)(row0 + ai * HALF + m * 16) * ldc + col0;
#pragma unroll
                for (int bj = 0; bj < 2; ++bj) { const f32x4 v0 = acc[ai][bj][m][0], v1 = acc[ai][bj][m][1]; const u32x4 gq = *(const u32x4*)(G2 + off + bj * HALF); const u32x4 tq = *(const u32x4*)(Tm + off + bj * HALF);
                    u32x4 w; w.x = cvt_pk_bf16(bf_lo(tq.x) + v0[0] * bf_lo(gq.x), bf_hi(tq.x) + v0[1] * bf_hi(gq.x)); w.y = cvt_pk_bf16(bf_lo(tq.y) + v0[2] * bf_lo(gq.y), bf_hi(tq.y) + v0[3] * bf_hi(gq.y));
                    w.z = cvt_pk_bf16(bf_lo(tq.z) + v1[0] * bf_lo(gq.z), bf_hi(tq.z) + v1[1] * bf_hi(gq.z)); w.w = cvt_pk_bf16(bf_lo(tq.w) + v1[2] * bf_lo(gq.w), bf_hi(tq.w) + v1[3] * bf_hi(gq.w));
                    *(u32x4*)(Dst + off + bj * HALF) = w; } }
    }
};
struct EpiResF32 {
    static constexpr bool PERM = false, AFTER_DRAIN = false;
    const float* res; float* out; int ldc; float mul;
    __device__ __forceinline__ void operator()(const AccT& acc, const Unit& u, int wr, int wc, int fr, int fq) const {
        { int t_ = threadIdx.x; asm volatile("" : "+v"(t_)); fr = t_ & 15; fq = (t_ >> 4) & 3; }
        const int row0 = u.pm * BM + wr * 64 + fr, col0 = u.pn * BM + wc * 32 + 4 * fq;
#pragma unroll
        for (int ai = 0; ai < 2; ++ai)
#pragma unroll
            for (int m = 0; m < 4; ++m) { const size_t off = (size_t)(row0 + ai * HALF + m * 16) * ldc + col0;
#pragma unroll
                for (int bj = 0; bj < 2; ++bj)
#pragma unroll
                    for (int n = 0; n < 2; ++n) { const f32x4 r = *(const f32x4*)(res + off + bj * HALF + n * 16); *(f32x4*)(out + off + bj * HALF + n * 16) = r + acc[ai][bj][m][n] * mul; } }
    }
};

__device__ __forceinline__ float row_rs(const float* ssq, int row) {
    const f32x4* p = (const f32x4*)(ssq + (size_t)row * 16); const f32x4 a = p[0], b = p[1], c = p[2], d = p[3];
    const float s = ((a[0] + a[1]) + (a[2] + a[3])) + ((b[0] + b[1]) + (b[2] + b[3])) + ((c[0] + c[1]) + (c[2] + c[3])) + ((d[0] + d[1]) + (d[2] + d[3]));
    return rsqrtf(s * (1.f / 1024.f) + 1e-6f);
}
struct EpiBf16RS {
    static constexpr bool PERM = true, AFTER_DRAIN = false;
    bf16_t* O; int ldc; const float* ssq;
    __device__ __forceinline__ void operator()(const AccT& acc, const Unit& u, int wr, int wc, int fr, int fq) const {
        { int t_ = threadIdx.x; asm volatile("" : "+v"(t_)); fr = t_ & 15; fq = (t_ >> 4) & 3; }
        const int row0 = u.pm * BM + wr * 64 + fr, col0 = u.pn * BM + wc * 32 + 8 * fq;
#pragma unroll
        for (int ai = 0; ai < 2; ++ai)
#pragma unroll
            for (int m = 0; m < 4; ++m) { int ro = row0 + ai * HALF + m * 16; asm volatile("" : "+v"(ro)); const float rs = row_rs(ssq, ro); bf16_t* rowp = O + (size_t)ro * ldc + col0;
#pragma unroll
                for (int bj = 0; bj < 2; ++bj) { const f32x4 v0 = acc[ai][bj][m][0] * rs, v1 = acc[ai][bj][m][1] * rs;
                    u32x4 w; w.x = cvt_pk_bf16(v0[0], v0[1]); w.y = cvt_pk_bf16(v0[2], v0[3]); w.z = cvt_pk_bf16(v1[0], v1[1]); w.w = cvt_pk_bf16(v1[2], v1[3]);
                    *(u32x4*)(rowp + bj * HALF) = w; } }
    }
};
struct EpiF16RS {
    static constexpr bool PERM = true, AFTER_DRAIN = false;
    _Float16* O; int ldc; const float* ssq;
    __device__ __forceinline__ void operator()(const AccT& acc, const Unit& u, int wr, int wc, int fr, int fq) const {
        { int t_ = threadIdx.x; asm volatile("" : "+v"(t_)); fr = t_ & 15; fq = (t_ >> 4) & 3; }
        typedef _Float16 h8 __attribute__((ext_vector_type(8)));
        const int row0 = u.pm * BM + wr * 64 + fr, col0 = u.pn * BM + wc * 32 + 8 * fq;
#pragma unroll
        for (int ai = 0; ai < 2; ++ai)
#pragma unroll
            for (int m = 0; m < 4; ++m) { int ro = row0 + ai * HALF + m * 16; asm volatile("" : "+v"(ro)); const float rs = row_rs(ssq, ro); _Float16* rowp = O + (size_t)ro * ldc + col0;
#pragma unroll
                for (int bj = 0; bj < 2; ++bj) { const f32x4 v0 = acc[ai][bj][m][0] * rs, v1 = acc[ai][bj][m][1] * rs;
                    h8 w = {(_Float16)v0[0], (_Float16)v0[1], (_Float16)v0[2], (_Float16)v0[3], (_Float16)v1[0], (_Float16)v1[1], (_Float16)v1[2], (_Float16)v1[3]};
                    *(h8*)(rowp + bj * HALF) = w; } }
    }
};
template <bool RES_F32> struct EpiResNorm {
    static constexpr bool PERM = true, AFTER_DRAIN = false;
    const float* resf; bf16_t* H; float* ssq; int ldc; float mul;
    __device__ __forceinline__ void operator()(const AccT& acc, const Unit& u, int wr, int wc, int fr, int fq) const {
        { int t_ = threadIdx.x; asm volatile("" : "+v"(t_)); fr = t_ & 15; fq = (t_ >> 4) & 3; }
        const int row0 = u.pm * BM + wr * 64 + fr, col0 = u.pn * BM + wc * 32 + 8 * fq;
#pragma unroll
        for (int ai = 0; ai < 2; ++ai)
#pragma unroll
            for (int m = 0; m < 4; ++m) { int ro = row0 + ai * HALF + m * 16; asm volatile("" : "+v"(ro)); const size_t off = (size_t)ro * ldc + col0; float ss = 0.f;
#pragma unroll
                for (int bj = 0; bj < 2; ++bj) { f32x4 r0, r1;
                    if (RES_F32) { r0 = *(const f32x4*)(resf + off + bj * HALF); r1 = *(const f32x4*)(resf + off + bj * HALF + 4); }
                    else { const u32x4 q = *(const u32x4*)(H + off + bj * HALF); r0 = (f32x4){bf_lo(q.x), bf_hi(q.x), bf_lo(q.y), bf_hi(q.y)}; r1 = (f32x4){bf_lo(q.z), bf_hi(q.z), bf_lo(q.w), bf_hi(q.w)}; }
                    const f32x4 v0 = r0 + acc[ai][bj][m][0] * mul, v1 = r1 + acc[ai][bj][m][1] * mul;
                    ss += ((v0[0] * v0[0] + v0[1] * v0[1]) + (v0[2] * v0[2] + v0[3] * v0[3])) + ((v1[0] * v1[0] + v1[1] * v1[1]) + (v1[2] * v1[2] + v1[3] * v1[3]));
                    u32x4 w; w.x = cvt_pk_bf16(v0[0], v0[1]); w.y = cvt_pk_bf16(v0[2], v0[3]); w.z = cvt_pk_bf16(v1[0], v1[1]); w.w = cvt_pk_bf16(v1[2], v1[3]);
                    *(u32x4*)(H + off + bj * HALF) = w; }
                ss += shx<16>(ss); ss = sum32(ss);
                if (fq == 0) ssq[(size_t)ro * 16 + u.pn * 4 + wc] = ss; }
    }
};
struct EpiIn {
    static constexpr bool PERM = true, AFTER_DRAIN = false;
    bf16_t *U, *Bb, *Q, *Kb, *V, *SGC, *SGA; const float* ropec; const float* ropes; float* kbar; float qscale;
    __device__ __forceinline__ void operator()(const AccT& acc, const Unit& u, int wr, int wc, int fr, int fq) const {
        { int t_ = threadIdx.x; asm volatile("" : "+v"(t_)); fr = t_ & 15; fq = (t_ >> 4) & 3; }
        const int pn = u.pn; const int row0 = u.pm * BM + wr * 64 + fr;
        if (pn < 4) {
            const int c0 = 128 * pn + 16 * wc + 4 * fq;
#pragma unroll
            for (int ai = 0; ai < 2; ++ai)
#pragma unroll
                for (int m = 0; m < 4; ++m) { int ro = row0 + ai * HALF + m * 16; asm volatile("" : "+v"(ro)); bf16_t* rowp = U + (size_t)ro * 512 + c0;
#pragma unroll
                    for (int bj = 0; bj < 2; ++bj) { const f32x4 x = acc[ai][bj][m][0] * acc[ai][bj][m][1]; u32x2 w; w.x = cvt_pk_bf16(x[0], x[1]); w.y = cvt_pk_bf16(x[2], x[3]); *(u32x2*)(rowp + bj * 64) = w; } }
        } else if (pn < 6 || (pn >= 10 && pn < 12)) {
            bf16_t* O = pn < 6 ? Bb : V; const int col0 = (pn < 6 ? pn - 4 : pn - 10) * BM + wc * 32 + 8 * fq;
#pragma unroll
            for (int ai = 0; ai < 2; ++ai)
#pragma unroll
                for (int m = 0; m < 4; ++m) { int ro = row0 + ai * HALF + m * 16; asm volatile("" : "+v"(ro)); bf16_t* rowp = O + (size_t)ro * 512 + col0;
#pragma unroll
                    for (int bj = 0; bj < 2; ++bj) { const f32x4 v0 = acc[ai][bj][m][0], v1 = acc[ai][bj][m][1];
                        u32x4 w; w.x = cvt_pk_bf16(v0[0], v0[1]); w.y = cvt_pk_bf16(v0[2], v0[3]); w.z = cvt_pk_bf16(v1[0], v1[1]); w.w = cvt_pk_bf16(v1[2], v1[3]);
                        *(u32x4*)(rowp + bj * HALF) = w; } }
        } else if (pn < 10) {
            const bool isk = pn >= 8; bf16_t* O = isk ? Kb : Q; const int colt = (isk ? pn - 8 : pn - 6) * BM + wc * 32 + 8 * fq;
            const int g4 = 4 * (4 * (wc & 1) + fq);
            const float sc = isk ? 1.f : qscale;
            f32x4 cs0[2] = {(f32x4){0.f, 0.f, 0.f, 0.f}, (f32x4){0.f, 0.f, 0.f, 0.f}}, cs1[2] = {(f32x4){0.f, 0.f, 0.f, 0.f}, (f32x4){0.f, 0.f, 0.f, 0.f}};
#pragma unroll
            for (int ai = 0; ai < 2; ++ai)
#pragma unroll
                for (int m = 0; m < 4; ++m) { int row = row0 + ai * HALF + m * 16; asm volatile("" : "+v"(row)); const int pos = row & 2047;
                    const f32x4 c = *(const f32x4*)(ropec + pos * 32 + g4) * sc, s = *(const f32x4*)(ropes + pos * 32 + g4) * sc;
                    bf16_t* rowp = O + (size_t)row * 512 + colt;
#pragma unroll
                    for (int bj = 0; bj < 2; ++bj) { const f32x4 x1 = acc[ai][bj][m][0], x2 = acc[ai][bj][m][1]; const f32x4 o1 = x1 * c - x2 * s, o2 = x2 * c + x1 * s;
                        cs0[bj] += o1; cs1[bj] += o2;
                        u32x4 w; w.x = cvt_pk_bf16(o1[0], o1[1]); w.y = cvt_pk_bf16(o1[2], o1[3]); w.z = cvt_pk_bf16(o2[0], o2[1]); w.w = cvt_pk_bf16(o2[2], o2[3]);
                        *(u32x4*)(rowp + bj * HALF) = w; }
                    asm volatile("" : "+v"(cs0[0]), "+v"(cs0[1]), "+v"(cs1[0]), "+v"(cs1[1]) :: "memory"); }
            if (isk) {
#pragma unroll
                for (int bj = 0; bj < 2; ++bj)
#pragma unroll
                    for (int j = 0; j < 4; ++j) { float a = cs0[bj][j], b = cs1[bj][j];
                        a += shx<1>(a); b += shx<1>(b); a += shx<2>(a); b += shx<2>(b); a += shx<4>(a); b += shx<4>(b); a += shx<8>(a); b += shx<8>(b);
                        if (fr == 0) { const int pc = (pn - 8) * BM + bj * HALF + wc * 32 + 8 * fq;
                            float* kb = kbar + (size_t)u.pm * 512 + pc; atomicAdd(kb + j, a); atomicAdd(kb + 4 + j, b); } }
            }
        } else {
            bf16_t* O = pn < 16 ? SGC : SGA; const int col0 = (pn < 16 ? pn - 12 : pn - 16) * BM + wc * 32 + 8 * fq;
#pragma unroll
            for (int ai = 0; ai < 2; ++ai)
#pragma unroll
                for (int m = 0; m < 4; ++m) { int ro = row0 + ai * HALF + m * 16; asm volatile("" : "+v"(ro)); bf16_t* rowp = O + (size_t)ro * 1024 + col0;
#pragma unroll
                    for (int bj = 0; bj < 2; ++bj) { f32x4 v0 = acc[ai][bj][m][0], v1 = acc[ai][bj][m][1];
#pragma unroll
                        for (int j = 0; j < 4; ++j) { v0[j] = __builtin_amdgcn_rcpf(1.f + __expf(-v0[j])); v1[j] = __builtin_amdgcn_rcpf(1.f + __expf(-v1[j])); }
                        u32x4 w; w.x = cvt_pk_bf16(v0[0], v0[1]); w.y = cvt_pk_bf16(v0[2], v0[3]); w.z = cvt_pk_bf16(v1[0], v1[1]); w.w = cvt_pk_bf16(v1[2], v1[3]);
                        *(u32x4*)(rowp + bj * HALF) = w; }
                    asm volatile("" ::: "memory"); }
        }
    }
};
struct EpiSoftmax {
    static constexpr bool PERM = true, AFTER_DRAIN = true;
    bf16_t* O; int ldc; float scale_log2;
    __device__ __forceinline__ void fused(AccT& acc, const Unit& u, int wr, int wc, int fr, int fq, PG8_LAS unsigned char* lds, int wid, int lane) const {
        { int t_ = threadIdx.x; asm volatile("" : "+v"(t_)); fr = t_ & 15; fq = (t_ >> 4) & 3; }
        PG8_LAS f32x2* X = (PG8_LAS f32x2*)lds;
        float mx[2][4];
#pragma unroll
        for (int ai = 0; ai < 2; ++ai)
#pragma unroll
            for (int m = 0; m < 4; ++m) { float a = -3.0e38f;
#pragma unroll
                for (int bj = 0; bj < 2; ++bj)
#pragma unroll
                    for (int n = 0; n < 2; ++n) { acc[ai][bj][m][n] = acc[ai][bj][m][n] * scale_log2; const f32x4 x = acc[ai][bj][m][n]; a = fmaxf(fmaxf(a, fmaxf(x[0], x[1])), fmaxf(x[2], x[3])); }
                a = fmaxf(a, shx<16>(a)); a = max32(a); mx[ai][m] = a;
                float s = 0.f;
#pragma unroll
                for (int bj = 0; bj < 2; ++bj)
#pragma unroll
                    for (int n = 0; n < 2; ++n) { f32x4 x = acc[ai][bj][m][n];
#pragma unroll
                        for (int j = 0; j < 4; ++j) { x[j] = __builtin_amdgcn_exp2f(x[j] - a); s += x[j]; }
                        acc[ai][bj][m][n] = x; }
                s += shx<16>(s); s = sum32(s);
                if (fq == 0) X[(ai * HALF + wr * 64 + m * 16 + fr) * 4 + wc] = (f32x2){a, s};
            }
        asm volatile("s_waitcnt lgkmcnt(0)" ::: "memory"); __builtin_amdgcn_s_barrier(); asm volatile("" ::: "memory");
        const int row0 = u.pm * BM + wr * 64 + fr, col0 = u.pn * BM + wc * 32 + 8 * fq;
#pragma unroll
        for (int ai = 0; ai < 2; ++ai)
#pragma unroll
            for (int m = 0; m < 4; ++m) { const int r = ai * HALF + wr * 64 + m * 16 + fr;
                const f32x2 e0 = X[r * 4 + 0], e1 = X[r * 4 + 1], e2 = X[r * 4 + 2], e3 = X[r * 4 + 3];
                const float M = fmaxf(fmaxf(e0.x, e1.x), fmaxf(e2.x, e3.x));
                const float L = e0.y * __builtin_amdgcn_exp2f(e0.x - M) + e1.y * __builtin_amdgcn_exp2f(e1.x - M) + e2.y * __builtin_amdgcn_exp2f(e2.x - M) + e3.y * __builtin_amdgcn_exp2f(e3.x - M);
                const float f = __builtin_amdgcn_exp2f(mx[ai][m] - M) * __builtin_amdgcn_rcpf(L);
                bf16_t* rowp = O + (size_t)(row0 + ai * HALF + m * 16) * ldc + col0;
#pragma unroll
                for (int bj = 0; bj < 2; ++bj) { const f32x4 v0 = acc[ai][bj][m][0] * f, v1 = acc[ai][bj][m][1] * f;
                    u32x4 w; w.x = cvt_pk_bf16(v0[0], v0[1]); w.y = cvt_pk_bf16(v0[2], v0[3]); w.z = cvt_pk_bf16(v1[0], v1[1]); w.w = cvt_pk_bf16(v1[2], v1[3]);
                    *(u32x4*)(rowp + bj * HALF) = w; } }
        asm volatile("s_waitcnt lgkmcnt(0)" ::: "memory"); __builtin_amdgcn_s_barrier(); asm volatile("" ::: "memory");
    }
};
}
namespace attn_body {
using bf16=__hip_bfloat16;
using bf16x8=__attribute__((ext_vector_type(8)))short;
using s16x4=__attribute__((ext_vector_type(4)))short;
using f32x16=__attribute__((ext_vector_type(16)))float;
using u32x4=__attribute__((ext_vector_type(4)))unsigned;
constexpr int BATCH=16,NHEAD=8,SEQ=2048,D=64,DM=NHEAD*D;
constexpr int NW=8,QBLK=32,QB=QBLK*NW,KVBLK=64,NQB=SEQ/QB;
constexpr int ATTN_PITCH=DM, ATTN_UNIT_ROWS=QB;
__device__ __forceinline__ int crow(int r,int hi){return (r&3)+8*(r>>2)+4*hi;}
#define SBAR() __builtin_amdgcn_sched_barrier(0)
__device__ __forceinline__ void cmask(f32x16&p0,f32x16&p1,int jb,int qrel,int hi){
  const float NEG=-INFINITY; int kb=64*jb+4*hi;
  #pragma unroll
  for(int r=0;r<16;++r){int kv=kb+(r&3)+8*(r>>2); if(kv>qrel)p0[r]=NEG; if(kv+32>qrel)p1[r]=NEG;}
}

constexpr int NSLOT=3, SLOTB=8192;
constexpr int LDS_K=0, LDS_V=NSLOT*SLOTB, LDS_WS=2*NSLOT*SLOTB, LDS_OST=LDS_WS+NW*64*4, LDS_SEL=LDS_OST+NW*4096, LDS_BYTES=LDS_SEL+NW*64*4;
constexpr float C2=0.125f*1.4426950408889634f;
__device__ __forceinline__ void glds16(const void*gsrc,unsigned lds_dst){unsigned keep;
  asm volatile("s_mov_b32 %0, m0\n\ts_mov_b32 m0, %2\n\ts_nop 0\n\tglobal_load_lds_dwordx4 %1, off\n\ts_mov_b32 m0, %0":"=&s"(keep):"v"(gsrc),"s"(lds_dst):"memory");}
__device__ __forceinline__ float max3f(float a,float b,float c){float r;asm("v_max3_f32 %0, %1, %2, %3":"=v"(r):"v"(a),"v"(b),"v"(c));return r;}
__device__ __forceinline__ float max2f(float a,float b){float r;asm("v_max_f32_e32 %0, %1, %2":"=v"(r):"v"(a),"v"(b));return r;}
__device__ __forceinline__ float fadd_s(float a,float b){float r;asm("v_add_f32_e32 %0, %1, %2":"=v"(r):"v"(a),"v"(b));return r;}
__device__ __forceinline__ float fsub_s(float a,float b){float r;asm("v_sub_f32_e32 %0, %1, %2":"=v"(r):"v"(a),"v"(b));return r;}
typedef float f32x2_t __attribute__((ext_vector_type(2))); typedef __bf16 bf16x2_t __attribute__((ext_vector_type(2)));
__device__ __forceinline__ unsigned cvtpk_s(float lo,float hi){f32x2_t v={lo,hi};bf16x2_t b=__builtin_convertvector(v,bf16x2_t);return __builtin_bit_cast(unsigned,b);}
#define WAIT_BAR(N) asm volatile("s_waitcnt vmcnt(" #N ") lgkmcnt(0)\n\ts_barrier":::"memory")

__device__ __forceinline__ void qkt(f32x16&p0,f32x16&p1,const char*Kslot,const bf16x8*qr,const f32x16&negm,int r32,int hi){
  const char*kb=Kslot+hi*1024+r32*16;
  #pragma unroll
  for(int d0=0;d0<4;++d0){
    const bf16x8 b0=*reinterpret_cast<const bf16x8*>(kb+d0*2048);
    const bf16x8 b1=*reinterpret_cast<const bf16x8*>(kb+d0*2048+512);
    if(d0==0){p0=__builtin_amdgcn_mfma_f32_32x32x16_bf16(b0,qr[0],negm,0,0,0);p1=__builtin_amdgcn_mfma_f32_32x32x16_bf16(b1,qr[0],negm,0,0,0);}
    else{p0=__builtin_amdgcn_mfma_f32_32x32x16_bf16(b0,qr[d0],p0,0,0,0);p1=__builtin_amdgcn_mfma_f32_32x32x16_bf16(b1,qr[d0],p1,0,0,0);}}
}
typedef __attribute__((address_space(3))) const char* lds_cptr;
typedef short v4i16_t __attribute__((ext_vector_type(4)));
__device__ __forceinline__ void kload8(bf16x8*kf,lds_cptr kp){
  kf[0]=*(const __attribute__((address_space(3))) bf16x8*)(kp);      kf[1]=*(const __attribute__((address_space(3))) bf16x8*)(kp+512);
  kf[2]=*(const __attribute__((address_space(3))) bf16x8*)(kp+2048); kf[3]=*(const __attribute__((address_space(3))) bf16x8*)(kp+2560);
  kf[4]=*(const __attribute__((address_space(3))) bf16x8*)(kp+4096); kf[5]=*(const __attribute__((address_space(3))) bf16x8*)(kp+4608);
  kf[6]=*(const __attribute__((address_space(3))) bf16x8*)(kp+6144); kf[7]=*(const __attribute__((address_space(3))) bf16x8*)(kp+6656);
}
__device__ __forceinline__ void kload2(bf16x8*kf,lds_cptr kp,int j){ kf[2*j]=*(const __attribute__((address_space(3))) bf16x8*)(kp+j*2048); kf[2*j+1]=*(const __attribute__((address_space(3))) bf16x8*)(kp+j*2048+512); }
__device__ __forceinline__ s16x4 vtr(lds_cptr p){ return __builtin_bit_cast(s16x4,__builtin_amdgcn_ds_read_tr16_b64_v4i16((__attribute__((address_space(3))) v4i16_t*)p)); }
__device__ __forceinline__ float rowmax(const f32x16&p0,const f32x16&p1){
  float a=max3f(p0[0],p0[1],p1[0]),b=max3f(p0[2],p0[3],p1[1]);a=max3f(a,p1[2],p1[3]);
  #pragma unroll
  for(int r=4;r<16;r+=4){a=max3f(a,p0[r],p0[r+1]);b=max3f(b,p0[r+2],p0[r+3]);a=max3f(a,p1[r],p1[r+1]);b=max3f(b,p1[r+2],p1[r+3]);}
  const float m=max2f(a,b);
  auto rr=__builtin_amdgcn_permlane32_swap(__float_as_uint(m),__float_as_uint(m),false,false);
  return max2f(__uint_as_float(rr[0]),__uint_as_float(rr[1]));
}
__device__ __forceinline__ void pv(f32x16*o,int vb,bf16x8 pa0,bf16x8 pa1,bf16x8 pa2,bf16x8 pa3){
  #pragma unroll
  for(int d0=0;d0<2;++d0){s16x4 lo[4],hi[4];
    #pragma unroll
    for(int ks=0;ks<4;++ks){
      asm volatile("ds_read_b64_tr_b16 %0,%1 offset:%c2":"=&v"(lo[ks]):"v"(vb),"i"(d0*4096+ks*1024):"memory");
      asm volatile("ds_read_b64_tr_b16 %0,%1 offset:%c2":"=&v"(hi[ks]):"v"(vb),"i"(d0*4096+ks*1024+512):"memory");}
    asm volatile("s_waitcnt lgkmcnt(0)":::"memory");SBAR();
    #define PK(k) (bf16x8){lo[k][0],lo[k][1],lo[k][2],lo[k][3],hi[k][0],hi[k][1],hi[k][2],hi[k][3]}
    o[d0]=__builtin_amdgcn_mfma_f32_32x32x16_bf16(pa0,PK(0),o[d0],0,0,0);
    o[d0]=__builtin_amdgcn_mfma_f32_32x32x16_bf16(pa1,PK(1),o[d0],0,0,0);
    o[d0]=__builtin_amdgcn_mfma_f32_32x32x16_bf16(pa2,PK(2),o[d0],0,0,0);
    o[d0]=__builtin_amdgcn_mfma_f32_32x32x16_bf16(pa3,PK(3),o[d0],0,0,0);
    #undef PK
  }
}

#ifndef ATTN_STORE16
#define ATTN_STORE16(p,v) (*(u32x4*)(p)=(v))
#endif
template<int THRL> __device__ __forceinline__ void attn_unit(int b,int h,int qb,const bf16*Q,const bf16*__restrict__ K,const bf16*__restrict__ V,bf16*O,const float*__restrict__ kbar,char*shm){
  int tid=threadIdx.x; asm volatile("":"+v"(tid)); const int lane=tid&63,r32=lane&31,hi=lane>>5; const int wid=__builtin_amdgcn_readfirstlane(tid>>6);
  const long rowbase=(long)b*SEQ; const int q0=qb*QB;
  const bf16*Qw=Q+(rowbase+q0+wid*QBLK)*DM+h*D;
  const bf16*Kh=K+rowbase*DM+h*D,*Vh=V+rowbase*DM+h*D;
  const unsigned lds0=(unsigned)(uintptr_t)shm;
  float*wsf=(float*)(shm+LDS_WS)+wid*64;
  const bf16*ksrc=Kh+(long)lane*DM+wid*8;
  const bf16*vsrc=Vh+(long)(16*(wid&3)+(lane>>2))*DM+(wid>>2)*32+(lane&3)*8;
  const unsigned kdst=lds0+LDS_K+wid*1024, vdst=lds0+LDS_V+wid*1024;
  #define DMA_K(t,slot) glds16(ksrc+(long)(t)*KVBLK*DM,(unsigned)__builtin_amdgcn_readfirstlane(kdst+(slot)))
  #define DMA_V(t,slot) glds16(vsrc+(long)(t)*KVBLK*DM,(unsigned)__builtin_amdgcn_readfirstlane(vdst+(slot)))
  const int vb0=(int)(lds0+LDS_V)+((lane>>4)&1)*32+(lane&3)*8+(4*hi+((lane&15)>>2))*64;
  const char*Kbase=shm+LDS_K; bf16x8 kf[8];
  const lds_cptr shm3=(lds_cptr)shm; const lds_cptr kp0=shm3+LDS_K+hi*1024+r32*16; const lds_cptr vp0=shm3+LDS_V+((lane>>4)&1)*32+(lane&3)*8+(4*hi+((lane&15)>>2))*64;
  const int NT=(q0+QB)/KVBLK;
  DMA_K(0,0);DMA_V(0,0);DMA_K(1,SLOTB);
  bf16x8 qr[4];
  #pragma unroll
  for(int d0=0;d0<4;++d0)qr[d0]=*reinterpret_cast<const bf16x8*>(&Qw[(long)r32*DM+d0*16+hi*8]);
  int selm=0;
  if(qb>0){
    float g[7]; int hi8=8*hi; asm volatile("":"+v"(hi8)); const float*kb=kbar+(size_t)(b*8)*512+h*64+hi8;
    #pragma unroll
    for(int n=0;n<7;++n){ float a=0.f;
      if(n<qb){
        #pragma unroll
        for(int d0=0;d0<4;++d0){ const float4 k0=*(const float4*)(kb+n*512+16*d0),k1=*(const float4*)(kb+n*512+16*d0+4); const bf16x8 qq=qr[d0];
          #define QF(e) __uint_as_float(((unsigned)(unsigned short)qq[e])<<16)
          a+=QF(0)*k0.x+QF(1)*k0.y+QF(2)*k0.z+QF(3)*k0.w+QF(4)*k1.x+QF(5)*k1.y+QF(6)*k1.z+QF(7)*k1.w;
          #undef QF
        } }
      a=::sum32(a); g[n]=(n<qb)?a:-INFINITY; asm volatile("":"+v"(g[n])::"memory"); }
    #pragma unroll
    for(int r=0;r<3;++r){ int best=-1; float bv=-INFINITY;
      #pragma unroll
      for(int n=0;n<7;++n) if(!((selm>>n)&1)&&g[n]>bv){bv=g[n];best=n;}
      if(best>=0)selm|=1<<best; }
  }
  selm|=1<<qb;
  typedef __attribute__((address_space(3))) int* lds_iptr;
  ((lds_iptr)(shm3+LDS_SEL))[tid]=selm;
  #define CURNEG(blk) ({ int t_=threadIdx.x; asm volatile("":"+v"(t_)); const int sm_=((lds_iptr)(shm3+LDS_SEL))[t_]; ((sm_>>(blk))&1)?0.f:-INFINITY; })
  #define NEGUPD(t) do{ if((((t)+1)&3)==0){ const float cn_=CURNEG(((t)+1)>>2); _Pragma("unroll") for(int r=0;r<16;++r)negm[r]=cn_-mhat; asm volatile("":"+v"(negm)); } }while(0)
  float mhat=0.f,l_reg=0.f;f32x16 o[2];o[0]=f32x16{};o[1]=f32x16{};f32x16 negm; { const float cn_=CURNEG(0); _Pragma("unroll") for(int r=0;r<16;++r)negm[r]=cn_; } asm volatile("":"+v"(negm));
  const int qrel=wid*QBLK+r32;
  #define CMASK(P0,P1,t) do{int jb_=(t)-(NT-4); if(jb_>=0)cmask(P0,P1,jb_,qrel,hi);}while(0)
  bool resc=false;
  #define START(P0,P1) do{ const float rm=rowmax(P0,P1); resc=false; \
    { const float dl=__builtin_fmaxf(rm,-24.f); mhat=fadd_s(mhat,dl); \
      _Pragma("unroll") for(int r=0;r<16;++r){P0[r]=fsub_s(P0[r],dl);P1[r]=fsub_s(P1[r],dl);} \
      { const float cn_=CURNEG(0); _Pragma("unroll") for(int r=0;r<16;++r)negm[r]=cn_-mhat; } asm volatile("":"+v"(negm)); } \
    _Pragma("unroll") for(int r=0;r<16;++r)P0[r]=__builtin_amdgcn_exp2f(P0[r]); }while(0)
  #define RESC() do{ if(resc){ asm volatile("s_waitcnt lgkmcnt(0)":::"memory"); \
      _Pragma("unroll") for(int d_=0;d_<2;++d_) _Pragma("unroll") for(int r=0;r<16;++r)o[d_][r]*=wsf[crow(r,hi)]; } }while(0)
  f32x16 pA0,pA1,pB0,pB1;
  int sl_prev=0,sl_cur=0,sl_next=SLOTB;
  #define ROT() do{sl_prev=sl_cur;sl_cur=sl_next;sl_next=(sl_next==(NSLOT-1)*SLOTB)?0:sl_next+SLOTB;}while(0)
  DMA_K(2,2*SLOTB);
  WAIT_BAR(3);
  qkt(pA0,pA1,Kbase,qr,negm,r32,hi);asm volatile("s_nop 15\n\ts_nop 7":"+v"(pA0),"+v"(pA1));CMASK(pA0,pA1,0);
  START(pA0,pA1);
  _Pragma("unroll") for(int r=0;r<16;++r)pA1[r]=__builtin_amdgcn_exp2f(pA1[r]);
  WAIT_BAR(0);
  DMA_K(3,0);DMA_V(1,SLOTB);
  ROT();
  kload8(kf,kp0+sl_cur);
  WAIT_BAR(2);
  s16x4 vlo[8],vhi[8]; u32x4 pw0,pw1,pw2,pw3;
  #define PKW(P,B) cvtpk_s(P[B],P[B+1])
  #define PAF(k) __builtin_bit_cast(bf16x8,pw##k)
  #define VFR(i) (bf16x8){vlo[i][0],vlo[i][1],vlo[i][2],vlo[i][3],vhi[i][0],vhi[i][1],vhi[i][2],vhi[i][3]}
  #define PIN(x) asm volatile("":"+v"(x))
  #define MX3(a,b,c) __builtin_fmaxf(__builtin_fmaxf((a),(b)),(c))
  #define GAPA(MF,A0,A1,A2,A3,W0,W1,PW) do{ MF; sacc+=A0; sacc+=A1; sacc+=A2; sacc+=A3; PIN(sacc); W0; W1; PIN(PW); SBAR(); }while(0)
  #define EX(v) __builtin_amdgcn_exp2f(v)
  #define GAPB(MF,X,B) do{ MF; X[B]=EX(X[B]); X[B+1]=EX(X[B+1]); X[B+2]=EX(X[B+2]); X[B+3]=EX(X[B+3]); PIN(X); SBAR(); }while(0)
  #define VRD(i) do{ vlo[i]=vtr(vp_+(((i)>>2)*4096+((i)&3)*1024)); vhi[i]=vtr(vp_+(((i)>>2)*4096+((i)&3)*1024+512)); }while(0)
  #define KRD(G,j) do{ if(G){ kload2(kf,kp0+sl_next,j); SBAR(); } }while(0)
  #define STEP(C0,C1,P0,P1,t,GK,GV,GL) do{ SBAR(); \
    const lds_cptr vp_=vp0+sl_prev; \
    VRD(0); SBAR(); float sacc=(P0[0]+P0[1]); \
    GAPA(C0=__builtin_amdgcn_mfma_f32_32x32x16_bf16(kf[0],qr[0],negm,0,0,0), P0[2],P0[3],P0[4],P0[5],     pw0[0]=PKW(P0,0), pw0[1]=PKW(P0,2), pw0); \
    VRD(4); SBAR(); GAPA(C1=__builtin_amdgcn_mfma_f32_32x32x16_bf16(kf[1],qr[0],negm,0,0,0), P0[6],P0[7],P0[8],P0[9],     pw0[2]=PKW(P0,4), pw0[3]=PKW(P0,6), pw0); \
    VRD(1); SBAR(); GAPA(C0=__builtin_amdgcn_mfma_f32_32x32x16_bf16(kf[2],qr[1],C0,0,0,0),   P0[10],P0[11],P0[12],P0[13], pw1[0]=PKW(P0,8), pw1[1]=PKW(P0,10), pw1); \
    VRD(5); SBAR(); GAPA(C1=__builtin_amdgcn_mfma_f32_32x32x16_bf16(kf[3],qr[1],C1,0,0,0),   P0[14],P0[15],P1[0],P1[1],   pw1[2]=PKW(P0,12),pw1[3]=PKW(P0,14), pw1); \
    VRD(2); SBAR(); GAPA(C0=__builtin_amdgcn_mfma_f32_32x32x16_bf16(kf[4],qr[2],C0,0,0,0),   P1[2],P1[3],P1[4],P1[5],     pw2[0]=PKW(P1,0), pw2[1]=PKW(P1,2), pw2); \
    VRD(6); SBAR(); GAPA(C1=__builtin_amdgcn_mfma_f32_32x32x16_bf16(kf[5],qr[2],C1,0,0,0),   P1[6],P1[7],P1[8],P1[9],     pw2[2]=PKW(P1,4), pw2[3]=PKW(P1,6), pw2); \
    VRD(3); SBAR(); GAPA(C0=__builtin_amdgcn_mfma_f32_32x32x16_bf16(kf[6],qr[3],C0,0,0,0),   P1[10],P1[11],P1[12],P1[13], pw3[0]=PKW(P1,8), pw3[1]=PKW(P1,10), pw3); \
    VRD(7); SBAR(); GAPA(C1=__builtin_amdgcn_mfma_f32_32x32x16_bf16(kf[7],qr[3],C1,0,0,0),   P1[14],P1[15],0.f,0.f,       pw3[2]=PKW(P1,12),pw3[3]=PKW(P1,14), pw3); \
    l_reg+=sacc; \
    if(GK){DMA_K((t)+3,sl_cur);} if(GV){DMA_V((t)+1,sl_next);} \
    CMASK(C0,C1,t); \
    { float a=MX3(C0[0],C0[1],C1[0]),b=MX3(C0[2],C0[3],C1[1]); a=MX3(a,C1[2],C1[3]); \
      _Pragma("unroll") for(int r=4;r<16;r+=4){a=MX3(a,C0[r],C0[r+1]);b=MX3(b,C0[r+2],C0[r+3]);a=MX3(a,C1[r],C1[r+1]);b=MX3(b,C1[r+2],C1[r+3]);} \
      float rm=__builtin_fmaxf(a,b); { auto rr=__builtin_amdgcn_permlane32_swap(__float_as_uint(rm),__float_as_uint(rm),false,false); rm=__builtin_fmaxf(__uint_as_float(rr[0]),__uint_as_float(rr[1])); } \
      resc=false; \
      if(__builtin_expect(__any(rm>(float)THRL),0)){ const float dl=__builtin_fmaxf(rm,0.f); mhat+=dl; \
        _Pragma("unroll") for(int r=0;r<16;++r){C0[r]-=dl;C1[r]-=dl;} \
        { const float cn_=CURNEG(((t)+1)>>2); _Pragma("unroll") for(int r=0;r<16;++r)negm[r]=cn_-mhat; } asm volatile("":"+v"(negm)); \
        const float f=__builtin_amdgcn_exp2f(-dl); l_reg*=f; if(hi==0)wsf[r32]=f; resc=true; } } \
    SBAR(); \
    GAPB(o[0]=__builtin_amdgcn_mfma_f32_32x32x16_bf16(PAF(0),VFR(0),o[0],0,0,0), C0,0); \
    GAPB(o[1]=__builtin_amdgcn_mfma_f32_32x32x16_bf16(PAF(0),VFR(4),o[1],0,0,0), C0,4); \
    KRD(GL,0); GAPB(o[0]=__builtin_amdgcn_mfma_f32_32x32x16_bf16(PAF(1),VFR(1),o[0],0,0,0), C0,8); \
    KRD(GL,1); GAPB(o[1]=__builtin_amdgcn_mfma_f32_32x32x16_bf16(PAF(1),VFR(5),o[1],0,0,0), C0,12); \
    KRD(GL,2); GAPB(o[0]=__builtin_amdgcn_mfma_f32_32x32x16_bf16(PAF(2),VFR(2),o[0],0,0,0), C1,0); \
    KRD(GL,3); GAPB(o[1]=__builtin_amdgcn_mfma_f32_32x32x16_bf16(PAF(2),VFR(6),o[1],0,0,0), C1,4); \
    GAPB(o[0]=__builtin_amdgcn_mfma_f32_32x32x16_bf16(PAF(3),VFR(3),o[0],0,0,0), C1,8); \
    GAPB(o[1]=__builtin_amdgcn_mfma_f32_32x32x16_bf16(PAF(3),VFR(7),o[1],0,0,0), C1,12); \
    }while(0)
  int t=1;
  #undef CMASK
  #define CMASK(P0,P1,t) do{}while(0)
  for(;t+5<NT;t+=2){
    STEP(pB0,pB1,pA0,pA1,t,true,true,true);     WAIT_BAR(2); RESC(); ROT(); NEGUPD(t);
    STEP(pA0,pA1,pB0,pB1,t+1,true,true,true);   WAIT_BAR(2); RESC(); ROT(); NEGUPD(t+1);
  }
  #undef CMASK
  #define CMASK(P0,P1,t) do{int jb_=(t)-(NT-4); if(jb_>=0)cmask(P0,P1,jb_,qrel,hi);}while(0)
  #define ENDW(tt) do{ if((tt)+3<NT){WAIT_BAR(2);} else if((tt)+2<NT){WAIT_BAR(1);} else {WAIT_BAR(0);} }while(0)
  for(;t+1<NT;t+=2){
    STEP(pB0,pB1,pA0,pA1,t,(t+3<NT),(t+1<NT),(t+1<NT));       ENDW(t);   RESC(); ROT(); NEGUPD(t);
    STEP(pA0,pA1,pB0,pB1,t+1,(t+4<NT),(t+2<NT),(t+2<NT));     ENDW(t+1); RESC(); ROT(); NEGUPD(t+1);
  }
  STEP(pB0,pB1,pA0,pA1,NT-1,false,false,false); RESC();
  { float sacc=pB0[0]+pB0[1]; _Pragma("unroll") for(int r=2;r<16;++r)sacc+=pB0[r]; _Pragma("unroll") for(int r=0;r<16;++r)sacc+=pB1[r]; l_reg+=sacc;
    pw0=(u32x4){PKW(pB0,0),PKW(pB0,2),PKW(pB0,4),PKW(pB0,6)};pw1=(u32x4){PKW(pB0,8),PKW(pB0,10),PKW(pB0,12),PKW(pB0,14)};pw2=(u32x4){PKW(pB1,0),PKW(pB1,2),PKW(pB1,4),PKW(pB1,6)};pw3=(u32x4){PKW(pB1,8),PKW(pB1,10),PKW(pB1,12),PKW(pB1,14)};
    SBAR(); pv(o,vb0+sl_cur,PAF(0),PAF(1),PAF(2),PAF(3)); }
  #undef PKW
  #undef PAF
  #undef VFR
  #undef PIN
  #undef MX3
  #undef GAPA
  #undef GAPB
  #undef EX
  #undef VRD
  #undef KRD
  #undef STEP
  #undef ENDW
  {auto rr=__builtin_amdgcn_permlane32_swap(__float_as_uint(l_reg),__float_as_uint(l_reg),false,false);l_reg=__uint_as_float(rr[0])+__uint_as_float(rr[1]);}
  if(hi==0)wsf[32+r32]=l_reg;asm volatile("s_waitcnt lgkmcnt(0)":::"memory");
  float rli[16];
  #pragma unroll
  for(int r=0;r<16;++r)rli[r]=__builtin_amdgcn_rcpf(wsf[32+crow(r,hi)]);
  bf16*Ow=O+(rowbase+q0+wid*QBLK)*DM+h*D;
  { bf16*stg=(bf16*)(shm+LDS_OST)+wid*2048;
    #pragma unroll
    for(int r=0;r<16;++r){const int orow=crow(r,hi);
      #pragma unroll
      for(int d0=0;d0<2;++d0)stg[orow*64+d0*32+r32]=__float2bfloat16(o[d0][r]*rli[r]);}
    asm volatile("s_waitcnt lgkmcnt(0)":::"memory");
    #pragma unroll
    for(int i=0;i<4;++i){const int row=i*8+(lane>>3),ch=lane&7; const u32x4 v=*(const u32x4*)(stg+row*64+ch*8); ATTN_STORE16(Ow+(long)row*DM+ch*8,v);} }
  asm volatile("s_waitcnt lgkmcnt(0)\n\ts_barrier":::"memory");
  #undef DMA_K
  #undef DMA_V
  #undef CMASK
  #undef START
  #undef CURNEG
  #undef NEGUPD
  #undef RESC
  #undef ROT
}
constexpr int ATTN_LDS_BYTES=LDS_BYTES;
struct AttnTensors { const bf16* Q; const bf16* K; const bf16* V; bf16* O; const float* kbar; };
struct AttnUnit { int bh; int qb; };
struct StaticOrder {
  int vcu,G;
  __device__ __forceinline__ explicit StaticOrder(int grid,int block):vcu((grid%8==0)?(block%8)*(grid/8)+block/8:block),G(grid){}
  __device__ __forceinline__ bool next(int i,AttnUnit&u)const{
    if(G==256){ if(i>=4)return false; const int s=vcu&1; u.bh=vcu>>1; u.qb=s?((i==0)?6:(i==1)?1:(i==2)?5:2):((i==0)?7:(i==1)?0:(i==2)?4:3); return true; }
    const int L=i*G+vcu; if(L>=1024)return false; u.bh=L>>3; u.qb=L&7; return true; }
  __device__ __forceinline__ void a_ready(const AttnUnit&)const{}
  __device__ __forceinline__ void done(const AttnUnit&)const{}
};
template<class Sched,int THRL=8> __device__ __forceinline__ void attn_phase(char*lds,const AttnTensors&T,const Sched&S){
  AttnUnit u;
  for(int i=0;S.next(i,u);++i){ S.a_ready(u); attn_unit<THRL>(u.bh/NHEAD,u.bh%NHEAD,u.qb,T.Q,T.K,T.V,T.O,T.kbar,lds); S.done(u); }
}
#undef SBAR
#undef WAIT_BAR
}
constexpr int NWAVES = 8;
constexpr int T = 32768, D = 1024, SEQ = 2048, MEMROWS = 4096, INW = 5120;
constexpr float RMS_EPS = 1e-6f;
constexpr size_t MiB = 1u << 20;
constexpr size_t WS_CTL = 0, CTL_ZERO_BYTES = 2 * MiB, WS_KBAR = 1 * MiB;
constexpr size_t WS_WIN = 2 * MiB, WS_WC = 12 * MiB, WS_WA = 13 * MiB, WS_WM = 14 * MiB, WS_WXQ = 16 * MiB, WS_WXKV = 18 * MiB, WS_WXO = 22 * MiB, WS_MT = 24 * MiB, WS_ROPE = 28 * MiB;
constexpr size_t WS_MEMN = 32 * MiB, WS_KX = 40 * MiB, WS_VXT = 48 * MiB;
constexpr size_t WS_SSQ1 = 30 * MiB, WS_SSQ2 = 56 * MiB;
constexpr size_t WS_A = 64 * MiB;
constexpr size_t WS_YC = 128 * MiB, WS_QO = 160 * MiB, WS_U = 192 * MiB, WS_K = 224 * MiB, WS_V = 256 * MiB;
constexpr size_t WS_SGC = 320 * MiB, WS_SGA = 384 * MiB;
constexpr size_t WS_A8I = 320 * MiB, WS_ASC = 352 * MiB;
constexpr size_t WS_EIDX = 448 * MiB, WS_GW = 464 * MiB, WS_PW = 480 * MiB, WS_END = 496 * MiB;
constexpr size_t WS_U8 = 288 * MiB, WS_V8T = 304 * MiB, WS_SU = 29 * MiB, WS_SV = 29 * MiB + 512 * 1024;
constexpr size_t WS_QX = 128 * MiB, WS_PM = 192 * MiB, WS_OX = 128 * MiB;
constexpr size_t WS_PO = 128 * MiB;
constexpr size_t WS_SC = 128 * MiB;
constexpr int CW_TMO = 0, CW_BAR = 4096, CW_Q = 8192;
constexpr int RING_OFF = 0, RING_BYTES = 131072;
constexpr int LDSCTL_OFF = RING_BYTES, MISC_OFF = LDSCTL_OFF + 320;
constexpr int LDS_BYTES = 163840;
constexpr int UL_OFF = RING_BYTES + 512, UL_WAVE = (LDS_BYTES - UL_OFF) / 8, UL_CAP = ((UL_WAVE - 64) / 16) & ~15;

#define GAS __attribute__((address_space(1)))
#define LAS __attribute__((address_space(3)))
typedef unsigned short bf16;
typedef unsigned v4u __attribute__((ext_vector_type(4)));
typedef unsigned v2u __attribute__((ext_vector_type(2)));
typedef float f32x4 __attribute__((ext_vector_type(4)));
typedef float f32x2v __attribute__((ext_vector_type(2)));
typedef _Float16 h2v __attribute__((ext_vector_type(2)));
typedef GAS unsigned gu32;
#define RLX_AGENT __ATOMIC_RELAXED, __HIP_MEMORY_SCOPE_AGENT
#define LDS_WAIT() asm volatile("s_waitcnt lgkmcnt(0)" ::: "memory")
#define VM_WAIT() asm volatile("s_waitcnt vmcnt(0)" ::: "memory")
__device__ __forceinline__ unsigned pk2(float lo, float hi) { return pg8::cvt_pk_bf16(lo, hi); }
__device__ __forceinline__ float bflo(unsigned u) { return __uint_as_float(u << 16); }
__device__ __forceinline__ float bfhi(unsigned u) { return __uint_as_float(u & 0xffff0000u); }

#define XB_TMO      128
#define XB_XCNT(j)  (256  + 64 * (j))
#define XB_XSUB(j)  (1280 + 64 * (j))
#define XB_XGEN(j)  (2304 + 64 * (j))
#define XB_TOP      3328
#define XB_TOPGEN   3392
#define XCD_BAR_WORDS 3456
#define XB_SPIN_CAP (1u << 18)
__device__ __forceinline__ unsigned xb_ld(unsigned* p)              { return __hip_atomic_load(p, __ATOMIC_RELAXED, __HIP_MEMORY_SCOPE_AGENT); }
__device__ __forceinline__ unsigned xb_add(unsigned* p, unsigned v) { return __hip_atomic_fetch_add(p, v, __ATOMIC_RELAXED, __HIP_MEMORY_SCOPE_AGENT); }
__device__ __forceinline__ unsigned xb_xcc_id() { return (unsigned)__builtin_amdgcn_s_getreg((3 << 11) | 20) & 0xFu; }
#define XB_SPIN(cond, bar) do { unsigned _sp = 0; while (cond) { __builtin_amdgcn_s_sleep(1); \
    if ((++_sp & 255u) == 0u) { if (xb_ld(&(bar)[XB_TMO])) break; if (_sp > XB_SPIN_CAP) { atomicAdd(&(bar)[XB_TMO], 1u); break; } } } } while (0)
struct XcdBarrier { unsigned* bar; unsigned x; volatile LAS unsigned* st; };
__device__ __forceinline__ XcdBarrier xcd_barrier_post(unsigned* bar, volatile LAS unsigned* st) {
    XcdBarrier b; b.bar = bar; b.x = xb_xcc_id(); b.st = st;
    if (threadIdx.x == 0) (void)xb_add(&bar[XB_XCNT(b.x)], 1u);
    return b;
}
__device__ __forceinline__ void xcd_barrier_complete(unsigned* bar, unsigned x, unsigned& nloc, unsigned& nx) {
    const unsigned G = gridDim.x * gridDim.y * gridDim.z;
    unsigned sum, cnt, mine, sp = 0u;
    for (;;) {
        sum = 0u; cnt = 0u; mine = 0u;
#pragma unroll
        for (unsigned j = 0; j < 16; ++j) { const unsigned c = xb_ld(&bar[XB_XCNT(j)]); sum += c; cnt += (c > 0u) ? 1u : 0u; mine = (j == x) ? c : mine; }
        if (sum == G) break;
        __builtin_amdgcn_s_sleep(1);
        if ((++sp & 255u) == 0u) { if (xb_ld(&bar[XB_TMO])) break; if (sp > XB_SPIN_CAP) { atomicAdd(&bar[XB_TMO], 1u); break; } }
    }
    nloc = mine > 0u ? mine : 1u; nx = cnt > 0u ? cnt : 1u;
}
__device__ __forceinline__ void xcd_barrier(const XcdBarrier& b) {
    asm volatile("s_waitcnt vmcnt(0)" ::: "memory");
    __syncthreads();
    if (threadIdx.x == 0) {
        unsigned* bar = b.bar;
        __builtin_amdgcn_s_waitcnt(0);
        unsigned nloc = b.st[0], nx = b.st[1];
        if (nloc == 0u) { xcd_barrier_complete(bar, b.x, nloc, nx); b.st[0] = nloc; b.st[1] = nx; }
        const unsigned old = xb_add(&bar[XB_XSUB(b.x)], 1u);
        const unsigned gen = old / nloc;
        if (old + 1u == (gen + 1u) * nloc) {
            __builtin_amdgcn_fence(__ATOMIC_RELEASE, "agent");
            asm volatile("s_waitcnt vmcnt(0)" ::: "memory");
            const unsigned og = xb_add(&bar[XB_TOP], 1u);
            const unsigned tg = og / nx;
            if (og + 1u == (tg + 1u) * nx) xb_add(&bar[XB_TOPGEN], 1u);
            else XB_SPIN(xb_ld(&bar[XB_TOPGEN]) == tg, bar);
            __builtin_amdgcn_fence(__ATOMIC_ACQUIRE, "agent");
            xb_add(&bar[XB_XGEN(b.x)], 1u);
            asm volatile("s_waitcnt vmcnt(0)" ::: "memory");
        } else {
            XB_SPIN(xb_ld(&bar[XB_XGEN(b.x)]) == gen, bar);
            __builtin_amdgcn_fence(__ATOMIC_ACQUIRE, "agent");
            asm volatile("s_waitcnt vmcnt(0)" ::: "memory");
        }
    }
    __syncthreads();
}

struct MapId { static __device__ __forceinline__ int src(int j) { return j; } };
struct MapWin {
    static __device__ __forceinline__ int src(int j) {
        if (j < 1024) { const int g8 = j >> 3, i = j & 7; return ((i < 4) ? 0 : 1024) + 4 * g8 + (i & 3); }
        if (j < 1536) return 512 + (j - 1024);
        if (j < 2560) { const int jj = j - 1536, qk = jj >> 9, p = jj & 511, head = p >> 6, pl = p & 63, g = pl >> 3, i = pl & 7; return 1536 + qk * 512 + head * 64 + 4 * g + (i & 3) + 32 * (i >> 2); }
        return j;
    }
};
template <class MAP>
__device__ __forceinline__ void p0_transpose_item(const float* W, int K, int N, int NOUT, bf16* WT, LAS float* scr, int item, int lane, const float* gain = nullptr) {
    const int nblk = NOUT / 32, kb = item / nblk, nb = item % nblk, k0 = 64 * kb, n0 = 32 * nb;
    const int sc = MAP::src(n0 + (lane & 31));
    float wv[32];
#pragma unroll
    for (int i = 0; i < 32; ++i) wv[i] = W[(size_t)(k0 + 2 * i + (lane >> 5)) * N + sc];
#pragma unroll
    for (int i = 0; i < 32; ++i) { const int kk = 2 * i + (lane >> 5); const float gk = gain ? gain[k0 + kk] : 1.f; scr[kk * 33 + (lane & 31)] = wv[i] * gk; }
    LDS_WAIT(); asm volatile("" ::: "memory");
    const int c = lane & 7;
#pragma unroll
    for (int j = 0; j < 4; ++j) { const int n = (lane >> 3) + 8 * j; const LAS float* s = scr + (8 * c) * 33 + n;
        v4u o; o.x = pk2(s[0 * 33], s[1 * 33]); o.y = pk2(s[2 * 33], s[3 * 33]); o.z = pk2(s[4 * 33], s[5 * 33]); o.w = pk2(s[6 * 33], s[7 * 33]);
        *(GAS v4u*)(WT + (size_t)(n0 + n) * K + k0 + 8 * c) = o; }
    LDS_WAIT(); asm volatile("" ::: "memory");
}
__device__ __forceinline__ void rms_row_to_bf16(const float* xrow, const float* g, bf16* orow, int lane) {
    const GAS f32x4* xr = (const GAS f32x4*)xrow + lane; const GAS f32x4* gr = (const GAS f32x4*)g + lane;
    f32x4 v[4]; float s = 0.f;
#pragma unroll
    for (int j = 0; j < 4; ++j) { v[j] = xr[64 * j]; s += (v[j].x * v[j].x + v[j].y * v[j].y) + (v[j].z * v[j].z + v[j].w * v[j].w); }
    const float r = rsqrtf(wave_sum(s) * (1.f / 1024.f) + RMS_EPS);
    GAS v2u* o8 = (GAS v2u*)orow + lane;
#pragma unroll
    for (int j = 0; j < 4; ++j) { const f32x4 gg = gr[64 * j]; v2u w; w.x = pk2(v[j].x * r * gg.x, v[j].y * r * gg.y); w.y = pk2(v[j].z * r * gg.z, v[j].w * r * gg.w); o8[64 * j] = w; }
}
template <int NR>
__device__ __forceinline__ void rms_rows_to_bf16(const float* x, const float* g, bf16* o, int m0, int stride, int lane) {
    f32x4 v[NR][4];
#pragma unroll
    for (int i = 0; i < NR; ++i) { const GAS f32x4* xr = (const GAS f32x4*)(x + (size_t)(m0 + i * stride) * 1024) + lane;
#pragma unroll
        for (int j = 0; j < 4; ++j) v[i][j] = xr[64 * j]; }
    f32x4 gg[4];
#pragma unroll
    for (int j = 0; j < 4; ++j) gg[j] = ((const GAS f32x4*)g + lane)[64 * j];
#pragma unroll
    for (int i = 0; i < NR; ++i) { float s = 0.f;
#pragma unroll
        for (int j = 0; j < 4; ++j) s += (v[i][j].x * v[i][j].x + v[i][j].y * v[i][j].y) + (v[i][j].z * v[i][j].z + v[i][j].w * v[i][j].w);
        const float r = rsqrtf(wave_sum(s) * (1.f / 1024.f) + RMS_EPS);
        GAS v2u* o8 = (GAS v2u*)(o + (size_t)(m0 + i * stride) * 1024) + lane;
#pragma unroll
        for (int j = 0; j < 4; ++j) { v2u w; w.x = pk2(v[i][j].x * r * gg[j].x, v[i][j].y * r * gg[j].y); w.y = pk2(v[i][j].z * r * gg[j].z, v[i][j].w * r * gg[j].w); o8[64 * j] = w; } }
}
__device__ __forceinline__ float fmax_asm(float a, float b) { float r; asm("v_max_f32 %0, %1, %2" : "=v"(r) : "v"(a), "v"(b)); return r; }
__device__ __forceinline__ float fmin_asm(float a, float b) { float r; asm("v_min_f32 %0, %1, %2" : "=v"(r) : "v"(a), "v"(b)); return r; }

#ifndef PH_MASK
#define PH_MASK 0xFFFFFFFFu
#endif
#define PH(k) ((PH_MASK >> (k)) & 1u)
#ifndef REP_MASK
#define REP_MASK 0u
#endif
#define NREP(k) (((REP_MASK >> (k)) & 1u) ? 2 : 1)
#ifndef DIAG_TS_A
#define DIAG_TS_A -1
#endif
#ifndef DIAG_TS_B
#define DIAG_TS_B -1
#endif
struct Args { const float* in[19]; float* out; unsigned char* ws; };

struct XOrder {
    const char* A; const char* Bt; int G, c, i0, mode;
    __device__ bool next(int i, pg8::Unit& u) const {
        if (i > 0) return false;
        const int L = i0 * G + c; if (L >= 512) return false;
        const int b = L >> 5, head = (L >> 3) & 3, rt = L & 7;
        u.pm = b * 8 + rt; u.pn = head;
        if (mode == 0) { u.a = A + (size_t)(b * 2048 + rt * 256) * 1024 * 2; u.b = Bt + (size_t)(head * 256) * 1024 * 2; }
        else { u.a = A + ((size_t)(b * 2048 + rt * 256) * 1024 + head * 256) * 2;
               u.b = (mode == 2) ? Bt + ((size_t)(head * 256) * 4096 + b * 256) * 2 : Bt + ((size_t)(b * 256) * 1024 + head * 256) * 2; }
        return true;
    }
};

__global__ void __launch_bounds__(NWAVES * 64, 2) mk_fwd(Args args) {
    extern __shared__ __attribute__((aligned(16))) unsigned char lds[];
    LAS unsigned char* L = (LAS unsigned char*)lds;
    volatile LAS unsigned* MISC = (volatile LAS unsigned*)(L + MISC_OFF);
    const int wave = __builtin_amdgcn_readfirstlane((int)threadIdx.x >> 6);
#define PH_LANES int tid = threadIdx.x; asm volatile("" : "+v"(tid)); const int lane = tid & 63; const int gt = vcu * (NWAVES * 64) + tid; (void)lane; (void)gt
    const int G = gridDim.x; const int bx = blockIdx.x; const int vcu = (G % 8 == 0) ? (bx % 8) * (G / 8) + bx / 8 : bx;
    unsigned char* ws = args.ws;
    gu32* ctl = (gu32*)(ws + WS_CTL);
    for (int u = threadIdx.x; u < (LDS_BYTES - LDSCTL_OFF) / 4; u += NWAVES * 64) ((LAS unsigned*)(L + LDSCTL_OFF))[u] = 0u;
    __syncthreads();
    XcdBarrier bar = xcd_barrier_post((unsigned*)(ctl + CW_BAR), MISC + 8);
    unsigned long long* tsw = (unsigned long long*)(ws + WS_CTL + 65536);
    int n_ts = 0;
#define TSTAMP() do { if (DIAG_TS_A >= 0) { if (bx == 0 && threadIdx.x == 0) tsw[n_ts] = __builtin_amdgcn_s_memrealtime(); ++n_ts; } } while (0)
    TSTAMP();

    const float *x = args.in[0], *mem = args.in[1], *g_mix = args.in[2], *w_in = args.in[3], *w_conv = args.in[4], *w_conv_out = args.in[5], *w_attn_out = args.in[6], *w_merge = args.in[7],
                *g_xattn = args.in[8], *g_mem = args.in[9], *w_xq = args.in[10], *w_xkv = args.in[11], *w_xo = args.in[12], *g_ffn = args.in[13], *w_pq = args.in[14], *sub_keys = args.in[15],
                *peer_u = args.in[16], *peer_v = args.in[17], *g_final = args.in[18];
    float* out = args.out;
    bf16 *WinT = (bf16*)(ws + WS_WIN), *WcT = (bf16*)(ws + WS_WC), *WaT = (bf16*)(ws + WS_WA), *WmT = (bf16*)(ws + WS_WM), *WxqT = (bf16*)(ws + WS_WXQ), *WxkvT = (bf16*)(ws + WS_WXKV),
         *WxoT = (bf16*)(ws + WS_WXO), *MT = (bf16*)(ws + WS_MT);
    float* ropec = (float*)(ws + WS_ROPE); float* ropes = ropec + 2048 * 32;
    float* kbar = (float*)(ws + WS_KBAR);
    bf16 *MEMN = (bf16*)(ws + WS_MEMN), *KX = (bf16*)(ws + WS_KX), *VXT = (bf16*)(ws + WS_VXT), *A = (bf16*)(ws + WS_A);
    bf16 *YC = (bf16*)(ws + WS_YC), *QO = (bf16*)(ws + WS_QO), *U = (bf16*)(ws + WS_U), *KB = (bf16*)(ws + WS_K), *VB = (bf16*)(ws + WS_V), *SGC = (bf16*)(ws + WS_SGC), *SGA = (bf16*)(ws + WS_SGA);
    bf16 *QX = (bf16*)(ws + WS_QX), *PM = (bf16*)(ws + WS_PM), *OX = (bf16*)(ws + WS_OX);
    _Float16* SC = (_Float16*)(ws + WS_SC);
    unsigned char* A8I = ws + WS_A8I; float* ASC = (float*)(ws + WS_ASC);
    int* EIDX = (int*)(ws + WS_EIDX); float* GW = (float*)(ws + WS_GW); unsigned* PW = (unsigned*)(ws + WS_PW);
    float* PO = (float*)(ws + WS_PO); float* SSQ1 = (float*)(ws + WS_SSQ1); float* SSQ2 = (float*)(ws + WS_SSQ2); (void)PO;
    unsigned char* U8 = ws + WS_U8; unsigned char* V8T = ws + WS_V8T; float* SU = (float*)(ws + WS_SU); float* SV = (float*)(ws + WS_SV);
    const int gw = vcu * NWAVES + wave, NGW = G * NWAVES;
    const int NGT = G * NWAVES * 64;

    asm volatile("; ===== PHASE 0 =====");
    if (PH(0)) for (int rep = 0; rep < NREP(0); ++rep) {
        PH_LANES; const bool dummy = rep < NREP(0) - 1; (void)dummy;
        LAS float* scr = (LAS float*)(L + RING_OFF + wave * 16384);
        constexpr int I_IN = (1024 / 64) * (5120 / 32), I_C = (512 / 64) * (1024 / 32), I_M = (1024 / 64) * (1024 / 32), I_KV = (1024 / 64) * (2048 / 32);
        constexpr int NITEMS = I_IN + 2 * I_C + 3 * I_M + I_KV;
        for (int it = gw; it < NITEMS; it += NGW) {
            int r = it;
            if (r < I_IN) { p0_transpose_item<MapWin>(w_in, 1024, 5120, 5120, WinT, scr, r, lane); continue; } r -= I_IN;
            if (r < I_C) { p0_transpose_item<MapId>(w_conv_out, 512, 1024, 1024, WcT, scr, r, lane); continue; } r -= I_C;
            if (r < I_C) { p0_transpose_item<MapId>(w_attn_out, 512, 1024, 1024, WaT, scr, r, lane); continue; } r -= I_C;
            if (r < I_M) { p0_transpose_item<MapId>(w_merge, 1024, 1024, 1024, WmT, scr, r, lane); continue; } r -= I_M;
            if (r < I_M) { p0_transpose_item<MapId>(w_xq, 1024, 1024, 1024, WxqT, scr, r, lane, g_xattn); continue; } r -= I_M;
            if (r < I_M) { p0_transpose_item<MapId>(w_xo, 1024, 1024, 1024, WxoT, scr, r, lane); continue; } r -= I_M;
            p0_transpose_item<MapId>(w_xkv, 1024, 2048, 2048, WxkvT, scr, r, lane);
        }
        { int m = gw; for (; m + 3 * NGW < T; m += 4 * NGW) rms_rows_to_bf16<4>(x, g_mix, A, m, NGW, lane); for (; m < T; m += NGW) rms_row_to_bf16(x + (size_t)m * D, g_mix, A + (size_t)m * D, lane); }
        { int m = gw; for (; m + NGW < MEMROWS; m += 2 * NGW) rms_rows_to_bf16<2>(mem, g_mem, MEMN, m, NGW, lane); for (; m < MEMROWS; m += NGW) rms_row_to_bf16(mem + (size_t)m * D, g_mem, MEMN + (size_t)m * D, lane); }
        for (int i = gt; i < 2048 * 32; i += NGT) { const int pos = i >> 5, f = i & 31; const float inv = powf(10000.0f, -(float)f / 32.0f); const float ang = (float)pos * inv; ropec[i] = cosf(ang); ropes[i] = sinf(ang); }
        __syncthreads();
        {
            LAS float* skl = (LAS float*)(L + RING_OFF);
            LAS float* wtl = skl + 128 * 129;
            for (int it = bx; it < 256; it += G) {
                const int hp = it >> 4, cb = it & 15;
                for (int i = tid; i < 128 * 128; i += NWAVES * 64) { const int n = i >> 7, d = i & 127; skl[n * 129 + d] = sub_keys[((size_t)hp * 128 + n) * 128 + d]; }
                for (int i = tid; i < 64 * 128; i += NWAVES * 64) { const int c = i >> 7, d = i & 127; wtl[c * 129 + d] = w_pq[(size_t)(cb * 64 + c) * 2048 + hp * 128 + d] * g_ffn[cb * 64 + c]; }
                __syncthreads();
                const int cg = tid & 15, ng = tid >> 4;
                float acc[4][4];
#pragma unroll
                for (int i = 0; i < 4; ++i)
#pragma unroll
                    for (int j = 0; j < 4; ++j) acc[i][j] = 0.f;
                for (int d = 0; d < 128; ++d) {
                    float wv[4], sv[4];
#pragma unroll
                    for (int i = 0; i < 4; ++i) { wv[i] = wtl[(4 * cg + i) * 129 + d]; sv[i] = skl[(4 * ng + i) * 129 + d]; }
#pragma unroll
                    for (int i = 0; i < 4; ++i)
#pragma unroll
                        for (int j = 0; j < 4; ++j) acc[i][j] += sv[i] * wv[j];
                }
#pragma unroll
                for (int i = 0; i < 4; ++i) { v2u w; w.x = pk2(acc[i][0], acc[i][1]); w.y = pk2(acc[i][2], acc[i][3]); *(GAS v2u*)(MT + (size_t)(hp * 128 + 4 * ng + i) * 1024 + cb * 64 + 4 * cg) = w; }
                __syncthreads();
            }
        }
    }
    xcd_barrier(bar); TSTAMP();

    asm volatile("; ===== PHASE 1 =====");
    if (PH(1)) for (int rep = 0; rep < NREP(1); ++rep) {
        PH_LANES; const bool dummy = rep < NREP(1) - 1; (void)dummy;
        pg8::Gemm g{1024, 1024, 1024}; pg8::StaticOrder S; S.init(A, 1024, WinT, 1024, T, INW, G, bx);
        pg8::EpiIn E{U, YC, QO, KB, VB, SGC, SGA, ropec, ropes, kbar, 0.125f * 1.4426950408889634f};
        pg8::gemm_phase<pg8::EpiIn, pg8::StaticOrder, true>(L + RING_OFF, g, S, E);
    }
    if (PH(1)) for (int rep = 0; rep < NREP(1); ++rep) {
        PH_LANES; const bool dummy = rep < NREP(1) - 1; (void)dummy;
        pg8::Gemm g{1024, 1024, 1024}; pg8::StaticOrder S; S.init(MEMN, 1024, WxkvT, 1024, MEMROWS, 1024, G, bx);
        pg8::EpiBf16 E{KX, 1024};
        pg8::gemm_phase<pg8::EpiBf16, pg8::StaticOrder, true>(L + RING_OFF, g, S, E);
    }
    if (PH(1)) for (int rep = 0; rep < NREP(1); ++rep) {
        PH_LANES; const bool dummy = rep < NREP(1) - 1; (void)dummy;
        pg8::Gemm g{1024, 1024, 1024}; pg8::StaticOrder S; S.init(WxkvT + (size_t)1024 * 1024, 1024, MEMN, 1024, 1024, MEMROWS, G, (bx + 128) % G);
        pg8::EpiBf16 E{VXT, 4096};
        pg8::gemm_phase<pg8::EpiBf16, pg8::StaticOrder, true>(L + RING_OFF, g, S, E);
    }
    if (PH(1)) for (int rep = 0; rep < NREP(1); ++rep) {
        PH_LANES; const bool dummy = rep < NREP(1) - 1; (void)dummy;
        int cb, ncb;
        if (G == 256) { const bool idle = (bx >= 64 && bx < 128) || bx >= 192; cb = idle ? ((bx < 128) ? bx - 64 : bx - 128) : 256; ncb = 128; } else { cb = bx; ncb = G; }
        const int cw = cb * NWAVES + wave, ncw = ncb * NWAVES;
        for (int e = (cb < ncb ? cw : 16384); e < 16384; e += ncw) {
            const GAS f32x4* r = (const GAS f32x4*)(peer_u + (size_t)e * D) + lane; f32x4 v[4]; float am = 0.f;
#pragma unroll
            for (int j = 0; j < 4; ++j) { v[j] = r[64 * j] * ((const GAS f32x4*)g_ffn + lane)[64 * j]; am = fmaxf(fmaxf(am, fmaxf(fabsf(v[j].x), fabsf(v[j].y))), fmaxf(fabsf(v[j].z), fabsf(v[j].w))); }
            am = wave_max(am);
            const float sc = am > 0.f ? 127.f / am : 1.f; if (lane == 0) SU[e] = am > 0.f ? am * (1.f / 127.f) : 1.f;
#pragma unroll
            for (int j = 0; j < 4; ++j) { const unsigned w = ((unsigned)(int)rintf(v[j].x * sc) & 255u) | (((unsigned)(int)rintf(v[j].y * sc) & 255u) << 8) | (((unsigned)(int)rintf(v[j].z * sc) & 255u) << 16) | (((unsigned)(int)rintf(v[j].w * sc) & 255u) << 24);
                *(GAS unsigned*)(U8 + (size_t)e * 1024 + 4 * lane + 256 * j) = w; }
        }
        __syncthreads();
        for (int it = cb; it < 256; it += ncb) {
            const int e0 = it * 64;
#pragma unroll 1
            for (int rr = 0; rr < 8; ++rr) {
                const int el = wave * 8 + rr, e = e0 + el;
                const GAS f32x4* r = (const GAS f32x4*)(peer_v + (size_t)e * D) + lane; f32x4 v[4]; float am = 0.f;
#pragma unroll
                for (int j = 0; j < 4; ++j) { v[j] = r[64 * j]; am = fmaxf(fmaxf(am, fmaxf(fabsf(v[j].x), fabsf(v[j].y))), fmaxf(fabsf(v[j].z), fabsf(v[j].w))); }
                am = wave_max(am);
                const float sc = am > 0.f ? 4.f / am : 1.f; if (lane == 0) SV[e] = am > 0.f ? am * 0.25f : 1.f;
#pragma unroll
                for (int j = 0; j < 4; ++j) { int w = __builtin_amdgcn_cvt_pk_bf8_f32(v[j].x * sc, v[j].y * sc, 0, false); w = __builtin_amdgcn_cvt_pk_bf8_f32(v[j].z * sc, v[j].w * sc, w, true);
                    *(LAS unsigned*)(L + RING_OFF + el * 1024 + 4 * lane + 256 * j) = (unsigned)w; }
            }
            __syncthreads();
#pragma unroll
            for (int i = 0; i < 8; ++i) { const int idx = tid + 512 * i, sl = idx >> 5, k = idx & 31;
                const v2u a0 = *(const LAS v2u*)(L + RING_OFF + (2 * k) * 1024 + sl * 8), a1 = *(const LAS v2u*)(L + RING_OFF + (2 * k + 1) * 1024 + sl * 8);
                *(GAS v4u*)(V8T + ((size_t)sl * 16384 + e0 + 2 * k) * 8) = (v4u){a0.x, a0.y, a1.x, a1.y}; }
            __syncthreads();
        }
    }
    xcd_barrier(bar); TSTAMP();

    asm volatile("; ===== PHASE 2 =====");
    if (PH(2)) for (int rep = 0; rep < NREP(2); ++rep) {
        PH_LANES; const bool dummy = rep < NREP(2) - 1; (void)dummy;
        for (int i = gt; i < T * 64; i += NGT) {
            const int row = i >> 6, cg = i & 63, s = row & 2047;
            const v4u u0 = *(const GAS v4u*)(U + (size_t)row * 512 + cg * 8);
            v4u u1 = (v4u){0u, 0u, 0u, 0u}, u2 = (v4u){0u, 0u, 0u, 0u};
            if (s >= 1) u1 = *(const GAS v4u*)(U + (size_t)(row - 1) * 512 + cg * 8);
            if (s >= 2) u2 = *(const GAS v4u*)(U + (size_t)(row - 2) * 512 + cg * 8);
            const v4u bq = *(const GAS v4u*)(YC + (size_t)row * 512 + cg * 8);
            const f32x4 w0a = *(const GAS f32x4*)(w_conv + cg * 8), w0b = *(const GAS f32x4*)(w_conv + cg * 8 + 4);
            const f32x4 w1a = *(const GAS f32x4*)(w_conv + 512 + cg * 8), w1b = *(const GAS f32x4*)(w_conv + 512 + cg * 8 + 4);
            const f32x4 w2a = *(const GAS f32x4*)(w_conv + 1024 + cg * 8), w2b = *(const GAS f32x4*)(w_conv + 1024 + cg * 8 + 4);
            v4u o;
#define CONV2(q, wa, ia, ib) pk2(bflo(bq.q) * (w0##wa[ia] * bflo(u2.q) + w1##wa[ia] * bflo(u1.q) + w2##wa[ia] * bflo(u0.q)), bfhi(bq.q) * (w0##wa[ib] * bfhi(u2.q) + w1##wa[ib] * bfhi(u1.q) + w2##wa[ib] * bfhi(u0.q)))
            o.x = CONV2(x, a, 0, 1); o.y = CONV2(y, a, 2, 3); o.z = CONV2(z, b, 0, 1); o.w = CONV2(w, b, 2, 3);
#undef CONV2
            { const bool conv_dummy = (NREP(2) == 2) && !dummy; *(GAS v4u*)(YC + (size_t)row * 512 + cg * 8) = conv_dummy ? bq : o; }
        }
        __syncthreads();
        const attn_body::AttnTensors AT{(const attn_body::bf16*)QO, (const attn_body::bf16*)KB, (const attn_body::bf16*)VB, (attn_body::bf16*)(dummy ? A : QO), kbar};
        const attn_body::StaticOrder S(G, bx);
        attn_body::attn_phase<attn_body::StaticOrder>((char*)lds + RING_OFF, AT, S);
    }
    xcd_barrier(bar); TSTAMP();

    asm volatile("; ===== PHASE 3 =====");
    if (PH(3)) for (int rep = 0; rep < NREP(3); ++rep) {
        PH_LANES; const bool dummy = rep < NREP(3) - 1; (void)dummy;
        pg8::Gemm g{512, 512, 512}; pg8::StaticOrder S; S.init(YC, 512, WcT, 512, T, 1024, G, bx);
        pg8::EpiGateMul E{SGC, dummy ? A : SGC, 1024};
        pg8::gemm_phase<pg8::EpiGateMul, pg8::StaticOrder, true>(L + RING_OFF, g, S, E);
    }
    if (PH(3)) for (int rep = 0; rep < NREP(3); ++rep) {
        PH_LANES; const bool dummy = rep < NREP(3) - 1; (void)dummy;
        pg8::Gemm g{512, 512, 512}; pg8::StaticOrder S; S.init(QO, 512, WaT, 512, T, 1024, G, bx);
        pg8::EpiGateFma E{SGC, SGA, dummy ? A : SGA, 1024};
        pg8::gemm_phase<pg8::EpiGateFma, pg8::StaticOrder, true>(L + RING_OFF, g, S, E);
    }
    xcd_barrier(bar); TSTAMP();

    asm volatile("; ===== PHASE 4 =====");
    if (PH(4)) for (int rep = 0; rep < NREP(4); ++rep) {
        PH_LANES; const bool dummy = rep < NREP(4) - 1; (void)dummy;
        pg8::Gemm g{1024, 1024, 1024}; pg8::StaticOrder S; S.init(SGA, 1024, WmT, 1024, T, 1024, G, bx);
        pg8::EpiResNorm<true> E{x, A, SSQ1, 1024, 1.f};
        pg8::gemm_phase<pg8::EpiResNorm<true>, pg8::StaticOrder, true>(L + RING_OFF, g, S, E);
    }
    xcd_barrier(bar); TSTAMP();

    asm volatile("; ===== PHASE 6 =====");
    if (PH(6)) for (int rep = 0; rep < NREP(6); ++rep) {
        PH_LANES; const bool dummy = rep < NREP(6) - 1; (void)dummy;
        const pg8::Gemm gq{1024, 1024, 1024}, gs{1024, 1024, 256}, gv{1024, 4096, 256};
        const pg8::EpiBf16RS Eq{QX, 1024, SSQ1}; const pg8::EpiSoftmax Es{PM, 1024, 0.0625f * 1.4426950408889634f}; const pg8::EpiBf16 Ev{OX, 1024};
        { XOrder S{(const char*)A, (const char*)WxqT, G, vcu, 0, 0}; pg8::gemm_phase<pg8::EpiBf16RS, XOrder, false>(L + RING_OFF, gq, S, Eq); }
        VM_WAIT(); __syncthreads();
        { XOrder S{(const char*)QX, (const char*)KX, G, vcu, 0, 1}; pg8::gemm_phase<pg8::EpiSoftmax, XOrder, false>(L + RING_OFF, gs, S, Es); }
        VM_WAIT(); __syncthreads();
        { XOrder S{(const char*)PM, (const char*)VXT, G, vcu, 0, 2}; pg8::gemm_phase<pg8::EpiBf16, XOrder, false>(L + RING_OFF, gv, S, Ev); }
        VM_WAIT(); __syncthreads();
        { XOrder S{(const char*)A, (const char*)WxqT, G, vcu, 1, 0}; pg8::gemm_phase<pg8::EpiBf16RS, XOrder, false>(L + RING_OFF, gq, S, Eq); }
        VM_WAIT(); __syncthreads();
        { XOrder S{(const char*)QX, (const char*)KX, G, vcu, 1, 1}; pg8::gemm_phase<pg8::EpiSoftmax, XOrder, false>(L + RING_OFF, gs, S, Es); }
        VM_WAIT(); __syncthreads();
        { XOrder S{(const char*)PM, (const char*)VXT, G, vcu, 1, 2}; pg8::gemm_phase<pg8::EpiBf16, XOrder, false>(L + RING_OFF, gv, S, Ev); }
    }
    xcd_barrier(bar); TSTAMP();

    asm volatile("; ===== PHASE 9 =====");
    if (PH(9)) for (int rep = 0; rep < NREP(9); ++rep) {
        PH_LANES; const bool dummy = rep < NREP(9) - 1; (void)dummy;
        pg8::Gemm g{1024, 1024, 1024}; pg8::StaticOrder S; S.init(OX, 1024, WxoT, 1024, T, 1024, G, bx);
        pg8::EpiResNorm<false> E{nullptr, A, SSQ2, 1024, dummy ? 0.f : 1.f};
        pg8::gemm_phase<pg8::EpiResNorm<false>, pg8::StaticOrder, true>(L + RING_OFF, g, S, E);
    }
    xcd_barrier(bar); TSTAMP();

    asm volatile("; ===== PHASE 11 =====");
    if (PH(11)) for (int rep = 0; rep < NREP(11); ++rep) {
        PH_LANES; const bool dummy = rep < NREP(11) - 1; (void)dummy;
        pg8::Gemm g{1024, 1024, 1024}; pg8::StaticOrder S; S.init(A, 1024, MT, 1024, T, 2048, G, bx);
        pg8::EpiF16RS E{SC, 2048, SSQ2};
        pg8::gemm_phase<pg8::EpiF16RS, pg8::StaticOrder, true>(L + RING_OFF, g, S, E);
    }
    xcd_barrier(bar); TSTAMP();

    asm volatile("; ===== PHASE 12 =====");
    if (PH(12)) for (int rep = 0; rep < NREP(12); ++rep) {
        PH_LANES; const bool dummy = rep < NREP(12) - 1; (void)dummy;
        typedef _Float16 h8 __attribute__((ext_vector_type(8)));
#define RCE(a, b) do { const float hi_ = fmax_asm(a, b); b = fmin_asm(a, b); a = hi_; } while (0)
#define RSORT16(K) do { RCE(K[0], K[1]); RCE(K[3], K[2]); RCE(K[4], K[5]); RCE(K[7], K[6]); RCE(K[8], K[9]); RCE(K[11], K[10]); RCE(K[12], K[13]); RCE(K[15], K[14]); RCE(K[0], K[2]); RCE(K[1], K[3]); RCE(K[6], K[4]); RCE(K[7], K[5]); RCE(K[8], K[10]); RCE(K[9], K[11]); RCE(K[14], K[12]); RCE(K[15], K[13]); RCE(K[0], K[1]); RCE(K[2], K[3]); RCE(K[5], K[4]); RCE(K[7], K[6]); RCE(K[8], K[9]); RCE(K[10], K[11]); RCE(K[13], K[12]); RCE(K[15], K[14]); RCE(K[0], K[4]); RCE(K[1], K[5]); RCE(K[2], K[6]); RCE(K[3], K[7]); RCE(K[12], K[8]); RCE(K[13], K[9]); RCE(K[14], K[10]); RCE(K[15], K[11]); RCE(K[0], K[2]); RCE(K[1], K[3]); RCE(K[4], K[6]); RCE(K[5], K[7]); RCE(K[10], K[8]); RCE(K[11], K[9]); RCE(K[14], K[12]); RCE(K[15], K[13]); RCE(K[0], K[1]); RCE(K[2], K[3]); RCE(K[4], K[5]); RCE(K[6], K[7]); RCE(K[9], K[8]); RCE(K[11], K[10]); RCE(K[13], K[12]); RCE(K[15], K[14]); RCE(K[0], K[8]); RCE(K[1], K[9]); RCE(K[2], K[10]); RCE(K[3], K[11]); RCE(K[4], K[12]); RCE(K[5], K[13]); RCE(K[6], K[14]); RCE(K[7], K[15]); RCE(K[0], K[4]); RCE(K[1], K[5]); RCE(K[2], K[6]); RCE(K[3], K[7]); RCE(K[8], K[12]); RCE(K[9], K[13]); RCE(K[10], K[14]); RCE(K[11], K[15]); RCE(K[0], K[2]); RCE(K[1], K[3]); RCE(K[4], K[6]); RCE(K[5], K[7]); RCE(K[8], K[10]); RCE(K[9], K[11]); RCE(K[12], K[14]); RCE(K[13], K[15]); RCE(K[0], K[1]); RCE(K[2], K[3]); RCE(K[4], K[5]); RCE(K[6], K[7]); RCE(K[8], K[9]); RCE(K[10], K[11]); RCE(K[12], K[13]); RCE(K[14], K[15]); } while (0)
#define RMERGE16(K) do { RCE(K[0], K[8]); RCE(K[1], K[9]); RCE(K[2], K[10]); RCE(K[3], K[11]); RCE(K[4], K[12]); RCE(K[5], K[13]); RCE(K[6], K[14]); RCE(K[7], K[15]); RCE(K[0], K[4]); RCE(K[1], K[5]); RCE(K[2], K[6]); RCE(K[3], K[7]); RCE(K[8], K[12]); RCE(K[9], K[13]); RCE(K[10], K[14]); RCE(K[11], K[15]); RCE(K[0], K[2]); RCE(K[1], K[3]); RCE(K[4], K[6]); RCE(K[5], K[7]); RCE(K[8], K[10]); RCE(K[9], K[11]); RCE(K[12], K[14]); RCE(K[13], K[15]); RCE(K[0], K[1]); RCE(K[2], K[3]); RCE(K[4], K[5]); RCE(K[6], K[7]); RCE(K[8], K[9]); RCE(K[10], K[11]); RCE(K[12], K[13]); RCE(K[14], K[15]); } while (0)
#define RKEYS(K, V0, V1, IDB) do { _Pragma("unroll") for (int e = 0; e < 8; ++e) { K[e] = __uint_as_float(__float_as_uint((float)V0[e]) | (unsigned)((IDB) + e)); K[8 + e] = __uint_as_float(__float_as_uint((float)V1[e]) | (unsigned)((IDB) + 8 + e)); } } while (0)
        for (int tb4 = gw * 4; tb4 < T; tb4 += NGW * 4) {
            v4u r0[4], r1[4]; float sq[4];
#pragma unroll
            for (int i = 0; i < 4; ++i) { const GAS v4u* ar = (const GAS v4u*)(A + (size_t)(tb4 + i) * D + 16 * lane); r0[i] = ar[0]; r1[i] = ar[1]; sq[i] = lane < 16 ? SSQ2[(size_t)(tb4 + i) * 16 + lane] : 0.f; }
#pragma unroll
            for (int i = 0; i < 4; ++i) {
                float a[16];
                a[0] = bflo(r0[i].x); a[1] = bfhi(r0[i].x); a[2] = bflo(r0[i].y); a[3] = bfhi(r0[i].y); a[4] = bflo(r0[i].z); a[5] = bfhi(r0[i].z); a[6] = bflo(r0[i].w); a[7] = bfhi(r0[i].w);
                a[8] = bflo(r1[i].x); a[9] = bfhi(r1[i].x); a[10] = bflo(r1[i].y); a[11] = bfhi(r1[i].y); a[12] = bflo(r1[i].z); a[13] = bfhi(r1[i].z); a[14] = bflo(r1[i].w); a[15] = bfhi(r1[i].w);
                float amx = 0.f;
#pragma unroll
                for (int k = 0; k < 16; ++k) amx = fmaxf(amx, fabsf(a[k]));
                amx = wave_max(amx);
                const float rs2 = rsqrtf(wave_sum(sq[i]) * (1.f / 1024.f) + RMS_EPS);
                const float asc = amx > 0.f ? 127.f / amx : 1.f;
                v4u qv;
#define QP4(k) (((unsigned)(int)rintf(a[4 * (k)] * asc) & 255u) | (((unsigned)(int)rintf(a[4 * (k) + 1] * asc) & 255u) << 8) | (((unsigned)(int)rintf(a[4 * (k) + 2] * asc) & 255u) << 16) | (((unsigned)(int)rintf(a[4 * (k) + 3] * asc) & 255u) << 24))
                qv.x = QP4(0); qv.y = QP4(1); qv.z = QP4(2); qv.w = QP4(3);
#undef QP4
                *(GAS v4u*)(A8I + (size_t)(tb4 + i) * 1024 + 16 * lane) = qv;
                if (lane == 0) ASC[tb4 + i] = (amx > 0.f ? amx * (1.f / 127.f) : 1.f) * rs2;
            }
        }
        LAS unsigned char* idl = L + RING_OFF + tid * 32;
        for (int task = gt; task < T * 8; task += NGT) {
            const int t = task >> 3, h = task & 7;
            const _Float16* row = SC + (size_t)t * 2048 + h * 256;
            float LA[16], LB[16];
#pragma unroll 1
            for (int p = 0; p < 2; ++p) {
                const _Float16* rp = row + p * 128;
                float Tk[16];
                h8 n0 = *(const h8*)(rp + 16), n1 = *(const h8*)(rp + 24);
                { const h8 v0 = *(const h8*)rp, v1 = *(const h8*)(rp + 8); RKEYS(Tk, v0, v1, 0); RSORT16(Tk); }
#pragma unroll 1
                for (int c = 1; c < 8; ++c) {
                    const h8 v0 = n0, v1 = n1;
                    { const int cn = c < 7 ? c + 1 : c; n0 = *(const h8*)(rp + cn * 16); n1 = *(const h8*)(rp + cn * 16 + 8); }
                    float K[16]; RKEYS(K, v0, v1, c * 16); RSORT16(K);
#pragma unroll
                    for (int i = 0; i < 16; ++i) Tk[i] = fmax_asm(Tk[i], K[15 - i]);
                    RMERGE16(Tk);
                }
#pragma unroll
                for (int k = 0; k < 16; ++k) { if (p == 0) LA[k] = Tk[k]; else LB[k] = Tk[k]; }
            }
#pragma unroll
            for (int k = 0; k < 16; k += 4) {
                ((LAS unsigned*)idl)[k >> 2] = (__float_as_uint(LA[k]) & 127u) | ((__float_as_uint(LA[k + 1]) & 127u) << 8) | ((__float_as_uint(LA[k + 2]) & 127u) << 16) | ((__float_as_uint(LA[k + 3]) & 127u) << 24);
                ((LAS unsigned*)idl)[4 + (k >> 2)] = (__float_as_uint(LB[k]) & 127u) | ((__float_as_uint(LB[k + 1]) & 127u) << 8) | ((__float_as_uint(LB[k + 2]) & 127u) << 16) | ((__float_as_uint(LB[k + 3]) & 127u) << 24);
            }
#define CKEY(a, b) __uint_as_float((__float_as_uint(LA[a] + LB[b]) & ~255u) | (unsigned)(255 - (16 * (a) + (b))))
            float Ck[16];
#pragma unroll
            for (int a = 0; a < 16; ++a) Ck[a] = CKEY(a, 0);
#define CRUN(b, n) do { _Pragma("unroll") for (int j = 0; j < (n); ++j) Ck[15 - j] = fmax_asm(Ck[15 - j], CKEY(j, b)); RMERGE16(Ck); } while (0)
            CRUN(1, 8); CRUN(2, 5); CRUN(3, 4); CRUN(4, 3); CRUN(5, 2); CRUN(6, 2); CRUN(7, 2);
#pragma unroll
            for (int j = 0; j < 8; ++j) Ck[15 - j] = fmax_asm(Ck[15 - j], CKEY(0, 8 + j));
            RMERGE16(Ck);
#undef CRUN
#undef CKEY
            LDS_WAIT();
            float ex[16]; float sum = 0.f;
#pragma unroll
            for (int k = 0; k < 16; ++k) { ex[k] = __expf(Ck[k] - Ck[0]); sum += ex[k]; }
            const float rs = 1.f / sum;
            int* eo = EIDX + (size_t)t * 128 + h * 16;
#pragma unroll
            for (int k = 0; k < 16; k += 4) {
                int ev[4];
#pragma unroll
                for (int j = 0; j < 4; ++j) { const unsigned id = 255u - (__float_as_uint(Ck[k + j]) & 255u); ev[j] = (int)idl[id >> 4] * 128 + (int)idl[16 + (id & 15u)]; }
                *(GAS v4u*)(eo + k) = (v4u){(pk2(0.f, ex[k] * rs) & 0xffff0000u) | (unsigned)ev[0], (pk2(0.f, ex[k + 1] * rs) & 0xffff0000u) | (unsigned)ev[1],
                                             (pk2(0.f, ex[k + 2] * rs) & 0xffff0000u) | (unsigned)ev[2], (pk2(0.f, ex[k + 3] * rs) & 0xffff0000u) | (unsigned)ev[3]};
            }
            LDS_WAIT();
        }
#undef RCE
#undef RSORT16
#undef RMERGE16
#undef RKEYS
    }
    xcd_barrier(bar); TSTAMP();

    asm volatile("; ===== PHASE 13 =====");
    if (PH(13)) for (int rep = 0; rep < NREP(13); ++rep) {
        PH_LANES; const bool dummy = rep < NREP(13) - 1; (void)dummy;
        volatile LAS unsigned* qslot = (volatile LAS unsigned*)(L + LDSCTL_OFF + 64);
        LAS unsigned char* tile = L + RING_OFF + wave * 8192;
        LAS float* rsl = (LAS float*)(L + UL_OFF + wave * UL_WAVE);
        LAS v4u* lst = (LAS v4u*)(L + UL_OFF + wave * UL_WAVE + 64);
        const int xs = (int)(xb_xcc_id() & 7u);
        __syncthreads();
        if (tid == 0) *qslot = __hip_atomic_fetch_add((unsigned*)(ctl + CW_Q + 64 * (rep * 8 + xs)), 1u, __ATOMIC_RELAXED, __HIP_MEMORY_SCOPE_AGENT);
        __syncthreads();
        const int rank = __builtin_amdgcn_readfirstlane((int)*qslot);
        int cnt[8];
#pragma unroll
        for (int j = 0; j < 8; ++j) cnt[j] = __builtin_amdgcn_readfirstlane((int)(xb_ld(bar.bar + XB_XCNT(j)) + xb_ld(bar.bar + XB_XCNT(j + 8))));
#pragma unroll 1
        for (int x = 0; x < 8; ++x) {
            int cn = 0;
#pragma unroll
            for (int j = 0; j < 8; ++j) cn = (j == x) ? cnt[j] : cn;
            int j0, jstep;
            if (x == xs) { j0 = rank * 8 + wave; jstep = cn * 8; } else if (cn == 0) { j0 = bx * 8 + wave; jstep = G * 8; } else continue;
#pragma unroll 1
            for (int job = j0; job < T / 8; job += jstep) {
                const int t0 = job * 8;
#pragma unroll 1
                for (int r0 = 0;; r0 += UL_CAP) {
                    int ln = lane; asm volatile("" : "+v"(ln));
#pragma unroll
                    for (int tl = 0; tl < 8; ++tl)
                        __builtin_amdgcn_global_load_lds((const unsigned*)(A8I + (size_t)(t0 + tl) * 1024 + ln * 16), (LAS unsigned*)(tile + tl * 1024), 16, 0, 0);
                    if (ln < 8) rsl[ln] = ASC[t0 + ln];
                    unsigned pa[8], pb[8];
#pragma unroll
                    for (int tl = 0; tl < 8; ++tl) { pa[tl] = (unsigned)EIDX[(size_t)(t0 + tl) * 128 + ln]; pb[tl] = (unsigned)EIDX[(size_t)(t0 + tl) * 128 + 64 + ln]; }
                    int total = 0; unsigned long long m0s[8], m1s[8];
#pragma unroll
                    for (int tl = 0; tl < 8; ++tl) { m0s[tl] = __ballot((int)((pa[tl] & 0xffffu) >> 11) == x); m1s[tl] = __ballot((int)((pb[tl] & 0xffffu) >> 11) == x); total += __popcll(m0s[tl]) + __popcll(m1s[tl]); }
                    float sua[8], sva[8], sub[8], svb[8];
#pragma unroll
                    for (int tl = 0; tl < 8; ++tl) { sua[tl] = sva[tl] = sub[tl] = svb[tl] = 0.f;
                        if ((m0s[tl] >> lane) & 1ull) { sua[tl] = SU[pa[tl] & 0xffffu]; sva[tl] = SV[pa[tl] & 0xffffu]; }
                        if ((m1s[tl] >> lane) & 1ull) { sub[tl] = SU[pb[tl] & 0xffffu]; svb[tl] = SV[pb[tl] & 0xffffu]; } }
                    asm volatile("s_waitcnt vmcnt(0) lgkmcnt(0)" ::: "memory");
                    int base = -r0;
#pragma unroll
                    for (int tl = 0; tl < 8; ++tl) {
                        const int n0 = __popcll(m0s[tl]), n1 = __popcll(m1s[tl]); const float rs = rsl[tl];
                        const int k0 = base + (int)__builtin_amdgcn_mbcnt_hi((unsigned)(m0s[tl] >> 32), __builtin_amdgcn_mbcnt_lo((unsigned)m0s[tl], 0u));
                        const int k1 = base + n0 + (int)__builtin_amdgcn_mbcnt_hi((unsigned)(m1s[tl] >> 32), __builtin_amdgcn_mbcnt_lo((unsigned)m1s[tl], 0u));
                        if (((m0s[tl] >> lane) & 1ull) && k0 >= 0 && k0 < UL_CAP) lst[k0] = (v4u){pa[tl], (unsigned)((tl << 7) | lane), __float_as_uint(sua[tl] * rs), __float_as_uint(__uint_as_float(pa[tl] & 0xffff0000u) * sva[tl])};
                        if (((m1s[tl] >> lane) & 1ull) && k1 >= 0 && k1 < UL_CAP) lst[k1] = (v4u){pb[tl], (unsigned)((tl << 7) | 64 | lane), __float_as_uint(sub[tl] * rs), __float_as_uint(__uint_as_float(pb[tl] & 0xffff0000u) * svb[tl])};
                        base += n0 + n1;
                    }
                    const int count = (total - r0) < UL_CAP ? (total - r0) : UL_CAP;
                    asm volatile("s_waitcnt lgkmcnt(0)" ::: "memory");
#define JLOAD(Q, EN, B16) do { const int myi_ = (B16) + (lane & 15); EN = lst[myi_ < count ? myi_ : count - 1];         \
                        _Pragma("unroll") for (int k = 0; k < 16; ++k) { const int e_ = __builtin_amdgcn_readlane((int)EN.x, k) & 0xffff; Q[k] = *(const GAS v4u*)(U8 + (size_t)e_ * 1024 + 16 * lane); } } while (0)
#define JCOMP(Q, EN, B16) do { int d[16]; \
                        _Pragma("unroll") for (int k = 0; k < 16; ++k) { const int tl_ = __builtin_amdgcn_readlane((int)EN.y, k) >> 7; const v4u qa_ = *(const LAS v4u*)(tile + tl_ * 1024 + lane * 16); \
                            d[k] = __builtin_amdgcn_sdot4((int)Q[k].w, (int)qa_.w, __builtin_amdgcn_sdot4((int)Q[k].z, (int)qa_.z, __builtin_amdgcn_sdot4((int)Q[k].y, (int)qa_.y, __builtin_amdgcn_sdot4((int)Q[k].x, (int)qa_.x, 0, false), false), false), false); } \
                        int r8[8], r4[4], r2[2]; \
                        _Pragma("unroll") for (int i = 0; i < 8; ++i) { auto sw = __builtin_amdgcn_permlane32_swap((unsigned)d[i], (unsigned)d[i + 8], false, false); r8[i] = (int)(sw[0] + sw[1]); } \
                        _Pragma("unroll") for (int i = 0; i < 4; ++i) { auto sw = __builtin_amdgcn_permlane16_swap((unsigned)r8[i], (unsigned)r8[i + 4], false, false); r4[i] = (int)(sw[0] + sw[1]); } \
                        const bool b3 = (lane >> 3) & 1, b2 = (lane >> 2) & 1; \
                        _Pragma("unroll") for (int i = 0; i < 2; ++i) { const int keep = b3 ? r4[i + 2] : r4[i], send = b3 ? r4[i] : r4[i + 2]; r2[i] = keep + __builtin_amdgcn_ds_swizzle(send, (8 << 10) | 0x1f); } \
                        int doti; { const int keep = b2 ? r2[1] : r2[0], send = b2 ? r2[0] : r2[1]; doti = keep + __builtin_amdgcn_ds_swizzle(send, (4 << 10) | 0x1f); } \
                        doti += __builtin_amdgcn_ds_swizzle(doti, (2 << 10) | 0x1f); doti += __builtin_amdgcn_ds_swizzle(doti, (1 << 10) | 0x1f); \
                          \
                        const int sl_ = (lane >> 2) * 4; \
                        const unsigned ex = (unsigned)__builtin_amdgcn_ds_bpermute(sl_, (int)EN.x), ey = (unsigned)__builtin_amdgcn_ds_bpermute(sl_, (int)EN.y); \
                        const float eus = __uint_as_float((unsigned)__builtin_amdgcn_ds_bpermute(sl_, (int)EN.z)), evs = __uint_as_float((unsigned)__builtin_amdgcn_ds_bpermute(sl_, (int)EN.w)); \
                        if ((lane & 3) == 0 && (B16) + (lane >> 2) < count) { \
                            const int e = (int)(ex & 0xffffu), slot = (int)(ey & 127u); const int t = t0 + (int)(ey >> 7); \
                            const float act = (float)doti * eus; const float u3 = 0.7978845608028654f * (act + 0.044715f * act * act * act); \
                            const float wv = act * __builtin_amdgcn_rcpf(1.f + __expf(-2.f * u3)) * evs;             \
                            PW[((size_t)((t >> 6) * 8 + (slot >> 4)) * 4 + ((slot >> 2) & 3)) * 256 + (t & 63) * 4 + (slot & 3)] = ((unsigned)__builtin_bit_cast(unsigned short, (_Float16)wv) << 16) | (unsigned)e;     } } while (0)
                    if (count > 0) {
                        v4u qa[16], qb[16]; v4u ena, enb;
                        JLOAD(qa, ena, 0);
#pragma unroll 1
                        for (int b16 = 0; b16 < count; b16 += 32) {
                            const bool has_b = b16 + 16 < count;
                            if (has_b) JLOAD(qb, enb, b16 + 16);
                            JCOMP(qa, ena, b16);
                            if (has_b) { if (b16 + 32 < count) JLOAD(qa, ena, b16 + 32); JCOMP(qb, enb, b16 + 16); }
                        }
                    }
#undef JLOAD
#undef JCOMP
                    asm volatile("s_waitcnt lgkmcnt(0)" ::: "memory");
                    if (r0 + UL_CAP >= total) break;
                }
            }
        }
        __syncthreads();
    }
    xcd_barrier(bar); TSTAMP();

    asm volatile("; ===== PHASE 14 =====");
    if (PH(14)) for (int rep = 0; rep < NREP(14); ++rep) {
        PH_LANES; const bool dummy = rep < NREP(14) - 1; (void)dummy;
        for (int item = vcu; item < 256; item += G) {
            const int sl = item & 127, half = item >> 7;
            __syncthreads();
#pragma unroll
            for (int i = 0; i < 16; ++i) *(LAS v4u*)(L + RING_OFF + (i * 512 + tid) * 16) = *(const GAS v4u*)(V8T + (size_t)sl * 131072 + (size_t)(i * 512 + tid) * 16);
            __syncthreads();
            const GAS v4u* pwb = (const GAS v4u*)(PW + (size_t)(half * 256 + wave) * 8192) + lane;
            v4u buf[4][4];
#pragma unroll
            for (int c = 0; c < 4; ++c)
#pragma unroll
                for (int k = 0; k < 4; ++k) buf[c][k] = pwb[c * 256 + k * 64];
#pragma unroll 1
            for (int itk = 0; itk < 32; ++itk) {
                const int g64 = half * 256 + itk * 8 + wave;
                const int t = g64 * 64 + lane;
                h2v acc[4] = {(h2v){(_Float16)0, (_Float16)0}, (h2v){(_Float16)0, (_Float16)0}, (h2v){(_Float16)0, (_Float16)0}, (h2v){(_Float16)0, (_Float16)0}};
#pragma unroll
                for (int c = 0; c < 8; ++c) {
                    v4u cur[4];
#pragma unroll
                    for (int k = 0; k < 4; ++k) cur[k] = buf[c & 3][k];
                    { const int sn = itk * 8 + c + 4; const int gn = (sn >> 3) > 31 ? 31 : (sn >> 3), cc = sn & 7; const GAS v4u* src = pwb + (size_t)gn * 8 * 2048 + cc * 256;
#pragma unroll
                      for (int k = 0; k < 4; ++k) buf[c & 3][k] = src[k * 64]; }
                    v2u tb[16];
#pragma unroll
                    for (int k = 0; k < 4; ++k)
#pragma unroll
                        for (int i = 0; i < 4; ++i) { const unsigned p = cur[k][i]; tb[k * 4 + i] = *(const LAS v2u*)(L + RING_OFF + ((p & 0xffffu) << 3)); }
#pragma unroll
                    for (int k = 0; k < 4; ++k)
#pragma unroll
                        for (int i = 0; i < 4; ++i) { const unsigned p = cur[k][i]; const v2u q = tb[k * 4 + i];
                            const h2v ww = __builtin_bit_cast(h2v, __builtin_amdgcn_perm(p, p, 0x03020302u));
                            acc[0] += ww * __builtin_bit_cast(h2v, __builtin_amdgcn_perm(0u, q.x, 0x010c000cu)); acc[1] += ww * __builtin_bit_cast(h2v, __builtin_amdgcn_perm(0u, q.x, 0x030c020cu));
                            acc[2] += ww * __builtin_bit_cast(h2v, __builtin_amdgcn_perm(0u, q.y, 0x010c000cu)); acc[3] += ww * __builtin_bit_cast(h2v, __builtin_amdgcn_perm(0u, q.y, 0x030c020cu)); }
                }
                GAS v4u* hr = (GAS v4u*)(A + (size_t)t * D + sl * 8);
                const v4u hq = *hr; const float mulv = dummy ? 0.f : 1.f;
                v4u ho; ho.x = pk2(bflo(hq.x) + (float)acc[0].x * mulv, bfhi(hq.x) + (float)acc[0].y * mulv); ho.y = pk2(bflo(hq.y) + (float)acc[1].x * mulv, bfhi(hq.y) + (float)acc[1].y * mulv);
                ho.z = pk2(bflo(hq.z) + (float)acc[2].x * mulv, bfhi(hq.z) + (float)acc[2].y * mulv); ho.w = pk2(bflo(hq.w) + (float)acc[3].x * mulv, bfhi(hq.w) + (float)acc[3].y * mulv);
                *hr = ho;
            }
        }
    }
    xcd_barrier(bar); TSTAMP();

#ifdef EXTRA_BARRIERS
    for (int eb = 0; eb < EXTRA_BARRIERS; ++eb) xcd_barrier(bar);
#endif
    asm volatile("; ===== PHASE 15 =====");
    if (PH(15)) for (int rep = 0; rep < NREP(15); ++rep) {
        PH_LANES; const bool dummy = rep < NREP(15) - 1; (void)dummy;
        for (int t = gw; t < T; t += NGW) {
            const GAS v4u* hr = (const GAS v4u*)(A + (size_t)t * D + 16 * lane); const v4u q0 = hr[0], q1 = hr[1];
            const GAS f32x4* gr = (const GAS f32x4*)(g_final + 16 * lane); GAS f32x4* orow = (GAS f32x4*)(out + (size_t)t * D + 16 * lane);
            f32x4 o[4] = {(f32x4){bflo(q0.x), bfhi(q0.x), bflo(q0.y), bfhi(q0.y)}, (f32x4){bflo(q0.z), bfhi(q0.z), bflo(q0.w), bfhi(q0.w)},
                          (f32x4){bflo(q1.x), bfhi(q1.x), bflo(q1.y), bfhi(q1.y)}, (f32x4){bflo(q1.z), bfhi(q1.z), bflo(q1.w), bfhi(q1.w)}};
            float ss = 0.f;
#pragma unroll
            for (int j = 0; j < 4; ++j) ss += (o[j].x * o[j].x + o[j].y * o[j].y) + (o[j].z * o[j].z + o[j].w * o[j].w);
            const float r = rsqrtf(wave_sum(ss) * (1.f / 1024.f) + RMS_EPS);
#pragma unroll
            for (int j = 0; j < 4; ++j) orow[j] = o[j] * r * gr[j];
        }
    }
}

extern "C" void kernel_launch(void* const* d_in, const int* in_sizes, int n_in, void* d_out, int out_size, void* d_ws, size_t ws_size, hipStream_t stream) {
    static int grid = 0;
    if (grid == 0) {
        if (n_in != 19 || out_size != T * D || ws_size < WS_END) { fprintf(stderr, "kernel_launch: unexpected problem (n_in %d, out %d, ws %zu < %zu); nothing launched\n", n_in, out_size, ws_size, (size_t)WS_END); grid = -1; return; }
        int dev = 0, cus = 0, per_cu = 0;
        if (hipGetDevice(&dev) != hipSuccess || hipDeviceGetAttribute(&cus, hipDeviceAttributeMultiprocessorCount, dev) != hipSuccess) { grid = -1; return; }
        if (hipFuncSetAttribute((const void*)mk_fwd, hipFuncAttributeMaxDynamicSharedMemorySize, LDS_BYTES) != hipSuccess) { fprintf(stderr, "kernel_launch: hipFuncSetAttribute failed\n"); grid = -1; return; }
        if (hipOccupancyMaxActiveBlocksPerMultiprocessor(&per_cu, (const void*)mk_fwd, NWAVES * 64, LDS_BYTES) != hipSuccess || per_cu < 1) { fprintf(stderr, "kernel_launch: occupancy query says %d blocks per CU\n", per_cu); }
        (void)hipGetLastError();
        grid = cus;
    }
    if (grid < 0) return;
    if (hipMemsetAsync((char*)d_ws + WS_CTL, 0, CTL_ZERO_BYTES, stream) != hipSuccess) return;
    Args a{};
    for (int i = 0; i < 19; ++i) a.in[i] = (const float*)d_in[i];
    a.out = (float*)d_out; a.ws = (unsigned char*)d_ws;
    hipLaunchKernelGGL(mk_fwd, dim3(grid), dim3(NWAVES * 64), LDS_BYTES, stream, a);
}
```

```cpp
#include <hip/hip_runtime.h>
#include <hip/hip_bf16.h>
#include <cstdio>
#include <cstdint>
#include <cmath>

#ifndef DIAG
#define DIAG 0
#endif


template <int O> __device__ __forceinline__ float shx(float v) { static_assert(O > 0 && O < 32, "shx"); return __uint_as_float((unsigned)__builtin_amdgcn_ds_swizzle((int)__float_as_uint(v), (O << 10) | 0x1f)); }
__device__ __forceinline__ float sum32(float v) { auto r = __builtin_amdgcn_permlane32_swap(__float_as_uint(v), __float_as_uint(v), false, false); return __uint_as_float(r[0]) + __uint_as_float(r[1]); }
__device__ __forceinline__ float max32(float v) { auto r = __builtin_amdgcn_permlane32_swap(__float_as_uint(v), __float_as_uint(v), false, false); return fmaxf(__uint_as_float(r[0]), __uint_as_float(r[1])); }
__device__ __forceinline__ float wave_max(float v) { v = fmaxf(v, shx<1>(v)); v = fmaxf(v, shx<2>(v)); v = fmaxf(v, shx<4>(v)); v = fmaxf(v, shx<8>(v)); v = fmaxf(v, shx<16>(v)); return max32(v); }
__device__ __forceinline__ float wave_sum(float v) { v += shx<1>(v); v += shx<2>(v); v += shx<4>(v); v += shx<8>(v); v += shx<16>(v); return sum32(v); }

namespace pg8 {
#define PG8_LAS __attribute__((address_space(3)))
typedef unsigned short bf16_t;
typedef short bf16x8 __attribute__((ext_vector_type(8)));
typedef float f32x4 __attribute__((ext_vector_type(4)));
typedef float f32x2 __attribute__((ext_vector_type(2)));
typedef unsigned u32x4 __attribute__((ext_vector_type(4)));
typedef unsigned u32x2 __attribute__((ext_vector_type(2)));
constexpr int BM = 256, BK = 64, HALF = 128, HTB = HALF * BK * 2  , STAGE_BYTES = 8 * HTB, NXCD = 8, WGM = 4;

__host__ __device__ __forceinline__ int lds_byte(int r, int c) { const int st = (r >> 4) * 2 + (c >> 5), rr = r & 15, cc = c & 31, ob = rr * 64 + cc * 2; return st * 1024 + (ob ^ (((ob >> 9) & 1) << 5)); }
__host__ __device__ __forceinline__ void stage_rc(int b, int& R, int& C) { const int st = b / 1024, sb = b % 1024, swz = sb ^ (((sb >> 9) & 1) << 5); R = (st >> 1) * 16 + swz / 64; C = (st & 1) * 32 + (swz % 64) / 2; }
__host__ __device__ __forceinline__ int perm32(int rho) { const int n = rho >> 4, i = rho & 15; return 8 * (i >> 2) + 4 * n + (i & 3); }

struct Unit { int pm, pn; const char* a; const char* b; };
struct Gemm { int lda, ldb, K; };

struct StaticOrder {
    int nM, nN, nwg, G, c; const char* A; const char* Bt; size_t astep, bstep;
    __device__ void init(const void* A_, int lda, const void* Bt_, int ldb, int M, int N, int G_, int c_) { nM = M / BM; nN = N / BM; nwg = nM * nN; G = G_; c = c_; A = (const char*)A_; Bt = (const char*)Bt_; astep = (size_t)BM * lda * 2; bstep = (size_t)BM * ldb * 2; }
    __device__ bool next(int i, Unit& u) const {
        const long L = (long)i * G + c; if (L >= nwg) return false;
        int wgid = (int)L; { const int q = nwg / NXCD, r = nwg % NXCD, xcd = wgid % NXCD, off = wgid / NXCD; wgid = (xcd < r ? xcd * (q + 1) : r * (q + 1) + (xcd - r) * q) + off; }
        const int nig = WGM * nN, gid = wgid / nig, fm = gid * WGM, gsz = (nM - fm) < WGM ? (nM - fm) : WGM;
        u.pm = fm + ((wgid % nig) % gsz); u.pn = (wgid % nig) / gsz; u.a = A + (size_t)u.pm * astep; u.b = Bt + (size_t)u.pn * bstep; return true;
    }
};

__device__ __forceinline__ unsigned cvt_pk_bf16(float lo, float hi) { typedef __bf16 bf2 __attribute__((ext_vector_type(2))); f32x2 v = {lo, hi}; bf2 b = __builtin_convertvector(v, bf2); return __builtin_bit_cast(unsigned, b); }
__device__ __forceinline__ float bf_lo(unsigned u) { return __uint_as_float(u << 16); }
__device__ __forceinline__ float bf_hi(unsigned u) { return __uint_as_float(u & 0xffff0000u); }

template <class Epi, class Sched, bool ALIGN_EPI>
__device__ __forceinline__ void gemm_phase(PG8_LAS unsigned char* lds, const Gemm g, const Sched& S, const Epi& E) {
    int tid = threadIdx.x; asm volatile("" : "+v"(tid));
    const int wid = __builtin_amdgcn_readfirstlane(tid >> 6), lane = tid & 63, wr = wid >> 2, wc = wid & 3, fr = lane & 15, fq = lane >> 4;
    const int K = g.K, nt = K / BK;
    unsigned voffA[2], voffB[2];
#pragma unroll
    for (int i = 0; i < 2; ++i) { int R, C; stage_rc(tid * 16 + i * 8192, R, C); const int Rb = Epi::PERM ? ((R & ~31) + perm32(R & 31)) : R;
        voffA[i] = (unsigned)(R * g.lda + C) * 2u; voffB[i] = (unsigned)(Rb * g.ldb + C) * 2u; }
    const size_t kstep = (size_t)(BK * 2);
    const size_t hstepA = (size_t)HALF * g.lda * 2, hstepB = (size_t)HALF * g.ldb * 2;
    const unsigned ldsw = (unsigned)wid * 1024u;
    const int aoff = lds_byte(wr * 64 + fr, fq * 8), boff = lds_byte(wc * 32 + fr, fq * 8);
#define PG8_SA(b, h) (((b) * 2 + (h)) * HTB)
#define PG8_SB(b, h) ((4 + (b) * 2 + (h)) * HTB)
#define PG8_STAGE(bufoff, gbase, voff) do { _Pragma("unroll") for (int _i = 0; _i < 2; ++_i) \
        __builtin_amdgcn_global_load_lds((const unsigned*)((const char*)(gbase) + (voff)[_i]), (PG8_LAS unsigned*)(lds + (bufoff) + ldsw + _i * 8192), 16, 0, 0); } while (0)
#define PG8_LDA(dst, b, h) do { _Pragma("unroll") for (int m = 0; m < 4; ++m) _Pragma("unroll") for (int k = 0; k < 2; ++k) dst[m][k] = *(const PG8_LAS bf16x8*)(lds + PG8_SA(b, h) + aoff + m * 2048 + k * 1024); } while (0)
#define PG8_LDB(dst, b, h) do { _Pragma("unroll") for (int n = 0; n < 2; ++n) _Pragma("unroll") for (int k = 0; k < 2; ++k) dst[n][k] = *(const PG8_LAS bf16x8*)(lds + PG8_SB(b, h) + boff + n * 2048 + k * 1024); } while (0)
#define PG8_MMA(ai, bj, At, Bt) do { __builtin_amdgcn_s_setprio(1); _Pragma("unroll") for (int m = 0; m < 4; ++m) _Pragma("unroll") for (int n = 0; n < 2; ++n) _Pragma("unroll") for (int k = 0; k < 2; ++k) \
        acc[ai][bj][m][n] = __builtin_amdgcn_mfma_f32_16x16x32_bf16(Bt[n][k], At[m][k], acc[ai][bj][m][n], 0, 0, 0); __builtin_amdgcn_s_setprio(0); } while (0)
#define PG8_WAIT_V(n) asm volatile("s_waitcnt vmcnt(" #n ")" ::: "memory")
#define PG8_WAIT_L(n) asm volatile("s_waitcnt lgkmcnt(" #n ")" ::: "memory")
#define PG8_BAR __builtin_amdgcn_s_barrier()
#define PG8_SCHED __builtin_amdgcn_sched_barrier(0)
    Unit cur, nxt; int ui = 0;
    if (!S.next(0, cur)) return;
    f32x4 acc[2][2][4][2];
#pragma unroll
    for (int a = 0; a < 2; ++a)
#pragma unroll
        for (int b = 0; b < 2; ++b)
#pragma unroll
            for (int m = 0; m < 4; ++m)
#pragma unroll
                for (int n = 0; n < 2; ++n) acc[a][b][m][n] = (f32x4){0.f, 0.f, 0.f, 0.f};
    bf16x8 At[4][2], B0[2][2], B1[2][2];
    const char* cA = cur.a; const char* cB = cur.b;
    PG8_STAGE(PG8_SB(0, 0), cB, voffB); PG8_STAGE(PG8_SB(0, 1), cB + hstepB, voffB); PG8_STAGE(PG8_SA(0, 0), cA, voffA); PG8_STAGE(PG8_SA(0, 1), cA + hstepA, voffA);
    if (wr == 1) PG8_BAR;
    PG8_WAIT_V(2); PG8_BAR;
    PG8_STAGE(PG8_SB(1, 0), cB + kstep, voffB); PG8_STAGE(PG8_SA(1, 0), cA + kstep, voffA); PG8_STAGE(PG8_SB(1, 1), cB + hstepB + kstep, voffB);
    PG8_WAIT_V(6); PG8_BAR;
    for (;;) {
        const bool has_next = S.next(ui + 1, nxt);
        const char* nA = has_next ? nxt.a : cA; const char* nB = has_next ? nxt.b : cB;
        for (int t = 0; t < nt; t += 2) {
            const bool last = (t == nt - 2);
            const char* a1 = cA + (size_t)(t + 1) * kstep;
            const char* a2 = last ? nA : cA + (size_t)(t + 2) * kstep; const char* b2 = last ? nB : cB + (size_t)(t + 2) * kstep;
            const char* a3 = a2 + kstep; const char* b3 = b2 + kstep;
            PG8_LDB(B0, 0, 0); PG8_LDB(B1, 0, 1); PG8_SCHED; PG8_LDA(At, 0, 0); PG8_STAGE(PG8_SA(1, 1), a1 + hstepA, voffA);
            PG8_WAIT_V(8); PG8_WAIT_L(0); PG8_BAR; PG8_MMA(0, 0, At, B0); PG8_MMA(0, 1, At, B1); PG8_BAR; PG8_SCHED;
            PG8_LDA(At, 0, 1); PG8_STAGE(PG8_SB(0, 0), b2, voffB); PG8_STAGE(PG8_SB(0, 1), b2 + hstepB, voffB); PG8_STAGE(PG8_SA(0, 0), a2, voffA);
            PG8_WAIT_V(8); PG8_WAIT_L(0); PG8_BAR; PG8_MMA(1, 0, At, B0); PG8_MMA(1, 1, At, B1); PG8_BAR; PG8_SCHED;
            PG8_LDB(B0, 1, 0); PG8_LDB(B1, 1, 1); PG8_SCHED; PG8_LDA(At, 1, 0); PG8_STAGE(PG8_SA(0, 1), a2 + hstepA, voffA);
            PG8_WAIT_V(8); PG8_WAIT_L(0); PG8_BAR; PG8_MMA(0, 0, At, B0); PG8_MMA(0, 1, At, B1); PG8_BAR; PG8_SCHED;
            PG8_LDA(At, 1, 1); PG8_STAGE(PG8_SB(1, 0), b3, voffB); PG8_STAGE(PG8_SB(1, 1), b3 + hstepB, voffB); PG8_STAGE(PG8_SA(1, 0), a3, voffA);
            PG8_WAIT_V(8); PG8_WAIT_L(0); PG8_BAR; PG8_MMA(1, 0, At, B0); PG8_MMA(1, 1, At, B1); PG8_BAR; PG8_SCHED;
        }
        if constexpr (ALIGN_EPI) { if (wr == 0) PG8_BAR; }
        if constexpr (!Epi::AFTER_DRAIN) { E(acc, cur, wr, wc, fr, fq); }
        if (!has_next) break;
#pragma unroll
        for (int a = 0; a < 2; ++a)
#pragma unroll
            for (int b = 0; b < 2; ++b)
#pragma unroll
                for (int m = 0; m < 4; ++m)
#pragma unroll
                    for (int n = 0; n < 2; ++n) acc[a][b][m][n] = (f32x4){0.f, 0.f, 0.f, 0.f};
        cur = nxt; cA = nA; cB = nB; ++ui;
        if constexpr (ALIGN_EPI) { if (wr == 1) PG8_BAR; }
    }
    PG8_WAIT_V(0);
    if constexpr (!ALIGN_EPI) { if (wr == 0) PG8_BAR; }
    PG8_BAR;
    if constexpr (Epi::AFTER_DRAIN) { E.fused(acc, cur, wr, wc, fr, fq, lds, wid, lane); }
#undef PG8_SA
#undef PG8_SB
#undef PG8_STAGE
#undef PG8_LDA
#undef PG8_LDB
#undef PG8_MMA
#undef PG8_WAIT_V
#undef PG8_WAIT_L
#undef PG8_BAR
#undef PG8_SCHED
}

typedef f32x4 AccT[2][2][4][2];

struct EpiBf16 {
    static constexpr bool PERM = true, AFTER_DRAIN = false;
    bf16_t* O; int ldc;
    __device__ __forceinline__ void operator()(const AccT& acc, const Unit& u, int wr, int wc, int fr, int fq) const {
        { int t_ = threadIdx.x; asm volatile("" : "+v"(t_)); fr = t_ & 15; fq = (t_ >> 4) & 3; }
        const int row0 = u.pm * BM + wr * 64 + fr, col0 = u.pn * BM + wc * 32 + 8 * fq;
#pragma unroll
        for (int ai = 0; ai < 2; ++ai)
#pragma unroll
            for (int m = 0; m < 4; ++m) { bf16_t* rowp = O + (size_t)(row0 + ai * HALF + m * 16) * ldc + col0;
#pragma unroll
                for (int bj = 0; bj < 2; ++bj) { const f32x4 v0 = acc[ai][bj][m][0], v1 = acc[ai][bj][m][1];
                    u32x4 w; w.x = cvt_pk_bf16(v0[0], v0[1]); w.y = cvt_pk_bf16(v0[2], v0[3]); w.z = cvt_pk_bf16(v1[0], v1[1]); w.w = cvt_pk_bf16(v1[2], v1[3]);
                    *(u32x4*)(rowp + bj * HALF) = w; } }
    }
};
struct EpiF16 {
    static constexpr bool PERM = true, AFTER_DRAIN = false;
    _Float16* O; int ldc;
    __device__ __forceinline__ void operator()(const AccT& acc, const Unit& u, int wr, int wc, int fr, int fq) const {
        { int t_ = threadIdx.x; asm volatile("" : "+v"(t_)); fr = t_ & 15; fq = (t_ >> 4) & 3; }
        typedef _Float16 h8 __attribute__((ext_vector_type(8)));
        const int row0 = u.pm * BM + wr * 64 + fr, col0 = u.pn * BM + wc * 32 + 8 * fq;
#pragma unroll
        for (int ai = 0; ai < 2; ++ai)
#pragma unroll
            for (int m = 0; m < 4; ++m) { _Float16* rowp = O + (size_t)(row0 + ai * HALF + m * 16) * ldc + col0;
#pragma unroll
                for (int bj = 0; bj < 2; ++bj) { const f32x4 v0 = acc[ai][bj][m][0], v1 = acc[ai][bj][m][1];
                    h8 w = {(_Float16)v0[0], (_Float16)v0[1], (_Float16)v0[2], (_Float16)v0[3], (_Float16)v1[0], (_Float16)v1[1], (_Float16)v1[2], (_Float16)v1[3]};
                    *(h8*)(rowp + bj * HALF) = w; } }
    }
};
struct EpiGateMul {
    static constexpr bool PERM = true, AFTER_DRAIN = false;
    const bf16_t* G; bf16_t* Dst; int ldc;
    __device__ __forceinline__ void operator()(const AccT& acc, const Unit& u, int wr, int wc, int fr, int fq) const {
        { int t_ = threadIdx.x; asm volatile("" : "+v"(t_)); fr = t_ & 15; fq = (t_ >> 4) & 3; }
        const int row0 = u.pm * BM + wr * 64 + fr, col0 = u.pn * BM + wc * 32 + 8 * fq;
#pragma unroll
        for (int ai = 0; ai < 2; ++ai)
#pragma unroll
            for (int m = 0; m < 4; ++m) { const size_t roff = (size_t)(row0 + ai * HALF + m * 16) * ldc + col0; const bf16_t* rowg = G + roff; bf16_t* rowp = Dst + roff;
#pragma unroll
                for (int bj = 0; bj < 2; ++bj) { const f32x4 v0 = acc[ai][bj][m][0], v1 = acc[ai][bj][m][1]; const u32x4 gq = *(const u32x4*)(rowg + bj * HALF);
                    u32x4 w; w.x = cvt_pk_bf16(v0[0] * bf_lo(gq.x), v0[1] * bf_hi(gq.x)); w.y = cvt_pk_bf16(v0[2] * bf_lo(gq.y), v0[3] * bf_hi(gq.y));
                    w.z = cvt_pk_bf16(v1[0] * bf_lo(gq.z), v1[1] * bf_hi(gq.z)); w.w = cvt_pk_bf16(v1[2] * bf_lo(gq.w), v1[3] * bf_hi(gq.w));
                    *(u32x4*)(rowp + bj * HALF) = w; } }
    }
};
struct EpiGateFma {
    static constexpr bool PERM = true, AFTER_DRAIN = false;
    const bf16_t* Tm; const bf16_t* G2; bf16_t* Dst; int ldc;
    __device__ __forceinline__ void operator()(const AccT& acc, const Unit& u, int wr, int wc, int fr, int fq) const {
        { int t_ = threadIdx.x; asm volatile("" : "+v"(t_)); fr = t_ & 15; fq = (t_ >> 4) & 3; }
        const int row0 = u.pm * BM + wr * 64 + fr, col0 = u.pn * BM + wc * 32 + 8 * fq;
#pragma unroll
        for (int ai = 0; ai < 2; ++ai)
#pragma unroll
            for (int m = 0; m < 4; ++m) { const size_t off = (size_t)(row0 + ai * HALF + m * 16) * ldc + col0;
#pragma unroll
                for (int bj = 0; bj < 2; ++bj) { const f32x4 v0 = acc[ai][bj][m][0], v1 = acc[ai][bj][m][1]; const u32x4 gq = *(const u32x4*)(G2 + off + bj * HALF); const u32x4 tq = *(const u32x4*)(Tm + off + bj * HALF);
                    u32x4 w; w.x = cvt_pk_bf16(bf_lo(tq.x) + v0[0] * bf_lo(gq.x), bf_hi(tq.x) + v0[1] * bf_hi(gq.x)); w.y = cvt_pk_bf16(bf_lo(tq.y) + v0[2] * bf_lo(gq.y), bf_hi(tq.y) + v0[3] * bf_hi(gq.y));
                    w.z = cvt_pk_bf16(bf_lo(tq.z) + v1[0] * bf_lo(gq.z), bf_hi(tq.z) + v1[1] * bf_hi(gq.z)); w.w = cvt_pk_bf16(bf_lo(tq.w) + v1[2] * bf_lo(gq.w), bf_hi(tq.w) + v1[3] * bf_hi(gq.w));
                    *(u32x4*)(Dst + off + bj * HALF) = w; } }
    }
};
struct EpiResF32 {
    static constexpr bool PERM = false, AFTER_DRAIN = false;
    const float* res; float* out; int ldc; float mul;
    __device__ __forceinline__ void operator()(const AccT& acc, const Unit& u, int wr, int wc, int fr, int fq) const {
        { int t_ = threadIdx.x; asm volatile("" : "+v"(t_)); fr = t_ & 15; fq = (t_ >> 4) & 3; }
        const int row0 = u.pm * BM + wr * 64 + fr, col0 = u.pn * BM + wc * 32 + 4 * fq;
#pragma unroll
        for (int ai = 0; ai < 2; ++ai)
#pragma unroll
            for (int m = 0; m < 4; ++m) { const size_t off = (size_t)(row0 + ai * HALF + m * 16) * ldc + col0;
#pragma unroll
                for (int bj = 0; bj < 2; ++bj)
#pragma unroll
                    for (int n = 0; n < 2; ++n) { const f32x4 r = *(const f32x4*)(res + off + bj * HALF + n * 16); *(f32x4*)(out + off + bj * HALF + n * 16) = r + acc[ai][bj][m][n] * mul; } }
    }
};

__device__ __forceinline__ float row_rs(const float* ssq, int row) {
    const f32x4* p = (const f32x4*)(ssq + (size_t)row * 16); const f32x4 a = p[0], b = p[1], c = p[2], d = p[3];
    const float s = ((a[0] + a[1]) + (a[2] + a[3])) + ((b[0] + b[1]) + (b[2] + b[3])) + ((c[0] + c[1]) + (c[2] + c[3])) + ((d[0] + d[1]) + (d[2] + d[3]));
    return rsqrtf(s * (1.f / 1024.f) + 1e-6f);
}
struct EpiBf16RS {
    static constexpr bool PERM = true, AFTER_DRAIN = false;
    bf16_t* O; int ldc; const float* ssq;
    __device__ __forceinline__ void operator()(const AccT& acc, const Unit& u, int wr, int wc, int fr, int fq) const {
        { int t_ = threadIdx.x; asm volatile("" : "+v"(t_)); fr = t_ & 15; fq = (t_ >> 4) & 3; }
        const int row0 = u.pm * BM + wr * 64 + fr, col0 = u.pn * BM + wc * 32 + 8 * fq;
#pragma unroll
        for (int ai = 0; ai < 2; ++ai)
#pragma unroll
            for (int m = 0; m < 4; ++m) { int ro = row0 + ai * HALF + m * 16; asm volatile("" : "+v"(ro)); const float rs = row_rs(ssq, ro); bf16_t* rowp = O + (size_t)ro * ldc + col0;
#pragma unroll
                for (int bj = 0; bj < 2; ++bj) { const f32x4 v0 = acc[ai][bj][m][0] * rs, v1 = acc[ai][bj][m][1] * rs;
                    u32x4 w; w.x = cvt_pk_bf16(v0[0], v0[1]); w.y = cvt_pk_bf16(v0[2], v0[3]); w.z = cvt_pk_bf16(v1[0], v1[1]); w.w = cvt_pk_bf16(v1[2], v1[3]);
                    *(u32x4*)(rowp + bj * HALF) = w; } }
    }
};
struct EpiF16RS {
    static constexpr bool PERM = true, AFTER_DRAIN = false;
    _Float16* O; int ldc; const float* ssq;
    __device__ __forceinline__ void operator()(const AccT& acc, const Unit& u, int wr, int wc, int fr, int fq) const {
        { int t_ = threadIdx.x; asm volatile("" : "+v"(t_)); fr = t_ & 15; fq = (t_ >> 4) & 3; }
        typedef _Float16 h8 __attribute__((ext_vector_type(8)));
        const int row0 = u.pm * BM + wr * 64 + fr, col0 = u.pn * BM + wc * 32 + 8 * fq;
#pragma unroll
        for (int ai = 0; ai < 2; ++ai)
#pragma unroll
            for (int m = 0; m < 4; ++m) { int ro = row0 + ai * HALF + m * 16; asm volatile("" : "+v"(ro)); const float rs = row_rs(ssq, ro); _Float16* rowp = O + (size_t)ro * ldc + col0;
#pragma unroll
                for (int bj = 0; bj < 2; ++bj) { const f32x4 v0 = acc[ai][bj][m][0] * rs, v1 = acc[ai][bj][m][1] * rs;
                    h8 w = {(_Float16)v0[0], (_Float16)v0[1], (_Float16)v0[2], (_Float16)v0[3], (_Float16)v1[0], (_Float16)v1[1], (_Float16)v1[2], (_Float16)v1[3]};
                    *(h8*)(rowp + bj * HALF) = w; } }
    }
};
template <bool RES_F32> struct EpiResNorm {
    static constexpr bool PERM = true, AFTER_DRAIN = false;
    const float* resf; bf16_t* H; float* ssq; int ldc; float mul;
    __device__ __forceinline__ void operator()(const AccT& acc, const Unit& u, int wr, int wc, int fr, int fq) const {
        { int t_ = threadIdx.x; asm volatile("" : "+v"(t_)); fr = t_ & 15; fq = (t_ >> 4) & 3; }
        const int row0 = u.pm * BM + wr * 64 + fr, col0 = u.pn * BM + wc * 32 + 8 * fq;
#pragma unroll
        for (int ai = 0; ai < 2; ++ai)
#pragma unroll
            for (int m = 0; m < 4; ++m) { int ro = row0 + ai * HALF + m * 16; asm volatile("" : "+v"(ro)); const size_t off = (size_t)ro * ldc + col0; float ss = 0.f;
#pragma unroll
                for (int bj = 0; bj < 2; ++bj) { f32x4 r0, r1;
                    if (RES_F32) { r0 = *(const f32x4*)(resf + off + bj * HALF); r1 = *(const f32x4*)(resf + off + bj * HALF + 4); }
                    else { const u32x4 q = *(const u32x4*)(H + off + bj * HALF); r0 = (f32x4){bf_lo(q.x), bf_hi(q.x), bf_lo(q.y), bf_hi(q.y)}; r1 = (f32x4){bf_lo(q.z), bf_hi(q.z), bf_lo(q.w), bf_hi(q.w)}; }
                    const f32x4 v0 = r0 + acc[ai][bj][m][0] * mul, v1 = r1 + acc[ai][bj][m][1] * mul;
                    ss += ((v0[0] * v0[0] + v0[1] * v0[1]) + (v0[2] * v0[2] + v0[3] * v0[3])) + ((v1[0] * v1[0] + v1[1] * v1[1]) + (v1[2] * v1[2] + v1[3] * v1[3]));
                    u32x4 w; w.x = cvt_pk_bf16(v0[0], v0[1]); w.y = cvt_pk_bf16(v0[2], v0[3]); w.z = cvt_pk_bf16(v1[0], v1[1]); w.w = cvt_pk_bf16(v1[2], v1[3]);
                    *(u32x4*)(H + off + bj * HALF) = w; }
                ss += shx<16>(ss); ss = sum32(ss);
                if (fq == 0) ssq[(size_t)ro * 16 + u.pn * 4 + wc] = ss; }
    }
};
struct EpiIn {
    static constexpr bool PERM = true, AFTER_DRAIN = false;
    bf16_t *U, *Bb, *Q, *Kb, *V, *SGC, *SGA; const float* ropec; const float* ropes; float* kbar; float qscale;
    __device__ __forceinline__ void operator()(const AccT& acc, const Unit& u, int wr, int wc, int fr, int fq) const {
        { int t_ = threadIdx.x; asm volatile("" : "+v"(t_)); fr = t_ & 15; fq = (t_ >> 4) & 3; }
        const int pn = u.pn; const int row0 = u.pm * BM + wr * 64 + fr;
        if (pn < 4) {
            const int c0 = 128 * pn + 16 * wc + 4 * fq;
#pragma unroll
            for (int ai = 0; ai < 2; ++ai)
#pragma unroll
                for (int m = 0; m < 4; ++m) { int ro = row0 + ai * HALF + m * 16; asm volatile("" : "+v"(ro)); bf16_t* rowp = U + (size_t)ro * 512 + c0;
#pragma unroll
                    for (int bj = 0; bj < 2; ++bj) { const f32x4 x = acc[ai][bj][m][0] * acc[ai][bj][m][1]; u32x2 w; w.x = cvt_pk_bf16(x[0], x[1]); w.y = cvt_pk_bf16(x[2], x[3]); *(u32x2*)(rowp + bj * 64) = w; } }
        } else if (pn < 6 || (pn >= 10 && pn < 12)) {
            bf16_t* O = pn < 6 ? Bb : V; const int col0 = (pn < 6 ? pn - 4 : pn - 10) * BM + wc * 32 + 8 * fq;
#pragma unroll
            for (int ai = 0; ai < 2; ++ai)
#pragma unroll
                for (int m = 0; m < 4; ++m) { int ro = row0 + ai * HALF + m * 16; asm volatile("" : "+v"(ro)); bf16_t* rowp = O + (size_t)ro * 512 + col0;
#pragma unroll
                    for (int bj = 0; bj < 2; ++bj) { const f32x4 v0 = acc[ai][bj][m][0], v1 = acc[ai][bj][m][1];
                        u32x4 w; w.x = cvt_pk_bf16(v0[0], v0[1]); w.y = cvt_pk_bf16(v0[2], v0[3]); w.z = cvt_pk_bf16(v1[0], v1[1]); w.w = cvt_pk_bf16(v1[2], v1[3]);
                        *(u32x4*)(rowp + bj * HALF) = w; } }
        } else if (pn < 10) {
            const bool isk = pn >= 8; bf16_t* O = isk ? Kb : Q; const int colt = (isk ? pn - 8 : pn - 6) * BM + wc * 32 + 8 * fq;
            const int g4 = 4 * (4 * (wc & 1) + fq);
            const float sc = isk ? 1.f : qscale;
            f32x4 cs0[2] = {(f32x4){0.f, 0.f, 0.f, 0.f}, (f32x4){0.f, 0.f, 0.f, 0.f}}, cs1[2] = {(f32x4){0.f, 0.f, 0.f, 0.f}, (f32x4){0.f, 0.f, 0.f, 0.f}};
#pragma unroll
            for (int ai = 0; ai < 2; ++ai)
#pragma unroll
                for (int m = 0; m < 4; ++m) { int row = row0 + ai * HALF + m * 16; asm volatile("" : "+v"(row)); const int pos = row & 2047;
                    const f32x4 c = *(const f32x4*)(ropec + pos * 32 + g4) * sc, s = *(const f32x4*)(ropes + pos * 32 + g4) * sc;
                    bf16_t* rowp = O + (size_t)row * 512 + colt;
#pragma unroll
                    for (int bj = 0; bj < 2; ++bj) { const f32x4 x1 = acc[ai][bj][m][0], x2 = acc[ai][bj][m][1]; const f32x4 o1 = x1 * c - x2 * s, o2 = x2 * c + x1 * s;
                        cs0[bj] += o1; cs1[bj] += o2;
                        u32x4 w; w.x = cvt_pk_bf16(o1[0], o1[1]); w.y = cvt_pk_bf16(o1[2], o1[3]); w.z = cvt_pk_bf16(o2[0], o2[1]); w.w = cvt_pk_bf16(o2[2], o2[3]);
                        *(u32x4*)(rowp + bj * HALF) = w; }
                    asm volatile("" : "+v"(cs0[0]), "+v"(cs0[1]), "+v"(cs1[0]), "+v"(cs1[1]) :: "memory"); }
            if (isk) {
#pragma unroll
                for (int bj = 0; bj < 2; ++bj)
#pragma unroll
                    for (int j = 0; j < 4; ++j) { float a = cs0[bj][j], b = cs1[bj][j];
                        a += shx<1>(a); b += shx<1>(b); a += shx<2>(a); b += shx<2>(b); a += shx<4>(a); b += shx<4>(b); a += shx<8>(a); b += shx<8>(b);
                        if (fr == 0) { const int pc = (pn - 8) * BM + bj * HALF + wc * 32 + 8 * fq;
                            float* kb = kbar + (size_t)u.pm * 512 + pc; atomicAdd(kb + j, a); atomicAdd(kb + 4 + j, b); } }
            }
        } else {
            bf16_t* O = pn < 16 ? SGC : SGA; const int col0 = (pn < 16 ? pn - 12 : pn - 16) * BM + wc * 32 + 8 * fq;
#pragma unroll
            for (int ai = 0; ai < 2; ++ai)
#pragma unroll
                for (int m = 0; m < 4; ++m) { int ro = row0 + ai * HALF + m * 16; asm volatile("" : "+v"(ro)); bf16_t* rowp = O + (size_t)ro * 1024 + col0;
#pragma unroll
                    for (int bj = 0; bj < 2; ++bj) { f32x4 v0 = acc[ai][bj][m][0], v1 = acc[ai][bj][m][1];
#pragma unroll
                        for (int j = 0; j < 4; ++j) { v0[j] = __builtin_amdgcn_rcpf(1.f + __expf(-v0[j])); v1[j] = __builtin_amdgcn_rcpf(1.f + __expf(-v1[j])); }
                        u32x4 w; w.x = cvt_pk_bf16(v0[0], v0[1]); w.y = cvt_pk_bf16(v0[2], v0[3]); w.z = cvt_pk_bf16(v1[0], v1[1]); w.w = cvt_pk_bf16(v1[2], v1[3]);
                        *(u32x4*)(rowp + bj * HALF) = w; }
                    asm volatile("" ::: "memory"); }
        }
    }
};
struct EpiSoftmax {
    static constexpr bool PERM = true, AFTER_DRAIN = true;
    bf16_t* O; int ldc; float scale_log2;
    __device__ __forceinline__ void fused(AccT& acc, const Unit& u, int wr, int wc, int fr, int fq, PG8_LAS unsigned char* lds, int wid, int lane) const {
        { int t_ = threadIdx.x; asm volatile("" : "+v"(t_)); fr = t_ & 15; fq = (t_ >> 4) & 3; }
        PG8_LAS f32x2* X = (PG8_LAS f32x2*)lds;
        float mx[2][4];
#pragma unroll
        for (int ai = 0; ai < 2; ++ai)
#pragma unroll
            for (int m = 0; m < 4; ++m) { float a = -3.0e38f;
#pragma unroll
                for (int bj = 0; bj < 2; ++bj)
#pragma unroll
                    for (int n = 0; n < 2; ++n) { acc[ai][bj][m][n] = acc[ai][bj][m][n] * scale_log2; const f32x4 x = acc[ai][bj][m][n]; a = fmaxf(fmaxf(a, fmaxf(x[0], x[1])), fmaxf(x[2], x[3])); }
                a = fmaxf(a, shx<16>(a)); a = max32(a); mx[ai][m] = a;
                float s = 0.f;
#pragma unroll
                for (int bj = 0; bj < 2; ++bj)
#pragma unroll
                    for (int n = 0; n < 2; ++n) { f32x4 x = acc[ai][bj][m][n];
#pragma unroll
                        for (int j = 0; j < 4; ++j) { x[j] = __builtin_amdgcn_exp2f(x[j] - a); s += x[j]; }
                        acc[ai][bj][m][n] = x; }
                s += shx<16>(s); s = sum32(s);
                if (fq == 0) X[(ai * HALF + wr * 64 + m * 16 + fr) * 4 + wc] = (f32x2){a, s};
            }
        asm volatile("s_waitcnt lgkmcnt(0)" ::: "memory"); __builtin_amdgcn_s_barrier(); asm volatile("" ::: "memory");
        const int row0 = u.pm * BM + wr * 64 + fr, col0 = u.pn * BM + wc * 32 + 8 * fq;
#pragma unroll
        for (int ai = 0; ai < 2; ++ai)
#pragma unroll
            for (int m = 0; m < 4; ++m) { const int r = ai * HALF + wr * 64 + m * 16 + fr;
                const f32x2 e0 = X[r * 4 + 0], e1 = X[r * 4 + 1], e2 = X[r * 4 + 2], e3 = X[r * 4 + 3];
                const float M = fmaxf(fmaxf(e0.x, e1.x), fmaxf(e2.x, e3.x));
                const float L = e0.y * __builtin_amdgcn_exp2f(e0.x - M) + e1.y * __builtin_amdgcn_exp2f(e1.x - M) + e2.y * __builtin_amdgcn_exp2f(e2.x - M) + e3.y * __builtin_amdgcn_exp2f(e3.x - M);
                const float f = __builtin_amdgcn_exp2f(mx[ai][m] - M) * __builtin_amdgcn_rcpf(L);
                bf16_t* rowp = O + (size_t)(row0 + ai * HALF + m * 16) * ldc + col0;
#pragma unroll
                for (int bj = 0; bj < 2; ++bj) { const f32x4 v0 = acc[ai][bj][m][0] * f, v1 = acc[ai][bj][m][1] * f;
                    u32x4 w; w.x = cvt_pk_bf16(v0[0], v0[1]); w.y = cvt_pk_bf16(v0[2], v0[3]); w.z = cvt_pk_bf16(v1[0], v1[1]); w.w = cvt_pk_bf16(v1[2], v1[3]);
                    *(u32x4*)(rowp + bj * HALF) = w; } }
        asm volatile("s_waitcnt lgkmcnt(0)" ::: "memory"); __builtin_amdgcn_s_barrier(); asm volatile("" ::: "memory");
    }
};
}
namespace attn_body {
using bf16=__hip_bfloat16;
using bf16x8=__attribute__((ext_vector_type(8)))short;
using s16x4=__attribute__((ext_vector_type(4)))short;
using f32x16=__attribute__((ext_vector_type(16)))float;
using u32x4=__attribute__((ext_vector_type(4)))unsigned;
constexpr int BATCH=16,NHEAD=8,SEQ=2048,D=64,DM=NHEAD*D;
constexpr int NW=8,QBLK=32,QB=QBLK*NW,KVBLK=64,NQB=SEQ/QB;
constexpr int ATTN_PITCH=DM, ATTN_UNIT_ROWS=QB;
__device__ __forceinline__ int crow(int r,int hi){return (r&3)+8*(r>>2)+4*hi;}
#define SBAR() __builtin_amdgcn_sched_barrier(0)
__device__ __forceinline__ void cmask(f32x16&p0,f32x16&p1,int jb,int qrel,int hi){
  const float NEG=-INFINITY; int kb=64*jb+4*hi;
  #pragma unroll
  for(int r=0;r<16;++r){int kv=kb+(r&3)+8*(r>>2); if(kv>qrel)p0[r]=NEG; if(kv+32>qrel)p1[r]=NEG;}
}

constexpr int NSLOT=3, SLOTB=8192;
constexpr int LDS_K=0, LDS_V=NSLOT*SLOTB, LDS_WS=2*NSLOT*SLOTB, LDS_OST=LDS_WS+NW*64*4, LDS_SEL=LDS_OST+NW*4096, LDS_BYTES=LDS_SEL+NW*64*4;
constexpr float C2=0.125f*1.4426950408889634f;
__device__ __forceinline__ void glds16(const void*gsrc,unsigned lds_dst){unsigned keep;
  asm volatile("s_mov_b32 %0, m0\n\ts_mov_b32 m0, %2\n\ts_nop 0\n\tglobal_load_lds_dwordx4 %1, off\n\ts_mov_b32 m0, %0":"=&s"(keep):"v"(gsrc),"s"(lds_dst):"memory");}
__device__ __forceinline__ float max3f(float a,float b,float c){float r;asm("v_max3_f32 %0, %1, %2, %3":"=v"(r):"v"(a),"v"(b),"v"(c));return r;}
__device__ __forceinline__ float max2f(float a,float b){float r;asm("v_max_f32_e32 %0, %1, %2":"=v"(r):"v"(a),"v"(b));return r;}
__device__ __forceinline__ float fadd_s(float a,float b){float r;asm("v_add_f32_e32 %0, %1, %2":"=v"(r):"v"(a),"v"(b));return r;}
__device__ __forceinline__ float fsub_s(float a,float b){float r;asm("v_sub_f32_e32 %0, %1, %2":"=v"(r):"v"(a),"v"(b));return r;}
typedef float f32x2_t __attribute__((ext_vector_type(2))); typedef __bf16 bf16x2_t __attribute__((ext_vector_type(2)));
__device__ __forceinline__ unsigned cvtpk_s(float lo,float hi){f32x2_t v={lo,hi};bf16x2_t b=__builtin_convertvector(v,bf16x2_t);return __builtin_bit_cast(unsigned,b);}
#define WAIT_BAR(N) asm volatile("s_waitcnt vmcnt(" #N ") lgkmcnt(0)\n\ts_barrier":::"memory")

__device__ __forceinline__ void qkt(f32x16&p0,f32x16&p1,const char*Kslot,const bf16x8*qr,const f32x16&negm,int r32,int hi){
  const char*kb=Kslot+hi*1024+r32*16;
  #pragma unroll
  for(int d0=0;d0<4;++d0){
    const bf16x8 b0=*reinterpret_cast<const bf16x8*>(kb+d0*2048);
    const bf16x8 b1=*reinterpret_cast<const bf16x8*>(kb+d0*2048+512);
    if(d0==0){p0=__builtin_amdgcn_mfma_f32_32x32x16_bf16(b0,qr[0],negm,0,0,0);p1=__builtin_amdgcn_mfma_f32_32x32x16_bf16(b1,qr[0],negm,0,0,0);}
    else{p0=__builtin_amdgcn_mfma_f32_32x32x16_bf16(b0,qr[d0],p0,0,0,0);p1=__builtin_amdgcn_mfma_f32_32x32x16_bf16(b1,qr[d0],p1,0,0,0);}}
}
typedef __attribute__((address_space(3))) const char* lds_cptr;
typedef short v4i16_t __attribute__((ext_vector_type(4)));
__device__ __forceinline__ void kload8(bf16x8*kf,lds_cptr kp){
  kf[0]=*(const __attribute__((address_space(3))) bf16x8*)(kp);      kf[1]=*(const __attribute__((address_space(3))) bf16x8*)(kp+512);
  kf[2]=*(const __attribute__((address_space(3))) bf16x8*)(kp+2048); kf[3]=*(const __attribute__((address_space(3))) bf16x8*)(kp+2560);
  kf[4]=*(const __attribute__((address_space(3))) bf16x8*)(kp+4096); kf[5]=*(const __attribute__((address_space(3))) bf16x8*)(kp+4608);
  kf[6]=*(const __attribute__((address_space(3))) bf16x8*)(kp+6144); kf[7]=*(const __attribute__((address_space(3))) bf16x8*)(kp+6656);
}
__device__ __forceinline__ void kload2(bf16x8*kf,lds_cptr kp,int j){ kf[2*j]=*(const __attribute__((address_space(3))) bf16x8*)(kp+j*2048); kf[2*j+1]=*(const __attribute__((address_space(3))) bf16x8*)(kp+j*2048+512); }
__device__ __forceinline__ s16x4 vtr(lds_cptr p){ return __builtin_bit_cast(s16x4,__builtin_amdgcn_ds_read_tr16_b64_v4i16((__attribute__((address_space(3))) v4i16_t*)p)); }
__device__ __forceinline__ float rowmax(const f32x16&p0,const f32x16&p1){
  float a=max3f(p0[0],p0[1],p1[0]),b=max3f(p0[2],p0[3],p1[1]);a=max3f(a,p1[2],p1[3]);
  #pragma unroll
  for(int r=4;r<16;r+=4){a=max3f(a,p0[r],p0[r+1]);b=max3f(b,p0[r+2],p0[r+3]);a=max3f(a,p1[r],p1[r+1]);b=max3f(b,p1[r+2],p1[r+3]);}
  const float m=max2f(a,b);
  auto rr=__builtin_amdgcn_permlane32_swap(__float_as_uint(m),__float_as_uint(m),false,false);
  return max2f(__uint_as_float(rr[0]),__uint_as_float(rr[1]));
}
__device__ __forceinline__ void pv(f32x16*o,int vb,bf16x8 pa0,bf16x8 pa1,bf16x8 pa2,bf16x8 pa3){
  #pragma unroll
  for(int d0=0;d0<2;++d0){s16x4 lo[4],hi[4];
    #pragma unroll
    for(int ks=0;ks<4;++ks){
      asm volatile("ds_read_b64_tr_b16 %0,%1 offset:%c2":"=&v"(lo[ks]):"v"(vb),"i"(d0*4096+ks*1024):"memory");
      asm volatile("ds_read_b64_tr_b16 %0,%1 offset:%c2":"=&v"(hi[ks]):"v"(vb),"i"(d0*4096+ks*1024+512):"memory");}
    asm volatile("s_waitcnt lgkmcnt(0)":::"memory");SBAR();
    #define PK(k) (bf16x8){lo[k][0],lo[k][1],lo[k][2],lo[k][3],hi[k][0],hi[k][1],hi[k][2],hi[k][3]}
    o[d0]=__builtin_amdgcn_mfma_f32_32x32x16_bf16(pa0,PK(0),o[d0],0,0,0);
    o[d0]=__builtin_amdgcn_mfma_f32_32x32x16_bf16(pa1,PK(1),o[d0],0,0,0);
    o[d0]=__builtin_amdgcn_mfma_f32_32x32x16_bf16(pa2,PK(2),o[d0],0,0,0);
    o[d0]=__builtin_amdgcn_mfma_f32_32x32x16_bf16(pa3,PK(3),o[d0],0,0,0);
    #undef PK
  }
}

#ifndef ATTN_STORE16
#define ATTN_STORE16(p,v) (*(u32x4*)(p)=(v))
#endif
template<int THRL> __device__ __forceinline__ void attn_unit(int b,int h,int qb,const bf16*Q,const bf16*__restrict__ K,const bf16*__restrict__ V,bf16*O,const float*__restrict__ kbar,char*shm){
  int tid=threadIdx.x; asm volatile("":"+v"(tid)); const int lane=tid&63,r32=lane&31,hi=lane>>5; const int wid=__builtin_amdgcn_readfirstlane(tid>>6);
  const long rowbase=(long)b*SEQ; const int q0=qb*QB;
  const bf16*Qw=Q+(rowbase+q0+wid*QBLK)*DM+h*D;
  const bf16*Kh=K+rowbase*DM+h*D,*Vh=V+rowbase*DM+h*D;
  const unsigned lds0=(unsigned)(uintptr_t)shm;
  float*wsf=(float*)(shm+LDS_WS)+wid*64;
  const bf16*ksrc=Kh+(long)lane*DM+wid*8;
  const bf16*vsrc=Vh+(long)(16*(wid&3)+(lane>>2))*DM+(wid>>2)*32+(lane&3)*8;
  const unsigned kdst=lds0+LDS_K+wid*1024, vdst=lds0+LDS_V+wid*1024;
  #define DMA_K(t,slot) glds16(ksrc+(long)(t)*KVBLK*DM,(unsigned)__builtin_amdgcn_readfirstlane(kdst+(slot)))
  #define DMA_V(t,slot) glds16(vsrc+(long)(t)*KVBLK*DM,(unsigned)__builtin_amdgcn_readfirstlane(vdst+(slot)))
  const int vb0=(int)(lds0+LDS_V)+((lane>>4)&1)*32+(lane&3)*8+(4*hi+((lane&15)>>2))*64;
  const char*Kbase=shm+LDS_K; bf16x8 kf[8];
  const lds_cptr shm3=(lds_cptr)shm; const lds_cptr kp0=shm3+LDS_K+hi*1024+r32*16; const lds_cptr vp0=shm3+LDS_V+((lane>>4)&1)*32+(lane&3)*8+(4*hi+((lane&15)>>2))*64;
  const int NT=(q0+QB)/KVBLK;
  DMA_K(0,0);DMA_V(0,0);DMA_K(1,SLOTB);
  bf16x8 qr[4];
  #pragma unroll
  for(int d0=0;d0<4;++d0)qr[d0]=*reinterpret_cast<const bf16x8*>(&Qw[(long)r32*DM+d0*16+hi*8]);
  int selm=0;
  if(qb>0){
    float g[7]; int hi8=8*hi; asm volatile("":"+v"(hi8)); const float*kb=kbar+(size_t)(b*8)*512+h*64+hi8;
    #pragma unroll
    for(int n=0;n<7;++n){ float a=0.f;
      if(n<qb){
        #pragma unroll
        for(int d0=0;d0<4;++d0){ const float4 k0=*(const float4*)(kb+n*512+16*d0),k1=*(const float4*)(kb+n*512+16*d0+4); const bf16x8 qq=qr[d0];
          #define QF(e) __uint_as_float(((unsigned)(unsigned short)qq[e])<<16)
          a+=QF(0)*k0.x+QF(1)*k0.y+QF(2)*k0.z+QF(3)*k0.w+QF(4)*k1.x+QF(5)*k1.y+QF(6)*k1.z+QF(7)*k1.w;
          #undef QF
        } }
      a=::sum32(a); g[n]=(n<qb)?a:-INFINITY; asm volatile("":"+v"(g[n])::"memory"); }
    #pragma unroll
    for(int r=0;r<3;++r){ int best=-1; float bv=-INFINITY;
      #pragma unroll
      for(int n=0;n<7;++n) if(!((selm>>n)&1)&&g[n]>bv){bv=g[n];best=n;}
      if(best>=0)selm|=1<<best; }
  }
  selm|=1<<qb;
  typedef __attribute__((address_space(3))) int* lds_iptr;
  ((lds_iptr)(shm3+LDS_SEL))[tid]=selm;
  #define CURNEG(blk) ({ int t_=threadIdx.x; asm volatile("":"+v"(t_)); const int sm_=((lds_iptr)(shm3+LDS_SEL))[t_]; ((sm_>>(blk))&1)?0.f:-INFINITY; })
  #define NEGUPD(t) do{ if((((t)+1)&3)==0){ const float cn_=CURNEG(((t)+1)>>2); _Pragma("unroll") for(int r=0;r<16;++r)negm[r]=cn_-mhat; asm volatile("":"+v"(negm)); } }while(0)
  float mhat=0.f,l_reg=0.f;f32x16 o[2];o[0]=f32x16{};o[1]=f32x16{};f32x16 negm; { const float cn_=CURNEG(0); _Pragma("unroll") for(int r=0;r<16;++r)negm[r]=cn_; } asm volatile("":"+v"(negm));
  const int qrel=wid*QBLK+r32;
  #define CMASK(P0,P1,t) do{int jb_=(t)-(NT-4); if(jb_>=0)cmask(P0,P1,jb_,qrel,hi);}while(0)
  bool resc=false;
  #define START(P0,P1) do{ const float rm=rowmax(P0,P1); resc=false; \
    { const float dl=__builtin_fmaxf(rm,-24.f); mhat=fadd_s(mhat,dl); \
      _Pragma("unroll") for(int r=0;r<16;++r){P0[r]=fsub_s(P0[r],dl);P1[r]=fsub_s(P1[r],dl);} \
      { const float cn_=CURNEG(0); _Pragma("unroll") for(int r=0;r<16;++r)negm[r]=cn_-mhat; } asm volatile("":"+v"(negm)); } \
    _Pragma("unroll") for(int r=0;r<16;++r)P0[r]=__builtin_amdgcn_exp2f(P0[r]); }while(0)
  #define RESC() do{ if(resc){ asm volatile("s_waitcnt lgkmcnt(0)":::"memory"); \
      _Pragma("unroll") for(int d_=0;d_<2;++d_) _Pragma("unroll") for(int r=0;r<16;++r)o[d_][r]*=wsf[crow(r,hi)]; } }while(0)
  f32x16 pA0,pA1,pB0,pB1;
  int sl_prev=0,sl_cur=0,sl_next=SLOTB;
  #define ROT() do{sl_prev=sl_cur;sl_cur=sl_next;sl_next=(sl_next==(NSLOT-1)*SLOTB)?0:sl_next+SLOTB;}while(0)
  DMA_K(2,2*SLOTB);
  WAIT_BAR(3);
  qkt(pA0,pA1,Kbase,qr,negm,r32,hi);asm volatile("s_nop 15\n\ts_nop 7":"+v"(pA0),"+v"(pA1));CMASK(pA0,pA1,0);
  START(pA0,pA1);
  _Pragma("unroll") for(int r=0;r<16;++r)pA1[r]=__builtin_amdgcn_exp2f(pA1[r]);
  WAIT_BAR(0);
  DMA_K(3,0);DMA_V(1,SLOTB);
  ROT();
  kload8(kf,kp0+sl_cur);
  WAIT_BAR(2);
  s16x4 vlo[8],vhi[8]; u32x4 pw0,pw1,pw2,pw3;
  #define PKW(P,B) cvtpk_s(P[B],P[B+1])
  #define PAF(k) __builtin_bit_cast(bf16x8,pw##k)
  #define VFR(i) (bf16x8){vlo[i][0],vlo[i][1],vlo[i][2],vlo[i][3],vhi[i][0],vhi[i][1],vhi[i][2],vhi[i][3]}
  #define PIN(x) asm volatile("":"+v"(x))
  #define MX3(a,b,c) __builtin_fmaxf(__builtin_fmaxf((a),(b)),(c))
  #define GAPA(MF,A0,A1,A2,A3,W0,W1,PW) do{ MF; sacc+=A0; sacc+=A1; sacc+=A2; sacc+=A3; PIN(sacc); W0; W1; PIN(PW); SBAR(); }while(0)
  #define EX(v) __builtin_amdgcn_exp2f(v)
  #define GAPB(MF,X,B) do{ MF; X[B]=EX(X[B]); X[B+1]=EX(X[B+1]); X[B+2]=EX(X[B+2]); X[B+3]=EX(X[B+3]); PIN(X); SBAR(); }while(0)
  #define VRD(i) do{ vlo[i]=vtr(vp_+(((i)>>2)*4096+((i)&3)*1024)); vhi[i]=vtr(vp_+(((i)>>2)*4096+((i)&3)*1024+512)); }while(0)
  #define KRD(G,j) do{ if(G){ kload2(kf,kp0+sl_next,j); SBAR(); } }while(0)
  #define STEP(C0,C1,P0,P1,t,GK,GV,GL) do{ SBAR(); \
    const lds_cptr vp_=vp0+sl_prev; \
    VRD(0); SBAR(); float sacc=(P0[0]+P0[1]); \
    GAPA(C0=__builtin_amdgcn_mfma_f32_32x32x16_bf16(kf[0],qr[0],negm,0,0,0), P0[2],P0[3],P0[4],P0[5],     pw0[0]=PKW(P0,0), pw0[1]=PKW(P0,2), pw0); \
    VRD(4); SBAR(); GAPA(C1=__builtin_amdgcn_mfma_f32_32x32x16_bf16(kf[1],qr[0],negm,0,0,0), P0[6],P0[7],P0[8],P0[9],     pw0[2]=PKW(P0,4), pw0[3]=PKW(P0,6), pw0); \
    VRD(1); SBAR(); GAPA(C0=__builtin_amdgcn_mfma_f32_32x32x16_bf16(kf[2],qr[1],C0,0,0,0),   P0[10],P0[11],P0[12],P0[13], pw1[0]=PKW(P0,8), pw1[1]=PKW(P0,10), pw1); \
    VRD(5); SBAR(); GAPA(C1=__builtin_amdgcn_mfma_f32_32x32x16_bf16(kf[3],qr[1],C1,0,0,0),   P0[14],P0[15],P1[0],P1[1],   pw1[2]=PKW(P0,12),pw1[3]=PKW(P0,14), pw1); \
    VRD(2); SBAR(); GAPA(C0=__builtin_amdgcn_mfma_f32_32x32x16_bf16(kf[4],qr[2],C0,0,0,0),   P1[2],P1[3],P1[4],P1[5],     pw2[0]=PKW(P1,0), pw2[1]=PKW(P1,2), pw2); \
    VRD(6); SBAR(); GAPA(C1=__builtin_amdgcn_mfma_f32_32x32x16_bf16(kf[5],qr[2],C1,0,0,0),   P1[6],P1[7],P1[8],P1[9],     pw2[2]=PKW(P1,4), pw2[3]=PKW(P1,6), pw2); \
    VRD(3); SBAR(); GAPA(C0=__builtin_amdgcn_mfma_f32_32x32x16_bf16(kf[6],qr[3],C0,0,0,0),   P1[10],P1[11],P1[12],P1[13], pw3[0]=PKW(P1,8), pw3[1]=PKW(P1,10), pw3); \
    VRD(7); SBAR(); GAPA(C1=__builtin_amdgcn_mfma_f32_32x32x16_bf16(kf[7],qr[3],C1,0,0,0),   P1[14],P1[15],0.f,0.f,       pw3[2]=PKW(P1,12),pw3[3]=PKW(P1,14), pw3); \
    l_reg+=sacc; \
    if(GK){DMA_K((t)+3,sl_cur);} if(GV){DMA_V((t)+1,sl_next);} \
    CMASK(C0,C1,t); \
    { float a=MX3(C0[0],C0[1],C1[0]),b=MX3(C0[2],C0[3],C1[1]); a=MX3(a,C1[2],C1[3]); \
      _Pragma("unroll") for(int r=4;r<16;r+=4){a=MX3(a,C0[r],C0[r+1]);b=MX3(b,C0[r+2],C0[r+3]);a=MX3(a,C1[r],C1[r+1]);b=MX3(b,C1[r+2],C1[r+3]);} \
      float rm=__builtin_fmaxf(a,b); { auto rr=__builtin_amdgcn_permlane32_swap(__float_as_uint(rm),__float_as_uint(rm),false,false); rm=__builtin_fmaxf(__uint_as_float(rr[0]),__uint_as_float(rr[1])); } \
      resc=false; \
      if(__builtin_expect(__any(rm>(float)THRL),0)){ const float dl=__builtin_fmaxf(rm,0.f); mhat+=dl; \
        _Pragma("unroll") for(int r=0;r<16;++r){C0[r]-=dl;C1[r]-=dl;} \
        { const float cn_=CURNEG(((t)+1)>>2); _Pragma("unroll") for(int r=0;r<16;++r)negm[r]=cn_-mhat; } asm volatile("":"+v"(negm)); \
        const float f=__builtin_amdgcn_exp2f(-dl); l_reg*=f; if(hi==0)wsf[r32]=f; resc=true; } } \
    SBAR(); \
    GAPB(o[0]=__builtin_amdgcn_mfma_f32_32x32x16_bf16(PAF(0),VFR(0),o[0],0,0,0), C0,0); \
    GAPB(o[1]=__builtin_amdgcn_mfma_f32_32x32x16_bf16(PAF(0),VFR(4),o[1],0,0,0), C0,4); \
    KRD(GL,0); GAPB(o[0]=__builtin_amdgcn_mfma_f32_32x32x16_bf16(PAF(1),VFR(1),o[0],0,0,0), C0,8); \
    KRD(GL,1); GAPB(o[1]=__builtin_amdgcn_mfma_f32_32x32x16_bf16(PAF(1),VFR(5),o[1],0,0,0), C0,12); \
    KRD(GL,2); GAPB(o[0]=__builtin_amdgcn_mfma_f32_32x32x16_bf16(PAF(2),VFR(2),o[0],0,0,0), C1,0); \
    KRD(GL,3); GAPB(o[1]=__builtin_amdgcn_mfma_f32_32x32x16_bf16(PAF(2),VFR(6),o[1],0,0,0), C1,4); \
    GAPB(o[0]=__builtin_amdgcn_mfma_f32_32x32x16_bf16(PAF(3),VFR(3),o[0],0,0,0), C1,8); \
    GAPB(o[1]=__builtin_amdgcn_mfma_f32_32x32x16_bf16(PAF(3),VFR(7),o[1],0,0,0), C1,12); \
    }while(0)
  int t=1;
  #undef CMASK
  #define CMASK(P0,P1,t) do{}while(0)
  for(;t+5<NT;t+=2){
    STEP(pB0,pB1,pA0,pA1,t,true,true,true);     WAIT_BAR(2); RESC(); ROT(); NEGUPD(t);
    STEP(pA0,pA1,pB0,pB1,t+1,true,true,true);   WAIT_BAR(2); RESC(); ROT(); NEGUPD(t+1);
  }
  #undef CMASK
  #define CMASK(P0,P1,t) do{int jb_=(t)-(NT-4); if(jb_>=0)cmask(P0,P1,jb_,qrel,hi);}while(0)
  #define ENDW(tt) do{ if((tt)+3<NT){WAIT_BAR(2);} else if((tt)+2<NT){WAIT_BAR(1);} else {WAIT_BAR(0);} }while(0)
  for(;t+1<NT;t+=2){
    STEP(pB0,pB1,pA0,pA1,t,(t+3<NT),(t+1<NT),(t+1<NT));       ENDW(t);   RESC(); ROT(); NEGUPD(t);
    STEP(pA0,pA1,pB0,pB1,t+1,(t+4<NT),(t+2<NT),(t+2<NT));     ENDW(t+1); RESC(); ROT(); NEGUPD(t+1);
  }
  STEP(pB0,pB1,pA0,pA1,NT-1,false,false,false); RESC();
  { float sacc=pB0[0]+pB0[1]; _Pragma("unroll") for(int r=2;r<16;++r)sacc+=pB0[r]; _Pragma("unroll") for(int r=0;r<16;++r)sacc+=pB1[r]; l_reg+=sacc;
    pw0=(u32x4){PKW(pB0,0),PKW(pB0,2),PKW(pB0,4),PKW(pB0,6)};pw1=(u32x4){PKW(pB0,8),PKW(pB0,10),PKW(pB0,12),PKW(pB0,14)};pw2=(u32x4){PKW(pB1,0),PKW(pB1,2),PKW(pB1,4),PKW(pB1,6)};pw3=(u32x4){PKW(pB1,8),PKW(pB1,10),PKW(pB1,12),PKW(pB1,14)};
    SBAR(); pv(o,vb0+sl_cur,PAF(0),PAF(1),PAF(2),PAF(3)); }
  #undef PKW
  #undef PAF
  #undef VFR
  #undef PIN
  #undef MX3
  #undef GAPA
  #undef GAPB
  #undef EX
  #undef VRD
  #undef KRD
  #undef STEP
  #undef ENDW
  {auto rr=__builtin_amdgcn_permlane32_swap(__float_as_uint(l_reg),__float_as_uint(l_reg),false,false);l_reg=__uint_as_float(rr[0])+__uint_as_float(rr[1]);}
  if(hi==0)wsf[32+r32]=l_reg;asm volatile("s_waitcnt lgkmcnt(0)":::"memory");
  float rli[16];
  #pragma unroll
  for(int r=0;r<16;++r)rli[r]=__builtin_amdgcn_rcpf(wsf[32+crow(r,hi)]);
  bf16*Ow=O+(rowbase+q0+wid*QBLK)*DM+h*D;
  { bf16*stg=(bf16*)(shm+LDS_OST)+wid*2048;
    #pragma unroll
    for(int r=0;r<16;++r){const int orow=crow(r,hi);
      #pragma unroll
      for(int d0=0;d0<2;++d0)stg[orow*64+d0*32+r32]=__float2bfloat16(o[d0][r]*rli[r]);}
    asm volatile("s_waitcnt lgkmcnt(0)":::"memory");
    #pragma unroll
    for(int i=0;i<4;++i){const int row=i*8+(lane>>3),ch=lane&7; const u32x4 v=*(const u32x4*)(stg+row*64+ch*8); ATTN_STORE16(Ow+(long)row*DM+ch*8,v);} }
  asm volatile("s_waitcnt lgkmcnt(0)\n\ts_barrier":::"memory");
  #undef DMA_K
  #undef DMA_V
  #undef CMASK
  #undef START
  #undef CURNEG
  #undef NEGUPD
  #undef RESC
  #undef ROT
}
constexpr int ATTN_LDS_BYTES=LDS_BYTES;
struct AttnTensors { const bf16* Q; const bf16* K; const bf16* V; bf16* O; const float* kbar; };
struct AttnUnit { int bh; int qb; };
struct StaticOrder {
  int vcu,G;
  __device__ __forceinline__ explicit StaticOrder(int grid,int block):vcu((grid%8==0)?(block%8)*(grid/8)+block/8:block),G(grid){}
  __device__ __forceinline__ bool next(int i,AttnUnit&u)const{
    if(G==256){ if(i>=4)return false; const int s=vcu&1; u.bh=vcu>>1; u.qb=s?((i==0)?6:(i==1)?1:(i==2)?5:2):((i==0)?7:(i==1)?0:(i==2)?4:3); return true; }
    const int L=i*G+vcu; if(L>=1024)return false; u.bh=L>>3; u.qb=L&7; return true; }
  __device__ __forceinline__ void a_ready(const AttnUnit&)const{}
  __device__ __forceinline__ void done(const AttnUnit&)const{}
};
template<class Sched,int THRL=8> __device__ __forceinline__ void attn_phase(char*lds,const AttnTensors&T,const Sched&S){
  AttnUnit u;
  for(int i=0;S.next(i,u);++i){ S.a_ready(u); attn_unit<THRL>(u.bh/NHEAD,u.bh%NHEAD,u.qb,T.Q,T.K,T.V,T.O,T.kbar,lds); S.done(u); }
}
#undef SBAR
#undef WAIT_BAR
}
constexpr int NWAVES = 8;
constexpr int T = 32768, D = 1024, SEQ = 2048, MEMROWS = 4096, INW = 5120;
constexpr float RMS_EPS = 1e-6f;
constexpr size_t MiB = 1u << 20;
constexpr size_t WS_CTL = 0, CTL_ZERO_BYTES = 2 * MiB, WS_KBAR = 1 * MiB;
constexpr size_t WS_WIN = 2 * MiB, WS_WC = 12 * MiB, WS_WA = 13 * MiB, WS_WM = 14 * MiB, WS_WXQ = 16 * MiB, WS_WXKV = 18 * MiB, WS_WXO = 22 * MiB, WS_MT = 24 * MiB, WS_ROPE = 28 * MiB;
constexpr size_t WS_MEMN = 32 * MiB, WS_KX = 40 * MiB, WS_VXT = 48 * MiB;
constexpr size_t WS_SSQ1 = 30 * MiB, WS_SSQ2 = 56 * MiB;
constexpr size_t WS_A = 64 * MiB;
constexpr size_t WS_YC = 128 * MiB, WS_QO = 160 * MiB, WS_U = 192 * MiB, WS_K = 224 * MiB, WS_V = 256 * MiB;
constexpr size_t WS_SGC = 320 * MiB, WS_SGA = 384 * MiB;
constexpr size_t WS_A8I = 320 * MiB, WS_ASC = 352 * MiB;
constexpr size_t WS_EIDX = 448 * MiB, WS_GW = 464 * MiB, WS_PW = 480 * MiB, WS_END = 496 * MiB;
constexpr size_t WS_U8 = 288 * MiB, WS_V8T = 304 * MiB, WS_SU = 29 * MiB, WS_SV = 29 * MiB + 512 * 1024;
constexpr size_t WS_QX = 128 * MiB, WS_PM = 192 * MiB, WS_OX = 128 * MiB;
constexpr size_t WS_PO = 128 * MiB;
constexpr size_t WS_SC = 128 * MiB;
constexpr int CW_TMO = 0, CW_BAR = 4096, CW_Q = 8192;
constexpr int RING_OFF = 0, RING_BYTES = 131072;
constexpr int LDSCTL_OFF = RING_BYTES, MISC_OFF = LDSCTL_OFF + 320;
constexpr int LDS_BYTES = 163840;
constexpr int UL_OFF = RING_BYTES + 512, UL_WAVE = (LDS_BYTES - UL_OFF) / 8, UL_CAP = ((UL_WAVE - 64) / 16) & ~15;

#define GAS __attribute__((address_space(1)))
#define LAS __attribute__((address_space(3)))
typedef unsigned short bf16;
typedef unsigned v4u __attribute__((ext_vector_type(4)));
typedef unsigned v2u __attribute__((ext_vector_type(2)));
typedef float f32x4 __attribute__((ext_vector_type(4)));
typedef float f32x2v __attribute__((ext_vector_type(2)));
typedef _Float16 h2v __attribute__((ext_vector_type(2)));
typedef GAS unsigned gu32;
#define RLX_AGENT __ATOMIC_RELAXED, __HIP_MEMORY_SCOPE_AGENT
#define LDS_WAIT() asm volatile("s_waitcnt lgkmcnt(0)" ::: "memory")
#define VM_WAIT() asm volatile("s_waitcnt vmcnt(0)" ::: "memory")
__device__ __forceinline__ unsigned pk2(float lo, float hi) { return pg8::cvt_pk_bf16(lo, hi); }
__device__ __forceinline__ float bflo(unsigned u) { return __uint_as_float(u << 16); }
__device__ __forceinline__ float bfhi(unsigned u) { return __uint_as_float(u & 0xffff0000u); }

#define XB_TMO      128
#define XB_XCNT(j)  (256  + 64 * (j))
#define XB_XSUB(j)  (1280 + 64 * (j))
#define XB_XGEN(j)  (2304 + 64 * (j))
#define XB_TOP      3328
#define XB_TOPGEN   3392
#define XCD_BAR_WORDS 3456
#define XB_SPIN_CAP (1u << 18)
__device__ __forceinline__ unsigned xb_ld(unsigned* p)              { return __hip_atomic_load(p, __ATOMIC_RELAXED, __HIP_MEMORY_SCOPE_AGENT); }
__device__ __forceinline__ unsigned xb_add(unsigned* p, unsigned v) { return __hip_atomic_fetch_add(p, v, __ATOMIC_RELAXED, __HIP_MEMORY_SCOPE_AGENT); }
__device__ __forceinline__ unsigned xb_xcc_id() { return (unsigned)__builtin_amdgcn_s_getreg((3 << 11) | 20) & 0xFu; }
#define XB_SPIN(cond, bar) do { unsigned _sp = 0; while (cond) { __builtin_amdgcn_s_sleep(1); \
    if ((++_sp & 255u) == 0u) { if (xb_ld(&(bar)[XB_TMO])) break; if (_sp > XB_SPIN_CAP) { atomicAdd(&(bar)[XB_TMO], 1u); break; } } } } while (0)
struct XcdBarrier { unsigned* bar; unsigned x; volatile LAS unsigned* st; };
__device__ __forceinline__ XcdBarrier xcd_barrier_post(unsigned* bar, volatile LAS unsigned* st) {
    XcdBarrier b; b.bar = bar; b.x = xb_xcc_id(); b.st = st;
    if (threadIdx.x == 0) (void)xb_add(&bar[XB_XCNT(b.x)], 1u);
    return b;
}
__device__ __forceinline__ void xcd_barrier_complete(unsigned* bar, unsigned x, unsigned& nloc, unsigned& nx) {
    const unsigned G = gridDim.x * gridDim.y * gridDim.z;
    unsigned sum, cnt, mine, sp = 0u;
    for (;;) {
        sum = 0u; cnt = 0u; mine = 0u;
#pragma unroll
        for (unsigned j = 0; j < 16; ++j) { const unsigned c = xb_ld(&bar[XB_XCNT(j)]); sum += c; cnt += (c > 0u) ? 1u : 0u; mine = (j == x) ? c : mine; }
        if (sum == G) break;
        __builtin_amdgcn_s_sleep(1);
        if ((++sp & 255u) == 0u) { if (xb_ld(&bar[XB_TMO])) break; if (sp > XB_SPIN_CAP) { atomicAdd(&bar[XB_TMO], 1u); break; } }
    }
    nloc = mine > 0u ? mine : 1u; nx = cnt > 0u ? cnt : 1u;
}
__device__ __forceinline__ void xcd_barrier(const XcdBarrier& b) {
    asm volatile("s_waitcnt vmcnt(0)" ::: "memory");
    __syncthreads();
    if (threadIdx.x == 0) {
        unsigned* bar = b.bar;
        __builtin_amdgcn_s_waitcnt(0);
        unsigned nloc = b.st[0], nx = b.st[1];
        if (nloc == 0u) { xcd_barrier_complete(bar, b.x, nloc, nx); b.st[0] = nloc; b.st[1] = nx; }
        const unsigned old = xb_add(&bar[XB_XSUB(b.x)], 1u);
        const unsigned gen = old / nloc;
        if (old + 1u == (gen + 1u) * nloc) {
            __builtin_amdgcn_fence(__ATOMIC_RELEASE, "agent");
            asm volatile("s_waitcnt vmcnt(0)" ::: "memory");
            const unsigned og = xb_add(&bar[XB_TOP], 1u);
            const unsigned tg = og / nx;
            if (og + 1u == (tg + 1u) * nx) xb_add(&bar[XB_TOPGEN], 1u);
            else XB_SPIN(xb_ld(&bar[XB_TOPGEN]) == tg, bar);
            __builtin_amdgcn_fence(__ATOMIC_ACQUIRE, "agent");
            xb_add(&bar[XB_XGEN(b.x)], 1u);
            asm volatile("s_waitcnt vmcnt(0)" ::: "memory");
        } else {
            XB_SPIN(xb_ld(&bar[XB_XGEN(b.x)]) == gen, bar);
            __builtin_amdgcn_fence(__ATOMIC_ACQUIRE, "agent");
            asm volatile("s_waitcnt vmcnt(0)" ::: "memory");
        }
    }
    __syncthreads();
}

struct MapId { static __device__ __forceinline__ int src(int j) { return j; } };
struct MapWin {
    static __device__ __forceinline__ int src(int j) {
        if (j < 1024) { const int g8 = j >> 3, i = j & 7; return ((i < 4) ? 0 : 1024) + 4 * g8 + (i & 3); }
        if (j < 1536) return 512 + (j - 1024);
        if (j < 2560) { const int jj = j - 1536, qk = jj >> 9, p = jj & 511, head = p >> 6, pl = p & 63, g = pl >> 3, i = pl & 7; return 1536 + qk * 512 + head * 64 + 4 * g + (i & 3) + 32 * (i >> 2); }
        return j;
    }
};
template <class MAP>
__device__ __forceinline__ void p0_transpose_item(const float* W, int K, int N, int NOUT, bf16* WT, LAS float* scr, int item, int lane, const float* gain = nullptr) {
    const int nblk = NOUT / 32, kb = item / nblk, nb = item % nblk, k0 = 64 * kb, n0 = 32 * nb;
    const int sc = MAP::src(n0 + (lane & 31));
    float wv[32];
#pragma unroll
    for (int i = 0; i < 32; ++i) wv[i] = W[(size_t)(k0 + 2 * i + (lane >> 5)) * N + sc];
#pragma unroll
    for (int i = 0; i < 32; ++i) { const int kk = 2 * i + (lane >> 5); const float gk = gain ? gain[k0 + kk] : 1.f; scr[kk * 33 + (lane & 31)] = wv[i] * gk; }
    LDS_WAIT(); asm volatile("" ::: "memory");
    const int c = lane & 7;
#pragma unroll
    for (int j = 0; j < 4; ++j) { const int n = (lane >> 3) + 8 * j; const LAS float* s = scr + (8 * c) * 33 + n;
        v4u o; o.x = pk2(s[0 * 33], s[1 * 33]); o.y = pk2(s[2 * 33], s[3 * 33]); o.z = pk2(s[4 * 33], s[5 * 33]); o.w = pk2(s[6 * 33], s[7 * 33]);
        *(GAS v4u*)(WT + (size_t)(n0 + n) * K + k0 + 8 * c) = o; }
    LDS_WAIT(); asm volatile("" ::: "memory");
}
__device__ __forceinline__ void rms_row_to_bf16(const float* xrow, const float* g, bf16* orow, int lane) {
    const GAS f32x4* xr = (const GAS f32x4*)xrow + lane; const GAS f32x4* gr = (const GAS f32x4*)g + lane;
    f32x4 v[4]; float s = 0.f;
#pragma unroll
    for (int j = 0; j < 4; ++j) { v[j] = xr[64 * j]; s += (v[j].x * v[j].x + v[j].y * v[j].y) + (v[j].z * v[j].z + v[j].w * v[j].w); }
    const float r = rsqrtf(wave_sum(s) * (1.f / 1024.f) + RMS_EPS);
    GAS v2u* o8 = (GAS v2u*)orow + lane;
#pragma unroll
    for (int j = 0; j < 4; ++j) { const f32x4 gg = gr[64 * j]; v2u w; w.x = pk2(v[j].x * r * gg.x, v[j].y * r * gg.y); w.y = pk2(v[j].z * r * gg.z, v[j].w * r * gg.w); o8[64 * j] = w; }
}
template <int NR>
__device__ __forceinline__ void rms_rows_to_bf16(const float* x, const float* g, bf16* o, int m0, int stride, int lane) {
    f32x4 v[NR][4];
#pragma unroll
    for (int i = 0; i < NR; ++i) { const GAS f32x4* xr = (const GAS f32x4*)(x + (size_t)(m0 + i * stride) * 1024) + lane;
#pragma unroll
        for (int j = 0; j < 4; ++j) v[i][j] = xr[64 * j]; }
    f32x4 gg[4];
#pragma unroll
    for (int j = 0; j < 4; ++j) gg[j] = ((const GAS f32x4*)g + lane)[64 * j];
#pragma unroll
    for (int i = 0; i < NR; ++i) { float s = 0.f;
#pragma unroll
        for (int j = 0; j < 4; ++j) s += (v[i][j].x * v[i][j].x + v[i][j].y * v[i][j].y) + (v[i][j].z * v[i][j].z + v[i][j].w * v[i][j].w);
        const float r = rsqrtf(wave_sum(s) * (1.f / 1024.f) + RMS_EPS);
        GAS v2u* o8 = (GAS v2u*)(o + (size_t)(m0 + i * stride) * 1024) + lane;
#pragma unroll
        for (int j = 0; j < 4; ++j) { v2u w; w.x = pk2(v[i][j].x * r * gg[j].x, v[i][j].y * r * gg[j].y); w.y = pk2(v[i][j].z * r * gg[j].z, v[i][j].w * r * gg[j].w); o8[64 * j] = w; } }
}
__device__ __forceinline__ float fmax_asm(float a, float b) { float r; asm("v_max_f32 %0, %1, %2" : "=v"(r) : "v"(a), "v"(b)); return r; }
__device__ __forceinline__ float fmin_asm(float a, float b) { float r; asm("v_min_f32 %0, %1, %2" : "=v"(r) : "v"(a), "v"(b)); return r; }

#ifndef PH_MASK
#define PH_MASK 0xFFFFFFFFu
#endif
#define PH(k) ((PH_MASK >> (k)) & 1u)
#ifndef REP_MASK
#define REP_MASK 0u
#endif
#define NREP(k) (((REP_MASK >> (k)) & 1u) ? 2 : 1)
#ifndef DIAG_TS_A
#define DIAG_TS_A -1
#endif
#ifndef DIAG_TS_B
#define DIAG_TS_B -1
#endif
struct Args { const float* in[19]; float* out; unsigned char* ws; };

struct XOrder {
    const char* A; const char* Bt; int G, c, i0, mode;
    __device__ bool next(int i, pg8::Unit& u) const {
        if (i > 0) return false;
        const int L = i0 * G + c; if (L >= 512) return false;
        const int b = L >> 5, head = (L >> 3) & 3, rt = L & 7;
        u.pm = b * 8 + rt; u.pn = head;
        if (mode == 0) { u.a = A + (size_t)(b * 2048 + rt * 256) * 1024 * 2; u.b = Bt + (size_t)(head * 256) * 1024 * 2; }
        else { u.a = A + ((size_t)(b * 2048 + rt * 256) * 1024 + head * 256) * 2;
               u.b = (mode == 2) ? Bt + ((size_t)(head * 256) * 4096 + b * 256) * 2 : Bt + ((size_t)(b * 256) * 1024 + head * 256) * 2; }
        return true;
    }
};

__global__ void __launch_bounds__(NWAVES * 64, 2) mk_fwd(Args args) {
    extern __shared__ __attribute__((aligned(16))) unsigned char lds[];
    LAS unsigned char* L = (LAS unsigned char*)lds;
    volatile LAS unsigned* MISC = (volatile LAS unsigned*)(L + MISC_OFF);
    const int wave = __builtin_amdgcn_readfirstlane((int)threadIdx.x >> 6);
#define PH_LANES int tid = threadIdx.x; asm volatile("" : "+v"(tid)); const int lane = tid & 63; const int gt = vcu * (NWAVES * 64) + tid; (void)lane; (void)gt
    const int G = gridDim.x; const int bx = blockIdx.x; const int vcu = (G % 8 == 0) ? (bx % 8) * (G / 8) + bx / 8 : bx;
    unsigned char* ws = args.ws;
    gu32* ctl = (gu32*)(ws + WS_CTL);
    for (int u = threadIdx.x; u < (LDS_BYTES - LDSCTL_OFF) / 4; u += NWAVES * 64) ((LAS unsigned*)(L + LDSCTL_OFF))[u] = 0u;
    __syncthreads();
    XcdBarrier bar = xcd_barrier_post((unsigned*)(ctl + CW_BAR), MISC + 8);
    unsigned long long* tsw = (unsigned long long*)(ws + WS_CTL + 65536);
    int n_ts = 0;
#define TSTAMP() do { if (DIAG_TS_A >= 0) { if (bx == 0 && threadIdx.x == 0) tsw[n_ts] = __builtin_amdgcn_s_memrealtime(); ++n_ts; } } while (0)
    TSTAMP();

    const float *x = args.in[0], *mem = args.in[1], *g_mix = args.in[2], *w_in = args.in[3], *w_conv = args.in[4], *w_conv_out = args.in[5], *w_attn_out = args.in[6], *w_merge = args.in[7],
                *g_xattn = args.in[8], *g_mem = args.in[9], *w_xq = args.in[10], *w_xkv = args.in[11], *w_xo = args.in[12], *g_ffn = args.in[13], *w_pq = args.in[14], *sub_keys = args.in[15],
                *peer_u = args.in[16], *peer_v = args.in[17], *g_final = args.in[18];
    float* out = args.out;
    bf16 *WinT = (bf16*)(ws + WS_WIN), *WcT = (bf16*)(ws + WS_WC), *WaT = (bf16*)(ws + WS_WA), *WmT = (bf16*)(ws + WS_WM), *WxqT = (bf16*)(ws + WS_WXQ), *WxkvT = (bf16*)(ws + WS_WXKV),
         *WxoT = (bf16*)(ws + WS_WXO), *MT = (bf16*)(ws + WS_MT);
    float* ropec = (float*)(ws + WS_ROPE); float* ropes = ropec + 2048 * 32;
    float* kbar = (float*)(ws + WS_KBAR);
    bf16 *MEMN = (bf16*)(ws + WS_MEMN), *KX = (bf16*)(ws + WS_KX), *VXT = (bf16*)(ws + WS_VXT), *A = (bf16*)(ws + WS_A);
    bf16 *YC = (bf16*)(ws + WS_YC), *QO = (bf16*)(ws + WS_QO), *U = (bf16*)(ws + WS_U), *KB = (bf16*)(ws + WS_K), *VB = (bf16*)(ws + WS_V), *SGC = (bf16*)(ws + WS_SGC), *SGA = (bf16*)(ws + WS_SGA);
    bf16 *QX = (bf16*)(ws + WS_QX), *PM = (bf16*)(ws + WS_PM), *OX = (bf16*)(ws + WS_OX);
    _Float16* SC = (_Float16*)(ws + WS_SC);
    unsigned char* A8I = ws + WS_A8I; float* ASC = (float*)(ws + WS_ASC);
    int* EIDX = (int*)(ws + WS_EIDX); float* GW = (float*)(ws + WS_GW); unsigned* PW = (unsigned*)(ws + WS_PW);
    float* PO = (float*)(ws + WS_PO); float* SSQ1 = (float*)(ws + WS_SSQ1); float* SSQ2 = (float*)(ws + WS_SSQ2); (void)PO;
    unsigned char* U8 = ws + WS_U8; unsigned char* V8T = ws + WS_V8T; float* SU = (float*)(ws + WS_SU); float* SV = (float*)(ws + WS_SV);
    const int gw = vcu * NWAVES + wave, NGW = G * NWAVES;
    const int NGT = G * NWAVES * 64;

    asm volatile("; ===== PHASE 0 =====");
    if (PH(0)) for (int rep = 0; rep < NREP(0); ++rep) {
        PH_LANES; const bool dummy = rep < NREP(0) - 1; (void)dummy;
        LAS float* scr = (LAS float*)(L + RING_OFF + wave * 16384);
        constexpr int I_IN = (1024 / 64) * (5120 / 32), I_C = (512 / 64) * (1024 / 32), I_M = (1024 / 64) * (1024 / 32), I_KV = (1024 / 64) * (2048 / 32);
        constexpr int NITEMS = I_IN + 2 * I_C + 3 * I_M + I_KV;
        for (int it = gw; it < NITEMS; it += NGW) {
            int r = it;
            if (r < I_IN) { p0_transpose_item<MapWin>(w_in, 1024, 5120, 5120, WinT, scr, r, lane); continue; } r -= I_IN;
            if (r < I_C) { p0_transpose_item<MapId>(w_conv_out, 512, 1024, 1024, WcT, scr, r, lane); continue; } r -= I_C;
            if (r < I_C) { p0_transpose_item<MapId>(w_attn_out, 512, 1024, 1024, WaT, scr, r, lane); continue; } r -= I_C;
            if (r < I_M) { p0_transpose_item<MapId>(w_merge, 1024, 1024, 1024, WmT, scr, r, lane); continue; } r -= I_M;
            if (r < I_M) { p0_transpose_item<MapId>(w_xq, 1024, 1024, 1024, WxqT, scr, r, lane, g_xattn); continue; } r -= I_M;
            if (r < I_M) { p0_transpose_item<MapId>(w_xo, 1024, 1024, 1024, WxoT, scr, r, lane); continue; } r -= I_M;
            p0_transpose_item<MapId>(w_xkv, 1024, 2048, 2048, WxkvT, scr, r, lane);
        }
        { int m = gw; for (; m + 3 * NGW < T; m += 4 * NGW) rms_rows_to_bf16<4>(x, g_mix, A, m, NGW, lane); for (; m < T; m += NGW) rms_row_to_bf16(x + (size_t)m * D, g_mix, A + (size_t)m * D, lane); }
        { int m = gw; for (; m + NGW < MEMROWS; m += 2 * NGW) rms_rows_to_bf16<2>(mem, g_mem, MEMN, m, NGW, lane); for (; m < MEMROWS; m += NGW) rms_row_to_bf16(mem + (size_t)m * D, g_mem, MEMN + (size_t)m * D, lane); }
        for (int i = gt; i < 2048 * 32; i += NGT) { const int pos = i >> 5, f = i & 31; const float inv = powf(10000.0f, -(float)f / 32.0f); const float ang = (float)pos * inv; ropec[i] = cosf(ang); ropes[i] = sinf(ang); }
        __syncthreads();
        {
            LAS float* skl = (LAS float*)(L + RING_OFF);
            LAS float* wtl = skl + 128 * 129;
            for (int it = bx; it < 256; it += G) {
                const int hp = it >> 4, cb = it & 15;
                for (int i = tid; i < 128 * 128; i += NWAVES * 64) { const int n = i >> 7, d = i & 127; skl[n * 129 + d] = sub_keys[((size_t)hp * 128 + n) * 128 + d]; }
                for (int i = tid; i < 64 * 128; i += NWAVES * 64) { const int c = i >> 7, d = i & 127; wtl[c * 129 + d] = w_pq[(size_t)(cb * 64 + c) * 2048 + hp * 128 + d] * g_ffn[cb * 64 + c]; }
                __syncthreads();
                const int cg = tid & 15, ng = tid >> 4;
                float acc[4][4];
#pragma unroll
                for (int i = 0; i < 4; ++i)
#pragma unroll
                    for (int j = 0; j < 4; ++j) acc[i][j] = 0.f;
                for (int d = 0; d < 128; ++d) {
                    float wv[4], sv[4];
#pragma unroll
                    for (int i = 0; i < 4; ++i) { wv[i] = wtl[(4 * cg + i) * 129 + d]; sv[i] = skl[(4 * ng + i) * 129 + d]; }
#pragma unroll
                    for (int i = 0; i < 4; ++i)
#pragma unroll
                        for (int j = 0; j < 4; ++j) acc[i][j] += sv[i] * wv[j];
                }
#pragma unroll
                for (int i = 0; i < 4; ++i) { v2u w; w.x = pk2(acc[i][0], acc[i][1]); w.y = pk2(acc[i][2], acc[i][3]); *(GAS v2u*)(MT + (size_t)(hp * 128 + 4 * ng + i) * 1024 + cb * 64 + 4 * cg) = w; }
                __syncthreads();
            }
        }
    }
    xcd_barrier(bar); TSTAMP();

    asm volatile("; ===== PHASE 1 =====");
    if (PH(1)) for (int rep = 0; rep < NREP(1); ++rep) {
        PH_LANES; const bool dummy = rep < NREP(1) - 1; (void)dummy;
        pg8::Gemm g{1024, 1024, 1024}; pg8::StaticOrder S; S.init(A, 1024, WinT, 1024, T, INW, G, bx);
        pg8::EpiIn E{U, YC, QO, KB, VB, SGC, SGA, ropec, ropes, kbar, 0.125f * 1.4426950408889634f};
        pg8::gemm_phase<pg8::EpiIn, pg8::StaticOrder, true>(L + RING_OFF, g, S, E);
    }
    if (PH(1)) for (int rep = 0; rep < NREP(1); ++rep) {
        PH_LANES; const bool dummy = rep < NREP(1) - 1; (void)dummy;
        pg8::Gemm g{1024, 1024, 1024}; pg8::StaticOrder S; S.init(MEMN, 1024, WxkvT, 1024, MEMROWS, 1024, G, bx);
        pg8::EpiBf16 E{KX, 1024};
        pg8::gemm_phase<pg8::EpiBf16, pg8::StaticOrder, true>(L + RING_OFF, g, S, E);
    }
    if (PH(1)) for (int rep = 0; rep < NREP(1); ++rep) {
        PH_LANES; const bool dummy = rep < NREP(1) - 1; (void)dummy;
        pg8::Gemm g{1024, 1024, 1024}; pg8::StaticOrder S; S.init(WxkvT + (size_t)1024 * 1024, 1024, MEMN, 1024, 1024, MEMROWS, G, (bx + 128) % G);
        pg8::EpiBf16 E{VXT, 4096};
        pg8::gemm_phase<pg8::EpiBf16, pg8::StaticOrder, true>(L + RING_OFF, g, S, E);
    }
    if (PH(1)) for (int rep = 0; rep < NREP(1); ++rep) {
        PH_LANES; const bool dummy = rep < NREP(1) - 1; (void)dummy;
        int cb, ncb;
        if (G == 256) { const bool idle = (bx >= 64 && bx < 128) || bx >= 192; cb = idle ? ((bx < 128) ? bx - 64 : bx - 128) : 256; ncb = 128; } else { cb = bx; ncb = G; }
        const int cw = cb * NWAVES + wave, ncw = ncb * NWAVES;
        for (int e = (cb < ncb ? cw : 16384); e < 16384; e += ncw) {
            const GAS f32x4* r = (const GAS f32x4*)(peer_u + (size_t)e * D) + lane; f32x4 v[4]; float am = 0.f;
#pragma unroll
            for (int j = 0; j < 4; ++j) { v[j] = r[64 * j] * ((const GAS f32x4*)g_ffn + lane)[64 * j]; am = fmaxf(fmaxf(am, fmaxf(fabsf(v[j].x), fabsf(v[j].y))), fmaxf(fabsf(v[j].z), fabsf(v[j].w))); }
            am = wave_max(am);
            const float sc = am > 0.f ? 127.f / am : 1.f; if (lane == 0) SU[e] = am > 0.f ? am * (1.f / 127.f) : 1.f;
#pragma unroll
            for (int j = 0; j < 4; ++j) { const unsigned w = ((unsigned)(int)rintf(v[j].x * sc) & 255u) | (((unsigned)(int)rintf(v[j].y * sc) & 255u) << 8) | (((unsigned)(int)rintf(v[j].z * sc) & 255u) << 16) | (((unsigned)(int)rintf(v[j].w * sc) & 255u) << 24);
                *(GAS unsigned*)(U8 + (size_t)e * 1024 + 4 * lane + 256 * j) = w; }
        }
        __syncthreads();
        for (int it = cb; it < 256; it += ncb) {
            const int e0 = it * 64;
#pragma unroll 1
            for (int rr = 0; rr < 8; ++rr) {
                const int el = wave * 8 + rr, e = e0 + el;
                const GAS f32x4* r = (const GAS f32x4*)(peer_v + (size_t)e * D) + lane; f32x4 v[4]; float am = 0.f;
#pragma unroll
                for (int j = 0; j < 4; ++j) { v[j] = r[64 * j]; am = fmaxf(fmaxf(am, fmaxf(fabsf(v[j].x), fabsf(v[j].y))), fmaxf(fabsf(v[j].z), fabsf(v[j].w))); }
                am = wave_max(am);
                const float sc = am > 0.f ? 4.f / am : 1.f; if (lane == 0) SV[e] = am > 0.f ? am * 0.25f : 1.f;
#pragma unroll
                for (int j = 0; j < 4; ++j) { int w = __builtin_amdgcn_cvt_pk_bf8_f32(v[j].x * sc, v[j].y * sc, 0, false); w = __builtin_amdgcn_cvt_pk_bf8_f32(v[j].z * sc, v[j].w * sc, w, true);
                    *(LAS unsigned*)(L + RING_OFF + el * 1024 + 4 * lane + 256 * j) = (unsigned)w; }
            }
            __syncthreads();
#pragma unroll
            for (int i = 0; i < 8; ++i) { const int idx = tid + 512 * i, sl = idx >> 5, k = idx & 31;
                const v2u a0 = *(const LAS v2u*)(L + RING_OFF + (2 * k) * 1024 + sl * 8), a1 = *(const LAS v2u*)(L + RING_OFF + (2 * k + 1) * 1024 + sl * 8);
                *(GAS v4u*)(V8T + ((size_t)sl * 16384 + e0 + 2 * k) * 8) = (v4u){a0.x, a0.y, a1.x, a1.y}; }
            __syncthreads();
        }
    }
    xcd_barrier(bar); TSTAMP();

    asm volatile("; ===== PHASE 2 =====");
    if (PH(2)) for (int rep = 0; rep < NREP(2); ++rep) {
        PH_LANES; const bool dummy = rep < NREP(2) - 1; (void)dummy;
        for (int i = gt; i < T * 64; i += NGT) {
            const int row = i >> 6, cg = i & 63, s = row & 2047;
            const v4u u0 = *(const GAS v4u*)(U + (size_t)row * 512 + cg * 8);
            v4u u1 = (v4u){0u, 0u, 0u, 0u}, u2 = (v4u){0u, 0u, 0u, 0u};
            if (s >= 1) u1 = *(const GAS v4u*)(U + (size_t)(row - 1) * 512 + cg * 8);
            if (s >= 2) u2 = *(const GAS v4u*)(U + (size_t)(row - 2) * 512 + cg * 8);
            const v4u bq = *(const GAS v4u*)(YC + (size_t)row * 512 + cg * 8);
            const f32x4 w0a = *(const GAS f32x4*)(w_conv + cg * 8), w0b = *(const GAS f32x4*)(w_conv + cg * 8 + 4);
            const f32x4 w1a = *(const GAS f32x4*)(w_conv + 512 + cg * 8), w1b = *(const GAS f32x4*)(w_conv + 512 + cg * 8 + 4);
            const f32x4 w2a = *(const GAS f32x4*)(w_conv + 1024 + cg * 8), w2b = *(const GAS f32x4*)(w_conv + 1024 + cg * 8 + 4);
            v4u o;
#define CONV2(q, wa, ia, ib) pk2(bflo(bq.q) * (w0##wa[ia] * bflo(u2.q) + w1##wa[ia] * bflo(u1.q) + w2##wa[ia] * bflo(u0.q)), bfhi(bq.q) * (w0##wa[ib] * bfhi(u2.q) + w1##wa[ib] * bfhi(u1.q) + w2##wa[ib] * bfhi(u0.q)))
            o.x = CONV2(x, a, 0, 1); o.y = CONV2(y, a, 2, 3); o.z = CONV2(z, b, 0, 1); o.w = CONV2(w, b, 2, 3);
#undef CONV2
            { const bool conv_dummy = (NREP(2) == 2) && !dummy; *(GAS v4u*)(YC + (size_t)row * 512 + cg * 8) = conv_dummy ? bq : o; }
        }
        __syncthreads();
        const attn_body::AttnTensors AT{(const attn_body::bf16*)QO, (const attn_body::bf16*)KB, (const attn_body::bf16*)VB, (attn_body::bf16*)(dummy ? A : QO), kbar};
        const attn_body::StaticOrder S(G, bx);
        attn_body::attn_phase<attn_body::StaticOrder>((char*)lds + RING_OFF, AT, S);
    }
    xcd_barrier(bar); TSTAMP();

    asm volatile("; ===== PHASE 3 =====");
    if (PH(3)) for (int rep = 0; rep < NREP(3); ++rep) {
        PH_LANES; const bool dummy = rep < NREP(3) - 1; (void)dummy;
        pg8::Gemm g{512, 512, 512}; pg8::StaticOrder S; S.init(YC, 512, WcT, 512, T, 1024, G, bx);
        pg8::EpiGateMul E{SGC, dummy ? A : SGC, 1024};
        pg8::gemm_phase<pg8::EpiGateMul, pg8::StaticOrder, true>(L + RING_OFF, g, S, E);
    }
    if (PH(3)) for (int rep = 0; rep < NREP(3); ++rep) {
        PH_LANES; const bool dummy = rep < NREP(3) - 1; (void)dummy;
        pg8::Gemm g{512, 512, 512}; pg8::StaticOrder S; S.init(QO, 512, WaT, 512, T, 1024, G, bx);
        pg8::EpiGateFma E{SGC, SGA, dummy ? A : SGA, 1024};
        pg8::gemm_phase<pg8::EpiGateFma, pg8::StaticOrder, true>(L + RING_OFF, g, S, E);
    }
    xcd_barrier(bar); TSTAMP();

    asm volatile("; ===== PHASE 4 =====");
    if (PH(4)) for (int rep = 0; rep < NREP(4); ++rep) {
        PH_LANES; const bool dummy = rep < NREP(4) - 1; (void)dummy;
        pg8::Gemm g{1024, 1024, 1024}; pg8::StaticOrder S; S.init(SGA, 1024, WmT, 1024, T, 1024, G, bx);
        pg8::EpiResNorm<true> E{x, A, SSQ1, 1024, 1.f};
        pg8::gemm_phase<pg8::EpiResNorm<true>, pg8::StaticOrder, true>(L + RING_OFF, g, S, E);
    }
    xcd_barrier(bar); TSTAMP();

    asm volatile("; ===== PHASE 6 =====");
    if (PH(6)) for (int rep = 0; rep < NREP(6); ++rep) {
        PH_LANES; const bool dummy = rep < NREP(6) - 1; (void)dummy;
        const pg8::Gemm gq{1024, 1024, 1024}, gs{1024, 1024, 256}, gv{1024, 4096, 256};
        const pg8::EpiBf16RS Eq{QX, 1024, SSQ1}; const pg8::EpiSoftmax Es{PM, 1024, 0.0625f * 1.4426950408889634f}; const pg8::EpiBf16 Ev{OX, 1024};
        { XOrder S{(const char*)A, (const char*)WxqT, G, vcu, 0, 0}; pg8::gemm_phase<pg8::EpiBf16RS, XOrder, false>(L + RING_OFF, gq, S, Eq); }
        VM_WAIT(); __syncthreads();
        { XOrder S{(const char*)QX, (const char*)KX, G, vcu, 0, 1}; pg8::gemm_phase<pg8::EpiSoftmax, XOrder, false>(L + RING_OFF, gs, S, Es); }
        VM_WAIT(); __syncthreads();
        { XOrder S{(const char*)PM, (const char*)VXT, G, vcu, 0, 2}; pg8::gemm_phase<pg8::EpiBf16, XOrder, false>(L + RING_OFF, gv, S, Ev); }
        VM_WAIT(); __syncthreads();
        { XOrder S{(const char*)A, (const char*)WxqT, G, vcu, 1, 0}; pg8::gemm_phase<pg8::EpiBf16RS, XOrder, false>(L + RING_OFF, gq, S, Eq); }
        VM_WAIT(); __syncthreads();
        { XOrder S{(const char*)QX, (const char*)KX, G, vcu, 1, 1}; pg8::gemm_phase<pg8::EpiSoftmax, XOrder, false>(L + RING_OFF, gs, S, Es); }
        VM_WAIT(); __syncthreads();
        { XOrder S{(const char*)PM, (const char*)VXT, G, vcu, 1, 2}; pg8::gemm_phase<pg8::EpiBf16, XOrder, false>(L + RING_OFF, gv, S, Ev); }
    }
    xcd_barrier(bar); TSTAMP();

    asm volatile("; ===== PHASE 9 =====");
    if (PH(9)) for (int rep = 0; rep < NREP(9); ++rep) {
        PH_LANES; const bool dummy = rep < NREP(9) - 1; (void)dummy;
        pg8::Gemm g{1024, 1024, 1024}; pg8::StaticOrder S; S.init(OX, 1024, WxoT, 1024, T, 1024, G, bx);
        pg8::EpiResNorm<false> E{nullptr, A, SSQ2, 1024, dummy ? 0.f : 1.f};
        pg8::gemm_phase<pg8::EpiResNorm<false>, pg8::StaticOrder, true>(L + RING_OFF, g, S, E);
    }
    xcd_barrier(bar); TSTAMP();

    asm volatile("; ===== PHASE 11 =====");
    if (PH(11)) for (int rep = 0; rep < NREP(11); ++rep) {
        PH_LANES; const bool dummy = rep < NREP(11) - 1; (void)dummy;
        pg8::Gemm g{1024, 1024, 1024}; pg8::StaticOrder S; S.init(A, 1024, MT, 1024, T, 2048, G, bx);
        pg8::EpiF16RS E{SC, 2048, SSQ2};
        pg8::gemm_phase<pg8::EpiF16RS, pg8::StaticOrder, true>(L + RING_OFF, g, S, E);
    }
    xcd_barrier(bar); TSTAMP();

    asm volatile("; ===== PHASE 12 =====");
    if (PH(12)) for (int rep = 0; rep < NREP(12); ++rep) {
        PH_LANES; const bool dummy = rep < NREP(12) - 1; (void)dummy;
        typedef _Float16 h8 __attribute__((ext_vector_type(8)));
#define RCE(a, b) do { const float hi_ = fmax_asm(a, b); b = fmin_asm(a, b); a = hi_; } while (0)
#define RSORT16(K) do { RCE(K[0], K[1]); RCE(K[3], K[2]); RCE(K[4], K[5]); RCE(K[7], K[6]); RCE(K[8], K[9]); RCE(K[11], K[10]); RCE(K[12], K[13]); RCE(K[15], K[14]); RCE(K[0], K[2]); RCE(K[1], K[3]); RCE(K[6], K[4]); RCE(K[7], K[5]); RCE(K[8], K[10]); RCE(K[9], K[11]); RCE(K[14], K[12]); RCE(K[15], K[13]); RCE(K[0], K[1]); RCE(K[2], K[3]); RCE(K[5], K[4]); RCE(K[7], K[6]); RCE(K[8], K[9]); RCE(K[10], K[11]); RCE(K[13], K[12]); RCE(K[15], K[14]); RCE(K[0], K[4]); RCE(K[1], K[5]); RCE(K[2], K[6]); RCE(K[3], K[7]); RCE(K[12], K[8]); RCE(K[13], K[9]); RCE(K[14], K[10]); RCE(K[15], K[11]); RCE(K[0], K[2]); RCE(K[1], K[3]); RCE(K[4], K[6]); RCE(K[5], K[7]); RCE(K[10], K[8]); RCE(K[11], K[9]); RCE(K[14], K[12]); RCE(K[15], K[13]); RCE(K[0], K[1]); RCE(K[2], K[3]); RCE(K[4], K[5]); RCE(K[6], K[7]); RCE(K[9], K[8]); RCE(K[11], K[10]); RCE(K[13], K[12]); RCE(K[15], K[14]); RCE(K[0], K[8]); RCE(K[1], K[9]); RCE(K[2], K[10]); RCE(K[3], K[11]); RCE(K[4], K[12]); RCE(K[5], K[13]); RCE(K[6], K[14]); RCE(K[7], K[15]); RCE(K[0], K[4]); RCE(K[1], K[5]); RCE(K[2], K[6]); RCE(K[3], K[7]); RCE(K[8], K[12]); RCE(K[9], K[13]); RCE(K[10], K[14]); RCE(K[11], K[15]); RCE(K[0], K[2]); RCE(K[1], K[3]); RCE(K[4], K[6]); RCE(K[5], K[7]); RCE(K[8], K[10]); RCE(K[9], K[11]); RCE(K[12], K[14]); RCE(K[13], K[15]); RCE(K[0], K[1]); RCE(K[2], K[3]); RCE(K[4], K[5]); RCE(K[6], K[7]); RCE(K[8], K[9]); RCE(K[10], K[11]); RCE(K[12], K[13]); RCE(K[14], K[15]); } while (0)
#define RMERGE16(K) do { RCE(K[0], K[8]); RCE(K[1], K[9]); RCE(K[2], K[10]); RCE(K[3], K[11]); RCE(K[4], K[12]); RCE(K[5], K[13]); RCE(K[6], K[14]); RCE(K[7], K[15]); RCE(K[0], K[4]); RCE(K[1], K[5]); RCE(K[2], K[6]); RCE(K[3], K[7]); RCE(K[8], K[12]); RCE(K[9], K[13]); RCE(K[10], K[14]); RCE(K[11], K[15]); RCE(K[0], K[2]); RCE(K[1], K[3]); RCE(K[4], K[6]); RCE(K[5], K[7]); RCE(K[8], K[10]); RCE(K[9], K[11]); RCE(K[12], K[14]); RCE(K[13], K[15]); RCE(K[0], K[1]); RCE(K[2], K[3]); RCE(K[4], K[5]); RCE(K[6], K[7]); RCE(K[8], K[9]); RCE(K[10], K[11]); RCE(K[12], K[13]); RCE(K[14], K[15]); } while (0)
#define RKEYS(K, V0, V1, IDB) do { _Pragma("unroll") for (int e = 0; e < 8; ++e) { K[e] = __uint_as_float(__float_as_uint((float)V0[e]) | (unsigned)((IDB) + e)); K[8 + e] = __uint_as_float(__float_as_uint((float)V1[e]) | (unsigned)((IDB) + 8 + e)); } } while (0)
        for (int tb4 = gw * 4; tb4 < T; tb4 += NGW * 4) {
            v4u r0[4], r1[4]; float sq[4];
#pragma unroll
            for (int i = 0; i < 4; ++i) { const GAS v4u* ar = (const GAS v4u*)(A + (size_t)(tb4 + i) * D + 16 * lane); r0[i] = ar[0]; r1[i] = ar[1]; sq[i] = lane < 16 ? SSQ2[(size_t)(tb4 + i) * 16 + lane] : 0.f; }
#pragma unroll
            for (int i = 0; i < 4; ++i) {
                float a[16];
                a[0] = bflo(r0[i].x); a[1] = bfhi(r0[i].x); a[2] = bflo(r0[i].y); a[3] = bfhi(r0[i].y); a[4] = bflo(r0[i].z); a[5] = bfhi(r0[i].z); a[6] = bflo(r0[i].w); a[7] = bfhi(r0[i].w);
                a[8] = bflo(r1[i].x); a[9] = bfhi(r1[i].x); a[10] = bflo(r1[i].y); a[11] = bfhi(r1[i].y); a[12] = bflo(r1[i].z); a[13] = bfhi(r1[i].z); a[14] = bflo(r1[i].w); a[15] = bfhi(r1[i].w);
                float amx = 0.f;
#pragma unroll
                for (int k = 0; k < 16; ++k) amx = fmaxf(amx, fabsf(a[k]));
                amx = wave_max(amx);
                const float rs2 = rsqrtf(wave_sum(sq[i]) * (1.f / 1024.f) + RMS_EPS);
                const float asc = amx > 0.f ? 127.f / amx : 1.f;
                v4u qv;
#define QP4(k) (((unsigned)(int)rintf(a[4 * (k)] * asc) & 255u) | (((unsigned)(int)rintf(a[4 * (k) + 1] * asc) & 255u) << 8) | (((unsigned)(int)rintf(a[4 * (k) + 2] * asc) & 255u) << 16) | (((unsigned)(int)rintf(a[4 * (k) + 3] * asc) & 255u) << 24))
                qv.x = QP4(0); qv.y = QP4(1); qv.z = QP4(2); qv.w = QP4(3);
#undef QP4
                *(GAS v4u*)(A8I + (size_t)(tb4 + i) * 1024 + 16 * lane) = qv;
                if (lane == 0) ASC[tb4 + i] = (amx > 0.f ? amx * (1.f / 127.f) : 1.f) * rs2;
            }
        }
        LAS unsigned char* idl = L + RING_OFF + tid * 32;
        for (int task = gt; task < T * 8; task += NGT) {
            const int t = task >> 3, h = task & 7;
            const _Float16* row = SC + (size_t)t * 2048 + h * 256;
            float LA[16], LB[16];
#pragma unroll 1
            for (int p = 0; p < 2; ++p) {
                const _Float16* rp = row + p * 128;
                float Tk[16];
                h8 n0 = *(const h8*)(rp + 16), n1 = *(const h8*)(rp + 24);
                { const h8 v0 = *(const h8*)rp, v1 = *(const h8*)(rp + 8); RKEYS(Tk, v0, v1, 0); RSORT16(Tk); }
#pragma unroll 1
                for (int c = 1; c < 8; ++c) {
                    const h8 v0 = n0, v1 = n1;
                    { const int cn = c < 7 ? c + 1 : c; n0 = *(const h8*)(rp + cn * 16); n1 = *(const h8*)(rp + cn * 16 + 8); }
                    float K[16]; RKEYS(K, v0, v1, c * 16); RSORT16(K);
#pragma unroll
                    for (int i = 0; i < 16; ++i) Tk[i] = fmax_asm(Tk[i], K[15 - i]);
                    RMERGE16(Tk);
                }
#pragma unroll
                for (int k = 0; k < 16; ++k) { if (p == 0) LA[k] = Tk[k]; else LB[k] = Tk[k]; }
            }
#pragma unroll
            for (int k = 0; k < 16; k += 4) {
                ((LAS unsigned*)idl)[k >> 2] = (__float_as_uint(LA[k]) & 127u) | ((__float_as_uint(LA[k + 1]) & 127u) << 8) | ((__float_as_uint(LA[k + 2]) & 127u) << 16) | ((__float_as_uint(LA[k + 3]) & 127u) << 24);
                ((LAS unsigned*)idl)[4 + (k >> 2)] = (__float_as_uint(LB[k]) & 127u) | ((__float_as_uint(LB[k + 1]) & 127u) << 8) | ((__float_as_uint(LB[k + 2]) & 127u) << 16) | ((__float_as_uint(LB[k + 3]) & 127u) << 24);
            }
#define CKEY(a, b) __uint_as_float((__float_as_uint(LA[a] + LB[b]) & ~255u) | (unsigned)(255 - (16 * (a) + (b))))
            float Ck[16];
#pragma unroll
            for (int a = 0; a < 16; ++a) Ck[a] = CKEY(a, 0);
#define CRUN(b, n) do { _Pragma("unroll") for (int j = 0; j < (n); ++j) Ck[15 - j] = fmax_asm(Ck[15 - j], CKEY(j, b)); RMERGE16(Ck); } while (0)
            CRUN(1, 8); CRUN(2, 5); CRUN(3, 4); CRUN(4, 3); CRUN(5, 2); CRUN(6, 2); CRUN(7, 2);
#pragma unroll
            for (int j = 0; j < 8; ++j) Ck[15 - j] = fmax_asm(Ck[15 - j], CKEY(0, 8 + j));
            RMERGE16(Ck);
#undef CRUN
#undef CKEY
            LDS_WAIT();
            float ex[16]; float sum = 0.f;
#pragma unroll
            for (int k = 0; k < 16; ++k) { ex[k] = __expf(Ck[k] - Ck[0]); sum += ex[k]; }
            const float rs = 1.f / sum;
            int* eo = EIDX + (size_t)t * 128 + h * 16;
#pragma unroll
            for (int k = 0; k < 16; k += 4) {
                int ev[4];
#pragma unroll
                for (int j = 0; j < 4; ++j) { const unsigned id = 255u - (__float_as_uint(Ck[k + j]) & 255u); ev[j] = (int)idl[id >> 4] * 128 + (int)idl[16 + (id & 15u)]; }
                *(GAS v4u*)(eo + k) = (v4u){(pk2(0.f, ex[k] * rs) & 0xffff0000u) | (unsigned)ev[0], (pk2(0.f, ex[k + 1] * rs) & 0xffff0000u) | (unsigned)ev[1],
                                             (pk2(0.f, ex[k + 2] * rs) & 0xffff0000u) | (unsigned)ev[2], (pk2(0.f, ex[k + 3] * rs) & 0xffff0000u) | (unsigned)ev[3]};
            }
            LDS_WAIT();
        }
#undef RCE
#undef RSORT16
#undef RMERGE16
#undef RKEYS
    }
    xcd_barrier(bar); TSTAMP();

    asm volatile("; ===== PHASE 13 =====");
    if (PH(13)) for (int rep = 0; rep < NREP(13); ++rep) {
        PH_LANES; const bool dummy = rep < NREP(13) - 1; (void)dummy;
        volatile LAS unsigned* qslot = (volatile LAS unsigned*)(L + LDSCTL_OFF + 64);
        LAS unsigned char* tile = L + RING_OFF + wave * 8192;
        LAS float* rsl = (LAS float*)(L + UL_OFF + wave * UL_WAVE);
        LAS v4u* lst = (LAS v4u*)(L + UL_OFF + wave * UL_WAVE + 64);
        const int xs = (int)(xb_xcc_id() & 7u);
        __syncthreads();
        if (tid == 0) *qslot = __hip_atomic_fetch_add((unsigned*)(ctl + CW_Q + 64 * (rep * 8 + xs)), 1u, __ATOMIC_RELAXED, __HIP_MEMORY_SCOPE_AGENT);
        __syncthreads();
        const int rank = __builtin_amdgcn_readfirstlane((int)*qslot);
        int cnt[8];
#pragma unroll
        for (int j = 0; j < 8; ++j) cnt[j] = __builtin_amdgcn_readfirstlane((int)(xb_ld(bar.bar + XB_XCNT(j)) + xb_ld(bar.bar + XB_XCNT(j + 8))));
#pragma unroll 1
        for (int x = 0; x < 8; ++x) {
            int cn = 0;
#pragma unroll
            for (int j = 0; j < 8; ++j) cn = (j == x) ? cnt[j] : cn;
            int j0, jstep;
            if (x == xs) { j0 = rank * 8 + wave; jstep = cn * 8; } else if (cn == 0) { j0 = bx * 8 + wave; jstep = G * 8; } else continue;
#pragma unroll 1
            for (int job = j0; job < T / 8; job += jstep) {
                const int t0 = job * 8;
#pragma unroll 1
                for (int r0 = 0;; r0 += UL_CAP) {
                    int ln = lane; asm volatile("" : "+v"(ln));
#pragma unroll
                    for (int tl = 0; tl < 8; ++tl)
                        __builtin_amdgcn_global_load_lds((const unsigned*)(A8I + (size_t)(t0 + tl) * 1024 + ln * 16), (LAS unsigned*)(tile + tl * 1024), 16, 0, 0);
                    if (ln < 8) rsl[ln] = ASC[t0 + ln];
                    unsigned pa[8], pb[8];
#pragma unroll
                    for (int tl = 0; tl < 8; ++tl) { pa[tl] = (unsigned)EIDX[(size_t)(t0 + tl) * 128 + ln]; pb[tl] = (unsigned)EIDX[(size_t)(t0 + tl) * 128 + 64 + ln]; }
                    int total = 0; unsigned long long m0s[8], m1s[8];
#pragma unroll
                    for (int tl = 0; tl < 8; ++tl) { m0s[tl] = __ballot((int)((pa[tl] & 0xffffu) >> 11) == x); m1s[tl] = __ballot((int)((pb[tl] & 0xffffu) >> 11) == x); total += __popcll(m0s[tl]) + __popcll(m1s[tl]); }
                    float sua[8], sva[8], sub[8], svb[8];
#pragma unroll
                    for (int tl = 0; tl < 8; ++tl) { sua[tl] = sva[tl] = sub[tl] = svb[tl] = 0.f;
                        if ((m0s[tl] >> lane) & 1ull) { sua[tl] = SU[pa[tl] & 0xffffu]; sva[tl] = SV[pa[tl] & 0xffffu]; }
                        if ((m1s[tl] >> lane) & 1ull) { sub[tl] = SU[pb[tl] & 0xffffu]; svb[tl] = SV[pb[tl] & 0xffffu]; } }
                    asm volatile("s_waitcnt vmcnt(0) lgkmcnt(0)" ::: "memory");
                    int base = -r0;
#pragma unroll
                    for (int tl = 0; tl < 8; ++tl) {
                        const int n0 = __popcll(m0s[tl]), n1 = __popcll(m1s[tl]); const float rs = rsl[tl];
                        const int k0 = base + (int)__builtin_amdgcn_mbcnt_hi((unsigned)(m0s[tl] >> 32), __builtin_amdgcn_mbcnt_lo((unsigned)m0s[tl], 0u));
                        const int k1 = base + n0 + (int)__builtin_amdgcn_mbcnt_hi((unsigned)(m1s[tl] >> 32), __builtin_amdgcn_mbcnt_lo((unsigned)m1s[tl], 0u));
                        if (((m0s[tl] >> lane) & 1ull) && k0 >= 0 && k0 < UL_CAP) lst[k0] = (v4u){pa[tl], (unsigned)((tl << 7) | lane), __float_as_uint(sua[tl] * rs), __float_as_uint(__uint_as_float(pa[tl] & 0xffff0000u) * sva[tl])};
                        if (((m1s[tl] >> lane) & 1ull) && k1 >= 0 && k1 < UL_CAP) lst[k1] = (v4u){pb[tl], (unsigned)((tl << 7) | 64 | lane), __float_as_uint(sub[tl] * rs), __float_as_uint(__uint_as_float(pb[tl] & 0xffff0000u) * svb[tl])};
                        base += n0 + n1;
                    }
                    const int count = (total - r0) < UL_CAP ? (total - r0) : UL_CAP;
                    asm volatile("s_waitcnt lgkmcnt(0)" ::: "memory");
#define JLOAD(Q, EN, B16) do { const int myi_ = (B16) + (lane & 15); EN = lst[myi_ < count ? myi_ : count - 1];         \
                        _Pragma("unroll") for (int k = 0; k < 16; ++k) { const int e_ = __builtin_amdgcn_readlane((int)EN.x, k) & 0xffff; Q[k] = *(const GAS v4u*)(U8 + (size_t)e_ * 1024 + 16 * lane); } } while (0)
#define JCOMP(Q, EN, B16) do { int d[16]; \
                        _Pragma("unroll") for (int k = 0; k < 16; ++k) { const int tl_ = __builtin_amdgcn_readlane((int)EN.y, k) >> 7; const v4u qa_ = *(const LAS v4u*)(tile + tl_ * 1024 + lane * 16); \
                            d[k] = __builtin_amdgcn_sdot4((int)Q[k].w, (int)qa_.w, __builtin_amdgcn_sdot4((int)Q[k].z, (int)qa_.z, __builtin_amdgcn_sdot4((int)Q[k].y, (int)qa_.y, __builtin_amdgcn_sdot4((int)Q[k].x, (int)qa_.x, 0, false), false), false), false); } \
                        int r8[8], r4[4], r2[2]; \
                        _Pragma("unroll") for (int i = 0; i < 8; ++i) { auto sw = __builtin_amdgcn_permlane32_swap((unsigned)d[i], (unsigned)d[i + 8], false, false); r8[i] = (int)(sw[0] + sw[1]); } \
                        _Pragma("unroll") for (int i = 0; i < 4; ++i) { auto sw = __builtin_amdgcn_permlane16_swap((unsigned)r8[i], (unsigned)r8[i + 4], false, false); r4[i] = (int)(sw[0] + sw[1]); } \
                        const bool b3 = (lane >> 3) & 1, b2 = (lane >> 2) & 1; \
                        _Pragma("unroll") for (int i = 0; i < 2; ++i) { const int keep = b3 ? r4[i + 2] : r4[i], send = b3 ? r4[i] : r4[i + 2]; r2[i] = keep + __builtin_amdgcn_ds_swizzle(send, (8 << 10) | 0x1f); } \
                        int doti; { const int keep = b2 ? r2[1] : r2[0], send = b2 ? r2[0] : r2[1]; doti = keep + __builtin_amdgcn_ds_swizzle(send, (4 << 10) | 0x1f); } \
                        doti += __builtin_amdgcn_ds_swizzle(doti, (2 << 10) | 0x1f); doti += __builtin_amdgcn_ds_swizzle(doti, (1 << 10) | 0x1f); \
                          \
                        const int sl_ = (lane >> 2) * 4; \
                        const unsigned ex = (unsigned)__builtin_amdgcn_ds_bpermute(sl_, (int)EN.x), ey = (unsigned)__builtin_amdgcn_ds_bpermute(sl_, (int)EN.y); \
                        const float eus = __uint_as_float((unsigned)__builtin_amdgcn_ds_bpermute(sl_, (int)EN.z)), evs = __uint_as_float((unsigned)__builtin_amdgcn_ds_bpermute(sl_, (int)EN.w)); \
                        if ((lane & 3) == 0 && (B16) + (lane >> 2) < count) { \
                            const int e = (int)(ex & 0xffffu), slot = (int)(ey & 127u); const int t = t0 + (int)(ey >> 7); \
                            const float act = (float)doti * eus; const float u3 = 0.7978845608028654f * (act + 0.044715f * act * act * act); \
                            const float wv = act * __builtin_amdgcn_rcpf(1.f + __expf(-2.f * u3)) * evs;             \
                            PW[((size_t)((t >> 6) * 8 + (slot >> 4)) * 4 + ((slot >> 2) & 3)) * 256 + (t & 63) * 4 + (slot & 3)] = ((unsigned)__builtin_bit_cast(unsigned short, (_Float16)wv) << 16) | (unsigned)e;     } } while (0)
                    if (count > 0) {
                        v4u qa[16], qb[16]; v4u ena, enb;
                        JLOAD(qa, ena, 0);
#pragma unroll 1
                        for (int b16 = 0; b16 < count; b16 += 32) {
                            const bool has_b = b16 + 16 < count;
                            if (has_b) JLOAD(qb, enb, b16 + 16);
                            JCOMP(qa, ena, b16);
                            if (has_b) { if (b16 + 32 < count) JLOAD(qa, ena, b16 + 32); JCOMP(qb, enb, b16 + 16); }
                        }
                    }
#undef JLOAD
#undef JCOMP
                    asm volatile("s_waitcnt lgkmcnt(0)" ::: "memory");
                    if (r0 + UL_CAP >= total) break;
                }
            }
        }
        __syncthreads();
    }
    xcd_barrier(bar); TSTAMP();

    asm volatile("; ===== PHASE 14 =====");
    if (PH(14)) for (int rep = 0; rep < NREP(14); ++rep) {
        PH_LANES; const bool dummy = rep < NREP(14) - 1; (void)dummy;
        for (int item = vcu; item < 256; item += G) {
            const int sl = item & 127, half = item >> 7;
            __syncthreads();
#pragma unroll
            for (int i = 0; i < 16; ++i) *(LAS v4u*)(L + RING_OFF + (i * 512 + tid) * 16) = *(const GAS v4u*)(V8T + (size_t)sl * 131072 + (size_t)(i * 512 + tid) * 16);
            __syncthreads();
            const GAS v4u* pwb = (const GAS v4u*)(PW + (size_t)(half * 256 + wave) * 8192) + lane;
            v4u buf[4][4];
#pragma unroll
            for (int c = 0; c < 4; ++c)
#pragma unroll
                for (int k = 0; k < 4; ++k) buf[c][k] = pwb[c * 256 + k * 64];
#pragma unroll 1
            for (int itk = 0; itk < 32; ++itk) {
                const int g64 = half * 256 + itk * 8 + wave;
                const int t = g64 * 64 + lane;
                h2v acc[4] = {(h2v){(_Float16)0, (_Float16)0}, (h2v){(_Float16)0, (_Float16)0}, (h2v){(_Float16)0, (_Float16)0}, (h2v){(_Float16)0, (_Float16)0}};
#pragma unroll
                for (int c = 0; c < 8; ++c) {
                    v4u cur[4];
#pragma unroll
                    for (int k = 0; k < 4; ++k) cur[k] = buf[c & 3][k];
                    { const int sn = itk * 8 + c + 4; const int gn = (sn >> 3) > 31 ? 31 : (sn >> 3), cc = sn & 7; const GAS v4u* src = pwb + (size_t)gn * 8 * 2048 + cc * 256;
#pragma unroll
                      for (int k = 0; k < 4; ++k) buf[c & 3][k] = src[k * 64]; }
                    v2u tb[16];
#pragma unroll
                    for (int k = 0; k < 4; ++k)
#pragma unroll
                        for (int i = 0; i < 4; ++i) { const unsigned p = cur[k][i]; tb[k * 4 + i] = *(const LAS v2u*)(L + RING_OFF + ((p & 0xffffu) << 3)); }
#pragma unroll
                    for (int k = 0; k < 4; ++k)
#pragma unroll
                        for (int i = 0; i < 4; ++i) { const unsigned p = cur[k][i]; const v2u q = tb[k * 4 + i];
                            const h2v ww = __builtin_bit_cast(h2v, __builtin_amdgcn_perm(p, p, 0x03020302u));
                            acc[0] += ww * __builtin_bit_cast(h2v, __builtin_amdgcn_perm(0u, q.x, 0x010c000cu)); acc[1] += ww * __builtin_bit_cast(h2v, __builtin_amdgcn_perm(0u, q.x, 0x030c020cu));
                            acc[2] += ww * __builtin_bit_cast(h2v, __builtin_amdgcn_perm(0u, q.y, 0x010c000cu)); acc[3] += ww * __builtin_bit_cast(h2v, __builtin_amdgcn_perm(0u, q.y, 0x030c020cu)); }
                }
                GAS v4u* hr = (GAS v4u*)(A + (size_t)t * D + sl * 8);
                const v4u hq = *hr; const float mulv = dummy ? 0.f : 1.f;
                v4u ho; ho.x = pk2(bflo(hq.x) + (float)acc[0].x * mulv, bfhi(hq.x) + (float)acc[0].y * mulv); ho.y = pk2(bflo(hq.y) + (float)acc[1].x * mulv, bfhi(hq.y) + (float)acc[1].y * mulv);
                ho.z = pk2(bflo(hq.z) + (float)acc[2].x * mulv, bfhi(hq.z) + (float)acc[2].y * mulv); ho.w = pk2(bflo(hq.w) + (float)acc[3].x * mulv, bfhi(hq.w) + (float)acc[3].y * mulv);
                *hr = ho;
            }
        }
    }
    xcd_barrier(bar); TSTAMP();

#ifdef EXTRA_BARRIERS
    for (int eb = 0; eb < EXTRA_BARRIERS; ++eb) xcd_barrier(bar);
#endif
    asm volatile("; ===== PHASE 15 =====");
    if (PH(15)) for (int rep = 0; rep < NREP(15); ++rep) {
        PH_LANES; const bool dummy = rep < NREP(15) - 1; (void)dummy;
        for (int t = gw; t < T; t += NGW) {
            const GAS v4u* hr = (const GAS v4u*)(A + (size_t)t * D + 16 * lane); const v4u q0 = hr[0], q1 = hr[1];
            const GAS f32x4* gr = (const GAS f32x4*)(g_final + 16 * lane); GAS f32x4* orow = (GAS f32x4*)(out + (size_t)t * D + 16 * lane);
            f32x4 o[4] = {(f32x4){bflo(q0.x), bfhi(q0.x), bflo(q0.y), bfhi(q0.y)}, (f32x4){bflo(q0.z), bfhi(q0.z), bflo(q0.w), bfhi(q0.w)},
                          (f32x4){bflo(q1.x), bfhi(q1.x), bflo(q1.y), bfhi(q1.y)}, (f32x4){bflo(q1.z), bfhi(q1.z), bflo(q1.w), bfhi(q1.w)}};
            float ss = 0.f;
#pragma unroll
            for (int j = 0; j < 4; ++j) ss += (o[j].x * o[j].x + o[j].y * o[j].y) + (o[j].z * o[j].z + o[j].w * o[j].w);
            const float r = rsqrtf(wave_sum(ss) * (1.f / 1024.f) + RMS_EPS);
#pragma unroll
            for (int j = 0; j < 4; ++j) orow[j] = o[j] * r * gr[j];
        }
    }
}

extern "C" void kernel_launch(void* const* d_in, const int* in_sizes, int n_in, void* d_out, int out_size, void* d_ws, size_t ws_size, hipStream_t stream) {
    static int grid = 0;
    if (grid == 0) {
        if (n_in != 19 || out_size != T * D || ws_size < WS_END) { fprintf(stderr, "kernel_launch: unexpected problem (n_in %d, out %d, ws %zu < %zu); nothing launched\n", n_in, out_size, ws_size, (size_t)WS_END); grid = -1; return; }
        int dev = 0, cus = 0, per_cu = 0;
        if (hipGetDevice(&dev) != hipSuccess || hipDeviceGetAttribute(&cus, hipDeviceAttributeMultiprocessorCount, dev) != hipSuccess) { grid = -1; return; }
        if (hipFuncSetAttribute((const void*)mk_fwd, hipFuncAttributeMaxDynamicSharedMemorySize, LDS_BYTES) != hipSuccess) { fprintf(stderr, "kernel_launch: hipFuncSetAttribute failed\n"); grid = -1; return; }
        if (hipOccupancyMaxActiveBlocksPerMultiprocessor(&per_cu, (const void*)mk_fwd, NWAVES * 64, LDS_BYTES) != hipSuccess || per_cu < 1) { fprintf(stderr, "kernel_launch: occupancy query says %d blocks per CU\n", per_cu); }
        (void)hipGetLastError();
        grid = cus;
    }
    if (grid < 0) return;
    if (hipMemsetAsync((char*)d_ws + WS_CTL, 0, CTL_ZERO_BYTES, stream) != hipSuccess) return;
    Args a{};
    for (int i = 0; i < 19; ++i) a.in[i] = (const float*)d_in[i];
    a.out = (float*)d_out; a.ws = (unsigned char*)d_ws;
    hipLaunchKernelGGL(mk_fwd, dim3(grid), dim3(NWAVES * 64), LDS_BYTES, stream, a);
}
```

```cpp
#include <hip/hip_runtime.h>
#include <hip/hip_bf16.h>
#include <cstdio>
#include <cstdint>
#include <cmath>

#ifndef DIAG
#define DIAG 0
#endif


template <int O> __device__ __forceinline__ float shx(float v) { static_assert(O > 0 && O < 32, "shx"); return __uint_as_float((unsigned)__builtin_amdgcn_ds_swizzle((int)__float_as_uint(v), (O << 10) | 0x1f)); }
__device__ __forceinline__ float sum32(float v) { auto r = __builtin_amdgcn_permlane32_swap(__float_as_uint(v), __float_as_uint(v), false, false); return __uint_as_float(r[0]) + __uint_as_float(r[1]); }
__device__ __forceinline__ float max32(float v) { auto r = __builtin_amdgcn_permlane32_swap(__float_as_uint(v), __float_as_uint(v), false, false); return fmaxf(__uint_as_float(r[0]), __uint_as_float(r[1])); }
__device__ __forceinline__ float wave_max(float v) { v = fmaxf(v, shx<1>(v)); v = fmaxf(v, shx<2>(v)); v = fmaxf(v, shx<4>(v)); v = fmaxf(v, shx<8>(v)); v = fmaxf(v, shx<16>(v)); return max32(v); }
__device__ __forceinline__ float wave_sum(float v) { v += shx<1>(v); v += shx<2>(v); v += shx<4>(v); v += shx<8>(v); v += shx<16>(v); return sum32(v); }

namespace pg8 {
#define PG8_LAS __attribute__((address_space(3)))
typedef unsigned short bf16_t;
typedef short bf16x8 __attribute__((ext_vector_type(8)));
typedef float f32x4 __attribute__((ext_vector_type(4)));
typedef float f32x2 __attribute__((ext_vector_type(2)));
typedef unsigned u32x4 __attribute__((ext_vector_type(4)));
typedef unsigned u32x2 __attribute__((ext_vector_type(2)));
constexpr int BM = 256, BK = 64, HALF = 128, HTB = HALF * BK * 2  , STAGE_BYTES = 8 * HTB, NXCD = 8, WGM = 4;

__host__ __device__ __forceinline__ int lds_byte(int r, int c) { const int st = (r >> 4) * 2 + (c >> 5), rr = r & 15, cc = c & 31, ob = rr * 64 + cc * 2; return st * 1024 + (ob ^ (((ob >> 9) & 1) << 5)); }
__host__ __device__ __forceinline__ void stage_rc(int b, int& R, int& C) { const int st = b / 1024, sb = b % 1024, swz = sb ^ (((sb >> 9) & 1) << 5); R = (st >> 1) * 16 + swz / 64; C = (st & 1) * 32 + (swz % 64) / 2; }
__host__ __device__ __forceinline__ int perm32(int rho) { const int n = rho >> 4, i = rho & 15; return 8 * (i >> 2) + 4 * n + (i & 3); }

struct Unit { int pm, pn; const char* a; const char* b; };
struct Gemm { int lda, ldb, K; };

struct StaticOrder {
    int nM, nN, nwg, G, c; const char* A; const char* Bt; size_t astep, bstep;
    __device__ void init(const void* A_, int lda, const void* Bt_, int ldb, int M, int N, int G_, int c_) { nM = M / BM; nN = N / BM; nwg = nM * nN; G = G_; c = c_; A = (const char*)A_; Bt = (const char*)Bt_; astep = (size_t)BM * lda * 2; bstep = (size_t)BM * ldb * 2; }
    __device__ bool next(int i, Unit& u) const {
        const long L = (long)i * G + c; if (L >= nwg) return false;
        int wgid = (int)L; { const int q = nwg / NXCD, r = nwg % NXCD, xcd = wgid % NXCD, off = wgid / NXCD; wgid = (xcd < r ? xcd * (q + 1) : r * (q + 1) + (xcd - r) * q) + off; }
        const int nig = WGM * nN, gid = wgid / nig, fm = gid * WGM, gsz = (nM - fm) < WGM ? (nM - fm) : WGM;
        u.pm = fm + ((wgid % nig) % gsz); u.pn = (wgid % nig) / gsz; u.a = A + (size_t)u.pm * astep; u.b = Bt + (size_t)u.pn * bstep; return true;
    }
};

__device__ __forceinline__ unsigned cvt_pk_bf16(float lo, float hi) { typedef __bf16 bf2 __attribute__((ext_vector_type(2))); f32x2 v = {lo, hi}; bf2 b = __builtin_convertvector(v, bf2); return __builtin_bit_cast(unsigned, b); }
__device__ __forceinline__ float bf_lo(unsigned u) { return __uint_as_float(u << 16); }
__device__ __forceinline__ float bf_hi(unsigned u) { return __uint_as_float(u & 0xffff0000u); }

template <class Epi, class Sched, bool ALIGN_EPI>
__device__ __forceinline__ void gemm_phase(PG8_LAS unsigned char* lds, const Gemm g, const Sched& S, const Epi& E) {
    int tid = threadIdx.x; asm volatile("" : "+v"(tid));
    const int wid = __builtin_amdgcn_readfirstlane(tid >> 6), lane = tid & 63, wr = wid >> 2, wc = wid & 3, fr = lane & 15, fq = lane >> 4;
    const int K = g.K, nt = K / BK;
    unsigned voffA[2], voffB[2];
#pragma unroll
    for (int i = 0; i < 2; ++i) { int R, C; stage_rc(tid * 16 + i * 8192, R, C); const int Rb = Epi::PERM ? ((R & ~31) + perm32(R & 31)) : R;
        voffA[i] = (unsigned)(R * g.lda + C) * 2u; voffB[i] = (unsigned)(Rb * g.ldb + C) * 2u; }
    const size_t kstep = (size_t)(BK * 2);
    const size_t hstepA = (size_t)HALF * g.lda * 2, hstepB = (size_t)HALF * g.ldb * 2;
    const unsigned ldsw = (unsigned)wid * 1024u;
    const int aoff = lds_byte(wr * 64 + fr, fq * 8), boff = lds_byte(wc * 32 + fr, fq * 8);
#define PG8_SA(b, h) (((b) * 2 + (h)) * HTB)
#define PG8_SB(b, h) ((4 + (b) * 2 + (h)) * HTB)
#define PG8_STAGE(bufoff, gbase, voff) do { _Pragma("unroll") for (int _i = 0; _i < 2; ++_i) \
        __builtin_amdgcn_global_load_lds((const unsigned*)((const char*)(gbase) + (voff)[_i]), (PG8_LAS unsigned*)(lds + (bufoff) + ldsw + _i * 8192), 16, 0, 0); } while (0)
#define PG8_LDA(dst, b, h) do { _Pragma("unroll") for (int m = 0; m < 4; ++m) _Pragma("unroll") for (int k = 0; k < 2; ++k) dst[m][k] = *(const PG8_LAS bf16x8*)(lds + PG8_SA(b, h) + aoff + m * 2048 + k * 1024); } while (0)
#define PG8_LDB(dst, b, h) do { _Pragma("unroll") for (int n = 0; n < 2; ++n) _Pragma("unroll") for (int k = 0; k < 2; ++k) dst[n][k] = *(const PG8_LAS bf16x8*)(lds + PG8_SB(b, h) + boff + n * 2048 + k * 1024); } while (0)
#define PG8_MMA(ai, bj, At, Bt) do { __builtin_amdgcn_s_setprio(1); _Pragma("unroll") for (int m = 0; m < 4; ++m) _Pragma("unroll") for (int n = 0; n < 2; ++n) _Pragma("unroll") for (int k = 0; k < 2; ++k) \
        acc[ai][bj][m][n] = __builtin_amdgcn_mfma_f32_16x16x32_bf16(Bt[n][k], At[m][k], acc[ai][bj][m][n], 0, 0, 0); __builtin_amdgcn_s_setprio(0); } while (0)
#define PG8_WAIT_V(n) asm volatile("s_waitcnt vmcnt(" #n ")" ::: "memory")
#define PG8_WAIT_L(n) asm volatile("s_waitcnt lgkmcnt(" #n ")" ::: "memory")
#define PG8_BAR __builtin_amdgcn_s_barrier()
#define PG8_SCHED __builtin_amdgcn_sched_barrier(0)
    Unit cur, nxt; int ui = 0;
    if (!S.next(0, cur)) return;
    f32x4 acc[2][2][4][2];
#pragma unroll
    for (int a = 0; a < 2; ++a)
#pragma unroll
        for (int b = 0; b < 2; ++b)
#pragma unroll
            for (int m = 0; m < 4; ++m)
#pragma unroll
                for (int n = 0; n < 2; ++n) acc[a][b][m][n] = (f32x4){0.f, 0.f, 0.f, 0.f};
    bf16x8 At[4][2], B0[2][2], B1[2][2];
    const char* cA = cur.a; const char* cB = cur.b;
    PG8_STAGE(PG8_SB(0, 0), cB, voffB); PG8_STAGE(PG8_SB(0, 1), cB + hstepB, voffB); PG8_STAGE(PG8_SA(0, 0), cA, voffA); PG8_STAGE(PG8_SA(0, 1), cA + hstepA, voffA);
    if (wr == 1) PG8_BAR;
    PG8_WAIT_V(2); PG8_BAR;
    PG8_STAGE(PG8_SB(1, 0), cB + kstep, voffB); PG8_STAGE(PG8_SA(1, 0), cA + kstep, voffA); PG8_STAGE(PG8_SB(1, 1), cB + hstepB + kstep, voffB);
    PG8_WAIT_V(6); PG8_BAR;
    for (;;) {
        const bool has_next = S.next(ui + 1, nxt);
        const char* nA = has_next ? nxt.a : cA; const char* nB = has_next ? nxt.b : cB;
        for (int t = 0; t < nt; t += 2) {
            const bool last = (t == nt - 2);
            const char* a1 = cA + (size_t)(t + 1) * kstep;
            const char* a2 = last ? nA : cA + (size_t)(t + 2) * kstep; const char* b2 = last ? nB : cB + (size_t)(t + 2) * kstep;
            const char* a3 = a2 + kstep; const char* b3 = b2 + kstep;
            PG8_LDB(B0, 0, 0); PG8_LDB(B1, 0, 1); PG8_SCHED; PG8_LDA(At, 0, 0); PG8_STAGE(PG8_SA(1, 1), a1 + hstepA, voffA);
            PG8_WAIT_V(8); PG8_WAIT_L(0); PG8_BAR; PG8_MMA(0, 0, At, B0); PG8_MMA(0, 1, At, B1); PG8_BAR; PG8_SCHED;
            PG8_LDA(At, 0, 1); PG8_STAGE(PG8_SB(0, 0), b2, voffB); PG8_STAGE(PG8_SB(0, 1), b2 + hstepB, voffB); PG8_STAGE(PG8_SA(0, 0), a2, voffA);
            PG8_WAIT_V(8); PG8_WAIT_L(0); PG8_BAR; PG8_MMA(1, 0, At, B0); PG8_MMA(1, 1, At, B1); PG8_BAR; PG8_SCHED;
            PG8_LDB(B0, 1, 0); PG8_LDB(B1, 1, 1); PG8_SCHED; PG8_LDA(At, 1, 0); PG8_STAGE(PG8_SA(0, 1), a2 + hstepA, voffA);
            PG8_WAIT_V(8); PG8_WAIT_L(0); PG8_BAR; PG8_MMA(0, 0, At, B0); PG8_MMA(0, 1, At, B1); PG8_BAR; PG8_SCHED;
            PG8_LDA(At, 1, 1); PG8_STAGE(PG8_SB(1, 0), b3, voffB); PG8_STAGE(PG8_SB(1, 1), b3 + hstepB, voffB); PG8_STAGE(PG8_SA(1, 0), a3, voffA);
            PG8_WAIT_V(8); PG8_WAIT_L(0); PG8_BAR; PG8_MMA(1, 0, At, B0); PG8_MMA(1, 1, At, B1); PG8_BAR; PG8_SCHED;
        }
        if constexpr (ALIGN_EPI) { if (wr == 0) PG8_BAR; }
        if constexpr (!Epi::AFTER_DRAIN) { E(acc, cur, wr, wc, fr, fq); }
        if (!has_next) break;
#pragma unroll
        for (int a = 0; a < 2; ++a)
#pragma unroll
            for (int b = 0; b < 2; ++b)
#pragma unroll
                for (int m = 0; m < 4; ++m)
#pragma unroll
                    for (int n = 0; n < 2; ++n) acc[a][b][m][n] = (f32x4){0.f, 0.f, 0.f, 0.f};
        cur = nxt; cA = nA; cB = nB; ++ui;
        if constexpr (ALIGN_EPI) { if (wr == 1) PG8_BAR; }
    }
    PG8_WAIT_V(0);
    if constexpr (!ALIGN_EPI) { if (wr == 0) PG8_BAR; }
    PG8_BAR;
    if constexpr (Epi::AFTER_DRAIN) { E.fused(acc, cur, wr, wc, fr, fq, lds, wid, lane); }
#undef PG8_SA
#undef PG8_SB
#undef PG8_STAGE
#undef PG8_LDA
#undef PG8_LDB
#undef PG8_MMA
#undef PG8_WAIT_V
#undef PG8_WAIT_L
#undef PG8_BAR
#undef PG8_SCHED
}

typedef f32x4 AccT[2][2][4][2];

struct EpiBf16 {
    static constexpr bool PERM = true, AFTER_DRAIN = false;
    bf16_t* O; int ldc;
    __device__ __forceinline__ void operator()(const AccT& acc, const Unit& u, int wr, int wc, int fr, int fq) const {
        { int t_ = threadIdx.x; asm volatile("" : "+v"(t_)); fr = t_ & 15; fq = (t_ >> 4) & 3; }
        const int row0 = u.pm * BM + wr * 64 + fr, col0 = u.pn * BM + wc * 32 + 8 * fq;
#pragma unroll
        for (int ai = 0; ai < 2; ++ai)
#pragma unroll
            for (int m = 0; m < 4; ++m) { bf16_t* rowp = O + (size_t)(row0 + ai * HALF + m * 16) * ldc + col0;
#pragma unroll
                for (int bj = 0; bj < 2; ++bj) { const f32x4 v0 = acc[ai][bj][m][0], v1 = acc[ai][bj][m][1];
                    u32x4 w; w.x = cvt_pk_bf16(v0[0], v0[1]); w.y = cvt_pk_bf16(v0[2], v0[3]); w.z = cvt_pk_bf16(v1[0], v1[1]); w.w = cvt_pk_bf16(v1[2], v1[3]);
                    *(u32x4*)(rowp + bj * HALF) = w; } }
    }
};
struct EpiF16 {
    static constexpr bool PERM = true, AFTER_DRAIN = false;
    _Float16* O; int ldc;
    __device__ __forceinline__ void operator()(const AccT& acc, const Unit& u, int wr, int wc, int fr, int fq) const {
        { int t_ = threadIdx.x; asm volatile("" : "+v"(t_)); fr = t_ & 15; fq = (t_ >> 4) & 3; }
        typedef _Float16 h8 __attribute__((ext_vector_type(8)));
        const int row0 = u.pm * BM + wr * 64 + fr, col0 = u.pn * BM + wc * 32 + 8 * fq;
#pragma unroll
        for (int ai = 0; ai < 2; ++ai)
#pragma unroll
            for (int m = 0; m < 4; ++m) { _Float16* rowp = O + (size_t)(row0 + ai * HALF + m * 16) * ldc + col0;
#pragma unroll
                for (int bj = 0; bj < 2; ++bj) { const f32x4 v0 = acc[ai][bj][m][0], v1 = acc[ai][bj][m][1];
                    h8 w = {(_Float16)v0[0], (_Float16)v0[1], (_Float16)v0[2], (_Float16)v0[3], (_Float16)v1[0], (_Float16)v1[1], (_Float16)v1[2], (_Float16)v1[3]};
                    *(h8*)(rowp + bj * HALF) = w; } }
    }
};
struct EpiGateMul {
    static constexpr bool PERM = true, AFTER_DRAIN = false;
    const bf16_t* G; bf16_t* Dst; int ldc;
    __device__ __forceinline__ void operator()(const AccT& acc, const Unit& u, int wr, int wc, int fr, int fq) const {
        { int t_ = threadIdx.x; asm volatile("" : "+v"(t_)); fr = t_ & 15; fq = (t_ >> 4) & 3; }
        const int row0 = u.pm * BM + wr * 64 + fr, col0 = u.pn * BM + wc * 32 + 8 * fq;
#pragma unroll
        for (int ai = 0; ai < 2; ++ai)
#pragma unroll
            for (int m = 0; m < 4; ++m) { const size_t roff = (size_t)(row0 + ai * HALF + m * 16) * ldc + col0; const bf16_t* rowg = G + roff; bf16_t* rowp = Dst + roff;
#pragma unroll
                for (int bj = 0; bj < 2; ++bj) { const f32x4 v0 = acc[ai][bj][m][0], v1 = acc[ai][bj][m][1]; const u32x4 gq = *(const u32x4*)(rowg + bj * HALF);
                    u32x4 w; w.x = cvt_pk_bf16(v0[0] * bf_lo(gq.x), v0[1] * bf_hi(gq.x)); w.y = cvt_pk_bf16(v0[2] * bf_lo(gq.y), v0[3] * bf_hi(gq.y));
                    w.z = cvt_pk_bf16(v1[0] * bf_lo(gq.z), v1[1] * bf_hi(gq.z)); w.w = cvt_pk_bf16(v1[2] * bf_lo(gq.w), v1[3] * bf_hi(gq.w));
                    *(u32x4*)(rowp + bj * HALF) = w; } }
    }
};
struct EpiGateFma {
    static constexpr bool PERM = true, AFTER_DRAIN = false;
    const bf16_t* Tm; const bf16_t* G2; bf16_t* Dst; int ldc;
    __device__ __forceinline__ void operator()(const AccT& acc, const Unit& u, int wr, int wc, int fr, int fq) const {
        { int t_ = threadIdx.x; asm volatile("" : "+v"(t_)); fr = t_ & 15; fq = (t_ >> 4) & 3; }
        const int row0 = u.pm * BM + wr * 64 + fr, col0 = u.pn * BM + wc * 32 + 8 * fq;
#pragma unroll
        for (int ai = 0; ai < 2; ++ai)
#pragma unroll
            for (int m = 0; m < 4; ++m) { const size_t off = (size_t)(row0 + ai * HALF + m * 16) * ldc + col0;
#pragma unroll
                for (int bj = 0; bj < 2; ++bj) { const f32x4 v0 = acc[ai][bj][m][0], v1 = acc[ai][bj][m][1]; const u32x4 gq = *(const u32x4*)(G2 + off + bj * HALF); const u32x4 tq = *(const u32x4*)(Tm + off + bj * HALF);
                    u32x4 w; w.x = cvt_pk_bf16(bf_lo(tq.x) + v0[0] * bf_lo(gq.x), bf_hi(tq.x) + v0[1] * bf_hi(gq.x)); w.y = cvt_pk_bf16(bf_lo(tq.y) + v0[2] * bf_lo(gq.y), bf_hi(tq.y) + v0[3] * bf_hi(gq.y));
                    w.z = cvt_pk_bf16(bf_lo(tq.z) + v1[0] * bf_lo(gq.z), bf_hi(tq.z) + v1[1] * bf_hi(gq.z)); w.w = cvt_pk_bf16(bf_lo(tq.w) + v1[2] * bf_lo(gq.w), bf_hi(tq.w) + v1[3] * bf_hi(gq.w));
                    *(u32x4*)(Dst + off + bj * HALF) = w; } }
    }
};
struct EpiResF32 {
    static constexpr bool PERM = false, AFTER_DRAIN = false;
    const float* res; float* out; int ldc; float mul;
    __device__ __forceinline__ void operator()(const AccT& acc, const Unit& u, int wr, int wc, int fr, int fq) const {
        { int t_ = threadIdx.x; asm volatile("" : "+v"(t_)); fr = t_ & 15; fq = (t_ >> 4) & 3; }
        const int row0 = u.pm * BM + wr * 64 + fr, col0 = u.pn * BM + wc * 32 + 4 * fq;
#pragma unroll
        for (int ai = 0; ai < 2; ++ai)
#pragma unroll
            for (int m = 0; m < 4; ++m) { const size_t off = (size_t)(row0 + ai * HALF + m * 16) * ldc + col0;
#pragma unroll
                for (int bj = 0; bj < 2; ++bj)
#pragma unroll
                    for (int n = 0; n < 2; ++n) { const f32x4 r = *(const f32x4*)(res + off + bj * HALF + n * 16); *(f32x4*)(out + off + bj * HALF + n * 16) = r + acc[ai][bj][m][n] * mul; } }
    }
};

__device__ __forceinline__ float row_rs(const float* ssq, int row) {
    const f32x4* p = (const f32x4*)(ssq + (size_t)row * 16); const f32x4 a = p[0], b = p[1], c = p[2], d = p[3];
    const float s = ((a[0] + a[1]) + (a[2] + a[3])) + ((b[0] + b[1]) + (b[2] + b[3])) + ((c[0] + c[1]) + (c[2] + c[3])) + ((d[0] + d[1]) + (d[2] + d[3]));
    return rsqrtf(s * (1.f / 1024.f) + 1e-6f);
}
struct EpiBf16RS {
    static constexpr bool PERM = true, AFTER_DRAIN = false;
    bf16_t* O; int ldc; const float* ssq;
    __device__ __forceinline__ void operator()(const AccT& acc, const Unit& u, int wr, int wc, int fr, int fq) const {
        { int t_ = threadIdx.x; asm volatile("" : "+v"(t_)); fr = t_ & 15; fq = (t_ >> 4) & 3; }
        const int row0 = u.pm * BM + wr * 64 + fr, col0 = u.pn * BM + wc * 32 + 8 * fq;
#pragma unroll
        for (int ai = 0; ai < 2; ++ai)
#pragma unroll
            for (int m = 0; m < 4; ++m) { int ro = row0 + ai * HALF + m * 16; asm volatile("" : "+v"(ro)); const float rs = row_rs(ssq, ro); bf16_t* rowp = O + (size_t)ro * ldc + col0;
#pragma unroll
                for (int bj = 0; bj < 2; ++bj) { const f32x4 v0 = acc[ai][bj][m][0] * rs, v1 = acc[ai][bj][m][1] * rs;
                    u32x4 w; w.x = cvt_pk_bf16(v0[0], v0[1]); w.y = cvt_pk_bf16(v0[2], v0[3]); w.z = cvt_pk_bf16(v1[0], v1[1]); w.w = cvt_pk_bf16(v1[2], v1[3]);
                    *(u32x4*)(rowp + bj * HALF) = w; } }
    }
};
struct EpiF16RS {
    static constexpr bool PERM = true, AFTER_DRAIN = false;
    _Float16* O; int ldc; const float* ssq;
    __device__ __forceinline__ void operator()(const AccT& acc, const Unit& u, int wr, int wc, int fr, int fq) const {
        { int t_ = threadIdx.x; asm volatile("" : "+v"(t_)); fr = t_ & 15; fq = (t_ >> 4) & 3; }
        typedef _Float16 h8 __attribute__((ext_vector_type(8)));
        const int row0 = u.pm * BM + wr * 64 + fr, col0 = u.pn * BM + wc * 32 + 8 * fq;
#pragma unroll
        for (int ai = 0; ai < 2; ++ai)
#pragma unroll
            for (int m = 0; m < 4; ++m) { int ro = row0 + ai * HALF + m * 16; asm volatile("" : "+v"(ro)); const float rs = row_rs(ssq, ro); _Float16* rowp = O + (size_t)ro * ldc + col0;
#pragma unroll
                for (int bj = 0; bj < 2; ++bj) { const f32x4 v0 = acc[ai][bj][m][0] * rs, v1 = acc[ai][bj][m][1] * rs;
                    h8 w = {(_Float16)v0[0], (_Float16)v0[1], (_Float16)v0[2], (_Float16)v0[3], (_Float16)v1[0], (_Float16)v1[1], (_Float16)v1[2], (_Float16)v1[3]};
                    *(h8*)(rowp + bj * HALF) = w; } }
    }
};
template <bool RES_F32> struct EpiResNorm {
    static constexpr bool PERM = true, AFTER_DRAIN = false;
    const float* resf; bf16_t* H; float* ssq; int ldc; float mul;
    __device__ __forceinline__ void operator()(const AccT& acc, const Unit& u, int wr, int wc, int fr, int fq) const {
        { int t_ = threadIdx.x; asm volatile("" : "+v"(t_)); fr = t_ & 15; fq = (t_ >> 4) & 3; }
        const int row0 = u.pm * BM + wr * 64 + fr, col0 = u.pn * BM + wc * 32 + 8 * fq;
#pragma unroll
        for (int ai = 0; ai < 2; ++ai)
#pragma unroll
            for (int m = 0; m < 4; ++m) { int ro = row0 + ai * HALF + m * 16; asm volatile("" : "+v"(ro)); const size_t off = (size_t)ro * ldc + col0; float ss = 0.f;
#pragma unroll
                for (int bj = 0; bj < 2; ++bj) { f32x4 r0, r1;
                    if (RES_F32) { r0 = *(const f32x4*)(resf + off + bj * HALF); r1 = *(const f32x4*)(resf + off + bj * HALF + 4); }
                    else { const u32x4 q = *(const u32x4*)(H + off + bj * HALF); r0 = (f32x4){bf_lo(q.x), bf_hi(q.x), bf_lo(q.y), bf_hi(q.y)}; r1 = (f32x4){bf_lo(q.z), bf_hi(q.z), bf_lo(q.w), bf_hi(q.w)}; }
                    const f32x4 v0 = r0 + acc[ai][bj][m][0] * mul, v1 = r1 + acc[ai][bj][m][1] * mul;
                    ss += ((v0[0] * v0[0] + v0[1] * v0[1]) + (v0[2] * v0[2] + v0[3] * v0[3])) + ((v1[0] * v1[0] + v1[1] * v1[1]) + (v1[2] * v1[2] + v1[3] * v1[3]));
                    u32x4 w; w.x = cvt_pk_bf16(v0[0], v0[1]); w.y = cvt_pk_bf16(v0[2], v0[3]); w.z = cvt_pk_bf16(v1[0], v1[1]); w.w = cvt_pk_bf16(v1[2], v1[3]);
                    *(u32x4*)(H + off + bj * HALF) = w; }
                ss += shx<16>(ss); ss = sum32(ss);
                if (fq == 0) ssq[(size_t)ro * 16 + u.pn * 4 + wc] = ss; }
    }
};
struct EpiIn {
    static constexpr bool PERM = true, AFTER_DRAIN = false;
    bf16_t *U, *Bb, *Q, *Kb, *V, *SGC, *SGA; const float* ropec; const float* ropes; float* kbar; float qscale;
    __device__ __forceinline__ void operator()(const AccT& acc, const Unit& u, int wr, int wc, int fr, int fq) const {
        { int t_ = threadIdx.x; asm volatile("" : "+v"(t_)); fr = t_ & 15; fq = (t_ >> 4) & 3; }
        const int pn = u.pn; const int row0 = u.pm * BM + wr * 64 + fr;
        if (pn < 4) {
            const int c0 = 128 * pn + 16 * wc + 4 * fq;
#pragma unroll
            for (int ai = 0; ai < 2; ++ai)
#pragma unroll
                for (int m = 0; m < 4; ++m) { int ro = row0 + ai * HALF + m * 16; asm volatile("" : "+v"(ro)); bf16_t* rowp = U + (size_t)ro * 512 + c0;
#pragma unroll
                    for (int bj = 0; bj < 2; ++bj) { const f32x4 x = acc[ai][bj][m][0] * acc[ai][bj][m][1]; u32x2 w; w.x = cvt_pk_bf16(x[0], x[1]); w.y = cvt_pk_bf16(x[2], x[3]); *(u32x2*)(rowp + bj * 64) = w; } }
        } else if (pn < 6 || (pn >= 10 && pn < 12)) {
            bf16_t* O = pn < 6 ? Bb : V; const int col0 = (pn < 6 ? pn - 4 : pn - 10) * BM + wc * 32 + 8 * fq;
#pragma unroll
            for (int ai = 0; ai < 2; ++ai)
#pragma unroll
                for (int m = 0; m < 4; ++m) { int ro = row0 + ai * HALF + m * 16; asm volatile("" : "+v"(ro)); bf16_t* rowp = O + (size_t)ro * 512 + col0;
#pragma unroll
                    for (int bj = 0; bj < 2; ++bj) { const f32x4 v0 = acc[ai][bj][m][0], v1 = acc[ai][bj][m][1];
                        u32x4 w; w.x = cvt_pk_bf16(v0[0], v0[1]); w.y = cvt_pk_bf16(v0[2], v0[3]); w.z = cvt_pk_bf16(v1[0], v1[1]); w.w = cvt_pk_bf16(v1[2], v1[3]);
                        *(u32x4*)(rowp + bj * HALF) = w; } }
        } else if (pn < 10) {
            const bool isk = pn >= 8; bf16_t* O = isk ? Kb : Q; const int colt = (isk ? pn - 8 : pn - 6) * BM + wc * 32 + 8 * fq;
            const int g4 = 4 * (4 * (wc & 1) + fq);
            const float sc = isk ? 1.f : qscale;
            f32x4 cs0[2] = {(f32x4){0.f, 0.f, 0.f, 0.f}, (f32x4){0.f, 0.f, 0.f, 0.f}}, cs1[2] = {(f32x4){0.f, 0.f, 0.f, 0.f}, (f32x4){0.f, 0.f, 0.f, 0.f}};
#pragma unroll
            for (int ai = 0; ai < 2; ++ai)
#pragma unroll
                for (int m = 0; m < 4; ++m) { int row = row0 + ai * HALF + m * 16; asm volatile("" : "+v"(row)); const int pos = row & 2047;
                    const f32x4 c = *(const f32x4*)(ropec + pos * 32 + g4) * sc, s = *(const f32x4*)(ropes + pos * 32 + g4) * sc;
                    bf16_t* rowp = O + (size_t)row * 512 + colt;
#pragma unroll
                    for (int bj = 0; bj < 2; ++bj) { const f32x4 x1 = acc[ai][bj][m][0], x2 = acc[ai][bj][m][1]; const f32x4 o1 = x1 * c - x2 * s, o2 = x2 * c + x1 * s;
                        cs0[bj] += o1; cs1[bj] += o2;
                        u32x4 w; w.x = cvt_pk_bf16(o1[0], o1[1]); w.y = cvt_pk_bf16(o1[2], o1[3]); w.z = cvt_pk_bf16(o2[0], o2[1]); w.w = cvt_pk_bf16(o2[2], o2[3]);
                        *(u32x4*)(rowp + bj * HALF) = w; }
                    asm volatile("" : "+v"(cs0[0]), "+v"(cs0[1]), "+v"(cs1[0]), "+v"(cs1[1]) :: "memory"); }
            if (isk) {
#pragma unroll
                for (int bj = 0; bj < 2; ++bj)
#pragma unroll
                    for (int j = 0; j < 4; ++j) { float a = cs0[bj][j], b = cs1[bj][j];
                        a += shx<1>(a); b += shx<1>(b); a += shx<2>(a); b += shx<2>(b); a += shx<4>(a); b += shx<4>(b); a += shx<8>(a); b += shx<8>(b);
                        if (fr == 0) { const int pc = (pn - 8) * BM + bj * HALF + wc * 32 + 8 * fq;
                            float* kb = kbar + (size_t)u.pm * 512 + pc; atomicAdd(kb + j, a); atomicAdd(kb + 4 + j, b); } }
            }
        } else {
            bf16_t* O = pn < 16 ? SGC : SGA; const int col0 = (pn < 16 ? pn - 12 : pn - 16) * BM + wc * 32 + 8 * fq;
#pragma unroll
            for (int ai = 0; ai < 2; ++ai)
#pragma unroll
                for (int m = 0; m < 4; ++m) { int ro = row0 + ai * HALF + m * 16; asm volatile("" : "+v"(ro)); bf16_t* rowp = O + (size_t)ro * 1024 + col0;
#pragma unroll
                    for (int bj = 0; bj < 2; ++bj) { f32x4 v0 = acc[ai][bj][m][0], v1 = acc[ai][bj][m][1];
#pragma unroll
                        for (int j = 0; j < 4; ++j) { v0[j] = __builtin_amdgcn_rcpf(1.f + __expf(-v0[j])); v1[j] = __builtin_amdgcn_rcpf(1.f + __expf(-v1[j])); }
                        u32x4 w; w.x = cvt_pk_bf16(v0[0], v0[1]); w.y = cvt_pk_bf16(v0[2], v0[3]); w.z = cvt_pk_bf16(v1[0], v1[1]); w.w = cvt_pk_bf16(v1[2], v1[3]);
                        *(u32x4*)(rowp + bj * HALF) = w; }
                    asm volatile("" ::: "memory"); }
        }
    }
};
struct EpiSoftmax {
    static constexpr bool PERM = true, AFTER_DRAIN = true;
    bf16_t* O; int ldc; float scale_log2;
    __device__ __forceinline__ void fused(AccT& acc, const Unit& u, int wr, int wc, int fr, int fq, PG8_LAS unsigned char* lds, int wid, int lane) const {
        { int t_ = threadIdx.x; asm volatile("" : "+v"(t_)); fr = t_ & 15; fq = (t_ >> 4) & 3; }
        PG8_LAS f32x2* X = (PG8_LAS f32x2*)lds;
        float mx[2][4];
#pragma unroll
        for (int ai = 0; ai < 2; ++ai)
#pragma unroll
            for (int m = 0; m < 4; ++m) { float a = -3.0e38f;
#pragma unroll
                for (int bj = 0; bj < 2; ++bj)
#pragma unroll
                    for (int n = 0; n < 2; ++n) { acc[ai][bj][m][n] = acc[ai][bj][m][n] * scale_log2; const f32x4 x = acc[ai][bj][m][n]; a = fmaxf(fmaxf(a, fmaxf(x[0], x[1])), fmaxf(x[2], x[3])); }
                a = fmaxf(a, shx<16>(a)); a = max32(a); mx[ai][m] = a;
                float s = 0.f;
#pragma unroll
                for (int bj = 0; bj < 2; ++bj)
#pragma unroll
                    for (int n = 0; n < 2; ++n) { f32x4 x = acc[ai][bj][m][n];
#pragma unroll
                        for (int j = 0; j < 4; ++j) { x[j] = __builtin_amdgcn_exp2f(x[j] - a); s += x[j]; }
                        acc[ai][bj][m][n] = x; }
                s += shx<16>(s); s = sum32(s);
                if (fq == 0) X[(ai * HALF + wr * 64 + m * 16 + fr) * 4 + wc] = (f32x2){a, s};
            }
        asm volatile("s_waitcnt lgkmcnt(0)" ::: "memory"); __builtin_amdgcn_s_barrier(); asm volatile("" ::: "memory");
        const int row0 = u.pm * BM + wr * 64 + fr, col0 = u.pn * BM + wc * 32 + 8 * fq;
#pragma unroll
        for (int ai = 0; ai < 2; ++ai)
#pragma unroll
            for (int m = 0; m < 4; ++m) { const int r = ai * HALF + wr * 64 + m * 16 + fr;
                const f32x2 e0 = X[r * 4 + 0], e1 = X[r * 4 + 1], e2 = X[r * 4 + 2], e3 = X[r * 4 + 3];
                const float M = fmaxf(fmaxf(e0.x, e1.x), fmaxf(e2.x, e3.x));
                const float L = e0.y * __builtin_amdgcn_exp2f(e0.x - M) + e1.y * __builtin_amdgcn_exp2f(e1.x - M) + e2.y * __builtin_amdgcn_exp2f(e2.x - M) + e3.y * __builtin_amdgcn_exp2f(e3.x - M);
                const float f = __builtin_amdgcn_exp2f(mx[ai][m] - M) * __builtin_amdgcn_rcpf(L);
                bf16_t* rowp = O + (size_t)(row0 + ai * HALF + m * 16) * ldc + col0;
#pragma unroll
                for (int bj = 0; bj < 2; ++bj) { const f32x4 v0 = acc[ai][bj][m][0] * f, v1 = acc[ai][bj][m][1] * f;
                    u32x4 w; w.x = cvt_pk_bf16(v0[0], v0[1]); w.y = cvt_pk_bf16(v0[2], v0[3]); w.z = cvt_pk_bf16(v1[0], v1[1]); w.w = cvt_pk_bf16(v1[2], v1[3]);
                    *(u32x4*)(rowp + bj * HALF) = w; } }
        asm volatile("s_waitcnt lgkmcnt(0)" ::: "memory"); __builtin_amdgcn_s_barrier(); asm volatile("" ::: "memory");
    }
};
}
namespace attn_body {
using bf16=__hip_bfloat16;
using bf16x8=__attribute__((ext_vector_type(8)))short;
using s16x4=__attribute__((ext_vector_type(4)))short;
using f32x16=__attribute__((ext_vector_type(16)))float;
using u32x4=__attribute__((ext_vector_type(4)))unsigned;
constexpr int BATCH=16,NHEAD=8,SEQ=2048,D=64,DM=NHEAD*D;
constexpr int NW=8,QBLK=32,QB=QBLK*NW,KVBLK=64,NQB=SEQ/QB;
constexpr int ATTN_PITCH=DM, ATTN_UNIT_ROWS=QB;
__device__ __forceinline__ int crow(int r,int hi){return (r&3)+8*(r>>2)+4*hi;}
#define SBAR() __builtin_amdgcn_sched_barrier(0)
__device__ __forceinline__ void cmask(f32x16&p0,f32x16&p1,int jb,int qrel,int hi){
  const float NEG=-INFINITY; int kb=64*jb+4*hi;
  #pragma unroll
  for(int r=0;r<16;++r){int kv=kb+(r&3)+8*(r>>2); if(kv>qrel)p0[r]=NEG; if(kv+32>qrel)p1[r]=NEG;}
}

constexpr int NSLOT=3, SLOTB=8192;
constexpr int LDS_K=0, LDS_V=NSLOT*SLOTB, LDS_WS=2*NSLOT*SLOTB, LDS_OST=LDS_WS+NW*64*4, LDS_SEL=LDS_OST+NW*4096, LDS_BYTES=LDS_SEL+NW*64*4;
constexpr float C2=0.125f*1.4426950408889634f;
__device__ __forceinline__ void glds16(const void*gsrc,unsigned lds_dst){unsigned keep;
  asm volatile("s_mov_b32 %0, m0\n\ts_mov_b32 m0, %2\n\ts_nop 0\n\tglobal_load_lds_dwordx4 %1, off\n\ts_mov_b32 m0, %0":"=&s"(keep):"v"(gsrc),"s"(lds_dst):"memory");}
__device__ __forceinline__ float max3f(float a,float b,float c){float r;asm("v_max3_f32 %0, %1, %2, %3":"=v"(r):"v"(a),"v"(b),"v"(c));return r;}
__device__ __forceinline__ float max2f(float a,float b){float r;asm("v_max_f32_e32 %0, %1, %2":"=v"(r):"v"(a),"v"(b));return r;}
__device__ __forceinline__ float fadd_s(float a,float b){float r;asm("v_add_f32_e32 %0, %1, %2":"=v"(r):"v"(a),"v"(b));return r;}
__device__ __forceinline__ float fsub_s(float a,float b){float r;asm("v_sub_f32_e32 %0, %1, %2":"=v"(r):"v"(a),"v"(b));return r;}
typedef float f32x2_t __attribute__((ext_vector_type(2))); typedef __bf16 bf16x2_t __attribute__((ext_vector_type(2)));
__device__ __forceinline__ unsigned cvtpk_s(float lo,float hi){f32x2_t v={lo,hi};bf16x2_t b=__builtin_convertvector(v,bf16x2_t);return __builtin_bit_cast(unsigned,b);}
#define WAIT_BAR(N) asm volatile("s_waitcnt vmcnt(" #N ") lgkmcnt(0)\n\ts_barrier":::"memory")

__device__ __forceinline__ void qkt(f32x16&p0,f32x16&p1,const char*Kslot,const bf16x8*qr,const f32x16&negm,int r32,int hi){
  const char*kb=Kslot+hi*1024+r32*16;
  #pragma unroll
  for(int d0=0;d0<4;++d0){
    const bf16x8 b0=*reinterpret_cast<const bf16x8*>(kb+d0*2048);
    const bf16x8 b1=*reinterpret_cast<const bf16x8*>(kb+d0*2048+512);
    if(d0==0){p0=__builtin_amdgcn_mfma_f32_32x32x16_bf16(b0,qr[0],negm,0,0,0);p1=__builtin_amdgcn_mfma_f32_32x32x16_bf16(b1,qr[0],negm,0,0,0);}
    else{p0=__builtin_amdgcn_mfma_f32_32x32x16_bf16(b0,qr[d0],p0,0,0,0);p1=__builtin_amdgcn_mfma_f32_32x32x16_bf16(b1,qr[d0],p1,0,0,0);}}
}
typedef __attribute__((address_space(3))) const char* lds_cptr;
typedef short v4i16_t __attribute__((ext_vector_type(4)));
__device__ __forceinline__ void kload8(bf16x8*kf,lds_cptr kp){
  kf[0]=*(const __attribute__((address_space(3))) bf16x8*)(kp);      kf[1]=*(const __attribute__((address_space(3))) bf16x8*)(kp+512);
  kf[2]=*(const __attribute__((address_space(3))) bf16x8*)(kp+2048); kf[3]=*(const __attribute__((address_space(3))) bf16x8*)(kp+2560);
  kf[4]=*(const __attribute__((address_space(3))) bf16x8*)(kp+4096); kf[5]=*(const __attribute__((address_space(3))) bf16x8*)(kp+4608);
  kf[6]=*(const __attribute__((address_space(3))) bf16x8*)(kp+6144); kf[7]=*(const __attribute__((address_space(3))) bf16x8*)(kp+6656);
}
__device__ __forceinline__ void kload2(bf16x8*kf,lds_cptr kp,int j){ kf[2*j]=*(const __attribute__((address_space(3))) bf16x8*)(kp+j*2048); kf[2*j+1]=*(const __attribute__((address_space(3))) bf16x8*)(kp+j*2048+512); }
__device__ __forceinline__ s16x4 vtr(lds_cptr p){ return __builtin_bit_cast(s16x4,__builtin_amdgcn_ds_read_tr16_b64_v4i16((__attribute__((address_space(3))) v4i16_t*)p)); }
__device__ __forceinline__ float rowmax(const f32x16&p0,const f32x16&p1){
  float a=max3f(p0[0],p0[1],p1[0]),b=max3f(p0[2],p0[3],p1[1]);a=max3f(a,p1[2],p1[3]);
  #pragma unroll
  for(int r=4;r<16;r+=4){a=max3f(a,p0[r],p0[r+1]);b=max3f(b,p0[r+2],p0[r+3]);a=max3f(a,p1[r],p1[r+1]);b=max3f(b,p1[r+2],p1[r+3]);}
  const float m=max2f(a,b);
  auto rr=__builtin_amdgcn_permlane32_swap(__float_as_uint(m),__float_as_uint(m),false,false);
  return max2f(__uint_as_float(rr[0]),__uint_as_float(rr[1]));
}
__device__ __forceinline__ void pv(f32x16*o,int vb,bf16x8 pa0,bf16x8 pa1,bf16x8 pa2,bf16x8 pa3){
  #pragma unroll
  for(int d0=0;d0<2;++d0){s16x4 lo[4],hi[4];
    #pragma unroll
    for(int ks=0;ks<4;++ks){
      asm volatile("ds_read_b64_tr_b16 %0,%1 offset:%c2":"=&v"(lo[ks]):"v"(vb),"i"(d0*4096+ks*1024):"memory");
      asm volatile("ds_read_b64_tr_b16 %0,%1 offset:%c2":"=&v"(hi[ks]):"v"(vb),"i"(d0*4096+ks*1024+512):"memory");}
    asm volatile("s_waitcnt lgkmcnt(0)":::"memory");SBAR();
    #define PK(k) (bf16x8){lo[k][0],lo[k][1],lo[k][2],lo[k][3],hi[k][0],hi[k][1],hi[k][2],hi[k][3]}
    o[d0]=__builtin_amdgcn_mfma_f32_32x32x16_bf16(pa0,PK(0),o[d0],0,0,0);
    o[d0]=__builtin_amdgcn_mfma_f32_32x32x16_bf16(pa1,PK(1),o[d0],0,0,0);
    o[d0]=__builtin_amdgcn_mfma_f32_32x32x16_bf16(pa2,PK(2),o[d0],0,0,0);
    o[d0]=__builtin_amdgcn_mfma_f32_32x32x16_bf16(pa3,PK(3),o[d0],0,0,0);
    #undef PK
  }
}

#ifndef ATTN_STORE16
#define ATTN_STORE16(p,v) (*(u32x4*)(p)=(v))
#endif
template<int THRL> __device__ __forceinline__ void attn_unit(int b,int h,int qb,const bf16*Q,const bf16*__restrict__ K,const bf16*__restrict__ V,bf16*O,const float*__restrict__ kbar,char*shm){
  int tid=threadIdx.x; asm volatile("":"+v"(tid)); const int lane=tid&63,r32=lane&31,hi=lane>>5; const int wid=__builtin_amdgcn_readfirstlane(tid>>6);
  const long rowbase=(long)b*SEQ; const int q0=qb*QB;
  const bf16*Qw=Q+(rowbase+q0+wid*QBLK)*DM+h*D;
  const bf16*Kh=K+rowbase*DM+h*D,*Vh=V+rowbase*DM+h*D;
  const unsigned lds0=(unsigned)(uintptr_t)shm;
  float*wsf=(float*)(shm+LDS_WS)+wid*64;
  const bf16*ksrc=Kh+(long)lane*DM+wid*8;
  const bf16*vsrc=Vh+(long)(16*(wid&3)+(lane>>2))*DM+(wid>>2)*32+(lane&3)*8;
  const unsigned kdst=lds0+LDS_K+wid*1024, vdst=lds0+LDS_V+wid*1024;
  #define DMA_K(t,slot) glds16(ksrc+(long)(t)*KVBLK*DM,(unsigned)__builtin_amdgcn_readfirstlane(kdst+(slot)))
  #define DMA_V(t,slot) glds16(vsrc+(long)(t)*KVBLK*DM,(unsigned)__builtin_amdgcn_readfirstlane(vdst+(slot)))
  const int vb0=(int)(lds0+LDS_V)+((lane>>4)&1)*32+(lane&3)*8+(4*hi+((lane&15)>>2))*64;
  const char*Kbase=shm+LDS_K; bf16x8 kf[8];
  const lds_cptr shm3=(lds_cptr)shm; const lds_cptr kp0=shm3+LDS_K+hi*1024+r32*16; const lds_cptr vp0=shm3+LDS_V+((lane>>4)&1)*32+(lane&3)*8+(4*hi+((lane&15)>>2))*64;
  const int NT=(q0+QB)/KVBLK;
  DMA_K(0,0);DMA_V(0,0);DMA_K(1,SLOTB);
  bf16x8 qr[4];
  #pragma unroll
  for(int d0=0;d0<4;++d0)qr[d0]=*reinterpret_cast<const bf16x8*>(&Qw[(long)r32*DM+d0*16+hi*8]);
  int selm=0;
  if(qb>0){
    float g[7]; int hi8=8*hi; asm volatile("":"+v"(hi8)); const float*kb=kbar+(size_t)(b*8)*512+h*64+hi8;
    #pragma unroll
    for(int n=0;n<7;++n){ float a=0.f;
      if(n<qb){
        #pragma unroll
        for(int d0=0;d0<4;++d0){ const float4 k0=*(const float4*)(kb+n*512+16*d0),k1=*(const float4*)(kb+n*512+16*d0+4); const bf16x8 qq=qr[d0];
          #define QF(e) __uint_as_float(((unsigned)(unsigned short)qq[e])<<16)
          a+=QF(0)*k0.x+QF(1)*k0.y+QF(2)*k0.z+QF(3)*k0.w+QF(4)*k1.x+QF(5)*k1.y+QF(6)*k1.z+QF(7)*k1.w;
          #undef QF
        } }
      a=::sum32(a); g[n]=(n<qb)?a:-INFINITY; asm volatile("":"+v"(g[n])::"memory"); }
    #pragma unroll
    for(int r=0;r<3;++r){ int best=-1; float bv=-INFINITY;
      #pragma unroll
      for(int n=0;n<7;++n) if(!((selm>>n)&1)&&g[n]>bv){bv=g[n];best=n;}
      if(best>=0)selm|=1<<best; }
  }
  selm|=1<<qb;
  typedef __attribute__((address_space(3))) int* lds_iptr;
  ((lds_iptr)(shm3+LDS_SEL))[tid]=selm;
  #define CURNEG(blk) ({ int t_=threadIdx.x; asm volatile("":"+v"(t_)); const int sm_=((lds_iptr)(shm3+LDS_SEL))[t_]; ((sm_>>(blk))&1)?0.f:-INFINITY; })
  #define NEGUPD(t) do{ if((((t)+1)&3)==0){ const float cn_=CURNEG(((t)+1)>>2); _Pragma("unroll") for(int r=0;r<16;++r)negm[r]=cn_-mhat; asm volatile("":"+v"(negm)); } }while(0)
  float mhat=0.f,l_reg=0.f;f32x16 o[2];o[0]=f32x16{};o[1]=f32x16{};f32x16 negm; { const float cn_=CURNEG(0); _Pragma("unroll") for(int r=0;r<16;++r)negm[r]=cn_; } asm volatile("":"+v"(negm));
  const int qrel=wid*QBLK+r32;
  #define CMASK(P0,P1,t) do{int jb_=(t)-(NT-4); if(jb_>=0)cmask(P0,P1,jb_,qrel,hi);}while(0)
  bool resc=false;
  #define START(P0,P1) do{ const float rm=rowmax(P0,P1); resc=false; \
    { const float dl=__builtin_fmaxf(rm,-24.f); mhat=fadd_s(mhat,dl); \
      _Pragma("unroll") for(int r=0;r<16;++r){P0[r]=fsub_s(P0[r],dl);P1[r]=fsub_s(P1[r],dl);} \
      { const float cn_=CURNEG(0); _Pragma("unroll") for(int r=0;r<16;++r)negm[r]=cn_-mhat; } asm volatile("":"+v"(negm)); } \
    _Pragma("unroll") for(int r=0;r<16;++r)P0[r]=__builtin_amdgcn_exp2f(P0[r]); }while(0)
  #define RESC() do{ if(resc){ asm volatile("s_waitcnt lgkmcnt(0)":::"memory"); \
      _Pragma("unroll") for(int d_=0;d_<2;++d_) _Pragma("unroll") for(int r=0;r<16;++r)o[d_][r]*=wsf[crow(r,hi)]; } }while(0)
  f32x16 pA0,pA1,pB0,pB1;
  int sl_prev=0,sl_cur=0,sl_next=SLOTB;
  #define ROT() do{sl_prev=sl_cur;sl_cur=sl_next;sl_next=(sl_next==(NSLOT-1)*SLOTB)?0:sl_next+SLOTB;}while(0)
  DMA_K(2,2*SLOTB);
  WAIT_BAR(3);
  qkt(pA0,pA1,Kbase,qr,negm,r32,hi);asm volatile("s_nop 15\n\ts_nop 7":"+v"(pA0),"+v"(pA1));CMASK(pA0,pA1,0);
  START(pA0,pA1);
  _Pragma("unroll") for(int r=0;r<16;++r)pA1[r]=__builtin_amdgcn_exp2f(pA1[r]);
  WAIT_BAR(0);
  DMA_K(3,0);DMA_V(1,SLOTB);
  ROT();
  kload8(kf,kp0+sl_cur);
  WAIT_BAR(2);
  s16x4 vlo[8],vhi[8]; u32x4 pw0,pw1,pw2,pw3;
  #define PKW(P,B) cvtpk_s(P[B],P[B+1])
  #define PAF(k) __builtin_bit_cast(bf16x8,pw##k)
  #define VFR(i) (bf16x8){vlo[i][0],vlo[i][1],vlo[i][2],vlo[i][3],vhi[i][0],vhi[i][1],vhi[i][2],vhi[i][3]}
  #define PIN(x) asm volatile("":"+v"(x))
  #define MX3(a,b,c) __builtin_fmaxf(__builtin_fmaxf((a),(b)),(c))
  #define GAPA(MF,A0,A1,A2,A3,W0,W1,PW) do{ MF; sacc+=A0; sacc+=A1; sacc+=A2; sacc+=A3; PIN(sacc); W0; W1; PIN(PW); SBAR(); }while(0)
  #define EX(v) __builtin_amdgcn_exp2f(v)
  #define GAPB(MF,X,B) do{ MF; X[B]=EX(X[B]); X[B+1]=EX(X[B+1]); X[B+2]=EX(X[B+2]); X[B+3]=EX(X[B+3]); PIN(X); SBAR(); }while(0)
  #define VRD(i) do{ vlo[i]=vtr(vp_+(((i)>>2)*4096+((i)&3)*1024)); vhi[i]=vtr(vp_+(((i)>>2)*4096+((i)&3)*1024+512)); }while(0)
  #define KRD(G,j) do{ if(G){ kload2(kf,kp0+sl_next,j); SBAR(); } }while(0)
  #define STEP(C0,C1,P0,P1,t,GK,GV,GL) do{ SBAR(); \
    const lds_cptr vp_=vp0+sl_prev; \
    VRD(0); SBAR(); float sacc=(P0[0]+P0[1]); \
    GAPA(C0=__builtin_amdgcn_mfma_f32_32x32x16_bf16(kf[0],qr[0],negm,0,0,0), P0[2],P0[3],P0[4],P0[5],     pw0[0]=PKW(P0,0), pw0[1]=PKW(P0,2), pw0); \
    VRD(4); SBAR(); GAPA(C1=__builtin_amdgcn_mfma_f32_32x32x16_bf16(kf[1],qr[0],negm,0,0,0), P0[6],P0[7],P0[8],P0[9],     pw0[2]=PKW(P0,4), pw0[3]=PKW(P0,6), pw0); \
    VRD(1); SBAR(); GAPA(C0=__builtin_amdgcn_mfma_f32_32x32x16_bf16(kf[2],qr[1],C0,0,0,0),   P0[10],P0[11],P0[12],P0[13], pw1[0]=PKW(P0,8), pw1[1]=PKW(P0,10), pw1); \
    VRD(5); SBAR(); GAPA(C1=__builtin_amdgcn_mfma_f32_32x32x16_bf16(kf[3],qr[1],C1,0,0,0),   P0[14],P0[15],P1[0],P1[1],   pw1[2]=PKW(P0,12),pw1[3]=PKW(P0,14), pw1); \
    VRD(2); SBAR(); GAPA(C0=__builtin_amdgcn_mfma_f32_32x32x16_bf16(kf[4],qr[2],C0,0,0,0),   P1[2],P1[3],P1[4],P1[5],     pw2[0]=PKW(P1,0), pw2[1]=PKW(P1,2), pw2); \
    VRD(6); SBAR(); GAPA(C1=__builtin_amdgcn_mfma_f32_32x32x16_bf16(kf[5],qr[2],C1,0,0,0),   P1[6],P1[7],P1[8],P1[9],     pw2[2]=PKW(P1,4), pw2[3]=PKW(P1,6), pw2); \
    VRD(3); SBAR(); GAPA(C0=__builtin_amdgcn_mfma_f32_32x32x16_bf16(kf[6],qr[3],C0,0,0,0),   P1[10],P1[11],P1[12],P1[13], pw3[0]=PKW(P1,8), pw3[1]=PKW(P1,10), pw3); \
    VRD(7); SBAR(); GAPA(C1=__builtin_amdgcn_mfma_f32_32x32x16_bf16(kf[7],qr[3],C1,0,0,0),   P1[14],P1[15],0.f,0.f,       pw3[2]=PKW(P1,12),pw3[3]=PKW(P1,14), pw3); \
    l_reg+=sacc; \
    if(GK){DMA_K((t)+3,sl_cur);} if(GV){DMA_V((t)+1,sl_next);} \
    CMASK(C0,C1,t); \
    { float a=MX3(C0[0],C0[1],C1[0]),b=MX3(C0[2],C0[3],C1[1]); a=MX3(a,C1[2],C1[3]); \
      _Pragma("unroll") for(int r=4;r<16;r+=4){a=MX3(a,C0[r],C0[r+1]);b=MX3(b,C0[r+2],C0[r+3]);a=MX3(a,C1[r],C1[r+1]);b=MX3(b,C1[r+2],C1[r+3]);} \
      float rm=__builtin_fmaxf(a,b); { auto rr=__builtin_amdgcn_permlane32_swap(__float_as_uint(rm),__float_as_uint(rm),false,false); rm=__builtin_fmaxf(__uint_as_float(rr[0]),__uint_as_float(rr[1])); } \
      resc=false; \
      if(__builtin_expect(__any(rm>(float)THRL),0)){ const float dl=__builtin_fmaxf(rm,0.f); mhat+=dl; \
        _Pragma("unroll") for(int r=0;r<16;++r){C0[r]-=dl;C1[r]-=dl;} \
        { const float cn_=CURNEG(((t)+1)>>2); _Pragma("unroll") for(int r=0;r<16;++r)negm[r]=cn_-mhat; } asm volatile("":"+v"(negm)); \
        const float f=__builtin_amdgcn_exp2f(-dl); l_reg*=f; if(hi==0)wsf[r32]=f; resc=true; } } \
    SBAR(); \
    GAPB(o[0]=__builtin_amdgcn_mfma_f32_32x32x16_bf16(PAF(0),VFR(0),o[0],0,0,0), C0,0); \
    GAPB(o[1]=__builtin_amdgcn_mfma_f32_32x32x16_bf16(PAF(0),VFR(4),o[1],0,0,0), C0,4); \
    KRD(GL,0); GAPB(o[0]=__builtin_amdgcn_mfma_f32_32x32x16_bf16(PAF(1),VFR(1),o[0],0,0,0), C0,8); \
    KRD(GL,1); GAPB(o[1]=__builtin_amdgcn_mfma_f32_32x32x16_bf16(PAF(1),VFR(5),o[1],0,0,0), C0,12); \
    KRD(GL,2); GAPB(o[0]=__builtin_amdgcn_mfma_f32_32x32x16_bf16(PAF(2),VFR(2),o[0],0,0,0), C1,0); \
    KRD(GL,3); GAPB(o[1]=__builtin_amdgcn_mfma_f32_32x32x16_bf16(PAF(2),VFR(6),o[1],0,0,0), C1,4); \
    GAPB(o[0]=__builtin_amdgcn_mfma_f32_32x32x16_bf16(PAF(3),VFR(3),o[0],0,0,0), C1,8); \
    GAPB(o[1]=__builtin_amdgcn_mfma_f32_32x32x16_bf16(PAF(3),VFR(7),o[1],0,0,0), C1,12); \
    }while(0)
  int t=1;
  #undef CMASK
  #define CMASK(P0,P1,t) do{}while(0)
  for(;t+5<NT;t+=2){
    STEP(pB0,pB1,pA0,pA1,t,true,true,true);     WAIT_BAR(2); RESC(); ROT(); NEGUPD(t);
    STEP(pA0,pA1,pB0,pB1,t+1,true,true,true);   WAIT_BAR(2); RESC(); ROT(); NEGUPD(t+1);
  }
  #undef CMASK
  #define CMASK(P0,P1,t) do{int jb_=(t)-(NT-4); if(jb_>=0)cmask(P0,P1,jb_,qrel,hi);}while(0)
  #define ENDW(tt) do{ if((tt)+3<NT){WAIT_BAR(2);} else if((tt)+2<NT){WAIT_BAR(1);} else {WAIT_BAR(0);} }while(0)
  for(;t+1<NT;t+=2){
    STEP(pB0,pB1,pA0,pA1,t,(t+3<NT),(t+1<NT),(t+1<NT));       ENDW(t);   RESC(); ROT(); NEGUPD(t);
    STEP(pA0,pA1,pB0,pB1,t+1,(t+4<NT),(t+2<NT),(t+2<NT));     ENDW(t+1); RESC(); ROT(); NEGUPD(t+1);
  }
  STEP(pB0,pB1,pA0,pA1,NT-1,false,false,false); RESC();
  { float sacc=pB0[0]+pB0[1]; _Pragma("unroll") for(int r=2;r<16;++r)sacc+=pB0[r]; _Pragma("unroll") for(int r=0;r<16;++r)sacc+=pB1[r]; l_reg+=sacc;
    pw0=(u32x4){PKW(pB0,0),PKW(pB0,2),PKW(pB0,4),PKW(pB0,6)};pw1=(u32x4){PKW(pB0,8),PKW(pB0,10),PKW(pB0,12),PKW(pB0,14)};pw2=(u32x4){PKW(pB1,0),PKW(pB1,2),PKW(pB1,4),PKW(pB1,6)};pw3=(u32x4){PKW(pB1,8),PKW(pB1,10),PKW(pB1,12),PKW(pB1,14)};
    SBAR(); pv(o,vb0+sl_cur,PAF(0),PAF(1),PAF(2),PAF(3)); }
  #undef PKW
  #undef PAF
  #undef VFR
  #undef PIN
  #undef MX3
  #undef GAPA
  #undef GAPB
  #undef EX
  #undef VRD
  #undef KRD
  #undef STEP
  #undef ENDW
  {auto rr=__builtin_amdgcn_permlane32_swap(__float_as_uint(l_reg),__float_as_uint(l_reg),false,false);l_reg=__uint_as_float(rr[0])+__uint_as_float(rr[1]);}
  if(hi==0)wsf[32+r32]=l_reg;asm volatile("s_waitcnt lgkmcnt(0)":::"memory");
  float rli[16];
  #pragma unroll
  for(int r=0;r<16;++r)rli[r]=__builtin_amdgcn_rcpf(wsf[32+crow(r,hi)]);
  bf16*Ow=O+(rowbase+q0+wid*QBLK)*DM+h*D;
  { bf16*stg=(bf16*)(shm+LDS_OST)+wid*2048;
    #pragma unroll
    for(int r=0;r<16;++r){const int orow=crow(r,hi);
      #pragma unroll
      for(int d0=0;d0<2;++d0)stg[orow*64+d0*32+r32]=__float2bfloat16(o[d0][r]*rli[r]);}
    asm volatile("s_waitcnt lgkmcnt(0)":::"memory");
    #pragma unroll
    for(int i=0;i<4;++i){const int row=i*8+(lane>>3),ch=lane&7; const u32x4 v=*(const u32x4*)(stg+row*64+ch*8); ATTN_STORE16(Ow+(long)row*DM+ch*8,v);} }
  asm volatile("s_waitcnt lgkmcnt(0)\n\ts_barrier":::"memory");
  #undef DMA_K
  #undef DMA_V
  #undef CMASK
  #undef START
  #undef CURNEG
  #undef NEGUPD
  #undef RESC
  #undef ROT
}
constexpr int ATTN_LDS_BYTES=LDS_BYTES;
struct AttnTensors { const bf16* Q; const bf16* K; const bf16* V; bf16* O; const float* kbar; };
struct AttnUnit { int bh; int qb; };
struct StaticOrder {
  int vcu,G;
  __device__ __forceinline__ explicit StaticOrder(int grid,int block):vcu((grid%8==0)?(block%8)*(grid/8)+block/8:block),G(grid){}
  __device__ __forceinline__ bool next(int i,AttnUnit&u)const{
    if(G==256){ if(i>=4)return false; const int s=vcu&1; u.bh=vcu>>1; u.qb=s?((i==0)?6:(i==1)?1:(i==2)?5:2):((i==0)?7:(i==1)?0:(i==2)?4:3); return true; }
    const int L=i*G+vcu; if(L>=1024)return false; u.bh=L>>3; u.qb=L&7; return true; }
  __device__ __forceinline__ void a_ready(const AttnUnit&)const{}
  __device__ __forceinline__ void done(const AttnUnit&)const{}
};
template<class Sched,int THRL=8> __device__ __forceinline__ void attn_phase(char*lds,const AttnTensors&T,const Sched&S){
  AttnUnit u;
  for(int i=0;S.next(i,u);++i){ S.a_ready(u); attn_unit<THRL>(u.bh/NHEAD,u.bh%NHEAD,u.qb,T.Q,T.K,T.V,T.O,T.kbar,lds); S.done(u); }
}
#undef SBAR
#undef WAIT_BAR
}
constexpr int NWAVES = 8;
constexpr int T = 32768, D = 1024, SEQ = 2048, MEMROWS = 4096, INW = 5120;
constexpr float RMS_EPS = 1e-6f;
constexpr size_t MiB = 1u << 20;
constexpr size_t WS_CTL = 0, CTL_ZERO_BYTES = 2 * MiB, WS_KBAR = 1 * MiB;
constexpr size_t WS_WIN = 2 * MiB, WS_WC = 12 * MiB, WS_WA = 13 * MiB, WS_WM = 14 * MiB, WS_WXQ = 16 * MiB, WS_WXKV = 18 * MiB, WS_WXO = 22 * MiB, WS_MT = 24 * MiB, WS_ROPE = 28 * MiB;
constexpr size_t WS_MEMN = 32 * MiB, WS_KX = 40 * MiB, WS_VXT = 48 * MiB;
constexpr size_t WS_SSQ1 = 30 * MiB, WS_SSQ2 = 56 * MiB;
constexpr size_t WS_A = 64 * MiB;
constexpr size_t WS_YC = 128 * MiB, WS_QO = 160 * MiB, WS_U = 192 * MiB, WS_K = 224 * MiB, WS_V = 256 * MiB;
constexpr size_t WS_SGC = 320 * MiB, WS_SGA = 384 * MiB;
constexpr size_t WS_A8I = 320 * MiB, WS_ASC = 352 * MiB;
constexpr size_t WS_EIDX = 448 * MiB, WS_GW = 464 * MiB, WS_PW = 480 * MiB, WS_END = 496 * MiB;
constexpr size_t WS_U8 = 288 * MiB, WS_V8T = 304 * MiB, WS_SU = 29 * MiB, WS_SV = 29 * MiB + 512 * 1024;
constexpr size_t WS_QX = 128 * MiB, WS_PM = 192 * MiB, WS_OX = 128 * MiB;
constexpr size_t WS_PO = 128 * MiB;
constexpr size_t WS_SC = 128 * MiB;
constexpr int CW_TMO = 0, CW_BAR = 4096, CW_Q = 8192;
constexpr int RING_OFF = 0, RING_BYTES = 131072;
constexpr int LDSCTL_OFF = RING_BYTES, MISC_OFF = LDSCTL_OFF + 320;
constexpr int LDS_BYTES = 163840;
constexpr int UL_OFF = RING_BYTES + 512, UL_WAVE = (LDS_BYTES - UL_OFF) / 8, UL_CAP = ((UL_WAVE - 64) / 16) & ~15;

#define GAS __attribute__((address_space(1)))
#define LAS __attribute__((address_space(3)))
typedef unsigned short bf16;
typedef unsigned v4u __attribute__((ext_vector_type(4)));
typedef unsigned v2u __attribute__((ext_vector_type(2)));
typedef float f32x4 __attribute__((ext_vector_type(4)));
typedef float f32x2v __attribute__((ext_vector_type(2)));
typedef _Float16 h2v __attribute__((ext_vector_type(2)));
typedef GAS unsigned gu32;
#define RLX_AGENT __ATOMIC_RELAXED, __HIP_MEMORY_SCOPE_AGENT
#define LDS_WAIT() asm volatile("s_waitcnt lgkmcnt(0)" ::: "memory")
#define VM_WAIT() asm volatile("s_waitcnt vmcnt(0)" ::: "memory")
__device__ __forceinline__ unsigned pk2(float lo, float hi) { return pg8::cvt_pk_bf16(lo, hi); }
__device__ __forceinline__ float bflo(unsigned u) { return __uint_as_float(u << 16); }
__device__ __forceinline__ float bfhi(unsigned u) { return __uint_as_float(u & 0xffff0000u); }

#define XB_TMO      128
#define XB_XCNT(j)  (256  + 64 * (j))
#define XB_XSUB(j)  (1280 + 64 * (j))
#define XB_XGEN(j)  (2304 + 64 * (j))
#define XB_TOP      3328
#define XB_TOPGEN   3392
#define XCD_BAR_WORDS 3456
#define XB_SPIN_CAP (1u << 18)
__device__ __forceinline__ unsigned xb_ld(unsigned* p)              { return __hip_atomic_load(p, __ATOMIC_RELAXED, __HIP_MEMORY_SCOPE_AGENT); }
__device__ __forceinline__ unsigned xb_add(unsigned* p, unsigned v) { return __hip_atomic_fetch_add(p, v, __ATOMIC_RELAXED, __HIP_MEMORY_SCOPE_AGENT); }
__device__ __forceinline__ unsigned xb_xcc_id() { return (unsigned)__builtin_amdgcn_s_getreg((3 << 11) | 20) & 0xFu; }
#define XB_SPIN(cond, bar) do { unsigned _sp = 0; while (cond) { __builtin_amdgcn_s_sleep(1); \
    if ((++_sp & 255u) == 0u) { if (xb_ld(&(bar)[XB_TMO])) break; if (_sp > XB_SPIN_CAP) { atomicAdd(&(bar)[XB_TMO], 1u); break; } } } } while (0)
struct XcdBarrier { unsigned* bar; unsigned x; volatile LAS unsigned* st; };
__device__ __forceinline__ XcdBarrier xcd_barrier_post(unsigned* bar, volatile LAS unsigned* st) {
    XcdBarrier b; b.bar = bar; b.x = xb_xcc_id(); b.st = st;
    if (threadIdx.x == 0) (void)xb_add(&bar[XB_XCNT(b.x)], 1u);
    return b;
}
__device__ __forceinline__ void xcd_barrier_complete(unsigned* bar, unsigned x, unsigned& nloc, unsigned& nx) {
    const unsigned G = gridDim.x * gridDim.y * gridDim.z;
    unsigned sum, cnt, mine, sp = 0u;
    for (;;) {
        sum = 0u; cnt = 0u; mine = 0u;
#pragma unroll
        for (unsigned j = 0; j < 16; ++j) { const unsigned c = xb_ld(&bar[XB_XCNT(j)]); sum += c; cnt += (c > 0u) ? 1u : 0u; mine = (j == x) ? c : mine; }
        if (sum == G) break;
        __builtin_amdgcn_s_sleep(1);
        if ((++sp & 255u) == 0u) { if (xb_ld(&bar[XB_TMO])) break; if (sp > XB_SPIN_CAP) { atomicAdd(&bar[XB_TMO], 1u); break; } }
    }
    nloc = mine > 0u ? mine : 1u; nx = cnt > 0u ? cnt : 1u;
}
__device__ __forceinline__ void xcd_barrier(const XcdBarrier& b) {
    asm volatile("s_waitcnt vmcnt(0)" ::: "memory");
    __syncthreads();
    if (threadIdx.x == 0) {
        unsigned* bar = b.bar;
        __builtin_amdgcn_s_waitcnt(0);
        unsigned nloc = b.st[0], nx = b.st[1];
        if (nloc == 0u) { xcd_barrier_complete(bar, b.x, nloc, nx); b.st[0] = nloc; b.st[1] = nx; }
        const unsigned old = xb_add(&bar[XB_XSUB(b.x)], 1u);
        const unsigned gen = old / nloc;
        if (old + 1u == (gen + 1u) * nloc) {
            __builtin_amdgcn_fence(__ATOMIC_RELEASE, "agent");
            asm volatile("s_waitcnt vmcnt(0)" ::: "memory");
            const unsigned og = xb_add(&bar[XB_TOP], 1u);
            const unsigned tg = og / nx;
            if (og + 1u == (tg + 1u) * nx) xb_add(&bar[XB_TOPGEN], 1u);
            else XB_SPIN(xb_ld(&bar[XB_TOPGEN]) == tg, bar);
            __builtin_amdgcn_fence(__ATOMIC_ACQUIRE, "agent");
            xb_add(&bar[XB_XGEN(b.x)], 1u);
            asm volatile("s_waitcnt vmcnt(0)" ::: "memory");
        } else {
            XB_SPIN(xb_ld(&bar[XB_XGEN(b.x)]) == gen, bar);
            __builtin_amdgcn_fence(__ATOMIC_ACQUIRE, "agent");
            asm volatile("s_waitcnt vmcnt(0)" ::: "memory");
        }
    }
    __syncthreads();
}

struct MapId { static __device__ __forceinline__ int src(int j) { return j; } };
struct MapWin {
    static __device__ __forceinline__ int src(int j) {
        if (j < 1024) { const int g8 = j >> 3, i = j & 7; return ((i < 4) ? 0 : 1024) + 4 * g8 + (i & 3); }
        if (j < 1536) return 512 + (j - 1024);
        if (j < 2560) { const int jj = j - 1536, qk = jj >> 9, p = jj & 511, head = p >> 6, pl = p & 63, g = pl >> 3, i = pl & 7; return 1536 + qk * 512 + head * 64 + 4 * g + (i & 3) + 32 * (i >> 2); }
        return j;
    }
};
template <class MAP>
__device__ __forceinline__ void p0_transpose_item(const float* W, int K, int N, int NOUT, bf16* WT, LAS float* scr, int item, int lane, const float* gain = nullptr) {
    const int nblk = NOUT / 32, kb = item / nblk, nb = item % nblk, k0 = 64 * kb, n0 = 32 * nb;
    const int sc = MAP::src(n0 + (lane & 31));
    float wv[32];
#pragma unroll
    for (int i = 0; i < 32; ++i) wv[i] = W[(size_t)(k0 + 2 * i + (lane >> 5)) * N + sc];
#pragma unroll
    for (int i = 0; i < 32; ++i) { const int kk = 2 * i + (lane >> 5); const float gk = gain ? gain[k0 + kk] : 1.f; scr[kk * 33 + (lane & 31)] = wv[i] * gk; }
    LDS_WAIT(); asm volatile("" ::: "memory");
    const int c = lane & 7;
#pragma unroll
    for (int j = 0; j < 4; ++j) { const int n = (lane >> 3) + 8 * j; const LAS float* s = scr + (8 * c) * 33 + n;
        v4u o; o.x = pk2(s[0 * 33], s[1 * 33]); o.y = pk2(s[2 * 33], s[3 * 33]); o.z = pk2(s[4 * 33], s[5 * 33]); o.w = pk2(s[6 * 33], s[7 * 33]);
        *(GAS v4u*)(WT + (size_t)(n0 + n) * K + k0 + 8 * c) = o; }
    LDS_WAIT(); asm volatile("" ::: "memory");
}
__device__ __forceinline__ void rms_row_to_bf16(const float* xrow, const float* g, bf16* orow, int lane) {
    const GAS f32x4* xr = (const GAS f32x4*)xrow + lane; const GAS f32x4* gr = (const GAS f32x4*)g + lane;
    f32x4 v[4]; float s = 0.f;
#pragma unroll
    for (int j = 0; j < 4; ++j) { v[j] = xr[64 * j]; s += (v[j].x * v[j].x + v[j].y * v[j].y) + (v[j].z * v[j].z + v[j].w * v[j].w); }
    const float r = rsqrtf(wave_sum(s) * (1.f / 1024.f) + RMS_EPS);
    GAS v2u* o8 = (GAS v2u*)orow + lane;
#pragma unroll
    for (int j = 0; j < 4; ++j) { const f32x4 gg = gr[64 * j]; v2u w; w.x = pk2(v[j].x * r * gg.x, v[j].y * r * gg.y); w.y = pk2(v[j].z * r * gg.z, v[j].w * r * gg.w); o8[64 * j] = w; }
}
template <int NR>
__device__ __forceinline__ void rms_rows_to_bf16(const float* x, const float* g, bf16* o, int m0, int stride, int lane) {
    f32x4 v[NR][4];
#pragma unroll
    for (int i = 0; i < NR; ++i) { const GAS f32x4* xr = (const GAS f32x4*)(x + (size_t)(m0 + i * stride) * 1024) + lane;
#pragma unroll
        for (int j = 0; j < 4; ++j) v[i][j] = xr[64 * j]; }
    f32x4 gg[4];
#pragma unroll
    for (int j = 0; j < 4; ++j) gg[j] = ((const GAS f32x4*)g + lane)[64 * j];
#pragma unroll
    for (int i = 0; i < NR; ++i) { float s = 0.f;
#pragma unroll
        for (int j = 0; j < 4; ++j) s += (v[i][j].x * v[i][j].x + v[i][j].y * v[i][j].y) + (v[i][j].z * v[i][j].z + v[i][j].w * v[i][j].w);
        const float r = rsqrtf(wave_sum(s) * (1.f / 1024.f) + RMS_EPS);
        GAS v2u* o8 = (GAS v2u*)(o + (size_t)(m0 + i * stride) * 1024) + lane;
#pragma unroll
        for (int j = 0; j < 4; ++j) { v2u w; w.x = pk2(v[i][j].x * r * gg[j].x, v[i][j].y * r * gg[j].y); w.y = pk2(v[i][j].z * r * gg[j].z, v[i][j].w * r * gg[j].w); o8[64 * j] = w; } }
}
__device__ __forceinline__ float fmax_asm(float a, float b) { float r; asm("v_max_f32 %0, %1, %2" : "=v"(r) : "v"(a), "v"(b)); return r; }
__device__ __forceinline__ float fmin_asm(float a, float b) { float r; asm("v_min_f32 %0, %1, %2" : "=v"(r) : "v"(a), "v"(b)); return r; }

#ifndef PH_MASK
#define PH_MASK 0xFFFFFFFFu
#endif
#define PH(k) ((PH_MASK >> (k)) & 1u)
#ifndef REP_MASK
#define REP_MASK 0u
#endif
#define NREP(k) (((REP_MASK >> (k)) & 1u) ? 2 : 1)
#ifndef DIAG_TS_A
#define DIAG_TS_A -1
#endif
#ifndef DIAG_TS_B
#define DIAG_TS_B -1
#endif
struct Args { const float* in[19]; float* out; unsigned char* ws; };

struct XOrder {
    const char* A; const char* Bt; int G, c, i0, mode;
    __device__ bool next(int i, pg8::Unit& u) const {
        if (i > 0) return false;
        const int L = i0 * G + c; if (L >= 512) return false;
        const int b = L >> 5, head = (L >> 3) & 3, rt = L & 7;
        u.pm = b * 8 + rt; u.pn = head;
        if (mode == 0) { u.a = A + (size_t)(b * 2048 + rt * 256) * 1024 * 2; u.b = Bt + (size_t)(head * 256) * 1024 * 2; }
        else { u.a = A + ((size_t)(b * 2048 + rt * 256) * 1024 + head * 256) * 2;
               u.b = (mode == 2) ? Bt + ((size_t)(head * 256) * 4096 + b * 256) * 2 : Bt + ((size_t)(b * 256) * 1024 + head * 256) * 2; }
        return true;
    }
};

__global__ void __launch_bounds__(NWAVES * 64, 2) mk_fwd(Args args) {
    extern __shared__ __attribute__((aligned(16))) unsigned char lds[];
    LAS unsigned char* L = (LAS unsigned char*)lds;
    volatile LAS unsigned* MISC = (volatile LAS unsigned*)(L + MISC_OFF);
    const int wave = __builtin_amdgcn_readfirstlane((int)threadIdx.x >> 6);
#define PH_LANES int tid = threadIdx.x; asm volatile("" : "+v"(tid)); const int lane = tid & 63; const int gt = vcu * (NWAVES * 64) + tid; (void)lane; (void)gt
    const int G = gridDim.x; const int bx = blockIdx.x; const int vcu = (G % 8 == 0) ? (bx % 8) * (G / 8) + bx / 8 : bx;
    unsigned char* ws = args.ws;
    gu32* ctl = (gu32*)(ws + WS_CTL);
    for (int u = threadIdx.x; u < (LDS_BYTES - LDSCTL_OFF) / 4; u += NWAVES * 64) ((LAS unsigned*)(L + LDSCTL_OFF))[u] = 0u;
    __syncthreads();
    XcdBarrier bar = xcd_barrier_post((unsigned*)(ctl + CW_BAR), MISC + 8);
    unsigned long long* tsw = (unsigned long long*)(ws + WS_CTL + 65536);
    int n_ts = 0;
#define TSTAMP() do { if (DIAG_TS_A >= 0) { if (bx == 0 && threadIdx.x == 0) tsw[n_ts] = __builtin_amdgcn_s_memrealtime(); ++n_ts; } } while (0)
    TSTAMP();

    const float *x = args.in[0], *mem = args.in[1], *g_mix = args.in[2], *w_in = args.in[3], *w_conv = args.in[4], *w_conv_out = args.in[5], *w_attn_out = args.in[6], *w_merge = args.in[7],
                *g_xattn = args.in[8], *g_mem = args.in[9], *w_xq = args.in[10], *w_xkv = args.in[11], *w_xo = args.in[12], *g_ffn = args.in[13], *w_pq = args.in[14], *sub_keys = args.in[15],
                *peer_u = args.in[16], *peer_v = args.in[17], *g_final = args.in[18];
    float* out = args.out;
    bf16 *WinT = (bf16*)(ws + WS_WIN), *WcT = (bf16*)(ws + WS_WC), *WaT = (bf16*)(ws + WS_WA), *WmT = (bf16*)(ws + WS_WM), *WxqT = (bf16*)(ws + WS_WXQ), *WxkvT = (bf16*)(ws + WS_WXKV),
         *WxoT = (bf16*)(ws + WS_WXO), *MT = (bf16*)(ws + WS_MT);
    float* ropec = (float*)(ws + WS_ROPE); float* ropes = ropec + 2048 * 32;
    float* kbar = (float*)(ws + WS_KBAR);
    bf16 *MEMN = (bf16*)(ws + WS_MEMN), *KX = (bf16*)(ws + WS_KX), *VXT = (bf16*)(ws + WS_VXT), *A = (bf16*)(ws + WS_A);
    bf16 *YC = (bf16*)(ws + WS_YC), *QO = (bf16*)(ws + WS_QO), *U = (bf16*)(ws + WS_U), *KB = (bf16*)(ws + WS_K), *VB = (bf16*)(ws + WS_V), *SGC = (bf16*)(ws + WS_SGC), *SGA = (bf16*)(ws + WS_SGA);
    bf16 *QX = (bf16*)(ws + WS_QX), *PM = (bf16*)(ws + WS_PM), *OX = (bf16*)(ws + WS_OX);
    _Float16* SC = (_Float16*)(ws + WS_SC);
    unsigned char* A8I = ws + WS_A8I; float* ASC = (float*)(ws + WS_ASC);
    int* EIDX = (int*)(ws + WS_EIDX); float* GW = (float*)(ws + WS_GW); unsigned* PW = (unsigned*)(ws + WS_PW);
    float* PO = (float*)(ws + WS_PO); float* SSQ1 = (float*)(ws + WS_SSQ1); float* SSQ2 = (float*)(ws + WS_SSQ2); (void)PO;
    unsigned char* U8 = ws + WS_U8; unsigned char* V8T = ws + WS_V8T; float* SU = (float*)(ws + WS_SU); float* SV = (float*)(ws + WS_SV);
    const int gw = vcu * NWAVES + wave, NGW = G * NWAVES;
    const int NGT = G * NWAVES * 64;

    asm volatile("; ===== PHASE 0 =====");
    if (PH(0)) for (int rep = 0; rep < NREP(0); ++rep) {
        PH_LANES; const bool dummy = rep < NREP(0) - 1; (void)dummy;
        LAS float* scr = (LAS float*)(L + RING_OFF + wave * 16384);
        constexpr int I_IN = (1024 / 64) * (5120 / 32), I_C = (512 / 64) * (1024 / 32), I_M = (1024 / 64) * (1024 / 32), I_KV = (1024 / 64) * (2048 / 32);
        constexpr int NITEMS = I_IN + 2 * I_C + 3 * I_M + I_KV;
        for (int it = gw; it < NITEMS; it += NGW) {
            int r = it;
            if (r < I_IN) { p0_transpose_item<MapWin>(w_in, 1024, 5120, 5120, WinT, scr, r, lane); continue; } r -= I_IN;
            if (r < I_C) { p0_transpose_item<MapId>(w_conv_out, 512, 1024, 1024, WcT, scr, r, lane); continue; } r -= I_C;
            if (r < I_C) { p0_transpose_item<MapId>(w_attn_out, 512, 1024, 1024, WaT, scr, r, lane); continue; } r -= I_C;
            if (r < I_M) { p0_transpose_item<MapId>(w_merge, 1024, 1024, 1024, WmT, scr, r, lane); continue; } r -= I_M;
            if (r < I_M) { p0_transpose_item<MapId>(w_xq, 1024, 1024, 1024, WxqT, scr, r, lane, g_xattn); continue; } r -= I_M;
            if (r < I_M) { p0_transpose_item<MapId>(w_xo, 1024, 1024, 1024, WxoT, scr, r, lane); continue; } r -= I_M;
            p0_transpose_item<MapId>(w_xkv, 1024, 2048, 2048, WxkvT, scr, r, lane);
        }
        { int m = gw; for (; m + 3 * NGW < T; m += 4 * NGW) rms_rows_to_bf16<4>(x, g_mix, A, m, NGW, lane); for (; m < T; m += NGW) rms_row_to_bf16(x + (size_t)m * D, g_mix, A + (size_t)m * D, lane); }
        { int m = gw; for (; m + NGW < MEMROWS; m += 2 * NGW) rms_rows_to_bf16<2>(mem, g_mem, MEMN, m, NGW, lane); for (; m < MEMROWS; m += NGW) rms_row_to_bf16(mem + (size_t)m * D, g_mem, MEMN + (size_t)m * D, lane); }
        for (int i = gt; i < 2048 * 32; i += NGT) { const int pos = i >> 5, f = i & 31; const float inv = powf(10000.0f, -(float)f / 32.0f); const float ang = (float)pos * inv; ropec[i] = cosf(ang); ropes[i] = sinf(ang); }
        __syncthreads();
        {
            LAS float* skl = (LAS float*)(L + RING_OFF);
            LAS float* wtl = skl + 128 * 129;
            for (int it = bx; it < 256; it += G) {
                const int hp = it >> 4, cb = it & 15;
                for (int i = tid; i < 128 * 128; i += NWAVES * 64) { const int n = i >> 7, d = i & 127; skl[n * 129 + d] = sub_keys[((size_t)hp * 128 + n) * 128 + d]; }
                for (int i = tid; i < 64 * 128; i += NWAVES * 64) { const int c = i >> 7, d = i & 127; wtl[c * 129 + d] = w_pq[(size_t)(cb * 64 + c) * 2048 + hp * 128 + d] * g_ffn[cb * 64 + c]; }
                __syncthreads();
                const int cg = tid & 15, ng = tid >> 4;
                float acc[4][4];
#pragma unroll
                for (int i = 0; i < 4; ++i)
#pragma unroll
                    for (int j = 0; j < 4; ++j) acc[i][j] = 0.f;
                for (int d = 0; d < 128; ++d) {
                    float wv[4], sv[4];
#pragma unroll
                    for (int i = 0; i < 4; ++i) { wv[i] = wtl[(4 * cg + i) * 129 + d]; sv[i] = skl[(4 * ng + i) * 129 + d]; }
#pragma unroll
                    for (int i = 0; i < 4; ++i)
#pragma unroll
                        for (int j = 0; j < 4; ++j) acc[i][j] += sv[i] * wv[j];
                }
#pragma unroll
                for (int i = 0; i < 4; ++i) { v2u w; w.x = pk2(acc[i][0], acc[i][1]); w.y = pk2(acc[i][2], acc[i][3]); *(GAS v2u*)(MT + (size_t)(hp * 128 + 4 * ng + i) * 1024 + cb * 64 + 4 * cg) = w; }
                __syncthreads();
            }
        }
    }
    xcd_barrier(bar); TSTAMP();

    asm volatile("; ===== PHASE 1 =====");
    if (PH(1)) for (int rep = 0; rep < NREP(1); ++rep) {
        PH_LANES; const bool dummy = rep < NREP(1) - 1; (void)dummy;
        pg8::Gemm g{1024, 1024, 1024}; pg8::StaticOrder S; S.init(A, 1024, WinT, 1024, T, INW, G, bx);
        pg8::EpiIn E{U, YC, QO, KB, VB, SGC, SGA, ropec, ropes, kbar, 0.125f * 1.4426950408889634f};
        pg8::gemm_phase<pg8::EpiIn, pg8::StaticOrder, true>(L + RING_OFF, g, S, E);
    }
    if (PH(1)) for (int rep = 0; rep < NREP(1); ++rep) {
        PH_LANES; const bool dummy = rep < NREP(1) - 1; (void)dummy;
        pg8::Gemm g{1024, 1024, 1024}; pg8::StaticOrder S; S.init(MEMN, 1024, WxkvT, 1024, MEMROWS, 1024, G, bx);
        pg8::EpiBf16 E{KX, 1024};
        pg8::gemm_phase<pg8::EpiBf16, pg8::StaticOrder, true>(L + RING_OFF, g, S, E);
    }
    if (PH(1)) for (int rep = 0; rep < NREP(1); ++rep) {
        PH_LANES; const bool dummy = rep < NREP(1) - 1; (void)dummy;
        pg8::Gemm g{1024, 1024, 1024}; pg8::StaticOrder S; S.init(WxkvT + (size_t)1024 * 1024, 1024, MEMN, 1024, 1024, MEMROWS, G, (bx + 128) % G);
        pg8::EpiBf16 E{VXT, 4096};
        pg8::gemm_phase<pg8::EpiBf16, pg8::StaticOrder, true>(L + RING_OFF, g, S, E);
    }
    if (PH(1)) for (int rep = 0; rep < NREP(1); ++rep) {
        PH_LANES; const bool dummy = rep < NREP(1) - 1; (void)dummy;
        int cb, ncb;
        if (G == 256) { const bool idle = (bx >= 64 && bx < 128) || bx >= 192; cb = idle ? ((bx < 128) ? bx - 64 : bx - 128) : 256; ncb = 128; } else { cb = bx; ncb = G; }
        const int cw = cb * NWAVES + wave, ncw = ncb * NWAVES;
        for (int e = (cb < ncb ? cw : 16384); e < 16384; e += ncw) {
            const GAS f32x4* r = (const GAS f32x4*)(peer_u + (size_t)e * D) + lane; f32x4 v[4]; float am = 0.f;
#pragma unroll
            for (int j = 0; j < 4; ++j) { v[j] = r[64 * j] * ((const GAS f32x4*)g_ffn + lane)[64 * j]; am = fmaxf(fmaxf(am, fmaxf(fabsf(v[j].x), fabsf(v[j].y))), fmaxf(fabsf(v[j].z), fabsf(v[j].w))); }
            am = wave_max(am);
            const float sc = am > 0.f ? 127.f / am : 1.f; if (lane == 0) SU[e] = am > 0.f ? am * (1.f / 127.f) : 1.f;
#pragma unroll
            for (int j = 0; j < 4; ++j) { const unsigned w = ((unsigned)(int)rintf(v[j].x * sc) & 255u) | (((unsigned)(int)rintf(v[j].y * sc) & 255u) << 8) | (((unsigned)(int)rintf(v[j].z * sc) & 255u) << 16) | (((unsigned)(int)rintf(v[j].w * sc) & 255u) << 24);
                *(GAS unsigned*)(U8 + (size_t)e * 1024 + 4 * lane + 256 * j) = w; }
        }
        __syncthreads();
        for (int it = cb; it < 256; it += ncb) {
            const int e0 = it * 64;
#pragma unroll 1
            for (int rr = 0; rr < 8; ++rr) {
                const int el = wave * 8 + rr, e = e0 + el;
                const GAS f32x4* r = (const GAS f32x4*)(peer_v + (size_t)e * D) + lane; f32x4 v[4]; float am = 0.f;
#pragma unroll
                for (int j = 0; j < 4; ++j) { v[j] = r[64 * j]; am = fmaxf(fmaxf(am, fmaxf(fabsf(v[j].x), fabsf(v[j].y))), fmaxf(fabsf(v[j].z), fabsf(v[j].w))); }
                am = wave_max(am);
                const float sc = am > 0.f ? 4.f / am : 1.f; if (lane == 0) SV[e] = am > 0.f ? am * 0.25f : 1.f;
#pragma unroll
                for (int j = 0; j < 4; ++j) { int w = __builtin_amdgcn_cvt_pk_bf8_f32(v[j].x * sc, v[j].y * sc, 0, false); w = __builtin_amdgcn_cvt_pk_bf8_f32(v[j].z * sc, v[j].w * sc, w, true);
                    *(LAS unsigned*)(L + RING_OFF + el * 1024 + 4 * lane + 256 * j) = (unsigned)w; }
            }
            __syncthreads();
#pragma unroll
            for (int i = 0; i < 8; ++i) { const int idx = tid + 512 * i, sl = idx >> 5, k = idx & 31;
                const v2u a0 = *(const LAS v2u*)(L + RING_OFF + (2 * k) * 1024 + sl * 8), a1 = *(const LAS v2u*)(L + RING_OFF + (2 * k + 1) * 1024 + sl * 8);
                *(GAS v4u*)(V8T + ((size_t)sl * 16384 + e0 + 2 * k) * 8) = (v4u){a0.x, a0.y, a1.x, a1.y}; }
            __syncthreads();
        }
    }
    xcd_barrier(bar); TSTAMP();

    asm volatile("; ===== PHASE 2 =====");
    if (PH(2)) for (int rep = 0; rep < NREP(2); ++rep) {
        PH_LANES; const bool dummy = rep < NREP(2) - 1; (void)dummy;
        for (int i = gt; i < T * 64; i += NGT) {
            const int row = i >> 6, cg = i & 63, s = row & 2047;
            const v4u u0 = *(const GAS v4u*)(U + (size_t)row * 512 + cg * 8);
            v4u u1 = (v4u){0u, 0u, 0u, 0u}, u2 = (v4u){0u, 0u, 0u, 0u};
            if (s >= 1) u1 = *(const GAS v4u*)(U + (size_t)(row - 1) * 512 + cg * 8);
            if (s >= 2) u2 = *(const GAS v4u*)(U + (size_t)(row - 2) * 512 + cg * 8);
            const v4u bq = *(const GAS v4u*)(YC + (size_t)row * 512 + cg * 8);
            const f32x4 w0a = *(const GAS f32x4*)(w_conv + cg * 8), w0b = *(const GAS f32x4*)(w_conv + cg * 8 + 4);
            const f32x4 w1a = *(const GAS f32x4*)(w_conv + 512 + cg * 8), w1b = *(const GAS f32x4*)(w_conv + 512 + cg * 8 + 4);
            const f32x4 w2a = *(const GAS f32x4*)(w_conv + 1024 + cg * 8), w2b = *(const GAS f32x4*)(w_conv + 1024 + cg * 8 + 4);
            v4u o;
#define CONV2(q, wa, ia, ib) pk2(bflo(bq.q) * (w0##wa[ia] * bflo(u2.q) + w1##wa[ia] * bflo(u1.q) + w2##wa[ia] * bflo(u0.q)), bfhi(bq.q) * (w0##wa[ib] * bfhi(u2.q) + w1##wa[ib] * bfhi(u1.q) + w2##wa[ib] * bfhi(u0.q)))
            o.x = CONV2(x, a, 0, 1); o.y = CONV2(y, a, 2, 3); o.z = CONV2(z, b, 0, 1); o.w = CONV2(w, b, 2, 3);
#undef CONV2
            { const bool conv_dummy = (NREP(2) == 2) && !dummy; *(GAS v4u*)(YC + (size_t)row * 512 + cg * 8) = conv_dummy ? bq : o; }
        }
        __syncthreads();
        const attn_body::AttnTensors AT{(const attn_body::bf16*)QO, (const attn_body::bf16*)KB, (const attn_body::bf16*)VB, (attn_body::bf16*)(dummy ? A : QO), kbar};
        const attn_body::StaticOrder S(G, bx);
        attn_body::attn_phase<attn_body::StaticOrder>((char*)lds + RING_OFF, AT, S);
    }
    xcd_barrier(bar); TSTAMP();

    asm volatile("; ===== PHASE 3 =====");
    if (PH(3)) for (int rep = 0; rep < NREP(3); ++rep) {
        PH_LANES; const bool dummy = rep < NREP(3) - 1; (void)dummy;
        pg8::Gemm g{512, 512, 512}; pg8::StaticOrder S; S.init(YC, 512, WcT, 512, T, 1024, G, bx);
        pg8::EpiGateMul E{SGC, dummy ? A : SGC, 1024};
        pg8::gemm_phase<pg8::EpiGateMul, pg8::StaticOrder, true>(L + RING_OFF, g, S, E);
    }
    if (PH(3)) for (int rep = 0; rep < NREP(3); ++rep) {
        PH_LANES; const bool dummy = rep < NREP(3) - 1; (void)dummy;
        pg8::Gemm g{512, 512, 512}; pg8::StaticOrder S; S.init(QO, 512, WaT, 512, T, 1024, G, bx);
        pg8::EpiGateFma E{SGC, SGA, dummy ? A : SGA, 1024};
        pg8::gemm_phase<pg8::EpiGateFma, pg8::StaticOrder, true>(L + RING_OFF, g, S, E);
    }
    xcd_barrier(bar); TSTAMP();

    asm volatile("; ===== PHASE 4 =====");
    if (PH(4)) for (int rep = 0; rep < NREP(4); ++rep) {
        PH_LANES; const bool dummy = rep < NREP(4) - 1; (void)dummy;
        pg8::Gemm g{1024, 1024, 1024}; pg8::StaticOrder S; S.init(SGA, 1024, WmT, 1024, T, 1024, G, bx);
        pg8::EpiResNorm<true> E{x, A, SSQ1, 1024, 1.f};
        pg8::gemm_phase<pg8::EpiResNorm<true>, pg8::StaticOrder, true>(L + RING_OFF, g, S, E);
    }
    xcd_barrier(bar); TSTAMP();

    asm volatile("; ===== PHASE 6 =====");
    if (PH(6)) for (int rep = 0; rep < NREP(6); ++rep) {
        PH_LANES; const bool dummy = rep < NREP(6) - 1; (void)dummy;
        const pg8::Gemm gq{1024, 1024, 1024}, gs{1024, 1024, 256}, gv{1024, 4096, 256};
        const pg8::EpiBf16RS Eq{QX, 1024, SSQ1}; const pg8::EpiSoftmax Es{PM, 1024, 0.0625f * 1.4426950408889634f}; const pg8::EpiBf16 Ev{OX, 1024};
        { XOrder S{(const char*)A, (const char*)WxqT, G, vcu, 0, 0}; pg8::gemm_phase<pg8::EpiBf16RS, XOrder, false>(L + RING_OFF, gq, S, Eq); }
        VM_WAIT(); __syncthreads();
        { XOrder S{(const char*)QX, (const char*)KX, G, vcu, 0, 1}; pg8::gemm_phase<pg8::EpiSoftmax, XOrder, false>(L + RING_OFF, gs, S, Es); }
        VM_WAIT(); __syncthreads();
        { XOrder S{(const char*)PM, (const char*)VXT, G, vcu, 0, 2}; pg8::gemm_phase<pg8::EpiBf16, XOrder, false>(L + RING_OFF, gv, S, Ev); }
        VM_WAIT(); __syncthreads();
        { XOrder S{(const char*)A, (const char*)WxqT, G, vcu, 1, 0}; pg8::gemm_phase<pg8::EpiBf16RS, XOrder, false>(L + RING_OFF, gq, S, Eq); }
        VM_WAIT(); __syncthreads();
        { XOrder S{(const char*)QX, (const char*)KX, G, vcu, 1, 1}; pg8::gemm_phase<pg8::EpiSoftmax, XOrder, false>(L + RING_OFF, gs, S, Es); }
        VM_WAIT(); __syncthreads();
        { XOrder S{(const char*)PM, (const char*)VXT, G, vcu, 1, 2}; pg8::gemm_phase<pg8::EpiBf16, XOrder, false>(L + RING_OFF, gv, S, Ev); }
    }
    xcd_barrier(bar); TSTAMP();

    asm volatile("; ===== PHASE 9 =====");
    if (PH(9)) for (int rep = 0; rep < NREP(9); ++rep) {
        PH_LANES; const bool dummy = rep < NREP(9) - 1; (void)dummy;
        pg8::Gemm g{1024, 1024, 1024}; pg8::StaticOrder S; S.init(OX, 1024, WxoT, 1024, T, 1024, G, bx);
        pg8::EpiResNorm<false> E{nullptr, A, SSQ2, 1024, dummy ? 0.f : 1.f};
        pg8::gemm_phase<pg8::EpiResNorm<false>, pg8::StaticOrder, true>(L + RING_OFF, g, S, E);
    }
    xcd_barrier(bar); TSTAMP();

    asm volatile("; ===== PHASE 11 =====");
    if (PH(11)) for (int rep = 0; rep < NREP(11); ++rep) {
        PH_LANES; const bool dummy = rep < NREP(11) - 1; (void)dummy;
        pg8::Gemm g{1024, 1024, 1024}; pg8::StaticOrder S; S.init(A, 1024, MT, 1024, T, 2048, G, bx);
        pg8::EpiF16RS E{SC, 2048, SSQ2};
        pg8::gemm_phase<pg8::EpiF16RS, pg8::StaticOrder, true>(L + RING_OFF, g, S, E);
    }
    xcd_barrier(bar); TSTAMP();

    asm volatile("; ===== PHASE 12 =====");
    if (PH(12)) for (int rep = 0; rep < NREP(12); ++rep) {
        PH_LANES; const bool dummy = rep < NREP(12) - 1; (void)dummy;
        typedef _Float16 h8 __attribute__((ext_vector_type(8)));
#define RCE(a, b) do { const float hi_ = fmax_asm(a, b); b = fmin_asm(a, b); a = hi_; } while (0)
#define RSORT16(K) do { RCE(K[0], K[1]); RCE(K[3], K[2]); RCE(K[4], K[5]); RCE(K[7], K[6]); RCE(K[8], K[9]); RCE(K[11], K[10]); RCE(K[12], K[13]); RCE(K[15], K[14]); RCE(K[0], K[2]); RCE(K[1], K[3]); RCE(K[6], K[4]); RCE(K[7], K[5]); RCE(K[8], K[10]); RCE(K[9], K[11]); RCE(K[14], K[12]); RCE(K[15], K[13]); RCE(K[0], K[1]); RCE(K[2], K[3]); RCE(K[5], K[4]); RCE(K[7], K[6]); RCE(K[8], K[9]); RCE(K[10], K[11]); RCE(K[13], K[12]); RCE(K[15], K[14]); RCE(K[0], K[4]); RCE(K[1], K[5]); RCE(K[2], K[6]); RCE(K[3], K[7]); RCE(K[12], K[8]); RCE(K[13], K[9]); RCE(K[14], K[10]); RCE(K[15], K[11]); RCE(K[0], K[2]); RCE(K[1], K[3]); RCE(K[4], K[6]); RCE(K[5], K[7]); RCE(K[10], K[8]); RCE(K[11], K[9]); RCE(K[14], K[12]); RCE(K[15], K[13]); RCE(K[0], K[1]); RCE(K[2], K[3]); RCE(K[4], K[5]); RCE(K[6], K[7]); RCE(K[9], K[8]); RCE(K[11], K[10]); RCE(K[13], K[12]); RCE(K[15], K[14]); RCE(K[0], K[8]); RCE(K[1], K[9]); RCE(K[2], K[10]); RCE(K[3], K[11]); RCE(K[4], K[12]); RCE(K[5], K[13]); RCE(K[6], K[14]); RCE(K[7], K[15]); RCE(K[0], K[4]); RCE(K[1], K[5]); RCE(K[2], K[6]); RCE(K[3], K[7]); RCE(K[8], K[12]); RCE(K[9], K[13]); RCE(K[10], K[14]); RCE(K[11], K[15]); RCE(K[0], K[2]); RCE(K[1], K[3]); RCE(K[4], K[6]); RCE(K[5], K[7]); RCE(K[8], K[10]); RCE(K[9], K[11]); RCE(K[12], K[14]); RCE(K[13], K[15]); RCE(K[0], K[1]); RCE(K[2], K[3]); RCE(K[4], K[5]); RCE(K[6], K[7]); RCE(K[8], K[9]); RCE(K[10], K[11]); RCE(K[12], K[13]); RCE(K[14], K[15]); } while (0)
#define RMERGE16(K) do { RCE(K[0], K[8]); RCE(K[1], K[9]); RCE(K[2], K[10]); RCE(K[3], K[11]); RCE(K[4], K[12]); RCE(K[5], K[13]); RCE(K[6], K[14]); RCE(K[7], K[15]); RCE(K[0], K[4]); RCE(K[1], K[5]); RCE(K[2], K[6]); RCE(K[3], K[7]); RCE(K[8], K[12]); RCE(K[9], K[13]); RCE(K[10], K[14]); RCE(K[11], K[15]); RCE(K[0], K[2]); RCE(K[1], K[3]); RCE(K[4], K[6]); RCE(K[5], K[7]); RCE(K[8], K[10]); RCE(K[9], K[11]); RCE(K[12], K[14]); RCE(K[13], K[15]); RCE(K[0], K[1]); RCE(K[2], K[3]); RCE(K[4], K[5]); RCE(K[6], K[7]); RCE(K[8], K[9]); RCE(K[10], K[11]); RCE(K[12], K[13]); RCE(K[14], K[15]); } while (0)
#define RKEYS(K, V0, V1, IDB) do { _Pragma("unroll") for (int e = 0; e < 8; ++e) { K[e] = __uint_as_float(__float_as_uint((float)V0[e]) | (unsigned)((IDB) + e)); K[8 + e] = __uint_as_float(__float_as_uint((float)V1[e]) | (unsigned)((IDB) + 8 + e)); } } while (0)
        for (int tb4 = gw * 4; tb4 < T; tb4 += NGW * 4) {
            v4u r0[4], r1[4]; float sq[4];
#pragma unroll
            for (int i = 0; i < 4; ++i) { const GAS v4u* ar = (const GAS v4u*)(A + (size_t)(tb4 + i) * D + 16 * lane); r0[i] = ar[0]; r1[i] = ar[1]; sq[i] = lane < 16 ? SSQ2[(size_t)(tb4 + i) * 16 + lane] : 0.f; }
#pragma unroll
            for (int i = 0; i < 4; ++i) {
                float a[16];
                a[0] = bflo(r0[i].x); a[1] = bfhi(r0[i].x); a[2] = bflo(r0[i].y); a[3] = bfhi(r0[i].y); a[4] = bflo(r0[i].z); a[5] = bfhi(r0[i].z); a[6] = bflo(r0[i].w); a[7] = bfhi(r0[i].w);
                a[8] = bflo(r1[i].x); a[9] = bfhi(r1[i].x); a[10] = bflo(r1[i].y); a[11] = bfhi(r1[i].y); a[12] = bflo(r1[i].z); a[13] = bfhi(r1[i].z); a[14] = bflo(r1[i].w); a[15] = bfhi(r1[i].w);
                float amx = 0.f;
#pragma unroll
                for (int k = 0; k < 16; ++k) amx = fmaxf(amx, fabsf(a[k]));
                amx = wave_max(amx);
                const float rs2 = rsqrtf(wave_sum(sq[i]) * (1.f / 1024.f) + RMS_EPS);
                const float asc = amx > 0.f ? 127.f / amx : 1.f;
                v4u qv;
#define QP4(k) (((unsigned)(int)rintf(a[4 * (k)] * asc) & 255u) | (((unsigned)(int)rintf(a[4 * (k) + 1] * asc) & 255u) << 8) | (((unsigned)(int)rintf(a[4 * (k) + 2] * asc) & 255u) << 16) | (((unsigned)(int)rintf(a[4 * (k) + 3] * asc) & 255u) << 24))
                qv.x = QP4(0); qv.y = QP4(1); qv.z = QP4(2); qv.w = QP4(3);
#undef QP4
                *(GAS v4u*)(A8I + (size_t)(tb4 + i) * 1024 + 16 * lane) = qv;
                if (lane == 0) ASC[tb4 + i] = (amx > 0.f ? amx * (1.f / 127.f) : 1.f) * rs2;
            }
        }
        LAS unsigned char* idl = L + RING_OFF + tid * 32;
        for (int task = gt; task < T * 8; task += NGT) {
            const int t = task >> 3, h = task & 7;
            const _Float16* row = SC + (size_t)t * 2048 + h * 256;
            float LA[16], LB[16];
#pragma unroll 1
            for (int p = 0; p < 2; ++p) {
                const _Float16* rp = row + p * 128;
                float Tk[16];
                h8 n0 = *(const h8*)(rp + 16), n1 = *(const h8*)(rp + 24);
                { const h8 v0 = *(const h8*)rp, v1 = *(const h8*)(rp + 8); RKEYS(Tk, v0, v1, 0); RSORT16(Tk); }
#pragma unroll 1
                for (int c = 1; c < 8; ++c) {
                    const h8 v0 = n0, v1 = n1;
                    { const int cn = c < 7 ? c + 1 : c; n0 = *(const h8*)(rp + cn * 16); n1 = *(const h8*)(rp + cn * 16 + 8); }
                    float K[16]; RKEYS(K, v0, v1, c * 16); RSORT16(K);
#pragma unroll
                    for (int i = 0; i < 16; ++i) Tk[i] = fmax_asm(Tk[i], K[15 - i]);
                    RMERGE16(Tk);
                }
#pragma unroll
                for (int k = 0; k < 16; ++k) { if (p == 0) LA[k] = Tk[k]; else LB[k] = Tk[k]; }
            }
#pragma unroll
            for (int k = 0; k < 16; k += 4) {
                ((LAS unsigned*)idl)[k >> 2] = (__float_as_uint(LA[k]) & 127u) | ((__float_as_uint(LA[k + 1]) & 127u) << 8) | ((__float_as_uint(LA[k + 2]) & 127u) << 16) | ((__float_as_uint(LA[k + 3]) & 127u) << 24);
                ((LAS unsigned*)idl)[4 + (k >> 2)] = (__float_as_uint(LB[k]) & 127u) | ((__float_as_uint(LB[k + 1]) & 127u) << 8) | ((__float_as_uint(LB[k + 2]) & 127u) << 16) | ((__float_as_uint(LB[k + 3]) & 127u) << 24);
            }
#define CKEY(a, b) __uint_as_float((__float_as_uint(LA[a] + LB[b]) & ~255u) | (unsigned)(255 - (16 * (a) + (b))))
            float Ck[16];
#pragma unroll
            for (int a = 0; a < 16; ++a) Ck[a] = CKEY(a, 0);
#define CRUN(b, n) do { _Pragma("unroll") for (int j = 0; j < (n); ++j) Ck[15 - j] = fmax_asm(Ck[15 - j], CKEY(j, b)); RMERGE16(Ck); } while (0)
            CRUN(1, 8); CRUN(2, 5); CRUN(3, 4); CRUN(4, 3); CRUN(5, 2); CRUN(6, 2); CRUN(7, 2);
#pragma unroll
            for (int j = 0; j < 8; ++j) Ck[15 - j] = fmax_asm(Ck[15 - j], CKEY(0, 8 + j));
            RMERGE16(Ck);
#undef CRUN
#undef CKEY
            LDS_WAIT();
            float ex[16]; float sum = 0.f;
#pragma unroll
            for (int k = 0; k < 16; ++k) { ex[k] = __expf(Ck[k] - Ck[0]); sum += ex[k]; }
            const float rs = 1.f / sum;
            int* eo = EIDX + (size_t)t * 128 + h * 16;
#pragma unroll
            for (int k = 0; k < 16; k += 4) {
                int ev[4];
#pragma unroll
                for (int j = 0; j < 4; ++j) { const unsigned id = 255u - (__float_as_uint(Ck[k + j]) & 255u); ev[j] = (int)idl[id >> 4] * 128 + (int)idl[16 + (id & 15u)]; }
                *(GAS v4u*)(eo + k) = (v4u){(pk2(0.f, ex[k] * rs) & 0xffff0000u) | (unsigned)ev[0], (pk2(0.f, ex[k + 1] * rs) & 0xffff0000u) | (unsigned)ev[1],
                                             (pk2(0.f, ex[k + 2] * rs) & 0xffff0000u) | (unsigned)ev[2], (pk2(0.f, ex[k + 3] * rs) & 0xffff0000u) | (unsigned)ev[3]};
            }
            LDS_WAIT();
        }
#undef RCE
#undef RSORT16
#undef RMERGE16
#undef RKEYS
    }
    xcd_barrier(bar); TSTAMP();

    asm volatile("; ===== PHASE 13 =====");
    if (PH(13)) for (int rep = 0; rep < NREP(13); ++rep) {
        PH_LANES; const bool dummy = rep < NREP(13) - 1; (void)dummy;
        volatile LAS unsigned* qslot = (volatile LAS unsigned*)(L + LDSCTL_OFF + 64);
        LAS unsigned char* tile = L + RING_OFF + wave * 8192;
        LAS float* rsl = (LAS float*)(L + UL_OFF + wave * UL_WAVE);
        LAS v4u* lst = (LAS v4u*)(L + UL_OFF + wave * UL_WAVE + 64);
        const int xs = (int)(xb_xcc_id() & 7u);
        __syncthreads();
        if (tid == 0) *qslot = __hip_atomic_fetch_add((unsigned*)(ctl + CW_Q + 64 * (rep * 8 + xs)), 1u, __ATOMIC_RELAXED, __HIP_MEMORY_SCOPE_AGENT);
        __syncthreads();
        const int rank = __builtin_amdgcn_readfirstlane((int)*qslot);
        int cnt[8];
#pragma unroll
        for (int j = 0; j < 8; ++j) cnt[j] = __builtin_amdgcn_readfirstlane((int)(xb_ld(bar.bar + XB_XCNT(j)) + xb_ld(bar.bar + XB_XCNT(j + 8))));
#pragma unroll 1
        for (int x = 0; x < 8; ++x) {
            int cn = 0;
#pragma unroll
            for (int j = 0; j < 8; ++j) cn = (j == x) ? cnt[j] : cn;
            int j0, jstep;
            if (x == xs) { j0 = rank * 8 + wave; jstep = cn * 8; } else if (cn == 0) { j0 = bx * 8 + wave; jstep = G * 8; } else continue;
#pragma unroll 1
            for (int job = j0; job < T / 8; job += jstep) {
                const int t0 = job * 8;
#pragma unroll 1
                for (int r0 = 0;; r0 += UL_CAP) {
                    int ln = lane; asm volatile("" : "+v"(ln));
#pragma unroll
                    for (int tl = 0; tl < 8; ++tl)
                        __builtin_amdgcn_global_load_lds((const unsigned*)(A8I + (size_t)(t0 + tl) * 1024 + ln * 16), (LAS unsigned*)(tile + tl * 1024), 16, 0, 0);
                    if (ln < 8) rsl[ln] = ASC[t0 + ln];
                    unsigned pa[8], pb[8];
#pragma unroll
                    for (int tl = 0; tl < 8; ++tl) { pa[tl] = (unsigned)EIDX[(size_t)(t0 + tl) * 128 + ln]; pb[tl] = (unsigned)EIDX[(size_t)(t0 + tl) * 128 + 64 + ln]; }
                    int total = 0; unsigned long long m0s[8], m1s[8];
#pragma unroll
                    for (int tl = 0; tl < 8; ++tl) { m0s[tl] = __ballot((int)((pa[tl] & 0xffffu) >> 11) == x); m1s[tl] = __ballot((int)((pb[tl] & 0xffffu) >> 11) == x); total += __popcll(m0s[tl]) + __popcll(m1s[tl]); }
                    float sua[8], sva[8], sub[8], svb[8];
#pragma unroll
                    for (int tl = 0; tl < 8; ++tl) { sua[tl] = sva[tl] = sub[tl] = svb[tl] = 0.f;
                        if ((m0s[tl] >> lane) & 1ull) { sua[tl] = SU[pa[tl] & 0xffffu]; sva[tl] = SV[pa[tl] & 0xffffu]; }
                        if ((m1s[tl] >> lane) & 1ull) { sub[tl] = SU[pb[tl] & 0xffffu]; svb[tl] = SV[pb[tl] & 0xffffu]; } }
                    asm volatile("s_waitcnt vmcnt(0) lgkmcnt(0)" ::: "memory");
                    int base = -r0;
#pragma unroll
                    for (int tl = 0; tl < 8; ++tl) {
                        const int n0 = __popcll(m0s[tl]), n1 = __popcll(m1s[tl]); const float rs = rsl[tl];
                        const int k0 = base + (int)__builtin_amdgcn_mbcnt_hi((unsigned)(m0s[tl] >> 32), __builtin_amdgcn_mbcnt_lo((unsigned)m0s[tl], 0u));
                        const int k1 = base + n0 + (int)__builtin_amdgcn_mbcnt_hi((unsigned)(m1s[tl] >> 32), __builtin_amdgcn_mbcnt_lo((unsigned)m1s[tl], 0u));
                        if (((m0s[tl] >> lane) & 1ull) && k0 >= 0 && k0 < UL_CAP) lst[k0] = (v4u){pa[tl], (unsigned)((tl << 7) | lane), __float_as_uint(sua[tl] * rs), __float_as_uint(__uint_as_float(pa[tl] & 0xffff0000u) * sva[tl])};
                        if (((m1s[tl] >> lane) & 1ull) && k1 >= 0 && k1 < UL_CAP) lst[k1] = (v4u){pb[tl], (unsigned)((tl << 7) | 64 | lane), __float_as_uint(sub[tl] * rs), __float_as_uint(__uint_as_float(pb[tl] & 0xffff0000u) * svb[tl])};
                        base += n0 + n1;
                    }
                    const int count = (total - r0) < UL_CAP ? (total - r0) : UL_CAP;
                    asm volatile("s_waitcnt lgkmcnt(0)" ::: "memory");
#define JLOAD(Q, EN, B16) do { const int myi_ = (B16) + (lane >> 2); EN = lst[myi_ < count ? myi_ : count - 1];         \
                        const unsigned char* rp_ = U8 + (size_t)(EN.x & 0xffffu) * 1024 + (lane & 3) * 16; \
                        _Pragma("unroll") for (int j = 0; j < 16; ++j) Q[j] = *(const GAS v4u*)(rp_ + j * 64); } while (0)
#define JCOMP(Q, EN, B16) do { const LAS unsigned char* ap_ = tile + (EN.y >> 7) * 1024 + (lane & 3) * 16; int d0 = 0, d1 = 0, d2 = 0, d3 = 0; \
                        _Pragma("unroll") for (int j = 0; j < 16; ++j) { const v4u qa_ = *(const LAS v4u*)(ap_ + j * 64); \
                            d0 = __builtin_amdgcn_sdot4((int)Q[j].x, (int)qa_.x, d0, false); d1 = __builtin_amdgcn_sdot4((int)Q[j].y, (int)qa_.y, d1, false); \
                            d2 = __builtin_amdgcn_sdot4((int)Q[j].z, (int)qa_.z, d2, false); d3 = __builtin_amdgcn_sdot4((int)Q[j].w, (int)qa_.w, d3, false); } \
                        int doti = (d0 + d1) + (d2 + d3); \
                        doti += __builtin_amdgcn_ds_swizzle(doti, (1 << 10) | 0x1f); doti += __builtin_amdgcn_ds_swizzle(doti, (2 << 10) | 0x1f);        \
                        if ((lane & 3) == 0 && (B16) + (lane >> 2) < count) { \
                            const int e = (int)(EN.x & 0xffffu), slot = (int)(EN.y & 127u); const int t = t0 + (int)(EN.y >> 7); \
                            const float act = (float)doti * __uint_as_float(EN.z); const float u3 = 0.7978845608028654f * (act + 0.044715f * act * act * act); \
                            const float wv = act * __builtin_amdgcn_rcpf(1.f + __expf(-2.f * u3)) * __uint_as_float(EN.w);             \
                            PW[((size_t)((t >> 6) * 8 + (slot >> 4)) * 4 + ((slot >> 2) & 3)) * 256 + (t & 63) * 4 + (slot & 3)] = ((unsigned)__builtin_bit_cast(unsigned short, (_Float16)wv) << 16) | (unsigned)e;     } } while (0)
                    if (count > 0) {
                        v4u qa[16], qb[16]; v4u ena, enb;
                        JLOAD(qa, ena, 0);
#pragma unroll 1
                        for (int b16 = 0; b16 < count; b16 += 32) {
                            const bool has_b = b16 + 16 < count;
                            if (has_b) JLOAD(qb, enb, b16 + 16);
                            JCOMP(qa, ena, b16);
                            if (has_b) { if (b16 + 32 < count) JLOAD(qa, ena, b16 + 32); JCOMP(qb, enb, b16 + 16); }
                        }
                    }
#undef JLOAD
#undef JCOMP
                    asm volatile("s_waitcnt lgkmcnt(0)" ::: "memory");
                    if (r0 + UL_CAP >= total) break;
                }
            }
        }
        __syncthreads();
    }
    xcd_barrier(bar); TSTAMP();

    asm volatile("; ===== PHASE 14 =====");
    if (PH(14)) for (int rep = 0; rep < NREP(14); ++rep) {
        PH_LANES; const bool dummy = rep < NREP(14) - 1; (void)dummy;
        for (int item = vcu; item < 256; item += G) {
            const int sl = item & 127, half = item >> 7;
            __syncthreads();
#pragma unroll
            for (int i = 0; i < 16; ++i) *(LAS v4u*)(L + RING_OFF + (i * 512 + tid) * 16) = *(const GAS v4u*)(V8T + (size_t)sl * 131072 + (size_t)(i * 512 + tid) * 16);
            __syncthreads();
            const GAS v4u* pwb = (const GAS v4u*)(PW + (size_t)(half * 256 + wave) * 8192) + lane;
            v4u buf[4][4];
#pragma unroll
            for (int c = 0; c < 4; ++c)
#pragma unroll
                for (int k = 0; k < 4; ++k) buf[c][k] = pwb[c * 256 + k * 64];
#pragma unroll 1
            for (int itk = 0; itk < 32; ++itk) {
                const int g64 = half * 256 + itk * 8 + wave;
                const int t = g64 * 64 + lane;
                unsigned accu[4] = {0u, 0u, 0u, 0u};
#pragma unroll
                for (int c = 0; c < 8; ++c) {
                    v4u cur[4];
#pragma unroll
                    for (int k = 0; k < 4; ++k) cur[k] = buf[c & 3][k];
                    { const int sn = itk * 8 + c + 4; const int gn = (sn >> 3) > 31 ? 31 : (sn >> 3), cc = sn & 7; const GAS v4u* src = pwb + (size_t)gn * 8 * 2048 + cc * 256;
#pragma unroll
                      for (int k = 0; k < 4; ++k) buf[c & 3][k] = src[k * 64]; }
                    v2u tb[16];
#pragma unroll
                    for (int k = 0; k < 4; ++k)
#pragma unroll
                        for (int i = 0; i < 4; ++i) { unsigned e_ = cur[k][i] & 0xffffu; asm("" : "+v"(e_));
                            tb[k * 4 + i] = *(const LAS v2u*)(L + RING_OFF + (e_ << 3)); }
#pragma unroll
                    for (int k = 0; k < 4; ++k)
#pragma unroll
                        for (int i = 0; i < 4; ++i) { const unsigned p = cur[k][i]; const v2u q = tb[k * 4 + i];
#define VFMA(ACC, T) asm("v_pk_fma_f16 %0, %1, %2, %0 op_sel:[0,1,0] op_sel_hi:[1,1,1]" : "+v"(ACC) : "v"(T), "v"(p))
                            const unsigned t0_ = __builtin_amdgcn_perm(0u, q.x, 0x010c000cu), t1_ = __builtin_amdgcn_perm(0u, q.x, 0x030c020cu), t2_ = __builtin_amdgcn_perm(0u, q.y, 0x010c000cu), t3_ = __builtin_amdgcn_perm(0u, q.y, 0x030c020cu);
                            VFMA(accu[0], t0_); VFMA(accu[1], t1_); VFMA(accu[2], t2_); VFMA(accu[3], t3_);
#undef VFMA
                        }
                }
                GAS v4u* hr = (GAS v4u*)(A + (size_t)t * D + sl * 8);
                const v4u hq = *hr; const float mulv = dummy ? 0.f : 1.f;
                h2v acc[4];
#pragma unroll
                for (int i = 0; i < 4; ++i) { const unsigned au_ = accu[i]; acc[i] = __builtin_bit_cast(h2v, au_); }
                v4u ho; ho.x = pk2(bflo(hq.x) + (float)acc[0].x * mulv, bfhi(hq.x) + (float)acc[0].y * mulv); ho.y = pk2(bflo(hq.y) + (float)acc[1].x * mulv, bfhi(hq.y) + (float)acc[1].y * mulv);
                ho.z = pk2(bflo(hq.z) + (float)acc[2].x * mulv, bfhi(hq.z) + (float)acc[2].y * mulv); ho.w = pk2(bflo(hq.w) + (float)acc[3].x * mulv, bfhi(hq.w) + (float)acc[3].y * mulv);
                *hr = ho;
            }
        }
    }
    xcd_barrier(bar); TSTAMP();

#ifdef EXTRA_BARRIERS
    for (int eb = 0; eb < EXTRA_BARRIERS; ++eb) xcd_barrier(bar);
#endif
    asm volatile("; ===== PHASE 15 =====");
    if (PH(15)) for (int rep = 0; rep < NREP(15); ++rep) {
        PH_LANES; const bool dummy = rep < NREP(15) - 1; (void)dummy;
        for (int t = gw; t < T; t += NGW) {
            const GAS v4u* hr = (const GAS v4u*)(A + (size_t)t * D + 16 * lane); const v4u q0 = hr[0], q1 = hr[1];
            const GAS f32x4* gr = (const GAS f32x4*)(g_final + 16 * lane); GAS f32x4* orow = (GAS f32x4*)(out + (size_t)t * D + 16 * lane);
            f32x4 o[4] = {(f32x4){bflo(q0.x), bfhi(q0.x), bflo(q0.y), bfhi(q0.y)}, (f32x4){bflo(q0.z), bfhi(q0.z), bflo(q0.w), bfhi(q0.w)},
                          (f32x4){bflo(q1.x), bfhi(q1.x), bflo(q1.y), bfhi(q1.y)}, (f32x4){bflo(q1.z), bfhi(q1.z), bflo(q1.w), bfhi(q1.w)}};
            float ss = 0.f;
#pragma unroll
            for (int j = 0; j < 4; ++j) ss += (o[j].x * o[j].x + o[j].y * o[j].y) + (o[j].z * o[j].z + o[j].w * o[j].w);
            const float r = rsqrtf(wave_sum(ss) * (1.f / 1024.f) + RMS_EPS);
#pragma unroll
            for (int j = 0; j < 4; ++j) orow[j] = o[j] * r * gr[j];
        }
    }
}

extern "C" void kernel_launch(void* const* d_in, const int* in_sizes, int n_in, void* d_out, int out_size, void* d_ws, size_t ws_size, hipStream_t stream) {
    static int grid = 0;
    if (grid == 0) {
        if (n_in != 19 || out_size != T * D || ws_size < WS_END) { fprintf(stderr, "kernel_launch: unexpected problem (n_in %d, out %d, ws %zu < %zu); nothing launched\n", n_in, out_size, ws_size, (size_t)WS_END); grid = -1; return; }
        int dev = 0, cus = 0, per_cu = 0;
        if (hipGetDevice(&dev) != hipSuccess || hipDeviceGetAttribute(&cus, hipDeviceAttributeMultiprocessorCount, dev) != hipSuccess) { grid = -1; return; }
        if (hipFuncSetAttribute((const void*)mk_fwd, hipFuncAttributeMaxDynamicSharedMemorySize, LDS_BYTES) != hipSuccess) { fprintf(stderr, "kernel_launch: hipFuncSetAttribute failed\n"); grid = -1; return; }
        if (hipOccupancyMaxActiveBlocksPerMultiprocessor(&per_cu, (const void*)mk_fwd, NWAVES * 64, LDS_BYTES) != hipSuccess || per_cu < 1) { fprintf(stderr, "kernel_launch: occupancy query says %d blocks per CU\n", per_cu); }
        (void)hipGetLastError();
        grid = cus;
    }
    if (grid < 0) return;
    if (hipMemsetAsync((char*)d_ws + WS_CTL, 0, CTL_ZERO_BYTES, stream) != hipSuccess) return;
    Args a{};
    for (int i = 0; i < 19; ++i) a.in[i] = (const float*)d_in[i];
    a.out = (float*)d_out; a.ws = (unsigned char*)d_ws;
    hipLaunchKernelGGL(mk_fwd, dim3(grid), dim3(NWAVES * 64), LDS_BYTES, stream, a);
}
```

```cpp
#include <hip/hip_runtime.h>
#include <hip/hip_bf16.h>
#include <cstdio>
#include <cstdint>
#include <cmath>

#ifndef DIAG
#define DIAG 0
#endif


template <int O> __device__ __forceinline__ float shx(float v) { static_assert(O > 0 && O < 32, "shx"); return __uint_as_float((unsigned)__builtin_amdgcn_ds_swizzle((int)__float_as_uint(v), (O << 10) | 0x1f)); }
__device__ __forceinline__ float sum32(float v) { auto r = __builtin_amdgcn_permlane32_swap(__float_as_uint(v), __float_as_uint(v), false, false); return __uint_as_float(r[0]) + __uint_as_float(r[1]); }
__device__ __forceinline__ float max32(float v) { auto r = __builtin_amdgcn_permlane32_swap(__float_as_uint(v), __float_as_uint(v), false, false); return fmaxf(__uint_as_float(r[0]), __uint_as_float(r[1])); }
__device__ __forceinline__ float wave_max(float v) { v = fmaxf(v, shx<1>(v)); v = fmaxf(v, shx<2>(v)); v = fmaxf(v, shx<4>(v)); v = fmaxf(v, shx<8>(v)); v = fmaxf(v, shx<16>(v)); return max32(v); }
__device__ __forceinline__ float wave_sum(float v) { v += shx<1>(v); v += shx<2>(v); v += shx<4>(v); v += shx<8>(v); v += shx<16>(v); return sum32(v); }

namespace pg8 {
#define PG8_LAS __attribute__((address_space(3)))
typedef unsigned short bf16_t;
typedef short bf16x8 __attribute__((ext_vector_type(8)));
typedef float f32x4 __attribute__((ext_vector_type(4)));
typedef float f32x2 __attribute__((ext_vector_type(2)));
typedef unsigned u32x4 __attribute__((ext_vector_type(4)));
typedef unsigned u32x2 __attribute__((ext_vector_type(2)));
constexpr int BM = 256, BK = 64, HALF = 128, HTB = HALF * BK * 2  , STAGE_BYTES = 8 * HTB, NXCD = 8, WGM = 4;

__host__ __device__ __forceinline__ int lds_byte(int r, int c) { const int st = (r >> 4) * 2 + (c >> 5), rr = r & 15, cc = c & 31, ob = rr * 64 + cc * 2; return st * 1024 + (ob ^ (((ob >> 9) & 1) << 5)); }
__host__ __device__ __forceinline__ void stage_rc(int b, int& R, int& C) { const int st = b / 1024, sb = b % 1024, swz = sb ^ (((sb >> 9) & 1) << 5); R = (st >> 1) * 16 + swz / 64; C = (st & 1) * 32 + (swz % 64) / 2; }
__host__ __device__ __forceinline__ int perm32(int rho) { const int n = rho >> 4, i = rho & 15; return 8 * (i >> 2) + 4 * n + (i & 3); }

struct Unit { int pm, pn; const char* a; const char* b; };
struct Gemm { int lda, ldb, K; };

struct StaticOrder {
    int nM, nN, nwg, G, c; const char* A; const char* Bt; size_t astep, bstep;
    __device__ void init(const void* A_, int lda, const void* Bt_, int ldb, int M, int N, int G_, int c_) { nM = M / BM; nN = N / BM; nwg = nM * nN; G = G_; c = c_; A = (const char*)A_; Bt = (const char*)Bt_; astep = (size_t)BM * lda * 2; bstep = (size_t)BM * ldb * 2; }
    __device__ bool next(int i, Unit& u) const {
        const long L = (long)i * G + c; if (L >= nwg) return false;
        int wgid = (int)L; { const int q = nwg / NXCD, r = nwg % NXCD, xcd = wgid % NXCD, off = wgid / NXCD; wgid = (xcd < r ? xcd * (q + 1) : r * (q + 1) + (xcd - r) * q) + off; }
        const int nig = WGM * nN, gid = wgid / nig, fm = gid * WGM, gsz = (nM - fm) < WGM ? (nM - fm) : WGM;
        u.pm = fm + ((wgid % nig) % gsz); u.pn = (wgid % nig) / gsz; u.a = A + (size_t)u.pm * astep; u.b = Bt + (size_t)u.pn * bstep; return true;
    }
};

__device__ __forceinline__ unsigned cvt_pk_bf16(float lo, float hi) { typedef __bf16 bf2 __attribute__((ext_vector_type(2))); f32x2 v = {lo, hi}; bf2 b = __builtin_convertvector(v, bf2); return __builtin_bit_cast(unsigned, b); }
__device__ __forceinline__ float bf_lo(unsigned u) { return __uint_as_float(u << 16); }
__device__ __forceinline__ float bf_hi(unsigned u) { return __uint_as_float(u & 0xffff0000u); }

template <class Epi, class Sched, bool ALIGN_EPI>
__device__ __forceinline__ void gemm_phase(PG8_LAS unsigned char* lds, const Gemm g, const Sched& S, const Epi& E) {
    int tid = threadIdx.x; asm volatile("" : "+v"(tid));
    const int wid = __builtin_amdgcn_readfirstlane(tid >> 6), lane = tid & 63, wr = wid >> 2, wc = wid & 3, fr = lane & 15, fq = lane >> 4;
    const int K = g.K, nt = K / BK;
    unsigned voffA[2], voffB[2];
#pragma unroll
    for (int i = 0; i < 2; ++i) { int R, C; stage_rc(tid * 16 + i * 8192, R, C); const int Rb = Epi::PERM ? ((R & ~31) + perm32(R & 31)) : R;
        voffA[i] = (unsigned)(R * g.lda + C) * 2u; voffB[i] = (unsigned)(Rb * g.ldb + C) * 2u; }
    const size_t kstep = (size_t)(BK * 2);
    const size_t hstepA = (size_t)HALF * g.lda * 2, hstepB = (size_t)HALF * g.ldb * 2;
    const unsigned ldsw = (unsigned)wid * 1024u;
    const int aoff = lds_byte(wr * 64 + fr, fq * 8), boff = lds_byte(wc * 32 + fr, fq * 8);
#define PG8_SA(b, h) (((b) * 2 + (h)) * HTB)
#define PG8_SB(b, h) ((4 + (b) * 2 + (h)) * HTB)
#define PG8_STAGE(bufoff, gbase, voff) do { _Pragma("unroll") for (int _i = 0; _i < 2; ++_i) \
        __builtin_amdgcn_global_load_lds((const unsigned*)((const char*)(gbase) + (voff)[_i]), (PG8_LAS unsigned*)(lds + (bufoff) + ldsw + _i * 8192), 16, 0, 0); } while (0)
#define PG8_LDA(dst, b, h) do { _Pragma("unroll") for (int m = 0; m < 4; ++m) _Pragma("unroll") for (int k = 0; k < 2; ++k) dst[m][k] = *(const PG8_LAS bf16x8*)(lds + PG8_SA(b, h) + aoff + m * 2048 + k * 1024); } while (0)
#define PG8_LDB(dst, b, h) do { _Pragma("unroll") for (int n = 0; n < 2; ++n) _Pragma("unroll") for (int k = 0; k < 2; ++k) dst[n][k] = *(const PG8_LAS bf16x8*)(lds + PG8_SB(b, h) + boff + n * 2048 + k * 1024); } while (0)
#define PG8_MMA(ai, bj, At, Bt) do { __builtin_amdgcn_s_setprio(1); _Pragma("unroll") for (int m = 0; m < 4; ++m) _Pragma("unroll") for (int n = 0; n < 2; ++n) _Pragma("unroll") for (int k = 0; k < 2; ++k) \
        acc[ai][bj][m][n] = __builtin_amdgcn_mfma_f32_16x16x32_bf16(Bt[n][k], At[m][k], acc[ai][bj][m][n], 0, 0, 0); __builtin_amdgcn_s_setprio(0); } while (0)
#define PG8_WAIT_V(n) asm volatile("s_waitcnt vmcnt(" #n ")" ::: "memory")
#define PG8_WAIT_L(n) asm volatile("s_waitcnt lgkmcnt(" #n ")" ::: "memory")
#define PG8_BAR __builtin_amdgcn_s_barrier()
#define PG8_SCHED __builtin_amdgcn_sched_barrier(0)
    Unit cur, nxt; int ui = 0;
    if (!S.next(0, cur)) return;
    f32x4 acc[2][2][4][2];
#pragma unroll
    for (int a = 0; a < 2; ++a)
#pragma unroll
        for (int b = 0; b < 2; ++b)
#pragma unroll
            for (int m = 0; m < 4; ++m)
#pragma unroll
                for (int n = 0; n < 2; ++n) acc[a][b][m][n] = (f32x4){0.f, 0.f, 0.f, 0.f};
    bf16x8 At[4][2], B0[2][2], B1[2][2];
    const char* cA = cur.a; const char* cB = cur.b;
    PG8_STAGE(PG8_SB(0, 0), cB, voffB); PG8_STAGE(PG8_SB(0, 1), cB + hstepB, voffB); PG8_STAGE(PG8_SA(0, 0), cA, voffA); PG8_STAGE(PG8_SA(0, 1), cA + hstepA, voffA);
    if (wr == 1) PG8_BAR;
    PG8_WAIT_V(2); PG8_BAR;
    PG8_STAGE(PG8_SB(1, 0), cB + kstep, voffB); PG8_STAGE(PG8_SA(1, 0), cA + kstep, voffA); PG8_STAGE(PG8_SB(1, 1), cB + hstepB + kstep, voffB);
    PG8_WAIT_V(6); PG8_BAR;
    for (;;) {
        const bool has_next = S.next(ui + 1, nxt);
        const char* nA = has_next ? nxt.a : cA; const char* nB = has_next ? nxt.b : cB;
        for (int t = 0; t < nt; t += 2) {
            const bool last = (t == nt - 2);
            const char* a1 = cA + (size_t)(t + 1) * kstep;
            const char* a2 = last ? nA : cA + (size_t)(t + 2) * kstep; const char* b2 = last ? nB : cB + (size_t)(t + 2) * kstep;
            const char* a3 = a2 + kstep; const char* b3 = b2 + kstep;
            PG8_LDB(B0, 0, 0); PG8_LDB(B1, 0, 1); PG8_SCHED; PG8_LDA(At, 0, 0); PG8_STAGE(PG8_SA(1, 1), a1 + hstepA, voffA);
            PG8_WAIT_V(8); PG8_WAIT_L(0); PG8_BAR; PG8_MMA(0, 0, At, B0); PG8_MMA(0, 1, At, B1); PG8_BAR; PG8_SCHED;
            PG8_LDA(At, 0, 1); PG8_STAGE(PG8_SB(0, 0), b2, voffB); PG8_STAGE(PG8_SB(0, 1), b2 + hstepB, voffB); PG8_STAGE(PG8_SA(0, 0), a2, voffA);
            PG8_WAIT_V(8); PG8_WAIT_L(0); PG8_BAR; PG8_MMA(1, 0, At, B0); PG8_MMA(1, 1, At, B1); PG8_BAR; PG8_SCHED;
            PG8_LDB(B0, 1, 0); PG8_LDB(B1, 1, 1); PG8_SCHED; PG8_LDA(At, 1, 0); PG8_STAGE(PG8_SA(0, 1), a2 + hstepA, voffA);
            PG8_WAIT_V(8); PG8_WAIT_L(0); PG8_BAR; PG8_MMA(0, 0, At, B0); PG8_MMA(0, 1, At, B1); PG8_BAR; PG8_SCHED;
            PG8_LDA(At, 1, 1); PG8_STAGE(PG8_SB(1, 0), b3, voffB); PG8_STAGE(PG8_SB(1, 1), b3 + hstepB, voffB); PG8_STAGE(PG8_SA(1, 0), a3, voffA);
            PG8_WAIT_V(8); PG8_WAIT_L(0); PG8_BAR; PG8_MMA(1, 0, At, B0); PG8_MMA(1, 1, At, B1); PG8_BAR; PG8_SCHED;
        }
        if constexpr (ALIGN_EPI) { if (wr == 0) PG8_BAR; }
        if constexpr (!Epi::AFTER_DRAIN) { E(acc, cur, wr, wc, fr, fq); }
        if (!has_next) break;
#pragma unroll
        for (int a = 0; a < 2; ++a)
#pragma unroll
            for (int b = 0; b < 2; ++b)
#pragma unroll
                for (int m = 0; m < 4; ++m)
#pragma unroll
                    for (int n = 0; n < 2; ++n) acc[a][b][m][n] = (f32x4){0.f, 0.f, 0.f, 0.f};
        cur = nxt; cA = nA; cB = nB; ++ui;
        if constexpr (ALIGN_EPI) { if (wr == 1) PG8_BAR; }
    }
    PG8_WAIT_V(0);
    if constexpr (!ALIGN_EPI) { if (wr == 0) PG8_BAR; }
    PG8_BAR;
    if constexpr (Epi::AFTER_DRAIN) { E.fused(acc, cur, wr, wc, fr, fq, lds, wid, lane); }
#undef PG8_SA
#undef PG8_SB
#undef PG8_STAGE
#undef PG8_LDA
#undef PG8_LDB
#undef PG8_MMA
#undef PG8_WAIT_V
#undef PG8_WAIT_L
#undef PG8_BAR
#undef PG8_SCHED
}

typedef f32x4 AccT[2][2][4][2];

struct EpiBf16 {
    static constexpr bool PERM = true, AFTER_DRAIN = false;
    bf16_t* O; int ldc;
    __device__ __forceinline__ void operator()(const AccT& acc, const Unit& u, int wr, int wc, int fr, int fq) const {
        { int t_ = threadIdx.x; asm volatile("" : "+v"(t_)); fr = t_ & 15; fq = (t_ >> 4) & 3; }
        const int row0 = u.pm * BM + wr * 64 + fr, col0 = u.pn * BM + wc * 32 + 8 * fq;
#pragma unroll
        for (int ai = 0; ai < 2; ++ai)
#pragma unroll
            for (int m = 0; m < 4; ++m) { bf16_t* rowp = O + (size_t)(row0 + ai * HALF + m * 16) * ldc + col0;
#pragma unroll
                for (int bj = 0; bj < 2; ++bj) { const f32x4 v0 = acc[ai][bj][m][0], v1 = acc[ai][bj][m][1];
                    u32x4 w; w.x = cvt_pk_bf16(v0[0], v0[1]); w.y = cvt_pk_bf16(v0[2], v0[3]); w.z = cvt_pk_bf16(v1[0], v1[1]); w.w = cvt_pk_bf16(v1[2], v1[3]);
                    *(u32x4*)(rowp + bj * HALF) = w; } }
    }
};
struct EpiF16 {
    static constexpr bool PERM = true, AFTER_DRAIN = false;
    _Float16* O; int ldc;
    __device__ __forceinline__ void operator()(const AccT& acc, const Unit& u, int wr, int wc, int fr, int fq) const {
        { int t_ = threadIdx.x; asm volatile("" : "+v"(t_)); fr = t_ & 15; fq = (t_ >> 4) & 3; }
        typedef _Float16 h8 __attribute__((ext_vector_type(8)));
        const int row0 = u.pm * BM + wr * 64 + fr, col0 = u.pn * BM + wc * 32 + 8 * fq;
#pragma unroll
        for (int ai = 0; ai < 2; ++ai)
#pragma unroll
            for (int m = 0; m < 4; ++m) { _Float16* rowp = O + (size_t)(row0 + ai * HALF + m * 16) * ldc + col0;
#pragma unroll
                for (int bj = 0; bj < 2; ++bj) { const f32x4 v0 = acc[ai][bj][m][0], v1 = acc[ai][bj][m][1];
                    h8 w = {(_Float16)v0[0], (_Float16)v0[1], (_Float16)v0[2], (_Float16)v0[3], (_Float16)v1[0], (_Float16)v1[1], (_Float16)v1[2], (_Float16)v1[3]};
                    *(h8*)(rowp + bj * HALF) = w; } }
    }
};
struct EpiGateMul {
    static constexpr bool PERM = true, AFTER_DRAIN = false;
    const bf16_t* G; bf16_t* Dst; int ldc;
    __device__ __forceinline__ void operator()(const AccT& acc, const Unit& u, int wr, int wc, int fr, int fq) const {
        { int t_ = threadIdx.x; asm volatile("" : "+v"(t_)); fr = t_ & 15; fq = (t_ >> 4) & 3; }
        const int row0 = u.pm * BM + wr * 64 + fr, col0 = u.pn * BM + wc * 32 + 8 * fq;
#pragma unroll
        for (int ai = 0; ai < 2; ++ai)
#pragma unroll
            for (int m = 0; m < 4; ++m) { const size_t roff = (size_t)(row0 + ai * HALF + m * 16) * ldc + col0; const bf16_t* rowg = G + roff; bf16_t* rowp = Dst + roff;
#pragma unroll
                for (int bj = 0; bj < 2; ++bj) { const f32x4 v0 = acc[ai][bj][m][0], v1 = acc[ai][bj][m][1]; const u32x4 gq = *(const u32x4*)(rowg + bj * HALF);
                    u32x4 w; w.x = cvt_pk_bf16(v0[0] * bf_lo(gq.x), v0[1] * bf_hi(gq.x)); w.y = cvt_pk_bf16(v0[2] * bf_lo(gq.y), v0[3] * bf_hi(gq.y));
                    w.z = cvt_pk_bf16(v1[0] * bf_lo(gq.z), v1[1] * bf_hi(gq.z)); w.w = cvt_pk_bf16(v1[2] * bf_lo(gq.w), v1[3] * bf_hi(gq.w));
                    *(u32x4*)(rowp + bj * HALF) = w; } }
    }
};
struct EpiGateFma {
    static constexpr bool PERM = true, AFTER_DRAIN = false;
    const bf16_t* Tm; const bf16_t* G2; bf16_t* Dst; int ldc;
    __device__ __forceinline__ void operator()(const AccT& acc, const Unit& u, int wr, int wc, int fr, int fq) const {
        { int t_ = threadIdx.x; asm volatile("" : "+v"(t_)); fr = t_ & 15; fq = (t_ >> 4) & 3; }
        const int row0 = u.pm * BM + wr * 64 + fr, col0 = u.pn * BM + wc * 32 + 8 * fq;
#pragma unroll
        for (int ai = 0; ai < 2; ++ai)
#pragma unroll
            for (int m = 0; m < 4; ++m) { const size_t off = (size_t)(row0 + ai * HALF + m * 16) * ldc + col0;
#pragma unroll
                for (int bj = 0; bj < 2; ++bj) { const f32x4 v0 = acc[ai][bj][m][0], v1 = acc[ai][bj][m][1]; const u32x4 gq = *(const u32x4*)(G2 + off + bj * HALF); const u32x4 tq = *(const u32x4*)(Tm + off + bj * HALF);
                    u32x4 w; w.x = cvt_pk_bf16(bf_lo(tq.x) + v0[0] * bf_lo(gq.x), bf_hi(tq.x) + v0[1] * bf_hi(gq.x)); w.y = cvt_pk_bf16(bf_lo(tq.y) + v0[2] * bf_lo(gq.y), bf_hi(tq.y) + v0[3] * bf_hi(gq.y));
                    w.z = cvt_pk_bf16(bf_lo(tq.z) + v1[0] * bf_lo(gq.z), bf_hi(tq.z) + v1[1] * bf_hi(gq.z)); w.w = cvt_pk_bf16(bf_lo(tq.w) + v1[2] * bf_lo(gq.w), bf_hi(tq.w) + v1[3] * bf_hi(gq.w));
                    *(u32x4*)(Dst + off + bj * HALF) = w; } }
    }
};
struct EpiResF32 {
    static constexpr bool PERM = false, AFTER_DRAIN = false;
    const float* res; float* out; int ldc; float mul;
    __device__ __forceinline__ void operator()(const AccT& acc, const Unit& u, int wr, int wc, int fr, int fq) const {
        { int t_ = threadIdx.x; asm volatile("" : "+v"(t_)); fr = t_ & 15; fq = (t_ >> 4) & 3; }
        const int row0 = u.pm * BM + wr * 64 + fr, col0 = u.pn * BM + wc * 32 + 4 * fq;
#pragma unroll
        for (int ai = 0; ai < 2; ++ai)
#pragma unroll
            for (int m = 0; m < 4; ++m) { const size_t off = (size_t)(row0 + ai * HALF + m * 16) * ldc + col0;
#pragma unroll
                for (int bj = 0; bj < 2; ++bj)
#pragma unroll
                    for (int n = 0; n < 2; ++n) { const f32x4 r = *(const f32x4*)(res + off + bj * HALF + n * 16); *(f32x4*)(out + off + bj * HALF + n * 16) = r + acc[ai][bj][m][n] * mul; } }
    }
};

__device__ __forceinline__ float row_rs(const float* ssq, int row) {
    const f32x4* p = (const f32x4*)(ssq + (size_t)row * 16); const f32x4 a = p[0], b = p[1], c = p[2], d = p[3];
    const float s = ((a[0] + a[1]) + (a[2] + a[3])) + ((b[0] + b[1]) + (b[2] + b[3])) + ((c[0] + c[1]) + (c[2] + c[3])) + ((d[0] + d[1]) + (d[2] + d[3]));
    return rsqrtf(s * (1.f / 1024.f) + 1e-6f);
}
struct EpiBf16RS {
    static constexpr bool PERM = true, AFTER_DRAIN = false;
    bf16_t* O; int ldc; const float* ssq;
    __device__ __forceinline__ void operator()(const AccT& acc, const Unit& u, int wr, int wc, int fr, int fq) const {
        { int t_ = threadIdx.x; asm volatile("" : "+v"(t_)); fr = t_ & 15; fq = (t_ >> 4) & 3; }
        const int row0 = u.pm * BM + wr * 64 + fr, col0 = u.pn * BM + wc * 32 + 8 * fq;
#pragma unroll
        for (int ai = 0; ai < 2; ++ai)
#pragma unroll
            for (int m = 0; m < 4; ++m) { int ro = row0 + ai * HALF + m * 16; asm volatile("" : "+v"(ro)); const float rs = row_rs(ssq, ro); bf16_t* rowp = O + (size_t)ro * ldc + col0;
#pragma unroll
                for (int bj = 0; bj < 2; ++bj) { const f32x4 v0 = acc[ai][bj][m][0] * rs, v1 = acc[ai][bj][m][1] * rs;
                    u32x4 w; w.x = cvt_pk_bf16(v0[0], v0[1]); w.y = cvt_pk_bf16(v0[2], v0[3]); w.z = cvt_pk_bf16(v1[0], v1[1]); w.w = cvt_pk_bf16(v1[2], v1[3]);
                    *(u32x4*)(rowp + bj * HALF) = w; } }
    }
};
struct EpiF16RS {
    static constexpr bool PERM = true, AFTER_DRAIN = false;
    _Float16* O; int ldc; const float* ssq;
    __device__ __forceinline__ void operator()(const AccT& acc, const Unit& u, int wr, int wc, int fr, int fq) const {
        { int t_ = threadIdx.x; asm volatile("" : "+v"(t_)); fr = t_ & 15; fq = (t_ >> 4) & 3; }
        typedef _Float16 h8 __attribute__((ext_vector_type(8)));
        const int row0 = u.pm * BM + wr * 64 + fr, col0 = u.pn * BM + wc * 32 + 8 * fq;
#pragma unroll
        for (int ai = 0; ai < 2; ++ai)
#pragma unroll
            for (int m = 0; m < 4; ++m) { int ro = row0 + ai * HALF + m * 16; asm volatile("" : "+v"(ro)); const float rs = row_rs(ssq, ro); _Float16* rowp = O + (size_t)ro * ldc + col0;
#pragma unroll
                for (int bj = 0; bj < 2; ++bj) { const f32x4 v0 = acc[ai][bj][m][0] * rs, v1 = acc[ai][bj][m][1] * rs;
                    h8 w = {(_Float16)v0[0], (_Float16)v0[1], (_Float16)v0[2], (_Float16)v0[3], (_Float16)v1[0], (_Float16)v1[1], (_Float16)v1[2], (_Float16)v1[3]};
                    *(h8*)(rowp + bj * HALF) = w; } }
    }
};
template <bool RES_F32> struct EpiResNorm {
    static constexpr bool PERM = true, AFTER_DRAIN = false;
    const float* resf; bf16_t* H; float* ssq; int ldc; float mul;
    __device__ __forceinline__ void operator()(const AccT& acc, const Unit& u, int wr, int wc, int fr, int fq) const {
        { int t_ = threadIdx.x; asm volatile("" : "+v"(t_)); fr = t_ & 15; fq = (t_ >> 4) & 3; }
        const int row0 = u.pm * BM + wr * 64 + fr, col0 = u.pn * BM + wc * 32 + 8 * fq;
#pragma unroll
        for (int ai = 0; ai < 2; ++ai)
#pragma unroll
            for (int m = 0; m < 4; ++m) { int ro = row0 + ai * HALF + m * 16; asm volatile("" : "+v"(ro)); const size_t off = (size_t)ro * ldc + col0; float ss = 0.f;
#pragma unroll
                for (int bj = 0; bj < 2; ++bj) { f32x4 r0, r1;
                    if (RES_F32) { r0 = *(const f32x4*)(resf + off + bj * HALF); r1 = *(const f32x4*)(resf + off + bj * HALF + 4); }
                    else { const u32x4 q = *(const u32x4*)(H + off + bj * HALF); r0 = (f32x4){bf_lo(q.x), bf_hi(q.x), bf_lo(q.y), bf_hi(q.y)}; r1 = (f32x4){bf_lo(q.z), bf_hi(q.z), bf_lo(q.w), bf_hi(q.w)}; }
                    const f32x4 v0 = r0 + acc[ai][bj][m][0] * mul, v1 = r1 + acc[ai][bj][m][1] * mul;
                    ss += ((v0[0] * v0[0] + v0[1] * v0[1]) + (v0[2] * v0[2] + v0[3] * v0[3])) + ((v1[0] * v1[0] + v1[1] * v1[1]) + (v1[2] * v1[2] + v1[3] * v1[3]));
                    u32x4 w; w.x = cvt_pk_bf16(v0[0], v0[1]); w.y = cvt_pk_bf16(v0[2], v0[3]); w.z = cvt_pk_bf16(v1[0], v1[1]); w.w = cvt_pk_bf16(v1[2], v1[3]);
                    *(u32x4*)(H + off + bj * HALF) = w; }
                ss += shx<16>(ss); ss = sum32(ss);
                if (fq == 0) ssq[(size_t)ro * 16 + u.pn * 4 + wc] = ss; }
    }
};
struct EpiIn {
    static constexpr bool PERM = true, AFTER_DRAIN = false;
    bf16_t *U, *Bb, *Q, *Kb, *V, *SGC, *SGA; const float* ropec; const float* ropes; float* kbar; float qscale;
    __device__ __forceinline__ void operator()(const AccT& acc, const Unit& u, int wr, int wc, int fr, int fq) const {
        { int t_ = threadIdx.x; asm volatile("" : "+v"(t_)); fr = t_ & 15; fq = (t_ >> 4) & 3; }
        const int pn = u.pn; const int row0 = u.pm * BM + wr * 64 + fr;
        if (pn < 4) {
            const int c0 = 128 * pn + 16 * wc + 4 * fq;
#pragma unroll
            for (int ai = 0; ai < 2; ++ai)
#pragma unroll
                for (int m = 0; m < 4; ++m) { int ro = row0 + ai * HALF + m * 16; asm volatile("" : "+v"(ro)); bf16_t* rowp = U + (size_t)ro * 512 + c0;
#pragma unroll
                    for (int bj = 0; bj < 2; ++bj) { const f32x4 x = acc[ai][bj][m][0] * acc[ai][bj][m][1]; u32x2 w; w.x = cvt_pk_bf16(x[0], x[1]); w.y = cvt_pk_bf16(x[2], x[3]); *(u32x2*)(rowp + bj * 64) = w; } }
        } else if (pn < 6 || (pn >= 10 && pn < 12)) {
            bf16_t* O = pn < 6 ? Bb : V; const int col0 = (pn < 6 ? pn - 4 : pn - 10) * BM + wc * 32 + 8 * fq;
#pragma unroll
            for (int ai = 0; ai < 2; ++ai)
#pragma unroll
                for (int m = 0; m < 4; ++m) { int ro = row0 + ai * HALF + m * 16; asm volatile("" : "+v"(ro)); bf16_t* rowp = O + (size_t)ro * 512 + col0;
#pragma unroll
                    for (int bj = 0; bj < 2; ++bj) { const f32x4 v0 = acc[ai][bj][m][0], v1 = acc[ai][bj][m][1];
                        u32x4 w; w.x = cvt_pk_bf16(v0[0], v0[1]); w.y = cvt_pk_bf16(v0[2], v0[3]); w.z = cvt_pk_bf16(v1[0], v1[1]); w.w = cvt_pk_bf16(v1[2], v1[3]);
                        *(u32x4*)(rowp + bj * HALF) = w; } }
        } else if (pn < 10) {
            const bool isk = pn >= 8; bf16_t* O = isk ? Kb : Q; const int colt = (isk ? pn - 8 : pn - 6) * BM + wc * 32 + 8 * fq;
            const int g4 = 4 * (4 * (wc & 1) + fq);
            const float sc = isk ? 1.f : qscale;
            f32x4 cs0[2] = {(f32x4){0.f, 0.f, 0.f, 0.f}, (f32x4){0.f, 0.f, 0.f, 0.f}}, cs1[2] = {(f32x4){0.f, 0.f, 0.f, 0.f}, (f32x4){0.f, 0.f, 0.f, 0.f}};
#pragma unroll
            for (int ai = 0; ai < 2; ++ai)
#pragma unroll
                for (int m = 0; m < 4; ++m) { int row = row0 + ai * HALF + m * 16; asm volatile("" : "+v"(row)); const int pos = row & 2047;
                    const f32x4 c = *(const f32x4*)(ropec + pos * 32 + g4) * sc, s = *(const f32x4*)(ropes + pos * 32 + g4) * sc;
                    bf16_t* rowp = O + (size_t)row * 512 + colt;
#pragma unroll
                    for (int bj = 0; bj < 2; ++bj) { const f32x4 x1 = acc[ai][bj][m][0], x2 = acc[ai][bj][m][1]; const f32x4 o1 = x1 * c - x2 * s, o2 = x2 * c + x1 * s;
                        cs0[bj] += o1; cs1[bj] += o2;
                        u32x4 w; w.x = cvt_pk_bf16(o1[0], o1[1]); w.y = cvt_pk_bf16(o1[2], o1[3]); w.z = cvt_pk_bf16(o2[0], o2[1]); w.w = cvt_pk_bf16(o2[2], o2[3]);
                        *(u32x4*)(rowp + bj * HALF) = w; }
                    asm volatile("" : "+v"(cs0[0]), "+v"(cs0[1]), "+v"(cs1[0]), "+v"(cs1[1]) :: "memory"); }
            if (isk) {
#pragma unroll
                for (int bj = 0; bj < 2; ++bj)
#pragma unroll
                    for (int j = 0; j < 4; ++j) { float a = cs0[bj][j], b = cs1[bj][j];
                        a += shx<1>(a); b += shx<1>(b); a += shx<2>(a); b += shx<2>(b); a += shx<4>(a); b += shx<4>(b); a += shx<8>(a); b += shx<8>(b);
                        if (fr == 0) { const int pc = (pn - 8) * BM + bj * HALF + wc * 32 + 8 * fq;
                            float* kb = kbar + (size_t)u.pm * 512 + pc; atomicAdd(kb + j, a); atomicAdd(kb + 4 + j, b); } }
            }
        } else {
            bf16_t* O = pn < 16 ? SGC : SGA; const int col0 = (pn < 16 ? pn - 12 : pn - 16) * BM + wc * 32 + 8 * fq;
#pragma unroll
            for (int ai = 0; ai < 2; ++ai)
#pragma unroll
                for (int m = 0; m < 4; ++m) { int ro = row0 + ai * HALF + m * 16; asm volatile("" : "+v"(ro)); bf16_t* rowp = O + (size_t)ro * 1024 + col0;
#pragma unroll
                    for (int bj = 0; bj < 2; ++bj) { f32x4 v0 = acc[ai][bj][m][0], v1 = acc[ai][bj][m][1];
#pragma unroll
                        for (int j = 0; j < 4; ++j) { v0[j] = __builtin_amdgcn_rcpf(1.f + __expf(-v0[j])); v1[j] = __builtin_amdgcn_rcpf(1.f + __expf(-v1[j])); }
                        u32x4 w; w.x = cvt_pk_bf16(v0[0], v0[1]); w.y = cvt_pk_bf16(v0[2], v0[3]); w.z = cvt_pk_bf16(v1[0], v1[1]); w.w = cvt_pk_bf16(v1[2], v1[3]);
                        *(u32x4*)(rowp + bj * HALF) = w; }
                    asm volatile("" ::: "memory"); }
        }
    }
};
struct EpiSoftmax {
    static constexpr bool PERM = true, AFTER_DRAIN = true;
    bf16_t* O; int ldc; float scale_log2;
    __device__ __forceinline__ void fused(AccT& acc, const Unit& u, int wr, int wc, int fr, int fq, PG8_LAS unsigned char* lds, int wid, int lane) const {
        { int t_ = threadIdx.x; asm volatile("" : "+v"(t_)); fr = t_ & 15; fq = (t_ >> 4) & 3; }
        PG8_LAS f32x2* X = (PG8_LAS f32x2*)lds;
        float mx[2][4];
#pragma unroll
        for (int ai = 0; ai < 2; ++ai)
#pragma unroll
            for (int m = 0; m < 4; ++m) { float a = -3.0e38f;
#pragma unroll
                for (int bj = 0; bj < 2; ++bj)
#pragma unroll
                    for (int n = 0; n < 2; ++n) { acc[ai][bj][m][n] = acc[ai][bj][m][n] * scale_log2; const f32x4 x = acc[ai][bj][m][n]; a = fmaxf(fmaxf(a, fmaxf(x[0], x[1])), fmaxf(x[2], x[3])); }
                a = fmaxf(a, shx<16>(a)); a = max32(a); mx[ai][m] = a;
                float s = 0.f;
#pragma unroll
                for (int bj = 0; bj < 2; ++bj)
#pragma unroll
                    for (int n = 0; n < 2; ++n) { f32x4 x = acc[ai][bj][m][n];
#pragma unroll
                        for (int j = 0; j < 4; ++j) { x[j] = __builtin_amdgcn_exp2f(x[j] - a); s += x[j]; }
                        acc[ai][bj][m][n] = x; }
                s += shx<16>(s); s = sum32(s);
                if (fq == 0) X[(ai * HALF + wr * 64 + m * 16 + fr) * 4 + wc] = (f32x2){a, s};
            }
        asm volatile("s_waitcnt lgkmcnt(0)" ::: "memory"); __builtin_amdgcn_s_barrier(); asm volatile("" ::: "memory");
        const int row0 = u.pm * BM + wr * 64 + fr, col0 = u.pn * BM + wc * 32 + 8 * fq;
#pragma unroll
        for (int ai = 0; ai < 2; ++ai)
#pragma unroll
            for (int m = 0; m < 4; ++m) { const int r = ai * HALF + wr * 64 + m * 16 + fr;
                const f32x2 e0 = X[r * 4 + 0], e1 = X[r * 4 + 1], e2 = X[r * 4 + 2], e3 = X[r * 4 + 3];
                const float M = fmaxf(fmaxf(e0.x, e1.x), fmaxf(e2.x, e3.x));
                const float L = e0.y * __builtin_amdgcn_exp2f(e0.x - M) + e1.y * __builtin_amdgcn_exp2f(e1.x - M) + e2.y * __builtin_amdgcn_exp2f(e2.x - M) + e3.y * __builtin_amdgcn_exp2f(e3.x - M);
                const float f = __builtin_amdgcn_exp2f(mx[ai][m] - M) * __builtin_amdgcn_rcpf(L);
                bf16_t* rowp = O + (size_t)(row0 + ai * HALF + m * 16) * ldc + col0;
#pragma unroll
                for (int bj = 0; bj < 2; ++bj) { const f32x4 v0 = acc[ai][bj][m][0] * f, v1 = acc[ai][bj][m][1] * f;
                    u32x4 w; w.x = cvt_pk_bf16(v0[0], v0[1]); w.y = cvt_pk_bf16(v0[2], v0[3]); w.z = cvt_pk_bf16(v1[0], v1[1]); w.w = cvt_pk_bf16(v1[2], v1[3]);
                    *(u32x4*)(rowp + bj * HALF) = w; } }
        asm volatile("s_waitcnt lgkmcnt(0)" ::: "memory"); __builtin_amdgcn_s_barrier(); asm volatile("" ::: "memory");
    }
};
}
namespace attn_body {
using bf16=__hip_bfloat16;
using bf16x8=__attribute__((ext_vector_type(8)))short;
using s16x4=__attribute__((ext_vector_type(4)))short;
using f32x16=__attribute__((ext_vector_type(16)))float;
using u32x4=__attribute__((ext_vector_type(4)))unsigned;
constexpr int BATCH=16,NHEAD=8,SEQ=2048,D=64,DM=NHEAD*D;
constexpr int NW=8,QBLK=32,QB=QBLK*NW,KVBLK=64,NQB=SEQ/QB;
constexpr int ATTN_PITCH=DM, ATTN_UNIT_ROWS=QB;
__device__ __forceinline__ int crow(int r,int hi){return (r&3)+8*(r>>2)+4*hi;}
#define SBAR() __builtin_amdgcn_sched_barrier(0)
__device__ __forceinline__ void cmask(f32x16&p0,f32x16&p1,int jb,int qrel,int hi){
  const float NEG=-INFINITY; int kb=64*jb+4*hi;
  #pragma unroll
  for(int r=0;r<16;++r){int kv=kb+(r&3)+8*(r>>2); if(kv>qrel)p0[r]=NEG; if(kv+32>qrel)p1[r]=NEG;}
}

constexpr int NSLOT=3, SLOTB=8192;
constexpr int LDS_K=0, LDS_V=NSLOT*SLOTB, LDS_WS=2*NSLOT*SLOTB, LDS_OST=LDS_WS+NW*64*4, LDS_SEL=LDS_OST+NW*4096, LDS_BYTES=LDS_SEL+NW*64*4;
constexpr float C2=0.125f*1.4426950408889634f;
__device__ __forceinline__ void glds16(const void*gsrc,unsigned lds_dst){unsigned keep;
  asm volatile("s_mov_b32 %0, m0\n\ts_mov_b32 m0, %2\n\ts_nop 0\n\tglobal_load_lds_dwordx4 %1, off\n\ts_mov_b32 m0, %0":"=&s"(keep):"v"(gsrc),"s"(lds_dst):"memory");}
__device__ __forceinline__ float max3f(float a,float b,float c){float r;asm("v_max3_f32 %0, %1, %2, %3":"=v"(r):"v"(a),"v"(b),"v"(c));return r;}
__device__ __forceinline__ float max2f(float a,float b){float r;asm("v_max_f32_e32 %0, %1, %2":"=v"(r):"v"(a),"v"(b));return r;}
__device__ __forceinline__ float fadd_s(float a,float b){float r;asm("v_add_f32_e32 %0, %1, %2":"=v"(r):"v"(a),"v"(b));return r;}
__device__ __forceinline__ float fsub_s(float a,float b){float r;asm("v_sub_f32_e32 %0, %1, %2":"=v"(r):"v"(a),"v"(b));return r;}
typedef float f32x2_t __attribute__((ext_vector_type(2))); typedef __bf16 bf16x2_t __attribute__((ext_vector_type(2)));
__device__ __forceinline__ unsigned cvtpk_s(float lo,float hi){f32x2_t v={lo,hi};bf16x2_t b=__builtin_convertvector(v,bf16x2_t);return __builtin_bit_cast(unsigned,b);}
#define WAIT_BAR(N) asm volatile("s_waitcnt vmcnt(" #N ") lgkmcnt(0)\n\ts_barrier":::"memory")

__device__ __forceinline__ void qkt(f32x16&p0,f32x16&p1,const char*Kslot,const bf16x8*qr,const f32x16&negm,int r32,int hi){
  const char*kb=Kslot+hi*1024+r32*16;
  #pragma unroll
  for(int d0=0;d0<4;++d0){
    const bf16x8 b0=*reinterpret_cast<const bf16x8*>(kb+d0*2048);
    const bf16x8 b1=*reinterpret_cast<const bf16x8*>(kb+d0*2048+512);
    if(d0==0){p0=__builtin_amdgcn_mfma_f32_32x32x16_bf16(b0,qr[0],negm,0,0,0);p1=__builtin_amdgcn_mfma_f32_32x32x16_bf16(b1,qr[0],negm,0,0,0);}
    else{p0=__builtin_amdgcn_mfma_f32_32x32x16_bf16(b0,qr[d0],p0,0,0,0);p1=__builtin_amdgcn_mfma_f32_32x32x16_bf16(b1,qr[d0],p1,0,0,0);}}
}
typedef __attribute__((address_space(3))) const char* lds_cptr;
typedef short v4i16_t __attribute__((ext_vector_type(4)));
__device__ __forceinline__ void kload8(bf16x8*kf,lds_cptr kp){
  kf[0]=*(const __attribute__((address_space(3))) bf16x8*)(kp);      kf[1]=*(const __attribute__((address_space(3))) bf16x8*)(kp+512);
  kf[2]=*(const __attribute__((address_space(3))) bf16x8*)(kp+2048); kf[3]=*(const __attribute__((address_space(3))) bf16x8*)(kp+2560);
  kf[4]=*(const __attribute__((address_space(3))) bf16x8*)(kp+4096); kf[5]=*(const __attribute__((address_space(3))) bf16x8*)(kp+4608);
  kf[6]=*(const __attribute__((address_space(3))) bf16x8*)(kp+6144); kf[7]=*(const __attribute__((address_space(3))) bf16x8*)(kp+6656);
}
__device__ __forceinline__ void kload2(bf16x8*kf,lds_cptr kp,int j){ kf[2*j]=*(const __attribute__((address_space(3))) bf16x8*)(kp+j*2048); kf[2*j+1]=*(const __attribute__((address_space(3))) bf16x8*)(kp+j*2048+512); }
__device__ __forceinline__ s16x4 vtr(lds_cptr p){ return __builtin_bit_cast(s16x4,__builtin_amdgcn_ds_read_tr16_b64_v4i16((__attribute__((address_space(3))) v4i16_t*)p)); }
__device__ __forceinline__ float rowmax(const f32x16&p0,const f32x16&p1){
  float a=max3f(p0[0],p0[1],p1[0]),b=max3f(p0[2],p0[3],p1[1]);a=max3f(a,p1[2],p1[3]);
  #pragma unroll
  for(int r=4;r<16;r+=4){a=max3f(a,p0[r],p0[r+1]);b=max3f(b,p0[r+2],p0[r+3]);a=max3f(a,p1[r],p1[r+1]);b=max3f(b,p1[r+2],p1[r+3]);}
  const float m=max2f(a,b);
  auto rr=__builtin_amdgcn_permlane32_swap(__float_as_uint(m),__float_as_uint(m),false,false);
  return max2f(__uint_as_float(rr[0]),__uint_as_float(rr[1]));
}
__device__ __forceinline__ void pv(f32x16*o,int vb,bf16x8 pa0,bf16x8 pa1,bf16x8 pa2,bf16x8 pa3){
  #pragma unroll
  for(int d0=0;d0<2;++d0){s16x4 lo[4],hi[4];
    #pragma unroll
    for(int ks=0;ks<4;++ks){
      asm volatile("ds_read_b64_tr_b16 %0,%1 offset:%c2":"=&v"(lo[ks]):"v"(vb),"i"(d0*4096+ks*1024):"memory");
      asm volatile("ds_read_b64_tr_b16 %0,%1 offset:%c2":"=&v"(hi[ks]):"v"(vb),"i"(d0*4096+ks*1024+512):"memory");}
    asm volatile("s_waitcnt lgkmcnt(0)":::"memory");SBAR();
    #define PK(k) (bf16x8){lo[k][0],lo[k][1],lo[k][2],lo[k][3],hi[k][0],hi[k][1],hi[k][2],hi[k][3]}
    o[d0]=__builtin_amdgcn_mfma_f32_32x32x16_bf16(pa0,PK(0),o[d0],0,0,0);
    o[d0]=__builtin_amdgcn_mfma_f32_32x32x16_bf16(pa1,PK(1),o[d0],0,0,0);
    o[d0]=__builtin_amdgcn_mfma_f32_32x32x16_bf16(pa2,PK(2),o[d0],0,0,0);
    o[d0]=__builtin_amdgcn_mfma_f32_32x32x16_bf16(pa3,PK(3),o[d0],0,0,0);
    #undef PK
  }
}

#ifndef ATTN_STORE16
#define ATTN_STORE16(p,v) (*(u32x4*)(p)=(v))
#endif
template<int THRL> __device__ __forceinline__ void attn_unit(int b,int h,int qb,const bf16*Q,const bf16*__restrict__ K,const bf16*__restrict__ V,bf16*O,const float*__restrict__ kbar,char*shm){
  int tid=threadIdx.x; asm volatile("":"+v"(tid)); const int lane=tid&63,r32=lane&31,hi=lane>>5; const int wid=__builtin_amdgcn_readfirstlane(tid>>6);
  const long rowbase=(long)b*SEQ; const int q0=qb*QB;
  const bf16*Qw=Q+(rowbase+q0+wid*QBLK)*DM+h*D;
  const bf16*Kh=K+rowbase*DM+h*D,*Vh=V+rowbase*DM+h*D;
  const unsigned lds0=(unsigned)(uintptr_t)shm;
  float*wsf=(float*)(shm+LDS_WS)+wid*64;
  const bf16*ksrc=Kh+(long)lane*DM+wid*8;
  const bf16*vsrc=Vh+(long)(16*(wid&3)+(lane>>2))*DM+(wid>>2)*32+(lane&3)*8;
  const unsigned kdst=lds0+LDS_K+wid*1024, vdst=lds0+LDS_V+wid*1024;
  #define DMA_K(t,slot) glds16(ksrc+(long)(t)*KVBLK*DM,(unsigned)__builtin_amdgcn_readfirstlane(kdst+(slot)))
  #define DMA_V(t,slot) glds16(vsrc+(long)(t)*KVBLK*DM,(unsigned)__builtin_amdgcn_readfirstlane(vdst+(slot)))
  const int vb0=(int)(lds0+LDS_V)+((lane>>4)&1)*32+(lane&3)*8+(4*hi+((lane&15)>>2))*64;
  const char*Kbase=shm+LDS_K; bf16x8 kf[8];
  const lds_cptr shm3=(lds_cptr)shm; const lds_cptr kp0=shm3+LDS_K+hi*1024+r32*16; const lds_cptr vp0=shm3+LDS_V+((lane>>4)&1)*32+(lane&3)*8+(4*hi+((lane&15)>>2))*64;
  const int NT=(q0+QB)/KVBLK;
  DMA_K(0,0);DMA_V(0,0);DMA_K(1,SLOTB);
  bf16x8 qr[4];
  #pragma unroll
  for(int d0=0;d0<4;++d0)qr[d0]=*reinterpret_cast<const bf16x8*>(&Qw[(long)r32*DM+d0*16+hi*8]);
  int selm=0;
  if(qb>0){
    float g[7]; int hi8=8*hi; asm volatile("":"+v"(hi8)); const float*kb=kbar+(size_t)(b*8)*512+h*64+hi8;
    #pragma unroll
    for(int n=0;n<7;++n){ float a=0.f;
      if(n<qb){
        #pragma unroll
        for(int d0=0;d0<4;++d0){ const float4 k0=*(const float4*)(kb+n*512+16*d0),k1=*(const float4*)(kb+n*512+16*d0+4); const bf16x8 qq=qr[d0];
          #define QF(e) __uint_as_float(((unsigned)(unsigned short)qq[e])<<16)
          a+=QF(0)*k0.x+QF(1)*k0.y+QF(2)*k0.z+QF(3)*k0.w+QF(4)*k1.x+QF(5)*k1.y+QF(6)*k1.z+QF(7)*k1.w;
          #undef QF
        } }
      a=::sum32(a); g[n]=(n<qb)?a:-INFINITY; asm volatile("":"+v"(g[n])::"memory"); }
    #pragma unroll
    for(int r=0;r<3;++r){ int best=-1; float bv=-INFINITY;
      #pragma unroll
      for(int n=0;n<7;++n) if(!((selm>>n)&1)&&g[n]>bv){bv=g[n];best=n;}
      if(best>=0)selm|=1<<best; }
  }
  selm|=1<<qb;
  typedef __attribute__((address_space(3))) int* lds_iptr;
  ((lds_iptr)(shm3+LDS_SEL))[tid]=selm;
  #define CURNEG(blk) ({ int t_=threadIdx.x; asm volatile("":"+v"(t_)); const int sm_=((lds_iptr)(shm3+LDS_SEL))[t_]; ((sm_>>(blk))&1)?0.f:-INFINITY; })
  #define NEGUPD(t) do{ if((((t)+1)&3)==0){ const float cn_=CURNEG(((t)+1)>>2); _Pragma("unroll") for(int r=0;r<16;++r)negm[r]=cn_-mhat; asm volatile("":"+v"(negm)); } }while(0)
  float mhat=0.f,l_reg=0.f;f32x16 o[2];o[0]=f32x16{};o[1]=f32x16{};f32x16 negm; { const float cn_=CURNEG(0); _Pragma("unroll") for(int r=0;r<16;++r)negm[r]=cn_; } asm volatile("":"+v"(negm));
  const int qrel=wid*QBLK+r32;
  #define CMASK(P0,P1,t) do{int jb_=(t)-(NT-4); if(jb_>=0)cmask(P0,P1,jb_,qrel,hi);}while(0)
  bool resc=false;
  #define START(P0,P1) do{ const float rm=rowmax(P0,P1); resc=false; \
    { const float dl=__builtin_fmaxf(rm,-24.f); mhat=fadd_s(mhat,dl); \
      _Pragma("unroll") for(int r=0;r<16;++r){P0[r]=fsub_s(P0[r],dl);P1[r]=fsub_s(P1[r],dl);} \
      { const float cn_=CURNEG(0); _Pragma("unroll") for(int r=0;r<16;++r)negm[r]=cn_-mhat; } asm volatile("":"+v"(negm)); } \
    _Pragma("unroll") for(int r=0;r<16;++r)P0[r]=__builtin_amdgcn_exp2f(P0[r]); }while(0)
  #define RESC() do{ if(resc){ asm volatile("s_waitcnt lgkmcnt(0)":::"memory"); \
      _Pragma("unroll") for(int d_=0;d_<2;++d_) _Pragma("unroll") for(int r=0;r<16;++r)o[d_][r]*=wsf[crow(r,hi)]; } }while(0)
  f32x16 pA0,pA1,pB0,pB1;
  int sl_prev=0,sl_cur=0,sl_next=SLOTB;
  #define ROT() do{sl_prev=sl_cur;sl_cur=sl_next;sl_next=(sl_next==(NSLOT-1)*SLOTB)?0:sl_next+SLOTB;}while(0)
  DMA_K(2,2*SLOTB);
  WAIT_BAR(3);
  qkt(pA0,pA1,Kbase,qr,negm,r32,hi);asm volatile("s_nop 15\n\ts_nop 7":"+v"(pA0),"+v"(pA1));CMASK(pA0,pA1,0);
  START(pA0,pA1);
  _Pragma("unroll") for(int r=0;r<16;++r)pA1[r]=__builtin_amdgcn_exp2f(pA1[r]);
  WAIT_BAR(0);
  DMA_K(3,0);DMA_V(1,SLOTB);
  ROT();
  kload8(kf,kp0+sl_cur);
  WAIT_BAR(2);
  s16x4 vlo[8],vhi[8]; u32x4 pw0,pw1,pw2,pw3;
  #define PKW(P,B) cvtpk_s(P[B],P[B+1])
  #define PAF(k) __builtin_bit_cast(bf16x8,pw##k)
  #define VFR(i) (bf16x8){vlo[i][0],vlo[i][1],vlo[i][2],vlo[i][3],vhi[i][0],vhi[i][1],vhi[i][2],vhi[i][3]}
  #define PIN(x) asm volatile("":"+v"(x))
  #define MX3(a,b,c) __builtin_fmaxf(__builtin_fmaxf((a),(b)),(c))
  #define GAPA(MF,A0,A1,A2,A3,W0,W1,PW) do{ MF; sacc+=A0; sacc+=A1; sacc+=A2; sacc+=A3; PIN(sacc); W0; W1; PIN(PW); SBAR(); }while(0)
  #define EX(v) __builtin_amdgcn_exp2f(v)
  #define GAPB(MF,X,B) do{ MF; X[B]=EX(X[B]); X[B+1]=EX(X[B+1]); X[B+2]=EX(X[B+2]); X[B+3]=EX(X[B+3]); PIN(X); SBAR(); }while(0)
  #define VRD(i) do{ vlo[i]=vtr(vp_+(((i)>>2)*4096+((i)&3)*1024)); vhi[i]=vtr(vp_+(((i)>>2)*4096+((i)&3)*1024+512)); }while(0)
  #define KRD(G,j) do{ if(G){ kload2(kf,kp0+sl_next,j); SBAR(); } }while(0)
  #define STEP(C0,C1,P0,P1,t,GK,GV,GL) do{ SBAR(); \
    const lds_cptr vp_=vp0+sl_prev; \
    VRD(0); SBAR(); float sacc=(P0[0]+P0[1]); \
    GAPA(C0=__builtin_amdgcn_mfma_f32_32x32x16_bf16(kf[0],qr[0],negm,0,0,0), P0[2],P0[3],P0[4],P0[5],     pw0[0]=PKW(P0,0), pw0[1]=PKW(P0,2), pw0); \
    VRD(4); SBAR(); GAPA(C1=__builtin_amdgcn_mfma_f32_32x32x16_bf16(kf[1],qr[0],negm,0,0,0), P0[6],P0[7],P0[8],P0[9],     pw0[2]=PKW(P0,4), pw0[3]=PKW(P0,6), pw0); \
    VRD(1); SBAR(); GAPA(C0=__builtin_amdgcn_mfma_f32_32x32x16_bf16(kf[2],qr[1],C0,0,0,0),   P0[10],P0[11],P0[12],P0[13], pw1[0]=PKW(P0,8), pw1[1]=PKW(P0,10), pw1); \
    VRD(5); SBAR(); GAPA(C1=__builtin_amdgcn_mfma_f32_32x32x16_bf16(kf[3],qr[1],C1,0,0,0),   P0[14],P0[15],P1[0],P1[1],   pw1[2]=PKW(P0,12),pw1[3]=PKW(P0,14), pw1); \
    VRD(2); SBAR(); GAPA(C0=__builtin_amdgcn_mfma_f32_32x32x16_bf16(kf[4],qr[2],C0,0,0,0),   P1[2],P1[3],P1[4],P1[5],     pw2[0]=PKW(P1,0), pw2[1]=PKW(P1,2), pw2); \
    VRD(6); SBAR(); GAPA(C1=__builtin_amdgcn_mfma_f32_32x32x16_bf16(kf[5],qr[2],C1,0,0,0),   P1[6],P1[7],P1[8],P1[9],     pw2[2]=PKW(P1,4), pw2[3]=PKW(P1,6), pw2); \
    VRD(3); SBAR(); GAPA(C0=__builtin_amdgcn_mfma_f32_32x32x16_bf16(kf[6],qr[3],C0,0,0,0),   P1[10],P1[11],P1[12],P1[13], pw3[0]=PKW(P1,8), pw3[1]=PKW(P1,10), pw3); \
    VRD(7); SBAR(); GAPA(C1=__builtin_amdgcn_mfma_f32_32x32x16_bf16(kf[7],qr[3],C1,0,0,0),   P1[14],P1[15],0.f,0.f,       pw3[2]=PKW(P1,12),pw3[3]=PKW(P1,14), pw3); \
    l_reg+=sacc; \
    if(GK){DMA_K((t)+3,sl_cur);} if(GV){DMA_V((t)+1,sl_next);} \
    CMASK(C0,C1,t); \
    { float a=MX3(C0[0],C0[1],C1[0]),b=MX3(C0[2],C0[3],C1[1]); a=MX3(a,C1[2],C1[3]); \
      _Pragma("unroll") for(int r=4;r<16;r+=4){a=MX3(a,C0[r],C0[r+1]);b=MX3(b,C0[r+2],C0[r+3]);a=MX3(a,C1[r],C1[r+1]);b=MX3(b,C1[r+2],C1[r+3]);} \
      float rm=__builtin_fmaxf(a,b); { auto rr=__builtin_amdgcn_permlane32_swap(__float_as_uint(rm),__float_as_uint(rm),false,false); rm=__builtin_fmaxf(__uint_as_float(rr[0]),__uint_as_float(rr[1])); } \
      resc=false; \
      if(__builtin_expect(__any(rm>(float)THRL),0)){ const float dl=__builtin_fmaxf(rm,0.f); mhat+=dl; \
        _Pragma("unroll") for(int r=0;r<16;++r){C0[r]-=dl;C1[r]-=dl;} \
        { const float cn_=CURNEG(((t)+1)>>2); _Pragma("unroll") for(int r=0;r<16;++r)negm[r]=cn_-mhat; } asm volatile("":"+v"(negm)); \
        const float f=__builtin_amdgcn_exp2f(-dl); l_reg*=f; if(hi==0)wsf[r32]=f; resc=true; } } \
    SBAR(); \
    GAPB(o[0]=__builtin_amdgcn_mfma_f32_32x32x16_bf16(PAF(0),VFR(0),o[0],0,0,0), C0,0); \
    GAPB(o[1]=__builtin_amdgcn_mfma_f32_32x32x16_bf16(PAF(0),VFR(4),o[1],0,0,0), C0,4); \
    KRD(GL,0); GAPB(o[0]=__builtin_amdgcn_mfma_f32_32x32x16_bf16(PAF(1),VFR(1),o[0],0,0,0), C0,8); \
    KRD(GL,1); GAPB(o[1]=__builtin_amdgcn_mfma_f32_32x32x16_bf16(PAF(1),VFR(5),o[1],0,0,0), C0,12); \
    KRD(GL,2); GAPB(o[0]=__builtin_amdgcn_mfma_f32_32x32x16_bf16(PAF(2),VFR(2),o[0],0,0,0), C1,0); \
    KRD(GL,3); GAPB(o[1]=__builtin_amdgcn_mfma_f32_32x32x16_bf16(PAF(2),VFR(6),o[1],0,0,0), C1,4); \
    GAPB(o[0]=__builtin_amdgcn_mfma_f32_32x32x16_bf16(PAF(3),VFR(3),o[0],0,0,0), C1,8); \
    GAPB(o[1]=__builtin_amdgcn_mfma_f32_32x32x16_bf16(PAF(3),VFR(7),o[1],0,0,0), C1,12); \
    }while(0)
  int t=1;
  #undef CMASK
  #define CMASK(P0,P1,t) do{}while(0)
  for(;t+5<NT;t+=2){
    STEP(pB0,pB1,pA0,pA1,t,true,true,true);     WAIT_BAR(2); RESC(); ROT(); NEGUPD(t);
    STEP(pA0,pA1,pB0,pB1,t+1,true,true,true);   WAIT_BAR(2); RESC(); ROT(); NEGUPD(t+1);
  }
  #undef CMASK
  #define CMASK(P0,P1,t) do{int jb_=(t)-(NT-4); if(jb_>=0)cmask(P0,P1,jb_,qrel,hi);}while(0)
  #define ENDW(tt) do{ if((tt)+3<NT){WAIT_BAR(2);} else if((tt)+2<NT){WAIT_BAR(1);} else {WAIT_BAR(0);} }while(0)
  for(;t+1<NT;t+=2){
    STEP(pB0,pB1,pA0,pA1,t,(t+3<NT),(t+1<NT),(t+1<NT));       ENDW(t);   RESC(); ROT(); NEGUPD(t);
    STEP(pA0,pA1,pB0,pB1,t+1,(t+4<NT),(t+2<NT),(t+2<NT));     ENDW(t+1); RESC(); ROT(); NEGUPD(t+1);
  }
  STEP(pB0,pB1,pA0,pA1,NT-1,false,false,false); RESC();
  { float sacc=pB0[0]+pB0[1]; _Pragma("unroll") for(int r=2;r<16;++r)sacc+=pB0[r]; _Pragma("unroll") for(int r=0;r<16;++r)sacc+=pB1[r]; l_reg+=sacc;
    pw0=(u32x4){PKW(pB0,0),PKW(pB0,2),PKW(pB0,4),PKW(pB0,6)};pw1=(u32x4){PKW(pB0,8),PKW(pB0,10),PKW(pB0,12),PKW(pB0,14)};pw2=(u32x4){PKW(pB1,0),PKW(pB1,2),PKW(pB1,4),PKW(pB1,6)};pw3=(u32x4){PKW(pB1,8),PKW(pB1,10),PKW(pB1,12),PKW(pB1,14)};
    SBAR(); pv(o,vb0+sl_cur,PAF(0),PAF(1),PAF(2),PAF(3)); }
  #undef PKW
  #undef PAF
  #undef VFR
  #undef PIN
  #undef MX3
  #undef GAPA
  #undef GAPB
  #undef EX
  #undef VRD
  #undef KRD
  #undef STEP
  #undef ENDW
  {auto rr=__builtin_amdgcn_permlane32_swap(__float_as_uint(l_reg),__float_as_uint(l_reg),false,false);l_reg=__uint_as_float(rr[0])+__uint_as_float(rr[1]);}
  if(hi==0)wsf[32+r32]=l_reg;asm volatile("s_waitcnt lgkmcnt(0)":::"memory");
  float rli[16];
  #pragma unroll
  for(int r=0;r<16;++r)rli[r]=__builtin_amdgcn_rcpf(wsf[32+crow(r,hi)]);
  bf16*Ow=O+(rowbase+q0+wid*QBLK)*DM+h*D;
  { bf16*stg=(bf16*)(shm+LDS_OST)+wid*2048;
    #pragma unroll
    for(int r=0;r<16;++r){const int orow=crow(r,hi);
      #pragma unroll
      for(int d0=0;d0<2;++d0)stg[orow*64+d0*32+r32]=__float2bfloat16(o[d0][r]*rli[r]);}
    asm volatile("s_waitcnt lgkmcnt(0)":::"memory");
    #pragma unroll
    for(int i=0;i<4;++i){const int row=i*8+(lane>>3),ch=lane&7; const u32x4 v=*(const u32x4*)(stg+row*64+ch*8); ATTN_STORE16(Ow+(long)row*DM+ch*8,v);} }
  asm volatile("s_waitcnt lgkmcnt(0)\n\ts_barrier":::"memory");
  #undef DMA_K
  #undef DMA_V
  #undef CMASK
  #undef START
  #undef CURNEG
  #undef NEGUPD
  #undef RESC
  #undef ROT
}
constexpr int ATTN_LDS_BYTES=LDS_BYTES;
struct AttnTensors { const bf16* Q; const bf16* K; const bf16* V; bf16* O; const float* kbar; };
struct AttnUnit { int bh; int qb; };
struct StaticOrder {
  int vcu,G;
  __device__ __forceinline__ explicit StaticOrder(int grid,int block):vcu((grid%8==0)?(block%8)*(grid/8)+block/8:block),G(grid){}
  __device__ __forceinline__ bool next(int i,AttnUnit&u)const{
    if(G==256){ if(i>=4)return false; const int s=vcu&1; u.bh=vcu>>1; u.qb=s?((i==0)?6:(i==1)?1:(i==2)?5:2):((i==0)?7:(i==1)?0:(i==2)?4:3); return true; }
    const int L=i*G+vcu; if(L>=1024)return false; u.bh=L>>3; u.qb=L&7; return true; }
  __device__ __forceinline__ void a_ready(const AttnUnit&)const{}
  __device__ __forceinline__ void done(const AttnUnit&)const{}
};
template<class Sched,int THRL=8> __device__ __forceinline__ void attn_phase(char*lds,const AttnTensors&T,const Sched&S){
  AttnUnit u;
  for(int i=0;S.next(i,u);++i){ S.a_ready(u); attn_unit<THRL>(u.bh/NHEAD,u.bh%NHEAD,u.qb,T.Q,T.K,T.V,T.O,T.kbar,lds); S.done(u); }
}
#undef SBAR
#undef WAIT_BAR
}
constexpr int NWAVES = 8;
constexpr int T = 32768, D = 1024, SEQ = 2048, MEMROWS = 4096, INW = 5120;
constexpr float RMS_EPS = 1e-6f;
constexpr size_t MiB = 1u << 20;
constexpr size_t WS_CTL = 0, CTL_ZERO_BYTES = 2 * MiB, WS_KBAR = 1 * MiB;
constexpr size_t WS_WIN = 2 * MiB, WS_WC = 12 * MiB, WS_WA = 13 * MiB, WS_WM = 14 * MiB, WS_WXQ = 16 * MiB, WS_WXKV = 18 * MiB, WS_WXO = 22 * MiB, WS_MT = 24 * MiB, WS_ROPE = 28 * MiB;
constexpr size_t WS_MEMN = 32 * MiB, WS_KX = 40 * MiB, WS_VXT = 48 * MiB;
constexpr size_t WS_SSQ1 = 30 * MiB, WS_SSQ2 = 56 * MiB;
constexpr size_t WS_A = 64 * MiB;
constexpr size_t WS_YC = 128 * MiB, WS_QO = 160 * MiB, WS_U = 192 * MiB, WS_K = 224 * MiB, WS_V = 256 * MiB;
constexpr size_t WS_SGC = 320 * MiB, WS_SGA = 384 * MiB;
constexpr size_t WS_A8I = 320 * MiB, WS_ASC = 352 * MiB;
constexpr size_t WS_EIDX = 448 * MiB, WS_GW = 464 * MiB, WS_PW = 480 * MiB, WS_END = 496 * MiB;
constexpr size_t WS_U8 = 288 * MiB, WS_V8T = 304 * MiB, WS_SU = 29 * MiB, WS_SV = 29 * MiB + 512 * 1024;
constexpr size_t WS_QX = 128 * MiB, WS_PM = 192 * MiB, WS_OX = 128 * MiB;
constexpr size_t WS_PO = 128 * MiB;
constexpr size_t WS_SC = 128 * MiB;
constexpr int CW_TMO = 0, CW_BAR = 4096, CW_Q = 8192;
constexpr int RING_OFF = 0, RING_BYTES = 131072;
constexpr int LDSCTL_OFF = RING_BYTES, MISC_OFF = LDSCTL_OFF + 320;
constexpr int LDS_BYTES = 163840;
constexpr int UL_OFF = RING_BYTES + 512, UL_WAVE = (LDS_BYTES - UL_OFF) / 8, UL_CAP = ((UL_WAVE - 64) / 8) & ~15;

#define GAS __attribute__((address_space(1)))
#define LAS __attribute__((address_space(3)))
typedef unsigned short bf16;
typedef unsigned v4u __attribute__((ext_vector_type(4)));
typedef unsigned v2u __attribute__((ext_vector_type(2)));
typedef float v2f __attribute__((ext_vector_type(2)));
typedef float f32x4 __attribute__((ext_vector_type(4)));
typedef float f32x2v __attribute__((ext_vector_type(2)));
typedef _Float16 h2v __attribute__((ext_vector_type(2)));
typedef GAS unsigned gu32;
#define RLX_AGENT __ATOMIC_RELAXED, __HIP_MEMORY_SCOPE_AGENT
#define LDS_WAIT() asm volatile("s_waitcnt lgkmcnt(0)" ::: "memory")
#define VM_WAIT() asm volatile("s_waitcnt vmcnt(0)" ::: "memory")
__device__ __forceinline__ unsigned pk2(float lo, float hi) { return pg8::cvt_pk_bf16(lo, hi); }
__device__ __forceinline__ float bflo(unsigned u) { return __uint_as_float(u << 16); }
__device__ __forceinline__ float bfhi(unsigned u) { return __uint_as_float(u & 0xffff0000u); }

#define XB_TMO      128
#define XB_XCNT(j)  (256  + 64 * (j))
#define XB_XSUB(j)  (1280 + 64 * (j))
#define XB_XGEN(j)  (2304 + 64 * (j))
#define XB_TOP      3328
#define XB_TOPGEN   3392
#define XCD_BAR_WORDS 3456
#define XB_SPIN_CAP (1u << 18)
__device__ __forceinline__ unsigned xb_ld(unsigned* p)              { return __hip_atomic_load(p, __ATOMIC_RELAXED, __HIP_MEMORY_SCOPE_AGENT); }
__device__ __forceinline__ unsigned xb_add(unsigned* p, unsigned v) { return __hip_atomic_fetch_add(p, v, __ATOMIC_RELAXED, __HIP_MEMORY_SCOPE_AGENT); }
__device__ __forceinline__ unsigned xb_xcc_id() { return (unsigned)__builtin_amdgcn_s_getreg((3 << 11) | 20) & 0xFu; }
#define XB_SPIN(cond, bar) do { unsigned _sp = 0; while (cond) { __builtin_amdgcn_s_sleep(1); \
    if ((++_sp & 255u) == 0u) { if (xb_ld(&(bar)[XB_TMO])) break; if (_sp > XB_SPIN_CAP) { atomicAdd(&(bar)[XB_TMO], 1u); break; } } } } while (0)
struct XcdBarrier { unsigned* bar; unsigned x; volatile LAS unsigned* st; };
__device__ __forceinline__ XcdBarrier xcd_barrier_post(unsigned* bar, volatile LAS unsigned* st) {
    XcdBarrier b; b.bar = bar; b.x = xb_xcc_id(); b.st = st;
    if (threadIdx.x == 0) (void)xb_add(&bar[XB_XCNT(b.x)], 1u);
    return b;
}
__device__ __forceinline__ void xcd_barrier_complete(unsigned* bar, unsigned x, unsigned& nloc, unsigned& nx) {
    const unsigned G = gridDim.x * gridDim.y * gridDim.z;
    unsigned sum, cnt, mine, sp = 0u;
    for (;;) {
        sum = 0u; cnt = 0u; mine = 0u;
#pragma unroll
        for (unsigned j = 0; j < 16; ++j) { const unsigned c = xb_ld(&bar[XB_XCNT(j)]); sum += c; cnt += (c > 0u) ? 1u : 0u; mine = (j == x) ? c : mine; }
        if (sum == G) break;
        __builtin_amdgcn_s_sleep(1);
        if ((++sp & 255u) == 0u) { if (xb_ld(&bar[XB_TMO])) break; if (sp > XB_SPIN_CAP) { atomicAdd(&bar[XB_TMO], 1u); break; } }
    }
    nloc = mine > 0u ? mine : 1u; nx = cnt > 0u ? cnt : 1u;
}
__device__ __forceinline__ void xcd_barrier(const XcdBarrier& b) {
    asm volatile("s_waitcnt vmcnt(0)" ::: "memory");
    __syncthreads();
    if (threadIdx.x == 0) {
        unsigned* bar = b.bar;
        __builtin_amdgcn_s_waitcnt(0);
        unsigned nloc = b.st[0], nx = b.st[1];
        if (nloc == 0u) { xcd_barrier_complete(bar, b.x, nloc, nx); b.st[0] = nloc; b.st[1] = nx; }
        const unsigned old = xb_add(&bar[XB_XSUB(b.x)], 1u);
        const unsigned gen = old / nloc;
        if (old + 1u == (gen + 1u) * nloc) {
            __builtin_amdgcn_fence(__ATOMIC_RELEASE, "agent");
            asm volatile("s_waitcnt vmcnt(0)" ::: "memory");
            const unsigned og = xb_add(&bar[XB_TOP], 1u);
            const unsigned tg = og / nx;
            if (og + 1u == (tg + 1u) * nx) xb_add(&bar[XB_TOPGEN], 1u);
            else XB_SPIN(xb_ld(&bar[XB_TOPGEN]) == tg, bar);
            __builtin_amdgcn_fence(__ATOMIC_ACQUIRE, "agent");
            xb_add(&bar[XB_XGEN(b.x)], 1u);
            asm volatile("s_waitcnt vmcnt(0)" ::: "memory");
        } else {
            XB_SPIN(xb_ld(&bar[XB_XGEN(b.x)]) == gen, bar);
            __builtin_amdgcn_fence(__ATOMIC_ACQUIRE, "agent");
            asm volatile("s_waitcnt vmcnt(0)" ::: "memory");
        }
    }
    __syncthreads();
}

struct MapId { static __device__ __forceinline__ int src(int j) { return j; } };
struct MapWin {
    static __device__ __forceinline__ int src(int j) {
        if (j < 1024) { const int g8 = j >> 3, i = j & 7; return ((i < 4) ? 0 : 1024) + 4 * g8 + (i & 3); }
        if (j < 1536) return 512 + (j - 1024);
        if (j < 2560) { const int jj = j - 1536, qk = jj >> 9, p = jj & 511, head = p >> 6, pl = p & 63, g = pl >> 3, i = pl & 7; return 1536 + qk * 512 + head * 64 + 4 * g + (i & 3) + 32 * (i >> 2); }
        return j;
    }
};
template <class MAP>
__device__ __forceinline__ void p0_transpose_item(const float* W, int K, int N, int NOUT, bf16* WT, LAS float* scr, int item, int lane, const float* gain = nullptr) {
    const int nblk = NOUT / 32, kb = item / nblk, nb = item % nblk, k0 = 64 * kb, n0 = 32 * nb;
    const int sc = MAP::src(n0 + (lane & 31));
    float wv[32];
#pragma unroll
    for (int i = 0; i < 32; ++i) wv[i] = W[(size_t)(k0 + 2 * i + (lane >> 5)) * N + sc];
#pragma unroll
    for (int i = 0; i < 32; ++i) { const int kk = 2 * i + (lane >> 5); const float gk = gain ? gain[k0 + kk] : 1.f; scr[kk * 33 + (lane & 31)] = wv[i] * gk; }
    LDS_WAIT(); asm volatile("" ::: "memory");
    const int c = lane & 7;
#pragma unroll
    for (int j = 0; j < 4; ++j) { const int n = (lane >> 3) + 8 * j; const LAS float* s = scr + (8 * c) * 33 + n;
        v4u o; o.x = pk2(s[0 * 33], s[1 * 33]); o.y = pk2(s[2 * 33], s[3 * 33]); o.z = pk2(s[4 * 33], s[5 * 33]); o.w = pk2(s[6 * 33], s[7 * 33]);
        *(GAS v4u*)(WT + (size_t)(n0 + n) * K + k0 + 8 * c) = o; }
    LDS_WAIT(); asm volatile("" ::: "memory");
}
__device__ __forceinline__ void rms_row_to_bf16(const float* xrow, const float* g, bf16* orow, int lane) {
    const GAS f32x4* xr = (const GAS f32x4*)xrow + lane; const GAS f32x4* gr = (const GAS f32x4*)g + lane;
    f32x4 v[4]; float s = 0.f;
#pragma unroll
    for (int j = 0; j < 4; ++j) { v[j] = xr[64 * j]; s += (v[j].x * v[j].x + v[j].y * v[j].y) + (v[j].z * v[j].z + v[j].w * v[j].w); }
    const float r = rsqrtf(wave_sum(s) * (1.f / 1024.f) + RMS_EPS);
    GAS v2u* o8 = (GAS v2u*)orow + lane;
#pragma unroll
    for (int j = 0; j < 4; ++j) { const f32x4 gg = gr[64 * j]; v2u w; w.x = pk2(v[j].x * r * gg.x, v[j].y * r * gg.y); w.y = pk2(v[j].z * r * gg.z, v[j].w * r * gg.w); o8[64 * j] = w; }
}
template <int NR>
__device__ __forceinline__ void rms_rows_to_bf16(const float* x, const float* g, bf16* o, int m0, int stride, int lane) {
    f32x4 v[NR][4];
#pragma unroll
    for (int i = 0; i < NR; ++i) { const GAS f32x4* xr = (const GAS f32x4*)(x + (size_t)(m0 + i * stride) * 1024) + lane;
#pragma unroll
        for (int j = 0; j < 4; ++j) v[i][j] = xr[64 * j]; }
    f32x4 gg[4];
#pragma unroll
    for (int j = 0; j < 4; ++j) gg[j] = ((const GAS f32x4*)g + lane)[64 * j];
#pragma unroll
    for (int i = 0; i < NR; ++i) { float s = 0.f;
#pragma unroll
        for (int j = 0; j < 4; ++j) s += (v[i][j].x * v[i][j].x + v[i][j].y * v[i][j].y) + (v[i][j].z * v[i][j].z + v[i][j].w * v[i][j].w);
        const float r = rsqrtf(wave_sum(s) * (1.f / 1024.f) + RMS_EPS);
        GAS v2u* o8 = (GAS v2u*)(o + (size_t)(m0 + i * stride) * 1024) + lane;
#pragma unroll
        for (int j = 0; j < 4; ++j) { v2u w; w.x = pk2(v[i][j].x * r * gg[j].x, v[i][j].y * r * gg[j].y); w.y = pk2(v[i][j].z * r * gg[j].z, v[i][j].w * r * gg[j].w); o8[64 * j] = w; } }
}
__device__ __forceinline__ float fmax_asm(float a, float b) { float r; asm("v_max_f32 %0, %1, %2" : "=v"(r) : "v"(a), "v"(b)); return r; }
__device__ __forceinline__ float fmin_asm(float a, float b) { float r; asm("v_min_f32 %0, %1, %2" : "=v"(r) : "v"(a), "v"(b)); return r; }

#ifndef PH_MASK
#define PH_MASK 0xFFFFFFFFu
#endif
#define PH(k) ((PH_MASK >> (k)) & 1u)
#ifndef REP_MASK
#define REP_MASK 0u
#endif
#define NREP(k) (((REP_MASK >> (k)) & 1u) ? 2 : 1)
#ifndef DIAG_TS_A
#define DIAG_TS_A -1
#endif
#ifndef DIAG_TS_B
#define DIAG_TS_B -1
#endif
struct Args { const float* in[19]; float* out; unsigned char* ws; };

struct XOrder {
    const char* A; const char* Bt; int G, c, i0, mode;
    __device__ bool next(int i, pg8::Unit& u) const {
        if (i > 0) return false;
        const int L = i0 * G + c; if (L >= 512) return false;
        const int b = L >> 5, head = (L >> 3) & 3, rt = L & 7;
        u.pm = b * 8 + rt; u.pn = head;
        if (mode == 0) { u.a = A + (size_t)(b * 2048 + rt * 256) * 1024 * 2; u.b = Bt + (size_t)(head * 256) * 1024 * 2; }
        else { u.a = A + ((size_t)(b * 2048 + rt * 256) * 1024 + head * 256) * 2;
               u.b = (mode == 2) ? Bt + ((size_t)(head * 256) * 4096 + b * 256) * 2 : Bt + ((size_t)(b * 256) * 1024 + head * 256) * 2; }
        return true;
    }
};

__global__ void __launch_bounds__(NWAVES * 64, 2) mk_fwd(Args args) {
    extern __shared__ __attribute__((aligned(16))) unsigned char lds[];
    LAS unsigned char* L = (LAS unsigned char*)lds;
    volatile LAS unsigned* MISC = (volatile LAS unsigned*)(L + MISC_OFF);
    const int wave = __builtin_amdgcn_readfirstlane((int)threadIdx.x >> 6);
#define PH_LANES int tid = threadIdx.x; asm volatile("" : "+v"(tid)); const int lane = tid & 63; const int gt = vcu * (NWAVES * 64) + tid; (void)lane; (void)gt
    const int G = gridDim.x; const int bx = blockIdx.x; const int vcu = (G % 8 == 0) ? (bx % 8) * (G / 8) + bx / 8 : bx;
    unsigned char* ws = args.ws;
    gu32* ctl = (gu32*)(ws + WS_CTL);
    for (int u = threadIdx.x; u < (LDS_BYTES - LDSCTL_OFF) / 4; u += NWAVES * 64) ((LAS unsigned*)(L + LDSCTL_OFF))[u] = 0u;
    __syncthreads();
    XcdBarrier bar = xcd_barrier_post((unsigned*)(ctl + CW_BAR), MISC + 8);
    unsigned long long* tsw = (unsigned long long*)(ws + WS_CTL + 65536);
    int n_ts = 0;
#define TSTAMP() do { if (DIAG_TS_A >= 0) { if (bx == 0 && threadIdx.x == 0) tsw[n_ts] = __builtin_amdgcn_s_memrealtime(); ++n_ts; } } while (0)
    TSTAMP();

    const float *x = args.in[0], *mem = args.in[1], *g_mix = args.in[2], *w_in = args.in[3], *w_conv = args.in[4], *w_conv_out = args.in[5], *w_attn_out = args.in[6], *w_merge = args.in[7],
                *g_xattn = args.in[8], *g_mem = args.in[9], *w_xq = args.in[10], *w_xkv = args.in[11], *w_xo = args.in[12], *g_ffn = args.in[13], *w_pq = args.in[14], *sub_keys = args.in[15],
                *peer_u = args.in[16], *peer_v = args.in[17], *g_final = args.in[18];
    float* out = args.out;
    bf16 *WinT = (bf16*)(ws + WS_WIN), *WcT = (bf16*)(ws + WS_WC), *WaT = (bf16*)(ws + WS_WA), *WmT = (bf16*)(ws + WS_WM), *WxqT = (bf16*)(ws + WS_WXQ), *WxkvT = (bf16*)(ws + WS_WXKV),
         *WxoT = (bf16*)(ws + WS_WXO), *MT = (bf16*)(ws + WS_MT);
    float* ropec = (float*)(ws + WS_ROPE); float* ropes = ropec + 2048 * 32;
    float* kbar = (float*)(ws + WS_KBAR);
    bf16 *MEMN = (bf16*)(ws + WS_MEMN), *KX = (bf16*)(ws + WS_KX), *VXT = (bf16*)(ws + WS_VXT), *A = (bf16*)(ws + WS_A);
    bf16 *YC = (bf16*)(ws + WS_YC), *QO = (bf16*)(ws + WS_QO), *U = (bf16*)(ws + WS_U), *KB = (bf16*)(ws + WS_K), *VB = (bf16*)(ws + WS_V), *SGC = (bf16*)(ws + WS_SGC), *SGA = (bf16*)(ws + WS_SGA);
    bf16 *QX = (bf16*)(ws + WS_QX), *PM = (bf16*)(ws + WS_PM), *OX = (bf16*)(ws + WS_OX);
    _Float16* SC = (_Float16*)(ws + WS_SC);
    unsigned char* A8I = ws + WS_A8I; float* ASC = (float*)(ws + WS_ASC);
    int* EIDX = (int*)(ws + WS_EIDX); float* GW = (float*)(ws + WS_GW); unsigned* PW = (unsigned*)(ws + WS_PW);
    float* PO = (float*)(ws + WS_PO); float* SSQ1 = (float*)(ws + WS_SSQ1); float* SSQ2 = (float*)(ws + WS_SSQ2); (void)PO;
    unsigned char* U8 = ws + WS_U8; unsigned char* V8T = ws + WS_V8T; float* SU = (float*)(ws + WS_SU); float* SV = (float*)(ws + WS_SV);
    const int gw = vcu * NWAVES + wave, NGW = G * NWAVES;
    const int NGT = G * NWAVES * 64;

    asm volatile("; ===== PHASE 0 =====");
    if (PH(0)) for (int rep = 0; rep < NREP(0); ++rep) {
        PH_LANES; const bool dummy = rep < NREP(0) - 1; (void)dummy;
        LAS float* scr = (LAS float*)(L + RING_OFF + wave * 16384);
        constexpr int I_IN = (1024 / 64) * (5120 / 32), I_C = (512 / 64) * (1024 / 32), I_M = (1024 / 64) * (1024 / 32), I_KV = (1024 / 64) * (2048 / 32);
        constexpr int NITEMS = I_IN + 2 * I_C + 3 * I_M + I_KV;
        for (int it = gw; it < NITEMS; it += NGW) {
            int r = it;
            if (r < I_IN) { p0_transpose_item<MapWin>(w_in, 1024, 5120, 5120, WinT, scr, r, lane); continue; } r -= I_IN;
            if (r < I_C) { p0_transpose_item<MapId>(w_conv_out, 512, 1024, 1024, WcT, scr, r, lane); continue; } r -= I_C;
            if (r < I_C) { p0_transpose_item<MapId>(w_attn_out, 512, 1024, 1024, WaT, scr, r, lane); continue; } r -= I_C;
            if (r < I_M) { p0_transpose_item<MapId>(w_merge, 1024, 1024, 1024, WmT, scr, r, lane); continue; } r -= I_M;
            if (r < I_M) { p0_transpose_item<MapId>(w_xq, 1024, 1024, 1024, WxqT, scr, r, lane, g_xattn); continue; } r -= I_M;
            if (r < I_M) { p0_transpose_item<MapId>(w_xo, 1024, 1024, 1024, WxoT, scr, r, lane); continue; } r -= I_M;
            p0_transpose_item<MapId>(w_xkv, 1024, 2048, 2048, WxkvT, scr, r, lane);
        }
        { int m = gw; for (; m + 3 * NGW < T; m += 4 * NGW) rms_rows_to_bf16<4>(x, g_mix, A, m, NGW, lane); for (; m < T; m += NGW) rms_row_to_bf16(x + (size_t)m * D, g_mix, A + (size_t)m * D, lane); }
        { int m = gw; for (; m + NGW < MEMROWS; m += 2 * NGW) rms_rows_to_bf16<2>(mem, g_mem, MEMN, m, NGW, lane); for (; m < MEMROWS; m += NGW) rms_row_to_bf16(mem + (size_t)m * D, g_mem, MEMN + (size_t)m * D, lane); }
        for (int i = gt; i < 2048 * 32; i += NGT) { const int pos = i >> 5, f = i & 31; const float inv = powf(10000.0f, -(float)f / 32.0f); const float ang = (float)pos * inv; ropec[i] = cosf(ang); ropes[i] = sinf(ang); }
        __syncthreads();
        {
            LAS float* skl = (LAS float*)(L + RING_OFF);
            LAS float* wtl = skl + 128 * 129;
            for (int it = bx; it < 256; it += G) {
                const int hp = it >> 4, cb = it & 15;
                for (int i = tid; i < 128 * 128; i += NWAVES * 64) { const int n = i >> 7, d = i & 127; skl[n * 129 + d] = sub_keys[((size_t)hp * 128 + n) * 128 + d]; }
                for (int i = tid; i < 64 * 128; i += NWAVES * 64) { const int c = i >> 7, d = i & 127; wtl[c * 129 + d] = w_pq[(size_t)(cb * 64 + c) * 2048 + hp * 128 + d] * g_ffn[cb * 64 + c]; }
                __syncthreads();
                const int cg = tid & 15, ng = tid >> 4;
                float acc[4][4];
#pragma unroll
                for (int i = 0; i < 4; ++i)
#pragma unroll
                    for (int j = 0; j < 4; ++j) acc[i][j] = 0.f;
                for (int d = 0; d < 128; ++d) {
                    float wv[4], sv[4];
#pragma unroll
                    for (int i = 0; i < 4; ++i) { wv[i] = wtl[(4 * cg + i) * 129 + d]; sv[i] = skl[(4 * ng + i) * 129 + d]; }
#pragma unroll
                    for (int i = 0; i < 4; ++i)
#pragma unroll
                        for (int j = 0; j < 4; ++j) acc[i][j] += sv[i] * wv[j];
                }
#pragma unroll
                for (int i = 0; i < 4; ++i) { v2u w; w.x = pk2(acc[i][0], acc[i][1]); w.y = pk2(acc[i][2], acc[i][3]); *(GAS v2u*)(MT + (size_t)(hp * 128 + 4 * ng + i) * 1024 + cb * 64 + 4 * cg) = w; }
                __syncthreads();
            }
        }
    }
    xcd_barrier(bar); TSTAMP();

    asm volatile("; ===== PHASE 1 =====");
    if (PH(1)) for (int rep = 0; rep < NREP(1); ++rep) {
        PH_LANES; const bool dummy = rep < NREP(1) - 1; (void)dummy;
        pg8::Gemm g{1024, 1024, 1024}; pg8::StaticOrder S; S.init(A, 1024, WinT, 1024, T, INW, G, bx);
        pg8::EpiIn E{U, YC, QO, KB, VB, SGC, SGA, ropec, ropes, kbar, 0.125f * 1.4426950408889634f};
        pg8::gemm_phase<pg8::EpiIn, pg8::StaticOrder, true>(L + RING_OFF, g, S, E);
    }
    if (PH(1)) for (int rep = 0; rep < NREP(1); ++rep) {
        PH_LANES; const bool dummy = rep < NREP(1) - 1; (void)dummy;
        pg8::Gemm g{1024, 1024, 1024}; pg8::StaticOrder S; S.init(MEMN, 1024, WxkvT, 1024, MEMROWS, 1024, G, bx);
        pg8::EpiBf16 E{KX, 1024};
        pg8::gemm_phase<pg8::EpiBf16, pg8::StaticOrder, true>(L + RING_OFF, g, S, E);
    }
    if (PH(1)) for (int rep = 0; rep < NREP(1); ++rep) {
        PH_LANES; const bool dummy = rep < NREP(1) - 1; (void)dummy;
        pg8::Gemm g{1024, 1024, 1024}; pg8::StaticOrder S; S.init(WxkvT + (size_t)1024 * 1024, 1024, MEMN, 1024, 1024, MEMROWS, G, (bx + 128) % G);
        pg8::EpiBf16 E{VXT, 4096};
        pg8::gemm_phase<pg8::EpiBf16, pg8::StaticOrder, true>(L + RING_OFF, g, S, E);
    }
    if (PH(1)) for (int rep = 0; rep < NREP(1); ++rep) {
        PH_LANES; const bool dummy = rep < NREP(1) - 1; (void)dummy;
        int cb, ncb;
        if (G == 256) { const bool idle = (bx >= 64 && bx < 128) || bx >= 192; cb = idle ? ((bx < 128) ? bx - 64 : bx - 128) : 256; ncb = 128; } else { cb = bx; ncb = G; }
        const int cw = cb * NWAVES + wave, ncw = ncb * NWAVES;
        for (int e = (cb < ncb ? cw : 16384); e < 16384; e += ncw) {
            const GAS f32x4* r = (const GAS f32x4*)(peer_u + (size_t)e * D) + lane; f32x4 v[4]; float am = 0.f;
#pragma unroll
            for (int j = 0; j < 4; ++j) { v[j] = r[64 * j] * ((const GAS f32x4*)g_ffn + lane)[64 * j]; am = fmaxf(fmaxf(am, fmaxf(fabsf(v[j].x), fabsf(v[j].y))), fmaxf(fabsf(v[j].z), fabsf(v[j].w))); }
            am = wave_max(am);
            const float sc = am > 0.f ? 127.f / am : 1.f; if (lane == 0) SU[2 * e] = am > 0.f ? am * (1.f / 127.f) : 1.f;
#pragma unroll
            for (int j = 0; j < 4; ++j) { const unsigned w = ((unsigned)(int)rintf(v[j].x * sc) & 255u) | (((unsigned)(int)rintf(v[j].y * sc) & 255u) << 8) | (((unsigned)(int)rintf(v[j].z * sc) & 255u) << 16) | (((unsigned)(int)rintf(v[j].w * sc) & 255u) << 24);
                *(GAS unsigned*)(U8 + (size_t)e * 1024 + 4 * lane + 256 * j) = w; }
        }
        __syncthreads();
        for (int it = cb; it < 256; it += ncb) {
            const int e0 = it * 64;
#pragma unroll 1
            for (int rr = 0; rr < 8; ++rr) {
                const int el = wave * 8 + rr, e = e0 + el;
                const GAS f32x4* r = (const GAS f32x4*)(peer_v + (size_t)e * D) + lane; f32x4 v[4]; float am = 0.f;
#pragma unroll
                for (int j = 0; j < 4; ++j) { v[j] = r[64 * j]; am = fmaxf(fmaxf(am, fmaxf(fabsf(v[j].x), fabsf(v[j].y))), fmaxf(fabsf(v[j].z), fabsf(v[j].w))); }
                am = wave_max(am);
                const float sc = am > 0.f ? 4.f / am : 1.f; if (lane == 0) SU[2 * e + 1] = am > 0.f ? am * 0.25f : 1.f;
#pragma unroll
                for (int j = 0; j < 4; ++j) { int w = __builtin_amdgcn_cvt_pk_bf8_f32(v[j].x * sc, v[j].y * sc, 0, false); w = __builtin_amdgcn_cvt_pk_bf8_f32(v[j].z * sc, v[j].w * sc, w, true);
                    *(LAS unsigned*)(L + RING_OFF + el * 1024 + 4 * lane + 256 * j) = (unsigned)w; }
            }
            __syncthreads();
#pragma unroll
            for (int i = 0; i < 8; ++i) { const int idx = tid + 512 * i, sl = idx >> 5, k = idx & 31;
                const v2u a0 = *(const LAS v2u*)(L + RING_OFF + (2 * k) * 1024 + sl * 8), a1 = *(const LAS v2u*)(L + RING_OFF + (2 * k + 1) * 1024 + sl * 8);
                *(GAS v4u*)(V8T + ((size_t)sl * 16384 + e0 + 2 * k) * 8) = (v4u){a0.x, a0.y, a1.x, a1.y}; }
            __syncthreads();
        }
    }
    xcd_barrier(bar); TSTAMP();

    asm volatile("; ===== PHASE 2 =====");
    if (PH(2)) for (int rep = 0; rep < NREP(2); ++rep) {
        PH_LANES; const bool dummy = rep < NREP(2) - 1; (void)dummy;
        for (int i = gt; i < T * 64; i += NGT) {
            const int row = i >> 6, cg = i & 63, s = row & 2047;
            const v4u u0 = *(const GAS v4u*)(U + (size_t)row * 512 + cg * 8);
            v4u u1 = (v4u){0u, 0u, 0u, 0u}, u2 = (v4u){0u, 0u, 0u, 0u};
            if (s >= 1) u1 = *(const GAS v4u*)(U + (size_t)(row - 1) * 512 + cg * 8);
            if (s >= 2) u2 = *(const GAS v4u*)(U + (size_t)(row - 2) * 512 + cg * 8);
            const v4u bq = *(const GAS v4u*)(YC + (size_t)row * 512 + cg * 8);
            const f32x4 w0a = *(const GAS f32x4*)(w_conv + cg * 8), w0b = *(const GAS f32x4*)(w_conv + cg * 8 + 4);
            const f32x4 w1a = *(const GAS f32x4*)(w_conv + 512 + cg * 8), w1b = *(const GAS f32x4*)(w_conv + 512 + cg * 8 + 4);
            const f32x4 w2a = *(const GAS f32x4*)(w_conv + 1024 + cg * 8), w2b = *(const GAS f32x4*)(w_conv + 1024 + cg * 8 + 4);
            v4u o;
#define CONV2(q, wa, ia, ib) pk2(bflo(bq.q) * (w0##wa[ia] * bflo(u2.q) + w1##wa[ia] * bflo(u1.q) + w2##wa[ia] * bflo(u0.q)), bfhi(bq.q) * (w0##wa[ib] * bfhi(u2.q) + w1##wa[ib] * bfhi(u1.q) + w2##wa[ib] * bfhi(u0.q)))
            o.x = CONV2(x, a, 0, 1); o.y = CONV2(y, a, 2, 3); o.z = CONV2(z, b, 0, 1); o.w = CONV2(w, b, 2, 3);
#undef CONV2
            { const bool conv_dummy = (NREP(2) == 2) && !dummy; *(GAS v4u*)(YC + (size_t)row * 512 + cg * 8) = conv_dummy ? bq : o; }
        }
        __syncthreads();
        const attn_body::AttnTensors AT{(const attn_body::bf16*)QO, (const attn_body::bf16*)KB, (const attn_body::bf16*)VB, (attn_body::bf16*)(dummy ? A : QO), kbar};
        const attn_body::StaticOrder S(G, bx);
        attn_body::attn_phase<attn_body::StaticOrder>((char*)lds + RING_OFF, AT, S);
    }
    xcd_barrier(bar); TSTAMP();

    asm volatile("; ===== PHASE 3 =====");
    if (PH(3)) for (int rep = 0; rep < NREP(3); ++rep) {
        PH_LANES; const bool dummy = rep < NREP(3) - 1; (void)dummy;
        pg8::Gemm g{512, 512, 512}; pg8::StaticOrder S; S.init(YC, 512, WcT, 512, T, 1024, G, bx);
        pg8::EpiGateMul E{SGC, dummy ? A : SGC, 1024};
        pg8::gemm_phase<pg8::EpiGateMul, pg8::StaticOrder, true>(L + RING_OFF, g, S, E);
    }
    if (PH(3)) for (int rep = 0; rep < NREP(3); ++rep) {
        PH_LANES; const bool dummy = rep < NREP(3) - 1; (void)dummy;
        pg8::Gemm g{512, 512, 512}; pg8::StaticOrder S; S.init(QO, 512, WaT, 512, T, 1024, G, bx);
        pg8::EpiGateFma E{SGC, SGA, dummy ? A : SGA, 1024};
        pg8::gemm_phase<pg8::EpiGateFma, pg8::StaticOrder, true>(L + RING_OFF, g, S, E);
    }
    xcd_barrier(bar); TSTAMP();

    asm volatile("; ===== PHASE 4 =====");
    if (PH(4)) for (int rep = 0; rep < NREP(4); ++rep) {
        PH_LANES; const bool dummy = rep < NREP(4) - 1; (void)dummy;
        pg8::Gemm g{1024, 1024, 1024}; pg8::StaticOrder S; S.init(SGA, 1024, WmT, 1024, T, 1024, G, bx);
        pg8::EpiResNorm<true> E{x, A, SSQ1, 1024, 1.f};
        pg8::gemm_phase<pg8::EpiResNorm<true>, pg8::StaticOrder, true>(L + RING_OFF, g, S, E);
    }
    xcd_barrier(bar); TSTAMP();

    asm volatile("; ===== PHASE 6 =====");
    if (PH(6)) for (int rep = 0; rep < NREP(6); ++rep) {
        PH_LANES; const bool dummy = rep < NREP(6) - 1; (void)dummy;
        const pg8::Gemm gq{1024, 1024, 1024}, gs{1024, 1024, 256}, gv{1024, 4096, 256};
        const pg8::EpiBf16RS Eq{QX, 1024, SSQ1}; const pg8::EpiSoftmax Es{PM, 1024, 0.0625f * 1.4426950408889634f}; const pg8::EpiBf16 Ev{OX, 1024};
        { XOrder S{(const char*)A, (const char*)WxqT, G, vcu, 0, 0}; pg8::gemm_phase<pg8::EpiBf16RS, XOrder, false>(L + RING_OFF, gq, S, Eq); }
        VM_WAIT(); __syncthreads();
        { XOrder S{(const char*)QX, (const char*)KX, G, vcu, 0, 1}; pg8::gemm_phase<pg8::EpiSoftmax, XOrder, false>(L + RING_OFF, gs, S, Es); }
        VM_WAIT(); __syncthreads();
        { XOrder S{(const char*)PM, (const char*)VXT, G, vcu, 0, 2}; pg8::gemm_phase<pg8::EpiBf16, XOrder, false>(L + RING_OFF, gv, S, Ev); }
        VM_WAIT(); __syncthreads();
        { XOrder S{(const char*)A, (const char*)WxqT, G, vcu, 1, 0}; pg8::gemm_phase<pg8::EpiBf16RS, XOrder, false>(L + RING_OFF, gq, S, Eq); }
        VM_WAIT(); __syncthreads();
        { XOrder S{(const char*)QX, (const char*)KX, G, vcu, 1, 1}; pg8::gemm_phase<pg8::EpiSoftmax, XOrder, false>(L + RING_OFF, gs, S, Es); }
        VM_WAIT(); __syncthreads();
        { XOrder S{(const char*)PM, (const char*)VXT, G, vcu, 1, 2}; pg8::gemm_phase<pg8::EpiBf16, XOrder, false>(L + RING_OFF, gv, S, Ev); }
    }
    xcd_barrier(bar); TSTAMP();

    asm volatile("; ===== PHASE 9 =====");
    if (PH(9)) for (int rep = 0; rep < NREP(9); ++rep) {
        PH_LANES; const bool dummy = rep < NREP(9) - 1; (void)dummy;
        pg8::Gemm g{1024, 1024, 1024}; pg8::StaticOrder S; S.init(OX, 1024, WxoT, 1024, T, 1024, G, bx);
        pg8::EpiResNorm<false> E{nullptr, A, SSQ2, 1024, dummy ? 0.f : 1.f};
        pg8::gemm_phase<pg8::EpiResNorm<false>, pg8::StaticOrder, true>(L + RING_OFF, g, S, E);
    }
    xcd_barrier(bar); TSTAMP();

    asm volatile("; ===== PHASE 11 =====");
    if (PH(11)) for (int rep = 0; rep < NREP(11); ++rep) {
        PH_LANES; const bool dummy = rep < NREP(11) - 1; (void)dummy;
        pg8::Gemm g{1024, 1024, 1024}; pg8::StaticOrder S; S.init(A, 1024, MT, 1024, T, 2048, G, bx);
        pg8::EpiF16RS E{SC, 2048, SSQ2};
        pg8::gemm_phase<pg8::EpiF16RS, pg8::StaticOrder, true>(L + RING_OFF, g, S, E);
    }
    xcd_barrier(bar); TSTAMP();

    asm volatile("; ===== PHASE 12 =====");
    if (PH(12)) for (int rep = 0; rep < NREP(12); ++rep) {
        PH_LANES; const bool dummy = rep < NREP(12) - 1; (void)dummy;
        typedef _Float16 h8 __attribute__((ext_vector_type(8)));
#define RCE(a, b) do { const float hi_ = fmax_asm(a, b); b = fmin_asm(a, b); a = hi_; } while (0)
#define RSORT16(K) do { RCE(K[0], K[1]); RCE(K[3], K[2]); RCE(K[4], K[5]); RCE(K[7], K[6]); RCE(K[8], K[9]); RCE(K[11], K[10]); RCE(K[12], K[13]); RCE(K[15], K[14]); RCE(K[0], K[2]); RCE(K[1], K[3]); RCE(K[6], K[4]); RCE(K[7], K[5]); RCE(K[8], K[10]); RCE(K[9], K[11]); RCE(K[14], K[12]); RCE(K[15], K[13]); RCE(K[0], K[1]); RCE(K[2], K[3]); RCE(K[5], K[4]); RCE(K[7], K[6]); RCE(K[8], K[9]); RCE(K[10], K[11]); RCE(K[13], K[12]); RCE(K[15], K[14]); RCE(K[0], K[4]); RCE(K[1], K[5]); RCE(K[2], K[6]); RCE(K[3], K[7]); RCE(K[12], K[8]); RCE(K[13], K[9]); RCE(K[14], K[10]); RCE(K[15], K[11]); RCE(K[0], K[2]); RCE(K[1], K[3]); RCE(K[4], K[6]); RCE(K[5], K[7]); RCE(K[10], K[8]); RCE(K[11], K[9]); RCE(K[14], K[12]); RCE(K[15], K[13]); RCE(K[0], K[1]); RCE(K[2], K[3]); RCE(K[4], K[5]); RCE(K[6], K[7]); RCE(K[9], K[8]); RCE(K[11], K[10]); RCE(K[13], K[12]); RCE(K[15], K[14]); RCE(K[0], K[8]); RCE(K[1], K[9]); RCE(K[2], K[10]); RCE(K[3], K[11]); RCE(K[4], K[12]); RCE(K[5], K[13]); RCE(K[6], K[14]); RCE(K[7], K[15]); RCE(K[0], K[4]); RCE(K[1], K[5]); RCE(K[2], K[6]); RCE(K[3], K[7]); RCE(K[8], K[12]); RCE(K[9], K[13]); RCE(K[10], K[14]); RCE(K[11], K[15]); RCE(K[0], K[2]); RCE(K[1], K[3]); RCE(K[4], K[6]); RCE(K[5], K[7]); RCE(K[8], K[10]); RCE(K[9], K[11]); RCE(K[12], K[14]); RCE(K[13], K[15]); RCE(K[0], K[1]); RCE(K[2], K[3]); RCE(K[4], K[5]); RCE(K[6], K[7]); RCE(K[8], K[9]); RCE(K[10], K[11]); RCE(K[12], K[13]); RCE(K[14], K[15]); } while (0)
#define RMERGE16(K) do { RCE(K[0], K[8]); RCE(K[1], K[9]); RCE(K[2], K[10]); RCE(K[3], K[11]); RCE(K[4], K[12]); RCE(K[5], K[13]); RCE(K[6], K[14]); RCE(K[7], K[15]); RCE(K[0], K[4]); RCE(K[1], K[5]); RCE(K[2], K[6]); RCE(K[3], K[7]); RCE(K[8], K[12]); RCE(K[9], K[13]); RCE(K[10], K[14]); RCE(K[11], K[15]); RCE(K[0], K[2]); RCE(K[1], K[3]); RCE(K[4], K[6]); RCE(K[5], K[7]); RCE(K[8], K[10]); RCE(K[9], K[11]); RCE(K[12], K[14]); RCE(K[13], K[15]); RCE(K[0], K[1]); RCE(K[2], K[3]); RCE(K[4], K[5]); RCE(K[6], K[7]); RCE(K[8], K[9]); RCE(K[10], K[11]); RCE(K[12], K[13]); RCE(K[14], K[15]); } while (0)
#define RKEYS(K, V0, V1, IDB) do { _Pragma("unroll") for (int e = 0; e < 8; ++e) { K[e] = __uint_as_float(__float_as_uint((float)V0[e]) | (unsigned)((IDB) + e)); K[8 + e] = __uint_as_float(__float_as_uint((float)V1[e]) | (unsigned)((IDB) + 8 + e)); } } while (0)
        for (int tb4 = gw * 4; tb4 < T; tb4 += NGW * 4) {
            v4u r0[4], r1[4]; float sq[4];
#pragma unroll
            for (int i = 0; i < 4; ++i) { const GAS v4u* ar = (const GAS v4u*)(A + (size_t)(tb4 + i) * D + 16 * lane); r0[i] = ar[0]; r1[i] = ar[1]; sq[i] = lane < 16 ? SSQ2[(size_t)(tb4 + i) * 16 + lane] : 0.f; }
#pragma unroll
            for (int i = 0; i < 4; ++i) {
                float a[16];
                a[0] = bflo(r0[i].x); a[1] = bfhi(r0[i].x); a[2] = bflo(r0[i].y); a[3] = bfhi(r0[i].y); a[4] = bflo(r0[i].z); a[5] = bfhi(r0[i].z); a[6] = bflo(r0[i].w); a[7] = bfhi(r0[i].w);
                a[8] = bflo(r1[i].x); a[9] = bfhi(r1[i].x); a[10] = bflo(r1[i].y); a[11] = bfhi(r1[i].y); a[12] = bflo(r1[i].z); a[13] = bfhi(r1[i].z); a[14] = bflo(r1[i].w); a[15] = bfhi(r1[i].w);
                float amx = 0.f;
#pragma unroll
                for (int k = 0; k < 16; ++k) amx = fmaxf(amx, fabsf(a[k]));
                amx = wave_max(amx);
                const float rs2 = rsqrtf(wave_sum(sq[i]) * (1.f / 1024.f) + RMS_EPS);
                const float asc = amx > 0.f ? 127.f / amx : 1.f;
                v4u qv;
#define QP4(k) (((unsigned)(int)rintf(a[4 * (k)] * asc) & 255u) | (((unsigned)(int)rintf(a[4 * (k) + 1] * asc) & 255u) << 8) | (((unsigned)(int)rintf(a[4 * (k) + 2] * asc) & 255u) << 16) | (((unsigned)(int)rintf(a[4 * (k) + 3] * asc) & 255u) << 24))
                qv.x = QP4(0); qv.y = QP4(1); qv.z = QP4(2); qv.w = QP4(3);
#undef QP4
                *(GAS v4u*)(A8I + (size_t)(tb4 + i) * 1024 + 16 * lane) = qv;
                if (lane == 0) ASC[tb4 + i] = (amx > 0.f ? amx * (1.f / 127.f) : 1.f) * rs2;
            }
        }
        LAS unsigned char* idl = L + RING_OFF + tid * 32;
        for (int task = gt; task < T * 8; task += NGT) {
            const int t = task >> 3, h = task & 7;
            const _Float16* row = SC + (size_t)t * 2048 + h * 256;
            float LA[16], LB[16];
#pragma unroll 1
            for (int p = 0; p < 2; ++p) {
                const _Float16* rp = row + p * 128;
                float Tk[16];
                h8 n0 = *(const h8*)(rp + 16), n1 = *(const h8*)(rp + 24);
                { const h8 v0 = *(const h8*)rp, v1 = *(const h8*)(rp + 8); RKEYS(Tk, v0, v1, 0); RSORT16(Tk); }
#pragma unroll 1
                for (int c = 1; c < 8; ++c) {
                    const h8 v0 = n0, v1 = n1;
                    { const int cn = c < 7 ? c + 1 : c; n0 = *(const h8*)(rp + cn * 16); n1 = *(const h8*)(rp + cn * 16 + 8); }
                    float K[16]; RKEYS(K, v0, v1, c * 16); RSORT16(K);
#pragma unroll
                    for (int i = 0; i < 16; ++i) Tk[i] = fmax_asm(Tk[i], K[15 - i]);
                    RMERGE16(Tk);
                }
#pragma unroll
                for (int k = 0; k < 16; ++k) { if (p == 0) LA[k] = Tk[k]; else LB[k] = Tk[k]; }
            }
#pragma unroll
            for (int k = 0; k < 16; k += 4) {
                ((LAS unsigned*)idl)[k >> 2] = (__float_as_uint(LA[k]) & 127u) | ((__float_as_uint(LA[k + 1]) & 127u) << 8) | ((__float_as_uint(LA[k + 2]) & 127u) << 16) | ((__float_as_uint(LA[k + 3]) & 127u) << 24);
                ((LAS unsigned*)idl)[4 + (k >> 2)] = (__float_as_uint(LB[k]) & 127u) | ((__float_as_uint(LB[k + 1]) & 127u) << 8) | ((__float_as_uint(LB[k + 2]) & 127u) << 16) | ((__float_as_uint(LB[k + 3]) & 127u) << 24);
            }
#define CKEY(a, b) __uint_as_float((__float_as_uint(LA[a] + LB[b]) & ~255u) | (unsigned)(255 - (16 * (a) + (b))))
            float Ck[16];
#pragma unroll
            for (int a = 0; a < 16; ++a) Ck[a] = CKEY(a, 0);
#define CRUN(b, n) do { _Pragma("unroll") for (int j = 0; j < (n); ++j) Ck[15 - j] = fmax_asm(Ck[15 - j], CKEY(j, b)); RMERGE16(Ck); } while (0)
            CRUN(1, 8); CRUN(2, 5); CRUN(3, 4); CRUN(4, 3); CRUN(5, 2); CRUN(6, 2); CRUN(7, 2);
#pragma unroll
            for (int j = 0; j < 8; ++j) Ck[15 - j] = fmax_asm(Ck[15 - j], CKEY(0, 8 + j));
            RMERGE16(Ck);
#undef CRUN
#undef CKEY
            LDS_WAIT();
            float ex[16]; float sum = 0.f;
#pragma unroll
            for (int k = 0; k < 16; ++k) { ex[k] = __expf(Ck[k] - Ck[0]); sum += ex[k]; }
            const float rs = 1.f / sum;
            int* eo = EIDX + (size_t)t * 128 + h * 16;
#pragma unroll
            for (int k = 0; k < 16; k += 4) {
                int ev[4];
#pragma unroll
                for (int j = 0; j < 4; ++j) { const unsigned id = 255u - (__float_as_uint(Ck[k + j]) & 255u); ev[j] = (int)idl[id >> 4] * 128 + (int)idl[16 + (id & 15u)]; }
                *(GAS v4u*)(eo + k) = (v4u){(pk2(0.f, ex[k] * rs) & 0xffff0000u) | (unsigned)ev[0], (pk2(0.f, ex[k + 1] * rs) & 0xffff0000u) | (unsigned)ev[1],
                                             (pk2(0.f, ex[k + 2] * rs) & 0xffff0000u) | (unsigned)ev[2], (pk2(0.f, ex[k + 3] * rs) & 0xffff0000u) | (unsigned)ev[3]};
            }
            LDS_WAIT();
        }
#undef RCE
#undef RSORT16
#undef RMERGE16
#undef RKEYS
    }
    xcd_barrier(bar); TSTAMP();

    asm volatile("; ===== PHASE 13 =====");
    if (PH(13)) for (int rep = 0; rep < NREP(13); ++rep) {
        PH_LANES; const bool dummy = rep < NREP(13) - 1; (void)dummy;
        volatile LAS unsigned* qslot = (volatile LAS unsigned*)(L + LDSCTL_OFF + 64);
        LAS unsigned char* tile = L + RING_OFF + wave * 8192;
        LAS float* rsl = (LAS float*)(L + UL_OFF + wave * UL_WAVE);
        LAS v2u* lst = (LAS v2u*)(L + UL_OFF + wave * UL_WAVE + 64);
        const int xs = (int)(xb_xcc_id() & 7u);
        __syncthreads();
        if (tid == 0) *qslot = __hip_atomic_fetch_add((unsigned*)(ctl + CW_Q + 64 * (rep * 8 + xs)), 1u, __ATOMIC_RELAXED, __HIP_MEMORY_SCOPE_AGENT);
        __syncthreads();
        const int rank = __builtin_amdgcn_readfirstlane((int)*qslot);
        int cnt[8];
#pragma unroll
        for (int j = 0; j < 8; ++j) cnt[j] = __builtin_amdgcn_readfirstlane((int)(xb_ld(bar.bar + XB_XCNT(j)) + xb_ld(bar.bar + XB_XCNT(j + 8))));
#pragma unroll 1
        for (int x = 0; x < 8; ++x) {
            int cn = 0;
#pragma unroll
            for (int j = 0; j < 8; ++j) cn = (j == x) ? cnt[j] : cn;
            int j0, jstep;
            if (x == xs) { j0 = rank * 8 + wave; jstep = cn * 8; } else if (cn == 0) { j0 = bx * 8 + wave; jstep = G * 8; } else continue;
#pragma unroll 1
            for (int job = j0; job < T / 8; job += jstep) {
                const int t0 = job * 8;
#pragma unroll 1
                for (int r0 = 0;; r0 += UL_CAP) {
                    int ln = lane; asm volatile("" : "+v"(ln));
#pragma unroll
                    for (int tl = 0; tl < 8; ++tl)
                        __builtin_amdgcn_global_load_lds((const unsigned*)(A8I + (size_t)(t0 + tl) * 1024 + ln * 16), (LAS unsigned*)(tile + tl * 1024), 16, 0, 0);
                    if (ln < 8) rsl[ln] = ASC[t0 + ln];
                    unsigned pa[8], pb[8];
#pragma unroll
                    for (int tl = 0; tl < 8; ++tl) { pa[tl] = (unsigned)EIDX[(size_t)(t0 + tl) * 128 + ln]; pb[tl] = (unsigned)EIDX[(size_t)(t0 + tl) * 128 + 64 + ln]; }
                    int total = 0; unsigned long long m0s[8], m1s[8];
#pragma unroll
                    for (int tl = 0; tl < 8; ++tl) { m0s[tl] = __ballot((int)((pa[tl] & 0xffffu) >> 11) == x); m1s[tl] = __ballot((int)((pb[tl] & 0xffffu) >> 11) == x); total += __popcll(m0s[tl]) + __popcll(m1s[tl]); }
                    asm volatile("s_waitcnt vmcnt(0)" ::: "memory");
                    int base = -r0;
#pragma unroll
                    for (int tl = 0; tl < 8; ++tl) {
                        const int n0 = __popcll(m0s[tl]), n1 = __popcll(m1s[tl]);
                        const int k0 = base + (int)__builtin_amdgcn_mbcnt_hi((unsigned)(m0s[tl] >> 32), __builtin_amdgcn_mbcnt_lo((unsigned)m0s[tl], 0u));
                        const int k1 = base + n0 + (int)__builtin_amdgcn_mbcnt_hi((unsigned)(m1s[tl] >> 32), __builtin_amdgcn_mbcnt_lo((unsigned)m1s[tl], 0u));
                        if (((m0s[tl] >> lane) & 1ull) && k0 >= 0 && k0 < UL_CAP) lst[k0] = (v2u){pa[tl], (unsigned)((tl << 7) | lane)};
                        if (((m1s[tl] >> lane) & 1ull) && k1 >= 0 && k1 < UL_CAP) lst[k1] = (v2u){pb[tl], (unsigned)((tl << 7) | 64 | lane)};
                        base += n0 + n1;
                    }
                    const int count = (total - r0) < UL_CAP ? (total - r0) : UL_CAP;
                    asm volatile("s_waitcnt lgkmcnt(0)" ::: "memory");
#define JLOAD(Q, EN, B16) do { const int myi_ = (B16) + (lane >> 2); EN = lst[myi_ < count ? myi_ : count - 1];         \
                        const unsigned char* rp_ = U8 + (size_t)(EN.x & 0xffffu) * 1024 + (lane & 3) * 16; \
                        EN##s = *(const GAS v2f*)(SU + 2 * (EN.x & 0xffffu));                                        \
                        _Pragma("unroll") for (int j = 0; j < 16; ++j) Q[j] = *(const GAS v4u*)(rp_ + j * 64); } while (0)
#define JCOMP(Q, EN, B16) do { const LAS unsigned char* ap_ = tile + (EN.y >> 7) * 1024 + (lane & 3) * 16; int d0 = 0, d1 = 0, d2 = 0, d3 = 0; \
                        _Pragma("unroll") for (int j = 0; j < 16; ++j) { const v4u qa_ = *(const LAS v4u*)(ap_ + j * 64); \
                            d0 = __builtin_amdgcn_sdot4((int)Q[j].x, (int)qa_.x, d0, false); d1 = __builtin_amdgcn_sdot4((int)Q[j].y, (int)qa_.y, d1, false); \
                            d2 = __builtin_amdgcn_sdot4((int)Q[j].z, (int)qa_.z, d2, false); d3 = __builtin_amdgcn_sdot4((int)Q[j].w, (int)qa_.w, d3, false); } \
                        int doti = (d0 + d1) + (d2 + d3); \
                        doti += __builtin_amdgcn_ds_swizzle(doti, (1 << 10) | 0x1f); doti += __builtin_amdgcn_ds_swizzle(doti, (2 << 10) | 0x1f);        \
                        if ((lane & 3) == 0 && (B16) + (lane >> 2) < count) { \
                            const int e = (int)(EN.x & 0xffffu), slot = (int)(EN.y & 127u); const int t = t0 + (int)(EN.y >> 7); \
                            const float act = (float)doti * (EN##s.x * rsl[EN.y >> 7]); const float u3 = 0.7978845608028654f * (act + 0.044715f * act * act * act); \
                            const float wv = act * __builtin_amdgcn_rcpf(1.f + __expf(-2.f * u3)) * (__uint_as_float(EN.x & 0xffff0000u) * EN##s.y);             \
                            PW[((size_t)((t >> 6) * 8 + (slot >> 4)) * 4 + ((slot >> 2) & 3)) * 256 + (t & 63) * 4 + (slot & 3)] = ((unsigned)__builtin_bit_cast(unsigned short, (_Float16)wv) << 16) | (unsigned)e;     } } while (0)
                    if (count > 0) {
                        v4u qa[16], qb[16]; v2u ena, enb; v2f enas, enbs;
                        JLOAD(qa, ena, 0);
#pragma unroll 1
                        for (int b16 = 0; b16 < count; b16 += 32) {
                            const bool has_b = b16 + 16 < count;
                            if (has_b) JLOAD(qb, enb, b16 + 16);
                            JCOMP(qa, ena, b16);
                            if (has_b) { if (b16 + 32 < count) JLOAD(qa, ena, b16 + 32); JCOMP(qb, enb, b16 + 16); }
                        }
                    }
#undef JLOAD
#undef JCOMP
                    asm volatile("s_waitcnt lgkmcnt(0)" ::: "memory");
                    if (r0 + UL_CAP >= total) break;
                }
            }
        }
        __syncthreads();
    }
    xcd_barrier(bar); TSTAMP();

    asm volatile("; ===== PHASE 14 =====");
    if (PH(14)) for (int rep = 0; rep < NREP(14); ++rep) {
        PH_LANES; const bool dummy = rep < NREP(14) - 1; (void)dummy;
        for (int item = vcu; item < 256; item += G) {
            const int sl = item & 127, half = item >> 7;
            __syncthreads();
#pragma unroll
            for (int i = 0; i < 16; ++i) *(LAS v4u*)(L + RING_OFF + (i * 512 + tid) * 16) = *(const GAS v4u*)(V8T + (size_t)sl * 131072 + (size_t)(i * 512 + tid) * 16);
            __syncthreads();
            const GAS v4u* pwb = (const GAS v4u*)(PW + (size_t)(half * 256 + wave) * 8192) + lane;
            v4u buf[4][4];
#pragma unroll
            for (int c = 0; c < 4; ++c)
#pragma unroll
                for (int k = 0; k < 4; ++k) buf[c][k] = pwb[c * 256 + k * 64];
#pragma unroll 1
            for (int itk = 0; itk < 32; ++itk) {
                const int g64 = half * 256 + itk * 8 + wave;
                const int t = g64 * 64 + lane;
                unsigned accu[4] = {0u, 0u, 0u, 0u};
#pragma unroll
                for (int c = 0; c < 8; ++c) {
                    v4u cur[4];
#pragma unroll
                    for (int k = 0; k < 4; ++k) cur[k] = buf[c & 3][k];
                    { const int sn = itk * 8 + c + 4; const int gn = (sn >> 3) > 31 ? 31 : (sn >> 3), cc = sn & 7; const GAS v4u* src = pwb + (size_t)gn * 8 * 2048 + cc * 256;
#pragma unroll
                      for (int k = 0; k < 4; ++k) buf[c & 3][k] = src[k * 64]; }
                    v2u tb[16];
#pragma unroll
                    for (int k = 0; k < 4; ++k)
#pragma unroll
                        for (int i = 0; i < 4; ++i) { unsigned e_ = cur[k][i] & 0xffffu; asm("" : "+v"(e_));
                            tb[k * 4 + i] = *(const LAS v2u*)(L + RING_OFF + (e_ << 3)); }
#pragma unroll
                    for (int k = 0; k < 4; ++k)
#pragma unroll
                        for (int i = 0; i < 4; ++i) { const unsigned p = cur[k][i]; const v2u q = tb[k * 4 + i];
#define VFMA(ACC, T) asm("v_pk_fma_f16 %0, %1, %2, %0 op_sel:[0,1,0] op_sel_hi:[1,1,1]" : "+v"(ACC) : "v"(T), "v"(p))
                            const unsigned t0_ = __builtin_amdgcn_perm(0u, q.x, 0x010c000cu), t1_ = __builtin_amdgcn_perm(0u, q.x, 0x030c020cu), t2_ = __builtin_amdgcn_perm(0u, q.y, 0x010c000cu), t3_ = __builtin_amdgcn_perm(0u, q.y, 0x030c020cu);
                            VFMA(accu[0], t0_); VFMA(accu[1], t1_); VFMA(accu[2], t2_); VFMA(accu[3], t3_);
#undef VFMA
                        }
                }
                GAS v4u* hr = (GAS v4u*)(A + (size_t)t * D + sl * 8);
                const v4u hq = *hr; const float mulv = dummy ? 0.f : 1.f;
                h2v acc[4];
#pragma unroll
                for (int i = 0; i < 4; ++i) { const unsigned au_ = accu[i]; acc[i] = __builtin_bit_cast(h2v, au_); }
                v4u ho; ho.x = pk2(bflo(hq.x) + (float)acc[0].x * mulv, bfhi(hq.x) + (float)acc[0].y * mulv); ho.y = pk2(bflo(hq.y) + (float)acc[1].x * mulv, bfhi(hq.y) + (float)acc[1].y * mulv);
                ho.z = pk2(bflo(hq.z) + (float)acc[2].x * mulv, bfhi(hq.z) + (float)acc[2].y * mulv); ho.w = pk2(bflo(hq.w) + (float)acc[3].x * mulv, bfhi(hq.w) + (float)acc[3].y * mulv);
                *hr = ho;
            }
        }
    }
    xcd_barrier(bar); TSTAMP();

#ifdef EXTRA_BARRIERS
    for (int eb = 0; eb < EXTRA_BARRIERS; ++eb) xcd_barrier(bar);
#endif
    asm volatile("; ===== PHASE 15 =====");
    if (PH(15)) for (int rep = 0; rep < NREP(15); ++rep) {
        PH_LANES; const bool dummy = rep < NREP(15) - 1; (void)dummy;
        for (int t = gw; t < T; t += NGW) {
            const GAS v4u* hr = (const GAS v4u*)(A + (size_t)t * D + 16 * lane); const v4u q0 = hr[0], q1 = hr[1];
            const GAS f32x4* gr = (const GAS f32x4*)(g_final + 16 * lane); GAS f32x4* orow = (GAS f32x4*)(out + (size_t)t * D + 16 * lane);
            f32x4 o[4] = {(f32x4){bflo(q0.x), bfhi(q0.x), bflo(q0.y), bfhi(q0.y)}, (f32x4){bflo(q0.z), bfhi(q0.z), bflo(q0.w), bfhi(q0.w)},
                          (f32x4){bflo(q1.x), bfhi(q1.x), bflo(q1.y), bfhi(q1.y)}, (f32x4){bflo(q1.z), bfhi(q1.z), bflo(q1.w), bfhi(q1.w)}};
            float ss = 0.f;
#pragma unroll
            for (int j = 0; j < 4; ++j) ss += (o[j].x * o[j].x + o[j].y * o[j].y) + (o[j].z * o[j].z + o[j].w * o[j].w);
            const float r = rsqrtf(wave_sum(ss) * (1.f / 1024.f) + RMS_EPS);
#pragma unroll
            for (int j = 0; j < 4; ++j) orow[j] = o[j] * r * gr[j];
        }
    }
}

extern "C" void kernel_launch(void* const* d_in, const int* in_sizes, int n_in, void* d_out, int out_size, void* d_ws, size_t ws_size, hipStream_t stream) {
    static int grid = 0;
    if (grid == 0) {
        if (n_in != 19 || out_size != T * D || ws_size < WS_END) { fprintf(stderr, "kernel_launch: unexpected problem (n_in %d, out %d, ws %zu < %zu); nothing launched\n", n_in, out_size, ws_size, (size_t)WS_END); grid = -1; return; }
        int dev = 0, cus = 0, per_cu = 0;
        if (hipGetDevice(&dev) != hipSuccess || hipDeviceGetAttribute(&cus, hipDeviceAttributeMultiprocessorCount, dev) != hipSuccess) { grid = -1; return; }
        if (hipFuncSetAttribute((const void*)mk_fwd, hipFuncAttributeMaxDynamicSharedMemorySize, LDS_BYTES) != hipSuccess) { fprintf(stderr, "kernel_launch: hipFuncSetAttribute failed\n"); grid = -1; return; }
        if (hipOccupancyMaxActiveBlocksPerMultiprocessor(&per_cu, (const void*)mk_fwd, NWAVES * 64, LDS_BYTES) != hipSuccess || per_cu < 1) { fprintf(stderr, "kernel_launch: occupancy query says %d blocks per CU\n", per_cu); }
        (void)hipGetLastError();
        grid = cus;
    }
    if (grid < 0) return;
    if (hipMemsetAsync((char*)d_ws + WS_CTL, 0, CTL_ZERO_BYTES, stream) != hipSuccess) return;
    Args a{};
    for (int i = 0; i < 19; ++i) a.in[i] = (const float*)d_in[i];
    a.out = (float*)d_out; a.ws = (unsigned char*)d_ws;
    hipLaunchKernelGGL(mk_fwd, dim3(grid), dim3(NWAVES * 64), LDS_BYTES, stream, a);
}
```

```cpp
#include <hip/hip_runtime.h>
#include <hip/hip_bf16.h>
#include <cstdio>
#include <cstdint>
#include <cmath>

#ifndef DIAG
#define DIAG 0
#endif


template <int O> __device__ __forceinline__ float shx(float v) { static_assert(O > 0 && O < 32, "shx"); return __uint_as_float((unsigned)__builtin_amdgcn_ds_swizzle((int)__float_as_uint(v), (O << 10) | 0x1f)); }
__device__ __forceinline__ float sum32(float v) { auto r = __builtin_amdgcn_permlane32_swap(__float_as_uint(v), __float_as_uint(v), false, false); return __uint_as_float(r[0]) + __uint_as_float(r[1]); }
__device__ __forceinline__ float max32(float v) { auto r = __builtin_amdgcn_permlane32_swap(__float_as_uint(v), __float_as_uint(v), false, false); return fmaxf(__uint_as_float(r[0]), __uint_as_float(r[1])); }
__device__ __forceinline__ float wave_max(float v) { v = fmaxf(v, shx<1>(v)); v = fmaxf(v, shx<2>(v)); v = fmaxf(v, shx<4>(v)); v = fmaxf(v, shx<8>(v)); v = fmaxf(v, shx<16>(v)); return max32(v); }
__device__ __forceinline__ float wave_sum(float v) { v += shx<1>(v); v += shx<2>(v); v += shx<4>(v); v += shx<8>(v); v += shx<16>(v); return sum32(v); }

namespace pg8 {
#define PG8_LAS __attribute__((address_space(3)))
typedef unsigned short bf16_t;
typedef short bf16x8 __attribute__((ext_vector_type(8)));
typedef float f32x4 __attribute__((ext_vector_type(4)));
typedef float f32x2 __attribute__((ext_vector_type(2)));
typedef unsigned u32x4 __attribute__((ext_vector_type(4)));
typedef unsigned u32x2 __attribute__((ext_vector_type(2)));
constexpr int BM = 256, BK = 64, HALF = 128, HTB = HALF * BK * 2  , STAGE_BYTES = 8 * HTB, NXCD = 8, WGM = 4;

__host__ __device__ __forceinline__ int lds_byte(int r, int c) { const int st = (r >> 4) * 2 + (c >> 5), rr = r & 15, cc = c & 31, ob = rr * 64 + cc * 2; return st * 1024 + (ob ^ (((ob >> 9) & 1) << 5)); }
__host__ __device__ __forceinline__ void stage_rc(int b, int& R, int& C) { const int st = b / 1024, sb = b % 1024, swz = sb ^ (((sb >> 9) & 1) << 5); R = (st >> 1) * 16 + swz / 64; C = (st & 1) * 32 + (swz % 64) / 2; }
__host__ __device__ __forceinline__ int perm32(int rho) { const int n = rho >> 4, i = rho & 15; return 8 * (i >> 2) + 4 * n + (i & 3); }

struct Unit { int pm, pn; const char* a; const char* b; };
struct Gemm { int lda, ldb, K; };

struct StaticOrder {
    int nM, nN, nwg, G, c; const char* A; const char* Bt; size_t astep, bstep;
    __device__ void init(const void* A_, int lda, const void* Bt_, int ldb, int M, int N, int G_, int c_) { nM = M / BM; nN = N / BM; nwg = nM * nN; G = G_; c = c_; A = (const char*)A_; Bt = (const char*)Bt_; astep = (size_t)BM * lda * 2; bstep = (size_t)BM * ldb * 2; }
    __device__ bool next(int i, Unit& u) const {
        const long L = (long)i * G + c; if (L >= nwg) return false;
        int wgid = (int)L; { const int q = nwg / NXCD, r = nwg % NXCD, xcd = wgid % NXCD, off = wgid / NXCD; wgid = (xcd < r ? xcd * (q + 1) : r * (q + 1) + (xcd - r) * q) + off; }
        const int nig = WGM * nN, gid = wgid / nig, fm = gid * WGM, gsz = (nM - fm) < WGM ? (nM - fm) : WGM;
        u.pm = fm + ((wgid % nig) % gsz); u.pn = (wgid % nig) / gsz; u.a = A + (size_t)u.pm * astep; u.b = Bt + (size_t)u.pn * bstep; return true;
    }
};

__device__ __forceinline__ unsigned cvt_pk_bf16(float lo, float hi) { typedef __bf16 bf2 __attribute__((ext_vector_type(2))); f32x2 v = {lo, hi}; bf2 b = __builtin_convertvector(v, bf2); return __builtin_bit_cast(unsigned, b); }
__device__ __forceinline__ float bf_lo(unsigned u) { return __uint_as_float(u << 16); }
__device__ __forceinline__ float bf_hi(unsigned u) { return __uint_as_float(u & 0xffff0000u); }

template <class Epi, class Sched, bool ALIGN_EPI>
__device__ __forceinline__ void gemm_phase(PG8_LAS unsigned char* lds, const Gemm g, const Sched& S, const Epi& E) {
    int tid = threadIdx.x; asm volatile("" : "+v"(tid));
    const int wid = __builtin_amdgcn_readfirstlane(tid >> 6), lane = tid & 63, wr = wid >> 2, wc = wid & 3, fr = lane & 15, fq = lane >> 4;
    const int K = g.K, nt = K / BK;
    unsigned voffA[2], voffB[2];
#pragma unroll
    for (int i = 0; i < 2; ++i) { int R, C; stage_rc(tid * 16 + i * 8192, R, C); const int Rb = Epi::PERM ? ((R & ~31) + perm32(R & 31)) : R;
        voffA[i] = (unsigned)(R * g.lda + C) * 2u; voffB[i] = (unsigned)(Rb * g.ldb + C) * 2u; }
    const size_t kstep = (size_t)(BK * 2);
    const size_t hstepA = (size_t)HALF * g.lda * 2, hstepB = (size_t)HALF * g.ldb * 2;
    const unsigned ldsw = (unsigned)wid * 1024u;
    const int aoff = lds_byte(wr * 64 + fr, fq * 8), boff = lds_byte(wc * 32 + fr, fq * 8);
#define PG8_SA(b, h) (((b) * 2 + (h)) * HTB)
#define PG8_SB(b, h) ((4 + (b) * 2 + (h)) * HTB)
#define PG8_STAGE(bufoff, gbase, voff) do { _Pragma("unroll") for (int _i = 0; _i < 2; ++_i) \
        __builtin_amdgcn_global_load_lds((const unsigned*)((const char*)(gbase) + (voff)[_i]), (PG8_LAS unsigned*)(lds + (bufoff) + ldsw + _i * 8192), 16, 0, 0); } while (0)
#define PG8_LDA(dst, b, h) do { _Pragma("unroll") for (int m = 0; m < 4; ++m) _Pragma("unroll") for (int k = 0; k < 2; ++k) dst[m][k] = *(const PG8_LAS bf16x8*)(lds + PG8_SA(b, h) + aoff + m * 2048 + k * 1024); } while (0)
#define PG8_LDB(dst, b, h) do { _Pragma("unroll") for (int n = 0; n < 2; ++n) _Pragma("unroll") for (int k = 0; k < 2; ++k) dst[n][k] = *(const PG8_LAS bf16x8*)(lds + PG8_SB(b, h) + boff + n * 2048 + k * 1024); } while (0)
#define PG8_MMA(ai, bj, At, Bt) do { __builtin_amdgcn_s_setprio(1); _Pragma("unroll") for (int m = 0; m < 4; ++m) _Pragma("unroll") for (int n = 0; n < 2; ++n) _Pragma("unroll") for (int k = 0; k < 2; ++k) \
        acc[ai][bj][m][n] = __builtin_amdgcn_mfma_f32_16x16x32_bf16(Bt[n][k], At[m][k], acc[ai][bj][m][n], 0, 0, 0); __builtin_amdgcn_s_setprio(0); } while (0)
#define PG8_WAIT_V(n) asm volatile("s_waitcnt vmcnt(" #n ")" ::: "memory")
#define PG8_WAIT_L(n) asm volatile("s_waitcnt lgkmcnt(" #n ")" ::: "memory")
#define PG8_BAR __builtin_amdgcn_s_barrier()
#define PG8_SCHED __builtin_amdgcn_sched_barrier(0)
    Unit cur, nxt; int ui = 0;
    if (!S.next(0, cur)) return;
    f32x4 acc[2][2][4][2];
#pragma unroll
    for (int a = 0; a < 2; ++a)
#pragma unroll
        for (int b = 0; b < 2; ++b)
#pragma unroll
            for (int m = 0; m < 4; ++m)
#pragma unroll
                for (int n = 0; n < 2; ++n) acc[a][b][m][n] = (f32x4){0.f, 0.f, 0.f, 0.f};
    bf16x8 At[4][2], B0[2][2], B1[2][2];
    const char* cA = cur.a; const char* cB = cur.b;
    PG8_STAGE(PG8_SB(0, 0), cB, voffB); PG8_STAGE(PG8_SB(0, 1), cB + hstepB, voffB); PG8_STAGE(PG8_SA(0, 0), cA, voffA); PG8_STAGE(PG8_SA(0, 1), cA + hstepA, voffA);
    if (wr == 1) PG8_BAR;
    PG8_WAIT_V(2); PG8_BAR;
    PG8_STAGE(PG8_SB(1, 0), cB + kstep, voffB); PG8_STAGE(PG8_SA(1, 0), cA + kstep, voffA); PG8_STAGE(PG8_SB(1, 1), cB + hstepB + kstep, voffB);
    PG8_WAIT_V(6); PG8_BAR;
    for (;;) {
        const bool has_next = S.next(ui + 1, nxt);
        const char* nA = has_next ? nxt.a : cA; const char* nB = has_next ? nxt.b : cB;
        for (int t = 0; t < nt; t += 2) {
            const bool last = (t == nt - 2);
            const char* a1 = cA + (size_t)(t + 1) * kstep;
            const char* a2 = last ? nA : cA + (size_t)(t + 2) * kstep; const char* b2 = last ? nB : cB + (size_t)(t + 2) * kstep;
            const char* a3 = a2 + kstep; const char* b3 = b2 + kstep;
            PG8_LDB(B0, 0, 0); PG8_LDB(B1, 0, 1); PG8_SCHED; PG8_LDA(At, 0, 0); PG8_STAGE(PG8_SA(1, 1), a1 + hstepA, voffA);
            PG8_WAIT_V(8); PG8_WAIT_L(0); PG8_BAR; PG8_MMA(0, 0, At, B0); PG8_MMA(0, 1, At, B1); PG8_BAR; PG8_SCHED;
            PG8_LDA(At, 0, 1); PG8_STAGE(PG8_SB(0, 0), b2, voffB); PG8_STAGE(PG8_SB(0, 1), b2 + hstepB, voffB); PG8_STAGE(PG8_SA(0, 0), a2, voffA);
            PG8_WAIT_V(8); PG8_WAIT_L(0); PG8_BAR; PG8_MMA(1, 0, At, B0); PG8_MMA(1, 1, At, B1); PG8_BAR; PG8_SCHED;
            PG8_LDB(B0, 1, 0); PG8_LDB(B1, 1, 1); PG8_SCHED; PG8_LDA(At, 1, 0); PG8_STAGE(PG8_SA(0, 1), a2 + hstepA, voffA);
            PG8_WAIT_V(8); PG8_WAIT_L(0); PG8_BAR; PG8_MMA(0, 0, At, B0); PG8_MMA(0, 1, At, B1); PG8_BAR; PG8_SCHED;
            PG8_LDA(At, 1, 1); PG8_STAGE(PG8_SB(1, 0), b3, voffB); PG8_STAGE(PG8_SB(1, 1), b3 + hstepB, voffB); PG8_STAGE(PG8_SA(1, 0), a3, voffA);
            PG8_WAIT_V(8); PG8_WAIT_L(0); PG8_BAR; PG8_MMA(1, 0, At, B0); PG8_MMA(1, 1, At, B1); PG8_BAR; PG8_SCHED;
        }
        if constexpr (ALIGN_EPI) { if (wr == 0) PG8_BAR; }
        if constexpr (!Epi::AFTER_DRAIN) { E(acc, cur, wr, wc, fr, fq); }
        if (!has_next) break;
#pragma unroll
        for (int a = 0; a < 2; ++a)
#pragma unroll
            for (int b = 0; b < 2; ++b)
#pragma unroll
                for (int m = 0; m < 4; ++m)
#pragma unroll
                    for (int n = 0; n < 2; ++n) acc[a][b][m][n] = (f32x4){0.f, 0.f, 0.f, 0.f};
        cur = nxt; cA = nA; cB = nB; ++ui;
        if constexpr (ALIGN_EPI) { if (wr == 1) PG8_BAR; }
    }
    PG8_WAIT_V(0);
    if constexpr (!ALIGN_EPI) { if (wr == 0) PG8_BAR; }
    PG8_BAR;
    if constexpr (Epi::AFTER_DRAIN) { E.fused(acc, cur, wr, wc, fr, fq, lds, wid, lane); }
#undef PG8_SA
#undef PG8_SB
#undef PG8_STAGE
#undef PG8_LDA
#undef PG8_LDB
#undef PG8_MMA
#undef PG8_WAIT_V
#undef PG8_WAIT_L
#undef PG8_BAR
#undef PG8_SCHED
}

typedef f32x4 AccT[2][2][4][2];

struct EpiBf16 {
    static constexpr bool PERM = true, AFTER_DRAIN = false;
    bf16_t* O; int ldc;
    __device__ __forceinline__ void operator()(const AccT& acc, const Unit& u, int wr, int wc, int fr, int fq) const {
        { int t_ = threadIdx.x; asm volatile("" : "+v"(t_)); fr = t_ & 15; fq = (t_ >> 4) & 3; }
        const int row0 = u.pm * BM + wr * 64 + fr, col0 = u.pn * BM + wc * 32 + 8 * fq;
#pragma unroll
        for (int ai = 0; ai < 2; ++ai)
#pragma unroll
            for (int m = 0; m < 4; ++m) { bf16_t* rowp = O + (size_t)(row0 + ai * HALF + m * 16) * ldc + col0;
#pragma unroll
                for (int bj = 0; bj < 2; ++bj) { const f32x4 v0 = acc[ai][bj][m][0], v1 = acc[ai][bj][m][1];
                    u32x4 w; w.x = cvt_pk_bf16(v0[0], v0[1]); w.y = cvt_pk_bf16(v0[2], v0[3]); w.z = cvt_pk_bf16(v1[0], v1[1]); w.w = cvt_pk_bf16(v1[2], v1[3]);
                    *(u32x4*)(rowp + bj * HALF) = w; } }
    }
};
struct EpiF16 {
    static constexpr bool PERM = true, AFTER_DRAIN = false;
    _Float16* O; int ldc;
    __device__ __forceinline__ void operator()(const AccT& acc, const Unit& u, int wr, int wc, int fr, int fq) const {
        { int t_ = threadIdx.x; asm volatile("" : "+v"(t_)); fr = t_ & 15; fq = (t_ >> 4) & 3; }
        typedef _Float16 h8 __attribute__((ext_vector_type(8)));
        const int row0 = u.pm * BM + wr * 64 + fr, col0 = u.pn * BM + wc * 32 + 8 * fq;
#pragma unroll
        for (int ai = 0; ai < 2; ++ai)
#pragma unroll
            for (int m = 0; m < 4; ++m) { _Float16* rowp = O + (size_t)(row0 + ai * HALF + m * 16) * ldc + col0;
#pragma unroll
                for (int bj = 0; bj < 2; ++bj) { const f32x4 v0 = acc[ai][bj][m][0], v1 = acc[ai][bj][m][1];
                    h8 w = {(_Float16)v0[0], (_Float16)v0[1], (_Float16)v0[2], (_Float16)v0[3], (_Float16)v1[0], (_Float16)v1[1], (_Float16)v1[2], (_Float16)v1[3]};
                    *(h8*)(rowp + bj * HALF) = w; } }
    }
};
struct EpiGateMul {
    static constexpr bool PERM = true, AFTER_DRAIN = false;
    const bf16_t* G; bf16_t* Dst; int ldc;
    __device__ __forceinline__ void operator()(const AccT& acc, const Unit& u, int wr, int wc, int fr, int fq) const {
        { int t_ = threadIdx.x; asm volatile("" : "+v"(t_)); fr = t_ & 15; fq = (t_ >> 4) & 3; }
        const int row0 = u.pm * BM + wr * 64 + fr, col0 = u.pn * BM + wc * 32 + 8 * fq;
#pragma unroll
        for (int ai = 0; ai < 2; ++ai)
#pragma unroll
            for (int m = 0; m < 4; ++m) { const size_t roff = (size_t)(row0 + ai * HALF + m * 16) * ldc + col0; const bf16_t* rowg = G + roff; bf16_t* rowp = Dst + roff;
#pragma unroll
                for (int bj = 0; bj < 2; ++bj) { const f32x4 v0 = acc[ai][bj][m][0], v1 = acc[ai][bj][m][1]; const u32x4 gq = *(const u32x4*)(rowg + bj * HALF);
                    u32x4 w; w.x = cvt_pk_bf16(v0[0] * bf_lo(gq.x), v0[1] * bf_hi(gq.x)); w.y = cvt_pk_bf16(v0[2] * bf_lo(gq.y), v0[3] * bf_hi(gq.y));
                    w.z = cvt_pk_bf16(v1[0] * bf_lo(gq.z), v1[1] * bf_hi(gq.z)); w.w = cvt_pk_bf16(v1[2] * bf_lo(gq.w), v1[3] * bf_hi(gq.w));
                    *(u32x4*)(rowp + bj * HALF) = w; } }
    }
};
struct EpiGateFma {
    static constexpr bool PERM = true, AFTER_DRAIN = false;
    const bf16_t* Tm; const bf16_t* G2; bf16_t* Dst; int ldc;
    __device__ __forceinline__ void operator()(const AccT& acc, const Unit& u, int wr, int wc, int fr, int fq) const {
        { int t_ = threadIdx.x; asm volatile("" : "+v"(t_)); fr = t_ & 15; fq = (t_ >> 4) & 3; }
        const int row0 = u.pm * BM + wr * 64 + fr, col0 = u.pn * BM + wc * 32 + 8 * fq;
#pragma unroll
        for (int ai = 0; ai < 2; ++ai)
#pragma unroll
            for (int m = 0; m < 4; ++m) { const size_t off = (size_t)(row0 + ai * HALF + m * 16) * ldc + col0;
#pragma unroll
                for (int bj = 0; bj < 2; ++bj) { const f32x4 v0 = acc[ai][bj][m][0], v1 = acc[ai][bj][m][1]; const u32x4 gq = *(const u32x4*)(G2 + off + bj * HALF); const u32x4 tq = *(const u32x4*)(Tm + off + bj * HALF);
                    u32x4 w; w.x = cvt_pk_bf16(bf_lo(tq.x) + v0[0] * bf_lo(gq.x), bf_hi(tq.x) + v0[1] * bf_hi(gq.x)); w.y = cvt_pk_bf16(bf_lo(tq.y) + v0[2] * bf_lo(gq.y), bf_hi(tq.y) + v0[3] * bf_hi(gq.y));
                    w.z = cvt_pk_bf16(bf_lo(tq.z) + v1[0] * bf_lo(gq.z), bf_hi(tq.z) + v1[1] * bf_hi(gq.z)); w.w = cvt_pk_bf16(bf_lo(tq.w) + v1[2] * bf_lo(gq.w), bf_hi(tq.w) + v1[3] * bf_hi(gq.w));
                    *(u32x4*)(Dst + off + bj * HALF) = w; } }
    }
};
struct EpiResF32 {
    static constexpr bool PERM = false, AFTER_DRAIN = false;
    const float* res; float* out; int ldc; float mul;
    __device__ __forceinline__ void operator()(const AccT& acc, const Unit& u, int wr, int wc, int fr, int fq) const {
        { int t_ = threadIdx.x; asm volatile("" : "+v"(t_)); fr = t_ & 15; fq = (t_ >> 4) & 3; }
        const int row0 = u.pm * BM + wr * 64 + fr, col0 = u.pn * BM + wc * 32 + 4 * fq;
#pragma unroll
        for (int ai = 0; ai < 2; ++ai)
#pragma unroll
            for (int m = 0; m < 4; ++m) { const size_t off = (size_t)(row0 + ai * HALF + m * 16) * ldc + col0;
#pragma unroll
                for (int bj = 0; bj < 2; ++bj)
#pragma unroll
                    for (int n = 0; n < 2; ++n) { const f32x4 r = *(const f32x4*)(res + off + bj * HALF + n * 16); *(f32x4*)(out + off + bj * HALF + n * 16) = r + acc[ai][bj][m][n] * mul; } }
    }
};

__device__ __forceinline__ float row_rs(const float* ssq, int row) {
    const f32x4* p = (const f32x4*)(ssq + (size_t)row * 16); const f32x4 a = p[0], b = p[1], c = p[2], d = p[3];
    const float s = ((a[0] + a[1]) + (a[2] + a[3])) + ((b[0] + b[1]) + (b[2] + b[3])) + ((c[0] + c[1]) + (c[2] + c[3])) + ((d[0] + d[1]) + (d[2] + d[3]));
    return rsqrtf(s * (1.f / 1024.f) + 1e-6f);
}
struct EpiBf16RS {
    static constexpr bool PERM = true, AFTER_DRAIN = false;
    bf16_t* O; int ldc; const float* ssq;
    __device__ __forceinline__ void operator()(const AccT& acc, const Unit& u, int wr, int wc, int fr, int fq) const {
        { int t_ = threadIdx.x; asm volatile("" : "+v"(t_)); fr = t_ & 15; fq = (t_ >> 4) & 3; }
        const int row0 = u.pm * BM + wr * 64 + fr, col0 = u.pn * BM + wc * 32 + 8 * fq;
#pragma unroll
        for (int ai = 0; ai < 2; ++ai)
#pragma unroll
            for (int m = 0; m < 4; ++m) { int ro = row0 + ai * HALF + m * 16; asm volatile("" : "+v"(ro)); const float rs = row_rs(ssq, ro); bf16_t* rowp = O + (size_t)ro * ldc + col0;
#pragma unroll
                for (int bj = 0; bj < 2; ++bj) { const f32x4 v0 = acc[ai][bj][m][0] * rs, v1 = acc[ai][bj][m][1] * rs;
                    u32x4 w; w.x = cvt_pk_bf16(v0[0], v0[1]); w.y = cvt_pk_bf16(v0[2], v0[3]); w.z = cvt_pk_bf16(v1[0], v1[1]); w.w = cvt_pk_bf16(v1[2], v1[3]);
                    *(u32x4*)(rowp + bj * HALF) = w; } }
    }
};
struct EpiF16RS {
    static constexpr bool PERM = true, AFTER_DRAIN = false;
    _Float16* O; int ldc; const float* ssq;
    __device__ __forceinline__ void operator()(const AccT& acc, const Unit& u, int wr, int wc, int fr, int fq) const {
        { int t_ = threadIdx.x; asm volatile("" : "+v"(t_)); fr = t_ & 15; fq = (t_ >> 4) & 3; }
        typedef _Float16 h8 __attribute__((ext_vector_type(8)));
        const int row0 = u.pm * BM + wr * 64 + fr, col0 = u.pn * BM + wc * 32 + 8 * fq;
#pragma unroll
        for (int ai = 0; ai < 2; ++ai)
#pragma unroll
            for (int m = 0; m < 4; ++m) { int ro = row0 + ai * HALF + m * 16; asm volatile("" : "+v"(ro)); const float rs = row_rs(ssq, ro); _Float16* rowp = O + (size_t)ro * ldc + col0;
#pragma unroll
                for (int bj = 0; bj < 2; ++bj) { const f32x4 v0 = acc[ai][bj][m][0] * rs, v1 = acc[ai][bj][m][1] * rs;
                    h8 w = {(_Float16)v0[0], (_Float16)v0[1], (_Float16)v0[2], (_Float16)v0[3], (_Float16)v1[0], (_Float16)v1[1], (_Float16)v1[2], (_Float16)v1[3]};
                    *(h8*)(rowp + bj * HALF) = w; } }
    }
};
template <bool RES_F32> struct EpiResNorm {
    static constexpr bool PERM = true, AFTER_DRAIN = false;
    const float* resf; bf16_t* H; float* ssq; int ldc; float mul;
    __device__ __forceinline__ void operator()(const AccT& acc, const Unit& u, int wr, int wc, int fr, int fq) const {
        { int t_ = threadIdx.x; asm volatile("" : "+v"(t_)); fr = t_ & 15; fq = (t_ >> 4) & 3; }
        const int row0 = u.pm * BM + wr * 64 + fr, col0 = u.pn * BM + wc * 32 + 8 * fq;
#pragma unroll
        for (int ai = 0; ai < 2; ++ai)
#pragma unroll
            for (int m = 0; m < 4; ++m) { int ro = row0 + ai * HALF + m * 16; asm volatile("" : "+v"(ro)); const size_t off = (size_t)ro * ldc + col0; float ss = 0.f;
#pragma unroll
                for (int bj = 0; bj < 2; ++bj) { f32x4 r0, r1;
                    if (RES_F32) { r0 = *(const f32x4*)(resf + off + bj * HALF); r1 = *(const f32x4*)(resf + off + bj * HALF + 4); }
                    else { const u32x4 q = *(const u32x4*)(H + off + bj * HALF); r0 = (f32x4){bf_lo(q.x), bf_hi(q.x), bf_lo(q.y), bf_hi(q.y)}; r1 = (f32x4){bf_lo(q.z), bf_hi(q.z), bf_lo(q.w), bf_hi(q.w)}; }
                    const f32x4 v0 = r0 + acc[ai][bj][m][0] * mul, v1 = r1 + acc[ai][bj][m][1] * mul;
                    ss += ((v0[0] * v0[0] + v0[1] * v0[1]) + (v0[2] * v0[2] + v0[3] * v0[3])) + ((v1[0] * v1[0] + v1[1] * v1[1]) + (v1[2] * v1[2] + v1[3] * v1[3]));
                    u32x4 w; w.x = cvt_pk_bf16(v0[0], v0[1]); w.y = cvt_pk_bf16(v0[2], v0[3]); w.z = cvt_pk_bf16(v1[0], v1[1]); w.w = cvt_pk_bf16(v1[2], v1[3]);
                    *(u32x4*)(H + off + bj * HALF) = w; }
                ss += shx<16>(ss); ss = sum32(ss);
                if (fq == 0) ssq[(size_t)ro * 16 + u.pn * 4 + wc] = ss; }
    }
};
struct EpiIn {
    static constexpr bool PERM = true, AFTER_DRAIN = false;
    bf16_t *U, *Bb, *Q, *Kb, *V, *SGC, *SGA; const float* ropec; const float* ropes; float* kbar; float qscale;
    __device__ __forceinline__ void operator()(const AccT& acc, const Unit& u, int wr, int wc, int fr, int fq) const {
        { int t_ = threadIdx.x; asm volatile("" : "+v"(t_)); fr = t_ & 15; fq = (t_ >> 4) & 3; }
        const int pn = u.pn; const int row0 = u.pm * BM + wr * 64 + fr;
        if (pn < 4) {
            const int c0 = 128 * pn + 16 * wc + 4 * fq;
#pragma unroll
            for (int ai = 0; ai < 2; ++ai)
#pragma unroll
                for (int m = 0; m < 4; ++m) { int ro = row0 + ai * HALF + m * 16; asm volatile("" : "+v"(ro)); bf16_t* rowp = U + (size_t)ro * 512 + c0;
#pragma unroll
                    for (int bj = 0; bj < 2; ++bj) { const f32x4 x = acc[ai][bj][m][0] * acc[ai][bj][m][1]; u32x2 w; w.x = cvt_pk_bf16(x[0], x[1]); w.y = cvt_pk_bf16(x[2], x[3]); *(u32x2*)(rowp + bj * 64) = w; } }
        } else if (pn < 6 || (pn >= 10 && pn < 12)) {
            bf16_t* O = pn < 6 ? Bb : V; const int col0 = (pn < 6 ? pn - 4 : pn - 10) * BM + wc * 32 + 8 * fq;
#pragma unroll
            for (int ai = 0; ai < 2; ++ai)
#pragma unroll
                for (int m = 0; m < 4; ++m) { int ro = row0 + ai * HALF + m * 16; asm volatile("" : "+v"(ro)); bf16_t* rowp = O + (size_t)ro * 512 + col0;
#pragma unroll
                    for (int bj = 0; bj < 2; ++bj) { const f32x4 v0 = acc[ai][bj][m][0], v1 = acc[ai][bj][m][1];
                        u32x4 w; w.x = cvt_pk_bf16(v0[0], v0[1]); w.y = cvt_pk_bf16(v0[2], v0[3]); w.z = cvt_pk_bf16(v1[0], v1[1]); w.w = cvt_pk_bf16(v1[2], v1[3]);
                        *(u32x4*)(rowp + bj * HALF) = w; } }
        } else if (pn < 10) {
            const bool isk = pn >= 8; bf16_t* O = isk ? Kb : Q; const int colt = (isk ? pn - 8 : pn - 6) * BM + wc * 32 + 8 * fq;
            const int g4 = 4 * (4 * (wc & 1) + fq);
            const float sc = isk ? 1.f : qscale;
            f32x4 cs0[2] = {(f32x4){0.f, 0.f, 0.f, 0.f}, (f32x4){0.f, 0.f, 0.f, 0.f}}, cs1[2] = {(f32x4){0.f, 0.f, 0.f, 0.f}, (f32x4){0.f, 0.f, 0.f, 0.f}};
#pragma unroll
            for (int ai = 0; ai < 2; ++ai)
#pragma unroll
                for (int m = 0; m < 4; ++m) { int row = row0 + ai * HALF + m * 16; asm volatile("" : "+v"(row)); const int pos = row & 2047;
                    const f32x4 c = *(const f32x4*)(ropec + pos * 32 + g4) * sc, s = *(const f32x4*)(ropes + pos * 32 + g4) * sc;
                    bf16_t* rowp = O + (size_t)row * 512 + colt;
#pragma unroll
                    for (int bj = 0; bj < 2; ++bj) { const f32x4 x1 = acc[ai][bj][m][0], x2 = acc[ai][bj][m][1]; const f32x4 o1 = x1 * c - x2 * s, o2 = x2 * c + x1 * s;
                        cs0[bj] += o1; cs1[bj] += o2;
                        u32x4 w; w.x = cvt_pk_bf16(o1[0], o1[1]); w.y = cvt_pk_bf16(o1[2], o1[3]); w.z = cvt_pk_bf16(o2[0], o2[1]); w.w = cvt_pk_bf16(o2[2], o2[3]);
                        *(u32x4*)(rowp + bj * HALF) = w; }
                    asm volatile("" : "+v"(cs0[0]), "+v"(cs0[1]), "+v"(cs1[0]), "+v"(cs1[1]) :: "memory"); }
            if (isk) {
#pragma unroll
                for (int bj = 0; bj < 2; ++bj)
#pragma unroll
                    for (int j = 0; j < 4; ++j) { float a = cs0[bj][j], b = cs1[bj][j];
                        a += shx<1>(a); b += shx<1>(b); a += shx<2>(a); b += shx<2>(b); a += shx<4>(a); b += shx<4>(b); a += shx<8>(a); b += shx<8>(b);
                        if (fr == 0) { const int pc = (pn - 8) * BM + bj * HALF + wc * 32 + 8 * fq;
                            float* kb = kbar + (size_t)u.pm * 512 + pc; atomicAdd(kb + j, a); atomicAdd(kb + 4 + j, b); } }
            }
        } else {
            bf16_t* O = pn < 16 ? SGC : SGA; const int col0 = (pn < 16 ? pn - 12 : pn - 16) * BM + wc * 32 + 8 * fq;
#pragma unroll
            for (int ai = 0; ai < 2; ++ai)
#pragma unroll
                for (int m = 0; m < 4; ++m) { int ro = row0 + ai * HALF + m * 16; asm volatile("" : "+v"(ro)); bf16_t* rowp = O + (size_t)ro * 1024 + col0;
#pragma unroll
                    for (int bj = 0; bj < 2; ++bj) { f32x4 v0 = acc[ai][bj][m][0], v1 = acc[ai][bj][m][1];
#pragma unroll
                        for (int j = 0; j < 4; ++j) { v0[j] = __builtin_amdgcn_rcpf(1.f + __expf(-v0[j])); v1[j] = __builtin_amdgcn_rcpf(1.f + __expf(-v1[j])); }
                        u32x4 w; w.x = cvt_pk_bf16(v0[0], v0[1]); w.y = cvt_pk_bf16(v0[2], v0[3]); w.z = cvt_pk_bf16(v1[0], v1[1]); w.w = cvt_pk_bf16(v1[2], v1[3]);
                        *(u32x4*)(rowp + bj * HALF) = w; }
                    asm volatile("" ::: "memory"); }
        }
    }
};
struct EpiSoftmax {
    static constexpr bool PERM = true, AFTER_DRAIN = true;
    bf16_t* O; int ldc; float scale_log2;
    __device__ __forceinline__ void fused(AccT& acc, const Unit& u, int wr, int wc, int fr, int fq, PG8_LAS unsigned char* lds, int wid, int lane) const {
        { int t_ = threadIdx.x; asm volatile("" : "+v"(t_)); fr = t_ & 15; fq = (t_ >> 4) & 3; }
        PG8_LAS f32x2* X = (PG8_LAS f32x2*)lds;
        float mx[2][4];
#pragma unroll
        for (int ai = 0; ai < 2; ++ai)
#pragma unroll
            for (int m = 0; m < 4; ++m) { float a = -3.0e38f;
#pragma unroll
                for (int bj = 0; bj < 2; ++bj)
#pragma unroll
                    for (int n = 0; n < 2; ++n) { acc[ai][bj][m][n] = acc[ai][bj][m][n] * scale_log2; const f32x4 x = acc[ai][bj][m][n]; a = fmaxf(fmaxf(a, fmaxf(x[0], x[1])), fmaxf(x[2], x[3])); }
                a = fmaxf(a, shx<16>(a)); a = max32(a); mx[ai][m] = a;
                float s = 0.f;
#pragma unroll
                for (int bj = 0; bj < 2; ++bj)
#pragma unroll
                    for (int n = 0; n < 2; ++n) { f32x4 x = acc[ai][bj][m][n];
#pragma unroll
                        for (int j = 0; j < 4; ++j) { x[j] = __builtin_amdgcn_exp2f(x[j] - a); s += x[j]; }
                        acc[ai][bj][m][n] = x; }
                s += shx<16>(s); s = sum32(s);
                if (fq == 0) X[(ai * HALF + wr * 64 + m * 16 + fr) * 4 + wc] = (f32x2){a, s};
            }
        asm volatile("s_waitcnt lgkmcnt(0)" ::: "memory"); __builtin_amdgcn_s_barrier(); asm volatile("" ::: "memory");
        const int row0 = u.pm * BM + wr * 64 + fr, col0 = u.pn * BM + wc * 32 + 8 * fq;
#pragma unroll
        for (int ai = 0; ai < 2; ++ai)
#pragma unroll
            for (int m = 0; m < 4; ++m) { const int r = ai * HALF + wr * 64 + m * 16 + fr;
                const f32x2 e0 = X[r * 4 + 0], e1 = X[r * 4 + 1], e2 = X[r * 4 + 2], e3 = X[r * 4 + 3];
                const float M = fmaxf(fmaxf(e0.x, e1.x), fmaxf(e2.x, e3.x));
                const float L = e0.y * __builtin_amdgcn_exp2f(e0.x - M) + e1.y * __builtin_amdgcn_exp2f(e1.x - M) + e2.y * __builtin_amdgcn_exp2f(e2.x - M) + e3.y * __builtin_amdgcn_exp2f(e3.x - M);
                const float f = __builtin_amdgcn_exp2f(mx[ai][m] - M) * __builtin_amdgcn_rcpf(L);
                bf16_t* rowp = O + (size_t)(row0 + ai * HALF + m * 16) * ldc + col0;
#pragma unroll
                for (int bj = 0; bj < 2; ++bj) { const f32x4 v0 = acc[ai][bj][m][0] * f, v1 = acc[ai][bj][m][1] * f;
                    u32x4 w; w.x = cvt_pk_bf16(v0[0], v0[1]); w.y = cvt_pk_bf16(v0[2], v0[3]); w.z = cvt_pk_bf16(v1[0], v1[1]); w.w = cvt_pk_bf16(v1[2], v1[3]);
                    *(u32x4*)(rowp + bj * HALF) = w; } }
        asm volatile("s_waitcnt lgkmcnt(0)" ::: "memory"); __builtin_amdgcn_s_barrier(); asm volatile("" ::: "memory");
    }
};
}
namespace attn_body {
using bf16=__hip_bfloat16;
using bf16x8=__attribute__((ext_vector_type(8)))short;
using s16x4=__attribute__((ext_vector_type(4)))short;
using f32x16=__attribute__((ext_vector_type(16)))float;
using u32x4=__attribute__((ext_vector_type(4)))unsigned;
constexpr int BATCH=16,NHEAD=8,SEQ=2048,D=64,DM=NHEAD*D;
constexpr int NW=8,QBLK=32,QB=QBLK*NW,KVBLK=64,NQB=SEQ/QB;
constexpr int ATTN_PITCH=DM, ATTN_UNIT_ROWS=QB;
__device__ __forceinline__ int crow(int r,int hi){return (r&3)+8*(r>>2)+4*hi;}
#define SBAR() __builtin_amdgcn_sched_barrier(0)
__device__ __forceinline__ void cmask(f32x16&p0,f32x16&p1,int jb,int qrel,int hi){
  const float NEG=-INFINITY; int kb=64*jb+4*hi;
  #pragma unroll
  for(int r=0;r<16;++r){int kv=kb+(r&3)+8*(r>>2); if(kv>qrel)p0[r]=NEG; if(kv+32>qrel)p1[r]=NEG;}
}

constexpr int NSLOT=3, SLOTB=8192;
constexpr int LDS_K=0, LDS_V=NSLOT*SLOTB, LDS_WS=2*NSLOT*SLOTB, LDS_OST=LDS_WS+NW*64*4, LDS_SEL=LDS_OST+NW*4096, LDS_BYTES=LDS_SEL+NW*64*4;
constexpr float C2=0.125f*1.4426950408889634f;
__device__ __forceinline__ void glds16(const void*gsrc,unsigned lds_dst){unsigned keep;
  asm volatile("s_mov_b32 %0, m0\n\ts_mov_b32 m0, %2\n\ts_nop 0\n\tglobal_load_lds_dwordx4 %1, off\n\ts_mov_b32 m0, %0":"=&s"(keep):"v"(gsrc),"s"(lds_dst):"memory");}
__device__ __forceinline__ float max3f(float a,float b,float c){float r;asm("v_max3_f32 %0, %1, %2, %3":"=v"(r):"v"(a),"v"(b),"v"(c));return r;}
__device__ __forceinline__ float max2f(float a,float b){float r;asm("v_max_f32_e32 %0, %1, %2":"=v"(r):"v"(a),"v"(b));return r;}
__device__ __forceinline__ float fadd_s(float a,float b){float r;asm("v_add_f32_e32 %0, %1, %2":"=v"(r):"v"(a),"v"(b));return r;}
__device__ __forceinline__ float fsub_s(float a,float b){float r;asm("v_sub_f32_e32 %0, %1, %2":"=v"(r):"v"(a),"v"(b));return r;}
typedef float f32x2_t __attribute__((ext_vector_type(2))); typedef __bf16 bf16x2_t __attribute__((ext_vector_type(2)));
__device__ __forceinline__ unsigned cvtpk_s(float lo,float hi){f32x2_t v={lo,hi};bf16x2_t b=__builtin_convertvector(v,bf16x2_t);return __builtin_bit_cast(unsigned,b);}
#define WAIT_BAR(N) asm volatile("s_waitcnt vmcnt(" #N ") lgkmcnt(0)\n\ts_barrier":::"memory")

__device__ __forceinline__ void qkt(f32x16&p0,f32x16&p1,const char*Kslot,const bf16x8*qr,const f32x16&negm,int r32,int hi){
  const char*kb=Kslot+hi*1024+r32*16;
  #pragma unroll
  for(int d0=0;d0<4;++d0){
    const bf16x8 b0=*reinterpret_cast<const bf16x8*>(kb+d0*2048);
    const bf16x8 b1=*reinterpret_cast<const bf16x8*>(kb+d0*2048+512);
    if(d0==0){p0=__builtin_amdgcn_mfma_f32_32x32x16_bf16(b0,qr[0],negm,0,0,0);p1=__builtin_amdgcn_mfma_f32_32x32x16_bf16(b1,qr[0],negm,0,0,0);}
    else{p0=__builtin_amdgcn_mfma_f32_32x32x16_bf16(b0,qr[d0],p0,0,0,0);p1=__builtin_amdgcn_mfma_f32_32x32x16_bf16(b1,qr[d0],p1,0,0,0);}}
}
typedef __attribute__((address_space(3))) const char* lds_cptr;
typedef short v4i16_t __attribute__((ext_vector_type(4)));
__device__ __forceinline__ void kload8(bf16x8*kf,lds_cptr kp){
  kf[0]=*(const __attribute__((address_space(3))) bf16x8*)(kp);      kf[1]=*(const __attribute__((address_space(3))) bf16x8*)(kp+512);
  kf[2]=*(const __attribute__((address_space(3))) bf16x8*)(kp+2048); kf[3]=*(const __attribute__((address_space(3))) bf16x8*)(kp+2560);
  kf[4]=*(const __attribute__((address_space(3))) bf16x8*)(kp+4096); kf[5]=*(const __attribute__((address_space(3))) bf16x8*)(kp+4608);
  kf[6]=*(const __attribute__((address_space(3))) bf16x8*)(kp+6144); kf[7]=*(const __attribute__((address_space(3))) bf16x8*)(kp+6656);
}
__device__ __forceinline__ void kload2(bf16x8*kf,lds_cptr kp,int j){ kf[2*j]=*(const __attribute__((address_space(3))) bf16x8*)(kp+j*2048); kf[2*j+1]=*(const __attribute__((address_space(3))) bf16x8*)(kp+j*2048+512); }
__device__ __forceinline__ s16x4 vtr(lds_cptr p){ return __builtin_bit_cast(s16x4,__builtin_amdgcn_ds_read_tr16_b64_v4i16((__attribute__((address_space(3))) v4i16_t*)p)); }
__device__ __forceinline__ float rowmax(const f32x16&p0,const f32x16&p1){
  float a=max3f(p0[0],p0[1],p1[0]),b=max3f(p0[2],p0[3],p1[1]);a=max3f(a,p1[2],p1[3]);
  #pragma unroll
  for(int r=4;r<16;r+=4){a=max3f(a,p0[r],p0[r+1]);b=max3f(b,p0[r+2],p0[r+3]);a=max3f(a,p1[r],p1[r+1]);b=max3f(b,p1[r+2],p1[r+3]);}
  const float m=max2f(a,b);
  auto rr=__builtin_amdgcn_permlane32_swap(__float_as_uint(m),__float_as_uint(m),false,false);
  return max2f(__uint_as_float(rr[0]),__uint_as_float(rr[1]));
}
__device__ __forceinline__ void pv(f32x16*o,int vb,bf16x8 pa0,bf16x8 pa1,bf16x8 pa2,bf16x8 pa3){
  #pragma unroll
  for(int d0=0;d0<2;++d0){s16x4 lo[4],hi[4];
    #pragma unroll
    for(int ks=0;ks<4;++ks){
      asm volatile("ds_read_b64_tr_b16 %0,%1 offset:%c2":"=&v"(lo[ks]):"v"(vb),"i"(d0*4096+ks*1024):"memory");
      asm volatile("ds_read_b64_tr_b16 %0,%1 offset:%c2":"=&v"(hi[ks]):"v"(vb),"i"(d0*4096+ks*1024+512):"memory");}
    asm volatile("s_waitcnt lgkmcnt(0)":::"memory");SBAR();
    #define PK(k) (bf16x8){lo[k][0],lo[k][1],lo[k][2],lo[k][3],hi[k][0],hi[k][1],hi[k][2],hi[k][3]}
    o[d0]=__builtin_amdgcn_mfma_f32_32x32x16_bf16(pa0,PK(0),o[d0],0,0,0);
    o[d0]=__builtin_amdgcn_mfma_f32_32x32x16_bf16(pa1,PK(1),o[d0],0,0,0);
    o[d0]=__builtin_amdgcn_mfma_f32_32x32x16_bf16(pa2,PK(2),o[d0],0,0,0);
    o[d0]=__builtin_amdgcn_mfma_f32_32x32x16_bf16(pa3,PK(3),o[d0],0,0,0);
    #undef PK
  }
}

#ifndef ATTN_STORE16
#define ATTN_STORE16(p,v) (*(u32x4*)(p)=(v))
#endif
template<int THRL> __device__ __forceinline__ void attn_unit(int b,int h,int qb,const bf16*Q,const bf16*__restrict__ K,const bf16*__restrict__ V,bf16*O,const float*__restrict__ kbar,char*shm){
  int tid=threadIdx.x; asm volatile("":"+v"(tid)); const int lane=tid&63,r32=lane&31,hi=lane>>5; const int wid=__builtin_amdgcn_readfirstlane(tid>>6);
  const long rowbase=(long)b*SEQ; const int q0=qb*QB;
  const bf16*Qw=Q+(rowbase+q0+wid*QBLK)*DM+h*D;
  const bf16*Kh=K+rowbase*DM+h*D,*Vh=V+rowbase*DM+h*D;
  const unsigned lds0=(unsigned)(uintptr_t)shm;
  float*wsf=(float*)(shm+LDS_WS)+wid*64;
  const bf16*ksrc=Kh+(long)lane*DM+wid*8;
  const bf16*vsrc=Vh+(long)(16*(wid&3)+(lane>>2))*DM+(wid>>2)*32+(lane&3)*8;
  const unsigned kdst=lds0+LDS_K+wid*1024, vdst=lds0+LDS_V+wid*1024;
  #define DMA_K(t,slot) glds16(ksrc+(long)(t)*KVBLK*DM,(unsigned)__builtin_amdgcn_readfirstlane(kdst+(slot)))
  #define DMA_V(t,slot) glds16(vsrc+(long)(t)*KVBLK*DM,(unsigned)__builtin_amdgcn_readfirstlane(vdst+(slot)))
  const int vb0=(int)(lds0+LDS_V)+((lane>>4)&1)*32+(lane&3)*8+(4*hi+((lane&15)>>2))*64;
  const char*Kbase=shm+LDS_K; bf16x8 kf[8];
  const lds_cptr shm3=(lds_cptr)shm; const lds_cptr kp0=shm3+LDS_K+hi*1024+r32*16; const lds_cptr vp0=shm3+LDS_V+((lane>>4)&1)*32+(lane&3)*8+(4*hi+((lane&15)>>2))*64;
  const int NT=(q0+QB)/KVBLK;
  DMA_K(0,0);DMA_V(0,0);DMA_K(1,SLOTB);
  bf16x8 qr[4];
  #pragma unroll
  for(int d0=0;d0<4;++d0)qr[d0]=*reinterpret_cast<const bf16x8*>(&Qw[(long)r32*DM+d0*16+hi*8]);
  int selm=0;
  if(qb>0){
    float g[7]; int hi8=8*hi; asm volatile("":"+v"(hi8)); const float*kb=kbar+(size_t)(b*8)*512+h*64+hi8;
    #pragma unroll
    for(int n=0;n<7;++n){ float a=0.f;
      if(n<qb){
        #pragma unroll
        for(int d0=0;d0<4;++d0){ const float4 k0=*(const float4*)(kb+n*512+16*d0),k1=*(const float4*)(kb+n*512+16*d0+4); const bf16x8 qq=qr[d0];
          #define QF(e) __uint_as_float(((unsigned)(unsigned short)qq[e])<<16)
          a+=QF(0)*k0.x+QF(1)*k0.y+QF(2)*k0.z+QF(3)*k0.w+QF(4)*k1.x+QF(5)*k1.y+QF(6)*k1.z+QF(7)*k1.w;
          #undef QF
        } }
      a=::sum32(a); g[n]=(n<qb)?a:-INFINITY; asm volatile("":"+v"(g[n])::"memory"); }
    #pragma unroll
    for(int r=0;r<3;++r){ int best=-1; float bv=-INFINITY;
      #pragma unroll
      for(int n=0;n<7;++n) if(!((selm>>n)&1)&&g[n]>bv){bv=g[n];best=n;}
      if(best>=0)selm|=1<<best; }
  }
  selm|=1<<qb;
  typedef __attribute__((address_space(3))) int* lds_iptr;
  ((lds_iptr)(shm3+LDS_SEL))[tid]=selm;
  #define CURNEG(blk) ({ int t_=threadIdx.x; asm volatile("":"+v"(t_)); const int sm_=((lds_iptr)(shm3+LDS_SEL))[t_]; ((sm_>>(blk))&1)?0.f:-INFINITY; })
  #define NEGUPD(t) do{ if((((t)+1)&3)==0){ const float cn_=CURNEG(((t)+1)>>2); _Pragma("unroll") for(int r=0;r<16;++r)negm[r]=cn_-mhat; asm volatile("":"+v"(negm)); } }while(0)
  float mhat=0.f,l_reg=0.f;f32x16 o[2];o[0]=f32x16{};o[1]=f32x16{};f32x16 negm; { const float cn_=CURNEG(0); _Pragma("unroll") for(int r=0;r<16;++r)negm[r]=cn_; } asm volatile("":"+v"(negm));
  const int qrel=wid*QBLK+r32;
  #define CMASK(P0,P1,t) do{int jb_=(t)-(NT-4); if(jb_>=0)cmask(P0,P1,jb_,qrel,hi);}while(0)
  bool resc=false;
  #define START(P0,P1) do{ const float rm=rowmax(P0,P1); resc=false; \
    { const float dl=__builtin_fmaxf(rm,-24.f); mhat=fadd_s(mhat,dl); \
      _Pragma("unroll") for(int r=0;r<16;++r){P0[r]=fsub_s(P0[r],dl);P1[r]=fsub_s(P1[r],dl);} \
      { const float cn_=CURNEG(0); _Pragma("unroll") for(int r=0;r<16;++r)negm[r]=cn_-mhat; } asm volatile("":"+v"(negm)); } \
    _Pragma("unroll") for(int r=0;r<16;++r)P0[r]=__builtin_amdgcn_exp2f(P0[r]); }while(0)
  #define RESC() do{ if(resc){ asm volatile("s_waitcnt lgkmcnt(0)":::"memory"); \
      _Pragma("unroll") for(int d_=0;d_<2;++d_) _Pragma("unroll") for(int r=0;r<16;++r)o[d_][r]*=wsf[crow(r,hi)]; } }while(0)
  f32x16 pA0,pA1,pB0,pB1;
  int sl_prev=0,sl_cur=0,sl_next=SLOTB;
  #define ROT() do{sl_prev=sl_cur;sl_cur=sl_next;sl_next=(sl_next==(NSLOT-1)*SLOTB)?0:sl_next+SLOTB;}while(0)
  DMA_K(2,2*SLOTB);
  WAIT_BAR(3);
  qkt(pA0,pA1,Kbase,qr,negm,r32,hi);asm volatile("s_nop 15\n\ts_nop 7":"+v"(pA0),"+v"(pA1));CMASK(pA0,pA1,0);
  START(pA0,pA1);
  _Pragma("unroll") for(int r=0;r<16;++r)pA1[r]=__builtin_amdgcn_exp2f(pA1[r]);
  WAIT_BAR(0);
  DMA_K(3,0);DMA_V(1,SLOTB);
  ROT();
  kload8(kf,kp0+sl_cur);
  WAIT_BAR(2);
  s16x4 vlo[8],vhi[8]; u32x4 pw0,pw1,pw2,pw3;
  #define PKW(P,B) cvtpk_s(P[B],P[B+1])
  #define PAF(k) __builtin_bit_cast(bf16x8,pw##k)
  #define VFR(i) (bf16x8){vlo[i][0],vlo[i][1],vlo[i][2],vlo[i][3],vhi[i][0],vhi[i][1],vhi[i][2],vhi[i][3]}
  #define PIN(x) asm volatile("":"+v"(x))
  #define MX3(a,b,c) __builtin_fmaxf(__builtin_fmaxf((a),(b)),(c))
  #define GAPA(MF,A0,A1,A2,A3,W0,W1,PW) do{ MF; sacc+=A0; sacc+=A1; sacc+=A2; sacc+=A3; PIN(sacc); W0; W1; PIN(PW); SBAR(); }while(0)
  #define EX(v) __builtin_amdgcn_exp2f(v)
  #define GAPB(MF,X,B) do{ MF; X[B]=EX(X[B]); X[B+1]=EX(X[B+1]); X[B+2]=EX(X[B+2]); X[B+3]=EX(X[B+3]); PIN(X); SBAR(); }while(0)
  #define VRD(i) do{ vlo[i]=vtr(vp_+(((i)>>2)*4096+((i)&3)*1024)); vhi[i]=vtr(vp_+(((i)>>2)*4096+((i)&3)*1024+512)); }while(0)
  #define KRD(G,j) do{ if(G){ kload2(kf,kp0+sl_next,j); SBAR(); } }while(0)
  #define STEP(C0,C1,P0,P1,t,GK,GV,GL) do{ SBAR(); \
    const lds_cptr vp_=vp0+sl_prev; \
    VRD(0); SBAR(); float sacc=(P0[0]+P0[1]); \
    GAPA(C0=__builtin_amdgcn_mfma_f32_32x32x16_bf16(kf[0],qr[0],negm,0,0,0), P0[2],P0[3],P0[4],P0[5],     pw0[0]=PKW(P0,0), pw0[1]=PKW(P0,2), pw0); \
    VRD(4); SBAR(); GAPA(C1=__builtin_amdgcn_mfma_f32_32x32x16_bf16(kf[1],qr[0],negm,0,0,0), P0[6],P0[7],P0[8],P0[9],     pw0[2]=PKW(P0,4), pw0[3]=PKW(P0,6), pw0); \
    VRD(1); SBAR(); GAPA(C0=__builtin_amdgcn_mfma_f32_32x32x16_bf16(kf[2],qr[1],C0,0,0,0),   P0[10],P0[11],P0[12],P0[13], pw1[0]=PKW(P0,8), pw1[1]=PKW(P0,10), pw1); \
    VRD(5); SBAR(); GAPA(C1=__builtin_amdgcn_mfma_f32_32x32x16_bf16(kf[3],qr[1],C1,0,0,0),   P0[14],P0[15],P1[0],P1[1],   pw1[2]=PKW(P0,12),pw1[3]=PKW(P0,14), pw1); \
    VRD(2); SBAR(); GAPA(C0=__builtin_amdgcn_mfma_f32_32x32x16_bf16(kf[4],qr[2],C0,0,0,0),   P1[2],P1[3],P1[4],P1[5],     pw2[0]=PKW(P1,0), pw2[1]=PKW(P1,2), pw2); \
    VRD(6); SBAR(); GAPA(C1=__builtin_amdgcn_mfma_f32_32x32x16_bf16(kf[5],qr[2],C1,0,0,0),   P1[6],P1[7],P1[8],P1[9],     pw2[2]=PKW(P1,4), pw2[3]=PKW(P1,6), pw2); \
    VRD(3); SBAR(); GAPA(C0=__builtin_amdgcn_mfma_f32_32x32x16_bf16(kf[6],qr[3],C0,0,0,0),   P1[10],P1[11],P1[12],P1[13], pw3[0]=PKW(P1,8), pw3[1]=PKW(P1,10), pw3); \
    VRD(7); SBAR(); GAPA(C1=__builtin_amdgcn_mfma_f32_32x32x16_bf16(kf[7],qr[3],C1,0,0,0),   P1[14],P1[15],0.f,0.f,       pw3[2]=PKW(P1,12),pw3[3]=PKW(P1,14), pw3); \
    l_reg+=sacc; \
    if(GK){DMA_K((t)+3,sl_cur);} if(GV){DMA_V((t)+1,sl_next);} \
    CMASK(C0,C1,t); \
    { float a=MX3(C0[0],C0[1],C1[0]),b=MX3(C0[2],C0[3],C1[1]); a=MX3(a,C1[2],C1[3]); \
      _Pragma("unroll") for(int r=4;r<16;r+=4){a=MX3(a,C0[r],C0[r+1]);b=MX3(b,C0[r+2],C0[r+3]);a=MX3(a,C1[r],C1[r+1]);b=MX3(b,C1[r+2],C1[r+3]);} \
      float rm=__builtin_fmaxf(a,b); { auto rr=__builtin_amdgcn_permlane32_swap(__float_as_uint(rm),__float_as_uint(rm),false,false); rm=__builtin_fmaxf(__uint_as_float(rr[0]),__uint_as_float(rr[1])); } \
      resc=false; \
      if(__builtin_expect(__any(rm>(float)THRL),0)){ const float dl=__builtin_fmaxf(rm,0.f); mhat+=dl; \
        _Pragma("unroll") for(int r=0;r<16;++r){C0[r]-=dl;C1[r]-=dl;} \
        { const float cn_=CURNEG(((t)+1)>>2); _Pragma("unroll") for(int r=0;r<16;++r)negm[r]=cn_-mhat; } asm volatile("":"+v"(negm)); \
        const float f=__builtin_amdgcn_exp2f(-dl); l_reg*=f; if(hi==0)wsf[r32]=f; resc=true; } } \
    SBAR(); \
    GAPB(o[0]=__builtin_amdgcn_mfma_f32_32x32x16_bf16(PAF(0),VFR(0),o[0],0,0,0), C0,0); \
    GAPB(o[1]=__builtin_amdgcn_mfma_f32_32x32x16_bf16(PAF(0),VFR(4),o[1],0,0,0), C0,4); \
    KRD(GL,0); GAPB(o[0]=__builtin_amdgcn_mfma_f32_32x32x16_bf16(PAF(1),VFR(1),o[0],0,0,0), C0,8); \
    KRD(GL,1); GAPB(o[1]=__builtin_amdgcn_mfma_f32_32x32x16_bf16(PAF(1),VFR(5),o[1],0,0,0), C0,12); \
    KRD(GL,2); GAPB(o[0]=__builtin_amdgcn_mfma_f32_32x32x16_bf16(PAF(2),VFR(2),o[0],0,0,0), C1,0); \
    KRD(GL,3); GAPB(o[1]=__builtin_amdgcn_mfma_f32_32x32x16_bf16(PAF(2),VFR(6),o[1],0,0,0), C1,4); \
    GAPB(o[0]=__builtin_amdgcn_mfma_f32_32x32x16_bf16(PAF(3),VFR(3),o[0],0,0,0), C1,8); \
    GAPB(o[1]=__builtin_amdgcn_mfma_f32_32x32x16_bf16(PAF(3),VFR(7),o[1],0,0,0), C1,12); \
    }while(0)
  int t=1;
  #undef CMASK
  #define CMASK(P0,P1,t) do{}while(0)
  for(;t+5<NT;t+=2){
    STEP(pB0,pB1,pA0,pA1,t,true,true,true);     WAIT_BAR(2); RESC(); ROT(); NEGUPD(t);
    STEP(pA0,pA1,pB0,pB1,t+1,true,true,true);   WAIT_BAR(2); RESC(); ROT(); NEGUPD(t+1);
  }
  #undef CMASK
  #define CMASK(P0,P1,t) do{int jb_=(t)-(NT-4); if(jb_>=0)cmask(P0,P1,jb_,qrel,hi);}while(0)
  #define ENDW(tt) do{ if((tt)+3<NT){WAIT_BAR(2);} else if((tt)+2<NT){WAIT_BAR(1);} else {WAIT_BAR(0);} }while(0)
  for(;t+1<NT;t+=2){
    STEP(pB0,pB1,pA0,pA1,t,(t+3<NT),(t+1<NT),(t+1<NT));       ENDW(t);   RESC(); ROT(); NEGUPD(t);
    STEP(pA0,pA1,pB0,pB1,t+1,(t+4<NT),(t+2<NT),(t+2<NT));     ENDW(t+1); RESC(); ROT(); NEGUPD(t+1);
  }
  STEP(pB0,pB1,pA0,pA1,NT-1,false,false,false); RESC();
  { float sacc=pB0[0]+pB0[1]; _Pragma("unroll") for(int r=2;r<16;++r)sacc+=pB0[r]; _Pragma("unroll") for(int r=0;r<16;++r)sacc+=pB1[r]; l_reg+=sacc;
    pw0=(u32x4){PKW(pB0,0),PKW(pB0,2),PKW(pB0,4),PKW(pB0,6)};pw1=(u32x4){PKW(pB0,8),PKW(pB0,10),PKW(pB0,12),PKW(pB0,14)};pw2=(u32x4){PKW(pB1,0),PKW(pB1,2),PKW(pB1,4),PKW(pB1,6)};pw3=(u32x4){PKW(pB1,8),PKW(pB1,10),PKW(pB1,12),PKW(pB1,14)};
    SBAR(); pv(o,vb0+sl_cur,PAF(0),PAF(1),PAF(2),PAF(3)); }
  #undef PKW
  #undef PAF
  #undef VFR
  #undef PIN
  #undef MX3
  #undef GAPA
  #undef GAPB
  #undef EX
  #undef VRD
  #undef KRD
  #undef STEP
  #undef ENDW
  {auto rr=__builtin_amdgcn_permlane32_swap(__float_as_uint(l_reg),__float_as_uint(l_reg),false,false);l_reg=__uint_as_float(rr[0])+__uint_as_float(rr[1]);}
  if(hi==0)wsf[32+r32]=l_reg;asm volatile("s_waitcnt lgkmcnt(0)":::"memory");
  float rli[16];
  #pragma unroll
  for(int r=0;r<16;++r)rli[r]=__builtin_amdgcn_rcpf(wsf[32+crow(r,hi)]);
  bf16*Ow=O+(rowbase+q0+wid*QBLK)*DM+h*D;
  { bf16*stg=(bf16*)(shm+LDS_OST)+wid*2048;
    #pragma unroll
    for(int r=0;r<16;++r){const int orow=crow(r,hi);
      #pragma unroll
      for(int d0=0;d0<2;++d0)stg[orow*64+d0*32+r32]=__float2bfloat16(o[d0][r]*rli[r]);}
    asm volatile("s_waitcnt lgkmcnt(0)":::"memory");
    #pragma unroll
    for(int i=0;i<4;++i){const int row=i*8+(lane>>3),ch=lane&7; const u32x4 v=*(const u32x4*)(stg+row*64+ch*8); ATTN_STORE16(Ow+(long)row*DM+ch*8,v);} }
  asm volatile("s_waitcnt lgkmcnt(0)\n\ts_barrier":::"memory");
  #undef DMA_K
  #undef DMA_V
  #undef CMASK
  #undef START
  #undef CURNEG
  #undef NEGUPD
  #undef RESC
  #undef ROT
}
constexpr int ATTN_LDS_BYTES=LDS_BYTES;
struct AttnTensors { const bf16* Q; const bf16* K; const bf16* V; bf16* O; const float* kbar; };
struct AttnUnit { int bh; int qb; };
struct StaticOrder {
  int vcu,G;
  __device__ __forceinline__ explicit StaticOrder(int grid,int block):vcu((grid%8==0)?(block%8)*(grid/8)+block/8:block),G(grid){}
  __device__ __forceinline__ bool next(int i,AttnUnit&u)const{
    if(G==256){ if(i>=4)return false; const int s=vcu&1; u.bh=vcu>>1; u.qb=s?((i==0)?6:(i==1)?1:(i==2)?5:2):((i==0)?7:(i==1)?0:(i==2)?4:3); return true; }
    const int L=i*G+vcu; if(L>=1024)return false; u.bh=L>>3; u.qb=L&7; return true; }
  __device__ __forceinline__ void a_ready(const AttnUnit&)const{}
  __device__ __forceinline__ void done(const AttnUnit&)const{}
};
template<class Sched,int THRL=8> __device__ __forceinline__ void attn_phase(char*lds,const AttnTensors&T,const Sched&S){
  AttnUnit u;
  for(int i=0;S.next(i,u);++i){ S.a_ready(u); attn_unit<THRL>(u.bh/NHEAD,u.bh%NHEAD,u.qb,T.Q,T.K,T.V,T.O,T.kbar,lds); S.done(u); }
}
#undef SBAR
#undef WAIT_BAR
}
constexpr int NWAVES = 8;
constexpr int T = 32768, D = 1024, SEQ = 2048, MEMROWS = 4096, INW = 5120;
constexpr float RMS_EPS = 1e-6f;
constexpr size_t MiB = 1u << 20;
constexpr size_t WS_CTL = 0, CTL_ZERO_BYTES = 2 * MiB, WS_KBAR = 1 * MiB;
constexpr size_t WS_WIN = 2 * MiB, WS_WC = 12 * MiB, WS_WA = 13 * MiB, WS_WM = 14 * MiB, WS_WXQ = 16 * MiB, WS_WXKV = 18 * MiB, WS_WXO = 22 * MiB, WS_MT = 24 * MiB, WS_ROPE = 28 * MiB;
constexpr size_t WS_MEMN = 32 * MiB, WS_KX = 40 * MiB, WS_VXT = 48 * MiB;
constexpr size_t WS_SSQ1 = 30 * MiB, WS_SSQ2 = 56 * MiB;
constexpr size_t WS_A = 64 * MiB;
constexpr size_t WS_YC = 128 * MiB, WS_QO = 160 * MiB, WS_U = 192 * MiB, WS_K = 224 * MiB, WS_V = 256 * MiB;
constexpr size_t WS_SGC = 320 * MiB, WS_SGA = 384 * MiB;
constexpr size_t WS_A8I = 320 * MiB, WS_ASC = 352 * MiB;
constexpr size_t WS_EIDX = 448 * MiB, WS_GW = 464 * MiB, WS_PW = 480 * MiB, WS_END = 496 * MiB;
constexpr size_t WS_U8 = 288 * MiB, WS_V8T = 304 * MiB, WS_SU = 29 * MiB, WS_SV = 29 * MiB + 512 * 1024;
constexpr size_t WS_QX = 128 * MiB, WS_PM = 192 * MiB, WS_OX = 128 * MiB;
constexpr size_t WS_PO = 128 * MiB;
constexpr size_t WS_SC = 128 * MiB;
constexpr int CW_TMO = 0, CW_BAR = 4096, CW_Q = 8192;
constexpr int RING_OFF = 0, RING_BYTES = 131072;
constexpr int LDSCTL_OFF = RING_BYTES, MISC_OFF = LDSCTL_OFF + 320;
constexpr int LDS_BYTES = 163840;
constexpr int UL_OFF = RING_BYTES + 512, UL_WAVE = (LDS_BYTES - UL_OFF) / 8, UL_CAP = ((UL_WAVE - 64) / 8) & ~15;

#define GAS __attribute__((address_space(1)))
#define LAS __attribute__((address_space(3)))
typedef unsigned short bf16;
typedef unsigned v4u __attribute__((ext_vector_type(4)));
typedef unsigned v2u __attribute__((ext_vector_type(2)));
typedef float v2f __attribute__((ext_vector_type(2)));
typedef float f32x4 __attribute__((ext_vector_type(4)));
typedef float f32x2v __attribute__((ext_vector_type(2)));
typedef _Float16 h2v __attribute__((ext_vector_type(2)));
typedef GAS unsigned gu32;
#define RLX_AGENT __ATOMIC_RELAXED, __HIP_MEMORY_SCOPE_AGENT
#define LDS_WAIT() asm volatile("s_waitcnt lgkmcnt(0)" ::: "memory")
#define VM_WAIT() asm volatile("s_waitcnt vmcnt(0)" ::: "memory")
__device__ __forceinline__ unsigned pk2(float lo, float hi) { return pg8::cvt_pk_bf16(lo, hi); }
__device__ __forceinline__ float bflo(unsigned u) { return __uint_as_float(u << 16); }
__device__ __forceinline__ float bfhi(unsigned u) { return __uint_as_float(u & 0xffff0000u); }

#define XB_TMO      128
#define XB_XCNT(j)  (256  + 64 * (j))
#define XB_XSUB(j)  (1280 + 64 * (j))
#define XB_XGEN(j)  (2304 + 64 * (j))
#define XB_TOP      3328
#define XB_TOPGEN   3392
#define XCD_BAR_WORDS 3456
#define XB_SPIN_CAP (1u << 18)
__device__ __forceinline__ unsigned xb_ld(unsigned* p)              { return __hip_atomic_load(p, __ATOMIC_RELAXED, __HIP_MEMORY_SCOPE_AGENT); }
__device__ __forceinline__ unsigned xb_add(unsigned* p, unsigned v) { return __hip_atomic_fetch_add(p, v, __ATOMIC_RELAXED, __HIP_MEMORY_SCOPE_AGENT); }
__device__ __forceinline__ unsigned xb_xcc_id() { return (unsigned)__builtin_amdgcn_s_getreg((3 << 11) | 20) & 0xFu; }
#define XB_SPIN(cond, bar) do { unsigned _sp = 0; while (cond) { __builtin_amdgcn_s_sleep(1); \
    if ((++_sp & 255u) == 0u) { if (xb_ld(&(bar)[XB_TMO])) break; if (_sp > XB_SPIN_CAP) { atomicAdd(&(bar)[XB_TMO], 1u); break; } } } } while (0)
struct XcdBarrier { unsigned* bar; unsigned x; volatile LAS unsigned* st; };
__device__ __forceinline__ XcdBarrier xcd_barrier_post(unsigned* bar, volatile LAS unsigned* st) {
    XcdBarrier b; b.bar = bar; b.x = xb_xcc_id(); b.st = st;
    if (threadIdx.x == 0) (void)xb_add(&bar[XB_XCNT(b.x)], 1u);
    return b;
}
__device__ __forceinline__ void xcd_barrier_complete(unsigned* bar, unsigned x, unsigned& nloc, unsigned& nx) {
    const unsigned G = gridDim.x * gridDim.y * gridDim.z;
    unsigned sum, cnt, mine, sp = 0u;
    for (;;) {
        sum = 0u; cnt = 0u; mine = 0u;
#pragma unroll
        for (unsigned j = 0; j < 16; ++j) { const unsigned c = xb_ld(&bar[XB_XCNT(j)]); sum += c; cnt += (c > 0u) ? 1u : 0u; mine = (j == x) ? c : mine; }
        if (sum == G) break;
        __builtin_amdgcn_s_sleep(1);
        if ((++sp & 255u) == 0u) { if (xb_ld(&bar[XB_TMO])) break; if (sp > XB_SPIN_CAP) { atomicAdd(&bar[XB_TMO], 1u); break; } }
    }
    nloc = mine > 0u ? mine : 1u; nx = cnt > 0u ? cnt : 1u;
}
__device__ __forceinline__ void xcd_barrier(const XcdBarrier& b) {
    asm volatile("s_waitcnt vmcnt(0)" ::: "memory");
    __syncthreads();
    if (threadIdx.x == 0) {
        unsigned* bar = b.bar;
        __builtin_amdgcn_s_waitcnt(0);
        unsigned nloc = b.st[0], nx = b.st[1];
        if (nloc == 0u) { xcd_barrier_complete(bar, b.x, nloc, nx); b.st[0] = nloc; b.st[1] = nx; }
        const unsigned old = xb_add(&bar[XB_XSUB(b.x)], 1u);
        const unsigned gen = old / nloc;
        if (old + 1u == (gen + 1u) * nloc) {
            __builtin_amdgcn_fence(__ATOMIC_RELEASE, "agent");
            asm volatile("s_waitcnt vmcnt(0)" ::: "memory");
            const unsigned og = xb_add(&bar[XB_TOP], 1u);
            const unsigned tg = og / nx;
            if (og + 1u == (tg + 1u) * nx) xb_add(&bar[XB_TOPGEN], 1u);
            else XB_SPIN(xb_ld(&bar[XB_TOPGEN]) == tg, bar);
            __builtin_amdgcn_fence(__ATOMIC_ACQUIRE, "agent");
            xb_add(&bar[XB_XGEN(b.x)], 1u);
            asm volatile("s_waitcnt vmcnt(0)" ::: "memory");
        } else {
            XB_SPIN(xb_ld(&bar[XB_XGEN(b.x)]) == gen, bar);
            __builtin_amdgcn_fence(__ATOMIC_ACQUIRE, "agent");
            asm volatile("s_waitcnt vmcnt(0)" ::: "memory");
        }
    }
    __syncthreads();
}

struct MapId { static __device__ __forceinline__ int src(int j) { return j; } };
struct MapWin {
    static __device__ __forceinline__ int src(int j) {
        if (j < 1024) { const int g8 = j >> 3, i = j & 7; return ((i < 4) ? 0 : 1024) + 4 * g8 + (i & 3); }
        if (j < 1536) return 512 + (j - 1024);
        if (j < 2560) { const int jj = j - 1536, qk = jj >> 9, p = jj & 511, head = p >> 6, pl = p & 63, g = pl >> 3, i = pl & 7; return 1536 + qk * 512 + head * 64 + 4 * g + (i & 3) + 32 * (i >> 2); }
        return j;
    }
};
template <class MAP>
__device__ __forceinline__ void p0_transpose_item(const float* W, int K, int N, int NOUT, bf16* WT, LAS float* scr, int item, int lane, const float* gain = nullptr) {
    const int nblk = NOUT / 32, kb = item / nblk, nb = item % nblk, k0 = 64 * kb, n0 = 32 * nb;
    const int sc = MAP::src(n0 + (lane & 31));
    float wv[32];
#pragma unroll
    for (int i = 0; i < 32; ++i) wv[i] = W[(size_t)(k0 + 2 * i + (lane >> 5)) * N + sc];
#pragma unroll
    for (int i = 0; i < 32; ++i) { const int kk = 2 * i + (lane >> 5); const float gk = gain ? gain[k0 + kk] : 1.f; scr[kk * 33 + (lane & 31)] = wv[i] * gk; }
    LDS_WAIT(); asm volatile("" ::: "memory");
    const int c = lane & 7;
#pragma unroll
    for (int j = 0; j < 4; ++j) { const int n = (lane >> 3) + 8 * j; const LAS float* s = scr + (8 * c) * 33 + n;
        v4u o; o.x = pk2(s[0 * 33], s[1 * 33]); o.y = pk2(s[2 * 33], s[3 * 33]); o.z = pk2(s[4 * 33], s[5 * 33]); o.w = pk2(s[6 * 33], s[7 * 33]);
        *(GAS v4u*)(WT + (size_t)(n0 + n) * K + k0 + 8 * c) = o; }
    LDS_WAIT(); asm volatile("" ::: "memory");
}
__device__ __forceinline__ void rms_row_to_bf16(const float* xrow, const float* g, bf16* orow, int lane) {
    const GAS f32x4* xr = (const GAS f32x4*)xrow + lane; const GAS f32x4* gr = (const GAS f32x4*)g + lane;
    f32x4 v[4]; float s = 0.f;
#pragma unroll
    for (int j = 0; j < 4; ++j) { v[j] = xr[64 * j]; s += (v[j].x * v[j].x + v[j].y * v[j].y) + (v[j].z * v[j].z + v[j].w * v[j].w); }
    const float r = rsqrtf(wave_sum(s) * (1.f / 1024.f) + RMS_EPS);
    GAS v2u* o8 = (GAS v2u*)orow + lane;
#pragma unroll
    for (int j = 0; j < 4; ++j) { const f32x4 gg = gr[64 * j]; v2u w; w.x = pk2(v[j].x * r * gg.x, v[j].y * r * gg.y); w.y = pk2(v[j].z * r * gg.z, v[j].w * r * gg.w); o8[64 * j] = w; }
}
template <int NR>
__device__ __forceinline__ void rms_rows_to_bf16(const float* x, const float* g, bf16* o, int m0, int stride, int lane) {
    f32x4 v[NR][4];
#pragma unroll
    for (int i = 0; i < NR; ++i) { const GAS f32x4* xr = (const GAS f32x4*)(x + (size_t)(m0 + i * stride) * 1024) + lane;
#pragma unroll
        for (int j = 0; j < 4; ++j) v[i][j] = xr[64 * j]; }
    f32x4 gg[4];
#pragma unroll
    for (int j = 0; j < 4; ++j) gg[j] = ((const GAS f32x4*)g + lane)[64 * j];
#pragma unroll
    for (int i = 0; i < NR; ++i) { float s = 0.f;
#pragma unroll
        for (int j = 0; j < 4; ++j) s += (v[i][j].x * v[i][j].x + v[i][j].y * v[i][j].y) + (v[i][j].z * v[i][j].z + v[i][j].w * v[i][j].w);
        const float r = rsqrtf(wave_sum(s) * (1.f / 1024.f) + RMS_EPS);
        GAS v2u* o8 = (GAS v2u*)(o + (size_t)(m0 + i * stride) * 1024) + lane;
#pragma unroll
        for (int j = 0; j < 4; ++j) { v2u w; w.x = pk2(v[i][j].x * r * gg[j].x, v[i][j].y * r * gg[j].y); w.y = pk2(v[i][j].z * r * gg[j].z, v[i][j].w * r * gg[j].w); o8[64 * j] = w; } }
}
__device__ __forceinline__ float fmax_asm(float a, float b) { float r; asm("v_max_f32 %0, %1, %2" : "=v"(r) : "v"(a), "v"(b)); return r; }
__device__ __forceinline__ float fmin_asm(float a, float b) { float r; asm("v_min_f32 %0, %1, %2" : "=v"(r) : "v"(a), "v"(b)); return r; }

#ifndef PH_MASK
#define PH_MASK 0xFFFFFFFFu
#endif
#define PH(k) ((PH_MASK >> (k)) & 1u)
#ifndef REP_MASK
#define REP_MASK 0u
#endif
#define NREP(k) (((REP_MASK >> (k)) & 1u) ? 2 : 1)
#ifndef DIAG_TS_A
#define DIAG_TS_A -1
#endif
#ifndef DIAG_TS_B
#define DIAG_TS_B -1
#endif
struct Args { const float* in[19]; float* out; unsigned char* ws; };

struct XOrder {
    const char* A; const char* Bt; int G, c, i0, mode;
    __device__ bool next(int i, pg8::Unit& u) const {
        if (i > 0) return false;
        const int L = i0 * G + c; if (L >= 512) return false;
        const int b = L >> 5, head = (L >> 3) & 3, rt = L & 7;
        u.pm = b * 8 + rt; u.pn = head;
        if (mode == 0) { u.a = A + (size_t)(b * 2048 + rt * 256) * 1024 * 2; u.b = Bt + (size_t)(head * 256) * 1024 * 2; }
        else { u.a = A + ((size_t)(b * 2048 + rt * 256) * 1024 + head * 256) * 2;
               u.b = (mode == 2) ? Bt + ((size_t)(head * 256) * 4096 + b * 256) * 2 : Bt + ((size_t)(b * 256) * 1024 + head * 256) * 2; }
        return true;
    }
};

__global__ void __launch_bounds__(NWAVES * 64, 2) mk_fwd(Args args) {
    extern __shared__ __attribute__((aligned(16))) unsigned char lds[];
    LAS unsigned char* L = (LAS unsigned char*)lds;
    volatile LAS unsigned* MISC = (volatile LAS unsigned*)(L + MISC_OFF);
    const int wave = __builtin_amdgcn_readfirstlane((int)threadIdx.x >> 6);
#define PH_LANES int tid = threadIdx.x; asm volatile("" : "+v"(tid)); const int lane = tid & 63; const int gt = vcu * (NWAVES * 64) + tid; (void)lane; (void)gt
    const int G = gridDim.x; const int bx = blockIdx.x; const int vcu = (G % 8 == 0) ? (bx % 8) * (G / 8) + bx / 8 : bx;
    unsigned char* ws = args.ws;
    gu32* ctl = (gu32*)(ws + WS_CTL);
    for (int u = threadIdx.x; u < (LDS_BYTES - LDSCTL_OFF) / 4; u += NWAVES * 64) ((LAS unsigned*)(L + LDSCTL_OFF))[u] = 0u;
    __syncthreads();
    XcdBarrier bar = xcd_barrier_post((unsigned*)(ctl + CW_BAR), MISC + 8);
    unsigned long long* tsw = (unsigned long long*)(ws + WS_CTL + 65536);
    int n_ts = 0;
#define TSTAMP() do { if (DIAG_TS_A >= 0) { if (bx == 0 && threadIdx.x == 0) tsw[n_ts] = __builtin_amdgcn_s_memrealtime(); ++n_ts; } } while (0)
    TSTAMP();

    const float *x = args.in[0], *mem = args.in[1], *g_mix = args.in[2], *w_in = args.in[3], *w_conv = args.in[4], *w_conv_out = args.in[5], *w_attn_out = args.in[6], *w_merge = args.in[7],
                *g_xattn = args.in[8], *g_mem = args.in[9], *w_xq = args.in[10], *w_xkv = args.in[11], *w_xo = args.in[12], *g_ffn = args.in[13], *w_pq = args.in[14], *sub_keys = args.in[15],
                *peer_u = args.in[16], *peer_v = args.in[17], *g_final = args.in[18];
    float* out = args.out;
    bf16 *WinT = (bf16*)(ws + WS_WIN), *WcT = (bf16*)(ws + WS_WC), *WaT = (bf16*)(ws + WS_WA), *WmT = (bf16*)(ws + WS_WM), *WxqT = (bf16*)(ws + WS_WXQ), *WxkvT = (bf16*)(ws + WS_WXKV),
         *WxoT = (bf16*)(ws + WS_WXO), *MT = (bf16*)(ws + WS_MT);
    float* ropec = (float*)(ws + WS_ROPE); float* ropes = ropec + 2048 * 32;
    float* kbar = (float*)(ws + WS_KBAR);
    bf16 *MEMN = (bf16*)(ws + WS_MEMN), *KX = (bf16*)(ws + WS_KX), *VXT = (bf16*)(ws + WS_VXT), *A = (bf16*)(ws + WS_A);
    bf16 *YC = (bf16*)(ws + WS_YC), *QO = (bf16*)(ws + WS_QO), *U = (bf16*)(ws + WS_U), *KB = (bf16*)(ws + WS_K), *VB = (bf16*)(ws + WS_V), *SGC = (bf16*)(ws + WS_SGC), *SGA = (bf16*)(ws + WS_SGA);
    bf16 *QX = (bf16*)(ws + WS_QX), *PM = (bf16*)(ws + WS_PM), *OX = (bf16*)(ws + WS_OX);
    _Float16* SC = (_Float16*)(ws + WS_SC);
    unsigned char* A8I = ws + WS_A8I; float* ASC = (float*)(ws + WS_ASC);
    int* EIDX = (int*)(ws + WS_EIDX); float* GW = (float*)(ws + WS_GW); unsigned* PW = (unsigned*)(ws + WS_PW);
    float* PO = (float*)(ws + WS_PO); float* SSQ1 = (float*)(ws + WS_SSQ1); float* SSQ2 = (float*)(ws + WS_SSQ2); (void)PO;
    unsigned char* U8 = ws + WS_U8; unsigned char* V8T = ws + WS_V8T; float* SU = (float*)(ws + WS_SU); float* SV = (float*)(ws + WS_SV);
    const int gw = vcu * NWAVES + wave, NGW = G * NWAVES;
    const int NGT = G * NWAVES * 64;

    asm volatile("; ===== PHASE 0 =====");
    if (PH(0)) for (int rep = 0; rep < NREP(0); ++rep) {
        PH_LANES; const bool dummy = rep < NREP(0) - 1; (void)dummy;
        LAS float* scr = (LAS float*)(L + RING_OFF + wave * 16384);
        constexpr int I_IN = (1024 / 64) * (5120 / 32), I_C = (512 / 64) * (1024 / 32), I_M = (1024 / 64) * (1024 / 32), I_KV = (1024 / 64) * (2048 / 32);
        constexpr int NITEMS = I_IN + 2 * I_C + 3 * I_M + I_KV;
        for (int it = gw; it < NITEMS; it += NGW) {
            int r = it;
            if (r < I_IN) { p0_transpose_item<MapWin>(w_in, 1024, 5120, 5120, WinT, scr, r, lane); continue; } r -= I_IN;
            if (r < I_C) { p0_transpose_item<MapId>(w_conv_out, 512, 1024, 1024, WcT, scr, r, lane); continue; } r -= I_C;
            if (r < I_C) { p0_transpose_item<MapId>(w_attn_out, 512, 1024, 1024, WaT, scr, r, lane); continue; } r -= I_C;
            if (r < I_M) { p0_transpose_item<MapId>(w_merge, 1024, 1024, 1024, WmT, scr, r, lane); continue; } r -= I_M;
            if (r < I_M) { p0_transpose_item<MapId>(w_xq, 1024, 1024, 1024, WxqT, scr, r, lane, g_xattn); continue; } r -= I_M;
            if (r < I_M) { p0_transpose_item<MapId>(w_xo, 1024, 1024, 1024, WxoT, scr, r, lane); continue; } r -= I_M;
            p0_transpose_item<MapId>(w_xkv, 1024, 2048, 2048, WxkvT, scr, r, lane);
        }
        { int m = gw; for (; m + 3 * NGW < T; m += 4 * NGW) rms_rows_to_bf16<4>(x, g_mix, A, m, NGW, lane); for (; m < T; m += NGW) rms_row_to_bf16(x + (size_t)m * D, g_mix, A + (size_t)m * D, lane); }
        { int m = gw; for (; m + NGW < MEMROWS; m += 2 * NGW) rms_rows_to_bf16<2>(mem, g_mem, MEMN, m, NGW, lane); for (; m < MEMROWS; m += NGW) rms_row_to_bf16(mem + (size_t)m * D, g_mem, MEMN + (size_t)m * D, lane); }
        for (int i = gt; i < 2048 * 32; i += NGT) { const int pos = i >> 5, f = i & 31; const float inv = powf(10000.0f, -(float)f / 32.0f); const float ang = (float)pos * inv; ropec[i] = cosf(ang); ropes[i] = sinf(ang); }
        __syncthreads();
        {
            LAS float* skl = (LAS float*)(L + RING_OFF);
            LAS float* wtl = skl + 128 * 129;
            for (int it = bx; it < 256; it += G) {
                const int hp = it >> 4, cb = it & 15;
                for (int i = tid; i < 128 * 128; i += NWAVES * 64) { const int n = i >> 7, d = i & 127; skl[n * 129 + d] = sub_keys[((size_t)hp * 128 + n) * 128 + d]; }
                for (int i = tid; i < 64 * 128; i += NWAVES * 64) { const int c = i >> 7, d = i & 127; wtl[c * 129 + d] = w_pq[(size_t)(cb * 64 + c) * 2048 + hp * 128 + d] * g_ffn[cb * 64 + c]; }
                __syncthreads();
                const int cg = tid & 15, ng = tid >> 4;
                float acc[4][4];
#pragma unroll
                for (int i = 0; i < 4; ++i)
#pragma unroll
                    for (int j = 0; j < 4; ++j) acc[i][j] = 0.f;
                for (int d = 0; d < 128; ++d) {
                    float wv[4], sv[4];
#pragma unroll
                    for (int i = 0; i < 4; ++i) { wv[i] = wtl[(4 * cg + i) * 129 + d]; sv[i] = skl[(4 * ng + i) * 129 + d]; }
#pragma unroll
                    for (int i = 0; i < 4; ++i)
#pragma unroll
                        for (int j = 0; j < 4; ++j) acc[i][j] += sv[i] * wv[j];
                }
#pragma unroll
                for (int i = 0; i < 4; ++i) { v2u w; w.x = pk2(acc[i][0], acc[i][1]); w.y = pk2(acc[i][2], acc[i][3]); *(GAS v2u*)(MT + (size_t)(hp * 128 + 4 * ng + i) * 1024 + cb * 64 + 4 * cg) = w; }
                __syncthreads();
            }
        }
    }
    xcd_barrier(bar); TSTAMP();

    asm volatile("; ===== PHASE 1 =====");
    if (PH(1)) for (int rep = 0; rep < NREP(1); ++rep) {
        PH_LANES; const bool dummy = rep < NREP(1) - 1; (void)dummy;
        pg8::Gemm g{1024, 1024, 1024}; pg8::StaticOrder S; S.init(A, 1024, WinT, 1024, T, INW, G, bx);
        pg8::EpiIn E{U, YC, QO, KB, VB, SGC, SGA, ropec, ropes, kbar, 0.125f * 1.4426950408889634f};
        pg8::gemm_phase<pg8::EpiIn, pg8::StaticOrder, true>(L + RING_OFF, g, S, E);
    }
    if (PH(1)) for (int rep = 0; rep < NREP(1); ++rep) {
        PH_LANES; const bool dummy = rep < NREP(1) - 1; (void)dummy;
        pg8::Gemm g{1024, 1024, 1024}; pg8::StaticOrder S; S.init(MEMN, 1024, WxkvT, 1024, MEMROWS, 1024, G, bx);
        pg8::EpiBf16 E{KX, 1024};
        pg8::gemm_phase<pg8::EpiBf16, pg8::StaticOrder, true>(L + RING_OFF, g, S, E);
    }
    if (PH(1)) for (int rep = 0; rep < NREP(1); ++rep) {
        PH_LANES; const bool dummy = rep < NREP(1) - 1; (void)dummy;
        pg8::Gemm g{1024, 1024, 1024}; pg8::StaticOrder S; S.init(WxkvT + (size_t)1024 * 1024, 1024, MEMN, 1024, 1024, MEMROWS, G, (bx + 128) % G);
        pg8::EpiBf16 E{VXT, 4096};
        pg8::gemm_phase<pg8::EpiBf16, pg8::StaticOrder, true>(L + RING_OFF, g, S, E);
    }
    if (PH(1)) for (int rep = 0; rep < NREP(1); ++rep) {
        PH_LANES; const bool dummy = rep < NREP(1) - 1; (void)dummy;
        int cb, ncb;
        if (G == 256) { const bool idle = (bx >= 64 && bx < 128) || bx >= 192; cb = idle ? ((bx < 128) ? bx - 64 : bx - 128) : 256; ncb = 128; } else { cb = bx; ncb = G; }
        const int cw = cb * NWAVES + wave, ncw = ncb * NWAVES;
        for (int e = (cb < ncb ? cw : 16384); e < 16384; e += ncw) {
            const GAS f32x4* r = (const GAS f32x4*)(peer_u + (size_t)e * D) + lane; f32x4 v[4]; float am = 0.f;
#pragma unroll
            for (int j = 0; j < 4; ++j) { v[j] = r[64 * j] * ((const GAS f32x4*)g_ffn + lane)[64 * j]; am = fmaxf(fmaxf(am, fmaxf(fabsf(v[j].x), fabsf(v[j].y))), fmaxf(fabsf(v[j].z), fabsf(v[j].w))); }
            am = wave_max(am);
            const float sc = am > 0.f ? 7.f / am : 1.f; int ns = 0;
#pragma unroll
            for (int j = 0; j < 2; ++j) {
                const int l0 = (int)rintf(v[j].x * sc) + 8, l1 = (int)rintf(v[j].y * sc) + 8, l2 = (int)rintf(v[j].z * sc) + 8, l3 = (int)rintf(v[j].w * sc) + 8;
                const int h0 = (int)rintf(v[j + 2].x * sc) + 8, h1 = (int)rintf(v[j + 2].y * sc) + 8, h2 = (int)rintf(v[j + 2].z * sc) + 8, h3 = (int)rintf(v[j + 2].w * sc) + 8;
                ns += (l0 + l1) + (l2 + l3) + (h0 + h1) + (h2 + h3);
                *(GAS unsigned*)(U8 + (size_t)e * 512 + 4 * lane + 256 * j) = (unsigned)(l0 | (h0 << 4)) | ((unsigned)(l1 | (h1 << 4)) << 8) | ((unsigned)(l2 | (h2 << 4)) << 16) | ((unsigned)(l3 | (h3 << 4)) << 24); }
            const float nsf = wave_sum((float)ns);
            if (lane == 0) { SU[4 * e] = am > 0.f ? am * (1.f / 7.f) : 1.f; SU[4 * e + 2] = nsf; }
        }
        __syncthreads();
        for (int it = cb; it < 256; it += ncb) {
            const int e0 = it * 64;
#pragma unroll 1
            for (int rr = 0; rr < 8; ++rr) {
                const int el = wave * 8 + rr, e = e0 + el;
                const GAS f32x4* r = (const GAS f32x4*)(peer_v + (size_t)e * D) + lane; f32x4 v[4]; float am = 0.f;
#pragma unroll
                for (int j = 0; j < 4; ++j) { v[j] = r[64 * j]; am = fmaxf(fmaxf(am, fmaxf(fabsf(v[j].x), fabsf(v[j].y))), fmaxf(fabsf(v[j].z), fabsf(v[j].w))); }
                am = wave_max(am);
                const float sc = am > 0.f ? 4.f / am : 1.f; if (lane == 0) SU[4 * e + 1] = am > 0.f ? am * 0.25f : 1.f;
#pragma unroll
                for (int j = 0; j < 4; ++j) { int w = __builtin_amdgcn_cvt_pk_bf8_f32(v[j].x * sc, v[j].y * sc, 0, false); w = __builtin_amdgcn_cvt_pk_bf8_f32(v[j].z * sc, v[j].w * sc, w, true);
                    *(LAS unsigned*)(L + RING_OFF + el * 1024 + 4 * lane + 256 * j) = (unsigned)w; }
            }
            __syncthreads();
#pragma unroll
            for (int i = 0; i < 8; ++i) { const int idx = tid + 512 * i, sl = idx >> 5, k = idx & 31;
                const v2u a0 = *(const LAS v2u*)(L + RING_OFF + (2 * k) * 1024 + sl * 8), a1 = *(const LAS v2u*)(L + RING_OFF + (2 * k + 1) * 1024 + sl * 8);
                *(GAS v4u*)(V8T + ((size_t)sl * 16384 + e0 + 2 * k) * 8) = (v4u){a0.x, a0.y, a1.x, a1.y}; }
            __syncthreads();
        }
    }
    xcd_barrier(bar); TSTAMP();

    asm volatile("; ===== PHASE 2 =====");
    if (PH(2)) for (int rep = 0; rep < NREP(2); ++rep) {
        PH_LANES; const bool dummy = rep < NREP(2) - 1; (void)dummy;
        for (int i = gt; i < T * 64; i += NGT) {
            const int row = i >> 6, cg = i & 63, s = row & 2047;
            const v4u u0 = *(const GAS v4u*)(U + (size_t)row * 512 + cg * 8);
            v4u u1 = (v4u){0u, 0u, 0u, 0u}, u2 = (v4u){0u, 0u, 0u, 0u};
            if (s >= 1) u1 = *(const GAS v4u*)(U + (size_t)(row - 1) * 512 + cg * 8);
            if (s >= 2) u2 = *(const GAS v4u*)(U + (size_t)(row - 2) * 512 + cg * 8);
            const v4u bq = *(const GAS v4u*)(YC + (size_t)row * 512 + cg * 8);
            const f32x4 w0a = *(const GAS f32x4*)(w_conv + cg * 8), w0b = *(const GAS f32x4*)(w_conv + cg * 8 + 4);
            const f32x4 w1a = *(const GAS f32x4*)(w_conv + 512 + cg * 8), w1b = *(const GAS f32x4*)(w_conv + 512 + cg * 8 + 4);
            const f32x4 w2a = *(const GAS f32x4*)(w_conv + 1024 + cg * 8), w2b = *(const GAS f32x4*)(w_conv + 1024 + cg * 8 + 4);
            v4u o;
#define CONV2(q, wa, ia, ib) pk2(bflo(bq.q) * (w0##wa[ia] * bflo(u2.q) + w1##wa[ia] * bflo(u1.q) + w2##wa[ia] * bflo(u0.q)), bfhi(bq.q) * (w0##wa[ib] * bfhi(u2.q) + w1##wa[ib] * bfhi(u1.q) + w2##wa[ib] * bfhi(u0.q)))
            o.x = CONV2(x, a, 0, 1); o.y = CONV2(y, a, 2, 3); o.z = CONV2(z, b, 0, 1); o.w = CONV2(w, b, 2, 3);
#undef CONV2
            { const bool conv_dummy = (NREP(2) == 2) && !dummy; *(GAS v4u*)(YC + (size_t)row * 512 + cg * 8) = conv_dummy ? bq : o; }
        }
        __syncthreads();
        const attn_body::AttnTensors AT{(const attn_body::bf16*)QO, (const attn_body::bf16*)KB, (const attn_body::bf16*)VB, (attn_body::bf16*)(dummy ? A : QO), kbar};
        const attn_body::StaticOrder S(G, bx);
        attn_body::attn_phase<attn_body::StaticOrder>((char*)lds + RING_OFF, AT, S);
    }
    xcd_barrier(bar); TSTAMP();

    asm volatile("; ===== PHASE 3 =====");
    if (PH(3)) for (int rep = 0; rep < NREP(3); ++rep) {
        PH_LANES; const bool dummy = rep < NREP(3) - 1; (void)dummy;
        pg8::Gemm g{512, 512, 512}; pg8::StaticOrder S; S.init(YC, 512, WcT, 512, T, 1024, G, bx);
        pg8::EpiGateMul E{SGC, dummy ? A : SGC, 1024};
        pg8::gemm_phase<pg8::EpiGateMul, pg8::StaticOrder, true>(L + RING_OFF, g, S, E);
    }
    if (PH(3)) for (int rep = 0; rep < NREP(3); ++rep) {
        PH_LANES; const bool dummy = rep < NREP(3) - 1; (void)dummy;
        pg8::Gemm g{512, 512, 512}; pg8::StaticOrder S; S.init(QO, 512, WaT, 512, T, 1024, G, bx);
        pg8::EpiGateFma E{SGC, SGA, dummy ? A : SGA, 1024};
        pg8::gemm_phase<pg8::EpiGateFma, pg8::StaticOrder, true>(L + RING_OFF, g, S, E);
    }
    xcd_barrier(bar); TSTAMP();

    asm volatile("; ===== PHASE 4 =====");
    if (PH(4)) for (int rep = 0; rep < NREP(4); ++rep) {
        PH_LANES; const bool dummy = rep < NREP(4) - 1; (void)dummy;
        pg8::Gemm g{1024, 1024, 1024}; pg8::StaticOrder S; S.init(SGA, 1024, WmT, 1024, T, 1024, G, bx);
        pg8::EpiResNorm<true> E{x, A, SSQ1, 1024, 1.f};
        pg8::gemm_phase<pg8::EpiResNorm<true>, pg8::StaticOrder, true>(L + RING_OFF, g, S, E);
    }
    xcd_barrier(bar); TSTAMP();

    asm volatile("; ===== PHASE 6 =====");
    if (PH(6)) for (int rep = 0; rep < NREP(6); ++rep) {
        PH_LANES; const bool dummy = rep < NREP(6) - 1; (void)dummy;
        const pg8::Gemm gq{1024, 1024, 1024}, gs{1024, 1024, 256}, gv{1024, 4096, 256};
        const pg8::EpiBf16RS Eq{QX, 1024, SSQ1}; const pg8::EpiSoftmax Es{PM, 1024, 0.0625f * 1.4426950408889634f}; const pg8::EpiBf16 Ev{OX, 1024};
        { XOrder S{(const char*)A, (const char*)WxqT, G, vcu, 0, 0}; pg8::gemm_phase<pg8::EpiBf16RS, XOrder, false>(L + RING_OFF, gq, S, Eq); }
        VM_WAIT(); __syncthreads();
        { XOrder S{(const char*)QX, (const char*)KX, G, vcu, 0, 1}; pg8::gemm_phase<pg8::EpiSoftmax, XOrder, false>(L + RING_OFF, gs, S, Es); }
        VM_WAIT(); __syncthreads();
        { XOrder S{(const char*)PM, (const char*)VXT, G, vcu, 0, 2}; pg8::gemm_phase<pg8::EpiBf16, XOrder, false>(L + RING_OFF, gv, S, Ev); }
        VM_WAIT(); __syncthreads();
        { XOrder S{(const char*)A, (const char*)WxqT, G, vcu, 1, 0}; pg8::gemm_phase<pg8::EpiBf16RS, XOrder, false>(L + RING_OFF, gq, S, Eq); }
        VM_WAIT(); __syncthreads();
        { XOrder S{(const char*)QX, (const char*)KX, G, vcu, 1, 1}; pg8::gemm_phase<pg8::EpiSoftmax, XOrder, false>(L + RING_OFF, gs, S, Es); }
        VM_WAIT(); __syncthreads();
        { XOrder S{(const char*)PM, (const char*)VXT, G, vcu, 1, 2}; pg8::gemm_phase<pg8::EpiBf16, XOrder, false>(L + RING_OFF, gv, S, Ev); }
    }
    xcd_barrier(bar); TSTAMP();

    asm volatile("; ===== PHASE 9 =====");
    if (PH(9)) for (int rep = 0; rep < NREP(9); ++rep) {
        PH_LANES; const bool dummy = rep < NREP(9) - 1; (void)dummy;
        pg8::Gemm g{1024, 1024, 1024}; pg8::StaticOrder S; S.init(OX, 1024, WxoT, 1024, T, 1024, G, bx);
        pg8::EpiResNorm<false> E{nullptr, A, SSQ2, 1024, dummy ? 0.f : 1.f};
        pg8::gemm_phase<pg8::EpiResNorm<false>, pg8::StaticOrder, true>(L + RING_OFF, g, S, E);
    }
    xcd_barrier(bar); TSTAMP();

    asm volatile("; ===== PHASE 11 =====");
    if (PH(11)) for (int rep = 0; rep < NREP(11); ++rep) {
        PH_LANES; const bool dummy = rep < NREP(11) - 1; (void)dummy;
        pg8::Gemm g{1024, 1024, 1024}; pg8::StaticOrder S; S.init(A, 1024, MT, 1024, T, 2048, G, bx);
        pg8::EpiF16RS E{SC, 2048, SSQ2};
        pg8::gemm_phase<pg8::EpiF16RS, pg8::StaticOrder, true>(L + RING_OFF, g, S, E);
    }
    xcd_barrier(bar); TSTAMP();

    asm volatile("; ===== PHASE 12 =====");
    if (PH(12)) for (int rep = 0; rep < NREP(12); ++rep) {
        PH_LANES; const bool dummy = rep < NREP(12) - 1; (void)dummy;
        typedef _Float16 h8 __attribute__((ext_vector_type(8)));
#define RCE(a, b) do { const float hi_ = fmax_asm(a, b); b = fmin_asm(a, b); a = hi_; } while (0)
#define RSORT16(K) do { RCE(K[0], K[1]); RCE(K[3], K[2]); RCE(K[4], K[5]); RCE(K[7], K[6]); RCE(K[8], K[9]); RCE(K[11], K[10]); RCE(K[12], K[13]); RCE(K[15], K[14]); RCE(K[0], K[2]); RCE(K[1], K[3]); RCE(K[6], K[4]); RCE(K[7], K[5]); RCE(K[8], K[10]); RCE(K[9], K[11]); RCE(K[14], K[12]); RCE(K[15], K[13]); RCE(K[0], K[1]); RCE(K[2], K[3]); RCE(K[5], K[4]); RCE(K[7], K[6]); RCE(K[8], K[9]); RCE(K[10], K[11]); RCE(K[13], K[12]); RCE(K[15], K[14]); RCE(K[0], K[4]); RCE(K[1], K[5]); RCE(K[2], K[6]); RCE(K[3], K[7]); RCE(K[12], K[8]); RCE(K[13], K[9]); RCE(K[14], K[10]); RCE(K[15], K[11]); RCE(K[0], K[2]); RCE(K[1], K[3]); RCE(K[4], K[6]); RCE(K[5], K[7]); RCE(K[10], K[8]); RCE(K[11], K[9]); RCE(K[14], K[12]); RCE(K[15], K[13]); RCE(K[0], K[1]); RCE(K[2], K[3]); RCE(K[4], K[5]); RCE(K[6], K[7]); RCE(K[9], K[8]); RCE(K[11], K[10]); RCE(K[13], K[12]); RCE(K[15], K[14]); RCE(K[0], K[8]); RCE(K[1], K[9]); RCE(K[2], K[10]); RCE(K[3], K[11]); RCE(K[4], K[12]); RCE(K[5], K[13]); RCE(K[6], K[14]); RCE(K[7], K[15]); RCE(K[0], K[4]); RCE(K[1], K[5]); RCE(K[2], K[6]); RCE(K[3], K[7]); RCE(K[8], K[12]); RCE(K[9], K[13]); RCE(K[10], K[14]); RCE(K[11], K[15]); RCE(K[0], K[2]); RCE(K[1], K[3]); RCE(K[4], K[6]); RCE(K[5], K[7]); RCE(K[8], K[10]); RCE(K[9], K[11]); RCE(K[12], K[14]); RCE(K[13], K[15]); RCE(K[0], K[1]); RCE(K[2], K[3]); RCE(K[4], K[5]); RCE(K[6], K[7]); RCE(K[8], K[9]); RCE(K[10], K[11]); RCE(K[12], K[13]); RCE(K[14], K[15]); } while (0)
#define RMERGE16(K) do { RCE(K[0], K[8]); RCE(K[1], K[9]); RCE(K[2], K[10]); RCE(K[3], K[11]); RCE(K[4], K[12]); RCE(K[5], K[13]); RCE(K[6], K[14]); RCE(K[7], K[15]); RCE(K[0], K[4]); RCE(K[1], K[5]); RCE(K[2], K[6]); RCE(K[3], K[7]); RCE(K[8], K[12]); RCE(K[9], K[13]); RCE(K[10], K[14]); RCE(K[11], K[15]); RCE(K[0], K[2]); RCE(K[1], K[3]); RCE(K[4], K[6]); RCE(K[5], K[7]); RCE(K[8], K[10]); RCE(K[9], K[11]); RCE(K[12], K[14]); RCE(K[13], K[15]); RCE(K[0], K[1]); RCE(K[2], K[3]); RCE(K[4], K[5]); RCE(K[6], K[7]); RCE(K[8], K[9]); RCE(K[10], K[11]); RCE(K[12], K[13]); RCE(K[14], K[15]); } while (0)
#define RKEYS(K, V0, V1, IDB) do { _Pragma("unroll") for (int e = 0; e < 8; ++e) { K[e] = __uint_as_float(__float_as_uint((float)V0[e]) | (unsigned)((IDB) + e)); K[8 + e] = __uint_as_float(__float_as_uint((float)V1[e]) | (unsigned)((IDB) + 8 + e)); } } while (0)
        for (int tb4 = gw * 4; tb4 < T; tb4 += NGW * 4) {
            v4u r0[4], r1[4]; float sq[4];
#pragma unroll
            for (int i = 0; i < 4; ++i) { const GAS v4u* ar = (const GAS v4u*)(A + (size_t)(tb4 + i) * D + 16 * lane); r0[i] = ar[0]; r1[i] = ar[1]; sq[i] = lane < 16 ? SSQ2[(size_t)(tb4 + i) * 16 + lane] : 0.f; }
#pragma unroll
            for (int i = 0; i < 4; ++i) {
                float a[16];
                a[0] = bflo(r0[i].x); a[1] = bfhi(r0[i].x); a[2] = bflo(r0[i].y); a[3] = bfhi(r0[i].y); a[4] = bflo(r0[i].z); a[5] = bfhi(r0[i].z); a[6] = bflo(r0[i].w); a[7] = bfhi(r0[i].w);
                a[8] = bflo(r1[i].x); a[9] = bfhi(r1[i].x); a[10] = bflo(r1[i].y); a[11] = bfhi(r1[i].y); a[12] = bflo(r1[i].z); a[13] = bfhi(r1[i].z); a[14] = bflo(r1[i].w); a[15] = bfhi(r1[i].w);
                float amx = 0.f;
#pragma unroll
                for (int k = 0; k < 16; ++k) amx = fmaxf(amx, fabsf(a[k]));
                amx = wave_max(amx);
                const float rs2 = rsqrtf(wave_sum(sq[i]) * (1.f / 1024.f) + RMS_EPS);
                const float asc = amx > 0.f ? 127.f / amx : 1.f;
                v4u qv;
#define QP4(k) ((unsigned)((int)rintf(a[4 * (k)] * asc) + 128) | ((unsigned)((int)rintf(a[4 * (k) + 1] * asc) + 128) << 8) | ((unsigned)((int)rintf(a[4 * (k) + 2] * asc) + 128) << 16) | ((unsigned)((int)rintf(a[4 * (k) + 3] * asc) + 128) << 24))
                qv.x = QP4(0); qv.y = QP4(1); qv.z = QP4(2); qv.w = QP4(3);
#undef QP4
                *(GAS v4u*)(A8I + (size_t)(tb4 + i) * 1024 + 16 * lane) = qv;
                float sa = 0.f;
#pragma unroll
                for (int k = 0; k < 16; ++k) sa += rintf(a[k] * asc);
                sa = wave_sum(sa);
                if (lane == 0) { ASC[tb4 + i] = (amx > 0.f ? amx * (1.f / 127.f) : 1.f) * rs2; ASC[T + tb4 + i] = sa + 131072.f; }
            }
        }
        LAS unsigned char* idl = L + RING_OFF + tid * 32;
        for (int task = gt; task < T * 8; task += NGT) {
            const int t = task >> 3, h = task & 7;
            const _Float16* row = SC + (size_t)t * 2048 + h * 256;
            float LA[16], LB[16];
#pragma unroll 1
            for (int p = 0; p < 2; ++p) {
                const _Float16* rp = row + p * 128;
                float Tk[16];
                h8 n0 = *(const h8*)(rp + 16), n1 = *(const h8*)(rp + 24);
                { const h8 v0 = *(const h8*)rp, v1 = *(const h8*)(rp + 8); RKEYS(Tk, v0, v1, 0); RSORT16(Tk); }
#pragma unroll 1
                for (int c = 1; c < 8; ++c) {
                    const h8 v0 = n0, v1 = n1;
                    { const int cn = c < 7 ? c + 1 : c; n0 = *(const h8*)(rp + cn * 16); n1 = *(const h8*)(rp + cn * 16 + 8); }
                    float K[16]; RKEYS(K, v0, v1, c * 16); RSORT16(K);
#pragma unroll
                    for (int i = 0; i < 16; ++i) Tk[i] = fmax_asm(Tk[i], K[15 - i]);
                    RMERGE16(Tk);
                }
#pragma unroll
                for (int k = 0; k < 16; ++k) { if (p == 0) LA[k] = Tk[k]; else LB[k] = Tk[k]; }
            }
#pragma unroll
            for (int k = 0; k < 16; k += 4) {
                ((LAS unsigned*)idl)[k >> 2] = (__float_as_uint(LA[k]) & 127u) | ((__float_as_uint(LA[k + 1]) & 127u) << 8) | ((__float_as_uint(LA[k + 2]) & 127u) << 16) | ((__float_as_uint(LA[k + 3]) & 127u) << 24);
                ((LAS unsigned*)idl)[4 + (k >> 2)] = (__float_as_uint(LB[k]) & 127u) | ((__float_as_uint(LB[k + 1]) & 127u) << 8) | ((__float_as_uint(LB[k + 2]) & 127u) << 16) | ((__float_as_uint(LB[k + 3]) & 127u) << 24);
            }
#define CKEY(a, b) __uint_as_float((__float_as_uint(LA[a] + LB[b]) & ~255u) | (unsigned)(255 - (16 * (a) + (b))))
            float Ck[16];
#pragma unroll
            for (int a = 0; a < 16; ++a) Ck[a] = CKEY(a, 0);
#define CRUN(b, n) do { _Pragma("unroll") for (int j = 0; j < (n); ++j) Ck[15 - j] = fmax_asm(Ck[15 - j], CKEY(j, b)); RMERGE16(Ck); } while (0)
            CRUN(1, 8); CRUN(2, 5); CRUN(3, 4); CRUN(4, 3); CRUN(5, 2); CRUN(6, 2); CRUN(7, 2);
#pragma unroll
            for (int j = 0; j < 8; ++j) Ck[15 - j] = fmax_asm(Ck[15 - j], CKEY(0, 8 + j));
            RMERGE16(Ck);
#undef CRUN
#undef CKEY
            LDS_WAIT();
            float ex[16]; float sum = 0.f;
#pragma unroll
            for (int k = 0; k < 16; ++k) { ex[k] = __expf(Ck[k] - Ck[0]); sum += ex[k]; }
            const float rs = 1.f / sum;
            int* eo = EIDX + (size_t)t * 128 + h * 16;
#pragma unroll
            for (int k = 0; k < 16; k += 4) {
                int ev[4];
#pragma unroll
                for (int j = 0; j < 4; ++j) { const unsigned id = 255u - (__float_as_uint(Ck[k + j]) & 255u); ev[j] = (int)idl[id >> 4] * 128 + (int)idl[16 + (id & 15u)]; }
                *(GAS v4u*)(eo + k) = (v4u){(pk2(0.f, ex[k] * rs) & 0xffff0000u) | (unsigned)ev[0], (pk2(0.f, ex[k + 1] * rs) & 0xffff0000u) | (unsigned)ev[1],
                                             (pk2(0.f, ex[k + 2] * rs) & 0xffff0000u) | (unsigned)ev[2], (pk2(0.f, ex[k + 3] * rs) & 0xffff0000u) | (unsigned)ev[3]};
            }
            LDS_WAIT();
        }
#undef RCE
#undef RSORT16
#undef RMERGE16
#undef RKEYS
    }
    xcd_barrier(bar); TSTAMP();

    asm volatile("; ===== PHASE 13 =====");
    if (PH(13)) for (int rep = 0; rep < NREP(13); ++rep) {
        PH_LANES; const bool dummy = rep < NREP(13) - 1; (void)dummy;
        volatile LAS unsigned* qslot = (volatile LAS unsigned*)(L + LDSCTL_OFF + 64);
        LAS unsigned char* tile = L + RING_OFF + wave * 8192;
        LAS float* rsl = (LAS float*)(L + UL_OFF + wave * UL_WAVE);
        LAS v2u* lst = (LAS v2u*)(L + UL_OFF + wave * UL_WAVE + 64);
        const int xs = (int)(xb_xcc_id() & 7u);
        __syncthreads();
        if (tid == 0) *qslot = __hip_atomic_fetch_add((unsigned*)(ctl + CW_Q + 64 * (rep * 8 + xs)), 1u, __ATOMIC_RELAXED, __HIP_MEMORY_SCOPE_AGENT);
        __syncthreads();
        const int rank = __builtin_amdgcn_readfirstlane((int)*qslot);
        int cnt[8];
#pragma unroll
        for (int j = 0; j < 8; ++j) cnt[j] = __builtin_amdgcn_readfirstlane((int)(xb_ld(bar.bar + XB_XCNT(j)) + xb_ld(bar.bar + XB_XCNT(j + 8))));
#pragma unroll 1
        for (int x = 0; x < 8; ++x) {
            int cn = 0;
#pragma unroll
            for (int j = 0; j < 8; ++j) cn = (j == x) ? cnt[j] : cn;
            int j0, jstep;
            if (x == xs) { j0 = rank * 8 + wave; jstep = cn * 8; } else if (cn == 0) { j0 = bx * 8 + wave; jstep = G * 8; } else continue;
#pragma unroll 1
            for (int job = j0; job < T / 8; job += jstep) {
                const int t0 = job * 8;
#pragma unroll 1
                for (int r0 = 0;; r0 += UL_CAP) {
                    int ln = lane; asm volatile("" : "+v"(ln));
#pragma unroll
                    for (int tl = 0; tl < 8; ++tl)
                        __builtin_amdgcn_global_load_lds((const unsigned*)(A8I + (size_t)(t0 + tl) * 1024 + ln * 16), (LAS unsigned*)(tile + tl * 1024), 16, 0, 0);
                    if (ln < 16) rsl[ln] = ASC[(ln & 8) * (T / 8) + t0 + (ln & 7)];
                    unsigned pa[8], pb[8];
#pragma unroll
                    for (int tl = 0; tl < 8; ++tl) { pa[tl] = (unsigned)EIDX[(size_t)(t0 + tl) * 128 + ln]; pb[tl] = (unsigned)EIDX[(size_t)(t0 + tl) * 128 + 64 + ln]; }
                    int total = 0; unsigned long long m0s[8], m1s[8];
#pragma unroll
                    for (int tl = 0; tl < 8; ++tl) { m0s[tl] = __ballot((int)((pa[tl] & 0xffffu) >> 11) == x); m1s[tl] = __ballot((int)((pb[tl] & 0xffffu) >> 11) == x); total += __popcll(m0s[tl]) + __popcll(m1s[tl]); }
                    asm volatile("s_waitcnt vmcnt(0)" ::: "memory");
                    int base = -r0;
#pragma unroll
                    for (int tl = 0; tl < 8; ++tl) {
                        const int n0 = __popcll(m0s[tl]), n1 = __popcll(m1s[tl]);
                        const int k0 = base + (int)__builtin_amdgcn_mbcnt_hi((unsigned)(m0s[tl] >> 32), __builtin_amdgcn_mbcnt_lo((unsigned)m0s[tl], 0u));
                        const int k1 = base + n0 + (int)__builtin_amdgcn_mbcnt_hi((unsigned)(m1s[tl] >> 32), __builtin_amdgcn_mbcnt_lo((unsigned)m1s[tl], 0u));
                        if (((m0s[tl] >> lane) & 1ull) && k0 >= 0 && k0 < UL_CAP) lst[k0] = (v2u){pa[tl], (unsigned)((tl << 7) | lane)};
                        if (((m1s[tl] >> lane) & 1ull) && k1 >= 0 && k1 < UL_CAP) lst[k1] = (v2u){pb[tl], (unsigned)((tl << 7) | 64 | lane)};
                        base += n0 + n1;
                    }
                    const int count = (total - r0) < UL_CAP ? (total - r0) : UL_CAP;
                    asm volatile("s_waitcnt lgkmcnt(0)" ::: "memory");
#define JLOAD(Q, EN, B16) do { const int myi_ = (B16) + (lane >> 2); EN = lst[myi_ < count ? myi_ : count - 1];         \
                        const unsigned char* rp_ = U8 + (size_t)(EN.x & 0xffffu) * 512 + (lane & 3) * 16; \
                        EN##s = *(const GAS f32x4*)(SU + 4 * (EN.x & 0xffffu));                                      \
                        _Pragma("unroll") for (int j = 0; j < 8; ++j) Q[j] = *(const GAS v4u*)(rp_ + j * 64); } while (0)
#define UD4(w, aa, acc) __builtin_amdgcn_udot4((unsigned)(w), (unsigned)(aa), (unsigned)(acc), false)
#define JCOMP(Q, EN, B16) do { const LAS unsigned char* ap_ = tile + (EN.y >> 7) * 1024 + (lane & 3) * 16; unsigned d0 = 0, d1 = 0, d2 = 0, d3 = 0, g0 = 0, g1 = 0, g2 = 0, g3 = 0; \
                        _Pragma("unroll") for (int j = 0; j < 8; ++j) { const v4u ql_ = *(const LAS v4u*)(ap_ + j * 64), qh_ = *(const LAS v4u*)(ap_ + 512 + j * 64);        \
                            d0 = UD4(Q[j].x & 0x0f0f0f0fu, ql_.x, d0); d1 = UD4(Q[j].y & 0x0f0f0f0fu, ql_.y, d1); d2 = UD4(Q[j].z & 0x0f0f0f0fu, ql_.z, d2); d3 = UD4(Q[j].w & 0x0f0f0f0fu, ql_.w, d3); \
                            g0 = UD4(Q[j].x & 0xf0f0f0f0u, qh_.x, g0); g1 = UD4(Q[j].y & 0xf0f0f0f0u, qh_.y, g1); g2 = UD4(Q[j].z & 0xf0f0f0f0u, qh_.z, g2); g3 = UD4(Q[j].w & 0xf0f0f0f0u, qh_.w, g3); } \
                        int doti = (int)(((d0 + d1) + (d2 + d3)) + ((((g0 + g1) + (g2 + g3))) >> 4));                       \
                        doti += __builtin_amdgcn_ds_swizzle(doti, (1 << 10) | 0x1f); doti += __builtin_amdgcn_ds_swizzle(doti, (2 << 10) | 0x1f);        \
                        if ((lane & 3) == 0 && (B16) + (lane >> 2) < count) { \
                            const int e = (int)(EN.x & 0xffffu), slot = (int)(EN.y & 127u); const int tl_ = (int)(EN.y >> 7); const int t = t0 + tl_; \
                            const float dq = ((float)doti - 128.f * EN##s.z) - (8.f * rsl[8 + tl_] - 1048576.f);               \
                            const float act = dq * (EN##s.x * rsl[tl_]); const float u3 = 0.7978845608028654f * (act + 0.044715f * act * act * act); \
                            const float wv = act * __builtin_amdgcn_rcpf(1.f + __expf(-2.f * u3)) * (__uint_as_float(EN.x & 0xffff0000u) * EN##s.y);             \
                            PW[((size_t)((t >> 6) * 8 + (slot >> 4)) * 4 + ((slot >> 2) & 3)) * 256 + (t & 63) * 4 + (slot & 3)] = ((unsigned)__builtin_bit_cast(unsigned short, (_Float16)wv) << 16) | (unsigned)e;     } } while (0)
                    if (count > 0) {
                        v4u qa[8], qb[8], qc[8], qd[8]; v2u ena, enb, enc, end_; f32x4 enas, enbs, encs, end_s;
                        JLOAD(qa, ena, 0);
                        if (16 < count) JLOAD(qb, enb, 16);
                        if (32 < count) JLOAD(qc, enc, 32);
                        int b16 = 0;
#pragma unroll 1
                        for (; b16 + 96 < count; b16 += 64) {
                            JLOAD(qd, end_, b16 + 48); JCOMP(qa, ena, b16);
                            JLOAD(qa, ena, b16 + 64); JCOMP(qb, enb, b16 + 16);
                            JLOAD(qb, enb, b16 + 80); JCOMP(qc, enc, b16 + 32);
                            JLOAD(qc, enc, b16 + 96); JCOMP(qd, end_, b16 + 48);
                        }
#pragma unroll 1
                        for (; b16 < count; b16 += 64) {
                            if (b16 + 48 < count) JLOAD(qd, end_, b16 + 48);
                            JCOMP(qa, ena, b16);
                            if (b16 + 16 < count) { if (b16 + 64 < count) JLOAD(qa, ena, b16 + 64); JCOMP(qb, enb, b16 + 16); }
                            if (b16 + 32 < count) { if (b16 + 80 < count) JLOAD(qb, enb, b16 + 80); JCOMP(qc, enc, b16 + 32); }
                            if (b16 + 48 < count) { if (b16 + 96 < count) JLOAD(qc, enc, b16 + 96); JCOMP(qd, end_, b16 + 48); }
                        }
                    }
#undef UD4
#undef JLOAD
#undef JCOMP
                    asm volatile("s_waitcnt lgkmcnt(0)" ::: "memory");
                    if (r0 + UL_CAP >= total) break;
                }
            }
        }
        __syncthreads();
    }
    xcd_barrier(bar); TSTAMP();

    asm volatile("; ===== PHASE 14 =====");
    if (PH(14)) for (int rep = 0; rep < NREP(14); ++rep) {
        PH_LANES; const bool dummy = rep < NREP(14) - 1; (void)dummy;
        for (int item = vcu; item < 256; item += G) {
            const int sl = item & 127, half = item >> 7;
            __syncthreads();
#pragma unroll
            for (int i = 0; i < 16; ++i) *(LAS v4u*)(L + RING_OFF + (i * 512 + tid) * 16) = *(const GAS v4u*)(V8T + (size_t)sl * 131072 + (size_t)(i * 512 + tid) * 16);
            __syncthreads();
            const GAS v4u* pwb = (const GAS v4u*)(PW + (size_t)(half * 256 + wave) * 8192) + lane;
            v4u buf[4][4];
#pragma unroll
            for (int c = 0; c < 4; ++c)
#pragma unroll
                for (int k = 0; k < 4; ++k) buf[c][k] = pwb[c * 256 + k * 64];
#pragma unroll 1
            for (int itk = 0; itk < 32; ++itk) {
                const int g64 = half * 256 + itk * 8 + wave;
                const int t = g64 * 64 + lane;
                unsigned accu[4] = {0u, 0u, 0u, 0u};
#pragma unroll
                for (int c = 0; c < 8; ++c) {
                    v4u cur[4];
#pragma unroll
                    for (int k = 0; k < 4; ++k) cur[k] = buf[c & 3][k];
                    { const int sn = itk * 8 + c + 4; const int gn = (sn >> 3) > 31 ? 31 : (sn >> 3), cc = sn & 7; const GAS v4u* src = pwb + (size_t)gn * 8 * 2048 + cc * 256;
#pragma unroll
                      for (int k = 0; k < 4; ++k) buf[c & 3][k] = src[k * 64]; }
                    v2u tb[16];
#pragma unroll
                    for (int k = 0; k < 4; ++k)
#pragma unroll
                        for (int i = 0; i < 4; ++i) { unsigned e_ = cur[k][i] & 0xffffu; asm("" : "+v"(e_));
                            tb[k * 4 + i] = *(const LAS v2u*)(L + RING_OFF + (e_ << 3)); }
#pragma unroll
                    for (int k = 0; k < 4; ++k)
#pragma unroll
                        for (int i = 0; i < 4; ++i) { const unsigned p = cur[k][i]; const v2u q = tb[k * 4 + i];
#define VFMA(ACC, T) asm("v_pk_fma_f16 %0, %1, %2, %0 op_sel:[0,1,0] op_sel_hi:[1,1,1]" : "+v"(ACC) : "v"(T), "v"(p))
                            const unsigned t0_ = __builtin_amdgcn_perm(0u, q.x, 0x010c000cu), t1_ = __builtin_amdgcn_perm(0u, q.x, 0x030c020cu), t2_ = __builtin_amdgcn_perm(0u, q.y, 0x010c000cu), t3_ = __builtin_amdgcn_perm(0u, q.y, 0x030c020cu);
                            VFMA(accu[0], t0_); VFMA(accu[1], t1_); VFMA(accu[2], t2_); VFMA(accu[3], t3_);
#undef VFMA
                        }
                }
                GAS v4u* hr = (GAS v4u*)(A + (size_t)t * D + sl * 8);
                const v4u hq = *hr; const float mulv = dummy ? 0.f : 1.f;
                h2v acc[4];
#pragma unroll
                for (int i = 0; i < 4; ++i) { const unsigned au_ = accu[i]; acc[i] = __builtin_bit_cast(h2v, au_); }
                v4u ho; ho.x = pk2(bflo(hq.x) + (float)acc[0].x * mulv, bfhi(hq.x) + (float)acc[0].y * mulv); ho.y = pk2(bflo(hq.y) + (float)acc[1].x * mulv, bfhi(hq.y) + (float)acc[1].y * mulv);
                ho.z = pk2(bflo(hq.z) + (float)acc[2].x * mulv, bfhi(hq.z) + (float)acc[2].y * mulv); ho.w = pk2(bflo(hq.w) + (float)acc[3].x * mulv, bfhi(hq.w) + (float)acc[3].y * mulv);
                *hr = ho;
            }
        }
    }
    xcd_barrier(bar); TSTAMP();

#ifdef EXTRA_BARRIERS
    for (int eb = 0; eb < EXTRA_BARRIERS; ++eb) xcd_barrier(bar);
#endif
    asm volatile("; ===== PHASE 15 =====");
    if (PH(15)) for (int rep = 0; rep < NREP(15); ++rep) {
        PH_LANES; const bool dummy = rep < NREP(15) - 1; (void)dummy;
        for (int t = gw; t < T; t += NGW) {
            const GAS v4u* hr = (const GAS v4u*)(A + (size_t)t * D + 16 * lane); const v4u q0 = hr[0], q1 = hr[1];
            const GAS f32x4* gr = (const GAS f32x4*)(g_final + 16 * lane); GAS f32x4* orow = (GAS f32x4*)(out + (size_t)t * D + 16 * lane);
            f32x4 o[4] = {(f32x4){bflo(q0.x), bfhi(q0.x), bflo(q0.y), bfhi(q0.y)}, (f32x4){bflo(q0.z), bfhi(q0.z), bflo(q0.w), bfhi(q0.w)},
                          (f32x4){bflo(q1.x), bfhi(q1.x), bflo(q1.y), bfhi(q1.y)}, (f32x4){bflo(q1.z), bfhi(q1.z), bflo(q1.w), bfhi(q1.w)}};
            float ss = 0.f;
#pragma unroll
            for (int j = 0; j < 4; ++j) ss += (o[j].x * o[j].x + o[j].y * o[j].y) + (o[j].z * o[j].z + o[j].w * o[j].w);
            const float r = rsqrtf(wave_sum(ss) * (1.f / 1024.f) + RMS_EPS);
#pragma unroll
            for (int j = 0; j < 4; ++j) orow[j] = o[j] * r * gr[j];
        }
    }
}

extern "C" void kernel_launch(void* const* d_in, const int* in_sizes, int n_in, void* d_out, int out_size, void* d_ws, size_t ws_size, hipStream_t stream) {
    static int grid = 0;
    if (grid == 0) {
        if (n_in != 19 || out_size != T * D || ws_size < WS_END) { fprintf(stderr, "kernel_launch: unexpected problem (n_in %d, out %d, ws %zu < %zu); nothing launched\n", n_in, out_size, ws_size, (size_t)WS_END); grid = -1; return; }
        int dev = 0, cus = 0, per_cu = 0;
        if (hipGetDevice(&dev) != hipSuccess || hipDeviceGetAttribute(&cus, hipDeviceAttributeMultiprocessorCount, dev) != hipSuccess) { grid = -1; return; }
        if (hipFuncSetAttribute((const void*)mk_fwd, hipFuncAttributeMaxDynamicSharedMemorySize, LDS_BYTES) != hipSuccess) { fprintf(stderr, "kernel_launch: hipFuncSetAttribute failed\n"); grid = -1; return; }
        if (hipOccupancyMaxActiveBlocksPerMultiprocessor(&per_cu, (const void*)mk_fwd, NWAVES * 64, LDS_BYTES) != hipSuccess || per_cu < 1) { fprintf(stderr, "kernel_launch: occupancy query says %d blocks per CU\n", per_cu); }
        (void)hipGetLastError();
        grid = cus;
    }
    if (grid < 0) return;
    if (hipMemsetAsync((char*)d_ws + WS_CTL, 0, CTL_ZERO_BYTES, stream) != hipSuccess) return;
    Args a{};
    for (int i = 0; i < 19; ++i) a.in[i] = (const float*)d_in[i];
    a.out = (float*)d_out; a.ws = (unsigned char*)d_ws;
    hipLaunchKernelGGL(mk_fwd, dim3(grid), dim3(NWAVES * 64), LDS_BYTES, stream, a);
}
```

```cpp
#include <hip/hip_runtime.h>
#include <hip/hip_bf16.h>
#include <cstdio>
#include <cstdint>
#include <cmath>

#ifndef DIAG
#define DIAG 0
#endif


template <int O> __device__ __forceinline__ float shx(float v) { static_assert(O > 0 && O < 32, "shx"); return __uint_as_float((unsigned)__builtin_amdgcn_ds_swizzle((int)__float_as_uint(v), (O << 10) | 0x1f)); }
__device__ __forceinline__ float sum32(float v) { auto r = __builtin_amdgcn_permlane32_swap(__float_as_uint(v), __float_as_uint(v), false, false); return __uint_as_float(r[0]) + __uint_as_float(r[1]); }
__device__ __forceinline__ float max32(float v) { auto r = __builtin_amdgcn_permlane32_swap(__float_as_uint(v), __float_as_uint(v), false, false); return fmaxf(__uint_as_float(r[0]), __uint_as_float(r[1])); }
__device__ __forceinline__ float wave_max(float v) { v = fmaxf(v, shx<1>(v)); v = fmaxf(v, shx<2>(v)); v = fmaxf(v, shx<4>(v)); v = fmaxf(v, shx<8>(v)); v = fmaxf(v, shx<16>(v)); return max32(v); }
__device__ __forceinline__ float wave_sum(float v) { v += shx<1>(v); v += shx<2>(v); v += shx<4>(v); v += shx<8>(v); v += shx<16>(v); return sum32(v); }

namespace pg8 {
#define PG8_LAS __attribute__((address_space(3)))
typedef unsigned short bf16_t;
typedef short bf16x8 __attribute__((ext_vector_type(8)));
typedef float f32x4 __attribute__((ext_vector_type(4)));
typedef float f32x2 __attribute__((ext_vector_type(2)));
typedef unsigned u32x4 __attribute__((ext_vector_type(4)));
typedef unsigned u32x2 __attribute__((ext_vector_type(2)));
constexpr int BM = 256, BK = 64, HALF = 128, HTB = HALF * BK * 2  , STAGE_BYTES = 8 * HTB, NXCD = 8, WGM = 4;

__host__ __device__ __forceinline__ int lds_byte(int r, int c) { const int st = (r >> 4) * 2 + (c >> 5), rr = r & 15, cc = c & 31, ob = rr * 64 + cc * 2; return st * 1024 + (ob ^ (((ob >> 9) & 1) << 5)); }
__host__ __device__ __forceinline__ void stage_rc(int b, int& R, int& C) { const int st = b / 1024, sb = b % 1024, swz = sb ^ (((sb >> 9) & 1) << 5); R = (st >> 1) * 16 + swz / 64; C = (st & 1) * 32 + (swz % 64) / 2; }
__host__ __device__ __forceinline__ int perm32(int rho) { const int n = rho >> 4, i = rho & 15; return 8 * (i >> 2) + 4 * n + (i & 3); }

struct Unit { int pm, pn; const char* a; const char* b; };
struct Gemm { int lda, ldb, K; };

struct StaticOrder {
    int nM, nN, nwg, G, c; const char* A; const char* Bt; size_t astep, bstep;
    __device__ void init(const void* A_, int lda, const void* Bt_, int ldb, int M, int N, int G_, int c_) { nM = M / BM; nN = N / BM; nwg = nM * nN; G = G_; c = c_; A = (const char*)A_; Bt = (const char*)Bt_; astep = (size_t)BM * lda * 2; bstep = (size_t)BM * ldb * 2; }
    __device__ bool next(int i, Unit& u) const {
        const long L = (long)i * G + c; if (L >= nwg) return false;
        int wgid = (int)L; { const int q = nwg / NXCD, r = nwg % NXCD, xcd = wgid % NXCD, off = wgid / NXCD; wgid = (xcd < r ? xcd * (q + 1) : r * (q + 1) + (xcd - r) * q) + off; }
        const int nig = WGM * nN, gid = wgid / nig, fm = gid * WGM, gsz = (nM - fm) < WGM ? (nM - fm) : WGM;
        u.pm = fm + ((wgid % nig) % gsz); u.pn = (wgid % nig) / gsz; u.a = A + (size_t)u.pm * astep; u.b = Bt + (size_t)u.pn * bstep; return true;
    }
};

__device__ __forceinline__ unsigned cvt_pk_bf16(float lo, float hi) { typedef __bf16 bf2 __attribute__((ext_vector_type(2))); f32x2 v = {lo, hi}; bf2 b = __builtin_convertvector(v, bf2); return __builtin_bit_cast(unsigned, b); }
__device__ __forceinline__ float bf_lo(unsigned u) { return __uint_as_float(u << 16); }
__device__ __forceinline__ float bf_hi(unsigned u) { return __uint_as_float(u & 0xffff0000u); }

template <class Epi, class Sched, bool ALIGN_EPI>
__device__ __forceinline__ void gemm_phase(PG8_LAS unsigned char* lds, const Gemm g, const Sched& S, const Epi& E) {
    int tid = threadIdx.x; asm volatile("" : "+v"(tid));
    const int wid = __builtin_amdgcn_readfirstlane(tid >> 6), lane = tid & 63, wr = wid >> 2, wc = wid & 3, fr = lane & 15, fq = lane >> 4;
    const int K = g.K, nt = K / BK;
    unsigned voffA[2], voffB[2];
#pragma unroll
    for (int i = 0; i < 2; ++i) { int R, C; stage_rc(tid * 16 + i * 8192, R, C); const int Rb = Epi::PERM ? ((R & ~31) + perm32(R & 31)) : R;
        voffA[i] = (unsigned)(R * g.lda + C) * 2u; voffB[i] = (unsigned)(Rb * g.ldb + C) * 2u; }
    const size_t kstep = (size_t)(BK * 2);
    const size_t hstepA = (size_t)HALF * g.lda * 2, hstepB = (size_t)HALF * g.ldb * 2;
    const unsigned ldsw = (unsigned)wid * 1024u;
    const int aoff = lds_byte(wr * 64 + fr, fq * 8), boff = lds_byte(wc * 32 + fr, fq * 8);
#define PG8_SA(b, h) (((b) * 2 + (h)) * HTB)
#define PG8_SB(b, h) ((4 + (b) * 2 + (h)) * HTB)
#define PG8_STAGE(bufoff, gbase, voff) do { _Pragma("unroll") for (int _i = 0; _i < 2; ++_i) \
        __builtin_amdgcn_global_load_lds((const unsigned*)((const char*)(gbase) + (voff)[_i]), (PG8_LAS unsigned*)(lds + (bufoff) + ldsw + _i * 8192), 16, 0, 0); } while (0)
#define PG8_LDA(dst, b, h) do { _Pragma("unroll") for (int m = 0; m < 4; ++m) _Pragma("unroll") for (int k = 0; k < 2; ++k) dst[m][k] = *(const PG8_LAS bf16x8*)(lds + PG8_SA(b, h) + aoff + m * 2048 + k * 1024); } while (0)
#define PG8_LDB(dst, b, h) do { _Pragma("unroll") for (int n = 0; n < 2; ++n) _Pragma("unroll") for (int k = 0; k < 2; ++k) dst[n][k] = *(const PG8_LAS bf16x8*)(lds + PG8_SB(b, h) + boff + n * 2048 + k * 1024); } while (0)
#define PG8_MMA(ai, bj, At, Bt) do { __builtin_amdgcn_s_setprio(1); _Pragma("unroll") for (int m = 0; m < 4; ++m) _Pragma("unroll") for (int n = 0; n < 2; ++n) _Pragma("unroll") for (int k = 0; k < 2; ++k) \
        acc[ai][bj][m][n] = __builtin_amdgcn_mfma_f32_16x16x32_bf16(Bt[n][k], At[m][k], acc[ai][bj][m][n], 0, 0, 0); __builtin_amdgcn_s_setprio(0); } while (0)
#define PG8_WAIT_V(n) asm volatile("s_waitcnt vmcnt(" #n ")" ::: "memory")
#define PG8_WAIT_L(n) asm volatile("s_waitcnt lgkmcnt(" #n ")" ::: "memory")
#define PG8_BAR __builtin_amdgcn_s_barrier()
#define PG8_SCHED __builtin_amdgcn_sched_barrier(0)
    Unit cur, nxt; int ui = 0;
    if (!S.next(0, cur)) return;
    f32x4 acc[2][2][4][2];
#pragma unroll
    for (int a = 0; a < 2; ++a)
#pragma unroll
        for (int b = 0; b < 2; ++b)
#pragma unroll
            for (int m = 0; m < 4; ++m)
#pragma unroll
                for (int n = 0; n < 2; ++n) acc[a][b][m][n] = (f32x4){0.f, 0.f, 0.f, 0.f};
    bf16x8 At[4][2], B0[2][2], B1[2][2];
    const char* cA = cur.a; const char* cB = cur.b;
    PG8_STAGE(PG8_SB(0, 0), cB, voffB); PG8_STAGE(PG8_SB(0, 1), cB + hstepB, voffB); PG8_STAGE(PG8_SA(0, 0), cA, voffA); PG8_STAGE(PG8_SA(0, 1), cA + hstepA, voffA);
    if (wr == 1) PG8_BAR;
    PG8_WAIT_V(2); PG8_BAR;
    PG8_STAGE(PG8_SB(1, 0), cB + kstep, voffB); PG8_STAGE(PG8_SA(1, 0), cA + kstep, voffA); PG8_STAGE(PG8_SB(1, 1), cB + hstepB + kstep, voffB);
    PG8_WAIT_V(6); PG8_BAR;
    for (;;) {
        const bool has_next = S.next(ui + 1, nxt);
        const char* nA = has_next ? nxt.a : cA; const char* nB = has_next ? nxt.b : cB;
        for (int t = 0; t < nt; t += 2) {
            const bool last = (t == nt - 2);
            const char* a1 = cA + (size_t)(t + 1) * kstep;
            const char* a2 = last ? nA : cA + (size_t)(t + 2) * kstep; const char* b2 = last ? nB : cB + (size_t)(t + 2) * kstep;
            const char* a3 = a2 + kstep; const char* b3 = b2 + kstep;
            PG8_LDB(B0, 0, 0); PG8_LDB(B1, 0, 1); PG8_SCHED; PG8_LDA(At, 0, 0); PG8_STAGE(PG8_SA(1, 1), a1 + hstepA, voffA);
            PG8_WAIT_V(8); PG8_WAIT_L(0); PG8_BAR; PG8_MMA(0, 0, At, B0); PG8_MMA(0, 1, At, B1); PG8_BAR; PG8_SCHED;
            PG8_LDA(At, 0, 1); PG8_STAGE(PG8_SB(0, 0), b2, voffB); PG8_STAGE(PG8_SB(0, 1), b2 + hstepB, voffB); PG8_STAGE(PG8_SA(0, 0), a2, voffA);
            PG8_WAIT_V(8); PG8_WAIT_L(0); PG8_BAR; PG8_MMA(1, 0, At, B0); PG8_MMA(1, 1, At, B1); PG8_BAR; PG8_SCHED;
            PG8_LDB(B0, 1, 0); PG8_LDB(B1, 1, 1); PG8_SCHED; PG8_LDA(At, 1, 0); PG8_STAGE(PG8_SA(0, 1), a2 + hstepA, voffA);
            PG8_WAIT_V(8); PG8_WAIT_L(0); PG8_BAR; PG8_MMA(0, 0, At, B0); PG8_MMA(0, 1, At, B1); PG8_BAR; PG8_SCHED;
            PG8_LDA(At, 1, 1); PG8_STAGE(PG8_SB(1, 0), b3, voffB); PG8_STAGE(PG8_SB(1, 1), b3 + hstepB, voffB); PG8_STAGE(PG8_SA(1, 0), a3, voffA);
            PG8_WAIT_V(8); PG8_WAIT_L(0); PG8_BAR; PG8_MMA(1, 0, At, B0); PG8_MMA(1, 1, At, B1); PG8_BAR; PG8_SCHED;
        }
        if constexpr (ALIGN_EPI) { if (wr == 0) PG8_BAR; }
        if constexpr (!Epi::AFTER_DRAIN) { E(acc, cur, wr, wc, fr, fq); }
        if (!has_next) break;
#pragma unroll
        for (int a = 0; a < 2; ++a)
#pragma unroll
            for (int b = 0; b < 2; ++b)
#pragma unroll
                for (int m = 0; m < 4; ++m)
#pragma unroll
                    for (int n = 0; n < 2; ++n) acc[a][b][m][n] = (f32x4){0.f, 0.f, 0.f, 0.f};
        cur = nxt; cA = nA; cB = nB; ++ui;
        if constexpr (ALIGN_EPI) { if (wr == 1) PG8_BAR; }
    }
    PG8_WAIT_V(0);
    if constexpr (!ALIGN_EPI) { if (wr == 0) PG8_BAR; }
    PG8_BAR;
    if constexpr (Epi::AFTER_DRAIN) { E.fused(acc, cur, wr, wc, fr, fq, lds, wid, lane); }
#undef PG8_SA
#undef PG8_SB
#undef PG8_STAGE
#undef PG8_LDA
#undef PG8_LDB
#undef PG8_MMA
#undef PG8_WAIT_V
#undef PG8_WAIT_L
#undef PG8_BAR
#undef PG8_SCHED
}

typedef f32x4 AccT[2][2][4][2];

struct EpiBf16 {
    static constexpr bool PERM = true, AFTER_DRAIN = false;
    bf16_t* O; int ldc;
    __device__ __forceinline__ void operator()(const AccT& acc, const Unit& u, int wr, int wc, int fr, int fq) const {
        { int t_ = threadIdx.x; asm volatile("" : "+v"(t_)); fr = t_ & 15; fq = (t_ >> 4) & 3; }
        const int row0 = u.pm * BM + wr * 64 + fr, col0 = u.pn * BM + wc * 32 + 8 * fq;
#pragma unroll
        for (int ai = 0; ai < 2; ++ai)
#pragma unroll
            for (int m = 0; m < 4; ++m) { bf16_t* rowp = O + (size_t)(row0 + ai * HALF + m * 16) * ldc + col0;
#pragma unroll
                for (int bj = 0; bj < 2; ++bj) { const f32x4 v0 = acc[ai][bj][m][0], v1 = acc[ai][bj][m][1];
                    u32x4 w; w.x = cvt_pk_bf16(v0[0], v0[1]); w.y = cvt_pk_bf16(v0[2], v0[3]); w.z = cvt_pk_bf16(v1[0], v1[1]); w.w = cvt_pk_bf16(v1[2], v1[3]);
                    *(u32x4*)(rowp + bj * HALF) = w; } }
    }
};
struct EpiF16 {
    static constexpr bool PERM = true, AFTER_DRAIN = false;
    _Float16* O; int ldc;
    __device__ __forceinline__ void operator()(const AccT& acc, const Unit& u, int wr, int wc, int fr, int fq) const {
        { int t_ = threadIdx.x; asm volatile("" : "+v"(t_)); fr = t_ & 15; fq = (t_ >> 4) & 3; }
        typedef _Float16 h8 __attribute__((ext_vector_type(8)));
        const int row0 = u.pm * BM + wr * 64 + fr, col0 = u.pn * BM + wc * 32 + 8 * fq;
#pragma unroll
        for (int ai = 0; ai < 2; ++ai)
#pragma unroll
            for (int m = 0; m < 4; ++m) { _Float16* rowp = O + (size_t)(row0 + ai * HALF + m * 16) * ldc + col0;
#pragma unroll
                for (int bj = 0; bj < 2; ++bj) { const f32x4 v0 = acc[ai][bj][m][0], v1 = acc[ai][bj][m][1];
                    h8 w = {(_Float16)v0[0], (_Float16)v0[1], (_Float16)v0[2], (_Float16)v0[3], (_Float16)v1[0], (_Float16)v1[1], (_Float16)v1[2], (_Float16)v1[3]};
                    *(h8*)(rowp + bj * HALF) = w; } }
    }
};
struct EpiGateMul {
    static constexpr bool PERM = true, AFTER_DRAIN = false;
    const bf16_t* G; bf16_t* Dst; int ldc;
    __device__ __forceinline__ void operator()(const AccT& acc, const Unit& u, int wr, int wc, int fr, int fq) const {
        { int t_ = threadIdx.x; asm volatile("" : "+v"(t_)); fr = t_ & 15; fq = (t_ >> 4) & 3; }
        const int row0 = u.pm * BM + wr * 64 + fr, col0 = u.pn * BM + wc * 32 + 8 * fq;
#pragma unroll
        for (int ai = 0; ai < 2; ++ai)
#pragma unroll
            for (int m = 0; m < 4; ++m) { const size_t roff = (size_t)(row0 + ai * HALF + m * 16) * ldc + col0; const bf16_t* rowg = G + roff; bf16_t* rowp = Dst + roff;
#pragma unroll
                for (int bj = 0; bj < 2; ++bj) { const f32x4 v0 = acc[ai][bj][m][0], v1 = acc[ai][bj][m][1]; const u32x4 gq = *(const u32x4*)(rowg + bj * HALF);
                    u32x4 w; w.x = cvt_pk_bf16(v0[0] * bf_lo(gq.x), v0[1] * bf_hi(gq.x)); w.y = cvt_pk_bf16(v0[2] * bf_lo(gq.y), v0[3] * bf_hi(gq.y));
                    w.z = cvt_pk_bf16(v1[0] * bf_lo(gq.z), v1[1] * bf_hi(gq.z)); w.w = cvt_pk_bf16(v1[2] * bf_lo(gq.w), v1[3] * bf_hi(gq.w));
                    *(u32x4*)(rowp + bj * HALF) = w; } }
    }
};
struct EpiGateFma {
    static constexpr bool PERM = true, AFTER_DRAIN = false;
    const bf16_t* Tm; const bf16_t* G2; bf16_t* Dst; int ldc;
    __device__ __forceinline__ void operator()(const AccT& acc, const Unit& u, int wr, int wc, int fr, int fq) const {
        { int t_ = threadIdx.x; asm volatile("" : "+v"(t_)); fr = t_ & 15; fq = (t_ >> 4) & 3; }
        const int row0 = u.pm * BM + wr * 64 + fr, col0 = u.pn * BM + wc * 32 + 8 * fq;
#pragma unroll
        for (int ai = 0; ai < 2; ++ai)
#pragma unroll
            for (int m = 0; m < 4; ++m) { const size_t off = (size_t)(row0 + ai * HALF + m * 16) * ldc + col0;
#pragma unroll
                for (int bj = 0; bj < 2; ++bj) { const f32x4 v0 = acc[ai][bj][m][0], v1 = acc[ai][bj][m][1]; const u32x4 gq = *(const u32x4*)(G2 + off + bj * HALF); const u32x4 tq = *(const u32x4*)(Tm + off + bj * HALF);
                    u32x4 w; w.x = cvt_pk_bf16(bf_lo(tq.x) + v0[0] * bf_lo(gq.x), bf_hi(tq.x) + v0[1] * bf_hi(gq.x)); w.y = cvt_pk_bf16(bf_lo(tq.y) + v0[2] * bf_lo(gq.y), bf_hi(tq.y) + v0[3] * bf_hi(gq.y));
                    w.z = cvt_pk_bf16(bf_lo(tq.z) + v1[0] * bf_lo(gq.z), bf_hi(tq.z) + v1[1] * bf_hi(gq.z)); w.w = cvt_pk_bf16(bf_lo(tq.w) + v1[2] * bf_lo(gq.w), bf_hi(tq.w) + v1[3] * bf_hi(gq.w));
                    *(u32x4*)(Dst + off + bj * HALF) = w; } }
    }
};
struct EpiResF32 {
    static constexpr bool PERM = false, AFTER_DRAIN = false;
    const float* res; float* out; int ldc; float mul;
    __device__ __forceinline__ void operator()(const AccT& acc, const Unit& u, int wr, int wc, int fr, int fq) const {
        { int t_ = threadIdx.x; asm volatile("" : "+v"(t_)); fr = t_ & 15; fq = (t_ >> 4) & 3; }
        const int row0 = u.pm * BM + wr * 64 + fr, col0 = u.pn * BM + wc * 32 + 4 * fq;
#pragma unroll
        for (int ai = 0; ai < 2; ++ai)
#pragma unroll
            for (int m = 0; m < 4; ++m) { const size_t off = (size_t)(row0 + ai * HALF + m * 16) * ldc + col0;
#pragma unroll
                for (int bj = 0; bj < 2; ++bj)
#pragma unroll
                    for (int n = 0; n < 2; ++n) { const f32x4 r = *(const f32x4*)(res + off + bj * HALF + n * 16); *(f32x4*)(out + off + bj * HALF + n * 16) = r + acc[ai][bj][m][n] * mul; } }
    }
};

__device__ __forceinline__ float row_rs(const float* ssq, int row) {
    const f32x4* p = (const f32x4*)(ssq + (size_t)row * 16); const f32x4 a = p[0], b = p[1], c = p[2], d = p[3];
    const float s = ((a[0] + a[1]) + (a[2] + a[3])) + ((b[0] + b[1]) + (b[2] + b[3])) + ((c[0] + c[1]) + (c[2] + c[3])) + ((d[0] + d[1]) + (d[2] + d[3]));
    return rsqrtf(s * (1.f / 1024.f) + 1e-6f);
}
struct EpiBf16RS {
    static constexpr bool PERM = true, AFTER_DRAIN = false;
    bf16_t* O; int ldc; const float* ssq;
    __device__ __forceinline__ void operator()(const AccT& acc, const Unit& u, int wr, int wc, int fr, int fq) const {
        { int t_ = threadIdx.x; asm volatile("" : "+v"(t_)); fr = t_ & 15; fq = (t_ >> 4) & 3; }
        const int row0 = u.pm * BM + wr * 64 + fr, col0 = u.pn * BM + wc * 32 + 8 * fq;
#pragma unroll
        for (int ai = 0; ai < 2; ++ai)
#pragma unroll
            for (int m = 0; m < 4; ++m) { int ro = row0 + ai * HALF + m * 16; asm volatile("" : "+v"(ro)); const float rs = row_rs(ssq, ro); bf16_t* rowp = O + (size_t)ro * ldc + col0;
#pragma unroll
                for (int bj = 0; bj < 2; ++bj) { const f32x4 v0 = acc[ai][bj][m][0] * rs, v1 = acc[ai][bj][m][1] * rs;
                    u32x4 w; w.x = cvt_pk_bf16(v0[0], v0[1]); w.y = cvt_pk_bf16(v0[2], v0[3]); w.z = cvt_pk_bf16(v1[0], v1[1]); w.w = cvt_pk_bf16(v1[2], v1[3]);
                    *(u32x4*)(rowp + bj * HALF) = w; } }
    }
};
struct EpiF16RS {
    static constexpr bool PERM = true, AFTER_DRAIN = false;
    _Float16* O; int ldc; const float* ssq;
    __device__ __forceinline__ void operator()(const AccT& acc, const Unit& u, int wr, int wc, int fr, int fq) const {
        { int t_ = threadIdx.x; asm volatile("" : "+v"(t_)); fr = t_ & 15; fq = (t_ >> 4) & 3; }
        typedef _Float16 h8 __attribute__((ext_vector_type(8)));
        const int row0 = u.pm * BM + wr * 64 + fr, col0 = u.pn * BM + wc * 32 + 8 * fq;
#pragma unroll
        for (int ai = 0; ai < 2; ++ai)
#pragma unroll
            for (int m = 0; m < 4; ++m) { int ro = row0 + ai * HALF + m * 16; asm volatile("" : "+v"(ro)); const float rs = row_rs(ssq, ro); _Float16* rowp = O + (size_t)ro * ldc + col0;
#pragma unroll
                for (int bj = 0; bj < 2; ++bj) { const f32x4 v0 = acc[ai][bj][m][0] * rs, v1 = acc[ai][bj][m][1] * rs;
                    h8 w = {(_Float16)v0[0], (_Float16)v0[1], (_Float16)v0[2], (_Float16)v0[3], (_Float16)v1[0], (_Float16)v1[1], (_Float16)v1[2], (_Float16)v1[3]};
                    *(h8*)(rowp + bj * HALF) = w; } }
    }
};
template <bool RES_F32> struct EpiResNorm {
    static constexpr bool PERM = true, AFTER_DRAIN = false;
    const float* resf; bf16_t* H; float* ssq; int ldc; float mul;
    __device__ __forceinline__ void operator()(const AccT& acc, const Unit& u, int wr, int wc, int fr, int fq) const {
        { int t_ = threadIdx.x; asm volatile("" : "+v"(t_)); fr = t_ & 15; fq = (t_ >> 4) & 3; }
        const int row0 = u.pm * BM + wr * 64 + fr, col0 = u.pn * BM + wc * 32 + 8 * fq;
#pragma unroll
        for (int ai = 0; ai < 2; ++ai)
#pragma unroll
            for (int m = 0; m < 4; ++m) { int ro = row0 + ai * HALF + m * 16; asm volatile("" : "+v"(ro)); const size_t off = (size_t)ro * ldc + col0; float ss = 0.f;
#pragma unroll
                for (int bj = 0; bj < 2; ++bj) { f32x4 r0, r1;
                    if (RES_F32) { r0 = *(const f32x4*)(resf + off + bj * HALF); r1 = *(const f32x4*)(resf + off + bj * HALF + 4); }
                    else { const u32x4 q = *(const u32x4*)(H + off + bj * HALF); r0 = (f32x4){bf_lo(q.x), bf_hi(q.x), bf_lo(q.y), bf_hi(q.y)}; r1 = (f32x4){bf_lo(q.z), bf_hi(q.z), bf_lo(q.w), bf_hi(q.w)}; }
                    const f32x4 v0 = r0 + acc[ai][bj][m][0] * mul, v1 = r1 + acc[ai][bj][m][1] * mul;
                    ss += ((v0[0] * v0[0] + v0[1] * v0[1]) + (v0[2] * v0[2] + v0[3] * v0[3])) + ((v1[0] * v1[0] + v1[1] * v1[1]) + (v1[2] * v1[2] + v1[3] * v1[3]));
                    u32x4 w; w.x = cvt_pk_bf16(v0[0], v0[1]); w.y = cvt_pk_bf16(v0[2], v0[3]); w.z = cvt_pk_bf16(v1[0], v1[1]); w.w = cvt_pk_bf16(v1[2], v1[3]);
                    *(u32x4*)(H + off + bj * HALF) = w; }
                ss += shx<16>(ss); ss = sum32(ss);
                if (fq == 0) ssq[(size_t)ro * 16 + u.pn * 4 + wc] = ss; }
    }
};
struct EpiIn {
    static constexpr bool PERM = true, AFTER_DRAIN = false;
    bf16_t *U, *Bb, *Q, *Kb, *V, *SGC, *SGA; const float* ropec; const float* ropes; float* kbar; float qscale;
    __device__ __forceinline__ void operator()(const AccT& acc, const Unit& u, int wr, int wc, int fr, int fq) const {
        { int t_ = threadIdx.x; asm volatile("" : "+v"(t_)); fr = t_ & 15; fq = (t_ >> 4) & 3; }
        const int pn = u.pn; const int row0 = u.pm * BM + wr * 64 + fr;
        if (pn < 4) {
            const int c0 = 128 * pn + 16 * wc + 4 * fq;
#pragma unroll
            for (int ai = 0; ai < 2; ++ai)
#pragma unroll
                for (int m = 0; m < 4; ++m) { int ro = row0 + ai * HALF + m * 16; asm volatile("" : "+v"(ro)); bf16_t* rowp = U + (size_t)ro * 512 + c0;
#pragma unroll
                    for (int bj = 0; bj < 2; ++bj) { const f32x4 x = acc[ai][bj][m][0] * acc[ai][bj][m][1]; u32x2 w; w.x = cvt_pk_bf16(x[0], x[1]); w.y = cvt_pk_bf16(x[2], x[3]); *(u32x2*)(rowp + bj * 64) = w; } }
        } else if (pn < 6 || (pn >= 10 && pn < 12)) {
            bf16_t* O = pn < 6 ? Bb : V; const int col0 = (pn < 6 ? pn - 4 : pn - 10) * BM + wc * 32 + 8 * fq;
#pragma unroll
            for (int ai = 0; ai < 2; ++ai)
#pragma unroll
                for (int m = 0; m < 4; ++m) { int ro = row0 + ai * HALF + m * 16; asm volatile("" : "+v"(ro)); bf16_t* rowp = O + (size_t)ro * 512 + col0;
#pragma unroll
                    for (int bj = 0; bj < 2; ++bj) { const f32x4 v0 = acc[ai][bj][m][0], v1 = acc[ai][bj][m][1];
                        u32x4 w; w.x = cvt_pk_bf16(v0[0], v0[1]); w.y = cvt_pk_bf16(v0[2], v0[3]); w.z = cvt_pk_bf16(v1[0], v1[1]); w.w = cvt_pk_bf16(v1[2], v1[3]);
                        *(u32x4*)(rowp + bj * HALF) = w; } }
        } else if (pn < 10) {
            const bool isk = pn >= 8; bf16_t* O = isk ? Kb : Q; const int colt = (isk ? pn - 8 : pn - 6) * BM + wc * 32 + 8 * fq;
            const int g4 = 4 * (4 * (wc & 1) + fq);
            const float sc = isk ? 1.f : qscale;
            f32x4 cs0[2] = {(f32x4){0.f, 0.f, 0.f, 0.f}, (f32x4){0.f, 0.f, 0.f, 0.f}}, cs1[2] = {(f32x4){0.f, 0.f, 0.f, 0.f}, (f32x4){0.f, 0.f, 0.f, 0.f}};
#pragma unroll
            for (int ai = 0; ai < 2; ++ai)
#pragma unroll
                for (int m = 0; m < 4; ++m) { int row = row0 + ai * HALF + m * 16; asm volatile("" : "+v"(row)); const int pos = row & 2047;
                    const f32x4 c = *(const f32x4*)(ropec + pos * 32 + g4) * sc, s = *(const f32x4*)(ropes + pos * 32 + g4) * sc;
                    bf16_t* rowp = O + (size_t)row * 512 + colt;
#pragma unroll
                    for (int bj = 0; bj < 2; ++bj) { const f32x4 x1 = acc[ai][bj][m][0], x2 = acc[ai][bj][m][1]; const f32x4 o1 = x1 * c - x2 * s, o2 = x2 * c + x1 * s;
                        cs0[bj] += o1; cs1[bj] += o2;
                        u32x4 w; w.x = cvt_pk_bf16(o1[0], o1[1]); w.y = cvt_pk_bf16(o1[2], o1[3]); w.z = cvt_pk_bf16(o2[0], o2[1]); w.w = cvt_pk_bf16(o2[2], o2[3]);
                        *(u32x4*)(rowp + bj * HALF) = w; }
                    asm volatile("" : "+v"(cs0[0]), "+v"(cs0[1]), "+v"(cs1[0]), "+v"(cs1[1]) :: "memory"); }
            if (isk) {
#pragma unroll
                for (int bj = 0; bj < 2; ++bj)
#pragma unroll
                    for (int j = 0; j < 4; ++j) { float a = cs0[bj][j], b = cs1[bj][j];
                        a += shx<1>(a); b += shx<1>(b); a += shx<2>(a); b += shx<2>(b); a += shx<4>(a); b += shx<4>(b); a += shx<8>(a); b += shx<8>(b);
                        if (fr == 0) { const int pc = (pn - 8) * BM + bj * HALF + wc * 32 + 8 * fq;
                            float* kb = kbar + (size_t)u.pm * 512 + pc; atomicAdd(kb + j, a); atomicAdd(kb + 4 + j, b); } }
            }
        } else {
            bf16_t* O = pn < 16 ? SGC : SGA; const int col0 = (pn < 16 ? pn - 12 : pn - 16) * BM + wc * 32 + 8 * fq;
#pragma unroll
            for (int ai = 0; ai < 2; ++ai)
#pragma unroll
                for (int m = 0; m < 4; ++m) { int ro = row0 + ai * HALF + m * 16; asm volatile("" : "+v"(ro)); bf16_t* rowp = O + (size_t)ro * 1024 + col0;
#pragma unroll
                    for (int bj = 0; bj < 2; ++bj) { f32x4 v0 = acc[ai][bj][m][0], v1 = acc[ai][bj][m][1];
#pragma unroll
                        for (int j = 0; j < 4; ++j) { v0[j] = __builtin_amdgcn_rcpf(1.f + __expf(-v0[j])); v1[j] = __builtin_amdgcn_rcpf(1.f + __expf(-v1[j])); }
                        u32x4 w; w.x = cvt_pk_bf16(v0[0], v0[1]); w.y = cvt_pk_bf16(v0[2], v0[3]); w.z = cvt_pk_bf16(v1[0], v1[1]); w.w = cvt_pk_bf16(v1[2], v1[3]);
                        *(u32x4*)(rowp + bj * HALF) = w; }
                    asm volatile("" ::: "memory"); }
        }
    }
};
struct EpiSoftmax {
    static constexpr bool PERM = true, AFTER_DRAIN = true;
    bf16_t* O; int ldc; float scale_log2;
    __device__ __forceinline__ void fused(AccT& acc, const Unit& u, int wr, int wc, int fr, int fq, PG8_LAS unsigned char* lds, int wid, int lane) const {
        { int t_ = threadIdx.x; asm volatile("" : "+v"(t_)); fr = t_ & 15; fq = (t_ >> 4) & 3; }
        PG8_LAS f32x2* X = (PG8_LAS f32x2*)lds;
        float mx[2][4];
#pragma unroll
        for (int ai = 0; ai < 2; ++ai)
#pragma unroll
            for (int m = 0; m < 4; ++m) { float a = -3.0e38f;
#pragma unroll
                for (int bj = 0; bj < 2; ++bj)
#pragma unroll
                    for (int n = 0; n < 2; ++n) { acc[ai][bj][m][n] = acc[ai][bj][m][n] * scale_log2; const f32x4 x = acc[ai][bj][m][n]; a = fmaxf(fmaxf(a, fmaxf(x[0], x[1])), fmaxf(x[2], x[3])); }
                a = fmaxf(a, shx<16>(a)); a = max32(a); mx[ai][m] = a;
                float s = 0.f;
#pragma unroll
                for (int bj = 0; bj < 2; ++bj)
#pragma unroll
                    for (int n = 0; n < 2; ++n) { f32x4 x = acc[ai][bj][m][n];
#pragma unroll
                        for (int j = 0; j < 4; ++j) { x[j] = __builtin_amdgcn_exp2f(x[j] - a); s += x[j]; }
                        acc[ai][bj][m][n] = x; }
                s += shx<16>(s); s = sum32(s);
                if (fq == 0) X[(ai * HALF + wr * 64 + m * 16 + fr) * 4 + wc] = (f32x2){a, s};
            }
        asm volatile("s_waitcnt lgkmcnt(0)" ::: "memory"); __builtin_amdgcn_s_barrier(); asm volatile("" ::: "memory");
        const int row0 = u.pm * BM + wr * 64 + fr, col0 = u.pn * BM + wc * 32 + 8 * fq;
#pragma unroll
        for (int ai = 0; ai < 2; ++ai)
#pragma unroll
            for (int m = 0; m < 4; ++m) { const int r = ai * HALF + wr * 64 + m * 16 + fr;
                const f32x2 e0 = X[r * 4 + 0], e1 = X[r * 4 + 1], e2 = X[r * 4 + 2], e3 = X[r * 4 + 3];
                const float M = fmaxf(fmaxf(e0.x, e1.x), fmaxf(e2.x, e3.x));
                const float L = e0.y * __builtin_amdgcn_exp2f(e0.x - M) + e1.y * __builtin_amdgcn_exp2f(e1.x - M) + e2.y * __builtin_amdgcn_exp2f(e2.x - M) + e3.y * __builtin_amdgcn_exp2f(e3.x - M);
                const float f = __builtin_amdgcn_exp2f(mx[ai][m] - M) * __builtin_amdgcn_rcpf(L);
                bf16_t* rowp = O + (size_t)(row0 + ai * HALF + m * 16) * ldc + col0;
#pragma unroll
                for (int bj = 0; bj < 2; ++bj) { const f32x4 v0 = acc[ai][bj][m][0] * f, v1 = acc[ai][bj][m][1] * f;
                    u32x4 w; w.x = cvt_pk_bf16(v0[0], v0[1]); w.y = cvt_pk_bf16(v0[2], v0[3]); w.z = cvt_pk_bf16(v1[0], v1[1]); w.w = cvt_pk_bf16(v1[2], v1[3]);
                    *(u32x4*)(rowp + bj * HALF) = w; } }
        asm volatile("s_waitcnt lgkmcnt(0)" ::: "memory"); __builtin_amdgcn_s_barrier(); asm volatile("" ::: "memory");
    }
};
}
namespace attn_body {
using bf16=__hip_bfloat16;
using bf16x8=__attribute__((ext_vector_type(8)))short;
using s16x4=__attribute__((ext_vector_type(4)))short;
using f32x16=__attribute__((ext_vector_type(16)))float;
using u32x4=__attribute__((ext_vector_type(4)))unsigned;
constexpr int BATCH=16,NHEAD=8,SEQ=2048,D=64,DM=NHEAD*D;
constexpr int NW=8,QBLK=32,QB=QBLK*NW,KVBLK=64,NQB=SEQ/QB;
constexpr int ATTN_PITCH=DM, ATTN_UNIT_ROWS=QB;
__device__ __forceinline__ int crow(int r,int hi){return (r&3)+8*(r>>2)+4*hi;}
#define SBAR() __builtin_amdgcn_sched_barrier(0)
__device__ __forceinline__ void cmask(f32x16&p0,f32x16&p1,int jb,int qrel,int hi){
  const float NEG=-INFINITY; int kb=64*jb+4*hi;
  #pragma unroll
  for(int r=0;r<16;++r){int kv=kb+(r&3)+8*(r>>2); if(kv>qrel)p0[r]=NEG; if(kv+32>qrel)p1[r]=NEG;}
}

constexpr int NSLOT=3, SLOTB=8192;
constexpr int LDS_K=0, LDS_V=NSLOT*SLOTB, LDS_WS=2*NSLOT*SLOTB, LDS_OST=LDS_WS+NW*64*4, LDS_SEL=LDS_OST+NW*4096, LDS_BYTES=LDS_SEL+NW*64*4;
constexpr float C2=0.125f*1.4426950408889634f;
__device__ __forceinline__ void glds16(const void*gsrc,unsigned lds_dst){unsigned keep;
  asm volatile("s_mov_b32 %0, m0\n\ts_mov_b32 m0, %2\n\ts_nop 0\n\tglobal_load_lds_dwordx4 %1, off\n\ts_mov_b32 m0, %0":"=&s"(keep):"v"(gsrc),"s"(lds_dst):"memory");}
__device__ __forceinline__ float max3f(float a,float b,float c){float r;asm("v_max3_f32 %0, %1, %2, %3":"=v"(r):"v"(a),"v"(b),"v"(c));return r;}
__device__ __forceinline__ float max2f(float a,float b){float r;asm("v_max_f32_e32 %0, %1, %2":"=v"(r):"v"(a),"v"(b));return r;}
__device__ __forceinline__ float fadd_s(float a,float b){float r;asm("v_add_f32_e32 %0, %1, %2":"=v"(r):"v"(a),"v"(b));return r;}
__device__ __forceinline__ float fsub_s(float a,float b){float r;asm("v_sub_f32_e32 %0, %1, %2":"=v"(r):"v"(a),"v"(b));return r;}
typedef float f32x2_t __attribute__((ext_vector_type(2))); typedef __bf16 bf16x2_t __attribute__((ext_vector_type(2)));
__device__ __forceinline__ unsigned cvtpk_s(float lo,float hi){f32x2_t v={lo,hi};bf16x2_t b=__builtin_convertvector(v,bf16x2_t);return __builtin_bit_cast(unsigned,b);}
#define WAIT_BAR(N) asm volatile("s_waitcnt vmcnt(" #N ") lgkmcnt(0)\n\ts_barrier":::"memory")

__device__ __forceinline__ void qkt(f32x16&p0,f32x16&p1,const char*Kslot,const bf16x8*qr,const f32x16&negm,int r32,int hi){
  const char*kb=Kslot+hi*1024+r32*16;
  #pragma unroll
  for(int d0=0;d0<4;++d0){
    const bf16x8 b0=*reinterpret_cast<const bf16x8*>(kb+d0*2048);
    const bf16x8 b1=*reinterpret_cast<const bf16x8*>(kb+d0*2048+512);
    if(d0==0){p0=__builtin_amdgcn_mfma_f32_32x32x16_bf16(b0,qr[0],negm,0,0,0);p1=__builtin_amdgcn_mfma_f32_32x32x16_bf16(b1,qr[0],negm,0,0,0);}
    else{p0=__builtin_amdgcn_mfma_f32_32x32x16_bf16(b0,qr[d0],p0,0,0,0);p1=__builtin_amdgcn_mfma_f32_32x32x16_bf16(b1,qr[d0],p1,0,0,0);}}
}
typedef __attribute__((address_space(3))) const char* lds_cptr;
typedef short v4i16_t __attribute__((ext_vector_type(4)));
__device__ __forceinline__ void kload8(bf16x8*kf,lds_cptr kp){
  kf[0]=*(const __attribute__((address_space(3))) bf16x8*)(kp);      kf[1]=*(const __attribute__((address_space(3))) bf16x8*)(kp+512);
  kf[2]=*(const __attribute__((address_space(3))) bf16x8*)(kp+2048); kf[3]=*(const __attribute__((address_space(3))) bf16x8*)(kp+2560);
  kf[4]=*(const __attribute__((address_space(3))) bf16x8*)(kp+4096); kf[5]=*(const __attribute__((address_space(3))) bf16x8*)(kp+4608);
  kf[6]=*(const __attribute__((address_space(3))) bf16x8*)(kp+6144); kf[7]=*(const __attribute__((address_space(3))) bf16x8*)(kp+6656);
}
__device__ __forceinline__ void kload2(bf16x8*kf,lds_cptr kp,int j){ kf[2*j]=*(const __attribute__((address_space(3))) bf16x8*)(kp+j*2048); kf[2*j+1]=*(const __attribute__((address_space(3))) bf16x8*)(kp+j*2048+512); }
__device__ __forceinline__ s16x4 vtr(lds_cptr p){ return __builtin_bit_cast(s16x4,__builtin_amdgcn_ds_read_tr16_b64_v4i16((__attribute__((address_space(3))) v4i16_t*)p)); }
__device__ __forceinline__ float rowmax(const f32x16&p0,const f32x16&p1){
  float a=max3f(p0[0],p0[1],p1[0]),b=max3f(p0[2],p0[3],p1[1]);a=max3f(a,p1[2],p1[3]);
  #pragma unroll
  for(int r=4;r<16;r+=4){a=max3f(a,p0[r],p0[r+1]);b=max3f(b,p0[r+2],p0[r+3]);a=max3f(a,p1[r],p1[r+1]);b=max3f(b,p1[r+2],p1[r+3]);}
  const float m=max2f(a,b);
  auto rr=__builtin_amdgcn_permlane32_swap(__float_as_uint(m),__float_as_uint(m),false,false);
  return max2f(__uint_as_float(rr[0]),__uint_as_float(rr[1]));
}
__device__ __forceinline__ void pv(f32x16*o,int vb,bf16x8 pa0,bf16x8 pa1,bf16x8 pa2,bf16x8 pa3){
  #pragma unroll
  for(int d0=0;d0<2;++d0){s16x4 lo[4],hi[4];
    #pragma unroll
    for(int ks=0;ks<4;++ks){
      asm volatile("ds_read_b64_tr_b16 %0,%1 offset:%c2":"=&v"(lo[ks]):"v"(vb),"i"(d0*4096+ks*1024):"memory");
      asm volatile("ds_read_b64_tr_b16 %0,%1 offset:%c2":"=&v"(hi[ks]):"v"(vb),"i"(d0*4096+ks*1024+512):"memory");}
    asm volatile("s_waitcnt lgkmcnt(0)":::"memory");SBAR();
    #define PK(k) (bf16x8){lo[k][0],lo[k][1],lo[k][2],lo[k][3],hi[k][0],hi[k][1],hi[k][2],hi[k][3]}
    o[d0]=__builtin_amdgcn_mfma_f32_32x32x16_bf16(pa0,PK(0),o[d0],0,0,0);
    o[d0]=__builtin_amdgcn_mfma_f32_32x32x16_bf16(pa1,PK(1),o[d0],0,0,0);
    o[d0]=__builtin_amdgcn_mfma_f32_32x32x16_bf16(pa2,PK(2),o[d0],0,0,0);
    o[d0]=__builtin_amdgcn_mfma_f32_32x32x16_bf16(pa3,PK(3),o[d0],0,0,0);
    #undef PK
  }
}

#ifndef ATTN_STORE16
#define ATTN_STORE16(p,v) (*(u32x4*)(p)=(v))
#endif
template<int THRL> __device__ __forceinline__ void attn_unit(int b,int h,int qb,const bf16*Q,const bf16*__restrict__ K,const bf16*__restrict__ V,bf16*O,const float*__restrict__ kbar,char*shm){
  int tid=threadIdx.x; asm volatile("":"+v"(tid)); const int lane=tid&63,r32=lane&31,hi=lane>>5; const int wid=__builtin_amdgcn_readfirstlane(tid>>6);
  const long rowbase=(long)b*SEQ; const int q0=qb*QB;
  const bf16*Qw=Q+(rowbase+q0+wid*QBLK)*DM+h*D;
  const bf16*Kh=K+rowbase*DM+h*D,*Vh=V+rowbase*DM+h*D;
  const unsigned lds0=(unsigned)(uintptr_t)shm;
  float*wsf=(float*)(shm+LDS_WS)+wid*64;
  const bf16*ksrc=Kh+(long)lane*DM+wid*8;
  const bf16*vsrc=Vh+(long)(16*(wid&3)+(lane>>2))*DM+(wid>>2)*32+(lane&3)*8;
  const unsigned kdst=lds0+LDS_K+wid*1024, vdst=lds0+LDS_V+wid*1024;
  #define DMA_K(t,slot) glds16(ksrc+(long)(t)*KVBLK*DM,(unsigned)__builtin_amdgcn_readfirstlane(kdst+(slot)))
  #define DMA_V(t,slot) glds16(vsrc+(long)(t)*KVBLK*DM,(unsigned)__builtin_amdgcn_readfirstlane(vdst+(slot)))
  const int vb0=(int)(lds0+LDS_V)+((lane>>4)&1)*32+(lane&3)*8+(4*hi+((lane&15)>>2))*64;
  const char*Kbase=shm+LDS_K; bf16x8 kf[8];
  const lds_cptr shm3=(lds_cptr)shm; const lds_cptr kp0=shm3+LDS_K+hi*1024+r32*16; const lds_cptr vp0=shm3+LDS_V+((lane>>4)&1)*32+(lane&3)*8+(4*hi+((lane&15)>>2))*64;
  const int NT=(q0+QB)/KVBLK;
  DMA_K(0,0);DMA_V(0,0);DMA_K(1,SLOTB);
  bf16x8 qr[4];
  #pragma unroll
  for(int d0=0;d0<4;++d0)qr[d0]=*reinterpret_cast<const bf16x8*>(&Qw[(long)r32*DM+d0*16+hi*8]);
  int selm=0;
  if(qb>0){
    float g[7]; int hi8=8*hi; asm volatile("":"+v"(hi8)); const float*kb=kbar+(size_t)(b*8)*512+h*64+hi8;
    #pragma unroll
    for(int n=0;n<7;++n){ float a=0.f;
      if(n<qb){
        #pragma unroll
        for(int d0=0;d0<4;++d0){ const float4 k0=*(const float4*)(kb+n*512+16*d0),k1=*(const float4*)(kb+n*512+16*d0+4); const bf16x8 qq=qr[d0];
          #define QF(e) __uint_as_float(((unsigned)(unsigned short)qq[e])<<16)
          a+=QF(0)*k0.x+QF(1)*k0.y+QF(2)*k0.z+QF(3)*k0.w+QF(4)*k1.x+QF(5)*k1.y+QF(6)*k1.z+QF(7)*k1.w;
          #undef QF
        } }
      a=::sum32(a); g[n]=(n<qb)?a:-INFINITY; asm volatile("":"+v"(g[n])::"memory"); }
    #pragma unroll
    for(int r=0;r<3;++r){ int best=-1; float bv=-INFINITY;
      #pragma unroll
      for(int n=0;n<7;++n) if(!((selm>>n)&1)&&g[n]>bv){bv=g[n];best=n;}
      if(best>=0)selm|=1<<best; }
  }
  selm|=1<<qb;
  typedef __attribute__((address_space(3))) int* lds_iptr;
  ((lds_iptr)(shm3+LDS_SEL))[tid]=selm;
  #define CURNEG(blk) ({ int t_=threadIdx.x; asm volatile("":"+v"(t_)); const int sm_=((lds_iptr)(shm3+LDS_SEL))[t_]; ((sm_>>(blk))&1)?0.f:-INFINITY; })
  #define NEGUPD(t) do{ if((((t)+1)&3)==0){ const float cn_=CURNEG(((t)+1)>>2); _Pragma("unroll") for(int r=0;r<16;++r)negm[r]=cn_-mhat; asm volatile("":"+v"(negm)); } }while(0)
  float mhat=0.f,l_reg=0.f;f32x16 o[2];o[0]=f32x16{};o[1]=f32x16{};f32x16 negm; { const float cn_=CURNEG(0); _Pragma("unroll") for(int r=0;r<16;++r)negm[r]=cn_; } asm volatile("":"+v"(negm));
  const int qrel=wid*QBLK+r32;
  #define CMASK(P0,P1,t) do{int jb_=(t)-(NT-4); if(jb_>=0)cmask(P0,P1,jb_,qrel,hi);}while(0)
  bool resc=false;
  #define START(P0,P1) do{ const float rm=rowmax(P0,P1); resc=false; \
    { const float dl=__builtin_fmaxf(rm,-24.f); mhat=fadd_s(mhat,dl); \
      _Pragma("unroll") for(int r=0;r<16;++r){P0[r]=fsub_s(P0[r],dl);P1[r]=fsub_s(P1[r],dl);} \
      { const float cn_=CURNEG(0); _Pragma("unroll") for(int r=0;r<16;++r)negm[r]=cn_-mhat; } asm volatile("":"+v"(negm)); } \
    _Pragma("unroll") for(int r=0;r<16;++r)P0[r]=__builtin_amdgcn_exp2f(P0[r]); }while(0)
  #define RESC() do{ if(resc){ asm volatile("s_waitcnt lgkmcnt(0)":::"memory"); \
      _Pragma("unroll") for(int d_=0;d_<2;++d_) _Pragma("unroll") for(int r=0;r<16;++r)o[d_][r]*=wsf[crow(r,hi)]; } }while(0)
  f32x16 pA0,pA1,pB0,pB1;
  int sl_prev=0,sl_cur=0,sl_next=SLOTB;
  #define ROT() do{sl_prev=sl_cur;sl_cur=sl_next;sl_next=(sl_next==(NSLOT-1)*SLOTB)?0:sl_next+SLOTB;}while(0)
  DMA_K(2,2*SLOTB);
  WAIT_BAR(3);
  qkt(pA0,pA1,Kbase,qr,negm,r32,hi);asm volatile("s_nop 15\n\ts_nop 7":"+v"(pA0),"+v"(pA1));CMASK(pA0,pA1,0);
  START(pA0,pA1);
  _Pragma("unroll") for(int r=0;r<16;++r)pA1[r]=__builtin_amdgcn_exp2f(pA1[r]);
  WAIT_BAR(0);
  DMA_K(3,0);DMA_V(1,SLOTB);
  ROT();
  kload8(kf,kp0+sl_cur);
  WAIT_BAR(2);
  s16x4 vlo[8],vhi[8]; u32x4 pw0,pw1,pw2,pw3;
  #define PKW(P,B) cvtpk_s(P[B],P[B+1])
  #define PAF(k) __builtin_bit_cast(bf16x8,pw##k)
  #define VFR(i) (bf16x8){vlo[i][0],vlo[i][1],vlo[i][2],vlo[i][3],vhi[i][0],vhi[i][1],vhi[i][2],vhi[i][3]}
  #define PIN(x) asm volatile("":"+v"(x))
  #define MX3(a,b,c) __builtin_fmaxf(__builtin_fmaxf((a),(b)),(c))
  #define GAPA(MF,A0,A1,A2,A3,W0,W1,PW) do{ MF; sacc+=A0; sacc+=A1; sacc+=A2; sacc+=A3; PIN(sacc); W0; W1; PIN(PW); SBAR(); }while(0)
  #define EX(v) __builtin_amdgcn_exp2f(v)
  #define GAPB(MF,X,B) do{ MF; X[B]=EX(X[B]); X[B+1]=EX(X[B+1]); X[B+2]=EX(X[B+2]); X[B+3]=EX(X[B+3]); PIN(X); SBAR(); }while(0)
  #define VRD(i) do{ vlo[i]=vtr(vp_+(((i)>>2)*4096+((i)&3)*1024)); vhi[i]=vtr(vp_+(((i)>>2)*4096+((i)&3)*1024+512)); }while(0)
  #define KRD(G,j) do{ if(G){ kload2(kf,kp0+sl_next,j); SBAR(); } }while(0)
  #define STEP(C0,C1,P0,P1,t,GK,GV,GL) do{ SBAR(); \
    const lds_cptr vp_=vp0+sl_prev; \
    VRD(0); SBAR(); float sacc=(P0[0]+P0[1]); \
    GAPA(C0=__builtin_amdgcn_mfma_f32_32x32x16_bf16(kf[0],qr[0],negm,0,0,0), P0[2],P0[3],P0[4],P0[5],     pw0[0]=PKW(P0,0), pw0[1]=PKW(P0,2), pw0); \
    VRD(4); SBAR(); GAPA(C1=__builtin_amdgcn_mfma_f32_32x32x16_bf16(kf[1],qr[0],negm,0,0,0), P0[6],P0[7],P0[8],P0[9],     pw0[2]=PKW(P0,4), pw0[3]=PKW(P0,6), pw0); \
    VRD(1); SBAR(); GAPA(C0=__builtin_amdgcn_mfma_f32_32x32x16_bf16(kf[2],qr[1],C0,0,0,0),   P0[10],P0[11],P0[12],P0[13], pw1[0]=PKW(P0,8), pw1[1]=PKW(P0,10), pw1); \
    VRD(5); SBAR(); GAPA(C1=__builtin_amdgcn_mfma_f32_32x32x16_bf16(kf[3],qr[1],C1,0,0,0),   P0[14],P0[15],P1[0],P1[1],   pw1[2]=PKW(P0,12),pw1[3]=PKW(P0,14), pw1); \
    VRD(2); SBAR(); GAPA(C0=__builtin_amdgcn_mfma_f32_32x32x16_bf16(kf[4],qr[2],C0,0,0,0),   P1[2],P1[3],P1[4],P1[5],     pw2[0]=PKW(P1,0), pw2[1]=PKW(P1,2), pw2); \
    VRD(6); SBAR(); GAPA(C1=__builtin_amdgcn_mfma_f32_32x32x16_bf16(kf[5],qr[2],C1,0,0,0),   P1[6],P1[7],P1[8],P1[9],     pw2[2]=PKW(P1,4), pw2[3]=PKW(P1,6), pw2); \
    VRD(3); SBAR(); GAPA(C0=__builtin_amdgcn_mfma_f32_32x32x16_bf16(kf[6],qr[3],C0,0,0,0),   P1[10],P1[11],P1[12],P1[13], pw3[0]=PKW(P1,8), pw3[1]=PKW(P1,10), pw3); \
    VRD(7); SBAR(); GAPA(C1=__builtin_amdgcn_mfma_f32_32x32x16_bf16(kf[7],qr[3],C1,0,0,0),   P1[14],P1[15],0.f,0.f,       pw3[2]=PKW(P1,12),pw3[3]=PKW(P1,14), pw3); \
    l_reg+=sacc; \
    if(GK){DMA_K((t)+3,sl_cur);} if(GV){DMA_V((t)+1,sl_next);} \
    CMASK(C0,C1,t); \
    { float a=MX3(C0[0],C0[1],C1[0]),b=MX3(C0[2],C0[3],C1[1]); a=MX3(a,C1[2],C1[3]); \
      _Pragma("unroll") for(int r=4;r<16;r+=4){a=MX3(a,C0[r],C0[r+1]);b=MX3(b,C0[r+2],C0[r+3]);a=MX3(a,C1[r],C1[r+1]);b=MX3(b,C1[r+2],C1[r+3]);} \
      float rm=__builtin_fmaxf(a,b); { auto rr=__builtin_amdgcn_permlane32_swap(__float_as_uint(rm),__float_as_uint(rm),false,false); rm=__builtin_fmaxf(__uint_as_float(rr[0]),__uint_as_float(rr[1])); } \
      resc=false; \
      if(__builtin_expect(__any(rm>(float)THRL),0)){ const float dl=__builtin_fmaxf(rm,0.f); mhat+=dl; \
        _Pragma("unroll") for(int r=0;r<16;++r){C0[r]-=dl;C1[r]-=dl;} \
        { const float cn_=CURNEG(((t)+1)>>2); _Pragma("unroll") for(int r=0;r<16;++r)negm[r]=cn_-mhat; } asm volatile("":"+v"(negm)); \
        const float f=__builtin_amdgcn_exp2f(-dl); l_reg*=f; if(hi==0)wsf[r32]=f; resc=true; } } \
    SBAR(); \
    GAPB(o[0]=__builtin_amdgcn_mfma_f32_32x32x16_bf16(PAF(0),VFR(0),o[0],0,0,0), C0,0); \
    GAPB(o[1]=__builtin_amdgcn_mfma_f32_32x32x16_bf16(PAF(0),VFR(4),o[1],0,0,0), C0,4); \
    KRD(GL,0); GAPB(o[0]=__builtin_amdgcn_mfma_f32_32x32x16_bf16(PAF(1),VFR(1),o[0],0,0,0), C0,8); \
    KRD(GL,1); GAPB(o[1]=__builtin_amdgcn_mfma_f32_32x32x16_bf16(PAF(1),VFR(5),o[1],0,0,0), C0,12); \
    KRD(GL,2); GAPB(o[0]=__builtin_amdgcn_mfma_f32_32x32x16_bf16(PAF(2),VFR(2),o[0],0,0,0), C1,0); \
    KRD(GL,3); GAPB(o[1]=__builtin_amdgcn_mfma_f32_32x32x16_bf16(PAF(2),VFR(6),o[1],0,0,0), C1,4); \
    GAPB(o[0]=__builtin_amdgcn_mfma_f32_32x32x16_bf16(PAF(3),VFR(3),o[0],0,0,0), C1,8); \
    GAPB(o[1]=__builtin_amdgcn_mfma_f32_32x32x16_bf16(PAF(3),VFR(7),o[1],0,0,0), C1,12); \
    }while(0)
  int t=1;
  #undef CMASK
  #define CMASK(P0,P1,t) do{}while(0)
  for(;t+5<NT;t+=2){
    STEP(pB0,pB1,pA0,pA1,t,true,true,true);     WAIT_BAR(2); RESC(); ROT(); NEGUPD(t);
    STEP(pA0,pA1,pB0,pB1,t+1,true,true,true);   WAIT_BAR(2); RESC(); ROT(); NEGUPD(t+1);
  }
  #undef CMASK
  #define CMASK(P0,P1,t) do{int jb_=(t)-(NT-4); if(jb_>=0)cmask(P0,P1,jb_,qrel,hi);}while(0)
  #define ENDW(tt) do{ if((tt)+3<NT){WAIT_BAR(2);} else if((tt)+2<NT){WAIT_BAR(1);} else {WAIT_BAR(0);} }while(0)
  for(;t+1<NT;t+=2){
    STEP(pB0,pB1,pA0,pA1,t,(t+3<NT),(t+1<NT),(t+1<NT));       ENDW(t);   RESC(); ROT(); NEGUPD(t);
    STEP(pA0,pA1,pB0,pB1,t+1,(t+4<NT),(t+2<NT),(t+2<NT));     ENDW(t+1); RESC(); ROT(); NEGUPD(t+1);
  }
  STEP(pB0,pB1,pA0,pA1,NT-1,false,false,false); RESC();
  { float sacc=pB0[0]+pB0[1]; _Pragma("unroll") for(int r=2;r<16;++r)sacc+=pB0[r]; _Pragma("unroll") for(int r=0;r<16;++r)sacc+=pB1[r]; l_reg+=sacc;
    pw0=(u32x4){PKW(pB0,0),PKW(pB0,2),PKW(pB0,4),PKW(pB0,6)};pw1=(u32x4){PKW(pB0,8),PKW(pB0,10),PKW(pB0,12),PKW(pB0,14)};pw2=(u32x4){PKW(pB1,0),PKW(pB1,2),PKW(pB1,4),PKW(pB1,6)};pw3=(u32x4){PKW(pB1,8),PKW(pB1,10),PKW(pB1,12),PKW(pB1,14)};
    SBAR(); pv(o,vb0+sl_cur,PAF(0),PAF(1),PAF(2),PAF(3)); }
  #undef PKW
  #undef PAF
  #undef VFR
  #undef PIN
  #undef MX3
  #undef GAPA
  #undef GAPB
  #undef EX
  #undef VRD
  #undef KRD
  #undef STEP
  #undef ENDW
  {auto rr=__builtin_amdgcn_permlane32_swap(__float_as_uint(l_reg),__float_as_uint(l_reg),false,false);l_reg=__uint_as_float(rr[0])+__uint_as_float(rr[1]);}
  if(hi==0)wsf[32+r32]=l_reg;asm volatile("s_waitcnt lgkmcnt(0)":::"memory");
  float rli[16];
  #pragma unroll
  for(int r=0;r<16;++r)rli[r]=__builtin_amdgcn_rcpf(wsf[32+crow(r,hi)]);
  bf16*Ow=O+(rowbase+q0+wid*QBLK)*DM+h*D;
  { bf16*stg=(bf16*)(shm+LDS_OST)+wid*2048;
    #pragma unroll
    for(int r=0;r<16;++r){const int orow=crow(r,hi);
      #pragma unroll
      for(int d0=0;d0<2;++d0)stg[orow*64+d0*32+r32]=__float2bfloat16(o[d0][r]*rli[r]);}
    asm volatile("s_waitcnt lgkmcnt(0)":::"memory");
    #pragma unroll
    for(int i=0;i<4;++i){const int row=i*8+(lane>>3),ch=lane&7; const u32x4 v=*(const u32x4*)(stg+row*64+ch*8); ATTN_STORE16(Ow+(long)row*DM+ch*8,v);} }
  asm volatile("s_waitcnt lgkmcnt(0)\n\ts_barrier":::"memory");
  #undef DMA_K
  #undef DMA_V
  #undef CMASK
  #undef START
  #undef CURNEG
  #undef NEGUPD
  #undef RESC
  #undef ROT
}
constexpr int ATTN_LDS_BYTES=LDS_BYTES;
struct AttnTensors { const bf16* Q; const bf16* K; const bf16* V; bf16* O; const float* kbar; };
struct AttnUnit { int bh; int qb; };
struct StaticOrder {
  int vcu,G;
  __device__ __forceinline__ explicit StaticOrder(int grid,int block):vcu((grid%8==0)?(block%8)*(grid/8)+block/8:block),G(grid){}
  __device__ __forceinline__ bool next(int i,AttnUnit&u)const{
    if(G==256){ if(i>=4)return false; const int s=vcu&1; u.bh=vcu>>1; u.qb=s?((i==0)?6:(i==1)?1:(i==2)?5:2):((i==0)?7:(i==1)?0:(i==2)?4:3); return true; }
    const int L=i*G+vcu; if(L>=1024)return false; u.bh=L>>3; u.qb=L&7; return true; }
  __device__ __forceinline__ void a_ready(const AttnUnit&)const{}
  __device__ __forceinline__ void done(const AttnUnit&)const{}
};
template<class Sched,int THRL=8> __device__ __forceinline__ void attn_phase(char*lds,const AttnTensors&T,const Sched&S){
  AttnUnit u;
  for(int i=0;S.next(i,u);++i){ S.a_ready(u); attn_unit<THRL>(u.bh/NHEAD,u.bh%NHEAD,u.qb,T.Q,T.K,T.V,T.O,T.kbar,lds); S.done(u); }
}
#undef SBAR
#undef WAIT_BAR
}
constexpr int NWAVES = 8;
constexpr int T = 32768, D = 1024, SEQ = 2048, MEMROWS = 4096, INW = 5120;
constexpr float RMS_EPS = 1e-6f;
constexpr size_t MiB = 1u << 20;
constexpr size_t WS_CTL = 0, CTL_ZERO_BYTES = 2 * MiB, WS_KBAR = 1 * MiB;
constexpr size_t WS_WIN = 2 * MiB, WS_WC = 12 * MiB, WS_WA = 13 * MiB, WS_WM = 14 * MiB, WS_WXQ = 16 * MiB, WS_WXKV = 18 * MiB, WS_WXO = 22 * MiB, WS_MT = 24 * MiB, WS_ROPE = 28 * MiB;
constexpr size_t WS_MEMN = 32 * MiB, WS_KX = 40 * MiB, WS_VXT = 48 * MiB;
constexpr size_t WS_SSQ1 = 30 * MiB, WS_SSQ2 = 56 * MiB;
constexpr size_t WS_A = 64 * MiB;
constexpr size_t WS_YC = 128 * MiB, WS_QO = 160 * MiB, WS_U = 192 * MiB, WS_K = 224 * MiB, WS_V = 256 * MiB;
constexpr size_t WS_SGC = 320 * MiB, WS_SGA = 384 * MiB;
constexpr size_t WS_A8I = 320 * MiB, WS_ASC = 352 * MiB;
constexpr size_t WS_EIDX = 448 * MiB, WS_GW = 464 * MiB, WS_PW = 480 * MiB, WS_END = 496 * MiB;
constexpr size_t WS_U8 = 288 * MiB, WS_V8T = 304 * MiB, WS_SU = 29 * MiB, WS_SV = 29 * MiB + 512 * 1024;
constexpr size_t WS_QX = 128 * MiB, WS_PM = 192 * MiB, WS_OX = 128 * MiB;
constexpr size_t WS_PO = 128 * MiB;
constexpr size_t WS_SC = 128 * MiB;
constexpr int CW_TMO = 0, CW_BAR = 4096, CW_Q = 8192;
constexpr int RING_OFF = 0, RING_BYTES = 131072;
constexpr int LDSCTL_OFF = RING_BYTES, MISC_OFF = LDSCTL_OFF + 320;
constexpr int LDS_BYTES = 163840;
constexpr int UL_OFF = RING_BYTES + 512, UL_WAVE = (LDS_BYTES - UL_OFF) / 8, UL_CAP = ((UL_WAVE - 128) / 8) & ~15;

#define GAS __attribute__((address_space(1)))
#define LAS __attribute__((address_space(3)))
typedef unsigned short bf16;
typedef unsigned v4u __attribute__((ext_vector_type(4)));
typedef unsigned v2u __attribute__((ext_vector_type(2)));
typedef float v2f __attribute__((ext_vector_type(2)));
typedef float f32x4 __attribute__((ext_vector_type(4)));
typedef float f32x2v __attribute__((ext_vector_type(2)));
typedef _Float16 h2v __attribute__((ext_vector_type(2)));
typedef GAS unsigned gu32;
#define RLX_AGENT __ATOMIC_RELAXED, __HIP_MEMORY_SCOPE_AGENT
#define LDS_WAIT() asm volatile("s_waitcnt lgkmcnt(0)" ::: "memory")
#define VM_WAIT() asm volatile("s_waitcnt vmcnt(0)" ::: "memory")
__device__ __forceinline__ unsigned pk2(float lo, float hi) { return pg8::cvt_pk_bf16(lo, hi); }
__device__ __forceinline__ float bflo(unsigned u) { return __uint_as_float(u << 16); }
__device__ __forceinline__ float bfhi(unsigned u) { return __uint_as_float(u & 0xffff0000u); }

#define XB_TMO      128
#define XB_XCNT(j)  (256  + 64 * (j))
#define XB_XSUB(j)  (1280 + 64 * (j))
#define XB_XGEN(j)  (2304 + 64 * (j))
#define XB_TOP      3328
#define XB_TOPGEN   3392
#define XCD_BAR_WORDS 3456
#define XB_SPIN_CAP (1u << 18)
__device__ __forceinline__ unsigned xb_ld(unsigned* p)              { return __hip_atomic_load(p, __ATOMIC_RELAXED, __HIP_MEMORY_SCOPE_AGENT); }
__device__ __forceinline__ unsigned xb_add(unsigned* p, unsigned v) { return __hip_atomic_fetch_add(p, v, __ATOMIC_RELAXED, __HIP_MEMORY_SCOPE_AGENT); }
__device__ __forceinline__ unsigned xb_xcc_id() { return (unsigned)__builtin_amdgcn_s_getreg((3 << 11) | 20) & 0xFu; }
#define XB_SPIN(cond, bar) do { unsigned _sp = 0; while (cond) { __builtin_amdgcn_s_sleep(1); \
    if ((++_sp & 255u) == 0u) { if (xb_ld(&(bar)[XB_TMO])) break; if (_sp > XB_SPIN_CAP) { atomicAdd(&(bar)[XB_TMO], 1u); break; } } } } while (0)
struct XcdBarrier { unsigned* bar; unsigned x; volatile LAS unsigned* st; };
__device__ __forceinline__ XcdBarrier xcd_barrier_post(unsigned* bar, volatile LAS unsigned* st) {
    XcdBarrier b; b.bar = bar; b.x = xb_xcc_id(); b.st = st;
    if (threadIdx.x == 0) (void)xb_add(&bar[XB_XCNT(b.x)], 1u);
    return b;
}
__device__ __forceinline__ void xcd_barrier_complete(unsigned* bar, unsigned x, unsigned& nloc, unsigned& nx) {
    const unsigned G = gridDim.x * gridDim.y * gridDim.z;
    unsigned sum, cnt, mine, sp = 0u;
    for (;;) {
        sum = 0u; cnt = 0u; mine = 0u;
#pragma unroll
        for (unsigned j = 0; j < 16; ++j) { const unsigned c = xb_ld(&bar[XB_XCNT(j)]); sum += c; cnt += (c > 0u) ? 1u : 0u; mine = (j == x) ? c : mine; }
        if (sum == G) break;
        __builtin_amdgcn_s_sleep(1);
        if ((++sp & 255u) == 0u) { if (xb_ld(&bar[XB_TMO])) break; if (sp > XB_SPIN_CAP) { atomicAdd(&bar[XB_TMO], 1u); break; } }
    }
    nloc = mine > 0u ? mine : 1u; nx = cnt > 0u ? cnt : 1u;
}
__device__ __forceinline__ void xcd_barrier(const XcdBarrier& b) {
    asm volatile("s_waitcnt vmcnt(0)" ::: "memory");
    __syncthreads();
    if (threadIdx.x == 0) {
        unsigned* bar = b.bar;
        __builtin_amdgcn_s_waitcnt(0);
        unsigned nloc = b.st[0], nx = b.st[1];
        if (nloc == 0u) { xcd_barrier_complete(bar, b.x, nloc, nx); b.st[0] = nloc; b.st[1] = nx; }
        const unsigned old = xb_add(&bar[XB_XSUB(b.x)], 1u);
        const unsigned gen = old / nloc;
        if (old + 1u == (gen + 1u) * nloc) {
            __builtin_amdgcn_fence(__ATOMIC_RELEASE, "agent");
            asm volatile("s_waitcnt vmcnt(0)" ::: "memory");
            const unsigned og = xb_add(&bar[XB_TOP], 1u);
            const unsigned tg = og / nx;
            if (og + 1u == (tg + 1u) * nx) xb_add(&bar[XB_TOPGEN], 1u);
            else XB_SPIN(xb_ld(&bar[XB_TOPGEN]) == tg, bar);
            __builtin_amdgcn_fence(__ATOMIC_ACQUIRE, "agent");
            xb_add(&bar[XB_XGEN(b.x)], 1u);
            asm volatile("s_waitcnt vmcnt(0)" ::: "memory");
        } else {
            XB_SPIN(xb_ld(&bar[XB_XGEN(b.x)]) == gen, bar);
            __builtin_amdgcn_fence(__ATOMIC_ACQUIRE, "agent");
            asm volatile("s_waitcnt vmcnt(0)" ::: "memory");
        }
    }
    __syncthreads();
}

struct MapId { static __device__ __forceinline__ int src(int j) { return j; } };
struct MapWin {
    static __device__ __forceinline__ int src(int j) {
        if (j < 1024) { const int g8 = j >> 3, i = j & 7; return ((i < 4) ? 0 : 1024) + 4 * g8 + (i & 3); }
        if (j < 1536) return 512 + (j - 1024);
        if (j < 2560) { const int jj = j - 1536, qk = jj >> 9, p = jj & 511, head = p >> 6, pl = p & 63, g = pl >> 3, i = pl & 7; return 1536 + qk * 512 + head * 64 + 4 * g + (i & 3) + 32 * (i >> 2); }
        return j;
    }
};
template <class MAP>
__device__ __forceinline__ void p0_transpose_item(const float* W, int K, int N, int NOUT, bf16* WT, LAS float* scr, int item, int lane, const float* gain = nullptr) {
    const int nblk = NOUT / 32, kb = item / nblk, nb = item % nblk, k0 = 64 * kb, n0 = 32 * nb;
    const int sc = MAP::src(n0 + (lane & 31));
    float wv[32];
#pragma unroll
    for (int i = 0; i < 32; ++i) wv[i] = W[(size_t)(k0 + 2 * i + (lane >> 5)) * N + sc];
#pragma unroll
    for (int i = 0; i < 32; ++i) { const int kk = 2 * i + (lane >> 5); const float gk = gain ? gain[k0 + kk] : 1.f; scr[kk * 33 + (lane & 31)] = wv[i] * gk; }
    LDS_WAIT(); asm volatile("" ::: "memory");
    const int c = lane & 7;
#pragma unroll
    for (int j = 0; j < 4; ++j) { const int n = (lane >> 3) + 8 * j; const LAS float* s = scr + (8 * c) * 33 + n;
        v4u o; o.x = pk2(s[0 * 33], s[1 * 33]); o.y = pk2(s[2 * 33], s[3 * 33]); o.z = pk2(s[4 * 33], s[5 * 33]); o.w = pk2(s[6 * 33], s[7 * 33]);
        *(GAS v4u*)(WT + (size_t)(n0 + n) * K + k0 + 8 * c) = o; }
    LDS_WAIT(); asm volatile("" ::: "memory");
}
__device__ __forceinline__ void rms_row_to_bf16(const float* xrow, const float* g, bf16* orow, int lane) {
    const GAS f32x4* xr = (const GAS f32x4*)xrow + lane; const GAS f32x4* gr = (const GAS f32x4*)g + lane;
    f32x4 v[4]; float s = 0.f;
#pragma unroll
    for (int j = 0; j < 4; ++j) { v[j] = xr[64 * j]; s += (v[j].x * v[j].x + v[j].y * v[j].y) + (v[j].z * v[j].z + v[j].w * v[j].w); }
    const float r = rsqrtf(wave_sum(s) * (1.f / 1024.f) + RMS_EPS);
    GAS v2u* o8 = (GAS v2u*)orow + lane;
#pragma unroll
    for (int j = 0; j < 4; ++j) { const f32x4 gg = gr[64 * j]; v2u w; w.x = pk2(v[j].x * r * gg.x, v[j].y * r * gg.y); w.y = pk2(v[j].z * r * gg.z, v[j].w * r * gg.w); o8[64 * j] = w; }
}
template <int NR>
__device__ __forceinline__ void rms_rows_to_bf16(const float* x, const float* g, bf16* o, int m0, int stride, int lane) {
    f32x4 v[NR][4];
#pragma unroll
    for (int i = 0; i < NR; ++i) { const GAS f32x4* xr = (const GAS f32x4*)(x + (size_t)(m0 + i * stride) * 1024) + lane;
#pragma unroll
        for (int j = 0; j < 4; ++j) v[i][j] = xr[64 * j]; }
    f32x4 gg[4];
#pragma unroll
    for (int j = 0; j < 4; ++j) gg[j] = ((const GAS f32x4*)g + lane)[64 * j];
#pragma unroll
    for (int i = 0; i < NR; ++i) { float s = 0.f;
#pragma unroll
        for (int j = 0; j < 4; ++j) s += (v[i][j].x * v[i][j].x + v[i][j].y * v[i][j].y) + (v[i][j].z * v[i][j].z + v[i][j].w * v[i][j].w);
        const float r = rsqrtf(wave_sum(s) * (1.f / 1024.f) + RMS_EPS);
        GAS v2u* o8 = (GAS v2u*)(o + (size_t)(m0 + i * stride) * 1024) + lane;
#pragma unroll
        for (int j = 0; j < 4; ++j) { v2u w; w.x = pk2(v[i][j].x * r * gg[j].x, v[i][j].y * r * gg[j].y); w.y = pk2(v[i][j].z * r * gg[j].z, v[i][j].w * r * gg[j].w); o8[64 * j] = w; } }
}
__device__ __forceinline__ float fmax_asm(float a, float b) { float r; asm("v_max_f32 %0, %1, %2" : "=v"(r) : "v"(a), "v"(b)); return r; }
__device__ __forceinline__ float fmin_asm(float a, float b) { float r; asm("v_min_f32 %0, %1, %2" : "=v"(r) : "v"(a), "v"(b)); return r; }

#ifndef PH_MASK
#define PH_MASK 0xFFFFFFFFu
#endif
#define PH(k) ((PH_MASK >> (k)) & 1u)
#ifndef REP_MASK
#define REP_MASK 0u
#endif
#define NREP(k) (((REP_MASK >> (k)) & 1u) ? 2 : 1)
#ifndef DIAG_TS_A
#define DIAG_TS_A -1
#endif
#ifndef DIAG_TS_B
#define DIAG_TS_B -1
#endif
struct Args { const float* in[19]; float* out; unsigned char* ws; };

struct XOrder {
    const char* A; const char* Bt; int G, c, i0, mode;
    __device__ bool next(int i, pg8::Unit& u) const {
        if (i > 0) return false;
        const int L = i0 * G + c; if (L >= 512) return false;
        const int b = L >> 5, head = (L >> 3) & 3, rt = L & 7;
        u.pm = b * 8 + rt; u.pn = head;
        if (mode == 0) { u.a = A + (size_t)(b * 2048 + rt * 256) * 1024 * 2; u.b = Bt + (size_t)(head * 256) * 1024 * 2; }
        else { u.a = A + ((size_t)(b * 2048 + rt * 256) * 1024 + head * 256) * 2;
               u.b = (mode == 2) ? Bt + ((size_t)(head * 256) * 4096 + b * 256) * 2 : Bt + ((size_t)(b * 256) * 1024 + head * 256) * 2; }
        return true;
    }
};

__global__ void __launch_bounds__(NWAVES * 64, 2) mk_fwd(Args args) {
    extern __shared__ __attribute__((aligned(16))) unsigned char lds[];
    LAS unsigned char* L = (LAS unsigned char*)lds;
    volatile LAS unsigned* MISC = (volatile LAS unsigned*)(L + MISC_OFF);
    const int wave = __builtin_amdgcn_readfirstlane((int)threadIdx.x >> 6);
#define PH_LANES int tid = threadIdx.x; asm volatile("" : "+v"(tid)); const int lane = tid & 63; const int gt = vcu * (NWAVES * 64) + tid; (void)lane; (void)gt
    const int G = gridDim.x; const int bx = blockIdx.x; const int vcu = (G % 8 == 0) ? (bx % 8) * (G / 8) + bx / 8 : bx;
    unsigned char* ws = args.ws;
    gu32* ctl = (gu32*)(ws + WS_CTL);
    for (int u = threadIdx.x; u < (LDS_BYTES - LDSCTL_OFF) / 4; u += NWAVES * 64) ((LAS unsigned*)(L + LDSCTL_OFF))[u] = 0u;
    __syncthreads();
    XcdBarrier bar = xcd_barrier_post((unsigned*)(ctl + CW_BAR), MISC + 8);
    unsigned long long* tsw = (unsigned long long*)(ws + WS_CTL + 65536);
    int n_ts = 0;
#define TSTAMP() do { if (DIAG_TS_A >= 0) { if (bx == 0 && threadIdx.x == 0) tsw[n_ts] = __builtin_amdgcn_s_memrealtime(); ++n_ts; } } while (0)
    TSTAMP();

    const float *x = args.in[0], *mem = args.in[1], *g_mix = args.in[2], *w_in = args.in[3], *w_conv = args.in[4], *w_conv_out = args.in[5], *w_attn_out = args.in[6], *w_merge = args.in[7],
                *g_xattn = args.in[8], *g_mem = args.in[9], *w_xq = args.in[10], *w_xkv = args.in[11], *w_xo = args.in[12], *g_ffn = args.in[13], *w_pq = args.in[14], *sub_keys = args.in[15],
                *peer_u = args.in[16], *peer_v = args.in[17], *g_final = args.in[18];
    float* out = args.out;
    bf16 *WinT = (bf16*)(ws + WS_WIN), *WcT = (bf16*)(ws + WS_WC), *WaT = (bf16*)(ws + WS_WA), *WmT = (bf16*)(ws + WS_WM), *WxqT = (bf16*)(ws + WS_WXQ), *WxkvT = (bf16*)(ws + WS_WXKV),
         *WxoT = (bf16*)(ws + WS_WXO), *MT = (bf16*)(ws + WS_MT);
    float* ropec = (float*)(ws + WS_ROPE); float* ropes = ropec + 2048 * 32;
    float* kbar = (float*)(ws + WS_KBAR);
    bf16 *MEMN = (bf16*)(ws + WS_MEMN), *KX = (bf16*)(ws + WS_KX), *VXT = (bf16*)(ws + WS_VXT), *A = (bf16*)(ws + WS_A);
    bf16 *YC = (bf16*)(ws + WS_YC), *QO = (bf16*)(ws + WS_QO), *U = (bf16*)(ws + WS_U), *KB = (bf16*)(ws + WS_K), *VB = (bf16*)(ws + WS_V), *SGC = (bf16*)(ws + WS_SGC), *SGA = (bf16*)(ws + WS_SGA);
    bf16 *QX = (bf16*)(ws + WS_QX), *PM = (bf16*)(ws + WS_PM), *OX = (bf16*)(ws + WS_OX);
    _Float16* SC = (_Float16*)(ws + WS_SC);
    unsigned char* A8I = ws + WS_A8I; float* ASC = (float*)(ws + WS_ASC);
    int* EIDX = (int*)(ws + WS_EIDX); float* GW = (float*)(ws + WS_GW); unsigned* PW = (unsigned*)(ws + WS_PW);
    float* PO = (float*)(ws + WS_PO); float* SSQ1 = (float*)(ws + WS_SSQ1); float* SSQ2 = (float*)(ws + WS_SSQ2); (void)PO;
    unsigned char* U8 = ws + WS_U8; unsigned char* V8T = ws + WS_V8T; float* SU = (float*)(ws + WS_SU); float* SV = (float*)(ws + WS_SV);
    const int gw = vcu * NWAVES + wave, NGW = G * NWAVES;
    const int NGT = G * NWAVES * 64;

    asm volatile("; ===== PHASE 0 =====");
    if (PH(0)) for (int rep = 0; rep < NREP(0); ++rep) {
        PH_LANES; const bool dummy = rep < NREP(0) - 1; (void)dummy;
        LAS float* scr = (LAS float*)(L + RING_OFF + wave * 16384);
        constexpr int I_IN = (1024 / 64) * (5120 / 32), I_C = (512 / 64) * (1024 / 32), I_M = (1024 / 64) * (1024 / 32), I_KV = (1024 / 64) * (2048 / 32);
        constexpr int NITEMS = I_IN + 2 * I_C + 3 * I_M + I_KV;
        for (int it = gw; it < NITEMS; it += NGW) {
            int r = it;
            if (r < I_IN) { p0_transpose_item<MapWin>(w_in, 1024, 5120, 5120, WinT, scr, r, lane); continue; } r -= I_IN;
            if (r < I_C) { p0_transpose_item<MapId>(w_conv_out, 512, 1024, 1024, WcT, scr, r, lane); continue; } r -= I_C;
            if (r < I_C) { p0_transpose_item<MapId>(w_attn_out, 512, 1024, 1024, WaT, scr, r, lane); continue; } r -= I_C;
            if (r < I_M) { p0_transpose_item<MapId>(w_merge, 1024, 1024, 1024, WmT, scr, r, lane); continue; } r -= I_M;
            if (r < I_M) { p0_transpose_item<MapId>(w_xq, 1024, 1024, 1024, WxqT, scr, r, lane, g_xattn); continue; } r -= I_M;
            if (r < I_M) { p0_transpose_item<MapId>(w_xo, 1024, 1024, 1024, WxoT, scr, r, lane); continue; } r -= I_M;
            p0_transpose_item<MapId>(w_xkv, 1024, 2048, 2048, WxkvT, scr, r, lane);
        }
        { int m = gw; for (; m + 3 * NGW < T; m += 4 * NGW) rms_rows_to_bf16<4>(x, g_mix, A, m, NGW, lane); for (; m < T; m += NGW) rms_row_to_bf16(x + (size_t)m * D, g_mix, A + (size_t)m * D, lane); }
        { int m = gw; for (; m + NGW < MEMROWS; m += 2 * NGW) rms_rows_to_bf16<2>(mem, g_mem, MEMN, m, NGW, lane); for (; m < MEMROWS; m += NGW) rms_row_to_bf16(mem + (size_t)m * D, g_mem, MEMN + (size_t)m * D, lane); }
        for (int i = gt; i < 2048 * 32; i += NGT) { const int pos = i >> 5, f = i & 31; const float inv = powf(10000.0f, -(float)f / 32.0f); const float ang = (float)pos * inv; ropec[i] = cosf(ang); ropes[i] = sinf(ang); }
        __syncthreads();
        {
            LAS float* skl = (LAS float*)(L + RING_OFF);
            LAS float* wtl = skl + 128 * 129;
            for (int it = bx; it < 256; it += G) {
                const int hp = it >> 4, cb = it & 15;
                for (int i = tid; i < 128 * 128; i += NWAVES * 64) { const int n = i >> 7, d = i & 127; skl[n * 129 + d] = sub_keys[((size_t)hp * 128 + n) * 128 + d]; }
                for (int i = tid; i < 64 * 128; i += NWAVES * 64) { const int c = i >> 7, d = i & 127; wtl[c * 129 + d] = w_pq[(size_t)(cb * 64 + c) * 2048 + hp * 128 + d] * g_ffn[cb * 64 + c]; }
                __syncthreads();
                const int cg = tid & 15, ng = tid >> 4;
                float acc[4][4];
#pragma unroll
                for (int i = 0; i < 4; ++i)
#pragma unroll
                    for (int j = 0; j < 4; ++j) acc[i][j] = 0.f;
                for (int d = 0; d < 128; ++d) {
                    float wv[4], sv[4];
#pragma unroll
                    for (int i = 0; i < 4; ++i) { wv[i] = wtl[(4 * cg + i) * 129 + d]; sv[i] = skl[(4 * ng + i) * 129 + d]; }
#pragma unroll
                    for (int i = 0; i < 4; ++i)
#pragma unroll
                        for (int j = 0; j < 4; ++j) acc[i][j] += sv[i] * wv[j];
                }
#pragma unroll
                for (int i = 0; i < 4; ++i) { v2u w; w.x = pk2(acc[i][0], acc[i][1]); w.y = pk2(acc[i][2], acc[i][3]); *(GAS v2u*)(MT + (size_t)(hp * 128 + 4 * ng + i) * 1024 + cb * 64 + 4 * cg) = w; }
                __syncthreads();
            }
        }
    }
    xcd_barrier(bar); TSTAMP();

    asm volatile("; ===== PHASE 1 =====");
    if (PH(1)) for (int rep = 0; rep < NREP(1); ++rep) {
        PH_LANES; const bool dummy = rep < NREP(1) - 1; (void)dummy;
        pg8::Gemm g{1024, 1024, 1024}; pg8::StaticOrder S; S.init(A, 1024, WinT, 1024, T, INW, G, bx);
        pg8::EpiIn E{U, YC, QO, KB, VB, SGC, SGA, ropec, ropes, kbar, 0.125f * 1.4426950408889634f};
        pg8::gemm_phase<pg8::EpiIn, pg8::StaticOrder, true>(L + RING_OFF, g, S, E);
    }
    if (PH(1)) for (int rep = 0; rep < NREP(1); ++rep) {
        PH_LANES; const bool dummy = rep < NREP(1) - 1; (void)dummy;
        pg8::Gemm g{1024, 1024, 1024}; pg8::StaticOrder S; S.init(MEMN, 1024, WxkvT, 1024, MEMROWS, 1024, G, bx);
        pg8::EpiBf16 E{KX, 1024};
        pg8::gemm_phase<pg8::EpiBf16, pg8::StaticOrder, true>(L + RING_OFF, g, S, E);
    }
    if (PH(1)) for (int rep = 0; rep < NREP(1); ++rep) {
        PH_LANES; const bool dummy = rep < NREP(1) - 1; (void)dummy;
        pg8::Gemm g{1024, 1024, 1024}; pg8::StaticOrder S; S.init(WxkvT + (size_t)1024 * 1024, 1024, MEMN, 1024, 1024, MEMROWS, G, (bx + 128) % G);
        pg8::EpiBf16 E{VXT, 4096};
        pg8::gemm_phase<pg8::EpiBf16, pg8::StaticOrder, true>(L + RING_OFF, g, S, E);
    }
    if (PH(1)) for (int rep = 0; rep < NREP(1); ++rep) {
        PH_LANES; const bool dummy = rep < NREP(1) - 1; (void)dummy;
        int cb, ncb;
        if (G == 256) { const bool idle = (bx >= 64 && bx < 128) || bx >= 192; cb = idle ? ((bx < 128) ? bx - 64 : bx - 128) : 256; ncb = 128; } else { cb = bx; ncb = G; }
        const int cw = cb * NWAVES + wave, ncw = ncb * NWAVES;
        for (int e = (cb < ncb ? cw : 16384); e < 16384; e += ncw) {
            const GAS f32x4* r = (const GAS f32x4*)(peer_u + (size_t)e * D) + lane; f32x4 v[4]; float am = 0.f;
#pragma unroll
            for (int j = 0; j < 4; ++j) { v[j] = r[64 * j] * ((const GAS f32x4*)g_ffn + lane)[64 * j]; am = fmaxf(fmaxf(am, fmaxf(fabsf(v[j].x), fabsf(v[j].y))), fmaxf(fabsf(v[j].z), fabsf(v[j].w))); }
            am = wave_max(am);
            const float sc = am > 0.f ? 7.f / am : 1.f; int ns = 0;
#pragma unroll
            for (int j = 0; j < 2; ++j) {
                const int l0 = (int)rintf(v[j].x * sc) + 8, l1 = (int)rintf(v[j].y * sc) + 8, l2 = (int)rintf(v[j].z * sc) + 8, l3 = (int)rintf(v[j].w * sc) + 8;
                const int h0 = (int)rintf(v[j + 2].x * sc) + 8, h1 = (int)rintf(v[j + 2].y * sc) + 8, h2 = (int)rintf(v[j + 2].z * sc) + 8, h3 = (int)rintf(v[j + 2].w * sc) + 8;
                ns += (l0 + l1) + (l2 + l3) + (h0 + h1) + (h2 + h3);
                *(GAS unsigned*)(U8 + (size_t)e * 512 + 4 * lane + 256 * j) = (unsigned)(l0 | (h0 << 4)) | ((unsigned)(l1 | (h1 << 4)) << 8) | ((unsigned)(l2 | (h2 << 4)) << 16) | ((unsigned)(l3 | (h3 << 4)) << 24); }
            const float nsf = wave_sum((float)ns);
            if (lane == 0) { SU[4 * e] = am > 0.f ? am * (1.f / 7.f) : 1.f; SU[4 * e + 2] = nsf; }
        }
        __syncthreads();
        for (int it = cb; it < 256; it += ncb) {
            const int e0 = it * 64;
#pragma unroll 1
            for (int rr = 0; rr < 8; ++rr) {
                const int el = wave * 8 + rr, e = e0 + el;
                const GAS f32x4* r = (const GAS f32x4*)(peer_v + (size_t)e * D) + lane; f32x4 v[4]; float am = 0.f;
#pragma unroll
                for (int j = 0; j < 4; ++j) { v[j] = r[64 * j]; am = fmaxf(fmaxf(am, fmaxf(fabsf(v[j].x), fabsf(v[j].y))), fmaxf(fabsf(v[j].z), fabsf(v[j].w))); }
                am = wave_max(am);
                const float sc = am > 0.f ? 4.f / am : 1.f; if (lane == 0) SU[4 * e + 1] = am > 0.f ? am * 0.25f : 1.f;
#pragma unroll
                for (int j = 0; j < 4; ++j) { int w = __builtin_amdgcn_cvt_pk_bf8_f32(v[j].x * sc, v[j].y * sc, 0, false); w = __builtin_amdgcn_cvt_pk_bf8_f32(v[j].z * sc, v[j].w * sc, w, true);
                    *(LAS unsigned*)(L + RING_OFF + el * 1024 + 4 * lane + 256 * j) = (unsigned)w; }
            }
            __syncthreads();
#pragma unroll
            for (int i = 0; i < 8; ++i) { const int idx = tid + 512 * i, sl = idx >> 5, k = idx & 31;
                const v2u a0 = *(const LAS v2u*)(L + RING_OFF + (2 * k) * 1024 + sl * 8), a1 = *(const LAS v2u*)(L + RING_OFF + (2 * k + 1) * 1024 + sl * 8);
                *(GAS v4u*)(V8T + ((size_t)sl * 16384 + e0 + 2 * k) * 8) = (v4u){a0.x, a0.y, a1.x, a1.y}; }
            __syncthreads();
        }
    }
    xcd_barrier(bar); TSTAMP();

    asm volatile("; ===== PHASE 2 =====");
    if (PH(2)) for (int rep = 0; rep < NREP(2); ++rep) {
        PH_LANES; const bool dummy = rep < NREP(2) - 1; (void)dummy;
        for (int i = gt; i < T * 64; i += NGT) {
            const int row = i >> 6, cg = i & 63, s = row & 2047;
            const v4u u0 = *(const GAS v4u*)(U + (size_t)row * 512 + cg * 8);
            v4u u1 = (v4u){0u, 0u, 0u, 0u}, u2 = (v4u){0u, 0u, 0u, 0u};
            if (s >= 1) u1 = *(const GAS v4u*)(U + (size_t)(row - 1) * 512 + cg * 8);
            if (s >= 2) u2 = *(const GAS v4u*)(U + (size_t)(row - 2) * 512 + cg * 8);
            const v4u bq = *(const GAS v4u*)(YC + (size_t)row * 512 + cg * 8);
            const f32x4 w0a = *(const GAS f32x4*)(w_conv + cg * 8), w0b = *(const GAS f32x4*)(w_conv + cg * 8 + 4);
            const f32x4 w1a = *(const GAS f32x4*)(w_conv + 512 + cg * 8), w1b = *(const GAS f32x4*)(w_conv + 512 + cg * 8 + 4);
            const f32x4 w2a = *(const GAS f32x4*)(w_conv + 1024 + cg * 8), w2b = *(const GAS f32x4*)(w_conv + 1024 + cg * 8 + 4);
            v4u o;
#define CONV2(q, wa, ia, ib) pk2(bflo(bq.q) * (w0##wa[ia] * bflo(u2.q) + w1##wa[ia] * bflo(u1.q) + w2##wa[ia] * bflo(u0.q)), bfhi(bq.q) * (w0##wa[ib] * bfhi(u2.q) + w1##wa[ib] * bfhi(u1.q) + w2##wa[ib] * bfhi(u0.q)))
            o.x = CONV2(x, a, 0, 1); o.y = CONV2(y, a, 2, 3); o.z = CONV2(z, b, 0, 1); o.w = CONV2(w, b, 2, 3);
#undef CONV2
            { const bool conv_dummy = (NREP(2) == 2) && !dummy; *(GAS v4u*)(YC + (size_t)row * 512 + cg * 8) = conv_dummy ? bq : o; }
        }
        __syncthreads();
        const attn_body::AttnTensors AT{(const attn_body::bf16*)QO, (const attn_body::bf16*)KB, (const attn_body::bf16*)VB, (attn_body::bf16*)(dummy ? A : QO), kbar};
        const attn_body::StaticOrder S(G, bx);
        attn_body::attn_phase<attn_body::StaticOrder>((char*)lds + RING_OFF, AT, S);
    }
    xcd_barrier(bar); TSTAMP();

    asm volatile("; ===== PHASE 3 =====");
    if (PH(3)) for (int rep = 0; rep < NREP(3); ++rep) {
        PH_LANES; const bool dummy = rep < NREP(3) - 1; (void)dummy;
        pg8::Gemm g{512, 512, 512}; pg8::StaticOrder S; S.init(YC, 512, WcT, 512, T, 1024, G, bx);
        pg8::EpiGateMul E{SGC, dummy ? A : SGC, 1024};
        pg8::gemm_phase<pg8::EpiGateMul, pg8::StaticOrder, true>(L + RING_OFF, g, S, E);
    }
    if (PH(3)) for (int rep = 0; rep < NREP(3); ++rep) {
        PH_LANES; const bool dummy = rep < NREP(3) - 1; (void)dummy;
        pg8::Gemm g{512, 512, 512}; pg8::StaticOrder S; S.init(QO, 512, WaT, 512, T, 1024, G, bx);
        pg8::EpiGateFma E{SGC, SGA, dummy ? A : SGA, 1024};
        pg8::gemm_phase<pg8::EpiGateFma, pg8::StaticOrder, true>(L + RING_OFF, g, S, E);
    }
    xcd_barrier(bar); TSTAMP();

    asm volatile("; ===== PHASE 4 =====");
    if (PH(4)) for (int rep = 0; rep < NREP(4); ++rep) {
        PH_LANES; const bool dummy = rep < NREP(4) - 1; (void)dummy;
        pg8::Gemm g{1024, 1024, 1024}; pg8::StaticOrder S; S.init(SGA, 1024, WmT, 1024, T, 1024, G, bx);
        pg8::EpiResNorm<true> E{x, A, SSQ1, 1024, 1.f};
        pg8::gemm_phase<pg8::EpiResNorm<true>, pg8::StaticOrder, true>(L + RING_OFF, g, S, E);
    }
    xcd_barrier(bar); TSTAMP();

    asm volatile("; ===== PHASE 6 =====");
    if (PH(6)) for (int rep = 0; rep < NREP(6); ++rep) {
        PH_LANES; const bool dummy = rep < NREP(6) - 1; (void)dummy;
        const pg8::Gemm gq{1024, 1024, 1024}, gs{1024, 1024, 256}, gv{1024, 4096, 256};
        const pg8::EpiBf16RS Eq{QX, 1024, SSQ1}; const pg8::EpiSoftmax Es{PM, 1024, 0.0625f * 1.4426950408889634f}; const pg8::EpiBf16 Ev{OX, 1024};
        { XOrder S{(const char*)A, (const char*)WxqT, G, vcu, 0, 0}; pg8::gemm_phase<pg8::EpiBf16RS, XOrder, false>(L + RING_OFF, gq, S, Eq); }
        VM_WAIT(); __syncthreads();
        { XOrder S{(const char*)QX, (const char*)KX, G, vcu, 0, 1}; pg8::gemm_phase<pg8::EpiSoftmax, XOrder, false>(L + RING_OFF, gs, S, Es); }
        VM_WAIT(); __syncthreads();
        { XOrder S{(const char*)PM, (const char*)VXT, G, vcu, 0, 2}; pg8::gemm_phase<pg8::EpiBf16, XOrder, false>(L + RING_OFF, gv, S, Ev); }
        VM_WAIT(); __syncthreads();
        { XOrder S{(const char*)A, (const char*)WxqT, G, vcu, 1, 0}; pg8::gemm_phase<pg8::EpiBf16RS, XOrder, false>(L + RING_OFF, gq, S, Eq); }
        VM_WAIT(); __syncthreads();
        { XOrder S{(const char*)QX, (const char*)KX, G, vcu, 1, 1}; pg8::gemm_phase<pg8::EpiSoftmax, XOrder, false>(L + RING_OFF, gs, S, Es); }
        VM_WAIT(); __syncthreads();
        { XOrder S{(const char*)PM, (const char*)VXT, G, vcu, 1, 2}; pg8::gemm_phase<pg8::EpiBf16, XOrder, false>(L + RING_OFF, gv, S, Ev); }
    }
    xcd_barrier(bar); TSTAMP();

    asm volatile("; ===== PHASE 9 =====");
    if (PH(9)) for (int rep = 0; rep < NREP(9); ++rep) {
        PH_LANES; const bool dummy = rep < NREP(9) - 1; (void)dummy;
        pg8::Gemm g{1024, 1024, 1024}; pg8::StaticOrder S; S.init(OX, 1024, WxoT, 1024, T, 1024, G, bx);
        pg8::EpiResNorm<false> E{nullptr, A, SSQ2, 1024, dummy ? 0.f : 1.f};
        pg8::gemm_phase<pg8::EpiResNorm<false>, pg8::StaticOrder, true>(L + RING_OFF, g, S, E);
    }
    xcd_barrier(bar); TSTAMP();

    asm volatile("; ===== PHASE 11 =====");
    if (PH(11)) for (int rep = 0; rep < NREP(11); ++rep) {
        PH_LANES; const bool dummy = rep < NREP(11) - 1; (void)dummy;
        pg8::Gemm g{1024, 1024, 1024}; pg8::StaticOrder S; S.init(A, 1024, MT, 1024, T, 2048, G, bx);
        pg8::EpiF16RS E{SC, 2048, SSQ2};
        pg8::gemm_phase<pg8::EpiF16RS, pg8::StaticOrder, true>(L + RING_OFF, g, S, E);
    }
    xcd_barrier(bar); TSTAMP();

    asm volatile("; ===== PHASE 12 =====");
    if (PH(12)) for (int rep = 0; rep < NREP(12); ++rep) {
        PH_LANES; const bool dummy = rep < NREP(12) - 1; (void)dummy;
        typedef _Float16 h8 __attribute__((ext_vector_type(8)));
#define RCE(a, b) do { const float hi_ = fmax_asm(a, b); b = fmin_asm(a, b); a = hi_; } while (0)
#define RSORT16(K) do { RCE(K[0], K[1]); RCE(K[3], K[2]); RCE(K[4], K[5]); RCE(K[7], K[6]); RCE(K[8], K[9]); RCE(K[11], K[10]); RCE(K[12], K[13]); RCE(K[15], K[14]); RCE(K[0], K[2]); RCE(K[1], K[3]); RCE(K[6], K[4]); RCE(K[7], K[5]); RCE(K[8], K[10]); RCE(K[9], K[11]); RCE(K[14], K[12]); RCE(K[15], K[13]); RCE(K[0], K[1]); RCE(K[2], K[3]); RCE(K[5], K[4]); RCE(K[7], K[6]); RCE(K[8], K[9]); RCE(K[10], K[11]); RCE(K[13], K[12]); RCE(K[15], K[14]); RCE(K[0], K[4]); RCE(K[1], K[5]); RCE(K[2], K[6]); RCE(K[3], K[7]); RCE(K[12], K[8]); RCE(K[13], K[9]); RCE(K[14], K[10]); RCE(K[15], K[11]); RCE(K[0], K[2]); RCE(K[1], K[3]); RCE(K[4], K[6]); RCE(K[5], K[7]); RCE(K[10], K[8]); RCE(K[11], K[9]); RCE(K[14], K[12]); RCE(K[15], K[13]); RCE(K[0], K[1]); RCE(K[2], K[3]); RCE(K[4], K[5]); RCE(K[6], K[7]); RCE(K[9], K[8]); RCE(K[11], K[10]); RCE(K[13], K[12]); RCE(K[15], K[14]); RCE(K[0], K[8]); RCE(K[1], K[9]); RCE(K[2], K[10]); RCE(K[3], K[11]); RCE(K[4], K[12]); RCE(K[5], K[13]); RCE(K[6], K[14]); RCE(K[7], K[15]); RCE(K[0], K[4]); RCE(K[1], K[5]); RCE(K[2], K[6]); RCE(K[3], K[7]); RCE(K[8], K[12]); RCE(K[9], K[13]); RCE(K[10], K[14]); RCE(K[11], K[15]); RCE(K[0], K[2]); RCE(K[1], K[3]); RCE(K[4], K[6]); RCE(K[5], K[7]); RCE(K[8], K[10]); RCE(K[9], K[11]); RCE(K[12], K[14]); RCE(K[13], K[15]); RCE(K[0], K[1]); RCE(K[2], K[3]); RCE(K[4], K[5]); RCE(K[6], K[7]); RCE(K[8], K[9]); RCE(K[10], K[11]); RCE(K[12], K[13]); RCE(K[14], K[15]); } while (0)
#define RMERGE16(K) do { RCE(K[0], K[8]); RCE(K[1], K[9]); RCE(K[2], K[10]); RCE(K[3], K[11]); RCE(K[4], K[12]); RCE(K[5], K[13]); RCE(K[6], K[14]); RCE(K[7], K[15]); RCE(K[0], K[4]); RCE(K[1], K[5]); RCE(K[2], K[6]); RCE(K[3], K[7]); RCE(K[8], K[12]); RCE(K[9], K[13]); RCE(K[10], K[14]); RCE(K[11], K[15]); RCE(K[0], K[2]); RCE(K[1], K[3]); RCE(K[4], K[6]); RCE(K[5], K[7]); RCE(K[8], K[10]); RCE(K[9], K[11]); RCE(K[12], K[14]); RCE(K[13], K[15]); RCE(K[0], K[1]); RCE(K[2], K[3]); RCE(K[4], K[5]); RCE(K[6], K[7]); RCE(K[8], K[9]); RCE(K[10], K[11]); RCE(K[12], K[13]); RCE(K[14], K[15]); } while (0)
#define RKEYS(K, V0, V1, IDB) do { _Pragma("unroll") for (int e = 0; e < 8; ++e) { K[e] = __uint_as_float(__float_as_uint((float)V0[e]) | (unsigned)((IDB) + e)); K[8 + e] = __uint_as_float(__float_as_uint((float)V1[e]) | (unsigned)((IDB) + 8 + e)); } } while (0)
        for (int tb4 = gw * 4; tb4 < T; tb4 += NGW * 4) {
            v4u r0[4], r1[4]; float sq[4];
#pragma unroll
            for (int i = 0; i < 4; ++i) { const GAS v4u* ar = (const GAS v4u*)(A + (size_t)(tb4 + i) * D + 16 * lane); r0[i] = ar[0]; r1[i] = ar[1]; sq[i] = lane < 16 ? SSQ2[(size_t)(tb4 + i) * 16 + lane] : 0.f; }
#pragma unroll
            for (int i = 0; i < 4; ++i) {
                float a[16];
                a[0] = bflo(r0[i].x); a[1] = bfhi(r0[i].x); a[2] = bflo(r0[i].y); a[3] = bfhi(r0[i].y); a[4] = bflo(r0[i].z); a[5] = bfhi(r0[i].z); a[6] = bflo(r0[i].w); a[7] = bfhi(r0[i].w);
                a[8] = bflo(r1[i].x); a[9] = bfhi(r1[i].x); a[10] = bflo(r1[i].y); a[11] = bfhi(r1[i].y); a[12] = bflo(r1[i].z); a[13] = bfhi(r1[i].z); a[14] = bflo(r1[i].w); a[15] = bfhi(r1[i].w);
                float amx = 0.f;
#pragma unroll
                for (int k = 0; k < 16; ++k) amx = fmaxf(amx, fabsf(a[k]));
                amx = wave_max(amx);
                const float rs2 = rsqrtf(wave_sum(sq[i]) * (1.f / 1024.f) + RMS_EPS);
                const float asc = amx > 0.f ? 127.f / amx : 1.f;
                v4u qv;
#define QP4(k) ((unsigned)((int)rintf(a[4 * (k)] * asc) + 128) | ((unsigned)((int)rintf(a[4 * (k) + 1] * asc) + 128) << 8) | ((unsigned)((int)rintf(a[4 * (k) + 2] * asc) + 128) << 16) | ((unsigned)((int)rintf(a[4 * (k) + 3] * asc) + 128) << 24))
                qv.x = QP4(0); qv.y = QP4(1); qv.z = QP4(2); qv.w = QP4(3);
#undef QP4
                { v4u pq;
                  pq.x = (unsigned)__shfl_xor((int)qv.x, 32); pq.y = (unsigned)__shfl_xor((int)qv.y, 32); pq.z = (unsigned)__shfl_xor((int)qv.z, 32); pq.w = (unsigned)__shfl_xor((int)qv.w, 32);
                  const bool lo_ = lane < 32; const v4u m_ = lo_ ? qv : pq, p_ = lo_ ? pq : qv;
                  v4u ov;
#define NP(m, p) (lo_ ? (((m) & 0x0f0f0f0fu) | (((p) & 0x0f0f0f0fu) << 4)) : ((((m) >> 4) & 0x0f0f0f0fu) | ((p) & 0xf0f0f0f0u)))
                  ov.x = NP(m_.x, p_.x); ov.y = NP(m_.y, p_.y); ov.z = NP(m_.z, p_.z); ov.w = NP(m_.w, p_.w);
#undef NP
                  *(GAS v4u*)(A8I + (size_t)(tb4 + i) * 1024 + 16 * lane) = ov; }
                float sa = 0.f;
#pragma unroll
                for (int k = 0; k < 16; ++k) sa += rintf(a[k] * asc);
                sa = wave_sum(sa);
                if (lane == 0) { ASC[tb4 + i] = (amx > 0.f ? amx * (1.f / 127.f) : 1.f) * rs2; ASC[T + tb4 + i] = sa + 131072.f; }
            }
        }
        LAS unsigned char* idl = L + RING_OFF + tid * 32;
        for (int task = gt; task < T * 8; task += NGT) {
            const int t = task >> 3, h = task & 7;
            const _Float16* row = SC + (size_t)t * 2048 + h * 256;
            float LA[16], LB[16];
#pragma unroll 1
            for (int p = 0; p < 2; ++p) {
                const _Float16* rp = row + p * 128;
                float Tk[16];
                h8 n0 = *(const h8*)(rp + 16), n1 = *(const h8*)(rp + 24);
                { const h8 v0 = *(const h8*)rp, v1 = *(const h8*)(rp + 8); RKEYS(Tk, v0, v1, 0); RSORT16(Tk); }
#pragma unroll 1
                for (int c = 1; c < 8; ++c) {
                    const h8 v0 = n0, v1 = n1;
                    { const int cn = c < 7 ? c + 1 : c; n0 = *(const h8*)(rp + cn * 16); n1 = *(const h8*)(rp + cn * 16 + 8); }
                    float K[16]; RKEYS(K, v0, v1, c * 16); RSORT16(K);
#pragma unroll
                    for (int i = 0; i < 16; ++i) Tk[i] = fmax_asm(Tk[i], K[15 - i]);
                    RMERGE16(Tk);
                }
#pragma unroll
                for (int k = 0; k < 16; ++k) { if (p == 0) LA[k] = Tk[k]; else LB[k] = Tk[k]; }
            }
#pragma unroll
            for (int k = 0; k < 16; k += 4) {
                ((LAS unsigned*)idl)[k >> 2] = (__float_as_uint(LA[k]) & 127u) | ((__float_as_uint(LA[k + 1]) & 127u) << 8) | ((__float_as_uint(LA[k + 2]) & 127u) << 16) | ((__float_as_uint(LA[k + 3]) & 127u) << 24);
                ((LAS unsigned*)idl)[4 + (k >> 2)] = (__float_as_uint(LB[k]) & 127u) | ((__float_as_uint(LB[k + 1]) & 127u) << 8) | ((__float_as_uint(LB[k + 2]) & 127u) << 16) | ((__float_as_uint(LB[k + 3]) & 127u) << 24);
            }
#define CKEY(a, b) __uint_as_float((__float_as_uint(LA[a] + LB[b]) & ~255u) | (unsigned)(255 - (16 * (a) + (b))))
            float Ck[16];
#pragma unroll
            for (int a = 0; a < 16; ++a) Ck[a] = CKEY(a, 0);
#define CRUN(b, n) do { _Pragma("unroll") for (int j = 0; j < (n); ++j) Ck[15 - j] = fmax_asm(Ck[15 - j], CKEY(j, b)); RMERGE16(Ck); } while (0)
            CRUN(1, 8); CRUN(2, 5); CRUN(3, 4); CRUN(4, 3); CRUN(5, 2); CRUN(6, 2); CRUN(7, 2);
#pragma unroll
            for (int j = 0; j < 8; ++j) Ck[15 - j] = fmax_asm(Ck[15 - j], CKEY(0, 8 + j));
            RMERGE16(Ck);
#undef CRUN
#undef CKEY
            LDS_WAIT();
            float ex[16]; float sum = 0.f;
#pragma unroll
            for (int k = 0; k < 16; ++k) { ex[k] = __expf(Ck[k] - Ck[0]); sum += ex[k]; }
            const float rs = 1.f / sum;
            int* eo = EIDX + (size_t)t * 128 + h * 16;
#pragma unroll
            for (int k = 0; k < 16; k += 4) {
                int ev[4];
#pragma unroll
                for (int j = 0; j < 4; ++j) { const unsigned id = 255u - (__float_as_uint(Ck[k + j]) & 255u); ev[j] = (int)idl[id >> 4] * 128 + (int)idl[16 + (id & 15u)]; }
                *(GAS v4u*)(eo + k) = (v4u){(pk2(0.f, ex[k] * rs) & 0xffff0000u) | (unsigned)ev[0], (pk2(0.f, ex[k + 1] * rs) & 0xffff0000u) | (unsigned)ev[1],
                                             (pk2(0.f, ex[k + 2] * rs) & 0xffff0000u) | (unsigned)ev[2], (pk2(0.f, ex[k + 3] * rs) & 0xffff0000u) | (unsigned)ev[3]};
            }
            LDS_WAIT();
        }
#undef RCE
#undef RSORT16
#undef RMERGE16
#undef RKEYS
    }
    xcd_barrier(bar); TSTAMP();

    asm volatile("; ===== PHASE 13 =====");
    if (PH(13)) for (int rep = 0; rep < NREP(13); ++rep) {
        PH_LANES; const bool dummy = rep < NREP(13) - 1; (void)dummy;
        volatile LAS unsigned* qslot = (volatile LAS unsigned*)(L + LDSCTL_OFF + 64);
        LAS unsigned char* tile = L + RING_OFF + wave * 16384;
        LAS float* rsl = (LAS float*)(L + UL_OFF + wave * UL_WAVE);
        LAS v2u* lst = (LAS v2u*)(L + UL_OFF + wave * UL_WAVE + 128);
        const int xs = (int)(xb_xcc_id() & 7u);
        __syncthreads();
        if (tid == 0) *qslot = __hip_atomic_fetch_add((unsigned*)(ctl + CW_Q + 64 * (rep * 8 + xs)), 1u, __ATOMIC_RELAXED, __HIP_MEMORY_SCOPE_AGENT);
        __syncthreads();
        const int rank = __builtin_amdgcn_readfirstlane((int)*qslot);
        int cnt[8];
#pragma unroll
        for (int j = 0; j < 8; ++j) cnt[j] = __builtin_amdgcn_readfirstlane((int)(xb_ld(bar.bar + XB_XCNT(j)) + xb_ld(bar.bar + XB_XCNT(j + 8))));
#pragma unroll 1
        for (int x = 0; x < 8; ++x) {
            int cn = 0;
#pragma unroll
            for (int j = 0; j < 8; ++j) cn = (j == x) ? cnt[j] : cn;
            int j0, jstep;
            if (x == xs) { j0 = rank * 8 + wave; jstep = cn * 8; } else if (cn == 0) { j0 = bx * 8 + wave; jstep = G * 8; } else continue;
#pragma unroll 1
            for (int job = j0; job < T / 16; job += jstep) {
                const int t0 = job * 16;
#pragma unroll 1
                for (int r0 = 0;; r0 += UL_CAP) {
                    int ln = lane; asm volatile("" : "+v"(ln));
#pragma unroll
                    for (int tl = 0; tl < 16; ++tl)
                        __builtin_amdgcn_global_load_lds((const unsigned*)(A8I + (size_t)(t0 + tl) * 1024 + ln * 16), (LAS unsigned*)(tile + tl * 1024), 16, 0, 0);
                    if (ln < 32) rsl[ln] = ASC[(ln & 16) * (T / 16) + t0 + (ln & 15)];
                    int total = 0;
#pragma unroll
                    for (int hb = 0; hb < 2; ++hb) {
                        unsigned pa[8], pb[8];
#pragma unroll
                        for (int tl = 0; tl < 8; ++tl) { pa[tl] = (unsigned)EIDX[(size_t)(t0 + hb * 8 + tl) * 128 + ln]; pb[tl] = (unsigned)EIDX[(size_t)(t0 + hb * 8 + tl) * 128 + 64 + ln]; }
#pragma unroll
                        for (int tl = 0; tl < 8; ++tl) {
                            const bool h0 = (int)((pa[tl] & 0xffffu) >> 11) == x, h1 = (int)((pb[tl] & 0xffffu) >> 11) == x;
                            const unsigned long long m0 = __ballot(h0), m1 = __ballot(h1);
                            const int k0 = total - r0 + (int)__builtin_amdgcn_mbcnt_hi((unsigned)(m0 >> 32), __builtin_amdgcn_mbcnt_lo((unsigned)m0, 0u));
                            const int k1 = total - r0 + __popcll(m0) + (int)__builtin_amdgcn_mbcnt_hi((unsigned)(m1 >> 32), __builtin_amdgcn_mbcnt_lo((unsigned)m1, 0u));
                            if (h0 && k0 >= 0 && k0 < UL_CAP) lst[k0] = (v2u){pa[tl], (unsigned)(((hb * 8 + tl) << 7) | ln)};
                            if (h1 && k1 >= 0 && k1 < UL_CAP) lst[k1] = (v2u){pb[tl], (unsigned)(((hb * 8 + tl) << 7) | 64 | ln)};
                            total += __popcll(m0) + __popcll(m1);
                        }
                    }
                    asm volatile("s_waitcnt vmcnt(0)" ::: "memory");
                    const int count = (total - r0) < UL_CAP ? (total - r0) : UL_CAP;
                    asm volatile("s_waitcnt lgkmcnt(0)" ::: "memory");
#define JLOAD(Q, EN, B16) do { const int myi_ = (B16) + (lane >> 2); EN = lst[myi_ < count ? myi_ : count - 1];         \
                        const unsigned char* rp_ = U8 + (size_t)(EN.x & 0xffffu) * 512 + (lane & 3) * 16; \
                        EN##s = *(const GAS f32x4*)(SU + 4 * (EN.x & 0xffffu));                                      \
                        _Pragma("unroll") for (int j = 0; j < 8; ++j) Q[j] = *(const GAS v4u*)(rp_ + j * 64); } while (0)
#define UD8(w, aa, acc) __builtin_amdgcn_udot8((unsigned)(w), (unsigned)(aa), (unsigned)(acc), false)
#define JCOMP(Q, EN, B16) do { const LAS unsigned char* ap_ = tile + (EN.y >> 7) * 1024 + (lane & 3) * 16; unsigned d0 = 0, d1 = 0, d2 = 0, d3 = 0, g0 = 0, g1 = 0, g2 = 0, g3 = 0; \
                        _Pragma("unroll") for (int j = 0; j < 8; ++j) { const v4u ql_ = *(const LAS v4u*)(ap_ + j * 64), qh_ = *(const LAS v4u*)(ap_ + 512 + j * 64);        \
                            d0 = UD8(Q[j].x, ql_.x, d0); d1 = UD8(Q[j].y, ql_.y, d1); d2 = UD8(Q[j].z, ql_.z, d2); d3 = UD8(Q[j].w, ql_.w, d3); \
                            g0 = UD8(Q[j].x, qh_.x, g0); g1 = UD8(Q[j].y, qh_.y, g1); g2 = UD8(Q[j].z, qh_.z, g2); g3 = UD8(Q[j].w, qh_.w, g3); } \
                        int doti = (int)(((d0 + d1) + (d2 + d3)) + ((((g0 + g1) + (g2 + g3))) << 4));                       \
                        doti += __builtin_amdgcn_ds_swizzle(doti, (1 << 10) | 0x1f); doti += __builtin_amdgcn_ds_swizzle(doti, (2 << 10) | 0x1f);        \
                        if ((lane & 3) == 0 && (B16) + (lane >> 2) < count) { \
                            const int e = (int)(EN.x & 0xffffu), slot = (int)(EN.y & 127u); const int tl_ = (int)(EN.y >> 7); const int t = t0 + tl_; \
                            const float dq = ((float)doti - 128.f * EN##s.z) - (8.f * rsl[16 + tl_] - 1048576.f);               \
                            const float act = dq * (EN##s.x * rsl[tl_]); const float u3 = 0.7978845608028654f * (act + 0.044715f * act * act * act); \
                            const float wv = act * __builtin_amdgcn_rcpf(1.f + __expf(-2.f * u3)) * (__uint_as_float(EN.x & 0xffff0000u) * EN##s.y);             \
                            PW[((size_t)((t >> 6) * 8 + (slot >> 4)) * 4 + ((slot >> 2) & 3)) * 256 + (t & 63) * 4 + (slot & 3)] = ((unsigned)__builtin_bit_cast(unsigned short, (_Float16)wv) << 16) | (unsigned)e;     } } while (0)
                    if (count > 0) {
                        v4u qa[8], qb[8], qc[8], qd[8]; v2u ena, enb, enc, end_; f32x4 enas, enbs, encs, end_s;
                        JLOAD(qa, ena, 0);
                        if (16 < count) JLOAD(qb, enb, 16);
                        if (32 < count) JLOAD(qc, enc, 32);
                        int b16 = 0;
#pragma unroll 1
                        for (; b16 + 96 < count; b16 += 64) {
                            JLOAD(qd, end_, b16 + 48); JCOMP(qa, ena, b16);
                            JLOAD(qa, ena, b16 + 64); JCOMP(qb, enb, b16 + 16);
                            JLOAD(qb, enb, b16 + 80); JCOMP(qc, enc, b16 + 32);
                            JLOAD(qc, enc, b16 + 96); JCOMP(qd, end_, b16 + 48);
                        }
#pragma unroll 1
                        for (; b16 < count; b16 += 64) {
                            if (b16 + 48 < count) JLOAD(qd, end_, b16 + 48);
                            JCOMP(qa, ena, b16);
                            if (b16 + 16 < count) { if (b16 + 64 < count) JLOAD(qa, ena, b16 + 64); JCOMP(qb, enb, b16 + 16); }
                            if (b16 + 32 < count) { if (b16 + 80 < count) JLOAD(qb, enb, b16 + 80); JCOMP(qc, enc, b16 + 32); }
                            if (b16 + 48 < count) { if (b16 + 96 < count) JLOAD(qc, enc, b16 + 96); JCOMP(qd, end_, b16 + 48); }
                        }
                    }
#undef UD8
#undef JLOAD
#undef JCOMP
                    asm volatile("s_waitcnt lgkmcnt(0)" ::: "memory");
                    if (r0 + UL_CAP >= total) break;
                }
            }
        }
        __syncthreads();
    }
    xcd_barrier(bar); TSTAMP();

    asm volatile("; ===== PHASE 14 =====");
    if (PH(14)) for (int rep = 0; rep < NREP(14); ++rep) {
        PH_LANES; const bool dummy = rep < NREP(14) - 1; (void)dummy;
        for (int item = vcu; item < 256; item += G) {
            const int sl = item & 127, half = item >> 7;
            __syncthreads();
#pragma unroll
            for (int i = 0; i < 16; ++i) *(LAS v4u*)(L + RING_OFF + (i * 512 + tid) * 16) = *(const GAS v4u*)(V8T + (size_t)sl * 131072 + (size_t)(i * 512 + tid) * 16);
            __syncthreads();
            const GAS v4u* pwb = (const GAS v4u*)(PW + (size_t)(half * 256 + wave) * 8192) + lane;
            v4u buf[4][4];
#pragma unroll
            for (int c = 0; c < 4; ++c)
#pragma unroll
                for (int k = 0; k < 4; ++k) buf[c][k] = pwb[c * 256 + k * 64];
#pragma unroll 1
            for (int itk = 0; itk < 32; ++itk) {
                const int g64 = half * 256 + itk * 8 + wave;
                const int t = g64 * 64 + lane;
                unsigned accu[4] = {0u, 0u, 0u, 0u};
#pragma unroll
                for (int c = 0; c < 8; ++c) {
                    v4u cur[4];
#pragma unroll
                    for (int k = 0; k < 4; ++k) cur[k] = buf[c & 3][k];
                    { const int sn = itk * 8 + c + 4; const int gn = (sn >> 3) > 31 ? 31 : (sn >> 3), cc = sn & 7; const GAS v4u* src = pwb + (size_t)gn * 8 * 2048 + cc * 256;
#pragma unroll
                      for (int k = 0; k < 4; ++k) buf[c & 3][k] = src[k * 64]; }
                    v2u tb[16];
#pragma unroll
                    for (int k = 0; k < 4; ++k)
#pragma unroll
                        for (int i = 0; i < 4; ++i) { unsigned e_ = cur[k][i] & 0xffffu; asm("" : "+v"(e_));
                            tb[k * 4 + i] = *(const LAS v2u*)(L + RING_OFF + (e_ << 3)); }
#pragma unroll
                    for (int k = 0; k < 4; ++k)
#pragma unroll
                        for (int i = 0; i < 4; ++i) { const unsigned p = cur[k][i]; const v2u q = tb[k * 4 + i];
#define VFMA(ACC, T) asm("v_pk_fma_f16 %0, %1, %2, %0 op_sel:[0,1,0] op_sel_hi:[1,1,1]" : "+v"(ACC) : "v"(T), "v"(p))
                            const unsigned t0_ = __builtin_amdgcn_perm(0u, q.x, 0x010c000cu), t1_ = __builtin_amdgcn_perm(0u, q.x, 0x030c020cu), t2_ = __builtin_amdgcn_perm(0u, q.y, 0x010c000cu), t3_ = __builtin_amdgcn_perm(0u, q.y, 0x030c020cu);
                            VFMA(accu[0], t0_); VFMA(accu[1], t1_); VFMA(accu[2], t2_); VFMA(accu[3], t3_);
#undef VFMA
                        }
                }
                GAS v4u* hr = (GAS v4u*)(A + (size_t)t * D + sl * 8);
                const v4u hq = *hr; const float mulv = dummy ? 0.f : 1.f;
                h2v acc[4];
#pragma unroll
                for (int i = 0; i < 4; ++i) { const unsigned au_ = accu[i]; acc[i] = __builtin_bit_cast(h2v, au_); }
                v4u ho; ho.x = pk2(bflo(hq.x) + (float)acc[0].x * mulv, bfhi(hq.x) + (float)acc[0].y * mulv); ho.y = pk2(bflo(hq.y) + (float)acc[1].x * mulv, bfhi(hq.y) + (float)acc[1].y * mulv);
                ho.z = pk2(bflo(hq.z) + (float)acc[2].x * mulv, bfhi(hq.z) + (float)acc[2].y * mulv); ho.w = pk2(bflo(hq.w) + (float)acc[3].x * mulv, bfhi(hq.w) + (float)acc[3].y * mulv);
                *hr = ho;
            }
        }
    }
    xcd_barrier(bar); TSTAMP();

#ifdef EXTRA_BARRIERS
    for (int eb = 0; eb < EXTRA_BARRIERS; ++eb) xcd_barrier(bar);
#endif
    asm volatile("; ===== PHASE 15 =====");
    if (PH(15)) for (int rep = 0; rep < NREP(15); ++rep) {
        PH_LANES; const bool dummy = rep < NREP(15) - 1; (void)dummy;
        for (int t = gw; t < T; t += NGW) {
            const GAS v4u* hr = (const GAS v4u*)(A + (size_t)t * D + 16 * lane); const v4u q0 = hr[0], q1 = hr[1];
            const GAS f32x4* gr = (const GAS f32x4*)(g_final + 16 * lane); GAS f32x4* orow = (GAS f32x4*)(out + (size_t)t * D + 16 * lane);
            f32x4 o[4] = {(f32x4){bflo(q0.x), bfhi(q0.x), bflo(q0.y), bfhi(q0.y)}, (f32x4){bflo(q0.z), bfhi(q0.z), bflo(q0.w), bfhi(q0.w)},
                          (f32x4){bflo(q1.x), bfhi(q1.x), bflo(q1.y), bfhi(q1.y)}, (f32x4){bflo(q1.z), bfhi(q1.z), bflo(q1.w), bfhi(q1.w)}};
            float ss = 0.f;
#pragma unroll
            for (int j = 0; j < 4; ++j) ss += (o[j].x * o[j].x + o[j].y * o[j].y) + (o[j].z * o[j].z + o[j].w * o[j].w);
            const float r = rsqrtf(wave_sum(ss) * (1.f / 1024.f) + RMS_EPS);
#pragma unroll
            for (int j = 0; j < 4; ++j) orow[j] = o[j] * r * gr[j];
        }
    }
}

extern "C" void kernel_launch(void* const* d_in, const int* in_sizes, int n_in, void* d_out, int out_size, void* d_ws, size_t ws_size, hipStream_t stream) {
    static int grid = 0;
    if (grid == 0) {
        if (n_in != 19 || out_size != T * D || ws_size < WS_END) { fprintf(stderr, "kernel_launch: unexpected problem (n_in %d, out %d, ws %zu < %zu); nothing launched\n", n_in, out_size, ws_size, (size_t)WS_END); grid = -1; return; }
        int dev = 0, cus = 0, per_cu = 0;
        if (hipGetDevice(&dev) != hipSuccess || hipDeviceGetAttribute(&cus, hipDeviceAttributeMultiprocessorCount, dev) != hipSuccess) { grid = -1; return; }
        if (hipFuncSetAttribute((const void*)mk_fwd, hipFuncAttributeMaxDynamicSharedMemorySize, LDS_BYTES) != hipSuccess) { fprintf(stderr, "kernel_launch: hipFuncSetAttribute failed\n"); grid = -1; return; }
        if (hipOccupancyMaxActiveBlocksPerMultiprocessor(&per_cu, (const void*)mk_fwd, NWAVES * 64, LDS_BYTES) != hipSuccess || per_cu < 1) { fprintf(stderr, "kernel_launch: occupancy query says %d blocks per CU\n", per_cu); }
        (void)hipGetLastError();
        grid = cus;
    }
    if (grid < 0) return;
    if (hipMemsetAsync((char*)d_ws + WS_CTL, 0, CTL_ZERO_BYTES, stream) != hipSuccess) return;
    Args a{};
    for (int i = 0; i < 19; ++i) a.in[i] = (const float*)d_in[i];
    a.out = (float*)d_out; a.ws = (unsigned char*)d_ws;
    hipLaunchKernelGGL(mk_fwd, dim3(grid), dim3(NWAVES * 64), LDS_BYTES, stream, a);
}
```

```cpp
#include <hip/hip_runtime.h>
#include <hip/hip_bf16.h>
#include <cstdio>
#include <cstdint>
#include <cmath>

#ifndef DIAG
#define DIAG 0
#endif


template <int O> __device__ __forceinline__ float shx(float v) { static_assert(O > 0 && O < 32, "shx"); return __uint_as_float((unsigned)__builtin_amdgcn_ds_swizzle((int)__float_as_uint(v), (O << 10) | 0x1f)); }
__device__ __forceinline__ float sum32(float v) { auto r = __builtin_amdgcn_permlane32_swap(__float_as_uint(v), __float_as_uint(v), false, false); return __uint_as_float(r[0]) + __uint_as_float(r[1]); }
__device__ __forceinline__ float max32(float v) { auto r = __builtin_amdgcn_permlane32_swap(__float_as_uint(v), __float_as_uint(v), false, false); return fmaxf(__uint_as_float(r[0]), __uint_as_float(r[1])); }
__device__ __forceinline__ float wave_max(float v) { v = fmaxf(v, shx<1>(v)); v = fmaxf(v, shx<2>(v)); v = fmaxf(v, shx<4>(v)); v = fmaxf(v, shx<8>(v)); v = fmaxf(v, shx<16>(v)); return max32(v); }
__device__ __forceinline__ float wave_sum(float v) { v += shx<1>(v); v += shx<2>(v); v += shx<4>(v); v += shx<8>(v); v += shx<16>(v); return sum32(v); }

namespace pg8 {
#define PG8_LAS __attribute__((address_space(3)))
typedef unsigned short bf16_t;
typedef short bf16x8 __attribute__((ext_vector_type(8)));
typedef float f32x4 __attribute__((ext_vector_type(4)));
typedef float f32x2 __attribute__((ext_vector_type(2)));
typedef unsigned u32x4 __attribute__((ext_vector_type(4)));
typedef unsigned u32x2 __attribute__((ext_vector_type(2)));
constexpr int BM = 256, BK = 64, HALF = 128, HTB = HALF * BK * 2  , STAGE_BYTES = 8 * HTB, NXCD = 8, WGM = 4;

__host__ __device__ __forceinline__ int lds_byte(int r, int c) { const int st = (r >> 4) * 2 + (c >> 5), rr = r & 15, cc = c & 31, ob = rr * 64 + cc * 2; return st * 1024 + (ob ^ (((ob >> 9) & 1) << 5)); }
__host__ __device__ __forceinline__ void stage_rc(int b, int& R, int& C) { const int st = b / 1024, sb = b % 1024, swz = sb ^ (((sb >> 9) & 1) << 5); R = (st >> 1) * 16 + swz / 64; C = (st & 1) * 32 + (swz % 64) / 2; }
__host__ __device__ __forceinline__ int perm32(int rho) { const int n = rho >> 4, i = rho & 15; return 8 * (i >> 2) + 4 * n + (i & 3); }

struct Unit { int pm, pn; const char* a; const char* b; };
struct Gemm { int lda, ldb, K; };

struct StaticOrder {
    int nM, nN, nwg, G, c; const char* A; const char* Bt; size_t astep, bstep;
    __device__ void init(const void* A_, int lda, const void* Bt_, int ldb, int M, int N, int G_, int c_) { nM = M / BM; nN = N / BM; nwg = nM * nN; G = G_; c = c_; A = (const char*)A_; Bt = (const char*)Bt_; astep = (size_t)BM * lda * 2; bstep = (size_t)BM * ldb * 2; }
    __device__ bool next(int i, Unit& u) const {
        const long L = (long)i * G + c; if (L >= nwg) return false;
        int wgid = (int)L; { const int q = nwg / NXCD, r = nwg % NXCD, xcd = wgid % NXCD, off = wgid / NXCD; wgid = (xcd < r ? xcd * (q + 1) : r * (q + 1) + (xcd - r) * q) + off; }
        const int nig = WGM * nN, gid = wgid / nig, fm = gid * WGM, gsz = (nM - fm) < WGM ? (nM - fm) : WGM;
        u.pm = fm + ((wgid % nig) % gsz); u.pn = (wgid % nig) / gsz; u.a = A + (size_t)u.pm * astep; u.b = Bt + (size_t)u.pn * bstep; return true;
    }
};

__device__ __forceinline__ unsigned cvt_pk_bf16(float lo, float hi) { typedef __bf16 bf2 __attribute__((ext_vector_type(2))); f32x2 v = {lo, hi}; bf2 b = __builtin_convertvector(v, bf2); return __builtin_bit_cast(unsigned, b); }
__device__ __forceinline__ float bf_lo(unsigned u) { return __uint_as_float(u << 16); }
__device__ __forceinline__ float bf_hi(unsigned u) { return __uint_as_float(u & 0xffff0000u); }

template <class Epi, class Sched, bool ALIGN_EPI>
__device__ __forceinline__ void gemm_phase(PG8_LAS unsigned char* lds, const Gemm g, const Sched& S, const Epi& E) {
    int tid = threadIdx.x; asm volatile("" : "+v"(tid));
    const int wid = __builtin_amdgcn_readfirstlane(tid >> 6), lane = tid & 63, wr = wid >> 2, wc = wid & 3, fr = lane & 15, fq = lane >> 4;
    const int K = g.K, nt = K / BK;
    unsigned voffA[2], voffB[2];
#pragma unroll
    for (int i = 0; i < 2; ++i) { int R, C; stage_rc(tid * 16 + i * 8192, R, C); const int Rb = Epi::PERM ? ((R & ~31) + perm32(R & 31)) : R;
        voffA[i] = (unsigned)(R * g.lda + C) * 2u; voffB[i] = (unsigned)(Rb * g.ldb + C) * 2u; }
    const size_t kstep = (size_t)(BK * 2);
    const size_t hstepA = (size_t)HALF * g.lda * 2, hstepB = (size_t)HALF * g.ldb * 2;
    const unsigned ldsw = (unsigned)wid * 1024u;
    const int aoff = lds_byte(wr * 64 + fr, fq * 8), boff = lds_byte(wc * 32 + fr, fq * 8);
#define PG8_SA(b, h) (((b) * 2 + (h)) * HTB)
#define PG8_SB(b, h) ((4 + (b) * 2 + (h)) * HTB)
#define PG8_STAGE(bufoff, gbase, voff) do { _Pragma("unroll") for (int _i = 0; _i < 2; ++_i) \
        __builtin_amdgcn_global_load_lds((const unsigned*)((const char*)(gbase) + (voff)[_i]), (PG8_LAS unsigned*)(lds + (bufoff) + ldsw + _i * 8192), 16, 0, 0); } while (0)
#define PG8_LDA(dst, b, h) do { _Pragma("unroll") for (int m = 0; m < 4; ++m) _Pragma("unroll") for (int k = 0; k < 2; ++k) dst[m][k] = *(const PG8_LAS bf16x8*)(lds + PG8_SA(b, h) + aoff + m * 2048 + k * 1024); } while (0)
#define PG8_LDB(dst, b, h) do { _Pragma("unroll") for (int n = 0; n < 2; ++n) _Pragma("unroll") for (int k = 0; k < 2; ++k) dst[n][k] = *(const PG8_LAS bf16x8*)(lds + PG8_SB(b, h) + boff + n * 2048 + k * 1024); } while (0)
#define PG8_MMA(ai, bj, At, Bt) do { __builtin_amdgcn_s_setprio(1); _Pragma("unroll") for (int m = 0; m < 4; ++m) _Pragma("unroll") for (int n = 0; n < 2; ++n) _Pragma("unroll") for (int k = 0; k < 2; ++k) \
        acc[ai][bj][m][n] = __builtin_amdgcn_mfma_f32_16x16x32_bf16(Bt[n][k], At[m][k], acc[ai][bj][m][n], 0, 0, 0); __builtin_amdgcn_s_setprio(0); } while (0)
#define PG8_WAIT_V(n) asm volatile("s_waitcnt vmcnt(" #n ")" ::: "memory")
#define PG8_WAIT_L(n) asm volatile("s_waitcnt lgkmcnt(" #n ")" ::: "memory")
#define PG8_BAR __builtin_amdgcn_s_barrier()
#define PG8_SCHED __builtin_amdgcn_sched_barrier(0)
    Unit cur, nxt; int ui = 0;
    if (!S.next(0, cur)) return;
    f32x4 acc[2][2][4][2];
#pragma unroll
    for (int a = 0; a < 2; ++a)
#pragma unroll
        for (int b = 0; b < 2; ++b)
#pragma unroll
            for (int m = 0; m < 4; ++m)
#pragma unroll
                for (int n = 0; n < 2; ++n) acc[a][b][m][n] = (f32x4){0.f, 0.f, 0.f, 0.f};
    bf16x8 At[4][2], B0[2][2], B1[2][2];
    const char* cA = cur.a; const char* cB = cur.b;
    PG8_STAGE(PG8_SB(0, 0), cB, voffB); PG8_STAGE(PG8_SB(0, 1), cB + hstepB, voffB); PG8_STAGE(PG8_SA(0, 0), cA, voffA); PG8_STAGE(PG8_SA(0, 1), cA + hstepA, voffA);
    if (wr == 1) PG8_BAR;
    PG8_WAIT_V(2); PG8_BAR;
    PG8_STAGE(PG8_SB(1, 0), cB + kstep, voffB); PG8_STAGE(PG8_SA(1, 0), cA + kstep, voffA); PG8_STAGE(PG8_SB(1, 1), cB + hstepB + kstep, voffB);
    PG8_WAIT_V(6); PG8_BAR;
    for (;;) {
        const bool has_next = S.next(ui + 1, nxt);
        const char* nA = has_next ? nxt.a : cA; const char* nB = has_next ? nxt.b : cB;
        for (int t = 0; t < nt; t += 2) {
            const bool last = (t == nt - 2);
            const char* a1 = cA + (size_t)(t + 1) * kstep;
            const char* a2 = last ? nA : cA + (size_t)(t + 2) * kstep; const char* b2 = last ? nB : cB + (size_t)(t + 2) * kstep;
            const char* a3 = a2 + kstep; const char* b3 = b2 + kstep;
            PG8_LDB(B0, 0, 0); PG8_LDB(B1, 0, 1); PG8_SCHED; PG8_LDA(At, 0, 0); PG8_STAGE(PG8_SA(1, 1), a1 + hstepA, voffA);
            PG8_WAIT_V(8); PG8_WAIT_L(0); PG8_BAR; PG8_MMA(0, 0, At, B0); PG8_MMA(0, 1, At, B1); PG8_BAR; PG8_SCHED;
            PG8_LDA(At, 0, 1); PG8_STAGE(PG8_SB(0, 0), b2, voffB); PG8_STAGE(PG8_SB(0, 1), b2 + hstepB, voffB); PG8_STAGE(PG8_SA(0, 0), a2, voffA);
            PG8_WAIT_V(8); PG8_WAIT_L(0); PG8_BAR; PG8_MMA(1, 0, At, B0); PG8_MMA(1, 1, At, B1); PG8_BAR; PG8_SCHED;
            PG8_LDB(B0, 1, 0); PG8_LDB(B1, 1, 1); PG8_SCHED; PG8_LDA(At, 1, 0); PG8_STAGE(PG8_SA(0, 1), a2 + hstepA, voffA);
            PG8_WAIT_V(8); PG8_WAIT_L(0); PG8_BAR; PG8_MMA(0, 0, At, B0); PG8_MMA(0, 1, At, B1); PG8_BAR; PG8_SCHED;
            PG8_LDA(At, 1, 1); PG8_STAGE(PG8_SB(1, 0), b3, voffB); PG8_STAGE(PG8_SB(1, 1), b3 + hstepB, voffB); PG8_STAGE(PG8_SA(1, 0), a3, voffA);
            PG8_WAIT_V(8); PG8_WAIT_L(0); PG8_BAR; PG8_MMA(1, 0, At, B0); PG8_MMA(1, 1, At, B1); PG8_BAR; PG8_SCHED;
        }
        if constexpr (ALIGN_EPI) { if (wr == 0) PG8_BAR; }
        if constexpr (!Epi::AFTER_DRAIN) { E(acc, cur, wr, wc, fr, fq); }
        if (!has_next) break;
#pragma unroll
        for (int a = 0; a < 2; ++a)
#pragma unroll
            for (int b = 0; b < 2; ++b)
#pragma unroll
                for (int m = 0; m < 4; ++m)
#pragma unroll
                    for (int n = 0; n < 2; ++n) acc[a][b][m][n] = (f32x4){0.f, 0.f, 0.f, 0.f};
        cur = nxt; cA = nA; cB = nB; ++ui;
        if constexpr (ALIGN_EPI) { if (wr == 1) PG8_BAR; }
    }
    PG8_WAIT_V(0);
    if constexpr (!ALIGN_EPI) { if (wr == 0) PG8_BAR; }
    PG8_BAR;
    if constexpr (Epi::AFTER_DRAIN) { E.fused(acc, cur, wr, wc, fr, fq, lds, wid, lane); }
#undef PG8_SA
#undef PG8_SB
#undef PG8_STAGE
#undef PG8_LDA
#undef PG8_LDB
#undef PG8_MMA
#undef PG8_WAIT_V
#undef PG8_WAIT_L
#undef PG8_BAR
#undef PG8_SCHED
}

typedef f32x4 AccT[2][2][4][2];

struct EpiBf16 {
    static constexpr bool PERM = true, AFTER_DRAIN = false;
    bf16_t* O; int ldc;
    __device__ __forceinline__ void operator()(const AccT& acc, const Unit& u, int wr, int wc, int fr, int fq) const {
        { int t_ = threadIdx.x; asm volatile("" : "+v"(t_)); fr = t_ & 15; fq = (t_ >> 4) & 3; }
        const int row0 = u.pm * BM + wr * 64 + fr, col0 = u.pn * BM + wc * 32 + 8 * fq;
#pragma unroll
        for (int ai = 0; ai < 2; ++ai)
#pragma unroll
            for (int m = 0; m < 4; ++m) { bf16_t* rowp = O + (size_t)(row0 + ai * HALF + m * 16) * ldc + col0;
#pragma unroll
                for (int bj = 0; bj < 2; ++bj) { const f32x4 v0 = acc[ai][bj][m][0], v1 = acc[ai][bj][m][1];
                    u32x4 w; w.x = cvt_pk_bf16(v0[0], v0[1]); w.y = cvt_pk_bf16(v0[2], v0[3]); w.z = cvt_pk_bf16(v1[0], v1[1]); w.w = cvt_pk_bf16(v1[2], v1[3]);
                    *(u32x4*)(rowp + bj * HALF) = w; } }
    }
};
struct EpiF16 {
    static constexpr bool PERM = true, AFTER_DRAIN = false;
    _Float16* O; int ldc;
    __device__ __forceinline__ void operator()(const AccT& acc, const Unit& u, int wr, int wc, int fr, int fq) const {
        { int t_ = threadIdx.x; asm volatile("" : "+v"(t_)); fr = t_ & 15; fq = (t_ >> 4) & 3; }
        typedef _Float16 h8 __attribute__((ext_vector_type(8)));
        const int row0 = u.pm * BM + wr * 64 + fr, col0 = u.pn * BM + wc * 32 + 8 * fq;
#pragma unroll
        for (int ai = 0; ai < 2; ++ai)
#pragma unroll
            for (int m = 0; m < 4; ++m) { _Float16* rowp = O + (size_t)(row0 + ai * HALF + m * 16) * ldc + col0;
#pragma unroll
                for (int bj = 0; bj < 2; ++bj) { const f32x4 v0 = acc[ai][bj][m][0], v1 = acc[ai][bj][m][1];
                    h8 w = {(_Float16)v0[0], (_Float16)v0[1], (_Float16)v0[2], (_Float16)v0[3], (_Float16)v1[0], (_Float16)v1[1], (_Float16)v1[2], (_Float16)v1[3]};
                    *(h8*)(rowp + bj * HALF) = w; } }
    }
};
struct EpiGateMul {
    static constexpr bool PERM = true, AFTER_DRAIN = false;
    const bf16_t* G; bf16_t* Dst; int ldc;
    __device__ __forceinline__ void operator()(const AccT& acc, const Unit& u, int wr, int wc, int fr, int fq) const {
        { int t_ = threadIdx.x; asm volatile("" : "+v"(t_)); fr = t_ & 15; fq = (t_ >> 4) & 3; }
        const int row0 = u.pm * BM + wr * 64 + fr, col0 = u.pn * BM + wc * 32 + 8 * fq;
#pragma unroll
        for (int ai = 0; ai < 2; ++ai)
#pragma unroll
            for (int m = 0; m < 4; ++m) { const size_t roff = (size_t)(row0 + ai * HALF + m * 16) * ldc + col0; const bf16_t* rowg = G + roff; bf16_t* rowp = Dst + roff;
#pragma unroll
                for (int bj = 0; bj < 2; ++bj) { const f32x4 v0 = acc[ai][bj][m][0], v1 = acc[ai][bj][m][1]; const u32x4 gq = *(const u32x4*)(rowg + bj * HALF);
                    u32x4 w; w.x = cvt_pk_bf16(v0[0] * bf_lo(gq.x), v0[1] * bf_hi(gq.x)); w.y = cvt_pk_bf16(v0[2] * bf_lo(gq.y), v0[3] * bf_hi(gq.y));
                    w.z = cvt_pk_bf16(v1[0] * bf_lo(gq.z), v1[1] * bf_hi(gq.z)); w.w = cvt_pk_bf16(v1[2] * bf_lo(gq.w), v1[3] * bf_hi(gq.w));
                    *(u32x4*)(rowp + bj * HALF) = w; } }
    }
};
struct EpiGateFma {
    static constexpr bool PERM = true, AFTER_DRAIN = false;
    const bf16_t* Tm; const bf16_t* G2; bf16_t* Dst; int ldc;
    __device__ __forceinline__ void operator()(const AccT& acc, const Unit& u, int wr, int wc, int fr, int fq) const {
        { int t_ = threadIdx.x; asm volatile("" : "+v"(t_)); fr = t_ & 15; fq = (t_ >> 4) & 3; }
        const int row0 = u.pm * BM + wr * 64 + fr, col0 = u.pn * BM + wc * 32 + 8 * fq;
#pragma unroll
        for (int ai = 0; ai < 2; ++ai)
#pragma unroll
            for (int m = 0; m < 4; ++m) { const size_t off = (size_t)(row0 + ai * HALF + m * 16) * ldc + col0;
#pragma unroll
                for (int bj = 0; bj < 2; ++bj) { const f32x4 v0 = acc[ai][bj][m][0], v1 = acc[ai][bj][m][1]; const u32x4 gq = *(const u32x4*)(G2 + off + bj * HALF); const u32x4 tq = *(const u32x4*)(Tm + off + bj * HALF);
                    u32x4 w; w.x = cvt_pk_bf16(bf_lo(tq.x) + v0[0] * bf_lo(gq.x), bf_hi(tq.x) + v0[1] * bf_hi(gq.x)); w.y = cvt_pk_bf16(bf_lo(tq.y) + v0[2] * bf_lo(gq.y), bf_hi(tq.y) + v0[3] * bf_hi(gq.y));
                    w.z = cvt_pk_bf16(bf_lo(tq.z) + v1[0] * bf_lo(gq.z), bf_hi(tq.z) + v1[1] * bf_hi(gq.z)); w.w = cvt_pk_bf16(bf_lo(tq.w) + v1[2] * bf_lo(gq.w), bf_hi(tq.w) + v1[3] * bf_hi(gq.w));
                    *(u32x4*)(Dst + off + bj * HALF) = w; } }
    }
};
struct EpiResF32 {
    static constexpr bool PERM = false, AFTER_DRAIN = false;
    const float* res; float* out; int ldc; float mul;
    __device__ __forceinline__ void operator()(const AccT& acc, const Unit& u, int wr, int wc, int fr, int fq) const {
        { int t_ = threadIdx.x; asm volatile("" : "+v"(t_)); fr = t_ & 15; fq = (t_ >> 4) & 3; }
        const int row0 = u.pm * BM + wr * 64 + fr, col0 = u.pn * BM + wc * 32 + 4 * fq;
#pragma unroll
        for (int ai = 0; ai < 2; ++ai)
#pragma unroll
            for (int m = 0; m < 4; ++m) { const size_t off = (size_t)(row0 + ai * HALF + m * 16) * ldc + col0;
#pragma unroll
                for (int bj = 0; bj < 2; ++bj)
#pragma unroll
                    for (int n = 0; n < 2; ++n) { const f32x4 r = *(const f32x4*)(res + off + bj * HALF + n * 16); *(f32x4*)(out + off + bj * HALF + n * 16) = r + acc[ai][bj][m][n] * mul; } }
    }
};

__device__ __forceinline__ float row_rs(const float* ssq, int row) {
    const f32x4* p = (const f32x4*)(ssq + (size_t)row * 16); const f32x4 a = p[0], b = p[1], c = p[2], d = p[3];
    const float s = ((a[0] + a[1]) + (a[2] + a[3])) + ((b[0] + b[1]) + (b[2] + b[3])) + ((c[0] + c[1]) + (c[2] + c[3])) + ((d[0] + d[1]) + (d[2] + d[3]));
    return rsqrtf(s * (1.f / 1024.f) + 1e-6f);
}
struct EpiBf16RS {
    static constexpr bool PERM = true, AFTER_DRAIN = false;
    bf16_t* O; int ldc; const float* ssq;
    __device__ __forceinline__ void operator()(const AccT& acc, const Unit& u, int wr, int wc, int fr, int fq) const {
        { int t_ = threadIdx.x; asm volatile("" : "+v"(t_)); fr = t_ & 15; fq = (t_ >> 4) & 3; }
        const int row0 = u.pm * BM + wr * 64 + fr, col0 = u.pn * BM + wc * 32 + 8 * fq;
#pragma unroll
        for (int ai = 0; ai < 2; ++ai)
#pragma unroll
            for (int m = 0; m < 4; ++m) { int ro = row0 + ai * HALF + m * 16; asm volatile("" : "+v"(ro)); const float rs = row_rs(ssq, ro); bf16_t* rowp = O + (size_t)ro * ldc + col0;
#pragma unroll
                for (int bj = 0; bj < 2; ++bj) { const f32x4 v0 = acc[ai][bj][m][0] * rs, v1 = acc[ai][bj][m][1] * rs;
                    u32x4 w; w.x = cvt_pk_bf16(v0[0], v0[1]); w.y = cvt_pk_bf16(v0[2], v0[3]); w.z = cvt_pk_bf16(v1[0], v1[1]); w.w = cvt_pk_bf16(v1[2], v1[3]);
                    *(u32x4*)(rowp + bj * HALF) = w; } }
    }
};
struct EpiF16RS {
    static constexpr bool PERM = true, AFTER_DRAIN = false;
    _Float16* O; int ldc; const float* ssq;
    __device__ __forceinline__ void operator()(const AccT& acc, const Unit& u, int wr, int wc, int fr, int fq) const {
        { int t_ = threadIdx.x; asm volatile("" : "+v"(t_)); fr = t_ & 15; fq = (t_ >> 4) & 3; }
        typedef _Float16 h8 __attribute__((ext_vector_type(8)));
        const int row0 = u.pm * BM + wr * 64 + fr, col0 = u.pn * BM + wc * 32 + 8 * fq;
#pragma unroll
        for (int ai = 0; ai < 2; ++ai)
#pragma unroll
            for (int m = 0; m < 4; ++m) { int ro = row0 + ai * HALF + m * 16; asm volatile("" : "+v"(ro)); const float rs = row_rs(ssq, ro); _Float16* rowp = O + (size_t)ro * ldc + col0;
#pragma unroll
                for (int bj = 0; bj < 2; ++bj) { const f32x4 v0 = acc[ai][bj][m][0] * rs, v1 = acc[ai][bj][m][1] * rs;
                    h8 w = {(_Float16)v0[0], (_Float16)v0[1], (_Float16)v0[2], (_Float16)v0[3], (_Float16)v1[0], (_Float16)v1[1], (_Float16)v1[2], (_Float16)v1[3]};
                    *(h8*)(rowp + bj * HALF) = w; } }
    }
};
template <bool RES_F32> struct EpiResNorm {
    static constexpr bool PERM = true, AFTER_DRAIN = false;
    const float* resf; bf16_t* H; float* ssq; int ldc; float mul;
    __device__ __forceinline__ void operator()(const AccT& acc, const Unit& u, int wr, int wc, int fr, int fq) const {
        { int t_ = threadIdx.x; asm volatile("" : "+v"(t_)); fr = t_ & 15; fq = (t_ >> 4) & 3; }
        const int row0 = u.pm * BM + wr * 64 + fr, col0 = u.pn * BM + wc * 32 + 8 * fq;
#pragma unroll
        for (int ai = 0; ai < 2; ++ai)
#pragma unroll
            for (int m = 0; m < 4; ++m) { int ro = row0 + ai * HALF + m * 16; asm volatile("" : "+v"(ro)); const size_t off = (size_t)ro * ldc + col0; float ss = 0.f;
#pragma unroll
                for (int bj = 0; bj < 2; ++bj) { f32x4 r0, r1;
                    if (RES_F32) { r0 = *(const f32x4*)(resf + off + bj * HALF); r1 = *(const f32x4*)(resf + off + bj * HALF + 4); }
                    else { const u32x4 q = *(const u32x4*)(H + off + bj * HALF); r0 = (f32x4){bf_lo(q.x), bf_hi(q.x), bf_lo(q.y), bf_hi(q.y)}; r1 = (f32x4){bf_lo(q.z), bf_hi(q.z), bf_lo(q.w), bf_hi(q.w)}; }
                    const f32x4 v0 = r0 + acc[ai][bj][m][0] * mul, v1 = r1 + acc[ai][bj][m][1] * mul;
                    ss += ((v0[0] * v0[0] + v0[1] * v0[1]) + (v0[2] * v0[2] + v0[3] * v0[3])) + ((v1[0] * v1[0] + v1[1] * v1[1]) + (v1[2] * v1[2] + v1[3] * v1[3]));
                    u32x4 w; w.x = cvt_pk_bf16(v0[0], v0[1]); w.y = cvt_pk_bf16(v0[2], v0[3]); w.z = cvt_pk_bf16(v1[0], v1[1]); w.w = cvt_pk_bf16(v1[2], v1[3]);
                    *(u32x4*)(H + off + bj * HALF) = w; }
                ss += shx<16>(ss); ss = sum32(ss);
                if (fq == 0) ssq[(size_t)ro * 16 + u.pn * 4 + wc] = ss; }
    }
};
struct EpiIn {
    static constexpr bool PERM = true, AFTER_DRAIN = false;
    bf16_t *U, *Bb, *Q, *Kb, *V, *SGC, *SGA; const float* ropec; const float* ropes; float* kbar; float qscale;
    __device__ __forceinline__ void operator()(const AccT& acc, const Unit& u, int wr, int wc, int fr, int fq) const {
        { int t_ = threadIdx.x; asm volatile("" : "+v"(t_)); fr = t_ & 15; fq = (t_ >> 4) & 3; }
        const int pn = u.pn; const int row0 = u.pm * BM + wr * 64 + fr;
        if (pn < 4) {
            const int c0 = 128 * pn + 16 * wc + 4 * fq;
#pragma unroll
            for (int ai = 0; ai < 2; ++ai)
#pragma unroll
                for (int m = 0; m < 4; ++m) { int ro = row0 + ai * HALF + m * 16; asm volatile("" : "+v"(ro)); bf16_t* rowp = U + (size_t)ro * 512 + c0;
#pragma unroll
                    for (int bj = 0; bj < 2; ++bj) { const f32x4 x = acc[ai][bj][m][0] * acc[ai][bj][m][1]; u32x2 w; w.x = cvt_pk_bf16(x[0], x[1]); w.y = cvt_pk_bf16(x[2], x[3]); *(u32x2*)(rowp + bj * 64) = w; } }
        } else if (pn < 6 || (pn >= 10 && pn < 12)) {
            bf16_t* O = pn < 6 ? Bb : V; const int col0 = (pn < 6 ? pn - 4 : pn - 10) * BM + wc * 32 + 8 * fq;
#pragma unroll
            for (int ai = 0; ai < 2; ++ai)
#pragma unroll
                for (int m = 0; m < 4; ++m) { int ro = row0 + ai * HALF + m * 16; asm volatile("" : "+v"(ro)); bf16_t* rowp = O + (size_t)ro * 512 + col0;
#pragma unroll
                    for (int bj = 0; bj < 2; ++bj) { const f32x4 v0 = acc[ai][bj][m][0], v1 = acc[ai][bj][m][1];
                        u32x4 w; w.x = cvt_pk_bf16(v0[0], v0[1]); w.y = cvt_pk_bf16(v0[2], v0[3]); w.z = cvt_pk_bf16(v1[0], v1[1]); w.w = cvt_pk_bf16(v1[2], v1[3]);
                        *(u32x4*)(rowp + bj * HALF) = w; } }
        } else if (pn < 10) {
            const bool isk = pn >= 8; bf16_t* O = isk ? Kb : Q; const int colt = (isk ? pn - 8 : pn - 6) * BM + wc * 32 + 8 * fq;
            const int g4 = 4 * (4 * (wc & 1) + fq);
            const float sc = isk ? 1.f : qscale;
            f32x4 cs0[2] = {(f32x4){0.f, 0.f, 0.f, 0.f}, (f32x4){0.f, 0.f, 0.f, 0.f}}, cs1[2] = {(f32x4){0.f, 0.f, 0.f, 0.f}, (f32x4){0.f, 0.f, 0.f, 0.f}};
#pragma unroll
            for (int ai = 0; ai < 2; ++ai)
#pragma unroll
                for (int m = 0; m < 4; ++m) { int row = row0 + ai * HALF + m * 16; asm volatile("" : "+v"(row)); const int pos = row & 2047;
                    const f32x4 c = *(const f32x4*)(ropec + pos * 32 + g4) * sc, s = *(const f32x4*)(ropes + pos * 32 + g4) * sc;
                    bf16_t* rowp = O + (size_t)row * 512 + colt;
#pragma unroll
                    for (int bj = 0; bj < 2; ++bj) { const f32x4 x1 = acc[ai][bj][m][0], x2 = acc[ai][bj][m][1]; const f32x4 o1 = x1 * c - x2 * s, o2 = x2 * c + x1 * s;
                        cs0[bj] += o1; cs1[bj] += o2;
                        u32x4 w; w.x = cvt_pk_bf16(o1[0], o1[1]); w.y = cvt_pk_bf16(o1[2], o1[3]); w.z = cvt_pk_bf16(o2[0], o2[1]); w.w = cvt_pk_bf16(o2[2], o2[3]);
                        *(u32x4*)(rowp + bj * HALF) = w; }
                    asm volatile("" : "+v"(cs0[0]), "+v"(cs0[1]), "+v"(cs1[0]), "+v"(cs1[1]) :: "memory"); }
            if (isk) {
#pragma unroll
                for (int bj = 0; bj < 2; ++bj)
#pragma unroll
                    for (int j = 0; j < 4; ++j) { float a = cs0[bj][j], b = cs1[bj][j];
                        a += shx<1>(a); b += shx<1>(b); a += shx<2>(a); b += shx<2>(b); a += shx<4>(a); b += shx<4>(b); a += shx<8>(a); b += shx<8>(b);
                        if (fr == 0) { const int pc = (pn - 8) * BM + bj * HALF + wc * 32 + 8 * fq;
                            float* kb = kbar + (size_t)u.pm * 512 + pc; atomicAdd(kb + j, a); atomicAdd(kb + 4 + j, b); } }
            }
        } else {
            bf16_t* O = pn < 16 ? SGC : SGA; const int col0 = (pn < 16 ? pn - 12 : pn - 16) * BM + wc * 32 + 8 * fq;
#pragma unroll
            for (int ai = 0; ai < 2; ++ai)
#pragma unroll
                for (int m = 0; m < 4; ++m) { int ro = row0 + ai * HALF + m * 16; asm volatile("" : "+v"(ro)); bf16_t* rowp = O + (size_t)ro * 1024 + col0;
#pragma unroll
                    for (int bj = 0; bj < 2; ++bj) { f32x4 v0 = acc[ai][bj][m][0], v1 = acc[ai][bj][m][1];
#pragma unroll
                        for (int j = 0; j < 4; ++j) { v0[j] = __builtin_amdgcn_rcpf(1.f + __expf(-v0[j])); v1[j] = __builtin_amdgcn_rcpf(1.f + __expf(-v1[j])); }
                        u32x4 w; w.x = cvt_pk_bf16(v0[0], v0[1]); w.y = cvt_pk_bf16(v0[2], v0[3]); w.z = cvt_pk_bf16(v1[0], v1[1]); w.w = cvt_pk_bf16(v1[2], v1[3]);
                        *(u32x4*)(rowp + bj * HALF) = w; }
                    asm volatile("" ::: "memory"); }
        }
    }
};
struct EpiSoftmax {
    static constexpr bool PERM = true, AFTER_DRAIN = true;
    bf16_t* O; int ldc; float scale_log2;
    __device__ __forceinline__ void fused(AccT& acc, const Unit& u, int wr, int wc, int fr, int fq, PG8_LAS unsigned char* lds, int wid, int lane) const {
        { int t_ = threadIdx.x; asm volatile("" : "+v"(t_)); fr = t_ & 15; fq = (t_ >> 4) & 3; }
        PG8_LAS f32x2* X = (PG8_LAS f32x2*)lds;
        float mx[2][4];
#pragma unroll
        for (int ai = 0; ai < 2; ++ai)
#pragma unroll
            for (int m = 0; m < 4; ++m) { float a = -3.0e38f;
#pragma unroll
                for (int bj = 0; bj < 2; ++bj)
#pragma unroll
                    for (int n = 0; n < 2; ++n) { acc[ai][bj][m][n] = acc[ai][bj][m][n] * scale_log2; const f32x4 x = acc[ai][bj][m][n]; a = fmaxf(fmaxf(a, fmaxf(x[0], x[1])), fmaxf(x[2], x[3])); }
                a = fmaxf(a, shx<16>(a)); a = max32(a); mx[ai][m] = a;
                float s = 0.f;
#pragma unroll
                for (int bj = 0; bj < 2; ++bj)
#pragma unroll
                    for (int n = 0; n < 2; ++n) { f32x4 x = acc[ai][bj][m][n];
#pragma unroll
                        for (int j = 0; j < 4; ++j) { x[j] = __builtin_amdgcn_exp2f(x[j] - a); s += x[j]; }
                        acc[ai][bj][m][n] = x; }
                s += shx<16>(s); s = sum32(s);
                if (fq == 0) X[(ai * HALF + wr * 64 + m * 16 + fr) * 4 + wc] = (f32x2){a, s};
            }
        asm volatile("s_waitcnt lgkmcnt(0)" ::: "memory"); __builtin_amdgcn_s_barrier(); asm volatile("" ::: "memory");
        const int row0 = u.pm * BM + wr * 64 + fr, col0 = u.pn * BM + wc * 32 + 8 * fq;
#pragma unroll
        for (int ai = 0; ai < 2; ++ai)
#pragma unroll
            for (int m = 0; m < 4; ++m) { const int r = ai * HALF + wr * 64 + m * 16 + fr;
                const f32x2 e0 = X[r * 4 + 0], e1 = X[r * 4 + 1], e2 = X[r * 4 + 2], e3 = X[r * 4 + 3];
                const float M = fmaxf(fmaxf(e0.x, e1.x), fmaxf(e2.x, e3.x));
                const float L = e0.y * __builtin_amdgcn_exp2f(e0.x - M) + e1.y * __builtin_amdgcn_exp2f(e1.x - M) + e2.y * __builtin_amdgcn_exp2f(e2.x - M) + e3.y * __builtin_amdgcn_exp2f(e3.x - M);
                const float f = __builtin_amdgcn_exp2f(mx[ai][m] - M) * __builtin_amdgcn_rcpf(L);
                bf16_t* rowp = O + (size_t)(row0 + ai * HALF + m * 16) * ldc + col0;
#pragma unroll
                for (int bj = 0; bj < 2; ++bj) { const f32x4 v0 = acc[ai][bj][m][0] * f, v1 = acc[ai][bj][m][1] * f;
                    u32x4 w; w.x = cvt_pk_bf16(v0[0], v0[1]); w.y = cvt_pk_bf16(v0[2], v0[3]); w.z = cvt_pk_bf16(v1[0], v1[1]); w.w = cvt_pk_bf16(v1[2], v1[3]);
                    *(u32x4*)(rowp + bj * HALF) = w; } }
        asm volatile("s_waitcnt lgkmcnt(0)" ::: "memory"); __builtin_amdgcn_s_barrier(); asm volatile("" ::: "memory");
    }
};
}
namespace attn_body {
using bf16=__hip_bfloat16;
using bf16x8=__attribute__((ext_vector_type(8)))short;
using s16x4=__attribute__((ext_vector_type(4)))short;
using f32x16=__attribute__((ext_vector_type(16)))float;
using u32x4=__attribute__((ext_vector_type(4)))unsigned;
constexpr int BATCH=16,NHEAD=8,SEQ=2048,D=64,DM=NHEAD*D;
constexpr int NW=8,QBLK=32,QB=QBLK*NW,KVBLK=64,NQB=SEQ/QB;
constexpr int ATTN_PITCH=DM, ATTN_UNIT_ROWS=QB;
__device__ __forceinline__ int crow(int r,int hi){return (r&3)+8*(r>>2)+4*hi;}
#define SBAR() __builtin_amdgcn_sched_barrier(0)
__device__ __forceinline__ void cmask(f32x16&p0,f32x16&p1,int jb,int qrel,int hi){
  const float NEG=-INFINITY; int kb=64*jb+4*hi;
  #pragma unroll
  for(int r=0;r<16;++r){int kv=kb+(r&3)+8*(r>>2); if(kv>qrel)p0[r]=NEG; if(kv+32>qrel)p1[r]=NEG;}
}

constexpr int NSLOT=3, SLOTB=8192;
constexpr int LDS_K=0, LDS_V=NSLOT*SLOTB, LDS_WS=2*NSLOT*SLOTB, LDS_OST=LDS_WS+NW*64*4, LDS_SEL=LDS_OST+NW*4096, LDS_BYTES=LDS_SEL+NW*64*4;
constexpr float C2=0.125f*1.4426950408889634f;
__device__ __forceinline__ void glds16(const void*gsrc,unsigned lds_dst){unsigned keep;
  asm volatile("s_mov_b32 %0, m0\n\ts_mov_b32 m0, %2\n\ts_nop 0\n\tglobal_load_lds_dwordx4 %1, off\n\ts_mov_b32 m0, %0":"=&s"(keep):"v"(gsrc),"s"(lds_dst):"memory");}
__device__ __forceinline__ float max3f(float a,float b,float c){float r;asm("v_max3_f32 %0, %1, %2, %3":"=v"(r):"v"(a),"v"(b),"v"(c));return r;}
__device__ __forceinline__ float max2f(float a,float b){float r;asm("v_max_f32_e32 %0, %1, %2":"=v"(r):"v"(a),"v"(b));return r;}
__device__ __forceinline__ float fadd_s(float a,float b){float r;asm("v_add_f32_e32 %0, %1, %2":"=v"(r):"v"(a),"v"(b));return r;}
__device__ __forceinline__ float fsub_s(float a,float b){float r;asm("v_sub_f32_e32 %0, %1, %2":"=v"(r):"v"(a),"v"(b));return r;}
typedef float f32x2_t __attribute__((ext_vector_type(2))); typedef __bf16 bf16x2_t __attribute__((ext_vector_type(2)));
__device__ __forceinline__ unsigned cvtpk_s(float lo,float hi){f32x2_t v={lo,hi};bf16x2_t b=__builtin_convertvector(v,bf16x2_t);return __builtin_bit_cast(unsigned,b);}
#define WAIT_BAR(N) asm volatile("s_waitcnt vmcnt(" #N ") lgkmcnt(0)\n\ts_barrier":::"memory")

__device__ __forceinline__ void qkt(f32x16&p0,f32x16&p1,const char*Kslot,const bf16x8*qr,const f32x16&negm,int r32,int hi){
  const char*kb=Kslot+hi*1024+r32*16;
  #pragma unroll
  for(int d0=0;d0<4;++d0){
    const bf16x8 b0=*reinterpret_cast<const bf16x8*>(kb+d0*2048);
    const bf16x8 b1=*reinterpret_cast<const bf16x8*>(kb+d0*2048+512);
    if(d0==0){p0=__builtin_amdgcn_mfma_f32_32x32x16_bf16(b0,qr[0],negm,0,0,0);p1=__builtin_amdgcn_mfma_f32_32x32x16_bf16(b1,qr[0],negm,0,0,0);}
    else{p0=__builtin_amdgcn_mfma_f32_32x32x16_bf16(b0,qr[d0],p0,0,0,0);p1=__builtin_amdgcn_mfma_f32_32x32x16_bf16(b1,qr[d0],p1,0,0,0);}}
}
typedef __attribute__((address_space(3))) const char* lds_cptr;
typedef short v4i16_t __attribute__((ext_vector_type(4)));
__device__ __forceinline__ void kload8(bf16x8*kf,lds_cptr kp){
  kf[0]=*(const __attribute__((address_space(3))) bf16x8*)(kp);      kf[1]=*(const __attribute__((address_space(3))) bf16x8*)(kp+512);
  kf[2]=*(const __attribute__((address_space(3))) bf16x8*)(kp+2048); kf[3]=*(const __attribute__((address_space(3))) bf16x8*)(kp+2560);
  kf[4]=*(const __attribute__((address_space(3))) bf16x8*)(kp+4096); kf[5]=*(const __attribute__((address_space(3))) bf16x8*)(kp+4608);
  kf[6]=*(const __attribute__((address_space(3))) bf16x8*)(kp+6144); kf[7]=*(const __attribute__((address_space(3))) bf16x8*)(kp+6656);
}
__device__ __forceinline__ void kload2(bf16x8*kf,lds_cptr kp,int j){ kf[2*j]=*(const __attribute__((address_space(3))) bf16x8*)(kp+j*2048); kf[2*j+1]=*(const __attribute__((address_space(3))) bf16x8*)(kp+j*2048+512); }
__device__ __forceinline__ s16x4 vtr(lds_cptr p){ return __builtin_bit_cast(s16x4,__builtin_amdgcn_ds_read_tr16_b64_v4i16((__attribute__((address_space(3))) v4i16_t*)p)); }
__device__ __forceinline__ float rowmax(const f32x16&p0,const f32x16&p1){
  float a=max3f(p0[0],p0[1],p1[0]),b=max3f(p0[2],p0[3],p1[1]);a=max3f(a,p1[2],p1[3]);
  #pragma unroll
  for(int r=4;r<16;r+=4){a=max3f(a,p0[r],p0[r+1]);b=max3f(b,p0[r+2],p0[r+3]);a=max3f(a,p1[r],p1[r+1]);b=max3f(b,p1[r+2],p1[r+3]);}
  const float m=max2f(a,b);
  auto rr=__builtin_amdgcn_permlane32_swap(__float_as_uint(m),__float_as_uint(m),false,false);
  return max2f(__uint_as_float(rr[0]),__uint_as_float(rr[1]));
}
__device__ __forceinline__ void pv(f32x16*o,int vb,bf16x8 pa0,bf16x8 pa1,bf16x8 pa2,bf16x8 pa3){
  #pragma unroll
  for(int d0=0;d0<2;++d0){s16x4 lo[4],hi[4];
    #pragma unroll
    for(int ks=0;ks<4;++ks){
      asm volatile("ds_read_b64_tr_b16 %0,%1 offset:%c2":"=&v"(lo[ks]):"v"(vb),"i"(d0*4096+ks*1024):"memory");
      asm volatile("ds_read_b64_tr_b16 %0,%1 offset:%c2":"=&v"(hi[ks]):"v"(vb),"i"(d0*4096+ks*1024+512):"memory");}
    asm volatile("s_waitcnt lgkmcnt(0)":::"memory");SBAR();
    #define PK(k) (bf16x8){lo[k][0],lo[k][1],lo[k][2],lo[k][3],hi[k][0],hi[k][1],hi[k][2],hi[k][3]}
    o[d0]=__builtin_amdgcn_mfma_f32_32x32x16_bf16(pa0,PK(0),o[d0],0,0,0);
    o[d0]=__builtin_amdgcn_mfma_f32_32x32x16_bf16(pa1,PK(1),o[d0],0,0,0);
    o[d0]=__builtin_amdgcn_mfma_f32_32x32x16_bf16(pa2,PK(2),o[d0],0,0,0);
    o[d0]=__builtin_amdgcn_mfma_f32_32x32x16_bf16(pa3,PK(3),o[d0],0,0,0);
    #undef PK
  }
}

#ifndef ATTN_STORE16
#define ATTN_STORE16(p,v) (*(u32x4*)(p)=(v))
#endif
template<int THRL> __device__ __forceinline__ void attn_unit(int b,int h,int qb,const bf16*Q,const bf16*__restrict__ K,const bf16*__restrict__ V,bf16*O,const float*__restrict__ kbar,char*shm){
  int tid=threadIdx.x; asm volatile("":"+v"(tid)); const int lane=tid&63,r32=lane&31,hi=lane>>5; const int wid=__builtin_amdgcn_readfirstlane(tid>>6);
  const long rowbase=(long)b*SEQ; const int q0=qb*QB;
  const bf16*Qw=Q+(rowbase+q0+wid*QBLK)*DM+h*D;
  const bf16*Kh=K+rowbase*DM+h*D,*Vh=V+rowbase*DM+h*D;
  const unsigned lds0=(unsigned)(uintptr_t)shm;
  float*wsf=(float*)(shm+LDS_WS)+wid*64;
  const bf16*ksrc=Kh+(long)lane*DM+wid*8;
  const bf16*vsrc=Vh+(long)(16*(wid&3)+(lane>>2))*DM+(wid>>2)*32+(lane&3)*8;
  const unsigned kdst=lds0+LDS_K+wid*1024, vdst=lds0+LDS_V+wid*1024;
  #define DMA_K(t,slot) glds16(ksrc+(long)(t)*KVBLK*DM,(unsigned)__builtin_amdgcn_readfirstlane(kdst+(slot)))
  #define DMA_V(t,slot) glds16(vsrc+(long)(t)*KVBLK*DM,(unsigned)__builtin_amdgcn_readfirstlane(vdst+(slot)))
  const int vb0=(int)(lds0+LDS_V)+((lane>>4)&1)*32+(lane&3)*8+(4*hi+((lane&15)>>2))*64;
  const char*Kbase=shm+LDS_K; bf16x8 kf[8];
  const lds_cptr shm3=(lds_cptr)shm; const lds_cptr kp0=shm3+LDS_K+hi*1024+r32*16; const lds_cptr vp0=shm3+LDS_V+((lane>>4)&1)*32+(lane&3)*8+(4*hi+((lane&15)>>2))*64;
  const int NT=(q0+QB)/KVBLK;
  DMA_K(0,0);DMA_V(0,0);DMA_K(1,SLOTB);
  bf16x8 qr[4];
  #pragma unroll
  for(int d0=0;d0<4;++d0)qr[d0]=*reinterpret_cast<const bf16x8*>(&Qw[(long)r32*DM+d0*16+hi*8]);
  int selm=0;
  if(qb>0){
    float g[7]; int hi8=8*hi; asm volatile("":"+v"(hi8)); const float*kb=kbar+(size_t)(b*8)*512+h*64+hi8;
    #pragma unroll
    for(int n=0;n<7;++n){ float a=0.f;
      if(n<qb){
        #pragma unroll
        for(int d0=0;d0<4;++d0){ const float4 k0=*(const float4*)(kb+n*512+16*d0),k1=*(const float4*)(kb+n*512+16*d0+4); const bf16x8 qq=qr[d0];
          #define QF(e) __uint_as_float(((unsigned)(unsigned short)qq[e])<<16)
          a+=QF(0)*k0.x+QF(1)*k0.y+QF(2)*k0.z+QF(3)*k0.w+QF(4)*k1.x+QF(5)*k1.y+QF(6)*k1.z+QF(7)*k1.w;
          #undef QF
        } }
      a=::sum32(a); g[n]=(n<qb)?a:-INFINITY; asm volatile("":"+v"(g[n])::"memory"); }
    #pragma unroll
    for(int r=0;r<3;++r){ int best=-1; float bv=-INFINITY;
      #pragma unroll
      for(int n=0;n<7;++n) if(!((selm>>n)&1)&&g[n]>bv){bv=g[n];best=n;}
      if(best>=0)selm|=1<<best; }
  }
  selm|=1<<qb;
  typedef __attribute__((address_space(3))) int* lds_iptr;
  ((lds_iptr)(shm3+LDS_SEL))[tid]=selm;
  #define CURNEG(blk) ({ int t_=threadIdx.x; asm volatile("":"+v"(t_)); const int sm_=((lds_iptr)(shm3+LDS_SEL))[t_]; ((sm_>>(blk))&1)?0.f:-INFINITY; })
  #define NEGUPD(t) do{ if((((t)+1)&3)==0){ const float cn_=CURNEG(((t)+1)>>2); _Pragma("unroll") for(int r=0;r<16;++r)negm[r]=cn_-mhat; asm volatile("":"+v"(negm)); } }while(0)
  float mhat=0.f,l_reg=0.f;f32x16 o[2];o[0]=f32x16{};o[1]=f32x16{};f32x16 negm; { const float cn_=CURNEG(0); _Pragma("unroll") for(int r=0;r<16;++r)negm[r]=cn_; } asm volatile("":"+v"(negm));
  const int qrel=wid*QBLK+r32;
  #define CMASK(P0,P1,t) do{int jb_=(t)-(NT-4); if(jb_>=0)cmask(P0,P1,jb_,qrel,hi);}while(0)
  bool resc=false;
  #define START(P0,P1) do{ const float rm=rowmax(P0,P1); resc=false; \
    { const float dl=__builtin_fmaxf(rm,-24.f); mhat=fadd_s(mhat,dl); \
      _Pragma("unroll") for(int r=0;r<16;++r){P0[r]=fsub_s(P0[r],dl);P1[r]=fsub_s(P1[r],dl);} \
      { const float cn_=CURNEG(0); _Pragma("unroll") for(int r=0;r<16;++r)negm[r]=cn_-mhat; } asm volatile("":"+v"(negm)); } \
    _Pragma("unroll") for(int r=0;r<16;++r)P0[r]=__builtin_amdgcn_exp2f(P0[r]); }while(0)
  #define RESC() do{ if(resc){ asm volatile("s_waitcnt lgkmcnt(0)":::"memory"); \
      _Pragma("unroll") for(int d_=0;d_<2;++d_) _Pragma("unroll") for(int r=0;r<16;++r)o[d_][r]*=wsf[crow(r,hi)]; } }while(0)
  f32x16 pA0,pA1,pB0,pB1;
  int sl_prev=0,sl_cur=0,sl_next=SLOTB;
  #define ROT() do{sl_prev=sl_cur;sl_cur=sl_next;sl_next=(sl_next==(NSLOT-1)*SLOTB)?0:sl_next+SLOTB;}while(0)
  DMA_K(2,2*SLOTB);
  WAIT_BAR(3);
  qkt(pA0,pA1,Kbase,qr,negm,r32,hi);asm volatile("s_nop 15\n\ts_nop 7":"+v"(pA0),"+v"(pA1));CMASK(pA0,pA1,0);
  START(pA0,pA1);
  _Pragma("unroll") for(int r=0;r<16;++r)pA1[r]=__builtin_amdgcn_exp2f(pA1[r]);
  WAIT_BAR(0);
  DMA_K(3,0);DMA_V(1,SLOTB);
  ROT();
  kload8(kf,kp0+sl_cur);
  WAIT_BAR(2);
  s16x4 vlo[8],vhi[8]; u32x4 pw0,pw1,pw2,pw3;
  #define PKW(P,B) cvtpk_s(P[B],P[B+1])
  #define PAF(k) __builtin_bit_cast(bf16x8,pw##k)
  #define VFR(i) (bf16x8){vlo[i][0],vlo[i][1],vlo[i][2],vlo[i][3],vhi[i][0],vhi[i][1],vhi[i][2],vhi[i][3]}
  #define PIN(x) asm volatile("":"+v"(x))
  #define MX3(a,b,c) __builtin_fmaxf(__builtin_fmaxf((a),(b)),(c))
  #define GAPA(MF,A0,A1,A2,A3,W0,W1,PW) do{ MF; sacc+=A0; sacc+=A1; sacc+=A2; sacc+=A3; PIN(sacc); W0; W1; PIN(PW); SBAR(); }while(0)
  #define EX(v) __builtin_amdgcn_exp2f(v)
  #define GAPB(MF,X,B) do{ MF; X[B]=EX(X[B]); X[B+1]=EX(X[B+1]); X[B+2]=EX(X[B+2]); X[B+3]=EX(X[B+3]); PIN(X); SBAR(); }while(0)
  #define VRD(i) do{ vlo[i]=vtr(vp_+(((i)>>2)*4096+((i)&3)*1024)); vhi[i]=vtr(vp_+(((i)>>2)*4096+((i)&3)*1024+512)); }while(0)
  #define KRD(G,j) do{ if(G){ kload2(kf,kp0+sl_next,j); SBAR(); } }while(0)
  #define STEP(C0,C1,P0,P1,t,GK,GV,GL) do{ SBAR(); \
    const lds_cptr vp_=vp0+sl_prev; \
    VRD(0); SBAR(); float sacc=(P0[0]+P0[1]); \
    GAPA(C0=__builtin_amdgcn_mfma_f32_32x32x16_bf16(kf[0],qr[0],negm,0,0,0), P0[2],P0[3],P0[4],P0[5],     pw0[0]=PKW(P0,0), pw0[1]=PKW(P0,2), pw0); \
    VRD(4); SBAR(); GAPA(C1=__builtin_amdgcn_mfma_f32_32x32x16_bf16(kf[1],qr[0],negm,0,0,0), P0[6],P0[7],P0[8],P0[9],     pw0[2]=PKW(P0,4), pw0[3]=PKW(P0,6), pw0); \
    VRD(1); SBAR(); GAPA(C0=__builtin_amdgcn_mfma_f32_32x32x16_bf16(kf[2],qr[1],C0,0,0,0),   P0[10],P0[11],P0[12],P0[13], pw1[0]=PKW(P0,8), pw1[1]=PKW(P0,10), pw1); \
    VRD(5); SBAR(); GAPA(C1=__builtin_amdgcn_mfma_f32_32x32x16_bf16(kf[3],qr[1],C1,0,0,0),   P0[14],P0[15],P1[0],P1[1],   pw1[2]=PKW(P0,12),pw1[3]=PKW(P0,14), pw1); \
    VRD(2); SBAR(); GAPA(C0=__builtin_amdgcn_mfma_f32_32x32x16_bf16(kf[4],qr[2],C0,0,0,0),   P1[2],P1[3],P1[4],P1[5],     pw2[0]=PKW(P1,0), pw2[1]=PKW(P1,2), pw2); \
    VRD(6); SBAR(); GAPA(C1=__builtin_amdgcn_mfma_f32_32x32x16_bf16(kf[5],qr[2],C1,0,0,0),   P1[6],P1[7],P1[8],P1[9],     pw2[2]=PKW(P1,4), pw2[3]=PKW(P1,6), pw2); \
    VRD(3); SBAR(); GAPA(C0=__builtin_amdgcn_mfma_f32_32x32x16_bf16(kf[6],qr[3],C0,0,0,0),   P1[10],P1[11],P1[12],P1[13], pw3[0]=PKW(P1,8), pw3[1]=PKW(P1,10), pw3); \
    VRD(7); SBAR(); GAPA(C1=__builtin_amdgcn_mfma_f32_32x32x16_bf16(kf[7],qr[3],C1,0,0,0),   P1[14],P1[15],0.f,0.f,       pw3[2]=PKW(P1,12),pw3[3]=PKW(P1,14), pw3); \
    l_reg+=sacc; \
    if(GK){DMA_K((t)+3,sl_cur);} if(GV){DMA_V((t)+1,sl_next);} \
    CMASK(C0,C1,t); \
    { float a=MX3(C0[0],C0[1],C1[0]),b=MX3(C0[2],C0[3],C1[1]); a=MX3(a,C1[2],C1[3]); \
      _Pragma("unroll") for(int r=4;r<16;r+=4){a=MX3(a,C0[r],C0[r+1]);b=MX3(b,C0[r+2],C0[r+3]);a=MX3(a,C1[r],C1[r+1]);b=MX3(b,C1[r+2],C1[r+3]);} \
      float rm=__builtin_fmaxf(a,b); { auto rr=__builtin_amdgcn_permlane32_swap(__float_as_uint(rm),__float_as_uint(rm),false,false); rm=__builtin_fmaxf(__uint_as_float(rr[0]),__uint_as_float(rr[1])); } \
      resc=false; \
      if(__builtin_expect(__any(rm>(float)THRL),0)){ const float dl=__builtin_fmaxf(rm,0.f); mhat+=dl; \
        _Pragma("unroll") for(int r=0;r<16;++r){C0[r]-=dl;C1[r]-=dl;} \
        { const float cn_=CURNEG(((t)+1)>>2); _Pragma("unroll") for(int r=0;r<16;++r)negm[r]=cn_-mhat; } asm volatile("":"+v"(negm)); \
        const float f=__builtin_amdgcn_exp2f(-dl); l_reg*=f; if(hi==0)wsf[r32]=f; resc=true; } } \
    SBAR(); \
    GAPB(o[0]=__builtin_amdgcn_mfma_f32_32x32x16_bf16(PAF(0),VFR(0),o[0],0,0,0), C0,0); \
    GAPB(o[1]=__builtin_amdgcn_mfma_f32_32x32x16_bf16(PAF(0),VFR(4),o[1],0,0,0), C0,4); \
    KRD(GL,0); GAPB(o[0]=__builtin_amdgcn_mfma_f32_32x32x16_bf16(PAF(1),VFR(1),o[0],0,0,0), C0,8); \
    KRD(GL,1); GAPB(o[1]=__builtin_amdgcn_mfma_f32_32x32x16_bf16(PAF(1),VFR(5),o[1],0,0,0), C0,12); \
    KRD(GL,2); GAPB(o[0]=__builtin_amdgcn_mfma_f32_32x32x16_bf16(PAF(2),VFR(2),o[0],0,0,0), C1,0); \
    KRD(GL,3); GAPB(o[1]=__builtin_amdgcn_mfma_f32_32x32x16_bf16(PAF(2),VFR(6),o[1],0,0,0), C1,4); \
    GAPB(o[0]=__builtin_amdgcn_mfma_f32_32x32x16_bf16(PAF(3),VFR(3),o[0],0,0,0), C1,8); \
    GAPB(o[1]=__builtin_amdgcn_mfma_f32_32x32x16_bf16(PAF(3),VFR(7),o[1],0,0,0), C1,12); \
    }while(0)
  int t=1;
  #undef CMASK
  #define CMASK(P0,P1,t) do{}while(0)
  for(;t+5<NT;t+=2){
    STEP(pB0,pB1,pA0,pA1,t,true,true,true);     WAIT_BAR(2); RESC(); ROT(); NEGUPD(t);
    STEP(pA0,pA1,pB0,pB1,t+1,true,true,true);   WAIT_BAR(2); RESC(); ROT(); NEGUPD(t+1);
  }
  #undef CMASK
  #define CMASK(P0,P1,t) do{int jb_=(t)-(NT-4); if(jb_>=0)cmask(P0,P1,jb_,qrel,hi);}while(0)
  #define ENDW(tt) do{ if((tt)+3<NT){WAIT_BAR(2);} else if((tt)+2<NT){WAIT_BAR(1);} else {WAIT_BAR(0);} }while(0)
  for(;t+1<NT;t+=2){
    STEP(pB0,pB1,pA0,pA1,t,(t+3<NT),(t+1<NT),(t+1<NT));       ENDW(t);   RESC(); ROT(); NEGUPD(t);
    STEP(pA0,pA1,pB0,pB1,t+1,(t+4<NT),(t+2<NT),(t+2<NT));     ENDW(t+1); RESC(); ROT(); NEGUPD(t+1);
  }
  STEP(pB0,pB1,pA0,pA1,NT-1,false,false,false); RESC();
  { float sacc=pB0[0]+pB0[1]; _Pragma("unroll") for(int r=2;r<16;++r)sacc+=pB0[r]; _Pragma("unroll") for(int r=0;r<16;++r)sacc+=pB1[r]; l_reg+=sacc;
    pw0=(u32x4){PKW(pB0,0),PKW(pB0,2),PKW(pB0,4),PKW(pB0,6)};pw1=(u32x4){PKW(pB0,8),PKW(pB0,10),PKW(pB0,12),PKW(pB0,14)};pw2=(u32x4){PKW(pB1,0),PKW(pB1,2),PKW(pB1,4),PKW(pB1,6)};pw3=(u32x4){PKW(pB1,8),PKW(pB1,10),PKW(pB1,12),PKW(pB1,14)};
    SBAR(); pv(o,vb0+sl_cur,PAF(0),PAF(1),PAF(2),PAF(3)); }
  #undef PKW
  #undef PAF
  #undef VFR
  #undef PIN
  #undef MX3
  #undef GAPA
  #undef GAPB
  #undef EX
  #undef VRD
  #undef KRD
  #undef STEP
  #undef ENDW
  {auto rr=__builtin_amdgcn_permlane32_swap(__float_as_uint(l_reg),__float_as_uint(l_reg),false,false);l_reg=__uint_as_float(rr[0])+__uint_as_float(rr[1]);}
  if(hi==0)wsf[32+r32]=l_reg;asm volatile("s_waitcnt lgkmcnt(0)":::"memory");
  float rli[16];
  #pragma unroll
  for(int r=0;r<16;++r)rli[r]=__builtin_amdgcn_rcpf(wsf[32+crow(r,hi)]);
  bf16*Ow=O+(rowbase+q0+wid*QBLK)*DM+h*D;
  { bf16*stg=(bf16*)(shm+LDS_OST)+wid*2048;
    #pragma unroll
    for(int r=0;r<16;++r){const int orow=crow(r,hi);
      #pragma unroll
      for(int d0=0;d0<2;++d0)stg[orow*64+d0*32+r32]=__float2bfloat16(o[d0][r]*rli[r]);}
    asm volatile("s_waitcnt lgkmcnt(0)":::"memory");
    #pragma unroll
    for(int i=0;i<4;++i){const int row=i*8+(lane>>3),ch=lane&7; const u32x4 v=*(const u32x4*)(stg+row*64+ch*8); ATTN_STORE16(Ow+(long)row*DM+ch*8,v);} }
  asm volatile("s_waitcnt lgkmcnt(0)\n\ts_barrier":::"memory");
  #undef DMA_K
  #undef DMA_V
  #undef CMASK
  #undef START
  #undef CURNEG
  #undef NEGUPD
  #undef RESC
  #undef ROT
}
constexpr int ATTN_LDS_BYTES=LDS_BYTES;
struct AttnTensors { const bf16* Q; const bf16* K; const bf16* V; bf16* O; const float* kbar; };
struct AttnUnit { int bh; int qb; };
struct StaticOrder {
  int vcu,G;
  __device__ __forceinline__ explicit StaticOrder(int grid,int block):vcu((grid%8==0)?(block%8)*(grid/8)+block/8:block),G(grid){}
  __device__ __forceinline__ bool next(int i,AttnUnit&u)const{
    if(G==256){ if(i>=4)return false; const int s=vcu&1; u.bh=vcu>>1; u.qb=s?((i==0)?6:(i==1)?1:(i==2)?5:2):((i==0)?7:(i==1)?0:(i==2)?4:3); return true; }
    const int L=i*G+vcu; if(L>=1024)return false; u.bh=L>>3; u.qb=L&7; return true; }
  __device__ __forceinline__ void a_ready(const AttnUnit&)const{}
  __device__ __forceinline__ void done(const AttnUnit&)const{}
};
template<class Sched,int THRL=8> __device__ __forceinline__ void attn_phase(char*lds,const AttnTensors&T,const Sched&S){
  AttnUnit u;
  for(int i=0;S.next(i,u);++i){ S.a_ready(u); attn_unit<THRL>(u.bh/NHEAD,u.bh%NHEAD,u.qb,T.Q,T.K,T.V,T.O,T.kbar,lds); S.done(u); }
}
#undef SBAR
#undef WAIT_BAR
}
constexpr int NWAVES = 8;
constexpr int T = 32768, D = 1024, SEQ = 2048, MEMROWS = 4096, INW = 5120;
constexpr float RMS_EPS = 1e-6f;
constexpr size_t MiB = 1u << 20;
constexpr size_t WS_CTL = 0, CTL_ZERO_BYTES = 2 * MiB, WS_KBAR = 1 * MiB;
constexpr size_t WS_WIN = 2 * MiB, WS_WC = 12 * MiB, WS_WA = 13 * MiB, WS_WM = 14 * MiB, WS_WXQ = 16 * MiB, WS_WXKV = 18 * MiB, WS_WXO = 22 * MiB, WS_MT = 24 * MiB, WS_ROPE = 28 * MiB;
constexpr size_t WS_MEMN = 32 * MiB, WS_KX = 40 * MiB, WS_VXT = 48 * MiB;
constexpr size_t WS_SSQ1 = 30 * MiB, WS_SSQ2 = 56 * MiB;
constexpr size_t WS_A = 64 * MiB;
constexpr size_t WS_YC = 128 * MiB, WS_QO = 160 * MiB, WS_U = 192 * MiB, WS_K = 224 * MiB, WS_V = 256 * MiB;
constexpr size_t WS_SGC = 320 * MiB, WS_SGA = 384 * MiB;
constexpr size_t WS_A8I = 320 * MiB, WS_ASC = 352 * MiB;
constexpr size_t WS_EIDX = 448 * MiB, WS_GW = 464 * MiB, WS_PW = 480 * MiB, WS_END = 496 * MiB;
constexpr size_t WS_U8 = 288 * MiB, WS_V8T = 304 * MiB, WS_SU = 29 * MiB, WS_SV = 29 * MiB + 512 * 1024;
constexpr size_t WS_QX = 128 * MiB, WS_PM = 192 * MiB, WS_OX = 128 * MiB;
constexpr size_t WS_PO = 128 * MiB;
constexpr size_t WS_SC = 128 * MiB;
constexpr int CW_TMO = 0, CW_BAR = 4096, CW_Q = 8192;
constexpr int RING_OFF = 0, RING_BYTES = 131072;
constexpr int LDSCTL_OFF = RING_BYTES, MISC_OFF = LDSCTL_OFF + 320;
constexpr int LDS_BYTES = 163840;
constexpr int UL_OFF = RING_BYTES + 512, UL_WAVE = (LDS_BYTES - UL_OFF) / 8, UL_CAP = ((UL_WAVE - 128 - 8) / 8) & ~15;

#define GAS __attribute__((address_space(1)))
#define LAS __attribute__((address_space(3)))
typedef unsigned short bf16;
typedef unsigned v4u __attribute__((ext_vector_type(4)));
typedef unsigned v2u __attribute__((ext_vector_type(2)));
typedef float v2f __attribute__((ext_vector_type(2)));
typedef float f32x3 __attribute__((ext_vector_type(3)));
typedef float f32x4 __attribute__((ext_vector_type(4)));
typedef float f32x2v __attribute__((ext_vector_type(2)));
typedef _Float16 h2v __attribute__((ext_vector_type(2)));
typedef GAS unsigned gu32;
#define RLX_AGENT __ATOMIC_RELAXED, __HIP_MEMORY_SCOPE_AGENT
#define LDS_WAIT() asm volatile("s_waitcnt lgkmcnt(0)" ::: "memory")
#define VM_WAIT() asm volatile("s_waitcnt vmcnt(0)" ::: "memory")
__device__ __forceinline__ unsigned pk2(float lo, float hi) { return pg8::cvt_pk_bf16(lo, hi); }
__device__ __forceinline__ float bflo(unsigned u) { return __uint_as_float(u << 16); }
__device__ __forceinline__ float bfhi(unsigned u) { return __uint_as_float(u & 0xffff0000u); }

#define XB_TMO      128
#define XB_XCNT(j)  (256  + 64 * (j))
#define XB_XSUB(j)  (1280 + 64 * (j))
#define XB_XGEN(j)  (2304 + 64 * (j))
#define XB_TOP      3328
#define XB_TOPGEN   3392
#define XCD_BAR_WORDS 3456
#define XB_SPIN_CAP (1u << 18)
__device__ __forceinline__ unsigned xb_ld(unsigned* p)              { return __hip_atomic_load(p, __ATOMIC_RELAXED, __HIP_MEMORY_SCOPE_AGENT); }
__device__ __forceinline__ unsigned xb_add(unsigned* p, unsigned v) { return __hip_atomic_fetch_add(p, v, __ATOMIC_RELAXED, __HIP_MEMORY_SCOPE_AGENT); }
__device__ __forceinline__ unsigned xb_xcc_id() { return (unsigned)__builtin_amdgcn_s_getreg((3 << 11) | 20) & 0xFu; }
#define XB_SPIN(cond, bar) do { unsigned _sp = 0; while (cond) { __builtin_amdgcn_s_sleep(1); \
    if ((++_sp & 255u) == 0u) { if (xb_ld(&(bar)[XB_TMO])) break; if (_sp > XB_SPIN_CAP) { atomicAdd(&(bar)[XB_TMO], 1u); break; } } } } while (0)
struct XcdBarrier { unsigned* bar; unsigned x; volatile LAS unsigned* st; };
__device__ __forceinline__ XcdBarrier xcd_barrier_post(unsigned* bar, volatile LAS unsigned* st) {
    XcdBarrier b; b.bar = bar; b.x = xb_xcc_id(); b.st = st;
    if (threadIdx.x == 0) (void)xb_add(&bar[XB_XCNT(b.x)], 1u);
    return b;
}
__device__ __forceinline__ void xcd_barrier_complete(unsigned* bar, unsigned x, unsigned& nloc, unsigned& nx) {
    const unsigned G = gridDim.x * gridDim.y * gridDim.z;
    unsigned sum, cnt, mine, sp = 0u;
    for (;;) {
        sum = 0u; cnt = 0u; mine = 0u;
#pragma unroll
        for (unsigned j = 0; j < 16; ++j) { const unsigned c = xb_ld(&bar[XB_XCNT(j)]); sum += c; cnt += (c > 0u) ? 1u : 0u; mine = (j == x) ? c : mine; }
        if (sum == G) break;
        __builtin_amdgcn_s_sleep(1);
        if ((++sp & 255u) == 0u) { if (xb_ld(&bar[XB_TMO])) break; if (sp > XB_SPIN_CAP) { atomicAdd(&bar[XB_TMO], 1u); break; } }
    }
    nloc = mine > 0u ? mine : 1u; nx = cnt > 0u ? cnt : 1u;
}
__device__ __forceinline__ void xcd_barrier(const XcdBarrier& b) {
    asm volatile("s_waitcnt vmcnt(0)" ::: "memory");
    __syncthreads();
    if (threadIdx.x == 0) {
        unsigned* bar = b.bar;
        __builtin_amdgcn_s_waitcnt(0);
        unsigned nloc = b.st[0], nx = b.st[1];
        if (nloc == 0u) { xcd_barrier_complete(bar, b.x, nloc, nx); b.st[0] = nloc; b.st[1] = nx; }
        const unsigned old = xb_add(&bar[XB_XSUB(b.x)], 1u);
        const unsigned gen = old / nloc;
        if (old + 1u == (gen + 1u) * nloc) {
            __builtin_amdgcn_fence(__ATOMIC_RELEASE, "agent");
            asm volatile("s_waitcnt vmcnt(0)" ::: "memory");
            const unsigned og = xb_add(&bar[XB_TOP], 1u);
            const unsigned tg = og / nx;
            if (og + 1u == (tg + 1u) * nx) xb_add(&bar[XB_TOPGEN], 1u);
            else XB_SPIN(xb_ld(&bar[XB_TOPGEN]) == tg, bar);
            __builtin_amdgcn_fence(__ATOMIC_ACQUIRE, "agent");
            xb_add(&bar[XB_XGEN(b.x)], 1u);
            asm volatile("s_waitcnt vmcnt(0)" ::: "memory");
        } else {
            XB_SPIN(xb_ld(&bar[XB_XGEN(b.x)]) == gen, bar);
            __builtin_amdgcn_fence(__ATOMIC_ACQUIRE, "agent");
            asm volatile("s_waitcnt vmcnt(0)" ::: "memory");
        }
    }
    __syncthreads();
}

struct MapId { static __device__ __forceinline__ int src(int j) { return j; } };
struct MapWin {
    static __device__ __forceinline__ int src(int j) {
        if (j < 1024) { const int g8 = j >> 3, i = j & 7; return ((i < 4) ? 0 : 1024) + 4 * g8 + (i & 3); }
        if (j < 1536) return 512 + (j - 1024);
        if (j < 2560) { const int jj = j - 1536, qk = jj >> 9, p = jj & 511, head = p >> 6, pl = p & 63, g = pl >> 3, i = pl & 7; return 1536 + qk * 512 + head * 64 + 4 * g + (i & 3) + 32 * (i >> 2); }
        return j;
    }
};
template <class MAP>
__device__ __forceinline__ void p0_transpose_item(const float* W, int K, int N, int NOUT, bf16* WT, LAS float* scr, int item, int lane, const float* gain = nullptr) {
    const int nblk = NOUT / 32, kb = item / nblk, nb = item % nblk, k0 = 64 * kb, n0 = 32 * nb;
    const int sc = MAP::src(n0 + (lane & 31));
    float wv[32];
#pragma unroll
    for (int i = 0; i < 32; ++i) wv[i] = W[(size_t)(k0 + 2 * i + (lane >> 5)) * N + sc];
#pragma unroll
    for (int i = 0; i < 32; ++i) { const int kk = 2 * i + (lane >> 5); const float gk = gain ? gain[k0 + kk] : 1.f; scr[kk * 33 + (lane & 31)] = wv[i] * gk; }
    LDS_WAIT(); asm volatile("" ::: "memory");
    const int c = lane & 7;
#pragma unroll
    for (int j = 0; j < 4; ++j) { const int n = (lane >> 3) + 8 * j; const LAS float* s = scr + (8 * c) * 33 + n;
        v4u o; o.x = pk2(s[0 * 33], s[1 * 33]); o.y = pk2(s[2 * 33], s[3 * 33]); o.z = pk2(s[4 * 33], s[5 * 33]); o.w = pk2(s[6 * 33], s[7 * 33]);
        *(GAS v4u*)(WT + (size_t)(n0 + n) * K + k0 + 8 * c) = o; }
    LDS_WAIT(); asm volatile("" ::: "memory");
}
__device__ __forceinline__ void rms_row_to_bf16(const float* xrow, const float* g, bf16* orow, int lane) {
    const GAS f32x4* xr = (const GAS f32x4*)xrow + lane; const GAS f32x4* gr = (const GAS f32x4*)g + lane;
    f32x4 v[4]; float s = 0.f;
#pragma unroll
    for (int j = 0; j < 4; ++j) { v[j] = xr[64 * j]; s += (v[j].x * v[j].x + v[j].y * v[j].y) + (v[j].z * v[j].z + v[j].w * v[j].w); }
    const float r = rsqrtf(wave_sum(s) * (1.f / 1024.f) + RMS_EPS);
    GAS v2u* o8 = (GAS v2u*)orow + lane;
#pragma unroll
    for (int j = 0; j < 4; ++j) { const f32x4 gg = gr[64 * j]; v2u w; w.x = pk2(v[j].x * r * gg.x, v[j].y * r * gg.y); w.y = pk2(v[j].z * r * gg.z, v[j].w * r * gg.w); o8[64 * j] = w; }
}
template <int NR>
__device__ __forceinline__ void rms_rows_to_bf16(const float* x, const float* g, bf16* o, int m0, int stride, int lane) {
    f32x4 v[NR][4];
#pragma unroll
    for (int i = 0; i < NR; ++i) { const GAS f32x4* xr = (const GAS f32x4*)(x + (size_t)(m0 + i * stride) * 1024) + lane;
#pragma unroll
        for (int j = 0; j < 4; ++j) v[i][j] = xr[64 * j]; }
    f32x4 gg[4];
#pragma unroll
    for (int j = 0; j < 4; ++j) gg[j] = ((const GAS f32x4*)g + lane)[64 * j];
#pragma unroll
    for (int i = 0; i < NR; ++i) { float s = 0.f;
#pragma unroll
        for (int j = 0; j < 4; ++j) s += (v[i][j].x * v[i][j].x + v[i][j].y * v[i][j].y) + (v[i][j].z * v[i][j].z + v[i][j].w * v[i][j].w);
        const float r = rsqrtf(wave_sum(s) * (1.f / 1024.f) + RMS_EPS);
        GAS v2u* o8 = (GAS v2u*)(o + (size_t)(m0 + i * stride) * 1024) + lane;
#pragma unroll
        for (int j = 0; j < 4; ++j) { v2u w; w.x = pk2(v[i][j].x * r * gg[j].x, v[i][j].y * r * gg[j].y); w.y = pk2(v[i][j].z * r * gg[j].z, v[i][j].w * r * gg[j].w); o8[64 * j] = w; } }
}
__device__ __forceinline__ float fmax_asm(float a, float b) { float r; asm("v_max_f32 %0, %1, %2" : "=v"(r) : "v"(a), "v"(b)); return r; }
__device__ __forceinline__ float fmin_asm(float a, float b) { float r; asm("v_min_f32 %0, %1, %2" : "=v"(r) : "v"(a), "v"(b)); return r; }

#ifndef PH_MASK
#define PH_MASK 0xFFFFFFFFu
#endif
#define PH(k) ((PH_MASK >> (k)) & 1u)
#ifndef REP_MASK
#define REP_MASK 0u
#endif
#define NREP(k) (((REP_MASK >> (k)) & 1u) ? 2 : 1)
#ifndef DIAG_TS_A
#define DIAG_TS_A -1
#endif
#ifndef DIAG_TS_B
#define DIAG_TS_B -1
#endif
struct Args { const float* in[19]; float* out; unsigned char* ws; };

struct XOrder {
    const char* A; const char* Bt; int G, c, i0, mode;
    __device__ bool next(int i, pg8::Unit& u) const {
        if (i > 0) return false;
        const int L = i0 * G + c; if (L >= 512) return false;
        const int b = L >> 5, head = (L >> 3) & 3, rt = L & 7;
        u.pm = b * 8 + rt; u.pn = head;
        if (mode == 0) { u.a = A + (size_t)(b * 2048 + rt * 256) * 1024 * 2; u.b = Bt + (size_t)(head * 256) * 1024 * 2; }
        else { u.a = A + ((size_t)(b * 2048 + rt * 256) * 1024 + head * 256) * 2;
               u.b = (mode == 2) ? Bt + ((size_t)(head * 256) * 4096 + b * 256) * 2 : Bt + ((size_t)(b * 256) * 1024 + head * 256) * 2; }
        return true;
    }
};

__global__ void __launch_bounds__(NWAVES * 64, 2) mk_fwd(Args args) {
    extern __shared__ __attribute__((aligned(16))) unsigned char lds[];
    LAS unsigned char* L = (LAS unsigned char*)lds;
    volatile LAS unsigned* MISC = (volatile LAS unsigned*)(L + MISC_OFF);
    const int wave = __builtin_amdgcn_readfirstlane((int)threadIdx.x >> 6);
#define PH_LANES int tid = threadIdx.x; asm volatile("" : "+v"(tid)); const int lane = tid & 63; const int gt = vcu * (NWAVES * 64) + tid; (void)lane; (void)gt
    const int G = gridDim.x; const int bx = blockIdx.x; const int vcu = (G % 8 == 0) ? (bx % 8) * (G / 8) + bx / 8 : bx;
    unsigned char* ws = args.ws;
    gu32* ctl = (gu32*)(ws + WS_CTL);
    for (int u = threadIdx.x; u < (LDS_BYTES - LDSCTL_OFF) / 4; u += NWAVES * 64) ((LAS unsigned*)(L + LDSCTL_OFF))[u] = 0u;
    __syncthreads();
    XcdBarrier bar = xcd_barrier_post((unsigned*)(ctl + CW_BAR), MISC + 8);
    unsigned long long* tsw = (unsigned long long*)(ws + WS_CTL + 65536);
    int n_ts = 0;
#define TSTAMP() do { if (DIAG_TS_A >= 0) { if (bx == 0 && threadIdx.x == 0) tsw[n_ts] = __builtin_amdgcn_s_memrealtime(); ++n_ts; } } while (0)
    TSTAMP();

    const float *x = args.in[0], *mem = args.in[1], *g_mix = args.in[2], *w_in = args.in[3], *w_conv = args.in[4], *w_conv_out = args.in[5], *w_attn_out = args.in[6], *w_merge = args.in[7],
                *g_xattn = args.in[8], *g_mem = args.in[9], *w_xq = args.in[10], *w_xkv = args.in[11], *w_xo = args.in[12], *g_ffn = args.in[13], *w_pq = args.in[14], *sub_keys = args.in[15],
                *peer_u = args.in[16], *peer_v = args.in[17], *g_final = args.in[18];
    float* out = args.out;
    bf16 *WinT = (bf16*)(ws + WS_WIN), *WcT = (bf16*)(ws + WS_WC), *WaT = (bf16*)(ws + WS_WA), *WmT = (bf16*)(ws + WS_WM), *WxqT = (bf16*)(ws + WS_WXQ), *WxkvT = (bf16*)(ws + WS_WXKV),
         *WxoT = (bf16*)(ws + WS_WXO), *MT = (bf16*)(ws + WS_MT);
    float* ropec = (float*)(ws + WS_ROPE); float* ropes = ropec + 2048 * 32;
    float* kbar = (float*)(ws + WS_KBAR);
    bf16 *MEMN = (bf16*)(ws + WS_MEMN), *KX = (bf16*)(ws + WS_KX), *VXT = (bf16*)(ws + WS_VXT), *A = (bf16*)(ws + WS_A);
    bf16 *YC = (bf16*)(ws + WS_YC), *QO = (bf16*)(ws + WS_QO), *U = (bf16*)(ws + WS_U), *KB = (bf16*)(ws + WS_K), *VB = (bf16*)(ws + WS_V), *SGC = (bf16*)(ws + WS_SGC), *SGA = (bf16*)(ws + WS_SGA);
    bf16 *QX = (bf16*)(ws + WS_QX), *PM = (bf16*)(ws + WS_PM), *OX = (bf16*)(ws + WS_OX);
    _Float16* SC = (_Float16*)(ws + WS_SC);
    unsigned char* A8I = ws + WS_A8I; float* ASC = (float*)(ws + WS_ASC);
    int* EIDX = (int*)(ws + WS_EIDX); float* GW = (float*)(ws + WS_GW); unsigned* PW = (unsigned*)(ws + WS_PW);
    float* PO = (float*)(ws + WS_PO); float* SSQ1 = (float*)(ws + WS_SSQ1); float* SSQ2 = (float*)(ws + WS_SSQ2); (void)PO;
    unsigned char* U8 = ws + WS_U8; unsigned char* V8T = ws + WS_V8T; float* SU = (float*)(ws + WS_SU); float* SV = (float*)(ws + WS_SV);
    const int gw = vcu * NWAVES + wave, NGW = G * NWAVES;
    const int NGT = G * NWAVES * 64;

    asm volatile("; ===== PHASE 0 =====");
    if (PH(0)) for (int rep = 0; rep < NREP(0); ++rep) {
        PH_LANES; const bool dummy = rep < NREP(0) - 1; (void)dummy;
        LAS float* scr = (LAS float*)(L + RING_OFF + wave * 16384);
        constexpr int I_IN = (1024 / 64) * (5120 / 32), I_C = (512 / 64) * (1024 / 32), I_M = (1024 / 64) * (1024 / 32), I_KV = (1024 / 64) * (2048 / 32);
        constexpr int NITEMS = I_IN + 2 * I_C + 3 * I_M + I_KV;
        for (int it = gw; it < NITEMS; it += NGW) {
            int r = it;
            if (r < I_IN) { p0_transpose_item<MapWin>(w_in, 1024, 5120, 5120, WinT, scr, r, lane); continue; } r -= I_IN;
            if (r < I_C) { p0_transpose_item<MapId>(w_conv_out, 512, 1024, 1024, WcT, scr, r, lane); continue; } r -= I_C;
            if (r < I_C) { p0_transpose_item<MapId>(w_attn_out, 512, 1024, 1024, WaT, scr, r, lane); continue; } r -= I_C;
            if (r < I_M) { p0_transpose_item<MapId>(w_merge, 1024, 1024, 1024, WmT, scr, r, lane); continue; } r -= I_M;
            if (r < I_M) { p0_transpose_item<MapId>(w_xq, 1024, 1024, 1024, WxqT, scr, r, lane, g_xattn); continue; } r -= I_M;
            if (r < I_M) { p0_transpose_item<MapId>(w_xo, 1024, 1024, 1024, WxoT, scr, r, lane); continue; } r -= I_M;
            p0_transpose_item<MapId>(w_xkv, 1024, 2048, 2048, WxkvT, scr, r, lane);
        }
        { int m = gw; for (; m + 3 * NGW < T; m += 4 * NGW) rms_rows_to_bf16<4>(x, g_mix, A, m, NGW, lane); for (; m < T; m += NGW) rms_row_to_bf16(x + (size_t)m * D, g_mix, A + (size_t)m * D, lane); }
        { int m = gw; for (; m + NGW < MEMROWS; m += 2 * NGW) rms_rows_to_bf16<2>(mem, g_mem, MEMN, m, NGW, lane); for (; m < MEMROWS; m += NGW) rms_row_to_bf16(mem + (size_t)m * D, g_mem, MEMN + (size_t)m * D, lane); }
        for (int i = gt; i < 2048 * 32; i += NGT) { const int pos = i >> 5, f = i & 31; const float inv = powf(10000.0f, -(float)f / 32.0f); const float ang = (float)pos * inv; ropec[i] = cosf(ang); ropes[i] = sinf(ang); }
        __syncthreads();
        {
            LAS float* skl = (LAS float*)(L + RING_OFF);
            LAS float* wtl = skl + 128 * 129;
            for (int it = bx; it < 256; it += G) {
                const int hp = it >> 4, cb = it & 15;
                for (int i = tid; i < 128 * 128; i += NWAVES * 64) { const int n = i >> 7, d = i & 127; skl[n * 129 + d] = sub_keys[((size_t)hp * 128 + n) * 128 + d]; }
                for (int i = tid; i < 64 * 128; i += NWAVES * 64) { const int c = i >> 7, d = i & 127; wtl[c * 129 + d] = w_pq[(size_t)(cb * 64 + c) * 2048 + hp * 128 + d] * g_ffn[cb * 64 + c]; }
                __syncthreads();
                const int cg = tid & 15, ng = tid >> 4;
                float acc[4][4];
#pragma unroll
                for (int i = 0; i < 4; ++i)
#pragma unroll
                    for (int j = 0; j < 4; ++j) acc[i][j] = 0.f;
                for (int d = 0; d < 128; ++d) {
                    float wv[4], sv[4];
#pragma unroll
                    for (int i = 0; i < 4; ++i) { wv[i] = wtl[(4 * cg + i) * 129 + d]; sv[i] = skl[(4 * ng + i) * 129 + d]; }
#pragma unroll
                    for (int i = 0; i < 4; ++i)
#pragma unroll
                        for (int j = 0; j < 4; ++j) acc[i][j] += sv[i] * wv[j];
                }
#pragma unroll
                for (int i = 0; i < 4; ++i) { v2u w; w.x = pk2(acc[i][0], acc[i][1]); w.y = pk2(acc[i][2], acc[i][3]); *(GAS v2u*)(MT + (size_t)(hp * 128 + 4 * ng + i) * 1024 + cb * 64 + 4 * cg) = w; }
                __syncthreads();
            }
        }
    }
    xcd_barrier(bar); TSTAMP();

    asm volatile("; ===== PHASE 1 =====");
    if (PH(1)) for (int rep = 0; rep < NREP(1); ++rep) {
        PH_LANES; const bool dummy = rep < NREP(1) - 1; (void)dummy;
        pg8::Gemm g{1024, 1024, 1024}; pg8::StaticOrder S; S.init(A, 1024, WinT, 1024, T, INW, G, bx);
        pg8::EpiIn E{U, YC, QO, KB, VB, SGC, SGA, ropec, ropes, kbar, 0.125f * 1.4426950408889634f};
        pg8::gemm_phase<pg8::EpiIn, pg8::StaticOrder, true>(L + RING_OFF, g, S, E);
    }
    if (PH(1)) for (int rep = 0; rep < NREP(1); ++rep) {
        PH_LANES; const bool dummy = rep < NREP(1) - 1; (void)dummy;
        pg8::Gemm g{1024, 1024, 1024}; pg8::StaticOrder S; S.init(MEMN, 1024, WxkvT, 1024, MEMROWS, 1024, G, bx);
        pg8::EpiBf16 E{KX, 1024};
        pg8::gemm_phase<pg8::EpiBf16, pg8::StaticOrder, true>(L + RING_OFF, g, S, E);
    }
    if (PH(1)) for (int rep = 0; rep < NREP(1); ++rep) {
        PH_LANES; const bool dummy = rep < NREP(1) - 1; (void)dummy;
        pg8::Gemm g{1024, 1024, 1024}; pg8::StaticOrder S; S.init(WxkvT + (size_t)1024 * 1024, 1024, MEMN, 1024, 1024, MEMROWS, G, (bx + 128) % G);
        pg8::EpiBf16 E{VXT, 4096};
        pg8::gemm_phase<pg8::EpiBf16, pg8::StaticOrder, true>(L + RING_OFF, g, S, E);
    }
    if (PH(1)) for (int rep = 0; rep < NREP(1); ++rep) {
        PH_LANES; const bool dummy = rep < NREP(1) - 1; (void)dummy;
        int cb, ncb;
        if (G == 256) { const bool idle = (bx >= 64 && bx < 128) || bx >= 192; cb = idle ? ((bx < 128) ? bx - 64 : bx - 128) : 256; ncb = 128; } else { cb = bx; ncb = G; }
        const int cw = cb * NWAVES + wave, ncw = ncb * NWAVES;
        for (int e = (cb < ncb ? cw : 16384); e < 16384; e += ncw) {
            const GAS f32x4* r = (const GAS f32x4*)(peer_u + (size_t)e * D) + lane; f32x4 v[4]; float am = 0.f;
#pragma unroll
            for (int j = 0; j < 4; ++j) { v[j] = r[64 * j] * ((const GAS f32x4*)g_ffn + lane)[64 * j]; am = fmaxf(fmaxf(am, fmaxf(fabsf(v[j].x), fabsf(v[j].y))), fmaxf(fabsf(v[j].z), fabsf(v[j].w))); }
            am = wave_max(am);
            const float sc = am > 0.f ? 7.f / am : 1.f; int ns = 0;
#pragma unroll
            for (int j = 0; j < 2; ++j) {
                const int l0 = (int)rintf(v[j].x * sc) + 8, l1 = (int)rintf(v[j].y * sc) + 8, l2 = (int)rintf(v[j].z * sc) + 8, l3 = (int)rintf(v[j].w * sc) + 8;
                const int h0 = (int)rintf(v[j + 2].x * sc) + 8, h1 = (int)rintf(v[j + 2].y * sc) + 8, h2 = (int)rintf(v[j + 2].z * sc) + 8, h3 = (int)rintf(v[j + 2].w * sc) + 8;
                ns += (l0 + l1) + (l2 + l3) + (h0 + h1) + (h2 + h3);
                *(GAS unsigned*)(U8 + (size_t)e * 512 + 4 * lane + 256 * j) = (unsigned)(l0 | (h0 << 4)) | ((unsigned)(l1 | (h1 << 4)) << 8) | ((unsigned)(l2 | (h2 << 4)) << 16) | ((unsigned)(l3 | (h3 << 4)) << 24); }
            const float nsf = wave_sum((float)ns);
            if (lane == 0) { SU[4 * e] = am > 0.f ? am * (1.f / 7.f) : 1.f; SU[4 * e + 2] = nsf; }
        }
        __syncthreads();
        for (int it = cb; it < 256; it += ncb) {
            const int e0 = it * 64;
#pragma unroll 1
            for (int rr = 0; rr < 8; ++rr) {
                const int el = wave * 8 + rr, e = e0 + el;
                const GAS f32x4* r = (const GAS f32x4*)(peer_v + (size_t)e * D) + lane; f32x4 v[4]; float am = 0.f;
#pragma unroll
                for (int j = 0; j < 4; ++j) { v[j] = r[64 * j]; am = fmaxf(fmaxf(am, fmaxf(fabsf(v[j].x), fabsf(v[j].y))), fmaxf(fabsf(v[j].z), fabsf(v[j].w))); }
                am = wave_max(am);
                const float sc = am > 0.f ? 4.f / am : 1.f; if (lane == 0) SU[4 * e + 1] = am > 0.f ? am * 0.25f : 1.f;
#pragma unroll
                for (int j = 0; j < 4; ++j) { int w = __builtin_amdgcn_cvt_pk_bf8_f32(v[j].x * sc, v[j].y * sc, 0, false); w = __builtin_amdgcn_cvt_pk_bf8_f32(v[j].z * sc, v[j].w * sc, w, true);
                    *(LAS unsigned*)(L + RING_OFF + el * 1024 + 4 * lane + 256 * j) = (unsigned)w; }
            }
            __syncthreads();
#pragma unroll
            for (int i = 0; i < 8; ++i) { const int idx = tid + 512 * i, sl = idx >> 5, k = idx & 31;
                const v2u a0 = *(const LAS v2u*)(L + RING_OFF + (2 * k) * 1024 + sl * 8), a1 = *(const LAS v2u*)(L + RING_OFF + (2 * k + 1) * 1024 + sl * 8);
                *(GAS v4u*)(V8T + ((size_t)sl * 16384 + e0 + 2 * k) * 8) = (v4u){a0.x, a0.y, a1.x, a1.y}; }
            __syncthreads();
        }
    }
    xcd_barrier(bar); TSTAMP();

    asm volatile("; ===== PHASE 2 =====");
    if (PH(2)) for (int rep = 0; rep < NREP(2); ++rep) {
        PH_LANES; const bool dummy = rep < NREP(2) - 1; (void)dummy;
        for (int i = gt; i < T * 64; i += NGT) {
            const int row = i >> 6, cg = i & 63, s = row & 2047;
            const v4u u0 = *(const GAS v4u*)(U + (size_t)row * 512 + cg * 8);
            v4u u1 = (v4u){0u, 0u, 0u, 0u}, u2 = (v4u){0u, 0u, 0u, 0u};
            if (s >= 1) u1 = *(const GAS v4u*)(U + (size_t)(row - 1) * 512 + cg * 8);
            if (s >= 2) u2 = *(const GAS v4u*)(U + (size_t)(row - 2) * 512 + cg * 8);
            const v4u bq = *(const GAS v4u*)(YC + (size_t)row * 512 + cg * 8);
            const f32x4 w0a = *(const GAS f32x4*)(w_conv + cg * 8), w0b = *(const GAS f32x4*)(w_conv + cg * 8 + 4);
            const f32x4 w1a = *(const GAS f32x4*)(w_conv + 512 + cg * 8), w1b = *(const GAS f32x4*)(w_conv + 512 + cg * 8 + 4);
            const f32x4 w2a = *(const GAS f32x4*)(w_conv + 1024 + cg * 8), w2b = *(const GAS f32x4*)(w_conv + 1024 + cg * 8 + 4);
            v4u o;
#define CONV2(q, wa, ia, ib) pk2(bflo(bq.q) * (w0##wa[ia] * bflo(u2.q) + w1##wa[ia] * bflo(u1.q) + w2##wa[ia] * bflo(u0.q)), bfhi(bq.q) * (w0##wa[ib] * bfhi(u2.q) + w1##wa[ib] * bfhi(u1.q) + w2##wa[ib] * bfhi(u0.q)))
            o.x = CONV2(x, a, 0, 1); o.y = CONV2(y, a, 2, 3); o.z = CONV2(z, b, 0, 1); o.w = CONV2(w, b, 2, 3);
#undef CONV2
            { const bool conv_dummy = (NREP(2) == 2) && !dummy; *(GAS v4u*)(YC + (size_t)row * 512 + cg * 8) = conv_dummy ? bq : o; }
        }
        __syncthreads();
        const attn_body::AttnTensors AT{(const attn_body::bf16*)QO, (const attn_body::bf16*)KB, (const attn_body::bf16*)VB, (attn_body::bf16*)(dummy ? A : QO), kbar};
        const attn_body::StaticOrder S(G, bx);
        attn_body::attn_phase<attn_body::StaticOrder>((char*)lds + RING_OFF, AT, S);
    }
    xcd_barrier(bar); TSTAMP();

    asm volatile("; ===== PHASE 3 =====");
    if (PH(3)) for (int rep = 0; rep < NREP(3); ++rep) {
        PH_LANES; const bool dummy = rep < NREP(3) - 1; (void)dummy;
        pg8::Gemm g{512, 512, 512}; pg8::StaticOrder S; S.init(YC, 512, WcT, 512, T, 1024, G, bx);
        pg8::EpiGateMul E{SGC, dummy ? A : SGC, 1024};
        pg8::gemm_phase<pg8::EpiGateMul, pg8::StaticOrder, true>(L + RING_OFF, g, S, E);
    }
    if (PH(3)) for (int rep = 0; rep < NREP(3); ++rep) {
        PH_LANES; const bool dummy = rep < NREP(3) - 1; (void)dummy;
        pg8::Gemm g{512, 512, 512}; pg8::StaticOrder S; S.init(QO, 512, WaT, 512, T, 1024, G, bx);
        pg8::EpiGateFma E{SGC, SGA, dummy ? A : SGA, 1024};
        pg8::gemm_phase<pg8::EpiGateFma, pg8::StaticOrder, true>(L + RING_OFF, g, S, E);
    }
    xcd_barrier(bar); TSTAMP();

    asm volatile("; ===== PHASE 4 =====");
    if (PH(4)) for (int rep = 0; rep < NREP(4); ++rep) {
        PH_LANES; const bool dummy = rep < NREP(4) - 1; (void)dummy;
        pg8::Gemm g{1024, 1024, 1024}; pg8::StaticOrder S; S.init(SGA, 1024, WmT, 1024, T, 1024, G, bx);
        pg8::EpiResNorm<true> E{x, A, SSQ1, 1024, 1.f};
        pg8::gemm_phase<pg8::EpiResNorm<true>, pg8::StaticOrder, true>(L + RING_OFF, g, S, E);
    }
    xcd_barrier(bar); TSTAMP();

    asm volatile("; ===== PHASE 6 =====");
    if (PH(6)) for (int rep = 0; rep < NREP(6); ++rep) {
        PH_LANES; const bool dummy = rep < NREP(6) - 1; (void)dummy;
        const pg8::Gemm gq{1024, 1024, 1024}, gs{1024, 1024, 256}, gv{1024, 4096, 256};
        const pg8::EpiBf16RS Eq{QX, 1024, SSQ1}; const pg8::EpiSoftmax Es{PM, 1024, 0.0625f * 1.4426950408889634f}; const pg8::EpiBf16 Ev{OX, 1024};
        { XOrder S{(const char*)A, (const char*)WxqT, G, vcu, 0, 0}; pg8::gemm_phase<pg8::EpiBf16RS, XOrder, false>(L + RING_OFF, gq, S, Eq); }
        VM_WAIT(); __syncthreads();
        { XOrder S{(const char*)QX, (const char*)KX, G, vcu, 0, 1}; pg8::gemm_phase<pg8::EpiSoftmax, XOrder, false>(L + RING_OFF, gs, S, Es); }
        VM_WAIT(); __syncthreads();
        { XOrder S{(const char*)PM, (const char*)VXT, G, vcu, 0, 2}; pg8::gemm_phase<pg8::EpiBf16, XOrder, false>(L + RING_OFF, gv, S, Ev); }
        VM_WAIT(); __syncthreads();
        { XOrder S{(const char*)A, (const char*)WxqT, G, vcu, 1, 0}; pg8::gemm_phase<pg8::EpiBf16RS, XOrder, false>(L + RING_OFF, gq, S, Eq); }
        VM_WAIT(); __syncthreads();
        { XOrder S{(const char*)QX, (const char*)KX, G, vcu, 1, 1}; pg8::gemm_phase<pg8::EpiSoftmax, XOrder, false>(L + RING_OFF, gs, S, Es); }
        VM_WAIT(); __syncthreads();
        { XOrder S{(const char*)PM, (const char*)VXT, G, vcu, 1, 2}; pg8::gemm_phase<pg8::EpiBf16, XOrder, false>(L + RING_OFF, gv, S, Ev); }
    }
    xcd_barrier(bar); TSTAMP();

    asm volatile("; ===== PHASE 9 =====");
    if (PH(9)) for (int rep = 0; rep < NREP(9); ++rep) {
        PH_LANES; const bool dummy = rep < NREP(9) - 1; (void)dummy;
        pg8::Gemm g{1024, 1024, 1024}; pg8::StaticOrder S; S.init(OX, 1024, WxoT, 1024, T, 1024, G, bx);
        pg8::EpiResNorm<false> E{nullptr, A, SSQ2, 1024, dummy ? 0.f : 1.f};
        pg8::gemm_phase<pg8::EpiResNorm<false>, pg8::StaticOrder, true>(L + RING_OFF, g, S, E);
    }
    xcd_barrier(bar); TSTAMP();

    asm volatile("; ===== PHASE 11 =====");
    if (PH(11)) for (int rep = 0; rep < NREP(11); ++rep) {
        PH_LANES; const bool dummy = rep < NREP(11) - 1; (void)dummy;
        pg8::Gemm g{1024, 1024, 1024}; pg8::StaticOrder S; S.init(A, 1024, MT, 1024, T, 2048, G, bx);
        pg8::EpiF16RS E{SC, 2048, SSQ2};
        pg8::gemm_phase<pg8::EpiF16RS, pg8::StaticOrder, true>(L + RING_OFF, g, S, E);
    }
    xcd_barrier(bar); TSTAMP();

    asm volatile("; ===== PHASE 12 =====");
    if (PH(12)) for (int rep = 0; rep < NREP(12); ++rep) {
        PH_LANES; const bool dummy = rep < NREP(12) - 1; (void)dummy;
        typedef _Float16 h8 __attribute__((ext_vector_type(8)));
#define RCE(a, b) do { const float hi_ = fmax_asm(a, b); b = fmin_asm(a, b); a = hi_; } while (0)
#define RSORT16(K) do { RCE(K[0], K[1]); RCE(K[3], K[2]); RCE(K[4], K[5]); RCE(K[7], K[6]); RCE(K[8], K[9]); RCE(K[11], K[10]); RCE(K[12], K[13]); RCE(K[15], K[14]); RCE(K[0], K[2]); RCE(K[1], K[3]); RCE(K[6], K[4]); RCE(K[7], K[5]); RCE(K[8], K[10]); RCE(K[9], K[11]); RCE(K[14], K[12]); RCE(K[15], K[13]); RCE(K[0], K[1]); RCE(K[2], K[3]); RCE(K[5], K[4]); RCE(K[7], K[6]); RCE(K[8], K[9]); RCE(K[10], K[11]); RCE(K[13], K[12]); RCE(K[15], K[14]); RCE(K[0], K[4]); RCE(K[1], K[5]); RCE(K[2], K[6]); RCE(K[3], K[7]); RCE(K[12], K[8]); RCE(K[13], K[9]); RCE(K[14], K[10]); RCE(K[15], K[11]); RCE(K[0], K[2]); RCE(K[1], K[3]); RCE(K[4], K[6]); RCE(K[5], K[7]); RCE(K[10], K[8]); RCE(K[11], K[9]); RCE(K[14], K[12]); RCE(K[15], K[13]); RCE(K[0], K[1]); RCE(K[2], K[3]); RCE(K[4], K[5]); RCE(K[6], K[7]); RCE(K[9], K[8]); RCE(K[11], K[10]); RCE(K[13], K[12]); RCE(K[15], K[14]); RCE(K[0], K[8]); RCE(K[1], K[9]); RCE(K[2], K[10]); RCE(K[3], K[11]); RCE(K[4], K[12]); RCE(K[5], K[13]); RCE(K[6], K[14]); RCE(K[7], K[15]); RCE(K[0], K[4]); RCE(K[1], K[5]); RCE(K[2], K[6]); RCE(K[3], K[7]); RCE(K[8], K[12]); RCE(K[9], K[13]); RCE(K[10], K[14]); RCE(K[11], K[15]); RCE(K[0], K[2]); RCE(K[1], K[3]); RCE(K[4], K[6]); RCE(K[5], K[7]); RCE(K[8], K[10]); RCE(K[9], K[11]); RCE(K[12], K[14]); RCE(K[13], K[15]); RCE(K[0], K[1]); RCE(K[2], K[3]); RCE(K[4], K[5]); RCE(K[6], K[7]); RCE(K[8], K[9]); RCE(K[10], K[11]); RCE(K[12], K[13]); RCE(K[14], K[15]); } while (0)
#define RMERGE16(K) do { RCE(K[0], K[8]); RCE(K[1], K[9]); RCE(K[2], K[10]); RCE(K[3], K[11]); RCE(K[4], K[12]); RCE(K[5], K[13]); RCE(K[6], K[14]); RCE(K[7], K[15]); RCE(K[0], K[4]); RCE(K[1], K[5]); RCE(K[2], K[6]); RCE(K[3], K[7]); RCE(K[8], K[12]); RCE(K[9], K[13]); RCE(K[10], K[14]); RCE(K[11], K[15]); RCE(K[0], K[2]); RCE(K[1], K[3]); RCE(K[4], K[6]); RCE(K[5], K[7]); RCE(K[8], K[10]); RCE(K[9], K[11]); RCE(K[12], K[14]); RCE(K[13], K[15]); RCE(K[0], K[1]); RCE(K[2], K[3]); RCE(K[4], K[5]); RCE(K[6], K[7]); RCE(K[8], K[9]); RCE(K[10], K[11]); RCE(K[12], K[13]); RCE(K[14], K[15]); } while (0)
#define RKEYS(K, V0, V1, IDB) do { _Pragma("unroll") for (int e = 0; e < 8; ++e) { K[e] = __uint_as_float(__float_as_uint((float)V0[e]) | (unsigned)((IDB) + e)); K[8 + e] = __uint_as_float(__float_as_uint((float)V1[e]) | (unsigned)((IDB) + 8 + e)); } } while (0)
        for (int tb4 = gw * 4; tb4 < T; tb4 += NGW * 4) {
            v4u r0[4], r1[4]; float sq[4];
#pragma unroll
            for (int i = 0; i < 4; ++i) { const GAS v4u* ar = (const GAS v4u*)(A + (size_t)(tb4 + i) * D + 16 * lane); r0[i] = ar[0]; r1[i] = ar[1]; sq[i] = lane < 16 ? SSQ2[(size_t)(tb4 + i) * 16 + lane] : 0.f; }
#pragma unroll
            for (int i = 0; i < 4; ++i) {
                float a[16];
                a[0] = bflo(r0[i].x); a[1] = bfhi(r0[i].x); a[2] = bflo(r0[i].y); a[3] = bfhi(r0[i].y); a[4] = bflo(r0[i].z); a[5] = bfhi(r0[i].z); a[6] = bflo(r0[i].w); a[7] = bfhi(r0[i].w);
                a[8] = bflo(r1[i].x); a[9] = bfhi(r1[i].x); a[10] = bflo(r1[i].y); a[11] = bfhi(r1[i].y); a[12] = bflo(r1[i].z); a[13] = bfhi(r1[i].z); a[14] = bflo(r1[i].w); a[15] = bfhi(r1[i].w);
                float amx = 0.f;
#pragma unroll
                for (int k = 0; k < 16; ++k) amx = fmaxf(amx, fabsf(a[k]));
                amx = wave_max(amx);
                const float rs2 = rsqrtf(wave_sum(sq[i]) * (1.f / 1024.f) + RMS_EPS);
                const float asc = amx > 0.f ? 127.f / amx : 1.f;
                v4u qv;
#define QP4(k) ((unsigned)((int)rintf(a[4 * (k)] * asc) + 128) | ((unsigned)((int)rintf(a[4 * (k) + 1] * asc) + 128) << 8) | ((unsigned)((int)rintf(a[4 * (k) + 2] * asc) + 128) << 16) | ((unsigned)((int)rintf(a[4 * (k) + 3] * asc) + 128) << 24))
                qv.x = QP4(0); qv.y = QP4(1); qv.z = QP4(2); qv.w = QP4(3);
#undef QP4
                { v4u pq;
                  pq.x = (unsigned)__shfl_xor((int)qv.x, 32); pq.y = (unsigned)__shfl_xor((int)qv.y, 32); pq.z = (unsigned)__shfl_xor((int)qv.z, 32); pq.w = (unsigned)__shfl_xor((int)qv.w, 32);
                  const bool lo_ = lane < 32; const v4u m_ = lo_ ? qv : pq, p_ = lo_ ? pq : qv;
                  v4u ov;
#define NP(m, p) (lo_ ? (((m) & 0x0f0f0f0fu) | (((p) & 0x0f0f0f0fu) << 4)) : ((((m) >> 4) & 0x0f0f0f0fu) | ((p) & 0xf0f0f0f0u)))
                  ov.x = NP(m_.x, p_.x); ov.y = NP(m_.y, p_.y); ov.z = NP(m_.z, p_.z); ov.w = NP(m_.w, p_.w);
#undef NP
                  *(GAS v4u*)(A8I + (size_t)(tb4 + i) * 1024 + 16 * lane) = ov; }
                float sa = 0.f;
#pragma unroll
                for (int k = 0; k < 16; ++k) sa += rintf(a[k] * asc);
                sa = wave_sum(sa);
                if (lane == 0) { ASC[tb4 + i] = (amx > 0.f ? amx * (1.f / 127.f) : 1.f) * rs2; ASC[T + tb4 + i] = sa + 131072.f; }
            }
        }
        LAS unsigned char* idl = L + RING_OFF + tid * 32;
        for (int task = gt; task < T * 8; task += NGT) {
            const int t = task >> 3, h = task & 7;
            const _Float16* row = SC + (size_t)t * 2048 + h * 256;
            float LA[16], LB[16];
#pragma unroll 1
            for (int p = 0; p < 2; ++p) {
                const _Float16* rp = row + p * 128;
                float Tk[16];
                h8 n0 = *(const h8*)(rp + 16), n1 = *(const h8*)(rp + 24);
                { const h8 v0 = *(const h8*)rp, v1 = *(const h8*)(rp + 8); RKEYS(Tk, v0, v1, 0); RSORT16(Tk); }
#pragma unroll 1
                for (int c = 1; c < 8; ++c) {
                    const h8 v0 = n0, v1 = n1;
                    { const int cn = c < 7 ? c + 1 : c; n0 = *(const h8*)(rp + cn * 16); n1 = *(const h8*)(rp + cn * 16 + 8); }
                    float K[16]; RKEYS(K, v0, v1, c * 16); RSORT16(K);
#pragma unroll
                    for (int i = 0; i < 16; ++i) Tk[i] = fmax_asm(Tk[i], K[15 - i]);
                    RMERGE16(Tk);
                }
#pragma unroll
                for (int k = 0; k < 16; ++k) { if (p == 0) LA[k] = Tk[k]; else LB[k] = Tk[k]; }
            }
#pragma unroll
            for (int k = 0; k < 16; k += 4) {
                ((LAS unsigned*)idl)[k >> 2] = (__float_as_uint(LA[k]) & 127u) | ((__float_as_uint(LA[k + 1]) & 127u) << 8) | ((__float_as_uint(LA[k + 2]) & 127u) << 16) | ((__float_as_uint(LA[k + 3]) & 127u) << 24);
                ((LAS unsigned*)idl)[4 + (k >> 2)] = (__float_as_uint(LB[k]) & 127u) | ((__float_as_uint(LB[k + 1]) & 127u) << 8) | ((__float_as_uint(LB[k + 2]) & 127u) << 16) | ((__float_as_uint(LB[k + 3]) & 127u) << 24);
            }
#define CKEY(a, b) __uint_as_float((__float_as_uint(LA[a] + LB[b]) & ~255u) | (unsigned)(255 - (16 * (a) + (b))))
            float Ck[16];
#pragma unroll
            for (int a = 0; a < 16; ++a) Ck[a] = CKEY(a, 0);
#define CRUN(b, n) do { _Pragma("unroll") for (int j = 0; j < (n); ++j) Ck[15 - j] = fmax_asm(Ck[15 - j], CKEY(j, b)); RMERGE16(Ck); } while (0)
            CRUN(1, 8); CRUN(2, 5); CRUN(3, 4); CRUN(4, 3); CRUN(5, 2); CRUN(6, 2); CRUN(7, 2);
#pragma unroll
            for (int j = 0; j < 8; ++j) Ck[15 - j] = fmax_asm(Ck[15 - j], CKEY(0, 8 + j));
            RMERGE16(Ck);
#undef CRUN
#undef CKEY
            LDS_WAIT();
            float ex[16]; float sum = 0.f;
#pragma unroll
            for (int k = 0; k < 16; ++k) { ex[k] = __expf(Ck[k] - Ck[0]); sum += ex[k]; }
            const float rs = 1.f / sum;
            int* eo = EIDX + (size_t)t * 128 + h * 16;
#pragma unroll
            for (int k = 0; k < 16; k += 4) {
                int ev[4];
#pragma unroll
                for (int j = 0; j < 4; ++j) { const unsigned id = 255u - (__float_as_uint(Ck[k + j]) & 255u); ev[j] = (int)idl[id >> 4] * 128 + (int)idl[16 + (id & 15u)]; }
                *(GAS v4u*)(eo + k) = (v4u){(pk2(0.f, ex[k] * rs) & 0xffff0000u) | (unsigned)ev[0], (pk2(0.f, ex[k + 1] * rs) & 0xffff0000u) | (unsigned)ev[1],
                                             (pk2(0.f, ex[k + 2] * rs) & 0xffff0000u) | (unsigned)ev[2], (pk2(0.f, ex[k + 3] * rs) & 0xffff0000u) | (unsigned)ev[3]};
            }
            LDS_WAIT();
        }
#undef RCE
#undef RSORT16
#undef RMERGE16
#undef RKEYS
    }
    xcd_barrier(bar); TSTAMP();

    asm volatile("; ===== PHASE 13 =====");
    if (PH(13)) for (int rep = 0; rep < NREP(13); ++rep) {
        PH_LANES; const bool dummy = rep < NREP(13) - 1; (void)dummy;
        volatile LAS unsigned* qslot = (volatile LAS unsigned*)(L + LDSCTL_OFF + 64);
        LAS unsigned char* tile = L + RING_OFF + wave * 16384;
        LAS float* rsl = (LAS float*)(L + UL_OFF + wave * UL_WAVE);
        LAS v2u* lst = (LAS v2u*)(L + UL_OFF + wave * UL_WAVE + 128);
        const int xs = (int)(xb_xcc_id() & 7u);
        __syncthreads();
        if (tid == 0) *qslot = __hip_atomic_fetch_add((unsigned*)(ctl + CW_Q + 64 * (rep * 8 + xs)), 1u, __ATOMIC_RELAXED, __HIP_MEMORY_SCOPE_AGENT);
        __syncthreads();
        const int rank = __builtin_amdgcn_readfirstlane((int)*qslot);
        int cnt[8];
#pragma unroll
        for (int j = 0; j < 8; ++j) cnt[j] = __builtin_amdgcn_readfirstlane((int)(xb_ld(bar.bar + XB_XCNT(j)) + xb_ld(bar.bar + XB_XCNT(j + 8))));
#pragma unroll 1
        for (int x = 0; x < 8; ++x) {
            int cn = 0;
#pragma unroll
            for (int j = 0; j < 8; ++j) cn = (j == x) ? cnt[j] : cn;
            int j0, jstep;
            if (x == xs) { j0 = rank * 8 + wave; jstep = cn * 8; } else if (cn == 0) { j0 = bx * 8 + wave; jstep = G * 8; } else continue;
#pragma unroll 1
            for (int job = j0; job < T / 16; job += jstep) {
                const int t0 = job * 16;
#pragma unroll 1
                for (int r0 = 0;; r0 += UL_CAP) {
                    int ln = lane; asm volatile("" : "+v"(ln));
#pragma unroll
                    for (int tl = 0; tl < 16; ++tl)
                        __builtin_amdgcn_global_load_lds((const unsigned*)(A8I + (size_t)(t0 + tl) * 1024 + ln * 16), (LAS unsigned*)(tile + tl * 1024), 16, 0, 0);
                    if (ln < 32) rsl[ln] = ASC[(ln & 16) * (T / 16) + t0 + (ln & 15)];
                    int total = 0;
#pragma unroll
                    for (int hb = 0; hb < 2; ++hb) {
                        unsigned pa[8], pb[8];
#pragma unroll
                        for (int tl = 0; tl < 8; ++tl) { pa[tl] = (unsigned)EIDX[(size_t)(t0 + hb * 8 + tl) * 128 + ln]; pb[tl] = (unsigned)EIDX[(size_t)(t0 + hb * 8 + tl) * 128 + 64 + ln]; }
#pragma unroll
                        for (int tl = 0; tl < 8; ++tl) {
                            const bool h0 = (int)((pa[tl] & 0xffffu) >> 11) == x, h1 = (int)((pb[tl] & 0xffffu) >> 11) == x;
                            const unsigned long long m0 = __ballot(h0), m1 = __ballot(h1);
                            const int k0 = total - r0 + (int)__builtin_amdgcn_mbcnt_hi((unsigned)(m0 >> 32), __builtin_amdgcn_mbcnt_lo((unsigned)m0, 0u));
                            const int k1 = total - r0 + __popcll(m0) + (int)__builtin_amdgcn_mbcnt_hi((unsigned)(m1 >> 32), __builtin_amdgcn_mbcnt_lo((unsigned)m1, 0u));
                            if (h0 && k0 >= 0 && k0 < UL_CAP) lst[k0] = (v2u){pa[tl], (unsigned)(((hb * 8 + tl) << 7) | ln)};
                            if (h1 && k1 >= 0 && k1 < UL_CAP) lst[k1] = (v2u){pb[tl], (unsigned)(((hb * 8 + tl) << 7) | 64 | ln)};
                            total += __popcll(m0) + __popcll(m1);
                        }
                    }
                    asm volatile("s_waitcnt vmcnt(0)" ::: "memory");
                    const int count = (total - r0) < UL_CAP ? (total - r0) : UL_CAP;
                    asm volatile("s_waitcnt lgkmcnt(0)" ::: "memory");
#define JLOAD(Q, EN, B16) do { const int myi_ = (B16) + (lane >> 2); EN = lst[myi_ < count ? myi_ : count - 1];         \
                        const unsigned char* rp_ = U8 + (size_t)(EN.x & 0xffffu) * 512 + (lane & 3) * 16; \
                        EN##s = *(const GAS f32x3*)(SU + 4 * (EN.x & 0xffffu));                                             \
                        _Pragma("unroll") for (int j = 0; j < 8; ++j) Q[j] = *(const GAS v4u*)(rp_ + j * 64); } while (0)
#define UD8(w, aa, acc) __builtin_amdgcn_udot8((unsigned)(w), (unsigned)(aa), (unsigned)(acc), false)
#define JCOMP(Q, EN, B16) do { const LAS unsigned char* ap_ = tile + (EN.y >> 7) * 1024 + (lane & 3) * 16; unsigned d0 = 0, d1 = 0, d2 = 0, d3 = 0, g0 = 0, g1 = 0, g2 = 0, g3 = 0; \
                        _Pragma("unroll") for (int j = 0; j < 8; ++j) { const v4u ql_ = *(const LAS v4u*)(ap_ + j * 64), qh_ = *(const LAS v4u*)(ap_ + 512 + j * 64);        \
                            d0 = UD8(Q[j].x, ql_.x, d0); d1 = UD8(Q[j].y, ql_.y, d1); d2 = UD8(Q[j].z, ql_.z, d2); d3 = UD8(Q[j].w, ql_.w, d3); \
                            g0 = UD8(Q[j].x, qh_.x, g0); g1 = UD8(Q[j].y, qh_.y, g1); g2 = UD8(Q[j].z, qh_.z, g2); g3 = UD8(Q[j].w, qh_.w, g3); } \
                        int doti = (int)(((d0 + d1) + (d2 + d3)) + ((((g0 + g1) + (g2 + g3))) << 4));                       \
                        doti += __builtin_amdgcn_mov_dpp(doti, 0xB1, 0xf, 0xf, true); doti += __builtin_amdgcn_mov_dpp(doti, 0x4E, 0xf, 0xf, true);        \
                        {                                                                                               \
                            const int e = (int)(EN.x & 0xffffu), slot = (int)(EN.y & 127u); const int tl_ = (int)(EN.y >> 7); const int t = t0 + tl_; \
                            const float dq = ((float)doti - 128.f * EN##s.z) - (8.f * rsl[16 + tl_] - 1048576.f);               \
                            const float act = dq * (EN##s.x * rsl[tl_]); const float u3 = 0.7978845608028654f * (act + 0.044715f * act * act * act); \
                            const float wv = act * __builtin_amdgcn_rcpf(1.f + __expf(-2.f * u3)) * (__uint_as_float(EN.x & 0xffff0000u) * EN##s.y);             \
                            (void)t; (void)slot; const int oi_ = (B16) + (lane >> 2); ((LAS unsigned*)lst)[2 * (oi_ < count ? oi_ : UL_CAP)] = ((unsigned)__builtin_bit_cast(unsigned short, (_Float16)wv) << 16) | (unsigned)e;     } } while (0)
                    if (count > 0) {
                        v4u qa[8], qb[8], qc[8], qd[8]; v2u ena, enb, enc, end_; f32x3 enas, enbs, encs, end_s;
                        int b16 = 0;
                        if (96 < count) {
                            JLOAD(qa, ena, 0); asm volatile("" ::: "memory"); JLOAD(qb, enb, 16); asm volatile("" ::: "memory"); JLOAD(qc, enc, 32); asm volatile("" ::: "memory");
#pragma unroll 1
                            for (; b16 + 96 < count; b16 += 64) {
                                JLOAD(qd, end_, b16 + 48); JCOMP(qa, ena, b16);
                                JLOAD(qa, ena, b16 + 64); JCOMP(qb, enb, b16 + 16);
                                JLOAD(qb, enb, b16 + 80); JCOMP(qc, enc, b16 + 32);
                                JLOAD(qc, enc, b16 + 96); JCOMP(qd, end_, b16 + 48);
                            }
                        } else {
                            JLOAD(qa, ena, 0);
                            if (16 < count) JLOAD(qb, enb, 16);
                            if (32 < count) JLOAD(qc, enc, 32);
                        }
#pragma unroll 1
                        for (; b16 < count; b16 += 64) {
                            if (b16 + 48 < count) JLOAD(qd, end_, b16 + 48);
                            JCOMP(qa, ena, b16);
                            if (b16 + 16 < count) { if (b16 + 64 < count) JLOAD(qa, ena, b16 + 64); JCOMP(qb, enb, b16 + 16); }
                            if (b16 + 32 < count) { if (b16 + 80 < count) JLOAD(qb, enb, b16 + 80); JCOMP(qc, enc, b16 + 32); }
                            if (b16 + 48 < count) { if (b16 + 96 < count) JLOAD(qc, enc, b16 + 96); JCOMP(qd, end_, b16 + 48); }
                        }
                        asm volatile("s_waitcnt lgkmcnt(0)" ::: "memory");
#pragma unroll 1
                        for (int i = lane; i < count; i += 64) { const v2u en_ = lst[i]; const int t = t0 + (int)(en_.y >> 7), slot = (int)(en_.y & 127u);
                            PW[((size_t)((t >> 6) * 8 + (slot >> 4)) * 4 + ((slot >> 2) & 3)) * 256 + (t & 63) * 4 + (slot & 3)] = en_.x; }
                    }
#undef UD8
#undef JLOAD
#undef JCOMP
                    asm volatile("s_waitcnt lgkmcnt(0)" ::: "memory");
                    if (r0 + UL_CAP >= total) break;
                }
            }
        }
        __syncthreads();
    }
    xcd_barrier(bar); TSTAMP();

    asm volatile("; ===== PHASE 14 =====");
    if (PH(14)) for (int rep = 0; rep < NREP(14); ++rep) {
        PH_LANES; const bool dummy = rep < NREP(14) - 1; (void)dummy;
        for (int item = vcu; item < 256; item += G) {
            const int sl = item & 127, half = item >> 7;
            __syncthreads();
#pragma unroll
            for (int i = 0; i < 16; ++i) *(LAS v4u*)(L + RING_OFF + (i * 512 + tid) * 16) = *(const GAS v4u*)(V8T + (size_t)sl * 131072 + (size_t)(i * 512 + tid) * 16);
            __syncthreads();
            const GAS v4u* pwb = (const GAS v4u*)(PW + (size_t)(half * 256 + wave) * 8192) + lane;
            v4u buf[4][4];
#pragma unroll
            for (int c = 0; c < 4; ++c)
#pragma unroll
                for (int k = 0; k < 4; ++k) buf[c][k] = pwb[c * 256 + k * 64];
#pragma unroll 1
            for (int itk = 0; itk < 32; ++itk) {
                const int g64 = half * 256 + itk * 8 + wave;
                const int t = g64 * 64 + lane;
                unsigned accu[4] = {0u, 0u, 0u, 0u};
#pragma unroll
                for (int c = 0; c < 8; ++c) {
                    v4u cur[4];
#pragma unroll
                    for (int k = 0; k < 4; ++k) cur[k] = buf[c & 3][k];
                    { const int sn = itk * 8 + c + 4; const int gn = (sn >> 3) > 31 ? 31 : (sn >> 3), cc = sn & 7; const GAS v4u* src = pwb + (size_t)gn * 8 * 2048 + cc * 256;
#pragma unroll
                      for (int k = 0; k < 4; ++k) buf[c & 3][k] = src[k * 64]; }
                    v2u tb[16];
#pragma unroll
                    for (int k = 0; k < 4; ++k)
#pragma unroll
                        for (int i = 0; i < 4; ++i) { unsigned e_ = cur[k][i] & 0xffffu; asm("" : "+v"(e_));
                            tb[k * 4 + i] = *(const LAS v2u*)(L + RING_OFF + (e_ << 3)); }
#pragma unroll
                    for (int k = 0; k < 4; ++k)
#pragma unroll
                        for (int i = 0; i < 4; ++i) { const unsigned p = cur[k][i]; const v2u q = tb[k * 4 + i];
#define VFMA(ACC, T) asm("v_pk_fma_f16 %0, %1, %2, %0 op_sel:[0,1,0] op_sel_hi:[1,1,1]" : "+v"(ACC) : "v"(T), "v"(p))
                            const unsigned t0_ = __builtin_amdgcn_perm(0u, q.x, 0x010c000cu), t1_ = __builtin_amdgcn_perm(0u, q.x, 0x030c020cu), t2_ = __builtin_amdgcn_perm(0u, q.y, 0x010c000cu), t3_ = __builtin_amdgcn_perm(0u, q.y, 0x030c020cu);
                            VFMA(accu[0], t0_); VFMA(accu[1], t1_); VFMA(accu[2], t2_); VFMA(accu[3], t3_);
#undef VFMA
                        }
                }
                GAS v4u* hr = (GAS v4u*)(A + (size_t)t * D + sl * 8);
                const v4u hq = *hr; const float mulv = dummy ? 0.f : 1.f;
                h2v acc[4];
#pragma unroll
                for (int i = 0; i < 4; ++i) { const unsigned au_ = accu[i]; acc[i] = __builtin_bit_cast(h2v, au_); }
                v4u ho; ho.x = pk2(bflo(hq.x) + (float)acc[0].x * mulv, bfhi(hq.x) + (float)acc[0].y * mulv); ho.y = pk2(bflo(hq.y) + (float)acc[1].x * mulv, bfhi(hq.y) + (float)acc[1].y * mulv);
                ho.z = pk2(bflo(hq.z) + (float)acc[2].x * mulv, bfhi(hq.z) + (float)acc[2].y * mulv); ho.w = pk2(bflo(hq.w) + (float)acc[3].x * mulv, bfhi(hq.w) + (float)acc[3].y * mulv);
                *hr = ho;
            }
        }
    }
    xcd_barrier(bar); TSTAMP();

#ifdef EXTRA_BARRIERS
    for (int eb = 0; eb < EXTRA_BARRIERS; ++eb) xcd_barrier(bar);
#endif
    asm volatile("; ===== PHASE 15 =====");
    if (PH(15)) for (int rep = 0; rep < NREP(15); ++rep) {
        PH_LANES; const bool dummy = rep < NREP(15) - 1; (void)dummy;
        for (int t = gw; t < T; t += NGW) {
            const GAS v4u* hr = (const GAS v4u*)(A + (size_t)t * D + 16 * lane); const v4u q0 = hr[0], q1 = hr[1];
            const GAS f32x4* gr = (const GAS f32x4*)(g_final + 16 * lane); GAS f32x4* orow = (GAS f32x4*)(out + (size_t)t * D + 16 * lane);
            f32x4 o[4] = {(f32x4){bflo(q0.x), bfhi(q0.x), bflo(q0.y), bfhi(q0.y)}, (f32x4){bflo(q0.z), bfhi(q0.z), bflo(q0.w), bfhi(q0.w)},
                          (f32x4){bflo(q1.x), bfhi(q1.x), bflo(q1.y), bfhi(q1.y)}, (f32x4){bflo(q1.z), bfhi(q1.z), bflo(q1.w), bfhi(q1.w)}};
            float ss = 0.f;
#pragma unroll
            for (int j = 0; j < 4; ++j) ss += (o[j].x * o[j].x + o[j].y * o[j].y) + (o[j].z * o[j].z + o[j].w * o[j].w);
            const float r = rsqrtf(wave_sum(ss) * (1.f / 1024.f) + RMS_EPS);
#pragma unroll
            for (int j = 0; j < 4; ++j) orow[j] = o[j] * r * gr[j];
        }
    }
}

extern "C" void kernel_launch(void* const* d_in, const int* in_sizes, int n_in, void* d_out, int out_size, void* d_ws, size_t ws_size, hipStream_t stream) {
    static int grid = 0;
    if (grid == 0) {
        if (n_in != 19 || out_size != T * D || ws_size < WS_END) { fprintf(stderr, "kernel_launch: unexpected problem (n_in %d, out %d, ws %zu < %zu); nothing launched\n", n_in, out_size, ws_size, (size_t)WS_END); grid = -1; return; }
        int dev = 0, cus = 0, per_cu = 0;
        if (hipGetDevice(&dev) != hipSuccess || hipDeviceGetAttribute(&cus, hipDeviceAttributeMultiprocessorCount, dev) != hipSuccess) { grid = -1; return; }
        if (hipFuncSetAttribute((const void*)mk_fwd, hipFuncAttributeMaxDynamicSharedMemorySize, LDS_BYTES) != hipSuccess) { fprintf(stderr, "kernel_launch: hipFuncSetAttribute failed\n"); grid = -1; return; }
        if (hipOccupancyMaxActiveBlocksPerMultiprocessor(&per_cu, (const void*)mk_fwd, NWAVES * 64, LDS_BYTES) != hipSuccess || per_cu < 1) { fprintf(stderr, "kernel_launch: occupancy query says %d blocks per CU\n", per_cu); }
        (void)hipGetLastError();
        grid = cus;
    }
    if (grid < 0) return;
    if (hipMemsetAsync((char*)d_ws + WS_CTL, 0, CTL_ZERO_BYTES, stream) != hipSuccess) return;
    Args a{};
    for (int i = 0; i < 19; ++i) a.in[i] = (const float*)d_in[i];
    a.out = (float*)d_out; a.ws = (unsigned char*)d_ws;
    hipLaunchKernelGGL(mk_fwd, dim3(grid), dim3(NWAVES * 64), LDS_BYTES, stream, a);
}
```

```cpp
#include <hip/hip_runtime.h>
#include <hip/hip_bf16.h>
#include <cstdio>
#include <cstdint>
#include <cmath>

#ifndef DIAG
#define DIAG 0
#endif


template <int O> __device__ __forceinline__ float shx(float v) { static_assert(O > 0 && O < 32, "shx"); return __uint_as_float((unsigned)__builtin_amdgcn_ds_swizzle((int)__float_as_uint(v), (O << 10) | 0x1f)); }
__device__ __forceinline__ float sum32(float v) { auto r = __builtin_amdgcn_permlane32_swap(__float_as_uint(v), __float_as_uint(v), false, false); return __uint_as_float(r[0]) + __uint_as_float(r[1]); }
__device__ __forceinline__ float max32(float v) { auto r = __builtin_amdgcn_permlane32_swap(__float_as_uint(v), __float_as_uint(v), false, false); return fmaxf(__uint_as_float(r[0]), __uint_as_float(r[1])); }
__device__ __forceinline__ float wave_max(float v) { v = fmaxf(v, shx<1>(v)); v = fmaxf(v, shx<2>(v)); v = fmaxf(v, shx<4>(v)); v = fmaxf(v, shx<8>(v)); v = fmaxf(v, shx<16>(v)); return max32(v); }
__device__ __forceinline__ float wave_sum(float v) { v += shx<1>(v); v += shx<2>(v); v += shx<4>(v); v += shx<8>(v); v += shx<16>(v); return sum32(v); }

namespace pg8 {
#define PG8_LAS __attribute__((address_space(3)))
typedef unsigned short bf16_t;
typedef short bf16x8 __attribute__((ext_vector_type(8)));
typedef float f32x4 __attribute__((ext_vector_type(4)));
typedef float f32x2 __attribute__((ext_vector_type(2)));
typedef unsigned u32x4 __attribute__((ext_vector_type(4)));
typedef unsigned u32x2 __attribute__((ext_vector_type(2)));
constexpr int BM = 256, BK = 64, HALF = 128, HTB = HALF * BK * 2  , STAGE_BYTES = 8 * HTB, NXCD = 8, WGM = 4;

__host__ __device__ __forceinline__ int lds_byte(int r, int c) { const int st = (r >> 4) * 2 + (c >> 5), rr = r & 15, cc = c & 31, ob = rr * 64 + cc * 2; return st * 1024 + (ob ^ (((ob >> 9) & 1) << 5)); }
__host__ __device__ __forceinline__ void stage_rc(int b, int& R, int& C) { const int st = b / 1024, sb = b % 1024, swz = sb ^ (((sb >> 9) & 1) << 5); R = (st >> 1) * 16 + swz / 64; C = (st & 1) * 32 + (swz % 64) / 2; }
__host__ __device__ __forceinline__ int perm32(int rho) { const int n = rho >> 4, i = rho & 15; return 8 * (i >> 2) + 4 * n + (i & 3); }

struct Unit { int pm, pn; const char* a; const char* b; };
struct Gemm { int lda, ldb, K; };

struct StaticOrder {
    int nM, nN, nwg, G, c; const char* A; const char* Bt; size_t astep, bstep;
    __device__ void init(const void* A_, int lda, const void* Bt_, int ldb, int M, int N, int G_, int c_) { nM = M / BM; nN = N / BM; nwg = nM * nN; G = G_; c = c_; A = (const char*)A_; Bt = (const char*)Bt_; astep = (size_t)BM * lda * 2; bstep = (size_t)BM * ldb * 2; }
    __device__ bool next(int i, Unit& u) const {
        const long L = (long)i * G + c; if (L >= nwg) return false;
        int wgid = (int)L; { const int q = nwg / NXCD, r = nwg % NXCD, xcd = wgid % NXCD, off = wgid / NXCD; wgid = (xcd < r ? xcd * (q + 1) : r * (q + 1) + (xcd - r) * q) + off; }
        const int nig = WGM * nN, gid = wgid / nig, fm = gid * WGM, gsz = (nM - fm) < WGM ? (nM - fm) : WGM;
        u.pm = fm + ((wgid % nig) % gsz); u.pn = (wgid % nig) / gsz; u.a = A + (size_t)u.pm * astep; u.b = Bt + (size_t)u.pn * bstep; return true;
    }
};

__device__ __forceinline__ unsigned cvt_pk_bf16(float lo, float hi) { typedef __bf16 bf2 __attribute__((ext_vector_type(2))); f32x2 v = {lo, hi}; bf2 b = __builtin_convertvector(v, bf2); return __builtin_bit_cast(unsigned, b); }
__device__ __forceinline__ float bf_lo(unsigned u) { return __uint_as_float(u << 16); }
__device__ __forceinline__ float bf_hi(unsigned u) { return __uint_as_float(u & 0xffff0000u); }

template <class Epi, class Sched, bool ALIGN_EPI>
__device__ __forceinline__ void gemm_phase(PG8_LAS unsigned char* lds, const Gemm g, const Sched& S, const Epi& E) {
    int tid = threadIdx.x; asm volatile("" : "+v"(tid));
    const int wid = __builtin_amdgcn_readfirstlane(tid >> 6), lane = tid & 63, wr = wid >> 2, wc = wid & 3, fr = lane & 15, fq = lane >> 4;
    const int K = g.K, nt = K / BK;
    unsigned voffA[2], voffB[2];
#pragma unroll
    for (int i = 0; i < 2; ++i) { int R, C; stage_rc(tid * 16 + i * 8192, R, C); const int Rb = Epi::PERM ? ((R & ~31) + perm32(R & 31)) : R;
        voffA[i] = (unsigned)(R * g.lda + C) * 2u; voffB[i] = (unsigned)(Rb * g.ldb + C) * 2u; }
    const size_t kstep = (size_t)(BK * 2);
    const size_t hstepA = (size_t)HALF * g.lda * 2, hstepB = (size_t)HALF * g.ldb * 2;
    const unsigned ldsw = (unsigned)wid * 1024u;
    const int aoff = lds_byte(wr * 64 + fr, fq * 8), boff = lds_byte(wc * 32 + fr, fq * 8);
#define PG8_SA(b, h) (((b) * 2 + (h)) * HTB)
#define PG8_SB(b, h) ((4 + (b) * 2 + (h)) * HTB)
#define PG8_STAGE(bufoff, gbase, voff) do { _Pragma("unroll") for (int _i = 0; _i < 2; ++_i) \
        __builtin_amdgcn_global_load_lds((const unsigned*)((const char*)(gbase) + (voff)[_i]), (PG8_LAS unsigned*)(lds + (bufoff) + ldsw + _i * 8192), 16, 0, 0); } while (0)
#define PG8_LDA(dst, b, h) do { _Pragma("unroll") for (int m = 0; m < 4; ++m) _Pragma("unroll") for (int k = 0; k < 2; ++k) dst[m][k] = *(const PG8_LAS bf16x8*)(lds + PG8_SA(b, h) + aoff + m * 2048 + k * 1024); } while (0)
#define PG8_LDB(dst, b, h) do { _Pragma("unroll") for (int n = 0; n < 2; ++n) _Pragma("unroll") for (int k = 0; k < 2; ++k) dst[n][k] = *(const PG8_LAS bf16x8*)(lds + PG8_SB(b, h) + boff + n * 2048 + k * 1024); } while (0)
#define PG8_MMA(ai, bj, At, Bt) do { __builtin_amdgcn_s_setprio(1); _Pragma("unroll") for (int m = 0; m < 4; ++m) _Pragma("unroll") for (int n = 0; n < 2; ++n) _Pragma("unroll") for (int k = 0; k < 2; ++k) \
        acc[ai][bj][m][n] = __builtin_amdgcn_mfma_f32_16x16x32_bf16(Bt[n][k], At[m][k], acc[ai][bj][m][n], 0, 0, 0); __builtin_amdgcn_s_setprio(0); } while (0)
#define PG8_WAIT_V(n) asm volatile("s_waitcnt vmcnt(" #n ")" ::: "memory")
#define PG8_WAIT_L(n) asm volatile("s_waitcnt lgkmcnt(" #n ")" ::: "memory")
#define PG8_BAR __builtin_amdgcn_s_barrier()
#define PG8_SCHED __builtin_amdgcn_sched_barrier(0)
    Unit cur, nxt; int ui = 0;
    if (!S.next(0, cur)) return;
    f32x4 acc[2][2][4][2];
#pragma unroll
    for (int a = 0; a < 2; ++a)
#pragma unroll
        for (int b = 0; b < 2; ++b)
#pragma unroll
            for (int m = 0; m < 4; ++m)
#pragma unroll
                for (int n = 0; n < 2; ++n) acc[a][b][m][n] = (f32x4){0.f, 0.f, 0.f, 0.f};
    bf16x8 At[4][2], B0[2][2], B1[2][2];
    const char* cA = cur.a; const char* cB = cur.b;
    PG8_STAGE(PG8_SB(0, 0), cB, voffB); PG8_STAGE(PG8_SB(0, 1), cB + hstepB, voffB); PG8_STAGE(PG8_SA(0, 0), cA, voffA); PG8_STAGE(PG8_SA(0, 1), cA + hstepA, voffA);
    if (wr == 1) PG8_BAR;
    PG8_WAIT_V(2); PG8_BAR;
    PG8_STAGE(PG8_SB(1, 0), cB + kstep, voffB); PG8_STAGE(PG8_SA(1, 0), cA + kstep, voffA); PG8_STAGE(PG8_SB(1, 1), cB + hstepB + kstep, voffB);
    PG8_WAIT_V(6); PG8_BAR;
    for (;;) {
        const bool has_next = S.next(ui + 1, nxt);
        const char* nA = has_next ? nxt.a : cA; const char* nB = has_next ? nxt.b : cB;
        for (int t = 0; t < nt; t += 2) {
            const bool last = (t == nt - 2);
            const char* a1 = cA + (size_t)(t + 1) * kstep;
            const char* a2 = last ? nA : cA + (size_t)(t + 2) * kstep; const char* b2 = last ? nB : cB + (size_t)(t + 2) * kstep;
            const char* a3 = a2 + kstep; const char* b3 = b2 + kstep;
            PG8_LDB(B0, 0, 0); PG8_LDB(B1, 0, 1); PG8_SCHED; PG8_LDA(At, 0, 0); PG8_STAGE(PG8_SA(1, 1), a1 + hstepA, voffA);
            PG8_WAIT_V(8); PG8_WAIT_L(0); PG8_BAR; PG8_MMA(0, 0, At, B0); PG8_MMA(0, 1, At, B1); PG8_BAR; PG8_SCHED;
            PG8_LDA(At, 0, 1); PG8_STAGE(PG8_SB(0, 0), b2, voffB); PG8_STAGE(PG8_SB(0, 1), b2 + hstepB, voffB); PG8_STAGE(PG8_SA(0, 0), a2, voffA);
            PG8_WAIT_V(8); PG8_WAIT_L(0); PG8_BAR; PG8_MMA(1, 0, At, B0); PG8_MMA(1, 1, At, B1); PG8_BAR; PG8_SCHED;
            PG8_LDB(B0, 1, 0); PG8_LDB(B1, 1, 1); PG8_SCHED; PG8_LDA(At, 1, 0); PG8_STAGE(PG8_SA(0, 1), a2 + hstepA, voffA);
            PG8_WAIT_V(8); PG8_WAIT_L(0); PG8_BAR; PG8_MMA(0, 0, At, B0); PG8_MMA(0, 1, At, B1); PG8_BAR; PG8_SCHED;
            PG8_LDA(At, 1, 1); PG8_STAGE(PG8_SB(1, 0), b3, voffB); PG8_STAGE(PG8_SB(1, 1), b3 + hstepB, voffB); PG8_STAGE(PG8_SA(1, 0), a3, voffA);
            PG8_WAIT_V(8); PG8_WAIT_L(0); PG8_BAR; PG8_MMA(1, 0, At, B0); PG8_MMA(1, 1, At, B1); PG8_BAR; PG8_SCHED;
        }
        if constexpr (ALIGN_EPI) { if (wr == 0) PG8_BAR; }
        if constexpr (!Epi::AFTER_DRAIN) { E(acc, cur, wr, wc, fr, fq); }
        if (!has_next) break;
#pragma unroll
        for (int a = 0; a < 2; ++a)
#pragma unroll
            for (int b = 0; b < 2; ++b)
#pragma unroll
                for (int m = 0; m < 4; ++m)
#pragma unroll
                    for (int n = 0; n < 2; ++n) acc[a][b][m][n] = (f32x4){0.f, 0.f, 0.f, 0.f};
        cur = nxt; cA = nA; cB = nB; ++ui;
        if constexpr (ALIGN_EPI) { if (wr == 1) PG8_BAR; }
    }
    PG8_WAIT_V(0);
    if constexpr (!ALIGN_EPI) { if (wr == 0) PG8_BAR; }
    PG8_BAR;
    if constexpr (Epi::AFTER_DRAIN) { E.fused(acc, cur, wr, wc, fr, fq, lds, wid, lane); }
#undef PG8_SA
#undef PG8_SB
#undef PG8_STAGE
#undef PG8_LDA
#undef PG8_LDB
#undef PG8_MMA
#undef PG8_WAIT_V
#undef PG8_WAIT_L
#undef PG8_BAR
#undef PG8_SCHED
}

typedef f32x4 AccT[2][2][4][2];

struct EpiBf16 {
    static constexpr bool PERM = true, AFTER_DRAIN = false;
    bf16_t* O; int ldc;
    __device__ __forceinline__ void operator()(const AccT& acc, const Unit& u, int wr, int wc, int fr, int fq) const {
        { int t_ = threadIdx.x; asm volatile("" : "+v"(t_)); fr = t_ & 15; fq = (t_ >> 4) & 3; }
        const int row0 = u.pm * BM + wr * 64 + fr, col0 = u.pn * BM + wc * 32 + 8 * fq;
#pragma unroll
        for (int ai = 0; ai < 2; ++ai)
#pragma unroll
            for (int m = 0; m < 4; ++m) { bf16_t* rowp = O + (size_t)(row0 + ai * HALF + m * 16) * ldc + col0;
#pragma unroll
                for (int bj = 0; bj < 2; ++bj) { const f32x4 v0 = acc[ai][bj][m][0], v1 = acc[ai][bj][m][1];
                    u32x4 w; w.x = cvt_pk_bf16(v0[0], v0[1]); w.y = cvt_pk_bf16(v0[2], v0[3]); w.z = cvt_pk_bf16(v1[0], v1[1]); w.w = cvt_pk_bf16(v1[2], v1[3]);
                    *(u32x4*)(rowp + bj * HALF) = w; } }
    }
};
struct EpiF16 {
    static constexpr bool PERM = true, AFTER_DRAIN = false;
    _Float16* O; int ldc;
    __device__ __forceinline__ void operator()(const AccT& acc, const Unit& u, int wr, int wc, int fr, int fq) const {
        { int t_ = threadIdx.x; asm volatile("" : "+v"(t_)); fr = t_ & 15; fq = (t_ >> 4) & 3; }
        typedef _Float16 h8 __attribute__((ext_vector_type(8)));
        const int row0 = u.pm * BM + wr * 64 + fr, col0 = u.pn * BM + wc * 32 + 8 * fq;
#pragma unroll
        for (int ai = 0; ai < 2; ++ai)
#pragma unroll
            for (int m = 0; m < 4; ++m) { _Float16* rowp = O + (size_t)(row0 + ai * HALF + m * 16) * ldc + col0;
#pragma unroll
                for (int bj = 0; bj < 2; ++bj) { const f32x4 v0 = acc[ai][bj][m][0], v1 = acc[ai][bj][m][1];
                    h8 w = {(_Float16)v0[0], (_Float16)v0[1], (_Float16)v0[2], (_Float16)v0[3], (_Float16)v1[0], (_Float16)v1[1], (_Float16)v1[2], (_Float16)v1[3]};
                    *(h8*)(rowp + bj * HALF) = w; } }
    }
};
struct EpiGateMul {
    static constexpr bool PERM = true, AFTER_DRAIN = false;
    const bf16_t* G; bf16_t* Dst; int ldc;
    __device__ __forceinline__ void operator()(const AccT& acc, const Unit& u, int wr, int wc, int fr, int fq) const {
        { int t_ = threadIdx.x; asm volatile("" : "+v"(t_)); fr = t_ & 15; fq = (t_ >> 4) & 3; }
        const int row0 = u.pm * BM + wr * 64 + fr, col0 = u.pn * BM + wc * 32 + 8 * fq;
        u32x4 gqa[2][4][2];
#pragma unroll
        for (int ai = 0; ai < 2; ++ai)
#pragma unroll
            for (int m = 0; m < 4; ++m) { int ro = row0 + ai * HALF + m * 16; asm volatile("" : "+v"(ro)); const bf16_t* rowg = G + (size_t)ro * ldc + col0;
#pragma unroll
                for (int bj = 0; bj < 2; ++bj) gqa[ai][m][bj] = *(const u32x4*)(rowg + bj * HALF); }
        __builtin_amdgcn_sched_barrier(0);
#pragma unroll
        for (int ai = 0; ai < 2; ++ai)
#pragma unroll
            for (int m = 0; m < 4; ++m) { int ro = row0 + ai * HALF + m * 16; asm volatile("" : "+v"(ro)); bf16_t* rowp = Dst + (size_t)ro * ldc + col0;
#pragma unroll
                for (int bj = 0; bj < 2; ++bj) { const f32x4 v0 = acc[ai][bj][m][0], v1 = acc[ai][bj][m][1]; const u32x4 gq = gqa[ai][m][bj];
                    u32x4 w; w.x = cvt_pk_bf16(v0[0] * bf_lo(gq.x), v0[1] * bf_hi(gq.x)); w.y = cvt_pk_bf16(v0[2] * bf_lo(gq.y), v0[3] * bf_hi(gq.y));
                    w.z = cvt_pk_bf16(v1[0] * bf_lo(gq.z), v1[1] * bf_hi(gq.z)); w.w = cvt_pk_bf16(v1[2] * bf_lo(gq.w), v1[3] * bf_hi(gq.w));
                    *(u32x4*)(rowp + bj * HALF) = w; } }
    }
};
struct EpiGateFma {
    static constexpr bool PERM = true, AFTER_DRAIN = false;
    const bf16_t* Tm; const bf16_t* G2; bf16_t* Dst; int ldc;
    __device__ __forceinline__ void operator()(const AccT& acc, const Unit& u, int wr, int wc, int fr, int fq) const {
        { int t_ = threadIdx.x; asm volatile("" : "+v"(t_)); fr = t_ & 15; fq = (t_ >> 4) & 3; }
        const int row0 = u.pm * BM + wr * 64 + fr, col0 = u.pn * BM + wc * 32 + 8 * fq;
#pragma unroll
        for (int ai = 0; ai < 2; ++ai) {
            u32x4 gqa[4][2], tqa[4][2];
#pragma unroll
            for (int m = 0; m < 4; ++m) { int ro = row0 + ai * HALF + m * 16; asm volatile("" : "+v"(ro)); const size_t off = (size_t)ro * ldc + col0;
#pragma unroll
                for (int bj = 0; bj < 2; ++bj) { gqa[m][bj] = *(const u32x4*)(G2 + off + bj * HALF); tqa[m][bj] = *(const u32x4*)(Tm + off + bj * HALF); } }
            __builtin_amdgcn_sched_barrier(0);
#pragma unroll
            for (int m = 0; m < 4; ++m) { int ro = row0 + ai * HALF + m * 16; asm volatile("" : "+v"(ro)); const size_t off = (size_t)ro * ldc + col0;
#pragma unroll
                for (int bj = 0; bj < 2; ++bj) { const f32x4 v0 = acc[ai][bj][m][0], v1 = acc[ai][bj][m][1]; const u32x4 gq = gqa[m][bj]; const u32x4 tq = tqa[m][bj];
                    u32x4 w; w.x = cvt_pk_bf16(bf_lo(tq.x) + v0[0] * bf_lo(gq.x), bf_hi(tq.x) + v0[1] * bf_hi(gq.x)); w.y = cvt_pk_bf16(bf_lo(tq.y) + v0[2] * bf_lo(gq.y), bf_hi(tq.y) + v0[3] * bf_hi(gq.y));
                    w.z = cvt_pk_bf16(bf_lo(tq.z) + v1[0] * bf_lo(gq.z), bf_hi(tq.z) + v1[1] * bf_hi(gq.z)); w.w = cvt_pk_bf16(bf_lo(tq.w) + v1[2] * bf_lo(gq.w), bf_hi(tq.w) + v1[3] * bf_hi(gq.w));
                    *(u32x4*)(Dst + off + bj * HALF) = w; } }
            __builtin_amdgcn_sched_barrier(0);
        }
    }
};
struct EpiResF32 {
    static constexpr bool PERM = false, AFTER_DRAIN = false;
    const float* res; float* out; int ldc; float mul;
    __device__ __forceinline__ void operator()(const AccT& acc, const Unit& u, int wr, int wc, int fr, int fq) const {
        { int t_ = threadIdx.x; asm volatile("" : "+v"(t_)); fr = t_ & 15; fq = (t_ >> 4) & 3; }
        const int row0 = u.pm * BM + wr * 64 + fr, col0 = u.pn * BM + wc * 32 + 4 * fq;
#pragma unroll
        for (int ai = 0; ai < 2; ++ai)
#pragma unroll
            for (int m = 0; m < 4; ++m) { const size_t off = (size_t)(row0 + ai * HALF + m * 16) * ldc + col0;
#pragma unroll
                for (int bj = 0; bj < 2; ++bj)
#pragma unroll
                    for (int n = 0; n < 2; ++n) { const f32x4 r = *(const f32x4*)(res + off + bj * HALF + n * 16); *(f32x4*)(out + off + bj * HALF + n * 16) = r + acc[ai][bj][m][n] * mul; } }
    }
};

__device__ __forceinline__ float row_rs(const float* ssq, int row) {
    const f32x4* p = (const f32x4*)(ssq + (size_t)row * 16); const f32x4 a = p[0], b = p[1], c = p[2], d = p[3];
    const float s = ((a[0] + a[1]) + (a[2] + a[3])) + ((b[0] + b[1]) + (b[2] + b[3])) + ((c[0] + c[1]) + (c[2] + c[3])) + ((d[0] + d[1]) + (d[2] + d[3]));
    return rsqrtf(s * (1.f / 1024.f) + 1e-6f);
}
struct EpiBf16RS {
    static constexpr bool PERM = true, AFTER_DRAIN = false;
    bf16_t* O; int ldc; const float* ssq;
    __device__ __forceinline__ void operator()(const AccT& acc, const Unit& u, int wr, int wc, int fr, int fq) const {
        { int t_ = threadIdx.x; asm volatile("" : "+v"(t_)); fr = t_ & 15; fq = (t_ >> 4) & 3; }
        const int row0 = u.pm * BM + wr * 64 + fr, col0 = u.pn * BM + wc * 32 + 8 * fq;
        float rsa[2][4];
#pragma unroll
        for (int ai = 0; ai < 2; ++ai)
#pragma unroll
            for (int m = 0; m < 4; ++m) { int ro = row0 + ai * HALF + m * 16; asm volatile("" : "+v"(ro)); rsa[ai][m] = row_rs(ssq, ro); }
        __builtin_amdgcn_sched_barrier(0);
#pragma unroll
        for (int ai = 0; ai < 2; ++ai)
#pragma unroll
            for (int m = 0; m < 4; ++m) { int ro = row0 + ai * HALF + m * 16; asm volatile("" : "+v"(ro)); const float rs = rsa[ai][m]; bf16_t* rowp = O + (size_t)ro * ldc + col0;
#pragma unroll
                for (int bj = 0; bj < 2; ++bj) { const f32x4 v0 = acc[ai][bj][m][0] * rs, v1 = acc[ai][bj][m][1] * rs;
                    u32x4 w; w.x = cvt_pk_bf16(v0[0], v0[1]); w.y = cvt_pk_bf16(v0[2], v0[3]); w.z = cvt_pk_bf16(v1[0], v1[1]); w.w = cvt_pk_bf16(v1[2], v1[3]);
                    *(u32x4*)(rowp + bj * HALF) = w; } }
    }
};
struct EpiF16RS {
    static constexpr bool PERM = true, AFTER_DRAIN = false;
    _Float16* O; int ldc; const float* ssq;
    __device__ __forceinline__ void operator()(const AccT& acc, const Unit& u, int wr, int wc, int fr, int fq) const {
        { int t_ = threadIdx.x; asm volatile("" : "+v"(t_)); fr = t_ & 15; fq = (t_ >> 4) & 3; }
        typedef _Float16 h8 __attribute__((ext_vector_type(8)));
        const int row0 = u.pm * BM + wr * 64 + fr, col0 = u.pn * BM + wc * 32 + 8 * fq;
#pragma unroll
        for (int ai = 0; ai < 2; ++ai)
#pragma unroll
            for (int m = 0; m < 4; ++m) { int ro = row0 + ai * HALF + m * 16; asm volatile("" : "+v"(ro)); const float rs = row_rs(ssq, ro); _Float16* rowp = O + (size_t)ro * ldc + col0;
#pragma unroll
                for (int bj = 0; bj < 2; ++bj) { const f32x4 v0 = acc[ai][bj][m][0] * rs, v1 = acc[ai][bj][m][1] * rs;
                    h8 w = {(_Float16)v0[0], (_Float16)v0[1], (_Float16)v0[2], (_Float16)v0[3], (_Float16)v1[0], (_Float16)v1[1], (_Float16)v1[2], (_Float16)v1[3]};
                    *(h8*)(rowp + bj * HALF) = w; } }
    }
};
template <bool RES_F32> struct EpiResNorm {
    static constexpr bool PERM = true, AFTER_DRAIN = false;
    const float* resf; bf16_t* H; float* ssq; int ldc; float mul;
    __device__ __forceinline__ void operator()(const AccT& acc, const Unit& u, int wr, int wc, int fr, int fq) const {
        { int t_ = threadIdx.x; asm volatile("" : "+v"(t_)); fr = t_ & 15; fq = (t_ >> 4) & 3; }
        const int row0 = u.pm * BM + wr * 64 + fr, col0 = u.pn * BM + wc * 32 + 8 * fq;
#pragma unroll
        for (int ai = 0; ai < 2; ++ai) {
            f32x4 ra[RES_F32 ? 4 : 1][2][2]; u32x4 qa[RES_F32 ? 1 : 4][2];
#pragma unroll
            for (int m = 0; m < 4; ++m) { int ro = row0 + ai * HALF + m * 16; asm volatile("" : "+v"(ro)); const size_t off = (size_t)ro * ldc + col0;
#pragma unroll
                for (int bj = 0; bj < 2; ++bj) {
                    if (RES_F32) { ra[RES_F32 ? m : 0][bj][0] = *(const f32x4*)(resf + off + bj * HALF); ra[RES_F32 ? m : 0][bj][1] = *(const f32x4*)(resf + off + bj * HALF + 4); }
                    else qa[RES_F32 ? 0 : m][bj] = *(const u32x4*)(H + off + bj * HALF); } }
            __builtin_amdgcn_sched_barrier(0);
#pragma unroll
            for (int m = 0; m < 4; ++m) { int ro = row0 + ai * HALF + m * 16; asm volatile("" : "+v"(ro)); const size_t off = (size_t)ro * ldc + col0; float ss = 0.f;
#pragma unroll
                for (int bj = 0; bj < 2; ++bj) { f32x4 r0, r1;
                    if (RES_F32) { r0 = ra[RES_F32 ? m : 0][bj][0]; r1 = ra[RES_F32 ? m : 0][bj][1]; }
                    else { const u32x4 q = qa[RES_F32 ? 0 : m][bj]; r0 = (f32x4){bf_lo(q.x), bf_hi(q.x), bf_lo(q.y), bf_hi(q.y)}; r1 = (f32x4){bf_lo(q.z), bf_hi(q.z), bf_lo(q.w), bf_hi(q.w)}; }
                    const f32x4 v0 = r0 + acc[ai][bj][m][0] * mul, v1 = r1 + acc[ai][bj][m][1] * mul;
                    ss += ((v0[0] * v0[0] + v0[1] * v0[1]) + (v0[2] * v0[2] + v0[3] * v0[3])) + ((v1[0] * v1[0] + v1[1] * v1[1]) + (v1[2] * v1[2] + v1[3] * v1[3]));
                    u32x4 w; w.x = cvt_pk_bf16(v0[0], v0[1]); w.y = cvt_pk_bf16(v0[2], v0[3]); w.z = cvt_pk_bf16(v1[0], v1[1]); w.w = cvt_pk_bf16(v1[2], v1[3]);
                    *(u32x4*)(H + off + bj * HALF) = w; }
                ss += shx<16>(ss); ss = sum32(ss);
                if (fq == 0) ssq[(size_t)ro * 16 + u.pn * 4 + wc] = ss; }
            __builtin_amdgcn_sched_barrier(0);
        }
    }
};
struct EpiIn {
    static constexpr bool PERM = true, AFTER_DRAIN = false;
    bf16_t *U, *Bb, *Q, *Kb, *V, *SGC, *SGA; const float* ropec; const float* ropes; float* kbar; float qscale;
    __device__ __forceinline__ void operator()(const AccT& acc, const Unit& u, int wr, int wc, int fr, int fq) const {
        { int t_ = threadIdx.x; asm volatile("" : "+v"(t_)); fr = t_ & 15; fq = (t_ >> 4) & 3; }
        const int pn = u.pn; const int row0 = u.pm * BM + wr * 64 + fr;
        if (pn < 4) {
            const int c0 = 128 * pn + 16 * wc + 4 * fq;
#pragma unroll
            for (int ai = 0; ai < 2; ++ai)
#pragma unroll
                for (int m = 0; m < 4; ++m) { int ro = row0 + ai * HALF + m * 16; asm volatile("" : "+v"(ro)); bf16_t* rowp = U + (size_t)ro * 512 + c0;
#pragma unroll
                    for (int bj = 0; bj < 2; ++bj) { const f32x4 x = acc[ai][bj][m][0] * acc[ai][bj][m][1]; u32x2 w; w.x = cvt_pk_bf16(x[0], x[1]); w.y = cvt_pk_bf16(x[2], x[3]); *(u32x2*)(rowp + bj * 64) = w; } }
        } else if (pn < 6 || (pn >= 10 && pn < 12)) {
            bf16_t* O = pn < 6 ? Bb : V; const int col0 = (pn < 6 ? pn - 4 : pn - 10) * BM + wc * 32 + 8 * fq;
#pragma unroll
            for (int ai = 0; ai < 2; ++ai)
#pragma unroll
                for (int m = 0; m < 4; ++m) { int ro = row0 + ai * HALF + m * 16; asm volatile("" : "+v"(ro)); bf16_t* rowp = O + (size_t)ro * 512 + col0;
#pragma unroll
                    for (int bj = 0; bj < 2; ++bj) { const f32x4 v0 = acc[ai][bj][m][0], v1 = acc[ai][bj][m][1];
                        u32x4 w; w.x = cvt_pk_bf16(v0[0], v0[1]); w.y = cvt_pk_bf16(v0[2], v0[3]); w.z = cvt_pk_bf16(v1[0], v1[1]); w.w = cvt_pk_bf16(v1[2], v1[3]);
                        *(u32x4*)(rowp + bj * HALF) = w; } }
        } else if (pn < 10) {
            const bool isk = pn >= 8; bf16_t* O = isk ? Kb : Q; const int colt = (isk ? pn - 8 : pn - 6) * BM + wc * 32 + 8 * fq;
            const int g4 = 4 * (4 * (wc & 1) + fq);
            const float sc = isk ? 1.f : qscale;
            f32x4 cs0[2] = {(f32x4){0.f, 0.f, 0.f, 0.f}, (f32x4){0.f, 0.f, 0.f, 0.f}}, cs1[2] = {(f32x4){0.f, 0.f, 0.f, 0.f}, (f32x4){0.f, 0.f, 0.f, 0.f}};
            f32x4 ca[2][4], sa[2][4];
#pragma unroll
            for (int ai = 0; ai < 2; ++ai)
#pragma unroll
                for (int m = 0; m < 4; ++m) { int row = row0 + ai * HALF + m * 16; asm volatile("" : "+v"(row)); const int pos = row & 2047;
                    ca[ai][m] = *(const f32x4*)(ropec + pos * 32 + g4); sa[ai][m] = *(const f32x4*)(ropes + pos * 32 + g4); }
            __builtin_amdgcn_sched_barrier(0);
#pragma unroll
            for (int ai = 0; ai < 2; ++ai)
#pragma unroll
                for (int m = 0; m < 4; ++m) { int row = row0 + ai * HALF + m * 16; asm volatile("" : "+v"(row));
                    const f32x4 c = ca[ai][m] * sc, s = sa[ai][m] * sc;
                    bf16_t* rowp = O + (size_t)row * 512 + colt;
#pragma unroll
                    for (int bj = 0; bj < 2; ++bj) { const f32x4 x1 = acc[ai][bj][m][0], x2 = acc[ai][bj][m][1]; const f32x4 o1 = x1 * c - x2 * s, o2 = x2 * c + x1 * s;
                        cs0[bj] += o1; cs1[bj] += o2;
                        u32x4 w; w.x = cvt_pk_bf16(o1[0], o1[1]); w.y = cvt_pk_bf16(o1[2], o1[3]); w.z = cvt_pk_bf16(o2[0], o2[1]); w.w = cvt_pk_bf16(o2[2], o2[3]);
                        *(u32x4*)(rowp + bj * HALF) = w; }
                    asm volatile("" : "+v"(cs0[0]), "+v"(cs0[1]), "+v"(cs1[0]), "+v"(cs1[1]) :: "memory"); }
            if (isk) {
#pragma unroll
                for (int bj = 0; bj < 2; ++bj)
#pragma unroll
                    for (int j = 0; j < 4; ++j) { float a = cs0[bj][j], b = cs1[bj][j];
                        a += shx<1>(a); b += shx<1>(b); a += shx<2>(a); b += shx<2>(b); a += shx<4>(a); b += shx<4>(b); a += shx<8>(a); b += shx<8>(b);
                        if (fr == 0) { const int pc = (pn - 8) * BM + bj * HALF + wc * 32 + 8 * fq;
                            float* kb = kbar + (size_t)u.pm * 512 + pc; atomicAdd(kb + j, a); atomicAdd(kb + 4 + j, b); } }
            }
        } else {
            bf16_t* O = pn < 16 ? SGC : SGA; const int col0 = (pn < 16 ? pn - 12 : pn - 16) * BM + wc * 32 + 8 * fq;
#pragma unroll
            for (int ai = 0; ai < 2; ++ai)
#pragma unroll
                for (int m = 0; m < 4; ++m) { int ro = row0 + ai * HALF + m * 16; asm volatile("" : "+v"(ro)); bf16_t* rowp = O + (size_t)ro * 1024 + col0;
#pragma unroll
                    for (int bj = 0; bj < 2; ++bj) { f32x4 v0 = acc[ai][bj][m][0], v1 = acc[ai][bj][m][1];
#pragma unroll
                        for (int j = 0; j < 4; ++j) { v0[j] = __builtin_amdgcn_rcpf(1.f + __expf(-v0[j])); v1[j] = __builtin_amdgcn_rcpf(1.f + __expf(-v1[j])); }
                        u32x4 w; w.x = cvt_pk_bf16(v0[0], v0[1]); w.y = cvt_pk_bf16(v0[2], v0[3]); w.z = cvt_pk_bf16(v1[0], v1[1]); w.w = cvt_pk_bf16(v1[2], v1[3]);
                        *(u32x4*)(rowp + bj * HALF) = w; }
                    asm volatile("" ::: "memory"); }
        }
    }
};
struct EpiSoftmax {
    static constexpr bool PERM = true, AFTER_DRAIN = true;
    bf16_t* O; int ldc; float scale_log2;
    __device__ __forceinline__ void fused(AccT& acc, const Unit& u, int wr, int wc, int fr, int fq, PG8_LAS unsigned char* lds, int wid, int lane) const {
        { int t_ = threadIdx.x; asm volatile("" : "+v"(t_)); fr = t_ & 15; fq = (t_ >> 4) & 3; }
        PG8_LAS f32x2* X = (PG8_LAS f32x2*)lds;
        float mx[2][4];
#pragma unroll
        for (int ai = 0; ai < 2; ++ai)
#pragma unroll
            for (int m = 0; m < 4; ++m) { float a = -3.0e38f;
#pragma unroll
                for (int bj = 0; bj < 2; ++bj)
#pragma unroll
                    for (int n = 0; n < 2; ++n) { acc[ai][bj][m][n] = acc[ai][bj][m][n] * scale_log2; const f32x4 x = acc[ai][bj][m][n]; a = fmaxf(fmaxf(a, fmaxf(x[0], x[1])), fmaxf(x[2], x[3])); }
                a = fmaxf(a, shx<16>(a)); a = max32(a); mx[ai][m] = a;
                float s = 0.f;
#pragma unroll
                for (int bj = 0; bj < 2; ++bj)
#pragma unroll
                    for (int n = 0; n < 2; ++n) { f32x4 x = acc[ai][bj][m][n];
#pragma unroll
                        for (int j = 0; j < 4; ++j) { x[j] = __builtin_amdgcn_exp2f(x[j] - a); s += x[j]; }
                        acc[ai][bj][m][n] = x; }
                s += shx<16>(s); s = sum32(s);
                if (fq == 0) X[(ai * HALF + wr * 64 + m * 16 + fr) * 4 + wc] = (f32x2){a, s};
            }
        asm volatile("s_waitcnt lgkmcnt(0)" ::: "memory"); __builtin_amdgcn_s_barrier(); asm volatile("" ::: "memory");
        const int row0 = u.pm * BM + wr * 64 + fr, col0 = u.pn * BM + wc * 32 + 8 * fq;
#pragma unroll
        for (int ai = 0; ai < 2; ++ai)
#pragma unroll
            for (int m = 0; m < 4; ++m) { const int r = ai * HALF + wr * 64 + m * 16 + fr;
                const f32x2 e0 = X[r * 4 + 0], e1 = X[r * 4 + 1], e2 = X[r * 4 + 2], e3 = X[r * 4 + 3];
                const float M = fmaxf(fmaxf(e0.x, e1.x), fmaxf(e2.x, e3.x));
                const float L = e0.y * __builtin_amdgcn_exp2f(e0.x - M) + e1.y * __builtin_amdgcn_exp2f(e1.x - M) + e2.y * __builtin_amdgcn_exp2f(e2.x - M) + e3.y * __builtin_amdgcn_exp2f(e3.x - M);
                const float f = __builtin_amdgcn_exp2f(mx[ai][m] - M) * __builtin_amdgcn_rcpf(L);
                bf16_t* rowp = O + (size_t)(row0 + ai * HALF + m * 16) * ldc + col0;
#pragma unroll
                for (int bj = 0; bj < 2; ++bj) { const f32x4 v0 = acc[ai][bj][m][0] * f, v1 = acc[ai][bj][m][1] * f;
                    u32x4 w; w.x = cvt_pk_bf16(v0[0], v0[1]); w.y = cvt_pk_bf16(v0[2], v0[3]); w.z = cvt_pk_bf16(v1[0], v1[1]); w.w = cvt_pk_bf16(v1[2], v1[3]);
                    *(u32x4*)(rowp + bj * HALF) = w; } }
        asm volatile("s_waitcnt lgkmcnt(0)" ::: "memory"); __builtin_amdgcn_s_barrier(); asm volatile("" ::: "memory");
    }
};
}
namespace attn_body {
using bf16=__hip_bfloat16;
using bf16x8=__attribute__((ext_vector_type(8)))short;
using s16x4=__attribute__((ext_vector_type(4)))short;
using f32x16=__attribute__((ext_vector_type(16)))float;
using u32x4=__attribute__((ext_vector_type(4)))unsigned;
constexpr int BATCH=16,NHEAD=8,SEQ=2048,D=64,DM=NHEAD*D;
constexpr int NW=8,QBLK=32,QB=QBLK*NW,KVBLK=64,NQB=SEQ/QB;
constexpr int ATTN_PITCH=DM, ATTN_UNIT_ROWS=QB;
__device__ __forceinline__ int crow(int r,int hi){return (r&3)+8*(r>>2)+4*hi;}
#define SBAR() __builtin_amdgcn_sched_barrier(0)
__device__ __forceinline__ void cmask(f32x16&p0,f32x16&p1,int jb,int qrel,int hi){
  const float NEG=-INFINITY; int kb=64*jb+4*hi;
  #pragma unroll
  for(int r=0;r<16;++r){int kv=kb+(r&3)+8*(r>>2); if(kv>qrel)p0[r]=NEG; if(kv+32>qrel)p1[r]=NEG;}
}

constexpr int NSLOT=3, SLOTB=8192;
constexpr int LDS_K=0, LDS_V=NSLOT*SLOTB, LDS_WS=2*NSLOT*SLOTB, LDS_OST=LDS_WS+NW*64*4, LDS_SEL=LDS_OST+NW*4096, LDS_BYTES=LDS_SEL+NW*64*4;
constexpr float C2=0.125f*1.4426950408889634f;
__device__ __forceinline__ void glds16(const void*gsrc,unsigned lds_dst){unsigned keep;
  asm volatile("s_mov_b32 %0, m0\n\ts_mov_b32 m0, %2\n\ts_nop 0\n\tglobal_load_lds_dwordx4 %1, off\n\ts_mov_b32 m0, %0":"=&s"(keep):"v"(gsrc),"s"(lds_dst):"memory");}
__device__ __forceinline__ float max3f(float a,float b,float c){float r;asm("v_max3_f32 %0, %1, %2, %3":"=v"(r):"v"(a),"v"(b),"v"(c));return r;}
__device__ __forceinline__ float max2f(float a,float b){float r;asm("v_max_f32_e32 %0, %1, %2":"=v"(r):"v"(a),"v"(b));return r;}
__device__ __forceinline__ float fadd_s(float a,float b){float r;asm("v_add_f32_e32 %0, %1, %2":"=v"(r):"v"(a),"v"(b));return r;}
__device__ __forceinline__ float fsub_s(float a,float b){float r;asm("v_sub_f32_e32 %0, %1, %2":"=v"(r):"v"(a),"v"(b));return r;}
typedef float f32x2_t __attribute__((ext_vector_type(2))); typedef __bf16 bf16x2_t __attribute__((ext_vector_type(2)));
__device__ __forceinline__ unsigned cvtpk_s(float lo,float hi){f32x2_t v={lo,hi};bf16x2_t b=__builtin_convertvector(v,bf16x2_t);return __builtin_bit_cast(unsigned,b);}
#define WAIT_BAR(N) asm volatile("s_waitcnt vmcnt(" #N ") lgkmcnt(0)\n\ts_barrier":::"memory")

__device__ __forceinline__ void qkt(f32x16&p0,f32x16&p1,const char*Kslot,const bf16x8*qr,const f32x16&negm,int r32,int hi){
  const char*kb=Kslot+hi*1024+r32*16;
  #pragma unroll
  for(int d0=0;d0<4;++d0){
    const bf16x8 b0=*reinterpret_cast<const bf16x8*>(kb+d0*2048);
    const bf16x8 b1=*reinterpret_cast<const bf16x8*>(kb+d0*2048+512);
    if(d0==0){p0=__builtin_amdgcn_mfma_f32_32x32x16_bf16(b0,qr[0],negm,0,0,0);p1=__builtin_amdgcn_mfma_f32_32x32x16_bf16(b1,qr[0],negm,0,0,0);}
    else{p0=__builtin_amdgcn_mfma_f32_32x32x16_bf16(b0,qr[d0],p0,0,0,0);p1=__builtin_amdgcn_mfma_f32_32x32x16_bf16(b1,qr[d0],p1,0,0,0);}}
}
typedef __attribute__((address_space(3))) const char* lds_cptr;
typedef short v4i16_t __attribute__((ext_vector_type(4)));
__device__ __forceinline__ void kload8(bf16x8*kf,lds_cptr kp){
  kf[0]=*(const __attribute__((address_space(3))) bf16x8*)(kp);      kf[1]=*(const __attribute__((address_space(3))) bf16x8*)(kp+512);
  kf[2]=*(const __attribute__((address_space(3))) bf16x8*)(kp+2048); kf[3]=*(const __attribute__((address_space(3))) bf16x8*)(kp+2560);
  kf[4]=*(const __attribute__((address_space(3))) bf16x8*)(kp+4096); kf[5]=*(const __attribute__((address_space(3))) bf16x8*)(kp+4608);
  kf[6]=*(const __attribute__((address_space(3))) bf16x8*)(kp+6144); kf[7]=*(const __attribute__((address_space(3))) bf16x8*)(kp+6656);
}
__device__ __forceinline__ void kload2(bf16x8*kf,lds_cptr kp,int j){ kf[2*j]=*(const __attribute__((address_space(3))) bf16x8*)(kp+j*2048); kf[2*j+1]=*(const __attribute__((address_space(3))) bf16x8*)(kp+j*2048+512); }
__device__ __forceinline__ s16x4 vtr(lds_cptr p){ return __builtin_bit_cast(s16x4,__builtin_amdgcn_ds_read_tr16_b64_v4i16((__attribute__((address_space(3))) v4i16_t*)p)); }
__device__ __forceinline__ float rowmax(const f32x16&p0,const f32x16&p1){
  float a=max3f(p0[0],p0[1],p1[0]),b=max3f(p0[2],p0[3],p1[1]);a=max3f(a,p1[2],p1[3]);
  #pragma unroll
  for(int r=4;r<16;r+=4){a=max3f(a,p0[r],p0[r+1]);b=max3f(b,p0[r+2],p0[r+3]);a=max3f(a,p1[r],p1[r+1]);b=max3f(b,p1[r+2],p1[r+3]);}
  const float m=max2f(a,b);
  auto rr=__builtin_amdgcn_permlane32_swap(__float_as_uint(m),__float_as_uint(m),false,false);
  return max2f(__uint_as_float(rr[0]),__uint_as_float(rr[1]));
}
__device__ __forceinline__ void pv(f32x16*o,int vb,bf16x8 pa0,bf16x8 pa1,bf16x8 pa2,bf16x8 pa3){
  #pragma unroll
  for(int d0=0;d0<2;++d0){s16x4 lo[4],hi[4];
    #pragma unroll
    for(int ks=0;ks<4;++ks){
      asm volatile("ds_read_b64_tr_b16 %0,%1 offset:%c2":"=&v"(lo[ks]):"v"(vb),"i"(d0*4096+ks*1024):"memory");
      asm volatile("ds_read_b64_tr_b16 %0,%1 offset:%c2":"=&v"(hi[ks]):"v"(vb),"i"(d0*4096+ks*1024+512):"memory");}
    asm volatile("s_waitcnt lgkmcnt(0)":::"memory");SBAR();
    #define PK(k) (bf16x8){lo[k][0],lo[k][1],lo[k][2],lo[k][3],hi[k][0],hi[k][1],hi[k][2],hi[k][3]}
    o[d0]=__builtin_amdgcn_mfma_f32_32x32x16_bf16(pa0,PK(0),o[d0],0,0,0);
    o[d0]=__builtin_amdgcn_mfma_f32_32x32x16_bf16(pa1,PK(1),o[d0],0,0,0);
    o[d0]=__builtin_amdgcn_mfma_f32_32x32x16_bf16(pa2,PK(2),o[d0],0,0,0);
    o[d0]=__builtin_amdgcn_mfma_f32_32x32x16_bf16(pa3,PK(3),o[d0],0,0,0);
    #undef PK
  }
}

#ifndef ATTN_STORE16
#define ATTN_STORE16(p,v) (*(u32x4*)(p)=(v))
#endif
template<int THRL> __device__ __forceinline__ void attn_unit(int b,int h,int qb,const bf16*Q,const bf16*__restrict__ K,const bf16*__restrict__ V,bf16*O,const float*__restrict__ kbar,char*shm){
  int tid=threadIdx.x; asm volatile("":"+v"(tid)); const int lane=tid&63,r32=lane&31,hi=lane>>5; const int wid=__builtin_amdgcn_readfirstlane(tid>>6);
  const long rowbase=(long)b*SEQ; const int q0=qb*QB;
  const bf16*Qw=Q+(rowbase+q0+wid*QBLK)*DM+h*D;
  const bf16*Kh=K+rowbase*DM+h*D,*Vh=V+rowbase*DM+h*D;
  const unsigned lds0=(unsigned)(uintptr_t)shm;
  float*wsf=(float*)(shm+LDS_WS)+wid*64;
  const bf16*ksrc=Kh+(long)lane*DM+wid*8;
  const bf16*vsrc=Vh+(long)(16*(wid&3)+(lane>>2))*DM+(wid>>2)*32+(lane&3)*8;
  const unsigned kdst=lds0+LDS_K+wid*1024, vdst=lds0+LDS_V+wid*1024;
  #define DMA_K(t,slot) glds16(ksrc+(long)(t)*KVBLK*DM,(unsigned)__builtin_amdgcn_readfirstlane(kdst+(slot)))
  #define DMA_V(t,slot) glds16(vsrc+(long)(t)*KVBLK*DM,(unsigned)__builtin_amdgcn_readfirstlane(vdst+(slot)))
  const int vb0=(int)(lds0+LDS_V)+((lane>>4)&1)*32+(lane&3)*8+(4*hi+((lane&15)>>2))*64;
  const char*Kbase=shm+LDS_K; bf16x8 kf[8];
  const lds_cptr shm3=(lds_cptr)shm; const lds_cptr kp0=shm3+LDS_K+hi*1024+r32*16; const lds_cptr vp0=shm3+LDS_V+((lane>>4)&1)*32+(lane&3)*8+(4*hi+((lane&15)>>2))*64;
  const int NT=(q0+QB)/KVBLK;
  DMA_K(0,0);DMA_V(0,0);DMA_K(1,SLOTB);
  bf16x8 qr[4];
  #pragma unroll
  for(int d0=0;d0<4;++d0)qr[d0]=*reinterpret_cast<const bf16x8*>(&Qw[(long)r32*DM+d0*16+hi*8]);
  int selm=0;
  if(qb>0){
    float g[7]; int hi8=8*hi; asm volatile("":"+v"(hi8)); const float*kb=kbar+(size_t)(b*8)*512+h*64+hi8;
    #pragma unroll
    for(int n=0;n<7;++n){ float a=0.f;
      if(n<qb){
        #pragma unroll
        for(int d0=0;d0<4;++d0){ const float4 k0=*(const float4*)(kb+n*512+16*d0),k1=*(const float4*)(kb+n*512+16*d0+4); const bf16x8 qq=qr[d0];
          #define QF(e) __uint_as_float(((unsigned)(unsigned short)qq[e])<<16)
          a+=QF(0)*k0.x+QF(1)*k0.y+QF(2)*k0.z+QF(3)*k0.w+QF(4)*k1.x+QF(5)*k1.y+QF(6)*k1.z+QF(7)*k1.w;
          #undef QF
        } }
      a=::sum32(a); g[n]=(n<qb)?a:-INFINITY; asm volatile("":"+v"(g[n])::"memory"); }
    #pragma unroll
    for(int r=0;r<3;++r){ int best=-1; float bv=-INFINITY;
      #pragma unroll
      for(int n=0;n<7;++n) if(!((selm>>n)&1)&&g[n]>bv){bv=g[n];best=n;}
      if(best>=0)selm|=1<<best; }
  }
  selm|=1<<qb;
  typedef __attribute__((address_space(3))) int* lds_iptr;
  ((lds_iptr)(shm3+LDS_SEL))[tid]=selm;
  #define CURNEG(blk) ({ int t_=threadIdx.x; asm volatile("":"+v"(t_)); const int sm_=((lds_iptr)(shm3+LDS_SEL))[t_]; ((sm_>>(blk))&1)?0.f:-INFINITY; })
  #define NEGUPD(t) do{ if((((t)+1)&3)==0){ const float cn_=CURNEG(((t)+1)>>2); _Pragma("unroll") for(int r=0;r<16;++r)negm[r]=cn_-mhat; asm volatile("":"+v"(negm)); } }while(0)
  float mhat=0.f,l_reg=0.f;f32x16 o[2];o[0]=f32x16{};o[1]=f32x16{};f32x16 negm; { const float cn_=CURNEG(0); _Pragma("unroll") for(int r=0;r<16;++r)negm[r]=cn_; } asm volatile("":"+v"(negm));
  const int qrel=wid*QBLK+r32;
  #define CMASK(P0,P1,t) do{int jb_=(t)-(NT-4); if(jb_>=0)cmask(P0,P1,jb_,qrel,hi);}while(0)
  bool resc=false;
  #define START(P0,P1) do{ const float rm=rowmax(P0,P1); resc=false; \
    { const float dl=__builtin_fmaxf(rm,-24.f); mhat=fadd_s(mhat,dl); \
      _Pragma("unroll") for(int r=0;r<16;++r){P0[r]=fsub_s(P0[r],dl);P1[r]=fsub_s(P1[r],dl);} \
      { const float cn_=CURNEG(0); _Pragma("unroll") for(int r=0;r<16;++r)negm[r]=cn_-mhat; } asm volatile("":"+v"(negm)); } \
    _Pragma("unroll") for(int r=0;r<16;++r)P0[r]=__builtin_amdgcn_exp2f(P0[r]); }while(0)
  #define RESC() do{ if(resc){ asm volatile("s_waitcnt lgkmcnt(0)":::"memory"); \
      _Pragma("unroll") for(int d_=0;d_<2;++d_) _Pragma("unroll") for(int r=0;r<16;++r)o[d_][r]*=wsf[crow(r,hi)]; } }while(0)
  f32x16 pA0,pA1,pB0,pB1;
  int sl_prev=0,sl_cur=0,sl_next=SLOTB;
  #define ROT() do{sl_prev=sl_cur;sl_cur=sl_next;sl_next=(sl_next==(NSLOT-1)*SLOTB)?0:sl_next+SLOTB;}while(0)
  DMA_K(2,2*SLOTB);
  WAIT_BAR(3);
  qkt(pA0,pA1,Kbase,qr,negm,r32,hi);asm volatile("s_nop 15\n\ts_nop 7":"+v"(pA0),"+v"(pA1));CMASK(pA0,pA1,0);
  START(pA0,pA1);
  _Pragma("unroll") for(int r=0;r<16;++r)pA1[r]=__builtin_amdgcn_exp2f(pA1[r]);
  WAIT_BAR(0);
  DMA_K(3,0);DMA_V(1,SLOTB);
  ROT();
  kload8(kf,kp0+sl_cur);
  WAIT_BAR(2);
  s16x4 vlo[8],vhi[8]; u32x4 pw0,pw1,pw2,pw3;
  #define PKW(P,B) cvtpk_s(P[B],P[B+1])
  #define PAF(k) __builtin_bit_cast(bf16x8,pw##k)
  #define VFR(i) (bf16x8){vlo[i][0],vlo[i][1],vlo[i][2],vlo[i][3],vhi[i][0],vhi[i][1],vhi[i][2],vhi[i][3]}
  #define PIN(x) asm volatile("":"+v"(x))
  #define MX3(a,b,c) __builtin_fmaxf(__builtin_fmaxf((a),(b)),(c))
  #define GAPA(MF,A0,A1,A2,A3,W0,W1,PW) do{ MF; sacc+=A0; sacc+=A1; sacc+=A2; sacc+=A3; PIN(sacc); W0; W1; PIN(PW); SBAR(); }while(0)
  #define EX(v) __builtin_amdgcn_exp2f(v)
  #define GAPB(MF,X,B) do{ MF; X[B]=EX(X[B]); X[B+1]=EX(X[B+1]); X[B+2]=EX(X[B+2]); X[B+3]=EX(X[B+3]); PIN(X); SBAR(); }while(0)
  #define VRD(i) do{ vlo[i]=vtr(vp_+(((i)>>2)*4096+((i)&3)*1024)); vhi[i]=vtr(vp_+(((i)>>2)*4096+((i)&3)*1024+512)); }while(0)
  #define KRD(G,j) do{ if(G){ kload2(kf,kp0+sl_next,j); SBAR(); } }while(0)
  #define STEP(C0,C1,P0,P1,t,GK,GV,GL) do{ SBAR(); \
    const lds_cptr vp_=vp0+sl_prev; \
    VRD(0); SBAR(); float sacc=(P0[0]+P0[1]); \
    GAPA(C0=__builtin_amdgcn_mfma_f32_32x32x16_bf16(kf[0],qr[0],negm,0,0,0), P0[2],P0[3],P0[4],P0[5],     pw0[0]=PKW(P0,0), pw0[1]=PKW(P0,2), pw0); \
    VRD(4); SBAR(); GAPA(C1=__builtin_amdgcn_mfma_f32_32x32x16_bf16(kf[1],qr[0],negm,0,0,0), P0[6],P0[7],P0[8],P0[9],     pw0[2]=PKW(P0,4), pw0[3]=PKW(P0,6), pw0); \
    VRD(1); SBAR(); GAPA(C0=__builtin_amdgcn_mfma_f32_32x32x16_bf16(kf[2],qr[1],C0,0,0,0),   P0[10],P0[11],P0[12],P0[13], pw1[0]=PKW(P0,8), pw1[1]=PKW(P0,10), pw1); \
    VRD(5); SBAR(); GAPA(C1=__builtin_amdgcn_mfma_f32_32x32x16_bf16(kf[3],qr[1],C1,0,0,0),   P0[14],P0[15],P1[0],P1[1],   pw1[2]=PKW(P0,12),pw1[3]=PKW(P0,14), pw1); \
    VRD(2); SBAR(); GAPA(C0=__builtin_amdgcn_mfma_f32_32x32x16_bf16(kf[4],qr[2],C0,0,0,0),   P1[2],P1[3],P1[4],P1[5],     pw2[0]=PKW(P1,0), pw2[1]=PKW(P1,2), pw2); \
    VRD(6); SBAR(); GAPA(C1=__builtin_amdgcn_mfma_f32_32x32x16_bf16(kf[5],qr[2],C1,0,0,0),   P1[6],P1[7],P1[8],P1[9],     pw2[2]=PKW(P1,4), pw2[3]=PKW(P1,6), pw2); \
    VRD(3); SBAR(); GAPA(C0=__builtin_amdgcn_mfma_f32_32x32x16_bf16(kf[6],qr[3],C0,0,0,0),   P1[10],P1[11],P1[12],P1[13], pw3[0]=PKW(P1,8), pw3[1]=PKW(P1,10), pw3); \
    VRD(7); SBAR(); GAPA(C1=__builtin_amdgcn_mfma_f32_32x32x16_bf16(kf[7],qr[3],C1,0,0,0),   P1[14],P1[15],0.f,0.f,       pw3[2]=PKW(P1,12),pw3[3]=PKW(P1,14), pw3); \
    l_reg+=sacc; \
    if(GK){DMA_K((t)+3,sl_cur);} if(GV){DMA_V((t)+1,sl_next);} \
    CMASK(C0,C1,t); \
    { float a=MX3(C0[0],C0[1],C1[0]),b=MX3(C0[2],C0[3],C1[1]); a=MX3(a,C1[2],C1[3]); \
      _Pragma("unroll") for(int r=4;r<16;r+=4){a=MX3(a,C0[r],C0[r+1]);b=MX3(b,C0[r+2],C0[r+3]);a=MX3(a,C1[r],C1[r+1]);b=MX3(b,C1[r+2],C1[r+3]);} \
      float rm=__builtin_fmaxf(a,b); { auto rr=__builtin_amdgcn_permlane32_swap(__float_as_uint(rm),__float_as_uint(rm),false,false); rm=__builtin_fmaxf(__uint_as_float(rr[0]),__uint_as_float(rr[1])); } \
      resc=false; \
      if(__builtin_expect(__any(rm>(float)THRL),0)){ const float dl=__builtin_fmaxf(rm,0.f); mhat+=dl; \
        _Pragma("unroll") for(int r=0;r<16;++r){C0[r]-=dl;C1[r]-=dl;} \
        { const float cn_=CURNEG(((t)+1)>>2); _Pragma("unroll") for(int r=0;r<16;++r)negm[r]=cn_-mhat; } asm volatile("":"+v"(negm)); \
        const float f=__builtin_amdgcn_exp2f(-dl); l_reg*=f; if(hi==0)wsf[r32]=f; resc=true; } } \
    SBAR(); \
    GAPB(o[0]=__builtin_amdgcn_mfma_f32_32x32x16_bf16(PAF(0),VFR(0),o[0],0,0,0), C0,0); \
    GAPB(o[1]=__builtin_amdgcn_mfma_f32_32x32x16_bf16(PAF(0),VFR(4),o[1],0,0,0), C0,4); \
    KRD(GL,0); GAPB(o[0]=__builtin_amdgcn_mfma_f32_32x32x16_bf16(PAF(1),VFR(1),o[0],0,0,0), C0,8); \
    KRD(GL,1); GAPB(o[1]=__builtin_amdgcn_mfma_f32_32x32x16_bf16(PAF(1),VFR(5),o[1],0,0,0), C0,12); \
    KRD(GL,2); GAPB(o[0]=__builtin_amdgcn_mfma_f32_32x32x16_bf16(PAF(2),VFR(2),o[0],0,0,0), C1,0); \
    KRD(GL,3); GAPB(o[1]=__builtin_amdgcn_mfma_f32_32x32x16_bf16(PAF(2),VFR(6),o[1],0,0,0), C1,4); \
    GAPB(o[0]=__builtin_amdgcn_mfma_f32_32x32x16_bf16(PAF(3),VFR(3),o[0],0,0,0), C1,8); \
    GAPB(o[1]=__builtin_amdgcn_mfma_f32_32x32x16_bf16(PAF(3),VFR(7),o[1],0,0,0), C1,12); \
    }while(0)
  int t=1;
  #undef CMASK
  #define CMASK(P0,P1,t) do{}while(0)
  for(;t+5<NT;t+=2){
    STEP(pB0,pB1,pA0,pA1,t,true,true,true);     WAIT_BAR(2); RESC(); ROT(); NEGUPD(t);
    STEP(pA0,pA1,pB0,pB1,t+1,true,true,true);   WAIT_BAR(2); RESC(); ROT(); NEGUPD(t+1);
  }
  #undef CMASK
  #define CMASK(P0,P1,t) do{int jb_=(t)-(NT-4); if(jb_>=0)cmask(P0,P1,jb_,qrel,hi);}while(0)
  #define ENDW(tt) do{ if((tt)+3<NT){WAIT_BAR(2);} else if((tt)+2<NT){WAIT_BAR(1);} else {WAIT_BAR(0);} }while(0)
  for(;t+1<NT;t+=2){
    STEP(pB0,pB1,pA0,pA1,t,(t+3<NT),(t+1<NT),(t+1<NT));       ENDW(t);   RESC(); ROT(); NEGUPD(t);
    STEP(pA0,pA1,pB0,pB1,t+1,(t+4<NT),(t+2<NT),(t+2<NT));     ENDW(t+1); RESC(); ROT(); NEGUPD(t+1);
  }
  STEP(pB0,pB1,pA0,pA1,NT-1,false,false,false); RESC();
  { float sacc=pB0[0]+pB0[1]; _Pragma("unroll") for(int r=2;r<16;++r)sacc+=pB0[r]; _Pragma("unroll") for(int r=0;r<16;++r)sacc+=pB1[r]; l_reg+=sacc;
    pw0=(u32x4){PKW(pB0,0),PKW(pB0,2),PKW(pB0,4),PKW(pB0,6)};pw1=(u32x4){PKW(pB0,8),PKW(pB0,10),PKW(pB0,12),PKW(pB0,14)};pw2=(u32x4){PKW(pB1,0),PKW(pB1,2),PKW(pB1,4),PKW(pB1,6)};pw3=(u32x4){PKW(pB1,8),PKW(pB1,10),PKW(pB1,12),PKW(pB1,14)};
    SBAR(); pv(o,vb0+sl_cur,PAF(0),PAF(1),PAF(2),PAF(3)); }
  #undef PKW
  #undef PAF
  #undef VFR
  #undef PIN
  #undef MX3
  #undef GAPA
  #undef GAPB
  #undef EX
  #undef VRD
  #undef KRD
  #undef STEP
  #undef ENDW
  {auto rr=__builtin_amdgcn_permlane32_swap(__float_as_uint(l_reg),__float_as_uint(l_reg),false,false);l_reg=__uint_as_float(rr[0])+__uint_as_float(rr[1]);}
  if(hi==0)wsf[32+r32]=l_reg;asm volatile("s_waitcnt lgkmcnt(0)":::"memory");
  float rli[16];
  #pragma unroll
  for(int r=0;r<16;++r)rli[r]=__builtin_amdgcn_rcpf(wsf[32+crow(r,hi)]);
  bf16*Ow=O+(rowbase+q0+wid*QBLK)*DM+h*D;
  { bf16*stg=(bf16*)(shm+LDS_OST)+wid*2048;
    #pragma unroll
    for(int r=0;r<16;++r){const int orow=crow(r,hi);
      #pragma unroll
      for(int d0=0;d0<2;++d0)stg[orow*64+d0*32+r32]=__float2bfloat16(o[d0][r]*rli[r]);}
    asm volatile("s_waitcnt lgkmcnt(0)":::"memory");
    #pragma unroll
    for(int i=0;i<4;++i){const int row=i*8+(lane>>3),ch=lane&7; const u32x4 v=*(const u32x4*)(stg+row*64+ch*8); ATTN_STORE16(Ow+(long)row*DM+ch*8,v);} }
  asm volatile("s_waitcnt lgkmcnt(0)\n\ts_barrier":::"memory");
  #undef DMA_K
  #undef DMA_V
  #undef CMASK
  #undef START
  #undef CURNEG
  #undef NEGUPD
  #undef RESC
  #undef ROT
}
constexpr int ATTN_LDS_BYTES=LDS_BYTES;
struct AttnTensors { const bf16* Q; const bf16* K; const bf16* V; bf16* O; const float* kbar; };
struct AttnUnit { int bh; int qb; };
struct StaticOrder {
  int vcu,G;
  __device__ __forceinline__ explicit StaticOrder(int grid,int block):vcu((grid%8==0)?(block%8)*(grid/8)+block/8:block),G(grid){}
  __device__ __forceinline__ bool next(int i,AttnUnit&u)const{
    if(G==256){ if(i>=4)return false; const int s=vcu&1; u.bh=vcu>>1; u.qb=s?((i==0)?6:(i==1)?1:(i==2)?5:2):((i==0)?7:(i==1)?0:(i==2)?4:3); return true; }
    const int L=i*G+vcu; if(L>=1024)return false; u.bh=L>>3; u.qb=L&7; return true; }
  __device__ __forceinline__ void a_ready(const AttnUnit&)const{}
  __device__ __forceinline__ void done(const AttnUnit&)const{}
};
template<class Sched,int THRL=8> __device__ __forceinline__ void attn_phase(char*lds,const AttnTensors&T,const Sched&S){
  AttnUnit u;
  for(int i=0;S.next(i,u);++i){ S.a_ready(u); attn_unit<THRL>(u.bh/NHEAD,u.bh%NHEAD,u.qb,T.Q,T.K,T.V,T.O,T.kbar,lds); S.done(u); }
}
#undef SBAR
#undef WAIT_BAR
}
constexpr int NWAVES = 8;
constexpr int T = 32768, D = 1024, SEQ = 2048, MEMROWS = 4096, INW = 5120;
constexpr float RMS_EPS = 1e-6f;
constexpr size_t MiB = 1u << 20;
constexpr size_t WS_CTL = 0, CTL_ZERO_BYTES = 2 * MiB, WS_KBAR = 1 * MiB;
constexpr size_t WS_WIN = 2 * MiB, WS_WC = 12 * MiB, WS_WA = 13 * MiB, WS_WM = 14 * MiB, WS_WXQ = 16 * MiB, WS_WXKV = 18 * MiB, WS_WXO = 22 * MiB, WS_MT = 24 * MiB, WS_ROPE = 28 * MiB;
constexpr size_t WS_MEMN = 32 * MiB, WS_KX = 40 * MiB, WS_VXT = 48 * MiB;
constexpr size_t WS_SSQ1 = 30 * MiB, WS_SSQ2 = 56 * MiB;
constexpr size_t WS_A = 64 * MiB;
constexpr size_t WS_YC = 128 * MiB, WS_QO = 160 * MiB, WS_U = 192 * MiB, WS_K = 224 * MiB, WS_V = 256 * MiB;
constexpr size_t WS_SGC = 320 * MiB, WS_SGA = 384 * MiB;
constexpr size_t WS_A8I = 320 * MiB, WS_ASC = 352 * MiB;
constexpr size_t WS_EIDX = 448 * MiB, WS_GW = 464 * MiB, WS_PW = 480 * MiB, WS_END = 496 * MiB;
constexpr size_t WS_U8 = 288 * MiB, WS_V8T = 304 * MiB, WS_SU = 29 * MiB, WS_SV = 29 * MiB + 512 * 1024;
constexpr size_t WS_QX = 128 * MiB, WS_PM = 192 * MiB, WS_OX = 128 * MiB;
constexpr size_t WS_PO = 128 * MiB;
constexpr size_t WS_SC = 128 * MiB;
constexpr int CW_TMO = 0, CW_BAR = 4096, CW_Q = 8192;
constexpr int RING_OFF = 0, RING_BYTES = 131072;
constexpr int LDSCTL_OFF = RING_BYTES, MISC_OFF = LDSCTL_OFF + 320;
constexpr int LDS_BYTES = 163840;
constexpr int UL_OFF = RING_BYTES + 512, UL_WAVE = (LDS_BYTES - UL_OFF) / 8, UL_CAP = ((UL_WAVE - 128 - 8) / 8) & ~15;

#define GAS __attribute__((address_space(1)))
#define LAS __attribute__((address_space(3)))
typedef unsigned short bf16;
typedef unsigned v4u __attribute__((ext_vector_type(4)));
typedef unsigned v2u __attribute__((ext_vector_type(2)));
typedef float v2f __attribute__((ext_vector_type(2)));
typedef float f32x3 __attribute__((ext_vector_type(3)));
typedef float f32x4 __attribute__((ext_vector_type(4)));
typedef float f32x2v __attribute__((ext_vector_type(2)));
typedef _Float16 h2v __attribute__((ext_vector_type(2)));
typedef GAS unsigned gu32;
#define RLX_AGENT __ATOMIC_RELAXED, __HIP_MEMORY_SCOPE_AGENT
#define LDS_WAIT() asm volatile("s_waitcnt lgkmcnt(0)" ::: "memory")
#define VM_WAIT() asm volatile("s_waitcnt vmcnt(0)" ::: "memory")
__device__ __forceinline__ unsigned pk2(float lo, float hi) { return pg8::cvt_pk_bf16(lo, hi); }
__device__ __forceinline__ float bflo(unsigned u) { return __uint_as_float(u << 16); }
__device__ __forceinline__ float bfhi(unsigned u) { return __uint_as_float(u & 0xffff0000u); }

#define XB_TMO      128
#define XB_XCNT(j)  (256  + 64 * (j))
#define XB_XSUB(j)  (1280 + 64 * (j))
#define XB_XGEN(j)  (2304 + 64 * (j))
#define XB_TOP      3328
#define XB_TOPGEN   3392
#define XCD_BAR_WORDS 3456
#define XB_SPIN_CAP (1u << 18)
__device__ __forceinline__ unsigned xb_ld(unsigned* p)              { return __hip_atomic_load(p, __ATOMIC_RELAXED, __HIP_MEMORY_SCOPE_AGENT); }
__device__ __forceinline__ unsigned xb_add(unsigned* p, unsigned v) { return __hip_atomic_fetch_add(p, v, __ATOMIC_RELAXED, __HIP_MEMORY_SCOPE_AGENT); }
__device__ __forceinline__ unsigned xb_xcc_id() { return (unsigned)__builtin_amdgcn_s_getreg((3 << 11) | 20) & 0xFu; }
#define XB_SPIN(cond, bar) do { unsigned _sp = 0; while (cond) { __builtin_amdgcn_s_sleep(1); \
    if ((++_sp & 255u) == 0u) { if (xb_ld(&(bar)[XB_TMO])) break; if (_sp > XB_SPIN_CAP) { atomicAdd(&(bar)[XB_TMO], 1u); break; } } } } while (0)
struct XcdBarrier { unsigned* bar; unsigned x; volatile LAS unsigned* st; };
__device__ __forceinline__ XcdBarrier xcd_barrier_post(unsigned* bar, volatile LAS unsigned* st) {
    XcdBarrier b; b.bar = bar; b.x = xb_xcc_id(); b.st = st;
    if (threadIdx.x == 0) (void)xb_add(&bar[XB_XCNT(b.x)], 1u);
    return b;
}
__device__ __forceinline__ void xcd_barrier_complete(unsigned* bar, unsigned x, unsigned& nloc, unsigned& nx) {
    const unsigned G = gridDim.x * gridDim.y * gridDim.z;
    unsigned sum, cnt, mine, sp = 0u;
    for (;;) {
        sum = 0u; cnt = 0u; mine = 0u;
#pragma unroll
        for (unsigned j = 0; j < 16; ++j) { const unsigned c = xb_ld(&bar[XB_XCNT(j)]); sum += c; cnt += (c > 0u) ? 1u : 0u; mine = (j == x) ? c : mine; }
        if (sum == G) break;
        __builtin_amdgcn_s_sleep(1);
        if ((++sp & 255u) == 0u) { if (xb_ld(&bar[XB_TMO])) break; if (sp > XB_SPIN_CAP) { atomicAdd(&bar[XB_TMO], 1u); break; } }
    }
    nloc = mine > 0u ? mine : 1u; nx = cnt > 0u ? cnt : 1u;
}
__device__ __forceinline__ void xcd_barrier(const XcdBarrier& b) {
    asm volatile("s_waitcnt vmcnt(0)" ::: "memory");
    __syncthreads();
    if (threadIdx.x == 0) {
        unsigned* bar = b.bar;
        __builtin_amdgcn_s_waitcnt(0);
        unsigned nloc = b.st[0], nx = b.st[1];
        if (nloc == 0u) { xcd_barrier_complete(bar, b.x, nloc, nx); b.st[0] = nloc; b.st[1] = nx; }
        const unsigned old = xb_add(&bar[XB_XSUB(b.x)], 1u);
        const unsigned gen = old / nloc;
        if (old + 1u == (gen + 1u) * nloc) {
            __builtin_amdgcn_fence(__ATOMIC_RELEASE, "agent");
            asm volatile("s_waitcnt vmcnt(0)" ::: "memory");
            const unsigned og = xb_add(&bar[XB_TOP], 1u);
            const unsigned tg = og / nx;
            if (og + 1u == (tg + 1u) * nx) xb_add(&bar[XB_TOPGEN], 1u);
            else XB_SPIN(xb_ld(&bar[XB_TOPGEN]) == tg, bar);
            __builtin_amdgcn_fence(__ATOMIC_ACQUIRE, "agent");
            xb_add(&bar[XB_XGEN(b.x)], 1u);
            asm volatile("s_waitcnt vmcnt(0)" ::: "memory");
        } else {
            XB_SPIN(xb_ld(&bar[XB_XGEN(b.x)]) == gen, bar);
            __builtin_amdgcn_fence(__ATOMIC_ACQUIRE, "agent");
            asm volatile("s_waitcnt vmcnt(0)" ::: "memory");
        }
    }
    __syncthreads();
}

struct MapId { static __device__ __forceinline__ int src(int j) { return j; } };
struct MapWin {
    static __device__ __forceinline__ int src(int j) {
        if (j < 1024) { const int g8 = j >> 3, i = j & 7; return ((i < 4) ? 0 : 1024) + 4 * g8 + (i & 3); }
        if (j < 1536) return 512 + (j - 1024);
        if (j < 2560) { const int jj = j - 1536, qk = jj >> 9, p = jj & 511, head = p >> 6, pl = p & 63, g = pl >> 3, i = pl & 7; return 1536 + qk * 512 + head * 64 + 4 * g + (i & 3) + 32 * (i >> 2); }
        return j;
    }
};
template <class MAP>
__device__ __forceinline__ void p0_transpose_item(const float* W, int K, int N, int NOUT, bf16* WT, LAS float* scr, int item, int lane, const float* gain = nullptr) {
    const int nblk = NOUT / 32, kb = item / nblk, nb = item % nblk, k0 = 64 * kb, n0 = 32 * nb;
    const int sc = MAP::src(n0 + (lane & 31));
    float wv[32];
#pragma unroll
    for (int i = 0; i < 32; ++i) wv[i] = W[(size_t)(k0 + 2 * i + (lane >> 5)) * N + sc];
#pragma unroll
    for (int i = 0; i < 32; ++i) { const int kk = 2 * i + (lane >> 5); const float gk = gain ? gain[k0 + kk] : 1.f; scr[kk * 33 + (lane & 31)] = wv[i] * gk; }
    LDS_WAIT(); asm volatile("" ::: "memory");
    const int c = lane & 7;
#pragma unroll
    for (int j = 0; j < 4; ++j) { const int n = (lane >> 3) + 8 * j; const LAS float* s = scr + (8 * c) * 33 + n;
        v4u o; o.x = pk2(s[0 * 33], s[1 * 33]); o.y = pk2(s[2 * 33], s[3 * 33]); o.z = pk2(s[4 * 33], s[5 * 33]); o.w = pk2(s[6 * 33], s[7 * 33]);
        *(GAS v4u*)(WT + (size_t)(n0 + n) * K + k0 + 8 * c) = o; }
    LDS_WAIT(); asm volatile("" ::: "memory");
}
__device__ __forceinline__ void rms_row_to_bf16(const float* xrow, const float* g, bf16* orow, int lane) {
    const GAS f32x4* xr = (const GAS f32x4*)xrow + lane; const GAS f32x4* gr = (const GAS f32x4*)g + lane;
    f32x4 v[4]; float s = 0.f;
#pragma unroll
    for (int j = 0; j < 4; ++j) { v[j] = xr[64 * j]; s += (v[j].x * v[j].x + v[j].y * v[j].y) + (v[j].z * v[j].z + v[j].w * v[j].w); }
    const float r = rsqrtf(wave_sum(s) * (1.f / 1024.f) + RMS_EPS);
    GAS v2u* o8 = (GAS v2u*)orow + lane;
#pragma unroll
    for (int j = 0; j < 4; ++j) { const f32x4 gg = gr[64 * j]; v2u w; w.x = pk2(v[j].x * r * gg.x, v[j].y * r * gg.y); w.y = pk2(v[j].z * r * gg.z, v[j].w * r * gg.w); o8[64 * j] = w; }
}
template <int NR>
__device__ __forceinline__ void rms_rows_to_bf16(const float* x, const float* g, bf16* o, int m0, int stride, int lane) {
    f32x4 v[NR][4];
#pragma unroll
    for (int i = 0; i < NR; ++i) { const GAS f32x4* xr = (const GAS f32x4*)(x + (size_t)(m0 + i * stride) * 1024) + lane;
#pragma unroll
        for (int j = 0; j < 4; ++j) v[i][j] = xr[64 * j]; }
    f32x4 gg[4];
#pragma unroll
    for (int j = 0; j < 4; ++j) gg[j] = ((const GAS f32x4*)g + lane)[64 * j];
#pragma unroll
    for (int i = 0; i < NR; ++i) { float s = 0.f;
#pragma unroll
        for (int j = 0; j < 4; ++j) s += (v[i][j].x * v[i][j].x + v[i][j].y * v[i][j].y) + (v[i][j].z * v[i][j].z + v[i][j].w * v[i][j].w);
        const float r = rsqrtf(wave_sum(s) * (1.f / 1024.f) + RMS_EPS);
        GAS v2u* o8 = (GAS v2u*)(o + (size_t)(m0 + i * stride) * 1024) + lane;
#pragma unroll
        for (int j = 0; j < 4; ++j) { v2u w; w.x = pk2(v[i][j].x * r * gg[j].x, v[i][j].y * r * gg[j].y); w.y = pk2(v[i][j].z * r * gg[j].z, v[i][j].w * r * gg[j].w); o8[64 * j] = w; } }
}
__device__ __forceinline__ float fmax_asm(float a, float b) { float r; asm("v_max_f32 %0, %1, %2" : "=v"(r) : "v"(a), "v"(b)); return r; }
__device__ __forceinline__ float fmin_asm(float a, float b) { float r; asm("v_min_f32 %0, %1, %2" : "=v"(r) : "v"(a), "v"(b)); return r; }

#ifndef PH_MASK
#define PH_MASK 0xFFFFFFFFu
#endif
#define PH(k) ((PH_MASK >> (k)) & 1u)
#ifndef REP_MASK
#define REP_MASK 0u
#endif
#define NREP(k) (((REP_MASK >> (k)) & 1u) ? 2 : 1)
#ifndef DIAG_TS_A
#define DIAG_TS_A -1
#endif
#ifndef DIAG_TS_B
#define DIAG_TS_B -1
#endif
struct Args { const float* in[19]; float* out; unsigned char* ws; };

struct XOrder {
    const char* A; const char* Bt; int G, c, i0, mode;
    __device__ bool next(int i, pg8::Unit& u) const {
        if (i > 0) return false;
        const int L = i0 * G + c; if (L >= 512) return false;
        const int b = L >> 5, head = (L >> 3) & 3, rt = L & 7;
        u.pm = b * 8 + rt; u.pn = head;
        if (mode == 0) { u.a = A + (size_t)(b * 2048 + rt * 256) * 1024 * 2; u.b = Bt + (size_t)(head * 256) * 1024 * 2; }
        else { u.a = A + ((size_t)(b * 2048 + rt * 256) * 1024 + head * 256) * 2;
               u.b = (mode == 2) ? Bt + ((size_t)(head * 256) * 4096 + b * 256) * 2 : Bt + ((size_t)(b * 256) * 1024 + head * 256) * 2; }
        return true;
    }
};

struct OneUnit { pg8::Unit u0; __device__ __forceinline__ bool next(int i, pg8::Unit& u) const { if (i != 0) return false; u = u0; return true; } };
struct EpiTile {
    static constexpr bool PERM = true, AFTER_DRAIN = true;
    const float* ssq;
    __device__ __forceinline__ void fused(pg8::AccT& acc, const pg8::Unit& u, int wr, int wc, int fr, int fq, PG8_LAS unsigned char* lds, int wid, int lane) const {
        { int t_ = threadIdx.x; asm volatile("" : "+v"(t_)); fr = t_ & 15; fq = (t_ >> 4) & 3; }
        typedef _Float16 h8 __attribute__((ext_vector_type(8)));
        float rsa[2][4];
#pragma unroll
        for (int ai = 0; ai < 2; ++ai)
#pragma unroll
            for (int m = 0; m < 4; ++m) { int rl = wr * 64 + fr + ai * pg8::HALF + m * 16; asm volatile("" : "+v"(rl)); rsa[ai][m] = pg8::row_rs(ssq, u.pm * pg8::BM + rl); }
        __builtin_amdgcn_sched_barrier(0);
#pragma unroll
        for (int ai = 0; ai < 2; ++ai)
#pragma unroll
            for (int m = 0; m < 4; ++m) { int rl = wr * 64 + fr + ai * pg8::HALF + m * 16; asm volatile("" : "+v"(rl)); const float rs = rsa[ai][m];
#pragma unroll
                for (int bj = 0; bj < 2; ++bj) { const f32x4 v0 = acc[ai][bj][m][0] * rs, v1 = acc[ai][bj][m][1] * rs;
                    h8 w = {(_Float16)v0[0], (_Float16)v0[1], (_Float16)v0[2], (_Float16)v0[3], (_Float16)v1[0], (_Float16)v1[1], (_Float16)v1[2], (_Float16)v1[3]};
                    *(PG8_LAS h8*)(lds + (wc * 4 + fq + bj * 16) * 4096 + rl * 16) = w; } }
    }
};

__global__ void __launch_bounds__(NWAVES * 64, 2) mk_fwd(Args args) {
    extern __shared__ __attribute__((aligned(16))) unsigned char lds[];
    LAS unsigned char* L = (LAS unsigned char*)lds;
    volatile LAS unsigned* MISC = (volatile LAS unsigned*)(L + MISC_OFF);
    const int wave = __builtin_amdgcn_readfirstlane((int)threadIdx.x >> 6);
#define PH_LANES int tid = threadIdx.x; asm volatile("" : "+v"(tid)); const int lane = tid & 63; const int gt = vcu * (NWAVES * 64) + tid; (void)lane; (void)gt
    const int G = gridDim.x; const int bx = blockIdx.x; const int vcu = (G % 8 == 0) ? (bx % 8) * (G / 8) + bx / 8 : bx;
    unsigned char* ws = args.ws;
    gu32* ctl = (gu32*)(ws + WS_CTL);
    for (int u = threadIdx.x; u < (LDS_BYTES - LDSCTL_OFF) / 4; u += NWAVES * 64) ((LAS unsigned*)(L + LDSCTL_OFF))[u] = 0u;
    __syncthreads();
    XcdBarrier bar = xcd_barrier_post((unsigned*)(ctl + CW_BAR), MISC + 8);
    unsigned long long* tsw = (unsigned long long*)(ws + WS_CTL + 65536);
    int n_ts = 0;
#define TSTAMP() do { if (DIAG_TS_A >= 0) { if (bx == 0 && threadIdx.x == 0) tsw[n_ts] = __builtin_amdgcn_s_memrealtime(); ++n_ts; } } while (0)
    TSTAMP();

    const float *x = args.in[0], *mem = args.in[1], *g_mix = args.in[2], *w_in = args.in[3], *w_conv = args.in[4], *w_conv_out = args.in[5], *w_attn_out = args.in[6], *w_merge = args.in[7],
                *g_xattn = args.in[8], *g_mem = args.in[9], *w_xq = args.in[10], *w_xkv = args.in[11], *w_xo = args.in[12], *g_ffn = args.in[13], *w_pq = args.in[14], *sub_keys = args.in[15],
                *peer_u = args.in[16], *peer_v = args.in[17], *g_final = args.in[18];
    float* out = args.out;
    bf16 *WinT = (bf16*)(ws + WS_WIN), *WcT = (bf16*)(ws + WS_WC), *WaT = (bf16*)(ws + WS_WA), *WmT = (bf16*)(ws + WS_WM), *WxqT = (bf16*)(ws + WS_WXQ), *WxkvT = (bf16*)(ws + WS_WXKV),
         *WxoT = (bf16*)(ws + WS_WXO), *MT = (bf16*)(ws + WS_MT);
    float* ropec = (float*)(ws + WS_ROPE); float* ropes = ropec + 2048 * 32;
    float* kbar = (float*)(ws + WS_KBAR);
    bf16 *MEMN = (bf16*)(ws + WS_MEMN), *KX = (bf16*)(ws + WS_KX), *VXT = (bf16*)(ws + WS_VXT), *A = (bf16*)(ws + WS_A);
    bf16 *YC = (bf16*)(ws + WS_YC), *QO = (bf16*)(ws + WS_QO), *U = (bf16*)(ws + WS_U), *KB = (bf16*)(ws + WS_K), *VB = (bf16*)(ws + WS_V), *SGC = (bf16*)(ws + WS_SGC), *SGA = (bf16*)(ws + WS_SGA);
    bf16 *QX = (bf16*)(ws + WS_QX), *PM = (bf16*)(ws + WS_PM), *OX = (bf16*)(ws + WS_OX);
    _Float16* SC = (_Float16*)(ws + WS_SC);
    unsigned char* A8I = ws + WS_A8I; float* ASC = (float*)(ws + WS_ASC);
    int* EIDX = (int*)(ws + WS_EIDX); float* GW = (float*)(ws + WS_GW); unsigned* PW = (unsigned*)(ws + WS_PW);
    float* PO = (float*)(ws + WS_PO); float* SSQ1 = (float*)(ws + WS_SSQ1); float* SSQ2 = (float*)(ws + WS_SSQ2); (void)PO;
    unsigned char* U8 = ws + WS_U8; unsigned char* V8T = ws + WS_V8T; float* SU = (float*)(ws + WS_SU); float* SV = (float*)(ws + WS_SV);
    const int gw = vcu * NWAVES + wave, NGW = G * NWAVES;
    const int NGT = G * NWAVES * 64;

    asm volatile("; ===== PHASE 0 =====");
    if (PH(0)) for (int rep = 0; rep < NREP(0); ++rep) {
        PH_LANES; const bool dummy = rep < NREP(0) - 1; (void)dummy;
        LAS float* scr = (LAS float*)(L + RING_OFF + wave * 16384);
        constexpr int I_IN = (1024 / 64) * (5120 / 32), I_C = (512 / 64) * (1024 / 32), I_M = (1024 / 64) * (1024 / 32), I_KV = (1024 / 64) * (2048 / 32);
        constexpr int NITEMS = I_IN + 2 * I_C + 3 * I_M + I_KV;
        for (int it = gw; it < NITEMS; it += NGW) {
            int r = it;
            if (r < I_IN) { p0_transpose_item<MapWin>(w_in, 1024, 5120, 5120, WinT, scr, r, lane); continue; } r -= I_IN;
            if (r < I_C) { p0_transpose_item<MapId>(w_conv_out, 512, 1024, 1024, WcT, scr, r, lane); continue; } r -= I_C;
            if (r < I_C) { p0_transpose_item<MapId>(w_attn_out, 512, 1024, 1024, WaT, scr, r, lane); continue; } r -= I_C;
            if (r < I_M) { p0_transpose_item<MapId>(w_merge, 1024, 1024, 1024, WmT, scr, r, lane); continue; } r -= I_M;
            if (r < I_M) { p0_transpose_item<MapId>(w_xq, 1024, 1024, 1024, WxqT, scr, r, lane, g_xattn); continue; } r -= I_M;
            if (r < I_M) { p0_transpose_item<MapId>(w_xo, 1024, 1024, 1024, WxoT, scr, r, lane); continue; } r -= I_M;
            p0_transpose_item<MapId>(w_xkv, 1024, 2048, 2048, WxkvT, scr, r, lane);
        }
        { int m = gw; for (; m + 3 * NGW < T; m += 4 * NGW) rms_rows_to_bf16<4>(x, g_mix, A, m, NGW, lane); for (; m < T; m += NGW) rms_row_to_bf16(x + (size_t)m * D, g_mix, A + (size_t)m * D, lane); }
        { int m = gw; for (; m + NGW < MEMROWS; m += 2 * NGW) rms_rows_to_bf16<2>(mem, g_mem, MEMN, m, NGW, lane); for (; m < MEMROWS; m += NGW) rms_row_to_bf16(mem + (size_t)m * D, g_mem, MEMN + (size_t)m * D, lane); }
        for (int i = gt; i < 2048 * 32; i += NGT) { const int pos = i >> 5, f = i & 31; const float inv = powf(10000.0f, -(float)f / 32.0f); const float ang = (float)pos * inv; ropec[i] = cosf(ang); ropes[i] = sinf(ang); }
        __syncthreads();
        {
            LAS float* skl = (LAS float*)(L + RING_OFF);
            LAS float* wtl = skl + 128 * 129;
            for (int it = bx; it < 256; it += G) {
                const int hp = it >> 4, cb = it & 15;
                {
                    f32x4 sk4[8], wq4[4]; float gq[4];
#pragma unroll
                    for (int k = 0; k < 8; ++k) { const int i4 = (tid + k * NWAVES * 64) * 4; sk4[k] = *(const GAS f32x4*)(sub_keys + (size_t)hp * 128 * 128 + i4); }
#pragma unroll
                    for (int k = 0; k < 4; ++k) { const int i4 = (tid + k * NWAVES * 64) * 4, c = i4 >> 7, d = i4 & 127; wq4[k] = *(const GAS f32x4*)(w_pq + (size_t)(cb * 64 + c) * 2048 + hp * 128 + d); gq[k] = g_ffn[cb * 64 + c]; }
                    __builtin_amdgcn_sched_barrier(0);
#pragma unroll
                    for (int k = 0; k < 8; ++k) { const int i4 = (tid + k * NWAVES * 64) * 4, n = i4 >> 7, d = i4 & 127;
#pragma unroll
                        for (int j = 0; j < 4; ++j) skl[n * 129 + d + j] = sk4[k][j]; }
#pragma unroll
                    for (int k = 0; k < 4; ++k) { const int i4 = (tid + k * NWAVES * 64) * 4, c = i4 >> 7, d = i4 & 127;
#pragma unroll
                        for (int j = 0; j < 4; ++j) wtl[c * 129 + d + j] = wq4[k][j] * gq[k]; }
                }
                __syncthreads();
                const int cg = tid & 15, ng = tid >> 4;
                float acc[4][4];
#pragma unroll
                for (int i = 0; i < 4; ++i)
#pragma unroll
                    for (int j = 0; j < 4; ++j) acc[i][j] = 0.f;
                for (int d = 0; d < 128; ++d) {
                    float wv[4], sv[4];
#pragma unroll
                    for (int i = 0; i < 4; ++i) { wv[i] = wtl[(4 * cg + i) * 129 + d]; sv[i] = skl[(4 * ng + i) * 129 + d]; }
#pragma unroll
                    for (int i = 0; i < 4; ++i)
#pragma unroll
                        for (int j = 0; j < 4; ++j) acc[i][j] += sv[i] * wv[j];
                }
#pragma unroll
                for (int i = 0; i < 4; ++i) { v2u w; w.x = pk2(acc[i][0], acc[i][1]); w.y = pk2(acc[i][2], acc[i][3]); *(GAS v2u*)(MT + (size_t)(hp * 128 + 4 * ng + i) * 1024 + cb * 64 + 4 * cg) = w; }
                __syncthreads();
            }
        }
    }
    xcd_barrier(bar); TSTAMP();

    asm volatile("; ===== PHASE 1 =====");
    if (PH(1)) for (int rep = 0; rep < NREP(1); ++rep) {
        PH_LANES; const bool dummy = rep < NREP(1) - 1; (void)dummy;
        pg8::Gemm g{1024, 1024, 1024}; pg8::StaticOrder S; S.init(A, 1024, WinT, 1024, T, INW, G, bx);
        pg8::EpiIn E{U, YC, QO, KB, VB, SGC, SGA, ropec, ropes, kbar, 0.125f * 1.4426950408889634f};
        pg8::gemm_phase<pg8::EpiIn, pg8::StaticOrder, true>(L + RING_OFF, g, S, E);
    }
    if (PH(1)) for (int rep = 0; rep < NREP(1); ++rep) {
        PH_LANES; const bool dummy = rep < NREP(1) - 1; (void)dummy;
        pg8::Gemm g{1024, 1024, 1024}; pg8::StaticOrder S; S.init(MEMN, 1024, WxkvT, 1024, MEMROWS, 1024, G, bx);
        pg8::EpiBf16 E{KX, 1024};
        pg8::gemm_phase<pg8::EpiBf16, pg8::StaticOrder, true>(L + RING_OFF, g, S, E);
    }
    if (PH(1)) for (int rep = 0; rep < NREP(1); ++rep) {
        PH_LANES; const bool dummy = rep < NREP(1) - 1; (void)dummy;
        pg8::Gemm g{1024, 1024, 1024}; pg8::StaticOrder S; S.init(WxkvT + (size_t)1024 * 1024, 1024, MEMN, 1024, 1024, MEMROWS, G, (bx + 128) % G);
        pg8::EpiBf16 E{VXT, 4096};
        pg8::gemm_phase<pg8::EpiBf16, pg8::StaticOrder, true>(L + RING_OFF, g, S, E);
    }
    if (PH(1)) for (int rep = 0; rep < NREP(1); ++rep) {
        PH_LANES; const bool dummy = rep < NREP(1) - 1; (void)dummy;
        int cb, ncb;
        if (G == 256) { const bool idle = (bx >= 64 && bx < 128) || bx >= 192; cb = idle ? ((bx < 128) ? bx - 64 : bx - 128) : 256; ncb = 128; } else { cb = bx; ncb = G; }
        const int cw = cb * NWAVES + wave, ncw = ncb * NWAVES;
        for (int e = (cb < ncb ? cw : 16384); e < 16384; e += ncw) {
            const GAS f32x4* r = (const GAS f32x4*)(peer_u + (size_t)e * D) + lane; f32x4 v[4]; float am = 0.f;
#pragma unroll
            for (int j = 0; j < 4; ++j) { v[j] = r[64 * j] * ((const GAS f32x4*)g_ffn + lane)[64 * j]; am = fmaxf(fmaxf(am, fmaxf(fabsf(v[j].x), fabsf(v[j].y))), fmaxf(fabsf(v[j].z), fabsf(v[j].w))); }
            am = wave_max(am);
            const float sc = am > 0.f ? 7.f / am : 1.f; int ns = 0;
#pragma unroll
            for (int j = 0; j < 2; ++j) {
                const int l0 = (int)rintf(v[j].x * sc) + 8, l1 = (int)rintf(v[j].y * sc) + 8, l2 = (int)rintf(v[j].z * sc) + 8, l3 = (int)rintf(v[j].w * sc) + 8;
                const int h0 = (int)rintf(v[j + 2].x * sc) + 8, h1 = (int)rintf(v[j + 2].y * sc) + 8, h2 = (int)rintf(v[j + 2].z * sc) + 8, h3 = (int)rintf(v[j + 2].w * sc) + 8;
                ns += (l0 + l1) + (l2 + l3) + (h0 + h1) + (h2 + h3);
                *(GAS unsigned*)(U8 + (size_t)e * 512 + 4 * lane + 256 * j) = (unsigned)(l0 | (h0 << 4)) | ((unsigned)(l1 | (h1 << 4)) << 8) | ((unsigned)(l2 | (h2 << 4)) << 16) | ((unsigned)(l3 | (h3 << 4)) << 24); }
            const float nsf = wave_sum((float)ns);
            if (lane == 0) { SU[4 * e] = am > 0.f ? am * (1.f / 7.f) : 1.f; SU[4 * e + 2] = nsf; }
        }
        __syncthreads();
        for (int it = cb; it < 256; it += ncb) {
            const int e0 = it * 64;
#pragma unroll 1
            for (int rr = 0; rr < 8; ++rr) {
                const int el = wave * 8 + rr, e = e0 + el;
                const GAS f32x4* r = (const GAS f32x4*)(peer_v + (size_t)e * D) + lane; f32x4 v[4]; float am = 0.f;
#pragma unroll
                for (int j = 0; j < 4; ++j) { v[j] = r[64 * j]; am = fmaxf(fmaxf(am, fmaxf(fabsf(v[j].x), fabsf(v[j].y))), fmaxf(fabsf(v[j].z), fabsf(v[j].w))); }
                am = wave_max(am);
                const float sc = am > 0.f ? 4.f / am : 1.f; if (lane == 0) SU[4 * e + 1] = am > 0.f ? am * 0.25f : 1.f;
#pragma unroll
                for (int j = 0; j < 4; ++j) { int w = __builtin_amdgcn_cvt_pk_bf8_f32(v[j].x * sc, v[j].y * sc, 0, false); w = __builtin_amdgcn_cvt_pk_bf8_f32(v[j].z * sc, v[j].w * sc, w, true);
                    *(LAS unsigned*)(L + RING_OFF + el * 1024 + 4 * lane + 256 * j) = (unsigned)w; }
            }
            __syncthreads();
#pragma unroll
            for (int i = 0; i < 8; ++i) { const int idx = tid + 512 * i, sl = idx >> 5, k = idx & 31;
                const v2u a0 = *(const LAS v2u*)(L + RING_OFF + (2 * k) * 1024 + sl * 8), a1 = *(const LAS v2u*)(L + RING_OFF + (2 * k + 1) * 1024 + sl * 8);
                *(GAS v4u*)(V8T + ((size_t)sl * 16384 + e0 + 2 * k) * 8) = (v4u){a0.x, a0.y, a1.x, a1.y}; }
            __syncthreads();
        }
    }
    xcd_barrier(bar); TSTAMP();

    asm volatile("; ===== PHASE 2 =====");
    if (PH(2)) for (int rep = 0; rep < NREP(2); ++rep) {
        PH_LANES; const bool dummy = rep < NREP(2) - 1; (void)dummy;
        {
            const int cg = gt & 63;
            const f32x4 w0a = *(const GAS f32x4*)(w_conv + cg * 8), w0b = *(const GAS f32x4*)(w_conv + cg * 8 + 4);
            const f32x4 w1a = *(const GAS f32x4*)(w_conv + 512 + cg * 8), w1b = *(const GAS f32x4*)(w_conv + 512 + cg * 8 + 4);
            const f32x4 w2a = *(const GAS f32x4*)(w_conv + 1024 + cg * 8), w2b = *(const GAS f32x4*)(w_conv + 1024 + cg * 8 + 4);
#pragma unroll 1
            for (int i = gt; i < T * 64; i += 4 * NGT) {
                v4u u0[4], u1[4], u2[4], bq[4];
#pragma unroll
                for (int j = 0; j < 4; ++j) { const int ij = i + j * NGT; const int row = (ij < T * 64 ? ij : gt) >> 6, s = row & 2047;
                    u0[j] = *(const GAS v4u*)(U + (size_t)row * 512 + cg * 8);
                    u1[j] = (v4u){0u, 0u, 0u, 0u}; u2[j] = (v4u){0u, 0u, 0u, 0u};
                    if (s >= 1) u1[j] = *(const GAS v4u*)(U + (size_t)(row - 1) * 512 + cg * 8);
                    if (s >= 2) u2[j] = *(const GAS v4u*)(U + (size_t)(row - 2) * 512 + cg * 8);
                    bq[j] = *(const GAS v4u*)(YC + (size_t)row * 512 + cg * 8); }
                __builtin_amdgcn_sched_barrier(0);
#pragma unroll
                for (int j = 0; j < 4; ++j) { const int ij = i + j * NGT; if (ij >= T * 64) break; const int row = ij >> 6;
                    v4u o;
#define CONV2(q, wa, ia, ib) pk2(bflo(bq[j].q) * (w0##wa[ia] * bflo(u2[j].q) + w1##wa[ia] * bflo(u1[j].q) + w2##wa[ia] * bflo(u0[j].q)), bfhi(bq[j].q) * (w0##wa[ib] * bfhi(u2[j].q) + w1##wa[ib] * bfhi(u1[j].q) + w2##wa[ib] * bfhi(u0[j].q)))
                    o.x = CONV2(x, a, 0, 1); o.y = CONV2(y, a, 2, 3); o.z = CONV2(z, b, 0, 1); o.w = CONV2(w, b, 2, 3);
#undef CONV2
                    { const bool conv_dummy = (NREP(2) == 2) && !dummy; *(GAS v4u*)(YC + (size_t)row * 512 + cg * 8) = conv_dummy ? bq[j] : o; } }
            }
        }
        __syncthreads();
        const attn_body::AttnTensors AT{(const attn_body::bf16*)QO, (const attn_body::bf16*)KB, (const attn_body::bf16*)VB, (attn_body::bf16*)(dummy ? A : QO), kbar};
        const attn_body::StaticOrder S(G, bx);
        attn_body::attn_phase<attn_body::StaticOrder>((char*)lds + RING_OFF, AT, S);
    }
    xcd_barrier(bar); TSTAMP();

    asm volatile("; ===== PHASE 3 =====");
    if (PH(3)) for (int rep = 0; rep < NREP(3); ++rep) {
        PH_LANES; const bool dummy = rep < NREP(3) - 1; (void)dummy;
        pg8::Gemm g{512, 512, 512}; pg8::StaticOrder S; S.init(YC, 512, WcT, 512, T, 1024, G, bx);
        pg8::EpiGateMul E{SGC, dummy ? A : SGC, 1024};
        pg8::gemm_phase<pg8::EpiGateMul, pg8::StaticOrder, true>(L + RING_OFF, g, S, E);
    }
    if (PH(3)) for (int rep = 0; rep < NREP(3); ++rep) {
        PH_LANES; const bool dummy = rep < NREP(3) - 1; (void)dummy;
        pg8::Gemm g{512, 512, 512}; pg8::StaticOrder S; S.init(QO, 512, WaT, 512, T, 1024, G, bx);
        pg8::EpiGateFma E{SGC, SGA, dummy ? A : SGA, 1024};
        pg8::gemm_phase<pg8::EpiGateFma, pg8::StaticOrder, true>(L + RING_OFF, g, S, E);
    }
    xcd_barrier(bar); TSTAMP();

    asm volatile("; ===== PHASE 4 =====");
    if (PH(4)) for (int rep = 0; rep < NREP(4); ++rep) {
        PH_LANES; const bool dummy = rep < NREP(4) - 1; (void)dummy;
        pg8::Gemm g{1024, 1024, 1024}; pg8::StaticOrder S; S.init(SGA, 1024, WmT, 1024, T, 1024, G, bx);
        pg8::EpiResNorm<true> E{x, A, SSQ1, 1024, 1.f};
        pg8::gemm_phase<pg8::EpiResNorm<true>, pg8::StaticOrder, true>(L + RING_OFF, g, S, E);
    }
    xcd_barrier(bar); TSTAMP();

    asm volatile("; ===== PHASE 6 =====");
    if (PH(6)) for (int rep = 0; rep < NREP(6); ++rep) {
        PH_LANES; const bool dummy = rep < NREP(6) - 1; (void)dummy;
        const pg8::Gemm gq{1024, 1024, 1024}, gs{1024, 1024, 256}, gv{1024, 4096, 256};
        const pg8::EpiBf16RS Eq{QX, 1024, SSQ1}; const pg8::EpiSoftmax Es{PM, 1024, 0.0625f * 1.4426950408889634f}; const pg8::EpiBf16 Ev{OX, 1024};
        { XOrder S{(const char*)A, (const char*)WxqT, G, vcu, 0, 0}; pg8::gemm_phase<pg8::EpiBf16RS, XOrder, false>(L + RING_OFF, gq, S, Eq); }
        VM_WAIT(); __syncthreads();
        { XOrder S{(const char*)QX, (const char*)KX, G, vcu, 0, 1}; pg8::gemm_phase<pg8::EpiSoftmax, XOrder, false>(L + RING_OFF, gs, S, Es); }
        VM_WAIT(); __syncthreads();
        { XOrder S{(const char*)PM, (const char*)VXT, G, vcu, 0, 2}; pg8::gemm_phase<pg8::EpiBf16, XOrder, false>(L + RING_OFF, gv, S, Ev); }
        VM_WAIT(); __syncthreads();
        { XOrder S{(const char*)A, (const char*)WxqT, G, vcu, 1, 0}; pg8::gemm_phase<pg8::EpiBf16RS, XOrder, false>(L + RING_OFF, gq, S, Eq); }
        VM_WAIT(); __syncthreads();
        { XOrder S{(const char*)QX, (const char*)KX, G, vcu, 1, 1}; pg8::gemm_phase<pg8::EpiSoftmax, XOrder, false>(L + RING_OFF, gs, S, Es); }
        VM_WAIT(); __syncthreads();
        { XOrder S{(const char*)PM, (const char*)VXT, G, vcu, 1, 2}; pg8::gemm_phase<pg8::EpiBf16, XOrder, false>(L + RING_OFF, gv, S, Ev); }
    }
    xcd_barrier(bar); TSTAMP();

    asm volatile("; ===== PHASE 9 =====");
    if (PH(9)) for (int rep = 0; rep < NREP(9); ++rep) {
        PH_LANES; const bool dummy = rep < NREP(9) - 1; (void)dummy;
        pg8::Gemm g{1024, 1024, 1024}; pg8::StaticOrder S; S.init(OX, 1024, WxoT, 1024, T, 1024, G, bx);
        pg8::EpiResNorm<false> E{nullptr, A, SSQ2, 1024, dummy ? 0.f : 1.f};
        pg8::gemm_phase<pg8::EpiResNorm<false>, pg8::StaticOrder, true>(L + RING_OFF, g, S, E);
    }
    xcd_barrier(bar); TSTAMP();

    asm volatile("; ===== PHASE 11 =====");
    if (PH(11)) for (int rep = 0; rep < NREP(11); ++rep) {
        PH_LANES; const bool dummy = rep < NREP(11) - 1; (void)dummy;
        typedef _Float16 h8 __attribute__((ext_vector_type(8)));
#define RCE(a, b) do { const float hi_ = fmax_asm(a, b); b = fmin_asm(a, b); a = hi_; } while (0)
#define RSORT16(K) do { RCE(K[0], K[1]); RCE(K[3], K[2]); RCE(K[4], K[5]); RCE(K[7], K[6]); RCE(K[8], K[9]); RCE(K[11], K[10]); RCE(K[12], K[13]); RCE(K[15], K[14]); RCE(K[0], K[2]); RCE(K[1], K[3]); RCE(K[6], K[4]); RCE(K[7], K[5]); RCE(K[8], K[10]); RCE(K[9], K[11]); RCE(K[14], K[12]); RCE(K[15], K[13]); RCE(K[0], K[1]); RCE(K[2], K[3]); RCE(K[5], K[4]); RCE(K[7], K[6]); RCE(K[8], K[9]); RCE(K[10], K[11]); RCE(K[13], K[12]); RCE(K[15], K[14]); RCE(K[0], K[4]); RCE(K[1], K[5]); RCE(K[2], K[6]); RCE(K[3], K[7]); RCE(K[12], K[8]); RCE(K[13], K[9]); RCE(K[14], K[10]); RCE(K[15], K[11]); RCE(K[0], K[2]); RCE(K[1], K[3]); RCE(K[4], K[6]); RCE(K[5], K[7]); RCE(K[10], K[8]); RCE(K[11], K[9]); RCE(K[14], K[12]); RCE(K[15], K[13]); RCE(K[0], K[1]); RCE(K[2], K[3]); RCE(K[4], K[5]); RCE(K[6], K[7]); RCE(K[9], K[8]); RCE(K[11], K[10]); RCE(K[13], K[12]); RCE(K[15], K[14]); RCE(K[0], K[8]); RCE(K[1], K[9]); RCE(K[2], K[10]); RCE(K[3], K[11]); RCE(K[4], K[12]); RCE(K[5], K[13]); RCE(K[6], K[14]); RCE(K[7], K[15]); RCE(K[0], K[4]); RCE(K[1], K[5]); RCE(K[2], K[6]); RCE(K[3], K[7]); RCE(K[8], K[12]); RCE(K[9], K[13]); RCE(K[10], K[14]); RCE(K[11], K[15]); RCE(K[0], K[2]); RCE(K[1], K[3]); RCE(K[4], K[6]); RCE(K[5], K[7]); RCE(K[8], K[10]); RCE(K[9], K[11]); RCE(K[12], K[14]); RCE(K[13], K[15]); RCE(K[0], K[1]); RCE(K[2], K[3]); RCE(K[4], K[5]); RCE(K[6], K[7]); RCE(K[8], K[9]); RCE(K[10], K[11]); RCE(K[12], K[13]); RCE(K[14], K[15]); } while (0)
#define RMERGE16(K) do { RCE(K[0], K[8]); RCE(K[1], K[9]); RCE(K[2], K[10]); RCE(K[3], K[11]); RCE(K[4], K[12]); RCE(K[5], K[13]); RCE(K[6], K[14]); RCE(K[7], K[15]); RCE(K[0], K[4]); RCE(K[1], K[5]); RCE(K[2], K[6]); RCE(K[3], K[7]); RCE(K[8], K[12]); RCE(K[9], K[13]); RCE(K[10], K[14]); RCE(K[11], K[15]); RCE(K[0], K[2]); RCE(K[1], K[3]); RCE(K[4], K[6]); RCE(K[5], K[7]); RCE(K[8], K[10]); RCE(K[9], K[11]); RCE(K[12], K[14]); RCE(K[13], K[15]); RCE(K[0], K[1]); RCE(K[2], K[3]); RCE(K[4], K[5]); RCE(K[6], K[7]); RCE(K[8], K[9]); RCE(K[10], K[11]); RCE(K[12], K[13]); RCE(K[14], K[15]); } while (0)
#define RKEYS(K, V0, V1, IDB) do { _Pragma("unroll") for (int e = 0; e < 8; ++e) { K[e] = __uint_as_float(__float_as_uint((float)V0[e]) | (unsigned)((IDB) + e)); K[8 + e] = __uint_as_float(__float_as_uint((float)V1[e]) | (unsigned)((IDB) + 8 + e)); } } while (0)
        pg8::Gemm g{1024, 1024, 1024};
        const EpiTile E{SSQ2};
#pragma unroll 1
        for (int ui = 0; ui < (T / 256) * 8; ++ui) {
            pg8::Unit cu_;
            {
                constexpr int nM = T / 256, nN = 8, nwg = nM * nN;
                const int Lq = ui * G + bx; if (Lq >= nwg) break;
                int wgid = Lq; { const int q = nwg / pg8::NXCD, r = nwg % pg8::NXCD, xcd = wgid % pg8::NXCD, off = wgid / pg8::NXCD; wgid = (xcd < r ? xcd * (q + 1) : r * (q + 1) + (xcd - r) * q) + off; }
                const int nig = pg8::WGM * nN, gid = wgid / nig, fm = gid * pg8::WGM, gsz = (nM - fm) < pg8::WGM ? (nM - fm) : pg8::WGM;
                cu_.pm = fm + ((wgid % nig) % gsz); cu_.pn = (wgid % nig) / gsz;
                cu_.a = (const char*)A + (size_t)cu_.pm * 256 * 1024 * 2; cu_.b = (const char*)MT + (size_t)cu_.pn * 256 * 1024 * 2; }
            { const OneUnit O{cu_}; pg8::gemm_phase<EpiTile, OneUnit, false>(L + RING_OFF, g, O, E); }
            __syncthreads();
            { int tl_ = threadIdx.x; asm volatile("" : "+v"(tl_)); tid = tl_; }
            const int lane = tid & 63;
            if (wave >= 4) {
            const int qt0 = cu_.pm * 256 + cu_.pn * 32 + (wave - 4) * 8;
        for (int tb4 = qt0; tb4 < qt0 + 8; tb4 += 4) {
            v4u r0[4], r1[4]; float sq[4];
#pragma unroll
            for (int i = 0; i < 4; ++i) { const GAS v4u* ar = (const GAS v4u*)(A + (size_t)(tb4 + i) * D + 16 * lane); r0[i] = ar[0]; r1[i] = ar[1]; sq[i] = lane < 16 ? SSQ2[(size_t)(tb4 + i) * 16 + lane] : 0.f; }
#pragma unroll
            for (int i = 0; i < 4; ++i) {
                float a[16];
                a[0] = bflo(r0[i].x); a[1] = bfhi(r0[i].x); a[2] = bflo(r0[i].y); a[3] = bfhi(r0[i].y); a[4] = bflo(r0[i].z); a[5] = bfhi(r0[i].z); a[6] = bflo(r0[i].w); a[7] = bfhi(r0[i].w);
                a[8] = bflo(r1[i].x); a[9] = bfhi(r1[i].x); a[10] = bflo(r1[i].y); a[11] = bfhi(r1[i].y); a[12] = bflo(r1[i].z); a[13] = bfhi(r1[i].z); a[14] = bflo(r1[i].w); a[15] = bfhi(r1[i].w);
                float amx = 0.f;
#pragma unroll
                for (int k = 0; k < 16; ++k) amx = fmaxf(amx, fabsf(a[k]));
                amx = wave_max(amx);
                const float rs2 = rsqrtf(wave_sum(sq[i]) * (1.f / 1024.f) + RMS_EPS);
                const float asc = amx > 0.f ? 127.f / amx : 1.f;
                v4u qv;
#define Q1(k, sel, old) __builtin_amdgcn_cvt_pk_u8_f32(__builtin_rintf(__builtin_fmaf(a[k], asc, 128.f)), sel, old)
                qv.x = Q1(3, 3, Q1(2, 2, Q1(1, 1, Q1(0, 0, 0u)))); qv.y = Q1(7, 3, Q1(6, 2, Q1(5, 1, Q1(4, 0, 0u)))); qv.z = Q1(11, 3, Q1(10, 2, Q1(9, 1, Q1(8, 0, 0u)))); qv.w = Q1(15, 3, Q1(14, 2, Q1(13, 1, Q1(12, 0, 0u))));
#undef Q1
                { const unsigned sh_ = lane < 32 ? 0u : 4u; v4u ov;
#define NP(q) do { auto r_ = __builtin_amdgcn_permlane32_swap(q, q, false, false);         \
                    ov_ = ((r_[0] >> sh_) & 0x0f0f0f0fu) | (((r_[1] >> sh_) & 0x0f0f0f0fu) << 4); } while (0)
                  unsigned ov_;
                  NP(qv.x); ov.x = ov_; NP(qv.y); ov.y = ov_; NP(qv.z); ov.z = ov_; NP(qv.w); ov.w = ov_;
#undef NP
                  *(GAS v4u*)(A8I + (size_t)(tb4 + i) * 1024 + 16 * lane) = ov; }
                float sa = (float)__builtin_amdgcn_sad_u8(qv.w, 0u, __builtin_amdgcn_sad_u8(qv.z, 0u, __builtin_amdgcn_sad_u8(qv.y, 0u, __builtin_amdgcn_sad_u8(qv.x, 0u, 0u))));
                sa = wave_sum(sa);
                if (lane == 0) { ASC[tb4 + i] = (amx > 0.f ? amx * (1.f / 127.f) : 1.f) * rs2; ASC[T + tb4 + i] = sa; }
            }
        }
            } else {
        LAS unsigned char* idl = L + UL_OFF + tid * 32;
        {
            const int rl_ = wave * 64 + lane; const int t = cu_.pm * 256 + rl_, h = cu_.pn;
            const LAS _Float16* row = (const LAS _Float16*)(L + RING_OFF + rl_ * 16);
            float LA[16], LB[16];
#pragma unroll 1
            for (int p = 0; p < 2; ++p) {
                const LAS _Float16* rp = row + p * 16 * 2048;
                float Tk[16];
                h8 n0 = *(const LAS h8*)(rp + 2 * 2048), n1 = *(const LAS h8*)(rp + 3 * 2048);
                { const h8 v0 = *(const LAS h8*)rp, v1 = *(const LAS h8*)(rp + 2048); RKEYS(Tk, v0, v1, 0); RSORT16(Tk); }
#pragma unroll 1
                for (int c = 1; c < 8; ++c) {
                    const h8 v0 = n0, v1 = n1;
                    { const int cn = c < 7 ? c + 1 : c; n0 = *(const LAS h8*)(rp + (2 * cn) * 2048); n1 = *(const LAS h8*)(rp + (2 * cn + 1) * 2048); }
                    float K[16]; RKEYS(K, v0, v1, c * 16); RSORT16(K);
#pragma unroll
                    for (int i = 0; i < 16; ++i) Tk[i] = fmax_asm(Tk[i], K[15 - i]);
                    RMERGE16(Tk);
                }
#pragma unroll
                for (int k = 0; k < 16; ++k) { if (p == 0) LA[k] = Tk[k]; else LB[k] = Tk[k]; }
            }
#pragma unroll
            for (int k = 0; k < 16; k += 4) {
                ((LAS unsigned*)idl)[k >> 2] = (__float_as_uint(LA[k]) & 127u) | ((__float_as_uint(LA[k + 1]) & 127u) << 8) | ((__float_as_uint(LA[k + 2]) & 127u) << 16) | ((__float_as_uint(LA[k + 3]) & 127u) << 24);
                ((LAS unsigned*)idl)[4 + (k >> 2)] = (__float_as_uint(LB[k]) & 127u) | ((__float_as_uint(LB[k + 1]) & 127u) << 8) | ((__float_as_uint(LB[k + 2]) & 127u) << 16) | ((__float_as_uint(LB[k + 3]) & 127u) << 24);
            }
#define CKEY(a, b) __uint_as_float((__float_as_uint(LA[a] + LB[b]) & ~255u) | (unsigned)(255 - (16 * (a) + (b))))
            float Ck[16];
#pragma unroll
            for (int a = 0; a < 16; ++a) Ck[a] = CKEY(a, 0);
#define CRUN(b, n) do { _Pragma("unroll") for (int j = 0; j < (n); ++j) Ck[15 - j] = fmax_asm(Ck[15 - j], CKEY(j, b)); RMERGE16(Ck); } while (0)
            CRUN(1, 8); CRUN(2, 5); CRUN(3, 4); CRUN(4, 3); CRUN(5, 2); CRUN(6, 2); CRUN(7, 2);
#pragma unroll
            for (int j = 0; j < 8; ++j) Ck[15 - j] = fmax_asm(Ck[15 - j], CKEY(0, 8 + j));
            RMERGE16(Ck);
#undef CRUN
#undef CKEY
            LDS_WAIT();
            float ex[16]; float sum = 0.f;
#pragma unroll
            for (int k = 0; k < 16; ++k) { ex[k] = __expf(Ck[k] - Ck[0]); sum += ex[k]; }
            const float rs = 1.f / sum;
            int* eo = EIDX + (size_t)t * 128 + h * 16;
#pragma unroll
            for (int k = 0; k < 16; k += 4) {
                int ev[4];
#pragma unroll
                for (int j = 0; j < 4; ++j) { const unsigned id = 255u - (__float_as_uint(Ck[k + j]) & 255u); ev[j] = (int)idl[id >> 4] * 128 + (int)idl[16 + (id & 15u)]; }
                *(GAS v4u*)(eo + k) = (v4u){(pk2(0.f, ex[k] * rs) & 0xffff0000u) | (unsigned)ev[0], (pk2(0.f, ex[k + 1] * rs) & 0xffff0000u) | (unsigned)ev[1],
                                             (pk2(0.f, ex[k + 2] * rs) & 0xffff0000u) | (unsigned)ev[2], (pk2(0.f, ex[k + 3] * rs) & 0xffff0000u) | (unsigned)ev[3]};
            }
            LDS_WAIT();
        }
            }
            __syncthreads();
        }
#undef RCE
#undef RSORT16
#undef RMERGE16
#undef RKEYS
    }
    xcd_barrier(bar); TSTAMP();


    asm volatile("; ===== PHASE 13 =====");
    if (PH(13)) for (int rep = 0; rep < NREP(13); ++rep) {
        PH_LANES; const bool dummy = rep < NREP(13) - 1; (void)dummy;
        volatile LAS unsigned* qslot = (volatile LAS unsigned*)(L + LDSCTL_OFF + 64);
        LAS unsigned char* tile = L + RING_OFF + wave * 16384;
        LAS float* rsl = (LAS float*)(L + UL_OFF + wave * UL_WAVE);
        LAS v2u* lst = (LAS v2u*)(L + UL_OFF + wave * UL_WAVE + 128);
        const int xs = (int)(xb_xcc_id() & 7u);
        __syncthreads();
        if (tid == 0) *qslot = __hip_atomic_fetch_add((unsigned*)(ctl + CW_Q + 64 * (rep * 8 + xs)), 1u, __ATOMIC_RELAXED, __HIP_MEMORY_SCOPE_AGENT);
        __syncthreads();
        const int rank = __builtin_amdgcn_readfirstlane((int)*qslot);
        int cnt[8];
#pragma unroll
        for (int j = 0; j < 8; ++j) cnt[j] = __builtin_amdgcn_readfirstlane((int)(xb_ld(bar.bar + XB_XCNT(j)) + xb_ld(bar.bar + XB_XCNT(j + 8))));
#pragma unroll 1
        for (int x = 0; x < 8; ++x) {
            int cn = 0;
#pragma unroll
            for (int j = 0; j < 8; ++j) cn = (j == x) ? cnt[j] : cn;
            int j0, jstep;
            if (x == xs) { j0 = rank * 8 + wave; jstep = cn * 8; } else if (cn == 0) { j0 = bx * 8 + wave; jstep = G * 8; } else continue;
#pragma unroll 1
            for (int job = j0; job < T / 16; job += jstep) {
                const int t0 = job * 16;
#pragma unroll 1
                for (int r0 = 0;; r0 += UL_CAP) {
                    int ln = lane; asm volatile("" : "+v"(ln));
#pragma unroll
                    for (int tl = 0; tl < 16; ++tl)
                        __builtin_amdgcn_global_load_lds((const unsigned*)(A8I + (size_t)(t0 + tl) * 1024 + ln * 16), (LAS unsigned*)(tile + tl * 1024), 16, 0, 0);
                    const float av_ = ASC[(ln & 16) * (T / 16) + t0 + (ln & 15)];
                    int total = 0;
                    unsigned pa[16], pb[16];
#pragma unroll
                    for (int tl = 0; tl < 16; ++tl) { pa[tl] = (unsigned)EIDX[(size_t)(t0 + tl) * 128 + ln]; pb[tl] = (unsigned)EIDX[(size_t)(t0 + tl) * 128 + 64 + ln]; }
#pragma unroll
                    for (int tl = 0; tl < 16; ++tl) {
                        const bool h0 = (int)((pa[tl] & 0xffffu) >> 11) == x, h1 = (int)((pb[tl] & 0xffffu) >> 11) == x;
                        const unsigned long long m0 = __ballot(h0), m1 = __ballot(h1);
                        const int k0 = total - r0 + (int)__builtin_amdgcn_mbcnt_hi((unsigned)(m0 >> 32), __builtin_amdgcn_mbcnt_lo((unsigned)m0, 0u));
                        const int k1 = total - r0 + __popcll(m0) + (int)__builtin_amdgcn_mbcnt_hi((unsigned)(m1 >> 32), __builtin_amdgcn_mbcnt_lo((unsigned)m1, 0u));
                        if (h0 && k0 >= 0 && k0 < UL_CAP) lst[k0] = (v2u){pa[tl], (unsigned)((tl << 7) | ln)};
                        if (h1 && k1 >= 0 && k1 < UL_CAP) lst[k1] = (v2u){pb[tl], (unsigned)((tl << 7) | 64 | ln)};
                        total += __popcll(m0) + __popcll(m1);
                    }
                    rsl[ln & 31] = av_;
                    asm volatile("s_waitcnt vmcnt(0)" ::: "memory");
                    const int count = (total - r0) < UL_CAP ? (total - r0) : UL_CAP;
                    asm volatile("s_waitcnt lgkmcnt(0)" ::: "memory");
#define JLOAD(Q, EN, B16) do { const int myi_ = (B16) + (lane >> 2); EN = lst[myi_ < count ? myi_ : count - 1];         \
                        const unsigned char* rp_ = U8 + (size_t)(EN.x & 0xffffu) * 512 + (lane & 3) * 16; \
                        EN##s = *(const GAS f32x3*)(SU + 4 * (EN.x & 0xffffu));                                             \
                        _Pragma("unroll") for (int j = 0; j < 8; ++j) Q[j] = *(const GAS v4u*)(rp_ + j * 64); } while (0)
#define UD8(w, aa, acc) __builtin_amdgcn_udot8((unsigned)(w), (unsigned)(aa), (unsigned)(acc), false)
#define JCOMP(Q, EN, B16) do { const LAS unsigned char* ap_ = tile + (EN.y >> 7) * 1024 + (lane & 3) * 16; unsigned d0 = 0, d1 = 0, d2 = 0, d3 = 0, g0 = 0, g1 = 0, g2 = 0, g3 = 0; \
                        v4u ql_[8], qh_[8];                                                                             \
                        _Pragma("unroll") for (int j = 0; j < 8; ++j) { ql_[j] = *(const LAS v4u*)(ap_ + j * 64); qh_[j] = *(const LAS v4u*)(ap_ + 512 + j * 64); }        \
                        __builtin_amdgcn_sched_barrier(0); \
                        _Pragma("unroll") for (int j = 0; j < 8; ++j) { \
                            d0 = UD8(Q[j].x, ql_[j].x, d0); d1 = UD8(Q[j].y, ql_[j].y, d1); d2 = UD8(Q[j].z, ql_[j].z, d2); d3 = UD8(Q[j].w, ql_[j].w, d3); \
                            g0 = UD8(Q[j].x, qh_[j].x, g0); g1 = UD8(Q[j].y, qh_[j].y, g1); g2 = UD8(Q[j].z, qh_[j].z, g2); g3 = UD8(Q[j].w, qh_[j].w, g3); } \
                        int doti = (int)(((d0 + d1) + (d2 + d3)) + ((((g0 + g1) + (g2 + g3))) << 4));                       \
                        doti += __builtin_amdgcn_mov_dpp(doti, 0xB1, 0xf, 0xf, true); doti += __builtin_amdgcn_mov_dpp(doti, 0x4E, 0xf, 0xf, true);        \
                        {                                                                                               \
                            const int e = (int)(EN.x & 0xffffu), slot = (int)(EN.y & 127u); const int tl_ = (int)(EN.y >> 7); const int t = t0 + tl_; \
                            const float dq = ((float)doti - 128.f * EN##s.z) - (8.f * rsl[16 + tl_] - 1048576.f);               \
                            const float act = dq * (EN##s.x * rsl[tl_]); const float u3 = 0.7978845608028654f * (act + 0.044715f * act * act * act); \
                            const float wv = act * __builtin_amdgcn_rcpf(1.f + __expf(-2.f * u3)) * (__uint_as_float(EN.x & 0xffff0000u) * EN##s.y);             \
                            (void)t; (void)slot; const int oi_ = (B16) + (lane >> 2); ((LAS unsigned*)lst)[2 * (oi_ < count ? oi_ : UL_CAP)] = ((unsigned)__builtin_bit_cast(unsigned short, (_Float16)wv) << 16) | (unsigned)e;     } } while (0)
                    if (count > 0) {
                        v4u qa[8], qb[8], qc[8], qd[8]; v2u ena, enb, enc, end_; f32x3 enas, enbs, encs, end_s;
                        int b16 = 0;
                        if (96 < count) {
                            JLOAD(qa, ena, 0); asm volatile("" ::: "memory"); JLOAD(qb, enb, 16); asm volatile("" ::: "memory"); JLOAD(qc, enc, 32); asm volatile("" ::: "memory");
#pragma unroll 1
                            for (; b16 + 96 < count; b16 += 64) {
                                JLOAD(qd, end_, b16 + 48); JCOMP(qa, ena, b16);
                                JLOAD(qa, ena, b16 + 64); JCOMP(qb, enb, b16 + 16);
                                JLOAD(qb, enb, b16 + 80); JCOMP(qc, enc, b16 + 32);
                                JLOAD(qc, enc, b16 + 96); JCOMP(qd, end_, b16 + 48);
                            }
                        } else {
                            JLOAD(qa, ena, 0);
                            if (16 < count) JLOAD(qb, enb, 16);
                            if (32 < count) JLOAD(qc, enc, 32);
                        }
#pragma unroll 1
                        for (; b16 < count; b16 += 64) {
                            if (b16 + 48 < count) JLOAD(qd, end_, b16 + 48);
                            JCOMP(qa, ena, b16);
                            if (b16 + 16 < count) { if (b16 + 64 < count) JLOAD(qa, ena, b16 + 64); JCOMP(qb, enb, b16 + 16); }
                            if (b16 + 32 < count) { if (b16 + 80 < count) JLOAD(qb, enb, b16 + 80); JCOMP(qc, enc, b16 + 32); }
                            if (b16 + 48 < count) { if (b16 + 96 < count) JLOAD(qc, enc, b16 + 96); JCOMP(qd, end_, b16 + 48); }
                        }
                        asm volatile("s_waitcnt lgkmcnt(0)" ::: "memory");
#pragma unroll 1
                        for (int i = lane; i < count; i += 64) { const v2u en_ = lst[i]; const int t = t0 + (int)(en_.y >> 7), slot = (int)(en_.y & 127u);
                            PW[((size_t)((t >> 6) * 8 + (slot >> 4)) * 4 + ((slot >> 2) & 3)) * 256 + (t & 63) * 4 + (slot & 3)] = en_.x; }
                    }
#undef UD8
#undef JLOAD
#undef JCOMP
                    asm volatile("s_waitcnt lgkmcnt(0)" ::: "memory");
                    if (r0 + UL_CAP >= total) break;
                }
            }
        }
        __syncthreads();
    }
    xcd_barrier(bar); TSTAMP();

    asm volatile("; ===== PHASE 14 =====");
    if (PH(14)) for (int rep = 0; rep < NREP(14); ++rep) {
        PH_LANES; const bool dummy = rep < NREP(14) - 1; (void)dummy;
        for (int item = vcu; item < 256; item += G) {
            const int sl = item & 127, half = item >> 7;
            __syncthreads();
#pragma unroll
            for (int i = 0; i < 16; ++i) *(LAS v4u*)(L + RING_OFF + (i * 512 + tid) * 16) = *(const GAS v4u*)(V8T + (size_t)sl * 131072 + (size_t)(i * 512 + tid) * 16);
            __syncthreads();
            const GAS v4u* pwb = (const GAS v4u*)(PW + (size_t)(half * 256 + wave) * 8192) + lane;
            v4u buf[4][4];
#pragma unroll
            for (int c = 0; c < 4; ++c)
#pragma unroll
                for (int k = 0; k < 4; ++k) buf[c][k] = pwb[c * 256 + k * 64];
            v2u tbA[8], tbB[8];
            unsigned accu[4] = {0u, 0u, 0u, 0u};
#define VREFILL(SL, SN) do { const int sn = (SN); const int gn = (sn >> 3) > 31 ? 31 : (sn >> 3), cc = sn & 7; const GAS v4u* src = pwb + (size_t)gn * 8 * 2048 + cc * 256;        \
                    _Pragma("unroll") for (int k = 0; k < 4; ++k) buf[SL][k] = src[k * 64]; } while (0)
#define VG2(TB, SL, K0) do { _Pragma("unroll") for (int k = 0; k < 2; ++k) _Pragma("unroll") for (int i = 0; i < 4; ++i) { unsigned e_ = buf[SL][(K0) + k][i] & 0xffffu; asm("" : "+v"(e_));         \
                    TB[k * 4 + i] = *(const LAS v2u*)(L + RING_OFF + (e_ << 3)); } } while (0)
#define VFMA(ACC, T) asm("v_pk_fma_f16 %0, %1, %2, %0 op_sel:[0,1,0] op_sel_hi:[1,1,1]" : "+v"(ACC) : "v"(T), "v"(p))
#define VC2(TB, SL, K0) do { _Pragma("unroll") for (int k = 0; k < 2; ++k) _Pragma("unroll") for (int i = 0; i < 4; ++i) { const unsigned p = buf[SL][(K0) + k][i]; const v2u q = TB[k * 4 + i]; \
                    const unsigned t0_ = __builtin_amdgcn_perm(0u, q.x, 0x010c000cu), t1_ = __builtin_amdgcn_perm(0u, q.x, 0x030c020cu), t2_ = __builtin_amdgcn_perm(0u, q.y, 0x010c000cu), t3_ = __builtin_amdgcn_perm(0u, q.y, 0x030c020cu); \
                    VFMA(accu[0], t0_); VFMA(accu[1], t1_); VFMA(accu[2], t2_); VFMA(accu[3], t3_); } } while (0)
#define VSTEP(C) do { VG2(tbA, (C) & 3, 0); VC2(tbB, ((C) - 1) & 3, 2); VREFILL(((C) - 1) & 3, itk * 8 + (C) + 3); VG2(tbB, (C) & 3, 2); VC2(tbA, (C) & 3, 0); } while (0)
#pragma unroll 1
            for (int itk = 0; itk <= 32; ++itk) {
                if (itk < 32) VG2(tbA, 0, 0);
                if (itk > 0) {
                    VC2(tbB, 3, 2);
                    const int g64 = half * 256 + (itk - 1) * 8 + wave;
                    const int t = g64 * 64 + lane;
                    GAS v4u* hr = (GAS v4u*)(A + (size_t)t * D + sl * 8);
                    const v4u hq = *hr; const float mulv = dummy ? 0.f : 1.f;
                    h2v acc[4];
#pragma unroll
                    for (int i = 0; i < 4; ++i) { const unsigned au_ = accu[i]; acc[i] = __builtin_bit_cast(h2v, au_); }
                    v4u ho; ho.x = pk2(bflo(hq.x) + (float)acc[0].x * mulv, bfhi(hq.x) + (float)acc[0].y * mulv); ho.y = pk2(bflo(hq.y) + (float)acc[1].x * mulv, bfhi(hq.y) + (float)acc[1].y * mulv);
                    ho.z = pk2(bflo(hq.z) + (float)acc[2].x * mulv, bfhi(hq.z) + (float)acc[2].y * mulv); ho.w = pk2(bflo(hq.w) + (float)acc[3].x * mulv, bfhi(hq.w) + (float)acc[3].y * mulv);
                    *hr = ho;
                }
                if (itk == 32) break;
                if (itk > 0) VREFILL(3, itk * 8 + 3);
                accu[0] = accu[1] = accu[2] = accu[3] = 0u;
                VG2(tbB, 0, 2); VC2(tbA, 0, 0);
                VSTEP(1); VSTEP(2); VSTEP(3); VSTEP(4); VSTEP(5); VSTEP(6); VSTEP(7);
            }
#undef VREFILL
#undef VG2
#undef VFMA
#undef VC2
#undef VSTEP
        }
    }
    xcd_barrier(bar); TSTAMP();

#ifdef EXTRA_BARRIERS
    for (int eb = 0; eb < EXTRA_BARRIERS; ++eb) xcd_barrier(bar);
#endif
    asm volatile("; ===== PHASE 15 =====");
    if (PH(15)) for (int rep = 0; rep < NREP(15); ++rep) {
        PH_LANES; const bool dummy = rep < NREP(15) - 1; (void)dummy;
        const GAS f32x4* gr = (const GAS f32x4*)(g_final + 16 * lane); const f32x4 g0 = gr[0], g1 = gr[1], g2 = gr[2], g3 = gr[3];
#pragma unroll 1
        for (int t = gw; t < T; t += 4 * NGW) {
            v4u q0[4], q1[4];
#pragma unroll
            for (int j = 0; j < 4; ++j) { const int tj = t + j * NGW < T ? t + j * NGW : t; const GAS v4u* hr = (const GAS v4u*)(A + (size_t)tj * D + 16 * lane); q0[j] = hr[0]; q1[j] = hr[1]; }
            __builtin_amdgcn_sched_barrier(0);
#pragma unroll
            for (int j = 0; j < 4; ++j) { if (t + j * NGW >= T) break;
                GAS f32x4* orow = (GAS f32x4*)(out + (size_t)(t + j * NGW) * D + 16 * lane);
                f32x4 o[4] = {(f32x4){bflo(q0[j].x), bfhi(q0[j].x), bflo(q0[j].y), bfhi(q0[j].y)}, (f32x4){bflo(q0[j].z), bfhi(q0[j].z), bflo(q0[j].w), bfhi(q0[j].w)},
                              (f32x4){bflo(q1[j].x), bfhi(q1[j].x), bflo(q1[j].y), bfhi(q1[j].y)}, (f32x4){bflo(q1[j].z), bfhi(q1[j].z), bflo(q1[j].w), bfhi(q1[j].w)}};
                float ss = 0.f;
#pragma unroll
                for (int k = 0; k < 4; ++k) ss += (o[k].x * o[k].x + o[k].y * o[k].y) + (o[k].z * o[k].z + o[k].w * o[k].w);
                const float r = rsqrtf(wave_sum(ss) * (1.f / 1024.f) + RMS_EPS);
                orow[0] = o[0] * r * g0; orow[1] = o[1] * r * g1; orow[2] = o[2] * r * g2; orow[3] = o[3] * r * g3; }
        }
    }
}

extern "C" void kernel_launch(void* const* d_in, const int* in_sizes, int n_in, void* d_out, int out_size, void* d_ws, size_t ws_size, hipStream_t stream) {
    static int grid = 0;
    if (grid == 0) {
        if (n_in != 19 || out_size != T * D || ws_size < WS_END) { fprintf(stderr, "kernel_launch: unexpected problem (n_in %d, out %d, ws %zu < %zu); nothing launched\n", n_in, out_size, ws_size, (size_t)WS_END); grid = -1; return; }
        int dev = 0, cus = 0, per_cu = 0;
        if (hipGetDevice(&dev) != hipSuccess || hipDeviceGetAttribute(&cus, hipDeviceAttributeMultiprocessorCount, dev) != hipSuccess) { grid = -1; return; }
        if (hipFuncSetAttribute((const void*)mk_fwd, hipFuncAttributeMaxDynamicSharedMemorySize, LDS_BYTES) != hipSuccess) { fprintf(stderr, "kernel_launch: hipFuncSetAttribute failed\n"); grid = -1; return; }
        if (hipOccupancyMaxActiveBlocksPerMultiprocessor(&per_cu, (const void*)mk_fwd, NWAVES * 64, LDS_BYTES) != hipSuccess || per_cu < 1) { fprintf(stderr, "kernel_launch: occupancy query says %d blocks per CU\n", per_cu); }
        (void)hipGetLastError();
        grid = cus;
    }
    if (grid < 0) return;
    if (hipMemsetAsync((char*)d_ws + WS_CTL, 0, CTL_ZERO_BYTES, stream) != hipSuccess) return;
    Args a{};
    for (int i = 0; i < 19; ++i) a.in[i] = (const float*)d_in[i];
    a.out = (float*)d_out; a.ws = (unsigned char*)d_ws;
    hipLaunchKernelGGL(mk_fwd, dim3(grid), dim3(NWAVES * 64), LDS_BYTES, stream, a);
}
```

```cpp
#include <hip/hip_runtime.h>
#include <hip/hip_bf16.h>
#include <cstdio>
#include <cstdint>
#include <cmath>

#ifndef DIAG
#define DIAG 0
#endif


template <int O> __device__ __forceinline__ float shx(float v) { static_assert(O > 0 && O < 32, "shx"); return __uint_as_float((unsigned)__builtin_amdgcn_ds_swizzle((int)__float_as_uint(v), (O << 10) | 0x1f)); }
__device__ __forceinline__ float sum32(float v) { auto r = __builtin_amdgcn_permlane32_swap(__float_as_uint(v), __float_as_uint(v), false, false); return __uint_as_float(r[0]) + __uint_as_float(r[1]); }
__device__ __forceinline__ float max32(float v) { auto r = __builtin_amdgcn_permlane32_swap(__float_as_uint(v), __float_as_uint(v), false, false); return fmaxf(__uint_as_float(r[0]), __uint_as_float(r[1])); }
__device__ __forceinline__ float wave_max(float v) { v = fmaxf(v, shx<1>(v)); v = fmaxf(v, shx<2>(v)); v = fmaxf(v, shx<4>(v)); v = fmaxf(v, shx<8>(v)); v = fmaxf(v, shx<16>(v)); return max32(v); }
__device__ __forceinline__ float wave_sum(float v) { v += shx<1>(v); v += shx<2>(v); v += shx<4>(v); v += shx<8>(v); v += shx<16>(v); return sum32(v); }

namespace pg8 {
#define PG8_LAS __attribute__((address_space(3)))
typedef unsigned short bf16_t;
typedef short bf16x8 __attribute__((ext_vector_type(8)));
typedef float f32x4 __attribute__((ext_vector_type(4)));
typedef float f32x2 __attribute__((ext_vector_type(2)));
typedef unsigned u32x4 __attribute__((ext_vector_type(4)));
typedef unsigned u32x2 __attribute__((ext_vector_type(2)));
constexpr int BM = 256, BK = 64, HALF = 128, HTB = HALF * BK * 2  , STAGE_BYTES = 8 * HTB, NXCD = 8, WGM = 4;

__host__ __device__ __forceinline__ int lds_byte(int r, int c) { const int st = (r >> 4) * 2 + (c >> 5), rr = r & 15, cc = c & 31, ob = rr * 64 + cc * 2; return st * 1024 + (ob ^ (((ob >> 9) & 1) << 5)); }
__host__ __device__ __forceinline__ void stage_rc(int b, int& R, int& C) { const int st = b / 1024, sb = b % 1024, swz = sb ^ (((sb >> 9) & 1) << 5); R = (st >> 1) * 16 + swz / 64; C = (st & 1) * 32 + (swz % 64) / 2; }
__host__ __device__ __forceinline__ int perm32(int rho) { const int n = rho >> 4, i = rho & 15; return 8 * (i >> 2) + 4 * n + (i & 3); }

struct Unit { int pm, pn; const char* a; const char* b; };
struct Gemm { int lda, ldb, K; };

struct StaticOrder {
    int nM, nN, nwg, G, c; const char* A; const char* Bt; size_t astep, bstep;
    __device__ void init(const void* A_, int lda, const void* Bt_, int ldb, int M, int N, int G_, int c_) { nM = M / BM; nN = N / BM; nwg = nM * nN; G = G_; c = c_; A = (const char*)A_; Bt = (const char*)Bt_; astep = (size_t)BM * lda * 2; bstep = (size_t)BM * ldb * 2; }
    __device__ bool next(int i, Unit& u) const {
        const long L = (long)i * G + c; if (L >= nwg) return false;
        int wgid = (int)L; { const int q = nwg / NXCD, r = nwg % NXCD, xcd = wgid % NXCD, off = wgid / NXCD; wgid = (xcd < r ? xcd * (q + 1) : r * (q + 1) + (xcd - r) * q) + off; }
        const int nig = WGM * nN, gid = wgid / nig, fm = gid * WGM, gsz = (nM - fm) < WGM ? (nM - fm) : WGM;
        u.pm = fm + ((wgid % nig) % gsz); u.pn = (wgid % nig) / gsz; u.a = A + (size_t)u.pm * astep; u.b = Bt + (size_t)u.pn * bstep; return true;
    }
};

__device__ __forceinline__ unsigned cvt_pk_bf16(float lo, float hi) { typedef __bf16 bf2 __attribute__((ext_vector_type(2))); f32x2 v = {lo, hi}; bf2 b = __builtin_convertvector(v, bf2); return __builtin_bit_cast(unsigned, b); }
__device__ __forceinline__ float bf_lo(unsigned u) { return __uint_as_float(u << 16); }
__device__ __forceinline__ float bf_hi(unsigned u) { return __uint_as_float(u & 0xffff0000u); }

template <class Epi, class Sched, bool ALIGN_EPI>
__device__ __forceinline__ void gemm_phase(PG8_LAS unsigned char* lds, const Gemm g, const Sched& S, const Epi& E) {
    int tid = threadIdx.x; asm volatile("" : "+v"(tid));
    const int wid = __builtin_amdgcn_readfirstlane(tid >> 6), lane = tid & 63, wr = wid >> 2, wc = wid & 3, fr = lane & 15, fq = lane >> 4;
    const int K = g.K, nt = K / BK;
    unsigned voffA[2], voffB[2];
#pragma unroll
    for (int i = 0; i < 2; ++i) { int R, C; stage_rc(tid * 16 + i * 8192, R, C); const int Rb = Epi::PERM ? ((R & ~31) + perm32(R & 31)) : R;
        voffA[i] = (unsigned)(R * g.lda + C) * 2u; voffB[i] = (unsigned)(Rb * g.ldb + C) * 2u; }
    const size_t kstep = (size_t)(BK * 2);
    const size_t hstepA = (size_t)HALF * g.lda * 2, hstepB = (size_t)HALF * g.ldb * 2;
    const unsigned ldsw = (unsigned)wid * 1024u;
    const int aoff = lds_byte(wr * 64 + fr, fq * 8), boff = lds_byte(wc * 32 + fr, fq * 8);
#define PG8_SA(b, h) (((b) * 2 + (h)) * HTB)
#define PG8_SB(b, h) ((4 + (b) * 2 + (h)) * HTB)
#define PG8_STAGE(bufoff, gbase, voff) do { _Pragma("unroll") for (int _i = 0; _i < 2; ++_i) \
        __builtin_amdgcn_global_load_lds((const unsigned*)((const char*)(gbase) + (voff)[_i]), (PG8_LAS unsigned*)(lds + (bufoff) + ldsw + _i * 8192), 16, 0, 0); } while (0)
#define PG8_LDA(dst, b, h) do { _Pragma("unroll") for (int m = 0; m < 4; ++m) _Pragma("unroll") for (int k = 0; k < 2; ++k) dst[m][k] = *(const PG8_LAS bf16x8*)(lds + PG8_SA(b, h) + aoff + m * 2048 + k * 1024); } while (0)
#define PG8_LDB(dst, b, h) do { _Pragma("unroll") for (int n = 0; n < 2; ++n) _Pragma("unroll") for (int k = 0; k < 2; ++k) dst[n][k] = *(const PG8_LAS bf16x8*)(lds + PG8_SB(b, h) + boff + n * 2048 + k * 1024); } while (0)
#define PG8_MMA(ai, bj, At, Bt) do { __builtin_amdgcn_s_setprio(1); _Pragma("unroll") for (int m = 0; m < 4; ++m) _Pragma("unroll") for (int n = 0; n < 2; ++n) _Pragma("unroll") for (int k = 0; k < 2; ++k) \
        acc[ai][bj][m][n] = __builtin_amdgcn_mfma_f32_16x16x32_bf16(Bt[n][k], At[m][k], acc[ai][bj][m][n], 0, 0, 0); __builtin_amdgcn_s_setprio(0); } while (0)
#define PG8_WAIT_V(n) asm volatile("s_waitcnt vmcnt(" #n ")" ::: "memory")
#define PG8_WAIT_L(n) asm volatile("s_waitcnt lgkmcnt(" #n ")" ::: "memory")
#define PG8_BAR __builtin_amdgcn_s_barrier()
#define PG8_SCHED __builtin_amdgcn_sched_barrier(0)
    Unit cur, nxt; int ui = 0;
    if (!S.next(0, cur)) return;
    f32x4 acc[2][2][4][2];
#pragma unroll
    for (int a = 0; a < 2; ++a)
#pragma unroll
        for (int b = 0; b < 2; ++b)
#pragma unroll
            for (int m = 0; m < 4; ++m)
#pragma unroll
                for (int n = 0; n < 2; ++n) acc[a][b][m][n] = (f32x4){0.f, 0.f, 0.f, 0.f};
    bf16x8 At[4][2], B0[2][2], B1[2][2];
    const char* cA = cur.a; const char* cB = cur.b;
    PG8_STAGE(PG8_SB(0, 0), cB, voffB); PG8_STAGE(PG8_SB(0, 1), cB + hstepB, voffB); PG8_STAGE(PG8_SA(0, 0), cA, voffA); PG8_STAGE(PG8_SA(0, 1), cA + hstepA, voffA);
    if (wr == 1) PG8_BAR;
    PG8_WAIT_V(2); PG8_BAR;
    PG8_STAGE(PG8_SB(1, 0), cB + kstep, voffB); PG8_STAGE(PG8_SA(1, 0), cA + kstep, voffA); PG8_STAGE(PG8_SB(1, 1), cB + hstepB + kstep, voffB);
    PG8_WAIT_V(6); PG8_BAR;
    for (;;) {
        const bool has_next = S.next(ui + 1, nxt);
        const char* nA = has_next ? nxt.a : cA; const char* nB = has_next ? nxt.b : cB;
        for (int t = 0; t < nt; t += 2) {
            const bool last = (t == nt - 2);
            const char* a1 = cA + (size_t)(t + 1) * kstep;
            const char* a2 = last ? nA : cA + (size_t)(t + 2) * kstep; const char* b2 = last ? nB : cB + (size_t)(t + 2) * kstep;
            const char* a3 = a2 + kstep; const char* b3 = b2 + kstep;
            PG8_LDB(B0, 0, 0); PG8_LDB(B1, 0, 1); PG8_SCHED; PG8_LDA(At, 0, 0); PG8_STAGE(PG8_SA(1, 1), a1 + hstepA, voffA);
            PG8_WAIT_V(8); PG8_WAIT_L(0); PG8_BAR; PG8_MMA(0, 0, At, B0); PG8_MMA(0, 1, At, B1); PG8_BAR; PG8_SCHED;
            PG8_LDA(At, 0, 1); PG8_STAGE(PG8_SB(0, 0), b2, voffB); PG8_STAGE(PG8_SB(0, 1), b2 + hstepB, voffB); PG8_STAGE(PG8_SA(0, 0), a2, voffA);
            PG8_WAIT_V(8); PG8_WAIT_L(0); PG8_BAR; PG8_MMA(1, 0, At, B0); PG8_MMA(1, 1, At, B1); PG8_BAR; PG8_SCHED;
            PG8_LDB(B0, 1, 0); PG8_LDB(B1, 1, 1); PG8_SCHED; PG8_LDA(At, 1, 0); PG8_STAGE(PG8_SA(0, 1), a2 + hstepA, voffA);
            PG8_WAIT_V(8); PG8_WAIT_L(0); PG8_BAR; PG8_MMA(0, 0, At, B0); PG8_MMA(0, 1, At, B1); PG8_BAR; PG8_SCHED;
            PG8_LDA(At, 1, 1); PG8_STAGE(PG8_SB(1, 0), b3, voffB); PG8_STAGE(PG8_SB(1, 1), b3 + hstepB, voffB); PG8_STAGE(PG8_SA(1, 0), a3, voffA);
            PG8_WAIT_V(8); PG8_WAIT_L(0); PG8_BAR; PG8_MMA(1, 0, At, B0); PG8_MMA(1, 1, At, B1); PG8_BAR; PG8_SCHED;
        }
        if constexpr (ALIGN_EPI) { if (wr == 0) PG8_BAR; }
        if constexpr (!Epi::AFTER_DRAIN) { E(acc, cur, wr, wc, fr, fq); }
        if (!has_next) break;
#pragma unroll
        for (int a = 0; a < 2; ++a)
#pragma unroll
            for (int b = 0; b < 2; ++b)
#pragma unroll
                for (int m = 0; m < 4; ++m)
#pragma unroll
                    for (int n = 0; n < 2; ++n) acc[a][b][m][n] = (f32x4){0.f, 0.f, 0.f, 0.f};
        cur = nxt; cA = nA; cB = nB; ++ui;
        if constexpr (ALIGN_EPI) { if (wr == 1) PG8_BAR; }
    }
    PG8_WAIT_V(0);
    if constexpr (!ALIGN_EPI) { if (wr == 0) PG8_BAR; }
    PG8_BAR;
    if constexpr (Epi::AFTER_DRAIN) { E.fused(acc, cur, wr, wc, fr, fq, lds, wid, lane); }
#undef PG8_SA
#undef PG8_SB
#undef PG8_STAGE
#undef PG8_LDA
#undef PG8_LDB
#undef PG8_MMA
#undef PG8_WAIT_V
#undef PG8_WAIT_L
#undef PG8_BAR
#undef PG8_SCHED
}

typedef f32x4 AccT[2][2][4][2];

struct EpiBf16 {
    static constexpr bool PERM = true, AFTER_DRAIN = false;
    bf16_t* O; int ldc;
    __device__ __forceinline__ void operator()(const AccT& acc, const Unit& u, int wr, int wc, int fr, int fq) const {
        { int t_ = threadIdx.x; asm volatile("" : "+v"(t_)); fr = t_ & 15; fq = (t_ >> 4) & 3; }
        const int row0 = u.pm * BM + wr * 64 + fr, col0 = u.pn * BM + wc * 32 + 8 * fq;
#pragma unroll
        for (int ai = 0; ai < 2; ++ai)
#pragma unroll
            for (int m = 0; m < 4; ++m) { bf16_t* rowp = O + (size_t)(row0 + ai * HALF + m * 16) * ldc + col0;
#pragma unroll
                for (int bj = 0; bj < 2; ++bj) { const f32x4 v0 = acc[ai][bj][m][0], v1 = acc[ai][bj][m][1];
                    u32x4 w; w.x = cvt_pk_bf16(v0[0], v0[1]); w.y = cvt_pk_bf16(v0[2], v0[3]); w.z = cvt_pk_bf16(v1[0], v1[1]); w.w = cvt_pk_bf16(v1[2], v1[3]);
                    *(u32x4*)(rowp + bj * HALF) = w; } }
    }
};
struct EpiF16 {
    static constexpr bool PERM = true, AFTER_DRAIN = false;
    _Float16* O; int ldc;
    __device__ __forceinline__ void operator()(const AccT& acc, const Unit& u, int wr, int wc, int fr, int fq) const {
        { int t_ = threadIdx.x; asm volatile("" : "+v"(t_)); fr = t_ & 15; fq = (t_ >> 4) & 3; }
        typedef _Float16 h8 __attribute__((ext_vector_type(8)));
        const int row0 = u.pm * BM + wr * 64 + fr, col0 = u.pn * BM + wc * 32 + 8 * fq;
#pragma unroll
        for (int ai = 0; ai < 2; ++ai)
#pragma unroll
            for (int m = 0; m < 4; ++m) { _Float16* rowp = O + (size_t)(row0 + ai * HALF + m * 16) * ldc + col0;
#pragma unroll
                for (int bj = 0; bj < 2; ++bj) { const f32x4 v0 = acc[ai][bj][m][0], v1 = acc[ai][bj][m][1];
                    h8 w = {(_Float16)v0[0], (_Float16)v0[1], (_Float16)v0[2], (_Float16)v0[3], (_Float16)v1[0], (_Float16)v1[1], (_Float16)v1[2], (_Float16)v1[3]};
                    *(h8*)(rowp + bj * HALF) = w; } }
    }
};
struct EpiGateMul {
    static constexpr bool PERM = true, AFTER_DRAIN = false;
    const bf16_t* G; bf16_t* Dst; int ldc;
    __device__ __forceinline__ void operator()(const AccT& acc, const Unit& u, int wr, int wc, int fr, int fq) const {
        { int t_ = threadIdx.x; asm volatile("" : "+v"(t_)); fr = t_ & 15; fq = (t_ >> 4) & 3; }
        const int row0 = u.pm * BM + wr * 64 + fr, col0 = u.pn * BM + wc * 32 + 8 * fq;
        u32x4 gqa[2][4][2];
#pragma unroll
        for (int ai = 0; ai < 2; ++ai)
#pragma unroll
            for (int m = 0; m < 4; ++m) { int ro = row0 + ai * HALF + m * 16; asm volatile("" : "+v"(ro)); const bf16_t* rowg = G + (size_t)ro * ldc + col0;
#pragma unroll
                for (int bj = 0; bj < 2; ++bj) gqa[ai][m][bj] = *(const u32x4*)(rowg + bj * HALF); }
        __builtin_amdgcn_sched_barrier(0);
#pragma unroll
        for (int ai = 0; ai < 2; ++ai)
#pragma unroll
            for (int m = 0; m < 4; ++m) { int ro = row0 + ai * HALF + m * 16; asm volatile("" : "+v"(ro)); bf16_t* rowp = Dst + (size_t)ro * ldc + col0;
#pragma unroll
                for (int bj = 0; bj < 2; ++bj) { const f32x4 v0 = acc[ai][bj][m][0], v1 = acc[ai][bj][m][1]; const u32x4 gq = gqa[ai][m][bj];
                    u32x4 w; w.x = cvt_pk_bf16(v0[0] * bf_lo(gq.x), v0[1] * bf_hi(gq.x)); w.y = cvt_pk_bf16(v0[2] * bf_lo(gq.y), v0[3] * bf_hi(gq.y));
                    w.z = cvt_pk_bf16(v1[0] * bf_lo(gq.z), v1[1] * bf_hi(gq.z)); w.w = cvt_pk_bf16(v1[2] * bf_lo(gq.w), v1[3] * bf_hi(gq.w));
                    *(u32x4*)(rowp + bj * HALF) = w; } }
    }
};
struct EpiGateFma {
    static constexpr bool PERM = true, AFTER_DRAIN = false;
    const bf16_t* Tm; const bf16_t* G2; bf16_t* Dst; int ldc;
    __device__ __forceinline__ void operator()(const AccT& acc, const Unit& u, int wr, int wc, int fr, int fq) const {
        { int t_ = threadIdx.x; asm volatile("" : "+v"(t_)); fr = t_ & 15; fq = (t_ >> 4) & 3; }
        const int row0 = u.pm * BM + wr * 64 + fr, col0 = u.pn * BM + wc * 32 + 8 * fq;
#pragma unroll
        for (int ai = 0; ai < 2; ++ai) {
            u32x4 gqa[4][2], tqa[4][2];
#pragma unroll
            for (int m = 0; m < 4; ++m) { int ro = row0 + ai * HALF + m * 16; asm volatile("" : "+v"(ro)); const size_t off = (size_t)ro * ldc + col0;
#pragma unroll
                for (int bj = 0; bj < 2; ++bj) { gqa[m][bj] = *(const u32x4*)(G2 + off + bj * HALF); tqa[m][bj] = *(const u32x4*)(Tm + off + bj * HALF); } }
            __builtin_amdgcn_sched_barrier(0);
#pragma unroll
            for (int m = 0; m < 4; ++m) { int ro = row0 + ai * HALF + m * 16; asm volatile("" : "+v"(ro)); const size_t off = (size_t)ro * ldc + col0;
#pragma unroll
                for (int bj = 0; bj < 2; ++bj) { const f32x4 v0 = acc[ai][bj][m][0], v1 = acc[ai][bj][m][1]; const u32x4 gq = gqa[m][bj]; const u32x4 tq = tqa[m][bj];
                    u32x4 w; w.x = cvt_pk_bf16(bf_lo(tq.x) + v0[0] * bf_lo(gq.x), bf_hi(tq.x) + v0[1] * bf_hi(gq.x)); w.y = cvt_pk_bf16(bf_lo(tq.y) + v0[2] * bf_lo(gq.y), bf_hi(tq.y) + v0[3] * bf_hi(gq.y));
                    w.z = cvt_pk_bf16(bf_lo(tq.z) + v1[0] * bf_lo(gq.z), bf_hi(tq.z) + v1[1] * bf_hi(gq.z)); w.w = cvt_pk_bf16(bf_lo(tq.w) + v1[2] * bf_lo(gq.w), bf_hi(tq.w) + v1[3] * bf_hi(gq.w));
                    *(u32x4*)(Dst + off + bj * HALF) = w; } }
            __builtin_amdgcn_sched_barrier(0);
        }
    }
};
struct EpiResF32 {
    static constexpr bool PERM = false, AFTER_DRAIN = false;
    const float* res; float* out; int ldc; float mul;
    __device__ __forceinline__ void operator()(const AccT& acc, const Unit& u, int wr, int wc, int fr, int fq) const {
        { int t_ = threadIdx.x; asm volatile("" : "+v"(t_)); fr = t_ & 15; fq = (t_ >> 4) & 3; }
        const int row0 = u.pm * BM + wr * 64 + fr, col0 = u.pn * BM + wc * 32 + 4 * fq;
#pragma unroll
        for (int ai = 0; ai < 2; ++ai)
#pragma unroll
            for (int m = 0; m < 4; ++m) { const size_t off = (size_t)(row0 + ai * HALF + m * 16) * ldc + col0;
#pragma unroll
                for (int bj = 0; bj < 2; ++bj)
#pragma unroll
                    for (int n = 0; n < 2; ++n) { const f32x4 r = *(const f32x4*)(res + off + bj * HALF + n * 16); *(f32x4*)(out + off + bj * HALF + n * 16) = r + acc[ai][bj][m][n] * mul; } }
    }
};

__device__ __forceinline__ float row_rs(const float* ssq, int row) {
    const f32x4* p = (const f32x4*)(ssq + (size_t)row * 16); const f32x4 a = p[0], b = p[1], c = p[2], d = p[3];
    const float s = ((a[0] + a[1]) + (a[2] + a[3])) + ((b[0] + b[1]) + (b[2] + b[3])) + ((c[0] + c[1]) + (c[2] + c[3])) + ((d[0] + d[1]) + (d[2] + d[3]));
    return rsqrtf(s * (1.f / 1024.f) + 1e-6f);
}
struct EpiBf16RS {
    static constexpr bool PERM = true, AFTER_DRAIN = false;
    bf16_t* O; int ldc; const float* ssq;
    __device__ __forceinline__ void operator()(const AccT& acc, const Unit& u, int wr, int wc, int fr, int fq) const {
        { int t_ = threadIdx.x; asm volatile("" : "+v"(t_)); fr = t_ & 15; fq = (t_ >> 4) & 3; }
        const int row0 = u.pm * BM + wr * 64 + fr, col0 = u.pn * BM + wc * 32 + 8 * fq;
        float rsa[2][4];
#pragma unroll
        for (int ai = 0; ai < 2; ++ai)
#pragma unroll
            for (int m = 0; m < 4; ++m) { int ro = row0 + ai * HALF + m * 16; asm volatile("" : "+v"(ro)); rsa[ai][m] = row_rs(ssq, ro); }
        __builtin_amdgcn_sched_barrier(0);
#pragma unroll
        for (int ai = 0; ai < 2; ++ai)
#pragma unroll
            for (int m = 0; m < 4; ++m) { int ro = row0 + ai * HALF + m * 16; asm volatile("" : "+v"(ro)); const float rs = rsa[ai][m]; bf16_t* rowp = O + (size_t)ro * ldc + col0;
#pragma unroll
                for (int bj = 0; bj < 2; ++bj) { const f32x4 v0 = acc[ai][bj][m][0] * rs, v1 = acc[ai][bj][m][1] * rs;
                    u32x4 w; w.x = cvt_pk_bf16(v0[0], v0[1]); w.y = cvt_pk_bf16(v0[2], v0[3]); w.z = cvt_pk_bf16(v1[0], v1[1]); w.w = cvt_pk_bf16(v1[2], v1[3]);
                    *(u32x4*)(rowp + bj * HALF) = w; } }
    }
};
struct EpiF16RS {
    static constexpr bool PERM = true, AFTER_DRAIN = false;
    _Float16* O; int ldc; const float* ssq;
    __device__ __forceinline__ void operator()(const AccT& acc, const Unit& u, int wr, int wc, int fr, int fq) const {
        { int t_ = threadIdx.x; asm volatile("" : "+v"(t_)); fr = t_ & 15; fq = (t_ >> 4) & 3; }
        typedef _Float16 h8 __attribute__((ext_vector_type(8)));
        const int row0 = u.pm * BM + wr * 64 + fr, col0 = u.pn * BM + wc * 32 + 8 * fq;
#pragma unroll
        for (int ai = 0; ai < 2; ++ai)
#pragma unroll
            for (int m = 0; m < 4; ++m) { int ro = row0 + ai * HALF + m * 16; asm volatile("" : "+v"(ro)); const float rs = row_rs(ssq, ro); _Float16* rowp = O + (size_t)ro * ldc + col0;
#pragma unroll
                for (int bj = 0; bj < 2; ++bj) { const f32x4 v0 = acc[ai][bj][m][0] * rs, v1 = acc[ai][bj][m][1] * rs;
                    h8 w = {(_Float16)v0[0], (_Float16)v0[1], (_Float16)v0[2], (_Float16)v0[3], (_Float16)v1[0], (_Float16)v1[1], (_Float16)v1[2], (_Float16)v1[3]};
                    *(h8*)(rowp + bj * HALF) = w; } }
    }
};
template <bool RES_F32> struct EpiResNorm {
    static constexpr bool PERM = true, AFTER_DRAIN = false;
    const float* resf; bf16_t* H; float* ssq; int ldc; float mul;
    __device__ __forceinline__ void operator()(const AccT& acc, const Unit& u, int wr, int wc, int fr, int fq) const {
        { int t_ = threadIdx.x; asm volatile("" : "+v"(t_)); fr = t_ & 15; fq = (t_ >> 4) & 3; }
        const int row0 = u.pm * BM + wr * 64 + fr, col0 = u.pn * BM + wc * 32 + 8 * fq;
#pragma unroll
        for (int ai = 0; ai < 2; ++ai) {
            f32x4 ra[RES_F32 ? 4 : 1][2][2]; u32x4 qa[RES_F32 ? 1 : 4][2];
#pragma unroll
            for (int m = 0; m < 4; ++m) { int ro = row0 + ai * HALF + m * 16; asm volatile("" : "+v"(ro)); const size_t off = (size_t)ro * ldc + col0;
#pragma unroll
                for (int bj = 0; bj < 2; ++bj) {
                    if (RES_F32) { ra[RES_F32 ? m : 0][bj][0] = *(const f32x4*)(resf + off + bj * HALF); ra[RES_F32 ? m : 0][bj][1] = *(const f32x4*)(resf + off + bj * HALF + 4); }
                    else qa[RES_F32 ? 0 : m][bj] = *(const u32x4*)(H + off + bj * HALF); } }
            __builtin_amdgcn_sched_barrier(0);
#pragma unroll
            for (int m = 0; m < 4; ++m) { int ro = row0 + ai * HALF + m * 16; asm volatile("" : "+v"(ro)); const size_t off = (size_t)ro * ldc + col0; float ss = 0.f;
#pragma unroll
                for (int bj = 0; bj < 2; ++bj) { f32x4 r0, r1;
                    if (RES_F32) { r0 = ra[RES_F32 ? m : 0][bj][0]; r1 = ra[RES_F32 ? m : 0][bj][1]; }
                    else { const u32x4 q = qa[RES_F32 ? 0 : m][bj]; r0 = (f32x4){bf_lo(q.x), bf_hi(q.x), bf_lo(q.y), bf_hi(q.y)}; r1 = (f32x4){bf_lo(q.z), bf_hi(q.z), bf_lo(q.w), bf_hi(q.w)}; }
                    const f32x4 v0 = r0 + acc[ai][bj][m][0] * mul, v1 = r1 + acc[ai][bj][m][1] * mul;
                    ss += ((v0[0] * v0[0] + v0[1] * v0[1]) + (v0[2] * v0[2] + v0[3] * v0[3])) + ((v1[0] * v1[0] + v1[1] * v1[1]) + (v1[2] * v1[2] + v1[3] * v1[3]));
                    u32x4 w; w.x = cvt_pk_bf16(v0[0], v0[1]); w.y = cvt_pk_bf16(v0[2], v0[3]); w.z = cvt_pk_bf16(v1[0], v1[1]); w.w = cvt_pk_bf16(v1[2], v1[3]);
                    *(u32x4*)(H + off + bj * HALF) = w; }
                ss += shx<16>(ss); ss = sum32(ss);
                if (fq == 0) ssq[(size_t)ro * 16 + u.pn * 4 + wc] = ss; }
            __builtin_amdgcn_sched_barrier(0);
        }
    }
};
struct EpiIn {
    static constexpr bool PERM = true, AFTER_DRAIN = false;
    bf16_t *U, *Bb, *Q, *Kb, *V, *SGC, *SGA; const float* ropec; const float* ropes; float* kbar; float qscale;
    __device__ __forceinline__ void operator()(const AccT& acc, const Unit& u, int wr, int wc, int fr, int fq) const {
        { int t_ = threadIdx.x; asm volatile("" : "+v"(t_)); fr = t_ & 15; fq = (t_ >> 4) & 3; }
        const int pn = u.pn; const int row0 = u.pm * BM + wr * 64 + fr;
        if (pn < 4) {
            const int c0 = 128 * pn + 16 * wc + 4 * fq;
#pragma unroll
            for (int ai = 0; ai < 2; ++ai)
#pragma unroll
                for (int m = 0; m < 4; ++m) { int ro = row0 + ai * HALF + m * 16; asm volatile("" : "+v"(ro)); bf16_t* rowp = U + (size_t)ro * 512 + c0;
#pragma unroll
                    for (int bj = 0; bj < 2; ++bj) { const f32x4 x = acc[ai][bj][m][0] * acc[ai][bj][m][1]; u32x2 w; w.x = cvt_pk_bf16(x[0], x[1]); w.y = cvt_pk_bf16(x[2], x[3]); *(u32x2*)(rowp + bj * 64) = w; } }
        } else if (pn < 6 || (pn >= 10 && pn < 12)) {
            bf16_t* O = pn < 6 ? Bb : V; const int col0 = (pn < 6 ? pn - 4 : pn - 10) * BM + wc * 32 + 8 * fq;
#pragma unroll
            for (int ai = 0; ai < 2; ++ai)
#pragma unroll
                for (int m = 0; m < 4; ++m) { int ro = row0 + ai * HALF + m * 16; asm volatile("" : "+v"(ro)); bf16_t* rowp = O + (size_t)ro * 512 + col0;
#pragma unroll
                    for (int bj = 0; bj < 2; ++bj) { const f32x4 v0 = acc[ai][bj][m][0], v1 = acc[ai][bj][m][1];
                        u32x4 w; w.x = cvt_pk_bf16(v0[0], v0[1]); w.y = cvt_pk_bf16(v0[2], v0[3]); w.z = cvt_pk_bf16(v1[0], v1[1]); w.w = cvt_pk_bf16(v1[2], v1[3]);
                        *(u32x4*)(rowp + bj * HALF) = w; } }
        } else if (pn < 10) {
            const bool isk = pn >= 8; bf16_t* O = isk ? Kb : Q; const int colt = (isk ? pn - 8 : pn - 6) * BM + wc * 32 + 8 * fq;
            const int g4 = 4 * (4 * (wc & 1) + fq);
            const float sc = isk ? 1.f : qscale;
            f32x4 cs0[2] = {(f32x4){0.f, 0.f, 0.f, 0.f}, (f32x4){0.f, 0.f, 0.f, 0.f}}, cs1[2] = {(f32x4){0.f, 0.f, 0.f, 0.f}, (f32x4){0.f, 0.f, 0.f, 0.f}};
            f32x4 ca[2][4], sa[2][4];
#pragma unroll
            for (int ai = 0; ai < 2; ++ai)
#pragma unroll
                for (int m = 0; m < 4; ++m) { int row = row0 + ai * HALF + m * 16; asm volatile("" : "+v"(row)); const int pos = row & 2047;
                    ca[ai][m] = *(const f32x4*)(ropec + pos * 32 + g4); sa[ai][m] = *(const f32x4*)(ropes + pos * 32 + g4); }
            __builtin_amdgcn_sched_barrier(0);
#pragma unroll
            for (int ai = 0; ai < 2; ++ai)
#pragma unroll
                for (int m = 0; m < 4; ++m) { int row = row0 + ai * HALF + m * 16; asm volatile("" : "+v"(row));
                    const f32x4 c = ca[ai][m] * sc, s = sa[ai][m] * sc;
                    bf16_t* rowp = O + (size_t)row * 512 + colt;
#pragma unroll
                    for (int bj = 0; bj < 2; ++bj) { const f32x4 x1 = acc[ai][bj][m][0], x2 = acc[ai][bj][m][1]; const f32x4 o1 = x1 * c - x2 * s, o2 = x2 * c + x1 * s;
                        cs0[bj] += o1; cs1[bj] += o2;
                        u32x4 w; w.x = cvt_pk_bf16(o1[0], o1[1]); w.y = cvt_pk_bf16(o1[2], o1[3]); w.z = cvt_pk_bf16(o2[0], o2[1]); w.w = cvt_pk_bf16(o2[2], o2[3]);
                        *(u32x4*)(rowp + bj * HALF) = w; }
                    asm volatile("" : "+v"(cs0[0]), "+v"(cs0[1]), "+v"(cs1[0]), "+v"(cs1[1]) :: "memory"); }
            if (isk) {
#pragma unroll
                for (int bj = 0; bj < 2; ++bj)
#pragma unroll
                    for (int j = 0; j < 4; ++j) { float a = cs0[bj][j], b = cs1[bj][j];
                        a += shx<1>(a); b += shx<1>(b); a += shx<2>(a); b += shx<2>(b); a += shx<4>(a); b += shx<4>(b); a += shx<8>(a); b += shx<8>(b);
                        if (fr == 0) { const int pc = (pn - 8) * BM + bj * HALF + wc * 32 + 8 * fq;
                            float* kb = kbar + (size_t)u.pm * 512 + pc; atomicAdd(kb + j, a); atomicAdd(kb + 4 + j, b); } }
            }
        } else {
            bf16_t* O = pn < 16 ? SGC : SGA; const int col0 = (pn < 16 ? pn - 12 : pn - 16) * BM + wc * 32 + 8 * fq;
#pragma unroll
            for (int ai = 0; ai < 2; ++ai)
#pragma unroll
                for (int m = 0; m < 4; ++m) { int ro = row0 + ai * HALF + m * 16; asm volatile("" : "+v"(ro)); bf16_t* rowp = O + (size_t)ro * 1024 + col0;
#pragma unroll
                    for (int bj = 0; bj < 2; ++bj) { f32x4 v0 = acc[ai][bj][m][0], v1 = acc[ai][bj][m][1];
#pragma unroll
                        for (int j = 0; j < 4; ++j) { v0[j] = __builtin_amdgcn_rcpf(1.f + __expf(-v0[j])); v1[j] = __builtin_amdgcn_rcpf(1.f + __expf(-v1[j])); }
                        u32x4 w; w.x = cvt_pk_bf16(v0[0], v0[1]); w.y = cvt_pk_bf16(v0[2], v0[3]); w.z = cvt_pk_bf16(v1[0], v1[1]); w.w = cvt_pk_bf16(v1[2], v1[3]);
                        *(u32x4*)(rowp + bj * HALF) = w; }
                    asm volatile("" ::: "memory"); }
        }
    }
};
struct EpiSoftmax {
    static constexpr bool PERM = true, AFTER_DRAIN = true;
    bf16_t* O; int ldc; float scale_log2;
    __device__ __forceinline__ void fused(AccT& acc, const Unit& u, int wr, int wc, int fr, int fq, PG8_LAS unsigned char* lds, int wid, int lane) const {
        { int t_ = threadIdx.x; asm volatile("" : "+v"(t_)); fr = t_ & 15; fq = (t_ >> 4) & 3; }
        PG8_LAS f32x2* X = (PG8_LAS f32x2*)lds;
        float mx[2][4];
#pragma unroll
        for (int ai = 0; ai < 2; ++ai)
#pragma unroll
            for (int m = 0; m < 4; ++m) { float a = -3.0e38f;
#pragma unroll
                for (int bj = 0; bj < 2; ++bj)
#pragma unroll
                    for (int n = 0; n < 2; ++n) { acc[ai][bj][m][n] = acc[ai][bj][m][n] * scale_log2; const f32x4 x = acc[ai][bj][m][n]; a = fmaxf(fmaxf(a, fmaxf(x[0], x[1])), fmaxf(x[2], x[3])); }
                a = fmaxf(a, shx<16>(a)); a = max32(a); mx[ai][m] = a;
                float s = 0.f;
#pragma unroll
                for (int bj = 0; bj < 2; ++bj)
#pragma unroll
                    for (int n = 0; n < 2; ++n) { f32x4 x = acc[ai][bj][m][n];
#pragma unroll
                        for (int j = 0; j < 4; ++j) { x[j] = __builtin_amdgcn_exp2f(x[j] - a); s += x[j]; }
                        acc[ai][bj][m][n] = x; }
                s += shx<16>(s); s = sum32(s);
                if (fq == 0) X[(ai * HALF + wr * 64 + m * 16 + fr) * 4 + wc] = (f32x2){a, s};
            }
        asm volatile("s_waitcnt lgkmcnt(0)" ::: "memory"); __builtin_amdgcn_s_barrier(); asm volatile("" ::: "memory");
        const int row0 = u.pm * BM + wr * 64 + fr, col0 = u.pn * BM + wc * 32 + 8 * fq;
#pragma unroll
        for (int ai = 0; ai < 2; ++ai)
#pragma unroll
            for (int m = 0; m < 4; ++m) { const int r = ai * HALF + wr * 64 + m * 16 + fr;
                const f32x2 e0 = X[r * 4 + 0], e1 = X[r * 4 + 1], e2 = X[r * 4 + 2], e3 = X[r * 4 + 3];
                const float M = fmaxf(fmaxf(e0.x, e1.x), fmaxf(e2.x, e3.x));
                const float L = e0.y * __builtin_amdgcn_exp2f(e0.x - M) + e1.y * __builtin_amdgcn_exp2f(e1.x - M) + e2.y * __builtin_amdgcn_exp2f(e2.x - M) + e3.y * __builtin_amdgcn_exp2f(e3.x - M);
                const float f = __builtin_amdgcn_exp2f(mx[ai][m] - M) * __builtin_amdgcn_rcpf(L);
                bf16_t* rowp = O + (size_t)(row0 + ai * HALF + m * 16) * ldc + col0;
#pragma unroll
                for (int bj = 0; bj < 2; ++bj) { const f32x4 v0 = acc[ai][bj][m][0] * f, v1 = acc[ai][bj][m][1] * f;
                    u32x4 w; w.x = cvt_pk_bf16(v0[0], v0[1]); w.y = cvt_pk_bf16(v0[2], v0[3]); w.z = cvt_pk_bf16(v1[0], v1[1]); w.w = cvt_pk_bf16(v1[2], v1[3]);
                    *(u32x4*)(rowp + bj * HALF) = w; } }
        asm volatile("s_waitcnt lgkmcnt(0)" ::: "memory"); __builtin_amdgcn_s_barrier(); asm volatile("" ::: "memory");
    }
};
}
namespace attn_body {
using bf16=__hip_bfloat16;
using bf16x8=__attribute__((ext_vector_type(8)))short;
using s16x4=__attribute__((ext_vector_type(4)))short;
using f32x16=__attribute__((ext_vector_type(16)))float;
using u32x4=__attribute__((ext_vector_type(4)))unsigned;
constexpr int BATCH=16,NHEAD=8,SEQ=2048,D=64,DM=NHEAD*D;
constexpr int NW=8,QBLK=32,QB=QBLK*NW,KVBLK=64,NQB=SEQ/QB;
constexpr int ATTN_PITCH=DM, ATTN_UNIT_ROWS=QB;
__device__ __forceinline__ int crow(int r,int hi){return (r&3)+8*(r>>2)+4*hi;}
#define SBAR() __builtin_amdgcn_sched_barrier(0)
__device__ __forceinline__ void cmask(f32x16&p0,f32x16&p1,int jb,int qrel,int hi){
  const float NEG=-INFINITY; int kb=64*jb+4*hi;
  #pragma unroll
  for(int r=0;r<16;++r){int kv=kb+(r&3)+8*(r>>2); if(kv>qrel)p0[r]=NEG; if(kv+32>qrel)p1[r]=NEG;}
}

constexpr int NSLOT=3, SLOTB=8192;
constexpr int LDS_K=0, LDS_V=NSLOT*SLOTB, LDS_WS=2*NSLOT*SLOTB, LDS_OST=LDS_WS+NW*64*4, LDS_SEL=LDS_OST+NW*4096, LDS_BYTES=LDS_SEL+NW*64*4;
constexpr float C2=0.125f*1.4426950408889634f;
__device__ __forceinline__ void glds16(const void*gsrc,unsigned lds_dst){unsigned keep;
  asm volatile("s_mov_b32 %0, m0\n\ts_mov_b32 m0, %2\n\ts_nop 0\n\tglobal_load_lds_dwordx4 %1, off\n\ts_mov_b32 m0, %0":"=&s"(keep):"v"(gsrc),"s"(lds_dst):"memory");}
__device__ __forceinline__ float max3f(float a,float b,float c){float r;asm("v_max3_f32 %0, %1, %2, %3":"=v"(r):"v"(a),"v"(b),"v"(c));return r;}
__device__ __forceinline__ float max2f(float a,float b){float r;asm("v_max_f32_e32 %0, %1, %2":"=v"(r):"v"(a),"v"(b));return r;}
__device__ __forceinline__ float fadd_s(float a,float b){float r;asm("v_add_f32_e32 %0, %1, %2":"=v"(r):"v"(a),"v"(b));return r;}
__device__ __forceinline__ float fsub_s(float a,float b){float r;asm("v_sub_f32_e32 %0, %1, %2":"=v"(r):"v"(a),"v"(b));return r;}
typedef float f32x2_t __attribute__((ext_vector_type(2))); typedef __bf16 bf16x2_t __attribute__((ext_vector_type(2)));
__device__ __forceinline__ unsigned cvtpk_s(float lo,float hi){f32x2_t v={lo,hi};bf16x2_t b=__builtin_convertvector(v,bf16x2_t);return __builtin_bit_cast(unsigned,b);}
#define WAIT_BAR(N) asm volatile("s_waitcnt vmcnt(" #N ") lgkmcnt(0)\n\ts_barrier":::"memory")

__device__ __forceinline__ void qkt(f32x16&p0,f32x16&p1,const char*Kslot,const bf16x8*qr,const f32x16&negm,int r32,int hi){
  const char*kb=Kslot+hi*1024+r32*16;
  #pragma unroll
  for(int d0=0;d0<4;++d0){
    const bf16x8 b0=*reinterpret_cast<const bf16x8*>(kb+d0*2048);
    const bf16x8 b1=*reinterpret_cast<const bf16x8*>(kb+d0*2048+512);
    if(d0==0){p0=__builtin_amdgcn_mfma_f32_32x32x16_bf16(b0,qr[0],negm,0,0,0);p1=__builtin_amdgcn_mfma_f32_32x32x16_bf16(b1,qr[0],negm,0,0,0);}
    else{p0=__builtin_amdgcn_mfma_f32_32x32x16_bf16(b0,qr[d0],p0,0,0,0);p1=__builtin_amdgcn_mfma_f32_32x32x16_bf16(b1,qr[d0],p1,0,0,0);}}
}
typedef __attribute__((address_space(3))) const char* lds_cptr;
typedef short v4i16_t __attribute__((ext_vector_type(4)));
__device__ __forceinline__ void kload8(bf16x8*kf,lds_cptr kp){
  kf[0]=*(const __attribute__((address_space(3))) bf16x8*)(kp);      kf[1]=*(const __attribute__((address_space(3))) bf16x8*)(kp+512);
  kf[2]=*(const __attribute__((address_space(3))) bf16x8*)(kp+2048); kf[3]=*(const __attribute__((address_space(3))) bf16x8*)(kp+2560);
  kf[4]=*(const __attribute__((address_space(3))) bf16x8*)(kp+4096); kf[5]=*(const __attribute__((address_space(3))) bf16x8*)(kp+4608);
  kf[6]=*(const __attribute__((address_space(3))) bf16x8*)(kp+6144); kf[7]=*(const __attribute__((address_space(3))) bf16x8*)(kp+6656);
}
__device__ __forceinline__ void kload2(bf16x8*kf,lds_cptr kp,int j){ kf[2*j]=*(const __attribute__((address_space(3))) bf16x8*)(kp+j*2048); kf[2*j+1]=*(const __attribute__((address_space(3))) bf16x8*)(kp+j*2048+512); }
__device__ __forceinline__ s16x4 vtr(lds_cptr p){ return __builtin_bit_cast(s16x4,__builtin_amdgcn_ds_read_tr16_b64_v4i16((__attribute__((address_space(3))) v4i16_t*)p)); }
__device__ __forceinline__ float rowmax(const f32x16&p0,const f32x16&p1){
  float a=max3f(p0[0],p0[1],p1[0]),b=max3f(p0[2],p0[3],p1[1]);a=max3f(a,p1[2],p1[3]);
  #pragma unroll
  for(int r=4;r<16;r+=4){a=max3f(a,p0[r],p0[r+1]);b=max3f(b,p0[r+2],p0[r+3]);a=max3f(a,p1[r],p1[r+1]);b=max3f(b,p1[r+2],p1[r+3]);}
  const float m=max2f(a,b);
  auto rr=__builtin_amdgcn_permlane32_swap(__float_as_uint(m),__float_as_uint(m),false,false);
  return max2f(__uint_as_float(rr[0]),__uint_as_float(rr[1]));
}
__device__ __forceinline__ void pv(f32x16*o,int vb,bf16x8 pa0,bf16x8 pa1,bf16x8 pa2,bf16x8 pa3){
  #pragma unroll
  for(int d0=0;d0<2;++d0){s16x4 lo[4],hi[4];
    #pragma unroll
    for(int ks=0;ks<4;++ks){
      asm volatile("ds_read_b64_tr_b16 %0,%1 offset:%c2":"=&v"(lo[ks]):"v"(vb),"i"(d0*4096+ks*1024):"memory");
      asm volatile("ds_read_b64_tr_b16 %0,%1 offset:%c2":"=&v"(hi[ks]):"v"(vb),"i"(d0*4096+ks*1024+512):"memory");}
    asm volatile("s_waitcnt lgkmcnt(0)":::"memory");SBAR();
    #define PK(k) (bf16x8){lo[k][0],lo[k][1],lo[k][2],lo[k][3],hi[k][0],hi[k][1],hi[k][2],hi[k][3]}
    o[d0]=__builtin_amdgcn_mfma_f32_32x32x16_bf16(pa0,PK(0),o[d0],0,0,0);
    o[d0]=__builtin_amdgcn_mfma_f32_32x32x16_bf16(pa1,PK(1),o[d0],0,0,0);
    o[d0]=__builtin_amdgcn_mfma_f32_32x32x16_bf16(pa2,PK(2),o[d0],0,0,0);
    o[d0]=__builtin_amdgcn_mfma_f32_32x32x16_bf16(pa3,PK(3),o[d0],0,0,0);
    #undef PK
  }
}

#ifndef ATTN_STORE16
#define ATTN_STORE16(p,v) (*(u32x4*)(p)=(v))
#endif
template<int THRL> __device__ __forceinline__ void attn_unit(int b,int h,int qb,const bf16*Q,const bf16*__restrict__ K,const bf16*__restrict__ V,bf16*O,const float*__restrict__ kbar,char*shm){
  int tid=threadIdx.x; asm volatile("":"+v"(tid)); const int lane=tid&63,r32=lane&31,hi=lane>>5; const int wid=__builtin_amdgcn_readfirstlane(tid>>6);
  const long rowbase=(long)b*SEQ; const int q0=qb*QB;
  const bf16*Qw=Q+(rowbase+q0+wid*QBLK)*DM+h*D;
  const bf16*Kh=K+rowbase*DM+h*D,*Vh=V+rowbase*DM+h*D;
  const unsigned lds0=(unsigned)(uintptr_t)shm;
  float*wsf=(float*)(shm+LDS_WS)+wid*64;
  const bf16*ksrc=Kh+(long)lane*DM+wid*8;
  const bf16*vsrc=Vh+(long)(16*(wid&3)+(lane>>2))*DM+(wid>>2)*32+(lane&3)*8;
  const unsigned kdst=lds0+LDS_K+wid*1024, vdst=lds0+LDS_V+wid*1024;
  #define DMA_K(t,slot) glds16(ksrc+(long)(t)*KVBLK*DM,(unsigned)__builtin_amdgcn_readfirstlane(kdst+(slot)))
  #define DMA_V(t,slot) glds16(vsrc+(long)(t)*KVBLK*DM,(unsigned)__builtin_amdgcn_readfirstlane(vdst+(slot)))
  const int vb0=(int)(lds0+LDS_V)+((lane>>4)&1)*32+(lane&3)*8+(4*hi+((lane&15)>>2))*64;
  const char*Kbase=shm+LDS_K; bf16x8 kf[8];
  const lds_cptr shm3=(lds_cptr)shm; const lds_cptr kp0=shm3+LDS_K+hi*1024+r32*16; const lds_cptr vp0=shm3+LDS_V+((lane>>4)&1)*32+(lane&3)*8+(4*hi+((lane&15)>>2))*64;
  const int NT=(q0+QB)/KVBLK;
  DMA_K(0,0);DMA_V(0,0);DMA_K(1,SLOTB);
  bf16x8 qr[4];
  #pragma unroll
  for(int d0=0;d0<4;++d0)qr[d0]=*reinterpret_cast<const bf16x8*>(&Qw[(long)r32*DM+d0*16+hi*8]);
  int selm=0;
  if(qb>0){
    float g[7]; int hi8=8*hi; asm volatile("":"+v"(hi8)); const float*kb=kbar+(size_t)(b*8)*512+h*64+hi8;
    #pragma unroll
    for(int n2=0;n2<8;n2+=2){ float4 ka[2][4][2]; if(n2>=qb){ g[n2]=-INFINITY; if(n2+1<7)g[n2+1]=-INFINITY; continue; }
      #pragma unroll
      for(int j=0;j<2;++j){ const int n=n2+j; if(n<7){ const int nn=(n<qb)?n:0;
        #pragma unroll
        for(int d0=0;d0<4;++d0){ ka[j][d0][0]=*(const float4*)(kb+nn*512+16*d0); ka[j][d0][1]=*(const float4*)(kb+nn*512+16*d0+4); } } }
      #pragma unroll
      for(int j=0;j<2;++j){ const int n=n2+j; if(n<7){ float a=0.f;
        #pragma unroll
        for(int d0=0;d0<4;++d0){ const float4 k0=ka[j][d0][0],k1=ka[j][d0][1]; const bf16x8 qq=qr[d0];
          #define QF(e) __uint_as_float(((unsigned)(unsigned short)qq[e])<<16)
          a+=QF(0)*k0.x+QF(1)*k0.y+QF(2)*k0.z+QF(3)*k0.w+QF(4)*k1.x+QF(5)*k1.y+QF(6)*k1.z+QF(7)*k1.w;
          #undef QF
        }
        a=::sum32(a); g[n]=(n<qb)?a:-INFINITY; asm volatile("":"+v"(g[n])); } }
      asm volatile("":::"memory"); }
    #pragma unroll
    for(int r=0;r<3;++r){ int best=-1; float bv=-INFINITY;
      #pragma unroll
      for(int n=0;n<7;++n) if(!((selm>>n)&1)&&g[n]>bv){bv=g[n];best=n;}
      if(best>=0)selm|=1<<best; }
  }
  selm|=1<<qb;
  typedef __attribute__((address_space(3))) int* lds_iptr;
  ((lds_iptr)(shm3+LDS_SEL))[tid]=selm;
  #define CURNEG(blk) ({ int t_=threadIdx.x; asm volatile("":"+v"(t_)); const int sm_=((lds_iptr)(shm3+LDS_SEL))[t_]; ((sm_>>(blk))&1)?0.f:-INFINITY; })
  #define NEGUPD(t) do{ if((((t)+1)&3)==0){ const float cn_=CURNEG(((t)+1)>>2); _Pragma("unroll") for(int r=0;r<16;++r)negm[r]=cn_-mhat; asm volatile("":"+v"(negm)); } }while(0)
  float mhat=0.f,l_reg=0.f;f32x16 o[2];o[0]=f32x16{};o[1]=f32x16{};f32x16 negm; { const float cn_=CURNEG(0); _Pragma("unroll") for(int r=0;r<16;++r)negm[r]=cn_; } asm volatile("":"+v"(negm));
  const int qrel=wid*QBLK+r32;
  #define CMASK(P0,P1,t) do{int jb_=(t)-(NT-4); if(jb_>=0)cmask(P0,P1,jb_,qrel,hi);}while(0)
  bool resc=false;
  #define START(P0,P1) do{ const float rm=rowmax(P0,P1); resc=false; \
    { const float dl=__builtin_fmaxf(rm,-24.f); mhat=fadd_s(mhat,dl); \
      _Pragma("unroll") for(int r=0;r<16;++r){P0[r]=fsub_s(P0[r],dl);P1[r]=fsub_s(P1[r],dl);} \
      { const float cn_=CURNEG(0); _Pragma("unroll") for(int r=0;r<16;++r)negm[r]=cn_-mhat; } asm volatile("":"+v"(negm)); } \
    _Pragma("unroll") for(int r=0;r<16;++r)P0[r]=__builtin_amdgcn_exp2f(P0[r]); }while(0)
  #define RESC() do{ if(resc){ asm volatile("s_waitcnt lgkmcnt(0)":::"memory"); \
      _Pragma("unroll") for(int d_=0;d_<2;++d_) _Pragma("unroll") for(int r=0;r<16;++r)o[d_][r]*=wsf[crow(r,hi)]; } }while(0)
  f32x16 pA0,pA1,pB0,pB1;
  int sl_prev=0,sl_cur=0,sl_next=SLOTB;
  #define ROT() do{sl_prev=sl_cur;sl_cur=sl_next;sl_next=(sl_next==(NSLOT-1)*SLOTB)?0:sl_next+SLOTB;}while(0)
  DMA_K(2,2*SLOTB);
  WAIT_BAR(3);
  qkt(pA0,pA1,Kbase,qr,negm,r32,hi);asm volatile("s_nop 15\n\ts_nop 7":"+v"(pA0),"+v"(pA1));CMASK(pA0,pA1,0);
  START(pA0,pA1);
  _Pragma("unroll") for(int r=0;r<16;++r)pA1[r]=__builtin_amdgcn_exp2f(pA1[r]);
  WAIT_BAR(0);
  DMA_K(3,0);DMA_V(1,SLOTB);
  ROT();
  kload8(kf,kp0+sl_cur);
  WAIT_BAR(2);
  s16x4 vlo[8],vhi[8]; u32x4 pw0,pw1,pw2,pw3;
  #define PKW(P,B) cvtpk_s(P[B],P[B+1])
  #define PAF(k) __builtin_bit_cast(bf16x8,pw##k)
  #define VFR(i) (bf16x8){vlo[i][0],vlo[i][1],vlo[i][2],vlo[i][3],vhi[i][0],vhi[i][1],vhi[i][2],vhi[i][3]}
  #define PIN(x) asm volatile("":"+v"(x))
  #define MX3(a,b,c) __builtin_fmaxf(__builtin_fmaxf((a),(b)),(c))
  #define GAPA(MF,A0,A1,A2,A3,W0,W1,PW) do{ MF; sacc+=A0; sacc+=A1; sacc+=A2; sacc+=A3; PIN(sacc); W0; W1; PIN(PW); SBAR(); }while(0)
  #define EX(v) __builtin_amdgcn_exp2f(v)
  #define GAPB(MF,X,B) do{ MF; X[B]=EX(X[B]); X[B+1]=EX(X[B+1]); X[B+2]=EX(X[B+2]); X[B+3]=EX(X[B+3]); PIN(X); SBAR(); }while(0)
  #define VRD(i) do{ vlo[i]=vtr(vp_+(((i)>>2)*4096+((i)&3)*1024)); vhi[i]=vtr(vp_+(((i)>>2)*4096+((i)&3)*1024+512)); }while(0)
  #define KRD(G,j) do{ if(G){ kload2(kf,kp0+sl_next,j); SBAR(); } }while(0)
  #define STEP(C0,C1,P0,P1,t,GK,GV,GL) do{ SBAR(); \
    const lds_cptr vp_=vp0+sl_prev; \
    VRD(0); SBAR(); float sacc=(P0[0]+P0[1]); \
    GAPA(C0=__builtin_amdgcn_mfma_f32_32x32x16_bf16(kf[0],qr[0],negm,0,0,0), P0[2],P0[3],P0[4],P0[5],     pw0[0]=PKW(P0,0), pw0[1]=PKW(P0,2), pw0); \
    VRD(4); SBAR(); GAPA(C1=__builtin_amdgcn_mfma_f32_32x32x16_bf16(kf[1],qr[0],negm,0,0,0), P0[6],P0[7],P0[8],P0[9],     pw0[2]=PKW(P0,4), pw0[3]=PKW(P0,6), pw0); \
    VRD(1); SBAR(); GAPA(C0=__builtin_amdgcn_mfma_f32_32x32x16_bf16(kf[2],qr[1],C0,0,0,0),   P0[10],P0[11],P0[12],P0[13], pw1[0]=PKW(P0,8), pw1[1]=PKW(P0,10), pw1); \
    VRD(5); SBAR(); GAPA(C1=__builtin_amdgcn_mfma_f32_32x32x16_bf16(kf[3],qr[1],C1,0,0,0),   P0[14],P0[15],P1[0],P1[1],   pw1[2]=PKW(P0,12),pw1[3]=PKW(P0,14), pw1); \
    VRD(2); SBAR(); GAPA(C0=__builtin_amdgcn_mfma_f32_32x32x16_bf16(kf[4],qr[2],C0,0,0,0),   P1[2],P1[3],P1[4],P1[5],     pw2[0]=PKW(P1,0), pw2[1]=PKW(P1,2), pw2); \
    VRD(6); SBAR(); GAPA(C1=__builtin_amdgcn_mfma_f32_32x32x16_bf16(kf[5],qr[2],C1,0,0,0),   P1[6],P1[7],P1[8],P1[9],     pw2[2]=PKW(P1,4), pw2[3]=PKW(P1,6), pw2); \
    VRD(3); SBAR(); GAPA(C0=__builtin_amdgcn_mfma_f32_32x32x16_bf16(kf[6],qr[3],C0,0,0,0),   P1[10],P1[11],P1[12],P1[13], pw3[0]=PKW(P1,8), pw3[1]=PKW(P1,10), pw3); \
    VRD(7); SBAR(); GAPA(C1=__builtin_amdgcn_mfma_f32_32x32x16_bf16(kf[7],qr[3],C1,0,0,0),   P1[14],P1[15],0.f,0.f,       pw3[2]=PKW(P1,12),pw3[3]=PKW(P1,14), pw3); \
    l_reg+=sacc; \
    if(GK){DMA_K((t)+3,sl_cur);} if(GV){DMA_V((t)+1,sl_next);} \
    CMASK(C0,C1,t); \
    { float a=MX3(C0[0],C0[1],C1[0]),b=MX3(C0[2],C0[3],C1[1]); a=MX3(a,C1[2],C1[3]); \
      _Pragma("unroll") for(int r=4;r<16;r+=4){a=MX3(a,C0[r],C0[r+1]);b=MX3(b,C0[r+2],C0[r+3]);a=MX3(a,C1[r],C1[r+1]);b=MX3(b,C1[r+2],C1[r+3]);} \
      float rm=__builtin_fmaxf(a,b); { auto rr=__builtin_amdgcn_permlane32_swap(__float_as_uint(rm),__float_as_uint(rm),false,false); rm=__builtin_fmaxf(__uint_as_float(rr[0]),__uint_as_float(rr[1])); } \
      resc=false; \
      if(__builtin_expect(__any(rm>(float)THRL),0)){ const float dl=__builtin_fmaxf(rm,0.f); mhat+=dl; \
        _Pragma("unroll") for(int r=0;r<16;++r){C0[r]-=dl;C1[r]-=dl;} \
        { const float cn_=CURNEG(((t)+1)>>2); _Pragma("unroll") for(int r=0;r<16;++r)negm[r]=cn_-mhat; } asm volatile("":"+v"(negm)); \
        const float f=__builtin_amdgcn_exp2f(-dl); l_reg*=f; if(hi==0)wsf[r32]=f; resc=true; } } \
    SBAR(); \
    GAPB(o[0]=__builtin_amdgcn_mfma_f32_32x32x16_bf16(PAF(0),VFR(0),o[0],0,0,0), C0,0); \
    GAPB(o[1]=__builtin_amdgcn_mfma_f32_32x32x16_bf16(PAF(0),VFR(4),o[1],0,0,0), C0,4); \
    KRD(GL,0); GAPB(o[0]=__builtin_amdgcn_mfma_f32_32x32x16_bf16(PAF(1),VFR(1),o[0],0,0,0), C0,8); \
    KRD(GL,1); GAPB(o[1]=__builtin_amdgcn_mfma_f32_32x32x16_bf16(PAF(1),VFR(5),o[1],0,0,0), C0,12); \
    KRD(GL,2); GAPB(o[0]=__builtin_amdgcn_mfma_f32_32x32x16_bf16(PAF(2),VFR(2),o[0],0,0,0), C1,0); \
    KRD(GL,3); GAPB(o[1]=__builtin_amdgcn_mfma_f32_32x32x16_bf16(PAF(2),VFR(6),o[1],0,0,0), C1,4); \
    GAPB(o[0]=__builtin_amdgcn_mfma_f32_32x32x16_bf16(PAF(3),VFR(3),o[0],0,0,0), C1,8); \
    GAPB(o[1]=__builtin_amdgcn_mfma_f32_32x32x16_bf16(PAF(3),VFR(7),o[1],0,0,0), C1,12); \
    }while(0)
  int t=1;
  #undef CMASK
  #define CMASK(P0,P1,t) do{}while(0)
  for(;t+5<NT;t+=2){
    STEP(pB0,pB1,pA0,pA1,t,true,true,true);     WAIT_BAR(2); RESC(); ROT(); NEGUPD(t);
    STEP(pA0,pA1,pB0,pB1,t+1,true,true,true);   WAIT_BAR(2); RESC(); ROT(); NEGUPD(t+1);
  }
  #undef CMASK
  #define CMASK(P0,P1,t) do{int jb_=(t)-(NT-4); if(jb_>=0)cmask(P0,P1,jb_,qrel,hi);}while(0)
  #define ENDW(tt) do{ if((tt)+3<NT){WAIT_BAR(2);} else if((tt)+2<NT){WAIT_BAR(1);} else {WAIT_BAR(0);} }while(0)
  for(;t+1<NT;t+=2){
    STEP(pB0,pB1,pA0,pA1,t,(t+3<NT),(t+1<NT),(t+1<NT));       ENDW(t);   RESC(); ROT(); NEGUPD(t);
    STEP(pA0,pA1,pB0,pB1,t+1,(t+4<NT),(t+2<NT),(t+2<NT));     ENDW(t+1); RESC(); ROT(); NEGUPD(t+1);
  }
  STEP(pB0,pB1,pA0,pA1,NT-1,false,false,false); RESC();
  { float sacc=pB0[0]+pB0[1]; _Pragma("unroll") for(int r=2;r<16;++r)sacc+=pB0[r]; _Pragma("unroll") for(int r=0;r<16;++r)sacc+=pB1[r]; l_reg+=sacc;
    pw0=(u32x4){PKW(pB0,0),PKW(pB0,2),PKW(pB0,4),PKW(pB0,6)};pw1=(u32x4){PKW(pB0,8),PKW(pB0,10),PKW(pB0,12),PKW(pB0,14)};pw2=(u32x4){PKW(pB1,0),PKW(pB1,2),PKW(pB1,4),PKW(pB1,6)};pw3=(u32x4){PKW(pB1,8),PKW(pB1,10),PKW(pB1,12),PKW(pB1,14)};
    SBAR(); pv(o,vb0+sl_cur,PAF(0),PAF(1),PAF(2),PAF(3)); }
  #undef PKW
  #undef PAF
  #undef VFR
  #undef PIN
  #undef MX3
  #undef GAPA
  #undef GAPB
  #undef EX
  #undef VRD
  #undef KRD
  #undef STEP
  #undef ENDW
  {auto rr=__builtin_amdgcn_permlane32_swap(__float_as_uint(l_reg),__float_as_uint(l_reg),false,false);l_reg=__uint_as_float(rr[0])+__uint_as_float(rr[1]);}
  if(hi==0)wsf[32+r32]=l_reg;asm volatile("s_waitcnt lgkmcnt(0)":::"memory");
  float rli[16];
  #pragma unroll
  for(int r=0;r<16;++r)rli[r]=__builtin_amdgcn_rcpf(wsf[32+crow(r,hi)]);
  bf16*Ow=O+(rowbase+q0+wid*QBLK)*DM+h*D;
  { bf16*stg=(bf16*)(shm+LDS_OST)+wid*2048;
    #pragma unroll
    for(int r=0;r<16;++r){const int orow=crow(r,hi);
      #pragma unroll
      for(int d0=0;d0<2;++d0)stg[orow*64+d0*32+r32]=__float2bfloat16(o[d0][r]*rli[r]);}
    asm volatile("s_waitcnt lgkmcnt(0)":::"memory");
    #pragma unroll
    for(int i=0;i<4;++i){const int row=i*8+(lane>>3),ch=lane&7; const u32x4 v=*(const u32x4*)(stg+row*64+ch*8); ATTN_STORE16(Ow+(long)row*DM+ch*8,v);} }
  asm volatile("s_waitcnt lgkmcnt(0)\n\ts_barrier":::"memory");
  #undef DMA_K
  #undef DMA_V
  #undef CMASK
  #undef START
  #undef CURNEG
  #undef NEGUPD
  #undef RESC
  #undef ROT
}
constexpr int ATTN_LDS_BYTES=LDS_BYTES;
struct AttnTensors { const bf16* Q; const bf16* K; const bf16* V; bf16* O; const float* kbar; };
struct AttnUnit { int bh; int qb; };
struct StaticOrder {
  int vcu,G;
  __device__ __forceinline__ explicit StaticOrder(int grid,int block):vcu((grid%8==0)?(block%8)*(grid/8)+block/8:block),G(grid){}
  __device__ __forceinline__ bool next(int i,AttnUnit&u)const{
    if(G==256){ if(i>=4)return false; const int s=vcu&1; u.bh=vcu>>1; u.qb=s?((i==0)?6:(i==1)?1:(i==2)?5:2):((i==0)?7:(i==1)?0:(i==2)?4:3); return true; }
    const int L=i*G+vcu; if(L>=1024)return false; u.bh=L>>3; u.qb=L&7; return true; }
  __device__ __forceinline__ void a_ready(const AttnUnit&)const{}
  __device__ __forceinline__ void done(const AttnUnit&)const{}
};
template<class Sched,int THRL=8> __device__ __forceinline__ void attn_phase(char*lds,const AttnTensors&T,const Sched&S){
  AttnUnit u;
  for(int i=0;S.next(i,u);++i){ S.a_ready(u); attn_unit<THRL>(u.bh/NHEAD,u.bh%NHEAD,u.qb,T.Q,T.K,T.V,T.O,T.kbar,lds); S.done(u); }
}
#undef SBAR
#undef WAIT_BAR
}
constexpr int NWAVES = 8;
constexpr int T = 32768, D = 1024, SEQ = 2048, MEMROWS = 4096, INW = 5120;
constexpr float RMS_EPS = 1e-6f;
constexpr size_t MiB = 1u << 20;
constexpr size_t WS_CTL = 0, CTL_ZERO_BYTES = 2 * MiB, WS_KBAR = 1 * MiB;
constexpr size_t WS_WIN = 2 * MiB, WS_WC = 12 * MiB, WS_WA = 13 * MiB, WS_WM = 14 * MiB, WS_WXQ = 16 * MiB, WS_WXKV = 18 * MiB, WS_WXO = 22 * MiB, WS_MT = 24 * MiB, WS_ROPE = 28 * MiB;
constexpr size_t WS_MEMN = 32 * MiB, WS_KX = 40 * MiB, WS_VXT = 48 * MiB;
constexpr size_t WS_SSQ1 = 30 * MiB, WS_SSQ2 = 56 * MiB;
constexpr size_t WS_A = 64 * MiB;
constexpr size_t WS_YC = 128 * MiB, WS_QO = 160 * MiB, WS_U = 192 * MiB, WS_K = 224 * MiB, WS_V = 256 * MiB;
constexpr size_t WS_SGC = 320 * MiB, WS_SGA = 384 * MiB;
constexpr size_t WS_A8I = 320 * MiB, WS_ASC = 352 * MiB;
constexpr size_t WS_EIDX = 448 * MiB, WS_GW = 464 * MiB, WS_PW = 480 * MiB, WS_END = 496 * MiB;
constexpr size_t WS_U8 = 288 * MiB, WS_V8T = 304 * MiB, WS_SU = 29 * MiB, WS_SV = 29 * MiB + 512 * 1024;
constexpr size_t WS_QX = 128 * MiB, WS_PM = 192 * MiB, WS_OX = 128 * MiB;
constexpr size_t WS_PO = 128 * MiB;
constexpr size_t WS_SC = 128 * MiB;
constexpr int CW_TMO = 0, CW_BAR = 4096, CW_Q = 8192;
constexpr int RING_OFF = 0, RING_BYTES = 131072;
constexpr int LDSCTL_OFF = RING_BYTES, MISC_OFF = LDSCTL_OFF + 320;
constexpr int LDS_BYTES = 163840;
constexpr int UL_OFF = RING_BYTES + 512, UL_WAVE = (LDS_BYTES - UL_OFF) / 8, UL_CAP = ((UL_WAVE - 128 - 8) / 8) & ~15;

#define GAS __attribute__((address_space(1)))
#define LAS __attribute__((address_space(3)))
typedef unsigned short bf16;
typedef unsigned v4u __attribute__((ext_vector_type(4)));
typedef unsigned v2u __attribute__((ext_vector_type(2)));
typedef float v2f __attribute__((ext_vector_type(2)));
typedef float f32x3 __attribute__((ext_vector_type(3)));
typedef float f32x4 __attribute__((ext_vector_type(4)));
typedef float f32x2v __attribute__((ext_vector_type(2)));
typedef _Float16 h2v __attribute__((ext_vector_type(2)));
typedef GAS unsigned gu32;
#define RLX_AGENT __ATOMIC_RELAXED, __HIP_MEMORY_SCOPE_AGENT
#define LDS_WAIT() asm volatile("s_waitcnt lgkmcnt(0)" ::: "memory")
#define VM_WAIT() asm volatile("s_waitcnt vmcnt(0)" ::: "memory")
__device__ __forceinline__ unsigned pk2(float lo, float hi) { return pg8::cvt_pk_bf16(lo, hi); }
__device__ __forceinline__ float bflo(unsigned u) { return __uint_as_float(u << 16); }
__device__ __forceinline__ float bfhi(unsigned u) { return __uint_as_float(u & 0xffff0000u); }

#define XB_TMO      128
#define XB_XCNT(j)  (256  + 64 * (j))
#define XB_XSUB(j)  (1280 + 64 * (j))
#define XB_XGEN(j)  (2304 + 64 * (j))
#define XB_TOP      3328
#define XB_TOPGEN   3392
#define XCD_BAR_WORDS 3456
#define XB_SPIN_CAP (1u << 18)
__device__ __forceinline__ unsigned xb_ld(unsigned* p)              { return __hip_atomic_load(p, __ATOMIC_RELAXED, __HIP_MEMORY_SCOPE_AGENT); }
__device__ __forceinline__ unsigned xb_add(unsigned* p, unsigned v) { return __hip_atomic_fetch_add(p, v, __ATOMIC_RELAXED, __HIP_MEMORY_SCOPE_AGENT); }
__device__ __forceinline__ unsigned xb_xcc_id() { return (unsigned)__builtin_amdgcn_s_getreg((3 << 11) | 20) & 0xFu; }
#define XB_SPIN(cond, bar) do { unsigned _sp = 0; while (cond) { __builtin_amdgcn_s_sleep(1); \
    if ((++_sp & 255u) == 0u) { if (xb_ld(&(bar)[XB_TMO])) break; if (_sp > XB_SPIN_CAP) { atomicAdd(&(bar)[XB_TMO], 1u); break; } } } } while (0)
struct XcdBarrier { unsigned* bar; unsigned x; volatile LAS unsigned* st; };
__device__ __forceinline__ XcdBarrier xcd_barrier_post(unsigned* bar, volatile LAS unsigned* st) {
    XcdBarrier b; b.bar = bar; b.x = xb_xcc_id(); b.st = st;
    if (threadIdx.x == 0) (void)xb_add(&bar[XB_XCNT(b.x)], 1u);
    return b;
}
__device__ __forceinline__ void xcd_barrier_complete(unsigned* bar, unsigned x, unsigned& nloc, unsigned& nx) {
    const unsigned G = gridDim.x * gridDim.y * gridDim.z;
    unsigned sum, cnt, mine, sp = 0u;
    for (;;) {
        sum = 0u; cnt = 0u; mine = 0u;
#pragma unroll
        for (unsigned j = 0; j < 16; ++j) { const unsigned c = xb_ld(&bar[XB_XCNT(j)]); sum += c; cnt += (c > 0u) ? 1u : 0u; mine = (j == x) ? c : mine; }
        if (sum == G) break;
        __builtin_amdgcn_s_sleep(1);
        if ((++sp & 255u) == 0u) { if (xb_ld(&bar[XB_TMO])) break; if (sp > XB_SPIN_CAP) { atomicAdd(&bar[XB_TMO], 1u); break; } }
    }
    nloc = mine > 0u ? mine : 1u; nx = cnt > 0u ? cnt : 1u;
}
__device__ __forceinline__ void xcd_barrier(const XcdBarrier& b) {
    asm volatile("s_waitcnt vmcnt(0)" ::: "memory");
    __syncthreads();
    if (threadIdx.x == 0) {
        unsigned* bar = b.bar;
        __builtin_amdgcn_s_waitcnt(0);
        unsigned nloc = b.st[0], nx = b.st[1];
        if (nloc == 0u) { xcd_barrier_complete(bar, b.x, nloc, nx); b.st[0] = nloc; b.st[1] = nx; }
        const unsigned old = xb_add(&bar[XB_XSUB(b.x)], 1u);
        const unsigned gen = old / nloc;
        if (old + 1u == (gen + 1u) * nloc) {
            __builtin_amdgcn_fence(__ATOMIC_RELEASE, "agent");
            asm volatile("s_waitcnt vmcnt(0)" ::: "memory");
            const unsigned og = xb_add(&bar[XB_TOP], 1u);
            const unsigned tg = og / nx;
            if (og + 1u == (tg + 1u) * nx) xb_add(&bar[XB_TOPGEN], 1u);
            else XB_SPIN(xb_ld(&bar[XB_TOPGEN]) == tg, bar);
            __builtin_amdgcn_fence(__ATOMIC_ACQUIRE, "agent");
            xb_add(&bar[XB_XGEN(b.x)], 1u);
            asm volatile("s_waitcnt vmcnt(0)" ::: "memory");
        } else {
            XB_SPIN(xb_ld(&bar[XB_XGEN(b.x)]) == gen, bar);
            __builtin_amdgcn_fence(__ATOMIC_ACQUIRE, "agent");
            asm volatile("s_waitcnt vmcnt(0)" ::: "memory");
        }
    }
    __syncthreads();
}

struct MapId { static __device__ __forceinline__ int src(int j) { return j; } };
struct MapWin {
    static __device__ __forceinline__ int src(int j) {
        if (j < 1024) { const int g8 = j >> 3, i = j & 7; return ((i < 4) ? 0 : 1024) + 4 * g8 + (i & 3); }
        if (j < 1536) return 512 + (j - 1024);
        if (j < 2560) { const int jj = j - 1536, qk = jj >> 9, p = jj & 511, head = p >> 6, pl = p & 63, g = pl >> 3, i = pl & 7; return 1536 + qk * 512 + head * 64 + 4 * g + (i & 3) + 32 * (i >> 2); }
        return j;
    }
};
template <class MAP>
__device__ __forceinline__ void p0_transpose_item(const float* W, int K, int N, int NOUT, bf16* WT, LAS float* scr, int item, int lane, const float* gain = nullptr) {
    const int nblk = NOUT / 32, kb = item / nblk, nb = item % nblk, k0 = 64 * kb, n0 = 32 * nb;
    const int sc = MAP::src(n0 + (lane & 31));
    float wv[32];
#pragma unroll
    for (int i = 0; i < 32; ++i) wv[i] = W[(size_t)(k0 + 2 * i + (lane >> 5)) * N + sc];
#pragma unroll
    for (int i = 0; i < 32; ++i) { const int kk = 2 * i + (lane >> 5); const float gk = gain ? gain[k0 + kk] : 1.f; scr[kk * 33 + (lane & 31)] = wv[i] * gk; }
    LDS_WAIT(); asm volatile("" ::: "memory");
    const int c = lane & 7;
#pragma unroll
    for (int j = 0; j < 4; ++j) { const int n = (lane >> 3) + 8 * j; const LAS float* s = scr + (8 * c) * 33 + n;
        v4u o; o.x = pk2(s[0 * 33], s[1 * 33]); o.y = pk2(s[2 * 33], s[3 * 33]); o.z = pk2(s[4 * 33], s[5 * 33]); o.w = pk2(s[6 * 33], s[7 * 33]);
        *(GAS v4u*)(WT + (size_t)(n0 + n) * K + k0 + 8 * c) = o; }
    LDS_WAIT(); asm volatile("" ::: "memory");
}
__device__ __forceinline__ void rms_row_to_bf16(const float* xrow, const float* g, bf16* orow, int lane) {
    const GAS f32x4* xr = (const GAS f32x4*)xrow + lane; const GAS f32x4* gr = (const GAS f32x4*)g + lane;
    f32x4 v[4]; float s = 0.f;
#pragma unroll
    for (int j = 0; j < 4; ++j) { v[j] = xr[64 * j]; s += (v[j].x * v[j].x + v[j].y * v[j].y) + (v[j].z * v[j].z + v[j].w * v[j].w); }
    const float r = rsqrtf(wave_sum(s) * (1.f / 1024.f) + RMS_EPS);
    GAS v2u* o8 = (GAS v2u*)orow + lane;
#pragma unroll
    for (int j = 0; j < 4; ++j) { const f32x4 gg = gr[64 * j]; v2u w; w.x = pk2(v[j].x * r * gg.x, v[j].y * r * gg.y); w.y = pk2(v[j].z * r * gg.z, v[j].w * r * gg.w); o8[64 * j] = w; }
}
template <int NR>
__device__ __forceinline__ void rms_rows_to_bf16(const float* x, const float* g, bf16* o, int m0, int stride, int lane) {
    f32x4 v[NR][4];
#pragma unroll
    for (int i = 0; i < NR; ++i) { const GAS f32x4* xr = (const GAS f32x4*)(x + (size_t)(m0 + i * stride) * 1024) + lane;
#pragma unroll
        for (int j = 0; j < 4; ++j) v[i][j] = xr[64 * j]; }
    f32x4 gg[4];
#pragma unroll
    for (int j = 0; j < 4; ++j) gg[j] = ((const GAS f32x4*)g + lane)[64 * j];
#pragma unroll
    for (int i = 0; i < NR; ++i) { float s = 0.f;
#pragma unroll
        for (int j = 0; j < 4; ++j) s += (v[i][j].x * v[i][j].x + v[i][j].y * v[i][j].y) + (v[i][j].z * v[i][j].z + v[i][j].w * v[i][j].w);
        const float r = rsqrtf(wave_sum(s) * (1.f / 1024.f) + RMS_EPS);
        GAS v2u* o8 = (GAS v2u*)(o + (size_t)(m0 + i * stride) * 1024) + lane;
#pragma unroll
        for (int j = 0; j < 4; ++j) { v2u w; w.x = pk2(v[i][j].x * r * gg[j].x, v[i][j].y * r * gg[j].y); w.y = pk2(v[i][j].z * r * gg[j].z, v[i][j].w * r * gg[j].w); o8[64 * j] = w; } }
}
__device__ __forceinline__ float fmax_asm(float a, float b) { float r; asm("v_max_f32 %0, %1, %2" : "=v"(r) : "v"(a), "v"(b)); return r; }
__device__ __forceinline__ float fmin_asm(float a, float b) { float r; asm("v_min_f32 %0, %1, %2" : "=v"(r) : "v"(a), "v"(b)); return r; }

#ifndef PH_MASK
#define PH_MASK 0xFFFFFFFFu
#endif
#define PH(k) ((PH_MASK >> (k)) & 1u)
#ifndef REP_MASK
#define REP_MASK 0u
#endif
#define NREP(k) (((REP_MASK >> (k)) & 1u) ? 2 : 1)
#ifndef DIAG_TS_A
#define DIAG_TS_A -1
#endif
#ifndef DIAG_TS_B
#define DIAG_TS_B -1
#endif
struct Args { const float* in[19]; float* out; unsigned char* ws; };

struct XOrder {
    const char* A; const char* Bt; int G, c, i0, mode;
    __device__ bool next(int i, pg8::Unit& u) const {
        if (i > 0) return false;
        const int L = i0 * G + c; if (L >= 512) return false;
        const int b = L >> 5, head = (L >> 3) & 3, rt = L & 7;
        u.pm = b * 8 + rt; u.pn = head;
        if (mode == 0) { u.a = A + (size_t)(b * 2048 + rt * 256) * 1024 * 2; u.b = Bt + (size_t)(head * 256) * 1024 * 2; }
        else { u.a = A + ((size_t)(b * 2048 + rt * 256) * 1024 + head * 256) * 2;
               u.b = (mode == 2) ? Bt + ((size_t)(head * 256) * 4096 + b * 256) * 2 : Bt + ((size_t)(b * 256) * 1024 + head * 256) * 2; }
        return true;
    }
};

struct OneUnit { pg8::Unit u0; __device__ __forceinline__ bool next(int i, pg8::Unit& u) const { if (i != 0) return false; u = u0; return true; } };
struct EpiTile {
    static constexpr bool PERM = true, AFTER_DRAIN = true;
    const float* ssq;
    __device__ __forceinline__ void fused(pg8::AccT& acc, const pg8::Unit& u, int wr, int wc, int fr, int fq, PG8_LAS unsigned char* lds, int wid, int lane) const {
        { int t_ = threadIdx.x; asm volatile("" : "+v"(t_)); fr = t_ & 15; fq = (t_ >> 4) & 3; }
        typedef _Float16 h8 __attribute__((ext_vector_type(8)));
        float rsa[2][4];
#pragma unroll
        for (int ai = 0; ai < 2; ++ai)
#pragma unroll
            for (int m = 0; m < 4; ++m) { int rl = wr * 64 + fr + ai * pg8::HALF + m * 16; asm volatile("" : "+v"(rl)); rsa[ai][m] = pg8::row_rs(ssq, u.pm * pg8::BM + rl); }
        __builtin_amdgcn_sched_barrier(0);
#pragma unroll
        for (int ai = 0; ai < 2; ++ai)
#pragma unroll
            for (int m = 0; m < 4; ++m) { int rl = wr * 64 + fr + ai * pg8::HALF + m * 16; asm volatile("" : "+v"(rl)); const float rs = rsa[ai][m];
#pragma unroll
                for (int bj = 0; bj < 2; ++bj) { const f32x4 v0 = acc[ai][bj][m][0] * rs, v1 = acc[ai][bj][m][1] * rs;
                    h8 w = {(_Float16)v0[0], (_Float16)v0[1], (_Float16)v0[2], (_Float16)v0[3], (_Float16)v1[0], (_Float16)v1[1], (_Float16)v1[2], (_Float16)v1[3]};
                    *(PG8_LAS h8*)(lds + (wc * 4 + fq + bj * 16) * 4096 + rl * 16) = w; } }
    }
};

__global__ void __launch_bounds__(NWAVES * 64, 2) mk_fwd(Args args) {
    extern __shared__ __attribute__((aligned(16))) unsigned char lds[];
    LAS unsigned char* L = (LAS unsigned char*)lds;
    volatile LAS unsigned* MISC = (volatile LAS unsigned*)(L + MISC_OFF);
    const int wave = __builtin_amdgcn_readfirstlane((int)threadIdx.x >> 6);
#define PH_LANES int tid = threadIdx.x; asm volatile("" : "+v"(tid)); const int lane = tid & 63; const int gt = vcu * (NWAVES * 64) + tid; (void)lane; (void)gt
    const int G = gridDim.x; const int bx = blockIdx.x; const int vcu = (G % 8 == 0) ? (bx % 8) * (G / 8) + bx / 8 : bx;
    unsigned char* ws = args.ws;
    gu32* ctl = (gu32*)(ws + WS_CTL);
    for (int u = threadIdx.x; u < (LDS_BYTES - LDSCTL_OFF) / 4; u += NWAVES * 64) ((LAS unsigned*)(L + LDSCTL_OFF))[u] = 0u;
    __syncthreads();
    XcdBarrier bar = xcd_barrier_post((unsigned*)(ctl + CW_BAR), MISC + 8);
    unsigned long long* tsw = (unsigned long long*)(ws + WS_CTL + 65536);
    int n_ts = 0;
#define TSTAMP() do { if (DIAG_TS_A >= 0) { if (bx == 0 && threadIdx.x == 0) tsw[n_ts] = __builtin_amdgcn_s_memrealtime(); ++n_ts; } } while (0)
    TSTAMP();

    const float *x = args.in[0], *mem = args.in[1], *g_mix = args.in[2], *w_in = args.in[3], *w_conv = args.in[4], *w_conv_out = args.in[5], *w_attn_out = args.in[6], *w_merge = args.in[7],
                *g_xattn = args.in[8], *g_mem = args.in[9], *w_xq = args.in[10], *w_xkv = args.in[11], *w_xo = args.in[12], *g_ffn = args.in[13], *w_pq = args.in[14], *sub_keys = args.in[15],
                *peer_u = args.in[16], *peer_v = args.in[17], *g_final = args.in[18];
    float* out = args.out;
    bf16 *WinT = (bf16*)(ws + WS_WIN), *WcT = (bf16*)(ws + WS_WC), *WaT = (bf16*)(ws + WS_WA), *WmT = (bf16*)(ws + WS_WM), *WxqT = (bf16*)(ws + WS_WXQ), *WxkvT = (bf16*)(ws + WS_WXKV),
         *WxoT = (bf16*)(ws + WS_WXO), *MT = (bf16*)(ws + WS_MT);
    float* ropec = (float*)(ws + WS_ROPE); float* ropes = ropec + 2048 * 32;
    float* kbar = (float*)(ws + WS_KBAR);
    bf16 *MEMN = (bf16*)(ws + WS_MEMN), *KX = (bf16*)(ws + WS_KX), *VXT = (bf16*)(ws + WS_VXT), *A = (bf16*)(ws + WS_A);
    bf16 *YC = (bf16*)(ws + WS_YC), *QO = (bf16*)(ws + WS_QO), *U = (bf16*)(ws + WS_U), *KB = (bf16*)(ws + WS_K), *VB = (bf16*)(ws + WS_V), *SGC = (bf16*)(ws + WS_SGC), *SGA = (bf16*)(ws + WS_SGA);
    bf16 *QX = (bf16*)(ws + WS_QX), *PM = (bf16*)(ws + WS_PM), *OX = (bf16*)(ws + WS_OX);
    _Float16* SC = (_Float16*)(ws + WS_SC);
    unsigned char* A8I = ws + WS_A8I; float* ASC = (float*)(ws + WS_ASC);
    int* EIDX = (int*)(ws + WS_EIDX); float* GW = (float*)(ws + WS_GW); unsigned* PW = (unsigned*)(ws + WS_PW);
    float* PO = (float*)(ws + WS_PO); float* SSQ1 = (float*)(ws + WS_SSQ1); float* SSQ2 = (float*)(ws + WS_SSQ2); (void)PO;
    unsigned char* U8 = ws + WS_U8; unsigned char* V8T = ws + WS_V8T; float* SU = (float*)(ws + WS_SU); float* SV = (float*)(ws + WS_SV);
    const int gw = vcu * NWAVES + wave, NGW = G * NWAVES;
    const int NGT = G * NWAVES * 64;

    asm volatile("; ===== PHASE 0 =====");
    if (PH(0)) for (int rep = 0; rep < NREP(0); ++rep) {
        PH_LANES; const bool dummy = rep < NREP(0) - 1; (void)dummy;
        const bool fold_first = ((bx >> 3) & 1) != 0;
        auto p0_fold = [&]() {
        {
            LAS float* skl = (LAS float*)(L + RING_OFF);
            LAS float* wtl = skl + 128 * 129;
            for (int it = bx; it < 256; it += G) {
                const int hp = it >> 4, cb = it & 15;
                for (int i = tid; i < 128 * 128; i += NWAVES * 64) { const int n = i >> 7, d = i & 127; skl[n * 129 + d] = sub_keys[((size_t)hp * 128 + n) * 128 + d]; }
                for (int i = tid; i < 64 * 128; i += NWAVES * 64) { const int c = i >> 7, d = i & 127; wtl[c * 129 + d] = w_pq[(size_t)(cb * 64 + c) * 2048 + hp * 128 + d] * g_ffn[cb * 64 + c]; }
                __syncthreads();
                const int cg = tid & 15, ng = tid >> 4;
                float acc[4][4];
#pragma unroll
                for (int i = 0; i < 4; ++i)
#pragma unroll
                    for (int j = 0; j < 4; ++j) acc[i][j] = 0.f;
                for (int d = 0; d < 128; ++d) {
                    float wv[4], sv[4];
#pragma unroll
                    for (int i = 0; i < 4; ++i) { wv[i] = wtl[(4 * cg + i) * 129 + d]; sv[i] = skl[(4 * ng + i) * 129 + d]; }
#pragma unroll
                    for (int i = 0; i < 4; ++i)
#pragma unroll
                        for (int j = 0; j < 4; ++j) acc[i][j] += sv[i] * wv[j];
                }
#pragma unroll
                for (int i = 0; i < 4; ++i) { v2u w; w.x = pk2(acc[i][0], acc[i][1]); w.y = pk2(acc[i][2], acc[i][3]); *(GAS v2u*)(MT + (size_t)(hp * 128 + 4 * ng + i) * 1024 + cb * 64 + 4 * cg) = w; }
                __syncthreads();
            }
        }
        };
        if (fold_first) { p0_fold(); }
        __syncthreads();
        LAS float* scr = (LAS float*)(L + RING_OFF + wave * 16384);
        constexpr int I_IN = (1024 / 64) * (5120 / 32), I_C = (512 / 64) * (1024 / 32), I_M = (1024 / 64) * (1024 / 32), I_KV = (1024 / 64) * (2048 / 32);
        constexpr int NITEMS = I_IN + 2 * I_C + 3 * I_M + I_KV;
        for (int it = gw; it < NITEMS; it += NGW) {
            int r = it;
            if (r < I_IN) { p0_transpose_item<MapWin>(w_in, 1024, 5120, 5120, WinT, scr, r, lane); continue; } r -= I_IN;
            if (r < I_C) { p0_transpose_item<MapId>(w_conv_out, 512, 1024, 1024, WcT, scr, r, lane); continue; } r -= I_C;
            if (r < I_C) { p0_transpose_item<MapId>(w_attn_out, 512, 1024, 1024, WaT, scr, r, lane); continue; } r -= I_C;
            if (r < I_M) { p0_transpose_item<MapId>(w_merge, 1024, 1024, 1024, WmT, scr, r, lane); continue; } r -= I_M;
            if (r < I_M) { p0_transpose_item<MapId>(w_xq, 1024, 1024, 1024, WxqT, scr, r, lane, g_xattn); continue; } r -= I_M;
            if (r < I_M) { p0_transpose_item<MapId>(w_xo, 1024, 1024, 1024, WxoT, scr, r, lane); continue; } r -= I_M;
            p0_transpose_item<MapId>(w_xkv, 1024, 2048, 2048, WxkvT, scr, r, lane);
        }
        { int m = gw; for (; m + 7 * NGW < T; m += 8 * NGW) rms_rows_to_bf16<8>(x, g_mix, A, m, NGW, lane); for (; m + 3 * NGW < T; m += 4 * NGW) rms_rows_to_bf16<4>(x, g_mix, A, m, NGW, lane); for (; m < T; m += NGW) rms_row_to_bf16(x + (size_t)m * D, g_mix, A + (size_t)m * D, lane); }
        { int m = gw; for (; m + NGW < MEMROWS; m += 2 * NGW) rms_rows_to_bf16<2>(mem, g_mem, MEMN, m, NGW, lane); for (; m < MEMROWS; m += NGW) rms_row_to_bf16(mem + (size_t)m * D, g_mem, MEMN + (size_t)m * D, lane); }
        for (int i = gt; i < 2048 * 32; i += NGT) { const int pos = i >> 5, f = i & 31; const float inv = powf(10000.0f, -(float)f / 32.0f); const float ang = (float)pos * inv; ropec[i] = cosf(ang); ropes[i] = sinf(ang); }
        __syncthreads();
        if (!fold_first) { p0_fold(); }
    }
    xcd_barrier(bar); TSTAMP();

    asm volatile("; ===== PHASE 1 =====");
    if (PH(1)) for (int rep = 0; rep < NREP(1); ++rep) {
        PH_LANES; const bool dummy = rep < NREP(1) - 1; (void)dummy;
        pg8::Gemm g{1024, 1024, 1024}; pg8::StaticOrder S; S.init(A, 1024, WinT, 1024, T, INW, G, bx);
        pg8::EpiIn E{U, YC, QO, KB, VB, SGC, SGA, ropec, ropes, kbar, 0.125f * 1.4426950408889634f};
        pg8::gemm_phase<pg8::EpiIn, pg8::StaticOrder, true>(L + RING_OFF, g, S, E);
    }
    if (PH(1)) for (int rep = 0; rep < NREP(1); ++rep) {
        PH_LANES; const bool dummy = rep < NREP(1) - 1; (void)dummy;
        pg8::Gemm g{1024, 1024, 1024}; pg8::StaticOrder S; S.init(MEMN, 1024, WxkvT, 1024, MEMROWS, 1024, G, (G == 256) ? (bx + 192) % G : bx);
        pg8::EpiBf16 E{KX, 1024};
        pg8::gemm_phase<pg8::EpiBf16, pg8::StaticOrder, true>(L + RING_OFF, g, S, E);
    }
    if (PH(1)) for (int rep = 0; rep < NREP(1); ++rep) {
        PH_LANES; const bool dummy = rep < NREP(1) - 1; (void)dummy;
        pg8::Gemm g{1024, 1024, 1024}; pg8::StaticOrder S; S.init(WxkvT + (size_t)1024 * 1024, 1024, MEMN, 1024, 1024, MEMROWS, G, (G == 256) ? (bx + 64) % G : (bx + 128) % G);
        pg8::EpiBf16 E{VXT, 4096};
        pg8::gemm_phase<pg8::EpiBf16, pg8::StaticOrder, true>(L + RING_OFF, g, S, E);
    }
    if (PH(1)) for (int rep = 0; rep < NREP(1); ++rep) {
        PH_LANES; const bool dummy = rep < NREP(1) - 1; (void)dummy;
        int cb, ncb;
        if (G == 256) { const bool idle = bx < 64 || (bx >= 128 && bx < 192); cb = idle ? ((bx < 64) ? bx : bx - 64) : 256; ncb = 128; } else { cb = bx; ncb = G; }
        const int cw = cb * NWAVES + wave, ncw = ncb * NWAVES;
        { const GAS f32x4* gp = (const GAS f32x4*)g_ffn + lane; const f32x4 gg[4] = {gp[0], gp[64], gp[128], gp[192]};
#pragma unroll 1
        for (int e4 = (cb < ncb ? cw : 16384); e4 < 16384; e4 += 4 * ncw) {
            f32x4 vq[4][4];
#pragma unroll
            for (int q = 0; q < 4; ++q) { const int eq = e4 + q * ncw < 16384 ? e4 + q * ncw : e4; const GAS f32x4* r = (const GAS f32x4*)(peer_u + (size_t)eq * D) + lane;
#pragma unroll
                for (int j = 0; j < 4; ++j) vq[q][j] = r[64 * j]; }
            __builtin_amdgcn_sched_barrier(0);
#pragma unroll
            for (int q = 0; q < 4; ++q) { const int e = e4 + q * ncw; if (e >= 16384) break;
                f32x4 v[4]; float am = 0.f;
#pragma unroll
                for (int j = 0; j < 4; ++j) { v[j] = vq[q][j] * gg[j]; am = fmaxf(fmaxf(am, fmaxf(fabsf(v[j].x), fabsf(v[j].y))), fmaxf(fabsf(v[j].z), fabsf(v[j].w))); }
                am = wave_max(am);
                const float sc = am > 0.f ? 7.f / am : 1.f; int ns = 0;
#pragma unroll
                for (int j = 0; j < 2; ++j) {
                    const int l0 = (int)rintf(v[j].x * sc) + 8, l1 = (int)rintf(v[j].y * sc) + 8, l2 = (int)rintf(v[j].z * sc) + 8, l3 = (int)rintf(v[j].w * sc) + 8;
                    const int h0 = (int)rintf(v[j + 2].x * sc) + 8, h1 = (int)rintf(v[j + 2].y * sc) + 8, h2 = (int)rintf(v[j + 2].z * sc) + 8, h3 = (int)rintf(v[j + 2].w * sc) + 8;
                    ns += (l0 + l1) + (l2 + l3) + (h0 + h1) + (h2 + h3);
                    *(GAS unsigned*)(U8 + (size_t)e * 512 + 4 * lane + 256 * j) = (unsigned)(l0 | (h0 << 4)) | ((unsigned)(l1 | (h1 << 4)) << 8) | ((unsigned)(l2 | (h2 << 4)) << 16) | ((unsigned)(l3 | (h3 << 4)) << 24); }
                const float nsf = wave_sum((float)ns);
                if (lane == 0) { SU[4 * e] = am > 0.f ? am * (1.f / 7.f) : 1.f; SU[4 * e + 2] = nsf; } }
        } }
        __syncthreads();
        for (int it = cb; it < 256; it += ncb) {
            const int e0 = it * 64;
#pragma unroll 1
            for (int rb = 0; rb < 8; rb += 4) {
                f32x4 vq[4][4];
#pragma unroll
                for (int q = 0; q < 4; ++q) { const GAS f32x4* r = (const GAS f32x4*)(peer_v + (size_t)(e0 + wave * 8 + rb + q) * D) + lane;
#pragma unroll
                    for (int j = 0; j < 4; ++j) vq[q][j] = r[64 * j]; }
                __builtin_amdgcn_sched_barrier(0);
#pragma unroll
                for (int q = 0; q < 4; ++q) { const int el = wave * 8 + rb + q, e = e0 + el; float am = 0.f;
#pragma unroll
                    for (int j = 0; j < 4; ++j) am = fmaxf(fmaxf(am, fmaxf(fabsf(vq[q][j].x), fabsf(vq[q][j].y))), fmaxf(fabsf(vq[q][j].z), fabsf(vq[q][j].w)));
                    am = wave_max(am);
                    const float sc = am > 0.f ? 4.f / am : 1.f; if (lane == 0) SU[4 * e + 1] = am > 0.f ? am * 0.25f : 1.f;
#pragma unroll
                    for (int j = 0; j < 4; ++j) { int w = __builtin_amdgcn_cvt_pk_bf8_f32(vq[q][j].x * sc, vq[q][j].y * sc, 0, false); w = __builtin_amdgcn_cvt_pk_bf8_f32(vq[q][j].z * sc, vq[q][j].w * sc, w, true);
                        *(LAS unsigned*)(L + RING_OFF + el * 1024 + 4 * lane + 256 * j) = (unsigned)w; } }
            }
            __syncthreads();
#pragma unroll
            for (int i = 0; i < 8; ++i) { const int idx = tid + 512 * i, sl = idx >> 5, k = idx & 31;
                const v2u a0 = *(const LAS v2u*)(L + RING_OFF + (2 * k) * 1024 + sl * 8), a1 = *(const LAS v2u*)(L + RING_OFF + (2 * k + 1) * 1024 + sl * 8);
                *(GAS v4u*)(V8T + ((size_t)sl * 16384 + e0 + 2 * k) * 8) = (v4u){a0.x, a0.y, a1.x, a1.y}; }
            __syncthreads();
        }
    }
    xcd_barrier(bar); TSTAMP();

    asm volatile("; ===== PHASE 2 =====");
    if (PH(2)) for (int rep = 0; rep < NREP(2); ++rep) {
        PH_LANES; const bool dummy = rep < NREP(2) - 1; (void)dummy;
        {
            const int cg = gt & 63;
            const f32x4 w0a = *(const GAS f32x4*)(w_conv + cg * 8), w0b = *(const GAS f32x4*)(w_conv + cg * 8 + 4);
            const f32x4 w1a = *(const GAS f32x4*)(w_conv + 512 + cg * 8), w1b = *(const GAS f32x4*)(w_conv + 512 + cg * 8 + 4);
            const f32x4 w2a = *(const GAS f32x4*)(w_conv + 1024 + cg * 8), w2b = *(const GAS f32x4*)(w_conv + 1024 + cg * 8 + 4);
#pragma unroll 1
            for (int i = gt; i < T * 64; i += 4 * NGT) {
                v4u u0[4], u1[4], u2[4], bq[4];
#pragma unroll
                for (int j = 0; j < 4; ++j) { const int ij = i + j * NGT; const int row = (ij < T * 64 ? ij : gt) >> 6, s = row & 2047;
                    u0[j] = *(const GAS v4u*)(U + (size_t)row * 512 + cg * 8);
                    u1[j] = (v4u){0u, 0u, 0u, 0u}; u2[j] = (v4u){0u, 0u, 0u, 0u};
                    if (s >= 1) u1[j] = *(const GAS v4u*)(U + (size_t)(row - 1) * 512 + cg * 8);
                    if (s >= 2) u2[j] = *(const GAS v4u*)(U + (size_t)(row - 2) * 512 + cg * 8);
                    bq[j] = *(const GAS v4u*)(YC + (size_t)row * 512 + cg * 8); }
                __builtin_amdgcn_sched_barrier(0);
#pragma unroll
                for (int j = 0; j < 4; ++j) { const int ij = i + j * NGT; if (ij >= T * 64) break; const int row = ij >> 6;
                    v4u o;
#define CONV2(q, wa, ia, ib) pk2(bflo(bq[j].q) * (w0##wa[ia] * bflo(u2[j].q) + w1##wa[ia] * bflo(u1[j].q) + w2##wa[ia] * bflo(u0[j].q)), bfhi(bq[j].q) * (w0##wa[ib] * bfhi(u2[j].q) + w1##wa[ib] * bfhi(u1[j].q) + w2##wa[ib] * bfhi(u0[j].q)))
                    o.x = CONV2(x, a, 0, 1); o.y = CONV2(y, a, 2, 3); o.z = CONV2(z, b, 0, 1); o.w = CONV2(w, b, 2, 3);
#undef CONV2
                    { const bool conv_dummy = (NREP(2) == 2) && !dummy; *(GAS v4u*)(YC + (size_t)row * 512 + cg * 8) = conv_dummy ? bq[j] : o; } }
            }
        }
        __syncthreads();
        const attn_body::AttnTensors AT{(const attn_body::bf16*)QO, (const attn_body::bf16*)KB, (const attn_body::bf16*)VB, (attn_body::bf16*)(dummy ? A : QO), kbar};
        const attn_body::StaticOrder S(G, bx);
        attn_body::attn_phase<attn_body::StaticOrder>((char*)lds + RING_OFF, AT, S);
    }
    xcd_barrier(bar); TSTAMP();

    asm volatile("; ===== PHASE 3 =====");
    if (PH(3)) for (int rep = 0; rep < NREP(3); ++rep) {
        PH_LANES; const bool dummy = rep < NREP(3) - 1; (void)dummy;
        pg8::Gemm g{512, 512, 512}; pg8::StaticOrder S; S.init(YC, 512, WcT, 512, T, 1024, G, bx);
        pg8::EpiGateMul E{SGC, dummy ? A : SGC, 1024};
        pg8::gemm_phase<pg8::EpiGateMul, pg8::StaticOrder, true>(L + RING_OFF, g, S, E);
    }
    if (PH(3)) for (int rep = 0; rep < NREP(3); ++rep) {
        PH_LANES; const bool dummy = rep < NREP(3) - 1; (void)dummy;
        pg8::Gemm g{512, 512, 512}; pg8::StaticOrder S; S.init(QO, 512, WaT, 512, T, 1024, G, bx);
        pg8::EpiGateFma E{SGC, SGA, dummy ? A : SGA, 1024};
        pg8::gemm_phase<pg8::EpiGateFma, pg8::StaticOrder, true>(L + RING_OFF, g, S, E);
    }
    xcd_barrier(bar); TSTAMP();

    asm volatile("; ===== PHASE 4 =====");
    if (PH(4)) for (int rep = 0; rep < NREP(4); ++rep) {
        PH_LANES; const bool dummy = rep < NREP(4) - 1; (void)dummy;
        pg8::Gemm g{1024, 1024, 1024}; pg8::StaticOrder S; S.init(SGA, 1024, WmT, 1024, T, 1024, G, bx);
        pg8::EpiResNorm<true> E{x, A, SSQ1, 1024, 1.f};
        pg8::gemm_phase<pg8::EpiResNorm<true>, pg8::StaticOrder, true>(L + RING_OFF, g, S, E);
    }
    xcd_barrier(bar); TSTAMP();

    asm volatile("; ===== PHASE 6 =====");
    if (PH(6)) for (int rep = 0; rep < NREP(6); ++rep) {
        PH_LANES; const bool dummy = rep < NREP(6) - 1; (void)dummy;
        const pg8::Gemm gq{1024, 1024, 1024}, gs{1024, 1024, 256}, gv{1024, 4096, 256};
        const pg8::EpiBf16RS Eq{QX, 1024, SSQ1}; const pg8::EpiSoftmax Es{PM, 1024, 0.0625f * 1.4426950408889634f}; const pg8::EpiBf16 Ev{OX, 1024};
        { XOrder S{(const char*)A, (const char*)WxqT, G, vcu, 0, 0}; pg8::gemm_phase<pg8::EpiBf16RS, XOrder, false>(L + RING_OFF, gq, S, Eq); }
        VM_WAIT(); __syncthreads();
        { XOrder S{(const char*)QX, (const char*)KX, G, vcu, 0, 1}; pg8::gemm_phase<pg8::EpiSoftmax, XOrder, false>(L + RING_OFF, gs, S, Es); }
        VM_WAIT(); __syncthreads();
        { XOrder S{(const char*)PM, (const char*)VXT, G, vcu, 0, 2}; pg8::gemm_phase<pg8::EpiBf16, XOrder, false>(L + RING_OFF, gv, S, Ev); }
        VM_WAIT(); __syncthreads();
        { XOrder S{(const char*)A, (const char*)WxqT, G, vcu, 1, 0}; pg8::gemm_phase<pg8::EpiBf16RS, XOrder, false>(L + RING_OFF, gq, S, Eq); }
        VM_WAIT(); __syncthreads();
        { XOrder S{(const char*)QX, (const char*)KX, G, vcu, 1, 1}; pg8::gemm_phase<pg8::EpiSoftmax, XOrder, false>(L + RING_OFF, gs, S, Es); }
        VM_WAIT(); __syncthreads();
        { XOrder S{(const char*)PM, (const char*)VXT, G, vcu, 1, 2}; pg8::gemm_phase<pg8::EpiBf16, XOrder, false>(L + RING_OFF, gv, S, Ev); }
    }
    xcd_barrier(bar); TSTAMP();

    asm volatile("; ===== PHASE 9 =====");
    if (PH(9)) for (int rep = 0; rep < NREP(9); ++rep) {
        PH_LANES; const bool dummy = rep < NREP(9) - 1; (void)dummy;
        pg8::Gemm g{1024, 1024, 1024}; pg8::StaticOrder S; S.init(OX, 1024, WxoT, 1024, T, 1024, G, bx);
        pg8::EpiResNorm<false> E{nullptr, A, SSQ2, 1024, dummy ? 0.f : 1.f};
        pg8::gemm_phase<pg8::EpiResNorm<false>, pg8::StaticOrder, true>(L + RING_OFF, g, S, E);
    }
    xcd_barrier(bar); TSTAMP();

    asm volatile("; ===== PHASE 11 =====");
    if (PH(11)) for (int rep = 0; rep < NREP(11); ++rep) {
        PH_LANES; const bool dummy = rep < NREP(11) - 1; (void)dummy;
        typedef _Float16 h8 __attribute__((ext_vector_type(8)));
#define RCE(a, b) do { const float hi_ = fmax_asm(a, b); b = fmin_asm(a, b); a = hi_; } while (0)
#define RSORT16(K) do { RCE(K[0], K[1]); RCE(K[3], K[2]); RCE(K[4], K[5]); RCE(K[7], K[6]); RCE(K[8], K[9]); RCE(K[11], K[10]); RCE(K[12], K[13]); RCE(K[15], K[14]); RCE(K[0], K[2]); RCE(K[1], K[3]); RCE(K[6], K[4]); RCE(K[7], K[5]); RCE(K[8], K[10]); RCE(K[9], K[11]); RCE(K[14], K[12]); RCE(K[15], K[13]); RCE(K[0], K[1]); RCE(K[2], K[3]); RCE(K[5], K[4]); RCE(K[7], K[6]); RCE(K[8], K[9]); RCE(K[10], K[11]); RCE(K[13], K[12]); RCE(K[15], K[14]); RCE(K[0], K[4]); RCE(K[1], K[5]); RCE(K[2], K[6]); RCE(K[3], K[7]); RCE(K[12], K[8]); RCE(K[13], K[9]); RCE(K[14], K[10]); RCE(K[15], K[11]); RCE(K[0], K[2]); RCE(K[1], K[3]); RCE(K[4], K[6]); RCE(K[5], K[7]); RCE(K[10], K[8]); RCE(K[11], K[9]); RCE(K[14], K[12]); RCE(K[15], K[13]); RCE(K[0], K[1]); RCE(K[2], K[3]); RCE(K[4], K[5]); RCE(K[6], K[7]); RCE(K[9], K[8]); RCE(K[11], K[10]); RCE(K[13], K[12]); RCE(K[15], K[14]); RCE(K[0], K[8]); RCE(K[1], K[9]); RCE(K[2], K[10]); RCE(K[3], K[11]); RCE(K[4], K[12]); RCE(K[5], K[13]); RCE(K[6], K[14]); RCE(K[7], K[15]); RCE(K[0], K[4]); RCE(K[1], K[5]); RCE(K[2], K[6]); RCE(K[3], K[7]); RCE(K[8], K[12]); RCE(K[9], K[13]); RCE(K[10], K[14]); RCE(K[11], K[15]); RCE(K[0], K[2]); RCE(K[1], K[3]); RCE(K[4], K[6]); RCE(K[5], K[7]); RCE(K[8], K[10]); RCE(K[9], K[11]); RCE(K[12], K[14]); RCE(K[13], K[15]); RCE(K[0], K[1]); RCE(K[2], K[3]); RCE(K[4], K[5]); RCE(K[6], K[7]); RCE(K[8], K[9]); RCE(K[10], K[11]); RCE(K[12], K[13]); RCE(K[14], K[15]); } while (0)
#define RMERGE16(K) do { RCE(K[0], K[8]); RCE(K[1], K[9]); RCE(K[2], K[10]); RCE(K[3], K[11]); RCE(K[4], K[12]); RCE(K[5], K[13]); RCE(K[6], K[14]); RCE(K[7], K[15]); RCE(K[0], K[4]); RCE(K[1], K[5]); RCE(K[2], K[6]); RCE(K[3], K[7]); RCE(K[8], K[12]); RCE(K[9], K[13]); RCE(K[10], K[14]); RCE(K[11], K[15]); RCE(K[0], K[2]); RCE(K[1], K[3]); RCE(K[4], K[6]); RCE(K[5], K[7]); RCE(K[8], K[10]); RCE(K[9], K[11]); RCE(K[12], K[14]); RCE(K[13], K[15]); RCE(K[0], K[1]); RCE(K[2], K[3]); RCE(K[4], K[5]); RCE(K[6], K[7]); RCE(K[8], K[9]); RCE(K[10], K[11]); RCE(K[12], K[13]); RCE(K[14], K[15]); } while (0)
#define RKEYS(K, V0, V1, IDB) do { _Pragma("unroll") for (int e = 0; e < 8; ++e) { K[e] = __uint_as_float(__float_as_uint((float)V0[e]) | (unsigned)((IDB) + e)); K[8 + e] = __uint_as_float(__float_as_uint((float)V1[e]) | (unsigned)((IDB) + 8 + e)); } } while (0)
        pg8::Gemm g{1024, 1024, 1024};
        const EpiTile E{SSQ2};
#pragma unroll 1
        for (int ui = 0; ui < (T / 256) * 8; ++ui) {
            pg8::Unit cu_;
            {
                constexpr int nM = T / 256, nN = 8, nwg = nM * nN;
                const int Lq = ui * G + bx; if (Lq >= nwg) break;
                int wgid = Lq; { const int q = nwg / pg8::NXCD, r = nwg % pg8::NXCD, xcd = wgid % pg8::NXCD, off = wgid / pg8::NXCD; wgid = (xcd < r ? xcd * (q + 1) : r * (q + 1) + (xcd - r) * q) + off; }
                const int nig = pg8::WGM * nN, gid = wgid / nig, fm = gid * pg8::WGM, gsz = (nM - fm) < pg8::WGM ? (nM - fm) : pg8::WGM;
                cu_.pm = fm + ((wgid % nig) % gsz); cu_.pn = (wgid % nig) / gsz;
                cu_.a = (const char*)A + (size_t)cu_.pm * 256 * 1024 * 2; cu_.b = (const char*)MT + (size_t)cu_.pn * 256 * 1024 * 2; }
            { const OneUnit O{cu_}; pg8::gemm_phase<EpiTile, OneUnit, false>(L + RING_OFF, g, O, E); }
            __syncthreads();
            { int tl_ = threadIdx.x; asm volatile("" : "+v"(tl_)); tid = tl_; }
            const int lane = tid & 63;
            if (wave >= 4) {
            const int qt0 = cu_.pm * 256 + cu_.pn * 32 + (wave - 4) * 8;
        for (int tb4 = qt0; tb4 < qt0 + 8; tb4 += 4) {
            v4u r0[4], r1[4]; float sq[4];
#pragma unroll
            for (int i = 0; i < 4; ++i) { const GAS v4u* ar = (const GAS v4u*)(A + (size_t)(tb4 + i) * D + 16 * lane); r0[i] = ar[0]; r1[i] = ar[1]; sq[i] = lane < 16 ? SSQ2[(size_t)(tb4 + i) * 16 + lane] : 0.f; }
#pragma unroll
            for (int i = 0; i < 4; ++i) {
                float a[16];
                a[0] = bflo(r0[i].x); a[1] = bfhi(r0[i].x); a[2] = bflo(r0[i].y); a[3] = bfhi(r0[i].y); a[4] = bflo(r0[i].z); a[5] = bfhi(r0[i].z); a[6] = bflo(r0[i].w); a[7] = bfhi(r0[i].w);
                a[8] = bflo(r1[i].x); a[9] = bfhi(r1[i].x); a[10] = bflo(r1[i].y); a[11] = bfhi(r1[i].y); a[12] = bflo(r1[i].z); a[13] = bfhi(r1[i].z); a[14] = bflo(r1[i].w); a[15] = bfhi(r1[i].w);
                float amx = 0.f;
#pragma unroll
                for (int k = 0; k < 16; ++k) amx = fmaxf(amx, fabsf(a[k]));
                amx = wave_max(amx);
                const float rs2 = rsqrtf(wave_sum(sq[i]) * (1.f / 1024.f) + RMS_EPS);
                const float asc = amx > 0.f ? 127.f / amx : 1.f;
                v4u qv;
#define Q1(k, sel, old) __builtin_amdgcn_cvt_pk_u8_f32(__builtin_rintf(__builtin_fmaf(a[k], asc, 128.f)), sel, old)
                qv.x = Q1(3, 3, Q1(2, 2, Q1(1, 1, Q1(0, 0, 0u)))); qv.y = Q1(7, 3, Q1(6, 2, Q1(5, 1, Q1(4, 0, 0u)))); qv.z = Q1(11, 3, Q1(10, 2, Q1(9, 1, Q1(8, 0, 0u)))); qv.w = Q1(15, 3, Q1(14, 2, Q1(13, 1, Q1(12, 0, 0u))));
#undef Q1
                { const unsigned sh_ = lane < 32 ? 0u : 4u; v4u ov;
#define NP(q) do { auto r_ = __builtin_amdgcn_permlane32_swap(q, q, false, false);         \
                    ov_ = ((r_[0] >> sh_) & 0x0f0f0f0fu) | (((r_[1] >> sh_) & 0x0f0f0f0fu) << 4); } while (0)
                  unsigned ov_;
                  NP(qv.x); ov.x = ov_; NP(qv.y); ov.y = ov_; NP(qv.z); ov.z = ov_; NP(qv.w); ov.w = ov_;
#undef NP
                  *(GAS v4u*)(A8I + (size_t)(tb4 + i) * 1024 + 16 * lane) = ov; }
                float sa = (float)__builtin_amdgcn_sad_u8(qv.w, 0u, __builtin_amdgcn_sad_u8(qv.z, 0u, __builtin_amdgcn_sad_u8(qv.y, 0u, __builtin_amdgcn_sad_u8(qv.x, 0u, 0u))));
                sa = wave_sum(sa);
                if (lane == 0) { ASC[tb4 + i] = (amx > 0.f ? amx * (1.f / 127.f) : 1.f) * rs2; ASC[T + tb4 + i] = sa; }
            }
        }
            } else {
        LAS unsigned char* idl = L + UL_OFF + tid * 32;
        {
            const int rl_ = wave * 64 + lane; const int t = cu_.pm * 256 + rl_, h = cu_.pn;
            const LAS _Float16* row = (const LAS _Float16*)(L + RING_OFF + rl_ * 16);
            float LA[16], LB[16];
#pragma unroll 1
            for (int p = 0; p < 2; ++p) {
                const LAS _Float16* rp = row + p * 16 * 2048;
                float Tk[16];
                h8 n0 = *(const LAS h8*)(rp + 2 * 2048), n1 = *(const LAS h8*)(rp + 3 * 2048);
                { const h8 v0 = *(const LAS h8*)rp, v1 = *(const LAS h8*)(rp + 2048); RKEYS(Tk, v0, v1, 0); RSORT16(Tk); }
#pragma unroll 1
                for (int c = 1; c < 8; ++c) {
                    const h8 v0 = n0, v1 = n1;
                    { const int cn = c < 7 ? c + 1 : c; n0 = *(const LAS h8*)(rp + (2 * cn) * 2048); n1 = *(const LAS h8*)(rp + (2 * cn + 1) * 2048); }
                    float K[16]; RKEYS(K, v0, v1, c * 16); RSORT16(K);
#pragma unroll
                    for (int i = 0; i < 16; ++i) Tk[i] = fmax_asm(Tk[i], K[15 - i]);
                    RMERGE16(Tk);
                }
#pragma unroll
                for (int k = 0; k < 16; ++k) { if (p == 0) LA[k] = Tk[k]; else LB[k] = Tk[k]; }
            }
#pragma unroll
            for (int k = 0; k < 16; k += 4) {
                ((LAS unsigned*)idl)[k >> 2] = (__float_as_uint(LA[k]) & 127u) | ((__float_as_uint(LA[k + 1]) & 127u) << 8) | ((__float_as_uint(LA[k + 2]) & 127u) << 16) | ((__float_as_uint(LA[k + 3]) & 127u) << 24);
                ((LAS unsigned*)idl)[4 + (k >> 2)] = (__float_as_uint(LB[k]) & 127u) | ((__float_as_uint(LB[k + 1]) & 127u) << 8) | ((__float_as_uint(LB[k + 2]) & 127u) << 16) | ((__float_as_uint(LB[k + 3]) & 127u) << 24);
            }
#define CKEY(a, b) __uint_as_float((__float_as_uint(LA[a] + LB[b]) & ~255u) | (unsigned)(255 - (16 * (a) + (b))))
            float Ck[16];
#pragma unroll
            for (int a = 0; a < 16; ++a) Ck[a] = CKEY(a, 0);
#define CRUN(b, n) do { _Pragma("unroll") for (int j = 0; j < (n); ++j) Ck[15 - j] = fmax_asm(Ck[15 - j], CKEY(j, b)); RMERGE16(Ck); } while (0)
            CRUN(1, 8); CRUN(2, 5); CRUN(3, 4); CRUN(4, 3); CRUN(5, 2); CRUN(6, 2); CRUN(7, 2);
#pragma unroll
            for (int j = 0; j < 8; ++j) Ck[15 - j] = fmax_asm(Ck[15 - j], CKEY(0, 8 + j));
            RMERGE16(Ck);
#undef CRUN
#undef CKEY
            LDS_WAIT();
            float ex[16]; float sum = 0.f;
#pragma unroll
            for (int k = 0; k < 16; ++k) { ex[k] = __expf(Ck[k] - Ck[0]); sum += ex[k]; }
            const float rs = 1.f / sum;
            int* eo = EIDX + (size_t)t * 128 + h * 16;
#pragma unroll
            for (int k = 0; k < 16; k += 4) {
                int ev[4];
#pragma unroll
                for (int j = 0; j < 4; ++j) { const unsigned id = 255u - (__float_as_uint(Ck[k + j]) & 255u); ev[j] = (int)idl[id >> 4] * 128 + (int)idl[16 + (id & 15u)]; }
                *(GAS v4u*)(eo + k) = (v4u){(pk2(0.f, ex[k] * rs) & 0xffff0000u) | (unsigned)ev[0], (pk2(0.f, ex[k + 1] * rs) & 0xffff0000u) | (unsigned)ev[1],
                                             (pk2(0.f, ex[k + 2] * rs) & 0xffff0000u) | (unsigned)ev[2], (pk2(0.f, ex[k + 3] * rs) & 0xffff0000u) | (unsigned)ev[3]};
            }
            LDS_WAIT();
        }
            }
            __syncthreads();
        }
#undef RCE
#undef RSORT16
#undef RMERGE16
#undef RKEYS
    }
    xcd_barrier(bar); TSTAMP();


    asm volatile("; ===== PHASE 13 =====");
    if (PH(13)) for (int rep = 0; rep < NREP(13); ++rep) {
        PH_LANES; const bool dummy = rep < NREP(13) - 1; (void)dummy;
        volatile LAS unsigned* qslot = (volatile LAS unsigned*)(L + LDSCTL_OFF + 64);
        LAS unsigned char* tile = L + RING_OFF + wave * 16384;
        LAS float* rsl = (LAS float*)(L + UL_OFF + wave * UL_WAVE);
        LAS v2u* lst = (LAS v2u*)(L + UL_OFF + wave * UL_WAVE + 128);
        const int xs = (int)(xb_xcc_id() & 7u);
        __syncthreads();
        if (tid == 0) *qslot = __hip_atomic_fetch_add((unsigned*)(ctl + CW_Q + 64 * (rep * 8 + xs)), 1u, __ATOMIC_RELAXED, __HIP_MEMORY_SCOPE_AGENT);
        __syncthreads();
        const int rank = __builtin_amdgcn_readfirstlane((int)*qslot);
        int cnt[8];
#pragma unroll
        for (int j = 0; j < 8; ++j) cnt[j] = __builtin_amdgcn_readfirstlane((int)(xb_ld(bar.bar + XB_XCNT(j)) + xb_ld(bar.bar + XB_XCNT(j + 8))));
#pragma unroll 1
        for (int x = 0; x < 8; ++x) {
            int cn = 0;
#pragma unroll
            for (int j = 0; j < 8; ++j) cn = (j == x) ? cnt[j] : cn;
            int j0, jstep;
            if (x == xs) { j0 = rank * 8 + wave; jstep = cn * 8; } else if (cn == 0) { j0 = bx * 8 + wave; jstep = G * 8; } else continue;
#pragma unroll 1
            for (int job = j0; job < T / 16; job += jstep) {
                const int t0 = job * 16;
#pragma unroll 1
                for (int r0 = 0;; r0 += UL_CAP) {
                    int ln = lane; asm volatile("" : "+v"(ln));
#pragma unroll
                    for (int tl = 0; tl < 16; ++tl)
                        __builtin_amdgcn_global_load_lds((const unsigned*)(A8I + (size_t)(t0 + tl) * 1024 + ln * 16), (LAS unsigned*)(tile + tl * 1024), 16, 0, 0);
                    const float av_ = ASC[(ln & 16) * (T / 16) + t0 + (ln & 15)];
                    int total = 0;
                    unsigned pa[16], pb[16];
#pragma unroll
                    for (int tl = 0; tl < 16; ++tl) { pa[tl] = (unsigned)EIDX[(size_t)(t0 + tl) * 128 + ln]; pb[tl] = (unsigned)EIDX[(size_t)(t0 + tl) * 128 + 64 + ln]; }
#pragma unroll
                    for (int tl = 0; tl < 16; ++tl) {
                        const bool h0 = (int)((pa[tl] & 0xffffu) >> 11) == x, h1 = (int)((pb[tl] & 0xffffu) >> 11) == x;
                        const unsigned long long m0 = __ballot(h0), m1 = __ballot(h1);
                        const int k0 = total - r0 + (int)__builtin_amdgcn_mbcnt_hi((unsigned)(m0 >> 32), __builtin_amdgcn_mbcnt_lo((unsigned)m0, 0u));
                        const int k1 = total - r0 + __popcll(m0) + (int)__builtin_amdgcn_mbcnt_hi((unsigned)(m1 >> 32), __builtin_amdgcn_mbcnt_lo((unsigned)m1, 0u));
                        if (h0 && k0 >= 0 && k0 < UL_CAP) lst[k0] = (v2u){pa[tl], (unsigned)((tl << 7) | ln)};
                        if (h1 && k1 >= 0 && k1 < UL_CAP) lst[k1] = (v2u){pb[tl], (unsigned)((tl << 7) | 64 | ln)};
                        total += __popcll(m0) + __popcll(m1);
                    }
                    rsl[ln & 31] = av_;
                    asm volatile("s_waitcnt vmcnt(0)" ::: "memory");
                    const int count = (total - r0) < UL_CAP ? (total - r0) : UL_CAP;
                    asm volatile("s_waitcnt lgkmcnt(0)" ::: "memory");
#define JLOAD(Q, EN, B16) do { const int myi_ = (B16) + (lane >> 2); EN = lst[myi_ < count ? myi_ : count - 1];         \
                        const unsigned char* rp_ = U8 + (size_t)(EN.x & 0xffffu) * 512 + (lane & 3) * 16; \
                        EN##s = *(const GAS f32x3*)(SU + 4 * (EN.x & 0xffffu));                                             \
                        _Pragma("unroll") for (int j = 0; j < 8; ++j) Q[j] = *(const GAS v4u*)(rp_ + j * 64); } while (0)
#define UD8(w, aa, acc) __builtin_amdgcn_udot8((unsigned)(w), (unsigned)(aa), (unsigned)(acc), false)
#define JCOMP(Q, EN, B16) do { const LAS unsigned char* ap_ = tile + (EN.y >> 7) * 1024 + (lane & 3) * 16; unsigned d0 = 0, d1 = 0, d2 = 0, d3 = 0, g0 = 0, g1 = 0, g2 = 0, g3 = 0; \
                        _Pragma("unroll") for (int jh = 0; jh < 8; jh += 4) { v4u ql_[4], qh_[4];                     \
                            _Pragma("unroll") for (int j = 0; j < 4; ++j) { ql_[j] = *(const LAS v4u*)(ap_ + (jh + j) * 64); qh_[j] = *(const LAS v4u*)(ap_ + 512 + (jh + j) * 64); }        \
                            __builtin_amdgcn_sched_barrier(0); \
                            _Pragma("unroll") for (int j = 0; j < 4; ++j) { \
                                d0 = UD8(Q[jh + j].x, ql_[j].x, d0); d1 = UD8(Q[jh + j].y, ql_[j].y, d1); d2 = UD8(Q[jh + j].z, ql_[j].z, d2); d3 = UD8(Q[jh + j].w, ql_[j].w, d3); \
                                g0 = UD8(Q[jh + j].x, qh_[j].x, g0); g1 = UD8(Q[jh + j].y, qh_[j].y, g1); g2 = UD8(Q[jh + j].z, qh_[j].z, g2); g3 = UD8(Q[jh + j].w, qh_[j].w, g3); } \
                            __builtin_amdgcn_sched_barrier(0); } \
                        int doti = (int)(((d0 + d1) + (d2 + d3)) + ((((g0 + g1) + (g2 + g3))) << 4));                       \
                        doti += __builtin_amdgcn_mov_dpp(doti, 0xB1, 0xf, 0xf, true); doti += __builtin_amdgcn_mov_dpp(doti, 0x4E, 0xf, 0xf, true);        \
                        {                                                                                               \
                            const int e = (int)(EN.x & 0xffffu), slot = (int)(EN.y & 127u); const int tl_ = (int)(EN.y >> 7); const int t = t0 + tl_; \
                            const float dq = ((float)doti - 128.f * EN##s.z) - (8.f * rsl[16 + tl_] - 1048576.f);               \
                            const float act = dq * (EN##s.x * rsl[tl_]); const float u3 = 0.7978845608028654f * (act + 0.044715f * act * act * act); \
                            const float wv = act * __builtin_amdgcn_rcpf(1.f + __expf(-2.f * u3)) * (__uint_as_float(EN.x & 0xffff0000u) * EN##s.y);             \
                            (void)t; (void)slot; const int oi_ = (B16) + (lane >> 2); ((LAS unsigned*)lst)[2 * (oi_ < count ? oi_ : UL_CAP)] = ((unsigned)__builtin_bit_cast(unsigned short, (_Float16)wv) << 16) | (unsigned)e;     } } while (0)
                    if (count > 0) {
                        v4u qa[8], qb[8], qc[8], qd[8], qe[8]; v2u ena, enb, enc, end_, ene; f32x3 enas, enbs, encs, end_s, enes;
                        int b16 = 0;
                        if (128 < count) {
                            JLOAD(qa, ena, 0); asm volatile("" ::: "memory"); JLOAD(qb, enb, 16); asm volatile("" ::: "memory"); JLOAD(qc, enc, 32); asm volatile("" ::: "memory"); JLOAD(qd, end_, 48); asm volatile("" ::: "memory");
#pragma unroll 1
                            for (; b16 + 128 < count; b16 += 80) {
                                JLOAD(qe, ene, b16 + 64); JCOMP(qa, ena, b16);
                                JLOAD(qa, ena, b16 + 80); JCOMP(qb, enb, b16 + 16);
                                JLOAD(qb, enb, b16 + 96); JCOMP(qc, enc, b16 + 32);
                                JLOAD(qc, enc, b16 + 112); JCOMP(qd, end_, b16 + 48);
                                JLOAD(qd, end_, b16 + 128); JCOMP(qe, ene, b16 + 64);
                            }
                        } else {
                            JLOAD(qa, ena, 0);
                            if (16 < count) JLOAD(qb, enb, 16);
                            if (32 < count) JLOAD(qc, enc, 32);
                            if (48 < count) JLOAD(qd, end_, 48);
                        }
#pragma unroll 1
                        for (; b16 < count; b16 += 80) {
                            if (b16 + 64 < count) JLOAD(qe, ene, b16 + 64);
                            JCOMP(qa, ena, b16);
                            if (b16 + 16 < count) { if (b16 + 80 < count) JLOAD(qa, ena, b16 + 80); JCOMP(qb, enb, b16 + 16); }
                            if (b16 + 32 < count) { if (b16 + 96 < count) JLOAD(qb, enb, b16 + 96); JCOMP(qc, enc, b16 + 32); }
                            if (b16 + 48 < count) { if (b16 + 112 < count) JLOAD(qc, enc, b16 + 112); JCOMP(qd, end_, b16 + 48); }
                            if (b16 + 64 < count) { if (b16 + 128 < count) JLOAD(qd, end_, b16 + 128); JCOMP(qe, ene, b16 + 64); }
                        }
                        asm volatile("s_waitcnt lgkmcnt(0)" ::: "memory");
#pragma unroll 1
                        for (int i = lane; i < count; i += 64) { const v2u en_ = lst[i]; const int t = t0 + (int)(en_.y >> 7), slot = (int)(en_.y & 127u);
                            PW[((size_t)((t >> 6) * 8 + (slot >> 4)) * 4 + ((slot >> 2) & 3)) * 256 + (t & 63) * 4 + (slot & 3)] = en_.x; }
                    }
#undef UD8
#undef JLOAD
#undef JCOMP
                    asm volatile("s_waitcnt lgkmcnt(0)" ::: "memory");
                    if (r0 + UL_CAP >= total) break;
                }
            }
        }
        __syncthreads();
    }
    xcd_barrier(bar); TSTAMP();

    asm volatile("; ===== PHASE 14 =====");
    if (PH(14)) for (int rep = 0; rep < NREP(14); ++rep) {
        PH_LANES; const bool dummy = rep < NREP(14) - 1; (void)dummy;
        for (int item = vcu; item < 256; item += G) {
            const int sl = item & 127, half = item >> 7;
            __syncthreads();
#pragma unroll 1
            for (int i0 = 0; i0 < 16; i0 += 8) {
#pragma unroll
                for (int i = 0; i < 8; ++i) *(LAS v4u*)(L + RING_OFF + ((i0 + i) * 512 + tid) * 16) = *(const GAS v4u*)(V8T + (size_t)sl * 131072 + (size_t)((i0 + i) * 512 + tid) * 16);
            }
            __syncthreads();
            const GAS v4u* pwb = (const GAS v4u*)(PW + (size_t)(half * 256 + wave) * 8192) + lane;
            v4u buf[4][4];
#pragma unroll
            for (int c = 0; c < 4; ++c)
#pragma unroll
                for (int k = 0; k < 4; ++k) buf[c][k] = pwb[c * 256 + k * 64];
            v2u tb0[8], tb1[8], tb2[8], tb3[8]; v4u hqn = {0u, 0u, 0u, 0u}; unsigned three_ = 3u; asm volatile("" : "+v"(three_));
            unsigned accu[4] = {0u, 0u, 0u, 0u};
#define VREFILL(SL, SN) do { const int sn = (SN); const int gn = (sn >> 3) > 31 ? 31 : (sn >> 3), cc = sn & 7; const GAS v4u* src = pwb + (size_t)gn * 8 * 2048 + cc * 256;        \
                    _Pragma("unroll") for (int k = 0; k < 4; ++k) buf[SL][k] = src[k * 64]; } while (0)
#define VG2(TB, SL, K0) do { _Pragma("unroll") for (int k = 0; k < 2; ++k) _Pragma("unroll") for (int i = 0; i < 4; ++i) { unsigned ad_;         \
                    asm("v_lshlrev_b32_sdwa %0, %1, %2 dst_sel:DWORD dst_unused:UNUSED_PAD src0_sel:DWORD src1_sel:WORD_0" : "=v"(ad_) : "v"(three_), "v"(buf[SL][(K0) + k][i])); \
                    TB[k * 4 + i] = *(const LAS v2u*)(unsigned)(ad_ + RING_OFF); } } while (0)
#define VFMA(ACC, T) asm("v_pk_fma_f16 %0, %1, %2, %0 op_sel:[0,1,0] op_sel_hi:[1,1,1]" : "+v"(ACC) : "v"(T), "v"(p))
#define VC2(TB, SL, K0) do { _Pragma("unroll") for (int k = 0; k < 2; ++k) _Pragma("unroll") for (int i = 0; i < 4; ++i) { const unsigned p = buf[SL][(K0) + k][i]; const v2u q = TB[k * 4 + i]; \
                    const unsigned t0_ = __builtin_amdgcn_perm(0u, q.x, 0x010c000cu), t1_ = __builtin_amdgcn_perm(0u, q.x, 0x030c020cu), t2_ = __builtin_amdgcn_perm(0u, q.y, 0x010c000cu), t3_ = __builtin_amdgcn_perm(0u, q.y, 0x030c020cu); \
                    VFMA(accu[0], t0_); VFMA(accu[1], t1_); VFMA(accu[2], t2_); VFMA(accu[3], t3_); } } while (0)
#define VTB(S) (((S) & 3) == 0 ? tb0 : ((S) & 3) == 1 ? tb1 : ((S) & 3) == 2 ? tb2 : tb3)
#define VG(S)  VG2(VTB(S), ((S) >> 1) & 3, 2 * ((S) & 1))
#define VC(S)  VC2(VTB(S), ((S) >> 1) & 3, 2 * ((S) & 1))
#define VSTEPQ(S) do { VG(S); VC((S) - 2); if ((((S) - 2) & 1) != 0) VREFILL((((S) - 2) >> 1) & 3, itk * 8 + (((S) - 2) >> 1) + 4); } while (0)
#pragma unroll 1
            for (int itk = 0; itk <= 32; ++itk) {
                if (itk < 32) VG(0);
                if (itk > 0) { VC(14); }
                if (itk < 32) VG(1);
                if (itk > 0) {
                    VC(15); VREFILL(3, itk * 8 + 3);
                    const int g64 = half * 256 + (itk - 1) * 8 + wave;
                    const int t = g64 * 64 + lane;
                    GAS v4u* hr = (GAS v4u*)(A + (size_t)t * D + sl * 8);
                    const v4u hq = hqn; const float mulv = dummy ? 0.f : 1.f;
                    h2v acc[4];
#pragma unroll
                    for (int i = 0; i < 4; ++i) { const unsigned au_ = accu[i]; acc[i] = __builtin_bit_cast(h2v, au_); }
                    v4u ho; ho.x = pk2(bflo(hq.x) + (float)acc[0].x * mulv, bfhi(hq.x) + (float)acc[0].y * mulv); ho.y = pk2(bflo(hq.y) + (float)acc[1].x * mulv, bfhi(hq.y) + (float)acc[1].y * mulv);
                    ho.z = pk2(bflo(hq.z) + (float)acc[2].x * mulv, bfhi(hq.z) + (float)acc[2].y * mulv); ho.w = pk2(bflo(hq.w) + (float)acc[3].x * mulv, bfhi(hq.w) + (float)acc[3].y * mulv);
                    *hr = ho;
                }
                if (itk == 32) break;
                hqn = *(const GAS v4u*)(A + (size_t)((half * 256 + itk * 8 + wave) * 64 + lane) * D + sl * 8);
                accu[0] = accu[1] = accu[2] = accu[3] = 0u;
                VSTEPQ(2); VSTEPQ(3); VSTEPQ(4); VSTEPQ(5); VSTEPQ(6); VSTEPQ(7); VSTEPQ(8); VSTEPQ(9); VSTEPQ(10); VSTEPQ(11); VSTEPQ(12); VSTEPQ(13); VSTEPQ(14); VSTEPQ(15);
            }
#undef VTB
#undef VG
#undef VC
#undef VSTEPQ
#undef VREFILL
#undef VG2
#undef VFMA
#undef VC2
        }
    }
    xcd_barrier(bar); TSTAMP();

#ifdef EXTRA_BARRIERS
    for (int eb = 0; eb < EXTRA_BARRIERS; ++eb) xcd_barrier(bar);
#endif
    asm volatile("; ===== PHASE 15 =====");
    if (PH(15)) for (int rep = 0; rep < NREP(15); ++rep) {
        PH_LANES; const bool dummy = rep < NREP(15) - 1; (void)dummy;
        const GAS f32x4* gr = (const GAS f32x4*)(g_final + 16 * lane); const f32x4 g0 = gr[0], g1 = gr[1], g2 = gr[2], g3 = gr[3];
#pragma unroll 1
        for (int t = gw; t < T; t += 16 * NGW) {
            v4u q0[16], q1[16];
#pragma unroll
            for (int j = 0; j < 16; ++j) { const int tj = t + j * NGW < T ? t + j * NGW : t; const GAS v4u* hr = (const GAS v4u*)(A + (size_t)tj * D + 16 * lane); q0[j] = hr[0]; q1[j] = hr[1]; }
            __builtin_amdgcn_sched_barrier(0);
#pragma unroll
            for (int j = 0; j < 16; ++j) { if (t + j * NGW >= T) break;
                GAS f32x4* orow = (GAS f32x4*)(out + (size_t)(t + j * NGW) * D + 16 * lane);
                f32x4 o[4] = {(f32x4){bflo(q0[j].x), bfhi(q0[j].x), bflo(q0[j].y), bfhi(q0[j].y)}, (f32x4){bflo(q0[j].z), bfhi(q0[j].z), bflo(q0[j].w), bfhi(q0[j].w)},
                              (f32x4){bflo(q1[j].x), bfhi(q1[j].x), bflo(q1[j].y), bfhi(q1[j].y)}, (f32x4){bflo(q1[j].z), bfhi(q1[j].z), bflo(q1[j].w), bfhi(q1[j].w)}};
                float ss = 0.f;
#pragma unroll
                for (int k = 0; k < 4; ++k) ss += (o[k].x * o[k].x + o[k].y * o[k].y) + (o[k].z * o[k].z + o[k].w * o[k].w);
                const float r = rsqrtf(wave_sum(ss) * (1.f / 1024.f) + RMS_EPS);
                orow[0] = o[0] * r * g0; orow[1] = o[1] * r * g1; orow[2] = o[2] * r * g2; orow[3] = o[3] * r * g3; }
        }
    }
}

extern "C" void kernel_launch(void* const* d_in, const int* in_sizes, int n_in, void* d_out, int out_size, void* d_ws, size_t ws_size, hipStream_t stream) {
    static int grid = 0;
    if (grid == 0) {
        if (n_in != 19 || out_size != T * D || ws_size < WS_END) { fprintf(stderr, "kernel_launch: unexpected problem (n_in %d, out %d, ws %zu < %zu); nothing launched\n", n_in, out_size, ws_size, (size_t)WS_END); grid = -1; return; }
        int dev = 0, cus = 0, per_cu = 0;
        if (hipGetDevice(&dev) != hipSuccess || hipDeviceGetAttribute(&cus, hipDeviceAttributeMultiprocessorCount, dev) != hipSuccess) { grid = -1; return; }
        if (hipFuncSetAttribute((const void*)mk_fwd, hipFuncAttributeMaxDynamicSharedMemorySize, LDS_BYTES) != hipSuccess) { fprintf(stderr, "kernel_launch: hipFuncSetAttribute failed\n"); grid = -1; return; }
        if (hipOccupancyMaxActiveBlocksPerMultiprocessor(&per_cu, (const void*)mk_fwd, NWAVES * 64, LDS_BYTES) != hipSuccess || per_cu < 1) { fprintf(stderr, "kernel_launch: occupancy query says %d blocks per CU\n", per_cu); }
        (void)hipGetLastError();
        grid = cus;
    }
    if (grid < 0) return;
    if (hipMemsetAsync((char*)d_ws + WS_CTL, 0, CTL_ZERO_BYTES, stream) != hipSuccess) return;
    Args a{};
    for (int i = 0; i < 19; ++i) a.in[i] = (const float*)d_in[i];
    a.out = (float*)d_out; a.ws = (unsigned char*)d_ws;
    hipLaunchKernelGGL(mk_fwd, dim3(grid), dim3(NWAVES * 64), LDS_BYTES, stream, a);
}
```
